# Optimizing an MI355X kernel written in HIP

```python
import jax, jax.numpy as jnp
from jax import lax
import numpy as np

D_MODEL = 1024
BATCH = 2
SEQ = 8192
DEPTH = 1

MLA_HEADS = 8
QK_NOPE = 64
QK_ROPE = 32
QK_HEAD = QK_NOPE + QK_ROPE
V_HEAD = 64
Q_LORA = 256
KV_LORA = 128
ROPE_THETA = 10000.0
Q_BLOCK = 128
CONV_GROUPS = 8
CONV_WIDTH = 512
CONV_K = 3
N_EXPERTS = 32
TOP_K = 4
D_FF = D_MODEL
SWIGLU_LIMIT = 7.0
SWIGLU_ALPHA = 1.702
EXPERT_BLOCK = 256
EPS = 1e-6
IN_SIZES = (Q_LORA, KV_LORA, QK_ROPE, CONV_WIDTH, CONV_WIDTH, CONV_WIDTH, D_MODEL, D_MODEL)
IN_COLS = sum(IN_SIZES)
IN_SPLITS = tuple(int(s) for s in np.cumsum(IN_SIZES)[:-1])

kernel_name = 'hybrid_mla_shortconv_moe_encoder'


def rms_norm(x, g):
    xf = x.astype(jnp.float32)
    y = xf * lax.rsqrt(jnp.mean(xf * xf, axis=-1, keepdims=True) + EPS)
    return (y * g.astype(jnp.float32)).astype(x.dtype)


def rope_tables(positions, dtype):
    inv_freq = ROPE_THETA ** (-jnp.arange(0, QK_ROPE, 2, dtype=jnp.float32) / QK_ROPE)
    ang = positions.astype(jnp.float32)[..., None] * inv_freq
    return jnp.cos(ang)[:, :, None, :].astype(dtype), jnp.sin(ang)[:, :, None, :].astype(dtype)


def apply_rope(t, cos, sin):
    t1, t2 = t[..., :QK_ROPE // 2], t[..., QK_ROPE // 2:]
    return jnp.concatenate([t1 * cos - t2 * sin, t1 * sin + t2 * cos], axis=-1)


def dense_attention(q, k, v):
    B, S, H, _ = q.shape
    nb = S // Q_BLOCK
    qb = q.reshape(B, nb, Q_BLOCK, H, QK_HEAD).transpose(1, 0, 3, 2, 4)
    kt = k.transpose(0, 2, 1, 3)
    vt = v.transpose(0, 2, 1, 3)
    scale = QK_HEAD ** -0.5

    def one_block(q_blk):
        s = jnp.einsum('bhqd,bhkd->bhqk', q_blk, kt, preferred_element_type=jnp.float32) * scale
        p = jax.nn.softmax(s, axis=-1)
        return jnp.einsum('bhqk,bhkd->bhqd', p.astype(vt.dtype), vt)

    o = lax.map(one_block, qb)
    return o.transpose(1, 0, 3, 2, 4).reshape(B, S, H * V_HEAD)


def mla_branch(c_q, c_kv, k_rope, cos, sin, q_a_g, kv_a_g, w_uq, w_ukv, q_g, k_g, w_o_mla):
    B, S, _ = c_q.shape
    q = (rms_norm(c_q, q_a_g) @ w_uq).reshape(B, S, MLA_HEADS, QK_HEAD)
    kv = (rms_norm(c_kv, kv_a_g) @ w_ukv).reshape(B, S, MLA_HEADS, QK_NOPE + V_HEAD)
    k_nope, v = kv[..., :QK_NOPE], kv[..., QK_NOPE:]
    k_r = jnp.broadcast_to(k_rope[:, :, None, :], (B, S, MLA_HEADS, QK_ROPE))
    k = jnp.concatenate([k_nope, k_r], axis=-1)
    q = rms_norm(q, q_g)
    k = rms_norm(k, k_g)
    q = jnp.concatenate([q[..., :QK_NOPE], apply_rope(q[..., QK_NOPE:], cos, sin)], axis=-1)
    k = jnp.concatenate([k[..., :QK_NOPE], apply_rope(k[..., QK_NOPE:], cos, sin)], axis=-1)
    return dense_attention(q, k, v) @ w_o_mla


def short_conv_branch(u, c_gate, b_gate, conv_w, w_o_conv):
    cu = c_gate * u
    p = jnp.pad(cu, ((0, 0), (1, 1), (0, 0)))
    y = conv_w[0] * p[:, :-2] + conv_w[1] * p[:, 1:-1] + conv_w[2] * p[:, 2:]
    return (b_gate * y) @ w_o_conv


def moe(h, router_w, router_b, w1, b1, w2, b2):
    B, S, D = h.shape
    n_tok = B * S
    hf = h.reshape(n_tok, D)
    logits = (hf @ router_w + router_b).astype(jnp.float32)
    top_v, top_i = lax.top_k(logits, TOP_K)
    top_w = jax.nn.softmax(top_v, axis=-1).astype(h.dtype)

    nk = n_tok * TOP_K
    e_flat = top_i.reshape(nk)
    w_flat = top_w.reshape(nk)
    tok_flat = jnp.arange(nk, dtype=jnp.int32) // TOP_K
    order = jnp.argsort(e_flat)
    e_sorted = e_flat[order]
    counts = jnp.bincount(e_flat, length=N_EXPERTS)
    group_start = jnp.cumsum(counts) - counts
    padded = (counts + EXPERT_BLOCK - 1) // EXPERT_BLOCK * EXPERT_BLOCK
    pad_end = jnp.cumsum(padded)
    pad_start = pad_end - padded
    rank = jnp.arange(nk, dtype=jnp.int32) - group_start[e_sorted]
    dest = pad_start[e_sorted] + rank
    n_blocks = (nk + N_EXPERTS * (EXPERT_BLOCK - 1) + EXPERT_BLOCK - 1) // EXPERT_BLOCK
    rows = n_blocks * EXPERT_BLOCK
    row_tok = jnp.zeros((rows,), jnp.int32).at[dest].set(tok_flat[order])
    row_w = jnp.zeros((rows,), h.dtype).at[dest].set(w_flat[order])
    block_exp = jnp.clip(jnp.searchsorted(pad_end, jnp.arange(n_blocks, dtype=jnp.int32) * EXPERT_BLOCK,
                                          side='right'), 0, N_EXPERTS - 1)
    xs = hf[row_tok].reshape(n_blocks, EXPERT_BLOCK, D)

    def expert_block(args):
        xb, e = args
        hm = xb @ w1[e] + b1[e]
        gate, up = hm[:, :D_FF], hm[:, D_FF:]
        gate = jnp.minimum(gate, SWIGLU_LIMIT)
        up = jnp.clip(up, -SWIGLU_LIMIT, SWIGLU_LIMIT)
        glu = gate * jax.nn.sigmoid(SWIGLU_ALPHA * gate)
        return ((up + 1.0) * glu) @ w2[e] + b2[e]

    ys = lax.map(expert_block, (xs, block_exp)).reshape(rows, D) * row_w[:, None]
    out = jax.ops.segment_sum(ys, row_tok, num_segments=n_tok)
    return out.reshape(B, S, D)


def setup_inputs(seed: int = 0) -> dict:
    key = jax.random.key(seed)
    ks = jax.random.split(key, 24)
    L = DEPTH

    def nrm(k, shape, fan_in):
        return jax.random.normal(k, shape, jnp.float32) * fan_in ** -0.5

    def gain(k, n):
        return 1.0 + 0.02 * jax.random.normal(k, (L, n), jnp.float32)

    x = jax.random.normal(ks[0], (BATCH, SEQ, D_MODEL), jnp.float32)
    offs = jax.random.randint(ks[1], (BATCH, 1), 0, 1024, dtype=jnp.int32)
    positions = jnp.arange(SEQ, dtype=jnp.int32)[None, :] + offs
    return {
        'x': x,
        'positions': positions,
        'norm1_g': gain(ks[2], D_MODEL),
        'w_in': nrm(ks[3], (L, D_MODEL, IN_COLS), D_MODEL),
        'q_a_norm_g': gain(ks[4], Q_LORA),
        'kv_a_norm_g': gain(ks[5], KV_LORA),
        'w_uq': nrm(ks[6], (L, Q_LORA, MLA_HEADS * QK_HEAD), Q_LORA),
        'w_ukv': nrm(ks[7], (L, KV_LORA, MLA_HEADS * (QK_NOPE + V_HEAD)), KV_LORA),
        'q_norm_g': gain(ks[8], QK_HEAD),
        'k_norm_g': gain(ks[9], QK_HEAD),
        'conv_w': nrm(ks[10], (L, CONV_K, CONV_WIDTH), CONV_K),
        'w_o_mla': nrm(ks[11], (L, MLA_HEADS * V_HEAD, D_MODEL), MLA_HEADS * V_HEAD),
        'w_o_conv': nrm(ks[12], (L, CONV_WIDTH, D_MODEL), CONV_WIDTH),
        'w_o': nrm(ks[13], (L, D_MODEL, D_MODEL), D_MODEL),
        'norm2_g': gain(ks[14], D_MODEL),
        'router_w': nrm(ks[15], (L, D_MODEL, N_EXPERTS), D_MODEL),
        'router_b': 0.01 * jax.random.normal(ks[16], (L, N_EXPERTS), jnp.float32),
        'expert_w1': nrm(ks[17], (L, N_EXPERTS, D_MODEL, 2 * D_FF), D_MODEL),
        'expert_b1': 0.01 * jax.random.normal(ks[18], (L, N_EXPERTS, 2 * D_FF), jnp.float32),
        'expert_w2': nrm(ks[19], (L, N_EXPERTS, D_FF, D_MODEL), D_FF),
        'expert_b2': 0.01 * jax.random.normal(ks[20], (L, N_EXPERTS, D_MODEL), jnp.float32),
    }


def reference(x, positions, norm1_g, w_in, q_a_norm_g, kv_a_norm_g, w_uq, w_ukv, q_norm_g, k_norm_g,
              conv_w, w_o_mla, w_o_conv, w_o, norm2_g, router_w, router_b,
              expert_w1, expert_b1, expert_w2, expert_b2):
    cos, sin = rope_tables(positions, x.dtype)
    for l in range(DEPTH):
        h = rms_norm(x, norm1_g[l])
        proj = h @ w_in[l]
        c_q, c_kv, k_rope, u, c_gate, b_gate, g_a, g_b = jnp.split(proj, IN_SPLITS, axis=-1)
        y_a = mla_branch(c_q, c_kv, k_rope, cos, sin, q_a_norm_g[l], kv_a_norm_g[l], w_uq[l], w_ukv[l],
                         q_norm_g[l], k_norm_g[l], w_o_mla[l])
        y_b = short_conv_branch(u, c_gate, b_gate, conv_w[l], w_o_conv[l])
        merged = jax.nn.sigmoid(g_a) * y_a + jax.nn.sigmoid(g_b) * y_b
        x = x + merged @ w_o[l]
        h2 = rms_norm(x, norm2_g[l])
        x = x + moe(h2, router_w[l], router_b[l], expert_w1[l], expert_b1[l], expert_w2[l], expert_b2[l])
    return x
```

```cpp
#include <hip/hip_runtime.h>
#include <hip/hip_cooperative_groups.h>
#include <cstdio>
#include <cstdint>
namespace cg = cooperative_groups;

typedef unsigned short bf16_t;
typedef short bf16x8 __attribute__((ext_vector_type(8)));
typedef short s16x4 __attribute__((ext_vector_type(4)));
typedef float f32x4 __attribute__((ext_vector_type(4)));
typedef float f32x2 __attribute__((ext_vector_type(2)));
typedef float f32x16 __attribute__((ext_vector_type(16)));
typedef unsigned u32x4 __attribute__((ext_vector_type(4)));
typedef unsigned u32x2 __attribute__((ext_vector_type(2)));
typedef __bf16 bf16x2_t __attribute__((ext_vector_type(2)));

constexpr int NTOK = 16384, DM = 1024, SEQ = 8192;
constexpr int INC = 4000, INCP = 4096;
constexpr int OFF_CQ = 0, OFF_CKV = 256, OFF_KR = 384, OFF_U = 416, OFF_C = 928, OFF_B = 1440, OFF_GA = 1952, OFF_GB = 2976;
constexpr int NH = 8, DQK = 96, DV = 64, NE = 32, TOPK = 4, DFF = 1024;
constexpr int QLORA = 256, KVLORA = 128, CONVW = 512;
constexpr int NPAIR = NTOK * TOPK;
constexpr int MAXROWS = 73728;
constexpr float EPS = 1e-6f;
constexpr int NTHREADS = 512, NWAVES = 8;
constexpr int LDS_BYTES = 147456;

constexpr size_t MiB = 1ull << 20;
constexpr size_t WS_CTL = 0;
constexpr size_t WS_WIN = 1 * MiB;
constexpr size_t WS_WUQ = 9 * MiB;
constexpr size_t WS_WUKV = WS_WUQ + 512 * 1024;
constexpr size_t WS_WOMLA = 10 * MiB;
constexpr size_t WS_WOCONV = 11 * MiB;
constexpr size_t WS_WO = 12 * MiB;
constexpr size_t WS_ROUTE = 14 * MiB;
constexpr size_t WS_W1 = 18 * MiB;
constexpr size_t WS_W2 = 146 * MiB;
constexpr size_t WS_XN = 210 * MiB;
constexpr size_t WS_PROJ = 242 * MiB;
constexpr size_t WS_CQN = 370 * MiB;
constexpr size_t WS_CKVN = 378 * MiB;
constexpr size_t WS_YBIN = 386 * MiB;
constexpr size_t WS_QPRE = 402 * MiB;
constexpr size_t WS_KVPRE = 450 * MiB;
constexpr size_t WS_Q = 514 * MiB;
constexpr size_t WS_K = 538 * MiB;
constexpr size_t WS_V = 570 * MiB;
constexpr size_t WS_AO = 586 * MiB;
constexpr size_t WS_M1 = 602 * MiB;
constexpr size_t WS_MERGED = 666 * MiB;
constexpr size_t WS_YS = 698 * MiB;
constexpr size_t WS_END = 826 * MiB;
constexpr size_t WS_ACT = WS_PROJ;
constexpr size_t WS_H2 = WS_XN;
constexpr size_t RT_PAIR_E = 0, RT_PAIR_RANK = 262144, RT_PAIR_W = 524288, RT_ROW_TOK = 786432, RT_ROW_W = 786432 + 294912, RT_ROW_SLOT = 786432 + 2 * 294912;
constexpr int CW_CNT = 64;

struct Params {
    const float* x; const int* pos; const float* norm1_g; const float* w_in; const float* q_a_g; const float* kv_a_g;
    const float* w_uq; const float* w_ukv; const float* q_g; const float* k_g; const float* conv_w; const float* w_o_mla;
    const float* w_o_conv; const float* w_o; const float* norm2_g; const float* router_w; const float* router_b;
    const float* w1; const float* b1; const float* w2; const float* b2;
    float* out; unsigned char* ws; int ph_lo, ph_hi;
};

__device__ __forceinline__ unsigned pk2(float lo, float hi) { f32x2 v = {lo, hi}; bf16x2_t b = __builtin_convertvector(v, bf16x2_t); return __builtin_bit_cast(unsigned, b); }
__device__ __forceinline__ float bf_lo(unsigned w) { return __uint_as_float(w << 16); }
__device__ __forceinline__ float bf_hi(unsigned w) { return __uint_as_float(w & 0xffff0000u); }
__device__ __forceinline__ float bf1(bf16_t h) { return __uint_as_float((unsigned)h << 16); }
__device__ __forceinline__ float wave_sum(float v) {
#pragma unroll
    for (int o = 1; o < 64; o <<= 1) v += __shfl_xor(v, o);
    return v;
}
__device__ __forceinline__ float sigmoidf_(float v) { return 1.f / (1.f + __expf(-v)); }

constexpr int SG_BM = 256, SG_BN = 128, SG_BK = 32;
template <class Epi>
__device__ __forceinline__ void sgemm_tile(unsigned char* lds, const bf16_t* __restrict__ A, const int* __restrict__ arow, const bf16_t* __restrict__ Bt,
                                           int K, int r0, int c0, const Epi& E) {
    const int tid = threadIdx.x, wid = tid >> 6, lane = tid & 63, wr = wid >> 1, wc = wid & 1, fr = lane & 15, fq = lane >> 4;
    unsigned char* SA = lds; unsigned char* SB = lds + 16384;
    const bf16_t* ap[2];
#pragma unroll
    for (int i = 0; i < 2; ++i) { const int p = tid + i * 512, r = p >> 2, c = (p & 3) * 8; const int ar = arow ? arow[r0 + r] : (r0 + r); ap[i] = A + (size_t)ar * K + c; }
    const bf16_t* bp; { const int r = tid >> 2, c = (tid & 3) * 8; bp = Bt + (size_t)(c0 + r) * K + c; }
    f32x4 acc[4][4];
#pragma unroll
    for (int m = 0; m < 4; ++m)
#pragma unroll
        for (int n = 0; n < 4; ++n) acc[m][n] = (f32x4){0.f, 0.f, 0.f, 0.f};
    const int nt = K / SG_BK;
    for (int t = 0; t < nt; ++t) {
#pragma unroll
        for (int i = 0; i < 2; ++i)
            __builtin_amdgcn_global_load_lds((const unsigned*)(ap[i] + t * SG_BK), (__attribute__((address_space(3))) unsigned*)(SA + (tid + i * 512) * 16), 16, 0, 0);
        __builtin_amdgcn_global_load_lds((const unsigned*)(bp + t * SG_BK), (__attribute__((address_space(3))) unsigned*)(SB + tid * 16), 16, 0, 0);
        asm volatile("s_waitcnt vmcnt(0)" ::: "memory");
        __syncthreads();
        bf16x8 af[4], bfr[4];
#pragma unroll
        for (int m = 0; m < 4; ++m) af[m] = *(const bf16x8*)(SA + ((wr * 64 + m * 16 + fr) * SG_BK + fq * 8) * 2);
#pragma unroll
        for (int n = 0; n < 4; ++n) bfr[n] = *(const bf16x8*)(SB + ((wc * 64 + n * 16 + fr) * SG_BK + fq * 8) * 2);
#pragma unroll
        for (int m = 0; m < 4; ++m)
#pragma unroll
            for (int n = 0; n < 4; ++n) acc[m][n] = __builtin_amdgcn_mfma_f32_16x16x32_bf16(bfr[n], af[m], acc[m][n], 0, 0, 0);
        __syncthreads();
    }
    E(acc, r0 + wr * 64, c0 + wc * 64, fr, fq);
}

struct EpiProj {
    bf16_t* O;
    __device__ __forceinline__ void operator()(const f32x4 (&acc)[4][4], int rw, int cw, int fr, int fq) const {
#pragma unroll
        for (int m = 0; m < 4; ++m)
#pragma unroll
            for (int n = 0; n < 4; ++n) { const int row = rw + m * 16 + fr, col = cw + n * 16 + fq * 4; f32x4 v = acc[m][n];
                if (col >= OFF_GA && col < INC) { v[0] = sigmoidf_(v[0]); v[1] = sigmoidf_(v[1]); v[2] = sigmoidf_(v[2]); v[3] = sigmoidf_(v[3]); }
                u32x2 w; w.x = pk2(v[0], v[1]); w.y = pk2(v[2], v[3]); *(u32x2*)(O + (size_t)row * INCP + col) = w; }
    }
};
struct EpiF32 {
    float* O; int ldc;
    __device__ __forceinline__ void operator()(const f32x4 (&acc)[4][4], int rw, int cw, int fr, int fq) const {
#pragma unroll
        for (int m = 0; m < 4; ++m)
#pragma unroll
            for (int n = 0; n < 4; ++n) { const int row = rw + m * 16 + fr, col = cw + n * 16 + fq * 4; *(f32x4*)(O + (size_t)row * ldc + col) = acc[m][n]; }
    }
};
struct EpiGateA {
    float* M1; const bf16_t* proj;
    __device__ __forceinline__ void operator()(const f32x4 (&acc)[4][4], int rw, int cw, int fr, int fq) const {
#pragma unroll
        for (int m = 0; m < 4; ++m)
#pragma unroll
            for (int n = 0; n < 4; ++n) { const int row = rw + m * 16 + fr, col = cw + n * 16 + fq * 4; const u32x2 g = *(const u32x2*)(proj + (size_t)row * INCP + OFF_GA + col);
                f32x4 v = acc[m][n]; v[0] *= bf_lo(g.x); v[1] *= bf_hi(g.x); v[2] *= bf_lo(g.y); v[3] *= bf_hi(g.y); *(f32x4*)(M1 + (size_t)row * DM + col) = v; }
    }
};
struct EpiGateB {
    const float* M1; const bf16_t* proj; bf16_t* O;
    __device__ __forceinline__ void operator()(const f32x4 (&acc)[4][4], int rw, int cw, int fr, int fq) const {
#pragma unroll
        for (int m = 0; m < 4; ++m)
#pragma unroll
            for (int n = 0; n < 4; ++n) { const int row = rw + m * 16 + fr, col = cw + n * 16 + fq * 4; const u32x2 g = *(const u32x2*)(proj + (size_t)row * INCP + OFF_GB + col);
                const f32x4 b = *(const f32x4*)(M1 + (size_t)row * DM + col); f32x4 v = acc[m][n];
                v[0] = b[0] + v[0] * bf_lo(g.x); v[1] = b[1] + v[1] * bf_hi(g.x); v[2] = b[2] + v[2] * bf_lo(g.y); v[3] = b[3] + v[3] * bf_hi(g.y);
                u32x2 w; w.x = pk2(v[0], v[1]); w.y = pk2(v[2], v[3]); *(u32x2*)(O + (size_t)row * DM + col) = w; }
    }
};
struct EpiResid {
    const float* X; float* O;
    __device__ __forceinline__ void operator()(const f32x4 (&acc)[4][4], int rw, int cw, int fr, int fq) const {
#pragma unroll
        for (int m = 0; m < 4; ++m)
#pragma unroll
            for (int n = 0; n < 4; ++n) { const int row = rw + m * 16 + fr, col = cw + n * 16 + fq * 4; const f32x4 b = *(const f32x4*)(X + (size_t)row * DM + col);
                *(f32x4*)(O + (size_t)row * DM + col) = b + acc[m][n]; }
    }
};
struct EpiSwiglu {
    bf16_t* ACT; const float* b1e;
    __device__ __forceinline__ void operator()(const f32x4 (&acc)[4][4], int rw, int cw, int fr, int fq) const {
#pragma unroll
        for (int m = 0; m < 4; ++m)
#pragma unroll
            for (int np = 0; np < 2; ++np) { const int row = rw + m * 16 + fr, f = (cw >> 1) + np * 16 + fq * 4;
                const f32x4 bg = *(const f32x4*)(b1e + f), bu = *(const f32x4*)(b1e + DFF + f); const f32x4 g4 = acc[m][2 * np] + bg, u4 = acc[m][2 * np + 1] + bu; float o[4];
#pragma unroll
                for (int j = 0; j < 4; ++j) { const float g = fminf(g4[j], 7.f), u = fminf(fmaxf(u4[j], -7.f), 7.f); const float glu = g * sigmoidf_(1.702f * g); o[j] = (u + 1.f) * glu; }
                u32x2 w; w.x = pk2(o[0], o[1]); w.y = pk2(o[2], o[3]); *(u32x2*)(ACT + (size_t)row * DFF + f) = w; }
    }
};
struct EpiMoeOut {
    bf16_t* YS; const float* b2e; const float* row_w; const int* row_slot;
    __device__ __forceinline__ void operator()(const f32x4 (&acc)[4][4], int rw, int cw, int fr, int fq) const {
#pragma unroll
        for (int m = 0; m < 4; ++m) { const int row = rw + m * 16 + fr; const int slot = row_slot[row]; const float w = row_w[row];
            if (slot >= 0) {
#pragma unroll
                for (int n = 0; n < 4; ++n) { const int col = cw + n * 16 + fq * 4; const f32x4 b = *(const f32x4*)(b2e + col); const f32x4 v = (acc[m][n] + b) * w;
                    u32x2 o; o.x = pk2(v[0], v[1]); o.y = pk2(v[2], v[3]); *(u32x2*)(YS + (size_t)slot * DM + col) = o; } } }
    }
};

template <class Epi>
__device__ __forceinline__ void sgemm_phase(unsigned char* lds, const bf16_t* A, const bf16_t* Bt, int M, int N, int K, const Epi& E) {
    const int nN = N / SG_BN, nU = (M / SG_BM) * nN;
    for (int u = blockIdx.x; u < nU; u += gridDim.x) { const int pm = u / nN, pn = u % nN; sgemm_tile(lds, A, nullptr, Bt, K, pm * SG_BM, pn * SG_BN, E); }
}

template <int MODE  >
__device__ __forceinline__ void transpose_item(const float* __restrict__ W, int K, int N, bf16_t* __restrict__ WT, const float* __restrict__ gain, float* scr, int item, int lane) {
    const int nblk = N / 32, kb = item / nblk, nb = item % nblk, k0 = 64 * kb, n0 = 32 * nb;
#pragma unroll
    for (int i = 0; i < 8; ++i) { const int kk = 8 * i + (lane >> 3), n4 = (lane & 7) * 4; f32x4 v = *(const f32x4*)(W + (size_t)(k0 + kk) * N + n0 + n4);
        if (gain) { const float g = gain[k0 + kk]; v = v * g; }
        float* s = scr + kk * 33 + n4; s[0] = v[0]; s[1] = v[1]; s[2] = v[2]; s[3] = v[3]; }
    asm volatile("s_waitcnt lgkmcnt(0)" ::: "memory");
    const int c = lane & 7;
#pragma unroll
    for (int j = 0; j < 4; ++j) { const int n = (lane >> 3) + 8 * j; const float* s = scr + (8 * c) * 33 + n;
        u32x4 o; o.x = pk2(s[0 * 33], s[1 * 33]); o.y = pk2(s[2 * 33], s[3 * 33]); o.z = pk2(s[4 * 33], s[5 * 33]); o.w = pk2(s[6 * 33], s[7 * 33]);
        int row = n0 + n;
        if (MODE == 1) { const int f = row & 1023; row = ((f >> 4) << 5) + ((row >> 10) << 4) + (f & 15); }
        *(u32x4*)(WT + (size_t)row * K + k0 + 8 * c) = o; }
    asm volatile("s_waitcnt lgkmcnt(0)" ::: "memory");
}
__device__ __forceinline__ void phase_prologue(const Params& p, unsigned char* lds) {
    const int tid = threadIdx.x, lane = tid & 63, wave = tid >> 6;
    float* scr = (float*)(lds + wave * 16384);
    const int gw = blockIdx.x * NWAVES + wave, NGW = gridDim.x * NWAVES;
    unsigned char* ws = p.ws;
    constexpr int I_WIN = (DM / 64) * (INC / 32), I_UQ = (QLORA / 64) * (768 / 32), I_UKV = (KVLORA / 64) * (1024 / 32), I_OM = (512 / 64) * (DM / 32), I_OC = I_OM, I_WO = (DM / 64) * (DM / 32);
    constexpr int I_W1 = (DM / 64) * (2048 / 32), I_W2 = (DFF / 64) * (DM / 32);
    constexpr int NSMALL = I_WIN + I_UQ + I_UKV + I_OM + I_OC + I_WO;
    constexpr int NITEMS = NSMALL + NE * (I_W1 + I_W2);
    for (int it = gw; it < NITEMS; it += NGW) {
        int r = it;
        if (r < I_WIN) { transpose_item<0>(p.w_in, DM, INC, (bf16_t*)(ws + WS_WIN), p.norm1_g, scr, r, lane); continue; } r -= I_WIN;
        if (r < I_UQ) { transpose_item<0>(p.w_uq, QLORA, 768, (bf16_t*)(ws + WS_WUQ), p.q_a_g, scr, r, lane); continue; } r -= I_UQ;
        if (r < I_UKV) { transpose_item<0>(p.w_ukv, KVLORA, 1024, (bf16_t*)(ws + WS_WUKV), p.kv_a_g, scr, r, lane); continue; } r -= I_UKV;
        if (r < I_OM) { transpose_item<0>(p.w_o_mla, 512, DM, (bf16_t*)(ws + WS_WOMLA), nullptr, scr, r, lane); continue; } r -= I_OM;
        if (r < I_OC) { transpose_item<0>(p.w_o_conv, 512, DM, (bf16_t*)(ws + WS_WOCONV), nullptr, scr, r, lane); continue; } r -= I_OC;
        if (r < I_WO) { transpose_item<0>(p.w_o, DM, DM, (bf16_t*)(ws + WS_WO), nullptr, scr, r, lane); continue; } r -= I_WO;
        const int e = r / (I_W1 + I_W2); r -= e * (I_W1 + I_W2);
        if (r < I_W1) transpose_item<1>(p.w1 + (size_t)e * DM * 2048, DM, 2048, (bf16_t*)(ws + WS_W1) + (size_t)e * 2048 * DM, nullptr, scr, r, lane);
        else transpose_item<0>(p.w2 + (size_t)e * DFF * DM, DFF, DM, (bf16_t*)(ws + WS_W2) + (size_t)e * DM * DFF, nullptr, scr, r - I_W1, lane);
    }
    { u32x4* z = (u32x4*)((bf16_t*)(ws + WS_WIN) + (size_t)INC * DM); const int nz = (INCP - INC) * DM * 2 / 16;
      for (int i = blockIdx.x * NTHREADS + tid; i < nz; i += gridDim.x * NTHREADS) z[i] = (u32x4){0u, 0u, 0u, 0u}; }
    { int* rt = (int*)(ws + WS_ROUTE + RT_ROW_TOK); float* rw = (float*)(ws + WS_ROUTE + RT_ROW_W); int* rs = (int*)(ws + WS_ROUTE + RT_ROW_SLOT);
      for (int i = blockIdx.x * NTHREADS + tid; i < MAXROWS; i += gridDim.x * NTHREADS) { rt[i] = 0; rw[i] = 0.f; rs[i] = -1; } }
    bf16_t* XN = (bf16_t*)(ws + WS_XN);
    for (int m = gw; m < NTOK; m += NGW) {
        const f32x4* xr = (const f32x4*)(p.x + (size_t)m * DM) + lane; f32x4 v[4]; float s = 0.f;
#pragma unroll
        for (int j = 0; j < 4; ++j) { v[j] = xr[64 * j]; s += (v[j][0] * v[j][0] + v[j][1] * v[j][1]) + (v[j][2] * v[j][2] + v[j][3] * v[j][3]); }
        const float rstd = rsqrtf(wave_sum(s) * (1.f / DM) + EPS);
        u32x2* o = (u32x2*)(XN + (size_t)m * DM) + lane;
#pragma unroll
        for (int j = 0; j < 4; ++j) { u32x2 w; w.x = pk2(v[j][0] * rstd, v[j][1] * rstd); w.y = pk2(v[j][2] * rstd, v[j][3] * rstd); o[64 * j] = w; }
    }
}

__device__ __forceinline__ void phase_tok_a(const Params& p) {
    const int tid = threadIdx.x, lane = tid & 63, wave = tid >> 6;
    const int gw = blockIdx.x * NWAVES + wave, NGW = gridDim.x * NWAVES;
    const bf16_t* PROJ = (const bf16_t*)(p.ws + WS_PROJ); bf16_t* CQN = (bf16_t*)(p.ws + WS_CQN); bf16_t* CKVN = (bf16_t*)(p.ws + WS_CKVN); bf16_t* YB = (bf16_t*)(p.ws + WS_YBIN);
    float cw0[8], cw1[8], cw2[8];
#pragma unroll
    for (int j = 0; j < 8; ++j) { cw0[j] = p.conv_w[8 * lane + j]; cw1[j] = p.conv_w[CONVW + 8 * lane + j]; cw2[j] = p.conv_w[2 * CONVW + 8 * lane + j]; }
    for (int t = gw; t < NTOK; t += NGW) {
        const bf16_t* pr = PROJ + (size_t)t * INCP;
        { const u32x2 w = *(const u32x2*)(pr + OFF_CQ + 4 * lane); const float a = bf_lo(w.x), b = bf_hi(w.x), c = bf_lo(w.y), d = bf_hi(w.y);
          const float rstd = rsqrtf(wave_sum(a * a + b * b + c * c + d * d) * (1.f / QLORA) + EPS);
          u32x2 o; o.x = pk2(a * rstd, b * rstd); o.y = pk2(c * rstd, d * rstd); *(u32x2*)(CQN + (size_t)t * QLORA + 4 * lane) = o; }
        { const unsigned w = *(const unsigned*)(pr + OFF_CKV + 2 * lane); const float a = bf_lo(w), b = bf_hi(w);
          const float rstd = rsqrtf(wave_sum(a * a + b * b) * (1.f / KVLORA) + EPS);
          *(unsigned*)(CKVN + (size_t)t * KVLORA + 2 * lane) = pk2(a * rstd, b * rstd); }
        { const int s = t & (SEQ - 1); float cu[3][8];
#pragma unroll
          for (int d = 0; d < 3; ++d) { const int ss = s + d - 1; if (ss >= 0 && ss < SEQ) { const bf16_t* q = pr + (ptrdiff_t)(d - 1) * INCP; const u32x4 u = *(const u32x4*)(q + OFF_U + 8 * lane), c = *(const u32x4*)(q + OFF_C + 8 * lane);
                  cu[d][0] = bf_lo(u.x) * bf_lo(c.x); cu[d][1] = bf_hi(u.x) * bf_hi(c.x); cu[d][2] = bf_lo(u.y) * bf_lo(c.y); cu[d][3] = bf_hi(u.y) * bf_hi(c.y);
                  cu[d][4] = bf_lo(u.z) * bf_lo(c.z); cu[d][5] = bf_hi(u.z) * bf_hi(c.z); cu[d][6] = bf_lo(u.w) * bf_lo(c.w); cu[d][7] = bf_hi(u.w) * bf_hi(c.w); }
              else {
#pragma unroll
                  for (int j = 0; j < 8; ++j) cu[d][j] = 0.f; } }
          const u32x4 bg = *(const u32x4*)(pr + OFF_B + 8 * lane); float bb[8] = {bf_lo(bg.x), bf_hi(bg.x), bf_lo(bg.y), bf_hi(bg.y), bf_lo(bg.z), bf_hi(bg.z), bf_lo(bg.w), bf_hi(bg.w)}; float y[8];
#pragma unroll
          for (int j = 0; j < 8; ++j) y[j] = bb[j] * (cw0[j] * cu[0][j] + cw1[j] * cu[1][j] + cw2[j] * cu[2][j]);
          u32x4 o; o.x = pk2(y[0], y[1]); o.y = pk2(y[2], y[3]); o.z = pk2(y[4], y[5]); o.w = pk2(y[6], y[7]); *(u32x4*)(YB + (size_t)t * CONVW + 8 * lane) = o; }
    }
}

__device__ __forceinline__ void phase_tok_b(const Params& p) {
    const int tid = threadIdx.x, lane = tid & 63, wave = tid >> 6, h = lane >> 3, sub = lane & 7;
    const int gw = blockIdx.x * NWAVES + wave, NGW = gridDim.x * NWAVES;
    const float* QPRE = (const float*)(p.ws + WS_QPRE); const float* KVPRE = (const float*)(p.ws + WS_KVPRE); const bf16_t* PROJ = (const bf16_t*)(p.ws + WS_PROJ);
    bf16_t* Q = (bf16_t*)(p.ws + WS_Q); bf16_t* Kb = (bf16_t*)(p.ws + WS_K); bf16_t* V = (bf16_t*)(p.ws + WS_V);
    float qg[12], kg[12];
#pragma unroll
    for (int j = 0; j < 8; ++j) { qg[j] = p.q_g[sub * 8 + j]; kg[j] = p.k_g[sub * 8 + j]; }
    qg[8] = p.q_g[64 + 2 * sub]; qg[9] = p.q_g[65 + 2 * sub]; qg[10] = p.q_g[80 + 2 * sub]; qg[11] = p.q_g[81 + 2 * sub];
    kg[8] = p.k_g[64 + 2 * sub]; kg[9] = p.k_g[65 + 2 * sub]; kg[10] = p.k_g[80 + 2 * sub]; kg[11] = p.k_g[81 + 2 * sub];
    const float if0 = exp2f(-(float)(2 * sub) * (13.287712379549449f / 16.f)), if1 = exp2f(-(float)(2 * sub + 1) * (13.287712379549449f / 16.f));
    for (int t = gw; t < NTOK; t += NGW) {
        const int b = t >> 13, s = t & (SEQ - 1); const float pos = (float)p.pos[t];
        float c0, s0, c1, s1; sincosf(pos * if0, &s0, &c0); sincosf(pos * if1, &s1, &c1);
        const size_t rowi = ((size_t)(b * NH + h) * SEQ + s);
        { const float* qp = QPRE + (size_t)t * 768 + h * DQK; const f32x4 a = *(const f32x4*)(qp + sub * 8), bq = *(const f32x4*)(qp + sub * 8 + 4); const f32x2 r1 = *(const f32x2*)(qp + 64 + 2 * sub), r2 = *(const f32x2*)(qp + 80 + 2 * sub);
          float v[12] = {a[0], a[1], a[2], a[3], bq[0], bq[1], bq[2], bq[3], r1[0], r1[1], r2[0], r2[1]}; float ss = 0.f;
#pragma unroll
          for (int j = 0; j < 12; ++j) ss += v[j] * v[j];
          ss += __shfl_xor(ss, 1); ss += __shfl_xor(ss, 2); ss += __shfl_xor(ss, 4);
          const float rstd = rsqrtf(ss * (1.f / DQK) + EPS);
#pragma unroll
          for (int j = 0; j < 12; ++j) v[j] *= rstd * qg[j];
          const float o8 = v[8] * c0 - v[10] * s0, o9 = v[9] * c1 - v[11] * s1, o10 = v[8] * s0 + v[10] * c0, o11 = v[9] * s1 + v[11] * c1;
          bf16_t* qo = Q + rowi * DQK; u32x4 w; w.x = pk2(v[0], v[1]); w.y = pk2(v[2], v[3]); w.z = pk2(v[4], v[5]); w.w = pk2(v[6], v[7]);
          *(u32x4*)(qo + sub * 8) = w; *(unsigned*)(qo + 64 + 2 * sub) = pk2(o8, o9); *(unsigned*)(qo + 80 + 2 * sub) = pk2(o10, o11); }
        { const float* kp = KVPRE + (size_t)t * 1024 + h * 128; const f32x4 a = *(const f32x4*)(kp + sub * 8), bq = *(const f32x4*)(kp + sub * 8 + 4);
          const bf16_t* kr = PROJ + (size_t)t * INCP + OFF_KR; const unsigned w1 = *(const unsigned*)(kr + 2 * sub), w2 = *(const unsigned*)(kr + 16 + 2 * sub);
          float v[12] = {a[0], a[1], a[2], a[3], bq[0], bq[1], bq[2], bq[3], bf_lo(w1), bf_hi(w1), bf_lo(w2), bf_hi(w2)}; float ss = 0.f;
#pragma unroll
          for (int j = 0; j < 12; ++j) ss += v[j] * v[j];
          ss += __shfl_xor(ss, 1); ss += __shfl_xor(ss, 2); ss += __shfl_xor(ss, 4);
          const float rstd = rsqrtf(ss * (1.f / DQK) + EPS);
#pragma unroll
          for (int j = 0; j < 12; ++j) v[j] *= rstd * kg[j];
          const float o8 = v[8] * c0 - v[10] * s0, o9 = v[9] * c1 - v[11] * s1, o10 = v[8] * s0 + v[10] * c0, o11 = v[9] * s1 + v[11] * c1;
          bf16_t* ko = Kb + rowi * 128; u32x4 w; w.x = pk2(v[0], v[1]); w.y = pk2(v[2], v[3]); w.z = pk2(v[4], v[5]); w.w = pk2(v[6], v[7]);
          *(u32x4*)(ko + sub * 8) = w; *(unsigned*)(ko + 64 + 2 * sub) = pk2(o8, o9); *(unsigned*)(ko + 80 + 2 * sub) = pk2(o10, o11);
          if (sub < 4) *(u32x4*)(ko + 96 + sub * 8) = (u32x4){0u, 0u, 0u, 0u};
          const f32x4 va = *(const f32x4*)(kp + 64 + sub * 8), vb = *(const f32x4*)(kp + 64 + sub * 8 + 4);
          u32x4 wv; wv.x = pk2(va[0], va[1]); wv.y = pk2(va[2], va[3]); wv.z = pk2(vb[0], vb[1]); wv.w = pk2(vb[2], vb[3]); *(u32x4*)(V + rowi * DV + sub * 8) = wv; }
    }
}

namespace att {
constexpr int NW = 8, QBLK = 32, KVBLK = 64;
constexpr float SCALE = 0.10206207261596575f;
constexpr float THR = 8.f;
constexpr int LDQ = DQK, LDK = 128, LDV = DV;
constexpr int SHM_V = KVBLK * DV * 2, SHM_K = KVBLK * 256, SHM_ATTN = 2 * SHM_V + 2 * SHM_K + NW * 64 * 4;
#define KSWZ(row, colB) ((row) * 256 + ((colB) ^ (((row) & 7) << 4)))
#define SBAR() __builtin_amdgcn_sched_barrier(0)
__device__ __forceinline__ int crow(int r, int hi) { return (r & 3) + 8 * (r >> 2) + 4 * hi; }
__device__ __forceinline__ unsigned cvtpk(float lo, float hi) { unsigned r; asm volatile("v_cvt_pk_bf16_f32 %0, %1, %2" : "=v"(r) : "v"(lo), "v"(hi)); return r; }
__device__ __forceinline__ void partialSM(f32x16& p0, f32x16& p1, float& m_reg, float& mn, float& alpha) {
    constexpr float C = SCALE * 1.4426950408889634f;
    float pmax = p0[0];
#pragma unroll
    for (int r = 1; r < 16; ++r) pmax = fmaxf(pmax, p0[r]);
#pragma unroll
    for (int r = 0; r < 16; ++r) pmax = fmaxf(pmax, p1[r]);
    { auto rr = __builtin_amdgcn_permlane32_swap(__float_as_uint(pmax), __float_as_uint(pmax), false, false); pmax = fmaxf(__uint_as_float(rr[0]), __uint_as_float(rr[1])); }
    if (__builtin_expect(__all(pmax - m_reg <= THR / SCALE), 1)) { mn = m_reg; alpha = 1.f; }
    else { mn = fmaxf(m_reg, pmax); alpha = __builtin_amdgcn_exp2f((m_reg - mn) * C); m_reg = mn; }
    const float mnC = -mn * C;
#pragma unroll
    for (int r = 0; r < 16; ++r) p0[r] = fmaf(p0[r], C, mnC);
#pragma unroll
    for (int r = 0; r < 16; ++r) p1[r] = fmaf(p1[r], C, mnC);
#pragma unroll
    for (int r = 0; r < 16; ++r) p0[r] = __builtin_amdgcn_exp2f(p0[r]);
}
__device__ __forceinline__ void finishSM(f32x16& p0, f32x16& p1, float alpha, float& l_reg, bf16x8& pa0, bf16x8& pa1, bf16x8& pa2, bf16x8& pa3) {
#pragma unroll
    for (int r = 0; r < 16; ++r) p1[r] = __builtin_amdgcn_exp2f(p1[r]);
    float ps = 0;
#pragma unroll
    for (int r = 0; r < 16; ++r) ps += p0[r];
#pragma unroll
    for (int r = 0; r < 16; ++r) ps += p1[r];
    { auto rr = __builtin_amdgcn_permlane32_swap(__float_as_uint(ps), __float_as_uint(ps), false, false); ps = __uint_as_float(rr[0]) + __uint_as_float(rr[1]); }
    l_reg = l_reg * alpha + ps;
#define PK4(P, BASE, OUT) do { unsigned a0 = cvtpk(P[BASE + 0], P[BASE + 1]), a1 = cvtpk(P[BASE + 2], P[BASE + 3]);   \
    unsigned b0 = cvtpk(P[BASE + 4], P[BASE + 5]), b1 = cvtpk(P[BASE + 6], P[BASE + 7]);                              \
    auto r0 = __builtin_amdgcn_permlane32_swap(a0, b0, false, false); auto r1 = __builtin_amdgcn_permlane32_swap(a1, b1, false, false); \
    u32x4 w = {r0[0], r1[0], r0[1], r1[1]}; OUT = *reinterpret_cast<bf16x8*>(&w); } while (0)
    PK4(p0, 0, pa0); PK4(p0, 8, pa1); PK4(p1, 0, pa2); PK4(p1, 8, pa3);
#undef PK4
}
__device__ __forceinline__ void qkt(f32x16& p0, f32x16& p1, const unsigned char* Ks, const bf16x8* qr, int r32, int hi) {
    p0 = f32x16{}; p1 = f32x16{};
#pragma unroll
    for (int d0 = 0; d0 < 6; ++d0) { const int cb = (d0 * 16 + hi * 8) * 2;
        const bf16x8 b0 = *reinterpret_cast<const bf16x8*>(Ks + KSWZ(r32, cb));
        const bf16x8 b1 = *reinterpret_cast<const bf16x8*>(Ks + KSWZ(32 + r32, cb));
        p0 = __builtin_amdgcn_mfma_f32_32x32x16_bf16(b0, qr[d0], p0, 0, 0, 0);
        p1 = __builtin_amdgcn_mfma_f32_32x32x16_bf16(b1, qr[d0], p1, 0, 0, 0); }
}
__device__ __forceinline__ int v_st(int k, int c) { const int kk = (k & ~0xC) | ((k & 4) << 1) | ((k & 8) >> 1); return ((kk >> 3) * 2 + (c >> 5)) * 512 + ((kk & 7) * 32 + (c & 31)) * 2; }
__device__ __forceinline__ int v_rd_base(int lane) { return ((lane & 3) << 3) | (((lane >> 2) & 3) << 6) | (((lane >> 4) & 1) << 5) | (((lane >> 5) & 1) << 8); }
constexpr int v_rd_off(int d0, int ks, int half) { return d0 * 512 + ks * 2048 + half * 1024; }
template <int OFF> __device__ __forceinline__ s16x4 tr_read(int vb) { s16x4 r; asm volatile("ds_read_b64_tr_b16 %0, %1 offset:%2" : "=&v"(r) : "v"(vb), "i"(OFF) : "memory"); return r; }
template <int D0> __device__ __forceinline__ void pv_one(f32x16& od, int vb, bf16x8 pa0, bf16x8 pa1, bf16x8 pa2, bf16x8 pa3) {
    const s16x4 l0 = tr_read<v_rd_off(D0, 0, 0)>(vb), h0 = tr_read<v_rd_off(D0, 0, 1)>(vb), l1 = tr_read<v_rd_off(D0, 1, 0)>(vb), h1 = tr_read<v_rd_off(D0, 1, 1)>(vb);
    const s16x4 l2 = tr_read<v_rd_off(D0, 2, 0)>(vb), h2 = tr_read<v_rd_off(D0, 2, 1)>(vb), l3 = tr_read<v_rd_off(D0, 3, 0)>(vb), h3 = tr_read<v_rd_off(D0, 3, 1)>(vb);
    asm volatile("s_waitcnt lgkmcnt(0)" ::: "memory"); SBAR();
#define PK(L, H) (bf16x8){L[0], L[1], L[2], L[3], H[0], H[1], H[2], H[3]}
    od = __builtin_amdgcn_mfma_f32_32x32x16_bf16(pa0, PK(l0, h0), od, 0, 0, 0);
    od = __builtin_amdgcn_mfma_f32_32x32x16_bf16(pa1, PK(l1, h1), od, 0, 0, 0);
    od = __builtin_amdgcn_mfma_f32_32x32x16_bf16(pa2, PK(l2, h2), od, 0, 0, 0);
    od = __builtin_amdgcn_mfma_f32_32x32x16_bf16(pa3, PK(l3, h3), od, 0, 0, 0);
#undef PK
}
__device__ __forceinline__ void pv_d0(f32x16* o, int vb, bf16x8 pa0, bf16x8 pa1, bf16x8 pa2, bf16x8 pa3) { pv_one<0>(o[0], vb, pa0, pa1, pa2, pa3); pv_one<1>(o[1], vb, pa0, pa1, pa2, pa3); }

__device__ __forceinline__ void attn_unit(const bf16_t* __restrict__ Qb, const bf16_t* __restrict__ Kh, const bf16_t* __restrict__ Vh, bf16_t* __restrict__ Ob, int seq, unsigned char* lds) {
    const int tid = threadIdx.x, wid = tid >> 6, lane = tid & 63, r32 = lane & 31, hi = lane >> 5;
    unsigned char* V_lds = lds; unsigned char* K_lds = lds + 2 * SHM_V;
    float* wsf = (float*)(lds + 2 * SHM_V + 2 * SHM_K) + wid * 64; float* li_l = wsf; float* al_l = wsf + 32;
    float m_reg = -1e30f, l_reg = 0; f32x16 o[2] = {}; bf16x8 qr[6];
    const bf16_t* Qw = Qb + (size_t)(wid * QBLK + r32) * LDQ + hi * 8;
#pragma unroll
    for (int d0 = 0; d0 < 6; ++d0) qr[d0] = *reinterpret_cast<const bf16x8*>(Qw + d0 * 16);
    const int sr = tid >> 4, sc = (tid & 15) * 8;
    const int vr = tid >> 3, vc = (tid & 7) * 8, vst = v_st(vr, vc);
    const int vb0 = (int)(uintptr_t)V_lds + v_rd_base(lane);
    struct { bf16x8 vs, ks0, ks1; } sr_[2];
#define SLOAD(i, k0) do { sr_[i].vs = *reinterpret_cast<const bf16x8*>(&Vh[(size_t)((k0) + vr) * LDV + vc]); \
    sr_[i].ks0 = *reinterpret_cast<const bf16x8*>(&Kh[(size_t)((k0) + sr) * LDK + sc]); sr_[i].ks1 = *reinterpret_cast<const bf16x8*>(&Kh[(size_t)((k0) + 32 + sr) * LDK + sc]); } while (0)
#define SWRITE(b, i) do { *(bf16x8*)(V_lds + (b) * SHM_V + vst) = sr_[i].vs; const int kc = sc * 2;               \
    *(bf16x8*)(K_lds + (b) * SHM_K + KSWZ(sr, kc)) = sr_[i].ks0; *(bf16x8*)(K_lds + (b) * SHM_K + KSWZ(32 + sr, kc)) = sr_[i].ks1; } while (0)
#define SWAIT() asm volatile("s_waitcnt vmcnt(3)" ::: "memory")
#define RESC(a) do { if (__any((a) < 1.f)) { if (hi == 0) al_l[r32] = (a); asm volatile("s_waitcnt lgkmcnt(0)" ::: "memory"); \
    _Pragma("unroll") for (int d = 0; d < 2; ++d) _Pragma("unroll") for (int r = 0; r < 16; ++r) o[d][r] *= al_l[crow(r, hi)]; } } while (0)
    f32x16 pA0, pA1, pB0, pB1; float mnA, mnB, alA, alB; bf16x8 pa0, pa1, pa2, pa3; const int NT = seq / KVBLK;
    constexpr int SE = 0, SO = 1;
    SLOAD(SE, 0); asm volatile("s_waitcnt vmcnt(0)" ::: "memory"); SWRITE(0, SE); __syncthreads();
    qkt(pA0, pA1, K_lds, qr, r32, hi); partialSM(pA0, pA1, m_reg, mnA, alA);
    SLOAD(SO, KVBLK); if (2 < NT) SLOAD(SE, 2 * KVBLK);
    SWAIT(); SWRITE(1, SO); __syncthreads();
    for (int j = 1; j + 1 < NT; j += 2) {
        SBAR(); qkt(pB0, pB1, K_lds + SHM_K, qr, r32, hi);
        finishSM(pA0, pA1, alA, l_reg, pa0, pa1, pa2, pa3); SBAR();
        SLOAD(SO, (j + 2) * KVBLK); SBAR();
        pv_d0(o, vb0, pa0, pa1, pa2, pa3); partialSM(pB0, pB1, m_reg, mnB, alB);
        __syncthreads(); SWAIT(); SWRITE(0, SE);
        RESC(alB); __syncthreads();
        SBAR(); qkt(pA0, pA1, K_lds, qr, r32, hi);
        finishSM(pB0, pB1, alB, l_reg, pa0, pa1, pa2, pa3); SBAR();
        if (j + 3 < NT) SLOAD(SE, (j + 3) * KVBLK); SBAR();
        pv_d0(o, vb0 + SHM_V, pa0, pa1, pa2, pa3); partialSM(pA0, pA1, m_reg, mnA, alA);
        __syncthreads(); SWAIT(); SWRITE(1, SO);
        RESC(alA); __syncthreads();
    }
    SBAR(); qkt(pB0, pB1, K_lds + SHM_K, qr, r32, hi);
    finishSM(pA0, pA1, alA, l_reg, pa0, pa1, pa2, pa3); SBAR();
    pv_d0(o, vb0, pa0, pa1, pa2, pa3); partialSM(pB0, pB1, m_reg, mnB, alB);
    __syncthreads(); RESC(alB);
    finishSM(pB0, pB1, alB, l_reg, pa0, pa1, pa2, pa3); SBAR();
    pv_d0(o, vb0 + SHM_V, pa0, pa1, pa2, pa3);
    if (hi == 0) li_l[r32] = l_reg; asm volatile("s_waitcnt lgkmcnt(0)" ::: "memory");
    float rli[16];
#pragma unroll
    for (int r = 0; r < 16; ++r) rli[r] = __builtin_amdgcn_rcpf(li_l[crow(r, hi)]);
    bf16_t* Ow = Ob + (size_t)(wid * QBLK) * 512;
#pragma unroll
    for (int r = 0; r < 16; ++r) { const int orow = crow(r, hi);
#pragma unroll
        for (int d0 = 0; d0 < 2; ++d0) Ow[(size_t)orow * 512 + d0 * 32 + r32] = (bf16_t)(pk2(o[d0][r] * rli[r], 0.f) & 0xffffu); }
    __syncthreads();
#undef SLOAD
#undef SWRITE
#undef SWAIT
#undef RESC
}
#undef KSWZ
#undef SBAR
}

__device__ __forceinline__ void phase_attn(const Params& p, unsigned char* lds) {
    const bf16_t* Q = (const bf16_t*)(p.ws + WS_Q); const bf16_t* Kb = (const bf16_t*)(p.ws + WS_K); const bf16_t* V = (const bf16_t*)(p.ws + WS_V); bf16_t* AO = (bf16_t*)(p.ws + WS_AO);
    constexpr int NQB = SEQ / 256, NU = 2 * NH * NQB;
    for (int u = blockIdx.x; u < NU; u += gridDim.x) {
        const int qb = u % NQB, h = (u / NQB) % NH, b = u / (NQB * NH); const size_t bh = (size_t)(b * NH + h) * SEQ;
        att::attn_unit(Q + (bh + (size_t)qb * 256) * DQK, Kb + bh * 128, V + bh * DV, AO + ((size_t)b * SEQ + (size_t)qb * 256) * 512 + h * DV, SEQ, lds);
    }
}

__device__ __forceinline__ void phase_router(const Params& p, unsigned char* lds) {
    const int tid = threadIdx.x, lane = tid & 63, wave = tid >> 6;
    float* hbuf = (float*)lds + wave * 4096;
    int* lcnt = (int*)(lds + 131072);
    int* lbase = lcnt + 32;
    int* pe = lbase + 32;
    int* prk = pe + 256;
    float* pw = (float*)(prk + 256);
    unsigned* gcnt = (unsigned*)(p.ws + WS_CTL) + CW_CNT;
    int* pair_e = (int*)(p.ws + WS_ROUTE + RT_PAIR_E); int* pair_rank = (int*)(p.ws + WS_ROUTE + RT_PAIR_RANK); float* pair_w = (float*)(p.ws + WS_ROUTE + RT_PAIR_W);
    bf16_t* H2 = (bf16_t*)(p.ws + WS_H2);
    const int e = lane & 31, half = lane >> 5;
    const float rb = p.router_b[e];
    for (int tg = blockIdx.x; tg < NTOK / 64; tg += gridDim.x) {
        if (tid < 32) lcnt[tid] = 0;
        __syncthreads();
        for (int pass = 0; pass < 2; ++pass) {
            const int tl0 = wave * 8 + pass * 4;
#pragma unroll
            for (int tt = 0; tt < 4; ++tt) {
                const int t = tg * 64 + tl0 + tt;
                const f32x4* xr = (const f32x4*)(p.out + (size_t)t * DM) + lane; f32x4 v[4]; float s = 0.f;
#pragma unroll
                for (int j = 0; j < 4; ++j) { v[j] = xr[64 * j]; s += (v[j][0] * v[j][0] + v[j][1] * v[j][1]) + (v[j][2] * v[j][2] + v[j][3] * v[j][3]); }
                const float rstd = rsqrtf(wave_sum(s) * (1.f / DM) + EPS);
                u32x2* o = (u32x2*)(H2 + (size_t)t * DM) + lane;
#pragma unroll
                for (int j = 0; j < 4; ++j) { const f32x4 g = *((const f32x4*)p.norm2_g + lane + 64 * j); const f32x4 hh = v[j] * rstd * g;
                    u32x2 w; w.x = pk2(hh[0], hh[1]); w.y = pk2(hh[2], hh[3]); o[64 * j] = w; *((f32x4*)(hbuf + tt * 1024) + lane + 64 * j) = hh; }
            }
            asm volatile("s_waitcnt lgkmcnt(0)" ::: "memory");
            float a0 = 0.f, a1 = 0.f, a2 = 0.f, a3 = 0.f;
            const float* rwp = p.router_w + (size_t)(half * 512) * NE + e; const float* hb = hbuf + half * 512;
#pragma unroll 16
            for (int kk = 0; kk < 512; ++kk) { const float r = rwp[(size_t)kk * NE]; a0 += hb[kk] * r; a1 += hb[1024 + kk] * r; a2 += hb[2048 + kk] * r; a3 += hb[3072 + kk] * r; }
            a0 += __shfl_xor(a0, 32); a1 += __shfl_xor(a1, 32); a2 += __shfl_xor(a2, 32); a3 += __shfl_xor(a3, 32);
            float lg[4] = {a0 + rb, a1 + rb, a2 + rb, a3 + rb};
#pragma unroll
            for (int tt = 0; tt < 4; ++tt) {
                float val = lg[tt]; float tv[4]; int ti[4];
#pragma unroll
                for (int r = 0; r < 4; ++r) {
                    float bv = val; int bi = e;
#pragma unroll
                    for (int o = 1; o < 32; o <<= 1) { const float ov = __shfl_xor(bv, o); const int oi = __shfl_xor(bi, o); if (ov > bv || (ov == bv && oi < bi)) { bv = ov; bi = oi; } }
                    tv[r] = bv; ti[r] = bi; if (e == bi) val = -INFINITY;
                }
                const float e1 = __expf(tv[1] - tv[0]), e2 = __expf(tv[2] - tv[0]), e3 = __expf(tv[3] - tv[0]); const float inv = 1.f / (1.f + e1 + e2 + e3);
                const float wv[4] = {inv, e1 * inv, e2 * inv, e3 * inv};
                if (lane < 4) { const int ee = lane == 0 ? ti[0] : lane == 1 ? ti[1] : lane == 2 ? ti[2] : ti[3]; const float ww = lane == 0 ? wv[0] : lane == 1 ? wv[1] : lane == 2 ? wv[2] : wv[3];
                    const int rl = atomicAdd(&lcnt[ee], 1); const int pl = (tl0 + tt) * 4 + lane; pe[pl] = ee; prk[pl] = rl; pw[pl] = ww; }
            }
            asm volatile("s_waitcnt lgkmcnt(0)" ::: "memory");
        }
        __syncthreads();
        if (tid < 32) lbase[tid] = (int)atomicAdd(&gcnt[tid], (unsigned)lcnt[tid]);
        __syncthreads();
        if (tid < 256) { const int gp = tg * 256 + tid; const int ee = pe[tid]; pair_e[gp] = ee; pair_rank[gp] = lbase[ee] + prk[tid]; pair_w[gp] = pw[tid]; }
        __syncthreads();
    }
}

__device__ __forceinline__ void build_block_table(const Params& p, int* bs) {
    const unsigned* gcnt = (const unsigned*)(p.ws + WS_CTL) + CW_CNT;
    if (threadIdx.x == 0) { int acc = 0; for (int e = 0; e < NE; ++e) { bs[e] = acc; acc += ((int)gcnt[e] + 255) >> 8; } bs[NE] = acc; }
    __syncthreads();
}

__device__ __forceinline__ void phase_scatter(const Params& p, unsigned char* lds) {
    int* bs = (int*)lds; build_block_table(p, bs);
    const int* pair_e = (const int*)(p.ws + WS_ROUTE + RT_PAIR_E); const int* pair_rank = (const int*)(p.ws + WS_ROUTE + RT_PAIR_RANK); const float* pair_w = (const float*)(p.ws + WS_ROUTE + RT_PAIR_W);
    int* rt = (int*)(p.ws + WS_ROUTE + RT_ROW_TOK); float* rw = (float*)(p.ws + WS_ROUTE + RT_ROW_W); int* rs = (int*)(p.ws + WS_ROUTE + RT_ROW_SLOT);
    for (int i = blockIdx.x * NTHREADS + threadIdx.x; i < NPAIR; i += gridDim.x * NTHREADS) {
        const int e = pair_e[i]; const int dest = bs[e] * 256 + pair_rank[i]; rt[dest] = i >> 2; rw[dest] = pair_w[i]; rs[dest] = i; }
    __syncthreads();
}

__device__ __forceinline__ void phase_moe1(const Params& p, unsigned char* lds) {
    int* bs = (int*)(lds + 32768); build_block_table(p, bs);
    const int nmb = bs[NE], nN = 2048 / SG_BN, nU = nmb * nN;
    const bf16_t* H2 = (const bf16_t*)(p.ws + WS_H2); const int* rt = (const int*)(p.ws + WS_ROUTE + RT_ROW_TOK);
    for (int u = blockIdx.x; u < nU; u += gridDim.x) {
        const int mb = u / nN, pn = u % nN; int e = 0;
        for (int k = 1; k < NE; ++k) if (bs[k] <= mb) e = k;
        EpiSwiglu E{(bf16_t*)(p.ws + WS_ACT), p.b1 + (size_t)e * 2048};
        sgemm_tile(lds, H2, rt, (const bf16_t*)(p.ws + WS_W1) + (size_t)e * 2048 * DM, DM, mb * 256, pn * SG_BN, E);
    }
}
__device__ __forceinline__ void phase_moe2(const Params& p, unsigned char* lds) {
    int* bs = (int*)(lds + 32768); build_block_table(p, bs);
    const int nmb = bs[NE], nN = DM / SG_BN, nU = nmb * nN;
    for (int u = blockIdx.x; u < nU; u += gridDim.x) {
        const int mb = u / nN, pn = u % nN; int e = 0;
        for (int k = 1; k < NE; ++k) if (bs[k] <= mb) e = k;
        EpiMoeOut E{(bf16_t*)(p.ws + WS_YS), p.b2 + (size_t)e * DM, (const float*)(p.ws + WS_ROUTE + RT_ROW_W), (const int*)(p.ws + WS_ROUTE + RT_ROW_SLOT)};
        sgemm_tile(lds, (const bf16_t*)(p.ws + WS_ACT), nullptr, (const bf16_t*)(p.ws + WS_W2) + (size_t)e * DM * DFF, DFF, mb * 256, pn * SG_BN, E);
    }
}

__device__ __forceinline__ void phase_combine(const Params& p) {
    const int tid = threadIdx.x, lane = tid & 63, wave = tid >> 6;
    const int gw = blockIdx.x * NWAVES + wave, NGW = gridDim.x * NWAVES;
    const bf16_t* YS = (const bf16_t*)(p.ws + WS_YS);
    for (int t = gw; t < NTOK; t += NGW) {
        f32x4* orow = (f32x4*)(p.out + (size_t)t * DM) + lane;
#pragma unroll
        for (int j = 0; j < 4; ++j) { f32x4 v = orow[64 * j];
#pragma unroll
            for (int k = 0; k < 4; ++k) { const u32x2 w = *((const u32x2*)(YS + ((size_t)t * 4 + k) * DM) + lane + 64 * j); v[0] += bf_lo(w.x); v[1] += bf_hi(w.x); v[2] += bf_lo(w.y); v[3] += bf_hi(w.y); }
            orow[64 * j] = v; }
    }
}

constexpr int NPHASE = 13;
__global__ void __launch_bounds__(NTHREADS, 2) mk_fwd(Params p) {
    extern __shared__ __attribute__((aligned(16))) unsigned char lds[];
    cg::grid_group grid = cg::this_grid();
    unsigned char* ws = p.ws;
    const int lo = p.ph_lo, hi = p.ph_hi;
#define IN(k) (lo <= (k) && (k) < hi)
#define SEAM(k) do { if (IN(k) && IN((k) + 1)) grid.sync(); } while (0)
    if (IN(0)) phase_prologue(p, lds);
    SEAM(0);
    if (IN(1)) { EpiProj E{(bf16_t*)(ws + WS_PROJ)}; sgemm_phase(lds, (const bf16_t*)(ws + WS_XN), (const bf16_t*)(ws + WS_WIN), NTOK, INCP, DM, E); }
    SEAM(1);
    if (IN(2)) phase_tok_a(p);
    SEAM(2);
    if (IN(3)) { EpiF32 Eq{(float*)(ws + WS_QPRE), 768}; sgemm_phase(lds, (const bf16_t*)(ws + WS_CQN), (const bf16_t*)(ws + WS_WUQ), NTOK, 768, QLORA, Eq);
                 EpiF32 Ek{(float*)(ws + WS_KVPRE), 1024}; sgemm_phase(lds, (const bf16_t*)(ws + WS_CKVN), (const bf16_t*)(ws + WS_WUKV), NTOK, 1024, KVLORA, Ek); }
    SEAM(3);
    if (IN(4)) phase_tok_b(p);
    SEAM(4);
    if (IN(5)) phase_attn(p, lds);
    SEAM(5);
    if (IN(6)) { EpiGateA E{(float*)(ws + WS_M1), (const bf16_t*)(ws + WS_PROJ)}; sgemm_phase(lds, (const bf16_t*)(ws + WS_AO), (const bf16_t*)(ws + WS_WOMLA), NTOK, DM, 512, E); }
    SEAM(6);
    if (IN(7)) { EpiGateB E{(const float*)(ws + WS_M1), (const bf16_t*)(ws + WS_PROJ), (bf16_t*)(ws + WS_MERGED)}; sgemm_phase(lds, (const bf16_t*)(ws + WS_YBIN), (const bf16_t*)(ws + WS_WOCONV), NTOK, DM, 512, E); }
    SEAM(7);
    if (IN(8)) { EpiResid E{p.x, p.out}; sgemm_phase(lds, (const bf16_t*)(ws + WS_MERGED), (const bf16_t*)(ws + WS_WO), NTOK, DM, DM, E); }
    SEAM(8);
    if (IN(9)) phase_router(p, lds);
    SEAM(9);
    if (IN(10)) phase_scatter(p, lds);
    SEAM(10);
    if (IN(11)) phase_moe1(p, lds);
    SEAM(11);
    if (IN(12)) phase_moe2(p, lds);
    SEAM(12);
    if (IN(13)) phase_combine(p);
#undef IN
#undef SEAM
}

extern "C" void kernel_launch(void* const* d_in, const int* in_sizes, int n_in, void* d_out, int out_size,
                              void* d_ws, size_t ws_size, hipStream_t stream) {
    static int grid_blocks = 0;
    if (!grid_blocks) {
        int dev = 0, cus = 0, per_cu = 0;
        (void)hipGetDevice(&dev);
        (void)hipDeviceGetAttribute(&cus, hipDeviceAttributeMultiprocessorCount, dev);
        (void)hipFuncSetAttribute((const void*)mk_fwd, hipFuncAttributeMaxDynamicSharedMemorySize, LDS_BYTES);
        (void)hipOccupancyMaxActiveBlocksPerMultiprocessor(&per_cu, (const void*)mk_fwd, NTHREADS, LDS_BYTES);
        if (per_cu < 1) { fprintf(stderr, "kernel_launch: occupancy query says %d blocks/CU\n", per_cu); per_cu = 1; }
        grid_blocks = cus;
        if (ws_size < WS_END || n_in != 21) fprintf(stderr, "kernel_launch: ws %zu < %zu or n_in %d != 21\n", ws_size, (size_t)WS_END, n_in);
    }
    (void)hipMemsetAsync((char*)d_ws + WS_CTL, 0, 1 * MiB, stream);
    Params p{};
    p.x = (const float*)d_in[0]; p.pos = (const int*)d_in[1]; p.norm1_g = (const float*)d_in[2]; p.w_in = (const float*)d_in[3]; p.q_a_g = (const float*)d_in[4];
    p.kv_a_g = (const float*)d_in[5]; p.w_uq = (const float*)d_in[6]; p.w_ukv = (const float*)d_in[7]; p.q_g = (const float*)d_in[8]; p.k_g = (const float*)d_in[9];
    p.conv_w = (const float*)d_in[10]; p.w_o_mla = (const float*)d_in[11]; p.w_o_conv = (const float*)d_in[12]; p.w_o = (const float*)d_in[13]; p.norm2_g = (const float*)d_in[14];
    p.router_w = (const float*)d_in[15]; p.router_b = (const float*)d_in[16]; p.w1 = (const float*)d_in[17]; p.b1 = (const float*)d_in[18]; p.w2 = (const float*)d_in[19]; p.b2 = (const float*)d_in[20];
    p.out = (float*)d_out; p.ws = (unsigned char*)d_ws; p.ph_lo = 0; p.ph_hi = NPHASE + 1;
    void* args[] = {&p};
    hipError_t e = hipLaunchCooperativeKernel((const void*)mk_fwd, dim3(grid_blocks), dim3(NTHREADS), args, LDS_BYTES, stream);
    if (e != hipSuccess) fprintf(stderr, "cooperative launch failed: %s (grid %d)\n", hipGetErrorString(e), grid_blocks);
}
```

```cpp
#include <hip/hip_runtime.h>
#include <hip/hip_cooperative_groups.h>
#include <cstdio>
#include <cstdint>
namespace cg = cooperative_groups;

typedef unsigned short bf16_t;
typedef short bf16x8 __attribute__((ext_vector_type(8)));
typedef short s16x4 __attribute__((ext_vector_type(4)));
typedef float f32x4 __attribute__((ext_vector_type(4)));
typedef float f32x2 __attribute__((ext_vector_type(2)));
typedef float f32x16 __attribute__((ext_vector_type(16)));
typedef unsigned u32x4 __attribute__((ext_vector_type(4)));
typedef unsigned u32x2 __attribute__((ext_vector_type(2)));
typedef __bf16 bf16x2_t __attribute__((ext_vector_type(2)));

constexpr int NTOK = 16384, DM = 1024, SEQ = 8192;
constexpr int INC = 4000, INCP = 4096;
constexpr int OFF_CQ = 0, OFF_CKV = 256, OFF_KR = 384, OFF_U = 416, OFF_C = 928, OFF_B = 1440, OFF_GA = 1952, OFF_GB = 2976;
constexpr int NH = 8, DQK = 96, DV = 64, NE = 32, TOPK = 4, DFF = 1024;
constexpr int QLORA = 256, KVLORA = 128, CONVW = 512;
constexpr int NPAIR = NTOK * TOPK;
constexpr int MAXROWS = 73728;
constexpr float EPS = 1e-6f;
constexpr int NTHREADS = 512, NWAVES = 8;
constexpr int LDS_BYTES = 147456;

constexpr size_t MiB = 1ull << 20;
constexpr size_t WS_CTL = 0;
constexpr size_t WS_WIN = 1 * MiB;
constexpr size_t WS_WUQ = 9 * MiB;
constexpr size_t WS_WUKV = WS_WUQ + 512 * 1024;
constexpr size_t WS_WOMLA = 10 * MiB;
constexpr size_t WS_WOCONV = 11 * MiB;
constexpr size_t WS_WO = 12 * MiB;
constexpr size_t WS_ROUTE = 14 * MiB;
constexpr size_t WS_W1 = 18 * MiB;
constexpr size_t WS_W2 = 146 * MiB;
constexpr size_t WS_XN = 210 * MiB;
constexpr size_t WS_PROJ = 242 * MiB;
constexpr size_t WS_CQN = 370 * MiB;
constexpr size_t WS_CKVN = 378 * MiB;
constexpr size_t WS_YBIN = 386 * MiB;
constexpr size_t WS_QPRE = 402 * MiB;
constexpr size_t WS_KVPRE = 450 * MiB;
constexpr size_t WS_Q = 514 * MiB;
constexpr size_t WS_K = 538 * MiB;
constexpr size_t WS_V = 570 * MiB;
constexpr size_t WS_AO = 586 * MiB;
constexpr size_t WS_M1 = 602 * MiB;
constexpr size_t WS_MERGED = 666 * MiB;
constexpr size_t WS_YS = 698 * MiB;
constexpr size_t WS_END = 826 * MiB;
constexpr size_t WS_ACT = WS_PROJ;
constexpr size_t WS_XS = 402 * MiB;
constexpr size_t RT_PAIR_E = 0, RT_PAIR_RANK = 262144, RT_PAIR_W = 524288, RT_ROW_TOK = 786432, RT_ROW_W = 786432 + 294912, RT_ROW_SLOT = 786432 + 2 * 294912;
constexpr int CW_CNT = 64;
constexpr int CW_BAR = 4096;
constexpr int MISC_OFF = 131072 + 8192;

struct Params {
    const float* x; const int* pos; const float* norm1_g; const float* w_in; const float* q_a_g; const float* kv_a_g;
    const float* w_uq; const float* w_ukv; const float* q_g; const float* k_g; const float* conv_w; const float* w_o_mla;
    const float* w_o_conv; const float* w_o; const float* norm2_g; const float* router_w; const float* router_b;
    const float* w1; const float* b1; const float* w2; const float* b2;
    float* out; unsigned char* ws; int ph_lo, ph_hi;
};

__device__ __forceinline__ unsigned pk2(float lo, float hi) { f32x2 v = {lo, hi}; bf16x2_t b = __builtin_convertvector(v, bf16x2_t); return __builtin_bit_cast(unsigned, b); }
__device__ __forceinline__ float bf_lo(unsigned w) { return __uint_as_float(w << 16); }
__device__ __forceinline__ float bf_hi(unsigned w) { return __uint_as_float(w & 0xffff0000u); }
__device__ __forceinline__ float bf1(bf16_t h) { return __uint_as_float((unsigned)h << 16); }
__device__ __forceinline__ float wave_sum(float v) {
#pragma unroll
    for (int o = 1; o < 64; o <<= 1) v += __shfl_xor(v, o);
    return v;
}
__device__ __forceinline__ float sigmoidf_(float v) { return 1.f / (1.f + __expf(-v)); }

namespace pg8 {
#define PG8_LAS __attribute__((address_space(3)))
constexpr int BM = 256, BK = 64, HALF = 128, HTB = HALF * BK * 2  , STAGE_BYTES = 8 * HTB, NXCD = 8, WGM = 8;

__host__ __device__ __forceinline__ int lds_byte(int r, int c) { const int st = (r >> 4) * 2 + (c >> 5), rr = r & 15, cc = c & 31, ob = rr * 64 + cc * 2; return st * 1024 + (ob ^ (((ob >> 9) & 1) << 5)); }
__host__ __device__ __forceinline__ void stage_rc(int b, int& R, int& C) { const int st = b / 1024, sb = b % 1024, swz = sb ^ (((sb >> 9) & 1) << 5); R = (st >> 1) * 16 + swz / 64; C = (st & 1) * 32 + (swz % 64) / 2; }
__host__ __device__ __forceinline__ int perm32(int rho) { const int n = rho >> 4, i = rho & 15; return 8 * (i >> 2) + 4 * n + (i & 3); }

struct Unit { int pm, pn, e; };
struct Gemm { const bf16_t* A; const bf16_t* Bt; int M, N, K; size_t bstride; };

struct StaticOrder {
    int nM, nN, nwg, G, c;
    __host__ __device__ void init(int M, int N, int G_, int c_) { nM = M / BM; nN = N / BM; nwg = nM * nN; G = G_; c = c_; }
    __host__ __device__ bool next(int i, Unit& u) const {
        const long L = (long)i * G + c; if (L >= nwg) return false;
        int wgid = (int)L; { const int q = nwg / NXCD, r = nwg % NXCD, xcd = wgid % NXCD, off = wgid / NXCD; wgid = (xcd < r ? xcd * (q + 1) : r * (q + 1) + (xcd - r) * q) + off; }
        const int nig = WGM * nN, gid = wgid / nig, fm = gid * WGM, gsz = (nM - fm) < WGM ? (nM - fm) : WGM;
        u.pm = fm + ((wgid % nig) % gsz); u.pn = (wgid % nig) / gsz; u.e = 0; return true;
    }
    __device__ __forceinline__ void a_ready(const Unit&) const {}
    __device__ __forceinline__ void done(const Unit&) const {}
};


struct EpiProj {
    static constexpr bool PERM = true, AFTER_DRAIN = false;
    bf16_t* O;
    __device__ __forceinline__ void operator()(const f32x4 (&acc)[2][2][4][2], const Unit& u, int wr, int wc, int fr, int fq) const {
        const int row0 = u.pm * BM + wr * 64 + fr, col0 = u.pn * BM + wc * 32 + 8 * fq;
#pragma unroll
        for (int ai = 0; ai < 2; ++ai)
#pragma unroll
            for (int m = 0; m < 4; ++m) { bf16_t* rowp = O + (size_t)(row0 + ai * HALF + m * 16) * INCP + col0;
#pragma unroll
                for (int bj = 0; bj < 2; ++bj) { f32x4 v0 = acc[ai][bj][m][0], v1 = acc[ai][bj][m][1]; const int col = col0 + bj * HALF;
                    if (col >= OFF_GA && col < INC) {
#pragma unroll
                        for (int j = 0; j < 4; ++j) { v0[j] = sigmoidf_(v0[j]); v1[j] = sigmoidf_(v1[j]); } }
                    u32x4 w; w.x = pk2(v0[0], v0[1]); w.y = pk2(v0[2], v0[3]); w.z = pk2(v1[0], v1[1]); w.w = pk2(v1[2], v1[3]);
                    *(u32x4*)(rowp + bj * HALF) = w; } }
    }
};
struct EpiF32 {
    static constexpr bool PERM = false, AFTER_DRAIN = false;
    float* O; int ldc;
    __device__ __forceinline__ void operator()(const f32x4 (&acc)[2][2][4][2], const Unit& u, int wr, int wc, int fr, int fq) const {
        const int row0 = u.pm * BM + wr * 64 + fr, col0 = u.pn * BM + wc * 32 + 4 * fq;
#pragma unroll
        for (int ai = 0; ai < 2; ++ai)
#pragma unroll
            for (int m = 0; m < 4; ++m) { float* rowp = O + (size_t)(row0 + ai * HALF + m * 16) * ldc + col0;
#pragma unroll
                for (int bj = 0; bj < 2; ++bj)
#pragma unroll
                    for (int n = 0; n < 2; ++n) *(f32x4*)(rowp + bj * HALF + n * 16) = acc[ai][bj][m][n]; }
    }
};
__device__ __forceinline__ void unpack8(const u32x4 g, float (&f)[8]) { f[0] = bf_lo(g.x); f[1] = bf_hi(g.x); f[2] = bf_lo(g.y); f[3] = bf_hi(g.y); f[4] = bf_lo(g.z); f[5] = bf_hi(g.z); f[6] = bf_lo(g.w); f[7] = bf_hi(g.w); }
struct EpiGateA {
    static constexpr bool PERM = true, AFTER_DRAIN = false;
    bf16_t* M1; const bf16_t* proj;
    __device__ __forceinline__ void operator()(const f32x4 (&acc)[2][2][4][2], const Unit& u, int wr, int wc, int fr, int fq) const {
        const int row0 = u.pm * BM + wr * 64 + fr, col0 = u.pn * BM + wc * 32 + 8 * fq;
#pragma unroll
        for (int ai = 0; ai < 2; ++ai)
#pragma unroll
            for (int m = 0; m < 4; ++m) { const size_t row = (size_t)(row0 + ai * HALF + m * 16);
#pragma unroll
                for (int bj = 0; bj < 2; ++bj) { const int col = col0 + bj * HALF; float g[8]; unpack8(*(const u32x4*)(proj + row * INCP + OFF_GA + col), g);
                    const f32x4 v0 = acc[ai][bj][m][0], v1 = acc[ai][bj][m][1];
                    u32x4 w; w.x = pk2(v0[0] * g[0], v0[1] * g[1]); w.y = pk2(v0[2] * g[2], v0[3] * g[3]); w.z = pk2(v1[0] * g[4], v1[1] * g[5]); w.w = pk2(v1[2] * g[6], v1[3] * g[7]);
                    *(u32x4*)(M1 + row * DM + col) = w; } }
    }
};
struct EpiGateB {
    static constexpr bool PERM = true, AFTER_DRAIN = false;
    const bf16_t* M1; const bf16_t* proj; bf16_t* O;
    __device__ __forceinline__ void operator()(const f32x4 (&acc)[2][2][4][2], const Unit& u, int wr, int wc, int fr, int fq) const {
        const int row0 = u.pm * BM + wr * 64 + fr, col0 = u.pn * BM + wc * 32 + 8 * fq;
#pragma unroll
        for (int ai = 0; ai < 2; ++ai)
#pragma unroll
            for (int m = 0; m < 4; ++m) { const size_t row = (size_t)(row0 + ai * HALF + m * 16);
#pragma unroll
                for (int bj = 0; bj < 2; ++bj) { const int col = col0 + bj * HALF; float g[8], b[8]; unpack8(*(const u32x4*)(proj + row * INCP + OFF_GB + col), g); unpack8(*(const u32x4*)(M1 + row * DM + col), b);
                    const f32x4 v0 = acc[ai][bj][m][0], v1 = acc[ai][bj][m][1];
                    u32x4 w; w.x = pk2(b[0] + v0[0] * g[0], b[1] + v0[1] * g[1]); w.y = pk2(b[2] + v0[2] * g[2], b[3] + v0[3] * g[3]);
                    w.z = pk2(b[4] + v1[0] * g[4], b[5] + v1[1] * g[5]); w.w = pk2(b[6] + v1[2] * g[6], b[7] + v1[3] * g[7]);
                    *(u32x4*)(O + row * DM + col) = w; } }
    }
};
struct EpiResid {
    static constexpr bool PERM = false, AFTER_DRAIN = false;
    const float* X; float* O;
    __device__ __forceinline__ void operator()(const f32x4 (&acc)[2][2][4][2], const Unit& u, int wr, int wc, int fr, int fq) const {
        const int row0 = u.pm * BM + wr * 64 + fr, col0 = u.pn * BM + wc * 32 + 4 * fq;
#pragma unroll
        for (int ai = 0; ai < 2; ++ai)
#pragma unroll
            for (int m = 0; m < 4; ++m) { const size_t off = (size_t)(row0 + ai * HALF + m * 16) * DM + col0;
#pragma unroll
                for (int bj = 0; bj < 2; ++bj)
#pragma unroll
                    for (int n = 0; n < 2; ++n) { const f32x4 b = *(const f32x4*)(X + off + bj * HALF + n * 16); *(f32x4*)(O + off + bj * HALF + n * 16) = b + acc[ai][bj][m][n]; } }
    }
};
struct EpiSwiglu {
    static constexpr bool PERM = true, AFTER_DRAIN = false;
    bf16_t* ACT; const float* b1;
    __device__ __forceinline__ void operator()(const f32x4 (&acc)[2][2][4][2], const Unit& u, int wr, int wc, int fr, int fq) const {
        const int row0 = u.pm * BM + wr * 64 + fr, f0 = u.pn * HALF + wc * 32 + 8 * fq; const float* be = b1 + (size_t)u.e * 2048;
        const f32x4 bg0 = *(const f32x4*)(be + f0), bg1 = *(const f32x4*)(be + f0 + 4), bu0 = *(const f32x4*)(be + DFF + f0), bu1 = *(const f32x4*)(be + DFF + f0 + 4);
#pragma unroll
        for (int ai = 0; ai < 2; ++ai)
#pragma unroll
            for (int m = 0; m < 4; ++m) { const size_t row = (size_t)(row0 + ai * HALF + m * 16); float o[8];
#pragma unroll
                for (int n = 0; n < 2; ++n) { const f32x4 g4 = acc[ai][0][m][n] + (n ? bg1 : bg0), u4 = acc[ai][1][m][n] + (n ? bu1 : bu0);
#pragma unroll
                    for (int j = 0; j < 4; ++j) { const float g = fminf(g4[j], 7.f), uu = fminf(fmaxf(u4[j], -7.f), 7.f); o[4 * n + j] = (uu + 1.f) * (g * sigmoidf_(1.702f * g)); } }
                u32x4 w; w.x = pk2(o[0], o[1]); w.y = pk2(o[2], o[3]); w.z = pk2(o[4], o[5]); w.w = pk2(o[6], o[7]); *(u32x4*)(ACT + row * DFF + f0) = w; }
    }
};
struct EpiMoeOut {
    static constexpr bool PERM = true, AFTER_DRAIN = false;
    bf16_t* YS; const float* b2; const float* row_w; const int* row_slot;
    __device__ __forceinline__ void operator()(const f32x4 (&acc)[2][2][4][2], const Unit& u, int wr, int wc, int fr, int fq) const {
        const int row0 = u.pm * BM + wr * 64 + fr, col0 = u.pn * BM + wc * 32 + 8 * fq; const float* be = b2 + (size_t)u.e * DM;
        f32x4 bv[2][2];
#pragma unroll
        for (int bj = 0; bj < 2; ++bj)
#pragma unroll
            for (int n = 0; n < 2; ++n) bv[bj][n] = *(const f32x4*)(be + col0 + bj * HALF + 4 * n);
#pragma unroll
        for (int ai = 0; ai < 2; ++ai)
#pragma unroll
            for (int m = 0; m < 4; ++m) { const int row = row0 + ai * HALF + m * 16; const int slot = row_slot[row]; const float w = row_w[row];
                if (slot >= 0) { bf16_t* rowp = YS + (size_t)slot * DM + col0;
#pragma unroll
                    for (int bj = 0; bj < 2; ++bj) { const f32x4 v0 = (acc[ai][bj][m][0] + bv[bj][0]) * w, v1 = (acc[ai][bj][m][1] + bv[bj][1]) * w;
                        u32x4 o; o.x = pk2(v0[0], v0[1]); o.y = pk2(v0[2], v0[3]); o.z = pk2(v1[0], v1[1]); o.w = pk2(v1[2], v1[3]); *(u32x4*)(rowp + bj * HALF) = o; } } }
    }
};
struct MoeOrder {
    StaticOrder so; unsigned long long epack;
    __device__ __forceinline__ bool next(int i, Unit& u) const { if (!so.next(i, u)) return false; u.e = (int)((epack >> (5 * i)) & 31ull); return true; }
    __device__ __forceinline__ void a_ready(const Unit&) const {}
    __device__ __forceinline__ void done(const Unit&) const {}
};
template <class Epi, class Sched, bool ALIGN_EPI = false, bool SP2 = false>
__device__ __forceinline__ void gemm_phase(PG8_LAS unsigned char* lds, const Gemm g, const Sched& S, const Epi& E) {
    const int tid = threadIdx.x, wid = __builtin_amdgcn_readfirstlane(tid >> 6), lane = tid & 63, wr = wid >> 2, wc = wid & 3, fr = lane & 15, fq = lane >> 4;
    const int K = g.K, nt = K / BK;
    unsigned voffA[2], voffB[2];
#pragma unroll
    for (int i = 0; i < 2; ++i) { int R, C; stage_rc(tid * 16 + i * 8192, R, C); const int Rb = Epi::PERM ? ((R & ~31) + perm32(R & 31)) : R;
        voffA[i] = (unsigned)(R * K + C) * 2u; voffB[i] = (unsigned)(Rb * K + C) * 2u; }
    const size_t kstep = (size_t)(BK * 2);
    const size_t hstep = (size_t)HALF * K * 2;
    const size_t tstep = 2 * hstep;
    const unsigned ldsw = (unsigned)wid * 1024u;
    const int aoff = lds_byte(wr * 64 + fr, fq * 8), boff = lds_byte(wc * 32 + fr, fq * 8);
#define PG8_SA(b, h) (((b) * 2 + (h)) * HTB)
#define PG8_SB(b, h) ((4 + (b) * 2 + (h)) * HTB)
#define PG8_STAGE(bufoff, gbase, voff) do { _Pragma("unroll") for (int _i = 0; _i < 2; ++_i) \
        __builtin_amdgcn_global_load_lds((const unsigned*)((const char*)(gbase) + (voff)[_i]), (PG8_LAS unsigned*)(lds + (bufoff) + ldsw + _i * 8192), 16, 0, 0); } while (0)
#define PG8_LDA(dst, b, h) do { _Pragma("unroll") for (int m = 0; m < 4; ++m) _Pragma("unroll") for (int k = 0; k < 2; ++k) dst[m][k] = *(const PG8_LAS bf16x8*)(lds + PG8_SA(b, h) + aoff + m * 2048 + k * 1024); } while (0)
#define PG8_LDB(dst, b, h) do { _Pragma("unroll") for (int n = 0; n < 2; ++n) _Pragma("unroll") for (int k = 0; k < 2; ++k) dst[n][k] = *(const PG8_LAS bf16x8*)(lds + PG8_SB(b, h) + boff + n * 2048 + k * 1024); } while (0)
#define PG8_MMA(ai, bj, At, Bt) do { __builtin_amdgcn_s_setprio(1); _Pragma("unroll") for (int m = 0; m < 4; ++m) _Pragma("unroll") for (int n = 0; n < 2; ++n) _Pragma("unroll") for (int k = 0; k < 2; ++k) \
        acc[ai][bj][m][n] = __builtin_amdgcn_mfma_f32_16x16x32_bf16(Bt[n][k], At[m][k], acc[ai][bj][m][n], 0, 0, 0); __builtin_amdgcn_s_setprio(0); } while (0)
#define PG8_WAIT_V(n) asm volatile("s_waitcnt vmcnt(" #n ")" ::: "memory")
#define PG8_WAIT_L(n) asm volatile("s_waitcnt lgkmcnt(" #n ")" ::: "memory")
#define PG8_BAR __builtin_amdgcn_s_barrier()
#define PG8_SCHED __builtin_amdgcn_sched_barrier(0)
    Unit cur, nxt; int ui = 0;
    if (!S.next(0, cur)) return;
    f32x4 acc[2][2][4][2];
#pragma unroll
    for (int a = 0; a < 2; ++a)
#pragma unroll
        for (int b = 0; b < 2; ++b)
#pragma unroll
            for (int m = 0; m < 4; ++m)
#pragma unroll
                for (int n = 0; n < 2; ++n) acc[a][b][m][n] = (f32x4){0.f, 0.f, 0.f, 0.f};
    bf16x8 At[4][2], B0[2][2], B1[2][2];
    const char* cA = (const char*)g.A + (size_t)cur.pm * tstep; const char* cB = (const char*)g.Bt + (size_t)cur.e * g.bstride + (size_t)cur.pn * tstep;
    S.a_ready(cur);
    if constexpr (SP2) {
        PG8_STAGE(PG8_SB(0, 0), cB, voffB); PG8_STAGE(PG8_SB(0, 1), cB + hstep, voffB); PG8_STAGE(PG8_SA(0, 0), cA, voffA); PG8_STAGE(PG8_SA(0, 1), cA + hstep, voffA);
        if (wr == 1) PG8_BAR;
        PG8_WAIT_V(2); PG8_BAR;
        PG8_STAGE(PG8_SB(1, 0), cB + kstep, voffB); PG8_STAGE(PG8_SA(1, 0), cA + kstep, voffA); PG8_STAGE(PG8_SB(1, 1), cB + hstep + kstep, voffB);
        PG8_WAIT_V(6); PG8_BAR;
    } else {
        PG8_STAGE(PG8_SB(0, 0), cB, voffB); PG8_STAGE(PG8_SA(0, 0), cA, voffA); PG8_STAGE(PG8_SB(0, 1), cB + hstep, voffB); PG8_STAGE(PG8_SA(0, 1), cA + hstep, voffA);
        if (wr == 1) PG8_BAR;
        PG8_WAIT_V(4); PG8_BAR;
        PG8_STAGE(PG8_SB(1, 0), cB + kstep, voffB); PG8_STAGE(PG8_SA(1, 0), cA + kstep, voffA); PG8_STAGE(PG8_SB(1, 1), cB + hstep + kstep, voffB);
        PG8_WAIT_V(6); PG8_BAR;
    }
    for (;;) {
        const bool has_next = S.next(ui + 1, nxt);
        const char* nA = has_next ? (const char*)g.A + (size_t)nxt.pm * tstep : cA; const char* nB = has_next ? (const char*)g.Bt + (size_t)nxt.e * g.bstride + (size_t)nxt.pn * tstep : cB;
        for (int t = 0; t < nt; t += 2) {
            const bool last = (t == nt - 2);
            const char* a1 = cA + (size_t)(t + 1) * kstep;
            const char* a2 = last ? nA : cA + (size_t)(t + 2) * kstep; const char* b2 = last ? nB : cB + (size_t)(t + 2) * kstep;
            const char* a3 = a2 + kstep; const char* b3 = b2 + kstep;
            if (last && has_next) S.a_ready(nxt);
            if constexpr (SP2) {
            PG8_LDB(B0, 0, 0); PG8_LDB(B1, 0, 1); PG8_SCHED; PG8_LDA(At, 0, 0); PG8_STAGE(PG8_SA(1, 1), a1 + hstep, voffA);
            PG8_WAIT_V(8); PG8_WAIT_L(0); PG8_BAR; PG8_MMA(0, 0, At, B0); PG8_MMA(0, 1, At, B1); PG8_BAR; PG8_SCHED;
            PG8_LDA(At, 0, 1); PG8_STAGE(PG8_SB(0, 0), b2, voffB); PG8_STAGE(PG8_SB(0, 1), b2 + hstep, voffB); PG8_STAGE(PG8_SA(0, 0), a2, voffA);
            PG8_WAIT_V(8); PG8_WAIT_L(0); PG8_BAR; PG8_MMA(1, 0, At, B0); PG8_MMA(1, 1, At, B1); PG8_BAR; PG8_SCHED;
            PG8_LDB(B0, 1, 0); PG8_LDB(B1, 1, 1); PG8_SCHED; PG8_LDA(At, 1, 0); PG8_STAGE(PG8_SA(0, 1), a2 + hstep, voffA);
            PG8_WAIT_V(8); PG8_WAIT_L(0); PG8_BAR; PG8_MMA(0, 0, At, B0); PG8_MMA(0, 1, At, B1); PG8_BAR; PG8_SCHED;
            PG8_LDA(At, 1, 1); PG8_STAGE(PG8_SB(1, 0), b3, voffB); PG8_STAGE(PG8_SB(1, 1), b3 + hstep, voffB); PG8_STAGE(PG8_SA(1, 0), a3, voffA);
            PG8_WAIT_V(8); PG8_WAIT_L(0); PG8_BAR; PG8_MMA(1, 0, At, B0); PG8_MMA(1, 1, At, B1); PG8_BAR; PG8_SCHED;
            } else {
            PG8_LDB(B0, 0, 0); PG8_SCHED; PG8_LDA(At, 0, 0); PG8_STAGE(PG8_SA(1, 1), a1 + hstep, voffA);
            PG8_WAIT_L(8); PG8_BAR; PG8_WAIT_L(0); PG8_MMA(0, 0, At, B0); PG8_BAR; PG8_SCHED;
            PG8_LDB(B1, 0, 1); PG8_STAGE(PG8_SB(0, 0), b2, voffB);
            PG8_BAR; PG8_WAIT_L(0); PG8_MMA(0, 1, At, B1); PG8_BAR;
            PG8_LDA(At, 0, 1); PG8_STAGE(PG8_SA(0, 0), a2, voffA);
            PG8_BAR; PG8_WAIT_L(0); PG8_MMA(1, 0, At, B0); PG8_BAR; PG8_SCHED;
            PG8_STAGE(PG8_SB(0, 1), b2 + hstep, voffB);
            PG8_WAIT_V(6); PG8_BAR; PG8_MMA(1, 1, At, B1); PG8_BAR;
            PG8_LDB(B0, 1, 0); PG8_SCHED; PG8_LDA(At, 1, 0); PG8_STAGE(PG8_SA(0, 1), a2 + hstep, voffA);
            PG8_WAIT_L(8); PG8_BAR; PG8_WAIT_L(0); PG8_MMA(0, 0, At, B0); PG8_BAR; PG8_SCHED;
            PG8_LDB(B1, 1, 1); PG8_STAGE(PG8_SB(1, 0), b3, voffB);
            PG8_BAR; PG8_WAIT_L(0); PG8_MMA(0, 1, At, B1); PG8_BAR;
            PG8_LDA(At, 1, 1); PG8_STAGE(PG8_SA(1, 0), a3, voffA);
            PG8_BAR; PG8_WAIT_L(0); PG8_MMA(1, 0, At, B0); PG8_BAR; PG8_SCHED;
            PG8_STAGE(PG8_SB(1, 1), b3 + hstep, voffB);
            PG8_WAIT_V(6); PG8_BAR; PG8_MMA(1, 1, At, B1); PG8_BAR;
            }
        }
        if constexpr (ALIGN_EPI) { if (wr == 0) PG8_BAR; }
        if constexpr (!Epi::AFTER_DRAIN) { E(acc, cur, wr, wc, fr, fq); S.done(cur); }
        if (!has_next) break;
#pragma unroll
        for (int a = 0; a < 2; ++a)
#pragma unroll
            for (int b = 0; b < 2; ++b)
#pragma unroll
                for (int m = 0; m < 4; ++m)
#pragma unroll
                    for (int n = 0; n < 2; ++n) acc[a][b][m][n] = (f32x4){0.f, 0.f, 0.f, 0.f};
        cur = nxt; cA = nA; cB = nB; ++ui;
        if constexpr (ALIGN_EPI) { if (wr == 1) PG8_BAR; }
    }
    PG8_WAIT_V(0);
    if constexpr (!ALIGN_EPI) { if (wr == 0) PG8_BAR; }
    PG8_BAR;
    if constexpr (Epi::AFTER_DRAIN) { E.fused(acc, cur, wr, wc, fr, fq, lds, wid, lane); S.done(cur); }
#undef PG8_SA
#undef PG8_SB
#undef PG8_STAGE
#undef PG8_LDA
#undef PG8_LDB
#undef PG8_MMA
#undef PG8_WAIT_V
#undef PG8_WAIT_L
#undef PG8_BAR
#undef PG8_SCHED
}
}

#define GAS __attribute__((address_space(1)))
#define LAS __attribute__((address_space(3)))
#define XB_TMO      128
#define XB_XCNT(j)  (256  + 64 * (j))
#define XB_XSUB(j)  (1280 + 64 * (j))
#define XB_XGEN(j)  (2304 + 64 * (j))
#define XB_TOP      3328
#define XB_TOPGEN   3392
#define XCD_BAR_WORDS 3456
#define XB_SPIN_CAP (1u << 18)

__device__ __forceinline__ unsigned xb_ld(unsigned* p)              { return __hip_atomic_load(p, __ATOMIC_RELAXED, __HIP_MEMORY_SCOPE_AGENT); }
__device__ __forceinline__ unsigned xb_add(unsigned* p, unsigned v) { return __hip_atomic_fetch_add(p, v, __ATOMIC_RELAXED, __HIP_MEMORY_SCOPE_AGENT); }
__device__ __forceinline__ unsigned xb_xcc_id() { return (unsigned)__builtin_amdgcn_s_getreg((3 << 11) | 20) & 0xFu; }
#define XB_SPIN(cond, bar) do { unsigned _sp = 0; while (cond) { __builtin_amdgcn_s_sleep(1); \
    if ((++_sp & 255u) == 0u) { if (xb_ld(&(bar)[XB_TMO])) break; if (_sp > XB_SPIN_CAP) { atomicAdd(&(bar)[XB_TMO], 1u); break; } } } } while (0)

struct XcdBarrier {
    unsigned* bar; unsigned x;
    volatile LAS unsigned* st;
};

__device__ __forceinline__ XcdBarrier xcd_barrier_post(unsigned* bar, volatile LAS unsigned* st) {
    XcdBarrier b; b.bar = bar; b.x = xb_xcc_id(); b.st = st;
    if (threadIdx.x == 0) (void)xb_add(&bar[XB_XCNT(b.x)], 1u);
    return b;
}
__device__ __forceinline__ void xcd_barrier_complete(unsigned* bar, unsigned x, unsigned& nloc, unsigned& nx) {
    const unsigned G = gridDim.x * gridDim.y * gridDim.z;
    unsigned sum, cnt, mine, sp = 0u;
    for (;;) {
        sum = 0u; cnt = 0u; mine = 0u;
#pragma unroll
        for (unsigned j = 0; j < 16; ++j) { const unsigned c = xb_ld(&bar[XB_XCNT(j)]); sum += c; cnt += (c > 0u) ? 1u : 0u; mine = (j == x) ? c : mine; }
        if (sum == G) break;
        __builtin_amdgcn_s_sleep(1);
        if ((++sp & 255u) == 0u) { if (xb_ld(&bar[XB_TMO])) break; if (sp > XB_SPIN_CAP) { atomicAdd(&bar[XB_TMO], 1u); break; } }
    }
    nloc = mine > 0u ? mine : 1u; nx = cnt > 0u ? cnt : 1u;
}

__device__ __forceinline__ void xcd_barrier(const XcdBarrier& b) {
    asm volatile("s_waitcnt vmcnt(0)" ::: "memory");
    __syncthreads();
    if (threadIdx.x == 0) {
        unsigned* bar = b.bar;
        __builtin_amdgcn_s_waitcnt(0);
        unsigned nloc = b.st[0], nx = b.st[1];
        if (nloc == 0u) { xcd_barrier_complete(bar, b.x, nloc, nx); b.st[0] = nloc; b.st[1] = nx; }
        const unsigned old = xb_add(&bar[XB_XSUB(b.x)], 1u);
        const unsigned gen = old / nloc;
        if (old + 1u == (gen + 1u) * nloc) {
            __builtin_amdgcn_fence(__ATOMIC_RELEASE, "agent");
            asm volatile("s_waitcnt vmcnt(0)" ::: "memory");
            const unsigned og = xb_add(&bar[XB_TOP], 1u);
            const unsigned tg = og / nx;
            if (og + 1u == (tg + 1u) * nx) xb_add(&bar[XB_TOPGEN], 1u);
            else XB_SPIN(xb_ld(&bar[XB_TOPGEN]) == tg, bar);
            __builtin_amdgcn_fence(__ATOMIC_ACQUIRE, "agent");
            xb_add(&bar[XB_XGEN(b.x)], 1u);
            asm volatile("s_waitcnt vmcnt(0)" ::: "memory");
        } else {
            XB_SPIN(xb_ld(&bar[XB_XGEN(b.x)]) == gen, bar);
            __builtin_amdgcn_fence(__ATOMIC_ACQUIRE, "agent");
            asm volatile("s_waitcnt vmcnt(0)" ::: "memory");
        }
    }
    __syncthreads();
}

template <int MODE  >
__device__ __forceinline__ void transpose_item(const float* __restrict__ W, int K, int N, bf16_t* __restrict__ WT, const float* __restrict__ gain, float* scr, int item, int lane) {
    const int nblk = N / 32, kb = item / nblk, nb = item % nblk, k0 = 64 * kb, n0 = 32 * nb;
#pragma unroll
    for (int i = 0; i < 8; ++i) { const int kk = 8 * i + (lane >> 3), n4 = (lane & 7) * 4; f32x4 v = *(const f32x4*)(W + (size_t)(k0 + kk) * N + n0 + n4);
        if (gain) { const float g = gain[k0 + kk]; v = v * g; }
        float* s = scr + kk * 33 + n4; s[0] = v[0]; s[1] = v[1]; s[2] = v[2]; s[3] = v[3]; }
    asm volatile("s_waitcnt lgkmcnt(0)" ::: "memory");
    const int c = lane & 7;
#pragma unroll
    for (int j = 0; j < 4; ++j) { const int n = (lane >> 3) + 8 * j; const float* s = scr + (8 * c) * 33 + n;
        u32x4 o; o.x = pk2(s[0 * 33], s[1 * 33]); o.y = pk2(s[2 * 33], s[3 * 33]); o.z = pk2(s[4 * 33], s[5 * 33]); o.w = pk2(s[6 * 33], s[7 * 33]);
        int row = n0 + n;
        if (MODE == 1) { const int f = row & 1023; row = ((f >> 7) << 8) + ((row >> 10) << 7) + (f & 127); }
        *(u32x4*)(WT + (size_t)row * K + k0 + 8 * c) = o; }
    asm volatile("s_waitcnt lgkmcnt(0)" ::: "memory");
}
__device__ __forceinline__ void phase_prologue(const Params& p, unsigned char* lds) {
    const int tid = threadIdx.x, lane = tid & 63, wave = tid >> 6;
    float* scr = (float*)(lds + wave * 16384);
    const int gw = blockIdx.x * NWAVES + wave, NGW = gridDim.x * NWAVES;
    unsigned char* ws = p.ws;
    constexpr int I_WIN = (DM / 64) * (INC / 32), I_UQ = (QLORA / 64) * (768 / 32), I_UKV = (KVLORA / 64) * (1024 / 32), I_OM = (512 / 64) * (DM / 32), I_OC = I_OM, I_WO = (DM / 64) * (DM / 32);
    constexpr int I_W1 = (DM / 64) * (2048 / 32), I_W2 = (DFF / 64) * (DM / 32);
    constexpr int NSMALL = I_WIN + I_UQ + I_UKV + I_OM + I_OC + I_WO;
    constexpr int NITEMS = NSMALL + NE * (I_W1 + I_W2);
    for (int it = gw; it < NITEMS; it += NGW) {
        int r = it;
        if (r < I_WIN) { transpose_item<0>(p.w_in, DM, INC, (bf16_t*)(ws + WS_WIN), p.norm1_g, scr, r, lane); continue; } r -= I_WIN;
        if (r < I_UQ) { transpose_item<0>(p.w_uq, QLORA, 768, (bf16_t*)(ws + WS_WUQ), p.q_a_g, scr, r, lane); continue; } r -= I_UQ;
        if (r < I_UKV) { transpose_item<0>(p.w_ukv, KVLORA, 1024, (bf16_t*)(ws + WS_WUKV), p.kv_a_g, scr, r, lane); continue; } r -= I_UKV;
        if (r < I_OM) { transpose_item<0>(p.w_o_mla, 512, DM, (bf16_t*)(ws + WS_WOMLA), nullptr, scr, r, lane); continue; } r -= I_OM;
        if (r < I_OC) { transpose_item<0>(p.w_o_conv, 512, DM, (bf16_t*)(ws + WS_WOCONV), nullptr, scr, r, lane); continue; } r -= I_OC;
        if (r < I_WO) { transpose_item<0>(p.w_o, DM, DM, (bf16_t*)(ws + WS_WO), nullptr, scr, r, lane); continue; } r -= I_WO;
        const int e = r / (I_W1 + I_W2); r -= e * (I_W1 + I_W2);
        if (r < I_W1) transpose_item<1>(p.w1 + (size_t)e * DM * 2048, DM, 2048, (bf16_t*)(ws + WS_W1) + (size_t)e * 2048 * DM, nullptr, scr, r, lane);
        else transpose_item<0>(p.w2 + (size_t)e * DFF * DM, DFF, DM, (bf16_t*)(ws + WS_W2) + (size_t)e * DM * DFF, nullptr, scr, r - I_W1, lane);
    }
    { u32x4* z = (u32x4*)((bf16_t*)(ws + WS_WIN) + (size_t)INC * DM); const int nz = (INCP - INC) * DM * 2 / 16;
      for (int i = blockIdx.x * NTHREADS + tid; i < nz; i += gridDim.x * NTHREADS) z[i] = (u32x4){0u, 0u, 0u, 0u}; }
    { int* rt = (int*)(ws + WS_ROUTE + RT_ROW_TOK); float* rw = (float*)(ws + WS_ROUTE + RT_ROW_W); int* rs = (int*)(ws + WS_ROUTE + RT_ROW_SLOT);
      for (int i = blockIdx.x * NTHREADS + tid; i < MAXROWS; i += gridDim.x * NTHREADS) { rt[i] = 0; rw[i] = 0.f; rs[i] = -1; } }
    bf16_t* XN = (bf16_t*)(ws + WS_XN);
    for (int m = gw; m < NTOK; m += NGW) {
        const f32x4* xr = (const f32x4*)(p.x + (size_t)m * DM) + lane; f32x4 v[4]; float s = 0.f;
#pragma unroll
        for (int j = 0; j < 4; ++j) { v[j] = xr[64 * j]; s += (v[j][0] * v[j][0] + v[j][1] * v[j][1]) + (v[j][2] * v[j][2] + v[j][3] * v[j][3]); }
        const float rstd = rsqrtf(wave_sum(s) * (1.f / DM) + EPS);
        u32x2* o = (u32x2*)(XN + (size_t)m * DM) + lane;
#pragma unroll
        for (int j = 0; j < 4; ++j) { u32x2 w; w.x = pk2(v[j][0] * rstd, v[j][1] * rstd); w.y = pk2(v[j][2] * rstd, v[j][3] * rstd); o[64 * j] = w; }
    }
}

__device__ __forceinline__ void phase_tok_a(const Params& p) {
    const int tid = threadIdx.x, lane = tid & 63, wave = tid >> 6;
    const int gw = blockIdx.x * NWAVES + wave, NGW = gridDim.x * NWAVES;
    const bf16_t* PROJ = (const bf16_t*)(p.ws + WS_PROJ); bf16_t* CQN = (bf16_t*)(p.ws + WS_CQN); bf16_t* CKVN = (bf16_t*)(p.ws + WS_CKVN); bf16_t* YB = (bf16_t*)(p.ws + WS_YBIN);
    float cw0[8], cw1[8], cw2[8];
#pragma unroll
    for (int j = 0; j < 8; ++j) { cw0[j] = p.conv_w[8 * lane + j]; cw1[j] = p.conv_w[CONVW + 8 * lane + j]; cw2[j] = p.conv_w[2 * CONVW + 8 * lane + j]; }
    for (int t = gw; t < NTOK; t += NGW) {
        const bf16_t* pr = PROJ + (size_t)t * INCP;
        { const u32x2 w = *(const u32x2*)(pr + OFF_CQ + 4 * lane); const float a = bf_lo(w.x), b = bf_hi(w.x), c = bf_lo(w.y), d = bf_hi(w.y);
          const float rstd = rsqrtf(wave_sum(a * a + b * b + c * c + d * d) * (1.f / QLORA) + EPS);
          u32x2 o; o.x = pk2(a * rstd, b * rstd); o.y = pk2(c * rstd, d * rstd); *(u32x2*)(CQN + (size_t)t * QLORA + 4 * lane) = o; }
        { const unsigned w = *(const unsigned*)(pr + OFF_CKV + 2 * lane); const float a = bf_lo(w), b = bf_hi(w);
          const float rstd = rsqrtf(wave_sum(a * a + b * b) * (1.f / KVLORA) + EPS);
          *(unsigned*)(CKVN + (size_t)t * KVLORA + 2 * lane) = pk2(a * rstd, b * rstd); }
        { const int s = t & (SEQ - 1); float cu[3][8];
#pragma unroll
          for (int d = 0; d < 3; ++d) { const int ss = s + d - 1; if (ss >= 0 && ss < SEQ) { const bf16_t* q = pr + (ptrdiff_t)(d - 1) * INCP; const u32x4 u = *(const u32x4*)(q + OFF_U + 8 * lane), c = *(const u32x4*)(q + OFF_C + 8 * lane);
                  cu[d][0] = bf_lo(u.x) * bf_lo(c.x); cu[d][1] = bf_hi(u.x) * bf_hi(c.x); cu[d][2] = bf_lo(u.y) * bf_lo(c.y); cu[d][3] = bf_hi(u.y) * bf_hi(c.y);
                  cu[d][4] = bf_lo(u.z) * bf_lo(c.z); cu[d][5] = bf_hi(u.z) * bf_hi(c.z); cu[d][6] = bf_lo(u.w) * bf_lo(c.w); cu[d][7] = bf_hi(u.w) * bf_hi(c.w); }
              else {
#pragma unroll
                  for (int j = 0; j < 8; ++j) cu[d][j] = 0.f; } }
          const u32x4 bg = *(const u32x4*)(pr + OFF_B + 8 * lane); float bb[8] = {bf_lo(bg.x), bf_hi(bg.x), bf_lo(bg.y), bf_hi(bg.y), bf_lo(bg.z), bf_hi(bg.z), bf_lo(bg.w), bf_hi(bg.w)}; float y[8];
#pragma unroll
          for (int j = 0; j < 8; ++j) y[j] = bb[j] * (cw0[j] * cu[0][j] + cw1[j] * cu[1][j] + cw2[j] * cu[2][j]);
          u32x4 o; o.x = pk2(y[0], y[1]); o.y = pk2(y[2], y[3]); o.z = pk2(y[4], y[5]); o.w = pk2(y[6], y[7]); *(u32x4*)(YB + (size_t)t * CONVW + 8 * lane) = o; }
    }
}

__device__ __forceinline__ void phase_tok_b(const Params& p) {
    const int tid = threadIdx.x, lane = tid & 63, wave = tid >> 6, h = lane >> 3, sub = lane & 7;
    const int gw = blockIdx.x * NWAVES + wave, NGW = gridDim.x * NWAVES;
    const float* QPRE = (const float*)(p.ws + WS_QPRE); const float* KVPRE = (const float*)(p.ws + WS_KVPRE); const bf16_t* PROJ = (const bf16_t*)(p.ws + WS_PROJ);
    bf16_t* Q = (bf16_t*)(p.ws + WS_Q); bf16_t* Kb = (bf16_t*)(p.ws + WS_K); bf16_t* V = (bf16_t*)(p.ws + WS_V);
    float qg[12], kg[12];
#pragma unroll
    for (int j = 0; j < 8; ++j) { qg[j] = p.q_g[sub * 8 + j]; kg[j] = p.k_g[sub * 8 + j]; }
    qg[8] = p.q_g[64 + 2 * sub]; qg[9] = p.q_g[65 + 2 * sub]; qg[10] = p.q_g[80 + 2 * sub]; qg[11] = p.q_g[81 + 2 * sub];
    kg[8] = p.k_g[64 + 2 * sub]; kg[9] = p.k_g[65 + 2 * sub]; kg[10] = p.k_g[80 + 2 * sub]; kg[11] = p.k_g[81 + 2 * sub];
    const float if0 = exp2f(-(float)(2 * sub) * (13.287712379549449f / 16.f)), if1 = exp2f(-(float)(2 * sub + 1) * (13.287712379549449f / 16.f));
    for (int t = gw; t < NTOK; t += NGW) {
        const int b = t >> 13, s = t & (SEQ - 1); const float pos = (float)p.pos[t];
        float c0, s0, c1, s1; sincosf(pos * if0, &s0, &c0); sincosf(pos * if1, &s1, &c1);
        const size_t rowi = ((size_t)(b * NH + h) * SEQ + s);
        { const float* qp = QPRE + (size_t)t * 768 + h * DQK; const f32x4 a = *(const f32x4*)(qp + sub * 8), bq = *(const f32x4*)(qp + sub * 8 + 4); const f32x2 r1 = *(const f32x2*)(qp + 64 + 2 * sub), r2 = *(const f32x2*)(qp + 80 + 2 * sub);
          float v[12] = {a[0], a[1], a[2], a[3], bq[0], bq[1], bq[2], bq[3], r1[0], r1[1], r2[0], r2[1]}; float ss = 0.f;
#pragma unroll
          for (int j = 0; j < 12; ++j) ss += v[j] * v[j];
          ss += __shfl_xor(ss, 1); ss += __shfl_xor(ss, 2); ss += __shfl_xor(ss, 4);
          const float rstd = rsqrtf(ss * (1.f / DQK) + EPS);
#pragma unroll
          for (int j = 0; j < 12; ++j) v[j] *= rstd * qg[j];
          const float o8 = v[8] * c0 - v[10] * s0, o9 = v[9] * c1 - v[11] * s1, o10 = v[8] * s0 + v[10] * c0, o11 = v[9] * s1 + v[11] * c1;
          bf16_t* qo = Q + rowi * DQK; u32x4 w; w.x = pk2(v[0], v[1]); w.y = pk2(v[2], v[3]); w.z = pk2(v[4], v[5]); w.w = pk2(v[6], v[7]);
          *(u32x4*)(qo + sub * 8) = w; *(unsigned*)(qo + 64 + 2 * sub) = pk2(o8, o9); *(unsigned*)(qo + 80 + 2 * sub) = pk2(o10, o11); }
        { const float* kp = KVPRE + (size_t)t * 1024 + h * 128; const f32x4 a = *(const f32x4*)(kp + sub * 8), bq = *(const f32x4*)(kp + sub * 8 + 4);
          const bf16_t* kr = PROJ + (size_t)t * INCP + OFF_KR; const unsigned w1 = *(const unsigned*)(kr + 2 * sub), w2 = *(const unsigned*)(kr + 16 + 2 * sub);
          float v[12] = {a[0], a[1], a[2], a[3], bq[0], bq[1], bq[2], bq[3], bf_lo(w1), bf_hi(w1), bf_lo(w2), bf_hi(w2)}; float ss = 0.f;
#pragma unroll
          for (int j = 0; j < 12; ++j) ss += v[j] * v[j];
          ss += __shfl_xor(ss, 1); ss += __shfl_xor(ss, 2); ss += __shfl_xor(ss, 4);
          const float rstd = rsqrtf(ss * (1.f / DQK) + EPS);
#pragma unroll
          for (int j = 0; j < 12; ++j) v[j] *= rstd * kg[j];
          const float o8 = v[8] * c0 - v[10] * s0, o9 = v[9] * c1 - v[11] * s1, o10 = v[8] * s0 + v[10] * c0, o11 = v[9] * s1 + v[11] * c1;
          bf16_t* ko = Kb + rowi * 128; u32x4 w; w.x = pk2(v[0], v[1]); w.y = pk2(v[2], v[3]); w.z = pk2(v[4], v[5]); w.w = pk2(v[6], v[7]);
          *(u32x4*)(ko + sub * 8) = w; *(unsigned*)(ko + 64 + 2 * sub) = pk2(o8, o9); *(unsigned*)(ko + 80 + 2 * sub) = pk2(o10, o11);
          if (sub < 4) *(u32x4*)(ko + 96 + sub * 8) = (u32x4){0u, 0u, 0u, 0u};
          const f32x4 va = *(const f32x4*)(kp + 64 + sub * 8), vb = *(const f32x4*)(kp + 64 + sub * 8 + 4);
          u32x4 wv; wv.x = pk2(va[0], va[1]); wv.y = pk2(va[2], va[3]); wv.z = pk2(vb[0], vb[1]); wv.w = pk2(vb[2], vb[3]); *(u32x4*)(V + rowi * DV + sub * 8) = wv; }
    }
}

namespace att {
constexpr int NW = 8, QBLK = 32, KVBLK = 64;
constexpr float SCALE = 0.10206207261596575f;
constexpr float THR = 8.f;
constexpr int LDQ = DQK, LDK = 128, LDV = DV;
constexpr int SHM_V = KVBLK * DV * 2, SHM_K = KVBLK * 256, SHM_ATTN = 2 * SHM_V + 2 * SHM_K + NW * 64 * 4;
#define KSWZ(row, colB) ((row) * 256 + ((colB) ^ (((row) & 7) << 4)))
#define SBAR() __builtin_amdgcn_sched_barrier(0)
__device__ __forceinline__ int crow(int r, int hi) { return (r & 3) + 8 * (r >> 2) + 4 * hi; }
__device__ __forceinline__ unsigned cvtpk(float lo, float hi) { unsigned r; asm volatile("v_cvt_pk_bf16_f32 %0, %1, %2" : "=v"(r) : "v"(lo), "v"(hi)); return r; }
__device__ __forceinline__ void partialSM(f32x16& p0, f32x16& p1, float& m_reg, float& mn, float& alpha) {
    constexpr float C = SCALE * 1.4426950408889634f;
    float pmax = p0[0];
#pragma unroll
    for (int r = 1; r < 16; ++r) pmax = fmaxf(pmax, p0[r]);
#pragma unroll
    for (int r = 0; r < 16; ++r) pmax = fmaxf(pmax, p1[r]);
    { auto rr = __builtin_amdgcn_permlane32_swap(__float_as_uint(pmax), __float_as_uint(pmax), false, false); pmax = fmaxf(__uint_as_float(rr[0]), __uint_as_float(rr[1])); }
    if (__builtin_expect(__all(pmax - m_reg <= THR / SCALE), 1)) { mn = m_reg; alpha = 1.f; }
    else { mn = fmaxf(m_reg, pmax); alpha = __builtin_amdgcn_exp2f((m_reg - mn) * C); m_reg = mn; }
    const float mnC = -mn * C;
#pragma unroll
    for (int r = 0; r < 16; ++r) p0[r] = fmaf(p0[r], C, mnC);
#pragma unroll
    for (int r = 0; r < 16; ++r) p1[r] = fmaf(p1[r], C, mnC);
#pragma unroll
    for (int r = 0; r < 16; ++r) p0[r] = __builtin_amdgcn_exp2f(p0[r]);
}
__device__ __forceinline__ void finishSM(f32x16& p0, f32x16& p1, float alpha, float& l_reg, bf16x8& pa0, bf16x8& pa1, bf16x8& pa2, bf16x8& pa3) {
#pragma unroll
    for (int r = 0; r < 16; ++r) p1[r] = __builtin_amdgcn_exp2f(p1[r]);
    float ps = 0;
#pragma unroll
    for (int r = 0; r < 16; ++r) ps += p0[r];
#pragma unroll
    for (int r = 0; r < 16; ++r) ps += p1[r];
    { auto rr = __builtin_amdgcn_permlane32_swap(__float_as_uint(ps), __float_as_uint(ps), false, false); ps = __uint_as_float(rr[0]) + __uint_as_float(rr[1]); }
    l_reg = l_reg * alpha + ps;
#define PK4(P, BASE, OUT) do { unsigned a0 = cvtpk(P[BASE + 0], P[BASE + 1]), a1 = cvtpk(P[BASE + 2], P[BASE + 3]);   \
    unsigned b0 = cvtpk(P[BASE + 4], P[BASE + 5]), b1 = cvtpk(P[BASE + 6], P[BASE + 7]);                              \
    auto r0 = __builtin_amdgcn_permlane32_swap(a0, b0, false, false); auto r1 = __builtin_amdgcn_permlane32_swap(a1, b1, false, false); \
    u32x4 w = {r0[0], r1[0], r0[1], r1[1]}; OUT = *reinterpret_cast<bf16x8*>(&w); } while (0)
    PK4(p0, 0, pa0); PK4(p0, 8, pa1); PK4(p1, 0, pa2); PK4(p1, 8, pa3);
#undef PK4
}
__device__ __forceinline__ void qkt(f32x16& p0, f32x16& p1, const unsigned char* Ks, const bf16x8* qr, int r32, int hi) {
    p0 = f32x16{}; p1 = f32x16{};
#pragma unroll
    for (int d0 = 0; d0 < 6; ++d0) { const int cb = (d0 * 16 + hi * 8) * 2;
        const bf16x8 b0 = *reinterpret_cast<const bf16x8*>(Ks + KSWZ(r32, cb));
        const bf16x8 b1 = *reinterpret_cast<const bf16x8*>(Ks + KSWZ(32 + r32, cb));
        p0 = __builtin_amdgcn_mfma_f32_32x32x16_bf16(b0, qr[d0], p0, 0, 0, 0);
        p1 = __builtin_amdgcn_mfma_f32_32x32x16_bf16(b1, qr[d0], p1, 0, 0, 0); }
}
__device__ __forceinline__ int v_st(int k, int c) { const int kk = (k & ~0xC) | ((k & 4) << 1) | ((k & 8) >> 1); return ((kk >> 3) * 2 + (c >> 5)) * 512 + ((kk & 7) * 32 + (c & 31)) * 2; }
__device__ __forceinline__ int v_rd_base(int lane) { return ((lane & 3) << 3) | (((lane >> 2) & 3) << 6) | (((lane >> 4) & 1) << 5) | (((lane >> 5) & 1) << 8); }
constexpr int v_rd_off(int d0, int ks, int half) { return d0 * 512 + ks * 2048 + half * 1024; }
template <int OFF> __device__ __forceinline__ s16x4 tr_read(int vb) { s16x4 r; asm volatile("ds_read_b64_tr_b16 %0, %1 offset:%2" : "=&v"(r) : "v"(vb), "i"(OFF) : "memory"); return r; }
template <int D0> __device__ __forceinline__ void pv_one(f32x16& od, int vb, bf16x8 pa0, bf16x8 pa1, bf16x8 pa2, bf16x8 pa3) {
    const s16x4 l0 = tr_read<v_rd_off(D0, 0, 0)>(vb), h0 = tr_read<v_rd_off(D0, 0, 1)>(vb), l1 = tr_read<v_rd_off(D0, 1, 0)>(vb), h1 = tr_read<v_rd_off(D0, 1, 1)>(vb);
    const s16x4 l2 = tr_read<v_rd_off(D0, 2, 0)>(vb), h2 = tr_read<v_rd_off(D0, 2, 1)>(vb), l3 = tr_read<v_rd_off(D0, 3, 0)>(vb), h3 = tr_read<v_rd_off(D0, 3, 1)>(vb);
    asm volatile("s_waitcnt lgkmcnt(0)" ::: "memory"); SBAR();
#define PK(L, H) (bf16x8){L[0], L[1], L[2], L[3], H[0], H[1], H[2], H[3]}
    od = __builtin_amdgcn_mfma_f32_32x32x16_bf16(pa0, PK(l0, h0), od, 0, 0, 0);
    od = __builtin_amdgcn_mfma_f32_32x32x16_bf16(pa1, PK(l1, h1), od, 0, 0, 0);
    od = __builtin_amdgcn_mfma_f32_32x32x16_bf16(pa2, PK(l2, h2), od, 0, 0, 0);
    od = __builtin_amdgcn_mfma_f32_32x32x16_bf16(pa3, PK(l3, h3), od, 0, 0, 0);
#undef PK
}
__device__ __forceinline__ void pv_d0(f32x16* o, int vb, bf16x8 pa0, bf16x8 pa1, bf16x8 pa2, bf16x8 pa3) { pv_one<0>(o[0], vb, pa0, pa1, pa2, pa3); pv_one<1>(o[1], vb, pa0, pa1, pa2, pa3); }

__device__ __forceinline__ void attn_unit(const bf16_t* __restrict__ Qb, const bf16_t* __restrict__ Kh, const bf16_t* __restrict__ Vh, bf16_t* __restrict__ Ob, int seq, unsigned char* lds) {
    const int tid = threadIdx.x, wid = tid >> 6, lane = tid & 63, r32 = lane & 31, hi = lane >> 5;
    unsigned char* V_lds = lds; unsigned char* K_lds = lds + 2 * SHM_V;
    float* wsf = (float*)(lds + 2 * SHM_V + 2 * SHM_K) + wid * 64; float* li_l = wsf; float* al_l = wsf + 32;
    float m_reg = -1e30f, l_reg = 0; f32x16 o[2] = {}; bf16x8 qr[6];
    const bf16_t* Qw = Qb + (size_t)(wid * QBLK + r32) * LDQ + hi * 8;
#pragma unroll
    for (int d0 = 0; d0 < 6; ++d0) qr[d0] = *reinterpret_cast<const bf16x8*>(Qw + d0 * 16);
    const int sr = tid >> 4, sc = (tid & 15) * 8;
    const int vr = tid >> 3, vc = (tid & 7) * 8, vst = v_st(vr, vc);
    const int vb0 = (int)(uintptr_t)V_lds + v_rd_base(lane);
    struct { bf16x8 vs, ks0, ks1; } sr_[2];
#define SLOAD(i, k0) do { sr_[i].vs = *reinterpret_cast<const bf16x8*>(&Vh[(size_t)((k0) + vr) * LDV + vc]); \
    sr_[i].ks0 = *reinterpret_cast<const bf16x8*>(&Kh[(size_t)((k0) + sr) * LDK + sc]); sr_[i].ks1 = *reinterpret_cast<const bf16x8*>(&Kh[(size_t)((k0) + 32 + sr) * LDK + sc]); } while (0)
#define SWRITE(b, i) do { *(bf16x8*)(V_lds + (b) * SHM_V + vst) = sr_[i].vs; const int kc = sc * 2;               \
    *(bf16x8*)(K_lds + (b) * SHM_K + KSWZ(sr, kc)) = sr_[i].ks0; *(bf16x8*)(K_lds + (b) * SHM_K + KSWZ(32 + sr, kc)) = sr_[i].ks1; } while (0)
#define SWAIT() asm volatile("s_waitcnt vmcnt(3)" ::: "memory")
#define RESC(a) do { if (__any((a) < 1.f)) { if (hi == 0) al_l[r32] = (a); asm volatile("s_waitcnt lgkmcnt(0)" ::: "memory"); \
    _Pragma("unroll") for (int d = 0; d < 2; ++d) _Pragma("unroll") for (int r = 0; r < 16; ++r) o[d][r] *= al_l[crow(r, hi)]; } } while (0)
    f32x16 pA0, pA1, pB0, pB1; float mnA, mnB, alA, alB; bf16x8 pa0, pa1, pa2, pa3; const int NT = seq / KVBLK;
    constexpr int SE = 0, SO = 1;
    SLOAD(SE, 0); asm volatile("s_waitcnt vmcnt(0)" ::: "memory"); SWRITE(0, SE); __syncthreads();
    qkt(pA0, pA1, K_lds, qr, r32, hi); partialSM(pA0, pA1, m_reg, mnA, alA);
    SLOAD(SO, KVBLK); if (2 < NT) SLOAD(SE, 2 * KVBLK);
    SWAIT(); SWRITE(1, SO); __syncthreads();
    for (int j = 1; j + 1 < NT; j += 2) {
        SBAR(); qkt(pB0, pB1, K_lds + SHM_K, qr, r32, hi);
        finishSM(pA0, pA1, alA, l_reg, pa0, pa1, pa2, pa3); SBAR();
        SLOAD(SO, (j + 2) * KVBLK); SBAR();
        pv_d0(o, vb0, pa0, pa1, pa2, pa3); partialSM(pB0, pB1, m_reg, mnB, alB);
        __syncthreads(); SWAIT(); SWRITE(0, SE);
        RESC(alB); __syncthreads();
        SBAR(); qkt(pA0, pA1, K_lds, qr, r32, hi);
        finishSM(pB0, pB1, alB, l_reg, pa0, pa1, pa2, pa3); SBAR();
        if (j + 3 < NT) SLOAD(SE, (j + 3) * KVBLK); SBAR();
        pv_d0(o, vb0 + SHM_V, pa0, pa1, pa2, pa3); partialSM(pA0, pA1, m_reg, mnA, alA);
        __syncthreads(); SWAIT(); SWRITE(1, SO);
        RESC(alA); __syncthreads();
    }
    SBAR(); qkt(pB0, pB1, K_lds + SHM_K, qr, r32, hi);
    finishSM(pA0, pA1, alA, l_reg, pa0, pa1, pa2, pa3); SBAR();
    pv_d0(o, vb0, pa0, pa1, pa2, pa3); partialSM(pB0, pB1, m_reg, mnB, alB);
    __syncthreads(); RESC(alB);
    finishSM(pB0, pB1, alB, l_reg, pa0, pa1, pa2, pa3); SBAR();
    pv_d0(o, vb0 + SHM_V, pa0, pa1, pa2, pa3);
    if (hi == 0) li_l[r32] = l_reg; asm volatile("s_waitcnt lgkmcnt(0)" ::: "memory");
    float rli[16];
#pragma unroll
    for (int r = 0; r < 16; ++r) rli[r] = __builtin_amdgcn_rcpf(li_l[crow(r, hi)]);
    bf16_t* Ow = Ob + (size_t)(wid * QBLK) * 512;
#pragma unroll
    for (int r = 0; r < 16; ++r) { const int orow = crow(r, hi);
#pragma unroll
        for (int d0 = 0; d0 < 2; ++d0) Ow[(size_t)orow * 512 + d0 * 32 + r32] = (bf16_t)(pk2(o[d0][r] * rli[r], 0.f) & 0xffffu); }
    __syncthreads();
#undef SLOAD
#undef SWRITE
#undef SWAIT
#undef RESC
}
#undef KSWZ
#undef SBAR
}

__device__ __forceinline__ void phase_attn(const Params& p, unsigned char* lds) {
    const bf16_t* Q = (const bf16_t*)(p.ws + WS_Q); const bf16_t* Kb = (const bf16_t*)(p.ws + WS_K); const bf16_t* V = (const bf16_t*)(p.ws + WS_V); bf16_t* AO = (bf16_t*)(p.ws + WS_AO);
    constexpr int NQB = SEQ / 256, NU = 2 * NH * NQB;
    for (int u = blockIdx.x; u < NU; u += gridDim.x) {
        const int qb = u % NQB, h = (u / NQB) % NH, b = u / (NQB * NH); const size_t bh = (size_t)(b * NH + h) * SEQ;
        att::attn_unit(Q + (bh + (size_t)qb * 256) * DQK, Kb + bh * 128, V + bh * DV, AO + ((size_t)b * SEQ + (size_t)qb * 256) * 512 + h * DV, SEQ, lds);
    }
}

__device__ __forceinline__ void phase_router(const Params& p, unsigned char* lds) {
    const int tid = threadIdx.x, lane = tid & 63, wave = tid >> 6;
    float* hbuf = (float*)lds + wave * 4096;
    int* lcnt = (int*)(lds + 131072);
    int* lbase = lcnt + 32;
    int* pe = lbase + 32;
    int* prk = pe + 256;
    float* pw = (float*)(prk + 256);
    unsigned* gcnt = (unsigned*)(p.ws + WS_CTL) + CW_CNT;
    int* pair_e = (int*)(p.ws + WS_ROUTE + RT_PAIR_E); int* pair_rank = (int*)(p.ws + WS_ROUTE + RT_PAIR_RANK); float* pair_w = (float*)(p.ws + WS_ROUTE + RT_PAIR_W);
    const int e = lane & 31, half = lane >> 5;
    const float rb = p.router_b[e];
    for (int tg = blockIdx.x; tg < NTOK / 64; tg += gridDim.x) {
        if (tid < 32) lcnt[tid] = 0;
        __syncthreads();
        for (int pass = 0; pass < 2; ++pass) {
            const int tl0 = wave * 8 + pass * 4;
#pragma unroll
            for (int tt = 0; tt < 4; ++tt) {
                const int t = tg * 64 + tl0 + tt;
                const f32x4* xr = (const f32x4*)(p.out + (size_t)t * DM) + lane; f32x4 v[4]; float s = 0.f;
#pragma unroll
                for (int j = 0; j < 4; ++j) { v[j] = xr[64 * j]; s += (v[j][0] * v[j][0] + v[j][1] * v[j][1]) + (v[j][2] * v[j][2] + v[j][3] * v[j][3]); }
                const float rstd = rsqrtf(wave_sum(s) * (1.f / DM) + EPS);
#pragma unroll
                for (int j = 0; j < 4; ++j) { const f32x4 g = *((const f32x4*)p.norm2_g + lane + 64 * j); const f32x4 hh = v[j] * rstd * g; *((f32x4*)(hbuf + tt * 1024) + lane + 64 * j) = hh; }
            }
            asm volatile("s_waitcnt lgkmcnt(0)" ::: "memory");
            float a0 = 0.f, a1 = 0.f, a2 = 0.f, a3 = 0.f;
            const float* rwp = p.router_w + (size_t)(half * 512) * NE + e; const float* hb = hbuf + half * 512;
#pragma unroll 16
            for (int kk = 0; kk < 512; ++kk) { const float r = rwp[(size_t)kk * NE]; a0 += hb[kk] * r; a1 += hb[1024 + kk] * r; a2 += hb[2048 + kk] * r; a3 += hb[3072 + kk] * r; }
            a0 += __shfl_xor(a0, 32); a1 += __shfl_xor(a1, 32); a2 += __shfl_xor(a2, 32); a3 += __shfl_xor(a3, 32);
            float lg[4] = {a0 + rb, a1 + rb, a2 + rb, a3 + rb};
#pragma unroll
            for (int tt = 0; tt < 4; ++tt) {
                float val = lg[tt]; float tv[4]; int ti[4];
#pragma unroll
                for (int r = 0; r < 4; ++r) {
                    float bv = val; int bi = e;
#pragma unroll
                    for (int o = 1; o < 32; o <<= 1) { const float ov = __shfl_xor(bv, o); const int oi = __shfl_xor(bi, o); if (ov > bv || (ov == bv && oi < bi)) { bv = ov; bi = oi; } }
                    tv[r] = bv; ti[r] = bi; if (e == bi) val = -INFINITY;
                }
                const float e1 = __expf(tv[1] - tv[0]), e2 = __expf(tv[2] - tv[0]), e3 = __expf(tv[3] - tv[0]); const float inv = 1.f / (1.f + e1 + e2 + e3);
                const float wv[4] = {inv, e1 * inv, e2 * inv, e3 * inv};
                if (lane < 4) { const int ee = lane == 0 ? ti[0] : lane == 1 ? ti[1] : lane == 2 ? ti[2] : ti[3]; const float ww = lane == 0 ? wv[0] : lane == 1 ? wv[1] : lane == 2 ? wv[2] : wv[3];
                    const int rl = atomicAdd(&lcnt[ee], 1); const int pl = (tl0 + tt) * 4 + lane; pe[pl] = ee; prk[pl] = rl; pw[pl] = ww; }
            }
            asm volatile("s_waitcnt lgkmcnt(0)" ::: "memory");
        }
        __syncthreads();
        if (tid < 32) lbase[tid] = (int)atomicAdd(&gcnt[tid], (unsigned)lcnt[tid]);
        __syncthreads();
        if (tid < 256) { const int gp = tg * 256 + tid; const int ee = pe[tid]; pair_e[gp] = ee; pair_rank[gp] = lbase[ee] + prk[tid]; pair_w[gp] = pw[tid]; }
        __syncthreads();
    }
}

__device__ __forceinline__ void build_block_table(const Params& p, int* bs) {
    const unsigned* gcnt = (const unsigned*)(p.ws + WS_CTL) + CW_CNT;
    if (threadIdx.x == 0) { int acc = 0; for (int e = 0; e < NE; ++e) { bs[e] = acc; acc += ((int)__hip_atomic_load(gcnt + e, __ATOMIC_RELAXED, __HIP_MEMORY_SCOPE_AGENT) + 255) >> 8; } bs[NE] = acc; }
    __syncthreads();
}

__device__ __forceinline__ void phase_scatter(const Params& p, unsigned char* lds) {
    int* bs = (int*)(lds + 131072); build_block_table(p, bs);
    const int tid = threadIdx.x, lane = tid & 63, wave = tid >> 6;
    const int gw = blockIdx.x * NWAVES + wave, NGW = gridDim.x * NWAVES;
    const int* pair_e = (const int*)(p.ws + WS_ROUTE + RT_PAIR_E); const int* pair_rank = (const int*)(p.ws + WS_ROUTE + RT_PAIR_RANK); const float* pair_w = (const float*)(p.ws + WS_ROUTE + RT_PAIR_W);
    float* rw = (float*)(p.ws + WS_ROUTE + RT_ROW_W); int* rs = (int*)(p.ws + WS_ROUTE + RT_ROW_SLOT);
    bf16_t* XS = (bf16_t*)(p.ws + WS_XS);
    for (int t = gw; t < NTOK; t += NGW) {
        int dest = 0;
        if (lane < 4) { const int i = t * 4 + lane; dest = bs[pair_e[i]] * 256 + pair_rank[i]; rw[dest] = pair_w[i]; rs[dest] = i; }
        const int d0 = __shfl(dest, 0), d1 = __shfl(dest, 1), d2 = __shfl(dest, 2), d3 = __shfl(dest, 3);
        const f32x4* xr = (const f32x4*)(p.out + (size_t)t * DM) + lane; f32x4 v[4]; float s = 0.f;
#pragma unroll
        for (int j = 0; j < 4; ++j) { v[j] = xr[64 * j]; s += (v[j][0] * v[j][0] + v[j][1] * v[j][1]) + (v[j][2] * v[j][2] + v[j][3] * v[j][3]); }
        const float rstd = rsqrtf(wave_sum(s) * (1.f / DM) + EPS);
#pragma unroll
        for (int j = 0; j < 4; ++j) { const f32x4 g = *((const f32x4*)p.norm2_g + lane + 64 * j); const f32x4 hh = v[j] * rstd * g; u32x2 w; w.x = pk2(hh[0], hh[1]); w.y = pk2(hh[2], hh[3]);
            *((u32x2*)(XS + (size_t)d0 * DM) + lane + 64 * j) = w; *((u32x2*)(XS + (size_t)d1 * DM) + lane + 64 * j) = w;
            *((u32x2*)(XS + (size_t)d2 * DM) + lane + 64 * j) = w; *((u32x2*)(XS + (size_t)d3 * DM) + lane + 64 * j) = w; }
    }
    { const unsigned* gcnt = (const unsigned*)(p.ws + WS_CTL) + CW_CNT;
      for (int e = 0; e < NE; ++e) { const int c = (int)__hip_atomic_load(gcnt + e, __ATOMIC_RELAXED, __HIP_MEMORY_SCOPE_AGENT); const int r0 = bs[e] * 256 + c, r1 = bs[e + 1] * 256;
          for (int r = r0 + gw; r < r1; r += NGW) { u32x4* o = (u32x4*)(XS + (size_t)r * DM) + lane; o[0] = (u32x4){0u, 0u, 0u, 0u}; o[64] = (u32x4){0u, 0u, 0u, 0u}; } } }
    __syncthreads();
}

__device__ __forceinline__ pg8::MoeOrder make_moe_order(const int* bs, int N) {
    pg8::MoeOrder S; S.so.init(bs[NE] * 256, N, (int)gridDim.x, (int)blockIdx.x); unsigned long long ep = 0ull;
    for (int i = 0; i < 12; ++i) { pg8::Unit u; if (!S.so.next(i, u)) break; int e = 0; for (int k = 1; k < NE; ++k) if (bs[k] <= u.pm) e = k; ep |= (unsigned long long)e << (5 * i); }
    S.epack = ep; return S;
}
__device__ __forceinline__ void phase_moe1(const Params& p, unsigned char* lds) {
    int* bs = (int*)(lds + 131072); build_block_table(p, bs);
    const pg8::MoeOrder S = make_moe_order(bs, 2048);
    pg8::Gemm g{(const bf16_t*)(p.ws + WS_XS), (const bf16_t*)(p.ws + WS_W1), bs[NE] * 256, 2048, DM, (size_t)2048 * DM * 2};
    pg8::EpiSwiglu E{(bf16_t*)(p.ws + WS_ACT), p.b1};
    pg8::gemm_phase<pg8::EpiSwiglu, pg8::MoeOrder, true, true>((PG8_LAS unsigned char*)lds, g, S, E);
}
__device__ __forceinline__ void phase_moe2(const Params& p, unsigned char* lds) {
    int* bs = (int*)(lds + 131072); build_block_table(p, bs);
    const pg8::MoeOrder S = make_moe_order(bs, DM);
    pg8::Gemm g{(const bf16_t*)(p.ws + WS_ACT), (const bf16_t*)(p.ws + WS_W2), bs[NE] * 256, DM, DFF, (size_t)DM * DFF * 2};
    pg8::EpiMoeOut E{(bf16_t*)(p.ws + WS_YS), p.b2, (const float*)(p.ws + WS_ROUTE + RT_ROW_W), (const int*)(p.ws + WS_ROUTE + RT_ROW_SLOT)};
    pg8::gemm_phase<pg8::EpiMoeOut, pg8::MoeOrder, true, true>((PG8_LAS unsigned char*)lds, g, S, E);
}

__device__ __forceinline__ void phase_combine(const Params& p) {
    const int tid = threadIdx.x, lane = tid & 63, wave = tid >> 6;
    const int gw = blockIdx.x * NWAVES + wave, NGW = gridDim.x * NWAVES;
    const bf16_t* YS = (const bf16_t*)(p.ws + WS_YS);
    for (int t = gw; t < NTOK; t += NGW) {
        f32x4* orow = (f32x4*)(p.out + (size_t)t * DM) + lane;
#pragma unroll
        for (int j = 0; j < 4; ++j) { f32x4 v = orow[64 * j];
#pragma unroll
            for (int k = 0; k < 4; ++k) { const u32x2 w = *((const u32x2*)(YS + ((size_t)t * 4 + k) * DM) + lane + 64 * j); v[0] += bf_lo(w.x); v[1] += bf_hi(w.x); v[2] += bf_lo(w.y); v[3] += bf_hi(w.y); }
            orow[64 * j] = v; }
    }
}

template <class Epi>
__device__ __forceinline__ void dense_gemm(unsigned char* lds, const bf16_t* A, const bf16_t* Bt, int M, int N, int K, const Epi& E) {
    pg8::Gemm g{A, Bt, M, N, K, 0}; pg8::StaticOrder S; S.init(M, N, (int)gridDim.x, (int)blockIdx.x);
    pg8::gemm_phase<Epi, pg8::StaticOrder, true, true>((PG8_LAS unsigned char*)lds, g, S, E);
}

constexpr int NPHASE = 13;
__global__ void __launch_bounds__(NTHREADS, 2) mk_fwd(Params p) {
    extern __shared__ __attribute__((aligned(16))) unsigned char lds[];
    cg::grid_group grid = cg::this_grid();
    unsigned char* ws = p.ws;
    volatile LAS unsigned* MISC = (volatile LAS unsigned*)((LAS unsigned char*)lds + MISC_OFF);
    if (threadIdx.x < 32) MISC[threadIdx.x] = 0u;
    __syncthreads();
    XcdBarrier bar = xcd_barrier_post((unsigned*)(ws + WS_CTL) + CW_BAR, MISC + 8);
    const int lo = p.ph_lo, hi = p.ph_hi;
    if (lo < 0) grid.sync();
#define IN(k) (lo <= (k) && (k) < hi)
#define SEAM(k) do { if (IN(k) && IN((k) + 1)) xcd_barrier(bar); } while (0)
    if (IN(0)) phase_prologue(p, lds);
    SEAM(0);
    if (IN(1)) { pg8::EpiProj E{(bf16_t*)(ws + WS_PROJ)}; dense_gemm(lds, (const bf16_t*)(ws + WS_XN), (const bf16_t*)(ws + WS_WIN), NTOK, INCP, DM, E); }
    SEAM(1);
    if (IN(2)) phase_tok_a(p);
    SEAM(2);
    if (IN(3)) { pg8::EpiF32 Eq{(float*)(ws + WS_QPRE), 768}; dense_gemm(lds, (const bf16_t*)(ws + WS_CQN), (const bf16_t*)(ws + WS_WUQ), NTOK, 768, QLORA, Eq);
                 pg8::EpiF32 Ek{(float*)(ws + WS_KVPRE), 1024}; dense_gemm(lds, (const bf16_t*)(ws + WS_CKVN), (const bf16_t*)(ws + WS_WUKV), NTOK, 1024, KVLORA, Ek); }
    SEAM(3);
    if (IN(4)) phase_tok_b(p);
    SEAM(4);
    if (IN(5)) phase_attn(p, lds);
    SEAM(5);
    if (IN(6)) { pg8::EpiGateA E{(bf16_t*)(ws + WS_M1), (const bf16_t*)(ws + WS_PROJ)}; dense_gemm(lds, (const bf16_t*)(ws + WS_AO), (const bf16_t*)(ws + WS_WOMLA), NTOK, DM, 512, E); }
    if (IN(7)) { pg8::EpiGateB E{(const bf16_t*)(ws + WS_M1), (const bf16_t*)(ws + WS_PROJ), (bf16_t*)(ws + WS_MERGED)}; dense_gemm(lds, (const bf16_t*)(ws + WS_YBIN), (const bf16_t*)(ws + WS_WOCONV), NTOK, DM, 512, E); }
    SEAM(7);
    if (IN(8)) { pg8::EpiResid E{p.x, p.out}; dense_gemm(lds, (const bf16_t*)(ws + WS_MERGED), (const bf16_t*)(ws + WS_WO), NTOK, DM, DM, E); }
    SEAM(8);
    if (IN(9)) phase_router(p, lds);
    SEAM(9);
    if (IN(10)) phase_scatter(p, lds);
    SEAM(10);
    if (IN(11)) phase_moe1(p, lds);
    SEAM(11);
    if (IN(12)) phase_moe2(p, lds);
    SEAM(12);
    if (IN(13)) phase_combine(p);
#undef IN
#undef SEAM
}

extern "C" void kernel_launch(void* const* d_in, const int* in_sizes, int n_in, void* d_out, int out_size,
                              void* d_ws, size_t ws_size, hipStream_t stream) {
    static int grid_blocks = 0;
    if (!grid_blocks) {
        int dev = 0, cus = 0, per_cu = 0;
        (void)hipGetDevice(&dev);
        (void)hipDeviceGetAttribute(&cus, hipDeviceAttributeMultiprocessorCount, dev);
        (void)hipFuncSetAttribute((const void*)mk_fwd, hipFuncAttributeMaxDynamicSharedMemorySize, LDS_BYTES);
        (void)hipOccupancyMaxActiveBlocksPerMultiprocessor(&per_cu, (const void*)mk_fwd, NTHREADS, LDS_BYTES);
        if (per_cu < 1) { fprintf(stderr, "kernel_launch: occupancy query says %d blocks/CU\n", per_cu); per_cu = 1; }
        grid_blocks = cus;
        if (ws_size < WS_END || n_in != 21) fprintf(stderr, "kernel_launch: ws %zu < %zu or n_in %d != 21\n", ws_size, (size_t)WS_END, n_in);
    }
    (void)hipMemsetAsync((char*)d_ws + WS_CTL, 0, 1 * MiB, stream);
    Params p{};
    p.x = (const float*)d_in[0]; p.pos = (const int*)d_in[1]; p.norm1_g = (const float*)d_in[2]; p.w_in = (const float*)d_in[3]; p.q_a_g = (const float*)d_in[4];
    p.kv_a_g = (const float*)d_in[5]; p.w_uq = (const float*)d_in[6]; p.w_ukv = (const float*)d_in[7]; p.q_g = (const float*)d_in[8]; p.k_g = (const float*)d_in[9];
    p.conv_w = (const float*)d_in[10]; p.w_o_mla = (const float*)d_in[11]; p.w_o_conv = (const float*)d_in[12]; p.w_o = (const float*)d_in[13]; p.norm2_g = (const float*)d_in[14];
    p.router_w = (const float*)d_in[15]; p.router_b = (const float*)d_in[16]; p.w1 = (const float*)d_in[17]; p.b1 = (const float*)d_in[18]; p.w2 = (const float*)d_in[19]; p.b2 = (const float*)d_in[20];
    p.out = (float*)d_out; p.ws = (unsigned char*)d_ws; p.ph_lo = 0; p.ph_hi = NPHASE + 1;
    void* args[] = {&p};
    hipError_t e = hipLaunchCooperativeKernel((const void*)mk_fwd, dim3(grid_blocks), dim3(NTHREADS), args, LDS_BYTES, stream);
    if (e != hipSuccess) fprintf(stderr, "cooperative launch failed: %s (grid %d)\n", hipGetErrorString(e), grid_blocks);
}
```

```cpp
#include <hip/hip_runtime.h>
#include <hip/hip_cooperative_groups.h>
#include <cstdio>
#include <cstdint>
namespace cg = cooperative_groups;

typedef unsigned short bf16_t;
typedef short bf16x8 __attribute__((ext_vector_type(8)));
typedef short s16x4 __attribute__((ext_vector_type(4)));
typedef float f32x4 __attribute__((ext_vector_type(4)));
typedef float f32x2 __attribute__((ext_vector_type(2)));
typedef float f32x16 __attribute__((ext_vector_type(16)));
typedef unsigned u32x4 __attribute__((ext_vector_type(4)));
typedef unsigned u32x2 __attribute__((ext_vector_type(2)));
typedef __bf16 bf16x2_t __attribute__((ext_vector_type(2)));

constexpr int NTOK = 16384, DM = 1024, SEQ = 8192;
constexpr int INC = 4000, INCP = 4096;
constexpr int OFF_CQ = 0, OFF_CKV = 256, OFF_KR = 384, OFF_U = 416, OFF_C = 928, OFF_B = 1440, OFF_GA = 1952, OFF_GB = 2976;
constexpr int NH = 8, DQK = 96, DV = 64, NE = 32, TOPK = 4, DFF = 1024;
constexpr int QLORA = 256, KVLORA = 128, CONVW = 512;
constexpr int NPAIR = NTOK * TOPK;
constexpr int MAXROWS = 73728;
constexpr float EPS = 1e-6f;
constexpr int NTHREADS = 512, NWAVES = 8;
constexpr int LDS_BYTES = 147456;

constexpr size_t MiB = 1ull << 20;
constexpr size_t WS_CTL = 0;
constexpr size_t WS_WIN = 1 * MiB;
constexpr size_t WS_WUQ = 9 * MiB;
constexpr size_t WS_WUKV = WS_WUQ + 512 * 1024;
constexpr size_t WS_WOMLA = 10 * MiB;
constexpr size_t WS_WOCONV = 11 * MiB;
constexpr size_t WS_WO = 12 * MiB;
constexpr size_t WS_ROUTE = 14 * MiB;
constexpr size_t WS_W1 = 18 * MiB;
constexpr size_t WS_W2 = 146 * MiB;
constexpr size_t WS_XN = 210 * MiB;
constexpr size_t WS_PROJ = 242 * MiB;
constexpr size_t WS_CQN = 370 * MiB;
constexpr size_t WS_CKVN = 378 * MiB;
constexpr size_t WS_YBIN = 386 * MiB;
constexpr size_t WS_QPRE = 402 * MiB;
constexpr size_t WS_KVPRE = 450 * MiB;
constexpr size_t WS_Q = 514 * MiB;
constexpr size_t WS_K = 538 * MiB;
constexpr size_t WS_V = 570 * MiB;
constexpr size_t WS_AO = 586 * MiB;
constexpr size_t WS_M1 = 602 * MiB;
constexpr size_t WS_MERGED = 666 * MiB;
constexpr size_t WS_YS = 698 * MiB;
constexpr size_t WS_END = 826 * MiB;
constexpr size_t WS_ACT = WS_PROJ;
constexpr size_t WS_XS = 402 * MiB;
constexpr size_t RT_PAIR_E = 0, RT_PAIR_RANK = 262144, RT_PAIR_W = 524288, RT_ROW_TOK = 786432, RT_ROW_W = 786432 + 294912, RT_ROW_SLOT = 786432 + 2 * 294912;
constexpr int CW_CNT = 64;
constexpr int CW_BAR = 4096;
constexpr int MISC_OFF = 131072 + 8192;

struct Params {
    const float* x; const int* pos; const float* norm1_g; const float* w_in; const float* q_a_g; const float* kv_a_g;
    const float* w_uq; const float* w_ukv; const float* q_g; const float* k_g; const float* conv_w; const float* w_o_mla;
    const float* w_o_conv; const float* w_o; const float* norm2_g; const float* router_w; const float* router_b;
    const float* w1; const float* b1; const float* w2; const float* b2;
    float* out; unsigned char* ws; int ph_lo, ph_hi;
};

__device__ __forceinline__ unsigned pk2(float lo, float hi) { f32x2 v = {lo, hi}; bf16x2_t b = __builtin_convertvector(v, bf16x2_t); return __builtin_bit_cast(unsigned, b); }
__device__ __forceinline__ float bf_lo(unsigned w) { return __uint_as_float(w << 16); }
__device__ __forceinline__ float bf_hi(unsigned w) { return __uint_as_float(w & 0xffff0000u); }
__device__ __forceinline__ float bf1(bf16_t h) { return __uint_as_float((unsigned)h << 16); }
__device__ __forceinline__ float wave_sum(float v) {
#pragma unroll
    for (int o = 1; o < 64; o <<= 1) v += __shfl_xor(v, o);
    return v;
}
__device__ __forceinline__ unsigned pk4_fp8(float a, float b, float c, float d) { unsigned w = 0u; w = (unsigned)__builtin_amdgcn_cvt_pk_fp8_f32(a, b, (int)w, false); w = (unsigned)__builtin_amdgcn_cvt_pk_fp8_f32(c, d, (int)w, true); return w; }
constexpr float W8_SCALE = 32.f, W8_INV = 1.f / 32.f;
__device__ __forceinline__ float sigmoidf_(float v) { return 1.f / (1.f + __expf(-v)); }

namespace pg8 {
#define PG8_LAS __attribute__((address_space(3)))
constexpr int BM = 256, BK = 64, HALF = 128, HTB = HALF * BK * 2  , STAGE_BYTES = 8 * HTB, NXCD = 8, WGM = 8;

__host__ __device__ __forceinline__ int lds_byte(int r, int c) { const int st = (r >> 4) * 2 + (c >> 5), rr = r & 15, cc = c & 31, ob = rr * 64 + cc * 2; return st * 1024 + (ob ^ (((ob >> 9) & 1) << 5)); }
__host__ __device__ __forceinline__ void stage_rc(int b, int& R, int& C) { const int st = b / 1024, sb = b % 1024, swz = sb ^ (((sb >> 9) & 1) << 5); R = (st >> 1) * 16 + swz / 64; C = (st & 1) * 32 + (swz % 64) / 2; }
__host__ __device__ __forceinline__ int perm32(int rho) { const int n = rho >> 4, i = rho & 15; return 8 * (i >> 2) + 4 * n + (i & 3); }

struct Unit { int pm, pn, e; };
struct Gemm { const bf16_t* A; const bf16_t* Bt; int M, N, K; size_t bstride; };

struct StaticOrder {
    int nM, nN, nwg, G, c;
    __host__ __device__ void init(int M, int N, int G_, int c_) { nM = M / BM; nN = N / BM; nwg = nM * nN; G = G_; c = c_; }
    __host__ __device__ bool next(int i, Unit& u) const {
        const long L = (long)i * G + c; if (L >= nwg) return false;
        int wgid = (int)L; { const int q = nwg / NXCD, r = nwg % NXCD, xcd = wgid % NXCD, off = wgid / NXCD; wgid = (xcd < r ? xcd * (q + 1) : r * (q + 1) + (xcd - r) * q) + off; }
        const int nig = WGM * nN, gid = wgid / nig, fm = gid * WGM, gsz = (nM - fm) < WGM ? (nM - fm) : WGM;
        u.pm = fm + ((wgid % nig) % gsz); u.pn = (wgid % nig) / gsz; u.e = 0; return true;
    }
    __device__ __forceinline__ void a_ready(const Unit&) const {}
    __device__ __forceinline__ void done(const Unit&) const {}
};


struct EpiProj {
    static constexpr bool PERM = true, AFTER_DRAIN = false;
    bf16_t* O;
    __device__ __forceinline__ void operator()(const f32x4 (&acc)[2][2][4][2], const Unit& u, int wr, int wc, int fr, int fq) const {
        const int row0 = u.pm * BM + wr * 64 + fr, col0 = u.pn * BM + wc * 32 + 8 * fq;
#pragma unroll
        for (int ai = 0; ai < 2; ++ai)
#pragma unroll
            for (int m = 0; m < 4; ++m) { bf16_t* rowp = O + (size_t)(row0 + ai * HALF + m * 16) * INCP + col0;
#pragma unroll
                for (int bj = 0; bj < 2; ++bj) { f32x4 v0 = acc[ai][bj][m][0], v1 = acc[ai][bj][m][1]; const int col = col0 + bj * HALF;
                    if (col >= OFF_GA && col < INC) {
#pragma unroll
                        for (int j = 0; j < 4; ++j) { v0[j] = sigmoidf_(v0[j]); v1[j] = sigmoidf_(v1[j]); } }
                    u32x4 w; w.x = pk2(v0[0], v0[1]); w.y = pk2(v0[2], v0[3]); w.z = pk2(v1[0], v1[1]); w.w = pk2(v1[2], v1[3]);
                    *(u32x4*)(rowp + bj * HALF) = w; } }
    }
};
struct EpiF32 {
    static constexpr bool PERM = false, AFTER_DRAIN = false;
    float* O; int ldc;
    __device__ __forceinline__ void operator()(const f32x4 (&acc)[2][2][4][2], const Unit& u, int wr, int wc, int fr, int fq) const {
        const int row0 = u.pm * BM + wr * 64 + fr, col0 = u.pn * BM + wc * 32 + 4 * fq;
#pragma unroll
        for (int ai = 0; ai < 2; ++ai)
#pragma unroll
            for (int m = 0; m < 4; ++m) { float* rowp = O + (size_t)(row0 + ai * HALF + m * 16) * ldc + col0;
#pragma unroll
                for (int bj = 0; bj < 2; ++bj)
#pragma unroll
                    for (int n = 0; n < 2; ++n) *(f32x4*)(rowp + bj * HALF + n * 16) = acc[ai][bj][m][n]; }
    }
};
__device__ __forceinline__ void unpack8(const u32x4 g, float (&f)[8]) { f[0] = bf_lo(g.x); f[1] = bf_hi(g.x); f[2] = bf_lo(g.y); f[3] = bf_hi(g.y); f[4] = bf_lo(g.z); f[5] = bf_hi(g.z); f[6] = bf_lo(g.w); f[7] = bf_hi(g.w); }
struct EpiGateA {
    static constexpr bool PERM = true, AFTER_DRAIN = false;
    bf16_t* M1; const bf16_t* proj;
    __device__ __forceinline__ void operator()(const f32x4 (&acc)[2][2][4][2], const Unit& u, int wr, int wc, int fr, int fq) const {
        const int row0 = u.pm * BM + wr * 64 + fr, col0 = u.pn * BM + wc * 32 + 8 * fq;
#pragma unroll
        for (int ai = 0; ai < 2; ++ai)
#pragma unroll
            for (int m = 0; m < 4; ++m) { const size_t row = (size_t)(row0 + ai * HALF + m * 16);
#pragma unroll
                for (int bj = 0; bj < 2; ++bj) { const int col = col0 + bj * HALF; float g[8]; unpack8(*(const u32x4*)(proj + row * INCP + OFF_GA + col), g);
                    const f32x4 v0 = acc[ai][bj][m][0], v1 = acc[ai][bj][m][1];
                    u32x4 w; w.x = pk2(v0[0] * g[0], v0[1] * g[1]); w.y = pk2(v0[2] * g[2], v0[3] * g[3]); w.z = pk2(v1[0] * g[4], v1[1] * g[5]); w.w = pk2(v1[2] * g[6], v1[3] * g[7]);
                    *(u32x4*)(M1 + row * DM + col) = w; } }
    }
};
struct EpiGateB {
    static constexpr bool PERM = true, AFTER_DRAIN = false;
    const bf16_t* M1; const bf16_t* proj; bf16_t* O;
    __device__ __forceinline__ void operator()(const f32x4 (&acc)[2][2][4][2], const Unit& u, int wr, int wc, int fr, int fq) const {
        const int row0 = u.pm * BM + wr * 64 + fr, col0 = u.pn * BM + wc * 32 + 8 * fq;
#pragma unroll
        for (int ai = 0; ai < 2; ++ai)
#pragma unroll
            for (int m = 0; m < 4; ++m) { const size_t row = (size_t)(row0 + ai * HALF + m * 16);
#pragma unroll
                for (int bj = 0; bj < 2; ++bj) { const int col = col0 + bj * HALF; float g[8], b[8]; unpack8(*(const u32x4*)(proj + row * INCP + OFF_GB + col), g); unpack8(*(const u32x4*)(M1 + row * DM + col), b);
                    const f32x4 v0 = acc[ai][bj][m][0], v1 = acc[ai][bj][m][1];
                    u32x4 w; w.x = pk2(b[0] + v0[0] * g[0], b[1] + v0[1] * g[1]); w.y = pk2(b[2] + v0[2] * g[2], b[3] + v0[3] * g[3]);
                    w.z = pk2(b[4] + v1[0] * g[4], b[5] + v1[1] * g[5]); w.w = pk2(b[6] + v1[2] * g[6], b[7] + v1[3] * g[7]);
                    *(u32x4*)(O + row * DM + col) = w; } }
    }
};
struct EpiResid {
    static constexpr bool PERM = false, AFTER_DRAIN = false;
    const float* X; float* O;
    __device__ __forceinline__ void operator()(const f32x4 (&acc)[2][2][4][2], const Unit& u, int wr, int wc, int fr, int fq) const {
        const int row0 = u.pm * BM + wr * 64 + fr, col0 = u.pn * BM + wc * 32 + 4 * fq;
#pragma unroll
        for (int ai = 0; ai < 2; ++ai)
#pragma unroll
            for (int m = 0; m < 4; ++m) { const size_t off = (size_t)(row0 + ai * HALF + m * 16) * DM + col0;
#pragma unroll
                for (int bj = 0; bj < 2; ++bj)
#pragma unroll
                    for (int n = 0; n < 2; ++n) { const f32x4 b = *(const f32x4*)(X + off + bj * HALF + n * 16); *(f32x4*)(O + off + bj * HALF + n * 16) = b + acc[ai][bj][m][n]; } }
    }
};
struct EpiSwiglu {
    static constexpr bool PERM = true, AFTER_DRAIN = false;
    unsigned char* ACT; const float* b1;
    __device__ __forceinline__ void operator()(const f32x4 (&acc)[2][2][4][2], const Unit& u, int wr, int wc, int fr, int fq) const {
        const int row0 = u.pm * BM + wr * 64 + fr, f0 = u.pn * HALF + wc * 32 + 8 * fq; const float* be = b1 + (size_t)u.e * 2048;
        const f32x4 bg0 = *(const f32x4*)(be + f0), bg1 = *(const f32x4*)(be + f0 + 4), bu0 = *(const f32x4*)(be + DFF + f0), bu1 = *(const f32x4*)(be + DFF + f0 + 4);
#pragma unroll
        for (int ai = 0; ai < 2; ++ai)
#pragma unroll
            for (int m = 0; m < 4; ++m) { const size_t row = (size_t)(row0 + ai * HALF + m * 16); float o[8];
#pragma unroll
                for (int n = 0; n < 2; ++n) { const f32x4 g4 = acc[ai][0][m][n] * W8_INV + (n ? bg1 : bg0), u4 = acc[ai][1][m][n] * W8_INV + (n ? bu1 : bu0);
#pragma unroll
                    for (int j = 0; j < 4; ++j) { const float g = fminf(g4[j], 7.f), uu = fminf(fmaxf(u4[j], -7.f), 7.f); o[4 * n + j] = (uu + 1.f) * (g * sigmoidf_(1.702f * g)); } }
                u32x2 w; w.x = pk4_fp8(o[0], o[1], o[2], o[3]); w.y = pk4_fp8(o[4], o[5], o[6], o[7]); *(u32x2*)(ACT + row * DFF + f0) = w; }
    }
};
struct EpiMoeOut {
    static constexpr bool PERM = true, AFTER_DRAIN = false;
    bf16_t* YS; const float* b2; const float* row_w; const int* row_slot;
    __device__ __forceinline__ void operator()(const f32x4 (&acc)[2][2][4][2], const Unit& u, int wr, int wc, int fr, int fq) const {
        const int row0 = u.pm * BM + wr * 64 + fr, col0 = u.pn * BM + wc * 32 + 8 * fq; const float* be = b2 + (size_t)u.e * DM;
        f32x4 bv[2][2];
#pragma unroll
        for (int bj = 0; bj < 2; ++bj)
#pragma unroll
            for (int n = 0; n < 2; ++n) bv[bj][n] = *(const f32x4*)(be + col0 + bj * HALF + 4 * n);
#pragma unroll
        for (int ai = 0; ai < 2; ++ai)
#pragma unroll
            for (int m = 0; m < 4; ++m) { const int row = row0 + ai * HALF + m * 16; const int slot = row_slot[row]; const float w = row_w[row];
                if (slot >= 0) { bf16_t* rowp = YS + (size_t)slot * DM + col0;
#pragma unroll
                    for (int bj = 0; bj < 2; ++bj) { const f32x4 v0 = (acc[ai][bj][m][0] * W8_INV + bv[bj][0]) * w, v1 = (acc[ai][bj][m][1] * W8_INV + bv[bj][1]) * w;
                        u32x4 o; o.x = pk2(v0[0], v0[1]); o.y = pk2(v0[2], v0[3]); o.z = pk2(v1[0], v1[1]); o.w = pk2(v1[2], v1[3]); *(u32x4*)(rowp + bj * HALF) = o; } } }
    }
};
struct MoeOrder {
    StaticOrder so; unsigned elo, ehi;
    __device__ __forceinline__ bool next(int i, Unit& u) const { if (!so.next(i, u)) return false; u.e = (int)(((i < 6 ? elo >> (5 * i) : ehi >> (5 * (i - 6)))) & 31u); return true; }
    __device__ __forceinline__ void a_ready(const Unit&) const {}
    __device__ __forceinline__ void done(const Unit&) const {}
};
typedef int i32x4_t __attribute__((ext_vector_type(4))); typedef int i32x8_t __attribute__((ext_vector_type(8)));
__device__ __forceinline__ i32x8_t cat8(bf16x8 lo, bf16x8 hi) { return __builtin_shufflevector(__builtin_bit_cast(i32x4_t, lo), __builtin_bit_cast(i32x4_t, hi), 0, 1, 2, 3, 4, 5, 6, 7); }
__device__ __forceinline__ void mfma_fp8_inplace(f32x4& c, const i32x8_t a, const i32x8_t b) { asm volatile("s_nop 1\n\tv_mfma_f32_16x16x128_f8f6f4 %0, %1, %2, %0" : "+v"(c) : "v"(a), "v"(b)); }
__device__ __forceinline__ void mfma_fp8_drain() { asm volatile("s_nop 15\n\ts_nop 7" ::: "memory"); __builtin_amdgcn_sched_barrier(0); }
template <class Epi, class Sched, bool ALIGN_EPI = false, bool SP2 = false, bool FP8 = false>
__device__ __forceinline__ void gemm_phase(PG8_LAS unsigned char* lds, const Gemm g, const Sched& S, const Epi& E) {
    const int tid = threadIdx.x, wid = __builtin_amdgcn_readfirstlane(tid >> 6), lane = tid & 63, wr = wid >> 2, wc = wid & 3, fr = lane & 15, fq = lane >> 4;
    const int K = g.K, nt = K / BK;
    unsigned voffA[2], voffB[2];
#pragma unroll
    for (int i = 0; i < 2; ++i) { int R, C; stage_rc(tid * 16 + i * 8192, R, C); const int Rb = Epi::PERM ? ((R & ~31) + perm32(R & 31)) : R;
        voffA[i] = (unsigned)(R * K + C) * 2u; voffB[i] = (unsigned)(Rb * K + C) * 2u; }
    const unsigned kstep = (unsigned)(BK * 2);
    const unsigned hstep = (unsigned)HALF * (unsigned)K * 2u;
    const unsigned tstep = 2u * hstep;
    const unsigned ldsw = (unsigned)wid * 1024u;
    const int aoff = lds_byte(wr * 64 + fr, fq * 8), boff = lds_byte(wc * 32 + fr, fq * 8);
#define PG8_SA(b, h) (((b) * 2 + (h)) * HTB)
#define PG8_SB(b, h) ((4 + (b) * 2 + (h)) * HTB)
#define PG8_STAGE(rs, bufoff, goff, voff) do { _Pragma("unroll") for (int _i = 0; _i < 2; ++_i) \
        __builtin_amdgcn_raw_ptr_buffer_load_lds(rs, (PG8_LAS void*)(lds + (bufoff) + ldsw + _i * 8192), 16, (int)(voff)[_i], (int)(goff), 0, 0); } while (0)
#define PG8_LDA(dst, b, h) do { _Pragma("unroll") for (int m = 0; m < 4; ++m) _Pragma("unroll") for (int k = 0; k < 2; ++k) dst[m][k] = *(const PG8_LAS bf16x8*)(lds + PG8_SA(b, h) + aoff + m * 2048 + k * 1024); } while (0)
#define PG8_LDB(dst, b, h) do { _Pragma("unroll") for (int n = 0; n < 2; ++n) _Pragma("unroll") for (int k = 0; k < 2; ++k) dst[n][k] = *(const PG8_LAS bf16x8*)(lds + PG8_SB(b, h) + boff + n * 2048 + k * 1024); } while (0)
#define PG8_MMA(ai, bj, At, Bt) do { __builtin_amdgcn_s_setprio(1); _Pragma("unroll") for (int m = 0; m < 4; ++m) _Pragma("unroll") for (int n = 0; n < 2; ++n) { \
        if constexpr (FP8) { mfma_fp8_inplace(acc[ai][bj][m][n], cat8(Bt[n][0], Bt[n][1]), cat8(At[m][0], At[m][1])); } \
        else { _Pragma("unroll") for (int k = 0; k < 2; ++k) acc[ai][bj][m][n] = __builtin_amdgcn_mfma_f32_16x16x32_bf16(Bt[n][k], At[m][k], acc[ai][bj][m][n], 0, 0, 0); } } \
        __builtin_amdgcn_s_setprio(0); } while (0)
#define PG8_WAIT_V(n) asm volatile("s_waitcnt vmcnt(" #n ")" ::: "memory")
#define PG8_WAIT_L(n) asm volatile("s_waitcnt lgkmcnt(" #n ")" ::: "memory")
#define PG8_BAR __builtin_amdgcn_s_barrier()
#define PG8_SCHED __builtin_amdgcn_sched_barrier(0)
    Unit cur, nxt; int ui = 0;
    if (!S.next(0, cur)) return;
    f32x4 acc[2][2][4][2];
#pragma unroll
    for (int a = 0; a < 2; ++a)
#pragma unroll
        for (int b = 0; b < 2; ++b)
#pragma unroll
            for (int m = 0; m < 4; ++m)
#pragma unroll
                for (int n = 0; n < 2; ++n) acc[a][b][m][n] = (f32x4){0.f, 0.f, 0.f, 0.f};
    bf16x8 At[4][2], B0[2][2], B1[2][2];
    unsigned cA = (unsigned)cur.pm * tstep, cB = (unsigned)cur.e * (unsigned)g.bstride + (unsigned)cur.pn * tstep;
    const __amdgpu_buffer_rsrc_t rsA = __builtin_amdgcn_make_buffer_rsrc((void*)g.A, 0, 0x7fffffff, 0x00020000), rsB = __builtin_amdgcn_make_buffer_rsrc((void*)g.Bt, 0, 0x7fffffff, 0x00020000);
    S.a_ready(cur);
    if constexpr (SP2) {
        PG8_STAGE(rsB, PG8_SB(0, 0), cB, voffB); PG8_STAGE(rsB, PG8_SB(0, 1), cB + hstep, voffB); PG8_STAGE(rsA, PG8_SA(0, 0), cA, voffA); PG8_STAGE(rsA, PG8_SA(0, 1), cA + hstep, voffA);
        if (wr == 1) PG8_BAR;
        PG8_WAIT_V(2); PG8_BAR;
        PG8_STAGE(rsB, PG8_SB(1, 0), cB + kstep, voffB); PG8_STAGE(rsA, PG8_SA(1, 0), cA + kstep, voffA); PG8_STAGE(rsB, PG8_SB(1, 1), cB + hstep + kstep, voffB);
        PG8_WAIT_V(6); PG8_BAR;
    } else {
        PG8_STAGE(rsB, PG8_SB(0, 0), cB, voffB); PG8_STAGE(rsA, PG8_SA(0, 0), cA, voffA); PG8_STAGE(rsB, PG8_SB(0, 1), cB + hstep, voffB); PG8_STAGE(rsA, PG8_SA(0, 1), cA + hstep, voffA);
        if (wr == 1) PG8_BAR;
        PG8_WAIT_V(4); PG8_BAR;
        PG8_STAGE(rsB, PG8_SB(1, 0), cB + kstep, voffB); PG8_STAGE(rsA, PG8_SA(1, 0), cA + kstep, voffA); PG8_STAGE(rsB, PG8_SB(1, 1), cB + hstep + kstep, voffB);
        PG8_WAIT_V(6); PG8_BAR;
    }
    for (;;) {
        const bool has_next = S.next(ui + 1, nxt);
        const unsigned nA = has_next ? (unsigned)nxt.pm * tstep : cA, nB = has_next ? (unsigned)nxt.e * (unsigned)g.bstride + (unsigned)nxt.pn * tstep : cB;
        for (int t = 0; t < nt; t += 2) {
            const bool last = (t == nt - 2);
            const unsigned a1 = cA + (unsigned)(t + 1) * kstep;
            const unsigned a2 = last ? nA : cA + (unsigned)(t + 2) * kstep, b2 = last ? nB : cB + (unsigned)(t + 2) * kstep;
            const unsigned a3 = a2 + kstep, b3 = b2 + kstep;
            if (last && has_next) S.a_ready(nxt);
            if constexpr (SP2) {
            PG8_LDB(B0, 0, 0); PG8_LDB(B1, 0, 1); PG8_SCHED; PG8_LDA(At, 0, 0); PG8_STAGE(rsA, PG8_SA(1, 1), a1 + hstep, voffA);
            PG8_WAIT_V(8); PG8_WAIT_L(0); PG8_BAR; PG8_MMA(0, 0, At, B0); PG8_MMA(0, 1, At, B1); PG8_BAR; PG8_SCHED;
            PG8_LDA(At, 0, 1); PG8_STAGE(rsB, PG8_SB(0, 0), b2, voffB); PG8_STAGE(rsB, PG8_SB(0, 1), b2 + hstep, voffB); PG8_STAGE(rsA, PG8_SA(0, 0), a2, voffA);
            PG8_WAIT_V(8); PG8_WAIT_L(0); PG8_BAR; PG8_MMA(1, 0, At, B0); PG8_MMA(1, 1, At, B1); PG8_BAR; PG8_SCHED;
            PG8_LDB(B0, 1, 0); PG8_LDB(B1, 1, 1); PG8_SCHED; PG8_LDA(At, 1, 0); PG8_STAGE(rsA, PG8_SA(0, 1), a2 + hstep, voffA);
            PG8_WAIT_V(8); PG8_WAIT_L(0); PG8_BAR; PG8_MMA(0, 0, At, B0); PG8_MMA(0, 1, At, B1); PG8_BAR; PG8_SCHED;
            PG8_LDA(At, 1, 1); PG8_STAGE(rsB, PG8_SB(1, 0), b3, voffB); PG8_STAGE(rsB, PG8_SB(1, 1), b3 + hstep, voffB); PG8_STAGE(rsA, PG8_SA(1, 0), a3, voffA);
            PG8_WAIT_V(8); PG8_WAIT_L(0); PG8_BAR; PG8_MMA(1, 0, At, B0); PG8_MMA(1, 1, At, B1); PG8_BAR; PG8_SCHED;
            } else {
            PG8_LDB(B0, 0, 0); PG8_SCHED; PG8_LDA(At, 0, 0); PG8_STAGE(rsA, PG8_SA(1, 1), a1 + hstep, voffA);
            PG8_WAIT_L(8); PG8_BAR; PG8_WAIT_L(0); PG8_MMA(0, 0, At, B0); PG8_BAR; PG8_SCHED;
            PG8_LDB(B1, 0, 1); PG8_STAGE(rsB, PG8_SB(0, 0), b2, voffB);
            PG8_BAR; PG8_WAIT_L(0); PG8_MMA(0, 1, At, B1); PG8_BAR;
            PG8_LDA(At, 0, 1); PG8_STAGE(rsA, PG8_SA(0, 0), a2, voffA);
            PG8_BAR; PG8_WAIT_L(0); PG8_MMA(1, 0, At, B0); PG8_BAR; PG8_SCHED;
            PG8_STAGE(rsB, PG8_SB(0, 1), b2 + hstep, voffB);
            PG8_WAIT_V(6); PG8_BAR; PG8_MMA(1, 1, At, B1); PG8_BAR;
            PG8_LDB(B0, 1, 0); PG8_SCHED; PG8_LDA(At, 1, 0); PG8_STAGE(rsA, PG8_SA(0, 1), a2 + hstep, voffA);
            PG8_WAIT_L(8); PG8_BAR; PG8_WAIT_L(0); PG8_MMA(0, 0, At, B0); PG8_BAR; PG8_SCHED;
            PG8_LDB(B1, 1, 1); PG8_STAGE(rsB, PG8_SB(1, 0), b3, voffB);
            PG8_BAR; PG8_WAIT_L(0); PG8_MMA(0, 1, At, B1); PG8_BAR;
            PG8_LDA(At, 1, 1); PG8_STAGE(rsA, PG8_SA(1, 0), a3, voffA);
            PG8_BAR; PG8_WAIT_L(0); PG8_MMA(1, 0, At, B0); PG8_BAR; PG8_SCHED;
            PG8_STAGE(rsB, PG8_SB(1, 1), b3 + hstep, voffB);
            PG8_WAIT_V(6); PG8_BAR; PG8_MMA(1, 1, At, B1); PG8_BAR;
            }
        }
        if constexpr (ALIGN_EPI) { if (wr == 0) PG8_BAR; }
        if constexpr (FP8) mfma_fp8_drain();
        if constexpr (!Epi::AFTER_DRAIN) { E(acc, cur, wr, wc, fr, fq); S.done(cur); }
        if (!has_next) break;
#pragma unroll
        for (int a = 0; a < 2; ++a)
#pragma unroll
            for (int b = 0; b < 2; ++b)
#pragma unroll
                for (int m = 0; m < 4; ++m)
#pragma unroll
                    for (int n = 0; n < 2; ++n) acc[a][b][m][n] = (f32x4){0.f, 0.f, 0.f, 0.f};
        cur = nxt; cA = nA; cB = nB; ++ui;
        if constexpr (ALIGN_EPI) { if (wr == 1) PG8_BAR; }
    }
    PG8_WAIT_V(0);
    if constexpr (!ALIGN_EPI) { if (wr == 0) PG8_BAR; }
    PG8_BAR;
    if constexpr (Epi::AFTER_DRAIN) { E.fused(acc, cur, wr, wc, fr, fq, lds, wid, lane); S.done(cur); }
#undef PG8_SA
#undef PG8_SB
#undef PG8_STAGE
#undef PG8_LDA
#undef PG8_LDB
#undef PG8_MMA
#undef PG8_WAIT_V
#undef PG8_WAIT_L
#undef PG8_BAR
#undef PG8_SCHED
}
}

#define GAS __attribute__((address_space(1)))
#define LAS __attribute__((address_space(3)))
#define XB_TMO      128
#define XB_XCNT(j)  (256  + 64 * (j))
#define XB_XSUB(j)  (1280 + 64 * (j))
#define XB_XGEN(j)  (2304 + 64 * (j))
#define XB_TOP      3328
#define XB_TOPGEN   3392
#define XCD_BAR_WORDS 3456
#define XB_SPIN_CAP (1u << 18)

__device__ __forceinline__ unsigned xb_ld(unsigned* p)              { return __hip_atomic_load(p, __ATOMIC_RELAXED, __HIP_MEMORY_SCOPE_AGENT); }
__device__ __forceinline__ unsigned xb_add(unsigned* p, unsigned v) { return __hip_atomic_fetch_add(p, v, __ATOMIC_RELAXED, __HIP_MEMORY_SCOPE_AGENT); }
__device__ __forceinline__ unsigned xb_xcc_id() { return (unsigned)__builtin_amdgcn_s_getreg((3 << 11) | 20) & 0xFu; }
#define XB_SPIN(cond, bar) do { unsigned _sp = 0; while (cond) { __builtin_amdgcn_s_sleep(1); \
    if ((++_sp & 255u) == 0u) { if (xb_ld(&(bar)[XB_TMO])) break; if (_sp > XB_SPIN_CAP) { atomicAdd(&(bar)[XB_TMO], 1u); break; } } } } while (0)

struct XcdBarrier {
    unsigned* bar; unsigned x;
    volatile LAS unsigned* st;
};

__device__ __forceinline__ XcdBarrier xcd_barrier_post(unsigned* bar, volatile LAS unsigned* st) {
    XcdBarrier b; b.bar = bar; b.x = xb_xcc_id(); b.st = st;
    if (threadIdx.x == 0) (void)xb_add(&bar[XB_XCNT(b.x)], 1u);
    return b;
}
__device__ __forceinline__ void xcd_barrier_complete(unsigned* bar, unsigned x, unsigned& nloc, unsigned& nx) {
    const unsigned G = gridDim.x * gridDim.y * gridDim.z;
    unsigned sum, cnt, mine, sp = 0u;
    for (;;) {
        sum = 0u; cnt = 0u; mine = 0u;
#pragma unroll
        for (unsigned j = 0; j < 16; ++j) { const unsigned c = xb_ld(&bar[XB_XCNT(j)]); sum += c; cnt += (c > 0u) ? 1u : 0u; mine = (j == x) ? c : mine; }
        if (sum == G) break;
        __builtin_amdgcn_s_sleep(1);
        if ((++sp & 255u) == 0u) { if (xb_ld(&bar[XB_TMO])) break; if (sp > XB_SPIN_CAP) { atomicAdd(&bar[XB_TMO], 1u); break; } }
    }
    nloc = mine > 0u ? mine : 1u; nx = cnt > 0u ? cnt : 1u;
}

__device__ __forceinline__ void xcd_barrier(const XcdBarrier& b) {
    asm volatile("s_waitcnt vmcnt(0)" ::: "memory");
    __syncthreads();
    if (threadIdx.x == 0) {
        unsigned* bar = b.bar;
        __builtin_amdgcn_s_waitcnt(0);
        unsigned nloc = b.st[0], nx = b.st[1];
        if (nloc == 0u) { xcd_barrier_complete(bar, b.x, nloc, nx); b.st[0] = nloc; b.st[1] = nx; }
        const unsigned old = xb_add(&bar[XB_XSUB(b.x)], 1u);
        const unsigned gen = old / nloc;
        if (old + 1u == (gen + 1u) * nloc) {
            __builtin_amdgcn_fence(__ATOMIC_RELEASE, "agent");
            asm volatile("s_waitcnt vmcnt(0)" ::: "memory");
            const unsigned og = xb_add(&bar[XB_TOP], 1u);
            const unsigned tg = og / nx;
            if (og + 1u == (tg + 1u) * nx) xb_add(&bar[XB_TOPGEN], 1u);
            else XB_SPIN(xb_ld(&bar[XB_TOPGEN]) == tg, bar);
            __builtin_amdgcn_fence(__ATOMIC_ACQUIRE, "agent");
            xb_add(&bar[XB_XGEN(b.x)], 1u);
            asm volatile("s_waitcnt vmcnt(0)" ::: "memory");
        } else {
            XB_SPIN(xb_ld(&bar[XB_XGEN(b.x)]) == gen, bar);
            __builtin_amdgcn_fence(__ATOMIC_ACQUIRE, "agent");
            asm volatile("s_waitcnt vmcnt(0)" ::: "memory");
        }
    }
    __syncthreads();
}

template <int MODE  >
__device__ __forceinline__ void transpose_item(const float* __restrict__ W, int K, int N, bf16_t* __restrict__ WT, const float* __restrict__ gain, float* scr, int item, int lane) {
    const int nblk = N / 32, kb = item / nblk, nb = item % nblk, k0 = 64 * kb, n0 = 32 * nb;
#pragma unroll
    for (int i = 0; i < 8; ++i) { const int kk = 8 * i + (lane >> 3), n4 = (lane & 7) * 4; f32x4 v = *(const f32x4*)(W + (size_t)(k0 + kk) * N + n0 + n4);
        if (gain) { const float g = gain[k0 + kk]; v = v * g; }
        float* s = scr + kk * 33 + n4; s[0] = v[0]; s[1] = v[1]; s[2] = v[2]; s[3] = v[3]; }
    asm volatile("s_waitcnt lgkmcnt(0)" ::: "memory");
    const int c = lane & 7;
#pragma unroll
    for (int j = 0; j < 4; ++j) { const int n = (lane >> 3) + 8 * j; const float* s = scr + (8 * c) * 33 + n;
        u32x4 o; o.x = pk2(s[0 * 33], s[1 * 33]); o.y = pk2(s[2 * 33], s[3 * 33]); o.z = pk2(s[4 * 33], s[5 * 33]); o.w = pk2(s[6 * 33], s[7 * 33]);
        int row = n0 + n;
        if (MODE == 1) { const int f = row & 1023; row = ((f >> 7) << 8) + ((row >> 10) << 7) + (f & 127); }
        *(u32x4*)(WT + (size_t)row * K + k0 + 8 * c) = o; }
    asm volatile("s_waitcnt lgkmcnt(0)" ::: "memory");
}
template <int MODE>
__device__ __forceinline__ void transpose_item_fp8(const float* __restrict__ W, int K, int N, unsigned char* __restrict__ WT, float* scr, int item, int lane) {
    const int nblk = N / 32, kb = item / nblk, nb = item % nblk, k0 = 64 * kb, n0 = 32 * nb;
#pragma unroll
    for (int i = 0; i < 8; ++i) { const int kk = 8 * i + (lane >> 3), n4 = (lane & 7) * 4; const f32x4 v = *(const f32x4*)(W + (size_t)(k0 + kk) * N + n0 + n4) * W8_SCALE;
        float* s = scr + kk * 33 + n4; s[0] = v[0]; s[1] = v[1]; s[2] = v[2]; s[3] = v[3]; }
    asm volatile("s_waitcnt lgkmcnt(0)" ::: "memory");
    const int c = lane & 7;
#pragma unroll
    for (int j = 0; j < 4; ++j) { const int n = (lane >> 3) + 8 * j; const float* s = scr + (8 * c) * 33 + n;
        u32x2 o; o.x = pk4_fp8(s[0 * 33], s[1 * 33], s[2 * 33], s[3 * 33]); o.y = pk4_fp8(s[4 * 33], s[5 * 33], s[6 * 33], s[7 * 33]);
        int row = n0 + n;
        if (MODE == 1) { const int f = row & 1023; row = ((f >> 7) << 8) + ((row >> 10) << 7) + (f & 127); }
        *(u32x2*)(WT + (size_t)row * K + k0 + 8 * c) = o; }
    asm volatile("s_waitcnt lgkmcnt(0)" ::: "memory");
}
__device__ __forceinline__ void phase_prologue(const Params& p, unsigned char* lds) {
    const int tid = threadIdx.x, lane = tid & 63, wave = tid >> 6;
    float* scr = (float*)(lds + wave * 16384);
    const int gw = blockIdx.x * NWAVES + wave, NGW = gridDim.x * NWAVES;
    unsigned char* ws = p.ws;
    constexpr int I_WIN = (DM / 64) * (INC / 32), I_UQ = (QLORA / 64) * (768 / 32), I_UKV = (KVLORA / 64) * (1024 / 32), I_OM = (512 / 64) * (DM / 32), I_OC = I_OM, I_WO = (DM / 64) * (DM / 32);
    constexpr int I_W1 = (DM / 64) * (2048 / 32), I_W2 = (DFF / 64) * (DM / 32);
    constexpr int NSMALL = I_WIN + I_UQ + I_UKV + I_OM + I_OC + I_WO;
    constexpr int NITEMS = NSMALL + NE * (I_W1 + I_W2);
    for (int it = gw; it < NITEMS; it += NGW) {
        int r = it;
        if (r < I_WIN) { transpose_item<0>(p.w_in, DM, INC, (bf16_t*)(ws + WS_WIN), p.norm1_g, scr, r, lane); continue; } r -= I_WIN;
        if (r < I_UQ) { transpose_item<0>(p.w_uq, QLORA, 768, (bf16_t*)(ws + WS_WUQ), p.q_a_g, scr, r, lane); continue; } r -= I_UQ;
        if (r < I_UKV) { transpose_item<0>(p.w_ukv, KVLORA, 1024, (bf16_t*)(ws + WS_WUKV), p.kv_a_g, scr, r, lane); continue; } r -= I_UKV;
        if (r < I_OM) { transpose_item<0>(p.w_o_mla, 512, DM, (bf16_t*)(ws + WS_WOMLA), nullptr, scr, r, lane); continue; } r -= I_OM;
        if (r < I_OC) { transpose_item<0>(p.w_o_conv, 512, DM, (bf16_t*)(ws + WS_WOCONV), nullptr, scr, r, lane); continue; } r -= I_OC;
        if (r < I_WO) { transpose_item<0>(p.w_o, DM, DM, (bf16_t*)(ws + WS_WO), nullptr, scr, r, lane); continue; } r -= I_WO;
        const int e = r / (I_W1 + I_W2); r -= e * (I_W1 + I_W2);
        if (r < I_W1) transpose_item_fp8<1>(p.w1 + (size_t)e * DM * 2048, DM, 2048, ws + WS_W1 + (size_t)e * 2048 * DM, scr, r, lane);
        else transpose_item_fp8<0>(p.w2 + (size_t)e * DFF * DM, DFF, DM, ws + WS_W2 + (size_t)e * DM * DFF, scr, r - I_W1, lane);
    }
    { u32x4* z = (u32x4*)((bf16_t*)(ws + WS_WIN) + (size_t)INC * DM); const int nz = (INCP - INC) * DM * 2 / 16;
      for (int i = blockIdx.x * NTHREADS + tid; i < nz; i += gridDim.x * NTHREADS) z[i] = (u32x4){0u, 0u, 0u, 0u}; }
    { int* rt = (int*)(ws + WS_ROUTE + RT_ROW_TOK); float* rw = (float*)(ws + WS_ROUTE + RT_ROW_W); int* rs = (int*)(ws + WS_ROUTE + RT_ROW_SLOT);
      for (int i = blockIdx.x * NTHREADS + tid; i < MAXROWS; i += gridDim.x * NTHREADS) { rt[i] = 0; rw[i] = 0.f; rs[i] = -1; } }
    bf16_t* XN = (bf16_t*)(ws + WS_XN);
    for (int m = gw; m < NTOK; m += NGW) {
        const f32x4* xr = (const f32x4*)(p.x + (size_t)m * DM) + lane; f32x4 v[4]; float s = 0.f;
#pragma unroll
        for (int j = 0; j < 4; ++j) { v[j] = xr[64 * j]; s += (v[j][0] * v[j][0] + v[j][1] * v[j][1]) + (v[j][2] * v[j][2] + v[j][3] * v[j][3]); }
        const float rstd = rsqrtf(wave_sum(s) * (1.f / DM) + EPS);
        u32x2* o = (u32x2*)(XN + (size_t)m * DM) + lane;
#pragma unroll
        for (int j = 0; j < 4; ++j) { u32x2 w; w.x = pk2(v[j][0] * rstd, v[j][1] * rstd); w.y = pk2(v[j][2] * rstd, v[j][3] * rstd); o[64 * j] = w; }
    }
}

__device__ __forceinline__ void phase_tok_a(const Params& p) {
    const int tid = threadIdx.x, lane = tid & 63, wave = tid >> 6;
    const int gw = blockIdx.x * NWAVES + wave, NGW = gridDim.x * NWAVES;
    const bf16_t* PROJ = (const bf16_t*)(p.ws + WS_PROJ); bf16_t* CQN = (bf16_t*)(p.ws + WS_CQN); bf16_t* CKVN = (bf16_t*)(p.ws + WS_CKVN); bf16_t* YB = (bf16_t*)(p.ws + WS_YBIN);
    float cw0[8], cw1[8], cw2[8];
#pragma unroll
    for (int j = 0; j < 8; ++j) { cw0[j] = p.conv_w[8 * lane + j]; cw1[j] = p.conv_w[CONVW + 8 * lane + j]; cw2[j] = p.conv_w[2 * CONVW + 8 * lane + j]; }
    for (int t = gw; t < NTOK; t += NGW) {
        const bf16_t* pr = PROJ + (size_t)t * INCP;
        { const u32x2 w = *(const u32x2*)(pr + OFF_CQ + 4 * lane); const float a = bf_lo(w.x), b = bf_hi(w.x), c = bf_lo(w.y), d = bf_hi(w.y);
          const float rstd = rsqrtf(wave_sum(a * a + b * b + c * c + d * d) * (1.f / QLORA) + EPS);
          u32x2 o; o.x = pk2(a * rstd, b * rstd); o.y = pk2(c * rstd, d * rstd); *(u32x2*)(CQN + (size_t)t * QLORA + 4 * lane) = o; }
        { const unsigned w = *(const unsigned*)(pr + OFF_CKV + 2 * lane); const float a = bf_lo(w), b = bf_hi(w);
          const float rstd = rsqrtf(wave_sum(a * a + b * b) * (1.f / KVLORA) + EPS);
          *(unsigned*)(CKVN + (size_t)t * KVLORA + 2 * lane) = pk2(a * rstd, b * rstd); }
        { const int s = t & (SEQ - 1); float cu[3][8];
#pragma unroll
          for (int d = 0; d < 3; ++d) { const int ss = s + d - 1; if (ss >= 0 && ss < SEQ) { const bf16_t* q = pr + (ptrdiff_t)(d - 1) * INCP; const u32x4 u = *(const u32x4*)(q + OFF_U + 8 * lane), c = *(const u32x4*)(q + OFF_C + 8 * lane);
                  cu[d][0] = bf_lo(u.x) * bf_lo(c.x); cu[d][1] = bf_hi(u.x) * bf_hi(c.x); cu[d][2] = bf_lo(u.y) * bf_lo(c.y); cu[d][3] = bf_hi(u.y) * bf_hi(c.y);
                  cu[d][4] = bf_lo(u.z) * bf_lo(c.z); cu[d][5] = bf_hi(u.z) * bf_hi(c.z); cu[d][6] = bf_lo(u.w) * bf_lo(c.w); cu[d][7] = bf_hi(u.w) * bf_hi(c.w); }
              else {
#pragma unroll
                  for (int j = 0; j < 8; ++j) cu[d][j] = 0.f; } }
          const u32x4 bg = *(const u32x4*)(pr + OFF_B + 8 * lane); float bb[8] = {bf_lo(bg.x), bf_hi(bg.x), bf_lo(bg.y), bf_hi(bg.y), bf_lo(bg.z), bf_hi(bg.z), bf_lo(bg.w), bf_hi(bg.w)}; float y[8];
#pragma unroll
          for (int j = 0; j < 8; ++j) y[j] = bb[j] * (cw0[j] * cu[0][j] + cw1[j] * cu[1][j] + cw2[j] * cu[2][j]);
          u32x4 o; o.x = pk2(y[0], y[1]); o.y = pk2(y[2], y[3]); o.z = pk2(y[4], y[5]); o.w = pk2(y[6], y[7]); *(u32x4*)(YB + (size_t)t * CONVW + 8 * lane) = o; }
    }
}

__device__ __forceinline__ void phase_tok_b(const Params& p) {
    const int tid = threadIdx.x, lane = tid & 63, wave = tid >> 6, h = lane >> 3, sub = lane & 7;
    const int gw = blockIdx.x * NWAVES + wave, NGW = gridDim.x * NWAVES;
    const float* QPRE = (const float*)(p.ws + WS_QPRE); const float* KVPRE = (const float*)(p.ws + WS_KVPRE); const bf16_t* PROJ = (const bf16_t*)(p.ws + WS_PROJ);
    bf16_t* Q = (bf16_t*)(p.ws + WS_Q); bf16_t* Kb = (bf16_t*)(p.ws + WS_K); bf16_t* V = (bf16_t*)(p.ws + WS_V);
    float qg[12], kg[12];
#pragma unroll
    for (int j = 0; j < 8; ++j) { qg[j] = p.q_g[sub * 8 + j]; kg[j] = p.k_g[sub * 8 + j]; }
    qg[8] = p.q_g[64 + 2 * sub]; qg[9] = p.q_g[65 + 2 * sub]; qg[10] = p.q_g[80 + 2 * sub]; qg[11] = p.q_g[81 + 2 * sub];
    kg[8] = p.k_g[64 + 2 * sub]; kg[9] = p.k_g[65 + 2 * sub]; kg[10] = p.k_g[80 + 2 * sub]; kg[11] = p.k_g[81 + 2 * sub];
    const float if0 = exp2f(-(float)(2 * sub) * (13.287712379549449f / 16.f)), if1 = exp2f(-(float)(2 * sub + 1) * (13.287712379549449f / 16.f));
    for (int t = gw; t < NTOK; t += NGW) {
        const int b = t >> 13, s = t & (SEQ - 1); const float pos = (float)p.pos[t];
        float c0, s0, c1, s1; sincosf(pos * if0, &s0, &c0); sincosf(pos * if1, &s1, &c1);
        const size_t rowi = ((size_t)(b * NH + h) * SEQ + s);
        { const float* qp = QPRE + (size_t)t * 768 + h * DQK; const f32x4 a = *(const f32x4*)(qp + sub * 8), bq = *(const f32x4*)(qp + sub * 8 + 4); const f32x2 r1 = *(const f32x2*)(qp + 64 + 2 * sub), r2 = *(const f32x2*)(qp + 80 + 2 * sub);
          float v[12] = {a[0], a[1], a[2], a[3], bq[0], bq[1], bq[2], bq[3], r1[0], r1[1], r2[0], r2[1]}; float ss = 0.f;
#pragma unroll
          for (int j = 0; j < 12; ++j) ss += v[j] * v[j];
          ss += __shfl_xor(ss, 1); ss += __shfl_xor(ss, 2); ss += __shfl_xor(ss, 4);
          const float rstd = rsqrtf(ss * (1.f / DQK) + EPS);
#pragma unroll
          for (int j = 0; j < 12; ++j) v[j] *= rstd * qg[j];
          const float o8 = v[8] * c0 - v[10] * s0, o9 = v[9] * c1 - v[11] * s1, o10 = v[8] * s0 + v[10] * c0, o11 = v[9] * s1 + v[11] * c1;
          bf16_t* qo = Q + rowi * DQK; u32x4 w; w.x = pk2(v[0], v[1]); w.y = pk2(v[2], v[3]); w.z = pk2(v[4], v[5]); w.w = pk2(v[6], v[7]);
          *(u32x4*)(qo + sub * 8) = w; *(unsigned*)(qo + 64 + 2 * sub) = pk2(o8, o9); *(unsigned*)(qo + 80 + 2 * sub) = pk2(o10, o11); }
        { const float* kp = KVPRE + (size_t)t * 1024 + h * 128; const f32x4 a = *(const f32x4*)(kp + sub * 8), bq = *(const f32x4*)(kp + sub * 8 + 4);
          const bf16_t* kr = PROJ + (size_t)t * INCP + OFF_KR; const unsigned w1 = *(const unsigned*)(kr + 2 * sub), w2 = *(const unsigned*)(kr + 16 + 2 * sub);
          float v[12] = {a[0], a[1], a[2], a[3], bq[0], bq[1], bq[2], bq[3], bf_lo(w1), bf_hi(w1), bf_lo(w2), bf_hi(w2)}; float ss = 0.f;
#pragma unroll
          for (int j = 0; j < 12; ++j) ss += v[j] * v[j];
          ss += __shfl_xor(ss, 1); ss += __shfl_xor(ss, 2); ss += __shfl_xor(ss, 4);
          const float rstd = rsqrtf(ss * (1.f / DQK) + EPS);
#pragma unroll
          for (int j = 0; j < 12; ++j) v[j] *= rstd * kg[j];
          const float o8 = v[8] * c0 - v[10] * s0, o9 = v[9] * c1 - v[11] * s1, o10 = v[8] * s0 + v[10] * c0, o11 = v[9] * s1 + v[11] * c1;
          bf16_t* ko = Kb + rowi * 128; u32x4 w; w.x = pk2(v[0], v[1]); w.y = pk2(v[2], v[3]); w.z = pk2(v[4], v[5]); w.w = pk2(v[6], v[7]);
          *(u32x4*)(ko + sub * 8) = w; *(unsigned*)(ko + 64 + 2 * sub) = pk2(o8, o9); *(unsigned*)(ko + 80 + 2 * sub) = pk2(o10, o11);
          if (sub < 4) *(u32x4*)(ko + 96 + sub * 8) = (u32x4){0u, 0u, 0u, 0u};
          const f32x4 va = *(const f32x4*)(kp + 64 + sub * 8), vb = *(const f32x4*)(kp + 64 + sub * 8 + 4);
          u32x4 wv; wv.x = pk2(va[0], va[1]); wv.y = pk2(va[2], va[3]); wv.z = pk2(vb[0], vb[1]); wv.w = pk2(vb[2], vb[3]); *(u32x4*)(V + rowi * DV + sub * 8) = wv; }
    }
}

namespace att {
constexpr int NW = 8, QBLK = 32, KVBLK = 64;
constexpr float SCALE = 0.10206207261596575f;
constexpr float THR = 8.f;
constexpr int LDQ = DQK, LDK = 128, LDV = DV;
constexpr int SHM_V = KVBLK * DV * 2, SHM_K = KVBLK * 256, SHM_ATTN = 2 * SHM_V + 2 * SHM_K + NW * 64 * 4;
#define KSWZ(row, colB) ((row) * 256 + ((colB) ^ (((row) & 7) << 4)))
#define SBAR() __builtin_amdgcn_sched_barrier(0)
__device__ __forceinline__ int crow(int r, int hi) { return (r & 3) + 8 * (r >> 2) + 4 * hi; }
__device__ __forceinline__ unsigned cvtpk(float lo, float hi) { unsigned r; asm volatile("v_cvt_pk_bf16_f32 %0, %1, %2" : "=v"(r) : "v"(lo), "v"(hi)); return r; }
__device__ __forceinline__ void partialSM(f32x16& p0, f32x16& p1, float& m_reg, float& mn, float& alpha) {
    constexpr float C = SCALE * 1.4426950408889634f;
    float pmax = p0[0];
#pragma unroll
    for (int r = 1; r < 16; ++r) pmax = fmaxf(pmax, p0[r]);
#pragma unroll
    for (int r = 0; r < 16; ++r) pmax = fmaxf(pmax, p1[r]);
    { auto rr = __builtin_amdgcn_permlane32_swap(__float_as_uint(pmax), __float_as_uint(pmax), false, false); pmax = fmaxf(__uint_as_float(rr[0]), __uint_as_float(rr[1])); }
    if (__builtin_expect(__all(pmax - m_reg <= THR / SCALE), 1)) { mn = m_reg; alpha = 1.f; }
    else { mn = fmaxf(m_reg, pmax); alpha = __builtin_amdgcn_exp2f((m_reg - mn) * C); m_reg = mn; }
    const float mnC = -mn * C;
#pragma unroll
    for (int r = 0; r < 16; ++r) p0[r] = fmaf(p0[r], C, mnC);
#pragma unroll
    for (int r = 0; r < 16; ++r) p1[r] = fmaf(p1[r], C, mnC);
#pragma unroll
    for (int r = 0; r < 16; ++r) p0[r] = __builtin_amdgcn_exp2f(p0[r]);
}
__device__ __forceinline__ void finishSM(f32x16& p0, f32x16& p1, float alpha, float& l_reg, bf16x8& pa0, bf16x8& pa1, bf16x8& pa2, bf16x8& pa3) {
#pragma unroll
    for (int r = 0; r < 16; ++r) p1[r] = __builtin_amdgcn_exp2f(p1[r]);
    float ps = 0;
#pragma unroll
    for (int r = 0; r < 16; ++r) ps += p0[r];
#pragma unroll
    for (int r = 0; r < 16; ++r) ps += p1[r];
    { auto rr = __builtin_amdgcn_permlane32_swap(__float_as_uint(ps), __float_as_uint(ps), false, false); ps = __uint_as_float(rr[0]) + __uint_as_float(rr[1]); }
    l_reg = l_reg * alpha + ps;
#define PK4(P, BASE, OUT) do { unsigned a0 = cvtpk(P[BASE + 0], P[BASE + 1]), a1 = cvtpk(P[BASE + 2], P[BASE + 3]);   \
    unsigned b0 = cvtpk(P[BASE + 4], P[BASE + 5]), b1 = cvtpk(P[BASE + 6], P[BASE + 7]);                              \
    auto r0 = __builtin_amdgcn_permlane32_swap(a0, b0, false, false); auto r1 = __builtin_amdgcn_permlane32_swap(a1, b1, false, false); \
    u32x4 w = {r0[0], r1[0], r0[1], r1[1]}; OUT = *reinterpret_cast<bf16x8*>(&w); } while (0)
    PK4(p0, 0, pa0); PK4(p0, 8, pa1); PK4(p1, 0, pa2); PK4(p1, 8, pa3);
#undef PK4
}
__device__ __forceinline__ void qkt(f32x16& p0, f32x16& p1, const unsigned char* Ks, const bf16x8* qr, int r32, int hi) {
    p0 = f32x16{}; p1 = f32x16{};
#pragma unroll
    for (int d0 = 0; d0 < 6; ++d0) { const int cb = (d0 * 16 + hi * 8) * 2;
        const bf16x8 b0 = *reinterpret_cast<const bf16x8*>(Ks + KSWZ(r32, cb));
        const bf16x8 b1 = *reinterpret_cast<const bf16x8*>(Ks + KSWZ(32 + r32, cb));
        p0 = __builtin_amdgcn_mfma_f32_32x32x16_bf16(b0, qr[d0], p0, 0, 0, 0);
        p1 = __builtin_amdgcn_mfma_f32_32x32x16_bf16(b1, qr[d0], p1, 0, 0, 0); }
}
__device__ __forceinline__ int v_st(int k, int c) { const int kk = (k & ~0xC) | ((k & 4) << 1) | ((k & 8) >> 1); return ((kk >> 3) * 2 + (c >> 5)) * 512 + ((kk & 7) * 32 + (c & 31)) * 2; }
__device__ __forceinline__ int v_rd_base(int lane) { return ((lane & 3) << 3) | (((lane >> 2) & 3) << 6) | (((lane >> 4) & 1) << 5) | (((lane >> 5) & 1) << 8); }
constexpr int v_rd_off(int d0, int ks, int half) { return d0 * 512 + ks * 2048 + half * 1024; }
template <int OFF> __device__ __forceinline__ s16x4 tr_read(int vb) { s16x4 r; asm volatile("ds_read_b64_tr_b16 %0, %1 offset:%2" : "=&v"(r) : "v"(vb), "i"(OFF) : "memory"); return r; }
template <int D0> __device__ __forceinline__ void pv_one(f32x16& od, int vb, bf16x8 pa0, bf16x8 pa1, bf16x8 pa2, bf16x8 pa3) {
    const s16x4 l0 = tr_read<v_rd_off(D0, 0, 0)>(vb), h0 = tr_read<v_rd_off(D0, 0, 1)>(vb), l1 = tr_read<v_rd_off(D0, 1, 0)>(vb), h1 = tr_read<v_rd_off(D0, 1, 1)>(vb);
    const s16x4 l2 = tr_read<v_rd_off(D0, 2, 0)>(vb), h2 = tr_read<v_rd_off(D0, 2, 1)>(vb), l3 = tr_read<v_rd_off(D0, 3, 0)>(vb), h3 = tr_read<v_rd_off(D0, 3, 1)>(vb);
    asm volatile("s_waitcnt lgkmcnt(0)" ::: "memory"); SBAR();
#define PK(L, H) (bf16x8){L[0], L[1], L[2], L[3], H[0], H[1], H[2], H[3]}
    od = __builtin_amdgcn_mfma_f32_32x32x16_bf16(pa0, PK(l0, h0), od, 0, 0, 0);
    od = __builtin_amdgcn_mfma_f32_32x32x16_bf16(pa1, PK(l1, h1), od, 0, 0, 0);
    od = __builtin_amdgcn_mfma_f32_32x32x16_bf16(pa2, PK(l2, h2), od, 0, 0, 0);
    od = __builtin_amdgcn_mfma_f32_32x32x16_bf16(pa3, PK(l3, h3), od, 0, 0, 0);
#undef PK
}
__device__ __forceinline__ void pv_d0(f32x16* o, int vb, bf16x8 pa0, bf16x8 pa1, bf16x8 pa2, bf16x8 pa3) { pv_one<0>(o[0], vb, pa0, pa1, pa2, pa3); pv_one<1>(o[1], vb, pa0, pa1, pa2, pa3); }

__device__ __forceinline__ void attn_unit(const bf16_t* __restrict__ Qb, const bf16_t* __restrict__ Kh, const bf16_t* __restrict__ Vh, bf16_t* __restrict__ Ob, int seq, unsigned char* lds) {
    const int tid = threadIdx.x, wid = tid >> 6, lane = tid & 63, r32 = lane & 31, hi = lane >> 5;
    unsigned char* V_lds = lds; unsigned char* K_lds = lds + 2 * SHM_V;
    float* wsf = (float*)(lds + 2 * SHM_V + 2 * SHM_K) + wid * 64; float* li_l = wsf; float* al_l = wsf + 32;
    float m_reg = -1e30f, l_reg = 0; f32x16 o[2] = {}; bf16x8 qr[6];
    const bf16_t* Qw = Qb + (size_t)(wid * QBLK + r32) * LDQ + hi * 8;
#pragma unroll
    for (int d0 = 0; d0 < 6; ++d0) qr[d0] = *reinterpret_cast<const bf16x8*>(Qw + d0 * 16);
    const int sr = tid >> 4, sc = (tid & 15) * 8;
    const int vr = tid >> 3, vc = (tid & 7) * 8, vst = v_st(vr, vc);
    const int vb0 = (int)(uintptr_t)V_lds + v_rd_base(lane);
    struct { bf16x8 vs, ks0, ks1; } sr_[2];
#define SLOAD(i, k0) do { sr_[i].vs = *reinterpret_cast<const bf16x8*>(&Vh[(size_t)((k0) + vr) * LDV + vc]); \
    sr_[i].ks0 = *reinterpret_cast<const bf16x8*>(&Kh[(size_t)((k0) + sr) * LDK + sc]); sr_[i].ks1 = *reinterpret_cast<const bf16x8*>(&Kh[(size_t)((k0) + 32 + sr) * LDK + sc]); } while (0)
#define SWRITE(b, i) do { *(bf16x8*)(V_lds + (b) * SHM_V + vst) = sr_[i].vs; const int kc = sc * 2;               \
    *(bf16x8*)(K_lds + (b) * SHM_K + KSWZ(sr, kc)) = sr_[i].ks0; *(bf16x8*)(K_lds + (b) * SHM_K + KSWZ(32 + sr, kc)) = sr_[i].ks1; } while (0)
#define SWAIT() asm volatile("s_waitcnt vmcnt(3)" ::: "memory")
#define RESC(a) do { if (__any((a) < 1.f)) { if (hi == 0) al_l[r32] = (a); asm volatile("s_waitcnt lgkmcnt(0)" ::: "memory"); \
    _Pragma("unroll") for (int d = 0; d < 2; ++d) _Pragma("unroll") for (int r = 0; r < 16; ++r) o[d][r] *= al_l[crow(r, hi)]; } } while (0)
    f32x16 pA0, pA1, pB0, pB1; float mnA, mnB, alA, alB; bf16x8 pa0, pa1, pa2, pa3; const int NT = seq / KVBLK;
    constexpr int SE = 0, SO = 1;
    SLOAD(SE, 0); asm volatile("s_waitcnt vmcnt(0)" ::: "memory"); SWRITE(0, SE); __syncthreads();
    qkt(pA0, pA1, K_lds, qr, r32, hi); partialSM(pA0, pA1, m_reg, mnA, alA);
    SLOAD(SO, KVBLK); if (2 < NT) SLOAD(SE, 2 * KVBLK);
    SWAIT(); SWRITE(1, SO); __syncthreads();
    for (int j = 1; j + 1 < NT; j += 2) {
        SBAR(); qkt(pB0, pB1, K_lds + SHM_K, qr, r32, hi);
        finishSM(pA0, pA1, alA, l_reg, pa0, pa1, pa2, pa3); SBAR();
        SLOAD(SO, (j + 2) * KVBLK); SBAR();
        pv_d0(o, vb0, pa0, pa1, pa2, pa3); partialSM(pB0, pB1, m_reg, mnB, alB);
        __syncthreads(); SWAIT(); SWRITE(0, SE);
        RESC(alB); __syncthreads();
        SBAR(); qkt(pA0, pA1, K_lds, qr, r32, hi);
        finishSM(pB0, pB1, alB, l_reg, pa0, pa1, pa2, pa3); SBAR();
        if (j + 3 < NT) SLOAD(SE, (j + 3) * KVBLK); SBAR();
        pv_d0(o, vb0 + SHM_V, pa0, pa1, pa2, pa3); partialSM(pA0, pA1, m_reg, mnA, alA);
        __syncthreads(); SWAIT(); SWRITE(1, SO);
        RESC(alA); __syncthreads();
    }
    SBAR(); qkt(pB0, pB1, K_lds + SHM_K, qr, r32, hi);
    finishSM(pA0, pA1, alA, l_reg, pa0, pa1, pa2, pa3); SBAR();
    pv_d0(o, vb0, pa0, pa1, pa2, pa3); partialSM(pB0, pB1, m_reg, mnB, alB);
    __syncthreads(); RESC(alB);
    finishSM(pB0, pB1, alB, l_reg, pa0, pa1, pa2, pa3); SBAR();
    pv_d0(o, vb0 + SHM_V, pa0, pa1, pa2, pa3);
    if (hi == 0) li_l[r32] = l_reg; asm volatile("s_waitcnt lgkmcnt(0)" ::: "memory");
    float rli[16];
#pragma unroll
    for (int r = 0; r < 16; ++r) rli[r] = __builtin_amdgcn_rcpf(li_l[crow(r, hi)]);
    bf16_t* Ow = Ob + (size_t)(wid * QBLK) * 512;
#pragma unroll
    for (int r = 0; r < 16; ++r) { const int orow = crow(r, hi);
#pragma unroll
        for (int d0 = 0; d0 < 2; ++d0) Ow[(size_t)orow * 512 + d0 * 32 + r32] = (bf16_t)(pk2(o[d0][r] * rli[r], 0.f) & 0xffffu); }
    __syncthreads();
#undef SLOAD
#undef SWRITE
#undef SWAIT
#undef RESC
}
#undef KSWZ
#undef SBAR
}

__device__ __forceinline__ void phase_attn(const Params& p, unsigned char* lds) {
    const bf16_t* Q = (const bf16_t*)(p.ws + WS_Q); const bf16_t* Kb = (const bf16_t*)(p.ws + WS_K); const bf16_t* V = (const bf16_t*)(p.ws + WS_V); bf16_t* AO = (bf16_t*)(p.ws + WS_AO);
    constexpr int NQB = SEQ / 256, NU = 2 * NH * NQB;
    for (int u = blockIdx.x; u < NU; u += gridDim.x) {
        const int qb = u % NQB, h = (u / NQB) % NH, b = u / (NQB * NH); const size_t bh = (size_t)(b * NH + h) * SEQ;
        att::attn_unit(Q + (bh + (size_t)qb * 256) * DQK, Kb + bh * 128, V + bh * DV, AO + ((size_t)b * SEQ + (size_t)qb * 256) * 512 + h * DV, SEQ, lds);
    }
}

__device__ __forceinline__ void phase_router(const Params& p, unsigned char* lds) {
    const int tid = threadIdx.x, lane = tid & 63, wave = tid >> 6;
    float* hbuf = (float*)lds + wave * 4096;
    int* lcnt = (int*)(lds + 131072);
    int* lbase = lcnt + 32;
    int* pe = lbase + 32;
    int* prk = pe + 256;
    float* pw = (float*)(prk + 256);
    unsigned* gcnt = (unsigned*)(p.ws + WS_CTL) + CW_CNT;
    int* pair_e = (int*)(p.ws + WS_ROUTE + RT_PAIR_E); int* pair_rank = (int*)(p.ws + WS_ROUTE + RT_PAIR_RANK); float* pair_w = (float*)(p.ws + WS_ROUTE + RT_PAIR_W);
    const int e = lane & 31, half = lane >> 5;
    const float rb = p.router_b[e];
    for (int tg = blockIdx.x; tg < NTOK / 64; tg += gridDim.x) {
        if (tid < 32) lcnt[tid] = 0;
        __syncthreads();
        for (int pass = 0; pass < 2; ++pass) {
            const int tl0 = wave * 8 + pass * 4;
#pragma unroll
            for (int tt = 0; tt < 4; ++tt) {
                const int t = tg * 64 + tl0 + tt;
                const f32x4* xr = (const f32x4*)(p.out + (size_t)t * DM) + lane; f32x4 v[4]; float s = 0.f;
#pragma unroll
                for (int j = 0; j < 4; ++j) { v[j] = xr[64 * j]; s += (v[j][0] * v[j][0] + v[j][1] * v[j][1]) + (v[j][2] * v[j][2] + v[j][3] * v[j][3]); }
                const float rstd = rsqrtf(wave_sum(s) * (1.f / DM) + EPS);
#pragma unroll
                for (int j = 0; j < 4; ++j) { const f32x4 g = *((const f32x4*)p.norm2_g + lane + 64 * j); const f32x4 hh = v[j] * rstd * g; *((f32x4*)(hbuf + tt * 1024) + lane + 64 * j) = hh; }
            }
            asm volatile("s_waitcnt lgkmcnt(0)" ::: "memory");
            float a0 = 0.f, a1 = 0.f, a2 = 0.f, a3 = 0.f;
            const float* rwp = p.router_w + (size_t)(half * 512) * NE + e; const float* hb = hbuf + half * 512;
#pragma unroll 16
            for (int kk = 0; kk < 512; ++kk) { const float r = rwp[(size_t)kk * NE]; a0 += hb[kk] * r; a1 += hb[1024 + kk] * r; a2 += hb[2048 + kk] * r; a3 += hb[3072 + kk] * r; }
            a0 += __shfl_xor(a0, 32); a1 += __shfl_xor(a1, 32); a2 += __shfl_xor(a2, 32); a3 += __shfl_xor(a3, 32);
            float lg[4] = {a0 + rb, a1 + rb, a2 + rb, a3 + rb};
#pragma unroll
            for (int tt = 0; tt < 4; ++tt) {
                float val = lg[tt]; float tv[4]; int ti[4];
#pragma unroll
                for (int r = 0; r < 4; ++r) {
                    float bv = val; int bi = e;
#pragma unroll
                    for (int o = 1; o < 32; o <<= 1) { const float ov = __shfl_xor(bv, o); const int oi = __shfl_xor(bi, o); if (ov > bv || (ov == bv && oi < bi)) { bv = ov; bi = oi; } }
                    tv[r] = bv; ti[r] = bi; if (e == bi) val = -INFINITY;
                }
                const float e1 = __expf(tv[1] - tv[0]), e2 = __expf(tv[2] - tv[0]), e3 = __expf(tv[3] - tv[0]); const float inv = 1.f / (1.f + e1 + e2 + e3);
                const float wv[4] = {inv, e1 * inv, e2 * inv, e3 * inv};
                if (lane < 4) { const int ee = lane == 0 ? ti[0] : lane == 1 ? ti[1] : lane == 2 ? ti[2] : ti[3]; const float ww = lane == 0 ? wv[0] : lane == 1 ? wv[1] : lane == 2 ? wv[2] : wv[3];
                    const int rl = atomicAdd(&lcnt[ee], 1); const int pl = (tl0 + tt) * 4 + lane; pe[pl] = ee; prk[pl] = rl; pw[pl] = ww; }
            }
            asm volatile("s_waitcnt lgkmcnt(0)" ::: "memory");
        }
        __syncthreads();
        if (tid < 32) lbase[tid] = (int)atomicAdd(&gcnt[tid], (unsigned)lcnt[tid]);
        __syncthreads();
        if (tid < 256) { const int gp = tg * 256 + tid; const int ee = pe[tid]; pair_e[gp] = ee; pair_rank[gp] = lbase[ee] + prk[tid]; pair_w[gp] = pw[tid]; }
        __syncthreads();
    }
}

__device__ __forceinline__ void build_block_table(const Params& p, int* bs) {
    const unsigned* gcnt = (const unsigned*)(p.ws + WS_CTL) + CW_CNT;
    if (threadIdx.x == 0) { int acc = 0; for (int e = 0; e < NE; ++e) { bs[e] = acc; acc += ((int)__hip_atomic_load(gcnt + e, __ATOMIC_RELAXED, __HIP_MEMORY_SCOPE_AGENT) + 255) >> 8; } bs[NE] = acc; }
    __syncthreads();
}

__device__ __forceinline__ void phase_scatter(const Params& p, unsigned char* lds) {
    int* bs = (int*)(lds + 131072); build_block_table(p, bs);
    const int tid = threadIdx.x, lane = tid & 63, wave = tid >> 6;
    const int gw = blockIdx.x * NWAVES + wave, NGW = gridDim.x * NWAVES;
    const int* pair_e = (const int*)(p.ws + WS_ROUTE + RT_PAIR_E); const int* pair_rank = (const int*)(p.ws + WS_ROUTE + RT_PAIR_RANK); const float* pair_w = (const float*)(p.ws + WS_ROUTE + RT_PAIR_W);
    float* rw = (float*)(p.ws + WS_ROUTE + RT_ROW_W); int* rs = (int*)(p.ws + WS_ROUTE + RT_ROW_SLOT);
    unsigned char* XS = p.ws + WS_XS;
    for (int t = gw; t < NTOK; t += NGW) {
        int dest = 0;
        if (lane < 4) { const int i = t * 4 + lane; dest = bs[pair_e[i]] * 256 + pair_rank[i]; rw[dest] = pair_w[i]; rs[dest] = i; }
        const int d0 = __shfl(dest, 0), d1 = __shfl(dest, 1), d2 = __shfl(dest, 2), d3 = __shfl(dest, 3);
        const f32x4* xr = (const f32x4*)(p.out + (size_t)t * DM) + lane; f32x4 v[4]; float s = 0.f;
#pragma unroll
        for (int j = 0; j < 4; ++j) { v[j] = xr[64 * j]; s += (v[j][0] * v[j][0] + v[j][1] * v[j][1]) + (v[j][2] * v[j][2] + v[j][3] * v[j][3]); }
        const float rstd = rsqrtf(wave_sum(s) * (1.f / DM) + EPS);
#pragma unroll
        for (int j = 0; j < 4; ++j) { const f32x4 g = *((const f32x4*)p.norm2_g + lane + 64 * j); const f32x4 hh = v[j] * rstd * g; const unsigned w = pk4_fp8(hh[0], hh[1], hh[2], hh[3]);
            *((unsigned*)(XS + (size_t)d0 * DM) + lane + 64 * j) = w; *((unsigned*)(XS + (size_t)d1 * DM) + lane + 64 * j) = w;
            *((unsigned*)(XS + (size_t)d2 * DM) + lane + 64 * j) = w; *((unsigned*)(XS + (size_t)d3 * DM) + lane + 64 * j) = w; }
    }
    { const unsigned* gcnt = (const unsigned*)(p.ws + WS_CTL) + CW_CNT;
      for (int e = 0; e < NE; ++e) { const int c = (int)__hip_atomic_load(gcnt + e, __ATOMIC_RELAXED, __HIP_MEMORY_SCOPE_AGENT); const int r0 = bs[e] * 256 + c, r1 = bs[e + 1] * 256;
          for (int r = r0 + gw; r < r1; r += NGW) { u32x4* o = (u32x4*)(XS + (size_t)r * DM) + lane; o[0] = (u32x4){0u, 0u, 0u, 0u}; } } }
    __syncthreads();
}

__device__ __forceinline__ pg8::MoeOrder make_moe_order(const int* bs, int N) {
    const int nmb = __builtin_amdgcn_readfirstlane(bs[NE]);
    pg8::MoeOrder S; S.so.init(nmb * 256, N, (int)gridDim.x, (int)blockIdx.x); unsigned elo = 0u, ehi = 0u;
    for (int i = 0; i < 12; ++i) { pg8::Unit u; if (!S.so.next(i, u)) break; int e = 0; for (int k = 1; k < NE; ++k) if (bs[k] <= u.pm) e = k;
        e = __builtin_amdgcn_readfirstlane(e); if (i < 6) elo |= (unsigned)e << (5 * i); else ehi |= (unsigned)e << (5 * (i - 6)); }
    S.elo = (unsigned)__builtin_amdgcn_readfirstlane((int)elo); S.ehi = (unsigned)__builtin_amdgcn_readfirstlane((int)ehi); return S;
}
__device__ __forceinline__ void phase_moe1(const Params& p, unsigned char* lds) {
    int* bs = (int*)(lds + 131072); build_block_table(p, bs);
    const pg8::MoeOrder S = make_moe_order(bs, 2048);
    pg8::Gemm g{(const bf16_t*)(p.ws + WS_XS), (const bf16_t*)(p.ws + WS_W1), 0, 2048, DM / 2, (size_t)2048 * DM};
    pg8::EpiSwiglu E{p.ws + WS_ACT, p.b1};
    pg8::gemm_phase<pg8::EpiSwiglu, pg8::MoeOrder, true, true, true>((PG8_LAS unsigned char*)lds, g, S, E);
}
__device__ __forceinline__ void phase_moe2(const Params& p, unsigned char* lds) {
    int* bs = (int*)(lds + 131072); build_block_table(p, bs);
    const pg8::MoeOrder S = make_moe_order(bs, DM);
    pg8::Gemm g{(const bf16_t*)(p.ws + WS_ACT), (const bf16_t*)(p.ws + WS_W2), 0, DM, DFF / 2, (size_t)DM * DFF};
    pg8::EpiMoeOut E{(bf16_t*)(p.ws + WS_YS), p.b2, (const float*)(p.ws + WS_ROUTE + RT_ROW_W), (const int*)(p.ws + WS_ROUTE + RT_ROW_SLOT)};
    pg8::gemm_phase<pg8::EpiMoeOut, pg8::MoeOrder, true, true, true>((PG8_LAS unsigned char*)lds, g, S, E);
}

__device__ __forceinline__ void phase_combine(const Params& p) {
    const int tid = threadIdx.x, lane = tid & 63, wave = tid >> 6;
    const int gw = blockIdx.x * NWAVES + wave, NGW = gridDim.x * NWAVES;
    const bf16_t* YS = (const bf16_t*)(p.ws + WS_YS);
    for (int t = gw; t < NTOK; t += NGW) {
        f32x4* orow = (f32x4*)(p.out + (size_t)t * DM) + lane;
#pragma unroll
        for (int j = 0; j < 4; ++j) { f32x4 v = orow[64 * j];
#pragma unroll
            for (int k = 0; k < 4; ++k) { const u32x2 w = *((const u32x2*)(YS + ((size_t)t * 4 + k) * DM) + lane + 64 * j); v[0] += bf_lo(w.x); v[1] += bf_hi(w.x); v[2] += bf_lo(w.y); v[3] += bf_hi(w.y); }
            orow[64 * j] = v; }
    }
}

template <class Epi>
__device__ __forceinline__ void dense_gemm(unsigned char* lds, const bf16_t* A, const bf16_t* Bt, int M, int N, int K, const Epi& E) {
    pg8::Gemm g{A, Bt, M, N, K, 0}; pg8::StaticOrder S; S.init(M, N, (int)gridDim.x, (int)blockIdx.x);
    pg8::gemm_phase<Epi, pg8::StaticOrder, true, true>((PG8_LAS unsigned char*)lds, g, S, E);
}

constexpr int NPHASE = 13;
__global__ void __launch_bounds__(NTHREADS, 2) mk_fwd(Params p) {
    extern __shared__ __attribute__((aligned(16))) unsigned char lds[];
    cg::grid_group grid = cg::this_grid();
    unsigned char* ws = p.ws;
    volatile LAS unsigned* MISC = (volatile LAS unsigned*)((LAS unsigned char*)lds + MISC_OFF);
    if (threadIdx.x < 32) MISC[threadIdx.x] = 0u;
    __syncthreads();
    XcdBarrier bar = xcd_barrier_post((unsigned*)(ws + WS_CTL) + CW_BAR, MISC + 8);
    const int lo = p.ph_lo, hi = p.ph_hi;
    if (lo < 0) grid.sync();
#define IN(k) (lo <= (k) && (k) < hi)
#define SEAM(k) do { if (IN(k) && IN((k) + 1)) xcd_barrier(bar); } while (0)
    if (IN(0)) phase_prologue(p, lds);
    SEAM(0);
    if (IN(1)) { pg8::EpiProj E{(bf16_t*)(ws + WS_PROJ)}; dense_gemm(lds, (const bf16_t*)(ws + WS_XN), (const bf16_t*)(ws + WS_WIN), NTOK, INCP, DM, E); }
    SEAM(1);
    if (IN(2)) phase_tok_a(p);
    SEAM(2);
    if (IN(3)) { pg8::EpiF32 Eq{(float*)(ws + WS_QPRE), 768}; dense_gemm(lds, (const bf16_t*)(ws + WS_CQN), (const bf16_t*)(ws + WS_WUQ), NTOK, 768, QLORA, Eq);
                 pg8::EpiF32 Ek{(float*)(ws + WS_KVPRE), 1024}; dense_gemm(lds, (const bf16_t*)(ws + WS_CKVN), (const bf16_t*)(ws + WS_WUKV), NTOK, 1024, KVLORA, Ek); }
    SEAM(3);
    if (IN(4)) phase_tok_b(p);
    SEAM(4);
    if (IN(5)) phase_attn(p, lds);
    SEAM(5);
    if (IN(6)) { pg8::EpiGateA E{(bf16_t*)(ws + WS_M1), (const bf16_t*)(ws + WS_PROJ)}; dense_gemm(lds, (const bf16_t*)(ws + WS_AO), (const bf16_t*)(ws + WS_WOMLA), NTOK, DM, 512, E); }
    if (IN(7)) { pg8::EpiGateB E{(const bf16_t*)(ws + WS_M1), (const bf16_t*)(ws + WS_PROJ), (bf16_t*)(ws + WS_MERGED)}; dense_gemm(lds, (const bf16_t*)(ws + WS_YBIN), (const bf16_t*)(ws + WS_WOCONV), NTOK, DM, 512, E); }
    SEAM(7);
    if (IN(8)) { pg8::EpiResid E{p.x, p.out}; dense_gemm(lds, (const bf16_t*)(ws + WS_MERGED), (const bf16_t*)(ws + WS_WO), NTOK, DM, DM, E); }
    SEAM(8);
    if (IN(9)) phase_router(p, lds);
    SEAM(9);
    if (IN(10)) phase_scatter(p, lds);
    SEAM(10);
    if (IN(11)) phase_moe1(p, lds);
    SEAM(11);
    if (IN(12)) phase_moe2(p, lds);
    SEAM(12);
    if (IN(13)) phase_combine(p);
#undef IN
#undef SEAM
}

extern "C" void kernel_launch(void* const* d_in, const int* in_sizes, int n_in, void* d_out, int out_size,
                              void* d_ws, size_t ws_size, hipStream_t stream) {
    static int grid_blocks = 0;
    if (!grid_blocks) {
        int dev = 0, cus = 0, per_cu = 0;
        (void)hipGetDevice(&dev);
        (void)hipDeviceGetAttribute(&cus, hipDeviceAttributeMultiprocessorCount, dev);
        (void)hipFuncSetAttribute((const void*)mk_fwd, hipFuncAttributeMaxDynamicSharedMemorySize, LDS_BYTES);
        (void)hipOccupancyMaxActiveBlocksPerMultiprocessor(&per_cu, (const void*)mk_fwd, NTHREADS, LDS_BYTES);
        if (per_cu < 1) { fprintf(stderr, "kernel_launch: occupancy query says %d blocks/CU\n", per_cu); per_cu = 1; }
        grid_blocks = cus;
        if (ws_size < WS_END || n_in != 21) fprintf(stderr, "kernel_launch: ws %zu < %zu or n_in %d != 21\n", ws_size, (size_t)WS_END, n_in);
    }
    (void)hipMemsetAsync((char*)d_ws + WS_CTL, 0, 1 * MiB, stream);
    Params p{};
    p.x = (const float*)d_in[0]; p.pos = (const int*)d_in[1]; p.norm1_g = (const float*)d_in[2]; p.w_in = (const float*)d_in[3]; p.q_a_g = (const float*)d_in[4];
    p.kv_a_g = (const float*)d_in[5]; p.w_uq = (const float*)d_in[6]; p.w_ukv = (const float*)d_in[7]; p.q_g = (const float*)d_in[8]; p.k_g = (const float*)d_in[9];
    p.conv_w = (const float*)d_in[10]; p.w_o_mla = (const float*)d_in[11]; p.w_o_conv = (const float*)d_in[12]; p.w_o = (const float*)d_in[13]; p.norm2_g = (const float*)d_in[14];
    p.router_w = (const float*)d_in[15]; p.router_b = (const float*)d_in[16]; p.w1 = (const float*)d_in[17]; p.b1 = (const float*)d_in[18]; p.w2 = (const float*)d_in[19]; p.b2 = (const float*)d_in[20];
    p.out = (float*)d_out; p.ws = (unsigned char*)d_ws; p.ph_lo = 0; p.ph_hi = NPHASE + 1;
    void* args[] = {&p};
    hipError_t e = hipLaunchCooperativeKernel((const void*)mk_fwd, dim3(grid_blocks), dim3(NTHREADS), args, LDS_BYTES, stream);
    if (e != hipSuccess) fprintf(stderr, "cooperative launch failed: %s (grid %d)\n", hipGetErrorString(e), grid_blocks);
}
```

```cpp
#include <hip/hip_runtime.h>
#include <hip/hip_cooperative_groups.h>
#include <cstdio>
#include <cstdint>
namespace cg = cooperative_groups;

typedef unsigned short bf16_t;
typedef short bf16x8 __attribute__((ext_vector_type(8)));
typedef short s16x4 __attribute__((ext_vector_type(4)));
typedef float f32x4 __attribute__((ext_vector_type(4)));
typedef float f32x2 __attribute__((ext_vector_type(2)));
typedef float f32x16 __attribute__((ext_vector_type(16)));
typedef unsigned u32x4 __attribute__((ext_vector_type(4)));
typedef unsigned u32x2 __attribute__((ext_vector_type(2)));
typedef __bf16 bf16x2_t __attribute__((ext_vector_type(2)));

constexpr int NTOK = 16384, DM = 1024, SEQ = 8192;
constexpr int INC = 4000, INCP = 4096;
constexpr int OFF_CQ = 0, OFF_CKV = 256, OFF_KR = 384, OFF_U = 416, OFF_C = 928, OFF_B = 1440, OFF_GA = 1952, OFF_GB = 2976;
constexpr int NH = 8, DQK = 96, DV = 64, NE = 32, TOPK = 4, DFF = 1024;
constexpr int QLORA = 256, KVLORA = 128, CONVW = 512;
constexpr int NPAIR = NTOK * TOPK;
constexpr int MAXROWS = 73728;
constexpr float EPS = 1e-6f;
constexpr int CAP = 16384;
constexpr int NTHREADS = 512, NWAVES = 8;
constexpr int LDS_BYTES = 147456;

constexpr size_t MiB = 1ull << 20;
constexpr size_t WS_CTL = 0;
constexpr size_t WS_WIN = 1 * MiB;
constexpr size_t WS_WUQ = 9 * MiB;
constexpr size_t WS_WUKV = WS_WUQ + 512 * 1024;
constexpr size_t WS_WOMLA = 10 * MiB;
constexpr size_t WS_WOCONV = 11 * MiB;
constexpr size_t WS_WO = 12 * MiB;
constexpr size_t WS_ROUTE = 14 * MiB;
constexpr size_t WS_W1 = 18 * MiB;
constexpr size_t WS_W2 = 146 * MiB;
constexpr size_t WS_XN = 210 * MiB;
constexpr size_t WS_PROJ = 242 * MiB;
constexpr size_t WS_CQN = 370 * MiB;
constexpr size_t WS_CKVN = 378 * MiB;
constexpr size_t WS_YBIN = 386 * MiB;
constexpr size_t WS_QPRE = 402 * MiB;
constexpr size_t WS_KVPRE = 450 * MiB;
constexpr size_t WS_Q = 514 * MiB;
constexpr size_t WS_K = 538 * MiB;
constexpr size_t WS_V = 570 * MiB;
constexpr size_t WS_AO = 586 * MiB;
constexpr size_t WS_M1 = 602 * MiB;
constexpr size_t WS_MERGED = 666 * MiB;
constexpr size_t WS_YS = 698 * MiB;
constexpr size_t WS_END = 826 * MiB;
constexpr size_t WS_ACT = WS_PROJ;
constexpr size_t WS_H8 = WS_XN;
constexpr size_t WS_GF = 830 * MiB;
constexpr size_t WS_RT2 = 832 * MiB;
constexpr size_t WS_END2 = 840 * MiB;
constexpr size_t RT_PAIR_E = 0, RT_PAIR_RANK = 262144, RT_PAIR_W = 524288, RT_ROW_TOK = 786432, RT_ROW_W = 786432 + 294912, RT_ROW_SLOT = 786432 + 2 * 294912;
constexpr int CW_CNT = 64;
constexpr int CW_BAR = 4096;
constexpr int MISC_OFF = LDS_BYTES - 256;

struct Params {
    const float* x; const int* pos; const float* norm1_g; const float* w_in; const float* q_a_g; const float* kv_a_g;
    const float* w_uq; const float* w_ukv; const float* q_g; const float* k_g; const float* conv_w; const float* w_o_mla;
    const float* w_o_conv; const float* w_o; const float* norm2_g; const float* router_w; const float* router_b;
    const float* w1; const float* b1; const float* w2; const float* b2;
    float* out; unsigned char* ws; int ph_lo, ph_hi;
};

__device__ __forceinline__ unsigned pk2(float lo, float hi) { f32x2 v = {lo, hi}; bf16x2_t b = __builtin_convertvector(v, bf16x2_t); return __builtin_bit_cast(unsigned, b); }
__device__ __forceinline__ float bf_lo(unsigned w) { return __uint_as_float(w << 16); }
__device__ __forceinline__ float bf_hi(unsigned w) { return __uint_as_float(w & 0xffff0000u); }
__device__ __forceinline__ float bf1(bf16_t h) { return __uint_as_float((unsigned)h << 16); }
__device__ __forceinline__ float wave_sum(float v) {
#pragma unroll
    for (int o = 1; o < 64; o <<= 1) v += __shfl_xor(v, o);
    return v;
}
__device__ __forceinline__ unsigned pk4_fp8(float a, float b, float c, float d) { unsigned w = 0u; w = (unsigned)__builtin_amdgcn_cvt_pk_fp8_f32(a, b, (int)w, false); w = (unsigned)__builtin_amdgcn_cvt_pk_fp8_f32(c, d, (int)w, true); return w; }
constexpr float W8_SCALE = 32.f, W8_INV = 1.f / 32.f;
__device__ __forceinline__ float sigmoidf_(float v) { return 1.f / (1.f + __expf(-v)); }

namespace pg8 {
#define PG8_LAS __attribute__((address_space(3)))
constexpr int BM = 256, BK = 64, HALF = 128, HTB = HALF * BK * 2  , STAGE_BYTES = 8 * HTB, NXCD = 8, WGM = 8;

__host__ __device__ __forceinline__ int lds_byte(int r, int c) { const int st = (r >> 4) * 2 + (c >> 5), rr = r & 15, cc = c & 31, ob = rr * 64 + cc * 2; return st * 1024 + (ob ^ (((ob >> 9) & 1) << 5)); }
__host__ __device__ __forceinline__ void stage_rc(int b, int& R, int& C) { const int st = b / 1024, sb = b % 1024, swz = sb ^ (((sb >> 9) & 1) << 5); R = (st >> 1) * 16 + swz / 64; C = (st & 1) * 32 + (swz % 64) / 2; }
__host__ __device__ __forceinline__ int perm32(int rho) { const int n = rho >> 4, i = rho & 15; return 8 * (i >> 2) + 4 * n + (i & 3); }

struct Unit { int pm, pn, e, rb; };
struct Gemm { const bf16_t* A; const bf16_t* Bt; int M, N, K; size_t bstride; };

struct StaticOrder {
    int nM, nN, nwg, G, c;
    __host__ __device__ void init(int M, int N, int G_, int c_) { nM = M / BM; nN = N / BM; nwg = nM * nN; G = G_; c = c_; }
    __host__ __device__ bool next(int i, Unit& u) const {
        const long L = (long)i * G + c; if (L >= nwg) return false;
        int wgid = (int)L; { const int q = nwg / NXCD, r = nwg % NXCD, xcd = wgid % NXCD, off = wgid / NXCD; wgid = (xcd < r ? xcd * (q + 1) : r * (q + 1) + (xcd - r) * q) + off; }
        const int nig = WGM * nN, gid = wgid / nig, fm = gid * WGM, gsz = (nM - fm) < WGM ? (nM - fm) : WGM;
        u.pm = fm + ((wgid % nig) % gsz); u.pn = (wgid % nig) / gsz; u.e = 0; u.rb = 0; return true;
    }
    __device__ __forceinline__ void a_ready(const Unit&) const {}
    __device__ __forceinline__ void done(const Unit&) const {}
};


struct EpiProj {
    static constexpr bool PERM = true, AFTER_DRAIN = false;
    bf16_t* O;
    __device__ __forceinline__ void operator()(const f32x4 (&acc)[2][2][4][2], const Unit& u, int wr, int wc, int fr, int fq) const {
        const int row0 = u.pm * BM + wr * 64 + fr, col0 = u.pn * BM + wc * 32 + 8 * fq;
#pragma unroll
        for (int ai = 0; ai < 2; ++ai)
#pragma unroll
            for (int m = 0; m < 4; ++m) { bf16_t* rowp = O + (size_t)(row0 + ai * HALF + m * 16) * INCP + col0;
#pragma unroll
                for (int bj = 0; bj < 2; ++bj) { f32x4 v0 = acc[ai][bj][m][0], v1 = acc[ai][bj][m][1]; const int col = col0 + bj * HALF;
                    if (col >= OFF_GA && col < INC) {
#pragma unroll
                        for (int j = 0; j < 4; ++j) { v0[j] = sigmoidf_(v0[j]); v1[j] = sigmoidf_(v1[j]); } }
                    u32x4 w; w.x = pk2(v0[0], v0[1]); w.y = pk2(v0[2], v0[3]); w.z = pk2(v1[0], v1[1]); w.w = pk2(v1[2], v1[3]);
                    *(u32x4*)(rowp + bj * HALF) = w; } }
    }
};
struct EpiF32 {
    static constexpr bool PERM = false, AFTER_DRAIN = false;
    float* O; int ldc;
    __device__ __forceinline__ void operator()(const f32x4 (&acc)[2][2][4][2], const Unit& u, int wr, int wc, int fr, int fq) const {
        const int row0 = u.pm * BM + wr * 64 + fr, col0 = u.pn * BM + wc * 32 + 4 * fq;
#pragma unroll
        for (int ai = 0; ai < 2; ++ai)
#pragma unroll
            for (int m = 0; m < 4; ++m) { float* rowp = O + (size_t)(row0 + ai * HALF + m * 16) * ldc + col0;
#pragma unroll
                for (int bj = 0; bj < 2; ++bj)
#pragma unroll
                    for (int n = 0; n < 2; ++n) *(f32x4*)(rowp + bj * HALF + n * 16) = acc[ai][bj][m][n]; }
    }
};
__device__ __forceinline__ void unpack8(const u32x4 g, float (&f)[8]) { f[0] = bf_lo(g.x); f[1] = bf_hi(g.x); f[2] = bf_lo(g.y); f[3] = bf_hi(g.y); f[4] = bf_lo(g.z); f[5] = bf_hi(g.z); f[6] = bf_lo(g.w); f[7] = bf_hi(g.w); }
struct EpiGateA {
    static constexpr bool PERM = true, AFTER_DRAIN = false;
    bf16_t* M1; const bf16_t* proj;
    __device__ __forceinline__ void operator()(const f32x4 (&acc)[2][2][4][2], const Unit& u, int wr, int wc, int fr, int fq) const {
        const int row0 = u.pm * BM + wr * 64 + fr, col0 = u.pn * BM + wc * 32 + 8 * fq;
#pragma unroll
        for (int ai = 0; ai < 2; ++ai)
#pragma unroll
            for (int m = 0; m < 4; ++m) { const size_t row = (size_t)(row0 + ai * HALF + m * 16);
#pragma unroll
                for (int bj = 0; bj < 2; ++bj) { const int col = col0 + bj * HALF; float g[8]; unpack8(*(const u32x4*)(proj + row * INCP + OFF_GA + col), g);
                    const f32x4 v0 = acc[ai][bj][m][0], v1 = acc[ai][bj][m][1];
                    u32x4 w; w.x = pk2(v0[0] * g[0], v0[1] * g[1]); w.y = pk2(v0[2] * g[2], v0[3] * g[3]); w.z = pk2(v1[0] * g[4], v1[1] * g[5]); w.w = pk2(v1[2] * g[6], v1[3] * g[7]);
                    *(u32x4*)(M1 + row * DM + col) = w; } }
    }
};
struct EpiGateB {
    static constexpr bool PERM = true, AFTER_DRAIN = false;
    const bf16_t* M1; const bf16_t* proj; bf16_t* O;
    __device__ __forceinline__ void operator()(const f32x4 (&acc)[2][2][4][2], const Unit& u, int wr, int wc, int fr, int fq) const {
        const int row0 = u.pm * BM + wr * 64 + fr, col0 = u.pn * BM + wc * 32 + 8 * fq;
#pragma unroll
        for (int ai = 0; ai < 2; ++ai)
#pragma unroll
            for (int m = 0; m < 4; ++m) { const size_t row = (size_t)(row0 + ai * HALF + m * 16);
#pragma unroll
                for (int bj = 0; bj < 2; ++bj) { const int col = col0 + bj * HALF; float g[8], b[8]; unpack8(*(const u32x4*)(proj + row * INCP + OFF_GB + col), g); unpack8(*(const u32x4*)(M1 + row * DM + col), b);
                    const f32x4 v0 = acc[ai][bj][m][0], v1 = acc[ai][bj][m][1];
                    u32x4 w; w.x = pk2(b[0] + v0[0] * g[0], b[1] + v0[1] * g[1]); w.y = pk2(b[2] + v0[2] * g[2], b[3] + v0[3] * g[3]);
                    w.z = pk2(b[4] + v1[0] * g[4], b[5] + v1[1] * g[5]); w.w = pk2(b[6] + v1[2] * g[6], b[7] + v1[3] * g[7]);
                    *(u32x4*)(O + row * DM + col) = w; } }
    }
};
struct EpiResid {
    static constexpr bool PERM = false, AFTER_DRAIN = false;
    const float* X; float* O;
    __device__ __forceinline__ void operator()(const f32x4 (&acc)[2][2][4][2], const Unit& u, int wr, int wc, int fr, int fq) const {
        const int row0 = u.pm * BM + wr * 64 + fr, col0 = u.pn * BM + wc * 32 + 4 * fq;
#pragma unroll
        for (int ai = 0; ai < 2; ++ai)
#pragma unroll
            for (int m = 0; m < 4; ++m) { const size_t off = (size_t)(row0 + ai * HALF + m * 16) * DM + col0;
#pragma unroll
                for (int bj = 0; bj < 2; ++bj)
#pragma unroll
                    for (int n = 0; n < 2; ++n) { const f32x4 b = *(const f32x4*)(X + off + bj * HALF + n * 16); *(f32x4*)(O + off + bj * HALF + n * 16) = b + acc[ai][bj][m][n]; } }
    }
};
struct EpiSwiglu {
    static constexpr bool PERM = true, AFTER_DRAIN = false;
    unsigned char* ACT; const float* b1; const float* row_rstd;
    __device__ __forceinline__ void operator()(const f32x4 (&acc)[2][2][4][2], const Unit& u, int wr, int wc, int fr, int fq) const {
        const int row0 = u.pm * BM + wr * 64 + fr, f0 = u.pn * HALF + wc * 32 + 8 * fq; const float* be = b1 + (size_t)u.e * 2048;
        const f32x4 bg0 = *(const f32x4*)(be + f0), bg1 = *(const f32x4*)(be + f0 + 4), bu0 = *(const f32x4*)(be + DFF + f0), bu1 = *(const f32x4*)(be + DFF + f0 + 4);
#pragma unroll
        for (int ai = 0; ai < 2; ++ai)
#pragma unroll
            for (int m = 0; m < 4; ++m) { const size_t row = (size_t)(row0 + ai * HALF + m * 16); float o[8]; const float rs = row_rstd[u.rb + wr * 64 + fr + ai * HALF + m * 16] * W8_INV;
#pragma unroll
                for (int n = 0; n < 2; ++n) { const f32x4 g4 = acc[ai][0][m][n] * rs + (n ? bg1 : bg0), u4 = acc[ai][1][m][n] * rs + (n ? bu1 : bu0);
#pragma unroll
                    for (int j = 0; j < 4; ++j) { const float g = fminf(g4[j], 7.f), uu = fminf(fmaxf(u4[j], -7.f), 7.f); o[4 * n + j] = (uu + 1.f) * (g * sigmoidf_(1.702f * g)); } }
                u32x2 w; w.x = pk4_fp8(o[0], o[1], o[2], o[3]); w.y = pk4_fp8(o[4], o[5], o[6], o[7]); *(u32x2*)(ACT + row * DFF + f0) = w; }
    }
};
struct EpiMoeOut {
    static constexpr bool PERM = true, AFTER_DRAIN = false;
    bf16_t* YS; const float* b2; const float* row_w; const int* row_slot;
    __device__ __forceinline__ void operator()(const f32x4 (&acc)[2][2][4][2], const Unit& u, int wr, int wc, int fr, int fq) const {
        const int row0 = u.pm * BM + wr * 64 + fr, col0 = u.pn * BM + wc * 32 + 8 * fq; const float* be = b2 + (size_t)u.e * DM;
        f32x4 bv[2][2];
#pragma unroll
        for (int bj = 0; bj < 2; ++bj)
#pragma unroll
            for (int n = 0; n < 2; ++n) bv[bj][n] = *(const f32x4*)(be + col0 + bj * HALF + 4 * n);
#pragma unroll
        for (int ai = 0; ai < 2; ++ai)
#pragma unroll
            for (int m = 0; m < 4; ++m) { const int row = u.rb + wr * 64 + fr + ai * HALF + m * 16; const int slot = row_slot[row]; const float w = row_w[row];
                if (slot >= 0) { bf16_t* rowp = YS + (size_t)slot * DM + col0;
#pragma unroll
                    for (int bj = 0; bj < 2; ++bj) { const f32x4 v0 = (acc[ai][bj][m][0] * W8_INV + bv[bj][0]) * w, v1 = (acc[ai][bj][m][1] * W8_INV + bv[bj][1]) * w;
                        u32x4 o; o.x = pk2(v0[0], v0[1]); o.y = pk2(v0[2], v0[3]); o.z = pk2(v1[0], v1[1]); o.w = pk2(v1[2], v1[3]); *(u32x4*)(rowp + bj * HALF) = o; } } }
    }
};
constexpr int MOE_MAXU = 12;
struct MoeOrder {
    StaticOrder so; const PG8_LAS int* utab; const PG8_LAS int* gtab;
    __device__ __forceinline__ bool next(int i, Unit& u) const { if (i >= MOE_MAXU || !so.next(i, u)) return false; const int v = __builtin_amdgcn_readfirstlane(utab[i]); u.e = v & 31; u.rb = (int)((unsigned)v >> 8); return true; }
    __device__ __forceinline__ void a_ready(const Unit&) const {}
    __device__ __forceinline__ void done(const Unit&) const {}
};
typedef int i32x4_t __attribute__((ext_vector_type(4))); typedef int i32x8_t __attribute__((ext_vector_type(8)));
__device__ __forceinline__ i32x8_t cat8(bf16x8 lo, bf16x8 hi) { return __builtin_shufflevector(__builtin_bit_cast(i32x4_t, lo), __builtin_bit_cast(i32x4_t, hi), 0, 1, 2, 3, 4, 5, 6, 7); }
__device__ __forceinline__ void mfma_fp8_inplace(f32x4& c, const i32x8_t a, const i32x8_t b) { asm volatile("s_nop 1\n\tv_mfma_f32_16x16x128_f8f6f4 %0, %1, %2, %0" : "+v"(c) : "v"(a), "v"(b)); }
__device__ __forceinline__ void mfma_fp8_drain() { asm volatile("s_nop 15\n\ts_nop 7" ::: "memory"); __builtin_amdgcn_sched_barrier(0); }
template <class Epi, class Sched, bool ALIGN_EPI = false, bool SP2 = false, bool FP8 = false, bool GATHER = false>
__device__ __forceinline__ void gemm_phase(PG8_LAS unsigned char* lds, const Gemm g, const Sched& S, const Epi& E) {
    const int tid = threadIdx.x, wid = __builtin_amdgcn_readfirstlane(tid >> 6), lane = tid & 63, wr = wid >> 2, wc = wid & 3, fr = lane & 15, fq = lane >> 4;
    const int K = g.K, nt = K / BK;
    static_assert(!GATHER || SP2, "GATHER is implemented for the SP2 loop only");
    unsigned voffA[2], voffB[2]; int gR0 = 0; unsigned gC = 0u;
#pragma unroll
    for (int i = 0; i < 2; ++i) { int R, C; stage_rc(tid * 16 + i * 8192, R, C); const int Rb = Epi::PERM ? ((R & ~31) + perm32(R & 31)) : R;
        voffA[i] = (unsigned)(R * K + C) * 2u; voffB[i] = (unsigned)(Rb * K + C) * 2u; if (i == 0) { gR0 = R; gC = (unsigned)C * 2u; } }
    unsigned gA[2][2] = {{0u, 0u}, {0u, 0u}}, ngA[2][2] = {{0u, 0u}, {0u, 0u}};
#define PG8_GLOAD(dst, ui_) do { _Pragma("unroll") for (int h_ = 0; h_ < 2; ++h_) _Pragma("unroll") for (int i_ = 0; i_ < 2; ++i_) \
        dst[h_][i_] = (unsigned)S.gtab[(ui_) * 256 + 128 * h_ + gR0 + 64 * i_] * ((unsigned)K * 2u) + gC; } while (0)
#define PG8_VA(h) (GATHER ? gA[h] : voffA)
    const unsigned kstep = (unsigned)(BK * 2);
    const unsigned hstep = (unsigned)HALF * (unsigned)K * 2u;
    const unsigned tstep = 2u * hstep;
    const unsigned hsA = GATHER ? 0u : hstep;
    const unsigned ldsw = (unsigned)wid * 1024u;
    const int aoff = lds_byte(wr * 64 + fr, fq * 8), boff = lds_byte(wc * 32 + fr, fq * 8);
#define PG8_SA(b, h) (((b) * 2 + (h)) * HTB)
#define PG8_SB(b, h) ((4 + (b) * 2 + (h)) * HTB)
#define PG8_STAGE(rs, bufoff, goff, voff) do { _Pragma("unroll") for (int _i = 0; _i < 2; ++_i) \
        __builtin_amdgcn_raw_ptr_buffer_load_lds(rs, (PG8_LAS void*)(lds + (bufoff) + ldsw + _i * 8192), 16, (int)(voff)[_i], (int)(goff), 0, 0); } while (0)
#define PG8_LDA(dst, b, h) do { _Pragma("unroll") for (int m = 0; m < 4; ++m) _Pragma("unroll") for (int k = 0; k < 2; ++k) dst[m][k] = *(const PG8_LAS bf16x8*)(lds + PG8_SA(b, h) + aoff + m * 2048 + k * 1024); } while (0)
#define PG8_LDB(dst, b, h) do { _Pragma("unroll") for (int n = 0; n < 2; ++n) _Pragma("unroll") for (int k = 0; k < 2; ++k) dst[n][k] = *(const PG8_LAS bf16x8*)(lds + PG8_SB(b, h) + boff + n * 2048 + k * 1024); } while (0)
#define PG8_MMA(ai, bj, At, Bt) do { __builtin_amdgcn_s_setprio(1); _Pragma("unroll") for (int m = 0; m < 4; ++m) _Pragma("unroll") for (int n = 0; n < 2; ++n) { \
        if constexpr (FP8) { mfma_fp8_inplace(acc[ai][bj][m][n], cat8(Bt[n][0], Bt[n][1]), cat8(At[m][0], At[m][1])); } \
        else { _Pragma("unroll") for (int k = 0; k < 2; ++k) acc[ai][bj][m][n] = __builtin_amdgcn_mfma_f32_16x16x32_bf16(Bt[n][k], At[m][k], acc[ai][bj][m][n], 0, 0, 0); } } \
        __builtin_amdgcn_s_setprio(0); } while (0)
#define PG8_WAIT_V(n) asm volatile("s_waitcnt vmcnt(" #n ")" ::: "memory")
#define PG8_WAIT_L(n) asm volatile("s_waitcnt lgkmcnt(" #n ")" ::: "memory")
#define PG8_BAR __builtin_amdgcn_s_barrier()
#define PG8_SCHED __builtin_amdgcn_sched_barrier(0)
    Unit cur, nxt; int ui = 0;
    if (!S.next(0, cur)) return;
    f32x4 acc[2][2][4][2];
#pragma unroll
    for (int a = 0; a < 2; ++a)
#pragma unroll
        for (int b = 0; b < 2; ++b)
#pragma unroll
            for (int m = 0; m < 4; ++m)
#pragma unroll
                for (int n = 0; n < 2; ++n) acc[a][b][m][n] = (f32x4){0.f, 0.f, 0.f, 0.f};
    bf16x8 At[4][2], B0[2][2], B1[2][2];
    unsigned cA = GATHER ? 0u : (unsigned)cur.pm * tstep, cB = (unsigned)cur.e * (unsigned)g.bstride + (unsigned)cur.pn * tstep;
    const __amdgpu_buffer_rsrc_t rsA = __builtin_amdgcn_make_buffer_rsrc((void*)g.A, 0, 0x7fffffff, 0x00020000), rsB = __builtin_amdgcn_make_buffer_rsrc((void*)g.Bt, 0, 0x7fffffff, 0x00020000);
    S.a_ready(cur);
    if constexpr (GATHER) PG8_GLOAD(gA, 0);
    if constexpr (SP2) {
        PG8_STAGE(rsB, PG8_SB(0, 0), cB, voffB); PG8_STAGE(rsB, PG8_SB(0, 1), cB + hstep, voffB); PG8_STAGE(rsA, PG8_SA(0, 0), cA, PG8_VA(0)); PG8_STAGE(rsA, PG8_SA(0, 1), cA + hsA, PG8_VA(1));
        if (wr == 1) PG8_BAR;
        PG8_WAIT_V(2); PG8_BAR;
        PG8_STAGE(rsB, PG8_SB(1, 0), cB + kstep, voffB); PG8_STAGE(rsA, PG8_SA(1, 0), cA + kstep, PG8_VA(0)); PG8_STAGE(rsB, PG8_SB(1, 1), cB + hstep + kstep, voffB);
        PG8_WAIT_V(6); PG8_BAR;
    } else {
        PG8_STAGE(rsB, PG8_SB(0, 0), cB, voffB); PG8_STAGE(rsA, PG8_SA(0, 0), cA, PG8_VA(0)); PG8_STAGE(rsB, PG8_SB(0, 1), cB + hstep, voffB); PG8_STAGE(rsA, PG8_SA(0, 1), cA + hsA, PG8_VA(1));
        if (wr == 1) PG8_BAR;
        PG8_WAIT_V(4); PG8_BAR;
        PG8_STAGE(rsB, PG8_SB(1, 0), cB + kstep, voffB); PG8_STAGE(rsA, PG8_SA(1, 0), cA + kstep, PG8_VA(0)); PG8_STAGE(rsB, PG8_SB(1, 1), cB + hstep + kstep, voffB);
        PG8_WAIT_V(6); PG8_BAR;
    }
    for (;;) {
        const bool has_next = S.next(ui + 1, nxt);
        if constexpr (GATHER) { if (has_next) PG8_GLOAD(ngA, ui + 1); else { ngA[0][0] = gA[0][0]; ngA[0][1] = gA[0][1]; ngA[1][0] = gA[1][0]; ngA[1][1] = gA[1][1]; } }
        const unsigned nA = (has_next && !GATHER) ? (unsigned)nxt.pm * tstep : cA, nB = has_next ? (unsigned)nxt.e * (unsigned)g.bstride + (unsigned)nxt.pn * tstep : cB;
        for (int t = 0; t < nt; t += 2) {
            const bool last = (t == nt - 2);
            const unsigned a1 = cA + (unsigned)(t + 1) * kstep;
            const unsigned a2 = last ? nA : cA + (unsigned)(t + 2) * kstep, b2 = last ? nB : cB + (unsigned)(t + 2) * kstep;
            const unsigned a3 = a2 + kstep, b3 = b2 + kstep;
            if (last && has_next) S.a_ready(nxt);
            if constexpr (SP2) {
            PG8_LDB(B0, 0, 0); PG8_LDB(B1, 0, 1); PG8_SCHED; PG8_LDA(At, 0, 0); PG8_STAGE(rsA, PG8_SA(1, 1), a1 + hsA, PG8_VA(1));
            if constexpr (GATHER) { if (last) { gA[0][0] = ngA[0][0]; gA[0][1] = ngA[0][1]; gA[1][0] = ngA[1][0]; gA[1][1] = ngA[1][1]; } }
            PG8_WAIT_V(8); PG8_WAIT_L(0); PG8_BAR; PG8_MMA(0, 0, At, B0); PG8_MMA(0, 1, At, B1); PG8_BAR; PG8_SCHED;
            PG8_LDA(At, 0, 1); PG8_STAGE(rsB, PG8_SB(0, 0), b2, voffB); PG8_STAGE(rsB, PG8_SB(0, 1), b2 + hstep, voffB); PG8_STAGE(rsA, PG8_SA(0, 0), a2, PG8_VA(0));
            PG8_WAIT_V(8); PG8_WAIT_L(0); PG8_BAR; PG8_MMA(1, 0, At, B0); PG8_MMA(1, 1, At, B1); PG8_BAR; PG8_SCHED;
            PG8_LDB(B0, 1, 0); PG8_LDB(B1, 1, 1); PG8_SCHED; PG8_LDA(At, 1, 0); PG8_STAGE(rsA, PG8_SA(0, 1), a2 + hsA, PG8_VA(1));
            PG8_WAIT_V(8); PG8_WAIT_L(0); PG8_BAR; PG8_MMA(0, 0, At, B0); PG8_MMA(0, 1, At, B1); PG8_BAR; PG8_SCHED;
            PG8_LDA(At, 1, 1); PG8_STAGE(rsB, PG8_SB(1, 0), b3, voffB); PG8_STAGE(rsB, PG8_SB(1, 1), b3 + hstep, voffB); PG8_STAGE(rsA, PG8_SA(1, 0), a3, PG8_VA(0));
            PG8_WAIT_V(8); PG8_WAIT_L(0); PG8_BAR; PG8_MMA(1, 0, At, B0); PG8_MMA(1, 1, At, B1); PG8_BAR; PG8_SCHED;
            } else {
            PG8_LDB(B0, 0, 0); PG8_SCHED; PG8_LDA(At, 0, 0); PG8_STAGE(rsA, PG8_SA(1, 1), a1 + hsA, PG8_VA(1));
            PG8_WAIT_L(8); PG8_BAR; PG8_WAIT_L(0); PG8_MMA(0, 0, At, B0); PG8_BAR; PG8_SCHED;
            PG8_LDB(B1, 0, 1); PG8_STAGE(rsB, PG8_SB(0, 0), b2, voffB);
            PG8_BAR; PG8_WAIT_L(0); PG8_MMA(0, 1, At, B1); PG8_BAR;
            PG8_LDA(At, 0, 1); PG8_STAGE(rsA, PG8_SA(0, 0), a2, PG8_VA(0));
            PG8_BAR; PG8_WAIT_L(0); PG8_MMA(1, 0, At, B0); PG8_BAR; PG8_SCHED;
            PG8_STAGE(rsB, PG8_SB(0, 1), b2 + hstep, voffB);
            PG8_WAIT_V(6); PG8_BAR; PG8_MMA(1, 1, At, B1); PG8_BAR;
            PG8_LDB(B0, 1, 0); PG8_SCHED; PG8_LDA(At, 1, 0); PG8_STAGE(rsA, PG8_SA(0, 1), a2 + hsA, PG8_VA(1));
            PG8_WAIT_L(8); PG8_BAR; PG8_WAIT_L(0); PG8_MMA(0, 0, At, B0); PG8_BAR; PG8_SCHED;
            PG8_LDB(B1, 1, 1); PG8_STAGE(rsB, PG8_SB(1, 0), b3, voffB);
            PG8_BAR; PG8_WAIT_L(0); PG8_MMA(0, 1, At, B1); PG8_BAR;
            PG8_LDA(At, 1, 1); PG8_STAGE(rsA, PG8_SA(1, 0), a3, PG8_VA(0));
            PG8_BAR; PG8_WAIT_L(0); PG8_MMA(1, 0, At, B0); PG8_BAR; PG8_SCHED;
            PG8_STAGE(rsB, PG8_SB(1, 1), b3 + hstep, voffB);
            PG8_WAIT_V(6); PG8_BAR; PG8_MMA(1, 1, At, B1); PG8_BAR;
            }
        }
        if constexpr (ALIGN_EPI) { if (wr == 0) PG8_BAR; }
        if constexpr (FP8) mfma_fp8_drain();
        if constexpr (!Epi::AFTER_DRAIN) { E(acc, cur, wr, wc, fr, fq); S.done(cur); }
        if (!has_next) break;
#pragma unroll
        for (int a = 0; a < 2; ++a)
#pragma unroll
            for (int b = 0; b < 2; ++b)
#pragma unroll
                for (int m = 0; m < 4; ++m)
#pragma unroll
                    for (int n = 0; n < 2; ++n) acc[a][b][m][n] = (f32x4){0.f, 0.f, 0.f, 0.f};
        cur = nxt; cA = nA; cB = nB; ++ui;
        if constexpr (ALIGN_EPI) { if (wr == 1) PG8_BAR; }
    }
    PG8_WAIT_V(0);
    if constexpr (!ALIGN_EPI) { if (wr == 0) PG8_BAR; }
    PG8_BAR;
    if constexpr (Epi::AFTER_DRAIN) { E.fused(acc, cur, wr, wc, fr, fq, lds, wid, lane); S.done(cur); }
#undef PG8_SA
#undef PG8_GLOAD
#undef PG8_VA
#undef PG8_SB
#undef PG8_STAGE
#undef PG8_LDA
#undef PG8_LDB
#undef PG8_MMA
#undef PG8_WAIT_V
#undef PG8_WAIT_L
#undef PG8_BAR
#undef PG8_SCHED
}
}

#define GAS __attribute__((address_space(1)))
#define LAS __attribute__((address_space(3)))
#define XB_TMO      128
#define XB_XCNT(j)  (256  + 64 * (j))
#define XB_XSUB(j)  (1280 + 64 * (j))
#define XB_XGEN(j)  (2304 + 64 * (j))
#define XB_TOP      3328
#define XB_TOPGEN   3392
#define XCD_BAR_WORDS 3456
#define XB_SPIN_CAP (1u << 18)

__device__ __forceinline__ unsigned xb_ld(unsigned* p)              { return __hip_atomic_load(p, __ATOMIC_RELAXED, __HIP_MEMORY_SCOPE_AGENT); }
__device__ __forceinline__ unsigned xb_add(unsigned* p, unsigned v) { return __hip_atomic_fetch_add(p, v, __ATOMIC_RELAXED, __HIP_MEMORY_SCOPE_AGENT); }
__device__ __forceinline__ unsigned xb_xcc_id() { return (unsigned)__builtin_amdgcn_s_getreg((3 << 11) | 20) & 0xFu; }
#define XB_SPIN(cond, bar) do { unsigned _sp = 0; while (cond) { __builtin_amdgcn_s_sleep(1); \
    if ((++_sp & 255u) == 0u) { if (xb_ld(&(bar)[XB_TMO])) break; if (_sp > XB_SPIN_CAP) { atomicAdd(&(bar)[XB_TMO], 1u); break; } } } } while (0)

struct XcdBarrier {
    unsigned* bar; unsigned x;
    volatile LAS unsigned* st;
};

__device__ __forceinline__ XcdBarrier xcd_barrier_post(unsigned* bar, volatile LAS unsigned* st) {
    XcdBarrier b; b.bar = bar; b.x = xb_xcc_id(); b.st = st;
    if (threadIdx.x == 0) (void)xb_add(&bar[XB_XCNT(b.x)], 1u);
    return b;
}
__device__ __forceinline__ void xcd_barrier_complete(unsigned* bar, unsigned x, unsigned& nloc, unsigned& nx) {
    const unsigned G = gridDim.x * gridDim.y * gridDim.z;
    unsigned sum, cnt, mine, sp = 0u;
    for (;;) {
        sum = 0u; cnt = 0u; mine = 0u;
#pragma unroll
        for (unsigned j = 0; j < 16; ++j) { const unsigned c = xb_ld(&bar[XB_XCNT(j)]); sum += c; cnt += (c > 0u) ? 1u : 0u; mine = (j == x) ? c : mine; }
        if (sum == G) break;
        __builtin_amdgcn_s_sleep(1);
        if ((++sp & 255u) == 0u) { if (xb_ld(&bar[XB_TMO])) break; if (sp > XB_SPIN_CAP) { atomicAdd(&bar[XB_TMO], 1u); break; } }
    }
    nloc = mine > 0u ? mine : 1u; nx = cnt > 0u ? cnt : 1u;
}

__device__ __forceinline__ void xcd_barrier(const XcdBarrier& b) {
    asm volatile("s_waitcnt vmcnt(0)" ::: "memory");
    __syncthreads();
    if (threadIdx.x == 0) {
        unsigned* bar = b.bar;
        __builtin_amdgcn_s_waitcnt(0);
        unsigned nloc = b.st[0], nx = b.st[1];
        if (nloc == 0u) { xcd_barrier_complete(bar, b.x, nloc, nx); b.st[0] = nloc; b.st[1] = nx; }
        const unsigned old = xb_add(&bar[XB_XSUB(b.x)], 1u);
        const unsigned gen = old / nloc;
        if (old + 1u == (gen + 1u) * nloc) {
            __builtin_amdgcn_fence(__ATOMIC_RELEASE, "agent");
            asm volatile("s_waitcnt vmcnt(0)" ::: "memory");
            const unsigned og = xb_add(&bar[XB_TOP], 1u);
            const unsigned tg = og / nx;
            if (og + 1u == (tg + 1u) * nx) xb_add(&bar[XB_TOPGEN], 1u);
            else XB_SPIN(xb_ld(&bar[XB_TOPGEN]) == tg, bar);
            __builtin_amdgcn_fence(__ATOMIC_ACQUIRE, "agent");
            xb_add(&bar[XB_XGEN(b.x)], 1u);
            asm volatile("s_waitcnt vmcnt(0)" ::: "memory");
        } else {
            XB_SPIN(xb_ld(&bar[XB_XGEN(b.x)]) == gen, bar);
            __builtin_amdgcn_fence(__ATOMIC_ACQUIRE, "agent");
            asm volatile("s_waitcnt vmcnt(0)" ::: "memory");
        }
    }
    __syncthreads();
}

template <int MODE  >
__device__ __forceinline__ void transpose_item(const float* __restrict__ W, int K, int N, bf16_t* __restrict__ WT, const float* __restrict__ gain, float* scr, int item, int lane) {
    const int nblk = N / 32, kb = item / nblk, nb = item % nblk, k0 = 64 * kb, n0 = 32 * nb;
#pragma unroll
    for (int i = 0; i < 8; ++i) { const int kk = 8 * i + (lane >> 3), n4 = (lane & 7) * 4; f32x4 v = *(const f32x4*)(W + (size_t)(k0 + kk) * N + n0 + n4);
        if (gain) { const float g = gain[k0 + kk]; v = v * g; }
        float* s = scr + kk * 33 + n4; s[0] = v[0]; s[1] = v[1]; s[2] = v[2]; s[3] = v[3]; }
    asm volatile("s_waitcnt lgkmcnt(0)" ::: "memory");
    const int c = lane & 7;
#pragma unroll
    for (int j = 0; j < 4; ++j) { const int n = (lane >> 3) + 8 * j; const float* s = scr + (8 * c) * 33 + n;
        u32x4 o; o.x = pk2(s[0 * 33], s[1 * 33]); o.y = pk2(s[2 * 33], s[3 * 33]); o.z = pk2(s[4 * 33], s[5 * 33]); o.w = pk2(s[6 * 33], s[7 * 33]);
        int row = n0 + n;
        if (MODE == 1) { const int f = row & 1023; row = ((f >> 7) << 8) + ((row >> 10) << 7) + (f & 127); }
        *(u32x4*)(WT + (size_t)row * K + k0 + 8 * c) = o; }
    asm volatile("s_waitcnt lgkmcnt(0)" ::: "memory");
}
template <int MODE>
__device__ __forceinline__ void transpose_item_fp8(const float* __restrict__ W, int K, int N, unsigned char* __restrict__ WT, float* scr, int item, int lane) {
    const int nblk = N / 32, kb = item / nblk, nb = item % nblk, k0 = 64 * kb, n0 = 32 * nb;
#pragma unroll
    for (int i = 0; i < 8; ++i) { const int kk = 8 * i + (lane >> 3), n4 = (lane & 7) * 4; const f32x4 v = *(const f32x4*)(W + (size_t)(k0 + kk) * N + n0 + n4) * W8_SCALE;
        float* s = scr + kk * 33 + n4; s[0] = v[0]; s[1] = v[1]; s[2] = v[2]; s[3] = v[3]; }
    asm volatile("s_waitcnt lgkmcnt(0)" ::: "memory");
    const int c = lane & 7;
#pragma unroll
    for (int j = 0; j < 4; ++j) { const int n = (lane >> 3) + 8 * j; const float* s = scr + (8 * c) * 33 + n;
        u32x2 o; o.x = pk4_fp8(s[0 * 33], s[1 * 33], s[2 * 33], s[3 * 33]); o.y = pk4_fp8(s[4 * 33], s[5 * 33], s[6 * 33], s[7 * 33]);
        int row = n0 + n;
        if (MODE == 1) { const int f = row & 1023; row = ((f >> 7) << 8) + ((row >> 10) << 7) + (f & 127); }
        *(u32x2*)(WT + (size_t)row * K + k0 + 8 * c) = o; }
    asm volatile("s_waitcnt lgkmcnt(0)" ::: "memory");
}
__device__ __forceinline__ void phase_prologue(const Params& p, unsigned char* lds) {
    const int tid = threadIdx.x, lane = tid & 63, wave = tid >> 6;
    float* scr = (float*)(lds + wave * 16384);
    const int gw = blockIdx.x * NWAVES + wave, NGW = gridDim.x * NWAVES;
    unsigned char* ws = p.ws;
    constexpr int I_WIN = (DM / 64) * (INC / 32), I_UQ = (QLORA / 64) * (768 / 32), I_UKV = (KVLORA / 64) * (1024 / 32), I_OM = (512 / 64) * (DM / 32), I_OC = I_OM, I_WO = (DM / 64) * (DM / 32);
    constexpr int I_W1 = (DM / 64) * (2048 / 32), I_W2 = (DFF / 64) * (DM / 32);
    constexpr int NSMALL = I_WIN + I_UQ + I_UKV + I_OM + I_OC + I_WO;
    constexpr int NITEMS = NSMALL + NE * (I_W1 + I_W2);
    for (int it = gw; it < NITEMS; it += NGW) {
        int r = it;
        if (r < I_WIN) { transpose_item<0>(p.w_in, DM, INC, (bf16_t*)(ws + WS_WIN), p.norm1_g, scr, r, lane); continue; } r -= I_WIN;
        if (r < I_UQ) { transpose_item<0>(p.w_uq, QLORA, 768, (bf16_t*)(ws + WS_WUQ), p.q_a_g, scr, r, lane); continue; } r -= I_UQ;
        if (r < I_UKV) { transpose_item<0>(p.w_ukv, KVLORA, 1024, (bf16_t*)(ws + WS_WUKV), p.kv_a_g, scr, r, lane); continue; } r -= I_UKV;
        if (r < I_OM) { transpose_item<0>(p.w_o_mla, 512, DM, (bf16_t*)(ws + WS_WOMLA), nullptr, scr, r, lane); continue; } r -= I_OM;
        if (r < I_OC) { transpose_item<0>(p.w_o_conv, 512, DM, (bf16_t*)(ws + WS_WOCONV), nullptr, scr, r, lane); continue; } r -= I_OC;
        if (r < I_WO) { transpose_item<0>(p.w_o, DM, DM, (bf16_t*)(ws + WS_WO), nullptr, scr, r, lane); continue; } r -= I_WO;
        const int e = r / (I_W1 + I_W2); r -= e * (I_W1 + I_W2);
        if (r < I_W1) transpose_item_fp8<1>(p.w1 + (size_t)e * DM * 2048, DM, 2048, ws + WS_W1 + (size_t)e * 2048 * DM, scr, r, lane);
        else transpose_item_fp8<0>(p.w2 + (size_t)e * DFF * DM, DFF, DM, ws + WS_W2 + (size_t)e * DM * DFF, scr, r - I_W1, lane);
    }
    { u32x4* z = (u32x4*)((bf16_t*)(ws + WS_WIN) + (size_t)INC * DM); const int nz = (INCP - INC) * DM * 2 / 16;
      for (int i = blockIdx.x * NTHREADS + tid; i < nz; i += gridDim.x * NTHREADS) z[i] = (u32x4){0u, 0u, 0u, 0u}; }
    { int* rt = (int*)(ws + WS_RT2); int* rs = (int*)(ws + WS_RT2 + 4 * MiB); float* rr = (float*)(ws + WS_RT2 + 6 * MiB);
      for (int i = blockIdx.x * NTHREADS + tid; i < NE * CAP; i += gridDim.x * NTHREADS) { rt[i] = 0; rs[i] = -1; rr[i] = 0.f; } }
    { u32x4* GF = (u32x4*)(ws + WS_GF);
      for (int i = blockIdx.x * NTHREADS + tid; i < 64 * 64; i += gridDim.x * NTHREADS) { const int ks = i >> 6, ln = i & 63, r = ln & 31, h = ln >> 5; float v[8], lo[8]; unsigned hi[4];
#pragma unroll
          for (int j = 0; j < 8; ++j) { const int k = 16 * ks + 8 * h + j; v[j] = p.norm2_g[k] * p.router_w[(size_t)k * NE + r]; }
#pragma unroll
          for (int j = 0; j < 4; ++j) { hi[j] = pk2(v[2 * j], v[2 * j + 1]); lo[2 * j] = v[2 * j] - bf_lo(hi[j]); lo[2 * j + 1] = v[2 * j + 1] - bf_hi(hi[j]); }
          GF[(ks * 2 + 0) * 64 + ln] = (u32x4){hi[0], hi[1], hi[2], hi[3]}; GF[(ks * 2 + 1) * 64 + ln] = (u32x4){pk2(lo[0], lo[1]), pk2(lo[2], lo[3]), pk2(lo[4], lo[5]), pk2(lo[6], lo[7])}; } }
    bf16_t* XN = (bf16_t*)(ws + WS_XN);
    for (int m = gw; m < NTOK; m += NGW) {
        const f32x4* xr = (const f32x4*)(p.x + (size_t)m * DM) + lane; f32x4 v[4]; float s = 0.f;
#pragma unroll
        for (int j = 0; j < 4; ++j) { v[j] = xr[64 * j]; s += (v[j][0] * v[j][0] + v[j][1] * v[j][1]) + (v[j][2] * v[j][2] + v[j][3] * v[j][3]); }
        const float rstd = rsqrtf(wave_sum(s) * (1.f / DM) + EPS);
        u32x2* o = (u32x2*)(XN + (size_t)m * DM) + lane;
#pragma unroll
        for (int j = 0; j < 4; ++j) { u32x2 w; w.x = pk2(v[j][0] * rstd, v[j][1] * rstd); w.y = pk2(v[j][2] * rstd, v[j][3] * rstd); o[64 * j] = w; }
    }
}

__device__ __forceinline__ void phase_tok_a(const Params& p) {
    const int tid = threadIdx.x, lane = tid & 63, wave = tid >> 6;
    const int gw = blockIdx.x * NWAVES + wave, NGW = gridDim.x * NWAVES;
    const bf16_t* PROJ = (const bf16_t*)(p.ws + WS_PROJ); bf16_t* CQN = (bf16_t*)(p.ws + WS_CQN); bf16_t* CKVN = (bf16_t*)(p.ws + WS_CKVN); bf16_t* YB = (bf16_t*)(p.ws + WS_YBIN);
    float cw0[8], cw1[8], cw2[8];
#pragma unroll
    for (int j = 0; j < 8; ++j) { cw0[j] = p.conv_w[8 * lane + j]; cw1[j] = p.conv_w[CONVW + 8 * lane + j]; cw2[j] = p.conv_w[2 * CONVW + 8 * lane + j]; }
    for (int t = gw; t < NTOK; t += NGW) {
        const bf16_t* pr = PROJ + (size_t)t * INCP;
        { const u32x2 w = *(const u32x2*)(pr + OFF_CQ + 4 * lane); const float a = bf_lo(w.x), b = bf_hi(w.x), c = bf_lo(w.y), d = bf_hi(w.y);
          const float rstd = rsqrtf(wave_sum(a * a + b * b + c * c + d * d) * (1.f / QLORA) + EPS);
          u32x2 o; o.x = pk2(a * rstd, b * rstd); o.y = pk2(c * rstd, d * rstd); *(u32x2*)(CQN + (size_t)t * QLORA + 4 * lane) = o; }
        { const unsigned w = *(const unsigned*)(pr + OFF_CKV + 2 * lane); const float a = bf_lo(w), b = bf_hi(w);
          const float rstd = rsqrtf(wave_sum(a * a + b * b) * (1.f / KVLORA) + EPS);
          *(unsigned*)(CKVN + (size_t)t * KVLORA + 2 * lane) = pk2(a * rstd, b * rstd); }
        { const int s = t & (SEQ - 1); float cu[3][8];
#pragma unroll
          for (int d = 0; d < 3; ++d) { const int ss = s + d - 1; if (ss >= 0 && ss < SEQ) { const bf16_t* q = pr + (ptrdiff_t)(d - 1) * INCP; const u32x4 u = *(const u32x4*)(q + OFF_U + 8 * lane), c = *(const u32x4*)(q + OFF_C + 8 * lane);
                  cu[d][0] = bf_lo(u.x) * bf_lo(c.x); cu[d][1] = bf_hi(u.x) * bf_hi(c.x); cu[d][2] = bf_lo(u.y) * bf_lo(c.y); cu[d][3] = bf_hi(u.y) * bf_hi(c.y);
                  cu[d][4] = bf_lo(u.z) * bf_lo(c.z); cu[d][5] = bf_hi(u.z) * bf_hi(c.z); cu[d][6] = bf_lo(u.w) * bf_lo(c.w); cu[d][7] = bf_hi(u.w) * bf_hi(c.w); }
              else {
#pragma unroll
                  for (int j = 0; j < 8; ++j) cu[d][j] = 0.f; } }
          const u32x4 bg = *(const u32x4*)(pr + OFF_B + 8 * lane); float bb[8] = {bf_lo(bg.x), bf_hi(bg.x), bf_lo(bg.y), bf_hi(bg.y), bf_lo(bg.z), bf_hi(bg.z), bf_lo(bg.w), bf_hi(bg.w)}; float y[8];
#pragma unroll
          for (int j = 0; j < 8; ++j) y[j] = bb[j] * (cw0[j] * cu[0][j] + cw1[j] * cu[1][j] + cw2[j] * cu[2][j]);
          u32x4 o; o.x = pk2(y[0], y[1]); o.y = pk2(y[2], y[3]); o.z = pk2(y[4], y[5]); o.w = pk2(y[6], y[7]); *(u32x4*)(YB + (size_t)t * CONVW + 8 * lane) = o; }
    }
}

constexpr float QSCALE = 0.10206207261596575f * 1.4426950408889634f;
__device__ __forceinline__ void phase_tok_b(const Params& p) {
    const int tid = threadIdx.x, lane = tid & 63, wave = tid >> 6, h = lane >> 3, sub = lane & 7;
    const int gw = blockIdx.x * NWAVES + wave, NGW = gridDim.x * NWAVES;
    const float* QPRE = (const float*)(p.ws + WS_QPRE); const float* KVPRE = (const float*)(p.ws + WS_KVPRE); const bf16_t* PROJ = (const bf16_t*)(p.ws + WS_PROJ);
    bf16_t* Q = (bf16_t*)(p.ws + WS_Q); bf16_t* Kb = (bf16_t*)(p.ws + WS_K); bf16_t* V = (bf16_t*)(p.ws + WS_V);
    float qg[12], kg[12];
#pragma unroll
    for (int j = 0; j < 8; ++j) { qg[j] = p.q_g[sub * 8 + j]; kg[j] = p.k_g[sub * 8 + j]; }
    qg[8] = p.q_g[64 + 2 * sub]; qg[9] = p.q_g[65 + 2 * sub]; qg[10] = p.q_g[80 + 2 * sub]; qg[11] = p.q_g[81 + 2 * sub];
    kg[8] = p.k_g[64 + 2 * sub]; kg[9] = p.k_g[65 + 2 * sub]; kg[10] = p.k_g[80 + 2 * sub]; kg[11] = p.k_g[81 + 2 * sub];
    const float if0 = exp2f(-(float)(2 * sub) * (13.287712379549449f / 16.f)), if1 = exp2f(-(float)(2 * sub + 1) * (13.287712379549449f / 16.f));
    for (int t = gw; t < NTOK; t += NGW) {
        const int b = t >> 13, s = t & (SEQ - 1); const float pos = (float)p.pos[t];
        float c0, s0, c1, s1; sincosf(pos * if0, &s0, &c0); sincosf(pos * if1, &s1, &c1);
        const size_t rowi = ((size_t)(b * NH + h) * SEQ + s);
        { const float* qp = QPRE + (size_t)t * 768 + h * DQK; const f32x4 a = *(const f32x4*)(qp + sub * 8), bq = *(const f32x4*)(qp + sub * 8 + 4); const f32x2 r1 = *(const f32x2*)(qp + 64 + 2 * sub), r2 = *(const f32x2*)(qp + 80 + 2 * sub);
          float v[12] = {a[0], a[1], a[2], a[3], bq[0], bq[1], bq[2], bq[3], r1[0], r1[1], r2[0], r2[1]}; float ss = 0.f;
#pragma unroll
          for (int j = 0; j < 12; ++j) ss += v[j] * v[j];
          ss += __shfl_xor(ss, 1); ss += __shfl_xor(ss, 2); ss += __shfl_xor(ss, 4);
          const float rstd = rsqrtf(ss * (1.f / DQK) + EPS);
#pragma unroll
          for (int j = 0; j < 12; ++j) v[j] *= rstd * qg[j] * QSCALE;
          const float o8 = v[8] * c0 - v[10] * s0, o9 = v[9] * c1 - v[11] * s1, o10 = v[8] * s0 + v[10] * c0, o11 = v[9] * s1 + v[11] * c1;
          bf16_t* qo = Q + rowi * DQK; u32x4 w; w.x = pk2(v[0], v[1]); w.y = pk2(v[2], v[3]); w.z = pk2(v[4], v[5]); w.w = pk2(v[6], v[7]);
          *(u32x4*)(qo + sub * 8) = w; *(unsigned*)(qo + 64 + 2 * sub) = pk2(o8, o9); *(unsigned*)(qo + 80 + 2 * sub) = pk2(o10, o11); }
        { const float* kp = KVPRE + (size_t)t * 1024 + h * 128; const f32x4 a = *(const f32x4*)(kp + sub * 8), bq = *(const f32x4*)(kp + sub * 8 + 4);
          const bf16_t* kr = PROJ + (size_t)t * INCP + OFF_KR; const unsigned w1 = *(const unsigned*)(kr + 2 * sub), w2 = *(const unsigned*)(kr + 16 + 2 * sub);
          float v[12] = {a[0], a[1], a[2], a[3], bq[0], bq[1], bq[2], bq[3], bf_lo(w1), bf_hi(w1), bf_lo(w2), bf_hi(w2)}; float ss = 0.f;
#pragma unroll
          for (int j = 0; j < 12; ++j) ss += v[j] * v[j];
          ss += __shfl_xor(ss, 1); ss += __shfl_xor(ss, 2); ss += __shfl_xor(ss, 4);
          const float rstd = rsqrtf(ss * (1.f / DQK) + EPS);
#pragma unroll
          for (int j = 0; j < 12; ++j) v[j] *= rstd * kg[j];
          const float o8 = v[8] * c0 - v[10] * s0, o9 = v[9] * c1 - v[11] * s1, o10 = v[8] * s0 + v[10] * c0, o11 = v[9] * s1 + v[11] * c1;
          bf16_t* ko = Kb + rowi * 128; u32x4 w; w.x = pk2(v[0], v[1]); w.y = pk2(v[2], v[3]); w.z = pk2(v[4], v[5]); w.w = pk2(v[6], v[7]);
          *(u32x4*)(ko + sub * 8) = w; *(unsigned*)(ko + 64 + 2 * sub) = pk2(o8, o9); *(unsigned*)(ko + 80 + 2 * sub) = pk2(o10, o11);
          if (sub < 4) *(u32x4*)(ko + 96 + sub * 8) = (u32x4){0u, 0u, 0u, 0u};
          const f32x4 va = *(const f32x4*)(kp + 64 + sub * 8), vb = *(const f32x4*)(kp + 64 + sub * 8 + 4);
          u32x4 wv; wv.x = pk2(va[0], va[1]); wv.y = pk2(va[2], va[3]); wv.z = pk2(vb[0], vb[1]); wv.w = pk2(vb[2], vb[3]); *(u32x4*)(V + rowi * DV + sub * 8) = wv; }
    }
}

namespace att {
constexpr int NW = 8, QBLK = 32, KVBLK = 64;
constexpr float SCALE = 0.10206207261596575f;
constexpr float QSC = SCALE * 1.4426950408889634f;
constexpr int LDQ = DQK, LDK = 128, LDV = DV;
constexpr int SHM_V = KVBLK * DV * 2, SHM_K = KVBLK * 256, SHM_ATTN = 2 * SHM_V + 2 * SHM_K + NW * 64 * 4;
#define KSWZ(row, colB) ((row) * 256 + ((colB) ^ (((row) & 7) << 4)))
#define SBAR() __builtin_amdgcn_sched_barrier(0)
__device__ __forceinline__ int crow(int r, int hi) { return (r & 3) + 8 * (r >> 2) + 4 * hi; }
__device__ __forceinline__ unsigned cvtpk(float lo, float hi) { unsigned r; asm volatile("v_cvt_pk_bf16_f32 %0, %1, %2" : "=v"(r) : "v"(lo), "v"(hi)); return r; }
#define EXPH(P) do { _Pragma("unroll") for (int r = 0; r < 16; ++r) P[r] = __builtin_amdgcn_exp2f(P[r]); } while (0)
__device__ __forceinline__ void finishSM(f32x16& p0, f32x16& p1, float& l_reg, bf16x8& pa0, bf16x8& pa1, bf16x8& pa2, bf16x8& pa3) {
    EXPH(p1);
    float ps0 = 0.f, ps1 = 0.f;
#pragma unroll
    for (int r = 0; r < 16; ++r) { ps0 += p0[r]; ps1 += p1[r]; }
    l_reg += ps0 + ps1;
#define PK4(P, BASE, OUT) do { unsigned a0 = cvtpk(P[BASE + 0], P[BASE + 1]), a1 = cvtpk(P[BASE + 2], P[BASE + 3]);   \
    unsigned b0 = cvtpk(P[BASE + 4], P[BASE + 5]), b1 = cvtpk(P[BASE + 6], P[BASE + 7]);                              \
    auto r0 = __builtin_amdgcn_permlane32_swap(a0, b0, false, false); auto r1 = __builtin_amdgcn_permlane32_swap(a1, b1, false, false); \
    u32x4 w = {r0[0], r1[0], r0[1], r1[1]}; OUT = *reinterpret_cast<bf16x8*>(&w); } while (0)
    PK4(p0, 0, pa0); PK4(p0, 8, pa1); PK4(p1, 0, pa2); PK4(p1, 8, pa3);
#undef PK4
}
__device__ __forceinline__ void qkt(f32x16& p0, f32x16& p1, const unsigned char* Ks, const bf16x8* qr, int r32, int hi) {
    p0 = f32x16{}; p1 = f32x16{};
#pragma unroll
    for (int d0 = 0; d0 < 6; ++d0) { const int cb = (d0 * 16 + hi * 8) * 2;
        const bf16x8 b0 = *reinterpret_cast<const bf16x8*>(Ks + KSWZ(r32, cb));
        const bf16x8 b1 = *reinterpret_cast<const bf16x8*>(Ks + KSWZ(32 + r32, cb));
        p0 = __builtin_amdgcn_mfma_f32_32x32x16_bf16(b0, qr[d0], p0, 0, 0, 0);
        p1 = __builtin_amdgcn_mfma_f32_32x32x16_bf16(b1, qr[d0], p1, 0, 0, 0); }
}
__device__ __forceinline__ int v_st(int k, int c) { const int kk = (k & ~0xC) | ((k & 4) << 1) | ((k & 8) >> 1); return ((kk >> 3) * 2 + (c >> 5)) * 512 + ((kk & 7) * 32 + (c & 31)) * 2; }
__device__ __forceinline__ int v_rd_base(int lane) { return ((lane & 3) << 3) | (((lane >> 2) & 3) << 6) | (((lane >> 4) & 1) << 5) | (((lane >> 5) & 1) << 8); }
constexpr int v_rd_off(int d0, int ks, int half) { return d0 * 512 + ks * 2048 + half * 1024; }
template <int OFF> __device__ __forceinline__ s16x4 tr_read(int vb) { s16x4 r; asm volatile("ds_read_b64_tr_b16 %0, %1 offset:%2" : "=&v"(r) : "v"(vb), "i"(OFF) : "memory"); return r; }
template <int D0> __device__ __forceinline__ void pv_one(f32x16& od, int vb, bf16x8 pa0, bf16x8 pa1, bf16x8 pa2, bf16x8 pa3) {
    const s16x4 l0 = tr_read<v_rd_off(D0, 0, 0)>(vb), h0 = tr_read<v_rd_off(D0, 0, 1)>(vb), l1 = tr_read<v_rd_off(D0, 1, 0)>(vb), h1 = tr_read<v_rd_off(D0, 1, 1)>(vb);
    const s16x4 l2 = tr_read<v_rd_off(D0, 2, 0)>(vb), h2 = tr_read<v_rd_off(D0, 2, 1)>(vb), l3 = tr_read<v_rd_off(D0, 3, 0)>(vb), h3 = tr_read<v_rd_off(D0, 3, 1)>(vb);
    asm volatile("s_waitcnt lgkmcnt(0)" ::: "memory"); SBAR();
#define PK(L, H) (bf16x8){L[0], L[1], L[2], L[3], H[0], H[1], H[2], H[3]}
    od = __builtin_amdgcn_mfma_f32_32x32x16_bf16(pa0, PK(l0, h0), od, 0, 0, 0);
    od = __builtin_amdgcn_mfma_f32_32x32x16_bf16(pa1, PK(l1, h1), od, 0, 0, 0);
    od = __builtin_amdgcn_mfma_f32_32x32x16_bf16(pa2, PK(l2, h2), od, 0, 0, 0);
    od = __builtin_amdgcn_mfma_f32_32x32x16_bf16(pa3, PK(l3, h3), od, 0, 0, 0);
#undef PK
}
__device__ __forceinline__ void pv_d0(f32x16* o, int vb, bf16x8 pa0, bf16x8 pa1, bf16x8 pa2, bf16x8 pa3) { pv_one<0>(o[0], vb, pa0, pa1, pa2, pa3); pv_one<1>(o[1], vb, pa0, pa1, pa2, pa3); }

__device__ __forceinline__ void attn_unit(const bf16_t* __restrict__ Qb, const bf16_t* __restrict__ Kh, const bf16_t* __restrict__ Vh, bf16_t* __restrict__ Ob, int seq, unsigned char* lds) {
    const int tid = threadIdx.x, wid = tid >> 6, lane = tid & 63, r32 = lane & 31, hi = lane >> 5;
    unsigned char* V_lds = lds; unsigned char* K_lds = lds + 2 * SHM_V;
    float* wsf = (float*)(lds + 2 * SHM_V + 2 * SHM_K) + wid * 64; float* li_l = wsf;
    float l_reg = 0; f32x16 o[2] = {}; bf16x8 qr[6];
    const bf16_t* Qw = Qb + (size_t)(wid * QBLK + r32) * LDQ + hi * 8;
#pragma unroll
    for (int d0 = 0; d0 < 6; ++d0) qr[d0] = *reinterpret_cast<const bf16x8*>(Qw + d0 * 16);
    const int sr = tid >> 4, sc = (tid & 15) * 8;
    const int vr = tid >> 3, vc = (tid & 7) * 8, vst = v_st(vr, vc);
    const int vb0 = (int)(uintptr_t)V_lds + v_rd_base(lane);
    struct { bf16x8 vs, ks0, ks1; } sr_;
#define SLOAD(k0) do { sr_.vs = *reinterpret_cast<const bf16x8*>(&Vh[(size_t)((k0) + vr) * LDV + vc]); \
    sr_.ks0 = *reinterpret_cast<const bf16x8*>(&Kh[(size_t)((k0) + sr) * LDK + sc]); sr_.ks1 = *reinterpret_cast<const bf16x8*>(&Kh[(size_t)((k0) + 32 + sr) * LDK + sc]); } while (0)
#define SWRITE(b) do { *(bf16x8*)(V_lds + (b) * SHM_V + vst) = sr_.vs; const int kc = sc * 2;               \
    *(bf16x8*)(K_lds + (b) * SHM_K + KSWZ(sr, kc)) = sr_.ks0; *(bf16x8*)(K_lds + (b) * SHM_K + KSWZ(32 + sr, kc)) = sr_.ks1; } while (0)
    f32x16 pA0, pA1, pB0, pB1; bf16x8 pa0, pa1, pa2, pa3; const int NT = seq / KVBLK;
    SLOAD(0); SWRITE(0); __syncthreads();
    qkt(pA0, pA1, K_lds, qr, r32, hi); EXPH(pA0);
    SLOAD(KVBLK); SWRITE(1); __syncthreads();
    for (int j = 1; j + 1 < NT; j += 2) {
        SBAR(); qkt(pB0, pB1, K_lds + SHM_K, qr, r32, hi);
        finishSM(pA0, pA1, l_reg, pa0, pa1, pa2, pa3); SBAR();
        SLOAD((j + 1) * KVBLK); SBAR();
        pv_d0(o, vb0, pa0, pa1, pa2, pa3); EXPH(pB0); SBAR();
        __syncthreads(); SWRITE(0);
        __syncthreads();
        SBAR(); qkt(pA0, pA1, K_lds, qr, r32, hi);
        finishSM(pB0, pB1, l_reg, pa0, pa1, pa2, pa3); SBAR();
        SLOAD((j + 2) * KVBLK); SBAR();
        pv_d0(o, vb0 + SHM_V, pa0, pa1, pa2, pa3); EXPH(pA0); SBAR();
        __syncthreads(); SWRITE(1);
        __syncthreads();
    }
    SBAR(); qkt(pB0, pB1, K_lds + SHM_K, qr, r32, hi);
    finishSM(pA0, pA1, l_reg, pa0, pa1, pa2, pa3); SBAR();
    pv_d0(o, vb0, pa0, pa1, pa2, pa3); EXPH(pB0);
    finishSM(pB0, pB1, l_reg, pa0, pa1, pa2, pa3); SBAR();
    pv_d0(o, vb0 + SHM_V, pa0, pa1, pa2, pa3);
    { auto rr = __builtin_amdgcn_permlane32_swap(__float_as_uint(l_reg), __float_as_uint(l_reg), false, false); l_reg = __uint_as_float(rr[0]) + __uint_as_float(rr[1]); }
    if (hi == 0) li_l[r32] = l_reg; asm volatile("s_waitcnt lgkmcnt(0)" ::: "memory");
    float rli[16];
#pragma unroll
    for (int r = 0; r < 16; ++r) rli[r] = __builtin_amdgcn_rcpf(li_l[crow(r, hi)]);
    bf16_t* Ow = Ob + (size_t)(wid * QBLK) * 512;
#pragma unroll
    for (int r = 0; r < 16; ++r) { const int orow = crow(r, hi);
#pragma unroll
        for (int d0 = 0; d0 < 2; ++d0) Ow[(size_t)orow * 512 + d0 * 32 + r32] = (bf16_t)(pk2(o[d0][r] * rli[r], 0.f) & 0xffffu); }
    __syncthreads();
#undef SLOAD
#undef SWRITE
}
#undef KSWZ
#undef SBAR
}

__device__ __forceinline__ void phase_attn(const Params& p, unsigned char* lds) {
    const bf16_t* Q = (const bf16_t*)(p.ws + WS_Q); const bf16_t* Kb = (const bf16_t*)(p.ws + WS_K); const bf16_t* V = (const bf16_t*)(p.ws + WS_V); bf16_t* AO = (bf16_t*)(p.ws + WS_AO);
    constexpr int NQB = SEQ / 256, NU = 2 * NH * NQB;
    for (int u = blockIdx.x; u < NU; u += gridDim.x) {
        const int qb = u % NQB, h = (u / NQB) % NH, b = u / (NQB * NH); const size_t bh = (size_t)(b * NH + h) * SEQ;
        att::attn_unit(Q + (bh + (size_t)qb * 256) * DQK, Kb + bh * 128, V + bh * DV, AO + ((size_t)b * SEQ + (size_t)qb * 256) * 512 + h * DV, SEQ, lds);
    }
}

__device__ __forceinline__ int crow16(int r, int hi) { return (r & 3) + 8 * (r >> 2) + 4 * hi; }
__device__ __forceinline__ void phase_router(const Params& p, unsigned char* lds) {
    const int tid = threadIdx.x, lane = tid & 63, wid = tid >> 6, tile = wid >> 2, kq = wid & 3, c = lane & 31, h = lane >> 5;
    float* red = (float*)lds;
    float* ssb = red + 2 * 4 * 16 * 64;
    int* lcnt = (int*)(ssb + 2 * 4 * 64);
    int* lbase = lcnt + 32;
    unsigned* gcnt = (unsigned*)(p.ws + WS_CTL) + CW_CNT;
    int* row_tok = (int*)(p.ws + WS_RT2); float* row_w = (float*)(p.ws + WS_RT2 + 2 * MiB); int* row_slot = (int*)(p.ws + WS_RT2 + 4 * MiB); float* row_rstd = (float*)(p.ws + WS_RT2 + 6 * MiB);
    const u32x4* GF = (const u32x4*)(p.ws + WS_GF);
    for (int tg = blockIdx.x; tg < NTOK / 64; tg += gridDim.x) {
        if (tid < 32) lcnt[tid] = 0;
        const int token = tg * 64 + tile * 32 + c;
        const float* xrow = p.out + (size_t)token * DM + kq * 256 + 8 * h; const float* g2p = p.norm2_g + kq * 256 + 8 * h;
        unsigned char* hrow = p.ws + WS_H8 + (size_t)token * DM + kq * 256 + 8 * h;
        f32x16 acc = {}; float ss = 0.f;
#pragma unroll 2
        for (int s = 0; s < 16; ++s) {
            const f32x4 a = *(const f32x4*)(xrow + 16 * s), b = *(const f32x4*)(xrow + 16 * s + 4); const f32x4 ga = *(const f32x4*)(g2p + 16 * s), gb = *(const f32x4*)(g2p + 16 * s + 4);
            ss += (a[0] * a[0] + a[1] * a[1]) + (a[2] * a[2] + a[3] * a[3]) + (b[0] * b[0] + b[1] * b[1]) + (b[2] * b[2] + b[3] * b[3]);
            u32x4 xh; xh.x = pk2(a[0], a[1]); xh.y = pk2(a[2], a[3]); xh.z = pk2(b[0], b[1]); xh.w = pk2(b[2], b[3]);
            u32x4 xl; xl.x = pk2(a[0] - bf_lo(xh.x), a[1] - bf_hi(xh.x)); xl.y = pk2(a[2] - bf_lo(xh.y), a[3] - bf_hi(xh.y)); xl.z = pk2(b[0] - bf_lo(xh.z), b[1] - bf_hi(xh.z)); xl.w = pk2(b[2] - bf_lo(xh.w), b[3] - bf_hi(xh.w));
            u32x2 h8; h8.x = pk4_fp8(a[0] * ga[0], a[1] * ga[1], a[2] * ga[2], a[3] * ga[3]); h8.y = pk4_fp8(b[0] * gb[0], b[1] * gb[1], b[2] * gb[2], b[3] * gb[3]); *(u32x2*)(hrow + 16 * s) = h8;
            const u32x4 gh = GF[((kq * 16 + s) * 2 + 0) * 64 + lane], gl = GF[((kq * 16 + s) * 2 + 1) * 64 + lane];
            acc = __builtin_amdgcn_mfma_f32_32x32x16_bf16(__builtin_bit_cast(bf16x8, gh), __builtin_bit_cast(bf16x8, xh), acc, 0, 0, 0);
            acc = __builtin_amdgcn_mfma_f32_32x32x16_bf16(__builtin_bit_cast(bf16x8, gh), __builtin_bit_cast(bf16x8, xl), acc, 0, 0, 0);
            acc = __builtin_amdgcn_mfma_f32_32x32x16_bf16(__builtin_bit_cast(bf16x8, gl), __builtin_bit_cast(bf16x8, xh), acc, 0, 0, 0);
        }
#pragma unroll
        for (int r = 0; r < 16; ++r) red[((tile * 4 + kq) * 16 + r) * 64 + lane] = acc[r];
        ssb[(tile * 4 + kq) * 64 + lane] = ss;
        __syncthreads();
        int te[4] = {0, 0, 0, 0}, rl[4] = {0, 0, 0, 0}; float tw[4] = {0.f, 0.f, 0.f, 0.f}; float rstd = 0.f;
        if (kq == 0) {
            float v[16]; float st = 0.f;
#pragma unroll
            for (int q = 0; q < 4; ++q) st += ssb[(tile * 4 + q) * 64 + lane];
            { auto rr = __builtin_amdgcn_permlane32_swap(__float_as_uint(st), __float_as_uint(st), false, false); st = __uint_as_float(rr[0]) + __uint_as_float(rr[1]); }
            rstd = rsqrtf(st * (1.f / DM) + EPS);
#pragma unroll
            for (int r = 0; r < 16; ++r) { float sacc = 0.f;
#pragma unroll
                for (int q = 0; q < 4; ++q) sacc += red[((tile * 4 + q) * 16 + r) * 64 + lane];
                v[r] = sacc * rstd + p.router_b[crow16(r, h)]; }
            float lv[4]; int le[4];
#pragma unroll
            for (int k = 0; k < 4; ++k) { float best = v[0]; int bi = 0;
#pragma unroll
                for (int r = 1; r < 16; ++r) { const bool gt = v[r] > best; best = gt ? v[r] : best; bi = gt ? r : bi; }
                lv[k] = best; le[k] = (bi & 3) + 8 * (bi >> 2) + 4 * h;
#pragma unroll
                for (int r = 0; r < 16; ++r) v[r] = (r == bi) ? -INFINITY : v[r]; }
            float cv[8]; int ce[8];
#pragma unroll
            for (int k = 0; k < 4; ++k) { auto rv = __builtin_amdgcn_permlane32_swap(__float_as_uint(lv[k]), __float_as_uint(lv[k]), false, false); auto re = __builtin_amdgcn_permlane32_swap((unsigned)le[k], (unsigned)le[k], false, false);
                cv[k] = __uint_as_float(rv[0]); cv[4 + k] = __uint_as_float(rv[1]); ce[k] = (int)re[0]; ce[4 + k] = (int)re[1]; }
            float tv[4];
#pragma unroll
            for (int k = 0; k < 4; ++k) { float best = cv[0]; int be = ce[0]; int bi = 0;
#pragma unroll
                for (int r = 1; r < 8; ++r) { const bool gt = (cv[r] > best) || (cv[r] == best && ce[r] < be); best = gt ? cv[r] : best; be = gt ? ce[r] : be; bi = gt ? r : bi; }
                tv[k] = best; te[k] = be;
#pragma unroll
                for (int r = 0; r < 8; ++r) cv[r] = (r == bi) ? -INFINITY : cv[r]; }
            const float e1 = __expf(tv[1] - tv[0]), e2 = __expf(tv[2] - tv[0]), e3 = __expf(tv[3] - tv[0]); const float inv = 1.f / (1.f + e1 + e2 + e3);
            tw[0] = inv; tw[1] = e1 * inv; tw[2] = e2 * inv; tw[3] = e3 * inv;
            if (h == 0) {
#pragma unroll
                for (int k = 0; k < 4; ++k) rl[k] = atomicAdd(&lcnt[te[k]], 1); }
        }
        __syncthreads();
        if (tid < 32) lbase[tid] = (int)atomicAdd(&gcnt[tid], (unsigned)lcnt[tid]);
        __syncthreads();
        if (kq == 0 && h == 0) {
#pragma unroll
            for (int k = 0; k < 4; ++k) { const int idx = te[k] * CAP + lbase[te[k]] + rl[k]; row_tok[idx] = token; row_w[idx] = tw[k]; row_slot[idx] = token * 4 + k; row_rstd[idx] = rstd; } }
        __syncthreads();
    }
}

__device__ __forceinline__ void build_block_table(const Params& p, int* bs) {
    const unsigned* gcnt = (const unsigned*)(p.ws + WS_CTL) + CW_CNT;
    if (threadIdx.x == 0) { int acc = 0; for (int e = 0; e < NE; ++e) { bs[e] = acc; acc += ((int)__hip_atomic_load(gcnt + e, __ATOMIC_RELAXED, __HIP_MEMORY_SCOPE_AGENT) + 255) >> 8; } bs[NE] = acc; }
    __syncthreads();
}

__device__ __forceinline__ pg8::MoeOrder make_moe_order(const Params& p, unsigned char* lds, int N, bool gather) {
    int* bs = (int*)(lds + 131072); int* utab = (int*)(lds + 131072 + 256); int* gtab = (int*)(lds + 131072 + 512);
    build_block_table(p, bs);
    const int nmb = __builtin_amdgcn_readfirstlane(bs[NE]);
    pg8::MoeOrder S; S.so.init(nmb * 256, N, (int)gridDim.x, (int)blockIdx.x); S.utab = (const PG8_LAS int*)utab; S.gtab = (const PG8_LAS int*)gtab;
    const int* row_tok = (const int*)(p.ws + WS_RT2);
    for (int i = 0; i < pg8::MOE_MAXU; ++i) { pg8::Unit u; if (!S.so.next(i, u)) break; int e = 0; for (int k = 1; k < NE; ++k) if (bs[k] <= u.pm) e = k;
        const int rb = e * CAP + (u.pm - bs[e]) * 256;
        if (threadIdx.x == 0) utab[i] = e | (rb << 8);
        if (gather && threadIdx.x < 256) gtab[i * 256 + threadIdx.x] = row_tok[rb + threadIdx.x]; }
    __syncthreads();
    return S;
}
__device__ __forceinline__ void phase_moe1(const Params& p, unsigned char* lds) {
    const pg8::MoeOrder S = make_moe_order(p, lds, 2048, true);
    pg8::Gemm g{(const bf16_t*)(p.ws + WS_H8), (const bf16_t*)(p.ws + WS_W1), 0, 2048, DM / 2, (size_t)2048 * DM};
    pg8::EpiSwiglu E{p.ws + WS_ACT, p.b1, (const float*)(p.ws + WS_RT2 + 6 * MiB)};
    pg8::gemm_phase<pg8::EpiSwiglu, pg8::MoeOrder, true, true, true, true>((PG8_LAS unsigned char*)lds, g, S, E);
}
__device__ __forceinline__ void phase_moe2(const Params& p, unsigned char* lds) {
    const pg8::MoeOrder S = make_moe_order(p, lds, DM, false);
    pg8::Gemm g{(const bf16_t*)(p.ws + WS_ACT), (const bf16_t*)(p.ws + WS_W2), 0, DM, DFF / 2, (size_t)DM * DFF};
    pg8::EpiMoeOut E{(bf16_t*)(p.ws + WS_YS), p.b2, (const float*)(p.ws + WS_RT2 + 2 * MiB), (const int*)(p.ws + WS_RT2 + 4 * MiB)};
    pg8::gemm_phase<pg8::EpiMoeOut, pg8::MoeOrder, true, true, true>((PG8_LAS unsigned char*)lds, g, S, E);
}

__device__ __forceinline__ void phase_combine(const Params& p) {
    const int tid = threadIdx.x, lane = tid & 63, wave = tid >> 6;
    const int gw = blockIdx.x * NWAVES + wave, NGW = gridDim.x * NWAVES;
    const bf16_t* YS = (const bf16_t*)(p.ws + WS_YS);
    for (int t = gw; t < NTOK; t += NGW) {
        f32x4* orow = (f32x4*)(p.out + (size_t)t * DM) + lane;
#pragma unroll
        for (int j = 0; j < 4; ++j) { f32x4 v = orow[64 * j];
#pragma unroll
            for (int k = 0; k < 4; ++k) { const u32x2 w = *((const u32x2*)(YS + ((size_t)t * 4 + k) * DM) + lane + 64 * j); v[0] += bf_lo(w.x); v[1] += bf_hi(w.x); v[2] += bf_lo(w.y); v[3] += bf_hi(w.y); }
            orow[64 * j] = v; }
    }
}

template <class Epi>
__device__ __forceinline__ void dense_gemm(unsigned char* lds, const bf16_t* A, const bf16_t* Bt, int M, int N, int K, const Epi& E) {
    pg8::Gemm g{A, Bt, M, N, K, 0}; pg8::StaticOrder S; S.init(M, N, (int)gridDim.x, (int)blockIdx.x);
    pg8::gemm_phase<Epi, pg8::StaticOrder, true, true>((PG8_LAS unsigned char*)lds, g, S, E);
}

constexpr int NPHASE = 13;
__global__ void __launch_bounds__(NTHREADS, 2) mk_fwd(Params p) {
    extern __shared__ __attribute__((aligned(16))) unsigned char lds[];
    cg::grid_group grid = cg::this_grid();
    unsigned char* ws = p.ws;
    volatile LAS unsigned* MISC = (volatile LAS unsigned*)((LAS unsigned char*)lds + MISC_OFF);
    if (threadIdx.x < 32) MISC[threadIdx.x] = 0u;
    __syncthreads();
    XcdBarrier bar = xcd_barrier_post((unsigned*)(ws + WS_CTL) + CW_BAR, MISC + 8);
    const int lo = p.ph_lo, hi = p.ph_hi;
    if (lo < 0) grid.sync();
#define IN(k) (lo <= (k) && (k) < hi)
#define SEAM(k) do { if (IN(k) && IN((k) + 1)) xcd_barrier(bar); } while (0)
    if (IN(0)) phase_prologue(p, lds);
    SEAM(0);
    if (IN(1)) { pg8::EpiProj E{(bf16_t*)(ws + WS_PROJ)}; dense_gemm(lds, (const bf16_t*)(ws + WS_XN), (const bf16_t*)(ws + WS_WIN), NTOK, INCP, DM, E); }
    SEAM(1);
    if (IN(2)) phase_tok_a(p);
    SEAM(2);
    if (IN(3)) { pg8::EpiF32 Eq{(float*)(ws + WS_QPRE), 768}; dense_gemm(lds, (const bf16_t*)(ws + WS_CQN), (const bf16_t*)(ws + WS_WUQ), NTOK, 768, QLORA, Eq);
                 pg8::EpiF32 Ek{(float*)(ws + WS_KVPRE), 1024}; dense_gemm(lds, (const bf16_t*)(ws + WS_CKVN), (const bf16_t*)(ws + WS_WUKV), NTOK, 1024, KVLORA, Ek); }
    SEAM(3);
    if (IN(4)) phase_tok_b(p);
    SEAM(4);
    if (IN(5)) phase_attn(p, lds);
    SEAM(5);
    if (IN(6)) { pg8::EpiGateA E{(bf16_t*)(ws + WS_M1), (const bf16_t*)(ws + WS_PROJ)}; dense_gemm(lds, (const bf16_t*)(ws + WS_AO), (const bf16_t*)(ws + WS_WOMLA), NTOK, DM, 512, E); }
    if (IN(7)) { pg8::EpiGateB E{(const bf16_t*)(ws + WS_M1), (const bf16_t*)(ws + WS_PROJ), (bf16_t*)(ws + WS_MERGED)}; dense_gemm(lds, (const bf16_t*)(ws + WS_YBIN), (const bf16_t*)(ws + WS_WOCONV), NTOK, DM, 512, E); }
    SEAM(7);
    if (IN(8)) { pg8::EpiResid E{p.x, p.out}; dense_gemm(lds, (const bf16_t*)(ws + WS_MERGED), (const bf16_t*)(ws + WS_WO), NTOK, DM, DM, E); }
    SEAM(8);
    if (IN(9)) phase_router(p, lds);
    if (IN(9) && IN(11)) xcd_barrier(bar);
    if (IN(11)) phase_moe1(p, lds);
    SEAM(11);
    if (IN(12)) phase_moe2(p, lds);
    SEAM(12);
    if (IN(13)) phase_combine(p);
#undef IN
#undef SEAM
}

extern "C" void kernel_launch(void* const* d_in, const int* in_sizes, int n_in, void* d_out, int out_size,
                              void* d_ws, size_t ws_size, hipStream_t stream) {
    static int grid_blocks = 0;
    if (!grid_blocks) {
        int dev = 0, cus = 0, per_cu = 0;
        (void)hipGetDevice(&dev);
        (void)hipDeviceGetAttribute(&cus, hipDeviceAttributeMultiprocessorCount, dev);
        (void)hipFuncSetAttribute((const void*)mk_fwd, hipFuncAttributeMaxDynamicSharedMemorySize, LDS_BYTES);
        (void)hipOccupancyMaxActiveBlocksPerMultiprocessor(&per_cu, (const void*)mk_fwd, NTHREADS, LDS_BYTES);
        if (per_cu < 1) { fprintf(stderr, "kernel_launch: occupancy query says %d blocks/CU\n", per_cu); per_cu = 1; }
        grid_blocks = cus;
        if (ws_size < WS_END2 || n_in != 21) fprintf(stderr, "kernel_launch: ws %zu < %zu or n_in %d != 21\n", ws_size, (size_t)WS_END2, n_in);
    }
    (void)hipMemsetAsync((char*)d_ws + WS_CTL, 0, 1 * MiB, stream);
    Params p{};
    p.x = (const float*)d_in[0]; p.pos = (const int*)d_in[1]; p.norm1_g = (const float*)d_in[2]; p.w_in = (const float*)d_in[3]; p.q_a_g = (const float*)d_in[4];
    p.kv_a_g = (const float*)d_in[5]; p.w_uq = (const float*)d_in[6]; p.w_ukv = (const float*)d_in[7]; p.q_g = (const float*)d_in[8]; p.k_g = (const float*)d_in[9];
    p.conv_w = (const float*)d_in[10]; p.w_o_mla = (const float*)d_in[11]; p.w_o_conv = (const float*)d_in[12]; p.w_o = (const float*)d_in[13]; p.norm2_g = (const float*)d_in[14];
    p.router_w = (const float*)d_in[15]; p.router_b = (const float*)d_in[16]; p.w1 = (const float*)d_in[17]; p.b1 = (const float*)d_in[18]; p.w2 = (const float*)d_in[19]; p.b2 = (const float*)d_in[20];
    p.out = (float*)d_out; p.ws = (unsigned char*)d_ws; p.ph_lo = 0; p.ph_hi = NPHASE + 1;
    void* args[] = {&p};
    hipError_t e = hipLaunchCooperativeKernel((const void*)mk_fwd, dim3(grid_blocks), dim3(NTHREADS), args, LDS_BYTES, stream);
    if (e != hipSuccess) fprintf(stderr, "cooperative launch failed: %s (grid %d)\n", hipGetErrorString(e), grid_blocks);
}
```

```cpp
#include <hip/hip_runtime.h>
#include <hip/hip_cooperative_groups.h>
#include <cstdio>
#include <cstdint>
namespace cg = cooperative_groups;

typedef unsigned short bf16_t;
typedef short bf16x8 __attribute__((ext_vector_type(8)));
typedef short s16x4 __attribute__((ext_vector_type(4)));
typedef float f32x4 __attribute__((ext_vector_type(4)));
typedef float f32x2 __attribute__((ext_vector_type(2)));
typedef float f32x16 __attribute__((ext_vector_type(16)));
typedef unsigned u32x4 __attribute__((ext_vector_type(4)));
typedef unsigned u32x2 __attribute__((ext_vector_type(2)));
typedef __bf16 bf16x2_t __attribute__((ext_vector_type(2)));

constexpr int NTOK = 16384, DM = 1024, SEQ = 8192;
constexpr int INC = 4000, INCP = 4096;
constexpr int OFF_CQ = 0, OFF_CKV = 256, OFF_KR = 384, OFF_U = 416, OFF_C = 928, OFF_B = 1440, OFF_GA = 1952, OFF_GB = 2976;
constexpr int NH = 8, DQK = 96, DV = 64, NE = 32, TOPK = 4, DFF = 1024;
constexpr int QLORA = 256, KVLORA = 128, CONVW = 512;
constexpr int NPAIR = NTOK * TOPK;
constexpr int MAXROWS = 73728;
constexpr float EPS = 1e-6f;
constexpr int CAP = 16384;
constexpr int NTHREADS = 512, NWAVES = 8;
constexpr int LDS_BYTES = 147456;

constexpr size_t MiB = 1ull << 20;
constexpr size_t WS_CTL = 0;
constexpr size_t WS_WIN = 1 * MiB;
constexpr size_t WS_WUQ = 9 * MiB;
constexpr size_t WS_WUKV = WS_WUQ + 512 * 1024;
constexpr size_t WS_WOMLA = 10 * MiB;
constexpr size_t WS_WOCONV = 11 * MiB;
constexpr size_t WS_WO = 12 * MiB;
constexpr size_t WS_ROUTE = 14 * MiB;
constexpr size_t WS_W1 = 18 * MiB;
constexpr size_t WS_W2 = 146 * MiB;
constexpr size_t WS_XN = 210 * MiB;
constexpr size_t WS_PROJ = 242 * MiB;
constexpr size_t WS_CQN = 370 * MiB;
constexpr size_t WS_CKVN = 378 * MiB;
constexpr size_t WS_YBIN = 386 * MiB;
constexpr size_t WS_QPRE = 402 * MiB;
constexpr size_t WS_KVPRE = 450 * MiB;
constexpr size_t WS_Q = 514 * MiB;
constexpr size_t WS_K = 538 * MiB;
constexpr size_t WS_V = 570 * MiB;
constexpr size_t WS_AO = 586 * MiB;
constexpr size_t WS_M1 = 602 * MiB;
constexpr size_t WS_MERGED = 666 * MiB;
constexpr size_t WS_YS = 698 * MiB;
constexpr size_t WS_END = 826 * MiB;
constexpr size_t WS_ACT = WS_PROJ;
constexpr size_t WS_H8 = WS_XN;
constexpr size_t WS_GF = 830 * MiB;
constexpr size_t WS_RT2 = 832 * MiB;
constexpr size_t WS_END2 = 840 * MiB;
constexpr size_t RT_PAIR_E = 0, RT_PAIR_RANK = 262144, RT_PAIR_W = 524288, RT_ROW_TOK = 786432, RT_ROW_W = 786432 + 294912, RT_ROW_SLOT = 786432 + 2 * 294912;
constexpr int CW_CNT = 64;
constexpr int CW_BAR = 4096;
constexpr int MISC_OFF = LDS_BYTES - 256;

struct Params {
    const float* x; const int* pos; const float* norm1_g; const float* w_in; const float* q_a_g; const float* kv_a_g;
    const float* w_uq; const float* w_ukv; const float* q_g; const float* k_g; const float* conv_w; const float* w_o_mla;
    const float* w_o_conv; const float* w_o; const float* norm2_g; const float* router_w; const float* router_b;
    const float* w1; const float* b1; const float* w2; const float* b2;
    float* out; unsigned char* ws; int ph_lo, ph_hi;
};

__device__ __forceinline__ unsigned pk2(float lo, float hi) { f32x2 v = {lo, hi}; bf16x2_t b = __builtin_convertvector(v, bf16x2_t); return __builtin_bit_cast(unsigned, b); }
__device__ __forceinline__ float bf_lo(unsigned w) { return __uint_as_float(w << 16); }
__device__ __forceinline__ float bf_hi(unsigned w) { return __uint_as_float(w & 0xffff0000u); }
__device__ __forceinline__ float bf1(bf16_t h) { return __uint_as_float((unsigned)h << 16); }
__device__ __forceinline__ float wave_sum(float v) {
#pragma unroll
    for (int o = 1; o < 64; o <<= 1) v += __shfl_xor(v, o);
    return v;
}
__device__ __forceinline__ unsigned pk4_fp8(float a, float b, float c, float d) { unsigned w = 0u; w = (unsigned)__builtin_amdgcn_cvt_pk_fp8_f32(a, b, (int)w, false); w = (unsigned)__builtin_amdgcn_cvt_pk_fp8_f32(c, d, (int)w, true); return w; }
constexpr float W8_SCALE = 32.f, W8_INV = 1.f / 32.f;
__device__ __forceinline__ float sigmoidf_(float v) { return 1.f / (1.f + __expf(-v)); }

namespace pg8 {
#define PG8_LAS __attribute__((address_space(3)))
constexpr int BM = 256, BK = 64, HALF = 128, HTB = HALF * BK * 2  , STAGE_BYTES = 8 * HTB, NXCD = 8, WGM = 8;

__host__ __device__ __forceinline__ int lds_byte(int r, int c) { const int st = (r >> 4) * 2 + (c >> 5), rr = r & 15, cc = c & 31, ob = rr * 64 + cc * 2; return st * 1024 + (ob ^ (((ob >> 9) & 1) << 5)); }
__host__ __device__ __forceinline__ void stage_rc(int b, int& R, int& C) { const int st = b / 1024, sb = b % 1024, swz = sb ^ (((sb >> 9) & 1) << 5); R = (st >> 1) * 16 + swz / 64; C = (st & 1) * 32 + (swz % 64) / 2; }
__host__ __device__ __forceinline__ int perm32(int rho) { const int n = rho >> 4, i = rho & 15; return 8 * (i >> 2) + 4 * n + (i & 3); }

struct Unit { int pm, pn, e, rb; };
struct Gemm { const bf16_t* A; const bf16_t* Bt; int M, N, K; size_t bstride; int lda; };

struct StaticOrder {
    int nM, nN, nwg, G, c;
    __host__ __device__ void init(int M, int N, int G_, int c_) { nM = M / BM; nN = N / BM; nwg = nM * nN; G = G_; c = c_; }
    __host__ __device__ bool next(int i, Unit& u) const {
        const long L = (long)i * G + c; if (L >= nwg) return false;
        int wgid = (int)L; { const int q = nwg / NXCD, r = nwg % NXCD, xcd = wgid % NXCD, off = wgid / NXCD; wgid = (xcd < r ? xcd * (q + 1) : r * (q + 1) + (xcd - r) * q) + off; }
        const int nig = WGM * nN, gid = wgid / nig, fm = gid * WGM, gsz = (nM - fm) < WGM ? (nM - fm) : WGM;
        u.pm = fm + ((wgid % nig) % gsz); u.pn = (wgid % nig) / gsz; u.e = 0; u.rb = 0; return true;
    }
    __device__ __forceinline__ void a_ready(const Unit&) const {}
    __device__ __forceinline__ void done(const Unit&) const {}
};


struct EpiProj {
    static constexpr bool PERM = true, AFTER_DRAIN = false;
    bf16_t* O;
    __device__ __forceinline__ void operator()(const f32x4 (&acc)[2][2][4][2], const Unit& u, int wr, int wc, int fr, int fq) const {
        const int row0 = u.pm * BM + wr * 64 + fr, col0 = u.pn * BM + wc * 32 + 8 * fq;
#pragma unroll
        for (int ai = 0; ai < 2; ++ai)
#pragma unroll
            for (int m = 0; m < 4; ++m) { bf16_t* rowp = O + (size_t)(row0 + ai * HALF + m * 16) * INCP + col0;
#pragma unroll
                for (int bj = 0; bj < 2; ++bj) { f32x4 v0 = acc[ai][bj][m][0], v1 = acc[ai][bj][m][1]; const int col = col0 + bj * HALF;
                    if (col >= OFF_GA && col < INC) {
#pragma unroll
                        for (int j = 0; j < 4; ++j) { v0[j] = sigmoidf_(v0[j]); v1[j] = sigmoidf_(v1[j]); } }
                    u32x4 w; w.x = pk2(v0[0], v0[1]); w.y = pk2(v0[2], v0[3]); w.z = pk2(v1[0], v1[1]); w.w = pk2(v1[2], v1[3]);
                    *(u32x4*)(rowp + bj * HALF) = w; } }
    }
};
struct EpiBf16 {
    static constexpr bool PERM = true, AFTER_DRAIN = false;
    bf16_t* O; int ldc;
    __device__ __forceinline__ void operator()(const f32x4 (&acc)[2][2][4][2], const Unit& u, int wr, int wc, int fr, int fq) const {
        const int row0 = u.pm * BM + wr * 64 + fr, col0 = u.pn * BM + wc * 32 + 8 * fq;
#pragma unroll
        for (int ai = 0; ai < 2; ++ai)
#pragma unroll
            for (int m = 0; m < 4; ++m) { bf16_t* rowp = O + (size_t)(row0 + ai * HALF + m * 16) * ldc + col0;
#pragma unroll
                for (int bj = 0; bj < 2; ++bj) { const f32x4 v0 = acc[ai][bj][m][0], v1 = acc[ai][bj][m][1];
                    u32x4 w; w.x = pk2(v0[0], v0[1]); w.y = pk2(v0[2], v0[3]); w.z = pk2(v1[0], v1[1]); w.w = pk2(v1[2], v1[3]); *(u32x4*)(rowp + bj * HALF) = w; } }
    }
};
struct EpiF32 {
    static constexpr bool PERM = false, AFTER_DRAIN = false;
    float* O; int ldc;
    __device__ __forceinline__ void operator()(const f32x4 (&acc)[2][2][4][2], const Unit& u, int wr, int wc, int fr, int fq) const {
        const int row0 = u.pm * BM + wr * 64 + fr, col0 = u.pn * BM + wc * 32 + 4 * fq;
#pragma unroll
        for (int ai = 0; ai < 2; ++ai)
#pragma unroll
            for (int m = 0; m < 4; ++m) { float* rowp = O + (size_t)(row0 + ai * HALF + m * 16) * ldc + col0;
#pragma unroll
                for (int bj = 0; bj < 2; ++bj)
#pragma unroll
                    for (int n = 0; n < 2; ++n) *(f32x4*)(rowp + bj * HALF + n * 16) = acc[ai][bj][m][n]; }
    }
};
__device__ __forceinline__ void unpack8(const u32x4 g, float (&f)[8]) { f[0] = bf_lo(g.x); f[1] = bf_hi(g.x); f[2] = bf_lo(g.y); f[3] = bf_hi(g.y); f[4] = bf_lo(g.z); f[5] = bf_hi(g.z); f[6] = bf_lo(g.w); f[7] = bf_hi(g.w); }
struct EpiGateA {
    static constexpr bool PERM = true, AFTER_DRAIN = false;
    bf16_t* M1; const bf16_t* proj;
    __device__ __forceinline__ void operator()(const f32x4 (&acc)[2][2][4][2], const Unit& u, int wr, int wc, int fr, int fq) const {
        const int row0 = u.pm * BM + wr * 64 + fr, col0 = u.pn * BM + wc * 32 + 8 * fq;
#pragma unroll
        for (int ai = 0; ai < 2; ++ai)
#pragma unroll
            for (int m = 0; m < 4; ++m) { const size_t row = (size_t)(row0 + ai * HALF + m * 16);
#pragma unroll
                for (int bj = 0; bj < 2; ++bj) { const int col = col0 + bj * HALF; float g[8]; unpack8(*(const u32x4*)(proj + row * INCP + OFF_GA + col), g);
                    const f32x4 v0 = acc[ai][bj][m][0], v1 = acc[ai][bj][m][1];
                    u32x4 w; w.x = pk2(v0[0] * g[0], v0[1] * g[1]); w.y = pk2(v0[2] * g[2], v0[3] * g[3]); w.z = pk2(v1[0] * g[4], v1[1] * g[5]); w.w = pk2(v1[2] * g[6], v1[3] * g[7]);
                    *(u32x4*)(M1 + row * DM + col) = w; } }
    }
};
struct EpiGateB {
    static constexpr bool PERM = true, AFTER_DRAIN = false;
    const bf16_t* M1; const bf16_t* proj; bf16_t* O;
    __device__ __forceinline__ void operator()(const f32x4 (&acc)[2][2][4][2], const Unit& u, int wr, int wc, int fr, int fq) const {
        const int row0 = u.pm * BM + wr * 64 + fr, col0 = u.pn * BM + wc * 32 + 8 * fq;
#pragma unroll
        for (int ai = 0; ai < 2; ++ai)
#pragma unroll
            for (int m = 0; m < 4; ++m) { const size_t row = (size_t)(row0 + ai * HALF + m * 16);
#pragma unroll
                for (int bj = 0; bj < 2; ++bj) { const int col = col0 + bj * HALF; float g[8], b[8]; unpack8(*(const u32x4*)(proj + row * INCP + OFF_GB + col), g); unpack8(*(const u32x4*)(M1 + row * DM + col), b);
                    const f32x4 v0 = acc[ai][bj][m][0], v1 = acc[ai][bj][m][1];
                    u32x4 w; w.x = pk2(b[0] + v0[0] * g[0], b[1] + v0[1] * g[1]); w.y = pk2(b[2] + v0[2] * g[2], b[3] + v0[3] * g[3]);
                    w.z = pk2(b[4] + v1[0] * g[4], b[5] + v1[1] * g[5]); w.w = pk2(b[6] + v1[2] * g[6], b[7] + v1[3] * g[7]);
                    *(u32x4*)(O + row * DM + col) = w; } }
    }
};
struct EpiResid {
    static constexpr bool PERM = false, AFTER_DRAIN = false;
    const float* X; float* O;
    __device__ __forceinline__ void operator()(const f32x4 (&acc)[2][2][4][2], const Unit& u, int wr, int wc, int fr, int fq) const {
        const int row0 = u.pm * BM + wr * 64 + fr, col0 = u.pn * BM + wc * 32 + 4 * fq;
#pragma unroll
        for (int ai = 0; ai < 2; ++ai)
#pragma unroll
            for (int m = 0; m < 4; ++m) { const size_t off = (size_t)(row0 + ai * HALF + m * 16) * DM + col0;
#pragma unroll
                for (int bj = 0; bj < 2; ++bj)
#pragma unroll
                    for (int n = 0; n < 2; ++n) { const f32x4 b = *(const f32x4*)(X + off + bj * HALF + n * 16); *(f32x4*)(O + off + bj * HALF + n * 16) = b + acc[ai][bj][m][n]; } }
    }
};
struct EpiSwiglu {
    static constexpr bool PERM = true, AFTER_DRAIN = false;
    unsigned char* ACT; const float* b1; const float* row_rstd;
    __device__ __forceinline__ void operator()(const f32x4 (&acc)[2][2][4][2], const Unit& u, int wr, int wc, int fr, int fq) const {
        const int row0 = u.pm * BM + wr * 64 + fr, f0 = u.pn * HALF + wc * 32 + 8 * fq; const float* be = b1 + (size_t)u.e * 2048;
        const f32x4 bg0 = *(const f32x4*)(be + f0), bg1 = *(const f32x4*)(be + f0 + 4), bu0 = *(const f32x4*)(be + DFF + f0), bu1 = *(const f32x4*)(be + DFF + f0 + 4);
#pragma unroll
        for (int ai = 0; ai < 2; ++ai)
#pragma unroll
            for (int m = 0; m < 4; ++m) { const size_t row = (size_t)(row0 + ai * HALF + m * 16); float o[8]; const float rs = row_rstd[u.rb + wr * 64 + fr + ai * HALF + m * 16] * W8_INV;
#pragma unroll
                for (int n = 0; n < 2; ++n) { const f32x4 g4 = acc[ai][0][m][n] * rs + (n ? bg1 : bg0), u4 = acc[ai][1][m][n] * rs + (n ? bu1 : bu0);
#pragma unroll
                    for (int j = 0; j < 4; ++j) { const float g = fminf(g4[j], 7.f), uu = fminf(fmaxf(u4[j], -7.f), 7.f); o[4 * n + j] = (uu + 1.f) * (g * sigmoidf_(1.702f * g)); } }
                u32x2 w; w.x = pk4_fp8(o[0], o[1], o[2], o[3]); w.y = pk4_fp8(o[4], o[5], o[6], o[7]); *(u32x2*)(ACT + row * DFF + f0) = w; }
    }
};
struct EpiMoeOut {
    static constexpr bool PERM = true, AFTER_DRAIN = false;
    bf16_t* YS; const float* b2; const float* row_w; const int* row_slot;
    __device__ __forceinline__ void operator()(const f32x4 (&acc)[2][2][4][2], const Unit& u, int wr, int wc, int fr, int fq) const {
        const int row0 = u.pm * BM + wr * 64 + fr, col0 = u.pn * BM + wc * 32 + 8 * fq; const float* be = b2 + (size_t)u.e * DM;
        f32x4 bv[2][2];
#pragma unroll
        for (int bj = 0; bj < 2; ++bj)
#pragma unroll
            for (int n = 0; n < 2; ++n) bv[bj][n] = *(const f32x4*)(be + col0 + bj * HALF + 4 * n);
#pragma unroll
        for (int ai = 0; ai < 2; ++ai)
#pragma unroll
            for (int m = 0; m < 4; ++m) { const int row = u.rb + wr * 64 + fr + ai * HALF + m * 16; const int slot = row_slot[row]; const float w = row_w[row];
                if (slot >= 0) { bf16_t* rowp = YS + (size_t)slot * DM + col0;
#pragma unroll
                    for (int bj = 0; bj < 2; ++bj) { const f32x4 v0 = (acc[ai][bj][m][0] * W8_INV + bv[bj][0]) * w, v1 = (acc[ai][bj][m][1] * W8_INV + bv[bj][1]) * w;
                        u32x4 o; o.x = pk2(v0[0], v0[1]); o.y = pk2(v0[2], v0[3]); o.z = pk2(v1[0], v1[1]); o.w = pk2(v1[2], v1[3]); *(u32x4*)(rowp + bj * HALF) = o; } } }
    }
};
constexpr int MOE_MAXU = 12;
struct MoeOrder {
    StaticOrder so; const PG8_LAS int* utab; const PG8_LAS int* gtab;
    __device__ __forceinline__ bool next(int i, Unit& u) const { if (i >= MOE_MAXU || !so.next(i, u)) return false; const int v = __builtin_amdgcn_readfirstlane(utab[i]); u.e = v & 31; u.rb = (int)((unsigned)v >> 8); return true; }
    __device__ __forceinline__ void a_ready(const Unit&) const {}
    __device__ __forceinline__ void done(const Unit&) const {}
};
typedef int i32x4_t __attribute__((ext_vector_type(4))); typedef int i32x8_t __attribute__((ext_vector_type(8)));
__device__ __forceinline__ i32x8_t cat8(bf16x8 lo, bf16x8 hi) { return __builtin_shufflevector(__builtin_bit_cast(i32x4_t, lo), __builtin_bit_cast(i32x4_t, hi), 0, 1, 2, 3, 4, 5, 6, 7); }
__device__ __forceinline__ void mfma_fp8_inplace(f32x4& c, const i32x8_t a, const i32x8_t b) { asm volatile("s_nop 1\n\tv_mfma_f32_16x16x128_f8f6f4 %0, %1, %2, %0" : "+v"(c) : "v"(a), "v"(b)); }
__device__ __forceinline__ void mfma_fp8_drain() { asm volatile("s_nop 15\n\ts_nop 7" ::: "memory"); __builtin_amdgcn_sched_barrier(0); }
template <class Epi, class Sched, bool ALIGN_EPI = false, bool SP2 = false, bool FP8 = false, bool GATHER = false>
__device__ __forceinline__ void gemm_phase(PG8_LAS unsigned char* lds, const Gemm g, const Sched& S, const Epi& E) {
    const int tid = threadIdx.x, wid = __builtin_amdgcn_readfirstlane(tid >> 6), lane = tid & 63, wr = wid >> 2, wc = wid & 3, fr = lane & 15, fq = lane >> 4;
    const int K = g.K, nt = K / BK;
    static_assert(!GATHER || SP2, "GATHER is implemented for the SP2 loop only");
    const unsigned rowA = (unsigned)(g.lda ? g.lda : K) * 2u;
    unsigned voffA[2], voffB[2]; int gR0 = 0; unsigned gC = 0u;
#pragma unroll
    for (int i = 0; i < 2; ++i) { int R, C; stage_rc(tid * 16 + i * 8192, R, C); const int Rb = Epi::PERM ? ((R & ~31) + perm32(R & 31)) : R;
        voffA[i] = (unsigned)R * rowA + (unsigned)C * 2u; voffB[i] = (unsigned)(Rb * K + C) * 2u; if (i == 0) { gR0 = R; gC = (unsigned)C * 2u; } }
    unsigned gA[2][2] = {{0u, 0u}, {0u, 0u}}, ngA[2][2] = {{0u, 0u}, {0u, 0u}};
#define PG8_GLOAD(dst, ui_) do { _Pragma("unroll") for (int h_ = 0; h_ < 2; ++h_) _Pragma("unroll") for (int i_ = 0; i_ < 2; ++i_) \
        dst[h_][i_] = (unsigned)S.gtab[(ui_) * 256 + 128 * h_ + gR0 + 64 * i_] * rowA + gC; } while (0)
#define PG8_VA(h) (GATHER ? gA[h] : voffA)
    const unsigned kstep = (unsigned)(BK * 2);
    const unsigned hstep = (unsigned)HALF * (unsigned)K * 2u;
    const unsigned tstep = 2u * hstep;
    const unsigned hstepA = (unsigned)HALF * rowA, tstepA = 2u * hstepA;
    const unsigned hsA = GATHER ? 0u : hstepA;
    const unsigned ldsw = (unsigned)wid * 1024u;
    const int aoff = lds_byte(wr * 64 + fr, fq * 8), boff = lds_byte(wc * 32 + fr, fq * 8);
#define PG8_SA(b, h) (((b) * 2 + (h)) * HTB)
#define PG8_SB(b, h) ((4 + (b) * 2 + (h)) * HTB)
#define PG8_STAGE(rs, bufoff, goff, voff) do { _Pragma("unroll") for (int _i = 0; _i < 2; ++_i) \
        __builtin_amdgcn_raw_ptr_buffer_load_lds(rs, (PG8_LAS void*)(lds + (bufoff) + ldsw + _i * 8192), 16, (int)(voff)[_i], (int)(goff), 0, 0); } while (0)
#define PG8_LDA(dst, b, h) do { _Pragma("unroll") for (int m = 0; m < 4; ++m) _Pragma("unroll") for (int k = 0; k < 2; ++k) dst[m][k] = *(const PG8_LAS bf16x8*)(lds + PG8_SA(b, h) + aoff + m * 2048 + k * 1024); } while (0)
#define PG8_LDB(dst, b, h) do { _Pragma("unroll") for (int n = 0; n < 2; ++n) _Pragma("unroll") for (int k = 0; k < 2; ++k) dst[n][k] = *(const PG8_LAS bf16x8*)(lds + PG8_SB(b, h) + boff + n * 2048 + k * 1024); } while (0)
#define PG8_MMA(ai, bj, At, Bt) do { __builtin_amdgcn_s_setprio(1); _Pragma("unroll") for (int m = 0; m < 4; ++m) _Pragma("unroll") for (int n = 0; n < 2; ++n) { \
        if constexpr (FP8) { mfma_fp8_inplace(acc[ai][bj][m][n], cat8(Bt[n][0], Bt[n][1]), cat8(At[m][0], At[m][1])); } \
        else { _Pragma("unroll") for (int k = 0; k < 2; ++k) acc[ai][bj][m][n] = __builtin_amdgcn_mfma_f32_16x16x32_bf16(Bt[n][k], At[m][k], acc[ai][bj][m][n], 0, 0, 0); } } \
        __builtin_amdgcn_s_setprio(0); } while (0)
#define PG8_WAIT_V(n) asm volatile("s_waitcnt vmcnt(" #n ")" ::: "memory")
#define PG8_WAIT_L(n) asm volatile("s_waitcnt lgkmcnt(" #n ")" ::: "memory")
#define PG8_BAR __builtin_amdgcn_s_barrier()
#define PG8_SCHED __builtin_amdgcn_sched_barrier(0)
    Unit cur, nxt; int ui = 0;
    if (!S.next(0, cur)) return;
    f32x4 acc[2][2][4][2];
#pragma unroll
    for (int a = 0; a < 2; ++a)
#pragma unroll
        for (int b = 0; b < 2; ++b)
#pragma unroll
            for (int m = 0; m < 4; ++m)
#pragma unroll
                for (int n = 0; n < 2; ++n) acc[a][b][m][n] = (f32x4){0.f, 0.f, 0.f, 0.f};
    bf16x8 At[4][2], B0[2][2], B1[2][2];
    unsigned cA = GATHER ? 0u : (unsigned)cur.pm * tstepA, cB = (unsigned)cur.e * (unsigned)g.bstride + (unsigned)cur.pn * tstep;
    const __amdgpu_buffer_rsrc_t rsA = __builtin_amdgcn_make_buffer_rsrc((void*)g.A, 0, 0x7fffffff, 0x00020000), rsB = __builtin_amdgcn_make_buffer_rsrc((void*)g.Bt, 0, 0x7fffffff, 0x00020000);
    S.a_ready(cur);
    if constexpr (GATHER) PG8_GLOAD(gA, 0);
    if constexpr (SP2) {
        PG8_STAGE(rsB, PG8_SB(0, 0), cB, voffB); PG8_STAGE(rsB, PG8_SB(0, 1), cB + hstep, voffB); PG8_STAGE(rsA, PG8_SA(0, 0), cA, PG8_VA(0)); PG8_STAGE(rsA, PG8_SA(0, 1), cA + hsA, PG8_VA(1));
        if (wr == 1) PG8_BAR;
        PG8_WAIT_V(2); PG8_BAR;
        PG8_STAGE(rsB, PG8_SB(1, 0), cB + kstep, voffB); PG8_STAGE(rsA, PG8_SA(1, 0), cA + kstep, PG8_VA(0)); PG8_STAGE(rsB, PG8_SB(1, 1), cB + hstep + kstep, voffB);
        PG8_WAIT_V(6); PG8_BAR;
    } else {
        PG8_STAGE(rsB, PG8_SB(0, 0), cB, voffB); PG8_STAGE(rsA, PG8_SA(0, 0), cA, PG8_VA(0)); PG8_STAGE(rsB, PG8_SB(0, 1), cB + hstep, voffB); PG8_STAGE(rsA, PG8_SA(0, 1), cA + hsA, PG8_VA(1));
        if (wr == 1) PG8_BAR;
        PG8_WAIT_V(4); PG8_BAR;
        PG8_STAGE(rsB, PG8_SB(1, 0), cB + kstep, voffB); PG8_STAGE(rsA, PG8_SA(1, 0), cA + kstep, PG8_VA(0)); PG8_STAGE(rsB, PG8_SB(1, 1), cB + hstep + kstep, voffB);
        PG8_WAIT_V(6); PG8_BAR;
    }
    for (;;) {
        const bool has_next = S.next(ui + 1, nxt);
        if constexpr (GATHER) { if (has_next) PG8_GLOAD(ngA, ui + 1); else { ngA[0][0] = gA[0][0]; ngA[0][1] = gA[0][1]; ngA[1][0] = gA[1][0]; ngA[1][1] = gA[1][1]; } }
        const unsigned nA = (has_next && !GATHER) ? (unsigned)nxt.pm * tstepA : cA, nB = has_next ? (unsigned)nxt.e * (unsigned)g.bstride + (unsigned)nxt.pn * tstep : cB;
        for (int t = 0; t < nt; t += 2) {
            const bool last = (t == nt - 2);
            const unsigned a1 = cA + (unsigned)(t + 1) * kstep;
            const unsigned a2 = last ? nA : cA + (unsigned)(t + 2) * kstep, b2 = last ? nB : cB + (unsigned)(t + 2) * kstep;
            const unsigned a3 = a2 + kstep, b3 = b2 + kstep;
            if (last && has_next) S.a_ready(nxt);
            if constexpr (SP2) {
            PG8_LDB(B0, 0, 0); PG8_LDB(B1, 0, 1); PG8_SCHED; PG8_LDA(At, 0, 0); PG8_STAGE(rsA, PG8_SA(1, 1), a1 + hsA, PG8_VA(1));
            if constexpr (GATHER) { if (last) { gA[0][0] = ngA[0][0]; gA[0][1] = ngA[0][1]; gA[1][0] = ngA[1][0]; gA[1][1] = ngA[1][1]; } }
            PG8_WAIT_V(8); PG8_WAIT_L(0); PG8_BAR; PG8_MMA(0, 0, At, B0); PG8_MMA(0, 1, At, B1); PG8_BAR; PG8_SCHED;
            PG8_LDA(At, 0, 1); PG8_STAGE(rsB, PG8_SB(0, 0), b2, voffB); PG8_STAGE(rsB, PG8_SB(0, 1), b2 + hstep, voffB); PG8_STAGE(rsA, PG8_SA(0, 0), a2, PG8_VA(0));
            PG8_WAIT_V(8); PG8_WAIT_L(0); PG8_BAR; PG8_MMA(1, 0, At, B0); PG8_MMA(1, 1, At, B1); PG8_BAR; PG8_SCHED;
            PG8_LDB(B0, 1, 0); PG8_LDB(B1, 1, 1); PG8_SCHED; PG8_LDA(At, 1, 0); PG8_STAGE(rsA, PG8_SA(0, 1), a2 + hsA, PG8_VA(1));
            PG8_WAIT_V(8); PG8_WAIT_L(0); PG8_BAR; PG8_MMA(0, 0, At, B0); PG8_MMA(0, 1, At, B1); PG8_BAR; PG8_SCHED;
            PG8_LDA(At, 1, 1); PG8_STAGE(rsB, PG8_SB(1, 0), b3, voffB); PG8_STAGE(rsB, PG8_SB(1, 1), b3 + hstep, voffB); PG8_STAGE(rsA, PG8_SA(1, 0), a3, PG8_VA(0));
            PG8_WAIT_V(8); PG8_WAIT_L(0); PG8_BAR; PG8_MMA(1, 0, At, B0); PG8_MMA(1, 1, At, B1); PG8_BAR; PG8_SCHED;
            } else {
            PG8_LDB(B0, 0, 0); PG8_SCHED; PG8_LDA(At, 0, 0); PG8_STAGE(rsA, PG8_SA(1, 1), a1 + hsA, PG8_VA(1));
            PG8_WAIT_L(8); PG8_BAR; PG8_WAIT_L(0); PG8_MMA(0, 0, At, B0); PG8_BAR; PG8_SCHED;
            PG8_LDB(B1, 0, 1); PG8_STAGE(rsB, PG8_SB(0, 0), b2, voffB);
            PG8_BAR; PG8_WAIT_L(0); PG8_MMA(0, 1, At, B1); PG8_BAR;
            PG8_LDA(At, 0, 1); PG8_STAGE(rsA, PG8_SA(0, 0), a2, PG8_VA(0));
            PG8_BAR; PG8_WAIT_L(0); PG8_MMA(1, 0, At, B0); PG8_BAR; PG8_SCHED;
            PG8_STAGE(rsB, PG8_SB(0, 1), b2 + hstep, voffB);
            PG8_WAIT_V(6); PG8_BAR; PG8_MMA(1, 1, At, B1); PG8_BAR;
            PG8_LDB(B0, 1, 0); PG8_SCHED; PG8_LDA(At, 1, 0); PG8_STAGE(rsA, PG8_SA(0, 1), a2 + hsA, PG8_VA(1));
            PG8_WAIT_L(8); PG8_BAR; PG8_WAIT_L(0); PG8_MMA(0, 0, At, B0); PG8_BAR; PG8_SCHED;
            PG8_LDB(B1, 1, 1); PG8_STAGE(rsB, PG8_SB(1, 0), b3, voffB);
            PG8_BAR; PG8_WAIT_L(0); PG8_MMA(0, 1, At, B1); PG8_BAR;
            PG8_LDA(At, 1, 1); PG8_STAGE(rsA, PG8_SA(1, 0), a3, PG8_VA(0));
            PG8_BAR; PG8_WAIT_L(0); PG8_MMA(1, 0, At, B0); PG8_BAR; PG8_SCHED;
            PG8_STAGE(rsB, PG8_SB(1, 1), b3 + hstep, voffB);
            PG8_WAIT_V(6); PG8_BAR; PG8_MMA(1, 1, At, B1); PG8_BAR;
            }
        }
        if constexpr (ALIGN_EPI) { if (wr == 0) PG8_BAR; }
        if constexpr (FP8) mfma_fp8_drain();
        if constexpr (!Epi::AFTER_DRAIN) { E(acc, cur, wr, wc, fr, fq); S.done(cur); }
        if (!has_next) break;
#pragma unroll
        for (int a = 0; a < 2; ++a)
#pragma unroll
            for (int b = 0; b < 2; ++b)
#pragma unroll
                for (int m = 0; m < 4; ++m)
#pragma unroll
                    for (int n = 0; n < 2; ++n) acc[a][b][m][n] = (f32x4){0.f, 0.f, 0.f, 0.f};
        cur = nxt; cA = nA; cB = nB; ++ui;
        if constexpr (ALIGN_EPI) { if (wr == 1) PG8_BAR; }
    }
    PG8_WAIT_V(0);
    if constexpr (!ALIGN_EPI) { if (wr == 0) PG8_BAR; }
    PG8_BAR;
    if constexpr (Epi::AFTER_DRAIN) { E.fused(acc, cur, wr, wc, fr, fq, lds, wid, lane); S.done(cur); }
#undef PG8_SA
#undef PG8_GLOAD
#undef PG8_VA
#undef PG8_SB
#undef PG8_STAGE
#undef PG8_LDA
#undef PG8_LDB
#undef PG8_MMA
#undef PG8_WAIT_V
#undef PG8_WAIT_L
#undef PG8_BAR
#undef PG8_SCHED
}
}

#define GAS __attribute__((address_space(1)))
#define LAS __attribute__((address_space(3)))
#define XB_TMO      128
#define XB_XCNT(j)  (256  + 64 * (j))
#define XB_XSUB(j)  (1280 + 64 * (j))
#define XB_XGEN(j)  (2304 + 64 * (j))
#define XB_TOP      3328
#define XB_TOPGEN   3392
#define XCD_BAR_WORDS 3456
#define XB_SPIN_CAP (1u << 18)

__device__ __forceinline__ unsigned xb_ld(unsigned* p)              { return __hip_atomic_load(p, __ATOMIC_RELAXED, __HIP_MEMORY_SCOPE_AGENT); }
__device__ __forceinline__ unsigned xb_add(unsigned* p, unsigned v) { return __hip_atomic_fetch_add(p, v, __ATOMIC_RELAXED, __HIP_MEMORY_SCOPE_AGENT); }
__device__ __forceinline__ unsigned xb_xcc_id() { return (unsigned)__builtin_amdgcn_s_getreg((3 << 11) | 20) & 0xFu; }
#define XB_SPIN(cond, bar) do { unsigned _sp = 0; while (cond) { __builtin_amdgcn_s_sleep(1); \
    if ((++_sp & 255u) == 0u) { if (xb_ld(&(bar)[XB_TMO])) break; if (_sp > XB_SPIN_CAP) { atomicAdd(&(bar)[XB_TMO], 1u); break; } } } } while (0)

struct XcdBarrier {
    unsigned* bar; unsigned x;
    volatile LAS unsigned* st;
};

__device__ __forceinline__ XcdBarrier xcd_barrier_post(unsigned* bar, volatile LAS unsigned* st) {
    XcdBarrier b; b.bar = bar; b.x = xb_xcc_id(); b.st = st;
    if (threadIdx.x == 0) (void)xb_add(&bar[XB_XCNT(b.x)], 1u);
    return b;
}
__device__ __forceinline__ void xcd_barrier_complete(unsigned* bar, unsigned x, unsigned& nloc, unsigned& nx) {
    const unsigned G = gridDim.x * gridDim.y * gridDim.z;
    unsigned sum, cnt, mine, sp = 0u;
    for (;;) {
        sum = 0u; cnt = 0u; mine = 0u;
#pragma unroll
        for (unsigned j = 0; j < 16; ++j) { const unsigned c = xb_ld(&bar[XB_XCNT(j)]); sum += c; cnt += (c > 0u) ? 1u : 0u; mine = (j == x) ? c : mine; }
        if (sum == G) break;
        __builtin_amdgcn_s_sleep(1);
        if ((++sp & 255u) == 0u) { if (xb_ld(&bar[XB_TMO])) break; if (sp > XB_SPIN_CAP) { atomicAdd(&bar[XB_TMO], 1u); break; } }
    }
    nloc = mine > 0u ? mine : 1u; nx = cnt > 0u ? cnt : 1u;
}

__device__ __forceinline__ void xcd_barrier(const XcdBarrier& b) {
    asm volatile("s_waitcnt vmcnt(0)" ::: "memory");
    __syncthreads();
    if (threadIdx.x == 0) {
        unsigned* bar = b.bar;
        __builtin_amdgcn_s_waitcnt(0);
        unsigned nloc = b.st[0], nx = b.st[1];
        if (nloc == 0u) { xcd_barrier_complete(bar, b.x, nloc, nx); b.st[0] = nloc; b.st[1] = nx; }
        const unsigned old = xb_add(&bar[XB_XSUB(b.x)], 1u);
        const unsigned gen = old / nloc;
        if (old + 1u == (gen + 1u) * nloc) {
            __builtin_amdgcn_fence(__ATOMIC_RELEASE, "agent");
            asm volatile("s_waitcnt vmcnt(0)" ::: "memory");
            const unsigned og = xb_add(&bar[XB_TOP], 1u);
            const unsigned tg = og / nx;
            if (og + 1u == (tg + 1u) * nx) xb_add(&bar[XB_TOPGEN], 1u);
            else XB_SPIN(xb_ld(&bar[XB_TOPGEN]) == tg, bar);
            __builtin_amdgcn_fence(__ATOMIC_ACQUIRE, "agent");
            xb_add(&bar[XB_XGEN(b.x)], 1u);
            asm volatile("s_waitcnt vmcnt(0)" ::: "memory");
        } else {
            XB_SPIN(xb_ld(&bar[XB_XGEN(b.x)]) == gen, bar);
            __builtin_amdgcn_fence(__ATOMIC_ACQUIRE, "agent");
            asm volatile("s_waitcnt vmcnt(0)" ::: "memory");
        }
    }
    __syncthreads();
}

template <int MODE  >
__device__ __forceinline__ void transpose_item(const float* __restrict__ W, int K, int N, bf16_t* __restrict__ WT, const float* __restrict__ gain, float* scr, int item, int lane) {
    const int nblk = N / 32, kb = item / nblk, nb = item % nblk, k0 = 64 * kb, n0 = 32 * nb;
#pragma unroll
    for (int i = 0; i < 8; ++i) { const int kk = 8 * i + (lane >> 3), n4 = (lane & 7) * 4; f32x4 v = *(const f32x4*)(W + (size_t)(k0 + kk) * N + n0 + n4);
        if (gain) { const float g = gain[k0 + kk]; v = v * g; }
        float* s = scr + kk * 33 + n4; s[0] = v[0]; s[1] = v[1]; s[2] = v[2]; s[3] = v[3]; }
    asm volatile("s_waitcnt lgkmcnt(0)" ::: "memory");
    const int c = lane & 7;
#pragma unroll
    for (int j = 0; j < 4; ++j) { const int n = (lane >> 3) + 8 * j; const float* s = scr + (8 * c) * 33 + n;
        u32x4 o; o.x = pk2(s[0 * 33], s[1 * 33]); o.y = pk2(s[2 * 33], s[3 * 33]); o.z = pk2(s[4 * 33], s[5 * 33]); o.w = pk2(s[6 * 33], s[7 * 33]);
        int row = n0 + n;
        if (MODE == 1) { const int f = row & 1023; row = ((f >> 7) << 8) + ((row >> 10) << 7) + (f & 127); }
        *(u32x4*)(WT + (size_t)row * K + k0 + 8 * c) = o; }
    asm volatile("s_waitcnt lgkmcnt(0)" ::: "memory");
}
template <int MODE>
__device__ __forceinline__ void transpose_item_fp8(const float* __restrict__ W, int K, int N, unsigned char* __restrict__ WT, float* scr, int item, int lane) {
    const int nblk = N / 32, kb = item / nblk, nb = item % nblk, k0 = 64 * kb, n0 = 32 * nb;
#pragma unroll
    for (int i = 0; i < 8; ++i) { const int kk = 8 * i + (lane >> 3), n4 = (lane & 7) * 4; const f32x4 v = *(const f32x4*)(W + (size_t)(k0 + kk) * N + n0 + n4) * W8_SCALE;
        float* s = scr + kk * 33 + n4; s[0] = v[0]; s[1] = v[1]; s[2] = v[2]; s[3] = v[3]; }
    asm volatile("s_waitcnt lgkmcnt(0)" ::: "memory");
    const int c = lane & 7;
#pragma unroll
    for (int j = 0; j < 4; ++j) { const int n = (lane >> 3) + 8 * j; const float* s = scr + (8 * c) * 33 + n;
        u32x2 o; o.x = pk4_fp8(s[0 * 33], s[1 * 33], s[2 * 33], s[3 * 33]); o.y = pk4_fp8(s[4 * 33], s[5 * 33], s[6 * 33], s[7 * 33]);
        int row = n0 + n;
        if (MODE == 1) { const int f = row & 1023; row = ((f >> 7) << 8) + ((row >> 10) << 7) + (f & 127); }
        *(u32x2*)(WT + (size_t)row * K + k0 + 8 * c) = o; }
    asm volatile("s_waitcnt lgkmcnt(0)" ::: "memory");
}
__device__ __forceinline__ void phase_prologue(const Params& p, unsigned char* lds) {
    const int tid = threadIdx.x, lane = tid & 63, wave = tid >> 6;
    float* scr = (float*)(lds + wave * 16384);
    const int gw = blockIdx.x * NWAVES + wave, NGW = gridDim.x * NWAVES;
    unsigned char* ws = p.ws;
    constexpr int I_WIN = (DM / 64) * (INC / 32), I_UQ = (QLORA / 64) * (768 / 32), I_UKV = (KVLORA / 64) * (1024 / 32), I_OM = (512 / 64) * (DM / 32), I_OC = I_OM, I_WO = (DM / 64) * (DM / 32);
    constexpr int I_W1 = (DM / 64) * (2048 / 32), I_W2 = (DFF / 64) * (DM / 32);
    constexpr int NSMALL = I_WIN + I_UQ + I_UKV + I_OM + I_OC + I_WO;
    constexpr int NITEMS = NSMALL + NE * (I_W1 + I_W2);
    for (int it = gw; it < NITEMS; it += NGW) {
        int r = it;
        if (r < I_WIN) { transpose_item<0>(p.w_in, DM, INC, (bf16_t*)(ws + WS_WIN), p.norm1_g, scr, r, lane); continue; } r -= I_WIN;
        if (r < I_UQ) { transpose_item<0>(p.w_uq, QLORA, 768, (bf16_t*)(ws + WS_WUQ), p.q_a_g, scr, r, lane); continue; } r -= I_UQ;
        if (r < I_UKV) { transpose_item<0>(p.w_ukv, KVLORA, 1024, (bf16_t*)(ws + WS_WUKV), p.kv_a_g, scr, r, lane); continue; } r -= I_UKV;
        if (r < I_OM) { transpose_item<0>(p.w_o_mla, 512, DM, (bf16_t*)(ws + WS_WOMLA), nullptr, scr, r, lane); continue; } r -= I_OM;
        if (r < I_OC) { transpose_item<0>(p.w_o_conv, 512, DM, (bf16_t*)(ws + WS_WOCONV), nullptr, scr, r, lane); continue; } r -= I_OC;
        if (r < I_WO) { transpose_item<0>(p.w_o, DM, DM, (bf16_t*)(ws + WS_WO), nullptr, scr, r, lane); continue; } r -= I_WO;
        const int e = r / (I_W1 + I_W2); r -= e * (I_W1 + I_W2);
        if (r < I_W1) transpose_item_fp8<1>(p.w1 + (size_t)e * DM * 2048, DM, 2048, ws + WS_W1 + (size_t)e * 2048 * DM, scr, r, lane);
        else transpose_item_fp8<0>(p.w2 + (size_t)e * DFF * DM, DFF, DM, ws + WS_W2 + (size_t)e * DM * DFF, scr, r - I_W1, lane);
    }
    { u32x4* z = (u32x4*)((bf16_t*)(ws + WS_WIN) + (size_t)INC * DM); const int nz = (INCP - INC) * DM * 2 / 16;
      for (int i = blockIdx.x * NTHREADS + tid; i < nz; i += gridDim.x * NTHREADS) z[i] = (u32x4){0u, 0u, 0u, 0u}; }
    { int* rt = (int*)(ws + WS_RT2); int* rs = (int*)(ws + WS_RT2 + 4 * MiB); float* rr = (float*)(ws + WS_RT2 + 6 * MiB);
      for (int i = blockIdx.x * NTHREADS + tid; i < NE * CAP; i += gridDim.x * NTHREADS) { rt[i] = 0; rs[i] = -1; rr[i] = 0.f; } }
    { u32x4* GF = (u32x4*)(ws + WS_GF);
      for (int i = blockIdx.x * NTHREADS + tid; i < 64 * 64; i += gridDim.x * NTHREADS) { const int ks = i >> 6, ln = i & 63, r = ln & 31, h = ln >> 5; float v[8], lo[8]; unsigned hi[4];
#pragma unroll
          for (int j = 0; j < 8; ++j) { const int k = 16 * ks + 8 * h + j; v[j] = p.norm2_g[k] * p.router_w[(size_t)k * NE + r]; }
#pragma unroll
          for (int j = 0; j < 4; ++j) { hi[j] = pk2(v[2 * j], v[2 * j + 1]); lo[2 * j] = v[2 * j] - bf_lo(hi[j]); lo[2 * j + 1] = v[2 * j + 1] - bf_hi(hi[j]); }
          GF[(ks * 2 + 0) * 64 + ln] = (u32x4){hi[0], hi[1], hi[2], hi[3]}; GF[(ks * 2 + 1) * 64 + ln] = (u32x4){pk2(lo[0], lo[1]), pk2(lo[2], lo[3]), pk2(lo[4], lo[5]), pk2(lo[6], lo[7])}; } }
    bf16_t* XN = (bf16_t*)(ws + WS_XN);
    for (int m = gw; m < NTOK; m += NGW) {
        const f32x4* xr = (const f32x4*)(p.x + (size_t)m * DM) + lane; f32x4 v[4]; float s = 0.f;
#pragma unroll
        for (int j = 0; j < 4; ++j) { v[j] = xr[64 * j]; s += (v[j][0] * v[j][0] + v[j][1] * v[j][1]) + (v[j][2] * v[j][2] + v[j][3] * v[j][3]); }
        const float rstd = rsqrtf(wave_sum(s) * (1.f / DM) + EPS);
        u32x2* o = (u32x2*)(XN + (size_t)m * DM) + lane;
#pragma unroll
        for (int j = 0; j < 4; ++j) { u32x2 w; w.x = pk2(v[j][0] * rstd, v[j][1] * rstd); w.y = pk2(v[j][2] * rstd, v[j][3] * rstd); o[64 * j] = w; }
    }
}

constexpr float QSCALE = 0.10206207261596575f * 1.4426950408889634f;
__device__ __forceinline__ void phase_tok_b(const Params& p) {
    const int tid = threadIdx.x, lane = tid & 63, wave = tid >> 6, h = lane >> 3, sub = lane & 7;
    const int gw = blockIdx.x * NWAVES + wave, NGW = gridDim.x * NWAVES;
    const bf16_t* QPRE = (const bf16_t*)(p.ws + WS_QPRE); const bf16_t* KVPRE = (const bf16_t*)(p.ws + WS_KVPRE); const bf16_t* PROJ = (const bf16_t*)(p.ws + WS_PROJ);
    bf16_t* Q = (bf16_t*)(p.ws + WS_Q); bf16_t* Kb = (bf16_t*)(p.ws + WS_K); bf16_t* V = (bf16_t*)(p.ws + WS_V); bf16_t* YB = (bf16_t*)(p.ws + WS_YBIN);
    float qg[12], kg[12];
#pragma unroll
    for (int j = 0; j < 8; ++j) { qg[j] = p.q_g[sub * 8 + j]; kg[j] = p.k_g[sub * 8 + j]; }
    qg[8] = p.q_g[64 + 2 * sub]; qg[9] = p.q_g[65 + 2 * sub]; qg[10] = p.q_g[80 + 2 * sub]; qg[11] = p.q_g[81 + 2 * sub];
    kg[8] = p.k_g[64 + 2 * sub]; kg[9] = p.k_g[65 + 2 * sub]; kg[10] = p.k_g[80 + 2 * sub]; kg[11] = p.k_g[81 + 2 * sub];
    const float if0 = exp2f(-(float)(2 * sub) * (13.287712379549449f / 16.f)), if1 = exp2f(-(float)(2 * sub + 1) * (13.287712379549449f / 16.f));
    float cw0[8], cw1[8], cw2[8];
#pragma unroll
    for (int j = 0; j < 8; ++j) { cw0[j] = p.conv_w[8 * lane + j]; cw1[j] = p.conv_w[CONVW + 8 * lane + j]; cw2[j] = p.conv_w[2 * CONVW + 8 * lane + j]; }
    for (int t = gw; t < NTOK; t += NGW) {
        const int b = t >> 13, s = t & (SEQ - 1); const float pos = (float)p.pos[t];
        const bf16_t* pr = PROJ + (size_t)t * INCP;
        float rs_q, rs_kv;
        { const u32x2 w = *(const u32x2*)(pr + OFF_CQ + 4 * lane); const float a = bf_lo(w.x), bq = bf_hi(w.x), c = bf_lo(w.y), d = bf_hi(w.y); rs_q = rsqrtf(wave_sum(a * a + bq * bq + c * c + d * d) * (1.f / QLORA) + EPS); }
        { const unsigned w = *(const unsigned*)(pr + OFF_CKV + 2 * lane); const float a = bf_lo(w), bq = bf_hi(w); rs_kv = rsqrtf(wave_sum(a * a + bq * bq) * (1.f / KVLORA) + EPS); }
        { float cu[3][8];
#pragma unroll
          for (int d = 0; d < 3; ++d) { const int ss = s + d - 1; if (ss >= 0 && ss < SEQ) { const bf16_t* q = pr + (ptrdiff_t)(d - 1) * INCP; const u32x4 u = *(const u32x4*)(q + OFF_U + 8 * lane), c = *(const u32x4*)(q + OFF_C + 8 * lane);
                  cu[d][0] = bf_lo(u.x) * bf_lo(c.x); cu[d][1] = bf_hi(u.x) * bf_hi(c.x); cu[d][2] = bf_lo(u.y) * bf_lo(c.y); cu[d][3] = bf_hi(u.y) * bf_hi(c.y);
                  cu[d][4] = bf_lo(u.z) * bf_lo(c.z); cu[d][5] = bf_hi(u.z) * bf_hi(c.z); cu[d][6] = bf_lo(u.w) * bf_lo(c.w); cu[d][7] = bf_hi(u.w) * bf_hi(c.w); }
              else {
#pragma unroll
                  for (int j = 0; j < 8; ++j) cu[d][j] = 0.f; } }
          const u32x4 bg = *(const u32x4*)(pr + OFF_B + 8 * lane); float bb[8] = {bf_lo(bg.x), bf_hi(bg.x), bf_lo(bg.y), bf_hi(bg.y), bf_lo(bg.z), bf_hi(bg.z), bf_lo(bg.w), bf_hi(bg.w)}; float y[8];
#pragma unroll
          for (int j = 0; j < 8; ++j) y[j] = bb[j] * (cw0[j] * cu[0][j] + cw1[j] * cu[1][j] + cw2[j] * cu[2][j]);
          u32x4 o; o.x = pk2(y[0], y[1]); o.y = pk2(y[2], y[3]); o.z = pk2(y[4], y[5]); o.w = pk2(y[6], y[7]); *(u32x4*)(YB + (size_t)t * CONVW + 8 * lane) = o; }
        float c0, s0, c1, s1; sincosf(pos * if0, &s0, &c0); sincosf(pos * if1, &s1, &c1);
        const size_t rowi = ((size_t)(b * NH + h) * SEQ + s);
        { const bf16_t* qp = QPRE + (size_t)t * 768 + h * DQK; const u32x4 a = *(const u32x4*)(qp + sub * 8); const unsigned r1 = *(const unsigned*)(qp + 64 + 2 * sub), r2 = *(const unsigned*)(qp + 80 + 2 * sub);
          float v[12] = {bf_lo(a.x), bf_hi(a.x), bf_lo(a.y), bf_hi(a.y), bf_lo(a.z), bf_hi(a.z), bf_lo(a.w), bf_hi(a.w), bf_lo(r1), bf_hi(r1), bf_lo(r2), bf_hi(r2)}; float ss = 0.f;
#pragma unroll
          for (int j = 0; j < 12; ++j) { v[j] *= rs_q; ss += v[j] * v[j]; }
          ss += __shfl_xor(ss, 1); ss += __shfl_xor(ss, 2); ss += __shfl_xor(ss, 4);
          const float rstd = rsqrtf(ss * (1.f / DQK) + EPS);
#pragma unroll
          for (int j = 0; j < 12; ++j) v[j] *= rstd * qg[j] * QSCALE;
          const float o8 = v[8] * c0 - v[10] * s0, o9 = v[9] * c1 - v[11] * s1, o10 = v[8] * s0 + v[10] * c0, o11 = v[9] * s1 + v[11] * c1;
          bf16_t* qo = Q + rowi * DQK; u32x4 w; w.x = pk2(v[0], v[1]); w.y = pk2(v[2], v[3]); w.z = pk2(v[4], v[5]); w.w = pk2(v[6], v[7]);
          *(u32x4*)(qo + sub * 8) = w; *(unsigned*)(qo + 64 + 2 * sub) = pk2(o8, o9); *(unsigned*)(qo + 80 + 2 * sub) = pk2(o10, o11); }
        { const bf16_t* kp = KVPRE + (size_t)t * 1024 + h * 128; const u32x4 a = *(const u32x4*)(kp + sub * 8);
          const bf16_t* kr = pr + OFF_KR; const unsigned w1 = *(const unsigned*)(kr + 2 * sub), w2 = *(const unsigned*)(kr + 16 + 2 * sub);
          float v[12] = {bf_lo(a.x) * rs_kv, bf_hi(a.x) * rs_kv, bf_lo(a.y) * rs_kv, bf_hi(a.y) * rs_kv, bf_lo(a.z) * rs_kv, bf_hi(a.z) * rs_kv, bf_lo(a.w) * rs_kv, bf_hi(a.w) * rs_kv, bf_lo(w1), bf_hi(w1), bf_lo(w2), bf_hi(w2)}; float ss = 0.f;
#pragma unroll
          for (int j = 0; j < 12; ++j) ss += v[j] * v[j];
          ss += __shfl_xor(ss, 1); ss += __shfl_xor(ss, 2); ss += __shfl_xor(ss, 4);
          const float rstd = rsqrtf(ss * (1.f / DQK) + EPS);
#pragma unroll
          for (int j = 0; j < 12; ++j) v[j] *= rstd * kg[j];
          const float o8 = v[8] * c0 - v[10] * s0, o9 = v[9] * c1 - v[11] * s1, o10 = v[8] * s0 + v[10] * c0, o11 = v[9] * s1 + v[11] * c1;
          bf16_t* ko = Kb + rowi * 128; u32x4 w; w.x = pk2(v[0], v[1]); w.y = pk2(v[2], v[3]); w.z = pk2(v[4], v[5]); w.w = pk2(v[6], v[7]);
          *(u32x4*)(ko + sub * 8) = w; *(unsigned*)(ko + 64 + 2 * sub) = pk2(o8, o9); *(unsigned*)(ko + 80 + 2 * sub) = pk2(o10, o11);
          if (sub < 4) *(u32x4*)(ko + 96 + sub * 8) = (u32x4){0u, 0u, 0u, 0u};
          const u32x4 va = *(const u32x4*)(kp + 64 + sub * 8);
          u32x4 wv; wv.x = pk2(bf_lo(va.x) * rs_kv, bf_hi(va.x) * rs_kv); wv.y = pk2(bf_lo(va.y) * rs_kv, bf_hi(va.y) * rs_kv); wv.z = pk2(bf_lo(va.z) * rs_kv, bf_hi(va.z) * rs_kv); wv.w = pk2(bf_lo(va.w) * rs_kv, bf_hi(va.w) * rs_kv);
          *(u32x4*)(V + rowi * DV + sub * 8) = wv; }
    }
}

namespace att {
constexpr int NW = 8, QBLK = 32, KVBLK = 64;
constexpr float SCALE = 0.10206207261596575f;
constexpr float QSC = SCALE * 1.4426950408889634f;
constexpr int LDQ = DQK, LDK = 128, LDV = DV;
constexpr int SHM_V = KVBLK * DV * 2, SHM_K = KVBLK * 256, SHM_ATTN = 2 * SHM_V + 2 * SHM_K + NW * 64 * 4;
#define KSWZ(row, colB) ((row) * 256 + ((colB) ^ (((row) & 7) << 4)))
#define SBAR() __builtin_amdgcn_sched_barrier(0)
__device__ __forceinline__ int crow(int r, int hi) { return (r & 3) + 8 * (r >> 2) + 4 * hi; }
__device__ __forceinline__ unsigned cvtpk(float lo, float hi) { unsigned r; asm volatile("v_cvt_pk_bf16_f32 %0, %1, %2" : "=v"(r) : "v"(lo), "v"(hi)); return r; }
#define EXPH(P) do { _Pragma("unroll") for (int r = 0; r < 16; ++r) P[r] = __builtin_amdgcn_exp2f(P[r]); } while (0)
__device__ __forceinline__ void finishSM(f32x16& p0, f32x16& p1, float& l_reg, bf16x8& pa0, bf16x8& pa1, bf16x8& pa2, bf16x8& pa3) {
    EXPH(p1);
    float ps0 = 0.f, ps1 = 0.f;
#pragma unroll
    for (int r = 0; r < 16; ++r) { ps0 += p0[r]; ps1 += p1[r]; }
    l_reg += ps0 + ps1;
#define PK4(P, BASE, OUT) do { unsigned a0 = cvtpk(P[BASE + 0], P[BASE + 1]), a1 = cvtpk(P[BASE + 2], P[BASE + 3]);   \
    unsigned b0 = cvtpk(P[BASE + 4], P[BASE + 5]), b1 = cvtpk(P[BASE + 6], P[BASE + 7]);                              \
    auto r0 = __builtin_amdgcn_permlane32_swap(a0, b0, false, false); auto r1 = __builtin_amdgcn_permlane32_swap(a1, b1, false, false); \
    u32x4 w = {r0[0], r1[0], r0[1], r1[1]}; OUT = *reinterpret_cast<bf16x8*>(&w); } while (0)
    PK4(p0, 0, pa0); PK4(p0, 8, pa1); PK4(p1, 0, pa2); PK4(p1, 8, pa3);
#undef PK4
}
__device__ __forceinline__ void qkt(f32x16& p0, f32x16& p1, const unsigned char* Ks, const bf16x8* qr, int r32, int hi) {
    p0 = f32x16{}; p1 = f32x16{};
#pragma unroll
    for (int d0 = 0; d0 < 6; ++d0) { const int cb = (d0 * 16 + hi * 8) * 2;
        const bf16x8 b0 = *reinterpret_cast<const bf16x8*>(Ks + KSWZ(r32, cb));
        const bf16x8 b1 = *reinterpret_cast<const bf16x8*>(Ks + KSWZ(32 + r32, cb));
        p0 = __builtin_amdgcn_mfma_f32_32x32x16_bf16(b0, qr[d0], p0, 0, 0, 0);
        p1 = __builtin_amdgcn_mfma_f32_32x32x16_bf16(b1, qr[d0], p1, 0, 0, 0); }
}
__device__ __forceinline__ int v_st(int k, int c) { const int kk = (k & ~0xC) | ((k & 4) << 1) | ((k & 8) >> 1); return ((kk >> 3) * 2 + (c >> 5)) * 512 + ((kk & 7) * 32 + (c & 31)) * 2; }
__device__ __forceinline__ int v_rd_base(int lane) { return ((lane & 3) << 3) | (((lane >> 2) & 3) << 6) | (((lane >> 4) & 1) << 5) | (((lane >> 5) & 1) << 8); }
constexpr int v_rd_off(int d0, int ks, int half) { return d0 * 512 + ks * 2048 + half * 1024; }
template <int OFF> __device__ __forceinline__ s16x4 tr_read(int vb) { s16x4 r; asm volatile("ds_read_b64_tr_b16 %0, %1 offset:%2" : "=&v"(r) : "v"(vb), "i"(OFF) : "memory"); return r; }
template <int D0> __device__ __forceinline__ void pv_one(f32x16& od, int vb, bf16x8 pa0, bf16x8 pa1, bf16x8 pa2, bf16x8 pa3) {
    const s16x4 l0 = tr_read<v_rd_off(D0, 0, 0)>(vb), h0 = tr_read<v_rd_off(D0, 0, 1)>(vb), l1 = tr_read<v_rd_off(D0, 1, 0)>(vb), h1 = tr_read<v_rd_off(D0, 1, 1)>(vb);
    const s16x4 l2 = tr_read<v_rd_off(D0, 2, 0)>(vb), h2 = tr_read<v_rd_off(D0, 2, 1)>(vb), l3 = tr_read<v_rd_off(D0, 3, 0)>(vb), h3 = tr_read<v_rd_off(D0, 3, 1)>(vb);
    asm volatile("s_waitcnt lgkmcnt(0)" ::: "memory"); SBAR();
#define PK(L, H) (bf16x8){L[0], L[1], L[2], L[3], H[0], H[1], H[2], H[3]}
    od = __builtin_amdgcn_mfma_f32_32x32x16_bf16(pa0, PK(l0, h0), od, 0, 0, 0);
    od = __builtin_amdgcn_mfma_f32_32x32x16_bf16(pa1, PK(l1, h1), od, 0, 0, 0);
    od = __builtin_amdgcn_mfma_f32_32x32x16_bf16(pa2, PK(l2, h2), od, 0, 0, 0);
    od = __builtin_amdgcn_mfma_f32_32x32x16_bf16(pa3, PK(l3, h3), od, 0, 0, 0);
#undef PK
}
__device__ __forceinline__ void pv_d0(f32x16* o, int vb, bf16x8 pa0, bf16x8 pa1, bf16x8 pa2, bf16x8 pa3) { pv_one<0>(o[0], vb, pa0, pa1, pa2, pa3); pv_one<1>(o[1], vb, pa0, pa1, pa2, pa3); }

__device__ __forceinline__ void attn_unit(const bf16_t* __restrict__ Qb, const bf16_t* __restrict__ Kh, const bf16_t* __restrict__ Vh, bf16_t* __restrict__ Ob, int seq, unsigned char* lds) {
    const int tid = threadIdx.x, wid = tid >> 6, lane = tid & 63, r32 = lane & 31, hi = lane >> 5;
    unsigned char* V_lds = lds; unsigned char* K_lds = lds + 2 * SHM_V;
    float* wsf = (float*)(lds + 2 * SHM_V + 2 * SHM_K) + wid * 64; float* li_l = wsf;
    float l_reg = 0; f32x16 o[2] = {}; bf16x8 qr[6];
    const bf16_t* Qw = Qb + (size_t)(wid * QBLK + r32) * LDQ + hi * 8;
#pragma unroll
    for (int d0 = 0; d0 < 6; ++d0) qr[d0] = *reinterpret_cast<const bf16x8*>(Qw + d0 * 16);
    const int sr = tid >> 4, sc = (tid & 15) * 8;
    const int vr = tid >> 3, vc = (tid & 7) * 8, vst = v_st(vr, vc);
    const int vb0 = (int)(uintptr_t)V_lds + v_rd_base(lane);
    struct { bf16x8 vs, ks0, ks1; } sr_;
#define SLOAD(k0) do { sr_.vs = *reinterpret_cast<const bf16x8*>(&Vh[(size_t)((k0) + vr) * LDV + vc]); \
    sr_.ks0 = *reinterpret_cast<const bf16x8*>(&Kh[(size_t)((k0) + sr) * LDK + sc]); sr_.ks1 = *reinterpret_cast<const bf16x8*>(&Kh[(size_t)((k0) + 32 + sr) * LDK + sc]); } while (0)
#define SWRITE(b) do { *(bf16x8*)(V_lds + (b) * SHM_V + vst) = sr_.vs; const int kc = sc * 2;               \
    *(bf16x8*)(K_lds + (b) * SHM_K + KSWZ(sr, kc)) = sr_.ks0; *(bf16x8*)(K_lds + (b) * SHM_K + KSWZ(32 + sr, kc)) = sr_.ks1; } while (0)
    f32x16 pA0, pA1, pB0, pB1; bf16x8 pa0, pa1, pa2, pa3; const int NT = seq / KVBLK;
    SLOAD(0); SWRITE(0); __syncthreads();
    qkt(pA0, pA1, K_lds, qr, r32, hi); EXPH(pA0);
    SLOAD(KVBLK); SWRITE(1); __syncthreads();
    for (int j = 1; j + 1 < NT; j += 2) {
        SBAR(); qkt(pB0, pB1, K_lds + SHM_K, qr, r32, hi);
        finishSM(pA0, pA1, l_reg, pa0, pa1, pa2, pa3); SBAR();
        SLOAD((j + 1) * KVBLK); SBAR();
        pv_d0(o, vb0, pa0, pa1, pa2, pa3); EXPH(pB0); SBAR();
        __syncthreads(); SWRITE(0);
        __syncthreads();
        SBAR(); qkt(pA0, pA1, K_lds, qr, r32, hi);
        finishSM(pB0, pB1, l_reg, pa0, pa1, pa2, pa3); SBAR();
        SLOAD((j + 2) * KVBLK); SBAR();
        pv_d0(o, vb0 + SHM_V, pa0, pa1, pa2, pa3); EXPH(pA0); SBAR();
        __syncthreads(); SWRITE(1);
        __syncthreads();
    }
    SBAR(); qkt(pB0, pB1, K_lds + SHM_K, qr, r32, hi);
    finishSM(pA0, pA1, l_reg, pa0, pa1, pa2, pa3); SBAR();
    pv_d0(o, vb0, pa0, pa1, pa2, pa3); EXPH(pB0);
    finishSM(pB0, pB1, l_reg, pa0, pa1, pa2, pa3); SBAR();
    pv_d0(o, vb0 + SHM_V, pa0, pa1, pa2, pa3);
    { auto rr = __builtin_amdgcn_permlane32_swap(__float_as_uint(l_reg), __float_as_uint(l_reg), false, false); l_reg = __uint_as_float(rr[0]) + __uint_as_float(rr[1]); }
    if (hi == 0) li_l[r32] = l_reg; asm volatile("s_waitcnt lgkmcnt(0)" ::: "memory");
    float rli[16];
#pragma unroll
    for (int r = 0; r < 16; ++r) rli[r] = __builtin_amdgcn_rcpf(li_l[crow(r, hi)]);
    bf16_t* Ow = Ob + (size_t)(wid * QBLK) * 512;
#pragma unroll
    for (int r = 0; r < 16; ++r) { const int orow = crow(r, hi);
#pragma unroll
        for (int d0 = 0; d0 < 2; ++d0) Ow[(size_t)orow * 512 + d0 * 32 + r32] = (bf16_t)(pk2(o[d0][r] * rli[r], 0.f) & 0xffffu); }
    __syncthreads();
#undef SLOAD
#undef SWRITE
}
#undef KSWZ
#undef SBAR
}

__device__ __forceinline__ void phase_attn(const Params& p, unsigned char* lds) {
    const bf16_t* Q = (const bf16_t*)(p.ws + WS_Q); const bf16_t* Kb = (const bf16_t*)(p.ws + WS_K); const bf16_t* V = (const bf16_t*)(p.ws + WS_V); bf16_t* AO = (bf16_t*)(p.ws + WS_AO);
    constexpr int NQB = SEQ / 256, NU = 2 * NH * NQB;
    for (int u = blockIdx.x; u < NU; u += gridDim.x) {
        const int qb = u % NQB, h = (u / NQB) % NH, b = u / (NQB * NH); const size_t bh = (size_t)(b * NH + h) * SEQ;
        att::attn_unit(Q + (bh + (size_t)qb * 256) * DQK, Kb + bh * 128, V + bh * DV, AO + ((size_t)b * SEQ + (size_t)qb * 256) * 512 + h * DV, SEQ, lds);
    }
}

__device__ __forceinline__ int crow16(int r, int hi) { return (r & 3) + 8 * (r >> 2) + 4 * hi; }
__device__ __forceinline__ void phase_router(const Params& p, unsigned char* lds) {
    const int tid = threadIdx.x, lane = tid & 63, wid = tid >> 6, tile = wid >> 2, kq = wid & 3, c = lane & 31, h = lane >> 5;
    float* red = (float*)lds;
    float* ssb = red + 2 * 4 * 16 * 64;
    int* lcnt = (int*)(ssb + 2 * 4 * 64);
    int* lbase = lcnt + 32;
    unsigned* gcnt = (unsigned*)(p.ws + WS_CTL) + CW_CNT;
    int* row_tok = (int*)(p.ws + WS_RT2); float* row_w = (float*)(p.ws + WS_RT2 + 2 * MiB); int* row_slot = (int*)(p.ws + WS_RT2 + 4 * MiB); float* row_rstd = (float*)(p.ws + WS_RT2 + 6 * MiB);
    const u32x4* GF = (const u32x4*)(p.ws + WS_GF);
    for (int tg = blockIdx.x; tg < NTOK / 64; tg += gridDim.x) {
        if (tid < 32) lcnt[tid] = 0;
        const int token = tg * 64 + tile * 32 + c;
        const float* xrow = p.out + (size_t)token * DM + kq * 256 + 8 * h; const float* g2p = p.norm2_g + kq * 256 + 8 * h;
        unsigned char* hrow = p.ws + WS_H8 + (size_t)token * DM + kq * 256 + 8 * h;
        f32x16 acc = {}; float ss = 0.f;
#pragma unroll 2
        for (int s = 0; s < 16; ++s) {
            const f32x4 a = *(const f32x4*)(xrow + 16 * s), b = *(const f32x4*)(xrow + 16 * s + 4); const f32x4 ga = *(const f32x4*)(g2p + 16 * s), gb = *(const f32x4*)(g2p + 16 * s + 4);
            ss += (a[0] * a[0] + a[1] * a[1]) + (a[2] * a[2] + a[3] * a[3]) + (b[0] * b[0] + b[1] * b[1]) + (b[2] * b[2] + b[3] * b[3]);
            u32x4 xh; xh.x = pk2(a[0], a[1]); xh.y = pk2(a[2], a[3]); xh.z = pk2(b[0], b[1]); xh.w = pk2(b[2], b[3]);
            u32x4 xl; xl.x = pk2(a[0] - bf_lo(xh.x), a[1] - bf_hi(xh.x)); xl.y = pk2(a[2] - bf_lo(xh.y), a[3] - bf_hi(xh.y)); xl.z = pk2(b[0] - bf_lo(xh.z), b[1] - bf_hi(xh.z)); xl.w = pk2(b[2] - bf_lo(xh.w), b[3] - bf_hi(xh.w));
            u32x2 h8; h8.x = pk4_fp8(a[0] * ga[0], a[1] * ga[1], a[2] * ga[2], a[3] * ga[3]); h8.y = pk4_fp8(b[0] * gb[0], b[1] * gb[1], b[2] * gb[2], b[3] * gb[3]); *(u32x2*)(hrow + 16 * s) = h8;
            const u32x4 gh = GF[((kq * 16 + s) * 2 + 0) * 64 + lane], gl = GF[((kq * 16 + s) * 2 + 1) * 64 + lane];
            acc = __builtin_amdgcn_mfma_f32_32x32x16_bf16(__builtin_bit_cast(bf16x8, gh), __builtin_bit_cast(bf16x8, xh), acc, 0, 0, 0);
            acc = __builtin_amdgcn_mfma_f32_32x32x16_bf16(__builtin_bit_cast(bf16x8, gh), __builtin_bit_cast(bf16x8, xl), acc, 0, 0, 0);
            acc = __builtin_amdgcn_mfma_f32_32x32x16_bf16(__builtin_bit_cast(bf16x8, gl), __builtin_bit_cast(bf16x8, xh), acc, 0, 0, 0);
        }
#pragma unroll
        for (int r = 0; r < 16; ++r) red[((tile * 4 + kq) * 16 + r) * 64 + lane] = acc[r];
        ssb[(tile * 4 + kq) * 64 + lane] = ss;
        __syncthreads();
        int te[4] = {0, 0, 0, 0}, rl[4] = {0, 0, 0, 0}; float tw[4] = {0.f, 0.f, 0.f, 0.f}; float rstd = 0.f;
        if (kq == 0) {
            float v[16]; float st = 0.f;
#pragma unroll
            for (int q = 0; q < 4; ++q) st += ssb[(tile * 4 + q) * 64 + lane];
            { auto rr = __builtin_amdgcn_permlane32_swap(__float_as_uint(st), __float_as_uint(st), false, false); st = __uint_as_float(rr[0]) + __uint_as_float(rr[1]); }
            rstd = rsqrtf(st * (1.f / DM) + EPS);
#pragma unroll
            for (int r = 0; r < 16; ++r) { float sacc = 0.f;
#pragma unroll
                for (int q = 0; q < 4; ++q) sacc += red[((tile * 4 + q) * 16 + r) * 64 + lane];
                v[r] = sacc * rstd + p.router_b[crow16(r, h)]; }
            float lv[4]; int le[4];
#pragma unroll
            for (int k = 0; k < 4; ++k) { float best = v[0]; int bi = 0;
#pragma unroll
                for (int r = 1; r < 16; ++r) { const bool gt = v[r] > best; best = gt ? v[r] : best; bi = gt ? r : bi; }
                lv[k] = best; le[k] = (bi & 3) + 8 * (bi >> 2) + 4 * h;
#pragma unroll
                for (int r = 0; r < 16; ++r) v[r] = (r == bi) ? -INFINITY : v[r]; }
            float cv[8]; int ce[8];
#pragma unroll
            for (int k = 0; k < 4; ++k) { auto rv = __builtin_amdgcn_permlane32_swap(__float_as_uint(lv[k]), __float_as_uint(lv[k]), false, false); auto re = __builtin_amdgcn_permlane32_swap((unsigned)le[k], (unsigned)le[k], false, false);
                cv[k] = __uint_as_float(rv[0]); cv[4 + k] = __uint_as_float(rv[1]); ce[k] = (int)re[0]; ce[4 + k] = (int)re[1]; }
            float tv[4];
#pragma unroll
            for (int k = 0; k < 4; ++k) { float best = cv[0]; int be = ce[0]; int bi = 0;
#pragma unroll
                for (int r = 1; r < 8; ++r) { const bool gt = (cv[r] > best) || (cv[r] == best && ce[r] < be); best = gt ? cv[r] : best; be = gt ? ce[r] : be; bi = gt ? r : bi; }
                tv[k] = best; te[k] = be;
#pragma unroll
                for (int r = 0; r < 8; ++r) cv[r] = (r == bi) ? -INFINITY : cv[r]; }
            const float e1 = __expf(tv[1] - tv[0]), e2 = __expf(tv[2] - tv[0]), e3 = __expf(tv[3] - tv[0]); const float inv = 1.f / (1.f + e1 + e2 + e3);
            tw[0] = inv; tw[1] = e1 * inv; tw[2] = e2 * inv; tw[3] = e3 * inv;
            if (h == 0) {
#pragma unroll
                for (int k = 0; k < 4; ++k) rl[k] = atomicAdd(&lcnt[te[k]], 1); }
        }
        __syncthreads();
        if (tid < 32) lbase[tid] = (int)atomicAdd(&gcnt[tid], (unsigned)lcnt[tid]);
        __syncthreads();
        if (kq == 0 && h == 0) {
#pragma unroll
            for (int k = 0; k < 4; ++k) { const int idx = te[k] * CAP + lbase[te[k]] + rl[k]; row_tok[idx] = token; row_w[idx] = tw[k]; row_slot[idx] = token * 4 + k; row_rstd[idx] = rstd; } }
        __syncthreads();
    }
}

__device__ __forceinline__ void build_block_table(const Params& p, int* bs) {
    const unsigned* gcnt = (const unsigned*)(p.ws + WS_CTL) + CW_CNT;
    if (threadIdx.x == 0) { int acc = 0; for (int e = 0; e < NE; ++e) { bs[e] = acc; acc += ((int)__hip_atomic_load(gcnt + e, __ATOMIC_RELAXED, __HIP_MEMORY_SCOPE_AGENT) + 255) >> 8; } bs[NE] = acc; }
    __syncthreads();
}

__device__ __forceinline__ pg8::MoeOrder make_moe_order(const Params& p, unsigned char* lds, int N, bool gather) {
    int* bs = (int*)(lds + 131072); int* utab = (int*)(lds + 131072 + 256); int* gtab = (int*)(lds + 131072 + 512);
    build_block_table(p, bs);
    const int nmb = __builtin_amdgcn_readfirstlane(bs[NE]);
    pg8::MoeOrder S; S.so.init(nmb * 256, N, (int)gridDim.x, (int)blockIdx.x); S.utab = (const PG8_LAS int*)utab; S.gtab = (const PG8_LAS int*)gtab;
    const int* row_tok = (const int*)(p.ws + WS_RT2);
    for (int i = 0; i < pg8::MOE_MAXU; ++i) { pg8::Unit u; if (!S.so.next(i, u)) break; int e = 0; for (int k = 1; k < NE; ++k) if (bs[k] <= u.pm) e = k;
        const int rb = e * CAP + (u.pm - bs[e]) * 256;
        if (threadIdx.x == 0) utab[i] = e | (rb << 8);
        if (gather && threadIdx.x < 256) gtab[i * 256 + threadIdx.x] = row_tok[rb + threadIdx.x]; }
    __syncthreads();
    return S;
}
__device__ __forceinline__ void phase_moe1(const Params& p, unsigned char* lds) {
    const pg8::MoeOrder S = make_moe_order(p, lds, 2048, true);
    pg8::Gemm g{(const bf16_t*)(p.ws + WS_H8), (const bf16_t*)(p.ws + WS_W1), 0, 2048, DM / 2, (size_t)2048 * DM, 0};
    pg8::EpiSwiglu E{p.ws + WS_ACT, p.b1, (const float*)(p.ws + WS_RT2 + 6 * MiB)};
    pg8::gemm_phase<pg8::EpiSwiglu, pg8::MoeOrder, true, true, true, true>((PG8_LAS unsigned char*)lds, g, S, E);
}
__device__ __forceinline__ void phase_moe2(const Params& p, unsigned char* lds) {
    const pg8::MoeOrder S = make_moe_order(p, lds, DM, false);
    pg8::Gemm g{(const bf16_t*)(p.ws + WS_ACT), (const bf16_t*)(p.ws + WS_W2), 0, DM, DFF / 2, (size_t)DM * DFF, 0};
    pg8::EpiMoeOut E{(bf16_t*)(p.ws + WS_YS), p.b2, (const float*)(p.ws + WS_RT2 + 2 * MiB), (const int*)(p.ws + WS_RT2 + 4 * MiB)};
    pg8::gemm_phase<pg8::EpiMoeOut, pg8::MoeOrder, true, true, true>((PG8_LAS unsigned char*)lds, g, S, E);
}

__device__ __forceinline__ void phase_combine(const Params& p) {
    const int tid = threadIdx.x, lane = tid & 63, wave = tid >> 6;
    const int gw = blockIdx.x * NWAVES + wave, NGW = gridDim.x * NWAVES;
    const bf16_t* YS = (const bf16_t*)(p.ws + WS_YS);
    for (int t = gw; t < NTOK; t += NGW) {
        f32x4* orow = (f32x4*)(p.out + (size_t)t * DM) + lane;
#pragma unroll
        for (int j = 0; j < 4; ++j) { f32x4 v = orow[64 * j];
#pragma unroll
            for (int k = 0; k < 4; ++k) { const u32x2 w = *((const u32x2*)(YS + ((size_t)t * 4 + k) * DM) + lane + 64 * j); v[0] += bf_lo(w.x); v[1] += bf_hi(w.x); v[2] += bf_lo(w.y); v[3] += bf_hi(w.y); }
            orow[64 * j] = v; }
    }
}

template <class Epi>
__device__ __forceinline__ void dense_gemm(unsigned char* lds, const bf16_t* A, const bf16_t* Bt, int M, int N, int K, const Epi& E, int lda = 0) {
    pg8::Gemm g{A, Bt, M, N, K, 0, lda}; pg8::StaticOrder S; S.init(M, N, (int)gridDim.x, (int)blockIdx.x);
    pg8::gemm_phase<Epi, pg8::StaticOrder, true, true>((PG8_LAS unsigned char*)lds, g, S, E);
}

constexpr int NPHASE = 13;
__global__ void __launch_bounds__(NTHREADS, 2) mk_fwd(Params p) {
    extern __shared__ __attribute__((aligned(16))) unsigned char lds[];
    cg::grid_group grid = cg::this_grid();
    unsigned char* ws = p.ws;
    volatile LAS unsigned* MISC = (volatile LAS unsigned*)((LAS unsigned char*)lds + MISC_OFF);
    if (threadIdx.x < 32) MISC[threadIdx.x] = 0u;
    __syncthreads();
    XcdBarrier bar = xcd_barrier_post((unsigned*)(ws + WS_CTL) + CW_BAR, MISC + 8);
    const int lo = p.ph_lo, hi = p.ph_hi;
    if (lo < 0) grid.sync();
#define IN(k) (lo <= (k) && (k) < hi)
#define SEAM(k) do { if (IN(k) && IN((k) + 1)) xcd_barrier(bar); } while (0)
    if (IN(0)) phase_prologue(p, lds);
    SEAM(0);
    if (IN(1)) { pg8::EpiProj E{(bf16_t*)(ws + WS_PROJ)}; dense_gemm(lds, (const bf16_t*)(ws + WS_XN), (const bf16_t*)(ws + WS_WIN), NTOK, INCP, DM, E); }
    if (IN(1) && IN(3)) xcd_barrier(bar);
    if (IN(3)) { pg8::EpiBf16 Eq{(bf16_t*)(ws + WS_QPRE), 768}; dense_gemm(lds, (const bf16_t*)(ws + WS_PROJ) + OFF_CQ, (const bf16_t*)(ws + WS_WUQ), NTOK, 768, QLORA, Eq, INCP);
                 pg8::EpiBf16 Ek{(bf16_t*)(ws + WS_KVPRE), 1024}; dense_gemm(lds, (const bf16_t*)(ws + WS_PROJ) + OFF_CKV, (const bf16_t*)(ws + WS_WUKV), NTOK, 1024, KVLORA, Ek, INCP); }
    SEAM(3);
    if (IN(4)) phase_tok_b(p);
    SEAM(4);
    if (IN(5)) phase_attn(p, lds);
    SEAM(5);
    if (IN(6)) { pg8::EpiGateA E{(bf16_t*)(ws + WS_M1), (const bf16_t*)(ws + WS_PROJ)}; dense_gemm(lds, (const bf16_t*)(ws + WS_AO), (const bf16_t*)(ws + WS_WOMLA), NTOK, DM, 512, E); }
    if (IN(7)) { pg8::EpiGateB E{(const bf16_t*)(ws + WS_M1), (const bf16_t*)(ws + WS_PROJ), (bf16_t*)(ws + WS_MERGED)}; dense_gemm(lds, (const bf16_t*)(ws + WS_YBIN), (const bf16_t*)(ws + WS_WOCONV), NTOK, DM, 512, E); }
    SEAM(7);
    if (IN(8)) { pg8::EpiResid E{p.x, p.out}; dense_gemm(lds, (const bf16_t*)(ws + WS_MERGED), (const bf16_t*)(ws + WS_WO), NTOK, DM, DM, E); }
    SEAM(8);
    if (IN(9)) phase_router(p, lds);
    if (IN(9) && IN(11)) xcd_barrier(bar);
    if (IN(11)) phase_moe1(p, lds);
    SEAM(11);
    if (IN(12)) phase_moe2(p, lds);
    SEAM(12);
    if (IN(13)) phase_combine(p);
#undef IN
#undef SEAM
}

extern "C" void kernel_launch(void* const* d_in, const int* in_sizes, int n_in, void* d_out, int out_size,
                              void* d_ws, size_t ws_size, hipStream_t stream) {
    static int grid_blocks = 0;
    if (!grid_blocks) {
        int dev = 0, cus = 0, per_cu = 0;
        (void)hipGetDevice(&dev);
        (void)hipDeviceGetAttribute(&cus, hipDeviceAttributeMultiprocessorCount, dev);
        (void)hipFuncSetAttribute((const void*)mk_fwd, hipFuncAttributeMaxDynamicSharedMemorySize, LDS_BYTES);
        (void)hipOccupancyMaxActiveBlocksPerMultiprocessor(&per_cu, (const void*)mk_fwd, NTHREADS, LDS_BYTES);
        if (per_cu < 1) { fprintf(stderr, "kernel_launch: occupancy query says %d blocks/CU\n", per_cu); per_cu = 1; }
        grid_blocks = cus;
        if (ws_size < WS_END2 || n_in != 21) fprintf(stderr, "kernel_launch: ws %zu < %zu or n_in %d != 21\n", ws_size, (size_t)WS_END2, n_in);
    }
    (void)hipMemsetAsync((char*)d_ws + WS_CTL, 0, 1 * MiB, stream);
    Params p{};
    p.x = (const float*)d_in[0]; p.pos = (const int*)d_in[1]; p.norm1_g = (const float*)d_in[2]; p.w_in = (const float*)d_in[3]; p.q_a_g = (const float*)d_in[4];
    p.kv_a_g = (const float*)d_in[5]; p.w_uq = (const float*)d_in[6]; p.w_ukv = (const float*)d_in[7]; p.q_g = (const float*)d_in[8]; p.k_g = (const float*)d_in[9];
    p.conv_w = (const float*)d_in[10]; p.w_o_mla = (const float*)d_in[11]; p.w_o_conv = (const float*)d_in[12]; p.w_o = (const float*)d_in[13]; p.norm2_g = (const float*)d_in[14];
    p.router_w = (const float*)d_in[15]; p.router_b = (const float*)d_in[16]; p.w1 = (const float*)d_in[17]; p.b1 = (const float*)d_in[18]; p.w2 = (const float*)d_in[19]; p.b2 = (const float*)d_in[20];
    p.out = (float*)d_out; p.ws = (unsigned char*)d_ws; p.ph_lo = 0; p.ph_hi = NPHASE + 1;
    void* args[] = {&p};
    hipError_t e = hipLaunchCooperativeKernel((const void*)mk_fwd, dim3(grid_blocks), dim3(NTHREADS), args, LDS_BYTES, stream);
    if (e != hipSuccess) fprintf(stderr, "cooperative launch failed: %s (grid %d)\n", hipGetErrorString(e), grid_blocks);
}
```

```cpp
#include <hip/hip_runtime.h>
#include <hip/hip_cooperative_groups.h>
#include <cstdio>
#include <cstdint>
namespace cg = cooperative_groups;

typedef unsigned short bf16_t;
typedef short bf16x8 __attribute__((ext_vector_type(8)));
typedef short s16x4 __attribute__((ext_vector_type(4)));
typedef float f32x4 __attribute__((ext_vector_type(4)));
typedef float f32x2 __attribute__((ext_vector_type(2)));
typedef float f32x16 __attribute__((ext_vector_type(16)));
typedef unsigned u32x4 __attribute__((ext_vector_type(4)));
typedef unsigned u32x2 __attribute__((ext_vector_type(2)));
typedef __bf16 bf16x2_t __attribute__((ext_vector_type(2)));

constexpr int NTOK = 16384, DM = 1024, SEQ = 8192;
constexpr int INC = 4000, INCP = 4096;
constexpr int OFF_CQ = 0, OFF_CKV = 256, OFF_KR = 384, OFF_U = 416, OFF_C = 928, OFF_B = 1440, OFF_GA = 1952, OFF_GB = 2976;
constexpr int NH = 8, DQK = 96, DV = 64, NE = 32, TOPK = 4, DFF = 1024;
constexpr int QLORA = 256, KVLORA = 128, CONVW = 512;
constexpr int NPAIR = NTOK * TOPK;
constexpr int MAXROWS = 73728;
constexpr float EPS = 1e-6f;
constexpr int CAP = 16384;
constexpr int NTHREADS = 512, NWAVES = 8;
constexpr int LDS_BYTES = 147456;

constexpr size_t MiB = 1ull << 20;
constexpr size_t WS_CTL = 0;
constexpr size_t WS_WIN = 1 * MiB;
constexpr size_t WS_WUQ = 9 * MiB;
constexpr size_t WS_WUKV = WS_WUQ + 512 * 1024;
constexpr size_t WS_WOMLA = 10 * MiB;
constexpr size_t WS_WOCONV = 11 * MiB;
constexpr size_t WS_WO = 12 * MiB;
constexpr size_t WS_ROUTE = 14 * MiB;
constexpr size_t WS_W1 = 18 * MiB;
constexpr size_t WS_W2 = 146 * MiB;
constexpr size_t WS_XN = 210 * MiB;
constexpr size_t WS_PROJ = 242 * MiB;
constexpr size_t WS_CQN = 370 * MiB;
constexpr size_t WS_CKVN = 378 * MiB;
constexpr size_t WS_YBIN = 386 * MiB;
constexpr size_t WS_QPRE = 402 * MiB;
constexpr size_t WS_KVPRE = 450 * MiB;
constexpr size_t WS_Q = 514 * MiB;
constexpr size_t WS_K = 538 * MiB;
constexpr size_t WS_V = 570 * MiB;
constexpr size_t WS_AO = 586 * MiB;
constexpr size_t WS_M1 = 602 * MiB;
constexpr size_t WS_MERGED = 666 * MiB;
constexpr size_t WS_YS = 698 * MiB;
constexpr size_t WS_END = 826 * MiB;
constexpr size_t WS_ACT = WS_PROJ;
constexpr size_t WS_H8 = WS_XN;
constexpr size_t WS_GF = 830 * MiB;
constexpr size_t WS_RT2 = 832 * MiB;
constexpr size_t WS_END2 = 840 * MiB;
constexpr size_t RT_PAIR_E = 0, RT_PAIR_RANK = 262144, RT_PAIR_W = 524288, RT_ROW_TOK = 786432, RT_ROW_W = 786432 + 294912, RT_ROW_SLOT = 786432 + 2 * 294912;
constexpr int CW_CNT = 64;
constexpr int CW_BAR = 4096;
constexpr int MISC_OFF = LDS_BYTES - 256;

struct Params {
    const float* x; const int* pos; const float* norm1_g; const float* w_in; const float* q_a_g; const float* kv_a_g;
    const float* w_uq; const float* w_ukv; const float* q_g; const float* k_g; const float* conv_w; const float* w_o_mla;
    const float* w_o_conv; const float* w_o; const float* norm2_g; const float* router_w; const float* router_b;
    const float* w1; const float* b1; const float* w2; const float* b2;
    float* out; unsigned char* ws; int ph_lo, ph_hi;
};

__device__ __forceinline__ unsigned pk2(float lo, float hi) { f32x2 v = {lo, hi}; bf16x2_t b = __builtin_convertvector(v, bf16x2_t); return __builtin_bit_cast(unsigned, b); }
__device__ __forceinline__ float bf_lo(unsigned w) { return __uint_as_float(w << 16); }
__device__ __forceinline__ float bf_hi(unsigned w) { return __uint_as_float(w & 0xffff0000u); }
__device__ __forceinline__ float bf1(bf16_t h) { return __uint_as_float((unsigned)h << 16); }
__device__ __forceinline__ float wave_sum(float v) {
#pragma unroll
    for (int o = 1; o < 64; o <<= 1) v += __shfl_xor(v, o);
    return v;
}
__device__ __forceinline__ unsigned pk4_fp8(float a, float b, float c, float d) { unsigned w = 0u; w = (unsigned)__builtin_amdgcn_cvt_pk_fp8_f32(a, b, (int)w, false); w = (unsigned)__builtin_amdgcn_cvt_pk_fp8_f32(c, d, (int)w, true); return w; }
constexpr float W8_SCALE = 32.f, W8_INV = 1.f / 32.f;
__device__ __forceinline__ float sigmoidf_(float v) { return 1.f / (1.f + __expf(-v)); }

namespace pg8 {
#define PG8_LAS __attribute__((address_space(3)))
constexpr int BM = 256, BK = 64, HALF = 128, HTB = HALF * BK * 2  , STAGE_BYTES = 8 * HTB, NXCD = 8, WGM = 8;

__host__ __device__ __forceinline__ int lds_byte(int r, int c) { const int st = (r >> 4) * 2 + (c >> 5), rr = r & 15, cc = c & 31, ob = rr * 64 + cc * 2; return st * 1024 + (ob ^ (((ob >> 9) & 1) << 5)); }
__host__ __device__ __forceinline__ void stage_rc(int b, int& R, int& C) { const int st = b / 1024, sb = b % 1024, swz = sb ^ (((sb >> 9) & 1) << 5); R = (st >> 1) * 16 + swz / 64; C = (st & 1) * 32 + (swz % 64) / 2; }
__host__ __device__ __forceinline__ int perm32(int rho) { const int n = rho >> 4, i = rho & 15; return 8 * (i >> 2) + 4 * n + (i & 3); }

struct Unit { int pm, pn, e, rb; };
struct Gemm { const bf16_t* A; const bf16_t* Bt; int M, N, K; size_t bstride; int lda; };

struct StaticOrder {
    int nM, nN, nwg, G, c;
    __host__ __device__ void init(int M, int N, int G_, int c_) { nM = M / BM; nN = N / BM; nwg = nM * nN; G = G_; c = c_; }
    __host__ __device__ bool next(int i, Unit& u) const {
        const long L = (long)i * G + c; if (L >= nwg) return false;
        int wgid = (int)L; { const int q = nwg / NXCD, r = nwg % NXCD, xcd = wgid % NXCD, off = wgid / NXCD; wgid = (xcd < r ? xcd * (q + 1) : r * (q + 1) + (xcd - r) * q) + off; }
        const int nig = WGM * nN, gid = wgid / nig, fm = gid * WGM, gsz = (nM - fm) < WGM ? (nM - fm) : WGM;
        u.pm = fm + ((wgid % nig) % gsz); u.pn = (wgid % nig) / gsz; u.e = 0; u.rb = 0; return true;
    }
    __device__ __forceinline__ void a_ready(const Unit&) const {}
    __device__ __forceinline__ void done(const Unit&) const {}
};


struct EpiProj {
    static constexpr bool PERM = true, AFTER_DRAIN = false;
    bf16_t* O;
    __device__ __forceinline__ void operator()(const f32x4 (&acc)[2][2][4][2], const Unit& u, int wr, int wc, int fr, int fq) const {
        const int row0 = u.pm * BM + wr * 64 + fr, col0 = u.pn * BM + wc * 32 + 8 * fq;
#pragma unroll
        for (int ai = 0; ai < 2; ++ai)
#pragma unroll
            for (int m = 0; m < 4; ++m) { bf16_t* rowp = O + (size_t)(row0 + ai * HALF + m * 16) * INCP + col0;
#pragma unroll
                for (int bj = 0; bj < 2; ++bj) { f32x4 v0 = acc[ai][bj][m][0], v1 = acc[ai][bj][m][1]; const int col = col0 + bj * HALF;
                    if (col >= OFF_GA && col < INC) {
#pragma unroll
                        for (int j = 0; j < 4; ++j) { v0[j] = sigmoidf_(v0[j]); v1[j] = sigmoidf_(v1[j]); } }
                    u32x4 w; w.x = pk2(v0[0], v0[1]); w.y = pk2(v0[2], v0[3]); w.z = pk2(v1[0], v1[1]); w.w = pk2(v1[2], v1[3]);
                    *(u32x4*)(rowp + bj * HALF) = w; } }
    }
};
struct EpiBf16 {
    static constexpr bool PERM = true, AFTER_DRAIN = false;
    bf16_t* O; int ldc;
    __device__ __forceinline__ void operator()(const f32x4 (&acc)[2][2][4][2], const Unit& u, int wr, int wc, int fr, int fq) const {
        const int row0 = u.pm * BM + wr * 64 + fr, col0 = u.pn * BM + wc * 32 + 8 * fq;
#pragma unroll
        for (int ai = 0; ai < 2; ++ai)
#pragma unroll
            for (int m = 0; m < 4; ++m) { bf16_t* rowp = O + (size_t)(row0 + ai * HALF + m * 16) * ldc + col0;
#pragma unroll
                for (int bj = 0; bj < 2; ++bj) { const f32x4 v0 = acc[ai][bj][m][0], v1 = acc[ai][bj][m][1];
                    u32x4 w; w.x = pk2(v0[0], v0[1]); w.y = pk2(v0[2], v0[3]); w.z = pk2(v1[0], v1[1]); w.w = pk2(v1[2], v1[3]); *(u32x4*)(rowp + bj * HALF) = w; } }
    }
};
struct EpiF32 {
    static constexpr bool PERM = false, AFTER_DRAIN = false;
    float* O; int ldc;
    __device__ __forceinline__ void operator()(const f32x4 (&acc)[2][2][4][2], const Unit& u, int wr, int wc, int fr, int fq) const {
        const int row0 = u.pm * BM + wr * 64 + fr, col0 = u.pn * BM + wc * 32 + 4 * fq;
#pragma unroll
        for (int ai = 0; ai < 2; ++ai)
#pragma unroll
            for (int m = 0; m < 4; ++m) { float* rowp = O + (size_t)(row0 + ai * HALF + m * 16) * ldc + col0;
#pragma unroll
                for (int bj = 0; bj < 2; ++bj)
#pragma unroll
                    for (int n = 0; n < 2; ++n) *(f32x4*)(rowp + bj * HALF + n * 16) = acc[ai][bj][m][n]; }
    }
};
__device__ __forceinline__ void unpack8(const u32x4 g, float (&f)[8]) { f[0] = bf_lo(g.x); f[1] = bf_hi(g.x); f[2] = bf_lo(g.y); f[3] = bf_hi(g.y); f[4] = bf_lo(g.z); f[5] = bf_hi(g.z); f[6] = bf_lo(g.w); f[7] = bf_hi(g.w); }
struct EpiGateA {
    static constexpr bool PERM = true, AFTER_DRAIN = false;
    bf16_t* M1; const bf16_t* proj;
    __device__ __forceinline__ void operator()(const f32x4 (&acc)[2][2][4][2], const Unit& u, int wr, int wc, int fr, int fq) const {
        const int row0 = u.pm * BM + wr * 64 + fr, col0 = u.pn * BM + wc * 32 + 8 * fq;
#pragma unroll
        for (int ai = 0; ai < 2; ++ai)
#pragma unroll
            for (int m = 0; m < 4; ++m) { const size_t row = (size_t)(row0 + ai * HALF + m * 16);
#pragma unroll
                for (int bj = 0; bj < 2; ++bj) { const int col = col0 + bj * HALF; float g[8]; unpack8(*(const u32x4*)(proj + row * INCP + OFF_GA + col), g);
                    const f32x4 v0 = acc[ai][bj][m][0], v1 = acc[ai][bj][m][1];
                    u32x4 w; w.x = pk2(v0[0] * g[0], v0[1] * g[1]); w.y = pk2(v0[2] * g[2], v0[3] * g[3]); w.z = pk2(v1[0] * g[4], v1[1] * g[5]); w.w = pk2(v1[2] * g[6], v1[3] * g[7]);
                    *(u32x4*)(M1 + row * DM + col) = w; } }
    }
};
struct EpiGateB {
    static constexpr bool PERM = true, AFTER_DRAIN = false;
    const bf16_t* M1; const bf16_t* proj; bf16_t* O;
    __device__ __forceinline__ void operator()(const f32x4 (&acc)[2][2][4][2], const Unit& u, int wr, int wc, int fr, int fq) const {
        const int row0 = u.pm * BM + wr * 64 + fr, col0 = u.pn * BM + wc * 32 + 8 * fq;
#pragma unroll
        for (int ai = 0; ai < 2; ++ai)
#pragma unroll
            for (int m = 0; m < 4; ++m) { const size_t row = (size_t)(row0 + ai * HALF + m * 16);
#pragma unroll
                for (int bj = 0; bj < 2; ++bj) { const int col = col0 + bj * HALF; float g[8], b[8]; unpack8(*(const u32x4*)(proj + row * INCP + OFF_GB + col), g); unpack8(*(const u32x4*)(M1 + row * DM + col), b);
                    const f32x4 v0 = acc[ai][bj][m][0], v1 = acc[ai][bj][m][1];
                    u32x4 w; w.x = pk2(b[0] + v0[0] * g[0], b[1] + v0[1] * g[1]); w.y = pk2(b[2] + v0[2] * g[2], b[3] + v0[3] * g[3]);
                    w.z = pk2(b[4] + v1[0] * g[4], b[5] + v1[1] * g[5]); w.w = pk2(b[6] + v1[2] * g[6], b[7] + v1[3] * g[7]);
                    *(u32x4*)(O + row * DM + col) = w; } }
    }
};
struct EpiResid {
    static constexpr bool PERM = false, AFTER_DRAIN = false;
    const float* X; float* O;
    __device__ __forceinline__ void operator()(const f32x4 (&acc)[2][2][4][2], const Unit& u, int wr, int wc, int fr, int fq) const {
        const int row0 = u.pm * BM + wr * 64 + fr, col0 = u.pn * BM + wc * 32 + 4 * fq;
#pragma unroll
        for (int ai = 0; ai < 2; ++ai)
#pragma unroll
            for (int m = 0; m < 4; ++m) { const size_t off = (size_t)(row0 + ai * HALF + m * 16) * DM + col0;
#pragma unroll
                for (int bj = 0; bj < 2; ++bj)
#pragma unroll
                    for (int n = 0; n < 2; ++n) { const f32x4 b = *(const f32x4*)(X + off + bj * HALF + n * 16); *(f32x4*)(O + off + bj * HALF + n * 16) = b + acc[ai][bj][m][n]; } }
    }
};
struct EpiSwiglu {
    static constexpr bool PERM = true, AFTER_DRAIN = false;
    unsigned char* ACT; const float* b1; const float* row_rstd;
    __device__ __forceinline__ void operator()(const f32x4 (&acc)[2][2][4][2], const Unit& u, int wr, int wc, int fr, int fq) const {
        const int row0 = u.pm * BM + wr * 64 + fr, f0 = u.pn * HALF + wc * 32 + 8 * fq; const float* be = b1 + (size_t)u.e * 2048;
        const f32x4 bg0 = *(const f32x4*)(be + f0), bg1 = *(const f32x4*)(be + f0 + 4), bu0 = *(const f32x4*)(be + DFF + f0), bu1 = *(const f32x4*)(be + DFF + f0 + 4);
#pragma unroll
        for (int ai = 0; ai < 2; ++ai)
#pragma unroll
            for (int m = 0; m < 4; ++m) { const size_t row = (size_t)(row0 + ai * HALF + m * 16); float o[8]; const float rs = row_rstd[u.rb + wr * 64 + fr + ai * HALF + m * 16] * W8_INV;
#pragma unroll
                for (int n = 0; n < 2; ++n) { const f32x4 g4 = acc[ai][0][m][n] * rs + (n ? bg1 : bg0), u4 = acc[ai][1][m][n] * rs + (n ? bu1 : bu0);
#pragma unroll
                    for (int j = 0; j < 4; ++j) { const float g = fminf(g4[j], 7.f), uu = fminf(fmaxf(u4[j], -7.f), 7.f); o[4 * n + j] = (uu + 1.f) * (g * sigmoidf_(1.702f * g)); } }
                u32x2 w; w.x = pk4_fp8(o[0], o[1], o[2], o[3]); w.y = pk4_fp8(o[4], o[5], o[6], o[7]); *(u32x2*)(ACT + row * DFF + f0) = w; }
    }
};
struct EpiMoeOut {
    static constexpr bool PERM = true, AFTER_DRAIN = false;
    bf16_t* YS; const float* b2; const float* row_w; const int* row_slot;
    __device__ __forceinline__ void operator()(const f32x4 (&acc)[2][2][4][2], const Unit& u, int wr, int wc, int fr, int fq) const {
        const int row0 = u.pm * BM + wr * 64 + fr, col0 = u.pn * BM + wc * 32 + 8 * fq; const float* be = b2 + (size_t)u.e * DM;
        f32x4 bv[2][2];
#pragma unroll
        for (int bj = 0; bj < 2; ++bj)
#pragma unroll
            for (int n = 0; n < 2; ++n) bv[bj][n] = *(const f32x4*)(be + col0 + bj * HALF + 4 * n);
#pragma unroll
        for (int ai = 0; ai < 2; ++ai)
#pragma unroll
            for (int m = 0; m < 4; ++m) { const int row = u.rb + wr * 64 + fr + ai * HALF + m * 16; const int slot = row_slot[row]; const float w = row_w[row];
                if (slot >= 0) { bf16_t* rowp = YS + (size_t)slot * DM + col0;
#pragma unroll
                    for (int bj = 0; bj < 2; ++bj) { const f32x4 v0 = (acc[ai][bj][m][0] * W8_INV + bv[bj][0]) * w, v1 = (acc[ai][bj][m][1] * W8_INV + bv[bj][1]) * w;
                        u32x4 o; o.x = pk2(v0[0], v0[1]); o.y = pk2(v0[2], v0[3]); o.z = pk2(v1[0], v1[1]); o.w = pk2(v1[2], v1[3]); *(u32x4*)(rowp + bj * HALF) = o; } } }
    }
};
constexpr int MOE_MAXU = 12;
struct MoeOrder {
    StaticOrder so; const PG8_LAS int* utab; const PG8_LAS int* gtab;
    __device__ __forceinline__ bool next(int i, Unit& u) const { if (i >= MOE_MAXU || !so.next(i, u)) return false; const int v = __builtin_amdgcn_readfirstlane(utab[i]); u.e = v & 31; u.rb = (int)((unsigned)v >> 8); return true; }
    __device__ __forceinline__ void a_ready(const Unit&) const {}
    __device__ __forceinline__ void done(const Unit&) const {}
};
typedef int i32x4_t __attribute__((ext_vector_type(4))); typedef int i32x8_t __attribute__((ext_vector_type(8)));
__device__ __forceinline__ i32x8_t cat8(bf16x8 lo, bf16x8 hi) { return __builtin_shufflevector(__builtin_bit_cast(i32x4_t, lo), __builtin_bit_cast(i32x4_t, hi), 0, 1, 2, 3, 4, 5, 6, 7); }
__device__ __forceinline__ void mfma_fp8_inplace(f32x4& c, const i32x8_t a, const i32x8_t b) { asm volatile("s_nop 1\n\tv_mfma_f32_16x16x128_f8f6f4 %0, %1, %2, %0" : "+v"(c) : "v"(a), "v"(b)); }
__device__ __forceinline__ void mfma_fp8_drain() { asm volatile("s_nop 15\n\ts_nop 7" ::: "memory"); __builtin_amdgcn_sched_barrier(0); }
template <class Epi, class Sched, bool ALIGN_EPI = false, bool SP2 = false, bool FP8 = false, bool GATHER = false>
__device__ __forceinline__ void gemm_phase(PG8_LAS unsigned char* lds, const Gemm g, const Sched& S, const Epi& E) {
    const int tid = threadIdx.x, wid = __builtin_amdgcn_readfirstlane(tid >> 6), lane = tid & 63, wr = wid >> 2, wc = wid & 3, fr = lane & 15, fq = lane >> 4;
    const int K = g.K, nt = K / BK;
    static_assert(!GATHER || SP2, "GATHER is implemented for the SP2 loop only");
    const unsigned rowA = (unsigned)(g.lda ? g.lda : K) * 2u;
    unsigned voffA[2], voffB[2]; int gR0 = 0; unsigned gC = 0u;
#pragma unroll
    for (int i = 0; i < 2; ++i) { int R, C; stage_rc(tid * 16 + i * 8192, R, C); const int Rb = Epi::PERM ? ((R & ~31) + perm32(R & 31)) : R;
        voffA[i] = (unsigned)R * rowA + (unsigned)C * 2u; voffB[i] = (unsigned)(Rb * K + C) * 2u; if (i == 0) { gR0 = R; gC = (unsigned)C * 2u; } }
    unsigned gA[2][2] = {{0u, 0u}, {0u, 0u}}, ngA[2][2] = {{0u, 0u}, {0u, 0u}};
#define PG8_GLOAD(dst, ui_) do { _Pragma("unroll") for (int h_ = 0; h_ < 2; ++h_) _Pragma("unroll") for (int i_ = 0; i_ < 2; ++i_) \
        dst[h_][i_] = (unsigned)S.gtab[(ui_) * 256 + 128 * h_ + gR0 + 64 * i_] * rowA + gC; } while (0)
#define PG8_VA(h) (GATHER ? gA[h] : voffA)
    const unsigned kstep = (unsigned)(BK * 2);
    const unsigned hstep = (unsigned)HALF * (unsigned)K * 2u;
    const unsigned tstep = 2u * hstep;
    const unsigned hstepA = (unsigned)HALF * rowA, tstepA = 2u * hstepA;
    const unsigned hsA = GATHER ? 0u : hstepA;
    const unsigned ldsw = (unsigned)wid * 1024u;
    const int aoff = lds_byte(wr * 64 + fr, fq * 8), boff = lds_byte(wc * 32 + fr, fq * 8);
#define PG8_SA(b, h) (((b) * 2 + (h)) * HTB)
#define PG8_SB(b, h) ((4 + (b) * 2 + (h)) * HTB)
#define PG8_STAGE(rs, bufoff, goff, voff) do { _Pragma("unroll") for (int _i = 0; _i < 2; ++_i) \
        __builtin_amdgcn_raw_ptr_buffer_load_lds(rs, (PG8_LAS void*)(lds + (bufoff) + ldsw + _i * 8192), 16, (int)(voff)[_i], (int)(goff), 0, 0); } while (0)
#define PG8_LDA(dst, b, h) do { _Pragma("unroll") for (int m = 0; m < 4; ++m) _Pragma("unroll") for (int k = 0; k < 2; ++k) dst[m][k] = *(const PG8_LAS bf16x8*)(lds + PG8_SA(b, h) + aoff + m * 2048 + k * 1024); } while (0)
#define PG8_LDB(dst, b, h) do { _Pragma("unroll") for (int n = 0; n < 2; ++n) _Pragma("unroll") for (int k = 0; k < 2; ++k) dst[n][k] = *(const PG8_LAS bf16x8*)(lds + PG8_SB(b, h) + boff + n * 2048 + k * 1024); } while (0)
#define PG8_MMA(ai, bj, At, Bt) do { __builtin_amdgcn_s_setprio(1); _Pragma("unroll") for (int m = 0; m < 4; ++m) _Pragma("unroll") for (int n = 0; n < 2; ++n) { \
        if constexpr (FP8) { mfma_fp8_inplace(acc[ai][bj][m][n], cat8(Bt[n][0], Bt[n][1]), cat8(At[m][0], At[m][1])); } \
        else { _Pragma("unroll") for (int k = 0; k < 2; ++k) acc[ai][bj][m][n] = __builtin_amdgcn_mfma_f32_16x16x32_bf16(Bt[n][k], At[m][k], acc[ai][bj][m][n], 0, 0, 0); } } \
        __builtin_amdgcn_s_setprio(0); } while (0)
#define PG8_WAIT_V(n) asm volatile("s_waitcnt vmcnt(" #n ")" ::: "memory")
#define PG8_WAIT_L(n) asm volatile("s_waitcnt lgkmcnt(" #n ")" ::: "memory")
#define PG8_BAR __builtin_amdgcn_s_barrier()
#define PG8_SCHED __builtin_amdgcn_sched_barrier(0)
    Unit cur, nxt; int ui = 0;
    if (!S.next(0, cur)) return;
    f32x4 acc[2][2][4][2];
#pragma unroll
    for (int a = 0; a < 2; ++a)
#pragma unroll
        for (int b = 0; b < 2; ++b)
#pragma unroll
            for (int m = 0; m < 4; ++m)
#pragma unroll
                for (int n = 0; n < 2; ++n) acc[a][b][m][n] = (f32x4){0.f, 0.f, 0.f, 0.f};
    bf16x8 At[4][2], B0[2][2], B1[2][2];
    unsigned cA = GATHER ? 0u : (unsigned)cur.pm * tstepA, cB = (unsigned)cur.e * (unsigned)g.bstride + (unsigned)cur.pn * tstep;
    const __amdgpu_buffer_rsrc_t rsA = __builtin_amdgcn_make_buffer_rsrc((void*)g.A, 0, 0x7fffffff, 0x00020000), rsB = __builtin_amdgcn_make_buffer_rsrc((void*)g.Bt, 0, 0x7fffffff, 0x00020000);
    S.a_ready(cur);
    if constexpr (GATHER) PG8_GLOAD(gA, 0);
    if constexpr (SP2) {
        PG8_STAGE(rsB, PG8_SB(0, 0), cB, voffB); PG8_STAGE(rsB, PG8_SB(0, 1), cB + hstep, voffB); PG8_STAGE(rsA, PG8_SA(0, 0), cA, PG8_VA(0)); PG8_STAGE(rsA, PG8_SA(0, 1), cA + hsA, PG8_VA(1));
        if (wr == 1) PG8_BAR;
        PG8_WAIT_V(2); PG8_BAR;
        PG8_STAGE(rsB, PG8_SB(1, 0), cB + kstep, voffB); PG8_STAGE(rsA, PG8_SA(1, 0), cA + kstep, PG8_VA(0)); PG8_STAGE(rsB, PG8_SB(1, 1), cB + hstep + kstep, voffB);
        PG8_WAIT_V(6); PG8_BAR;
    } else {
        PG8_STAGE(rsB, PG8_SB(0, 0), cB, voffB); PG8_STAGE(rsA, PG8_SA(0, 0), cA, PG8_VA(0)); PG8_STAGE(rsB, PG8_SB(0, 1), cB + hstep, voffB); PG8_STAGE(rsA, PG8_SA(0, 1), cA + hsA, PG8_VA(1));
        if (wr == 1) PG8_BAR;
        PG8_WAIT_V(4); PG8_BAR;
        PG8_STAGE(rsB, PG8_SB(1, 0), cB + kstep, voffB); PG8_STAGE(rsA, PG8_SA(1, 0), cA + kstep, PG8_VA(0)); PG8_STAGE(rsB, PG8_SB(1, 1), cB + hstep + kstep, voffB);
        PG8_WAIT_V(6); PG8_BAR;
    }
    for (;;) {
        const bool has_next = S.next(ui + 1, nxt);
        if constexpr (GATHER) { if (has_next) PG8_GLOAD(ngA, ui + 1); else { ngA[0][0] = gA[0][0]; ngA[0][1] = gA[0][1]; ngA[1][0] = gA[1][0]; ngA[1][1] = gA[1][1]; } }
        const unsigned nA = (has_next && !GATHER) ? (unsigned)nxt.pm * tstepA : cA, nB = has_next ? (unsigned)nxt.e * (unsigned)g.bstride + (unsigned)nxt.pn * tstep : cB;
        for (int t = 0; t < nt; t += 2) {
            const bool last = (t == nt - 2);
            const unsigned a1 = cA + (unsigned)(t + 1) * kstep;
            const unsigned a2 = last ? nA : cA + (unsigned)(t + 2) * kstep, b2 = last ? nB : cB + (unsigned)(t + 2) * kstep;
            const unsigned a3 = a2 + kstep, b3 = b2 + kstep;
            if (last && has_next) S.a_ready(nxt);
            if constexpr (SP2) {
            PG8_LDB(B0, 0, 0); PG8_LDB(B1, 0, 1); PG8_SCHED; PG8_LDA(At, 0, 0); PG8_STAGE(rsA, PG8_SA(1, 1), a1 + hsA, PG8_VA(1));
            if constexpr (GATHER) { if (last) { gA[0][0] = ngA[0][0]; gA[0][1] = ngA[0][1]; gA[1][0] = ngA[1][0]; gA[1][1] = ngA[1][1]; } }
            PG8_WAIT_V(8); PG8_WAIT_L(0); PG8_BAR; PG8_MMA(0, 0, At, B0); PG8_MMA(0, 1, At, B1); PG8_BAR; PG8_SCHED;
            PG8_LDA(At, 0, 1); PG8_STAGE(rsB, PG8_SB(0, 0), b2, voffB); PG8_STAGE(rsB, PG8_SB(0, 1), b2 + hstep, voffB); PG8_STAGE(rsA, PG8_SA(0, 0), a2, PG8_VA(0));
            PG8_WAIT_V(8); PG8_WAIT_L(0); PG8_BAR; PG8_MMA(1, 0, At, B0); PG8_MMA(1, 1, At, B1); PG8_BAR; PG8_SCHED;
            PG8_LDB(B0, 1, 0); PG8_LDB(B1, 1, 1); PG8_SCHED; PG8_LDA(At, 1, 0); PG8_STAGE(rsA, PG8_SA(0, 1), a2 + hsA, PG8_VA(1));
            PG8_WAIT_V(8); PG8_WAIT_L(0); PG8_BAR; PG8_MMA(0, 0, At, B0); PG8_MMA(0, 1, At, B1); PG8_BAR; PG8_SCHED;
            PG8_LDA(At, 1, 1); PG8_STAGE(rsB, PG8_SB(1, 0), b3, voffB); PG8_STAGE(rsB, PG8_SB(1, 1), b3 + hstep, voffB); PG8_STAGE(rsA, PG8_SA(1, 0), a3, PG8_VA(0));
            PG8_WAIT_V(8); PG8_WAIT_L(0); PG8_BAR; PG8_MMA(1, 0, At, B0); PG8_MMA(1, 1, At, B1); PG8_BAR; PG8_SCHED;
            } else {
            PG8_LDB(B0, 0, 0); PG8_SCHED; PG8_LDA(At, 0, 0); PG8_STAGE(rsA, PG8_SA(1, 1), a1 + hsA, PG8_VA(1));
            PG8_WAIT_L(8); PG8_BAR; PG8_WAIT_L(0); PG8_MMA(0, 0, At, B0); PG8_BAR; PG8_SCHED;
            PG8_LDB(B1, 0, 1); PG8_STAGE(rsB, PG8_SB(0, 0), b2, voffB);
            PG8_BAR; PG8_WAIT_L(0); PG8_MMA(0, 1, At, B1); PG8_BAR;
            PG8_LDA(At, 0, 1); PG8_STAGE(rsA, PG8_SA(0, 0), a2, PG8_VA(0));
            PG8_BAR; PG8_WAIT_L(0); PG8_MMA(1, 0, At, B0); PG8_BAR; PG8_SCHED;
            PG8_STAGE(rsB, PG8_SB(0, 1), b2 + hstep, voffB);
            PG8_WAIT_V(6); PG8_BAR; PG8_MMA(1, 1, At, B1); PG8_BAR;
            PG8_LDB(B0, 1, 0); PG8_SCHED; PG8_LDA(At, 1, 0); PG8_STAGE(rsA, PG8_SA(0, 1), a2 + hsA, PG8_VA(1));
            PG8_WAIT_L(8); PG8_BAR; PG8_WAIT_L(0); PG8_MMA(0, 0, At, B0); PG8_BAR; PG8_SCHED;
            PG8_LDB(B1, 1, 1); PG8_STAGE(rsB, PG8_SB(1, 0), b3, voffB);
            PG8_BAR; PG8_WAIT_L(0); PG8_MMA(0, 1, At, B1); PG8_BAR;
            PG8_LDA(At, 1, 1); PG8_STAGE(rsA, PG8_SA(1, 0), a3, PG8_VA(0));
            PG8_BAR; PG8_WAIT_L(0); PG8_MMA(1, 0, At, B0); PG8_BAR; PG8_SCHED;
            PG8_STAGE(rsB, PG8_SB(1, 1), b3 + hstep, voffB);
            PG8_WAIT_V(6); PG8_BAR; PG8_MMA(1, 1, At, B1); PG8_BAR;
            }
        }
        if constexpr (ALIGN_EPI) { if (wr == 0) PG8_BAR; }
        if constexpr (FP8) mfma_fp8_drain();
        if constexpr (!Epi::AFTER_DRAIN) { E(acc, cur, wr, wc, fr, fq); S.done(cur); }
        if (!has_next) break;
#pragma unroll
        for (int a = 0; a < 2; ++a)
#pragma unroll
            for (int b = 0; b < 2; ++b)
#pragma unroll
                for (int m = 0; m < 4; ++m)
#pragma unroll
                    for (int n = 0; n < 2; ++n) acc[a][b][m][n] = (f32x4){0.f, 0.f, 0.f, 0.f};
        cur = nxt; cA = nA; cB = nB; ++ui;
        if constexpr (ALIGN_EPI) { if (wr == 1) PG8_BAR; }
    }
    PG8_WAIT_V(0);
    if constexpr (!ALIGN_EPI) { if (wr == 0) PG8_BAR; }
    PG8_BAR;
    if constexpr (Epi::AFTER_DRAIN) { E.fused(acc, cur, wr, wc, fr, fq, lds, wid, lane); S.done(cur); }
#undef PG8_SA
#undef PG8_GLOAD
#undef PG8_VA
#undef PG8_SB
#undef PG8_STAGE
#undef PG8_LDA
#undef PG8_LDB
#undef PG8_MMA
#undef PG8_WAIT_V
#undef PG8_WAIT_L
#undef PG8_BAR
#undef PG8_SCHED
}
}

#define GAS __attribute__((address_space(1)))
#define LAS __attribute__((address_space(3)))
#define XB_TMO      128
#define XB_XCNT(j)  (256  + 64 * (j))
#define XB_XSUB(j)  (1280 + 64 * (j))
#define XB_XGEN(j)  (2304 + 64 * (j))
#define XB_TOP      3328
#define XB_TOPGEN   3392
#define XCD_BAR_WORDS 3456
#define XB_SPIN_CAP (1u << 18)

__device__ __forceinline__ unsigned xb_ld(unsigned* p)              { return __hip_atomic_load(p, __ATOMIC_RELAXED, __HIP_MEMORY_SCOPE_AGENT); }
__device__ __forceinline__ unsigned xb_add(unsigned* p, unsigned v) { return __hip_atomic_fetch_add(p, v, __ATOMIC_RELAXED, __HIP_MEMORY_SCOPE_AGENT); }
__device__ __forceinline__ unsigned xb_xcc_id() { return (unsigned)__builtin_amdgcn_s_getreg((3 << 11) | 20) & 0xFu; }
#define XB_SPIN(cond, bar) do { unsigned _sp = 0; while (cond) { __builtin_amdgcn_s_sleep(1); \
    if ((++_sp & 255u) == 0u) { if (xb_ld(&(bar)[XB_TMO])) break; if (_sp > XB_SPIN_CAP) { atomicAdd(&(bar)[XB_TMO], 1u); break; } } } } while (0)

struct XcdBarrier {
    unsigned* bar; unsigned x;
    volatile LAS unsigned* st;
};

__device__ __forceinline__ XcdBarrier xcd_barrier_post(unsigned* bar, volatile LAS unsigned* st) {
    XcdBarrier b; b.bar = bar; b.x = xb_xcc_id(); b.st = st;
    if (threadIdx.x == 0) (void)xb_add(&bar[XB_XCNT(b.x)], 1u);
    return b;
}
__device__ __forceinline__ void xcd_barrier_complete(unsigned* bar, unsigned x, unsigned& nloc, unsigned& nx) {
    const unsigned G = gridDim.x * gridDim.y * gridDim.z;
    unsigned sum, cnt, mine, sp = 0u;
    for (;;) {
        sum = 0u; cnt = 0u; mine = 0u;
#pragma unroll
        for (unsigned j = 0; j < 16; ++j) { const unsigned c = xb_ld(&bar[XB_XCNT(j)]); sum += c; cnt += (c > 0u) ? 1u : 0u; mine = (j == x) ? c : mine; }
        if (sum == G) break;
        __builtin_amdgcn_s_sleep(1);
        if ((++sp & 255u) == 0u) { if (xb_ld(&bar[XB_TMO])) break; if (sp > XB_SPIN_CAP) { atomicAdd(&bar[XB_TMO], 1u); break; } }
    }
    nloc = mine > 0u ? mine : 1u; nx = cnt > 0u ? cnt : 1u;
}

__device__ __forceinline__ void xcd_barrier(const XcdBarrier& b) {
    asm volatile("s_waitcnt vmcnt(0)" ::: "memory");
    __syncthreads();
    if (threadIdx.x == 0) {
        unsigned* bar = b.bar;
        __builtin_amdgcn_s_waitcnt(0);
        unsigned nloc = b.st[0], nx = b.st[1];
        if (nloc == 0u) { xcd_barrier_complete(bar, b.x, nloc, nx); b.st[0] = nloc; b.st[1] = nx; }
        const unsigned old = xb_add(&bar[XB_XSUB(b.x)], 1u);
        const unsigned gen = old / nloc;
        if (old + 1u == (gen + 1u) * nloc) {
            __builtin_amdgcn_fence(__ATOMIC_RELEASE, "agent");
            asm volatile("s_waitcnt vmcnt(0)" ::: "memory");
            const unsigned og = xb_add(&bar[XB_TOP], 1u);
            const unsigned tg = og / nx;
            if (og + 1u == (tg + 1u) * nx) xb_add(&bar[XB_TOPGEN], 1u);
            else XB_SPIN(xb_ld(&bar[XB_TOPGEN]) == tg, bar);
            __builtin_amdgcn_fence(__ATOMIC_ACQUIRE, "agent");
            xb_add(&bar[XB_XGEN(b.x)], 1u);
            asm volatile("s_waitcnt vmcnt(0)" ::: "memory");
        } else {
            XB_SPIN(xb_ld(&bar[XB_XGEN(b.x)]) == gen, bar);
            __builtin_amdgcn_fence(__ATOMIC_ACQUIRE, "agent");
            asm volatile("s_waitcnt vmcnt(0)" ::: "memory");
        }
    }
    __syncthreads();
}

template <int MODE  >
__device__ __forceinline__ void transpose_item(const float* __restrict__ W, int K, int N, bf16_t* __restrict__ WT, const float* __restrict__ gain, float* scr, int item, int lane) {
    const int nblk = N / 32, kb = item / nblk, nb = item % nblk, k0 = 64 * kb, n0 = 32 * nb;
#pragma unroll
    for (int i = 0; i < 8; ++i) { const int kk = 8 * i + (lane >> 3), n4 = (lane & 7) * 4; f32x4 v = *(const f32x4*)(W + (size_t)(k0 + kk) * N + n0 + n4);
        if (gain) { const float g = gain[k0 + kk]; v = v * g; }
        float* s = scr + kk * 33 + n4; s[0] = v[0]; s[1] = v[1]; s[2] = v[2]; s[3] = v[3]; }
    asm volatile("s_waitcnt lgkmcnt(0)" ::: "memory");
    const int c = lane & 7;
#pragma unroll
    for (int j = 0; j < 4; ++j) { const int n = (lane >> 3) + 8 * j; const float* s = scr + (8 * c) * 33 + n;
        u32x4 o; o.x = pk2(s[0 * 33], s[1 * 33]); o.y = pk2(s[2 * 33], s[3 * 33]); o.z = pk2(s[4 * 33], s[5 * 33]); o.w = pk2(s[6 * 33], s[7 * 33]);
        int row = n0 + n;
        if (MODE == 1) { const int f = row & 1023; row = ((f >> 7) << 8) + ((row >> 10) << 7) + (f & 127); }
        *(u32x4*)(WT + (size_t)row * K + k0 + 8 * c) = o; }
    asm volatile("s_waitcnt lgkmcnt(0)" ::: "memory");
}
template <int MODE>
__device__ __forceinline__ void transpose_item_fp8(const float* __restrict__ W, int K, int N, unsigned char* __restrict__ WT, float* scr, int item, int lane) {
    const int nblk = N / 32, kb = item / nblk, nb = item % nblk, k0 = 64 * kb, n0 = 32 * nb;
#pragma unroll
    for (int i = 0; i < 8; ++i) { const int kk = 8 * i + (lane >> 3), n4 = (lane & 7) * 4; const f32x4 v = *(const f32x4*)(W + (size_t)(k0 + kk) * N + n0 + n4) * W8_SCALE;
        float* s = scr + kk * 33 + n4; s[0] = v[0]; s[1] = v[1]; s[2] = v[2]; s[3] = v[3]; }
    asm volatile("s_waitcnt lgkmcnt(0)" ::: "memory");
    const int c = lane & 7;
#pragma unroll
    for (int j = 0; j < 4; ++j) { const int n = (lane >> 3) + 8 * j; const float* s = scr + (8 * c) * 33 + n;
        u32x2 o; o.x = pk4_fp8(s[0 * 33], s[1 * 33], s[2 * 33], s[3 * 33]); o.y = pk4_fp8(s[4 * 33], s[5 * 33], s[6 * 33], s[7 * 33]);
        int row = n0 + n;
        if (MODE == 1) { const int f = row & 1023; row = ((f >> 7) << 8) + ((row >> 10) << 7) + (f & 127); }
        *(u32x2*)(WT + (size_t)row * K + k0 + 8 * c) = o; }
    asm volatile("s_waitcnt lgkmcnt(0)" ::: "memory");
}
__device__ __forceinline__ void phase_prologue(const Params& p, unsigned char* lds) {
    const int tid = threadIdx.x, lane = tid & 63, wave = tid >> 6;
    float* scr = (float*)(lds + wave * 16384);
    const int gw = blockIdx.x * NWAVES + wave, NGW = gridDim.x * NWAVES;
    unsigned char* ws = p.ws;
    constexpr int I_WIN = (DM / 64) * (INC / 32), I_UQ = (QLORA / 64) * (768 / 32), I_UKV = (KVLORA / 64) * (1024 / 32), I_OM = (512 / 64) * (DM / 32), I_OC = I_OM, I_WO = (DM / 64) * (DM / 32);
    constexpr int I_W1 = (DM / 64) * (2048 / 32), I_W2 = (DFF / 64) * (DM / 32);
    constexpr int NSMALL = I_WIN + I_UQ + I_UKV + I_OM + I_OC + I_WO;
    constexpr int NITEMS = NSMALL + NE * (I_W1 + I_W2);
    for (int it = gw; it < NITEMS; it += NGW) {
        int r = it;
        if (r < I_WIN) { transpose_item<0>(p.w_in, DM, INC, (bf16_t*)(ws + WS_WIN), p.norm1_g, scr, r, lane); continue; } r -= I_WIN;
        if (r < I_UQ) { transpose_item<0>(p.w_uq, QLORA, 768, (bf16_t*)(ws + WS_WUQ), p.q_a_g, scr, r, lane); continue; } r -= I_UQ;
        if (r < I_UKV) { transpose_item<0>(p.w_ukv, KVLORA, 1024, (bf16_t*)(ws + WS_WUKV), p.kv_a_g, scr, r, lane); continue; } r -= I_UKV;
        if (r < I_OM) { transpose_item<0>(p.w_o_mla, 512, DM, (bf16_t*)(ws + WS_WOMLA), nullptr, scr, r, lane); continue; } r -= I_OM;
        if (r < I_OC) { transpose_item<0>(p.w_o_conv, 512, DM, (bf16_t*)(ws + WS_WOCONV), nullptr, scr, r, lane); continue; } r -= I_OC;
        if (r < I_WO) { transpose_item<0>(p.w_o, DM, DM, (bf16_t*)(ws + WS_WO), nullptr, scr, r, lane); continue; } r -= I_WO;
        const int e = r / (I_W1 + I_W2); r -= e * (I_W1 + I_W2);
        if (r < I_W1) transpose_item_fp8<1>(p.w1 + (size_t)e * DM * 2048, DM, 2048, ws + WS_W1 + (size_t)e * 2048 * DM, scr, r, lane);
        else transpose_item_fp8<0>(p.w2 + (size_t)e * DFF * DM, DFF, DM, ws + WS_W2 + (size_t)e * DM * DFF, scr, r - I_W1, lane);
    }
    { u32x4* z = (u32x4*)((bf16_t*)(ws + WS_WIN) + (size_t)INC * DM); const int nz = (INCP - INC) * DM * 2 / 16;
      for (int i = blockIdx.x * NTHREADS + tid; i < nz; i += gridDim.x * NTHREADS) z[i] = (u32x4){0u, 0u, 0u, 0u}; }
    { int* rt = (int*)(ws + WS_RT2); int* rs = (int*)(ws + WS_RT2 + 4 * MiB); float* rr = (float*)(ws + WS_RT2 + 6 * MiB);
      for (int i = blockIdx.x * NTHREADS + tid; i < NE * CAP; i += gridDim.x * NTHREADS) { rt[i] = 0; rs[i] = -1; rr[i] = 0.f; } }
    { u32x4* GF = (u32x4*)(ws + WS_GF);
      for (int i = blockIdx.x * NTHREADS + tid; i < 64 * 64; i += gridDim.x * NTHREADS) { const int ks = i >> 6, ln = i & 63, r = ln & 31, h = ln >> 5; float v[8], lo[8]; unsigned hi[4];
#pragma unroll
          for (int j = 0; j < 8; ++j) { const int k = 16 * ks + 8 * h + j; v[j] = p.norm2_g[k] * p.router_w[(size_t)k * NE + r]; }
#pragma unroll
          for (int j = 0; j < 4; ++j) { hi[j] = pk2(v[2 * j], v[2 * j + 1]); lo[2 * j] = v[2 * j] - bf_lo(hi[j]); lo[2 * j + 1] = v[2 * j + 1] - bf_hi(hi[j]); }
          GF[(ks * 2 + 0) * 64 + ln] = (u32x4){hi[0], hi[1], hi[2], hi[3]}; GF[(ks * 2 + 1) * 64 + ln] = (u32x4){pk2(lo[0], lo[1]), pk2(lo[2], lo[3]), pk2(lo[4], lo[5]), pk2(lo[6], lo[7])}; } }
    bf16_t* XN = (bf16_t*)(ws + WS_XN);
    for (int m = gw; m < NTOK; m += NGW) {
        const f32x4* xr = (const f32x4*)(p.x + (size_t)m * DM) + lane; f32x4 v[4]; float s = 0.f;
#pragma unroll
        for (int j = 0; j < 4; ++j) { v[j] = xr[64 * j]; s += (v[j][0] * v[j][0] + v[j][1] * v[j][1]) + (v[j][2] * v[j][2] + v[j][3] * v[j][3]); }
        const float rstd = rsqrtf(wave_sum(s) * (1.f / DM) + EPS);
        u32x2* o = (u32x2*)(XN + (size_t)m * DM) + lane;
#pragma unroll
        for (int j = 0; j < 4; ++j) { u32x2 w; w.x = pk2(v[j][0] * rstd, v[j][1] * rstd); w.y = pk2(v[j][2] * rstd, v[j][3] * rstd); o[64 * j] = w; }
    }
}

constexpr float QSCALE = 0.10206207261596575f * 1.4426950408889634f;
__device__ __forceinline__ void phase_tok_b(const Params& p) {
    const int tid = threadIdx.x, lane = tid & 63, wave = tid >> 6, h = lane >> 3, sub = lane & 7;
    const int gw = blockIdx.x * NWAVES + wave, NGW = gridDim.x * NWAVES;
    const bf16_t* QPRE = (const bf16_t*)(p.ws + WS_QPRE); const bf16_t* KVPRE = (const bf16_t*)(p.ws + WS_KVPRE); const bf16_t* PROJ = (const bf16_t*)(p.ws + WS_PROJ);
    bf16_t* Q = (bf16_t*)(p.ws + WS_Q); bf16_t* Kb = (bf16_t*)(p.ws + WS_K); bf16_t* V = (bf16_t*)(p.ws + WS_V); bf16_t* YB = (bf16_t*)(p.ws + WS_YBIN);
    float qg[12], kg[12];
#pragma unroll
    for (int j = 0; j < 8; ++j) { qg[j] = p.q_g[sub * 8 + j]; kg[j] = p.k_g[sub * 8 + j]; }
    qg[8] = p.q_g[64 + 2 * sub]; qg[9] = p.q_g[65 + 2 * sub]; qg[10] = p.q_g[80 + 2 * sub]; qg[11] = p.q_g[81 + 2 * sub];
    kg[8] = p.k_g[64 + 2 * sub]; kg[9] = p.k_g[65 + 2 * sub]; kg[10] = p.k_g[80 + 2 * sub]; kg[11] = p.k_g[81 + 2 * sub];
    const float if0 = exp2f(-(float)(2 * sub) * (13.287712379549449f / 16.f)), if1 = exp2f(-(float)(2 * sub + 1) * (13.287712379549449f / 16.f));
    float cw0[8], cw1[8], cw2[8];
#pragma unroll
    for (int j = 0; j < 8; ++j) { cw0[j] = p.conv_w[8 * lane + j]; cw1[j] = p.conv_w[CONVW + 8 * lane + j]; cw2[j] = p.conv_w[2 * CONVW + 8 * lane + j]; }
    for (int t = gw; t < NTOK; t += NGW) {
        const int b = t >> 13, s = t & (SEQ - 1); const float pos = (float)p.pos[t];
        const bf16_t* pr = PROJ + (size_t)t * INCP;
        float rs_q, rs_kv;
        { const u32x2 w = *(const u32x2*)(pr + OFF_CQ + 4 * lane); const float a = bf_lo(w.x), bq = bf_hi(w.x), c = bf_lo(w.y), d = bf_hi(w.y); rs_q = rsqrtf(wave_sum(a * a + bq * bq + c * c + d * d) * (1.f / QLORA) + EPS); }
        { const unsigned w = *(const unsigned*)(pr + OFF_CKV + 2 * lane); const float a = bf_lo(w), bq = bf_hi(w); rs_kv = rsqrtf(wave_sum(a * a + bq * bq) * (1.f / KVLORA) + EPS); }
        { float cu[3][8];
#pragma unroll
          for (int d = 0; d < 3; ++d) { const int ss = s + d - 1; if (ss >= 0 && ss < SEQ) { const bf16_t* q = pr + (ptrdiff_t)(d - 1) * INCP; const u32x4 u = *(const u32x4*)(q + OFF_U + 8 * lane), c = *(const u32x4*)(q + OFF_C + 8 * lane);
                  cu[d][0] = bf_lo(u.x) * bf_lo(c.x); cu[d][1] = bf_hi(u.x) * bf_hi(c.x); cu[d][2] = bf_lo(u.y) * bf_lo(c.y); cu[d][3] = bf_hi(u.y) * bf_hi(c.y);
                  cu[d][4] = bf_lo(u.z) * bf_lo(c.z); cu[d][5] = bf_hi(u.z) * bf_hi(c.z); cu[d][6] = bf_lo(u.w) * bf_lo(c.w); cu[d][7] = bf_hi(u.w) * bf_hi(c.w); }
              else {
#pragma unroll
                  for (int j = 0; j < 8; ++j) cu[d][j] = 0.f; } }
          const u32x4 bg = *(const u32x4*)(pr + OFF_B + 8 * lane); float bb[8] = {bf_lo(bg.x), bf_hi(bg.x), bf_lo(bg.y), bf_hi(bg.y), bf_lo(bg.z), bf_hi(bg.z), bf_lo(bg.w), bf_hi(bg.w)}; float y[8];
#pragma unroll
          for (int j = 0; j < 8; ++j) y[j] = bb[j] * (cw0[j] * cu[0][j] + cw1[j] * cu[1][j] + cw2[j] * cu[2][j]);
          u32x4 o; o.x = pk2(y[0], y[1]); o.y = pk2(y[2], y[3]); o.z = pk2(y[4], y[5]); o.w = pk2(y[6], y[7]); *(u32x4*)(YB + (size_t)t * CONVW + 8 * lane) = o; }
        float c0, s0, c1, s1; sincosf(pos * if0, &s0, &c0); sincosf(pos * if1, &s1, &c1);
        const size_t rowi = ((size_t)(b * NH + h) * SEQ + s);
        { const bf16_t* qp = QPRE + (size_t)t * 768 + h * DQK; const u32x4 a = *(const u32x4*)(qp + sub * 8); const unsigned r1 = *(const unsigned*)(qp + 64 + 2 * sub), r2 = *(const unsigned*)(qp + 80 + 2 * sub);
          float v[12] = {bf_lo(a.x), bf_hi(a.x), bf_lo(a.y), bf_hi(a.y), bf_lo(a.z), bf_hi(a.z), bf_lo(a.w), bf_hi(a.w), bf_lo(r1), bf_hi(r1), bf_lo(r2), bf_hi(r2)}; float ss = 0.f;
#pragma unroll
          for (int j = 0; j < 12; ++j) { v[j] *= rs_q; ss += v[j] * v[j]; }
          ss += __shfl_xor(ss, 1); ss += __shfl_xor(ss, 2); ss += __shfl_xor(ss, 4);
          const float rstd = rsqrtf(ss * (1.f / DQK) + EPS);
#pragma unroll
          for (int j = 0; j < 12; ++j) v[j] *= rstd * qg[j] * QSCALE;
          const float o8 = v[8] * c0 - v[10] * s0, o9 = v[9] * c1 - v[11] * s1, o10 = v[8] * s0 + v[10] * c0, o11 = v[9] * s1 + v[11] * c1;
          bf16_t* qo = Q + rowi * DQK; u32x4 w; w.x = pk2(v[0], v[1]); w.y = pk2(v[2], v[3]); w.z = pk2(v[4], v[5]); w.w = pk2(v[6], v[7]);
          *(u32x4*)(qo + sub * 8) = w; *(unsigned*)(qo + 64 + 2 * sub) = pk2(o8, o9); *(unsigned*)(qo + 80 + 2 * sub) = pk2(o10, o11); }
        { const bf16_t* kp = KVPRE + (size_t)t * 1024 + h * 128; const u32x4 a = *(const u32x4*)(kp + sub * 8);
          const bf16_t* kr = pr + OFF_KR; const unsigned w1 = *(const unsigned*)(kr + 2 * sub), w2 = *(const unsigned*)(kr + 16 + 2 * sub);
          float v[12] = {bf_lo(a.x) * rs_kv, bf_hi(a.x) * rs_kv, bf_lo(a.y) * rs_kv, bf_hi(a.y) * rs_kv, bf_lo(a.z) * rs_kv, bf_hi(a.z) * rs_kv, bf_lo(a.w) * rs_kv, bf_hi(a.w) * rs_kv, bf_lo(w1), bf_hi(w1), bf_lo(w2), bf_hi(w2)}; float ss = 0.f;
#pragma unroll
          for (int j = 0; j < 12; ++j) ss += v[j] * v[j];
          ss += __shfl_xor(ss, 1); ss += __shfl_xor(ss, 2); ss += __shfl_xor(ss, 4);
          const float rstd = rsqrtf(ss * (1.f / DQK) + EPS);
#pragma unroll
          for (int j = 0; j < 12; ++j) v[j] *= rstd * kg[j];
          const float o8 = v[8] * c0 - v[10] * s0, o9 = v[9] * c1 - v[11] * s1, o10 = v[8] * s0 + v[10] * c0, o11 = v[9] * s1 + v[11] * c1;
          bf16_t* ko = Kb + rowi * 128; u32x4 w; w.x = pk2(v[0], v[1]); w.y = pk2(v[2], v[3]); w.z = pk2(v[4], v[5]); w.w = pk2(v[6], v[7]);
          *(u32x4*)(ko + sub * 8) = w; *(unsigned*)(ko + 64 + 2 * sub) = pk2(o8, o9); *(unsigned*)(ko + 80 + 2 * sub) = pk2(o10, o11);
          if (sub < 4) *(u32x4*)(ko + 96 + sub * 8) = (u32x4){0u, 0u, 0u, 0u};
          const u32x4 va = *(const u32x4*)(kp + 64 + sub * 8);
          u32x4 wv; wv.x = pk2(bf_lo(va.x) * rs_kv, bf_hi(va.x) * rs_kv); wv.y = pk2(bf_lo(va.y) * rs_kv, bf_hi(va.y) * rs_kv); wv.z = pk2(bf_lo(va.z) * rs_kv, bf_hi(va.z) * rs_kv); wv.w = pk2(bf_lo(va.w) * rs_kv, bf_hi(va.w) * rs_kv);
          *(u32x4*)(V + rowi * DV + sub * 8) = wv; }
    }
}

namespace att {
constexpr int NW = 8, QBLK = 32, KVBLK = 64;
constexpr float SCALE = 0.10206207261596575f;
constexpr float QSC = SCALE * 1.4426950408889634f;
constexpr int LDQ = DQK, LDK = 128, LDV = DV;
constexpr int SHM_V = KVBLK * DV * 2, SHM_K = KVBLK * 256, SHM_ATTN = 2 * SHM_V + 2 * SHM_K + NW * 64 * 4;
#define KSWZ(row, colB) ((row) * 256 + ((colB) ^ (((row) & 7) << 4)))
#define SBAR() __builtin_amdgcn_sched_barrier(0)
__device__ __forceinline__ int crow(int r, int hi) { return (r & 3) + 8 * (r >> 2) + 4 * hi; }
__device__ __forceinline__ unsigned cvtpk(float lo, float hi) { unsigned r; asm volatile("v_cvt_pk_bf16_f32 %0, %1, %2" : "=v"(r) : "v"(lo), "v"(hi)); return r; }
#define EXPH(P) do { _Pragma("unroll") for (int r = 0; r < 16; ++r) P[r] = __builtin_amdgcn_exp2f(P[r]); } while (0)
__device__ __forceinline__ void finishSM(f32x16& p0, f32x16& p1, float& l_reg, bf16x8& pa0, bf16x8& pa1, bf16x8& pa2, bf16x8& pa3) {
    EXPH(p1);
    float ps0 = 0.f, ps1 = 0.f;
#pragma unroll
    for (int r = 0; r < 16; ++r) { ps0 += p0[r]; ps1 += p1[r]; }
    l_reg += ps0 + ps1;
#define PK4(P, BASE, OUT) do { unsigned a0 = cvtpk(P[BASE + 0], P[BASE + 1]), a1 = cvtpk(P[BASE + 2], P[BASE + 3]);   \
    unsigned b0 = cvtpk(P[BASE + 4], P[BASE + 5]), b1 = cvtpk(P[BASE + 6], P[BASE + 7]);                              \
    auto r0 = __builtin_amdgcn_permlane32_swap(a0, b0, false, false); auto r1 = __builtin_amdgcn_permlane32_swap(a1, b1, false, false); \
    u32x4 w = {r0[0], r1[0], r0[1], r1[1]}; OUT = *reinterpret_cast<bf16x8*>(&w); } while (0)
    PK4(p0, 0, pa0); PK4(p0, 8, pa1); PK4(p1, 0, pa2); PK4(p1, 8, pa3);
#undef PK4
}
__device__ __forceinline__ void qkt(f32x16& p0, f32x16& p1, const unsigned char* Ks, const bf16x8* qr, int r32, int hi) {
    p0 = f32x16{}; p1 = f32x16{};
#pragma unroll
    for (int d0 = 0; d0 < 6; ++d0) { const int cb = (d0 * 16 + hi * 8) * 2;
        const bf16x8 b0 = *reinterpret_cast<const bf16x8*>(Ks + KSWZ(r32, cb));
        const bf16x8 b1 = *reinterpret_cast<const bf16x8*>(Ks + KSWZ(32 + r32, cb));
        p0 = __builtin_amdgcn_mfma_f32_32x32x16_bf16(b0, qr[d0], p0, 0, 0, 0);
        p1 = __builtin_amdgcn_mfma_f32_32x32x16_bf16(b1, qr[d0], p1, 0, 0, 0); }
}
__device__ __forceinline__ int v_st(int k, int c) { const int kk = (k & ~0xC) | ((k & 4) << 1) | ((k & 8) >> 1); return ((kk >> 3) * 2 + (c >> 5)) * 512 + ((kk & 7) * 32 + (c & 31)) * 2; }
__device__ __forceinline__ int v_rd_base(int lane) { return ((lane & 3) << 3) | (((lane >> 2) & 3) << 6) | (((lane >> 4) & 1) << 5) | (((lane >> 5) & 1) << 8); }
constexpr int v_rd_off(int d0, int ks, int half) { return d0 * 512 + ks * 2048 + half * 1024; }
template <int OFF> __device__ __forceinline__ s16x4 tr_read(int vb) { s16x4 r; asm volatile("ds_read_b64_tr_b16 %0, %1 offset:%2" : "=&v"(r) : "v"(vb), "i"(OFF) : "memory"); return r; }
template <int D0> __device__ __forceinline__ void pv_one(f32x16& od, int vb, bf16x8 pa0, bf16x8 pa1, bf16x8 pa2, bf16x8 pa3) {
    const s16x4 l0 = tr_read<v_rd_off(D0, 0, 0)>(vb), h0 = tr_read<v_rd_off(D0, 0, 1)>(vb), l1 = tr_read<v_rd_off(D0, 1, 0)>(vb), h1 = tr_read<v_rd_off(D0, 1, 1)>(vb);
    const s16x4 l2 = tr_read<v_rd_off(D0, 2, 0)>(vb), h2 = tr_read<v_rd_off(D0, 2, 1)>(vb), l3 = tr_read<v_rd_off(D0, 3, 0)>(vb), h3 = tr_read<v_rd_off(D0, 3, 1)>(vb);
    asm volatile("s_waitcnt lgkmcnt(0)" ::: "memory"); SBAR();
#define PK(L, H) (bf16x8){L[0], L[1], L[2], L[3], H[0], H[1], H[2], H[3]}
    __builtin_amdgcn_s_setprio(1);
    od = __builtin_amdgcn_mfma_f32_32x32x16_bf16(pa0, PK(l0, h0), od, 0, 0, 0);
    od = __builtin_amdgcn_mfma_f32_32x32x16_bf16(pa1, PK(l1, h1), od, 0, 0, 0);
    od = __builtin_amdgcn_mfma_f32_32x32x16_bf16(pa2, PK(l2, h2), od, 0, 0, 0);
    od = __builtin_amdgcn_mfma_f32_32x32x16_bf16(pa3, PK(l3, h3), od, 0, 0, 0);
    __builtin_amdgcn_s_setprio(0);
#undef PK
}
__device__ __forceinline__ void pv_d0(f32x16* o, int vb, bf16x8 pa0, bf16x8 pa1, bf16x8 pa2, bf16x8 pa3) { pv_one<0>(o[0], vb, pa0, pa1, pa2, pa3); pv_one<1>(o[1], vb, pa0, pa1, pa2, pa3); }

__device__ __forceinline__ void attn_unit(const bf16_t* __restrict__ Qb, const bf16_t* __restrict__ Kh, const bf16_t* __restrict__ Vh, bf16_t* __restrict__ Ob, int seq, unsigned char* lds) {
    const int tid = threadIdx.x, wid = __builtin_amdgcn_readfirstlane(tid >> 6), lane = tid & 63, r32 = lane & 31, hi = lane >> 5;
    unsigned char* V_lds = lds; unsigned char* K_lds = lds + 2 * SHM_V;
    float* wsf = (float*)(lds + 2 * SHM_V + 2 * SHM_K) + wid * 64; float* li_l = wsf;
    float l_reg = 0; f32x16 o[2] = {}; bf16x8 qr[6];
    const bf16_t* Qw = Qb + (size_t)(wid * QBLK + r32) * LDQ + hi * 8;
#pragma unroll
    for (int d0 = 0; d0 < 6; ++d0) qr[d0] = *reinterpret_cast<const bf16x8*>(Qw + d0 * 16);
    const int kr0 = 8 * wid + (lane >> 4), kcp = lane & 15;
    const bf16_t* ksrc0 = Kh + (size_t)kr0 * LDK + ((kcp ^ (kr0 & 7)) * 8);
    const bf16_t* ksrc1 = Kh + (size_t)(kr0 + 4) * LDK + ((kcp ^ ((kr0 + 4) & 7)) * 8);
    const int vkk = 8 * wid + ((lane >> 2) & 7), vk = (vkk & ~0xC) | ((vkk & 4) << 1) | ((vkk & 8) >> 1), vcc = 32 * (lane >> 5) + 8 * (lane & 3);
    const bf16_t* vsrc = Vh + (size_t)vk * LDV + vcc;
    typedef __attribute__((address_space(3))) unsigned* lds_u32p;
#define DMA_K(t, slot) do { __builtin_amdgcn_global_load_lds((const unsigned*)(ksrc0 + (size_t)(t) * KVBLK * LDK), (lds_u32p)(K_lds + (slot) * SHM_K + wid * 2048 + lane * 16), 16, 0, 0); \
                            __builtin_amdgcn_global_load_lds((const unsigned*)(ksrc1 + (size_t)(t) * KVBLK * LDK), (lds_u32p)(K_lds + (slot) * SHM_K + wid * 2048 + 1024 + lane * 16), 16, 0, 0); } while (0)
#define DMA_V(t, slot) __builtin_amdgcn_global_load_lds((const unsigned*)(vsrc + (size_t)(t) * KVBLK * LDV), (lds_u32p)(V_lds + (slot) * SHM_V + wid * 1024 + lane * 16), 16, 0, 0)
    const int vb0 = (int)(uintptr_t)V_lds + v_rd_base(lane);
    f32x16 pA0, pA1, pB0, pB1; bf16x8 pa0, pa1, pa2, pa3; const int NT = seq / KVBLK;
    DMA_K(0, 0); DMA_V(0, 0); DMA_K(1, 1);
    asm volatile("s_waitcnt vmcnt(0)" ::: "memory"); __syncthreads();
    qkt(pA0, pA1, K_lds, qr, r32, hi); EXPH(pA0); SBAR();
    __syncthreads();
    for (int j = 0; j + 2 < NT; j += 2) {
        DMA_K(j + 2, 0); DMA_V(j + 1, 1); SBAR();
        qkt(pB0, pB1, K_lds + SHM_K, qr, r32, hi);
        finishSM(pA0, pA1, l_reg, pa0, pa1, pa2, pa3); SBAR();
        pv_d0(o, vb0, pa0, pa1, pa2, pa3); EXPH(pB0); SBAR();
        asm volatile("s_waitcnt vmcnt(0)" ::: "memory"); __syncthreads();
        DMA_K(j + 3, 1); DMA_V(j + 2, 0); SBAR();
        qkt(pA0, pA1, K_lds, qr, r32, hi);
        finishSM(pB0, pB1, l_reg, pa0, pa1, pa2, pa3); SBAR();
        pv_d0(o, vb0 + SHM_V, pa0, pa1, pa2, pa3); EXPH(pA0); SBAR();
        asm volatile("s_waitcnt vmcnt(0)" ::: "memory"); __syncthreads();
    }
    DMA_V(NT - 1, 1); SBAR();
    qkt(pB0, pB1, K_lds + SHM_K, qr, r32, hi);
    finishSM(pA0, pA1, l_reg, pa0, pa1, pa2, pa3); SBAR();
    pv_d0(o, vb0, pa0, pa1, pa2, pa3); EXPH(pB0); SBAR();
    asm volatile("s_waitcnt vmcnt(0)" ::: "memory"); __syncthreads();
    finishSM(pB0, pB1, l_reg, pa0, pa1, pa2, pa3); SBAR();
    pv_d0(o, vb0 + SHM_V, pa0, pa1, pa2, pa3);
    { auto rr = __builtin_amdgcn_permlane32_swap(__float_as_uint(l_reg), __float_as_uint(l_reg), false, false); l_reg = __uint_as_float(rr[0]) + __uint_as_float(rr[1]); }
    if (hi == 0) li_l[r32] = l_reg; asm volatile("s_waitcnt lgkmcnt(0)" ::: "memory");
    float rli[16];
#pragma unroll
    for (int r = 0; r < 16; ++r) rli[r] = __builtin_amdgcn_rcpf(li_l[crow(r, hi)]);
    bf16_t* Ow = Ob + (size_t)(wid * QBLK) * 512;
#pragma unroll
    for (int r = 0; r < 16; ++r) { const int orow = crow(r, hi);
#pragma unroll
        for (int d0 = 0; d0 < 2; ++d0) Ow[(size_t)orow * 512 + d0 * 32 + r32] = (bf16_t)(pk2(o[d0][r] * rli[r], 0.f) & 0xffffu); }
    __syncthreads();
#undef DMA_K
#undef DMA_V
}
#undef KSWZ
#undef SBAR
}

__device__ __forceinline__ void phase_attn(const Params& p, unsigned char* lds) {
    const bf16_t* Q = (const bf16_t*)(p.ws + WS_Q); const bf16_t* Kb = (const bf16_t*)(p.ws + WS_K); const bf16_t* V = (const bf16_t*)(p.ws + WS_V); bf16_t* AO = (bf16_t*)(p.ws + WS_AO);
    constexpr int NQB = SEQ / 256, NU = 2 * NH * NQB;
    for (int u = blockIdx.x; u < NU; u += gridDim.x) {
        const int qb = u % NQB, h = (u / NQB) % NH, b = u / (NQB * NH); const size_t bh = (size_t)(b * NH + h) * SEQ;
        att::attn_unit(Q + (bh + (size_t)qb * 256) * DQK, Kb + bh * 128, V + bh * DV, AO + ((size_t)b * SEQ + (size_t)qb * 256) * 512 + h * DV, SEQ, lds);
    }
}

__device__ __forceinline__ int crow16(int r, int hi) { return (r & 3) + 8 * (r >> 2) + 4 * hi; }
__device__ __forceinline__ void phase_router(const Params& p, unsigned char* lds) {
    const int tid = threadIdx.x, lane = tid & 63, wid = tid >> 6, tile = wid >> 2, kq = wid & 3, c = lane & 31, h = lane >> 5;
    float* red = (float*)lds;
    float* ssb = red + 2 * 4 * 16 * 64;
    int* lcnt = (int*)(ssb + 2 * 4 * 64);
    int* lbase = lcnt + 32;
    unsigned* gcnt = (unsigned*)(p.ws + WS_CTL) + CW_CNT;
    int* row_tok = (int*)(p.ws + WS_RT2); float* row_w = (float*)(p.ws + WS_RT2 + 2 * MiB); int* row_slot = (int*)(p.ws + WS_RT2 + 4 * MiB); float* row_rstd = (float*)(p.ws + WS_RT2 + 6 * MiB);
    const u32x4* GF = (const u32x4*)(p.ws + WS_GF);
    for (int tg = blockIdx.x; tg < NTOK / 64; tg += gridDim.x) {
        if (tid < 32) lcnt[tid] = 0;
        const int token = tg * 64 + tile * 32 + c;
        const float* xrow = p.out + (size_t)token * DM + kq * 256 + 8 * h; const float* g2p = p.norm2_g + kq * 256 + 8 * h;
        unsigned char* hrow = p.ws + WS_H8 + (size_t)token * DM + kq * 256 + 8 * h;
        f32x16 acc = {}; float ss = 0.f;
#pragma unroll 2
        for (int s = 0; s < 16; ++s) {
            const f32x4 a = *(const f32x4*)(xrow + 16 * s), b = *(const f32x4*)(xrow + 16 * s + 4); const f32x4 ga = *(const f32x4*)(g2p + 16 * s), gb = *(const f32x4*)(g2p + 16 * s + 4);
            ss += (a[0] * a[0] + a[1] * a[1]) + (a[2] * a[2] + a[3] * a[3]) + (b[0] * b[0] + b[1] * b[1]) + (b[2] * b[2] + b[3] * b[3]);
            u32x4 xh; xh.x = pk2(a[0], a[1]); xh.y = pk2(a[2], a[3]); xh.z = pk2(b[0], b[1]); xh.w = pk2(b[2], b[3]);
            u32x4 xl; xl.x = pk2(a[0] - bf_lo(xh.x), a[1] - bf_hi(xh.x)); xl.y = pk2(a[2] - bf_lo(xh.y), a[3] - bf_hi(xh.y)); xl.z = pk2(b[0] - bf_lo(xh.z), b[1] - bf_hi(xh.z)); xl.w = pk2(b[2] - bf_lo(xh.w), b[3] - bf_hi(xh.w));
            u32x2 h8; h8.x = pk4_fp8(a[0] * ga[0], a[1] * ga[1], a[2] * ga[2], a[3] * ga[3]); h8.y = pk4_fp8(b[0] * gb[0], b[1] * gb[1], b[2] * gb[2], b[3] * gb[3]); *(u32x2*)(hrow + 16 * s) = h8;
            const u32x4 gh = GF[((kq * 16 + s) * 2 + 0) * 64 + lane], gl = GF[((kq * 16 + s) * 2 + 1) * 64 + lane];
            acc = __builtin_amdgcn_mfma_f32_32x32x16_bf16(__builtin_bit_cast(bf16x8, gh), __builtin_bit_cast(bf16x8, xh), acc, 0, 0, 0);
            acc = __builtin_amdgcn_mfma_f32_32x32x16_bf16(__builtin_bit_cast(bf16x8, gh), __builtin_bit_cast(bf16x8, xl), acc, 0, 0, 0);
            acc = __builtin_amdgcn_mfma_f32_32x32x16_bf16(__builtin_bit_cast(bf16x8, gl), __builtin_bit_cast(bf16x8, xh), acc, 0, 0, 0);
        }
#pragma unroll
        for (int r = 0; r < 16; ++r) red[((tile * 4 + kq) * 16 + r) * 64 + lane] = acc[r];
        ssb[(tile * 4 + kq) * 64 + lane] = ss;
        __syncthreads();
        int te[4] = {0, 0, 0, 0}, rl[4] = {0, 0, 0, 0}; float tw[4] = {0.f, 0.f, 0.f, 0.f}; float rstd = 0.f;
        if (kq == 0) {
            float v[16]; float st = 0.f;
#pragma unroll
            for (int q = 0; q < 4; ++q) st += ssb[(tile * 4 + q) * 64 + lane];
            { auto rr = __builtin_amdgcn_permlane32_swap(__float_as_uint(st), __float_as_uint(st), false, false); st = __uint_as_float(rr[0]) + __uint_as_float(rr[1]); }
            rstd = rsqrtf(st * (1.f / DM) + EPS);
#pragma unroll
            for (int r = 0; r < 16; ++r) { float sacc = 0.f;
#pragma unroll
                for (int q = 0; q < 4; ++q) sacc += red[((tile * 4 + q) * 16 + r) * 64 + lane];
                v[r] = sacc * rstd + p.router_b[crow16(r, h)]; }
            float lv[4]; int le[4];
#pragma unroll
            for (int k = 0; k < 4; ++k) { float best = v[0]; int bi = 0;
#pragma unroll
                for (int r = 1; r < 16; ++r) { const bool gt = v[r] > best; best = gt ? v[r] : best; bi = gt ? r : bi; }
                lv[k] = best; le[k] = (bi & 3) + 8 * (bi >> 2) + 4 * h;
#pragma unroll
                for (int r = 0; r < 16; ++r) v[r] = (r == bi) ? -INFINITY : v[r]; }
            float cv[8]; int ce[8];
#pragma unroll
            for (int k = 0; k < 4; ++k) { auto rv = __builtin_amdgcn_permlane32_swap(__float_as_uint(lv[k]), __float_as_uint(lv[k]), false, false); auto re = __builtin_amdgcn_permlane32_swap((unsigned)le[k], (unsigned)le[k], false, false);
                cv[k] = __uint_as_float(rv[0]); cv[4 + k] = __uint_as_float(rv[1]); ce[k] = (int)re[0]; ce[4 + k] = (int)re[1]; }
            float tv[4];
#pragma unroll
            for (int k = 0; k < 4; ++k) { float best = cv[0]; int be = ce[0]; int bi = 0;
#pragma unroll
                for (int r = 1; r < 8; ++r) { const bool gt = (cv[r] > best) || (cv[r] == best && ce[r] < be); best = gt ? cv[r] : best; be = gt ? ce[r] : be; bi = gt ? r : bi; }
                tv[k] = best; te[k] = be;
#pragma unroll
                for (int r = 0; r < 8; ++r) cv[r] = (r == bi) ? -INFINITY : cv[r]; }
            const float e1 = __expf(tv[1] - tv[0]), e2 = __expf(tv[2] - tv[0]), e3 = __expf(tv[3] - tv[0]); const float inv = 1.f / (1.f + e1 + e2 + e3);
            tw[0] = inv; tw[1] = e1 * inv; tw[2] = e2 * inv; tw[3] = e3 * inv;
            if (h == 0) {
#pragma unroll
                for (int k = 0; k < 4; ++k) rl[k] = atomicAdd(&lcnt[te[k]], 1); }
        }
        __syncthreads();
        if (tid < 32) lbase[tid] = (int)atomicAdd(&gcnt[tid], (unsigned)lcnt[tid]);
        __syncthreads();
        if (kq == 0 && h == 0) {
#pragma unroll
            for (int k = 0; k < 4; ++k) { const int idx = te[k] * CAP + lbase[te[k]] + rl[k]; row_tok[idx] = token; row_w[idx] = tw[k]; row_slot[idx] = token * 4 + k; row_rstd[idx] = rstd; } }
        __syncthreads();
    }
}

__device__ __forceinline__ void build_block_table(const Params& p, int* bs) {
    const unsigned* gcnt = (const unsigned*)(p.ws + WS_CTL) + CW_CNT;
    if (threadIdx.x == 0) { int acc = 0; for (int e = 0; e < NE; ++e) { bs[e] = acc; acc += ((int)__hip_atomic_load(gcnt + e, __ATOMIC_RELAXED, __HIP_MEMORY_SCOPE_AGENT) + 255) >> 8; } bs[NE] = acc; }
    __syncthreads();
}

__device__ __forceinline__ pg8::MoeOrder make_moe_order(const Params& p, unsigned char* lds, int N, bool gather) {
    int* bs = (int*)(lds + 131072); int* utab = (int*)(lds + 131072 + 256); int* gtab = (int*)(lds + 131072 + 512);
    build_block_table(p, bs);
    const int nmb = __builtin_amdgcn_readfirstlane(bs[NE]);
    pg8::MoeOrder S; S.so.init(nmb * 256, N, (int)gridDim.x, (int)blockIdx.x); S.utab = (const PG8_LAS int*)utab; S.gtab = (const PG8_LAS int*)gtab;
    const int* row_tok = (const int*)(p.ws + WS_RT2);
    for (int i = 0; i < pg8::MOE_MAXU; ++i) { pg8::Unit u; if (!S.so.next(i, u)) break; int e = 0; for (int k = 1; k < NE; ++k) if (bs[k] <= u.pm) e = k;
        const int rb = e * CAP + (u.pm - bs[e]) * 256;
        if (threadIdx.x == 0) utab[i] = e | (rb << 8);
        if (gather && threadIdx.x < 256) gtab[i * 256 + threadIdx.x] = row_tok[rb + threadIdx.x]; }
    __syncthreads();
    return S;
}
__device__ __forceinline__ void phase_moe1(const Params& p, unsigned char* lds) {
    const pg8::MoeOrder S = make_moe_order(p, lds, 2048, true);
    pg8::Gemm g{(const bf16_t*)(p.ws + WS_H8), (const bf16_t*)(p.ws + WS_W1), 0, 2048, DM / 2, (size_t)2048 * DM, 0};
    pg8::EpiSwiglu E{p.ws + WS_ACT, p.b1, (const float*)(p.ws + WS_RT2 + 6 * MiB)};
    pg8::gemm_phase<pg8::EpiSwiglu, pg8::MoeOrder, true, true, true, true>((PG8_LAS unsigned char*)lds, g, S, E);
}
__device__ __forceinline__ void phase_moe2(const Params& p, unsigned char* lds) {
    const pg8::MoeOrder S = make_moe_order(p, lds, DM, false);
    pg8::Gemm g{(const bf16_t*)(p.ws + WS_ACT), (const bf16_t*)(p.ws + WS_W2), 0, DM, DFF / 2, (size_t)DM * DFF, 0};
    pg8::EpiMoeOut E{(bf16_t*)(p.ws + WS_YS), p.b2, (const float*)(p.ws + WS_RT2 + 2 * MiB), (const int*)(p.ws + WS_RT2 + 4 * MiB)};
    pg8::gemm_phase<pg8::EpiMoeOut, pg8::MoeOrder, true, true, true>((PG8_LAS unsigned char*)lds, g, S, E);
}

__device__ __forceinline__ void phase_combine(const Params& p) {
    const int tid = threadIdx.x, lane = tid & 63, wave = tid >> 6;
    const int gw = blockIdx.x * NWAVES + wave, NGW = gridDim.x * NWAVES;
    const bf16_t* YS = (const bf16_t*)(p.ws + WS_YS);
    for (int t = gw; t < NTOK; t += NGW) {
        f32x4* orow = (f32x4*)(p.out + (size_t)t * DM) + lane;
#pragma unroll
        for (int j = 0; j < 4; ++j) { f32x4 v = orow[64 * j];
#pragma unroll
            for (int k = 0; k < 4; ++k) { const u32x2 w = *((const u32x2*)(YS + ((size_t)t * 4 + k) * DM) + lane + 64 * j); v[0] += bf_lo(w.x); v[1] += bf_hi(w.x); v[2] += bf_lo(w.y); v[3] += bf_hi(w.y); }
            orow[64 * j] = v; }
    }
}

template <class Epi>
__device__ __forceinline__ void dense_gemm(unsigned char* lds, const bf16_t* A, const bf16_t* Bt, int M, int N, int K, const Epi& E, int lda = 0) {
    pg8::Gemm g{A, Bt, M, N, K, 0, lda}; pg8::StaticOrder S; S.init(M, N, (int)gridDim.x, (int)blockIdx.x);
    pg8::gemm_phase<Epi, pg8::StaticOrder, true, true>((PG8_LAS unsigned char*)lds, g, S, E);
}

constexpr int NPHASE = 13;
__global__ void __launch_bounds__(NTHREADS, 2) mk_fwd(Params p) {
    extern __shared__ __attribute__((aligned(16))) unsigned char lds[];
    cg::grid_group grid = cg::this_grid();
    unsigned char* ws = p.ws;
    volatile LAS unsigned* MISC = (volatile LAS unsigned*)((LAS unsigned char*)lds + MISC_OFF);
    if (threadIdx.x < 32) MISC[threadIdx.x] = 0u;
    __syncthreads();
    XcdBarrier bar = xcd_barrier_post((unsigned*)(ws + WS_CTL) + CW_BAR, MISC + 8);
    const int lo = p.ph_lo, hi = p.ph_hi;
    if (lo < 0) grid.sync();
#define IN(k) (lo <= (k) && (k) < hi)
#define SEAM(k) do { if (IN(k) && IN((k) + 1)) xcd_barrier(bar); } while (0)
    if (IN(0)) phase_prologue(p, lds);
    SEAM(0);
    if (IN(1)) { pg8::EpiProj E{(bf16_t*)(ws + WS_PROJ)}; dense_gemm(lds, (const bf16_t*)(ws + WS_XN), (const bf16_t*)(ws + WS_WIN), NTOK, INCP, DM, E); }
    if (IN(1) && IN(3)) xcd_barrier(bar);
    if (IN(3)) { pg8::EpiBf16 Eq{(bf16_t*)(ws + WS_QPRE), 768}; dense_gemm(lds, (const bf16_t*)(ws + WS_PROJ) + OFF_CQ, (const bf16_t*)(ws + WS_WUQ), NTOK, 768, QLORA, Eq, INCP);
                 pg8::EpiBf16 Ek{(bf16_t*)(ws + WS_KVPRE), 1024}; dense_gemm(lds, (const bf16_t*)(ws + WS_PROJ) + OFF_CKV, (const bf16_t*)(ws + WS_WUKV), NTOK, 1024, KVLORA, Ek, INCP); }
    SEAM(3);
    if (IN(4)) phase_tok_b(p);
    SEAM(4);
    if (IN(5)) phase_attn(p, lds);
    SEAM(5);
    if (IN(6)) { pg8::EpiGateA E{(bf16_t*)(ws + WS_M1), (const bf16_t*)(ws + WS_PROJ)}; dense_gemm(lds, (const bf16_t*)(ws + WS_AO), (const bf16_t*)(ws + WS_WOMLA), NTOK, DM, 512, E); }
    if (IN(7)) { pg8::EpiGateB E{(const bf16_t*)(ws + WS_M1), (const bf16_t*)(ws + WS_PROJ), (bf16_t*)(ws + WS_MERGED)}; dense_gemm(lds, (const bf16_t*)(ws + WS_YBIN), (const bf16_t*)(ws + WS_WOCONV), NTOK, DM, 512, E); }
    SEAM(7);
    if (IN(8)) { pg8::EpiResid E{p.x, p.out}; dense_gemm(lds, (const bf16_t*)(ws + WS_MERGED), (const bf16_t*)(ws + WS_WO), NTOK, DM, DM, E); }
    SEAM(8);
    if (IN(9)) phase_router(p, lds);
    if (IN(9) && IN(11)) xcd_barrier(bar);
    if (IN(11)) phase_moe1(p, lds);
    SEAM(11);
    if (IN(12)) phase_moe2(p, lds);
    SEAM(12);
    if (IN(13)) phase_combine(p);
#undef IN
#undef SEAM
}

extern "C" void kernel_launch(void* const* d_in, const int* in_sizes, int n_in, void* d_out, int out_size,
                              void* d_ws, size_t ws_size, hipStream_t stream) {
    static int grid_blocks = 0;
    if (!grid_blocks) {
        int dev = 0, cus = 0, per_cu = 0;
        (void)hipGetDevice(&dev);
        (void)hipDeviceGetAttribute(&cus, hipDeviceAttributeMultiprocessorCount, dev);
        (void)hipFuncSetAttribute((const void*)mk_fwd, hipFuncAttributeMaxDynamicSharedMemorySize, LDS_BYTES);
        (void)hipOccupancyMaxActiveBlocksPerMultiprocessor(&per_cu, (const void*)mk_fwd, NTHREADS, LDS_BYTES);
        if (per_cu < 1) { fprintf(stderr, "kernel_launch: occupancy query says %d blocks/CU\n", per_cu); per_cu = 1; }
        grid_blocks = cus;
        if (ws_size < WS_END2 || n_in != 21) fprintf(stderr, "kernel_launch: ws %zu < %zu or n_in %d != 21\n", ws_size, (size_t)WS_END2, n_in);
    }
    (void)hipMemsetAsync((char*)d_ws + WS_CTL, 0, 1 * MiB, stream);
    Params p{};
    p.x = (const float*)d_in[0]; p.pos = (const int*)d_in[1]; p.norm1_g = (const float*)d_in[2]; p.w_in = (const float*)d_in[3]; p.q_a_g = (const float*)d_in[4];
    p.kv_a_g = (const float*)d_in[5]; p.w_uq = (const float*)d_in[6]; p.w_ukv = (const float*)d_in[7]; p.q_g = (const float*)d_in[8]; p.k_g = (const float*)d_in[9];
    p.conv_w = (const float*)d_in[10]; p.w_o_mla = (const float*)d_in[11]; p.w_o_conv = (const float*)d_in[12]; p.w_o = (const float*)d_in[13]; p.norm2_g = (const float*)d_in[14];
    p.router_w = (const float*)d_in[15]; p.router_b = (const float*)d_in[16]; p.w1 = (const float*)d_in[17]; p.b1 = (const float*)d_in[18]; p.w2 = (const float*)d_in[19]; p.b2 = (const float*)d_in[20];
    p.out = (float*)d_out; p.ws = (unsigned char*)d_ws; p.ph_lo = 0; p.ph_hi = NPHASE + 1;
    void* args[] = {&p};
    hipError_t e = hipLaunchCooperativeKernel((const void*)mk_fwd, dim3(grid_blocks), dim3(NTHREADS), args, LDS_BYTES, stream);
    if (e != hipSuccess) fprintf(stderr, "cooperative launch failed: %s (grid %d)\n", hipGetErrorString(e), grid_blocks);
}
```

```cpp
#include <hip/hip_runtime.h>
#include <hip/hip_cooperative_groups.h>
#include <cstdio>
#include <cstdint>
namespace cg = cooperative_groups;

typedef unsigned short bf16_t;
typedef short bf16x8 __attribute__((ext_vector_type(8)));
typedef short s16x4 __attribute__((ext_vector_type(4)));
typedef float f32x4 __attribute__((ext_vector_type(4)));
typedef float f32x2 __attribute__((ext_vector_type(2)));
typedef float f32x16 __attribute__((ext_vector_type(16)));
typedef unsigned u32x4 __attribute__((ext_vector_type(4)));
typedef unsigned u32x2 __attribute__((ext_vector_type(2)));
typedef __bf16 bf16x2_t __attribute__((ext_vector_type(2)));

constexpr int NTOK = 16384, DM = 1024, SEQ = 8192;
constexpr int INC = 4000, INCP = 4096;
constexpr int OFF_CQ = 0, OFF_CKV = 256, OFF_KR = 384, OFF_U = 416, OFF_C = 928, OFF_B = 1440, OFF_GA = 1952, OFF_GB = 2976;
constexpr int NH = 8, DQK = 96, DV = 64, NE = 32, TOPK = 4, DFF = 1024;
constexpr int QLORA = 256, KVLORA = 128, CONVW = 512;
constexpr int NPAIR = NTOK * TOPK;
constexpr int MAXROWS = 73728;
constexpr float EPS = 1e-6f;
constexpr int CAP = 16384;
constexpr int NTHREADS = 512, NWAVES = 8;
constexpr int LDS_BYTES = 147456;

constexpr size_t MiB = 1ull << 20;
constexpr size_t WS_CTL = 0;
constexpr size_t WS_WIN = 1 * MiB;
constexpr size_t WS_WUQ = 9 * MiB;
constexpr size_t WS_WUKV = WS_WUQ + 512 * 1024;
constexpr size_t WS_WOMLA = 10 * MiB;
constexpr size_t WS_WOCONV = 11 * MiB;
constexpr size_t WS_WO = 12 * MiB;
constexpr size_t WS_ROUTE = 14 * MiB;
constexpr size_t WS_W1 = 18 * MiB;
constexpr size_t WS_W2 = 146 * MiB;
constexpr size_t WS_XN = 210 * MiB;
constexpr size_t WS_PROJ = 242 * MiB;
constexpr size_t WS_CQN = 370 * MiB;
constexpr size_t WS_CKVN = 378 * MiB;
constexpr size_t WS_YBIN = 386 * MiB;
constexpr size_t WS_QPRE = 402 * MiB;
constexpr size_t WS_KVPRE = 450 * MiB;
constexpr size_t WS_Q = 514 * MiB;
constexpr size_t WS_K = 538 * MiB;
constexpr size_t WS_V = 570 * MiB;
constexpr size_t WS_AO = 586 * MiB;
constexpr size_t WS_M1 = 602 * MiB;
constexpr size_t WS_MERGED = 666 * MiB;
constexpr size_t WS_YS = 698 * MiB;
constexpr size_t WS_END = 826 * MiB;
constexpr size_t WS_ACT = WS_PROJ;
constexpr size_t WS_H8 = WS_XN;
constexpr size_t WS_GF = 830 * MiB;
constexpr size_t WS_RT2 = 832 * MiB;
constexpr size_t WS_END2 = 840 * MiB;
constexpr size_t RT_PAIR_E = 0, RT_PAIR_RANK = 262144, RT_PAIR_W = 524288, RT_ROW_TOK = 786432, RT_ROW_W = 786432 + 294912, RT_ROW_SLOT = 786432 + 2 * 294912;
constexpr int CW_CNT = 64;
constexpr int CW_BAR = 4096;
constexpr int MISC_OFF = LDS_BYTES - 256;

struct Params {
    const float* x; const int* pos; const float* norm1_g; const float* w_in; const float* q_a_g; const float* kv_a_g;
    const float* w_uq; const float* w_ukv; const float* q_g; const float* k_g; const float* conv_w; const float* w_o_mla;
    const float* w_o_conv; const float* w_o; const float* norm2_g; const float* router_w; const float* router_b;
    const float* w1; const float* b1; const float* w2; const float* b2;
    float* out; unsigned char* ws; int ph_lo, ph_hi;
};

__device__ __forceinline__ unsigned pk2(float lo, float hi) { f32x2 v = {lo, hi}; bf16x2_t b = __builtin_convertvector(v, bf16x2_t); return __builtin_bit_cast(unsigned, b); }
__device__ __forceinline__ float bf_lo(unsigned w) { return __uint_as_float(w << 16); }
__device__ __forceinline__ float bf_hi(unsigned w) { return __uint_as_float(w & 0xffff0000u); }
__device__ __forceinline__ float bf1(bf16_t h) { return __uint_as_float((unsigned)h << 16); }
__device__ __forceinline__ float wave_sum(float v) {
#pragma unroll
    for (int o = 1; o < 64; o <<= 1) v += __shfl_xor(v, o);
    return v;
}
__device__ __forceinline__ unsigned pk4_fp8(float a, float b, float c, float d) { unsigned w = 0u; w = (unsigned)__builtin_amdgcn_cvt_pk_fp8_f32(a, b, (int)w, false); w = (unsigned)__builtin_amdgcn_cvt_pk_fp8_f32(c, d, (int)w, true); return w; }
constexpr float W8_SCALE = 32.f, W8_INV = 1.f / 32.f;
__device__ __forceinline__ float sigmoidf_(float v) { return __builtin_amdgcn_rcpf(1.f + __builtin_amdgcn_exp2f(v * -1.4426950408889634f)); }

namespace pg8 {
#define PG8_LAS __attribute__((address_space(3)))
constexpr int BM = 256, BK = 64, HALF = 128, HTB = HALF * BK * 2  , STAGE_BYTES = 8 * HTB, NXCD = 8, WGM = 8;

__host__ __device__ __forceinline__ int lds_byte(int r, int c) { const int st = (r >> 4) * 2 + (c >> 5), rr = r & 15, cc = c & 31, ob = rr * 64 + cc * 2; return st * 1024 + (ob ^ (((ob >> 9) & 1) << 5)); }
__host__ __device__ __forceinline__ void stage_rc(int b, int& R, int& C) { const int st = b / 1024, sb = b % 1024, swz = sb ^ (((sb >> 9) & 1) << 5); R = (st >> 1) * 16 + swz / 64; C = (st & 1) * 32 + (swz % 64) / 2; }
__host__ __device__ __forceinline__ int perm32(int rho) { const int n = rho >> 4, i = rho & 15; return 8 * (i >> 2) + 4 * n + (i & 3); }

struct Unit { int pm, pn, e, rb; };
struct Gemm { const bf16_t* A; const bf16_t* Bt; int M, N, K; size_t bstride; int lda; };

struct StaticOrder {
    int nM, nN, nwg, G, c;
    __host__ __device__ void init(int M, int N, int G_, int c_) { nM = M / BM; nN = N / BM; nwg = nM * nN; G = G_; c = c_; }
    __host__ __device__ bool next(int i, Unit& u) const {
        const long L = (long)i * G + c; if (L >= nwg) return false;
        int wgid = (int)L; { const int q = nwg / NXCD, r = nwg % NXCD, xcd = wgid % NXCD, off = wgid / NXCD; wgid = (xcd < r ? xcd * (q + 1) : r * (q + 1) + (xcd - r) * q) + off; }
        const int nig = WGM * nN, gid = wgid / nig, fm = gid * WGM, gsz = (nM - fm) < WGM ? (nM - fm) : WGM;
        u.pm = fm + ((wgid % nig) % gsz); u.pn = (wgid % nig) / gsz; u.e = 0; u.rb = 0; return true;
    }
    __device__ __forceinline__ void a_ready(const Unit&) const {}
    __device__ __forceinline__ void done(const Unit&) const {}
};


struct EpiProj {
    static constexpr bool PERM = true, AFTER_DRAIN = false;
    bf16_t* O;
    __device__ __forceinline__ void operator()(const f32x4 (&acc)[2][2][4][2], const Unit& u, int wr, int wc, int fr, int fq) const {
        const int row0 = u.pm * BM + wr * 64 + fr, col0 = u.pn * BM + wc * 32 + 8 * fq;
#pragma unroll
        for (int ai = 0; ai < 2; ++ai)
#pragma unroll
            for (int m = 0; m < 4; ++m) { bf16_t* rowp = O + (size_t)(row0 + ai * HALF + m * 16) * INCP + col0;
#pragma unroll
                for (int bj = 0; bj < 2; ++bj) { f32x4 v0 = acc[ai][bj][m][0], v1 = acc[ai][bj][m][1]; const int col = col0 + bj * HALF;
                    if (col >= OFF_GA && col < INC) {
#pragma unroll
                        for (int j = 0; j < 4; ++j) { v0[j] = sigmoidf_(v0[j]); v1[j] = sigmoidf_(v1[j]); } }
                    u32x4 w; w.x = pk2(v0[0], v0[1]); w.y = pk2(v0[2], v0[3]); w.z = pk2(v1[0], v1[1]); w.w = pk2(v1[2], v1[3]);
                    *(u32x4*)(rowp + bj * HALF) = w; } }
    }
};
struct EpiBf16 {
    static constexpr bool PERM = true, AFTER_DRAIN = false;
    bf16_t* O; int ldc;
    __device__ __forceinline__ void operator()(const f32x4 (&acc)[2][2][4][2], const Unit& u, int wr, int wc, int fr, int fq) const {
        const int row0 = u.pm * BM + wr * 64 + fr, col0 = u.pn * BM + wc * 32 + 8 * fq;
#pragma unroll
        for (int ai = 0; ai < 2; ++ai)
#pragma unroll
            for (int m = 0; m < 4; ++m) { bf16_t* rowp = O + (size_t)(row0 + ai * HALF + m * 16) * ldc + col0;
#pragma unroll
                for (int bj = 0; bj < 2; ++bj) { const f32x4 v0 = acc[ai][bj][m][0], v1 = acc[ai][bj][m][1];
                    u32x4 w; w.x = pk2(v0[0], v0[1]); w.y = pk2(v0[2], v0[3]); w.z = pk2(v1[0], v1[1]); w.w = pk2(v1[2], v1[3]); *(u32x4*)(rowp + bj * HALF) = w; } }
    }
};
struct EpiF32 {
    static constexpr bool PERM = false, AFTER_DRAIN = false;
    float* O; int ldc;
    __device__ __forceinline__ void operator()(const f32x4 (&acc)[2][2][4][2], const Unit& u, int wr, int wc, int fr, int fq) const {
        const int row0 = u.pm * BM + wr * 64 + fr, col0 = u.pn * BM + wc * 32 + 4 * fq;
#pragma unroll
        for (int ai = 0; ai < 2; ++ai)
#pragma unroll
            for (int m = 0; m < 4; ++m) { float* rowp = O + (size_t)(row0 + ai * HALF + m * 16) * ldc + col0;
#pragma unroll
                for (int bj = 0; bj < 2; ++bj)
#pragma unroll
                    for (int n = 0; n < 2; ++n) *(f32x4*)(rowp + bj * HALF + n * 16) = acc[ai][bj][m][n]; }
    }
};
__device__ __forceinline__ void unpack8(const u32x4 g, float (&f)[8]) { f[0] = bf_lo(g.x); f[1] = bf_hi(g.x); f[2] = bf_lo(g.y); f[3] = bf_hi(g.y); f[4] = bf_lo(g.z); f[5] = bf_hi(g.z); f[6] = bf_lo(g.w); f[7] = bf_hi(g.w); }
struct EpiGateA {
    static constexpr bool PERM = true, AFTER_DRAIN = false;
    bf16_t* M1; const bf16_t* proj;
    __device__ __forceinline__ void operator()(const f32x4 (&acc)[2][2][4][2], const Unit& u, int wr, int wc, int fr, int fq) const {
        const int row0 = u.pm * BM + wr * 64 + fr, col0 = u.pn * BM + wc * 32 + 8 * fq;
#pragma unroll
        for (int ai = 0; ai < 2; ++ai)
#pragma unroll
            for (int m = 0; m < 4; ++m) { const size_t row = (size_t)(row0 + ai * HALF + m * 16);
#pragma unroll
                for (int bj = 0; bj < 2; ++bj) { const int col = col0 + bj * HALF; float g[8]; unpack8(*(const u32x4*)(proj + row * INCP + OFF_GA + col), g);
                    const f32x4 v0 = acc[ai][bj][m][0], v1 = acc[ai][bj][m][1];
                    u32x4 w; w.x = pk2(v0[0] * g[0], v0[1] * g[1]); w.y = pk2(v0[2] * g[2], v0[3] * g[3]); w.z = pk2(v1[0] * g[4], v1[1] * g[5]); w.w = pk2(v1[2] * g[6], v1[3] * g[7]);
                    *(u32x4*)(M1 + row * DM + col) = w; } }
    }
};
struct EpiGateB {
    static constexpr bool PERM = true, AFTER_DRAIN = false;
    const bf16_t* M1; const bf16_t* proj; bf16_t* O;
    __device__ __forceinline__ void operator()(const f32x4 (&acc)[2][2][4][2], const Unit& u, int wr, int wc, int fr, int fq) const {
        const int row0 = u.pm * BM + wr * 64 + fr, col0 = u.pn * BM + wc * 32 + 8 * fq;
#pragma unroll
        for (int ai = 0; ai < 2; ++ai)
#pragma unroll
            for (int m = 0; m < 4; ++m) { const size_t row = (size_t)(row0 + ai * HALF + m * 16);
#pragma unroll
                for (int bj = 0; bj < 2; ++bj) { const int col = col0 + bj * HALF; float g[8], b[8]; unpack8(*(const u32x4*)(proj + row * INCP + OFF_GB + col), g); unpack8(*(const u32x4*)(M1 + row * DM + col), b);
                    const f32x4 v0 = acc[ai][bj][m][0], v1 = acc[ai][bj][m][1];
                    u32x4 w; w.x = pk2(b[0] + v0[0] * g[0], b[1] + v0[1] * g[1]); w.y = pk2(b[2] + v0[2] * g[2], b[3] + v0[3] * g[3]);
                    w.z = pk2(b[4] + v1[0] * g[4], b[5] + v1[1] * g[5]); w.w = pk2(b[6] + v1[2] * g[6], b[7] + v1[3] * g[7]);
                    *(u32x4*)(O + row * DM + col) = w; } }
    }
};
struct EpiResid {
    static constexpr bool PERM = false, AFTER_DRAIN = false;
    const float* X; float* O;
    __device__ __forceinline__ void operator()(const f32x4 (&acc)[2][2][4][2], const Unit& u, int wr, int wc, int fr, int fq) const {
        const int row0 = u.pm * BM + wr * 64 + fr, col0 = u.pn * BM + wc * 32 + 4 * fq;
#pragma unroll
        for (int ai = 0; ai < 2; ++ai)
#pragma unroll
            for (int m = 0; m < 4; ++m) { const size_t off = (size_t)(row0 + ai * HALF + m * 16) * DM + col0;
#pragma unroll
                for (int bj = 0; bj < 2; ++bj)
#pragma unroll
                    for (int n = 0; n < 2; ++n) { const f32x4 b = *(const f32x4*)(X + off + bj * HALF + n * 16); *(f32x4*)(O + off + bj * HALF + n * 16) = b + acc[ai][bj][m][n]; } }
    }
};
struct EpiSwiglu {
    static constexpr bool PERM = true, AFTER_DRAIN = false;
    unsigned char* ACT; const float* b1; const float* row_rstd;
    __device__ __forceinline__ void operator()(const f32x4 (&acc)[2][2][4][2], const Unit& u, int wr, int wc, int fr, int fq) const {
        const int row0 = u.pm * BM + wr * 64 + fr, f0 = u.pn * HALF + wc * 32 + 8 * fq; const float* be = b1 + (size_t)u.e * 2048;
        const f32x4 bg0 = *(const f32x4*)(be + f0), bg1 = *(const f32x4*)(be + f0 + 4), bu0 = *(const f32x4*)(be + DFF + f0), bu1 = *(const f32x4*)(be + DFF + f0 + 4);
#pragma unroll
        for (int ai = 0; ai < 2; ++ai)
#pragma unroll
            for (int m = 0; m < 4; ++m) { const size_t row = (size_t)(row0 + ai * HALF + m * 16); float o[8]; const float rs = row_rstd[u.rb + wr * 64 + fr + ai * HALF + m * 16] * W8_INV;
#pragma unroll
                for (int n = 0; n < 2; ++n) { const f32x4 g4 = acc[ai][0][m][n] * rs + (n ? bg1 : bg0), u4 = acc[ai][1][m][n] * rs + (n ? bu1 : bu0);
#pragma unroll
                    for (int j = 0; j < 4; ++j) { const float g = fminf(g4[j], 7.f), uu = fminf(fmaxf(u4[j], -7.f), 7.f); o[4 * n + j] = (uu + 1.f) * (g * sigmoidf_(1.702f * g)); } }
                u32x2 w; w.x = pk4_fp8(o[0], o[1], o[2], o[3]); w.y = pk4_fp8(o[4], o[5], o[6], o[7]); *(u32x2*)(ACT + row * DFF + f0) = w; }
    }
};
struct EpiMoeOut {
    static constexpr bool PERM = true, AFTER_DRAIN = false;
    bf16_t* YS; const float* b2; const float* row_w; const int* row_slot;
    __device__ __forceinline__ void operator()(const f32x4 (&acc)[2][2][4][2], const Unit& u, int wr, int wc, int fr, int fq) const {
        const int row0 = u.pm * BM + wr * 64 + fr, col0 = u.pn * BM + wc * 32 + 8 * fq; const float* be = b2 + (size_t)u.e * DM;
        f32x4 bv[2][2];
#pragma unroll
        for (int bj = 0; bj < 2; ++bj)
#pragma unroll
            for (int n = 0; n < 2; ++n) bv[bj][n] = *(const f32x4*)(be + col0 + bj * HALF + 4 * n);
#pragma unroll
        for (int ai = 0; ai < 2; ++ai)
#pragma unroll
            for (int m = 0; m < 4; ++m) { const int row = u.rb + wr * 64 + fr + ai * HALF + m * 16; const int slot = row_slot[row]; const float w = row_w[row];
                if (slot >= 0) { bf16_t* rowp = YS + (size_t)slot * DM + col0;
#pragma unroll
                    for (int bj = 0; bj < 2; ++bj) { const f32x4 v0 = (acc[ai][bj][m][0] * W8_INV + bv[bj][0]) * w, v1 = (acc[ai][bj][m][1] * W8_INV + bv[bj][1]) * w;
                        u32x4 o; o.x = pk2(v0[0], v0[1]); o.y = pk2(v0[2], v0[3]); o.z = pk2(v1[0], v1[1]); o.w = pk2(v1[2], v1[3]); *(u32x4*)(rowp + bj * HALF) = o; } } }
    }
};
constexpr int MOE_MAXU = 12;
struct MoeOrder {
    StaticOrder so; const PG8_LAS int* utab; const PG8_LAS int* gtab;
    __device__ __forceinline__ bool next(int i, Unit& u) const { if (i >= MOE_MAXU || !so.next(i, u)) return false; const int v = __builtin_amdgcn_readfirstlane(utab[i]); u.e = v & 31; u.rb = (int)((unsigned)v >> 8); return true; }
    __device__ __forceinline__ void a_ready(const Unit&) const {}
    __device__ __forceinline__ void done(const Unit&) const {}
};
typedef int i32x4_t __attribute__((ext_vector_type(4))); typedef int i32x8_t __attribute__((ext_vector_type(8)));
__device__ __forceinline__ i32x8_t cat8(bf16x8 lo, bf16x8 hi) { return __builtin_shufflevector(__builtin_bit_cast(i32x4_t, lo), __builtin_bit_cast(i32x4_t, hi), 0, 1, 2, 3, 4, 5, 6, 7); }
__device__ __forceinline__ void mfma_fp8_inplace(f32x4& c, const i32x8_t a, const i32x8_t b) { asm volatile("s_nop 1\n\tv_mfma_f32_16x16x128_f8f6f4 %0, %1, %2, %0" : "+v"(c) : "v"(a), "v"(b)); }
__device__ __forceinline__ void mfma_fp8_drain() { asm volatile("s_nop 15\n\ts_nop 7" ::: "memory"); __builtin_amdgcn_sched_barrier(0); }
template <class Epi, class Sched, bool ALIGN_EPI = false, bool SP2 = false, bool FP8 = false, bool GATHER = false>
__device__ __forceinline__ void gemm_phase(PG8_LAS unsigned char* lds, const Gemm g, const Sched& S, const Epi& E) {
    const int tid = threadIdx.x, wid = __builtin_amdgcn_readfirstlane(tid >> 6), lane = tid & 63, wr = wid >> 2, wc = wid & 3, fr = lane & 15, fq = lane >> 4;
    const int K = g.K, nt = K / BK;
    static_assert(!GATHER || SP2, "GATHER is implemented for the SP2 loop only");
    const unsigned rowA = (unsigned)(g.lda ? g.lda : K) * 2u;
    unsigned voffA[2], voffB[2]; int gR0 = 0; unsigned gC = 0u;
#pragma unroll
    for (int i = 0; i < 2; ++i) { int R, C; stage_rc(tid * 16 + i * 8192, R, C); const int Rb = Epi::PERM ? ((R & ~31) + perm32(R & 31)) : R;
        voffA[i] = (unsigned)R * rowA + (unsigned)C * 2u; voffB[i] = (unsigned)(Rb * K + C) * 2u; if (i == 0) { gR0 = R; gC = (unsigned)C * 2u; } }
    unsigned gA[2][2] = {{0u, 0u}, {0u, 0u}}, ngA[2][2] = {{0u, 0u}, {0u, 0u}};
#define PG8_GLOAD(dst, ui_) do { _Pragma("unroll") for (int h_ = 0; h_ < 2; ++h_) _Pragma("unroll") for (int i_ = 0; i_ < 2; ++i_) \
        dst[h_][i_] = (unsigned)S.gtab[(ui_) * 256 + 128 * h_ + gR0 + 64 * i_] * rowA + gC; } while (0)
#define PG8_VA(h) (GATHER ? gA[h] : voffA)
    const unsigned kstep = (unsigned)(BK * 2);
    const unsigned hstep = (unsigned)HALF * (unsigned)K * 2u;
    const unsigned tstep = 2u * hstep;
    const unsigned hstepA = (unsigned)HALF * rowA, tstepA = 2u * hstepA;
    const unsigned hsA = GATHER ? 0u : hstepA;
    const unsigned ldsw = (unsigned)wid * 1024u;
    const int aoff = lds_byte(wr * 64 + fr, fq * 8), boff = lds_byte(wc * 32 + fr, fq * 8);
#define PG8_SA(b, h) (((b) * 2 + (h)) * HTB)
#define PG8_SB(b, h) ((4 + (b) * 2 + (h)) * HTB)
#define PG8_STAGE(rs, bufoff, goff, voff) do { _Pragma("unroll") for (int _i = 0; _i < 2; ++_i) \
        __builtin_amdgcn_raw_ptr_buffer_load_lds(rs, (PG8_LAS void*)(lds + (bufoff) + ldsw + _i * 8192), 16, (int)(voff)[_i], (int)(goff), 0, 0); } while (0)
#define PG8_LDA(dst, b, h) do { _Pragma("unroll") for (int m = 0; m < 4; ++m) _Pragma("unroll") for (int k = 0; k < 2; ++k) dst[m][k] = *(const PG8_LAS bf16x8*)(lds + PG8_SA(b, h) + aoff + m * 2048 + k * 1024); } while (0)
#define PG8_LDB(dst, b, h) do { _Pragma("unroll") for (int n = 0; n < 2; ++n) _Pragma("unroll") for (int k = 0; k < 2; ++k) dst[n][k] = *(const PG8_LAS bf16x8*)(lds + PG8_SB(b, h) + boff + n * 2048 + k * 1024); } while (0)
#define PG8_MMA(ai, bj, At, Bt) do { __builtin_amdgcn_s_setprio(1); _Pragma("unroll") for (int m = 0; m < 4; ++m) _Pragma("unroll") for (int n = 0; n < 2; ++n) { \
        if constexpr (FP8) { mfma_fp8_inplace(acc[ai][bj][m][n], cat8(Bt[n][0], Bt[n][1]), cat8(At[m][0], At[m][1])); } \
        else { _Pragma("unroll") for (int k = 0; k < 2; ++k) acc[ai][bj][m][n] = __builtin_amdgcn_mfma_f32_16x16x32_bf16(Bt[n][k], At[m][k], acc[ai][bj][m][n], 0, 0, 0); } } \
        __builtin_amdgcn_s_setprio(0); } while (0)
#define PG8_WAIT_V(n) asm volatile("s_waitcnt vmcnt(" #n ")" ::: "memory")
#define PG8_WAIT_L(n) asm volatile("s_waitcnt lgkmcnt(" #n ")" ::: "memory")
#define PG8_BAR __builtin_amdgcn_s_barrier()
#define PG8_SCHED __builtin_amdgcn_sched_barrier(0)
    Unit cur, nxt; int ui = 0;
    if (!S.next(0, cur)) return;
    f32x4 acc[2][2][4][2];
#pragma unroll
    for (int a = 0; a < 2; ++a)
#pragma unroll
        for (int b = 0; b < 2; ++b)
#pragma unroll
            for (int m = 0; m < 4; ++m)
#pragma unroll
                for (int n = 0; n < 2; ++n) acc[a][b][m][n] = (f32x4){0.f, 0.f, 0.f, 0.f};
    bf16x8 At[4][2], B0[2][2], B1[2][2];
    unsigned cA = GATHER ? 0u : (unsigned)cur.pm * tstepA, cB = (unsigned)cur.e * (unsigned)g.bstride + (unsigned)cur.pn * tstep;
    const __amdgpu_buffer_rsrc_t rsA = __builtin_amdgcn_make_buffer_rsrc((void*)g.A, 0, 0x7fffffff, 0x00020000), rsB = __builtin_amdgcn_make_buffer_rsrc((void*)g.Bt, 0, 0x7fffffff, 0x00020000);
    S.a_ready(cur);
    if constexpr (GATHER) PG8_GLOAD(gA, 0);
    if constexpr (SP2) {
        PG8_STAGE(rsB, PG8_SB(0, 0), cB, voffB); PG8_STAGE(rsB, PG8_SB(0, 1), cB + hstep, voffB); PG8_STAGE(rsA, PG8_SA(0, 0), cA, PG8_VA(0)); PG8_STAGE(rsA, PG8_SA(0, 1), cA + hsA, PG8_VA(1));
        if (wr == 1) PG8_BAR;
        PG8_WAIT_V(2); PG8_BAR;
        PG8_STAGE(rsB, PG8_SB(1, 0), cB + kstep, voffB); PG8_STAGE(rsA, PG8_SA(1, 0), cA + kstep, PG8_VA(0)); PG8_STAGE(rsB, PG8_SB(1, 1), cB + hstep + kstep, voffB);
        PG8_WAIT_V(6); PG8_BAR;
    } else {
        PG8_STAGE(rsB, PG8_SB(0, 0), cB, voffB); PG8_STAGE(rsA, PG8_SA(0, 0), cA, PG8_VA(0)); PG8_STAGE(rsB, PG8_SB(0, 1), cB + hstep, voffB); PG8_STAGE(rsA, PG8_SA(0, 1), cA + hsA, PG8_VA(1));
        if (wr == 1) PG8_BAR;
        PG8_WAIT_V(4); PG8_BAR;
        PG8_STAGE(rsB, PG8_SB(1, 0), cB + kstep, voffB); PG8_STAGE(rsA, PG8_SA(1, 0), cA + kstep, PG8_VA(0)); PG8_STAGE(rsB, PG8_SB(1, 1), cB + hstep + kstep, voffB);
        PG8_WAIT_V(6); PG8_BAR;
    }
    for (;;) {
        const bool has_next = S.next(ui + 1, nxt);
        if constexpr (GATHER) { if (has_next) PG8_GLOAD(ngA, ui + 1); else { ngA[0][0] = gA[0][0]; ngA[0][1] = gA[0][1]; ngA[1][0] = gA[1][0]; ngA[1][1] = gA[1][1]; } }
        const unsigned nA = (has_next && !GATHER) ? (unsigned)nxt.pm * tstepA : cA, nB = has_next ? (unsigned)nxt.e * (unsigned)g.bstride + (unsigned)nxt.pn * tstep : cB;
        for (int t = 0; t < nt; t += 2) {
            const bool last = (t == nt - 2);
            const unsigned a1 = cA + (unsigned)(t + 1) * kstep;
            const unsigned a2 = last ? nA : cA + (unsigned)(t + 2) * kstep, b2 = last ? nB : cB + (unsigned)(t + 2) * kstep;
            const unsigned a3 = a2 + kstep, b3 = b2 + kstep;
            if (last && has_next) S.a_ready(nxt);
            if constexpr (SP2) {
            PG8_LDB(B0, 0, 0); PG8_LDB(B1, 0, 1); PG8_SCHED; PG8_LDA(At, 0, 0); PG8_STAGE(rsA, PG8_SA(1, 1), a1 + hsA, PG8_VA(1));
            if constexpr (GATHER) { if (last) { gA[0][0] = ngA[0][0]; gA[0][1] = ngA[0][1]; gA[1][0] = ngA[1][0]; gA[1][1] = ngA[1][1]; } }
            PG8_WAIT_V(8); PG8_WAIT_L(0); PG8_BAR; PG8_MMA(0, 0, At, B0); PG8_MMA(0, 1, At, B1); PG8_BAR; PG8_SCHED;
            PG8_LDA(At, 0, 1); PG8_STAGE(rsB, PG8_SB(0, 0), b2, voffB); PG8_STAGE(rsB, PG8_SB(0, 1), b2 + hstep, voffB); PG8_STAGE(rsA, PG8_SA(0, 0), a2, PG8_VA(0));
            PG8_WAIT_V(8); PG8_WAIT_L(0); PG8_BAR; PG8_MMA(1, 0, At, B0); PG8_MMA(1, 1, At, B1); PG8_BAR; PG8_SCHED;
            PG8_LDB(B0, 1, 0); PG8_LDB(B1, 1, 1); PG8_SCHED; PG8_LDA(At, 1, 0); PG8_STAGE(rsA, PG8_SA(0, 1), a2 + hsA, PG8_VA(1));
            PG8_WAIT_V(8); PG8_WAIT_L(0); PG8_BAR; PG8_MMA(0, 0, At, B0); PG8_MMA(0, 1, At, B1); PG8_BAR; PG8_SCHED;
            PG8_LDA(At, 1, 1); PG8_STAGE(rsB, PG8_SB(1, 0), b3, voffB); PG8_STAGE(rsB, PG8_SB(1, 1), b3 + hstep, voffB); PG8_STAGE(rsA, PG8_SA(1, 0), a3, PG8_VA(0));
            PG8_WAIT_V(8); PG8_WAIT_L(0); PG8_BAR; PG8_MMA(1, 0, At, B0); PG8_MMA(1, 1, At, B1); PG8_BAR; PG8_SCHED;
            } else {
            PG8_LDB(B0, 0, 0); PG8_SCHED; PG8_LDA(At, 0, 0); PG8_STAGE(rsA, PG8_SA(1, 1), a1 + hsA, PG8_VA(1));
            PG8_WAIT_L(8); PG8_BAR; PG8_WAIT_L(0); PG8_MMA(0, 0, At, B0); PG8_BAR; PG8_SCHED;
            PG8_LDB(B1, 0, 1); PG8_STAGE(rsB, PG8_SB(0, 0), b2, voffB);
            PG8_BAR; PG8_WAIT_L(0); PG8_MMA(0, 1, At, B1); PG8_BAR;
            PG8_LDA(At, 0, 1); PG8_STAGE(rsA, PG8_SA(0, 0), a2, PG8_VA(0));
            PG8_BAR; PG8_WAIT_L(0); PG8_MMA(1, 0, At, B0); PG8_BAR; PG8_SCHED;
            PG8_STAGE(rsB, PG8_SB(0, 1), b2 + hstep, voffB);
            PG8_WAIT_V(6); PG8_BAR; PG8_MMA(1, 1, At, B1); PG8_BAR;
            PG8_LDB(B0, 1, 0); PG8_SCHED; PG8_LDA(At, 1, 0); PG8_STAGE(rsA, PG8_SA(0, 1), a2 + hsA, PG8_VA(1));
            PG8_WAIT_L(8); PG8_BAR; PG8_WAIT_L(0); PG8_MMA(0, 0, At, B0); PG8_BAR; PG8_SCHED;
            PG8_LDB(B1, 1, 1); PG8_STAGE(rsB, PG8_SB(1, 0), b3, voffB);
            PG8_BAR; PG8_WAIT_L(0); PG8_MMA(0, 1, At, B1); PG8_BAR;
            PG8_LDA(At, 1, 1); PG8_STAGE(rsA, PG8_SA(1, 0), a3, PG8_VA(0));
            PG8_BAR; PG8_WAIT_L(0); PG8_MMA(1, 0, At, B0); PG8_BAR; PG8_SCHED;
            PG8_STAGE(rsB, PG8_SB(1, 1), b3 + hstep, voffB);
            PG8_WAIT_V(6); PG8_BAR; PG8_MMA(1, 1, At, B1); PG8_BAR;
            }
        }
        if constexpr (ALIGN_EPI) { if (wr == 0) PG8_BAR; }
        if constexpr (FP8) mfma_fp8_drain();
        if constexpr (!Epi::AFTER_DRAIN) { E(acc, cur, wr, wc, fr, fq); S.done(cur); }
        if (!has_next) break;
#pragma unroll
        for (int a = 0; a < 2; ++a)
#pragma unroll
            for (int b = 0; b < 2; ++b)
#pragma unroll
                for (int m = 0; m < 4; ++m)
#pragma unroll
                    for (int n = 0; n < 2; ++n) acc[a][b][m][n] = (f32x4){0.f, 0.f, 0.f, 0.f};
        cur = nxt; cA = nA; cB = nB; ++ui;
        if constexpr (ALIGN_EPI) { if (wr == 1) PG8_BAR; }
    }
    PG8_WAIT_V(0);
    if constexpr (!ALIGN_EPI) { if (wr == 0) PG8_BAR; }
    PG8_BAR;
    if constexpr (Epi::AFTER_DRAIN) { E.fused(acc, cur, wr, wc, fr, fq, lds, wid, lane); S.done(cur); }
#undef PG8_SA
#undef PG8_GLOAD
#undef PG8_VA
#undef PG8_SB
#undef PG8_STAGE
#undef PG8_LDA
#undef PG8_LDB
#undef PG8_MMA
#undef PG8_WAIT_V
#undef PG8_WAIT_L
#undef PG8_BAR
#undef PG8_SCHED
}
}

#define GAS __attribute__((address_space(1)))
#define LAS __attribute__((address_space(3)))
#define XB_TMO      128
#define XB_XCNT(j)  (256  + 64 * (j))
#define XB_XSUB(j)  (1280 + 64 * (j))
#define XB_XGEN(j)  (2304 + 64 * (j))
#define XB_TOP      3328
#define XB_TOPGEN   3392
#define XCD_BAR_WORDS 3456
#define XB_SPIN_CAP (1u << 18)

__device__ __forceinline__ unsigned xb_ld(unsigned* p)              { return __hip_atomic_load(p, __ATOMIC_RELAXED, __HIP_MEMORY_SCOPE_AGENT); }
__device__ __forceinline__ unsigned xb_add(unsigned* p, unsigned v) { return __hip_atomic_fetch_add(p, v, __ATOMIC_RELAXED, __HIP_MEMORY_SCOPE_AGENT); }
__device__ __forceinline__ unsigned xb_xcc_id() { return (unsigned)__builtin_amdgcn_s_getreg((3 << 11) | 20) & 0xFu; }
#define XB_SPIN(cond, bar) do { unsigned _sp = 0; while (cond) { __builtin_amdgcn_s_sleep(1); \
    if ((++_sp & 255u) == 0u) { if (xb_ld(&(bar)[XB_TMO])) break; if (_sp > XB_SPIN_CAP) { atomicAdd(&(bar)[XB_TMO], 1u); break; } } } } while (0)

struct XcdBarrier {
    unsigned* bar; unsigned x;
    volatile LAS unsigned* st;
};

__device__ __forceinline__ XcdBarrier xcd_barrier_post(unsigned* bar, volatile LAS unsigned* st) {
    XcdBarrier b; b.bar = bar; b.x = xb_xcc_id(); b.st = st;
    if (threadIdx.x == 0) (void)xb_add(&bar[XB_XCNT(b.x)], 1u);
    return b;
}
__device__ __forceinline__ void xcd_barrier_complete(unsigned* bar, unsigned x, unsigned& nloc, unsigned& nx) {
    const unsigned G = gridDim.x * gridDim.y * gridDim.z;
    unsigned sum, cnt, mine, sp = 0u;
    for (;;) {
        sum = 0u; cnt = 0u; mine = 0u;
#pragma unroll
        for (unsigned j = 0; j < 16; ++j) { const unsigned c = xb_ld(&bar[XB_XCNT(j)]); sum += c; cnt += (c > 0u) ? 1u : 0u; mine = (j == x) ? c : mine; }
        if (sum == G) break;
        __builtin_amdgcn_s_sleep(1);
        if ((++sp & 255u) == 0u) { if (xb_ld(&bar[XB_TMO])) break; if (sp > XB_SPIN_CAP) { atomicAdd(&bar[XB_TMO], 1u); break; } }
    }
    nloc = mine > 0u ? mine : 1u; nx = cnt > 0u ? cnt : 1u;
}

__device__ __forceinline__ void xcd_barrier(const XcdBarrier& b) {
    asm volatile("s_waitcnt vmcnt(0)" ::: "memory");
    __syncthreads();
    if (threadIdx.x == 0) {
        unsigned* bar = b.bar;
        __builtin_amdgcn_s_waitcnt(0);
        unsigned nloc = b.st[0], nx = b.st[1];
        if (nloc == 0u) { xcd_barrier_complete(bar, b.x, nloc, nx); b.st[0] = nloc; b.st[1] = nx; }
        const unsigned old = xb_add(&bar[XB_XSUB(b.x)], 1u);
        const unsigned gen = old / nloc;
        if (old + 1u == (gen + 1u) * nloc) {
            __builtin_amdgcn_fence(__ATOMIC_RELEASE, "agent");
            asm volatile("s_waitcnt vmcnt(0)" ::: "memory");
            const unsigned og = xb_add(&bar[XB_TOP], 1u);
            const unsigned tg = og / nx;
            if (og + 1u == (tg + 1u) * nx) xb_add(&bar[XB_TOPGEN], 1u);
            else XB_SPIN(xb_ld(&bar[XB_TOPGEN]) == tg, bar);
            __builtin_amdgcn_fence(__ATOMIC_ACQUIRE, "agent");
            xb_add(&bar[XB_XGEN(b.x)], 1u);
            asm volatile("s_waitcnt vmcnt(0)" ::: "memory");
        } else {
            XB_SPIN(xb_ld(&bar[XB_XGEN(b.x)]) == gen, bar);
            __builtin_amdgcn_fence(__ATOMIC_ACQUIRE, "agent");
            asm volatile("s_waitcnt vmcnt(0)" ::: "memory");
        }
    }
    __syncthreads();
}

template <int MODE  >
__device__ __forceinline__ void transpose_item(const float* __restrict__ W, int K, int N, bf16_t* __restrict__ WT, const float* __restrict__ gain, float* scr, int item, int lane) {
    const int nblk = N / 32, kb = item / nblk, nb = item % nblk, k0 = 64 * kb, n0 = 32 * nb;
#pragma unroll
    for (int i = 0; i < 8; ++i) { const int kk = 8 * i + (lane >> 3), n4 = (lane & 7) * 4; f32x4 v = *(const f32x4*)(W + (size_t)(k0 + kk) * N + n0 + n4);
        if (gain) { const float g = gain[k0 + kk]; v = v * g; }
        float* s = scr + kk * 33 + n4; s[0] = v[0]; s[1] = v[1]; s[2] = v[2]; s[3] = v[3]; }
    asm volatile("s_waitcnt lgkmcnt(0)" ::: "memory");
    const int c = lane & 7;
#pragma unroll
    for (int j = 0; j < 4; ++j) { const int n = (lane >> 3) + 8 * j; const float* s = scr + (8 * c) * 33 + n;
        u32x4 o; o.x = pk2(s[0 * 33], s[1 * 33]); o.y = pk2(s[2 * 33], s[3 * 33]); o.z = pk2(s[4 * 33], s[5 * 33]); o.w = pk2(s[6 * 33], s[7 * 33]);
        int row = n0 + n;
        if (MODE == 1) { const int f = row & 1023; row = ((f >> 7) << 8) + ((row >> 10) << 7) + (f & 127); }
        *(u32x4*)(WT + (size_t)row * K + k0 + 8 * c) = o; }
    asm volatile("s_waitcnt lgkmcnt(0)" ::: "memory");
}
template <int MODE>
__device__ __forceinline__ void transpose_item_fp8(const float* __restrict__ W, int K, int N, unsigned char* __restrict__ WT, float* scr, int item, int lane) {
    const int nblk = N / 32, kb = item / nblk, nb = item % nblk, k0 = 64 * kb, n0 = 32 * nb;
#pragma unroll
    for (int i = 0; i < 8; ++i) { const int kk = 8 * i + (lane >> 3), n4 = (lane & 7) * 4; const f32x4 v = *(const f32x4*)(W + (size_t)(k0 + kk) * N + n0 + n4) * W8_SCALE;
        float* s = scr + kk * 33 + n4; s[0] = v[0]; s[1] = v[1]; s[2] = v[2]; s[3] = v[3]; }
    asm volatile("s_waitcnt lgkmcnt(0)" ::: "memory");
    const int c = lane & 7;
#pragma unroll
    for (int j = 0; j < 4; ++j) { const int n = (lane >> 3) + 8 * j; const float* s = scr + (8 * c) * 33 + n;
        u32x2 o; o.x = pk4_fp8(s[0 * 33], s[1 * 33], s[2 * 33], s[3 * 33]); o.y = pk4_fp8(s[4 * 33], s[5 * 33], s[6 * 33], s[7 * 33]);
        int row = n0 + n;
        if (MODE == 1) { const int f = row & 1023; row = ((f >> 7) << 8) + ((row >> 10) << 7) + (f & 127); }
        *(u32x2*)(WT + (size_t)row * K + k0 + 8 * c) = o; }
    asm volatile("s_waitcnt lgkmcnt(0)" ::: "memory");
}
__device__ __forceinline__ void phase_prologue(const Params& p, unsigned char* lds) {
    const int tid = threadIdx.x, lane = tid & 63, wave = tid >> 6;
    float* scr = (float*)(lds + wave * 16384);
    const int gw = blockIdx.x * NWAVES + wave, NGW = gridDim.x * NWAVES;
    unsigned char* ws = p.ws;
    constexpr int I_WIN = (DM / 64) * (INC / 32), I_UQ = (QLORA / 64) * (768 / 32), I_UKV = (KVLORA / 64) * (1024 / 32), I_OM = (512 / 64) * (DM / 32), I_OC = I_OM, I_WO = (DM / 64) * (DM / 32);
    constexpr int I_W1 = (DM / 64) * (2048 / 32), I_W2 = (DFF / 64) * (DM / 32);
    constexpr int NSMALL = I_WIN + I_UQ + I_UKV + I_OM + I_OC + I_WO;
    constexpr int NITEMS = NSMALL + NE * (I_W1 + I_W2);
    for (int it = gw; it < NITEMS; it += NGW) {
        int r = it;
        if (r < I_WIN) { transpose_item<0>(p.w_in, DM, INC, (bf16_t*)(ws + WS_WIN), p.norm1_g, scr, r, lane); continue; } r -= I_WIN;
        if (r < I_UQ) { transpose_item<0>(p.w_uq, QLORA, 768, (bf16_t*)(ws + WS_WUQ), p.q_a_g, scr, r, lane); continue; } r -= I_UQ;
        if (r < I_UKV) { transpose_item<0>(p.w_ukv, KVLORA, 1024, (bf16_t*)(ws + WS_WUKV), p.kv_a_g, scr, r, lane); continue; } r -= I_UKV;
        if (r < I_OM) { transpose_item<0>(p.w_o_mla, 512, DM, (bf16_t*)(ws + WS_WOMLA), nullptr, scr, r, lane); continue; } r -= I_OM;
        if (r < I_OC) { transpose_item<0>(p.w_o_conv, 512, DM, (bf16_t*)(ws + WS_WOCONV), nullptr, scr, r, lane); continue; } r -= I_OC;
        if (r < I_WO) { transpose_item<0>(p.w_o, DM, DM, (bf16_t*)(ws + WS_WO), nullptr, scr, r, lane); continue; } r -= I_WO;
        const int e = r / (I_W1 + I_W2); r -= e * (I_W1 + I_W2);
        if (r < I_W1) transpose_item_fp8<1>(p.w1 + (size_t)e * DM * 2048, DM, 2048, ws + WS_W1 + (size_t)e * 2048 * DM, scr, r, lane);
        else transpose_item_fp8<0>(p.w2 + (size_t)e * DFF * DM, DFF, DM, ws + WS_W2 + (size_t)e * DM * DFF, scr, r - I_W1, lane);
    }
    { u32x4* z = (u32x4*)((bf16_t*)(ws + WS_WIN) + (size_t)INC * DM); const int nz = (INCP - INC) * DM * 2 / 16;
      for (int i = blockIdx.x * NTHREADS + tid; i < nz; i += gridDim.x * NTHREADS) z[i] = (u32x4){0u, 0u, 0u, 0u}; }
    { int* rt = (int*)(ws + WS_RT2); int* rs = (int*)(ws + WS_RT2 + 4 * MiB); float* rr = (float*)(ws + WS_RT2 + 6 * MiB);
      for (int i = blockIdx.x * NTHREADS + tid; i < NE * CAP; i += gridDim.x * NTHREADS) { rt[i] = 0; rs[i] = -1; rr[i] = 0.f; } }
    { u32x4* GF = (u32x4*)(ws + WS_GF);
      for (int i = blockIdx.x * NTHREADS + tid; i < 64 * 64; i += gridDim.x * NTHREADS) { const int ks = i >> 6, ln = i & 63, r = ln & 31, h = ln >> 5; float v[8], lo[8]; unsigned hi[4];
#pragma unroll
          for (int j = 0; j < 8; ++j) { const int k = 16 * ks + 8 * h + j; v[j] = p.norm2_g[k] * p.router_w[(size_t)k * NE + r]; }
#pragma unroll
          for (int j = 0; j < 4; ++j) { hi[j] = pk2(v[2 * j], v[2 * j + 1]); lo[2 * j] = v[2 * j] - bf_lo(hi[j]); lo[2 * j + 1] = v[2 * j + 1] - bf_hi(hi[j]); }
          GF[(ks * 2 + 0) * 64 + ln] = (u32x4){hi[0], hi[1], hi[2], hi[3]}; GF[(ks * 2 + 1) * 64 + ln] = (u32x4){pk2(lo[0], lo[1]), pk2(lo[2], lo[3]), pk2(lo[4], lo[5]), pk2(lo[6], lo[7])}; } }
    bf16_t* XN = (bf16_t*)(ws + WS_XN);
    for (int m = gw; m < NTOK; m += NGW) {
        const f32x4* xr = (const f32x4*)(p.x + (size_t)m * DM) + lane; f32x4 v[4]; float s = 0.f;
#pragma unroll
        for (int j = 0; j < 4; ++j) { v[j] = xr[64 * j]; s += (v[j][0] * v[j][0] + v[j][1] * v[j][1]) + (v[j][2] * v[j][2] + v[j][3] * v[j][3]); }
        const float rstd = rsqrtf(wave_sum(s) * (1.f / DM) + EPS);
        u32x2* o = (u32x2*)(XN + (size_t)m * DM) + lane;
#pragma unroll
        for (int j = 0; j < 4; ++j) { u32x2 w; w.x = pk2(v[j][0] * rstd, v[j][1] * rstd); w.y = pk2(v[j][2] * rstd, v[j][3] * rstd); o[64 * j] = w; }
    }
}

constexpr float QSCALE = 0.10206207261596575f * 1.4426950408889634f;
__device__ __forceinline__ void phase_tok_b(const Params& p) {
    const int tid = threadIdx.x, lane = tid & 63, wave = tid >> 6, h = lane >> 3, sub = lane & 7;
    const int gw = blockIdx.x * NWAVES + wave, NGW = gridDim.x * NWAVES;
    const bf16_t* QPRE = (const bf16_t*)(p.ws + WS_QPRE); const bf16_t* KVPRE = (const bf16_t*)(p.ws + WS_KVPRE); const bf16_t* PROJ = (const bf16_t*)(p.ws + WS_PROJ);
    bf16_t* Q = (bf16_t*)(p.ws + WS_Q); bf16_t* Kb = (bf16_t*)(p.ws + WS_K); bf16_t* V = (bf16_t*)(p.ws + WS_V); bf16_t* YB = (bf16_t*)(p.ws + WS_YBIN);
    float qg[12], kg[12];
#pragma unroll
    for (int j = 0; j < 8; ++j) { qg[j] = p.q_g[sub * 8 + j]; kg[j] = p.k_g[sub * 8 + j]; }
    qg[8] = p.q_g[64 + 2 * sub]; qg[9] = p.q_g[65 + 2 * sub]; qg[10] = p.q_g[80 + 2 * sub]; qg[11] = p.q_g[81 + 2 * sub];
    kg[8] = p.k_g[64 + 2 * sub]; kg[9] = p.k_g[65 + 2 * sub]; kg[10] = p.k_g[80 + 2 * sub]; kg[11] = p.k_g[81 + 2 * sub];
    const float if0 = exp2f(-(float)(2 * sub) * (13.287712379549449f / 16.f)), if1 = exp2f(-(float)(2 * sub + 1) * (13.287712379549449f / 16.f));
    float cw0[8], cw1[8], cw2[8];
#pragma unroll
    for (int j = 0; j < 8; ++j) { cw0[j] = p.conv_w[8 * lane + j]; cw1[j] = p.conv_w[CONVW + 8 * lane + j]; cw2[j] = p.conv_w[2 * CONVW + 8 * lane + j]; }
    for (int t = gw; t < NTOK; t += NGW) {
        const int b = t >> 13, s = t & (SEQ - 1); const float pos = (float)p.pos[t];
        const bf16_t* pr = PROJ + (size_t)t * INCP;
        float rs_q, rs_kv;
        { const u32x2 w = *(const u32x2*)(pr + OFF_CQ + 4 * lane); const float a = bf_lo(w.x), bq = bf_hi(w.x), c = bf_lo(w.y), d = bf_hi(w.y); rs_q = rsqrtf(wave_sum(a * a + bq * bq + c * c + d * d) * (1.f / QLORA) + EPS); }
        { const unsigned w = *(const unsigned*)(pr + OFF_CKV + 2 * lane); const float a = bf_lo(w), bq = bf_hi(w); rs_kv = rsqrtf(wave_sum(a * a + bq * bq) * (1.f / KVLORA) + EPS); }
        { float cu[3][8];
#pragma unroll
          for (int d = 0; d < 3; ++d) { const int ss = s + d - 1; if (ss >= 0 && ss < SEQ) { const bf16_t* q = pr + (ptrdiff_t)(d - 1) * INCP; const u32x4 u = *(const u32x4*)(q + OFF_U + 8 * lane), c = *(const u32x4*)(q + OFF_C + 8 * lane);
                  cu[d][0] = bf_lo(u.x) * bf_lo(c.x); cu[d][1] = bf_hi(u.x) * bf_hi(c.x); cu[d][2] = bf_lo(u.y) * bf_lo(c.y); cu[d][3] = bf_hi(u.y) * bf_hi(c.y);
                  cu[d][4] = bf_lo(u.z) * bf_lo(c.z); cu[d][5] = bf_hi(u.z) * bf_hi(c.z); cu[d][6] = bf_lo(u.w) * bf_lo(c.w); cu[d][7] = bf_hi(u.w) * bf_hi(c.w); }
              else {
#pragma unroll
                  for (int j = 0; j < 8; ++j) cu[d][j] = 0.f; } }
          const u32x4 bg = *(const u32x4*)(pr + OFF_B + 8 * lane); float bb[8] = {bf_lo(bg.x), bf_hi(bg.x), bf_lo(bg.y), bf_hi(bg.y), bf_lo(bg.z), bf_hi(bg.z), bf_lo(bg.w), bf_hi(bg.w)}; float y[8];
#pragma unroll
          for (int j = 0; j < 8; ++j) y[j] = bb[j] * (cw0[j] * cu[0][j] + cw1[j] * cu[1][j] + cw2[j] * cu[2][j]);
          u32x4 o; o.x = pk2(y[0], y[1]); o.y = pk2(y[2], y[3]); o.z = pk2(y[4], y[5]); o.w = pk2(y[6], y[7]); *(u32x4*)(YB + (size_t)t * CONVW + 8 * lane) = o; }
        float c0, s0, c1, s1; sincosf(pos * if0, &s0, &c0); sincosf(pos * if1, &s1, &c1);
        const size_t rowi = ((size_t)(b * NH + h) * SEQ + s);
        { const bf16_t* qp = QPRE + (size_t)t * 768 + h * DQK; const u32x4 a = *(const u32x4*)(qp + sub * 8); const unsigned r1 = *(const unsigned*)(qp + 64 + 2 * sub), r2 = *(const unsigned*)(qp + 80 + 2 * sub);
          float v[12] = {bf_lo(a.x), bf_hi(a.x), bf_lo(a.y), bf_hi(a.y), bf_lo(a.z), bf_hi(a.z), bf_lo(a.w), bf_hi(a.w), bf_lo(r1), bf_hi(r1), bf_lo(r2), bf_hi(r2)}; float ss = 0.f;
#pragma unroll
          for (int j = 0; j < 12; ++j) { v[j] *= rs_q; ss += v[j] * v[j]; }
          ss += __shfl_xor(ss, 1); ss += __shfl_xor(ss, 2); ss += __shfl_xor(ss, 4);
          const float rstd = rsqrtf(ss * (1.f / DQK) + EPS);
#pragma unroll
          for (int j = 0; j < 12; ++j) v[j] *= rstd * qg[j] * QSCALE;
          const float o8 = v[8] * c0 - v[10] * s0, o9 = v[9] * c1 - v[11] * s1, o10 = v[8] * s0 + v[10] * c0, o11 = v[9] * s1 + v[11] * c1;
          bf16_t* qo = Q + rowi * DQK; u32x4 w; w.x = pk2(v[0], v[1]); w.y = pk2(v[2], v[3]); w.z = pk2(v[4], v[5]); w.w = pk2(v[6], v[7]);
          *(u32x4*)(qo + sub * 8) = w; *(unsigned*)(qo + 64 + 2 * sub) = pk2(o8, o9); *(unsigned*)(qo + 80 + 2 * sub) = pk2(o10, o11); }
        { const bf16_t* kp = KVPRE + (size_t)t * 1024 + h * 128; const u32x4 a = *(const u32x4*)(kp + sub * 8);
          const bf16_t* kr = pr + OFF_KR; const unsigned w1 = *(const unsigned*)(kr + 2 * sub), w2 = *(const unsigned*)(kr + 16 + 2 * sub);
          float v[12] = {bf_lo(a.x) * rs_kv, bf_hi(a.x) * rs_kv, bf_lo(a.y) * rs_kv, bf_hi(a.y) * rs_kv, bf_lo(a.z) * rs_kv, bf_hi(a.z) * rs_kv, bf_lo(a.w) * rs_kv, bf_hi(a.w) * rs_kv, bf_lo(w1), bf_hi(w1), bf_lo(w2), bf_hi(w2)}; float ss = 0.f;
#pragma unroll
          for (int j = 0; j < 12; ++j) ss += v[j] * v[j];
          ss += __shfl_xor(ss, 1); ss += __shfl_xor(ss, 2); ss += __shfl_xor(ss, 4);
          const float rstd = rsqrtf(ss * (1.f / DQK) + EPS);
#pragma unroll
          for (int j = 0; j < 12; ++j) v[j] *= rstd * kg[j];
          const float o8 = v[8] * c0 - v[10] * s0, o9 = v[9] * c1 - v[11] * s1, o10 = v[8] * s0 + v[10] * c0, o11 = v[9] * s1 + v[11] * c1;
          bf16_t* ko = Kb + rowi * 128; u32x4 w; w.x = pk2(v[0], v[1]); w.y = pk2(v[2], v[3]); w.z = pk2(v[4], v[5]); w.w = pk2(v[6], v[7]);
          *(u32x4*)(ko + sub * 8) = w; *(unsigned*)(ko + 64 + 2 * sub) = pk2(o8, o9); *(unsigned*)(ko + 80 + 2 * sub) = pk2(o10, o11);
          if (sub < 4) *(u32x4*)(ko + 96 + sub * 8) = (u32x4){0u, 0u, 0u, 0u};
          const u32x4 va = *(const u32x4*)(kp + 64 + sub * 8);
          u32x4 wv; wv.x = pk2(bf_lo(va.x) * rs_kv, bf_hi(va.x) * rs_kv); wv.y = pk2(bf_lo(va.y) * rs_kv, bf_hi(va.y) * rs_kv); wv.z = pk2(bf_lo(va.z) * rs_kv, bf_hi(va.z) * rs_kv); wv.w = pk2(bf_lo(va.w) * rs_kv, bf_hi(va.w) * rs_kv);
          *(u32x4*)(V + rowi * DV + sub * 8) = wv; }
    }
}

namespace att {
constexpr int NW = 8, QBLK = 32, KVBLK = 64;
constexpr float SCALE = 0.10206207261596575f;
constexpr float QSC = SCALE * 1.4426950408889634f;
constexpr int LDQ = DQK, LDK = 128, LDV = DV;
constexpr int SHM_V = KVBLK * DV * 2, SHM_K = KVBLK * 256, SHM_ATTN = 2 * SHM_V + 2 * SHM_K + NW * 64 * 4;
#define KSWZ(row, colB) ((row) * 256 + ((colB) ^ (((row) & 7) << 4)))
#define SBAR() __builtin_amdgcn_sched_barrier(0)
__device__ __forceinline__ int crow(int r, int hi) { return (r & 3) + 8 * (r >> 2) + 4 * hi; }
__device__ __forceinline__ unsigned cvtpk(float lo, float hi) { unsigned r; asm volatile("v_cvt_pk_bf16_f32 %0, %1, %2" : "=v"(r) : "v"(lo), "v"(hi)); return r; }
#define EXPH(P) do { _Pragma("unroll") for (int r = 0; r < 16; ++r) P[r] = __builtin_amdgcn_exp2f(P[r]); } while (0)
__device__ __forceinline__ void finishSM(f32x16& p0, f32x16& p1, float& l_reg, bf16x8& pa0, bf16x8& pa1, bf16x8& pa2, bf16x8& pa3) {
    EXPH(p1);
    float ps0 = 0.f, ps1 = 0.f;
#pragma unroll
    for (int r = 0; r < 16; ++r) { ps0 += p0[r]; ps1 += p1[r]; }
    l_reg += ps0 + ps1;
#define PK4(P, BASE, OUT) do { unsigned a0 = cvtpk(P[BASE + 0], P[BASE + 1]), a1 = cvtpk(P[BASE + 2], P[BASE + 3]);   \
    unsigned b0 = cvtpk(P[BASE + 4], P[BASE + 5]), b1 = cvtpk(P[BASE + 6], P[BASE + 7]);                              \
    auto r0 = __builtin_amdgcn_permlane32_swap(a0, b0, false, false); auto r1 = __builtin_amdgcn_permlane32_swap(a1, b1, false, false); \
    u32x4 w = {r0[0], r1[0], r0[1], r1[1]}; OUT = *reinterpret_cast<bf16x8*>(&w); } while (0)
    PK4(p0, 0, pa0); PK4(p0, 8, pa1); PK4(p1, 0, pa2); PK4(p1, 8, pa3);
#undef PK4
}
__device__ __forceinline__ void qkt(f32x16& p0, f32x16& p1, const unsigned char* Ks, const bf16x8* qr, int r32, int hi) {
    p0 = f32x16{}; p1 = f32x16{};
#pragma unroll
    for (int d0 = 0; d0 < 6; ++d0) { const int cb = (d0 * 16 + hi * 8) * 2;
        const bf16x8 b0 = *reinterpret_cast<const bf16x8*>(Ks + KSWZ(r32, cb));
        const bf16x8 b1 = *reinterpret_cast<const bf16x8*>(Ks + KSWZ(32 + r32, cb));
        p0 = __builtin_amdgcn_mfma_f32_32x32x16_bf16(b0, qr[d0], p0, 0, 0, 0);
        p1 = __builtin_amdgcn_mfma_f32_32x32x16_bf16(b1, qr[d0], p1, 0, 0, 0); }
}
__device__ __forceinline__ int v_st(int k, int c) { const int kk = (k & ~0xC) | ((k & 4) << 1) | ((k & 8) >> 1); return ((kk >> 3) * 2 + (c >> 5)) * 512 + ((kk & 7) * 32 + (c & 31)) * 2; }
__device__ __forceinline__ int v_rd_base(int lane) { return ((lane & 3) << 3) | (((lane >> 2) & 3) << 6) | (((lane >> 4) & 1) << 5) | (((lane >> 5) & 1) << 8); }
constexpr int v_rd_off(int d0, int ks, int half) { return d0 * 512 + ks * 2048 + half * 1024; }
template <int OFF> __device__ __forceinline__ s16x4 tr_read(int vb) { s16x4 r; asm volatile("ds_read_b64_tr_b16 %0, %1 offset:%2" : "=&v"(r) : "v"(vb), "i"(OFF) : "memory"); return r; }
template <int D0> __device__ __forceinline__ void pv_one(f32x16& od, int vb, bf16x8 pa0, bf16x8 pa1, bf16x8 pa2, bf16x8 pa3) {
    const s16x4 l0 = tr_read<v_rd_off(D0, 0, 0)>(vb), h0 = tr_read<v_rd_off(D0, 0, 1)>(vb), l1 = tr_read<v_rd_off(D0, 1, 0)>(vb), h1 = tr_read<v_rd_off(D0, 1, 1)>(vb);
    const s16x4 l2 = tr_read<v_rd_off(D0, 2, 0)>(vb), h2 = tr_read<v_rd_off(D0, 2, 1)>(vb), l3 = tr_read<v_rd_off(D0, 3, 0)>(vb), h3 = tr_read<v_rd_off(D0, 3, 1)>(vb);
    asm volatile("s_waitcnt lgkmcnt(0)" ::: "memory"); SBAR();
#define PK(L, H) (bf16x8){L[0], L[1], L[2], L[3], H[0], H[1], H[2], H[3]}
    __builtin_amdgcn_s_setprio(1);
    od = __builtin_amdgcn_mfma_f32_32x32x16_bf16(pa0, PK(l0, h0), od, 0, 0, 0);
    od = __builtin_amdgcn_mfma_f32_32x32x16_bf16(pa1, PK(l1, h1), od, 0, 0, 0);
    od = __builtin_amdgcn_mfma_f32_32x32x16_bf16(pa2, PK(l2, h2), od, 0, 0, 0);
    od = __builtin_amdgcn_mfma_f32_32x32x16_bf16(pa3, PK(l3, h3), od, 0, 0, 0);
    __builtin_amdgcn_s_setprio(0);
#undef PK
}
__device__ __forceinline__ void pv_d0(f32x16* o, int vb, bf16x8 pa0, bf16x8 pa1, bf16x8 pa2, bf16x8 pa3) { pv_one<0>(o[0], vb, pa0, pa1, pa2, pa3); pv_one<1>(o[1], vb, pa0, pa1, pa2, pa3); }

__device__ __forceinline__ void attn_unit(const bf16_t* __restrict__ Qb, const bf16_t* __restrict__ Kh, const bf16_t* __restrict__ Vh, bf16_t* __restrict__ Ob, int seq, unsigned char* lds) {
    const int tid = threadIdx.x, wid = __builtin_amdgcn_readfirstlane(tid >> 6), lane = tid & 63, r32 = lane & 31, hi = lane >> 5;
    unsigned char* V_lds = lds; unsigned char* K_lds = lds + 2 * SHM_V;
    float* wsf = (float*)(lds + 2 * SHM_V + 2 * SHM_K) + wid * 64; float* li_l = wsf;
    float l_reg = 0; f32x16 o[2] = {}; bf16x8 qr[6];
    const bf16_t* Qw = Qb + (size_t)(wid * QBLK + r32) * LDQ + hi * 8;
#pragma unroll
    for (int d0 = 0; d0 < 6; ++d0) qr[d0] = *reinterpret_cast<const bf16x8*>(Qw + d0 * 16);
    const int kr0 = 8 * wid + (lane >> 4), kcp = lane & 15;
    const bf16_t* ksrc0 = Kh + (size_t)kr0 * LDK + ((kcp ^ (kr0 & 7)) * 8);
    const bf16_t* ksrc1 = Kh + (size_t)(kr0 + 4) * LDK + ((kcp ^ ((kr0 + 4) & 7)) * 8);
    const int vkk = 8 * wid + ((lane >> 2) & 7), vk = (vkk & ~0xC) | ((vkk & 4) << 1) | ((vkk & 8) >> 1), vcc = 32 * (lane >> 5) + 8 * (lane & 3);
    const bf16_t* vsrc = Vh + (size_t)vk * LDV + vcc;
    typedef __attribute__((address_space(3))) unsigned* lds_u32p;
#define DMA_K(t, slot) do { __builtin_amdgcn_global_load_lds((const unsigned*)(ksrc0 + (size_t)(t) * KVBLK * LDK), (lds_u32p)(K_lds + (slot) * SHM_K + wid * 2048 + lane * 16), 16, 0, 0); \
                            __builtin_amdgcn_global_load_lds((const unsigned*)(ksrc1 + (size_t)(t) * KVBLK * LDK), (lds_u32p)(K_lds + (slot) * SHM_K + wid * 2048 + 1024 + lane * 16), 16, 0, 0); } while (0)
#define DMA_V(t, slot) __builtin_amdgcn_global_load_lds((const unsigned*)(vsrc + (size_t)(t) * KVBLK * LDV), (lds_u32p)(V_lds + (slot) * SHM_V + wid * 1024 + lane * 16), 16, 0, 0)
    const int vb0 = (int)(uintptr_t)V_lds + v_rd_base(lane);
    f32x16 pA0, pA1, pB0, pB1; bf16x8 pa0, pa1, pa2, pa3; const int NT = seq / KVBLK;
    DMA_K(0, 0); DMA_V(0, 0); DMA_K(1, 1);
    asm volatile("s_waitcnt vmcnt(0)" ::: "memory"); __syncthreads();
    qkt(pA0, pA1, K_lds, qr, r32, hi); EXPH(pA0); SBAR();
    __syncthreads();
    for (int j = 0; j + 2 < NT; j += 2) {
        DMA_K(j + 2, 0); DMA_V(j + 1, 1); SBAR();
        qkt(pB0, pB1, K_lds + SHM_K, qr, r32, hi);
        finishSM(pA0, pA1, l_reg, pa0, pa1, pa2, pa3); SBAR();
        pv_d0(o, vb0, pa0, pa1, pa2, pa3); EXPH(pB0); SBAR();
        asm volatile("s_waitcnt vmcnt(0)" ::: "memory"); __syncthreads();
        DMA_K(j + 3, 1); DMA_V(j + 2, 0); SBAR();
        qkt(pA0, pA1, K_lds, qr, r32, hi);
        finishSM(pB0, pB1, l_reg, pa0, pa1, pa2, pa3); SBAR();
        pv_d0(o, vb0 + SHM_V, pa0, pa1, pa2, pa3); EXPH(pA0); SBAR();
        asm volatile("s_waitcnt vmcnt(0)" ::: "memory"); __syncthreads();
    }
    DMA_V(NT - 1, 1); SBAR();
    qkt(pB0, pB1, K_lds + SHM_K, qr, r32, hi);
    finishSM(pA0, pA1, l_reg, pa0, pa1, pa2, pa3); SBAR();
    pv_d0(o, vb0, pa0, pa1, pa2, pa3); EXPH(pB0); SBAR();
    asm volatile("s_waitcnt vmcnt(0)" ::: "memory"); __syncthreads();
    finishSM(pB0, pB1, l_reg, pa0, pa1, pa2, pa3); SBAR();
    pv_d0(o, vb0 + SHM_V, pa0, pa1, pa2, pa3);
    { auto rr = __builtin_amdgcn_permlane32_swap(__float_as_uint(l_reg), __float_as_uint(l_reg), false, false); l_reg = __uint_as_float(rr[0]) + __uint_as_float(rr[1]); }
    if (hi == 0) li_l[r32] = l_reg; asm volatile("s_waitcnt lgkmcnt(0)" ::: "memory");
    float rli[16];
#pragma unroll
    for (int r = 0; r < 16; ++r) rli[r] = __builtin_amdgcn_rcpf(li_l[crow(r, hi)]);
    bf16_t* Ow = Ob + (size_t)(wid * QBLK) * 512;
#pragma unroll
    for (int r = 0; r < 16; ++r) { const int orow = crow(r, hi);
#pragma unroll
        for (int d0 = 0; d0 < 2; ++d0) Ow[(size_t)orow * 512 + d0 * 32 + r32] = (bf16_t)(pk2(o[d0][r] * rli[r], 0.f) & 0xffffu); }
    __syncthreads();
#undef DMA_K
#undef DMA_V
}
#undef KSWZ
#undef SBAR
}

__device__ __forceinline__ void phase_attn(const Params& p, unsigned char* lds) {
    const bf16_t* Q = (const bf16_t*)(p.ws + WS_Q); const bf16_t* Kb = (const bf16_t*)(p.ws + WS_K); const bf16_t* V = (const bf16_t*)(p.ws + WS_V); bf16_t* AO = (bf16_t*)(p.ws + WS_AO);
    constexpr int NQB = SEQ / 256, NU = 2 * NH * NQB;
    for (int u = blockIdx.x; u < NU; u += gridDim.x) {
        const int qb = u % NQB, h = (u / NQB) % NH, b = u / (NQB * NH); const size_t bh = (size_t)(b * NH + h) * SEQ;
        att::attn_unit(Q + (bh + (size_t)qb * 256) * DQK, Kb + bh * 128, V + bh * DV, AO + ((size_t)b * SEQ + (size_t)qb * 256) * 512 + h * DV, SEQ, lds);
    }
}

__device__ __forceinline__ int crow16(int r, int hi) { return (r & 3) + 8 * (r >> 2) + 4 * hi; }
__device__ __forceinline__ void phase_router(const Params& p, unsigned char* lds) {
    const int tid = threadIdx.x, lane = tid & 63, wid = tid >> 6, tile = wid >> 2, kq = wid & 3, c = lane & 31, h = lane >> 5;
    float* red = (float*)lds;
    float* ssb = red + 2 * 4 * 16 * 64;
    int* lcnt = (int*)(ssb + 2 * 4 * 64);
    int* lbase = lcnt + 32;
    unsigned* gcnt = (unsigned*)(p.ws + WS_CTL) + CW_CNT;
    int* row_tok = (int*)(p.ws + WS_RT2); float* row_w = (float*)(p.ws + WS_RT2 + 2 * MiB); int* row_slot = (int*)(p.ws + WS_RT2 + 4 * MiB); float* row_rstd = (float*)(p.ws + WS_RT2 + 6 * MiB);
    const u32x4* GF = (const u32x4*)(p.ws + WS_GF);
    for (int tg = blockIdx.x; tg < NTOK / 64; tg += gridDim.x) {
        if (tid < 32) lcnt[tid] = 0;
        const int token = tg * 64 + tile * 32 + c;
        const float* xrow = p.out + (size_t)token * DM + kq * 256 + 8 * h; const float* g2p = p.norm2_g + kq * 256 + 8 * h;
        unsigned char* hrow = p.ws + WS_H8 + (size_t)token * DM + kq * 256 + 8 * h;
        f32x16 acc = {}; float ss = 0.f;
#pragma unroll 2
        for (int s = 0; s < 16; ++s) {
            const f32x4 a = *(const f32x4*)(xrow + 16 * s), b = *(const f32x4*)(xrow + 16 * s + 4); const f32x4 ga = *(const f32x4*)(g2p + 16 * s), gb = *(const f32x4*)(g2p + 16 * s + 4);
            ss += (a[0] * a[0] + a[1] * a[1]) + (a[2] * a[2] + a[3] * a[3]) + (b[0] * b[0] + b[1] * b[1]) + (b[2] * b[2] + b[3] * b[3]);
            u32x4 xh; xh.x = pk2(a[0], a[1]); xh.y = pk2(a[2], a[3]); xh.z = pk2(b[0], b[1]); xh.w = pk2(b[2], b[3]);
            u32x4 xl; xl.x = pk2(a[0] - bf_lo(xh.x), a[1] - bf_hi(xh.x)); xl.y = pk2(a[2] - bf_lo(xh.y), a[3] - bf_hi(xh.y)); xl.z = pk2(b[0] - bf_lo(xh.z), b[1] - bf_hi(xh.z)); xl.w = pk2(b[2] - bf_lo(xh.w), b[3] - bf_hi(xh.w));
            u32x2 h8; h8.x = pk4_fp8(a[0] * ga[0], a[1] * ga[1], a[2] * ga[2], a[3] * ga[3]); h8.y = pk4_fp8(b[0] * gb[0], b[1] * gb[1], b[2] * gb[2], b[3] * gb[3]); *(u32x2*)(hrow + 16 * s) = h8;
            const u32x4 gh = GF[((kq * 16 + s) * 2 + 0) * 64 + lane], gl = GF[((kq * 16 + s) * 2 + 1) * 64 + lane];
            acc = __builtin_amdgcn_mfma_f32_32x32x16_bf16(__builtin_bit_cast(bf16x8, gh), __builtin_bit_cast(bf16x8, xh), acc, 0, 0, 0);
            acc = __builtin_amdgcn_mfma_f32_32x32x16_bf16(__builtin_bit_cast(bf16x8, gh), __builtin_bit_cast(bf16x8, xl), acc, 0, 0, 0);
            acc = __builtin_amdgcn_mfma_f32_32x32x16_bf16(__builtin_bit_cast(bf16x8, gl), __builtin_bit_cast(bf16x8, xh), acc, 0, 0, 0);
        }
#pragma unroll
        for (int r = 0; r < 16; ++r) red[((tile * 4 + kq) * 16 + r) * 64 + lane] = acc[r];
        ssb[(tile * 4 + kq) * 64 + lane] = ss;
        __syncthreads();
        int te[4] = {0, 0, 0, 0}, rl[4] = {0, 0, 0, 0}; float tw[4] = {0.f, 0.f, 0.f, 0.f}; float rstd = 0.f;
        if (kq == 0) {
            float v[16]; float st = 0.f;
#pragma unroll
            for (int q = 0; q < 4; ++q) st += ssb[(tile * 4 + q) * 64 + lane];
            { auto rr = __builtin_amdgcn_permlane32_swap(__float_as_uint(st), __float_as_uint(st), false, false); st = __uint_as_float(rr[0]) + __uint_as_float(rr[1]); }
            rstd = rsqrtf(st * (1.f / DM) + EPS);
#pragma unroll
            for (int r = 0; r < 16; ++r) { float sacc = 0.f;
#pragma unroll
                for (int q = 0; q < 4; ++q) sacc += red[((tile * 4 + q) * 16 + r) * 64 + lane];
                v[r] = sacc * rstd + p.router_b[crow16(r, h)]; }
            float lv[4]; int le[4];
#pragma unroll
            for (int k = 0; k < 4; ++k) { float best = v[0]; int bi = 0;
#pragma unroll
                for (int r = 1; r < 16; ++r) { const bool gt = v[r] > best; best = gt ? v[r] : best; bi = gt ? r : bi; }
                lv[k] = best; le[k] = (bi & 3) + 8 * (bi >> 2) + 4 * h;
#pragma unroll
                for (int r = 0; r < 16; ++r) v[r] = (r == bi) ? -INFINITY : v[r]; }
            float cv[8]; int ce[8];
#pragma unroll
            for (int k = 0; k < 4; ++k) { auto rv = __builtin_amdgcn_permlane32_swap(__float_as_uint(lv[k]), __float_as_uint(lv[k]), false, false); auto re = __builtin_amdgcn_permlane32_swap((unsigned)le[k], (unsigned)le[k], false, false);
                cv[k] = __uint_as_float(rv[0]); cv[4 + k] = __uint_as_float(rv[1]); ce[k] = (int)re[0]; ce[4 + k] = (int)re[1]; }
            float tv[4];
#pragma unroll
            for (int k = 0; k < 4; ++k) { float best = cv[0]; int be = ce[0]; int bi = 0;
#pragma unroll
                for (int r = 1; r < 8; ++r) { const bool gt = (cv[r] > best) || (cv[r] == best && ce[r] < be); best = gt ? cv[r] : best; be = gt ? ce[r] : be; bi = gt ? r : bi; }
                tv[k] = best; te[k] = be;
#pragma unroll
                for (int r = 0; r < 8; ++r) cv[r] = (r == bi) ? -INFINITY : cv[r]; }
            const float e1 = __expf(tv[1] - tv[0]), e2 = __expf(tv[2] - tv[0]), e3 = __expf(tv[3] - tv[0]); const float inv = 1.f / (1.f + e1 + e2 + e3);
            tw[0] = inv; tw[1] = e1 * inv; tw[2] = e2 * inv; tw[3] = e3 * inv;
            if (h == 0) {
#pragma unroll
                for (int k = 0; k < 4; ++k) rl[k] = atomicAdd(&lcnt[te[k]], 1); }
        }
        __syncthreads();
        if (tid < 32) lbase[tid] = (int)atomicAdd(&gcnt[tid], (unsigned)lcnt[tid]);
        __syncthreads();
        if (kq == 0 && h == 0) {
#pragma unroll
            for (int k = 0; k < 4; ++k) { const int idx = te[k] * CAP + lbase[te[k]] + rl[k]; row_tok[idx] = token; row_w[idx] = tw[k]; row_slot[idx] = token * 4 + k; row_rstd[idx] = rstd; } }
        __syncthreads();
    }
}

__device__ __forceinline__ void build_block_table(const Params& p, int* bs) {
    const unsigned* gcnt = (const unsigned*)(p.ws + WS_CTL) + CW_CNT;
    if (threadIdx.x == 0) { int acc = 0; for (int e = 0; e < NE; ++e) { bs[e] = acc; acc += ((int)__hip_atomic_load(gcnt + e, __ATOMIC_RELAXED, __HIP_MEMORY_SCOPE_AGENT) + 255) >> 8; } bs[NE] = acc; }
    __syncthreads();
}

__device__ __forceinline__ pg8::MoeOrder make_moe_order(const Params& p, unsigned char* lds, int N, bool gather) {
    int* bs = (int*)(lds + 131072); int* utab = (int*)(lds + 131072 + 256); int* gtab = (int*)(lds + 131072 + 512);
    build_block_table(p, bs);
    const int nmb = __builtin_amdgcn_readfirstlane(bs[NE]);
    pg8::MoeOrder S; S.so.init(nmb * 256, N, (int)gridDim.x, (int)blockIdx.x); S.utab = (const PG8_LAS int*)utab; S.gtab = (const PG8_LAS int*)gtab;
    const int* row_tok = (const int*)(p.ws + WS_RT2);
    for (int i = 0; i < pg8::MOE_MAXU; ++i) { pg8::Unit u; if (!S.so.next(i, u)) break; int e = 0; for (int k = 1; k < NE; ++k) if (bs[k] <= u.pm) e = k;
        const int rb = e * CAP + (u.pm - bs[e]) * 256;
        if (threadIdx.x == 0) utab[i] = e | (rb << 8);
        if (gather && threadIdx.x < 256) gtab[i * 256 + threadIdx.x] = row_tok[rb + threadIdx.x]; }
    __syncthreads();
    return S;
}
__device__ __forceinline__ void phase_moe1(const Params& p, unsigned char* lds) {
    const pg8::MoeOrder S = make_moe_order(p, lds, 2048, true);
    pg8::Gemm g{(const bf16_t*)(p.ws + WS_H8), (const bf16_t*)(p.ws + WS_W1), 0, 2048, DM / 2, (size_t)2048 * DM, 0};
    pg8::EpiSwiglu E{p.ws + WS_ACT, p.b1, (const float*)(p.ws + WS_RT2 + 6 * MiB)};
    pg8::gemm_phase<pg8::EpiSwiglu, pg8::MoeOrder, true, true, true, true>((PG8_LAS unsigned char*)lds, g, S, E);
}
__device__ __forceinline__ void phase_moe2(const Params& p, unsigned char* lds) {
    const pg8::MoeOrder S = make_moe_order(p, lds, DM, false);
    pg8::Gemm g{(const bf16_t*)(p.ws + WS_ACT), (const bf16_t*)(p.ws + WS_W2), 0, DM, DFF / 2, (size_t)DM * DFF, 0};
    pg8::EpiMoeOut E{(bf16_t*)(p.ws + WS_YS), p.b2, (const float*)(p.ws + WS_RT2 + 2 * MiB), (const int*)(p.ws + WS_RT2 + 4 * MiB)};
    pg8::gemm_phase<pg8::EpiMoeOut, pg8::MoeOrder, true, true, true>((PG8_LAS unsigned char*)lds, g, S, E);
}

__device__ __forceinline__ void phase_combine(const Params& p) {
    const int tid = threadIdx.x, lane = tid & 63, wave = tid >> 6;
    const int gw = blockIdx.x * NWAVES + wave, NGW = gridDim.x * NWAVES;
    const bf16_t* YS = (const bf16_t*)(p.ws + WS_YS);
    for (int t = gw; t < NTOK; t += NGW) {
        f32x4* orow = (f32x4*)(p.out + (size_t)t * DM) + lane;
#pragma unroll
        for (int j = 0; j < 4; ++j) { f32x4 v = orow[64 * j];
#pragma unroll
            for (int k = 0; k < 4; ++k) { const u32x2 w = *((const u32x2*)(YS + ((size_t)t * 4 + k) * DM) + lane + 64 * j); v[0] += bf_lo(w.x); v[1] += bf_hi(w.x); v[2] += bf_lo(w.y); v[3] += bf_hi(w.y); }
            orow[64 * j] = v; }
    }
}

template <class Epi>
__device__ __forceinline__ void dense_gemm(unsigned char* lds, const bf16_t* A, const bf16_t* Bt, int M, int N, int K, const Epi& E, int lda = 0) {
    pg8::Gemm g{A, Bt, M, N, K, 0, lda}; pg8::StaticOrder S; S.init(M, N, (int)gridDim.x, (int)blockIdx.x);
    pg8::gemm_phase<Epi, pg8::StaticOrder, true, true>((PG8_LAS unsigned char*)lds, g, S, E);
}

constexpr int NPHASE = 13;
__global__ void __launch_bounds__(NTHREADS, 2) mk_fwd(Params p) {
    extern __shared__ __attribute__((aligned(16))) unsigned char lds[];
    cg::grid_group grid = cg::this_grid();
    unsigned char* ws = p.ws;
    volatile LAS unsigned* MISC = (volatile LAS unsigned*)((LAS unsigned char*)lds + MISC_OFF);
    if (threadIdx.x < 32) MISC[threadIdx.x] = 0u;
    __syncthreads();
    XcdBarrier bar = xcd_barrier_post((unsigned*)(ws + WS_CTL) + CW_BAR, MISC + 8);
    const int lo = p.ph_lo, hi = p.ph_hi;
    if (lo < 0) grid.sync();
#define IN(k) (lo <= (k) && (k) < hi)
#define SEAM(k) do { if (IN(k) && IN((k) + 1)) xcd_barrier(bar); } while (0)
    if (IN(0)) phase_prologue(p, lds);
    SEAM(0);
    if (IN(1)) { pg8::EpiProj E{(bf16_t*)(ws + WS_PROJ)}; dense_gemm(lds, (const bf16_t*)(ws + WS_XN), (const bf16_t*)(ws + WS_WIN), NTOK, INCP, DM, E); }
    if (IN(1) && IN(3)) xcd_barrier(bar);
    if (IN(3)) { pg8::EpiBf16 Eq{(bf16_t*)(ws + WS_QPRE), 768}; dense_gemm(lds, (const bf16_t*)(ws + WS_PROJ) + OFF_CQ, (const bf16_t*)(ws + WS_WUQ), NTOK, 768, QLORA, Eq, INCP);
                 pg8::EpiBf16 Ek{(bf16_t*)(ws + WS_KVPRE), 1024}; dense_gemm(lds, (const bf16_t*)(ws + WS_PROJ) + OFF_CKV, (const bf16_t*)(ws + WS_WUKV), NTOK, 1024, KVLORA, Ek, INCP); }
    SEAM(3);
    if (IN(4)) phase_tok_b(p);
    SEAM(4);
    if (IN(5)) phase_attn(p, lds);
    SEAM(5);
    if (IN(6)) { pg8::EpiGateA E{(bf16_t*)(ws + WS_M1), (const bf16_t*)(ws + WS_PROJ)}; dense_gemm(lds, (const bf16_t*)(ws + WS_AO), (const bf16_t*)(ws + WS_WOMLA), NTOK, DM, 512, E); }
    if (IN(7)) { pg8::EpiGateB E{(const bf16_t*)(ws + WS_M1), (const bf16_t*)(ws + WS_PROJ), (bf16_t*)(ws + WS_MERGED)}; dense_gemm(lds, (const bf16_t*)(ws + WS_YBIN), (const bf16_t*)(ws + WS_WOCONV), NTOK, DM, 512, E); }
    SEAM(7);
    if (IN(8)) { pg8::EpiResid E{p.x, p.out}; dense_gemm(lds, (const bf16_t*)(ws + WS_MERGED), (const bf16_t*)(ws + WS_WO), NTOK, DM, DM, E); }
    SEAM(8);
    if (IN(9)) phase_router(p, lds);
    if (IN(9) && IN(11)) xcd_barrier(bar);
    if (IN(11)) phase_moe1(p, lds);
    SEAM(11);
    if (IN(12)) phase_moe2(p, lds);
    SEAM(12);
    if (IN(13)) phase_combine(p);
#undef IN
#undef SEAM
}

extern "C" void kernel_launch(void* const* d_in, const int* in_sizes, int n_in, void* d_out, int out_size,
                              void* d_ws, size_t ws_size, hipStream_t stream) {
    static int grid_blocks = 0;
    if (!grid_blocks) {
        int dev = 0, cus = 0, per_cu = 0;
        (void)hipGetDevice(&dev);
        (void)hipDeviceGetAttribute(&cus, hipDeviceAttributeMultiprocessorCount, dev);
        (void)hipFuncSetAttribute((const void*)mk_fwd, hipFuncAttributeMaxDynamicSharedMemorySize, LDS_BYTES);
        (void)hipOccupancyMaxActiveBlocksPerMultiprocessor(&per_cu, (const void*)mk_fwd, NTHREADS, LDS_BYTES);
        if (per_cu < 1) { fprintf(stderr, "kernel_launch: occupancy query says %d blocks/CU\n", per_cu); per_cu = 1; }
        grid_blocks = cus;
        if (ws_size < WS_END2 || n_in != 21) fprintf(stderr, "kernel_launch: ws %zu < %zu or n_in %d != 21\n", ws_size, (size_t)WS_END2, n_in);
    }
    (void)hipMemsetAsync((char*)d_ws + WS_CTL, 0, 1 * MiB, stream);
    Params p{};
    p.x = (const float*)d_in[0]; p.pos = (const int*)d_in[1]; p.norm1_g = (const float*)d_in[2]; p.w_in = (const float*)d_in[3]; p.q_a_g = (const float*)d_in[4];
    p.kv_a_g = (const float*)d_in[5]; p.w_uq = (const float*)d_in[6]; p.w_ukv = (const float*)d_in[7]; p.q_g = (const float*)d_in[8]; p.k_g = (const float*)d_in[9];
    p.conv_w = (const float*)d_in[10]; p.w_o_mla = (const float*)d_in[11]; p.w_o_conv = (const float*)d_in[12]; p.w_o = (const float*)d_in[13]; p.norm2_g = (const float*)d_in[14];
    p.router_w = (const float*)d_in[15]; p.router_b = (const float*)d_in[16]; p.w1 = (const float*)d_in[17]; p.b1 = (const float*)d_in[18]; p.w2 = (const float*)d_in[19]; p.b2 = (const float*)d_in[20];
    p.out = (float*)d_out; p.ws = (unsigned char*)d_ws; p.ph_lo = 0; p.ph_hi = NPHASE + 1;
    void* args[] = {&p};
    hipError_t e = hipLaunchCooperativeKernel((const void*)mk_fwd, dim3(grid_blocks), dim3(NTHREADS), args, LDS_BYTES, stream);
    if (e != hipSuccess) fprintf(stderr, "cooperative launch failed: %s (grid %d)\n", hipGetErrorString(e), grid_blocks);
}
```

```cpp
#include <hip/hip_runtime.h>
#include <hip/hip_cooperative_groups.h>
#include <cstdio>
#include <cstdint>
namespace cg = cooperative_groups;

typedef unsigned short bf16_t;
typedef short bf16x8 __attribute__((ext_vector_type(8)));
typedef short s16x4 __attribute__((ext_vector_type(4)));
typedef float f32x4 __attribute__((ext_vector_type(4)));
typedef float f32x2 __attribute__((ext_vector_type(2)));
typedef float f32x16 __attribute__((ext_vector_type(16)));
typedef unsigned u32x4 __attribute__((ext_vector_type(4)));
typedef unsigned u32x2 __attribute__((ext_vector_type(2)));
typedef __bf16 bf16x2_t __attribute__((ext_vector_type(2)));

constexpr int NTOK = 16384, DM = 1024, SEQ = 8192;
constexpr int INC = 4000, INCP = 4096;
constexpr int OFF_CQ = 0, OFF_CKV = 256, OFF_KR = 384, OFF_U = 416, OFF_C = 928, OFF_B = 1440, OFF_GA = 1952, OFF_GB = 2976;
constexpr int NH = 8, DQK = 96, DV = 64, NE = 32, TOPK = 4, DFF = 1024;
constexpr int QLORA = 256, KVLORA = 128, CONVW = 512;
constexpr int NPAIR = NTOK * TOPK;
constexpr int MAXROWS = 73728;
constexpr float EPS = 1e-6f;
constexpr int CAP = 16384;
constexpr int NTHREADS = 512, NWAVES = 8;
constexpr int LDS_BYTES = 147456;

constexpr size_t MiB = 1ull << 20;
constexpr size_t WS_CTL = 0;
constexpr size_t WS_WIN = 1 * MiB;
constexpr size_t WS_WUQ = 9 * MiB;
constexpr size_t WS_WUKV = WS_WUQ + 512 * 1024;
constexpr size_t WS_WOMLA = 10 * MiB;
constexpr size_t WS_WOCONV = 11 * MiB;
constexpr size_t WS_WO = 12 * MiB;
constexpr size_t WS_ROUTE = 14 * MiB;
constexpr size_t WS_W1 = 18 * MiB;
constexpr size_t WS_W2 = 146 * MiB;
constexpr size_t WS_XN = 210 * MiB;
constexpr size_t WS_PROJ = 242 * MiB;
constexpr size_t WS_CQN = 370 * MiB;
constexpr size_t WS_CKVN = 378 * MiB;
constexpr size_t WS_YBIN = 386 * MiB;
constexpr size_t WS_QPRE = 402 * MiB;
constexpr size_t WS_KVPRE = 450 * MiB;
constexpr size_t WS_Q = 514 * MiB;
constexpr size_t WS_K = 538 * MiB;
constexpr size_t WS_V = 570 * MiB;
constexpr size_t WS_AO = 586 * MiB;
constexpr size_t WS_M1 = 602 * MiB;
constexpr size_t WS_MERGED = 666 * MiB;
constexpr size_t WS_YS = 698 * MiB;
constexpr size_t WS_END = 826 * MiB;
constexpr size_t WS_ACT = WS_PROJ;
constexpr size_t WS_H8 = WS_XN;
constexpr size_t WS_GF = 830 * MiB;
constexpr size_t WS_RT2 = 832 * MiB;
constexpr size_t WS_END2 = 840 * MiB;
constexpr size_t RT_PAIR_E = 0, RT_PAIR_RANK = 262144, RT_PAIR_W = 524288, RT_ROW_TOK = 786432, RT_ROW_W = 786432 + 294912, RT_ROW_SLOT = 786432 + 2 * 294912;
constexpr int CW_CNT = 64;
constexpr int CW_BAR = 4096;
constexpr int MISC_OFF = LDS_BYTES - 256;

struct Params {
    const float* x; const int* pos; const float* norm1_g; const float* w_in; const float* q_a_g; const float* kv_a_g;
    const float* w_uq; const float* w_ukv; const float* q_g; const float* k_g; const float* conv_w; const float* w_o_mla;
    const float* w_o_conv; const float* w_o; const float* norm2_g; const float* router_w; const float* router_b;
    const float* w1; const float* b1; const float* w2; const float* b2;
    float* out; unsigned char* ws; int ph_lo, ph_hi;
};

__device__ __forceinline__ unsigned pk2(float lo, float hi) { f32x2 v = {lo, hi}; bf16x2_t b = __builtin_convertvector(v, bf16x2_t); return __builtin_bit_cast(unsigned, b); }
__device__ __forceinline__ float bf_lo(unsigned w) { return __uint_as_float(w << 16); }
__device__ __forceinline__ float bf_hi(unsigned w) { return __uint_as_float(w & 0xffff0000u); }
__device__ __forceinline__ float bf1(bf16_t h) { return __uint_as_float((unsigned)h << 16); }
__device__ __forceinline__ float wave_sum(float v) {
#pragma unroll
    for (int o = 1; o < 64; o <<= 1) v += __shfl_xor(v, o);
    return v;
}
__device__ __forceinline__ unsigned pk4_fp8(float a, float b, float c, float d) { unsigned w = 0u; w = (unsigned)__builtin_amdgcn_cvt_pk_fp8_f32(a, b, (int)w, false); w = (unsigned)__builtin_amdgcn_cvt_pk_fp8_f32(c, d, (int)w, true); return w; }
constexpr float W8_SCALE = 32.f, W8_INV = 1.f / 32.f;
__device__ __forceinline__ float sigmoidf_(float v) { return __builtin_amdgcn_rcpf(1.f + __builtin_amdgcn_exp2f(v * -1.4426950408889634f)); }

namespace pg8 {
#define PG8_LAS __attribute__((address_space(3)))
constexpr int BM = 256, BK = 64, HALF = 128, HTB = HALF * BK * 2  , STAGE_BYTES = 8 * HTB, NXCD = 8, WGM = 8;

__host__ __device__ __forceinline__ int lds_byte(int r, int c) { const int st = (r >> 4) * 2 + (c >> 5), rr = r & 15, cc = c & 31, ob = rr * 64 + cc * 2; return st * 1024 + (ob ^ (((ob >> 9) & 1) << 5)); }
__host__ __device__ __forceinline__ void stage_rc(int b, int& R, int& C) { const int st = b / 1024, sb = b % 1024, swz = sb ^ (((sb >> 9) & 1) << 5); R = (st >> 1) * 16 + swz / 64; C = (st & 1) * 32 + (swz % 64) / 2; }
__host__ __device__ __forceinline__ int perm32(int rho) { const int n = rho >> 4, i = rho & 15; return 8 * (i >> 2) + 4 * n + (i & 3); }

struct Unit { int pm, pn, e, rb; };
struct Gemm { const bf16_t* A; const bf16_t* Bt; int M, N, K; size_t bstride; int lda; };

struct StaticOrder {
    int nM, nN, nwg, G, c;
    __host__ __device__ void init(int M, int N, int G_, int c_) { nM = M / BM; nN = N / BM; nwg = nM * nN; G = G_; c = c_; }
    __host__ __device__ bool next(int i, Unit& u) const {
        const long L = (long)i * G + c; if (L >= nwg) return false;
        int wgid = (int)L; { const int q = nwg / NXCD, r = nwg % NXCD, xcd = wgid % NXCD, off = wgid / NXCD; wgid = (xcd < r ? xcd * (q + 1) : r * (q + 1) + (xcd - r) * q) + off; }
        const int nig = WGM * nN, gid = wgid / nig, fm = gid * WGM, gsz = (nM - fm) < WGM ? (nM - fm) : WGM;
        u.pm = fm + ((wgid % nig) % gsz); u.pn = (wgid % nig) / gsz; u.e = 0; u.rb = 0; return true;
    }
    __device__ __forceinline__ void a_ready(const Unit&) const {}
    __device__ __forceinline__ void done(const Unit&) const {}
};


struct EpiProj {
    static constexpr bool PERM = true, AFTER_DRAIN = false;
    bf16_t* O;
    __device__ __forceinline__ void operator()(const f32x4 (&acc)[2][2][4][2], const Unit& u, int wr, int wc, int fr, int fq) const {
        const int row0 = u.pm * BM + wr * 64 + fr, col0 = u.pn * BM + wc * 32 + 8 * fq;
#pragma unroll
        for (int ai = 0; ai < 2; ++ai)
#pragma unroll
            for (int m = 0; m < 4; ++m) { bf16_t* rowp = O + (size_t)(row0 + ai * HALF + m * 16) * INCP + col0;
#pragma unroll
                for (int bj = 0; bj < 2; ++bj) { f32x4 v0 = acc[ai][bj][m][0], v1 = acc[ai][bj][m][1]; const int col = col0 + bj * HALF;
                    if (col >= OFF_GA && col < INC) {
#pragma unroll
                        for (int j = 0; j < 4; ++j) { v0[j] = sigmoidf_(v0[j]); v1[j] = sigmoidf_(v1[j]); } }
                    u32x4 w; w.x = pk2(v0[0], v0[1]); w.y = pk2(v0[2], v0[3]); w.z = pk2(v1[0], v1[1]); w.w = pk2(v1[2], v1[3]);
                    *(u32x4*)(rowp + bj * HALF) = w; } }
    }
};
struct EpiBf16 {
    static constexpr bool PERM = true, AFTER_DRAIN = false;
    bf16_t* O; int ldc;
    __device__ __forceinline__ void operator()(const f32x4 (&acc)[2][2][4][2], const Unit& u, int wr, int wc, int fr, int fq) const {
        const int row0 = u.pm * BM + wr * 64 + fr, col0 = u.pn * BM + wc * 32 + 8 * fq;
#pragma unroll
        for (int ai = 0; ai < 2; ++ai)
#pragma unroll
            for (int m = 0; m < 4; ++m) { bf16_t* rowp = O + (size_t)(row0 + ai * HALF + m * 16) * ldc + col0;
#pragma unroll
                for (int bj = 0; bj < 2; ++bj) { const f32x4 v0 = acc[ai][bj][m][0], v1 = acc[ai][bj][m][1];
                    u32x4 w; w.x = pk2(v0[0], v0[1]); w.y = pk2(v0[2], v0[3]); w.z = pk2(v1[0], v1[1]); w.w = pk2(v1[2], v1[3]); *(u32x4*)(rowp + bj * HALF) = w; } }
    }
};
struct EpiF32 {
    static constexpr bool PERM = false, AFTER_DRAIN = false;
    float* O; int ldc;
    __device__ __forceinline__ void operator()(const f32x4 (&acc)[2][2][4][2], const Unit& u, int wr, int wc, int fr, int fq) const {
        const int row0 = u.pm * BM + wr * 64 + fr, col0 = u.pn * BM + wc * 32 + 4 * fq;
#pragma unroll
        for (int ai = 0; ai < 2; ++ai)
#pragma unroll
            for (int m = 0; m < 4; ++m) { float* rowp = O + (size_t)(row0 + ai * HALF + m * 16) * ldc + col0;
#pragma unroll
                for (int bj = 0; bj < 2; ++bj)
#pragma unroll
                    for (int n = 0; n < 2; ++n) *(f32x4*)(rowp + bj * HALF + n * 16) = acc[ai][bj][m][n]; }
    }
};
__device__ __forceinline__ void unpack8(const u32x4 g, float (&f)[8]) { f[0] = bf_lo(g.x); f[1] = bf_hi(g.x); f[2] = bf_lo(g.y); f[3] = bf_hi(g.y); f[4] = bf_lo(g.z); f[5] = bf_hi(g.z); f[6] = bf_lo(g.w); f[7] = bf_hi(g.w); }
struct EpiGateA {
    static constexpr bool PERM = true, AFTER_DRAIN = false;
    bf16_t* M1; const bf16_t* proj;
    __device__ __forceinline__ void operator()(const f32x4 (&acc)[2][2][4][2], const Unit& u, int wr, int wc, int fr, int fq) const {
        const int row0 = u.pm * BM + wr * 64 + fr, col0 = u.pn * BM + wc * 32 + 8 * fq;
#pragma unroll
        for (int ai = 0; ai < 2; ++ai)
#pragma unroll
            for (int m = 0; m < 4; ++m) { const size_t row = (size_t)(row0 + ai * HALF + m * 16);
#pragma unroll
                for (int bj = 0; bj < 2; ++bj) { const int col = col0 + bj * HALF; float g[8]; unpack8(*(const u32x4*)(proj + row * INCP + OFF_GA + col), g);
                    const f32x4 v0 = acc[ai][bj][m][0], v1 = acc[ai][bj][m][1];
                    u32x4 w; w.x = pk2(v0[0] * g[0], v0[1] * g[1]); w.y = pk2(v0[2] * g[2], v0[3] * g[3]); w.z = pk2(v1[0] * g[4], v1[1] * g[5]); w.w = pk2(v1[2] * g[6], v1[3] * g[7]);
                    *(u32x4*)(M1 + row * DM + col) = w; } }
    }
};
struct EpiGateB {
    static constexpr bool PERM = true, AFTER_DRAIN = false;
    const bf16_t* M1; const bf16_t* proj; bf16_t* O;
    __device__ __forceinline__ void operator()(const f32x4 (&acc)[2][2][4][2], const Unit& u, int wr, int wc, int fr, int fq) const {
        const int row0 = u.pm * BM + wr * 64 + fr, col0 = u.pn * BM + wc * 32 + 8 * fq;
#pragma unroll
        for (int ai = 0; ai < 2; ++ai)
#pragma unroll
            for (int m = 0; m < 4; ++m) { const size_t row = (size_t)(row0 + ai * HALF + m * 16);
#pragma unroll
                for (int bj = 0; bj < 2; ++bj) { const int col = col0 + bj * HALF; float g[8], b[8]; unpack8(*(const u32x4*)(proj + row * INCP + OFF_GB + col), g); unpack8(*(const u32x4*)(M1 + row * DM + col), b);
                    const f32x4 v0 = acc[ai][bj][m][0], v1 = acc[ai][bj][m][1];
                    u32x4 w; w.x = pk2(b[0] + v0[0] * g[0], b[1] + v0[1] * g[1]); w.y = pk2(b[2] + v0[2] * g[2], b[3] + v0[3] * g[3]);
                    w.z = pk2(b[4] + v1[0] * g[4], b[5] + v1[1] * g[5]); w.w = pk2(b[6] + v1[2] * g[6], b[7] + v1[3] * g[7]);
                    *(u32x4*)(O + row * DM + col) = w; } }
    }
};
struct EpiResid {
    static constexpr bool PERM = false, AFTER_DRAIN = false;
    const float* X; float* O;
    __device__ __forceinline__ void operator()(const f32x4 (&acc)[2][2][4][2], const Unit& u, int wr, int wc, int fr, int fq) const {
        const int row0 = u.pm * BM + wr * 64 + fr, col0 = u.pn * BM + wc * 32 + 4 * fq;
#pragma unroll
        for (int ai = 0; ai < 2; ++ai)
#pragma unroll
            for (int m = 0; m < 4; ++m) { const size_t off = (size_t)(row0 + ai * HALF + m * 16) * DM + col0;
#pragma unroll
                for (int bj = 0; bj < 2; ++bj)
#pragma unroll
                    for (int n = 0; n < 2; ++n) { const f32x4 b = *(const f32x4*)(X + off + bj * HALF + n * 16); *(f32x4*)(O + off + bj * HALF + n * 16) = b + acc[ai][bj][m][n]; } }
    }
};
struct EpiSwiglu {
    static constexpr bool PERM = true, AFTER_DRAIN = false;
    unsigned char* ACT; const float* b1; const float* row_rstd;
    __device__ __forceinline__ void operator()(const f32x4 (&acc)[2][2][4][2], const Unit& u, int wr, int wc, int fr, int fq) const {
        const int row0 = u.pm * BM + wr * 64 + fr, f0 = u.pn * HALF + wc * 32 + 8 * fq; const float* be = b1 + (size_t)u.e * 2048;
        const f32x4 bg0 = *(const f32x4*)(be + f0), bg1 = *(const f32x4*)(be + f0 + 4), bu0 = *(const f32x4*)(be + DFF + f0), bu1 = *(const f32x4*)(be + DFF + f0 + 4);
        float rsv[8];
#pragma unroll
        for (int i = 0; i < 8; ++i) rsv[i] = row_rstd[u.rb + wr * 64 + fr + (i >> 2) * HALF + (i & 3) * 16] * W8_INV;
#pragma unroll
        for (int ai = 0; ai < 2; ++ai)
#pragma unroll
            for (int m = 0; m < 4; ++m) { const size_t row = (size_t)(row0 + ai * HALF + m * 16); float o[8]; const float rs = rsv[ai * 4 + m];
#pragma unroll
                for (int n = 0; n < 2; ++n) { const f32x4 g4 = acc[ai][0][m][n] * rs + (n ? bg1 : bg0), u4 = acc[ai][1][m][n] * rs + (n ? bu1 : bu0);
#pragma unroll
                    for (int j = 0; j < 4; ++j) { const float g = fminf(g4[j], 7.f), uu = fminf(fmaxf(u4[j], -7.f), 7.f); o[4 * n + j] = (uu + 1.f) * (g * sigmoidf_(1.702f * g)); } }
                u32x2 w; w.x = pk4_fp8(o[0], o[1], o[2], o[3]); w.y = pk4_fp8(o[4], o[5], o[6], o[7]); *(u32x2*)(ACT + row * DFF + f0) = w; }
    }
};
struct EpiMoeOut {
    static constexpr bool PERM = true, AFTER_DRAIN = false;
    bf16_t* YS; const float* b2; const float* row_w; const int* row_slot;
    __device__ __forceinline__ void operator()(const f32x4 (&acc)[2][2][4][2], const Unit& u, int wr, int wc, int fr, int fq) const {
        const int col0 = u.pn * BM + wc * 32 + 8 * fq; const float* be = b2 + (size_t)u.e * DM; const int rbase = u.rb + wr * 64 + fr;
        int slot[8]; float w[8];
#pragma unroll
        for (int i = 0; i < 8; ++i) { const int row = rbase + (i >> 2) * HALF + (i & 3) * 16; slot[i] = row_slot[row]; w[i] = row_w[row] * W8_INV; }
        f32x4 bv[2][2];
#pragma unroll
        for (int bj = 0; bj < 2; ++bj)
#pragma unroll
            for (int n = 0; n < 2; ++n) bv[bj][n] = *(const f32x4*)(be + col0 + bj * HALF + 4 * n) * W8_SCALE;
#pragma unroll
        for (int ai = 0; ai < 2; ++ai)
#pragma unroll
            for (int m = 0; m < 4; ++m) { const int i = ai * 4 + m;
                if (slot[i] >= 0) { bf16_t* rowp = YS + (size_t)slot[i] * DM + col0;
#pragma unroll
                    for (int bj = 0; bj < 2; ++bj) { const f32x4 v0 = (acc[ai][bj][m][0] + bv[bj][0]) * w[i], v1 = (acc[ai][bj][m][1] + bv[bj][1]) * w[i];
                        u32x4 o; o.x = pk2(v0[0], v0[1]); o.y = pk2(v0[2], v0[3]); o.z = pk2(v1[0], v1[1]); o.w = pk2(v1[2], v1[3]); *(u32x4*)(rowp + bj * HALF) = o; } } }
    }
};
constexpr int MOE_MAXU = 12;
struct MoeOrder {
    StaticOrder so; const PG8_LAS int* utab; const PG8_LAS int* gtab;
    __device__ __forceinline__ bool next(int i, Unit& u) const { if (i >= MOE_MAXU || !so.next(i, u)) return false; const int v = __builtin_amdgcn_readfirstlane(utab[i]); u.e = v & 31; u.rb = (int)((unsigned)v >> 8); return true; }
    __device__ __forceinline__ void a_ready(const Unit&) const {}
    __device__ __forceinline__ void done(const Unit&) const {}
};
typedef int i32x4_t __attribute__((ext_vector_type(4))); typedef int i32x8_t __attribute__((ext_vector_type(8)));
__device__ __forceinline__ i32x8_t cat8(bf16x8 lo, bf16x8 hi) { return __builtin_shufflevector(__builtin_bit_cast(i32x4_t, lo), __builtin_bit_cast(i32x4_t, hi), 0, 1, 2, 3, 4, 5, 6, 7); }
__device__ __forceinline__ void mfma_fp8_inplace(f32x4& c, const i32x8_t a, const i32x8_t b) { asm volatile("s_nop 1\n\tv_mfma_f32_16x16x128_f8f6f4 %0, %1, %2, %0" : "+v"(c) : "v"(a), "v"(b)); }
__device__ __forceinline__ void mfma_fp8_drain() { asm volatile("s_nop 15\n\ts_nop 7" ::: "memory"); __builtin_amdgcn_sched_barrier(0); }
template <class Epi, class Sched, bool ALIGN_EPI = false, bool SP2 = false, bool FP8 = false, bool GATHER = false>
__device__ __forceinline__ void gemm_phase(PG8_LAS unsigned char* lds, const Gemm g, const Sched& S, const Epi& E) {
    const int tid = threadIdx.x, wid = __builtin_amdgcn_readfirstlane(tid >> 6), lane = tid & 63, wr = wid >> 2, wc = wid & 3, fr = lane & 15, fq = lane >> 4;
    const int K = g.K, nt = K / BK;
    static_assert(!GATHER || SP2, "GATHER is implemented for the SP2 loop only");
    const unsigned rowA = (unsigned)(g.lda ? g.lda : K) * 2u;
    unsigned voffA[2], voffB[2]; int gR0 = 0; unsigned gC = 0u;
#pragma unroll
    for (int i = 0; i < 2; ++i) { int R, C; stage_rc(tid * 16 + i * 8192, R, C); const int Rb = Epi::PERM ? ((R & ~31) + perm32(R & 31)) : R;
        voffA[i] = (unsigned)R * rowA + (unsigned)C * 2u; voffB[i] = (unsigned)(Rb * K + C) * 2u; if (i == 0) { gR0 = R; gC = (unsigned)C * 2u; } }
    unsigned gA[2][2] = {{0u, 0u}, {0u, 0u}}, ngA[2][2] = {{0u, 0u}, {0u, 0u}};
#define PG8_GLOAD(dst, ui_) do { _Pragma("unroll") for (int h_ = 0; h_ < 2; ++h_) _Pragma("unroll") for (int i_ = 0; i_ < 2; ++i_) \
        dst[h_][i_] = (unsigned)S.gtab[(ui_) * 256 + 128 * h_ + gR0 + 64 * i_] * rowA + gC; } while (0)
#define PG8_VA(h) (GATHER ? gA[h] : voffA)
    const unsigned kstep = (unsigned)(BK * 2);
    const unsigned hstep = (unsigned)HALF * (unsigned)K * 2u;
    const unsigned tstep = 2u * hstep;
    const unsigned hstepA = (unsigned)HALF * rowA, tstepA = 2u * hstepA;
    const unsigned hsA = GATHER ? 0u : hstepA;
    const unsigned ldsw = (unsigned)wid * 1024u;
    const int aoff = lds_byte(wr * 64 + fr, fq * 8), boff = lds_byte(wc * 32 + fr, fq * 8);
#define PG8_SA(b, h) (((b) * 2 + (h)) * HTB)
#define PG8_SB(b, h) ((4 + (b) * 2 + (h)) * HTB)
#define PG8_STAGE(rs, bufoff, goff, voff) do { _Pragma("unroll") for (int _i = 0; _i < 2; ++_i) \
        __builtin_amdgcn_raw_ptr_buffer_load_lds(rs, (PG8_LAS void*)(lds + (bufoff) + ldsw + _i * 8192), 16, (int)(voff)[_i], (int)(goff), 0, 0); } while (0)
#define PG8_LDA(dst, b, h) do { _Pragma("unroll") for (int m = 0; m < 4; ++m) _Pragma("unroll") for (int k = 0; k < 2; ++k) dst[m][k] = *(const PG8_LAS bf16x8*)(lds + PG8_SA(b, h) + aoff + m * 2048 + k * 1024); } while (0)
#define PG8_LDB(dst, b, h) do { _Pragma("unroll") for (int n = 0; n < 2; ++n) _Pragma("unroll") for (int k = 0; k < 2; ++k) dst[n][k] = *(const PG8_LAS bf16x8*)(lds + PG8_SB(b, h) + boff + n * 2048 + k * 1024); } while (0)
#define PG8_MMA(ai, bj, At, Bt) do { __builtin_amdgcn_s_setprio(1); _Pragma("unroll") for (int m = 0; m < 4; ++m) _Pragma("unroll") for (int n = 0; n < 2; ++n) { \
        if constexpr (FP8) { mfma_fp8_inplace(acc[ai][bj][m][n], cat8(Bt[n][0], Bt[n][1]), cat8(At[m][0], At[m][1])); } \
        else { _Pragma("unroll") for (int k = 0; k < 2; ++k) acc[ai][bj][m][n] = __builtin_amdgcn_mfma_f32_16x16x32_bf16(Bt[n][k], At[m][k], acc[ai][bj][m][n], 0, 0, 0); } } \
        __builtin_amdgcn_s_setprio(0); } while (0)
#define PG8_WAIT_V(n) asm volatile("s_waitcnt vmcnt(" #n ")" ::: "memory")
#define PG8_WAIT_L(n) asm volatile("s_waitcnt lgkmcnt(" #n ")" ::: "memory")
#define PG8_BAR __builtin_amdgcn_s_barrier()
#define PG8_SCHED __builtin_amdgcn_sched_barrier(0)
    Unit cur, nxt; int ui = 0;
    if (!S.next(0, cur)) return;
    f32x4 acc[2][2][4][2];
#pragma unroll
    for (int a = 0; a < 2; ++a)
#pragma unroll
        for (int b = 0; b < 2; ++b)
#pragma unroll
            for (int m = 0; m < 4; ++m)
#pragma unroll
                for (int n = 0; n < 2; ++n) acc[a][b][m][n] = (f32x4){0.f, 0.f, 0.f, 0.f};
    bf16x8 At[4][2], B0[2][2], B1[2][2];
    unsigned cA = GATHER ? 0u : (unsigned)cur.pm * tstepA, cB = (unsigned)cur.e * (unsigned)g.bstride + (unsigned)cur.pn * tstep;
    const __amdgpu_buffer_rsrc_t rsA = __builtin_amdgcn_make_buffer_rsrc((void*)g.A, 0, 0x7fffffff, 0x00020000), rsB = __builtin_amdgcn_make_buffer_rsrc((void*)g.Bt, 0, 0x7fffffff, 0x00020000);
    S.a_ready(cur);
    if constexpr (GATHER) PG8_GLOAD(gA, 0);
    if constexpr (SP2) {
        PG8_STAGE(rsB, PG8_SB(0, 0), cB, voffB); PG8_STAGE(rsB, PG8_SB(0, 1), cB + hstep, voffB); PG8_STAGE(rsA, PG8_SA(0, 0), cA, PG8_VA(0)); PG8_STAGE(rsA, PG8_SA(0, 1), cA + hsA, PG8_VA(1));
        if (wr == 1) PG8_BAR;
        PG8_WAIT_V(2); PG8_BAR;
        PG8_STAGE(rsB, PG8_SB(1, 0), cB + kstep, voffB); PG8_STAGE(rsA, PG8_SA(1, 0), cA + kstep, PG8_VA(0)); PG8_STAGE(rsB, PG8_SB(1, 1), cB + hstep + kstep, voffB);
        PG8_WAIT_V(6); PG8_BAR;
    } else {
        PG8_STAGE(rsB, PG8_SB(0, 0), cB, voffB); PG8_STAGE(rsA, PG8_SA(0, 0), cA, PG8_VA(0)); PG8_STAGE(rsB, PG8_SB(0, 1), cB + hstep, voffB); PG8_STAGE(rsA, PG8_SA(0, 1), cA + hsA, PG8_VA(1));
        if (wr == 1) PG8_BAR;
        PG8_WAIT_V(4); PG8_BAR;
        PG8_STAGE(rsB, PG8_SB(1, 0), cB + kstep, voffB); PG8_STAGE(rsA, PG8_SA(1, 0), cA + kstep, PG8_VA(0)); PG8_STAGE(rsB, PG8_SB(1, 1), cB + hstep + kstep, voffB);
        PG8_WAIT_V(6); PG8_BAR;
    }
    for (;;) {
        const bool has_next = S.next(ui + 1, nxt);
        if constexpr (GATHER) { if (has_next) PG8_GLOAD(ngA, ui + 1); else { ngA[0][0] = gA[0][0]; ngA[0][1] = gA[0][1]; ngA[1][0] = gA[1][0]; ngA[1][1] = gA[1][1]; } }
        const unsigned nA = (has_next && !GATHER) ? (unsigned)nxt.pm * tstepA : cA, nB = has_next ? (unsigned)nxt.e * (unsigned)g.bstride + (unsigned)nxt.pn * tstep : cB;
        for (int t = 0; t < nt; t += 2) {
            const bool last = (t == nt - 2);
            const unsigned a1 = cA + (unsigned)(t + 1) * kstep;
            const unsigned a2 = last ? nA : cA + (unsigned)(t + 2) * kstep, b2 = last ? nB : cB + (unsigned)(t + 2) * kstep;
            const unsigned a3 = a2 + kstep, b3 = b2 + kstep;
            if (last && has_next) S.a_ready(nxt);
            if constexpr (SP2) {
            PG8_LDB(B0, 0, 0); PG8_LDB(B1, 0, 1); PG8_SCHED; PG8_LDA(At, 0, 0); PG8_STAGE(rsA, PG8_SA(1, 1), a1 + hsA, PG8_VA(1));
            if constexpr (GATHER) { if (last) { gA[0][0] = ngA[0][0]; gA[0][1] = ngA[0][1]; gA[1][0] = ngA[1][0]; gA[1][1] = ngA[1][1]; } }
            PG8_WAIT_V(8); PG8_WAIT_L(0); PG8_BAR; PG8_MMA(0, 0, At, B0); PG8_MMA(0, 1, At, B1); PG8_BAR; PG8_SCHED;
            PG8_LDA(At, 0, 1); PG8_STAGE(rsB, PG8_SB(0, 0), b2, voffB); PG8_STAGE(rsB, PG8_SB(0, 1), b2 + hstep, voffB); PG8_STAGE(rsA, PG8_SA(0, 0), a2, PG8_VA(0));
            PG8_WAIT_V(8); PG8_WAIT_L(0); PG8_BAR; PG8_MMA(1, 0, At, B0); PG8_MMA(1, 1, At, B1); PG8_BAR; PG8_SCHED;
            PG8_LDB(B0, 1, 0); PG8_LDB(B1, 1, 1); PG8_SCHED; PG8_LDA(At, 1, 0); PG8_STAGE(rsA, PG8_SA(0, 1), a2 + hsA, PG8_VA(1));
            PG8_WAIT_V(8); PG8_WAIT_L(0); PG8_BAR; PG8_MMA(0, 0, At, B0); PG8_MMA(0, 1, At, B1); PG8_BAR; PG8_SCHED;
            PG8_LDA(At, 1, 1); PG8_STAGE(rsB, PG8_SB(1, 0), b3, voffB); PG8_STAGE(rsB, PG8_SB(1, 1), b3 + hstep, voffB); PG8_STAGE(rsA, PG8_SA(1, 0), a3, PG8_VA(0));
            PG8_WAIT_V(8); PG8_WAIT_L(0); PG8_BAR; PG8_MMA(1, 0, At, B0); PG8_MMA(1, 1, At, B1); PG8_BAR; PG8_SCHED;
            } else {
            PG8_LDB(B0, 0, 0); PG8_SCHED; PG8_LDA(At, 0, 0); PG8_STAGE(rsA, PG8_SA(1, 1), a1 + hsA, PG8_VA(1));
            PG8_WAIT_L(8); PG8_BAR; PG8_WAIT_L(0); PG8_MMA(0, 0, At, B0); PG8_BAR; PG8_SCHED;
            PG8_LDB(B1, 0, 1); PG8_STAGE(rsB, PG8_SB(0, 0), b2, voffB);
            PG8_BAR; PG8_WAIT_L(0); PG8_MMA(0, 1, At, B1); PG8_BAR;
            PG8_LDA(At, 0, 1); PG8_STAGE(rsA, PG8_SA(0, 0), a2, PG8_VA(0));
            PG8_BAR; PG8_WAIT_L(0); PG8_MMA(1, 0, At, B0); PG8_BAR; PG8_SCHED;
            PG8_STAGE(rsB, PG8_SB(0, 1), b2 + hstep, voffB);
            PG8_WAIT_V(6); PG8_BAR; PG8_MMA(1, 1, At, B1); PG8_BAR;
            PG8_LDB(B0, 1, 0); PG8_SCHED; PG8_LDA(At, 1, 0); PG8_STAGE(rsA, PG8_SA(0, 1), a2 + hsA, PG8_VA(1));
            PG8_WAIT_L(8); PG8_BAR; PG8_WAIT_L(0); PG8_MMA(0, 0, At, B0); PG8_BAR; PG8_SCHED;
            PG8_LDB(B1, 1, 1); PG8_STAGE(rsB, PG8_SB(1, 0), b3, voffB);
            PG8_BAR; PG8_WAIT_L(0); PG8_MMA(0, 1, At, B1); PG8_BAR;
            PG8_LDA(At, 1, 1); PG8_STAGE(rsA, PG8_SA(1, 0), a3, PG8_VA(0));
            PG8_BAR; PG8_WAIT_L(0); PG8_MMA(1, 0, At, B0); PG8_BAR; PG8_SCHED;
            PG8_STAGE(rsB, PG8_SB(1, 1), b3 + hstep, voffB);
            PG8_WAIT_V(6); PG8_BAR; PG8_MMA(1, 1, At, B1); PG8_BAR;
            }
        }
        if constexpr (ALIGN_EPI) { if (wr == 0) PG8_BAR; }
        if constexpr (FP8) mfma_fp8_drain();
        if constexpr (!Epi::AFTER_DRAIN) { E(acc, cur, wr, wc, fr, fq); S.done(cur); }
        if (!has_next) break;
#pragma unroll
        for (int a = 0; a < 2; ++a)
#pragma unroll
            for (int b = 0; b < 2; ++b)
#pragma unroll
                for (int m = 0; m < 4; ++m)
#pragma unroll
                    for (int n = 0; n < 2; ++n) acc[a][b][m][n] = (f32x4){0.f, 0.f, 0.f, 0.f};
        cur = nxt; cA = nA; cB = nB; ++ui;
        if constexpr (ALIGN_EPI) { if (wr == 1) PG8_BAR; }
    }
    PG8_WAIT_V(0);
    if constexpr (!ALIGN_EPI) { if (wr == 0) PG8_BAR; }
    PG8_BAR;
    if constexpr (Epi::AFTER_DRAIN) { E.fused(acc, cur, wr, wc, fr, fq, lds, wid, lane); S.done(cur); }
#undef PG8_SA
#undef PG8_GLOAD
#undef PG8_VA
#undef PG8_SB
#undef PG8_STAGE
#undef PG8_LDA
#undef PG8_LDB
#undef PG8_MMA
#undef PG8_WAIT_V
#undef PG8_WAIT_L
#undef PG8_BAR
#undef PG8_SCHED
}
}

#define GAS __attribute__((address_space(1)))
#define LAS __attribute__((address_space(3)))
#define XB_TMO      128
#define XB_XCNT(j)  (256  + 64 * (j))
#define XB_XSUB(j)  (1280 + 64 * (j))
#define XB_XGEN(j)  (2304 + 64 * (j))
#define XB_TOP      3328
#define XB_TOPGEN   3392
#define XCD_BAR_WORDS 3456
#define XB_SPIN_CAP (1u << 18)

__device__ __forceinline__ unsigned xb_ld(unsigned* p)              { return __hip_atomic_load(p, __ATOMIC_RELAXED, __HIP_MEMORY_SCOPE_AGENT); }
__device__ __forceinline__ unsigned xb_add(unsigned* p, unsigned v) { return __hip_atomic_fetch_add(p, v, __ATOMIC_RELAXED, __HIP_MEMORY_SCOPE_AGENT); }
__device__ __forceinline__ unsigned xb_xcc_id() { return (unsigned)__builtin_amdgcn_s_getreg((3 << 11) | 20) & 0xFu; }
#define XB_SPIN(cond, bar) do { unsigned _sp = 0; while (cond) { __builtin_amdgcn_s_sleep(1); \
    if ((++_sp & 255u) == 0u) { if (xb_ld(&(bar)[XB_TMO])) break; if (_sp > XB_SPIN_CAP) { atomicAdd(&(bar)[XB_TMO], 1u); break; } } } } while (0)

struct XcdBarrier {
    unsigned* bar; unsigned x;
    volatile LAS unsigned* st;
};

__device__ __forceinline__ XcdBarrier xcd_barrier_post(unsigned* bar, volatile LAS unsigned* st) {
    XcdBarrier b; b.bar = bar; b.x = xb_xcc_id(); b.st = st;
    if (threadIdx.x == 0) (void)xb_add(&bar[XB_XCNT(b.x)], 1u);
    return b;
}
__device__ __forceinline__ void xcd_barrier_complete(unsigned* bar, unsigned x, unsigned& nloc, unsigned& nx) {
    const unsigned G = gridDim.x * gridDim.y * gridDim.z;
    unsigned sum, cnt, mine, sp = 0u;
    for (;;) {
        sum = 0u; cnt = 0u; mine = 0u;
#pragma unroll
        for (unsigned j = 0; j < 16; ++j) { const unsigned c = xb_ld(&bar[XB_XCNT(j)]); sum += c; cnt += (c > 0u) ? 1u : 0u; mine = (j == x) ? c : mine; }
        if (sum == G) break;
        __builtin_amdgcn_s_sleep(1);
        if ((++sp & 255u) == 0u) { if (xb_ld(&bar[XB_TMO])) break; if (sp > XB_SPIN_CAP) { atomicAdd(&bar[XB_TMO], 1u); break; } }
    }
    nloc = mine > 0u ? mine : 1u; nx = cnt > 0u ? cnt : 1u;
}

__device__ __forceinline__ void xcd_barrier(const XcdBarrier& b) {
    asm volatile("s_waitcnt vmcnt(0)" ::: "memory");
    __syncthreads();
    if (threadIdx.x == 0) {
        unsigned* bar = b.bar;
        __builtin_amdgcn_s_waitcnt(0);
        unsigned nloc = b.st[0], nx = b.st[1];
        if (nloc == 0u) { xcd_barrier_complete(bar, b.x, nloc, nx); b.st[0] = nloc; b.st[1] = nx; }
        const unsigned old = xb_add(&bar[XB_XSUB(b.x)], 1u);
        const unsigned gen = old / nloc;
        if (old + 1u == (gen + 1u) * nloc) {
            __builtin_amdgcn_fence(__ATOMIC_RELEASE, "agent");
            asm volatile("s_waitcnt vmcnt(0)" ::: "memory");
            const unsigned og = xb_add(&bar[XB_TOP], 1u);
            const unsigned tg = og / nx;
            if (og + 1u == (tg + 1u) * nx) xb_add(&bar[XB_TOPGEN], 1u);
            else XB_SPIN(xb_ld(&bar[XB_TOPGEN]) == tg, bar);
            __builtin_amdgcn_fence(__ATOMIC_ACQUIRE, "agent");
            xb_add(&bar[XB_XGEN(b.x)], 1u);
            asm volatile("s_waitcnt vmcnt(0)" ::: "memory");
        } else {
            XB_SPIN(xb_ld(&bar[XB_XGEN(b.x)]) == gen, bar);
            __builtin_amdgcn_fence(__ATOMIC_ACQUIRE, "agent");
            asm volatile("s_waitcnt vmcnt(0)" ::: "memory");
        }
    }
    __syncthreads();
}

template <int MODE  >
__device__ __forceinline__ void transpose_item(const float* __restrict__ W, int K, int N, bf16_t* __restrict__ WT, const float* __restrict__ gain, float* scr, int item, int lane) {
    const int nblk = N / 32, kb = item / nblk, nb = item % nblk, k0 = 64 * kb, n0 = 32 * nb;
#pragma unroll
    for (int i = 0; i < 8; ++i) { const int kk = 8 * i + (lane >> 3), n4 = (lane & 7) * 4; f32x4 v = *(const f32x4*)(W + (size_t)(k0 + kk) * N + n0 + n4);
        if (gain) { const float g = gain[k0 + kk]; v = v * g; }
        float* s = scr + kk * 33 + n4; s[0] = v[0]; s[1] = v[1]; s[2] = v[2]; s[3] = v[3]; }
    asm volatile("s_waitcnt lgkmcnt(0)" ::: "memory");
    const int c = lane & 7;
#pragma unroll
    for (int j = 0; j < 4; ++j) { const int n = (lane >> 3) + 8 * j; const float* s = scr + (8 * c) * 33 + n;
        u32x4 o; o.x = pk2(s[0 * 33], s[1 * 33]); o.y = pk2(s[2 * 33], s[3 * 33]); o.z = pk2(s[4 * 33], s[5 * 33]); o.w = pk2(s[6 * 33], s[7 * 33]);
        int row = n0 + n;
        if (MODE == 1) { const int f = row & 1023; row = ((f >> 7) << 8) + ((row >> 10) << 7) + (f & 127); }
        *(u32x4*)(WT + (size_t)row * K + k0 + 8 * c) = o; }
    asm volatile("s_waitcnt lgkmcnt(0)" ::: "memory");
}
template <int MODE>
__device__ __forceinline__ void transpose_item_fp8(const float* __restrict__ W, int K, int N, unsigned char* __restrict__ WT, float* scr, int item, int lane) {
    const int nblk = N / 32, kb = item / nblk, nb = item % nblk, k0 = 64 * kb, n0 = 32 * nb;
#pragma unroll
    for (int i = 0; i < 8; ++i) { const int kk = 8 * i + (lane >> 3), n4 = (lane & 7) * 4; const f32x4 v = *(const f32x4*)(W + (size_t)(k0 + kk) * N + n0 + n4) * W8_SCALE;
        float* s = scr + kk * 33 + n4; s[0] = v[0]; s[1] = v[1]; s[2] = v[2]; s[3] = v[3]; }
    asm volatile("s_waitcnt lgkmcnt(0)" ::: "memory");
    const int c = lane & 7;
#pragma unroll
    for (int j = 0; j < 4; ++j) { const int n = (lane >> 3) + 8 * j; const float* s = scr + (8 * c) * 33 + n;
        u32x2 o; o.x = pk4_fp8(s[0 * 33], s[1 * 33], s[2 * 33], s[3 * 33]); o.y = pk4_fp8(s[4 * 33], s[5 * 33], s[6 * 33], s[7 * 33]);
        int row = n0 + n;
        if (MODE == 1) { const int f = row & 1023; row = ((f >> 7) << 8) + ((row >> 10) << 7) + (f & 127); }
        *(u32x2*)(WT + (size_t)row * K + k0 + 8 * c) = o; }
    asm volatile("s_waitcnt lgkmcnt(0)" ::: "memory");
}
__device__ __forceinline__ void phase_prologue(const Params& p, unsigned char* lds) {
    const int tid = threadIdx.x, lane = tid & 63, wave = tid >> 6;
    float* scr = (float*)(lds + wave * 16384);
    const int gw = blockIdx.x * NWAVES + wave, NGW = gridDim.x * NWAVES;
    unsigned char* ws = p.ws;
    constexpr int I_WIN = (DM / 64) * (INC / 32), I_UQ = (QLORA / 64) * (768 / 32), I_UKV = (KVLORA / 64) * (1024 / 32), I_OM = (512 / 64) * (DM / 32), I_OC = I_OM, I_WO = (DM / 64) * (DM / 32);
    constexpr int I_W1 = (DM / 64) * (2048 / 32), I_W2 = (DFF / 64) * (DM / 32);
    constexpr int NSMALL = I_WIN + I_UQ + I_UKV + I_OM + I_OC + I_WO;
    constexpr int NITEMS = NSMALL + NE * (I_W1 + I_W2);
    for (int it = gw; it < NITEMS; it += NGW) {
        int r = it;
        if (r < I_WIN) { transpose_item<0>(p.w_in, DM, INC, (bf16_t*)(ws + WS_WIN), p.norm1_g, scr, r, lane); continue; } r -= I_WIN;
        if (r < I_UQ) { transpose_item<0>(p.w_uq, QLORA, 768, (bf16_t*)(ws + WS_WUQ), p.q_a_g, scr, r, lane); continue; } r -= I_UQ;
        if (r < I_UKV) { transpose_item<0>(p.w_ukv, KVLORA, 1024, (bf16_t*)(ws + WS_WUKV), p.kv_a_g, scr, r, lane); continue; } r -= I_UKV;
        if (r < I_OM) { transpose_item<0>(p.w_o_mla, 512, DM, (bf16_t*)(ws + WS_WOMLA), nullptr, scr, r, lane); continue; } r -= I_OM;
        if (r < I_OC) { transpose_item<0>(p.w_o_conv, 512, DM, (bf16_t*)(ws + WS_WOCONV), nullptr, scr, r, lane); continue; } r -= I_OC;
        if (r < I_WO) { transpose_item<0>(p.w_o, DM, DM, (bf16_t*)(ws + WS_WO), nullptr, scr, r, lane); continue; } r -= I_WO;
        const int e = r / (I_W1 + I_W2); r -= e * (I_W1 + I_W2);
        if (r < I_W1) transpose_item_fp8<1>(p.w1 + (size_t)e * DM * 2048, DM, 2048, ws + WS_W1 + (size_t)e * 2048 * DM, scr, r, lane);
        else transpose_item_fp8<0>(p.w2 + (size_t)e * DFF * DM, DFF, DM, ws + WS_W2 + (size_t)e * DM * DFF, scr, r - I_W1, lane);
    }
    { u32x4* z = (u32x4*)((bf16_t*)(ws + WS_WIN) + (size_t)INC * DM); const int nz = (INCP - INC) * DM * 2 / 16;
      for (int i = blockIdx.x * NTHREADS + tid; i < nz; i += gridDim.x * NTHREADS) z[i] = (u32x4){0u, 0u, 0u, 0u}; }
    { int* rt = (int*)(ws + WS_RT2); int* rs = (int*)(ws + WS_RT2 + 4 * MiB); float* rr = (float*)(ws + WS_RT2 + 6 * MiB);
      for (int i = blockIdx.x * NTHREADS + tid; i < NE * CAP; i += gridDim.x * NTHREADS) { rt[i] = 0; rs[i] = -1; rr[i] = 0.f; } }
    { u32x4* GF = (u32x4*)(ws + WS_GF);
      for (int i = blockIdx.x * NTHREADS + tid; i < 64 * 64; i += gridDim.x * NTHREADS) { const int ks = i >> 6, ln = i & 63, r = ln & 31, h = ln >> 5; float v[8], lo[8]; unsigned hi[4];
#pragma unroll
          for (int j = 0; j < 8; ++j) { const int k = 16 * ks + 8 * h + j; v[j] = p.norm2_g[k] * p.router_w[(size_t)k * NE + r]; }
#pragma unroll
          for (int j = 0; j < 4; ++j) { hi[j] = pk2(v[2 * j], v[2 * j + 1]); lo[2 * j] = v[2 * j] - bf_lo(hi[j]); lo[2 * j + 1] = v[2 * j + 1] - bf_hi(hi[j]); }
          GF[(ks * 2 + 0) * 64 + ln] = (u32x4){hi[0], hi[1], hi[2], hi[3]}; GF[(ks * 2 + 1) * 64 + ln] = (u32x4){pk2(lo[0], lo[1]), pk2(lo[2], lo[3]), pk2(lo[4], lo[5]), pk2(lo[6], lo[7])}; } }
    bf16_t* XN = (bf16_t*)(ws + WS_XN);
    for (int m = gw; m < NTOK; m += NGW) {
        const f32x4* xr = (const f32x4*)(p.x + (size_t)m * DM) + lane; f32x4 v[4]; float s = 0.f;
#pragma unroll
        for (int j = 0; j < 4; ++j) { v[j] = xr[64 * j]; s += (v[j][0] * v[j][0] + v[j][1] * v[j][1]) + (v[j][2] * v[j][2] + v[j][3] * v[j][3]); }
        const float rstd = rsqrtf(wave_sum(s) * (1.f / DM) + EPS);
        u32x2* o = (u32x2*)(XN + (size_t)m * DM) + lane;
#pragma unroll
        for (int j = 0; j < 4; ++j) { u32x2 w; w.x = pk2(v[j][0] * rstd, v[j][1] * rstd); w.y = pk2(v[j][2] * rstd, v[j][3] * rstd); o[64 * j] = w; }
    }
}

constexpr float QSCALE = 0.10206207261596575f * 1.4426950408889634f;
struct TokRaw { u32x2 cq; unsigned ckv; u32x4 u[3], c[3], bg, qa, ka, va; unsigned q1, q2, k1, k2; float pos, m0, m2; };
__device__ __forceinline__ void tokb_load(TokRaw& r, const Params& p, int t, int lane, int h, int sub) {
    const bf16_t* PROJ = (const bf16_t*)(p.ws + WS_PROJ); const bf16_t* pr = PROJ + (size_t)t * INCP; const int s = t & (SEQ - 1);
    r.pos = (float)p.pos[t];
    r.cq = *(const u32x2*)(pr + OFF_CQ + 4 * lane); r.ckv = *(const unsigned*)(pr + OFF_CKV + 2 * lane);
    r.m0 = s > 0 ? 1.f : 0.f; r.m2 = s < SEQ - 1 ? 1.f : 0.f;
    const bf16_t* pm = s > 0 ? pr - INCP : pr; const bf16_t* pp = s < SEQ - 1 ? pr + INCP : pr;
    r.u[0] = *(const u32x4*)(pm + OFF_U + 8 * lane); r.c[0] = *(const u32x4*)(pm + OFF_C + 8 * lane);
    r.u[1] = *(const u32x4*)(pr + OFF_U + 8 * lane); r.c[1] = *(const u32x4*)(pr + OFF_C + 8 * lane);
    r.u[2] = *(const u32x4*)(pp + OFF_U + 8 * lane); r.c[2] = *(const u32x4*)(pp + OFF_C + 8 * lane);
    r.bg = *(const u32x4*)(pr + OFF_B + 8 * lane);
    const bf16_t* qp = (const bf16_t*)(p.ws + WS_QPRE) + (size_t)t * 768 + h * DQK; r.qa = *(const u32x4*)(qp + sub * 8); r.q1 = *(const unsigned*)(qp + 64 + 2 * sub); r.q2 = *(const unsigned*)(qp + 80 + 2 * sub);
    const bf16_t* kp = (const bf16_t*)(p.ws + WS_KVPRE) + (size_t)t * 1024 + h * 128; r.ka = *(const u32x4*)(kp + sub * 8); r.va = *(const u32x4*)(kp + 64 + sub * 8);
    const bf16_t* kr = pr + OFF_KR; r.k1 = *(const unsigned*)(kr + 2 * sub); r.k2 = *(const unsigned*)(kr + 16 + 2 * sub);
}
__device__ __forceinline__ void mulpair8(const u32x4 u, const u32x4 c, float (&o)[8]) {
    o[0] = bf_lo(u.x) * bf_lo(c.x); o[1] = bf_hi(u.x) * bf_hi(c.x); o[2] = bf_lo(u.y) * bf_lo(c.y); o[3] = bf_hi(u.y) * bf_hi(c.y);
    o[4] = bf_lo(u.z) * bf_lo(c.z); o[5] = bf_hi(u.z) * bf_hi(c.z); o[6] = bf_lo(u.w) * bf_lo(c.w); o[7] = bf_hi(u.w) * bf_hi(c.w); }
__device__ __forceinline__ void tokb_compute(const TokRaw& r, const Params& p, int t, int lane, int h, int sub, const float (&qg)[12], const float (&kg)[12], float if0, float if1,
                                             const float (&cw0)[8], const float (&cw1)[8], const float (&cw2)[8]) {
    bf16_t* Q = (bf16_t*)(p.ws + WS_Q); bf16_t* Kb = (bf16_t*)(p.ws + WS_K); bf16_t* V = (bf16_t*)(p.ws + WS_V); bf16_t* YB = (bf16_t*)(p.ws + WS_YBIN);
    const int b = t >> 13, s = t & (SEQ - 1);
    float rs_q, rs_kv;
    { const float a = bf_lo(r.cq.x), bq = bf_hi(r.cq.x), c = bf_lo(r.cq.y), d = bf_hi(r.cq.y); rs_q = rsqrtf(wave_sum(a * a + bq * bq + c * c + d * d) * (1.f / QLORA) + EPS); }
    { const float a = bf_lo(r.ckv), bq = bf_hi(r.ckv); rs_kv = rsqrtf(wave_sum(a * a + bq * bq) * (1.f / KVLORA) + EPS); }
    { float cu0[8], cu1[8], cu2[8], bb[8]; mulpair8(r.u[0], r.c[0], cu0); mulpair8(r.u[1], r.c[1], cu1); mulpair8(r.u[2], r.c[2], cu2);
      bb[0] = bf_lo(r.bg.x); bb[1] = bf_hi(r.bg.x); bb[2] = bf_lo(r.bg.y); bb[3] = bf_hi(r.bg.y); bb[4] = bf_lo(r.bg.z); bb[5] = bf_hi(r.bg.z); bb[6] = bf_lo(r.bg.w); bb[7] = bf_hi(r.bg.w); float y[8];
#pragma unroll
      for (int j = 0; j < 8; ++j) y[j] = bb[j] * (cw0[j] * r.m0 * cu0[j] + cw1[j] * cu1[j] + cw2[j] * r.m2 * cu2[j]);
      u32x4 o; o.x = pk2(y[0], y[1]); o.y = pk2(y[2], y[3]); o.z = pk2(y[4], y[5]); o.w = pk2(y[6], y[7]); *(u32x4*)(YB + (size_t)t * CONVW + 8 * lane) = o; }
    float c0, s0, c1, s1; sincosf(r.pos * if0, &s0, &c0); sincosf(r.pos * if1, &s1, &c1);
    const size_t rowi = ((size_t)(b * NH + h) * SEQ + s);
    { float v[12] = {bf_lo(r.qa.x), bf_hi(r.qa.x), bf_lo(r.qa.y), bf_hi(r.qa.y), bf_lo(r.qa.z), bf_hi(r.qa.z), bf_lo(r.qa.w), bf_hi(r.qa.w), bf_lo(r.q1), bf_hi(r.q1), bf_lo(r.q2), bf_hi(r.q2)}; float ss = 0.f;
#pragma unroll
      for (int j = 0; j < 12; ++j) { v[j] *= rs_q; ss += v[j] * v[j]; }
      ss += __shfl_xor(ss, 1); ss += __shfl_xor(ss, 2); ss += __shfl_xor(ss, 4);
      const float rstd = rsqrtf(ss * (1.f / DQK) + EPS);
#pragma unroll
      for (int j = 0; j < 12; ++j) v[j] *= rstd * qg[j] * QSCALE;
      const float o8 = v[8] * c0 - v[10] * s0, o9 = v[9] * c1 - v[11] * s1, o10 = v[8] * s0 + v[10] * c0, o11 = v[9] * s1 + v[11] * c1;
      bf16_t* qo = Q + rowi * DQK; u32x4 w; w.x = pk2(v[0], v[1]); w.y = pk2(v[2], v[3]); w.z = pk2(v[4], v[5]); w.w = pk2(v[6], v[7]);
      *(u32x4*)(qo + sub * 8) = w; *(unsigned*)(qo + 64 + 2 * sub) = pk2(o8, o9); *(unsigned*)(qo + 80 + 2 * sub) = pk2(o10, o11); }
    { float v[12] = {bf_lo(r.ka.x) * rs_kv, bf_hi(r.ka.x) * rs_kv, bf_lo(r.ka.y) * rs_kv, bf_hi(r.ka.y) * rs_kv, bf_lo(r.ka.z) * rs_kv, bf_hi(r.ka.z) * rs_kv, bf_lo(r.ka.w) * rs_kv, bf_hi(r.ka.w) * rs_kv,
                   bf_lo(r.k1), bf_hi(r.k1), bf_lo(r.k2), bf_hi(r.k2)}; float ss = 0.f;
#pragma unroll
      for (int j = 0; j < 12; ++j) ss += v[j] * v[j];
      ss += __shfl_xor(ss, 1); ss += __shfl_xor(ss, 2); ss += __shfl_xor(ss, 4);
      const float rstd = rsqrtf(ss * (1.f / DQK) + EPS);
#pragma unroll
      for (int j = 0; j < 12; ++j) v[j] *= rstd * kg[j];
      const float o8 = v[8] * c0 - v[10] * s0, o9 = v[9] * c1 - v[11] * s1, o10 = v[8] * s0 + v[10] * c0, o11 = v[9] * s1 + v[11] * c1;
      bf16_t* ko = Kb + rowi * 128; u32x4 w; w.x = pk2(v[0], v[1]); w.y = pk2(v[2], v[3]); w.z = pk2(v[4], v[5]); w.w = pk2(v[6], v[7]);
      *(u32x4*)(ko + sub * 8) = w; *(unsigned*)(ko + 64 + 2 * sub) = pk2(o8, o9); *(unsigned*)(ko + 80 + 2 * sub) = pk2(o10, o11);
      if (sub < 4) *(u32x4*)(ko + 96 + sub * 8) = (u32x4){0u, 0u, 0u, 0u};
      u32x4 wv; wv.x = pk2(bf_lo(r.va.x) * rs_kv, bf_hi(r.va.x) * rs_kv); wv.y = pk2(bf_lo(r.va.y) * rs_kv, bf_hi(r.va.y) * rs_kv); wv.z = pk2(bf_lo(r.va.z) * rs_kv, bf_hi(r.va.z) * rs_kv); wv.w = pk2(bf_lo(r.va.w) * rs_kv, bf_hi(r.va.w) * rs_kv);
      *(u32x4*)(V + rowi * DV + sub * 8) = wv; }
}
__device__ __forceinline__ void phase_tok_b(const Params& p) {
    const int tid = threadIdx.x, lane = tid & 63, wave = tid >> 6, h = lane >> 3, sub = lane & 7;
    const int gw = blockIdx.x * NWAVES + wave, NGW = gridDim.x * NWAVES;
    float qg[12], kg[12];
#pragma unroll
    for (int j = 0; j < 8; ++j) { qg[j] = p.q_g[sub * 8 + j]; kg[j] = p.k_g[sub * 8 + j]; }
    qg[8] = p.q_g[64 + 2 * sub]; qg[9] = p.q_g[65 + 2 * sub]; qg[10] = p.q_g[80 + 2 * sub]; qg[11] = p.q_g[81 + 2 * sub];
    kg[8] = p.k_g[64 + 2 * sub]; kg[9] = p.k_g[65 + 2 * sub]; kg[10] = p.k_g[80 + 2 * sub]; kg[11] = p.k_g[81 + 2 * sub];
    const float if0 = exp2f(-(float)(2 * sub) * (13.287712379549449f / 16.f)), if1 = exp2f(-(float)(2 * sub + 1) * (13.287712379549449f / 16.f));
    float cw0[8], cw1[8], cw2[8];
#pragma unroll
    for (int j = 0; j < 8; ++j) { cw0[j] = p.conv_w[8 * lane + j]; cw1[j] = p.conv_w[CONVW + 8 * lane + j]; cw2[j] = p.conv_w[2 * CONVW + 8 * lane + j]; }
    for (int t = gw; t < NTOK; t += 2 * NGW) {
        const int t1 = t + NGW; const bool two = t1 < NTOK;
        TokRaw r0, r1; tokb_load(r0, p, t, lane, h, sub); tokb_load(r1, p, two ? t1 : t, lane, h, sub);
        tokb_compute(r0, p, t, lane, h, sub, qg, kg, if0, if1, cw0, cw1, cw2);
        if (two) tokb_compute(r1, p, t1, lane, h, sub, qg, kg, if0, if1, cw0, cw1, cw2);
    }
}

namespace att {
constexpr int NW = 8, QBLK = 32, KVBLK = 64;
constexpr float SCALE = 0.10206207261596575f;
constexpr float QSC = SCALE * 1.4426950408889634f;
constexpr int LDQ = DQK, LDK = 128, LDV = DV;
constexpr int SHM_V = KVBLK * DV * 2, SHM_K = KVBLK * 256, SHM_ATTN = 2 * SHM_V + 2 * SHM_K + NW * 64 * 4;
#define KSWZ(row, colB) ((row) * 256 + ((colB) ^ (((row) & 7) << 4)))
#define SBAR() __builtin_amdgcn_sched_barrier(0)
__device__ __forceinline__ int crow(int r, int hi) { return (r & 3) + 8 * (r >> 2) + 4 * hi; }
__device__ __forceinline__ unsigned cvtpk(float lo, float hi) { unsigned r; asm volatile("v_cvt_pk_bf16_f32 %0, %1, %2" : "=v"(r) : "v"(lo), "v"(hi)); return r; }
#define EXPH(P) do { _Pragma("unroll") for (int r = 0; r < 16; ++r) P[r] = __builtin_amdgcn_exp2f(P[r]); } while (0)
__device__ __forceinline__ void finishSM(f32x16& p0, f32x16& p1, float& l_reg, bf16x8& pa0, bf16x8& pa1, bf16x8& pa2, bf16x8& pa3) {
    EXPH(p1);
    float ps0 = 0.f, ps1 = 0.f;
#pragma unroll
    for (int r = 0; r < 16; ++r) { ps0 += p0[r]; ps1 += p1[r]; }
    l_reg += ps0 + ps1;
#define PK4(P, BASE, OUT) do { unsigned a0 = cvtpk(P[BASE + 0], P[BASE + 1]), a1 = cvtpk(P[BASE + 2], P[BASE + 3]);   \
    unsigned b0 = cvtpk(P[BASE + 4], P[BASE + 5]), b1 = cvtpk(P[BASE + 6], P[BASE + 7]);                              \
    auto r0 = __builtin_amdgcn_permlane32_swap(a0, b0, false, false); auto r1 = __builtin_amdgcn_permlane32_swap(a1, b1, false, false); \
    u32x4 w = {r0[0], r1[0], r0[1], r1[1]}; OUT = *reinterpret_cast<bf16x8*>(&w); } while (0)
    PK4(p0, 0, pa0); PK4(p0, 8, pa1); PK4(p1, 0, pa2); PK4(p1, 8, pa3);
#undef PK4
}
__device__ __forceinline__ void qkt(f32x16& p0, f32x16& p1, const unsigned char* Ks, const bf16x8* qr, int r32, int hi) {
    p0 = f32x16{}; p1 = f32x16{};
#pragma unroll
    for (int d0 = 0; d0 < 6; ++d0) { const int cb = (d0 * 16 + hi * 8) * 2;
        const bf16x8 b0 = *reinterpret_cast<const bf16x8*>(Ks + KSWZ(r32, cb));
        const bf16x8 b1 = *reinterpret_cast<const bf16x8*>(Ks + KSWZ(32 + r32, cb));
        p0 = __builtin_amdgcn_mfma_f32_32x32x16_bf16(b0, qr[d0], p0, 0, 0, 0);
        p1 = __builtin_amdgcn_mfma_f32_32x32x16_bf16(b1, qr[d0], p1, 0, 0, 0); }
}
__device__ __forceinline__ int v_st(int k, int c) { const int kk = (k & ~0xC) | ((k & 4) << 1) | ((k & 8) >> 1); return ((kk >> 3) * 2 + (c >> 5)) * 512 + ((kk & 7) * 32 + (c & 31)) * 2; }
__device__ __forceinline__ int v_rd_base(int lane) { return ((lane & 3) << 3) | (((lane >> 2) & 3) << 6) | (((lane >> 4) & 1) << 5) | (((lane >> 5) & 1) << 8); }
constexpr int v_rd_off(int d0, int ks, int half) { return d0 * 512 + ks * 2048 + half * 1024; }
template <int OFF> __device__ __forceinline__ s16x4 tr_read(int vb) { s16x4 r; asm volatile("ds_read_b64_tr_b16 %0, %1 offset:%2" : "=&v"(r) : "v"(vb), "i"(OFF) : "memory"); return r; }
template <int D0> __device__ __forceinline__ void pv_one(f32x16& od, int vb, bf16x8 pa0, bf16x8 pa1, bf16x8 pa2, bf16x8 pa3) {
    const s16x4 l0 = tr_read<v_rd_off(D0, 0, 0)>(vb), h0 = tr_read<v_rd_off(D0, 0, 1)>(vb), l1 = tr_read<v_rd_off(D0, 1, 0)>(vb), h1 = tr_read<v_rd_off(D0, 1, 1)>(vb);
    const s16x4 l2 = tr_read<v_rd_off(D0, 2, 0)>(vb), h2 = tr_read<v_rd_off(D0, 2, 1)>(vb), l3 = tr_read<v_rd_off(D0, 3, 0)>(vb), h3 = tr_read<v_rd_off(D0, 3, 1)>(vb);
    asm volatile("s_waitcnt lgkmcnt(0)" ::: "memory"); SBAR();
#define PK(L, H) (bf16x8){L[0], L[1], L[2], L[3], H[0], H[1], H[2], H[3]}
    __builtin_amdgcn_s_setprio(1);
    od = __builtin_amdgcn_mfma_f32_32x32x16_bf16(pa0, PK(l0, h0), od, 0, 0, 0);
    od = __builtin_amdgcn_mfma_f32_32x32x16_bf16(pa1, PK(l1, h1), od, 0, 0, 0);
    od = __builtin_amdgcn_mfma_f32_32x32x16_bf16(pa2, PK(l2, h2), od, 0, 0, 0);
    od = __builtin_amdgcn_mfma_f32_32x32x16_bf16(pa3, PK(l3, h3), od, 0, 0, 0);
    __builtin_amdgcn_s_setprio(0);
#undef PK
}
__device__ __forceinline__ void pv_d0(f32x16* o, int vb, bf16x8 pa0, bf16x8 pa1, bf16x8 pa2, bf16x8 pa3) { pv_one<0>(o[0], vb, pa0, pa1, pa2, pa3); pv_one<1>(o[1], vb, pa0, pa1, pa2, pa3); }

__device__ __forceinline__ void attn_unit(const bf16_t* __restrict__ Qb, const bf16_t* __restrict__ Kh, const bf16_t* __restrict__ Vh, bf16_t* __restrict__ Ob, int seq, unsigned char* lds) {
    const int tid = threadIdx.x, wid = __builtin_amdgcn_readfirstlane(tid >> 6), lane = tid & 63, r32 = lane & 31, hi = lane >> 5;
    unsigned char* V_lds = lds; unsigned char* K_lds = lds + 2 * SHM_V;
    float* wsf = (float*)(lds + 2 * SHM_V + 2 * SHM_K) + wid * 64; float* li_l = wsf;
    float l_reg = 0; f32x16 o[2] = {}; bf16x8 qr[6];
    const bf16_t* Qw = Qb + (size_t)(wid * QBLK + r32) * LDQ + hi * 8;
#pragma unroll
    for (int d0 = 0; d0 < 6; ++d0) qr[d0] = *reinterpret_cast<const bf16x8*>(Qw + d0 * 16);
    const int kr0 = 8 * wid + (lane >> 4), kcp = lane & 15;
    const bf16_t* ksrc0 = Kh + (size_t)kr0 * LDK + ((kcp ^ (kr0 & 7)) * 8);
    const bf16_t* ksrc1 = Kh + (size_t)(kr0 + 4) * LDK + ((kcp ^ ((kr0 + 4) & 7)) * 8);
    const int vkk = 8 * wid + ((lane >> 2) & 7), vk = (vkk & ~0xC) | ((vkk & 4) << 1) | ((vkk & 8) >> 1), vcc = 32 * (lane >> 5) + 8 * (lane & 3);
    const bf16_t* vsrc = Vh + (size_t)vk * LDV + vcc;
    typedef __attribute__((address_space(3))) unsigned* lds_u32p;
#define DMA_K(t, slot) do { __builtin_amdgcn_global_load_lds((const unsigned*)(ksrc0 + (size_t)(t) * KVBLK * LDK), (lds_u32p)(K_lds + (slot) * SHM_K + wid * 2048 + lane * 16), 16, 0, 0); \
                            __builtin_amdgcn_global_load_lds((const unsigned*)(ksrc1 + (size_t)(t) * KVBLK * LDK), (lds_u32p)(K_lds + (slot) * SHM_K + wid * 2048 + 1024 + lane * 16), 16, 0, 0); } while (0)
#define DMA_V(t, slot) __builtin_amdgcn_global_load_lds((const unsigned*)(vsrc + (size_t)(t) * KVBLK * LDV), (lds_u32p)(V_lds + (slot) * SHM_V + wid * 1024 + lane * 16), 16, 0, 0)
    const int vb0 = (int)(uintptr_t)V_lds + v_rd_base(lane);
    f32x16 pA0, pA1, pB0, pB1; bf16x8 pa0, pa1, pa2, pa3; const int NT = seq / KVBLK;
    DMA_K(0, 0); DMA_V(0, 0); DMA_K(1, 1);
    asm volatile("s_waitcnt vmcnt(0)" ::: "memory"); __syncthreads();
    qkt(pA0, pA1, K_lds, qr, r32, hi); EXPH(pA0); SBAR();
    __syncthreads();
    for (int j = 0; j + 2 < NT; j += 2) {
        DMA_K(j + 2, 0); DMA_V(j + 1, 1); SBAR();
        qkt(pB0, pB1, K_lds + SHM_K, qr, r32, hi);
        finishSM(pA0, pA1, l_reg, pa0, pa1, pa2, pa3); SBAR();
        pv_d0(o, vb0, pa0, pa1, pa2, pa3); EXPH(pB0); SBAR();
        asm volatile("s_waitcnt vmcnt(0)" ::: "memory"); __syncthreads();
        DMA_K(j + 3, 1); DMA_V(j + 2, 0); SBAR();
        qkt(pA0, pA1, K_lds, qr, r32, hi);
        finishSM(pB0, pB1, l_reg, pa0, pa1, pa2, pa3); SBAR();
        pv_d0(o, vb0 + SHM_V, pa0, pa1, pa2, pa3); EXPH(pA0); SBAR();
        asm volatile("s_waitcnt vmcnt(0)" ::: "memory"); __syncthreads();
    }
    DMA_V(NT - 1, 1); SBAR();
    qkt(pB0, pB1, K_lds + SHM_K, qr, r32, hi);
    finishSM(pA0, pA1, l_reg, pa0, pa1, pa2, pa3); SBAR();
    pv_d0(o, vb0, pa0, pa1, pa2, pa3); EXPH(pB0); SBAR();
    asm volatile("s_waitcnt vmcnt(0)" ::: "memory"); __syncthreads();
    finishSM(pB0, pB1, l_reg, pa0, pa1, pa2, pa3); SBAR();
    pv_d0(o, vb0 + SHM_V, pa0, pa1, pa2, pa3);
    { auto rr = __builtin_amdgcn_permlane32_swap(__float_as_uint(l_reg), __float_as_uint(l_reg), false, false); l_reg = __uint_as_float(rr[0]) + __uint_as_float(rr[1]); }
    if (hi == 0) li_l[r32] = l_reg; asm volatile("s_waitcnt lgkmcnt(0)" ::: "memory");
    float rli[16];
#pragma unroll
    for (int r = 0; r < 16; ++r) rli[r] = __builtin_amdgcn_rcpf(li_l[crow(r, hi)]);
    bf16_t* Ow = Ob + (size_t)(wid * QBLK) * 512;
#pragma unroll
    for (int r = 0; r < 16; ++r) { const int orow = crow(r, hi);
#pragma unroll
        for (int d0 = 0; d0 < 2; ++d0) Ow[(size_t)orow * 512 + d0 * 32 + r32] = (bf16_t)(pk2(o[d0][r] * rli[r], 0.f) & 0xffffu); }
    __syncthreads();
#undef DMA_K
#undef DMA_V
}
#undef KSWZ
#undef SBAR
}

__device__ __forceinline__ void phase_attn(const Params& p, unsigned char* lds) {
    const bf16_t* Q = (const bf16_t*)(p.ws + WS_Q); const bf16_t* Kb = (const bf16_t*)(p.ws + WS_K); const bf16_t* V = (const bf16_t*)(p.ws + WS_V); bf16_t* AO = (bf16_t*)(p.ws + WS_AO);
    constexpr int NQB = SEQ / 256, NU = 2 * NH * NQB;
    for (int u = blockIdx.x; u < NU; u += gridDim.x) {
        const int qb = u % NQB, h = (u / NQB) % NH, b = u / (NQB * NH); const size_t bh = (size_t)(b * NH + h) * SEQ;
        att::attn_unit(Q + (bh + (size_t)qb * 256) * DQK, Kb + bh * 128, V + bh * DV, AO + ((size_t)b * SEQ + (size_t)qb * 256) * 512 + h * DV, SEQ, lds);
    }
}

__device__ __forceinline__ int crow16(int r, int hi) { return (r & 3) + 8 * (r >> 2) + 4 * hi; }
__device__ __forceinline__ void phase_router(const Params& p, unsigned char* lds) {
    const int tid = threadIdx.x, lane = tid & 63, wid = tid >> 6, tile = wid >> 2, kq = wid & 3, c = lane & 31, h = lane >> 5;
    float* red = (float*)lds;
    float* ssb = red + 2 * 4 * 16 * 64;
    int* lcnt = (int*)(ssb + 2 * 4 * 64);
    int* lbase = lcnt + 32;
    unsigned* gcnt = (unsigned*)(p.ws + WS_CTL) + CW_CNT;
    int* row_tok = (int*)(p.ws + WS_RT2); float* row_w = (float*)(p.ws + WS_RT2 + 2 * MiB); int* row_slot = (int*)(p.ws + WS_RT2 + 4 * MiB); float* row_rstd = (float*)(p.ws + WS_RT2 + 6 * MiB);
    const u32x4* GF = (const u32x4*)(p.ws + WS_GF);
    for (int tg = blockIdx.x; tg < NTOK / 64; tg += gridDim.x) {
        if (tid < 32) lcnt[tid] = 0;
        const int token = tg * 64 + tile * 32 + c;
        const float* xrow = p.out + (size_t)token * DM + kq * 256 + 8 * h; const float* g2p = p.norm2_g + kq * 256 + 8 * h;
        unsigned char* hrow = p.ws + WS_H8 + (size_t)token * DM + kq * 256 + 8 * h;
        f32x16 acc = {}; float ss = 0.f;
#pragma unroll 2
        for (int s = 0; s < 16; ++s) {
            const f32x4 a = *(const f32x4*)(xrow + 16 * s), b = *(const f32x4*)(xrow + 16 * s + 4); const f32x4 ga = *(const f32x4*)(g2p + 16 * s), gb = *(const f32x4*)(g2p + 16 * s + 4);
            ss += (a[0] * a[0] + a[1] * a[1]) + (a[2] * a[2] + a[3] * a[3]) + (b[0] * b[0] + b[1] * b[1]) + (b[2] * b[2] + b[3] * b[3]);
            u32x4 xh; xh.x = pk2(a[0], a[1]); xh.y = pk2(a[2], a[3]); xh.z = pk2(b[0], b[1]); xh.w = pk2(b[2], b[3]);
            u32x4 xl; xl.x = pk2(a[0] - bf_lo(xh.x), a[1] - bf_hi(xh.x)); xl.y = pk2(a[2] - bf_lo(xh.y), a[3] - bf_hi(xh.y)); xl.z = pk2(b[0] - bf_lo(xh.z), b[1] - bf_hi(xh.z)); xl.w = pk2(b[2] - bf_lo(xh.w), b[3] - bf_hi(xh.w));
            u32x2 h8; h8.x = pk4_fp8(a[0] * ga[0], a[1] * ga[1], a[2] * ga[2], a[3] * ga[3]); h8.y = pk4_fp8(b[0] * gb[0], b[1] * gb[1], b[2] * gb[2], b[3] * gb[3]); *(u32x2*)(hrow + 16 * s) = h8;
            const u32x4 gh = GF[((kq * 16 + s) * 2 + 0) * 64 + lane], gl = GF[((kq * 16 + s) * 2 + 1) * 64 + lane];
            acc = __builtin_amdgcn_mfma_f32_32x32x16_bf16(__builtin_bit_cast(bf16x8, gh), __builtin_bit_cast(bf16x8, xh), acc, 0, 0, 0);
            acc = __builtin_amdgcn_mfma_f32_32x32x16_bf16(__builtin_bit_cast(bf16x8, gh), __builtin_bit_cast(bf16x8, xl), acc, 0, 0, 0);
            acc = __builtin_amdgcn_mfma_f32_32x32x16_bf16(__builtin_bit_cast(bf16x8, gl), __builtin_bit_cast(bf16x8, xh), acc, 0, 0, 0);
        }
#pragma unroll
        for (int r = 0; r < 16; ++r) red[((tile * 4 + kq) * 16 + r) * 64 + lane] = acc[r];
        ssb[(tile * 4 + kq) * 64 + lane] = ss;
        __syncthreads();
        int te[4] = {0, 0, 0, 0}, rl[4] = {0, 0, 0, 0}; float tw[4] = {0.f, 0.f, 0.f, 0.f}; float rstd = 0.f;
        if (kq == 0) {
            float v[16]; float st = 0.f;
#pragma unroll
            for (int q = 0; q < 4; ++q) st += ssb[(tile * 4 + q) * 64 + lane];
            { auto rr = __builtin_amdgcn_permlane32_swap(__float_as_uint(st), __float_as_uint(st), false, false); st = __uint_as_float(rr[0]) + __uint_as_float(rr[1]); }
            rstd = rsqrtf(st * (1.f / DM) + EPS);
#pragma unroll
            for (int r = 0; r < 16; ++r) { float sacc = 0.f;
#pragma unroll
                for (int q = 0; q < 4; ++q) sacc += red[((tile * 4 + q) * 16 + r) * 64 + lane];
                v[r] = sacc * rstd + p.router_b[crow16(r, h)]; }
            float lv[4]; int le[4];
#pragma unroll
            for (int k = 0; k < 4; ++k) { float best = v[0]; int bi = 0;
#pragma unroll
                for (int r = 1; r < 16; ++r) { const bool gt = v[r] > best; best = gt ? v[r] : best; bi = gt ? r : bi; }
                lv[k] = best; le[k] = (bi & 3) + 8 * (bi >> 2) + 4 * h;
#pragma unroll
                for (int r = 0; r < 16; ++r) v[r] = (r == bi) ? -INFINITY : v[r]; }
            float cv[8]; int ce[8];
#pragma unroll
            for (int k = 0; k < 4; ++k) { auto rv = __builtin_amdgcn_permlane32_swap(__float_as_uint(lv[k]), __float_as_uint(lv[k]), false, false); auto re = __builtin_amdgcn_permlane32_swap((unsigned)le[k], (unsigned)le[k], false, false);
                cv[k] = __uint_as_float(rv[0]); cv[4 + k] = __uint_as_float(rv[1]); ce[k] = (int)re[0]; ce[4 + k] = (int)re[1]; }
            float tv[4];
#pragma unroll
            for (int k = 0; k < 4; ++k) { float best = cv[0]; int be = ce[0]; int bi = 0;
#pragma unroll
                for (int r = 1; r < 8; ++r) { const bool gt = (cv[r] > best) || (cv[r] == best && ce[r] < be); best = gt ? cv[r] : best; be = gt ? ce[r] : be; bi = gt ? r : bi; }
                tv[k] = best; te[k] = be;
#pragma unroll
                for (int r = 0; r < 8; ++r) cv[r] = (r == bi) ? -INFINITY : cv[r]; }
            const float e1 = __expf(tv[1] - tv[0]), e2 = __expf(tv[2] - tv[0]), e3 = __expf(tv[3] - tv[0]); const float inv = 1.f / (1.f + e1 + e2 + e3);
            tw[0] = inv; tw[1] = e1 * inv; tw[2] = e2 * inv; tw[3] = e3 * inv;
            if (h == 0) {
#pragma unroll
                for (int k = 0; k < 4; ++k) rl[k] = atomicAdd(&lcnt[te[k]], 1); }
        }
        __syncthreads();
        if (tid < 32) lbase[tid] = (int)atomicAdd(&gcnt[tid], (unsigned)lcnt[tid]);
        __syncthreads();
        if (kq == 0 && h == 0) {
#pragma unroll
            for (int k = 0; k < 4; ++k) { const int idx = te[k] * CAP + lbase[te[k]] + rl[k]; row_tok[idx] = token; row_w[idx] = tw[k]; row_slot[idx] = token * 4 + k; row_rstd[idx] = rstd; } }
        __syncthreads();
    }
}

__device__ __forceinline__ void build_block_table(const Params& p, int* bs) {
    const unsigned* gcnt = (const unsigned*)(p.ws + WS_CTL) + CW_CNT;
    if (threadIdx.x == 0) { int acc = 0; for (int e = 0; e < NE; ++e) { bs[e] = acc; acc += ((int)__hip_atomic_load(gcnt + e, __ATOMIC_RELAXED, __HIP_MEMORY_SCOPE_AGENT) + 255) >> 8; } bs[NE] = acc; }
    __syncthreads();
}

__device__ __forceinline__ pg8::MoeOrder make_moe_order(const Params& p, unsigned char* lds, int N, bool gather) {
    int* bs = (int*)(lds + 131072); int* utab = (int*)(lds + 131072 + 256); int* gtab = (int*)(lds + 131072 + 512);
    build_block_table(p, bs);
    const int nmb = __builtin_amdgcn_readfirstlane(bs[NE]);
    pg8::MoeOrder S; S.so.init(nmb * 256, N, (int)gridDim.x, (int)blockIdx.x); S.utab = (const PG8_LAS int*)utab; S.gtab = (const PG8_LAS int*)gtab;
    const int* row_tok = (const int*)(p.ws + WS_RT2);
    for (int i = 0; i < pg8::MOE_MAXU; ++i) { pg8::Unit u; if (!S.so.next(i, u)) break; int e = 0; for (int k = 1; k < NE; ++k) if (bs[k] <= u.pm) e = k;
        const int rb = e * CAP + (u.pm - bs[e]) * 256;
        if (threadIdx.x == 0) utab[i] = e | (rb << 8);
        if (gather && threadIdx.x < 256) gtab[i * 256 + threadIdx.x] = row_tok[rb + threadIdx.x]; }
    __syncthreads();
    return S;
}
__device__ __forceinline__ void phase_moe1(const Params& p, unsigned char* lds) {
    const pg8::MoeOrder S = make_moe_order(p, lds, 2048, true);
    pg8::Gemm g{(const bf16_t*)(p.ws + WS_H8), (const bf16_t*)(p.ws + WS_W1), 0, 2048, DM / 2, (size_t)2048 * DM, 0};
    pg8::EpiSwiglu E{p.ws + WS_ACT, p.b1, (const float*)(p.ws + WS_RT2 + 6 * MiB)};
    pg8::gemm_phase<pg8::EpiSwiglu, pg8::MoeOrder, true, true, true, true>((PG8_LAS unsigned char*)lds, g, S, E);
}
__device__ __forceinline__ void phase_moe2(const Params& p, unsigned char* lds) {
    const pg8::MoeOrder S = make_moe_order(p, lds, DM, false);
    pg8::Gemm g{(const bf16_t*)(p.ws + WS_ACT), (const bf16_t*)(p.ws + WS_W2), 0, DM, DFF / 2, (size_t)DM * DFF, 0};
    pg8::EpiMoeOut E{(bf16_t*)(p.ws + WS_YS), p.b2, (const float*)(p.ws + WS_RT2 + 2 * MiB), (const int*)(p.ws + WS_RT2 + 4 * MiB)};
    pg8::gemm_phase<pg8::EpiMoeOut, pg8::MoeOrder, true, true, true>((PG8_LAS unsigned char*)lds, g, S, E);
}

__device__ __forceinline__ void phase_combine(const Params& p) {
    const int tid = threadIdx.x, lane = tid & 63, wave = tid >> 6;
    const int gw = blockIdx.x * NWAVES + wave, NGW = gridDim.x * NWAVES;
    const bf16_t* YS = (const bf16_t*)(p.ws + WS_YS);
    for (int t = gw; t < NTOK; t += NGW) {
        f32x4* orow = (f32x4*)(p.out + (size_t)t * DM) + lane;
#pragma unroll
        for (int j = 0; j < 4; ++j) { f32x4 v = orow[64 * j];
#pragma unroll
            for (int k = 0; k < 4; ++k) { const u32x2 w = *((const u32x2*)(YS + ((size_t)t * 4 + k) * DM) + lane + 64 * j); v[0] += bf_lo(w.x); v[1] += bf_hi(w.x); v[2] += bf_lo(w.y); v[3] += bf_hi(w.y); }
            orow[64 * j] = v; }
    }
}

template <class Epi>
__device__ __forceinline__ void dense_gemm(unsigned char* lds, const bf16_t* A, const bf16_t* Bt, int M, int N, int K, const Epi& E, int lda = 0) {
    pg8::Gemm g{A, Bt, M, N, K, 0, lda}; pg8::StaticOrder S; S.init(M, N, (int)gridDim.x, (int)blockIdx.x);
    pg8::gemm_phase<Epi, pg8::StaticOrder, true, true>((PG8_LAS unsigned char*)lds, g, S, E);
}

constexpr int NPHASE = 13;
__global__ void __launch_bounds__(NTHREADS, 2) mk_fwd(Params p) {
    extern __shared__ __attribute__((aligned(16))) unsigned char lds[];
    cg::grid_group grid = cg::this_grid();
    unsigned char* ws = p.ws;
    volatile LAS unsigned* MISC = (volatile LAS unsigned*)((LAS unsigned char*)lds + MISC_OFF);
    if (threadIdx.x < 32) MISC[threadIdx.x] = 0u;
    __syncthreads();
    XcdBarrier bar = xcd_barrier_post((unsigned*)(ws + WS_CTL) + CW_BAR, MISC + 8);
    const int lo = p.ph_lo, hi = p.ph_hi;
    if (lo < 0) grid.sync();
#define IN(k) (lo <= (k) && (k) < hi)
#define SEAM(k) do { if (IN(k) && IN((k) + 1)) xcd_barrier(bar); } while (0)
    if (IN(0)) phase_prologue(p, lds);
    SEAM(0);
    if (IN(1)) { pg8::EpiProj E{(bf16_t*)(ws + WS_PROJ)}; dense_gemm(lds, (const bf16_t*)(ws + WS_XN), (const bf16_t*)(ws + WS_WIN), NTOK, INCP, DM, E); }
    if (IN(1) && IN(3)) xcd_barrier(bar);
    if (IN(3)) { pg8::EpiBf16 Eq{(bf16_t*)(ws + WS_QPRE), 768}; dense_gemm(lds, (const bf16_t*)(ws + WS_PROJ) + OFF_CQ, (const bf16_t*)(ws + WS_WUQ), NTOK, 768, QLORA, Eq, INCP);
                 pg8::EpiBf16 Ek{(bf16_t*)(ws + WS_KVPRE), 1024}; dense_gemm(lds, (const bf16_t*)(ws + WS_PROJ) + OFF_CKV, (const bf16_t*)(ws + WS_WUKV), NTOK, 1024, KVLORA, Ek, INCP); }
    SEAM(3);
    if (IN(4)) phase_tok_b(p);
    SEAM(4);
    if (IN(5)) phase_attn(p, lds);
    SEAM(5);
    if (IN(6)) { pg8::EpiGateA E{(bf16_t*)(ws + WS_M1), (const bf16_t*)(ws + WS_PROJ)}; dense_gemm(lds, (const bf16_t*)(ws + WS_AO), (const bf16_t*)(ws + WS_WOMLA), NTOK, DM, 512, E); }
    if (IN(7)) { pg8::EpiGateB E{(const bf16_t*)(ws + WS_M1), (const bf16_t*)(ws + WS_PROJ), (bf16_t*)(ws + WS_MERGED)}; dense_gemm(lds, (const bf16_t*)(ws + WS_YBIN), (const bf16_t*)(ws + WS_WOCONV), NTOK, DM, 512, E); }
    SEAM(7);
    if (IN(8)) { pg8::EpiResid E{p.x, p.out}; dense_gemm(lds, (const bf16_t*)(ws + WS_MERGED), (const bf16_t*)(ws + WS_WO), NTOK, DM, DM, E); }
    SEAM(8);
    if (IN(9)) phase_router(p, lds);
    if (IN(9) && IN(11)) xcd_barrier(bar);
    if (IN(11)) phase_moe1(p, lds);
    SEAM(11);
    if (IN(12)) phase_moe2(p, lds);
    SEAM(12);
    if (IN(13)) phase_combine(p);
#undef IN
#undef SEAM
}

extern "C" void kernel_launch(void* const* d_in, const int* in_sizes, int n_in, void* d_out, int out_size,
                              void* d_ws, size_t ws_size, hipStream_t stream) {
    static int grid_blocks = 0;
    if (!grid_blocks) {
        int dev = 0, cus = 0, per_cu = 0;
        (void)hipGetDevice(&dev);
        (void)hipDeviceGetAttribute(&cus, hipDeviceAttributeMultiprocessorCount, dev);
        (void)hipFuncSetAttribute((const void*)mk_fwd, hipFuncAttributeMaxDynamicSharedMemorySize, LDS_BYTES);
        (void)hipOccupancyMaxActiveBlocksPerMultiprocessor(&per_cu, (const void*)mk_fwd, NTHREADS, LDS_BYTES);
        if (per_cu < 1) { fprintf(stderr, "kernel_launch: occupancy query says %d blocks/CU\n", per_cu); per_cu = 1; }
        grid_blocks = cus;
        if (ws_size < WS_END2 || n_in != 21) fprintf(stderr, "kernel_launch: ws %zu < %zu or n_in %d != 21\n", ws_size, (size_t)WS_END2, n_in);
    }
    (void)hipMemsetAsync((char*)d_ws + WS_CTL, 0, 1 * MiB, stream);
    Params p{};
    p.x = (const float*)d_in[0]; p.pos = (const int*)d_in[1]; p.norm1_g = (const float*)d_in[2]; p.w_in = (const float*)d_in[3]; p.q_a_g = (const float*)d_in[4];
    p.kv_a_g = (const float*)d_in[5]; p.w_uq = (const float*)d_in[6]; p.w_ukv = (const float*)d_in[7]; p.q_g = (const float*)d_in[8]; p.k_g = (const float*)d_in[9];
    p.conv_w = (const float*)d_in[10]; p.w_o_mla = (const float*)d_in[11]; p.w_o_conv = (const float*)d_in[12]; p.w_o = (const float*)d_in[13]; p.norm2_g = (const float*)d_in[14];
    p.router_w = (const float*)d_in[15]; p.router_b = (const float*)d_in[16]; p.w1 = (const float*)d_in[17]; p.b1 = (const float*)d_in[18]; p.w2 = (const float*)d_in[19]; p.b2 = (const float*)d_in[20];
    p.out = (float*)d_out; p.ws = (unsigned char*)d_ws; p.ph_lo = 0; p.ph_hi = NPHASE + 1;
    void* args[] = {&p};
    hipError_t e = hipLaunchCooperativeKernel((const void*)mk_fwd, dim3(grid_blocks), dim3(NTHREADS), args, LDS_BYTES, stream);
    if (e != hipSuccess) fprintf(stderr, "cooperative launch failed: %s (grid %d)\n", hipGetErrorString(e), grid_blocks);
}
```

```cpp
#include <hip/hip_runtime.h>
#include <hip/hip_cooperative_groups.h>
#include <cstdio>
#include <cstdint>
namespace cg = cooperative_groups;

typedef unsigned short bf16_t;
typedef short bf16x8 __attribute__((ext_vector_type(8)));
typedef short s16x4 __attribute__((ext_vector_type(4)));
typedef float f32x4 __attribute__((ext_vector_type(4)));
typedef float f32x2 __attribute__((ext_vector_type(2)));
typedef float f32x16 __attribute__((ext_vector_type(16)));
typedef unsigned u32x4 __attribute__((ext_vector_type(4)));
typedef unsigned u32x2 __attribute__((ext_vector_type(2)));
typedef __bf16 bf16x2_t __attribute__((ext_vector_type(2)));

constexpr int NTOK = 16384, DM = 1024, SEQ = 8192;
constexpr int INC = 4000, INCP = 4096;
constexpr int OFF_CQ = 0, OFF_CKV = 256, OFF_KR = 384, OFF_U = 416, OFF_C = 928, OFF_B = 1440, OFF_GA = 1952, OFF_GB = 2976;
constexpr int NH = 8, DQK = 96, DV = 64, NE = 32, TOPK = 4, DFF = 1024;
constexpr int QLORA = 256, KVLORA = 128, CONVW = 512;
constexpr int NPAIR = NTOK * TOPK;
constexpr int MAXROWS = 73728;
constexpr float EPS = 1e-6f;
constexpr int CAP = 16384;
constexpr int NTHREADS = 512, NWAVES = 8;
constexpr int LDS_BYTES = 147456;

constexpr size_t MiB = 1ull << 20;
constexpr size_t WS_CTL = 0;
constexpr size_t WS_WIN = 1 * MiB;
constexpr size_t WS_WUQ = 9 * MiB;
constexpr size_t WS_WUKV = WS_WUQ + 512 * 1024;
constexpr size_t WS_WOMLA = 10 * MiB;
constexpr size_t WS_WOCONV = 11 * MiB;
constexpr size_t WS_WO = 12 * MiB;
constexpr size_t WS_ROUTE = 14 * MiB;
constexpr size_t WS_W1 = 18 * MiB;
constexpr size_t WS_W2 = 146 * MiB;
constexpr size_t WS_XN = 210 * MiB;
constexpr size_t WS_PROJ = 242 * MiB;
constexpr size_t WS_CQN = 370 * MiB;
constexpr size_t WS_CKVN = 378 * MiB;
constexpr size_t WS_YBIN = 386 * MiB;
constexpr size_t WS_QPRE = 402 * MiB;
constexpr size_t WS_KVPRE = 450 * MiB;
constexpr size_t WS_Q = 514 * MiB;
constexpr size_t WS_K = 538 * MiB;
constexpr size_t WS_V = 570 * MiB;
constexpr size_t WS_AO = 586 * MiB;
constexpr size_t WS_M1 = 602 * MiB;
constexpr size_t WS_MERGED = 666 * MiB;
constexpr size_t WS_YS = 698 * MiB;
constexpr size_t WS_END = 826 * MiB;
constexpr size_t WS_ACT = WS_PROJ;
constexpr size_t WS_H8 = WS_XN;
constexpr size_t WS_GF = 830 * MiB;
constexpr size_t WS_RT2 = 832 * MiB;
constexpr size_t WS_END2 = 840 * MiB;
constexpr size_t RT_PAIR_E = 0, RT_PAIR_RANK = 262144, RT_PAIR_W = 524288, RT_ROW_TOK = 786432, RT_ROW_W = 786432 + 294912, RT_ROW_SLOT = 786432 + 2 * 294912;
constexpr int CW_CNT = 64;
constexpr int CW_BAR = 4096;
constexpr int MISC_OFF = LDS_BYTES - 256;

struct Params {
    const float* x; const int* pos; const float* norm1_g; const float* w_in; const float* q_a_g; const float* kv_a_g;
    const float* w_uq; const float* w_ukv; const float* q_g; const float* k_g; const float* conv_w; const float* w_o_mla;
    const float* w_o_conv; const float* w_o; const float* norm2_g; const float* router_w; const float* router_b;
    const float* w1; const float* b1; const float* w2; const float* b2;
    float* out; unsigned char* ws; int ph_lo, ph_hi;
};

__device__ __forceinline__ unsigned pk2(float lo, float hi) { f32x2 v = {lo, hi}; bf16x2_t b = __builtin_convertvector(v, bf16x2_t); return __builtin_bit_cast(unsigned, b); }
__device__ __forceinline__ float bf_lo(unsigned w) { return __uint_as_float(w << 16); }
__device__ __forceinline__ float bf_hi(unsigned w) { return __uint_as_float(w & 0xffff0000u); }
__device__ __forceinline__ float bf1(bf16_t h) { return __uint_as_float((unsigned)h << 16); }
__device__ __forceinline__ float wave_sum(float v) {
#pragma unroll
    for (int o = 1; o < 64; o <<= 1) v += __shfl_xor(v, o);
    return v;
}
__device__ __forceinline__ unsigned pk4_fp8(float a, float b, float c, float d) { unsigned w = 0u; w = (unsigned)__builtin_amdgcn_cvt_pk_fp8_f32(a, b, (int)w, false); w = (unsigned)__builtin_amdgcn_cvt_pk_fp8_f32(c, d, (int)w, true); return w; }
constexpr float W8_SCALE = 32.f, W8_INV = 1.f / 32.f;
__device__ __forceinline__ float sigmoidf_(float v) { return __builtin_amdgcn_rcpf(1.f + __builtin_amdgcn_exp2f(v * -1.4426950408889634f)); }

namespace pg8 {
#define PG8_LAS __attribute__((address_space(3)))
constexpr int BM = 256, BK = 64, HALF = 128, HTB = HALF * BK * 2  , STAGE_BYTES = 8 * HTB, NXCD = 8, WGM = 8;

__host__ __device__ __forceinline__ int lds_byte(int r, int c) { const int st = (r >> 4) * 2 + (c >> 5), rr = r & 15, cc = c & 31, ob = rr * 64 + cc * 2; return st * 1024 + (ob ^ (((ob >> 9) & 1) << 5)); }
__host__ __device__ __forceinline__ void stage_rc(int b, int& R, int& C) { const int st = b / 1024, sb = b % 1024, swz = sb ^ (((sb >> 9) & 1) << 5); R = (st >> 1) * 16 + swz / 64; C = (st & 1) * 32 + (swz % 64) / 2; }
__host__ __device__ __forceinline__ int perm32(int rho) { const int n = rho >> 4, i = rho & 15; return 8 * (i >> 2) + 4 * n + (i & 3); }

struct Unit { int pm, pn, e, rb; };
struct Gemm { const bf16_t* A; const bf16_t* Bt; int M, N, K; size_t bstride; int lda; };

struct StaticOrder {
    int nM, nN, nwg, G, c;
    __host__ __device__ void init(int M, int N, int G_, int c_) { nM = M / BM; nN = N / BM; nwg = nM * nN; G = G_; c = c_; }
    __host__ __device__ bool next(int i, Unit& u) const {
        const long L = (long)i * G + c; if (L >= nwg) return false;
        int wgid = (int)L; { const int q = nwg / NXCD, r = nwg % NXCD, xcd = wgid % NXCD, off = wgid / NXCD; wgid = (xcd < r ? xcd * (q + 1) : r * (q + 1) + (xcd - r) * q) + off; }
        const int nig = WGM * nN, gid = wgid / nig, fm = gid * WGM, gsz = (nM - fm) < WGM ? (nM - fm) : WGM;
        u.pm = fm + ((wgid % nig) % gsz); u.pn = (wgid % nig) / gsz; u.e = 0; u.rb = 0; return true;
    }
    __device__ __forceinline__ void a_ready(const Unit&) const {}
    __device__ __forceinline__ void done(const Unit&) const {}
};


struct EpiProj {
    static constexpr bool PERM = true, AFTER_DRAIN = false;
    bf16_t* O;
    __device__ __forceinline__ void operator()(const f32x4 (&acc)[2][2][4][2], const Unit& u, int wr, int wc, int fr, int fq) const {
        const int row0 = u.pm * BM + wr * 64 + fr, col0 = u.pn * BM + wc * 32 + 8 * fq;
#pragma unroll
        for (int ai = 0; ai < 2; ++ai)
#pragma unroll
            for (int m = 0; m < 4; ++m) { bf16_t* rowp = O + (size_t)(row0 + ai * HALF + m * 16) * INCP + col0;
#pragma unroll
                for (int bj = 0; bj < 2; ++bj) { f32x4 v0 = acc[ai][bj][m][0], v1 = acc[ai][bj][m][1]; const int col = col0 + bj * HALF;
                    if (col >= OFF_GA && col < INC) {
#pragma unroll
                        for (int j = 0; j < 4; ++j) { v0[j] = sigmoidf_(v0[j]); v1[j] = sigmoidf_(v1[j]); } }
                    u32x4 w; w.x = pk2(v0[0], v0[1]); w.y = pk2(v0[2], v0[3]); w.z = pk2(v1[0], v1[1]); w.w = pk2(v1[2], v1[3]);
                    *(u32x4*)(rowp + bj * HALF) = w; } }
    }
};
struct EpiBf16 {
    static constexpr bool PERM = true, AFTER_DRAIN = false;
    bf16_t* O; int ldc;
    __device__ __forceinline__ void operator()(const f32x4 (&acc)[2][2][4][2], const Unit& u, int wr, int wc, int fr, int fq) const {
        const int row0 = u.pm * BM + wr * 64 + fr, col0 = u.pn * BM + wc * 32 + 8 * fq;
#pragma unroll
        for (int ai = 0; ai < 2; ++ai)
#pragma unroll
            for (int m = 0; m < 4; ++m) { bf16_t* rowp = O + (size_t)(row0 + ai * HALF + m * 16) * ldc + col0;
#pragma unroll
                for (int bj = 0; bj < 2; ++bj) { const f32x4 v0 = acc[ai][bj][m][0], v1 = acc[ai][bj][m][1];
                    u32x4 w; w.x = pk2(v0[0], v0[1]); w.y = pk2(v0[2], v0[3]); w.z = pk2(v1[0], v1[1]); w.w = pk2(v1[2], v1[3]); *(u32x4*)(rowp + bj * HALF) = w; } }
    }
};
struct EpiF32 {
    static constexpr bool PERM = false, AFTER_DRAIN = false;
    float* O; int ldc;
    __device__ __forceinline__ void operator()(const f32x4 (&acc)[2][2][4][2], const Unit& u, int wr, int wc, int fr, int fq) const {
        const int row0 = u.pm * BM + wr * 64 + fr, col0 = u.pn * BM + wc * 32 + 4 * fq;
#pragma unroll
        for (int ai = 0; ai < 2; ++ai)
#pragma unroll
            for (int m = 0; m < 4; ++m) { float* rowp = O + (size_t)(row0 + ai * HALF + m * 16) * ldc + col0;
#pragma unroll
                for (int bj = 0; bj < 2; ++bj)
#pragma unroll
                    for (int n = 0; n < 2; ++n) *(f32x4*)(rowp + bj * HALF + n * 16) = acc[ai][bj][m][n]; }
    }
};
__device__ __forceinline__ void unpack8(const u32x4 g, float (&f)[8]) { f[0] = bf_lo(g.x); f[1] = bf_hi(g.x); f[2] = bf_lo(g.y); f[3] = bf_hi(g.y); f[4] = bf_lo(g.z); f[5] = bf_hi(g.z); f[6] = bf_lo(g.w); f[7] = bf_hi(g.w); }
struct EpiGateA {
    static constexpr bool PERM = true, AFTER_DRAIN = false;
    bf16_t* M1; const bf16_t* proj;
    __device__ __forceinline__ void operator()(const f32x4 (&acc)[2][2][4][2], const Unit& u, int wr, int wc, int fr, int fq) const {
        const int row0 = u.pm * BM + wr * 64 + fr, col0 = u.pn * BM + wc * 32 + 8 * fq;
#pragma unroll
        for (int ai = 0; ai < 2; ++ai)
#pragma unroll
            for (int m = 0; m < 4; ++m) { const size_t row = (size_t)(row0 + ai * HALF + m * 16);
#pragma unroll
                for (int bj = 0; bj < 2; ++bj) { const int col = col0 + bj * HALF; float g[8]; unpack8(*(const u32x4*)(proj + row * INCP + OFF_GA + col), g);
                    const f32x4 v0 = acc[ai][bj][m][0], v1 = acc[ai][bj][m][1];
                    u32x4 w; w.x = pk2(v0[0] * g[0], v0[1] * g[1]); w.y = pk2(v0[2] * g[2], v0[3] * g[3]); w.z = pk2(v1[0] * g[4], v1[1] * g[5]); w.w = pk2(v1[2] * g[6], v1[3] * g[7]);
                    *(u32x4*)(M1 + row * DM + col) = w; } }
    }
};
struct EpiGateB {
    static constexpr bool PERM = true, AFTER_DRAIN = false;
    const bf16_t* M1; const bf16_t* proj; bf16_t* O;
    __device__ __forceinline__ void operator()(const f32x4 (&acc)[2][2][4][2], const Unit& u, int wr, int wc, int fr, int fq) const {
        const int row0 = u.pm * BM + wr * 64 + fr, col0 = u.pn * BM + wc * 32 + 8 * fq;
#pragma unroll
        for (int ai = 0; ai < 2; ++ai)
#pragma unroll
            for (int m = 0; m < 4; ++m) { const size_t row = (size_t)(row0 + ai * HALF + m * 16);
#pragma unroll
                for (int bj = 0; bj < 2; ++bj) { const int col = col0 + bj * HALF; float g[8], b[8]; unpack8(*(const u32x4*)(proj + row * INCP + OFF_GB + col), g); unpack8(*(const u32x4*)(M1 + row * DM + col), b);
                    const f32x4 v0 = acc[ai][bj][m][0], v1 = acc[ai][bj][m][1];
                    u32x4 w; w.x = pk2(b[0] + v0[0] * g[0], b[1] + v0[1] * g[1]); w.y = pk2(b[2] + v0[2] * g[2], b[3] + v0[3] * g[3]);
                    w.z = pk2(b[4] + v1[0] * g[4], b[5] + v1[1] * g[5]); w.w = pk2(b[6] + v1[2] * g[6], b[7] + v1[3] * g[7]);
                    *(u32x4*)(O + row * DM + col) = w; } }
    }
};
struct EpiResid {
    static constexpr bool PERM = false, AFTER_DRAIN = false;
    const float* X; float* O;
    __device__ __forceinline__ void operator()(const f32x4 (&acc)[2][2][4][2], const Unit& u, int wr, int wc, int fr, int fq) const {
        const int row0 = u.pm * BM + wr * 64 + fr, col0 = u.pn * BM + wc * 32 + 4 * fq;
#pragma unroll
        for (int ai = 0; ai < 2; ++ai)
#pragma unroll
            for (int m = 0; m < 4; ++m) { const size_t off = (size_t)(row0 + ai * HALF + m * 16) * DM + col0;
#pragma unroll
                for (int bj = 0; bj < 2; ++bj)
#pragma unroll
                    for (int n = 0; n < 2; ++n) { const f32x4 b = *(const f32x4*)(X + off + bj * HALF + n * 16); *(f32x4*)(O + off + bj * HALF + n * 16) = b + acc[ai][bj][m][n]; } }
    }
};
struct EpiSwiglu {
    static constexpr bool PERM = true, AFTER_DRAIN = false;
    unsigned char* ACT; const float* b1; const float* row_rstd;
    __device__ __forceinline__ void operator()(const f32x4 (&acc)[2][2][4][2], const Unit& u, int wr, int wc, int fr, int fq) const {
        const int row0 = u.pm * BM + wr * 64 + fr, f0 = u.pn * HALF + wc * 32 + 8 * fq; const float* be = b1 + (size_t)u.e * 2048;
        const f32x4 bg0 = *(const f32x4*)(be + f0), bg1 = *(const f32x4*)(be + f0 + 4), bu0 = *(const f32x4*)(be + DFF + f0), bu1 = *(const f32x4*)(be + DFF + f0 + 4);
        float rsv[8];
#pragma unroll
        for (int i = 0; i < 8; ++i) rsv[i] = row_rstd[u.rb + wr * 64 + fr + (i >> 2) * HALF + (i & 3) * 16] * W8_INV;
#pragma unroll
        for (int ai = 0; ai < 2; ++ai)
#pragma unroll
            for (int m = 0; m < 4; ++m) { const size_t row = (size_t)(row0 + ai * HALF + m * 16); float o[8]; const float rs = rsv[ai * 4 + m];
#pragma unroll
                for (int n = 0; n < 2; ++n) { const f32x4 g4 = acc[ai][0][m][n] * rs + (n ? bg1 : bg0), u4 = acc[ai][1][m][n] * rs + (n ? bu1 : bu0);
#pragma unroll
                    for (int j = 0; j < 4; ++j) { const float g = fminf(g4[j], 7.f), uu = fminf(fmaxf(u4[j], -7.f), 7.f); o[4 * n + j] = (uu + 1.f) * (g * sigmoidf_(1.702f * g)); } }
                u32x2 w; w.x = pk4_fp8(o[0], o[1], o[2], o[3]); w.y = pk4_fp8(o[4], o[5], o[6], o[7]); *(u32x2*)(ACT + row * DFF + f0) = w; }
    }
};
struct EpiMoeOut {
    static constexpr bool PERM = true, AFTER_DRAIN = false;
    bf16_t* YS; const float* b2; const float* row_w; const int* row_slot;
    __device__ __forceinline__ void operator()(const f32x4 (&acc)[2][2][4][2], const Unit& u, int wr, int wc, int fr, int fq) const {
        const int col0 = u.pn * BM + wc * 32 + 8 * fq; const float* be = b2 + (size_t)u.e * DM; const int rbase = u.rb + wr * 64 + fr;
        int slot[8]; float w[8];
#pragma unroll
        for (int i = 0; i < 8; ++i) { const int row = rbase + (i >> 2) * HALF + (i & 3) * 16; slot[i] = row_slot[row]; w[i] = row_w[row] * W8_INV; }
        f32x4 bv[2][2];
#pragma unroll
        for (int bj = 0; bj < 2; ++bj)
#pragma unroll
            for (int n = 0; n < 2; ++n) bv[bj][n] = *(const f32x4*)(be + col0 + bj * HALF + 4 * n) * W8_SCALE;
#pragma unroll
        for (int ai = 0; ai < 2; ++ai)
#pragma unroll
            for (int m = 0; m < 4; ++m) { const int i = ai * 4 + m;
                if (slot[i] >= 0) { bf16_t* rowp = YS + (size_t)slot[i] * DM + col0;
#pragma unroll
                    for (int bj = 0; bj < 2; ++bj) { const f32x4 v0 = (acc[ai][bj][m][0] + bv[bj][0]) * w[i], v1 = (acc[ai][bj][m][1] + bv[bj][1]) * w[i];
                        u32x4 o; o.x = pk2(v0[0], v0[1]); o.y = pk2(v0[2], v0[3]); o.z = pk2(v1[0], v1[1]); o.w = pk2(v1[2], v1[3]); *(u32x4*)(rowp + bj * HALF) = o; } } }
    }
};
constexpr int MOE_MAXU = 12;
struct MoeOrder {
    StaticOrder so; const PG8_LAS int* utab; const PG8_LAS int* gtab;
    __device__ __forceinline__ bool next(int i, Unit& u) const { if (i >= MOE_MAXU || !so.next(i, u)) return false; const int v = __builtin_amdgcn_readfirstlane(utab[i]); u.e = v & 31; u.rb = (int)((unsigned)v >> 8); return true; }
    __device__ __forceinline__ void a_ready(const Unit&) const {}
    __device__ __forceinline__ void done(const Unit&) const {}
};
typedef int i32x4_t __attribute__((ext_vector_type(4))); typedef int i32x8_t __attribute__((ext_vector_type(8)));
__device__ __forceinline__ i32x8_t cat8(bf16x8 lo, bf16x8 hi) { return __builtin_shufflevector(__builtin_bit_cast(i32x4_t, lo), __builtin_bit_cast(i32x4_t, hi), 0, 1, 2, 3, 4, 5, 6, 7); }
__device__ __forceinline__ void mfma_fp8_inplace(f32x4& c, const i32x8_t a, const i32x8_t b) { asm volatile("s_nop 1\n\tv_mfma_f32_16x16x128_f8f6f4 %0, %1, %2, %0" : "+v"(c) : "v"(a), "v"(b)); }
__device__ __forceinline__ void mfma_fp8_drain() { asm volatile("s_nop 15\n\ts_nop 7" ::: "memory"); __builtin_amdgcn_sched_barrier(0); }
template <class Epi, class Sched, bool ALIGN_EPI = false, bool SP2 = false, bool FP8 = false, bool GATHER = false>
__device__ __forceinline__ void gemm_phase(PG8_LAS unsigned char* lds, const Gemm g, const Sched& S, const Epi& E) {
    const int tid = threadIdx.x, wid = __builtin_amdgcn_readfirstlane(tid >> 6), lane = tid & 63, wr = wid >> 2, wc = wid & 3, fr = lane & 15, fq = lane >> 4;
    const int K = g.K, nt = K / BK;
    static_assert(!GATHER || SP2, "GATHER is implemented for the SP2 loop only");
    const unsigned rowA = (unsigned)(g.lda ? g.lda : K) * 2u;
    unsigned voffA[2], voffB[2]; int gR0 = 0; unsigned gC = 0u;
#pragma unroll
    for (int i = 0; i < 2; ++i) { int R, C; stage_rc(tid * 16 + i * 8192, R, C); const int Rb = Epi::PERM ? ((R & ~31) + perm32(R & 31)) : R;
        voffA[i] = (unsigned)R * rowA + (unsigned)C * 2u; voffB[i] = (unsigned)(Rb * K + C) * 2u; if (i == 0) { gR0 = R; gC = (unsigned)C * 2u; } }
    unsigned gA[2][2] = {{0u, 0u}, {0u, 0u}}, ngA[2][2] = {{0u, 0u}, {0u, 0u}};
#define PG8_GLOAD(dst, ui_) do { _Pragma("unroll") for (int h_ = 0; h_ < 2; ++h_) _Pragma("unroll") for (int i_ = 0; i_ < 2; ++i_) \
        dst[h_][i_] = (unsigned)S.gtab[(ui_) * 256 + 128 * h_ + gR0 + 64 * i_] * rowA + gC; } while (0)
#define PG8_VA(h) (GATHER ? gA[h] : voffA)
    const unsigned kstep = (unsigned)(BK * 2);
    const unsigned hstep = (unsigned)HALF * (unsigned)K * 2u;
    const unsigned tstep = 2u * hstep;
    const unsigned hstepA = (unsigned)HALF * rowA, tstepA = 2u * hstepA;
    const unsigned hsA = GATHER ? 0u : hstepA;
    const unsigned ldsw = (unsigned)wid * 1024u;
    const int aoff = lds_byte(wr * 64 + fr, fq * 8), boff = lds_byte(wc * 32 + fr, fq * 8);
#define PG8_SA(b, h) (((b) * 2 + (h)) * HTB)
#define PG8_SB(b, h) ((4 + (b) * 2 + (h)) * HTB)
#define PG8_STAGE(rs, bufoff, goff, voff) do { _Pragma("unroll") for (int _i = 0; _i < 2; ++_i) \
        __builtin_amdgcn_raw_ptr_buffer_load_lds(rs, (PG8_LAS void*)(lds + (bufoff) + ldsw + _i * 8192), 16, (int)(voff)[_i], (int)(goff), 0, 0); } while (0)
#define PG8_LDA(dst, b, h) do { _Pragma("unroll") for (int m = 0; m < 4; ++m) _Pragma("unroll") for (int k = 0; k < 2; ++k) dst[m][k] = *(const PG8_LAS bf16x8*)(lds + PG8_SA(b, h) + aoff + m * 2048 + k * 1024); } while (0)
#define PG8_LDB(dst, b, h) do { _Pragma("unroll") for (int n = 0; n < 2; ++n) _Pragma("unroll") for (int k = 0; k < 2; ++k) dst[n][k] = *(const PG8_LAS bf16x8*)(lds + PG8_SB(b, h) + boff + n * 2048 + k * 1024); } while (0)
#define PG8_MMA(ai, bj, At, Bt) do { __builtin_amdgcn_s_setprio(1); _Pragma("unroll") for (int m = 0; m < 4; ++m) _Pragma("unroll") for (int n = 0; n < 2; ++n) { \
        if constexpr (FP8) { mfma_fp8_inplace(acc[ai][bj][m][n], cat8(Bt[n][0], Bt[n][1]), cat8(At[m][0], At[m][1])); } \
        else { _Pragma("unroll") for (int k = 0; k < 2; ++k) acc[ai][bj][m][n] = __builtin_amdgcn_mfma_f32_16x16x32_bf16(Bt[n][k], At[m][k], acc[ai][bj][m][n], 0, 0, 0); } } \
        __builtin_amdgcn_s_setprio(0); } while (0)
#define PG8_WAIT_V(n) asm volatile("s_waitcnt vmcnt(" #n ")" ::: "memory")
#define PG8_WAIT_L(n) asm volatile("s_waitcnt lgkmcnt(" #n ")" ::: "memory")
#define PG8_BAR __builtin_amdgcn_s_barrier()
#define PG8_SCHED __builtin_amdgcn_sched_barrier(0)
    Unit cur, nxt; int ui = 0;
    if (!S.next(0, cur)) return;
    f32x4 acc[2][2][4][2];
#pragma unroll
    for (int a = 0; a < 2; ++a)
#pragma unroll
        for (int b = 0; b < 2; ++b)
#pragma unroll
            for (int m = 0; m < 4; ++m)
#pragma unroll
                for (int n = 0; n < 2; ++n) acc[a][b][m][n] = (f32x4){0.f, 0.f, 0.f, 0.f};
    bf16x8 At[4][2], B0[2][2], B1[2][2];
    unsigned cA = GATHER ? 0u : (unsigned)cur.pm * tstepA, cB = (unsigned)cur.e * (unsigned)g.bstride + (unsigned)cur.pn * tstep;
    const __amdgpu_buffer_rsrc_t rsA = __builtin_amdgcn_make_buffer_rsrc((void*)g.A, 0, 0x7fffffff, 0x00020000), rsB = __builtin_amdgcn_make_buffer_rsrc((void*)g.Bt, 0, 0x7fffffff, 0x00020000);
    S.a_ready(cur);
    if constexpr (GATHER) PG8_GLOAD(gA, 0);
    if constexpr (SP2) {
        PG8_STAGE(rsB, PG8_SB(0, 0), cB, voffB); PG8_STAGE(rsB, PG8_SB(0, 1), cB + hstep, voffB); PG8_STAGE(rsA, PG8_SA(0, 0), cA, PG8_VA(0)); PG8_STAGE(rsA, PG8_SA(0, 1), cA + hsA, PG8_VA(1));
        if (wr == 1) PG8_BAR;
        PG8_WAIT_V(2); PG8_BAR;
        PG8_STAGE(rsB, PG8_SB(1, 0), cB + kstep, voffB); PG8_STAGE(rsA, PG8_SA(1, 0), cA + kstep, PG8_VA(0)); PG8_STAGE(rsB, PG8_SB(1, 1), cB + hstep + kstep, voffB);
        PG8_WAIT_V(6); PG8_BAR;
    } else {
        PG8_STAGE(rsB, PG8_SB(0, 0), cB, voffB); PG8_STAGE(rsA, PG8_SA(0, 0), cA, PG8_VA(0)); PG8_STAGE(rsB, PG8_SB(0, 1), cB + hstep, voffB); PG8_STAGE(rsA, PG8_SA(0, 1), cA + hsA, PG8_VA(1));
        if (wr == 1) PG8_BAR;
        PG8_WAIT_V(4); PG8_BAR;
        PG8_STAGE(rsB, PG8_SB(1, 0), cB + kstep, voffB); PG8_STAGE(rsA, PG8_SA(1, 0), cA + kstep, PG8_VA(0)); PG8_STAGE(rsB, PG8_SB(1, 1), cB + hstep + kstep, voffB);
        PG8_WAIT_V(6); PG8_BAR;
    }
    for (;;) {
        const bool has_next = S.next(ui + 1, nxt);
        if constexpr (GATHER) { if (has_next) PG8_GLOAD(ngA, ui + 1); else { ngA[0][0] = gA[0][0]; ngA[0][1] = gA[0][1]; ngA[1][0] = gA[1][0]; ngA[1][1] = gA[1][1]; } }
        const unsigned nA = (has_next && !GATHER) ? (unsigned)nxt.pm * tstepA : cA, nB = has_next ? (unsigned)nxt.e * (unsigned)g.bstride + (unsigned)nxt.pn * tstep : cB;
        for (int t = 0; t < nt; t += 2) {
            const bool last = (t == nt - 2);
            const unsigned a1 = cA + (unsigned)(t + 1) * kstep;
            const unsigned a2 = last ? nA : cA + (unsigned)(t + 2) * kstep, b2 = last ? nB : cB + (unsigned)(t + 2) * kstep;
            const unsigned a3 = a2 + kstep, b3 = b2 + kstep;
            if (last && has_next) S.a_ready(nxt);
            if constexpr (SP2) {
            PG8_LDB(B0, 0, 0); PG8_LDB(B1, 0, 1); PG8_SCHED; PG8_LDA(At, 0, 0); PG8_STAGE(rsA, PG8_SA(1, 1), a1 + hsA, PG8_VA(1));
            if constexpr (GATHER) { if (last) { gA[0][0] = ngA[0][0]; gA[0][1] = ngA[0][1]; gA[1][0] = ngA[1][0]; gA[1][1] = ngA[1][1]; } }
            PG8_WAIT_V(8); PG8_WAIT_L(0); PG8_BAR; PG8_MMA(0, 0, At, B0); PG8_MMA(0, 1, At, B1); PG8_BAR; PG8_SCHED;
            PG8_LDA(At, 0, 1); PG8_STAGE(rsB, PG8_SB(0, 0), b2, voffB); PG8_STAGE(rsB, PG8_SB(0, 1), b2 + hstep, voffB); PG8_STAGE(rsA, PG8_SA(0, 0), a2, PG8_VA(0));
            PG8_WAIT_V(8); PG8_WAIT_L(0); PG8_BAR; PG8_MMA(1, 0, At, B0); PG8_MMA(1, 1, At, B1); PG8_BAR; PG8_SCHED;
            PG8_LDB(B0, 1, 0); PG8_LDB(B1, 1, 1); PG8_SCHED; PG8_LDA(At, 1, 0); PG8_STAGE(rsA, PG8_SA(0, 1), a2 + hsA, PG8_VA(1));
            PG8_WAIT_V(8); PG8_WAIT_L(0); PG8_BAR; PG8_MMA(0, 0, At, B0); PG8_MMA(0, 1, At, B1); PG8_BAR; PG8_SCHED;
            PG8_LDA(At, 1, 1); PG8_STAGE(rsB, PG8_SB(1, 0), b3, voffB); PG8_STAGE(rsB, PG8_SB(1, 1), b3 + hstep, voffB); PG8_STAGE(rsA, PG8_SA(1, 0), a3, PG8_VA(0));
            PG8_WAIT_V(8); PG8_WAIT_L(0); PG8_BAR; PG8_MMA(1, 0, At, B0); PG8_MMA(1, 1, At, B1); PG8_BAR; PG8_SCHED;
            } else {
            PG8_LDB(B0, 0, 0); PG8_SCHED; PG8_LDA(At, 0, 0); PG8_STAGE(rsA, PG8_SA(1, 1), a1 + hsA, PG8_VA(1));
            PG8_WAIT_L(8); PG8_BAR; PG8_WAIT_L(0); PG8_MMA(0, 0, At, B0); PG8_BAR; PG8_SCHED;
            PG8_LDB(B1, 0, 1); PG8_STAGE(rsB, PG8_SB(0, 0), b2, voffB);
            PG8_BAR; PG8_WAIT_L(0); PG8_MMA(0, 1, At, B1); PG8_BAR;
            PG8_LDA(At, 0, 1); PG8_STAGE(rsA, PG8_SA(0, 0), a2, PG8_VA(0));
            PG8_BAR; PG8_WAIT_L(0); PG8_MMA(1, 0, At, B0); PG8_BAR; PG8_SCHED;
            PG8_STAGE(rsB, PG8_SB(0, 1), b2 + hstep, voffB);
            PG8_WAIT_V(6); PG8_BAR; PG8_MMA(1, 1, At, B1); PG8_BAR;
            PG8_LDB(B0, 1, 0); PG8_SCHED; PG8_LDA(At, 1, 0); PG8_STAGE(rsA, PG8_SA(0, 1), a2 + hsA, PG8_VA(1));
            PG8_WAIT_L(8); PG8_BAR; PG8_WAIT_L(0); PG8_MMA(0, 0, At, B0); PG8_BAR; PG8_SCHED;
            PG8_LDB(B1, 1, 1); PG8_STAGE(rsB, PG8_SB(1, 0), b3, voffB);
            PG8_BAR; PG8_WAIT_L(0); PG8_MMA(0, 1, At, B1); PG8_BAR;
            PG8_LDA(At, 1, 1); PG8_STAGE(rsA, PG8_SA(1, 0), a3, PG8_VA(0));
            PG8_BAR; PG8_WAIT_L(0); PG8_MMA(1, 0, At, B0); PG8_BAR; PG8_SCHED;
            PG8_STAGE(rsB, PG8_SB(1, 1), b3 + hstep, voffB);
            PG8_WAIT_V(6); PG8_BAR; PG8_MMA(1, 1, At, B1); PG8_BAR;
            }
        }
        if constexpr (ALIGN_EPI) { if (wr == 0) PG8_BAR; }
        if constexpr (FP8) mfma_fp8_drain();
        if constexpr (!Epi::AFTER_DRAIN) { E(acc, cur, wr, wc, fr, fq); S.done(cur); }
        if (!has_next) break;
#pragma unroll
        for (int a = 0; a < 2; ++a)
#pragma unroll
            for (int b = 0; b < 2; ++b)
#pragma unroll
                for (int m = 0; m < 4; ++m)
#pragma unroll
                    for (int n = 0; n < 2; ++n) acc[a][b][m][n] = (f32x4){0.f, 0.f, 0.f, 0.f};
        cur = nxt; cA = nA; cB = nB; ++ui;
        if constexpr (ALIGN_EPI) { if (wr == 1) PG8_BAR; }
    }
    PG8_WAIT_V(0);
    if constexpr (!ALIGN_EPI) { if (wr == 0) PG8_BAR; }
    PG8_BAR;
    if constexpr (Epi::AFTER_DRAIN) { E.fused(acc, cur, wr, wc, fr, fq, lds, wid, lane); S.done(cur); }
#undef PG8_SA
#undef PG8_GLOAD
#undef PG8_VA
#undef PG8_SB
#undef PG8_STAGE
#undef PG8_LDA
#undef PG8_LDB
#undef PG8_MMA
#undef PG8_WAIT_V
#undef PG8_WAIT_L
#undef PG8_BAR
#undef PG8_SCHED
}
}

#define GAS __attribute__((address_space(1)))
#define LAS __attribute__((address_space(3)))
#define XB_TMO      128
#define XB_XCNT(j)  (256  + 64 * (j))
#define XB_XSUB(j)  (1280 + 64 * (j))
#define XB_XGEN(j)  (2304 + 64 * (j))
#define XB_TOP      3328
#define XB_TOPGEN   3392
#define XCD_BAR_WORDS 3456
#define XB_SPIN_CAP (1u << 18)

__device__ __forceinline__ unsigned xb_ld(unsigned* p)              { return __hip_atomic_load(p, __ATOMIC_RELAXED, __HIP_MEMORY_SCOPE_AGENT); }
__device__ __forceinline__ unsigned xb_add(unsigned* p, unsigned v) { return __hip_atomic_fetch_add(p, v, __ATOMIC_RELAXED, __HIP_MEMORY_SCOPE_AGENT); }
__device__ __forceinline__ unsigned xb_xcc_id() { return (unsigned)__builtin_amdgcn_s_getreg((3 << 11) | 20) & 0xFu; }
#define XB_SPIN(cond, bar) do { unsigned _sp = 0; while (cond) { __builtin_amdgcn_s_sleep(1); \
    if ((++_sp & 255u) == 0u) { if (xb_ld(&(bar)[XB_TMO])) break; if (_sp > XB_SPIN_CAP) { atomicAdd(&(bar)[XB_TMO], 1u); break; } } } } while (0)

struct XcdBarrier {
    unsigned* bar; unsigned x;
    volatile LAS unsigned* st;
};

__device__ __forceinline__ XcdBarrier xcd_barrier_post(unsigned* bar, volatile LAS unsigned* st) {
    XcdBarrier b; b.bar = bar; b.x = xb_xcc_id(); b.st = st;
    if (threadIdx.x == 0) (void)xb_add(&bar[XB_XCNT(b.x)], 1u);
    return b;
}
__device__ __forceinline__ void xcd_barrier_complete(unsigned* bar, unsigned x, unsigned& nloc, unsigned& nx) {
    const unsigned G = gridDim.x * gridDim.y * gridDim.z;
    unsigned sum, cnt, mine, sp = 0u;
    for (;;) {
        sum = 0u; cnt = 0u; mine = 0u;
#pragma unroll
        for (unsigned j = 0; j < 16; ++j) { const unsigned c = xb_ld(&bar[XB_XCNT(j)]); sum += c; cnt += (c > 0u) ? 1u : 0u; mine = (j == x) ? c : mine; }
        if (sum == G) break;
        __builtin_amdgcn_s_sleep(1);
        if ((++sp & 255u) == 0u) { if (xb_ld(&bar[XB_TMO])) break; if (sp > XB_SPIN_CAP) { atomicAdd(&bar[XB_TMO], 1u); break; } }
    }
    nloc = mine > 0u ? mine : 1u; nx = cnt > 0u ? cnt : 1u;
}

__device__ __forceinline__ void xcd_barrier(const XcdBarrier& b) {
    asm volatile("s_waitcnt vmcnt(0)" ::: "memory");
    __syncthreads();
    if (threadIdx.x == 0) {
        unsigned* bar = b.bar;
        __builtin_amdgcn_s_waitcnt(0);
        unsigned nloc = b.st[0], nx = b.st[1];
        if (nloc == 0u) { xcd_barrier_complete(bar, b.x, nloc, nx); b.st[0] = nloc; b.st[1] = nx; }
        const unsigned old = xb_add(&bar[XB_XSUB(b.x)], 1u);
        const unsigned gen = old / nloc;
        if (old + 1u == (gen + 1u) * nloc) {
            __builtin_amdgcn_fence(__ATOMIC_RELEASE, "agent");
            asm volatile("s_waitcnt vmcnt(0)" ::: "memory");
            const unsigned og = xb_add(&bar[XB_TOP], 1u);
            const unsigned tg = og / nx;
            if (og + 1u == (tg + 1u) * nx) xb_add(&bar[XB_TOPGEN], 1u);
            else XB_SPIN(xb_ld(&bar[XB_TOPGEN]) == tg, bar);
            __builtin_amdgcn_fence(__ATOMIC_ACQUIRE, "agent");
            xb_add(&bar[XB_XGEN(b.x)], 1u);
            asm volatile("s_waitcnt vmcnt(0)" ::: "memory");
        } else {
            XB_SPIN(xb_ld(&bar[XB_XGEN(b.x)]) == gen, bar);
            __builtin_amdgcn_fence(__ATOMIC_ACQUIRE, "agent");
            asm volatile("s_waitcnt vmcnt(0)" ::: "memory");
        }
    }
    __syncthreads();
}

template <int MODE  >
__device__ __forceinline__ void transpose_item(const float* __restrict__ W, int K, int N, bf16_t* __restrict__ WT, const float* __restrict__ gain, float* scr, int item, int lane) {
    const int nblk = N / 32, kb = item / nblk, nb = item % nblk, k0 = 64 * kb, n0 = 32 * nb;
#pragma unroll
    for (int i = 0; i < 8; ++i) { const int kk = 8 * i + (lane >> 3), n4 = (lane & 7) * 4; f32x4 v = *(const f32x4*)(W + (size_t)(k0 + kk) * N + n0 + n4);
        if (gain) { const float g = gain[k0 + kk]; v = v * g; }
        float* s = scr + kk * 33 + n4; s[0] = v[0]; s[1] = v[1]; s[2] = v[2]; s[3] = v[3]; }
    asm volatile("s_waitcnt lgkmcnt(0)" ::: "memory");
    const int c = lane & 7;
#pragma unroll
    for (int j = 0; j < 4; ++j) { const int n = (lane >> 3) + 8 * j; const float* s = scr + (8 * c) * 33 + n;
        u32x4 o; o.x = pk2(s[0 * 33], s[1 * 33]); o.y = pk2(s[2 * 33], s[3 * 33]); o.z = pk2(s[4 * 33], s[5 * 33]); o.w = pk2(s[6 * 33], s[7 * 33]);
        int row = n0 + n;
        if (MODE == 1) { const int f = row & 1023; row = ((f >> 7) << 8) + ((row >> 10) << 7) + (f & 127); }
        *(u32x4*)(WT + (size_t)row * K + k0 + 8 * c) = o; }
    asm volatile("s_waitcnt lgkmcnt(0)" ::: "memory");
}
template <int MODE>
__device__ __forceinline__ void transpose_item_fp8(const float* __restrict__ W, int K, int N, unsigned char* __restrict__ WT, float* scr, int item, int lane) {
    const int nblk = N / 32, kb = item / nblk, nb = item % nblk, k0 = 64 * kb, n0 = 32 * nb;
#pragma unroll
    for (int i = 0; i < 8; ++i) { const int kk = 8 * i + (lane >> 3), n4 = (lane & 7) * 4; const f32x4 v = *(const f32x4*)(W + (size_t)(k0 + kk) * N + n0 + n4) * W8_SCALE;
        float* s = scr + kk * 33 + n4; s[0] = v[0]; s[1] = v[1]; s[2] = v[2]; s[3] = v[3]; }
    asm volatile("s_waitcnt lgkmcnt(0)" ::: "memory");
    const int c = lane & 7;
#pragma unroll
    for (int j = 0; j < 4; ++j) { const int n = (lane >> 3) + 8 * j; const float* s = scr + (8 * c) * 33 + n;
        u32x2 o; o.x = pk4_fp8(s[0 * 33], s[1 * 33], s[2 * 33], s[3 * 33]); o.y = pk4_fp8(s[4 * 33], s[5 * 33], s[6 * 33], s[7 * 33]);
        int row = n0 + n;
        if (MODE == 1) { const int f = row & 1023; row = ((f >> 7) << 8) + ((row >> 10) << 7) + (f & 127); }
        *(u32x2*)(WT + (size_t)row * K + k0 + 8 * c) = o; }
    asm volatile("s_waitcnt lgkmcnt(0)" ::: "memory");
}
__device__ __forceinline__ void phase_prologue(const Params& p, unsigned char* lds) {
    const int tid = threadIdx.x, lane = tid & 63, wave = tid >> 6;
    float* scr = (float*)(lds + wave * 16384);
    const int gw = blockIdx.x * NWAVES + wave, NGW = gridDim.x * NWAVES;
    unsigned char* ws = p.ws;
    constexpr int I_WIN = (DM / 64) * (INC / 32), I_UQ = (QLORA / 64) * (768 / 32), I_UKV = (KVLORA / 64) * (1024 / 32), I_OM = (512 / 64) * (DM / 32), I_OC = I_OM, I_WO = (DM / 64) * (DM / 32);
    constexpr int I_W1 = (DM / 64) * (2048 / 32), I_W2 = (DFF / 64) * (DM / 32);
    constexpr int NSMALL = I_WIN + I_UQ + I_UKV + I_OM + I_OC + I_WO;
    constexpr int NITEMS = NSMALL;
    for (int it = gw; it < NITEMS; it += NGW) {
        int r = it;
        if (r < I_WIN) { transpose_item<0>(p.w_in, DM, INC, (bf16_t*)(ws + WS_WIN), p.norm1_g, scr, r, lane); continue; } r -= I_WIN;
        if (r < I_UQ) { transpose_item<0>(p.w_uq, QLORA, 768, (bf16_t*)(ws + WS_WUQ), p.q_a_g, scr, r, lane); continue; } r -= I_UQ;
        if (r < I_UKV) { transpose_item<0>(p.w_ukv, KVLORA, 1024, (bf16_t*)(ws + WS_WUKV), p.kv_a_g, scr, r, lane); continue; } r -= I_UKV;
        if (r < I_OM) { transpose_item<0>(p.w_o_mla, 512, DM, (bf16_t*)(ws + WS_WOMLA), nullptr, scr, r, lane); continue; } r -= I_OM;
        if (r < I_OC) { transpose_item<0>(p.w_o_conv, 512, DM, (bf16_t*)(ws + WS_WOCONV), nullptr, scr, r, lane); continue; } r -= I_OC;
        transpose_item<0>(p.w_o, DM, DM, (bf16_t*)(ws + WS_WO), nullptr, scr, r, lane);
    }
    { u32x4* z = (u32x4*)((bf16_t*)(ws + WS_WIN) + (size_t)INC * DM); const int nz = (INCP - INC) * DM * 2 / 16;
      for (int i = blockIdx.x * NTHREADS + tid; i < nz; i += gridDim.x * NTHREADS) z[i] = (u32x4){0u, 0u, 0u, 0u}; }
    { int* rt = (int*)(ws + WS_RT2); int* rs = (int*)(ws + WS_RT2 + 4 * MiB); float* rr = (float*)(ws + WS_RT2 + 6 * MiB);
      for (int i = blockIdx.x * NTHREADS + tid; i < NE * CAP; i += gridDim.x * NTHREADS) { rt[i] = 0; rs[i] = -1; rr[i] = 0.f; } }
    { u32x4* GF = (u32x4*)(ws + WS_GF);
      for (int i = blockIdx.x * NTHREADS + tid; i < 64 * 64; i += gridDim.x * NTHREADS) { const int ks = i >> 6, ln = i & 63, r = ln & 31, h = ln >> 5; float v[8], lo[8]; unsigned hi[4];
#pragma unroll
          for (int j = 0; j < 8; ++j) { const int k = 16 * ks + 8 * h + j; v[j] = p.norm2_g[k] * p.router_w[(size_t)k * NE + r]; }
#pragma unroll
          for (int j = 0; j < 4; ++j) { hi[j] = pk2(v[2 * j], v[2 * j + 1]); lo[2 * j] = v[2 * j] - bf_lo(hi[j]); lo[2 * j + 1] = v[2 * j + 1] - bf_hi(hi[j]); }
          GF[(ks * 2 + 0) * 64 + ln] = (u32x4){hi[0], hi[1], hi[2], hi[3]}; GF[(ks * 2 + 1) * 64 + ln] = (u32x4){pk2(lo[0], lo[1]), pk2(lo[2], lo[3]), pk2(lo[4], lo[5]), pk2(lo[6], lo[7])}; } }
    bf16_t* XN = (bf16_t*)(ws + WS_XN);
    for (int m = gw; m < NTOK; m += NGW) {
        const f32x4* xr = (const f32x4*)(p.x + (size_t)m * DM) + lane; f32x4 v[4]; float s = 0.f;
#pragma unroll
        for (int j = 0; j < 4; ++j) { v[j] = xr[64 * j]; s += (v[j][0] * v[j][0] + v[j][1] * v[j][1]) + (v[j][2] * v[j][2] + v[j][3] * v[j][3]); }
        const float rstd = rsqrtf(wave_sum(s) * (1.f / DM) + EPS);
        u32x2* o = (u32x2*)(XN + (size_t)m * DM) + lane;
#pragma unroll
        for (int j = 0; j < 4; ++j) { u32x2 w; w.x = pk2(v[j][0] * rstd, v[j][1] * rstd); w.y = pk2(v[j][2] * rstd, v[j][3] * rstd); o[64 * j] = w; }
    }
}

constexpr float QSCALE = 0.10206207261596575f * 1.4426950408889634f;
struct TokRaw { u32x2 cq; unsigned ckv; u32x4 u[3], c[3], bg, qa, ka, va; unsigned q1, q2, k1, k2; float pos, m0, m2; };
__device__ __forceinline__ void tokb_load(TokRaw& r, const Params& p, int t, int lane, int h, int sub) {
    const bf16_t* PROJ = (const bf16_t*)(p.ws + WS_PROJ); const bf16_t* pr = PROJ + (size_t)t * INCP; const int s = t & (SEQ - 1);
    r.pos = (float)p.pos[t];
    r.cq = *(const u32x2*)(pr + OFF_CQ + 4 * lane); r.ckv = *(const unsigned*)(pr + OFF_CKV + 2 * lane);
    r.m0 = s > 0 ? 1.f : 0.f; r.m2 = s < SEQ - 1 ? 1.f : 0.f;
    const bf16_t* pm = s > 0 ? pr - INCP : pr; const bf16_t* pp = s < SEQ - 1 ? pr + INCP : pr;
    r.u[0] = *(const u32x4*)(pm + OFF_U + 8 * lane); r.c[0] = *(const u32x4*)(pm + OFF_C + 8 * lane);
    r.u[1] = *(const u32x4*)(pr + OFF_U + 8 * lane); r.c[1] = *(const u32x4*)(pr + OFF_C + 8 * lane);
    r.u[2] = *(const u32x4*)(pp + OFF_U + 8 * lane); r.c[2] = *(const u32x4*)(pp + OFF_C + 8 * lane);
    r.bg = *(const u32x4*)(pr + OFF_B + 8 * lane);
    const bf16_t* qp = (const bf16_t*)(p.ws + WS_QPRE) + (size_t)t * 768 + h * DQK; r.qa = *(const u32x4*)(qp + sub * 8); r.q1 = *(const unsigned*)(qp + 64 + 2 * sub); r.q2 = *(const unsigned*)(qp + 80 + 2 * sub);
    const bf16_t* kp = (const bf16_t*)(p.ws + WS_KVPRE) + (size_t)t * 1024 + h * 128; r.ka = *(const u32x4*)(kp + sub * 8); r.va = *(const u32x4*)(kp + 64 + sub * 8);
    const bf16_t* kr = pr + OFF_KR; r.k1 = *(const unsigned*)(kr + 2 * sub); r.k2 = *(const unsigned*)(kr + 16 + 2 * sub);
}
__device__ __forceinline__ void mulpair8(const u32x4 u, const u32x4 c, float (&o)[8]) {
    o[0] = bf_lo(u.x) * bf_lo(c.x); o[1] = bf_hi(u.x) * bf_hi(c.x); o[2] = bf_lo(u.y) * bf_lo(c.y); o[3] = bf_hi(u.y) * bf_hi(c.y);
    o[4] = bf_lo(u.z) * bf_lo(c.z); o[5] = bf_hi(u.z) * bf_hi(c.z); o[6] = bf_lo(u.w) * bf_lo(c.w); o[7] = bf_hi(u.w) * bf_hi(c.w); }
__device__ __forceinline__ void tokb_compute(const TokRaw& r, const Params& p, int t, int lane, int h, int sub, const float (&qg)[12], const float (&kg)[12], float if0, float if1,
                                             const float (&cw0)[8], const float (&cw1)[8], const float (&cw2)[8]) {
    bf16_t* Q = (bf16_t*)(p.ws + WS_Q); bf16_t* Kb = (bf16_t*)(p.ws + WS_K); bf16_t* V = (bf16_t*)(p.ws + WS_V); bf16_t* YB = (bf16_t*)(p.ws + WS_YBIN);
    const int b = t >> 13, s = t & (SEQ - 1);
    float rs_q, rs_kv;
    { const float a = bf_lo(r.cq.x), bq = bf_hi(r.cq.x), c = bf_lo(r.cq.y), d = bf_hi(r.cq.y); rs_q = rsqrtf(wave_sum(a * a + bq * bq + c * c + d * d) * (1.f / QLORA) + EPS); }
    { const float a = bf_lo(r.ckv), bq = bf_hi(r.ckv); rs_kv = rsqrtf(wave_sum(a * a + bq * bq) * (1.f / KVLORA) + EPS); }
    { float cu0[8], cu1[8], cu2[8], bb[8]; mulpair8(r.u[0], r.c[0], cu0); mulpair8(r.u[1], r.c[1], cu1); mulpair8(r.u[2], r.c[2], cu2);
      bb[0] = bf_lo(r.bg.x); bb[1] = bf_hi(r.bg.x); bb[2] = bf_lo(r.bg.y); bb[3] = bf_hi(r.bg.y); bb[4] = bf_lo(r.bg.z); bb[5] = bf_hi(r.bg.z); bb[6] = bf_lo(r.bg.w); bb[7] = bf_hi(r.bg.w); float y[8];
#pragma unroll
      for (int j = 0; j < 8; ++j) y[j] = bb[j] * (cw0[j] * r.m0 * cu0[j] + cw1[j] * cu1[j] + cw2[j] * r.m2 * cu2[j]);
      u32x4 o; o.x = pk2(y[0], y[1]); o.y = pk2(y[2], y[3]); o.z = pk2(y[4], y[5]); o.w = pk2(y[6], y[7]); *(u32x4*)(YB + (size_t)t * CONVW + 8 * lane) = o; }
    float c0, s0, c1, s1; sincosf(r.pos * if0, &s0, &c0); sincosf(r.pos * if1, &s1, &c1);
    const size_t rowi = ((size_t)(b * NH + h) * SEQ + s);
    { float v[12] = {bf_lo(r.qa.x), bf_hi(r.qa.x), bf_lo(r.qa.y), bf_hi(r.qa.y), bf_lo(r.qa.z), bf_hi(r.qa.z), bf_lo(r.qa.w), bf_hi(r.qa.w), bf_lo(r.q1), bf_hi(r.q1), bf_lo(r.q2), bf_hi(r.q2)}; float ss = 0.f;
#pragma unroll
      for (int j = 0; j < 12; ++j) { v[j] *= rs_q; ss += v[j] * v[j]; }
      ss += __shfl_xor(ss, 1); ss += __shfl_xor(ss, 2); ss += __shfl_xor(ss, 4);
      const float rstd = rsqrtf(ss * (1.f / DQK) + EPS);
#pragma unroll
      for (int j = 0; j < 12; ++j) v[j] *= rstd * qg[j] * QSCALE;
      const float o8 = v[8] * c0 - v[10] * s0, o9 = v[9] * c1 - v[11] * s1, o10 = v[8] * s0 + v[10] * c0, o11 = v[9] * s1 + v[11] * c1;
      bf16_t* qo = Q + rowi * DQK; u32x4 w; w.x = pk2(v[0], v[1]); w.y = pk2(v[2], v[3]); w.z = pk2(v[4], v[5]); w.w = pk2(v[6], v[7]);
      *(u32x4*)(qo + sub * 8) = w; *(unsigned*)(qo + 64 + 2 * sub) = pk2(o8, o9); *(unsigned*)(qo + 80 + 2 * sub) = pk2(o10, o11); }
    { float v[12] = {bf_lo(r.ka.x) * rs_kv, bf_hi(r.ka.x) * rs_kv, bf_lo(r.ka.y) * rs_kv, bf_hi(r.ka.y) * rs_kv, bf_lo(r.ka.z) * rs_kv, bf_hi(r.ka.z) * rs_kv, bf_lo(r.ka.w) * rs_kv, bf_hi(r.ka.w) * rs_kv,
                   bf_lo(r.k1), bf_hi(r.k1), bf_lo(r.k2), bf_hi(r.k2)}; float ss = 0.f;
#pragma unroll
      for (int j = 0; j < 12; ++j) ss += v[j] * v[j];
      ss += __shfl_xor(ss, 1); ss += __shfl_xor(ss, 2); ss += __shfl_xor(ss, 4);
      const float rstd = rsqrtf(ss * (1.f / DQK) + EPS);
#pragma unroll
      for (int j = 0; j < 12; ++j) v[j] *= rstd * kg[j];
      const float o8 = v[8] * c0 - v[10] * s0, o9 = v[9] * c1 - v[11] * s1, o10 = v[8] * s0 + v[10] * c0, o11 = v[9] * s1 + v[11] * c1;
      bf16_t* ko = Kb + rowi * 128; u32x4 w; w.x = pk2(v[0], v[1]); w.y = pk2(v[2], v[3]); w.z = pk2(v[4], v[5]); w.w = pk2(v[6], v[7]);
      *(u32x4*)(ko + sub * 8) = w; *(unsigned*)(ko + 64 + 2 * sub) = pk2(o8, o9); *(unsigned*)(ko + 80 + 2 * sub) = pk2(o10, o11);
      if (sub < 4) *(u32x4*)(ko + 96 + sub * 8) = (u32x4){0u, 0u, 0u, 0u};
      u32x4 wv; wv.x = pk2(bf_lo(r.va.x) * rs_kv, bf_hi(r.va.x) * rs_kv); wv.y = pk2(bf_lo(r.va.y) * rs_kv, bf_hi(r.va.y) * rs_kv); wv.z = pk2(bf_lo(r.va.z) * rs_kv, bf_hi(r.va.z) * rs_kv); wv.w = pk2(bf_lo(r.va.w) * rs_kv, bf_hi(r.va.w) * rs_kv);
      *(u32x4*)(V + rowi * DV + sub * 8) = wv; }
}
__device__ __forceinline__ void phase_tok_b(const Params& p) {
    const int tid = threadIdx.x, lane = tid & 63, wave = tid >> 6, h = lane >> 3, sub = lane & 7;
    const int gw = blockIdx.x * NWAVES + wave, NGW = gridDim.x * NWAVES;
    float qg[12], kg[12];
#pragma unroll
    for (int j = 0; j < 8; ++j) { qg[j] = p.q_g[sub * 8 + j]; kg[j] = p.k_g[sub * 8 + j]; }
    qg[8] = p.q_g[64 + 2 * sub]; qg[9] = p.q_g[65 + 2 * sub]; qg[10] = p.q_g[80 + 2 * sub]; qg[11] = p.q_g[81 + 2 * sub];
    kg[8] = p.k_g[64 + 2 * sub]; kg[9] = p.k_g[65 + 2 * sub]; kg[10] = p.k_g[80 + 2 * sub]; kg[11] = p.k_g[81 + 2 * sub];
    const float if0 = exp2f(-(float)(2 * sub) * (13.287712379549449f / 16.f)), if1 = exp2f(-(float)(2 * sub + 1) * (13.287712379549449f / 16.f));
    float cw0[8], cw1[8], cw2[8];
#pragma unroll
    for (int j = 0; j < 8; ++j) { cw0[j] = p.conv_w[8 * lane + j]; cw1[j] = p.conv_w[CONVW + 8 * lane + j]; cw2[j] = p.conv_w[2 * CONVW + 8 * lane + j]; }
    for (int t = gw; t < NTOK; t += 2 * NGW) {
        const int t1 = t + NGW; const bool two = t1 < NTOK;
        TokRaw r0, r1; tokb_load(r0, p, t, lane, h, sub); tokb_load(r1, p, two ? t1 : t, lane, h, sub);
        tokb_compute(r0, p, t, lane, h, sub, qg, kg, if0, if1, cw0, cw1, cw2);
        if (two) tokb_compute(r1, p, t1, lane, h, sub, qg, kg, if0, if1, cw0, cw1, cw2);
    }
}

constexpr int WC_EXP_ITEMS = NE * 1536, WC_TILE_F = 32 * 68;
struct WcItem { const float* W; unsigned char* WT; int N, k0, n0, mode; };
__device__ __forceinline__ WcItem wc_decode(const Params& p, int x) {
    WcItem it; const int e = x / 1536, r = x - e * 1536;
    if (r < 1024) { it.W = p.w1 + (size_t)e * DM * 2048; it.WT = p.ws + WS_W1 + (size_t)e * 2048 * DM; it.N = 2048; it.k0 = 64 * (r >> 6); it.n0 = 32 * (r & 63); it.mode = 1; }
    else { const int q = r - 1024; it.W = p.w2 + (size_t)e * DFF * DM; it.WT = p.ws + WS_W2 + (size_t)e * DM * DFF; it.N = DM; it.k0 = 64 * (q >> 5); it.n0 = 32 * (q & 31); it.mode = 0; }
    return it;
}
struct WConv { float* tile; int x0, nitems, cs; f32x4 pend; };
__device__ __forceinline__ void wconv_step(WConv& c, const Params& p, int lane) {
    const int cs = c.cs, nst = 8 * c.nitems;
    if (cs > 0 && cs <= nst) {
        const int kk = 8 * ((cs - 1) & 7) + (lane >> 3), n4 = (lane & 7) * 4; float* t = c.tile + n4 * 68 + kk;
        t[0] = c.pend[0] * W8_SCALE; t[68] = c.pend[1] * W8_SCALE; t[136] = c.pend[2] * W8_SCALE; t[204] = c.pend[3] * W8_SCALE;
        if ((cs & 7) == 0) {
            const WcItem it = wc_decode(p, c.x0 + (cs >> 3) - 1); const int c8 = lane & 7;
#pragma unroll
            for (int j = 0; j < 4; ++j) { const int n = (lane >> 3) + 8 * j; const f32x4 a = *(const f32x4*)(c.tile + n * 68 + 8 * c8), b = *(const f32x4*)(c.tile + n * 68 + 8 * c8 + 4);
                u32x2 o; o.x = pk4_fp8(a[0], a[1], a[2], a[3]); o.y = pk4_fp8(b[0], b[1], b[2], b[3]);
                int row = it.n0 + n; if (it.mode == 1) { const int f = row & 1023; row = ((f >> 7) << 8) + ((row >> 10) << 7) + (f & 127); }
                *(u32x2*)(it.WT + (size_t)row * DM + it.k0 + 8 * c8) = o; }
        }
    }
    if (cs < nst) {
        const WcItem it = wc_decode(p, c.x0 + (cs >> 3)); const int kk = 8 * (cs & 7) + (lane >> 3), n4 = (lane & 7) * 4;
        c.pend = *(const f32x4*)(it.W + (size_t)(it.k0 + kk) * it.N + it.n0 + n4);
    }
    c.cs = cs + 1;
}

namespace att {
constexpr int NW = 8, QBLK = 32, KVBLK = 64;
constexpr float SCALE = 0.10206207261596575f;
constexpr float QSC = SCALE * 1.4426950408889634f;
constexpr int LDQ = DQK, LDK = 128, LDV = DV;
constexpr int SHM_V = KVBLK * DV * 2, SHM_K = KVBLK * 256, SHM_ATTN = 2 * SHM_V + 2 * SHM_K + NW * 64 * 4;
#define KSWZ(row, colB) ((row) * 256 + ((colB) ^ (((row) & 7) << 4)))
#define SBAR() __builtin_amdgcn_sched_barrier(0)
__device__ __forceinline__ int crow(int r, int hi) { return (r & 3) + 8 * (r >> 2) + 4 * hi; }
__device__ __forceinline__ float fadd_s(float a, float b) { float r; asm("v_add_f32_e32 %0, %1, %2" : "=v"(r) : "v"(a), "v"(b)); return r; }
__device__ __forceinline__ unsigned cvtpk(float lo, float hi) { unsigned r; asm volatile("v_cvt_pk_bf16_f32 %0, %1, %2" : "=v"(r) : "v"(lo), "v"(hi)); return r; }
#define EXPH(P) do { _Pragma("unroll") for (int r = 0; r < 16; ++r) P[r] = __builtin_amdgcn_exp2f(P[r]); } while (0)
__device__ __forceinline__ void finishSM(f32x16& p0, f32x16& p1, float& l_reg, bf16x8& pa0, bf16x8& pa1, bf16x8& pa2, bf16x8& pa3) {
    EXPH(p1);
    float ps0 = p0[0], ps1 = p1[0];
#pragma unroll
    for (int r = 1; r < 16; ++r) { ps0 = fadd_s(ps0, p0[r]); ps1 = fadd_s(ps1, p1[r]); }
    l_reg += ps0 + ps1;
#define PK4(P, BASE, OUT) do { unsigned a0 = cvtpk(P[BASE + 0], P[BASE + 1]), a1 = cvtpk(P[BASE + 2], P[BASE + 3]);   \
    unsigned b0 = cvtpk(P[BASE + 4], P[BASE + 5]), b1 = cvtpk(P[BASE + 6], P[BASE + 7]);                              \
    auto r0 = __builtin_amdgcn_permlane32_swap(a0, b0, false, false); auto r1 = __builtin_amdgcn_permlane32_swap(a1, b1, false, false); \
    u32x4 w = {r0[0], r1[0], r0[1], r1[1]}; OUT = *reinterpret_cast<bf16x8*>(&w); } while (0)
    PK4(p0, 0, pa0); PK4(p0, 8, pa1); PK4(p1, 0, pa2); PK4(p1, 8, pa3);
#undef PK4
}
__device__ __forceinline__ void qkt(f32x16& p0, f32x16& p1, const unsigned char* Ks, const bf16x8* qr, int r32, int hi) {
    p0 = f32x16{}; p1 = f32x16{};
#pragma unroll
    for (int d0 = 0; d0 < 6; ++d0) { const int cb = (d0 * 16 + hi * 8) * 2;
        const bf16x8 b0 = *reinterpret_cast<const bf16x8*>(Ks + KSWZ(r32, cb));
        const bf16x8 b1 = *reinterpret_cast<const bf16x8*>(Ks + KSWZ(32 + r32, cb));
        p0 = __builtin_amdgcn_mfma_f32_32x32x16_bf16(b0, qr[d0], p0, 0, 0, 0);
        p1 = __builtin_amdgcn_mfma_f32_32x32x16_bf16(b1, qr[d0], p1, 0, 0, 0); }
}
__device__ __forceinline__ int v_st(int k, int c) { const int kk = (k & ~0xC) | ((k & 4) << 1) | ((k & 8) >> 1); return ((kk >> 3) * 2 + (c >> 5)) * 512 + ((kk & 7) * 32 + (c & 31)) * 2; }
__device__ __forceinline__ int v_rd_base(int lane) { return ((lane & 3) << 3) | (((lane >> 2) & 3) << 6) | (((lane >> 4) & 1) << 5) | (((lane >> 5) & 1) << 8); }
constexpr int v_rd_off(int d0, int ks, int half) { return d0 * 512 + ks * 2048 + half * 1024; }
template <int OFF> __device__ __forceinline__ s16x4 tr_read(int vb) { s16x4 r; asm volatile("ds_read_b64_tr_b16 %0, %1 offset:%2" : "=&v"(r) : "v"(vb), "i"(OFF) : "memory"); return r; }
template <int D0> __device__ __forceinline__ void pv_one(f32x16& od, int vb, bf16x8 pa0, bf16x8 pa1, bf16x8 pa2, bf16x8 pa3) {
    const s16x4 l0 = tr_read<v_rd_off(D0, 0, 0)>(vb), h0 = tr_read<v_rd_off(D0, 0, 1)>(vb), l1 = tr_read<v_rd_off(D0, 1, 0)>(vb), h1 = tr_read<v_rd_off(D0, 1, 1)>(vb);
    const s16x4 l2 = tr_read<v_rd_off(D0, 2, 0)>(vb), h2 = tr_read<v_rd_off(D0, 2, 1)>(vb), l3 = tr_read<v_rd_off(D0, 3, 0)>(vb), h3 = tr_read<v_rd_off(D0, 3, 1)>(vb);
    asm volatile("s_waitcnt lgkmcnt(0)" ::: "memory"); SBAR();
#define PK(L, H) (bf16x8){L[0], L[1], L[2], L[3], H[0], H[1], H[2], H[3]}
    __builtin_amdgcn_s_setprio(1);
    od = __builtin_amdgcn_mfma_f32_32x32x16_bf16(pa0, PK(l0, h0), od, 0, 0, 0);
    od = __builtin_amdgcn_mfma_f32_32x32x16_bf16(pa1, PK(l1, h1), od, 0, 0, 0);
    od = __builtin_amdgcn_mfma_f32_32x32x16_bf16(pa2, PK(l2, h2), od, 0, 0, 0);
    od = __builtin_amdgcn_mfma_f32_32x32x16_bf16(pa3, PK(l3, h3), od, 0, 0, 0);
    __builtin_amdgcn_s_setprio(0);
#undef PK
}
__device__ __forceinline__ void pv_d0(f32x16* o, int vb, bf16x8 pa0, bf16x8 pa1, bf16x8 pa2, bf16x8 pa3) { pv_one<0>(o[0], vb, pa0, pa1, pa2, pa3); pv_one<1>(o[1], vb, pa0, pa1, pa2, pa3); }

__device__ __forceinline__ void attn_unit(const bf16_t* __restrict__ Qb, const bf16_t* __restrict__ Kh, const bf16_t* __restrict__ Vh, bf16_t* __restrict__ Ob, int seq, unsigned char* lds, WConv& wc, const Params& prm) {
    const int tid = threadIdx.x, wid = __builtin_amdgcn_readfirstlane(tid >> 6), lane = tid & 63, r32 = lane & 31, hi = lane >> 5;
    unsigned char* V_lds = lds; unsigned char* K_lds = lds + 2 * SHM_V;
    float* wsf = (float*)(lds + 2 * SHM_V + 2 * SHM_K) + wid * 64; float* li_l = wsf;
    float l_reg = 0; f32x16 o[2] = {}; bf16x8 qr[6];
    const bf16_t* Qw = Qb + (size_t)(wid * QBLK + r32) * LDQ + hi * 8;
#pragma unroll
    for (int d0 = 0; d0 < 6; ++d0) qr[d0] = *reinterpret_cast<const bf16x8*>(Qw + d0 * 16);
    const int kr0 = 8 * wid + (lane >> 4), kcp = lane & 15;
    const bf16_t* ksrc0 = Kh + (size_t)kr0 * LDK + ((kcp ^ (kr0 & 7)) * 8);
    const bf16_t* ksrc1 = Kh + (size_t)(kr0 + 4) * LDK + ((kcp ^ ((kr0 + 4) & 7)) * 8);
    const int vkk = 8 * wid + ((lane >> 2) & 7), vk = (vkk & ~0xC) | ((vkk & 4) << 1) | ((vkk & 8) >> 1), vcc = 32 * (lane >> 5) + 8 * (lane & 3);
    const bf16_t* vsrc = Vh + (size_t)vk * LDV + vcc;
    typedef __attribute__((address_space(3))) unsigned* lds_u32p;
#define DMA_K(t, slot) do { __builtin_amdgcn_global_load_lds((const unsigned*)(ksrc0 + (size_t)(t) * KVBLK * LDK), (lds_u32p)(K_lds + (slot) * SHM_K + wid * 2048 + lane * 16), 16, 0, 0); \
                            __builtin_amdgcn_global_load_lds((const unsigned*)(ksrc1 + (size_t)(t) * KVBLK * LDK), (lds_u32p)(K_lds + (slot) * SHM_K + wid * 2048 + 1024 + lane * 16), 16, 0, 0); } while (0)
#define DMA_V(t, slot) __builtin_amdgcn_global_load_lds((const unsigned*)(vsrc + (size_t)(t) * KVBLK * LDV), (lds_u32p)(V_lds + (slot) * SHM_V + wid * 1024 + lane * 16), 16, 0, 0)
    const int vb0 = (int)(uintptr_t)V_lds + v_rd_base(lane);
    f32x16 pA0, pA1, pB0, pB1; bf16x8 pa0, pa1, pa2, pa3; const int NT = seq / KVBLK;
    DMA_K(0, 0); DMA_V(0, 0); DMA_K(1, 1);
    asm volatile("s_waitcnt vmcnt(0)" ::: "memory"); __syncthreads();
    qkt(pA0, pA1, K_lds, qr, r32, hi); EXPH(pA0); SBAR();
    __syncthreads();
    for (int j = 0; j + 2 < NT; j += 2) {
        DMA_K(j + 2, 0); DMA_V(j + 1, 1); wconv_step(wc, prm, lane); SBAR();
        qkt(pB0, pB1, K_lds + SHM_K, qr, r32, hi);
        finishSM(pA0, pA1, l_reg, pa0, pa1, pa2, pa3); SBAR();
        pv_d0(o, vb0, pa0, pa1, pa2, pa3); EXPH(pB0); SBAR();
        asm volatile("s_waitcnt vmcnt(0)" ::: "memory"); __syncthreads();
        DMA_K(j + 3, 1); DMA_V(j + 2, 0); wconv_step(wc, prm, lane); SBAR();
        qkt(pA0, pA1, K_lds, qr, r32, hi);
        finishSM(pB0, pB1, l_reg, pa0, pa1, pa2, pa3); SBAR();
        pv_d0(o, vb0 + SHM_V, pa0, pa1, pa2, pa3); EXPH(pA0); SBAR();
        asm volatile("s_waitcnt vmcnt(0)" ::: "memory"); __syncthreads();
    }
    DMA_V(NT - 1, 1); wconv_step(wc, prm, lane); SBAR();
    qkt(pB0, pB1, K_lds + SHM_K, qr, r32, hi);
    finishSM(pA0, pA1, l_reg, pa0, pa1, pa2, pa3); SBAR();
    pv_d0(o, vb0, pa0, pa1, pa2, pa3); EXPH(pB0); SBAR();
    asm volatile("s_waitcnt vmcnt(0)" ::: "memory"); __syncthreads();
    finishSM(pB0, pB1, l_reg, pa0, pa1, pa2, pa3); SBAR();
    pv_d0(o, vb0 + SHM_V, pa0, pa1, pa2, pa3);
    { auto rr = __builtin_amdgcn_permlane32_swap(__float_as_uint(l_reg), __float_as_uint(l_reg), false, false); l_reg = __uint_as_float(rr[0]) + __uint_as_float(rr[1]); }
    if (hi == 0) li_l[r32] = l_reg; asm volatile("s_waitcnt lgkmcnt(0)" ::: "memory");
    float rli[16];
#pragma unroll
    for (int r = 0; r < 16; ++r) rli[r] = __builtin_amdgcn_rcpf(li_l[crow(r, hi)]);
    bf16_t* Ow = Ob + (size_t)(wid * QBLK) * 512;
#pragma unroll
    for (int r = 0; r < 16; ++r) { const int orow = crow(r, hi);
#pragma unroll
        for (int d0 = 0; d0 < 2; ++d0) Ow[(size_t)orow * 512 + d0 * 32 + r32] = (bf16_t)(pk2(o[d0][r] * rli[r], 0.f) & 0xffffu); }
    __syncthreads();
#undef DMA_K
#undef DMA_V
}
#undef KSWZ
#undef SBAR
}

__device__ __forceinline__ void phase_attn(const Params& p, unsigned char* lds) {
    const bf16_t* Q = (const bf16_t*)(p.ws + WS_Q); const bf16_t* Kb = (const bf16_t*)(p.ws + WS_K); const bf16_t* V = (const bf16_t*)(p.ws + WS_V); bf16_t* AO = (bf16_t*)(p.ws + WS_AO);
    constexpr int NQB = SEQ / 256, NU = 2 * NH * NQB;
    const int lane = threadIdx.x & 63, wave = __builtin_amdgcn_readfirstlane(threadIdx.x >> 6), gw = blockIdx.x * NWAVES + wave, NGW = gridDim.x * NWAVES;
    const int ipw = (WC_EXP_ITEMS + NGW - 1) / NGW, nun = ((int)blockIdx.x < NU) ? (NU - 1 - (int)blockIdx.x) / (int)gridDim.x + 1 : 0, steps = nun * (SEQ / att::KVBLK - 1);
    int cov = (steps - 1) / 8; cov = cov < 0 ? 0 : (cov > ipw ? ipw : cov);
    WConv wc; wc.tile = (float*)(lds + att::SHM_ATTN) + wave * WC_TILE_F; wc.x0 = gw * ipw; wc.cs = 0; wc.pend = (f32x4){0.f, 0.f, 0.f, 0.f};
    { const int left = WC_EXP_ITEMS - wc.x0; wc.nitems = left < 0 ? 0 : (left < cov ? left : cov); }
    for (int u = blockIdx.x; u < NU; u += gridDim.x) {
        const int qb = u % NQB, h = (u / NQB) % NH, b = u / (NQB * NH); const size_t bh = (size_t)(b * NH + h) * SEQ;
        att::attn_unit(Q + (bh + (size_t)qb * 256) * DQK, Kb + bh * 128, V + bh * DV, AO + ((size_t)b * SEQ + (size_t)qb * 256) * 512 + h * DV, SEQ, lds, wc, p);
    }
    while (wc.cs <= 8 * wc.nitems) wconv_step(wc, p, lane);
}
__device__ __forceinline__ void wconv_cleanup(const Params& p, unsigned char* lds) {
    constexpr int NQB = SEQ / 256, NU = 2 * NH * NQB;
    const int lane = threadIdx.x & 63, wave = threadIdx.x >> 6, gw = blockIdx.x * NWAVES + wave, NGW = gridDim.x * NWAVES;
    const int ipw = (WC_EXP_ITEMS + NGW - 1) / NGW, nun = ((int)blockIdx.x < NU) ? (NU - 1 - (int)blockIdx.x) / (int)gridDim.x + 1 : 0, steps = nun * (SEQ / att::KVBLK - 1);
    int cov = (steps - 1) / 8; cov = cov < 0 ? 0 : (cov > ipw ? ipw : cov);
    float* scr = (float*)(lds + wave * 16384);
    for (int i = cov; i < ipw; ++i) { const int x = gw * ipw + i; if (x >= WC_EXP_ITEMS) break; const WcItem it = wc_decode(p, x); const int r = x % 1536;
        if (it.mode == 1) transpose_item_fp8<1>(it.W, DM, 2048, it.WT, scr, r, lane); else transpose_item_fp8<0>(it.W, DFF, DM, it.WT, scr, r - 1024, lane); }
    __syncthreads();
}

__device__ __forceinline__ int crow16(int r, int hi) { return (r & 3) + 8 * (r >> 2) + 4 * hi; }
__device__ __forceinline__ void phase_router(const Params& p, unsigned char* lds) {
    const int tid = threadIdx.x, lane = tid & 63, wid = tid >> 6, tile = wid >> 2, kq = wid & 3, c = lane & 31, h = lane >> 5;
    float* red = (float*)lds;
    float* ssb = red + 2 * 4 * 16 * 64;
    int* lcnt = (int*)(ssb + 2 * 4 * 64);
    int* lbase = lcnt + 32;
    unsigned* gcnt = (unsigned*)(p.ws + WS_CTL) + CW_CNT;
    int* row_tok = (int*)(p.ws + WS_RT2); float* row_w = (float*)(p.ws + WS_RT2 + 2 * MiB); int* row_slot = (int*)(p.ws + WS_RT2 + 4 * MiB); float* row_rstd = (float*)(p.ws + WS_RT2 + 6 * MiB);
    const u32x4* GF = (const u32x4*)(p.ws + WS_GF);
    for (int tg = blockIdx.x; tg < NTOK / 64; tg += gridDim.x) {
        if (tid < 32) lcnt[tid] = 0;
        const int token = tg * 64 + tile * 32 + c;
        const float* xrow = p.out + (size_t)token * DM + kq * 256 + 8 * h; const float* g2p = p.norm2_g + kq * 256 + 8 * h;
        unsigned char* hrow = p.ws + WS_H8 + (size_t)token * DM + kq * 256 + 8 * h;
        f32x16 acc = {}; float ss = 0.f;
#pragma unroll 2
        for (int s = 0; s < 16; ++s) {
            const f32x4 a = *(const f32x4*)(xrow + 16 * s), b = *(const f32x4*)(xrow + 16 * s + 4); const f32x4 ga = *(const f32x4*)(g2p + 16 * s), gb = *(const f32x4*)(g2p + 16 * s + 4);
            ss += (a[0] * a[0] + a[1] * a[1]) + (a[2] * a[2] + a[3] * a[3]) + (b[0] * b[0] + b[1] * b[1]) + (b[2] * b[2] + b[3] * b[3]);
            u32x4 xh; xh.x = pk2(a[0], a[1]); xh.y = pk2(a[2], a[3]); xh.z = pk2(b[0], b[1]); xh.w = pk2(b[2], b[3]);
            u32x4 xl; xl.x = pk2(a[0] - bf_lo(xh.x), a[1] - bf_hi(xh.x)); xl.y = pk2(a[2] - bf_lo(xh.y), a[3] - bf_hi(xh.y)); xl.z = pk2(b[0] - bf_lo(xh.z), b[1] - bf_hi(xh.z)); xl.w = pk2(b[2] - bf_lo(xh.w), b[3] - bf_hi(xh.w));
            u32x2 h8; h8.x = pk4_fp8(a[0] * ga[0], a[1] * ga[1], a[2] * ga[2], a[3] * ga[3]); h8.y = pk4_fp8(b[0] * gb[0], b[1] * gb[1], b[2] * gb[2], b[3] * gb[3]); *(u32x2*)(hrow + 16 * s) = h8;
            const u32x4 gh = GF[((kq * 16 + s) * 2 + 0) * 64 + lane], gl = GF[((kq * 16 + s) * 2 + 1) * 64 + lane];
            acc = __builtin_amdgcn_mfma_f32_32x32x16_bf16(__builtin_bit_cast(bf16x8, gh), __builtin_bit_cast(bf16x8, xh), acc, 0, 0, 0);
            acc = __builtin_amdgcn_mfma_f32_32x32x16_bf16(__builtin_bit_cast(bf16x8, gh), __builtin_bit_cast(bf16x8, xl), acc, 0, 0, 0);
            acc = __builtin_amdgcn_mfma_f32_32x32x16_bf16(__builtin_bit_cast(bf16x8, gl), __builtin_bit_cast(bf16x8, xh), acc, 0, 0, 0);
        }
#pragma unroll
        for (int r = 0; r < 16; ++r) red[((tile * 4 + kq) * 16 + r) * 64 + lane] = acc[r];
        ssb[(tile * 4 + kq) * 64 + lane] = ss;
        __syncthreads();
        int te[4] = {0, 0, 0, 0}, rl[4] = {0, 0, 0, 0}; float tw[4] = {0.f, 0.f, 0.f, 0.f}; float rstd = 0.f;
        if (kq == 0) {
            float v[16]; float st = 0.f;
#pragma unroll
            for (int q = 0; q < 4; ++q) st += ssb[(tile * 4 + q) * 64 + lane];
            { auto rr = __builtin_amdgcn_permlane32_swap(__float_as_uint(st), __float_as_uint(st), false, false); st = __uint_as_float(rr[0]) + __uint_as_float(rr[1]); }
            rstd = rsqrtf(st * (1.f / DM) + EPS);
#pragma unroll
            for (int r = 0; r < 16; ++r) { float sacc = 0.f;
#pragma unroll
                for (int q = 0; q < 4; ++q) sacc += red[((tile * 4 + q) * 16 + r) * 64 + lane];
                v[r] = sacc * rstd + p.router_b[crow16(r, h)]; }
            float lv[4]; int le[4];
#pragma unroll
            for (int k = 0; k < 4; ++k) { float best = v[0]; int bi = 0;
#pragma unroll
                for (int r = 1; r < 16; ++r) { const bool gt = v[r] > best; best = gt ? v[r] : best; bi = gt ? r : bi; }
                lv[k] = best; le[k] = (bi & 3) + 8 * (bi >> 2) + 4 * h;
#pragma unroll
                for (int r = 0; r < 16; ++r) v[r] = (r == bi) ? -INFINITY : v[r]; }
            float cv[8]; int ce[8];
#pragma unroll
            for (int k = 0; k < 4; ++k) { auto rv = __builtin_amdgcn_permlane32_swap(__float_as_uint(lv[k]), __float_as_uint(lv[k]), false, false); auto re = __builtin_amdgcn_permlane32_swap((unsigned)le[k], (unsigned)le[k], false, false);
                cv[k] = __uint_as_float(rv[0]); cv[4 + k] = __uint_as_float(rv[1]); ce[k] = (int)re[0]; ce[4 + k] = (int)re[1]; }
            float tv[4];
#pragma unroll
            for (int k = 0; k < 4; ++k) { float best = cv[0]; int be = ce[0]; int bi = 0;
#pragma unroll
                for (int r = 1; r < 8; ++r) { const bool gt = (cv[r] > best) || (cv[r] == best && ce[r] < be); best = gt ? cv[r] : best; be = gt ? ce[r] : be; bi = gt ? r : bi; }
                tv[k] = best; te[k] = be;
#pragma unroll
                for (int r = 0; r < 8; ++r) cv[r] = (r == bi) ? -INFINITY : cv[r]; }
            const float e1 = __expf(tv[1] - tv[0]), e2 = __expf(tv[2] - tv[0]), e3 = __expf(tv[3] - tv[0]); const float inv = 1.f / (1.f + e1 + e2 + e3);
            tw[0] = inv; tw[1] = e1 * inv; tw[2] = e2 * inv; tw[3] = e3 * inv;
            if (h == 0) {
#pragma unroll
                for (int k = 0; k < 4; ++k) rl[k] = atomicAdd(&lcnt[te[k]], 1); }
        }
        __syncthreads();
        if (tid < 32) lbase[tid] = (int)atomicAdd(&gcnt[tid], (unsigned)lcnt[tid]);
        __syncthreads();
        if (kq == 0 && h == 0) {
#pragma unroll
            for (int k = 0; k < 4; ++k) { const int idx = te[k] * CAP + lbase[te[k]] + rl[k]; row_tok[idx] = token; row_w[idx] = tw[k]; row_slot[idx] = token * 4 + k; row_rstd[idx] = rstd; } }
        __syncthreads();
    }
}

__device__ __forceinline__ void build_block_table(const Params& p, int* bs) {
    const unsigned* gcnt = (const unsigned*)(p.ws + WS_CTL) + CW_CNT;
    if (threadIdx.x == 0) { int acc = 0; for (int e = 0; e < NE; ++e) { bs[e] = acc; acc += ((int)__hip_atomic_load(gcnt + e, __ATOMIC_RELAXED, __HIP_MEMORY_SCOPE_AGENT) + 255) >> 8; } bs[NE] = acc; }
    __syncthreads();
}

__device__ __forceinline__ pg8::MoeOrder make_moe_order(const Params& p, unsigned char* lds, int N, bool gather) {
    int* bs = (int*)(lds + 131072); int* utab = (int*)(lds + 131072 + 256); int* gtab = (int*)(lds + 131072 + 512);
    build_block_table(p, bs);
    const int nmb = __builtin_amdgcn_readfirstlane(bs[NE]);
    pg8::MoeOrder S; S.so.init(nmb * 256, N, (int)gridDim.x, (int)blockIdx.x); S.utab = (const PG8_LAS int*)utab; S.gtab = (const PG8_LAS int*)gtab;
    const int* row_tok = (const int*)(p.ws + WS_RT2);
    for (int i = 0; i < pg8::MOE_MAXU; ++i) { pg8::Unit u; if (!S.so.next(i, u)) break; int e = 0; for (int k = 1; k < NE; ++k) if (bs[k] <= u.pm) e = k;
        const int rb = e * CAP + (u.pm - bs[e]) * 256;
        if (threadIdx.x == 0) utab[i] = e | (rb << 8);
        if (gather && threadIdx.x < 256) gtab[i * 256 + threadIdx.x] = row_tok[rb + threadIdx.x]; }
    __syncthreads();
    return S;
}
__device__ __forceinline__ void phase_moe1(const Params& p, unsigned char* lds) {
    const pg8::MoeOrder S = make_moe_order(p, lds, 2048, true);
    pg8::Gemm g{(const bf16_t*)(p.ws + WS_H8), (const bf16_t*)(p.ws + WS_W1), 0, 2048, DM / 2, (size_t)2048 * DM, 0};
    pg8::EpiSwiglu E{p.ws + WS_ACT, p.b1, (const float*)(p.ws + WS_RT2 + 6 * MiB)};
    pg8::gemm_phase<pg8::EpiSwiglu, pg8::MoeOrder, true, true, true, true>((PG8_LAS unsigned char*)lds, g, S, E);
}
__device__ __forceinline__ void phase_moe2(const Params& p, unsigned char* lds) {
    const pg8::MoeOrder S = make_moe_order(p, lds, DM, false);
    pg8::Gemm g{(const bf16_t*)(p.ws + WS_ACT), (const bf16_t*)(p.ws + WS_W2), 0, DM, DFF / 2, (size_t)DM * DFF, 0};
    pg8::EpiMoeOut E{(bf16_t*)(p.ws + WS_YS), p.b2, (const float*)(p.ws + WS_RT2 + 2 * MiB), (const int*)(p.ws + WS_RT2 + 4 * MiB)};
    pg8::gemm_phase<pg8::EpiMoeOut, pg8::MoeOrder, true, true, true>((PG8_LAS unsigned char*)lds, g, S, E);
}

__device__ __forceinline__ void phase_combine(const Params& p) {
    const int tid = threadIdx.x, lane = tid & 63, wave = tid >> 6;
    const int gw = blockIdx.x * NWAVES + wave, NGW = gridDim.x * NWAVES;
    const bf16_t* YS = (const bf16_t*)(p.ws + WS_YS);
    for (int t = gw; t < NTOK; t += NGW) {
        f32x4* orow = (f32x4*)(p.out + (size_t)t * DM) + lane;
#pragma unroll
        for (int j = 0; j < 4; ++j) { f32x4 v = orow[64 * j];
#pragma unroll
            for (int k = 0; k < 4; ++k) { const u32x2 w = *((const u32x2*)(YS + ((size_t)t * 4 + k) * DM) + lane + 64 * j); v[0] += bf_lo(w.x); v[1] += bf_hi(w.x); v[2] += bf_lo(w.y); v[3] += bf_hi(w.y); }
            orow[64 * j] = v; }
    }
}

template <class Epi>
__device__ __forceinline__ void dense_gemm(unsigned char* lds, const bf16_t* A, const bf16_t* Bt, int M, int N, int K, const Epi& E, int lda = 0) {
    pg8::Gemm g{A, Bt, M, N, K, 0, lda}; pg8::StaticOrder S; S.init(M, N, (int)gridDim.x, (int)blockIdx.x);
    pg8::gemm_phase<Epi, pg8::StaticOrder, true, true>((PG8_LAS unsigned char*)lds, g, S, E);
}

constexpr int NPHASE = 13;
__global__ void __launch_bounds__(NTHREADS, 2) mk_fwd(Params p) {
    extern __shared__ __attribute__((aligned(16))) unsigned char lds[];
    cg::grid_group grid = cg::this_grid();
    unsigned char* ws = p.ws;
    volatile LAS unsigned* MISC = (volatile LAS unsigned*)((LAS unsigned char*)lds + MISC_OFF);
    if (threadIdx.x < 32) MISC[threadIdx.x] = 0u;
    __syncthreads();
    XcdBarrier bar = xcd_barrier_post((unsigned*)(ws + WS_CTL) + CW_BAR, MISC + 8);
    const int lo = p.ph_lo, hi = p.ph_hi;
    if (lo < 0) grid.sync();
#define IN(k) (lo <= (k) && (k) < hi)
#define SEAM(k) do { if (IN(k) && IN((k) + 1)) xcd_barrier(bar); } while (0)
    if (IN(0)) phase_prologue(p, lds);
    SEAM(0);
    if (IN(1)) { pg8::EpiProj E{(bf16_t*)(ws + WS_PROJ)}; dense_gemm(lds, (const bf16_t*)(ws + WS_XN), (const bf16_t*)(ws + WS_WIN), NTOK, INCP, DM, E); }
    if (IN(1) && IN(3)) xcd_barrier(bar);
    if (IN(3)) { pg8::EpiBf16 Eq{(bf16_t*)(ws + WS_QPRE), 768}; dense_gemm(lds, (const bf16_t*)(ws + WS_PROJ) + OFF_CQ, (const bf16_t*)(ws + WS_WUQ), NTOK, 768, QLORA, Eq, INCP);
                 pg8::EpiBf16 Ek{(bf16_t*)(ws + WS_KVPRE), 1024}; dense_gemm(lds, (const bf16_t*)(ws + WS_PROJ) + OFF_CKV, (const bf16_t*)(ws + WS_WUKV), NTOK, 1024, KVLORA, Ek, INCP); }
    SEAM(3);
    if (IN(4)) phase_tok_b(p);
    SEAM(4);
    if (IN(5)) phase_attn(p, lds);
    SEAM(5);
    if (IN(6)) { pg8::EpiGateA E{(bf16_t*)(ws + WS_M1), (const bf16_t*)(ws + WS_PROJ)}; dense_gemm(lds, (const bf16_t*)(ws + WS_AO), (const bf16_t*)(ws + WS_WOMLA), NTOK, DM, 512, E); }
    if (IN(7)) { pg8::EpiGateB E{(const bf16_t*)(ws + WS_M1), (const bf16_t*)(ws + WS_PROJ), (bf16_t*)(ws + WS_MERGED)}; dense_gemm(lds, (const bf16_t*)(ws + WS_YBIN), (const bf16_t*)(ws + WS_WOCONV), NTOK, DM, 512, E); }
    SEAM(7);
    if (IN(8)) { pg8::EpiResid E{p.x, p.out}; dense_gemm(lds, (const bf16_t*)(ws + WS_MERGED), (const bf16_t*)(ws + WS_WO), NTOK, DM, DM, E); }
    SEAM(8);
    if (IN(9)) { wconv_cleanup(p, lds); phase_router(p, lds); }
    if (IN(9) && IN(11)) xcd_barrier(bar);
    if (IN(11)) phase_moe1(p, lds);
    SEAM(11);
    if (IN(12)) phase_moe2(p, lds);
    SEAM(12);
    if (IN(13)) phase_combine(p);
#undef IN
#undef SEAM
}

extern "C" void kernel_launch(void* const* d_in, const int* in_sizes, int n_in, void* d_out, int out_size,
                              void* d_ws, size_t ws_size, hipStream_t stream) {
    static int grid_blocks = 0;
    if (!grid_blocks) {
        int dev = 0, cus = 0, per_cu = 0;
        (void)hipGetDevice(&dev);
        (void)hipDeviceGetAttribute(&cus, hipDeviceAttributeMultiprocessorCount, dev);
        (void)hipFuncSetAttribute((const void*)mk_fwd, hipFuncAttributeMaxDynamicSharedMemorySize, LDS_BYTES);
        (void)hipOccupancyMaxActiveBlocksPerMultiprocessor(&per_cu, (const void*)mk_fwd, NTHREADS, LDS_BYTES);
        if (per_cu < 1) { fprintf(stderr, "kernel_launch: occupancy query says %d blocks/CU\n", per_cu); per_cu = 1; }
        grid_blocks = cus;
        if (ws_size < WS_END2 || n_in != 21) fprintf(stderr, "kernel_launch: ws %zu < %zu or n_in %d != 21\n", ws_size, (size_t)WS_END2, n_in);
    }
    (void)hipMemsetAsync((char*)d_ws + WS_CTL, 0, 1 * MiB, stream);
    Params p{};
    p.x = (const float*)d_in[0]; p.pos = (const int*)d_in[1]; p.norm1_g = (const float*)d_in[2]; p.w_in = (const float*)d_in[3]; p.q_a_g = (const float*)d_in[4];
    p.kv_a_g = (const float*)d_in[5]; p.w_uq = (const float*)d_in[6]; p.w_ukv = (const float*)d_in[7]; p.q_g = (const float*)d_in[8]; p.k_g = (const float*)d_in[9];
    p.conv_w = (const float*)d_in[10]; p.w_o_mla = (const float*)d_in[11]; p.w_o_conv = (const float*)d_in[12]; p.w_o = (const float*)d_in[13]; p.norm2_g = (const float*)d_in[14];
    p.router_w = (const float*)d_in[15]; p.router_b = (const float*)d_in[16]; p.w1 = (const float*)d_in[17]; p.b1 = (const float*)d_in[18]; p.w2 = (const float*)d_in[19]; p.b2 = (const float*)d_in[20];
    p.out = (float*)d_out; p.ws = (unsigned char*)d_ws; p.ph_lo = 0; p.ph_hi = NPHASE + 1;
    void* args[] = {&p};
    hipError_t e = hipLaunchCooperativeKernel((const void*)mk_fwd, dim3(grid_blocks), dim3(NTHREADS), args, LDS_BYTES, stream);
    if (e != hipSuccess) fprintf(stderr, "cooperative launch failed: %s (grid %d)\n", hipGetErrorString(e), grid_blocks);
}
```

```cpp
#include <hip/hip_runtime.h>
#include <hip/hip_cooperative_groups.h>
#include <cstdio>
#include <cstdint>
namespace cg = cooperative_groups;

typedef unsigned short bf16_t;
typedef short bf16x8 __attribute__((ext_vector_type(8)));
typedef short s16x4 __attribute__((ext_vector_type(4)));
typedef float f32x4 __attribute__((ext_vector_type(4)));
typedef float f32x2 __attribute__((ext_vector_type(2)));
typedef float f32x16 __attribute__((ext_vector_type(16)));
typedef unsigned u32x4 __attribute__((ext_vector_type(4)));
typedef unsigned u32x2 __attribute__((ext_vector_type(2)));
typedef __bf16 bf16x2_t __attribute__((ext_vector_type(2)));

constexpr int NTOK = 16384, DM = 1024, SEQ = 8192;
constexpr int INC = 4000, INCP = 4096;
constexpr int OFF_CQ = 0, OFF_CKV = 256, OFF_KR = 384, OFF_U = 416, OFF_C = 928, OFF_B = 1440, OFF_GA = 1952, OFF_GB = 2976;
constexpr int NH = 8, DQK = 96, DV = 64, NE = 32, TOPK = 4, DFF = 1024;
constexpr int QLORA = 256, KVLORA = 128, CONVW = 512;
constexpr int NPAIR = NTOK * TOPK;
constexpr int MAXROWS = 73728;
constexpr float EPS = 1e-6f;
constexpr int CAP = 16384;
constexpr int NTHREADS = 512, NWAVES = 8;
constexpr int LDS_BYTES = 147456;

constexpr size_t MiB = 1ull << 20;
constexpr size_t WS_CTL = 0;
constexpr size_t WS_WIN = 1 * MiB;
constexpr size_t WS_WUQ = 9 * MiB;
constexpr size_t WS_WUKV = WS_WUQ + 512 * 1024;
constexpr size_t WS_WOMLA = 10 * MiB;
constexpr size_t WS_WOCONV = 11 * MiB;
constexpr size_t WS_WO = 12 * MiB;
constexpr size_t WS_ROUTE = 14 * MiB;
constexpr size_t WS_W1 = 18 * MiB;
constexpr size_t WS_W2 = 146 * MiB;
constexpr size_t WS_XN = 210 * MiB;
constexpr size_t WS_PROJ = 242 * MiB;
constexpr size_t WS_CQN = 370 * MiB;
constexpr size_t WS_CKVN = 378 * MiB;
constexpr size_t WS_YBIN = 386 * MiB;
constexpr size_t WS_QPRE = 402 * MiB;
constexpr size_t WS_KVPRE = 450 * MiB;
constexpr size_t WS_Q = 514 * MiB;
constexpr size_t WS_K = 538 * MiB;
constexpr size_t WS_V = 570 * MiB;
constexpr size_t WS_AO = 586 * MiB;
constexpr size_t WS_M1 = 602 * MiB;
constexpr size_t WS_MERGED = 666 * MiB;
constexpr size_t WS_YS = 698 * MiB;
constexpr size_t WS_END = 826 * MiB;
constexpr size_t WS_ACT = WS_PROJ;
constexpr size_t WS_H8 = WS_XN;
constexpr size_t WS_GF = 830 * MiB;
constexpr size_t WS_RT2 = 832 * MiB;
constexpr size_t WS_END2 = 840 * MiB;
constexpr size_t RT_PAIR_E = 0, RT_PAIR_RANK = 262144, RT_PAIR_W = 524288, RT_ROW_TOK = 786432, RT_ROW_W = 786432 + 294912, RT_ROW_SLOT = 786432 + 2 * 294912;
constexpr int CW_CNT = 64;
constexpr int CW_BAR = 4096;
constexpr int MISC_OFF = LDS_BYTES - 256;

struct Params {
    const float* x; const int* pos; const float* norm1_g; const float* w_in; const float* q_a_g; const float* kv_a_g;
    const float* w_uq; const float* w_ukv; const float* q_g; const float* k_g; const float* conv_w; const float* w_o_mla;
    const float* w_o_conv; const float* w_o; const float* norm2_g; const float* router_w; const float* router_b;
    const float* w1; const float* b1; const float* w2; const float* b2;
    float* out; unsigned char* ws; int ph_lo, ph_hi;
};

__device__ __forceinline__ unsigned pk2(float lo, float hi) { f32x2 v = {lo, hi}; bf16x2_t b = __builtin_convertvector(v, bf16x2_t); return __builtin_bit_cast(unsigned, b); }
__device__ __forceinline__ float bf_lo(unsigned w) { return __uint_as_float(w << 16); }
__device__ __forceinline__ float bf_hi(unsigned w) { return __uint_as_float(w & 0xffff0000u); }
__device__ __forceinline__ float bf1(bf16_t h) { return __uint_as_float((unsigned)h << 16); }
__device__ __forceinline__ float wave_sum(float v) {
#pragma unroll
    for (int o = 1; o < 64; o <<= 1) v += __shfl_xor(v, o);
    return v;
}
__device__ __forceinline__ unsigned pk4_fp8(float a, float b, float c, float d) { unsigned w = 0u; w = (unsigned)__builtin_amdgcn_cvt_pk_fp8_f32(a, b, (int)w, false); w = (unsigned)__builtin_amdgcn_cvt_pk_fp8_f32(c, d, (int)w, true); return w; }
constexpr float W8_SCALE = 32.f, W8_INV = 1.f / 32.f;
__device__ __forceinline__ float sigmoidf_(float v) { return __builtin_amdgcn_rcpf(1.f + __builtin_amdgcn_exp2f(v * -1.4426950408889634f)); }

namespace pg8 {
#define PG8_LAS __attribute__((address_space(3)))
constexpr int BM = 256, BK = 64, HALF = 128, HTB = HALF * BK * 2  , STAGE_BYTES = 8 * HTB, NXCD = 8, WGM = 8;

__host__ __device__ __forceinline__ int lds_byte(int r, int c) { const int st = (r >> 4) * 2 + (c >> 5), rr = r & 15, cc = c & 31, ob = rr * 64 + cc * 2; return st * 1024 + (ob ^ (((ob >> 9) & 1) << 5)); }
__host__ __device__ __forceinline__ void stage_rc(int b, int& R, int& C) { const int st = b / 1024, sb = b % 1024, swz = sb ^ (((sb >> 9) & 1) << 5); R = (st >> 1) * 16 + swz / 64; C = (st & 1) * 32 + (swz % 64) / 2; }
__host__ __device__ __forceinline__ int perm32(int rho) { const int n = rho >> 4, i = rho & 15; return 8 * (i >> 2) + 4 * n + (i & 3); }

struct Unit { int pm, pn, e, rb; };
struct Gemm { const bf16_t* A; const bf16_t* Bt; int M, N, K; size_t bstride; int lda; };

struct StaticOrder {
    int nM, nN, nwg, G, c;
    __host__ __device__ void init(int M, int N, int G_, int c_) { nM = M / BM; nN = N / BM; nwg = nM * nN; G = G_; c = c_; }
    __host__ __device__ bool next(int i, Unit& u) const {
        const long L = (long)i * G + c; if (L >= nwg) return false;
        int wgid = (int)L; { const int q = nwg / NXCD, r = nwg % NXCD, xcd = wgid % NXCD, off = wgid / NXCD; wgid = (xcd < r ? xcd * (q + 1) : r * (q + 1) + (xcd - r) * q) + off; }
        const int nig = WGM * nN, gid = wgid / nig, fm = gid * WGM, gsz = (nM - fm) < WGM ? (nM - fm) : WGM;
        u.pm = fm + ((wgid % nig) % gsz); u.pn = (wgid % nig) / gsz; u.e = 0; u.rb = 0; return true;
    }
    __device__ __forceinline__ void a_ready(const Unit&) const {}
    __device__ __forceinline__ void done(const Unit&) const {}
};


struct EpiProj {
    static constexpr bool PERM = true, AFTER_DRAIN = false;
    bf16_t* O;
    __device__ __forceinline__ void operator()(const f32x4 (&acc)[2][2][4][2], const Unit& u, int wr, int wc, int fr, int fq) const {
        const int row0 = u.pm * BM + wr * 64 + fr, col0 = u.pn * BM + wc * 32 + 8 * fq;
#pragma unroll
        for (int ai = 0; ai < 2; ++ai)
#pragma unroll
            for (int m = 0; m < 4; ++m) { bf16_t* rowp = O + (size_t)(row0 + ai * HALF + m * 16) * INCP + col0;
#pragma unroll
                for (int bj = 0; bj < 2; ++bj) { f32x4 v0 = acc[ai][bj][m][0], v1 = acc[ai][bj][m][1]; const int col = col0 + bj * HALF;
                    if (col >= OFF_GA && col < INC) {
#pragma unroll
                        for (int j = 0; j < 4; ++j) { v0[j] = sigmoidf_(v0[j]); v1[j] = sigmoidf_(v1[j]); } }
                    u32x4 w; w.x = pk2(v0[0], v0[1]); w.y = pk2(v0[2], v0[3]); w.z = pk2(v1[0], v1[1]); w.w = pk2(v1[2], v1[3]);
                    *(u32x4*)(rowp + bj * HALF) = w; } }
    }
};
struct EpiBf16 {
    static constexpr bool PERM = true, AFTER_DRAIN = false;
    bf16_t* O; int ldc;
    __device__ __forceinline__ void operator()(const f32x4 (&acc)[2][2][4][2], const Unit& u, int wr, int wc, int fr, int fq) const {
        const int row0 = u.pm * BM + wr * 64 + fr, col0 = u.pn * BM + wc * 32 + 8 * fq;
#pragma unroll
        for (int ai = 0; ai < 2; ++ai)
#pragma unroll
            for (int m = 0; m < 4; ++m) { bf16_t* rowp = O + (size_t)(row0 + ai * HALF + m * 16) * ldc + col0;
#pragma unroll
                for (int bj = 0; bj < 2; ++bj) { const f32x4 v0 = acc[ai][bj][m][0], v1 = acc[ai][bj][m][1];
                    u32x4 w; w.x = pk2(v0[0], v0[1]); w.y = pk2(v0[2], v0[3]); w.z = pk2(v1[0], v1[1]); w.w = pk2(v1[2], v1[3]); *(u32x4*)(rowp + bj * HALF) = w; } }
    }
};
struct EpiF32 {
    static constexpr bool PERM = false, AFTER_DRAIN = false;
    float* O; int ldc;
    __device__ __forceinline__ void operator()(const f32x4 (&acc)[2][2][4][2], const Unit& u, int wr, int wc, int fr, int fq) const {
        const int row0 = u.pm * BM + wr * 64 + fr, col0 = u.pn * BM + wc * 32 + 4 * fq;
#pragma unroll
        for (int ai = 0; ai < 2; ++ai)
#pragma unroll
            for (int m = 0; m < 4; ++m) { float* rowp = O + (size_t)(row0 + ai * HALF + m * 16) * ldc + col0;
#pragma unroll
                for (int bj = 0; bj < 2; ++bj)
#pragma unroll
                    for (int n = 0; n < 2; ++n) *(f32x4*)(rowp + bj * HALF + n * 16) = acc[ai][bj][m][n]; }
    }
};
__device__ __forceinline__ void unpack8(const u32x4 g, float (&f)[8]) { f[0] = bf_lo(g.x); f[1] = bf_hi(g.x); f[2] = bf_lo(g.y); f[3] = bf_hi(g.y); f[4] = bf_lo(g.z); f[5] = bf_hi(g.z); f[6] = bf_lo(g.w); f[7] = bf_hi(g.w); }
struct EpiGateA {
    static constexpr bool PERM = true, AFTER_DRAIN = false;
    bf16_t* M1; const bf16_t* proj;
    __device__ __forceinline__ void operator()(const f32x4 (&acc)[2][2][4][2], const Unit& u, int wr, int wc, int fr, int fq) const {
        const int row0 = u.pm * BM + wr * 64 + fr, col0 = u.pn * BM + wc * 32 + 8 * fq;
#pragma unroll
        for (int ai = 0; ai < 2; ++ai)
#pragma unroll
            for (int m = 0; m < 4; ++m) { const size_t row = (size_t)(row0 + ai * HALF + m * 16);
#pragma unroll
                for (int bj = 0; bj < 2; ++bj) { const int col = col0 + bj * HALF; float g[8]; unpack8(*(const u32x4*)(proj + row * INCP + OFF_GA + col), g);
                    const f32x4 v0 = acc[ai][bj][m][0], v1 = acc[ai][bj][m][1];
                    u32x4 w; w.x = pk2(v0[0] * g[0], v0[1] * g[1]); w.y = pk2(v0[2] * g[2], v0[3] * g[3]); w.z = pk2(v1[0] * g[4], v1[1] * g[5]); w.w = pk2(v1[2] * g[6], v1[3] * g[7]);
                    *(u32x4*)(M1 + row * DM + col) = w; } }
    }
};
struct EpiGateB {
    static constexpr bool PERM = true, AFTER_DRAIN = false;
    const bf16_t* M1; const bf16_t* proj; bf16_t* O;
    __device__ __forceinline__ void operator()(const f32x4 (&acc)[2][2][4][2], const Unit& u, int wr, int wc, int fr, int fq) const {
        const int row0 = u.pm * BM + wr * 64 + fr, col0 = u.pn * BM + wc * 32 + 8 * fq;
#pragma unroll
        for (int ai = 0; ai < 2; ++ai)
#pragma unroll
            for (int m = 0; m < 4; ++m) { const size_t row = (size_t)(row0 + ai * HALF + m * 16);
#pragma unroll
                for (int bj = 0; bj < 2; ++bj) { const int col = col0 + bj * HALF; float g[8], b[8]; unpack8(*(const u32x4*)(proj + row * INCP + OFF_GB + col), g); unpack8(*(const u32x4*)(M1 + row * DM + col), b);
                    const f32x4 v0 = acc[ai][bj][m][0], v1 = acc[ai][bj][m][1];
                    u32x4 w; w.x = pk2(b[0] + v0[0] * g[0], b[1] + v0[1] * g[1]); w.y = pk2(b[2] + v0[2] * g[2], b[3] + v0[3] * g[3]);
                    w.z = pk2(b[4] + v1[0] * g[4], b[5] + v1[1] * g[5]); w.w = pk2(b[6] + v1[2] * g[6], b[7] + v1[3] * g[7]);
                    *(u32x4*)(O + row * DM + col) = w; } }
    }
};
struct EpiResid {
    static constexpr bool PERM = false, AFTER_DRAIN = false;
    const float* X; float* O;
    __device__ __forceinline__ void operator()(const f32x4 (&acc)[2][2][4][2], const Unit& u, int wr, int wc, int fr, int fq) const {
        const int row0 = u.pm * BM + wr * 64 + fr, col0 = u.pn * BM + wc * 32 + 4 * fq;
#pragma unroll
        for (int ai = 0; ai < 2; ++ai)
#pragma unroll
            for (int m = 0; m < 4; ++m) { const size_t off = (size_t)(row0 + ai * HALF + m * 16) * DM + col0;
#pragma unroll
                for (int bj = 0; bj < 2; ++bj)
#pragma unroll
                    for (int n = 0; n < 2; ++n) { const f32x4 b = *(const f32x4*)(X + off + bj * HALF + n * 16); *(f32x4*)(O + off + bj * HALF + n * 16) = b + acc[ai][bj][m][n]; } }
    }
};
struct EpiSwiglu {
    static constexpr bool PERM = true, AFTER_DRAIN = false;
    unsigned char* ACT; const float* b1; const float* row_rstd;
    __device__ __forceinline__ void operator()(const f32x4 (&acc)[2][2][4][2], const Unit& u, int wr, int wc, int fr, int fq) const {
        const int row0 = u.pm * BM + wr * 64 + fr, f0 = u.pn * HALF + wc * 32 + 8 * fq; const float* be = b1 + (size_t)u.e * 2048;
        const f32x4 bg0 = *(const f32x4*)(be + f0), bg1 = *(const f32x4*)(be + f0 + 4), bu0 = *(const f32x4*)(be + DFF + f0), bu1 = *(const f32x4*)(be + DFF + f0 + 4);
        float rsv[8];
#pragma unroll
        for (int i = 0; i < 8; ++i) rsv[i] = row_rstd[u.rb + wr * 64 + fr + (i >> 2) * HALF + (i & 3) * 16] * W8_INV;
#pragma unroll
        for (int ai = 0; ai < 2; ++ai)
#pragma unroll
            for (int m = 0; m < 4; ++m) { const size_t row = (size_t)(row0 + ai * HALF + m * 16); float o[8]; const float rs = rsv[ai * 4 + m];
#pragma unroll
                for (int n = 0; n < 2; ++n) { const f32x4 g4 = acc[ai][0][m][n] * rs + (n ? bg1 : bg0), u4 = acc[ai][1][m][n] * rs + (n ? bu1 : bu0);
#pragma unroll
                    for (int j = 0; j < 4; ++j) { const float g = fminf(g4[j], 7.f), uu = fminf(fmaxf(u4[j], -7.f), 7.f); o[4 * n + j] = (uu + 1.f) * (g * sigmoidf_(1.702f * g)); } }
                u32x2 w; w.x = pk4_fp8(o[0], o[1], o[2], o[3]); w.y = pk4_fp8(o[4], o[5], o[6], o[7]); *(u32x2*)(ACT + row * DFF + f0) = w; }
    }
};
struct EpiMoeOut {
    static constexpr bool PERM = true, AFTER_DRAIN = false;
    bf16_t* YS; const float* b2; const float* row_w; const int* row_slot;
    __device__ __forceinline__ void operator()(const f32x4 (&acc)[2][2][4][2], const Unit& u, int wr, int wc, int fr, int fq) const {
        const int col0 = u.pn * BM + wc * 32 + 8 * fq; const float* be = b2 + (size_t)u.e * DM; const int rbase = u.rb + wr * 64 + fr;
        int slot[8]; float w[8];
#pragma unroll
        for (int i = 0; i < 8; ++i) { const int row = rbase + (i >> 2) * HALF + (i & 3) * 16; slot[i] = row_slot[row]; w[i] = row_w[row] * W8_INV; }
        f32x4 bv[2][2];
#pragma unroll
        for (int bj = 0; bj < 2; ++bj)
#pragma unroll
            for (int n = 0; n < 2; ++n) bv[bj][n] = *(const f32x4*)(be + col0 + bj * HALF + 4 * n) * W8_SCALE;
#pragma unroll
        for (int ai = 0; ai < 2; ++ai)
#pragma unroll
            for (int m = 0; m < 4; ++m) { const int i = ai * 4 + m;
                if (slot[i] >= 0) { bf16_t* rowp = YS + (size_t)slot[i] * DM + col0;
#pragma unroll
                    for (int bj = 0; bj < 2; ++bj) { const f32x4 v0 = (acc[ai][bj][m][0] + bv[bj][0]) * w[i], v1 = (acc[ai][bj][m][1] + bv[bj][1]) * w[i];
                        u32x4 o; o.x = pk2(v0[0], v0[1]); o.y = pk2(v0[2], v0[3]); o.z = pk2(v1[0], v1[1]); o.w = pk2(v1[2], v1[3]); *(u32x4*)(rowp + bj * HALF) = o; } } }
    }
};
constexpr int MOE_MAXU = 12;
struct MoeOrder {
    StaticOrder so; const PG8_LAS int* utab; const PG8_LAS int* gtab;
    __device__ __forceinline__ bool next(int i, Unit& u) const { if (i >= MOE_MAXU || !so.next(i, u)) return false; const int v = __builtin_amdgcn_readfirstlane(utab[i]); u.e = v & 31; u.rb = (int)((unsigned)v >> 8); return true; }
    __device__ __forceinline__ void a_ready(const Unit&) const {}
    __device__ __forceinline__ void done(const Unit&) const {}
};
typedef int i32x4_t __attribute__((ext_vector_type(4))); typedef int i32x8_t __attribute__((ext_vector_type(8)));
__device__ __forceinline__ i32x8_t cat8(bf16x8 lo, bf16x8 hi) { return __builtin_shufflevector(__builtin_bit_cast(i32x4_t, lo), __builtin_bit_cast(i32x4_t, hi), 0, 1, 2, 3, 4, 5, 6, 7); }
__device__ __forceinline__ void mfma_fp8_inplace(f32x4& c, const i32x8_t a, const i32x8_t b) { asm volatile("s_nop 1\n\tv_mfma_f32_16x16x128_f8f6f4 %0, %1, %2, %0" : "+v"(c) : "v"(a), "v"(b)); }
__device__ __forceinline__ void mfma_fp8_drain() { asm volatile("s_nop 15\n\ts_nop 7" ::: "memory"); __builtin_amdgcn_sched_barrier(0); }
template <class Epi, class Sched, bool ALIGN_EPI = false, bool SP2 = false, bool FP8 = false, bool GATHER = false>
__device__ __forceinline__ void gemm_phase(PG8_LAS unsigned char* lds, const Gemm g, const Sched& S, const Epi& E) {
    const int tid = threadIdx.x, wid = __builtin_amdgcn_readfirstlane(tid >> 6), lane = tid & 63, wr = wid >> 2, wc = wid & 3, fr = lane & 15, fq = lane >> 4;
    const int K = g.K, nt = K / BK;
    static_assert(!GATHER || SP2, "GATHER is implemented for the SP2 loop only");
    const unsigned rowA = (unsigned)(g.lda ? g.lda : K) * 2u;
    unsigned voffA[2], voffB[2]; int gR0 = 0; unsigned gC = 0u;
#pragma unroll
    for (int i = 0; i < 2; ++i) { int R, C; stage_rc(tid * 16 + i * 8192, R, C); const int Rb = Epi::PERM ? ((R & ~31) + perm32(R & 31)) : R;
        voffA[i] = (unsigned)R * rowA + (unsigned)C * 2u; voffB[i] = (unsigned)(Rb * K + C) * 2u; if (i == 0) { gR0 = R; gC = (unsigned)C * 2u; } }
    unsigned gA[2][2] = {{0u, 0u}, {0u, 0u}}, ngA[2][2] = {{0u, 0u}, {0u, 0u}};
#define PG8_GLOAD(dst, ui_) do { _Pragma("unroll") for (int h_ = 0; h_ < 2; ++h_) _Pragma("unroll") for (int i_ = 0; i_ < 2; ++i_) \
        dst[h_][i_] = (unsigned)S.gtab[(ui_) * 256 + 128 * h_ + gR0 + 64 * i_] * rowA + gC; } while (0)
#define PG8_VA(h) (GATHER ? gA[h] : voffA)
    const unsigned kstep = (unsigned)(BK * 2);
    const unsigned hstep = (unsigned)HALF * (unsigned)K * 2u;
    const unsigned tstep = 2u * hstep;
    const unsigned hstepA = (unsigned)HALF * rowA, tstepA = 2u * hstepA;
    const unsigned hsA = GATHER ? 0u : hstepA;
    const unsigned ldsw = (unsigned)wid * 1024u;
    const int aoff = lds_byte(wr * 64 + fr, fq * 8), boff = lds_byte(wc * 32 + fr, fq * 8);
#define PG8_SA(b, h) (((b) * 2 + (h)) * HTB)
#define PG8_SB(b, h) ((4 + (b) * 2 + (h)) * HTB)
#define PG8_STAGE(rs, bufoff, goff, voff) do { _Pragma("unroll") for (int _i = 0; _i < 2; ++_i) \
        __builtin_amdgcn_raw_ptr_buffer_load_lds(rs, (PG8_LAS void*)(lds + (bufoff) + ldsw + _i * 8192), 16, (int)(voff)[_i], (int)(goff), 0, 0); } while (0)
#define PG8_LDA(dst, b, h) do { _Pragma("unroll") for (int m = 0; m < 4; ++m) _Pragma("unroll") for (int k = 0; k < 2; ++k) dst[m][k] = *(const PG8_LAS bf16x8*)(lds + PG8_SA(b, h) + aoff + m * 2048 + k * 1024); } while (0)
#define PG8_LDB(dst, b, h) do { _Pragma("unroll") for (int n = 0; n < 2; ++n) _Pragma("unroll") for (int k = 0; k < 2; ++k) dst[n][k] = *(const PG8_LAS bf16x8*)(lds + PG8_SB(b, h) + boff + n * 2048 + k * 1024); } while (0)
#define PG8_MMA(ai, bj, At, Bt) do { __builtin_amdgcn_s_setprio(1); _Pragma("unroll") for (int m = 0; m < 4; ++m) _Pragma("unroll") for (int n = 0; n < 2; ++n) { \
        if constexpr (FP8) { mfma_fp8_inplace(acc[ai][bj][m][n], cat8(Bt[n][0], Bt[n][1]), cat8(At[m][0], At[m][1])); } \
        else { _Pragma("unroll") for (int k = 0; k < 2; ++k) acc[ai][bj][m][n] = __builtin_amdgcn_mfma_f32_16x16x32_bf16(Bt[n][k], At[m][k], acc[ai][bj][m][n], 0, 0, 0); } } \
        __builtin_amdgcn_s_setprio(0); } while (0)
#define PG8_WAIT_V(n) asm volatile("s_waitcnt vmcnt(" #n ")" ::: "memory")
#define PG8_WAIT_L(n) asm volatile("s_waitcnt lgkmcnt(" #n ")" ::: "memory")
#define PG8_BAR __builtin_amdgcn_s_barrier()
#define PG8_SCHED __builtin_amdgcn_sched_barrier(0)
    Unit cur, nxt; int ui = 0;
    if (!S.next(0, cur)) return;
    f32x4 acc[2][2][4][2];
#pragma unroll
    for (int a = 0; a < 2; ++a)
#pragma unroll
        for (int b = 0; b < 2; ++b)
#pragma unroll
            for (int m = 0; m < 4; ++m)
#pragma unroll
                for (int n = 0; n < 2; ++n) acc[a][b][m][n] = (f32x4){0.f, 0.f, 0.f, 0.f};
    bf16x8 At[4][2], B0[2][2], B1[2][2];
    unsigned cA = GATHER ? 0u : (unsigned)cur.pm * tstepA, cB = (unsigned)cur.e * (unsigned)g.bstride + (unsigned)cur.pn * tstep;
    const __amdgpu_buffer_rsrc_t rsA = __builtin_amdgcn_make_buffer_rsrc((void*)g.A, 0, 0x7fffffff, 0x00020000), rsB = __builtin_amdgcn_make_buffer_rsrc((void*)g.Bt, 0, 0x7fffffff, 0x00020000);
    S.a_ready(cur);
    if constexpr (GATHER) PG8_GLOAD(gA, 0);
    if constexpr (SP2) {
        PG8_STAGE(rsB, PG8_SB(0, 0), cB, voffB); PG8_STAGE(rsB, PG8_SB(0, 1), cB + hstep, voffB); PG8_STAGE(rsA, PG8_SA(0, 0), cA, PG8_VA(0)); PG8_STAGE(rsA, PG8_SA(0, 1), cA + hsA, PG8_VA(1));
        if (wr == 1) PG8_BAR;
        PG8_WAIT_V(2); PG8_BAR;
        PG8_STAGE(rsB, PG8_SB(1, 0), cB + kstep, voffB); PG8_STAGE(rsA, PG8_SA(1, 0), cA + kstep, PG8_VA(0)); PG8_STAGE(rsB, PG8_SB(1, 1), cB + hstep + kstep, voffB);
        PG8_WAIT_V(6); PG8_BAR;
    } else {
        PG8_STAGE(rsB, PG8_SB(0, 0), cB, voffB); PG8_STAGE(rsA, PG8_SA(0, 0), cA, PG8_VA(0)); PG8_STAGE(rsB, PG8_SB(0, 1), cB + hstep, voffB); PG8_STAGE(rsA, PG8_SA(0, 1), cA + hsA, PG8_VA(1));
        if (wr == 1) PG8_BAR;
        PG8_WAIT_V(4); PG8_BAR;
        PG8_STAGE(rsB, PG8_SB(1, 0), cB + kstep, voffB); PG8_STAGE(rsA, PG8_SA(1, 0), cA + kstep, PG8_VA(0)); PG8_STAGE(rsB, PG8_SB(1, 1), cB + hstep + kstep, voffB);
        PG8_WAIT_V(6); PG8_BAR;
    }
    for (;;) {
        const bool has_next = S.next(ui + 1, nxt);
        if constexpr (GATHER) { if (has_next) PG8_GLOAD(ngA, ui + 1); else { ngA[0][0] = gA[0][0]; ngA[0][1] = gA[0][1]; ngA[1][0] = gA[1][0]; ngA[1][1] = gA[1][1]; } }
        const unsigned nA = (has_next && !GATHER) ? (unsigned)nxt.pm * tstepA : cA, nB = has_next ? (unsigned)nxt.e * (unsigned)g.bstride + (unsigned)nxt.pn * tstep : cB;
        for (int t = 0; t < nt; t += 2) {
            const bool last = (t == nt - 2);
            const unsigned a1 = cA + (unsigned)(t + 1) * kstep;
            const unsigned a2 = last ? nA : cA + (unsigned)(t + 2) * kstep, b2 = last ? nB : cB + (unsigned)(t + 2) * kstep;
            const unsigned a3 = a2 + kstep, b3 = b2 + kstep;
            if (last && has_next) S.a_ready(nxt);
            if constexpr (SP2) {
            PG8_LDB(B0, 0, 0); PG8_LDB(B1, 0, 1); PG8_SCHED; PG8_LDA(At, 0, 0); PG8_STAGE(rsA, PG8_SA(1, 1), a1 + hsA, PG8_VA(1));
            if constexpr (GATHER) { if (last) { gA[0][0] = ngA[0][0]; gA[0][1] = ngA[0][1]; gA[1][0] = ngA[1][0]; gA[1][1] = ngA[1][1]; } }
            PG8_WAIT_V(8); PG8_WAIT_L(0); PG8_BAR; PG8_MMA(0, 0, At, B0); PG8_MMA(0, 1, At, B1); PG8_BAR; PG8_SCHED;
            PG8_LDA(At, 0, 1); PG8_STAGE(rsB, PG8_SB(0, 0), b2, voffB); PG8_STAGE(rsB, PG8_SB(0, 1), b2 + hstep, voffB); PG8_STAGE(rsA, PG8_SA(0, 0), a2, PG8_VA(0));
            PG8_WAIT_V(8); PG8_WAIT_L(0); PG8_BAR; PG8_MMA(1, 0, At, B0); PG8_MMA(1, 1, At, B1); PG8_BAR; PG8_SCHED;
            PG8_LDB(B0, 1, 0); PG8_LDB(B1, 1, 1); PG8_SCHED; PG8_LDA(At, 1, 0); PG8_STAGE(rsA, PG8_SA(0, 1), a2 + hsA, PG8_VA(1));
            PG8_WAIT_V(8); PG8_WAIT_L(0); PG8_BAR; PG8_MMA(0, 0, At, B0); PG8_MMA(0, 1, At, B1); PG8_BAR; PG8_SCHED;
            PG8_LDA(At, 1, 1); PG8_STAGE(rsB, PG8_SB(1, 0), b3, voffB); PG8_STAGE(rsB, PG8_SB(1, 1), b3 + hstep, voffB); PG8_STAGE(rsA, PG8_SA(1, 0), a3, PG8_VA(0));
            PG8_WAIT_V(8); PG8_WAIT_L(0); PG8_BAR; PG8_MMA(1, 0, At, B0); PG8_MMA(1, 1, At, B1); PG8_BAR; PG8_SCHED;
            } else {
            PG8_LDB(B0, 0, 0); PG8_SCHED; PG8_LDA(At, 0, 0); PG8_STAGE(rsA, PG8_SA(1, 1), a1 + hsA, PG8_VA(1));
            PG8_WAIT_L(8); PG8_BAR; PG8_WAIT_L(0); PG8_MMA(0, 0, At, B0); PG8_BAR; PG8_SCHED;
            PG8_LDB(B1, 0, 1); PG8_STAGE(rsB, PG8_SB(0, 0), b2, voffB);
            PG8_BAR; PG8_WAIT_L(0); PG8_MMA(0, 1, At, B1); PG8_BAR;
            PG8_LDA(At, 0, 1); PG8_STAGE(rsA, PG8_SA(0, 0), a2, PG8_VA(0));
            PG8_BAR; PG8_WAIT_L(0); PG8_MMA(1, 0, At, B0); PG8_BAR; PG8_SCHED;
            PG8_STAGE(rsB, PG8_SB(0, 1), b2 + hstep, voffB);
            PG8_WAIT_V(6); PG8_BAR; PG8_MMA(1, 1, At, B1); PG8_BAR;
            PG8_LDB(B0, 1, 0); PG8_SCHED; PG8_LDA(At, 1, 0); PG8_STAGE(rsA, PG8_SA(0, 1), a2 + hsA, PG8_VA(1));
            PG8_WAIT_L(8); PG8_BAR; PG8_WAIT_L(0); PG8_MMA(0, 0, At, B0); PG8_BAR; PG8_SCHED;
            PG8_LDB(B1, 1, 1); PG8_STAGE(rsB, PG8_SB(1, 0), b3, voffB);
            PG8_BAR; PG8_WAIT_L(0); PG8_MMA(0, 1, At, B1); PG8_BAR;
            PG8_LDA(At, 1, 1); PG8_STAGE(rsA, PG8_SA(1, 0), a3, PG8_VA(0));
            PG8_BAR; PG8_WAIT_L(0); PG8_MMA(1, 0, At, B0); PG8_BAR; PG8_SCHED;
            PG8_STAGE(rsB, PG8_SB(1, 1), b3 + hstep, voffB);
            PG8_WAIT_V(6); PG8_BAR; PG8_MMA(1, 1, At, B1); PG8_BAR;
            }
        }
        if constexpr (ALIGN_EPI) { if (wr == 0) PG8_BAR; }
        if constexpr (FP8) mfma_fp8_drain();
        if constexpr (!Epi::AFTER_DRAIN) { E(acc, cur, wr, wc, fr, fq); S.done(cur); }
        if (!has_next) break;
#pragma unroll
        for (int a = 0; a < 2; ++a)
#pragma unroll
            for (int b = 0; b < 2; ++b)
#pragma unroll
                for (int m = 0; m < 4; ++m)
#pragma unroll
                    for (int n = 0; n < 2; ++n) acc[a][b][m][n] = (f32x4){0.f, 0.f, 0.f, 0.f};
        cur = nxt; cA = nA; cB = nB; ++ui;
        if constexpr (ALIGN_EPI) { if (wr == 1) PG8_BAR; }
    }
    PG8_WAIT_V(0);
    if constexpr (!ALIGN_EPI) { if (wr == 0) PG8_BAR; }
    PG8_BAR;
    if constexpr (Epi::AFTER_DRAIN) { E.fused(acc, cur, wr, wc, fr, fq, lds, wid, lane); S.done(cur); }
#undef PG8_SA
#undef PG8_GLOAD
#undef PG8_VA
#undef PG8_SB
#undef PG8_STAGE
#undef PG8_LDA
#undef PG8_LDB
#undef PG8_MMA
#undef PG8_WAIT_V
#undef PG8_WAIT_L
#undef PG8_BAR
#undef PG8_SCHED
}
}

#define GAS __attribute__((address_space(1)))
#define LAS __attribute__((address_space(3)))
#define XB_TMO      128
#define XB_XCNT(j)  (256  + 64 * (j))
#define XB_XSUB(j)  (1280 + 64 * (j))
#define XB_XGEN(j)  (2304 + 64 * (j))
#define XB_TOP      3328
#define XB_TOPGEN   3392
#define XCD_BAR_WORDS 3456
#define XB_SPIN_CAP (1u << 18)

__device__ __forceinline__ unsigned xb_ld(unsigned* p)              { return __hip_atomic_load(p, __ATOMIC_RELAXED, __HIP_MEMORY_SCOPE_AGENT); }
__device__ __forceinline__ unsigned xb_add(unsigned* p, unsigned v) { return __hip_atomic_fetch_add(p, v, __ATOMIC_RELAXED, __HIP_MEMORY_SCOPE_AGENT); }
__device__ __forceinline__ unsigned xb_xcc_id() { return (unsigned)__builtin_amdgcn_s_getreg((3 << 11) | 20) & 0xFu; }
#define XB_SPIN(cond, bar) do { unsigned _sp = 0; while (cond) { __builtin_amdgcn_s_sleep(1); \
    if ((++_sp & 255u) == 0u) { if (xb_ld(&(bar)[XB_TMO])) break; if (_sp > XB_SPIN_CAP) { atomicAdd(&(bar)[XB_TMO], 1u); break; } } } } while (0)

struct XcdBarrier {
    unsigned* bar; unsigned x;
    volatile LAS unsigned* st;
};

__device__ __forceinline__ XcdBarrier xcd_barrier_post(unsigned* bar, volatile LAS unsigned* st) {
    XcdBarrier b; b.bar = bar; b.x = xb_xcc_id(); b.st = st;
    if (threadIdx.x == 0) (void)xb_add(&bar[XB_XCNT(b.x)], 1u);
    return b;
}
__device__ __forceinline__ void xcd_barrier_complete(unsigned* bar, unsigned x, unsigned& nloc, unsigned& nx) {
    const unsigned G = gridDim.x * gridDim.y * gridDim.z;
    unsigned sum, cnt, mine, sp = 0u;
    for (;;) {
        sum = 0u; cnt = 0u; mine = 0u;
#pragma unroll
        for (unsigned j = 0; j < 16; ++j) { const unsigned c = xb_ld(&bar[XB_XCNT(j)]); sum += c; cnt += (c > 0u) ? 1u : 0u; mine = (j == x) ? c : mine; }
        if (sum == G) break;
        __builtin_amdgcn_s_sleep(1);
        if ((++sp & 255u) == 0u) { if (xb_ld(&bar[XB_TMO])) break; if (sp > XB_SPIN_CAP) { atomicAdd(&bar[XB_TMO], 1u); break; } }
    }
    nloc = mine > 0u ? mine : 1u; nx = cnt > 0u ? cnt : 1u;
}

__device__ __forceinline__ void xcd_barrier(const XcdBarrier& b) {
    asm volatile("s_waitcnt vmcnt(0)" ::: "memory");
    __syncthreads();
    if (threadIdx.x == 0) {
        unsigned* bar = b.bar;
        __builtin_amdgcn_s_waitcnt(0);
        unsigned nloc = b.st[0], nx = b.st[1];
        if (nloc == 0u) { xcd_barrier_complete(bar, b.x, nloc, nx); b.st[0] = nloc; b.st[1] = nx; }
        const unsigned old = xb_add(&bar[XB_XSUB(b.x)], 1u);
        const unsigned gen = old / nloc;
        if (old + 1u == (gen + 1u) * nloc) {
            __builtin_amdgcn_fence(__ATOMIC_RELEASE, "agent");
            asm volatile("s_waitcnt vmcnt(0)" ::: "memory");
            const unsigned og = xb_add(&bar[XB_TOP], 1u);
            const unsigned tg = og / nx;
            if (og + 1u == (tg + 1u) * nx) xb_add(&bar[XB_TOPGEN], 1u);
            else XB_SPIN(xb_ld(&bar[XB_TOPGEN]) == tg, bar);
            __builtin_amdgcn_fence(__ATOMIC_ACQUIRE, "agent");
            xb_add(&bar[XB_XGEN(b.x)], 1u);
            asm volatile("s_waitcnt vmcnt(0)" ::: "memory");
        } else {
            XB_SPIN(xb_ld(&bar[XB_XGEN(b.x)]) == gen, bar);
            __builtin_amdgcn_fence(__ATOMIC_ACQUIRE, "agent");
            asm volatile("s_waitcnt vmcnt(0)" ::: "memory");
        }
    }
    __syncthreads();
}

template <int MODE  >
__device__ __forceinline__ void transpose_item(const float* __restrict__ W, int K, int N, bf16_t* __restrict__ WT, const float* __restrict__ gain, float* scr, int item, int lane) {
    const int nblk = N / 32, kb = item / nblk, nb = item % nblk, k0 = 64 * kb, n0 = 32 * nb;
#pragma unroll
    for (int i = 0; i < 8; ++i) { const int kk = 8 * i + (lane >> 3), n4 = (lane & 7) * 4; f32x4 v = *(const f32x4*)(W + (size_t)(k0 + kk) * N + n0 + n4);
        if (gain) { const float g = gain[k0 + kk]; v = v * g; }
        float* s = scr + kk * 33 + n4; s[0] = v[0]; s[1] = v[1]; s[2] = v[2]; s[3] = v[3]; }
    asm volatile("s_waitcnt lgkmcnt(0)" ::: "memory");
    const int c = lane & 7;
#pragma unroll
    for (int j = 0; j < 4; ++j) { const int n = (lane >> 3) + 8 * j; const float* s = scr + (8 * c) * 33 + n;
        u32x4 o; o.x = pk2(s[0 * 33], s[1 * 33]); o.y = pk2(s[2 * 33], s[3 * 33]); o.z = pk2(s[4 * 33], s[5 * 33]); o.w = pk2(s[6 * 33], s[7 * 33]);
        int row = n0 + n;
        if (MODE == 1) { const int f = row & 1023; row = ((f >> 7) << 8) + ((row >> 10) << 7) + (f & 127); }
        *(u32x4*)(WT + (size_t)row * K + k0 + 8 * c) = o; }
    asm volatile("s_waitcnt lgkmcnt(0)" ::: "memory");
}
template <int MODE>
__device__ __forceinline__ void transpose_item_fp8(const float* __restrict__ W, int K, int N, unsigned char* __restrict__ WT, float* scr, int item, int lane) {
    const int nblk = N / 32, kb = item / nblk, nb = item % nblk, k0 = 64 * kb, n0 = 32 * nb;
#pragma unroll
    for (int i = 0; i < 8; ++i) { const int kk = 8 * i + (lane >> 3), n4 = (lane & 7) * 4; const f32x4 v = *(const f32x4*)(W + (size_t)(k0 + kk) * N + n0 + n4) * W8_SCALE;
        float* s = scr + kk * 33 + n4; s[0] = v[0]; s[1] = v[1]; s[2] = v[2]; s[3] = v[3]; }
    asm volatile("s_waitcnt lgkmcnt(0)" ::: "memory");
    const int c = lane & 7;
#pragma unroll
    for (int j = 0; j < 4; ++j) { const int n = (lane >> 3) + 8 * j; const float* s = scr + (8 * c) * 33 + n;
        u32x2 o; o.x = pk4_fp8(s[0 * 33], s[1 * 33], s[2 * 33], s[3 * 33]); o.y = pk4_fp8(s[4 * 33], s[5 * 33], s[6 * 33], s[7 * 33]);
        int row = n0 + n;
        if (MODE == 1) { const int f = row & 1023; row = ((f >> 7) << 8) + ((row >> 10) << 7) + (f & 127); }
        *(u32x2*)(WT + (size_t)row * K + k0 + 8 * c) = o; }
    asm volatile("s_waitcnt lgkmcnt(0)" ::: "memory");
}
__device__ __forceinline__ void phase_prologue(const Params& p, unsigned char* lds) {
    const int tid = threadIdx.x, lane = tid & 63, wave = tid >> 6;
    float* scr = (float*)(lds + wave * 16384);
    const int gw = blockIdx.x * NWAVES + wave, NGW = gridDim.x * NWAVES;
    unsigned char* ws = p.ws;
    constexpr int I_WIN = (DM / 64) * (INC / 32), I_UQ = (QLORA / 64) * (768 / 32), I_UKV = (KVLORA / 64) * (1024 / 32), I_OM = (512 / 64) * (DM / 32), I_OC = I_OM, I_WO = (DM / 64) * (DM / 32);
    constexpr int I_W1 = (DM / 64) * (2048 / 32), I_W2 = (DFF / 64) * (DM / 32);
    constexpr int NSMALL = I_WIN + I_UQ + I_UKV + I_OM + I_OC + I_WO;
    constexpr int NITEMS = NSMALL;
    for (int it = gw; it < NITEMS; it += NGW) {
        int r = it;
        if (r < I_WIN) { transpose_item<0>(p.w_in, DM, INC, (bf16_t*)(ws + WS_WIN), p.norm1_g, scr, r, lane); continue; } r -= I_WIN;
        if (r < I_UQ) { transpose_item<0>(p.w_uq, QLORA, 768, (bf16_t*)(ws + WS_WUQ), p.q_a_g, scr, r, lane); continue; } r -= I_UQ;
        if (r < I_UKV) { transpose_item<0>(p.w_ukv, KVLORA, 1024, (bf16_t*)(ws + WS_WUKV), p.kv_a_g, scr, r, lane); continue; } r -= I_UKV;
        if (r < I_OM) { transpose_item<0>(p.w_o_mla, 512, DM, (bf16_t*)(ws + WS_WOMLA), nullptr, scr, r, lane); continue; } r -= I_OM;
        if (r < I_OC) { transpose_item<0>(p.w_o_conv, 512, DM, (bf16_t*)(ws + WS_WOCONV), nullptr, scr, r, lane); continue; } r -= I_OC;
        transpose_item<0>(p.w_o, DM, DM, (bf16_t*)(ws + WS_WO), nullptr, scr, r, lane);
    }
    { u32x4* z = (u32x4*)((bf16_t*)(ws + WS_WIN) + (size_t)INC * DM); const int nz = (INCP - INC) * DM * 2 / 16;
      for (int i = blockIdx.x * NTHREADS + tid; i < nz; i += gridDim.x * NTHREADS) z[i] = (u32x4){0u, 0u, 0u, 0u}; }
    { int* rt = (int*)(ws + WS_RT2); int* rs = (int*)(ws + WS_RT2 + 4 * MiB); float* rr = (float*)(ws + WS_RT2 + 6 * MiB);
      for (int i = blockIdx.x * NTHREADS + tid; i < NE * CAP; i += gridDim.x * NTHREADS) { rt[i] = 0; rs[i] = -1; rr[i] = 0.f; } }
    { u32x4* GF = (u32x4*)(ws + WS_GF);
      for (int i = blockIdx.x * NTHREADS + tid; i < 64 * 64; i += gridDim.x * NTHREADS) { const int ks = i >> 6, ln = i & 63, r = ln & 31, h = ln >> 5; float v[8], lo[8]; unsigned hi[4];
#pragma unroll
          for (int j = 0; j < 8; ++j) { const int k = 16 * ks + 8 * h + j; v[j] = p.norm2_g[k] * p.router_w[(size_t)k * NE + r]; }
#pragma unroll
          for (int j = 0; j < 4; ++j) { hi[j] = pk2(v[2 * j], v[2 * j + 1]); lo[2 * j] = v[2 * j] - bf_lo(hi[j]); lo[2 * j + 1] = v[2 * j + 1] - bf_hi(hi[j]); }
          GF[(ks * 2 + 0) * 64 + ln] = (u32x4){hi[0], hi[1], hi[2], hi[3]}; GF[(ks * 2 + 1) * 64 + ln] = (u32x4){pk2(lo[0], lo[1]), pk2(lo[2], lo[3]), pk2(lo[4], lo[5]), pk2(lo[6], lo[7])}; } }
    bf16_t* XN = (bf16_t*)(ws + WS_XN);
    for (int m = gw; m < NTOK; m += NGW) {
        const f32x4* xr = (const f32x4*)(p.x + (size_t)m * DM) + lane; f32x4 v[4]; float s = 0.f;
#pragma unroll
        for (int j = 0; j < 4; ++j) { v[j] = xr[64 * j]; s += (v[j][0] * v[j][0] + v[j][1] * v[j][1]) + (v[j][2] * v[j][2] + v[j][3] * v[j][3]); }
        const float rstd = rsqrtf(wave_sum(s) * (1.f / DM) + EPS);
        u32x2* o = (u32x2*)(XN + (size_t)m * DM) + lane;
#pragma unroll
        for (int j = 0; j < 4; ++j) { u32x2 w; w.x = pk2(v[j][0] * rstd, v[j][1] * rstd); w.y = pk2(v[j][2] * rstd, v[j][3] * rstd); o[64 * j] = w; }
    }
}

constexpr float QSCALE = 0.10206207261596575f * 1.4426950408889634f;
struct TokRaw { u32x2 cq; unsigned ckv; u32x4 u[3], c[3], bg, qa, ka, va; unsigned q1, q2, k1, k2; float pos, m0, m2; };
__device__ __forceinline__ void tokb_load(TokRaw& r, const Params& p, int t, int lane, int h, int sub) {
    const bf16_t* PROJ = (const bf16_t*)(p.ws + WS_PROJ); const bf16_t* pr = PROJ + (size_t)t * INCP; const int s = t & (SEQ - 1);
    r.pos = (float)p.pos[t];
    r.cq = *(const u32x2*)(pr + OFF_CQ + 4 * lane); r.ckv = *(const unsigned*)(pr + OFF_CKV + 2 * lane);
    r.m0 = s > 0 ? 1.f : 0.f; r.m2 = s < SEQ - 1 ? 1.f : 0.f;
    const bf16_t* pm = s > 0 ? pr - INCP : pr; const bf16_t* pp = s < SEQ - 1 ? pr + INCP : pr;
    r.u[0] = *(const u32x4*)(pm + OFF_U + 8 * lane); r.c[0] = *(const u32x4*)(pm + OFF_C + 8 * lane);
    r.u[1] = *(const u32x4*)(pr + OFF_U + 8 * lane); r.c[1] = *(const u32x4*)(pr + OFF_C + 8 * lane);
    r.u[2] = *(const u32x4*)(pp + OFF_U + 8 * lane); r.c[2] = *(const u32x4*)(pp + OFF_C + 8 * lane);
    r.bg = *(const u32x4*)(pr + OFF_B + 8 * lane);
    const bf16_t* qp = (const bf16_t*)(p.ws + WS_QPRE) + (size_t)t * 768 + h * DQK; r.qa = *(const u32x4*)(qp + sub * 8); r.q1 = *(const unsigned*)(qp + 64 + 2 * sub); r.q2 = *(const unsigned*)(qp + 80 + 2 * sub);
    const bf16_t* kp = (const bf16_t*)(p.ws + WS_KVPRE) + (size_t)t * 1024 + h * 128; r.ka = *(const u32x4*)(kp + sub * 8); r.va = *(const u32x4*)(kp + 64 + sub * 8);
    const bf16_t* kr = pr + OFF_KR; r.k1 = *(const unsigned*)(kr + 2 * sub); r.k2 = *(const unsigned*)(kr + 16 + 2 * sub);
}
__device__ __forceinline__ void mulpair8(const u32x4 u, const u32x4 c, float (&o)[8]) {
    o[0] = bf_lo(u.x) * bf_lo(c.x); o[1] = bf_hi(u.x) * bf_hi(c.x); o[2] = bf_lo(u.y) * bf_lo(c.y); o[3] = bf_hi(u.y) * bf_hi(c.y);
    o[4] = bf_lo(u.z) * bf_lo(c.z); o[5] = bf_hi(u.z) * bf_hi(c.z); o[6] = bf_lo(u.w) * bf_lo(c.w); o[7] = bf_hi(u.w) * bf_hi(c.w); }
__device__ __forceinline__ void tokb_compute(const TokRaw& r, const Params& p, int t, int lane, int h, int sub, const float (&qg)[12], const float (&kg)[12], float if0, float if1,
                                             const float (&cw0)[8], const float (&cw1)[8], const float (&cw2)[8]) {
    bf16_t* Q = (bf16_t*)(p.ws + WS_Q); bf16_t* Kb = (bf16_t*)(p.ws + WS_K); bf16_t* V = (bf16_t*)(p.ws + WS_V); bf16_t* YB = (bf16_t*)(p.ws + WS_YBIN);
    const int b = t >> 13, s = t & (SEQ - 1);
    float rs_q, rs_kv;
    { const float a = bf_lo(r.cq.x), bq = bf_hi(r.cq.x), c = bf_lo(r.cq.y), d = bf_hi(r.cq.y); rs_q = rsqrtf(wave_sum(a * a + bq * bq + c * c + d * d) * (1.f / QLORA) + EPS); }
    { const float a = bf_lo(r.ckv), bq = bf_hi(r.ckv); rs_kv = rsqrtf(wave_sum(a * a + bq * bq) * (1.f / KVLORA) + EPS); }
    { float cu0[8], cu1[8], cu2[8], bb[8]; mulpair8(r.u[0], r.c[0], cu0); mulpair8(r.u[1], r.c[1], cu1); mulpair8(r.u[2], r.c[2], cu2);
      bb[0] = bf_lo(r.bg.x); bb[1] = bf_hi(r.bg.x); bb[2] = bf_lo(r.bg.y); bb[3] = bf_hi(r.bg.y); bb[4] = bf_lo(r.bg.z); bb[5] = bf_hi(r.bg.z); bb[6] = bf_lo(r.bg.w); bb[7] = bf_hi(r.bg.w); float y[8];
#pragma unroll
      for (int j = 0; j < 8; ++j) y[j] = bb[j] * (cw0[j] * r.m0 * cu0[j] + cw1[j] * cu1[j] + cw2[j] * r.m2 * cu2[j]);
      u32x4 o; o.x = pk2(y[0], y[1]); o.y = pk2(y[2], y[3]); o.z = pk2(y[4], y[5]); o.w = pk2(y[6], y[7]); *(u32x4*)(YB + (size_t)t * CONVW + 8 * lane) = o; }
    float c0, s0, c1, s1; sincosf(r.pos * if0, &s0, &c0); sincosf(r.pos * if1, &s1, &c1);
    const size_t rowi = ((size_t)(b * NH + h) * SEQ + s);
    { float v[12] = {bf_lo(r.qa.x), bf_hi(r.qa.x), bf_lo(r.qa.y), bf_hi(r.qa.y), bf_lo(r.qa.z), bf_hi(r.qa.z), bf_lo(r.qa.w), bf_hi(r.qa.w), bf_lo(r.q1), bf_hi(r.q1), bf_lo(r.q2), bf_hi(r.q2)}; float ss = 0.f;
#pragma unroll
      for (int j = 0; j < 12; ++j) { v[j] *= rs_q; ss += v[j] * v[j]; }
      ss += __shfl_xor(ss, 1); ss += __shfl_xor(ss, 2); ss += __shfl_xor(ss, 4);
      const float rstd = rsqrtf(ss * (1.f / DQK) + EPS);
#pragma unroll
      for (int j = 0; j < 12; ++j) v[j] *= rstd * qg[j] * QSCALE;
      const float o8 = v[8] * c0 - v[10] * s0, o9 = v[9] * c1 - v[11] * s1, o10 = v[8] * s0 + v[10] * c0, o11 = v[9] * s1 + v[11] * c1;
      bf16_t* qo = Q + rowi * DQK; u32x4 w; w.x = pk2(v[0], v[1]); w.y = pk2(v[2], v[3]); w.z = pk2(v[4], v[5]); w.w = pk2(v[6], v[7]);
      *(u32x4*)(qo + sub * 8) = w; *(unsigned*)(qo + 64 + 2 * sub) = pk2(o8, o9); *(unsigned*)(qo + 80 + 2 * sub) = pk2(o10, o11); }
    { float v[12] = {bf_lo(r.ka.x) * rs_kv, bf_hi(r.ka.x) * rs_kv, bf_lo(r.ka.y) * rs_kv, bf_hi(r.ka.y) * rs_kv, bf_lo(r.ka.z) * rs_kv, bf_hi(r.ka.z) * rs_kv, bf_lo(r.ka.w) * rs_kv, bf_hi(r.ka.w) * rs_kv,
                   bf_lo(r.k1), bf_hi(r.k1), bf_lo(r.k2), bf_hi(r.k2)}; float ss = 0.f;
#pragma unroll
      for (int j = 0; j < 12; ++j) ss += v[j] * v[j];
      ss += __shfl_xor(ss, 1); ss += __shfl_xor(ss, 2); ss += __shfl_xor(ss, 4);
      const float rstd = rsqrtf(ss * (1.f / DQK) + EPS);
#pragma unroll
      for (int j = 0; j < 12; ++j) v[j] *= rstd * kg[j];
      const float o8 = v[8] * c0 - v[10] * s0, o9 = v[9] * c1 - v[11] * s1, o10 = v[8] * s0 + v[10] * c0, o11 = v[9] * s1 + v[11] * c1;
      bf16_t* ko = Kb + rowi * 128; u32x4 w; w.x = pk2(v[0], v[1]); w.y = pk2(v[2], v[3]); w.z = pk2(v[4], v[5]); w.w = pk2(v[6], v[7]);
      *(u32x4*)(ko + sub * 8) = w; *(unsigned*)(ko + 64 + 2 * sub) = pk2(o8, o9); *(unsigned*)(ko + 80 + 2 * sub) = pk2(o10, o11);
      if (sub < 4) *(u32x4*)(ko + 96 + sub * 8) = (u32x4){0u, 0u, 0u, 0u};
      u32x4 wv; wv.x = pk2(bf_lo(r.va.x) * rs_kv, bf_hi(r.va.x) * rs_kv); wv.y = pk2(bf_lo(r.va.y) * rs_kv, bf_hi(r.va.y) * rs_kv); wv.z = pk2(bf_lo(r.va.z) * rs_kv, bf_hi(r.va.z) * rs_kv); wv.w = pk2(bf_lo(r.va.w) * rs_kv, bf_hi(r.va.w) * rs_kv);
      *(u32x4*)(V + rowi * DV + sub * 8) = wv; }
}
__device__ __forceinline__ void phase_tok_b(const Params& p) {
    const int tid = threadIdx.x, lane = tid & 63, wave = tid >> 6, h = lane >> 3, sub = lane & 7;
    const int gw = blockIdx.x * NWAVES + wave, NGW = gridDim.x * NWAVES;
    float qg[12], kg[12];
#pragma unroll
    for (int j = 0; j < 8; ++j) { qg[j] = p.q_g[sub * 8 + j]; kg[j] = p.k_g[sub * 8 + j]; }
    qg[8] = p.q_g[64 + 2 * sub]; qg[9] = p.q_g[65 + 2 * sub]; qg[10] = p.q_g[80 + 2 * sub]; qg[11] = p.q_g[81 + 2 * sub];
    kg[8] = p.k_g[64 + 2 * sub]; kg[9] = p.k_g[65 + 2 * sub]; kg[10] = p.k_g[80 + 2 * sub]; kg[11] = p.k_g[81 + 2 * sub];
    const float if0 = exp2f(-(float)(2 * sub) * (13.287712379549449f / 16.f)), if1 = exp2f(-(float)(2 * sub + 1) * (13.287712379549449f / 16.f));
    float cw0[8], cw1[8], cw2[8];
#pragma unroll
    for (int j = 0; j < 8; ++j) { cw0[j] = p.conv_w[8 * lane + j]; cw1[j] = p.conv_w[CONVW + 8 * lane + j]; cw2[j] = p.conv_w[2 * CONVW + 8 * lane + j]; }
    for (int t = gw; t < NTOK; t += 2 * NGW) {
        const int t1 = t + NGW; const bool two = t1 < NTOK;
        TokRaw r0, r1; tokb_load(r0, p, t, lane, h, sub); tokb_load(r1, p, two ? t1 : t, lane, h, sub);
        tokb_compute(r0, p, t, lane, h, sub, qg, kg, if0, if1, cw0, cw1, cw2);
        if (two) tokb_compute(r1, p, t1, lane, h, sub, qg, kg, if0, if1, cw0, cw1, cw2);
    }
}

constexpr int WC_EXP_ITEMS = NE * 1536, WC_TILE_F = 32 * 68;
struct WcItem { const float* W; unsigned char* WT; int N, k0, n0, mode; };
__device__ __forceinline__ WcItem wc_decode(const Params& p, int x) {
    WcItem it; const int e = x / 1536, r = x - e * 1536;
    if (r < 1024) { it.W = p.w1 + (size_t)e * DM * 2048; it.WT = p.ws + WS_W1 + (size_t)e * 2048 * DM; it.N = 2048; it.k0 = 64 * (r >> 6); it.n0 = 32 * (r & 63); it.mode = 1; }
    else { const int q = r - 1024; it.W = p.w2 + (size_t)e * DFF * DM; it.WT = p.ws + WS_W2 + (size_t)e * DM * DFF; it.N = DM; it.k0 = 64 * (q >> 5); it.n0 = 32 * (q & 31); it.mode = 0; }
    return it;
}
struct WConv { float* tile; int x0, nitems, cs; f32x4 pend; };
__device__ __forceinline__ void wconv_step(WConv& c, const Params& p, int lane) {
    const int cs = c.cs, nst = 8 * c.nitems;
    if (cs > 0 && cs <= nst) {
        const int kk = 8 * ((cs - 1) & 7) + (lane >> 3), n4 = (lane & 7) * 4; float* t = c.tile + n4 * 68 + kk;
        t[0] = c.pend[0] * W8_SCALE; t[68] = c.pend[1] * W8_SCALE; t[136] = c.pend[2] * W8_SCALE; t[204] = c.pend[3] * W8_SCALE;
        if ((cs & 7) == 0) {
            const WcItem it = wc_decode(p, c.x0 + (cs >> 3) - 1); const int c8 = lane & 7;
#pragma unroll
            for (int j = 0; j < 4; ++j) { const int n = (lane >> 3) + 8 * j; const f32x4 a = *(const f32x4*)(c.tile + n * 68 + 8 * c8), b = *(const f32x4*)(c.tile + n * 68 + 8 * c8 + 4);
                u32x2 o; o.x = pk4_fp8(a[0], a[1], a[2], a[3]); o.y = pk4_fp8(b[0], b[1], b[2], b[3]);
                int row = it.n0 + n; if (it.mode == 1) { const int f = row & 1023; row = ((f >> 7) << 8) + ((row >> 10) << 7) + (f & 127); }
                *(u32x2*)(it.WT + (size_t)row * DM + it.k0 + 8 * c8) = o; }
        }
    }
    if (cs < nst) {
        const WcItem it = wc_decode(p, c.x0 + (cs >> 3)); const int kk = 8 * (cs & 7) + (lane >> 3), n4 = (lane & 7) * 4;
        c.pend = *(const f32x4*)(it.W + (size_t)(it.k0 + kk) * it.N + it.n0 + n4);
    }
    c.cs = cs + 1;
}

namespace att {
constexpr int NW = 8, QBLK = 32, KVBLK = 64;
constexpr float SCALE = 0.10206207261596575f;
constexpr float QSC = SCALE * 1.4426950408889634f;
constexpr int LDQ = DQK, LDK = 128, LDV = DV;
constexpr int SHM_V = KVBLK * DV * 2, SHM_K = KVBLK * 256, SHM_ATTN = 2 * SHM_V + 2 * SHM_K + NW * 64 * 4;
#define KSWZ(row, colB) ((row) * 256 + ((colB) ^ (((row) & 7) << 4)))
#define SBAR() __builtin_amdgcn_sched_barrier(0)
__device__ __forceinline__ int crow(int r, int hi) { return (r & 3) + 8 * (r >> 2) + 4 * hi; }
__device__ __forceinline__ float fadd_s(float a, float b) { float r; asm("v_add_f32_e32 %0, %1, %2" : "=v"(r) : "v"(a), "v"(b)); return r; }
__device__ __forceinline__ unsigned cvtpk(float lo, float hi) { unsigned r; asm volatile("v_cvt_pk_bf16_f32 %0, %1, %2" : "=v"(r) : "v"(lo), "v"(hi)); return r; }
#define EXPH(P) do { _Pragma("unroll") for (int r = 0; r < 16; ++r) P[r] = __builtin_amdgcn_exp2f(P[r]); } while (0)
__device__ __forceinline__ void finishSM(f32x16& p0, f32x16& p1, float& l_reg, bf16x8& pa0, bf16x8& pa1, bf16x8& pa2, bf16x8& pa3) {
    EXPH(p1);
    float ps0 = p0[0], ps1 = p1[0];
#pragma unroll
    for (int r = 1; r < 16; ++r) { ps0 = fadd_s(ps0, p0[r]); ps1 = fadd_s(ps1, p1[r]); }
    l_reg += ps0 + ps1;
#define PK4(P, BASE, OUT) do { unsigned a0 = cvtpk(P[BASE + 0], P[BASE + 1]), a1 = cvtpk(P[BASE + 2], P[BASE + 3]);   \
    unsigned b0 = cvtpk(P[BASE + 4], P[BASE + 5]), b1 = cvtpk(P[BASE + 6], P[BASE + 7]);                              \
    auto r0 = __builtin_amdgcn_permlane32_swap(a0, b0, false, false); auto r1 = __builtin_amdgcn_permlane32_swap(a1, b1, false, false); \
    u32x4 w = {r0[0], r1[0], r0[1], r1[1]}; OUT = *reinterpret_cast<bf16x8*>(&w); } while (0)
    PK4(p0, 0, pa0); PK4(p0, 8, pa1); PK4(p1, 0, pa2); PK4(p1, 8, pa3);
#undef PK4
}
__device__ __forceinline__ void qkt(f32x16& p0, f32x16& p1, const unsigned char* Ks, const bf16x8* qr, int r32, int hi) {
    p0 = f32x16{}; p1 = f32x16{};
#pragma unroll
    for (int d0 = 0; d0 < 6; ++d0) { const int cb = (d0 * 16 + hi * 8) * 2;
        const bf16x8 b0 = *reinterpret_cast<const bf16x8*>(Ks + KSWZ(r32, cb));
        const bf16x8 b1 = *reinterpret_cast<const bf16x8*>(Ks + KSWZ(32 + r32, cb));
        p0 = __builtin_amdgcn_mfma_f32_32x32x16_bf16(b0, qr[d0], p0, 0, 0, 0);
        p1 = __builtin_amdgcn_mfma_f32_32x32x16_bf16(b1, qr[d0], p1, 0, 0, 0); }
}
__device__ __forceinline__ int v_st(int k, int c) { const int kk = (k & ~0xC) | ((k & 4) << 1) | ((k & 8) >> 1); return ((kk >> 3) * 2 + (c >> 5)) * 512 + ((kk & 7) * 32 + (c & 31)) * 2; }
__device__ __forceinline__ int v_rd_base(int lane) { return ((lane & 3) << 3) | (((lane >> 2) & 3) << 6) | (((lane >> 4) & 1) << 5) | (((lane >> 5) & 1) << 8); }
constexpr int v_rd_off(int d0, int ks, int half) { return d0 * 512 + ks * 2048 + half * 1024; }
template <int OFF> __device__ __forceinline__ s16x4 tr_read(int vb) { s16x4 r; asm volatile("ds_read_b64_tr_b16 %0, %1 offset:%2" : "=&v"(r) : "v"(vb), "i"(OFF) : "memory"); return r; }
template <int D0> __device__ __forceinline__ void pv_one(f32x16& od, int vb, bf16x8 pa0, bf16x8 pa1, bf16x8 pa2, bf16x8 pa3) {
    const s16x4 l0 = tr_read<v_rd_off(D0, 0, 0)>(vb), h0 = tr_read<v_rd_off(D0, 0, 1)>(vb), l1 = tr_read<v_rd_off(D0, 1, 0)>(vb), h1 = tr_read<v_rd_off(D0, 1, 1)>(vb);
    const s16x4 l2 = tr_read<v_rd_off(D0, 2, 0)>(vb), h2 = tr_read<v_rd_off(D0, 2, 1)>(vb), l3 = tr_read<v_rd_off(D0, 3, 0)>(vb), h3 = tr_read<v_rd_off(D0, 3, 1)>(vb);
    asm volatile("s_waitcnt lgkmcnt(0)" ::: "memory"); SBAR();
#define PK(L, H) (bf16x8){L[0], L[1], L[2], L[3], H[0], H[1], H[2], H[3]}
    od = __builtin_amdgcn_mfma_f32_32x32x16_bf16(pa0, PK(l0, h0), od, 0, 0, 0);
    od = __builtin_amdgcn_mfma_f32_32x32x16_bf16(pa1, PK(l1, h1), od, 0, 0, 0);
    od = __builtin_amdgcn_mfma_f32_32x32x16_bf16(pa2, PK(l2, h2), od, 0, 0, 0);
    od = __builtin_amdgcn_mfma_f32_32x32x16_bf16(pa3, PK(l3, h3), od, 0, 0, 0);
#undef PK
}
__device__ __forceinline__ void pv_d0(f32x16* o, int vb, bf16x8 pa0, bf16x8 pa1, bf16x8 pa2, bf16x8 pa3) { pv_one<0>(o[0], vb, pa0, pa1, pa2, pa3); pv_one<1>(o[1], vb, pa0, pa1, pa2, pa3); }
struct VFrag { s16x4 l0, h0, l1, h1, l2, h2, l3, h3; };
template <int D0> __device__ __forceinline__ void vread(VFrag& f, int vb) {
    f.l0 = tr_read<v_rd_off(D0, 0, 0)>(vb); f.h0 = tr_read<v_rd_off(D0, 0, 1)>(vb); f.l1 = tr_read<v_rd_off(D0, 1, 0)>(vb); f.h1 = tr_read<v_rd_off(D0, 1, 1)>(vb);
    f.l2 = tr_read<v_rd_off(D0, 2, 0)>(vb); f.h2 = tr_read<v_rd_off(D0, 2, 1)>(vb); f.l3 = tr_read<v_rd_off(D0, 3, 0)>(vb); f.h3 = tr_read<v_rd_off(D0, 3, 1)>(vb); }
__device__ __forceinline__ void vmma(f32x16& od, const VFrag& f, bf16x8 pa0, bf16x8 pa1, bf16x8 pa2, bf16x8 pa3) {
#define PK(L, H) (bf16x8){L[0], L[1], L[2], L[3], H[0], H[1], H[2], H[3]}
    od = __builtin_amdgcn_mfma_f32_32x32x16_bf16(pa0, PK(f.l0, f.h0), od, 0, 0, 0);
    od = __builtin_amdgcn_mfma_f32_32x32x16_bf16(pa1, PK(f.l1, f.h1), od, 0, 0, 0);
    od = __builtin_amdgcn_mfma_f32_32x32x16_bf16(pa2, PK(f.l2, f.h2), od, 0, 0, 0);
    od = __builtin_amdgcn_mfma_f32_32x32x16_bf16(pa3, PK(f.l3, f.h3), od, 0, 0, 0);
#undef PK
}
#define EXPQ(P, B) do { _Pragma("unroll") for (int r = (B); r < (B) + 8; ++r) P[r] = __builtin_amdgcn_exp2f(P[r]); } while (0)
#define LWAIT() do { asm volatile("s_waitcnt lgkmcnt(0)" ::: "memory"); SBAR(); } while (0)
#define PV_STEP(vb, PN) do { LWAIT(); VFrag f1_; vread<1>(f1_, (vb)); vmma(o[0], f0, pa0, pa1, pa2, pa3); EXPQ(PN, 0); LWAIT(); vmma(o[1], f1_, pa0, pa1, pa2, pa3); EXPQ(PN, 8); SBAR(); } while (0)

__device__ __forceinline__ void attn_unit(const bf16_t* __restrict__ Qb, const bf16_t* __restrict__ Kh, const bf16_t* __restrict__ Vh, bf16_t* __restrict__ Ob, int seq, unsigned char* lds, WConv& wc, const Params& prm) {
    const int tid = threadIdx.x, wid = __builtin_amdgcn_readfirstlane(tid >> 6), lane = tid & 63, r32 = lane & 31, hi = lane >> 5;
    unsigned char* V_lds = lds; unsigned char* K_lds = lds + 2 * SHM_V;
    float* wsf = (float*)(lds + 2 * SHM_V + 2 * SHM_K) + wid * 64; float* li_l = wsf;
    float l_reg = 0; f32x16 o[2] = {}; bf16x8 qr[6];
    const bf16_t* Qw = Qb + (size_t)(wid * QBLK + r32) * LDQ + hi * 8;
#pragma unroll
    for (int d0 = 0; d0 < 6; ++d0) qr[d0] = *reinterpret_cast<const bf16x8*>(Qw + d0 * 16);
    const int kr0 = 8 * wid + (lane >> 4), kcp = lane & 15;
    const bf16_t* ksrc0 = Kh + (size_t)kr0 * LDK + ((kcp ^ (kr0 & 7)) * 8);
    const bf16_t* ksrc1 = Kh + (size_t)(kr0 + 4) * LDK + ((kcp ^ ((kr0 + 4) & 7)) * 8);
    const int vkk = 8 * wid + ((lane >> 2) & 7), vk = (vkk & ~0xC) | ((vkk & 4) << 1) | ((vkk & 8) >> 1), vcc = 32 * (lane >> 5) + 8 * (lane & 3);
    const bf16_t* vsrc = Vh + (size_t)vk * LDV + vcc;
    typedef __attribute__((address_space(3))) unsigned* lds_u32p;
#define DMA_K(t, slot) do { __builtin_amdgcn_global_load_lds((const unsigned*)(ksrc0 + (size_t)(t) * KVBLK * LDK), (lds_u32p)(K_lds + (slot) * SHM_K + wid * 2048 + lane * 16), 16, 0, 0); \
                            __builtin_amdgcn_global_load_lds((const unsigned*)(ksrc1 + (size_t)(t) * KVBLK * LDK), (lds_u32p)(K_lds + (slot) * SHM_K + wid * 2048 + 1024 + lane * 16), 16, 0, 0); } while (0)
#define DMA_V(t, slot) __builtin_amdgcn_global_load_lds((const unsigned*)(vsrc + (size_t)(t) * KVBLK * LDV), (lds_u32p)(V_lds + (slot) * SHM_V + wid * 1024 + lane * 16), 16, 0, 0)
    const int vb0 = (int)(uintptr_t)V_lds + v_rd_base(lane);
    f32x16 pA0, pA1, pB0, pB1; bf16x8 pa0, pa1, pa2, pa3; const int NT = seq / KVBLK;
    DMA_K(0, 0); DMA_V(0, 0); DMA_K(1, 1);
    asm volatile("s_waitcnt vmcnt(0)" ::: "memory"); __syncthreads();
    qkt(pA0, pA1, K_lds, qr, r32, hi); EXPH(pA0); SBAR();
    __syncthreads();
    VFrag f0;
    for (int j = 0; j + 2 < NT; j += 2) {
        DMA_K(j + 2, 0); DMA_V(j + 1, 1); wconv_step(wc, prm, lane); SBAR();
        vread<0>(f0, vb0);
        qkt(pB0, pB1, K_lds + SHM_K, qr, r32, hi);
        finishSM(pA0, pA1, l_reg, pa0, pa1, pa2, pa3); SBAR();
        PV_STEP(vb0, pB0);
        asm volatile("s_waitcnt vmcnt(0)" ::: "memory"); __syncthreads();
        DMA_K(j + 3, 1); DMA_V(j + 2, 0); wconv_step(wc, prm, lane); SBAR();
        vread<0>(f0, vb0 + SHM_V);
        qkt(pA0, pA1, K_lds, qr, r32, hi);
        finishSM(pB0, pB1, l_reg, pa0, pa1, pa2, pa3); SBAR();
        PV_STEP(vb0 + SHM_V, pA0);
        asm volatile("s_waitcnt vmcnt(0)" ::: "memory"); __syncthreads();
    }
    DMA_V(NT - 1, 1); wconv_step(wc, prm, lane); SBAR();
    vread<0>(f0, vb0);
    qkt(pB0, pB1, K_lds + SHM_K, qr, r32, hi);
    finishSM(pA0, pA1, l_reg, pa0, pa1, pa2, pa3); SBAR();
    PV_STEP(vb0, pB0);
    asm volatile("s_waitcnt vmcnt(0)" ::: "memory"); __syncthreads();
    finishSM(pB0, pB1, l_reg, pa0, pa1, pa2, pa3); SBAR();
    pv_d0(o, vb0 + SHM_V, pa0, pa1, pa2, pa3);
    { auto rr = __builtin_amdgcn_permlane32_swap(__float_as_uint(l_reg), __float_as_uint(l_reg), false, false); l_reg = __uint_as_float(rr[0]) + __uint_as_float(rr[1]); }
    if (hi == 0) li_l[r32] = l_reg; asm volatile("s_waitcnt lgkmcnt(0)" ::: "memory");
    float rli[16];
#pragma unroll
    for (int r = 0; r < 16; ++r) rli[r] = __builtin_amdgcn_rcpf(li_l[crow(r, hi)]);
    bf16_t* Ow = Ob + (size_t)(wid * QBLK) * 512;
#pragma unroll
    for (int r = 0; r < 16; ++r) { const int orow = crow(r, hi);
#pragma unroll
        for (int d0 = 0; d0 < 2; ++d0) Ow[(size_t)orow * 512 + d0 * 32 + r32] = (bf16_t)(pk2(o[d0][r] * rli[r], 0.f) & 0xffffu); }
    __syncthreads();
#undef DMA_K
#undef DMA_V
}
#undef KSWZ
#undef SBAR
}

__device__ __forceinline__ void phase_attn(const Params& p, unsigned char* lds) {
    const bf16_t* Q = (const bf16_t*)(p.ws + WS_Q); const bf16_t* Kb = (const bf16_t*)(p.ws + WS_K); const bf16_t* V = (const bf16_t*)(p.ws + WS_V); bf16_t* AO = (bf16_t*)(p.ws + WS_AO);
    constexpr int NQB = SEQ / 256, NU = 2 * NH * NQB;
    const int lane = threadIdx.x & 63, wave = __builtin_amdgcn_readfirstlane(threadIdx.x >> 6), gw = blockIdx.x * NWAVES + wave, NGW = gridDim.x * NWAVES;
    const int ipw = (WC_EXP_ITEMS + NGW - 1) / NGW, nun = ((int)blockIdx.x < NU) ? (NU - 1 - (int)blockIdx.x) / (int)gridDim.x + 1 : 0, steps = nun * (SEQ / att::KVBLK - 1);
    int cov = (steps - 1) / 8; cov = cov < 0 ? 0 : (cov > ipw ? ipw : cov);
    WConv wc; wc.tile = (float*)(lds + att::SHM_ATTN) + wave * WC_TILE_F; wc.x0 = gw * ipw; wc.cs = 0; wc.pend = (f32x4){0.f, 0.f, 0.f, 0.f};
    { const int left = WC_EXP_ITEMS - wc.x0; wc.nitems = left < 0 ? 0 : (left < cov ? left : cov); }
    if (wave >= 4) __builtin_amdgcn_s_setprio(1);
    const bool xmap = false;
    for (int u0 = blockIdx.x, rnd = 0; u0 < NU; u0 += gridDim.x, ++rnd) {
        const int u = xmap ? (((int)blockIdx.x & 7) + 8 * rnd) * NQB + ((int)blockIdx.x >> 3) : u0;
        const int qb = u % NQB, h = (u / NQB) % NH, b = u / (NQB * NH); const size_t bh = (size_t)(b * NH + h) * SEQ;
        att::attn_unit(Q + (bh + (size_t)qb * 256) * DQK, Kb + bh * 128, V + bh * DV, AO + ((size_t)b * SEQ + (size_t)qb * 256) * 512 + h * DV, SEQ, lds, wc, p);
    }
    __builtin_amdgcn_s_setprio(0);
    while (wc.cs <= 8 * wc.nitems) wconv_step(wc, p, lane);
}
__device__ __forceinline__ void wconv_cleanup(const Params& p, unsigned char* lds) {
    constexpr int NQB = SEQ / 256, NU = 2 * NH * NQB;
    const int lane = threadIdx.x & 63, wave = threadIdx.x >> 6, gw = blockIdx.x * NWAVES + wave, NGW = gridDim.x * NWAVES;
    const int ipw = (WC_EXP_ITEMS + NGW - 1) / NGW, nun = ((int)blockIdx.x < NU) ? (NU - 1 - (int)blockIdx.x) / (int)gridDim.x + 1 : 0, steps = nun * (SEQ / att::KVBLK - 1);
    int cov = (steps - 1) / 8; cov = cov < 0 ? 0 : (cov > ipw ? ipw : cov);
    float* scr = (float*)(lds + wave * 16384);
    for (int i = cov; i < ipw; ++i) { const int x = gw * ipw + i; if (x >= WC_EXP_ITEMS) break; const WcItem it = wc_decode(p, x); const int r = x % 1536;
        if (it.mode == 1) transpose_item_fp8<1>(it.W, DM, 2048, it.WT, scr, r, lane); else transpose_item_fp8<0>(it.W, DFF, DM, it.WT, scr, r - 1024, lane); }
    __syncthreads();
}

__device__ __forceinline__ int crow16(int r, int hi) { return (r & 3) + 8 * (r >> 2) + 4 * hi; }
__device__ __forceinline__ void phase_router(const Params& p, unsigned char* lds) {
    const int tid = threadIdx.x, lane = tid & 63, wid = tid >> 6, tile = wid >> 2, kq = wid & 3, c = lane & 31, h = lane >> 5;
    float* red = (float*)lds;
    float* ssb = red + 2 * 4 * 16 * 64;
    int* lcnt = (int*)(ssb + 2 * 4 * 64);
    int* lbase = lcnt + 32;
    unsigned* gcnt = (unsigned*)(p.ws + WS_CTL) + CW_CNT;
    int* row_tok = (int*)(p.ws + WS_RT2); float* row_w = (float*)(p.ws + WS_RT2 + 2 * MiB); int* row_slot = (int*)(p.ws + WS_RT2 + 4 * MiB); float* row_rstd = (float*)(p.ws + WS_RT2 + 6 * MiB);
    const u32x4* GF = (const u32x4*)(p.ws + WS_GF);
    for (int tg = blockIdx.x; tg < NTOK / 64; tg += gridDim.x) {
        if (tid < 32) lcnt[tid] = 0;
        const int token = tg * 64 + tile * 32 + c;
        const float* xrow = p.out + (size_t)token * DM + kq * 256 + 8 * h; const float* g2p = p.norm2_g + kq * 256 + 8 * h;
        unsigned char* hrow = p.ws + WS_H8 + (size_t)token * DM + kq * 256 + 8 * h;
        f32x16 acc = {}; float ss = 0.f;
#pragma unroll 2
        for (int s = 0; s < 16; ++s) {
            const f32x4 a = *(const f32x4*)(xrow + 16 * s), b = *(const f32x4*)(xrow + 16 * s + 4); const f32x4 ga = *(const f32x4*)(g2p + 16 * s), gb = *(const f32x4*)(g2p + 16 * s + 4);
            ss += (a[0] * a[0] + a[1] * a[1]) + (a[2] * a[2] + a[3] * a[3]) + (b[0] * b[0] + b[1] * b[1]) + (b[2] * b[2] + b[3] * b[3]);
            u32x4 xh; xh.x = pk2(a[0], a[1]); xh.y = pk2(a[2], a[3]); xh.z = pk2(b[0], b[1]); xh.w = pk2(b[2], b[3]);
            u32x4 xl; xl.x = pk2(a[0] - bf_lo(xh.x), a[1] - bf_hi(xh.x)); xl.y = pk2(a[2] - bf_lo(xh.y), a[3] - bf_hi(xh.y)); xl.z = pk2(b[0] - bf_lo(xh.z), b[1] - bf_hi(xh.z)); xl.w = pk2(b[2] - bf_lo(xh.w), b[3] - bf_hi(xh.w));
            u32x2 h8; h8.x = pk4_fp8(a[0] * ga[0], a[1] * ga[1], a[2] * ga[2], a[3] * ga[3]); h8.y = pk4_fp8(b[0] * gb[0], b[1] * gb[1], b[2] * gb[2], b[3] * gb[3]); *(u32x2*)(hrow + 16 * s) = h8;
            const u32x4 gh = GF[((kq * 16 + s) * 2 + 0) * 64 + lane], gl = GF[((kq * 16 + s) * 2 + 1) * 64 + lane];
            acc = __builtin_amdgcn_mfma_f32_32x32x16_bf16(__builtin_bit_cast(bf16x8, gh), __builtin_bit_cast(bf16x8, xh), acc, 0, 0, 0);
            acc = __builtin_amdgcn_mfma_f32_32x32x16_bf16(__builtin_bit_cast(bf16x8, gh), __builtin_bit_cast(bf16x8, xl), acc, 0, 0, 0);
            acc = __builtin_amdgcn_mfma_f32_32x32x16_bf16(__builtin_bit_cast(bf16x8, gl), __builtin_bit_cast(bf16x8, xh), acc, 0, 0, 0);
        }
#pragma unroll
        for (int r = 0; r < 16; ++r) red[((tile * 4 + kq) * 16 + r) * 64 + lane] = acc[r];
        ssb[(tile * 4 + kq) * 64 + lane] = ss;
        __syncthreads();
        int te[4] = {0, 0, 0, 0}, rl[4] = {0, 0, 0, 0}; float tw[4] = {0.f, 0.f, 0.f, 0.f}; float rstd = 0.f;
        if (kq == 0) {
            float v[16]; float st = 0.f;
#pragma unroll
            for (int q = 0; q < 4; ++q) st += ssb[(tile * 4 + q) * 64 + lane];
            { auto rr = __builtin_amdgcn_permlane32_swap(__float_as_uint(st), __float_as_uint(st), false, false); st = __uint_as_float(rr[0]) + __uint_as_float(rr[1]); }
            rstd = rsqrtf(st * (1.f / DM) + EPS);
#pragma unroll
            for (int r = 0; r < 16; ++r) { float sacc = 0.f;
#pragma unroll
                for (int q = 0; q < 4; ++q) sacc += red[((tile * 4 + q) * 16 + r) * 64 + lane];
                v[r] = sacc * rstd + p.router_b[crow16(r, h)]; }
            float lv[4]; int le[4];
#pragma unroll
            for (int k = 0; k < 4; ++k) { float best = v[0]; int bi = 0;
#pragma unroll
                for (int r = 1; r < 16; ++r) { const bool gt = v[r] > best; best = gt ? v[r] : best; bi = gt ? r : bi; }
                lv[k] = best; le[k] = (bi & 3) + 8 * (bi >> 2) + 4 * h;
#pragma unroll
                for (int r = 0; r < 16; ++r) v[r] = (r == bi) ? -INFINITY : v[r]; }
            float cv[8]; int ce[8];
#pragma unroll
            for (int k = 0; k < 4; ++k) { auto rv = __builtin_amdgcn_permlane32_swap(__float_as_uint(lv[k]), __float_as_uint(lv[k]), false, false); auto re = __builtin_amdgcn_permlane32_swap((unsigned)le[k], (unsigned)le[k], false, false);
                cv[k] = __uint_as_float(rv[0]); cv[4 + k] = __uint_as_float(rv[1]); ce[k] = (int)re[0]; ce[4 + k] = (int)re[1]; }
            float tv[4];
#pragma unroll
            for (int k = 0; k < 4; ++k) { float best = cv[0]; int be = ce[0]; int bi = 0;
#pragma unroll
                for (int r = 1; r < 8; ++r) { const bool gt = (cv[r] > best) || (cv[r] == best && ce[r] < be); best = gt ? cv[r] : best; be = gt ? ce[r] : be; bi = gt ? r : bi; }
                tv[k] = best; te[k] = be;
#pragma unroll
                for (int r = 0; r < 8; ++r) cv[r] = (r == bi) ? -INFINITY : cv[r]; }
            const float e1 = __expf(tv[1] - tv[0]), e2 = __expf(tv[2] - tv[0]), e3 = __expf(tv[3] - tv[0]); const float inv = 1.f / (1.f + e1 + e2 + e3);
            tw[0] = inv; tw[1] = e1 * inv; tw[2] = e2 * inv; tw[3] = e3 * inv;
            if (h == 0) {
#pragma unroll
                for (int k = 0; k < 4; ++k) rl[k] = atomicAdd(&lcnt[te[k]], 1); }
        }
        __syncthreads();
        if (tid < 32) lbase[tid] = (int)atomicAdd(&gcnt[tid], (unsigned)lcnt[tid]);
        __syncthreads();
        if (kq == 0 && h == 0) {
#pragma unroll
            for (int k = 0; k < 4; ++k) { const int idx = te[k] * CAP + lbase[te[k]] + rl[k]; row_tok[idx] = token; row_w[idx] = tw[k]; row_slot[idx] = token * 4 + k; row_rstd[idx] = rstd; } }
        __syncthreads();
    }
}

__device__ __forceinline__ void build_block_table(const Params& p, int* bs) {
    const unsigned* gcnt = (const unsigned*)(p.ws + WS_CTL) + CW_CNT;
    if (threadIdx.x == 0) { int acc = 0; for (int e = 0; e < NE; ++e) { bs[e] = acc; acc += ((int)__hip_atomic_load(gcnt + e, __ATOMIC_RELAXED, __HIP_MEMORY_SCOPE_AGENT) + 255) >> 8; } bs[NE] = acc; }
    __syncthreads();
}

__device__ __forceinline__ pg8::MoeOrder make_moe_order(const Params& p, unsigned char* lds, int N, bool gather) {
    int* bs = (int*)(lds + 131072); int* utab = (int*)(lds + 131072 + 256); int* gtab = (int*)(lds + 131072 + 512);
    build_block_table(p, bs);
    const int nmb = __builtin_amdgcn_readfirstlane(bs[NE]);
    pg8::MoeOrder S; S.so.init(nmb * 256, N, (int)gridDim.x, (int)blockIdx.x); S.utab = (const PG8_LAS int*)utab; S.gtab = (const PG8_LAS int*)gtab;
    const int* row_tok = (const int*)(p.ws + WS_RT2);
    for (int i = 0; i < pg8::MOE_MAXU; ++i) { pg8::Unit u; if (!S.so.next(i, u)) break; int e = 0; for (int k = 1; k < NE; ++k) if (bs[k] <= u.pm) e = k;
        const int rb = e * CAP + (u.pm - bs[e]) * 256;
        if (threadIdx.x == 0) utab[i] = e | (rb << 8);
        if (gather && threadIdx.x < 256) gtab[i * 256 + threadIdx.x] = row_tok[rb + threadIdx.x]; }
    __syncthreads();
    return S;
}
__device__ __forceinline__ void phase_moe1(const Params& p, unsigned char* lds) {
    const pg8::MoeOrder S = make_moe_order(p, lds, 2048, true);
    pg8::Gemm g{(const bf16_t*)(p.ws + WS_H8), (const bf16_t*)(p.ws + WS_W1), 0, 2048, DM / 2, (size_t)2048 * DM, 0};
    pg8::EpiSwiglu E{p.ws + WS_ACT, p.b1, (const float*)(p.ws + WS_RT2 + 6 * MiB)};
    pg8::gemm_phase<pg8::EpiSwiglu, pg8::MoeOrder, true, true, true, true>((PG8_LAS unsigned char*)lds, g, S, E);
}
__device__ __forceinline__ void phase_moe2(const Params& p, unsigned char* lds) {
    const pg8::MoeOrder S = make_moe_order(p, lds, DM, false);
    pg8::Gemm g{(const bf16_t*)(p.ws + WS_ACT), (const bf16_t*)(p.ws + WS_W2), 0, DM, DFF / 2, (size_t)DM * DFF, 0};
    pg8::EpiMoeOut E{(bf16_t*)(p.ws + WS_YS), p.b2, (const float*)(p.ws + WS_RT2 + 2 * MiB), (const int*)(p.ws + WS_RT2 + 4 * MiB)};
    pg8::gemm_phase<pg8::EpiMoeOut, pg8::MoeOrder, true, true, true>((PG8_LAS unsigned char*)lds, g, S, E);
}

__device__ __forceinline__ void phase_combine(const Params& p) {
    const int tid = threadIdx.x, lane = tid & 63, wave = tid >> 6;
    const int gw = blockIdx.x * NWAVES + wave, NGW = gridDim.x * NWAVES;
    const bf16_t* YS = (const bf16_t*)(p.ws + WS_YS);
    for (int t = gw; t < NTOK; t += NGW) {
        f32x4* orow = (f32x4*)(p.out + (size_t)t * DM) + lane;
#pragma unroll
        for (int j = 0; j < 4; ++j) { f32x4 v = orow[64 * j];
#pragma unroll
            for (int k = 0; k < 4; ++k) { const u32x2 w = *((const u32x2*)(YS + ((size_t)t * 4 + k) * DM) + lane + 64 * j); v[0] += bf_lo(w.x); v[1] += bf_hi(w.x); v[2] += bf_lo(w.y); v[3] += bf_hi(w.y); }
            orow[64 * j] = v; }
    }
}

template <class Epi>
__device__ __forceinline__ void dense_gemm(unsigned char* lds, const bf16_t* A, const bf16_t* Bt, int M, int N, int K, const Epi& E, int lda = 0) {
    pg8::Gemm g{A, Bt, M, N, K, 0, lda}; pg8::StaticOrder S; S.init(M, N, (int)gridDim.x, (int)blockIdx.x);
    pg8::gemm_phase<Epi, pg8::StaticOrder, true, true>((PG8_LAS unsigned char*)lds, g, S, E);
}

constexpr int NPHASE = 13;
__global__ void __launch_bounds__(NTHREADS, 2) mk_fwd(Params p) {
    extern __shared__ __attribute__((aligned(16))) unsigned char lds[];
    cg::grid_group grid = cg::this_grid();
    unsigned char* ws = p.ws;
    volatile LAS unsigned* MISC = (volatile LAS unsigned*)((LAS unsigned char*)lds + MISC_OFF);
    if (threadIdx.x < 32) MISC[threadIdx.x] = 0u;
    __syncthreads();
    XcdBarrier bar = xcd_barrier_post((unsigned*)(ws + WS_CTL) + CW_BAR, MISC + 8);
    const int lo = p.ph_lo, hi = p.ph_hi;
    if (lo < 0) grid.sync();
#define IN(k) (lo <= (k) && (k) < hi)
#define SEAM(k) do { if (IN(k) && IN((k) + 1)) xcd_barrier(bar); } while (0)
    if (IN(0)) phase_prologue(p, lds);
    SEAM(0);
    if (IN(1)) { pg8::EpiProj E{(bf16_t*)(ws + WS_PROJ)}; dense_gemm(lds, (const bf16_t*)(ws + WS_XN), (const bf16_t*)(ws + WS_WIN), NTOK, INCP, DM, E); }
    if (IN(1) && IN(3)) xcd_barrier(bar);
    if (IN(3)) { pg8::EpiBf16 Eq{(bf16_t*)(ws + WS_QPRE), 768}; dense_gemm(lds, (const bf16_t*)(ws + WS_PROJ) + OFF_CQ, (const bf16_t*)(ws + WS_WUQ), NTOK, 768, QLORA, Eq, INCP);
                 pg8::EpiBf16 Ek{(bf16_t*)(ws + WS_KVPRE), 1024}; dense_gemm(lds, (const bf16_t*)(ws + WS_PROJ) + OFF_CKV, (const bf16_t*)(ws + WS_WUKV), NTOK, 1024, KVLORA, Ek, INCP); }
    SEAM(3);
    if (IN(4)) phase_tok_b(p);
    SEAM(4);
    if (IN(5)) phase_attn(p, lds);
    SEAM(5);
    if (IN(6)) { pg8::EpiGateA E{(bf16_t*)(ws + WS_M1), (const bf16_t*)(ws + WS_PROJ)}; dense_gemm(lds, (const bf16_t*)(ws + WS_AO), (const bf16_t*)(ws + WS_WOMLA), NTOK, DM, 512, E); }
    if (IN(7)) { pg8::EpiGateB E{(const bf16_t*)(ws + WS_M1), (const bf16_t*)(ws + WS_PROJ), (bf16_t*)(ws + WS_MERGED)}; dense_gemm(lds, (const bf16_t*)(ws + WS_YBIN), (const bf16_t*)(ws + WS_WOCONV), NTOK, DM, 512, E); }
    SEAM(7);
    if (IN(8)) { pg8::EpiResid E{p.x, p.out}; dense_gemm(lds, (const bf16_t*)(ws + WS_MERGED), (const bf16_t*)(ws + WS_WO), NTOK, DM, DM, E); }
    SEAM(8);
    if (IN(9)) { wconv_cleanup(p, lds); phase_router(p, lds); }
    if (IN(9) && IN(11)) xcd_barrier(bar);
    if (IN(11)) phase_moe1(p, lds);
    SEAM(11);
    if (IN(12)) phase_moe2(p, lds);
    SEAM(12);
    if (IN(13)) phase_combine(p);
#undef IN
#undef SEAM
}

extern "C" void kernel_launch(void* const* d_in, const int* in_sizes, int n_in, void* d_out, int out_size,
                              void* d_ws, size_t ws_size, hipStream_t stream) {
    static int grid_blocks = 0;
    if (!grid_blocks) {
        int dev = 0, cus = 0, per_cu = 0;
        (void)hipGetDevice(&dev);
        (void)hipDeviceGetAttribute(&cus, hipDeviceAttributeMultiprocessorCount, dev);
        (void)hipFuncSetAttribute((const void*)mk_fwd, hipFuncAttributeMaxDynamicSharedMemorySize, LDS_BYTES);
        (void)hipOccupancyMaxActiveBlocksPerMultiprocessor(&per_cu, (const void*)mk_fwd, NTHREADS, LDS_BYTES);
        if (per_cu < 1) { fprintf(stderr, "kernel_launch: occupancy query says %d blocks/CU\n", per_cu); per_cu = 1; }
        grid_blocks = cus;
        if (ws_size < WS_END2 || n_in != 21) fprintf(stderr, "kernel_launch: ws %zu < %zu or n_in %d != 21\n", ws_size, (size_t)WS_END2, n_in);
    }
    (void)hipMemsetAsync((char*)d_ws + WS_CTL, 0, 1 * MiB, stream);
    Params p{};
    p.x = (const float*)d_in[0]; p.pos = (const int*)d_in[1]; p.norm1_g = (const float*)d_in[2]; p.w_in = (const float*)d_in[3]; p.q_a_g = (const float*)d_in[4];
    p.kv_a_g = (const float*)d_in[5]; p.w_uq = (const float*)d_in[6]; p.w_ukv = (const float*)d_in[7]; p.q_g = (const float*)d_in[8]; p.k_g = (const float*)d_in[9];
    p.conv_w = (const float*)d_in[10]; p.w_o_mla = (const float*)d_in[11]; p.w_o_conv = (const float*)d_in[12]; p.w_o = (const float*)d_in[13]; p.norm2_g = (const float*)d_in[14];
    p.router_w = (const float*)d_in[15]; p.router_b = (const float*)d_in[16]; p.w1 = (const float*)d_in[17]; p.b1 = (const float*)d_in[18]; p.w2 = (const float*)d_in[19]; p.b2 = (const float*)d_in[20];
    p.out = (float*)d_out; p.ws = (unsigned char*)d_ws; p.ph_lo = 0; p.ph_hi = NPHASE + 1;
    void* args[] = {&p};
    hipError_t e = hipLaunchCooperativeKernel((const void*)mk_fwd, dim3(grid_blocks), dim3(NTHREADS), args, LDS_BYTES, stream);
    if (e != hipSuccess) fprintf(stderr, "cooperative launch failed: %s (grid %d)\n", hipGetErrorString(e), grid_blocks);
}
```

```cpp
#include <hip/hip_runtime.h>
#include <hip/hip_cooperative_groups.h>
#include <cstdio>
#include <cstdint>
namespace cg = cooperative_groups;

typedef unsigned short bf16_t;
typedef short bf16x8 __attribute__((ext_vector_type(8)));
typedef short s16x4 __attribute__((ext_vector_type(4)));
typedef float f32x4 __attribute__((ext_vector_type(4)));
typedef float f32x2 __attribute__((ext_vector_type(2)));
typedef float f32x16 __attribute__((ext_vector_type(16)));
typedef unsigned u32x4 __attribute__((ext_vector_type(4)));
typedef unsigned u32x2 __attribute__((ext_vector_type(2)));
typedef __bf16 bf16x2_t __attribute__((ext_vector_type(2)));

constexpr int NTOK = 16384, DM = 1024, SEQ = 8192;
constexpr int INC = 4000, INCP = 4096;
constexpr int OFF_CQ = 0, OFF_CKV = 256, OFF_KR = 384, OFF_U = 416, OFF_C = 928, OFF_B = 1440, OFF_GA = 1952, OFF_GB = 2976;
constexpr int NH = 8, DQK = 96, DV = 64, NE = 32, TOPK = 4, DFF = 1024;
constexpr int QLORA = 256, KVLORA = 128, CONVW = 512;
constexpr int NPAIR = NTOK * TOPK;
constexpr int MAXROWS = 73728;
constexpr float EPS = 1e-6f;
constexpr int CAP = 16384;
constexpr int NTHREADS = 512, NWAVES = 8;
constexpr int LDS_BYTES = 147456;

constexpr size_t MiB = 1ull << 20;
constexpr size_t WS_CTL = 0;
constexpr size_t WS_WIN = 1 * MiB;
constexpr size_t WS_WUQ = 9 * MiB;
constexpr size_t WS_WUKV = WS_WUQ + 512 * 1024;
constexpr size_t WS_WOMLA = 10 * MiB;
constexpr size_t WS_WOCONV = 11 * MiB;
constexpr size_t WS_WO = 12 * MiB;
constexpr size_t WS_ROUTE = 14 * MiB;
constexpr size_t WS_W1 = 18 * MiB;
constexpr size_t WS_W2 = 146 * MiB;
constexpr size_t WS_XN = 210 * MiB;
constexpr size_t WS_PROJ = 242 * MiB;
constexpr size_t WS_CQN = 370 * MiB;
constexpr size_t WS_CKVN = 378 * MiB;
constexpr size_t WS_YBIN = 386 * MiB;
constexpr size_t WS_QPRE = 402 * MiB;
constexpr size_t WS_KVPRE = 450 * MiB;
constexpr size_t WS_Q = 514 * MiB;
constexpr size_t WS_K = 538 * MiB;
constexpr size_t WS_V = 570 * MiB;
constexpr size_t WS_AO = 586 * MiB;
constexpr size_t WS_M1 = 602 * MiB;
constexpr size_t WS_MERGED = 666 * MiB;
constexpr size_t WS_YS = 698 * MiB;
constexpr size_t WS_END = 826 * MiB;
constexpr size_t WS_ACT = WS_PROJ;
constexpr size_t WS_H8 = WS_XN;
constexpr size_t WS_GF = 830 * MiB;
constexpr size_t WS_RT2 = 832 * MiB;
constexpr size_t WS_END2 = 840 * MiB;
constexpr size_t RT_PAIR_E = 0, RT_PAIR_RANK = 262144, RT_PAIR_W = 524288, RT_ROW_TOK = 786432, RT_ROW_W = 786432 + 294912, RT_ROW_SLOT = 786432 + 2 * 294912;
constexpr int CW_CNT = 64;
constexpr int CW_BAR = 4096;
constexpr int MISC_OFF = LDS_BYTES - 256;

struct Params {
    const float* x; const int* pos; const float* norm1_g; const float* w_in; const float* q_a_g; const float* kv_a_g;
    const float* w_uq; const float* w_ukv; const float* q_g; const float* k_g; const float* conv_w; const float* w_o_mla;
    const float* w_o_conv; const float* w_o; const float* norm2_g; const float* router_w; const float* router_b;
    const float* w1; const float* b1; const float* w2; const float* b2;
    float* out; unsigned char* ws; int ph_lo, ph_hi;
};

__device__ __forceinline__ unsigned pk2(float lo, float hi) { f32x2 v = {lo, hi}; bf16x2_t b = __builtin_convertvector(v, bf16x2_t); return __builtin_bit_cast(unsigned, b); }
__device__ __forceinline__ float bf_lo(unsigned w) { return __uint_as_float(w << 16); }
__device__ __forceinline__ float bf_hi(unsigned w) { return __uint_as_float(w & 0xffff0000u); }
__device__ __forceinline__ float bf1(bf16_t h) { return __uint_as_float((unsigned)h << 16); }
__device__ __forceinline__ float wave_sum(float v) {
#pragma unroll
    for (int o = 1; o < 64; o <<= 1) v += __shfl_xor(v, o);
    return v;
}
__device__ __forceinline__ unsigned pk4_fp8(float a, float b, float c, float d) { unsigned w = 0u; w = (unsigned)__builtin_amdgcn_cvt_pk_fp8_f32(a, b, (int)w, false); w = (unsigned)__builtin_amdgcn_cvt_pk_fp8_f32(c, d, (int)w, true); return w; }
constexpr float W8_SCALE = 32.f, W8_INV = 1.f / 32.f, YS_SCALE = 8.f, YS_INV = 0.125f;
__device__ __forceinline__ float sigmoidf_(float v) { return __builtin_amdgcn_rcpf(1.f + __builtin_amdgcn_exp2f(v * -1.4426950408889634f)); }

namespace pg8 {
#define PG8_LAS __attribute__((address_space(3)))
constexpr int BM = 256, BK = 64, HALF = 128, HTB = HALF * BK * 2  , STAGE_BYTES = 8 * HTB, NXCD = 8, WGM = 8;

__host__ __device__ __forceinline__ int lds_byte(int r, int c) { const int st = (r >> 4) * 2 + (c >> 5), rr = r & 15, cc = c & 31, ob = rr * 64 + cc * 2; return st * 1024 + (ob ^ (((ob >> 9) & 1) << 5)); }
__host__ __device__ __forceinline__ void stage_rc(int b, int& R, int& C) { const int st = b / 1024, sb = b % 1024, swz = sb ^ (((sb >> 9) & 1) << 5); R = (st >> 1) * 16 + swz / 64; C = (st & 1) * 32 + (swz % 64) / 2; }
__host__ __device__ __forceinline__ int perm32(int rho) { const int n = rho >> 4, i = rho & 15; return 8 * (i >> 2) + 4 * n + (i & 3); }

struct Unit { int pm, pn, e, rb; };
struct Gemm { const bf16_t* A; const bf16_t* Bt; int M, N, K; size_t bstride; int lda; };

struct StaticOrder {
    int nM, nN, nwg, G, c;
    __host__ __device__ void init(int M, int N, int G_, int c_) { nM = M / BM; nN = N / BM; nwg = nM * nN; G = G_; c = c_; }
    __host__ __device__ bool next(int i, Unit& u) const {
        const long L = (long)i * G + c; if (L >= nwg) return false;
        int wgid = (int)L; { const int q = nwg / NXCD, r = nwg % NXCD, xcd = wgid % NXCD, off = wgid / NXCD; wgid = (xcd < r ? xcd * (q + 1) : r * (q + 1) + (xcd - r) * q) + off; }
        const int nig = WGM * nN, gid = wgid / nig, fm = gid * WGM, gsz = (nM - fm) < WGM ? (nM - fm) : WGM;
        u.pm = fm + ((wgid % nig) % gsz); u.pn = (wgid % nig) / gsz; u.e = 0; u.rb = 0; return true;
    }
    __device__ __forceinline__ void a_ready(const Unit&) const {}
    __device__ __forceinline__ void done(const Unit&) const {}
};


struct EpiProj {
    static constexpr bool PERM = true, AFTER_DRAIN = false;
    bf16_t* O;
    __device__ __forceinline__ void operator()(const f32x4 (&acc)[2][2][4][2], const Unit& u, int wr, int wc, int fr, int fq) const {
        const int row0 = u.pm * BM + wr * 64 + fr, col0 = u.pn * BM + wc * 32 + 8 * fq;
#pragma unroll
        for (int ai = 0; ai < 2; ++ai)
#pragma unroll
            for (int m = 0; m < 4; ++m) { bf16_t* rowp = O + (size_t)(row0 + ai * HALF + m * 16) * INCP + col0;
#pragma unroll
                for (int bj = 0; bj < 2; ++bj) { f32x4 v0 = acc[ai][bj][m][0], v1 = acc[ai][bj][m][1]; const int col = col0 + bj * HALF;
                    if (col >= OFF_GA && col < INC) {
#pragma unroll
                        for (int j = 0; j < 4; ++j) { v0[j] = sigmoidf_(v0[j]); v1[j] = sigmoidf_(v1[j]); } }
                    u32x4 w; w.x = pk2(v0[0], v0[1]); w.y = pk2(v0[2], v0[3]); w.z = pk2(v1[0], v1[1]); w.w = pk2(v1[2], v1[3]);
                    *(u32x4*)(rowp + bj * HALF) = w; } }
    }
};
struct EpiBf16 {
    static constexpr bool PERM = true, AFTER_DRAIN = false;
    bf16_t* O; int ldc;
    __device__ __forceinline__ void operator()(const f32x4 (&acc)[2][2][4][2], const Unit& u, int wr, int wc, int fr, int fq) const {
        const int row0 = u.pm * BM + wr * 64 + fr, col0 = u.pn * BM + wc * 32 + 8 * fq;
#pragma unroll
        for (int ai = 0; ai < 2; ++ai)
#pragma unroll
            for (int m = 0; m < 4; ++m) { bf16_t* rowp = O + (size_t)(row0 + ai * HALF + m * 16) * ldc + col0;
#pragma unroll
                for (int bj = 0; bj < 2; ++bj) { const f32x4 v0 = acc[ai][bj][m][0], v1 = acc[ai][bj][m][1];
                    u32x4 w; w.x = pk2(v0[0], v0[1]); w.y = pk2(v0[2], v0[3]); w.z = pk2(v1[0], v1[1]); w.w = pk2(v1[2], v1[3]); *(u32x4*)(rowp + bj * HALF) = w; } }
    }
};
struct EpiF32 {
    static constexpr bool PERM = false, AFTER_DRAIN = false;
    float* O; int ldc;
    __device__ __forceinline__ void operator()(const f32x4 (&acc)[2][2][4][2], const Unit& u, int wr, int wc, int fr, int fq) const {
        const int row0 = u.pm * BM + wr * 64 + fr, col0 = u.pn * BM + wc * 32 + 4 * fq;
#pragma unroll
        for (int ai = 0; ai < 2; ++ai)
#pragma unroll
            for (int m = 0; m < 4; ++m) { float* rowp = O + (size_t)(row0 + ai * HALF + m * 16) * ldc + col0;
#pragma unroll
                for (int bj = 0; bj < 2; ++bj)
#pragma unroll
                    for (int n = 0; n < 2; ++n) *(f32x4*)(rowp + bj * HALF + n * 16) = acc[ai][bj][m][n]; }
    }
};
__device__ __forceinline__ void unpack8(const u32x4 g, float (&f)[8]) { f[0] = bf_lo(g.x); f[1] = bf_hi(g.x); f[2] = bf_lo(g.y); f[3] = bf_hi(g.y); f[4] = bf_lo(g.z); f[5] = bf_hi(g.z); f[6] = bf_lo(g.w); f[7] = bf_hi(g.w); }
struct EpiGateA {
    static constexpr bool PERM = true, AFTER_DRAIN = false;
    bf16_t* M1; const bf16_t* proj;
    __device__ __forceinline__ void operator()(const f32x4 (&acc)[2][2][4][2], const Unit& u, int wr, int wc, int fr, int fq) const {
        const int row0 = u.pm * BM + wr * 64 + fr, col0 = u.pn * BM + wc * 32 + 8 * fq;
#pragma unroll
        for (int ai = 0; ai < 2; ++ai)
#pragma unroll
            for (int m = 0; m < 4; ++m) { const size_t row = (size_t)(row0 + ai * HALF + m * 16);
#pragma unroll
                for (int bj = 0; bj < 2; ++bj) { const int col = col0 + bj * HALF; float g[8]; unpack8(*(const u32x4*)(proj + row * INCP + OFF_GA + col), g);
                    const f32x4 v0 = acc[ai][bj][m][0], v1 = acc[ai][bj][m][1];
                    u32x4 w; w.x = pk2(v0[0] * g[0], v0[1] * g[1]); w.y = pk2(v0[2] * g[2], v0[3] * g[3]); w.z = pk2(v1[0] * g[4], v1[1] * g[5]); w.w = pk2(v1[2] * g[6], v1[3] * g[7]);
                    *(u32x4*)(M1 + row * DM + col) = w; } }
    }
};
struct EpiGateB {
    static constexpr bool PERM = true, AFTER_DRAIN = false;
    const bf16_t* M1; const bf16_t* proj; bf16_t* O;
    __device__ __forceinline__ void operator()(const f32x4 (&acc)[2][2][4][2], const Unit& u, int wr, int wc, int fr, int fq) const {
        const int row0 = u.pm * BM + wr * 64 + fr, col0 = u.pn * BM + wc * 32 + 8 * fq;
#pragma unroll
        for (int ai = 0; ai < 2; ++ai)
#pragma unroll
            for (int m = 0; m < 4; ++m) { const size_t row = (size_t)(row0 + ai * HALF + m * 16);
#pragma unroll
                for (int bj = 0; bj < 2; ++bj) { const int col = col0 + bj * HALF; float g[8], b[8]; unpack8(*(const u32x4*)(proj + row * INCP + OFF_GB + col), g); unpack8(*(const u32x4*)(M1 + row * DM + col), b);
                    const f32x4 v0 = acc[ai][bj][m][0], v1 = acc[ai][bj][m][1];
                    u32x4 w; w.x = pk2(b[0] + v0[0] * g[0], b[1] + v0[1] * g[1]); w.y = pk2(b[2] + v0[2] * g[2], b[3] + v0[3] * g[3]);
                    w.z = pk2(b[4] + v1[0] * g[4], b[5] + v1[1] * g[5]); w.w = pk2(b[6] + v1[2] * g[6], b[7] + v1[3] * g[7]);
                    *(u32x4*)(O + row * DM + col) = w; } }
    }
};
struct EpiResid {
    static constexpr bool PERM = false, AFTER_DRAIN = false;
    const float* X; float* O;
    __device__ __forceinline__ void operator()(const f32x4 (&acc)[2][2][4][2], const Unit& u, int wr, int wc, int fr, int fq) const {
        const int row0 = u.pm * BM + wr * 64 + fr, col0 = u.pn * BM + wc * 32 + 4 * fq;
#pragma unroll
        for (int ai = 0; ai < 2; ++ai)
#pragma unroll
            for (int m = 0; m < 4; ++m) { const size_t off = (size_t)(row0 + ai * HALF + m * 16) * DM + col0;
#pragma unroll
                for (int bj = 0; bj < 2; ++bj)
#pragma unroll
                    for (int n = 0; n < 2; ++n) { const f32x4 b = *(const f32x4*)(X + off + bj * HALF + n * 16); *(f32x4*)(O + off + bj * HALF + n * 16) = b + acc[ai][bj][m][n]; } }
    }
};
struct EpiSwiglu {
    static constexpr bool PERM = true, AFTER_DRAIN = false;
    unsigned char* ACT; const float* b1; const float* row_rstd;
    __device__ __forceinline__ void operator()(const f32x4 (&acc)[2][2][4][2], const Unit& u, int wr, int wc, int fr, int fq) const {
        const int row0 = u.pm * BM + wr * 64 + fr, f0 = u.pn * HALF + wc * 32 + 8 * fq; const float* be = b1 + (size_t)u.e * 2048;
        const f32x4 bg0 = *(const f32x4*)(be + f0), bg1 = *(const f32x4*)(be + f0 + 4), bu0 = *(const f32x4*)(be + DFF + f0), bu1 = *(const f32x4*)(be + DFF + f0 + 4);
        float rsv[8];
#pragma unroll
        for (int i = 0; i < 8; ++i) rsv[i] = row_rstd[u.rb + wr * 64 + fr + (i >> 2) * HALF + (i & 3) * 16] * W8_INV;
#pragma unroll
        for (int ai = 0; ai < 2; ++ai)
#pragma unroll
            for (int m = 0; m < 4; ++m) { const size_t row = (size_t)(row0 + ai * HALF + m * 16); float o[8]; const float rs = rsv[ai * 4 + m];
#pragma unroll
                for (int n = 0; n < 2; ++n) { const f32x4 g4 = acc[ai][0][m][n] * rs + (n ? bg1 : bg0), u4 = acc[ai][1][m][n] * rs + (n ? bu1 : bu0);
#pragma unroll
                    for (int j = 0; j < 4; ++j) { const float g = fminf(g4[j], 7.f), uu = fminf(fmaxf(u4[j], -7.f), 7.f); o[4 * n + j] = (uu + 1.f) * (g * sigmoidf_(1.702f * g)); } }
                u32x2 w; w.x = pk4_fp8(o[0], o[1], o[2], o[3]); w.y = pk4_fp8(o[4], o[5], o[6], o[7]); *(u32x2*)(ACT + row * DFF + f0) = w; }
    }
};
struct EpiMoeOut {
    static constexpr bool PERM = true, AFTER_DRAIN = false;
    unsigned char* YS; const float* b2; const float* row_w; const int* row_slot;
    __device__ __forceinline__ void operator()(const f32x4 (&acc)[2][2][4][2], const Unit& u, int wr, int wc, int fr, int fq) const {
        const int col0 = u.pn * BM + wc * 32 + 8 * fq; const float* be = b2 + (size_t)u.e * DM; const int rbase = u.rb + wr * 64 + fr;
        int slot[8]; float w[8];
#pragma unroll
        for (int i = 0; i < 8; ++i) { const int row = rbase + (i >> 2) * HALF + (i & 3) * 16; slot[i] = row_slot[row]; w[i] = row_w[row] * (W8_INV * YS_SCALE); }
        f32x4 bv[2][2];
#pragma unroll
        for (int bj = 0; bj < 2; ++bj)
#pragma unroll
            for (int n = 0; n < 2; ++n) bv[bj][n] = *(const f32x4*)(be + col0 + bj * HALF + 4 * n) * W8_SCALE;
#pragma unroll
        for (int ai = 0; ai < 2; ++ai)
#pragma unroll
            for (int m = 0; m < 4; ++m) { const int i = ai * 4 + m;
                if (slot[i] >= 0) { unsigned char* rowp = YS + (size_t)slot[i] * DM + col0;
#pragma unroll
                    for (int bj = 0; bj < 2; ++bj) { const f32x4 v0 = (acc[ai][bj][m][0] + bv[bj][0]) * w[i], v1 = (acc[ai][bj][m][1] + bv[bj][1]) * w[i];
                        u32x2 o; o.x = pk4_fp8(v0[0], v0[1], v0[2], v0[3]); o.y = pk4_fp8(v1[0], v1[1], v1[2], v1[3]); *(u32x2*)(rowp + bj * HALF) = o; } } }
    }
};
constexpr int MOE_MAXU = 12;
struct MoeOrder {
    StaticOrder so; const PG8_LAS int* utab; const PG8_LAS int* gtab;
    __device__ __forceinline__ bool next(int i, Unit& u) const { if (i >= MOE_MAXU || !so.next(i, u)) return false; const int v = __builtin_amdgcn_readfirstlane(utab[i]); u.e = v & 31; u.rb = (int)((unsigned)v >> 8); return true; }
    __device__ __forceinline__ void a_ready(const Unit&) const {}
    __device__ __forceinline__ void done(const Unit&) const {}
};
typedef int i32x4_t __attribute__((ext_vector_type(4))); typedef int i32x8_t __attribute__((ext_vector_type(8)));
__device__ __forceinline__ i32x8_t cat8(bf16x8 lo, bf16x8 hi) { return __builtin_shufflevector(__builtin_bit_cast(i32x4_t, lo), __builtin_bit_cast(i32x4_t, hi), 0, 1, 2, 3, 4, 5, 6, 7); }
__device__ __forceinline__ void mfma_fp8_inplace(f32x4& c, const i32x8_t a, const i32x8_t b) { asm volatile("s_nop 1\n\tv_mfma_f32_16x16x128_f8f6f4 %0, %1, %2, %0" : "+v"(c) : "v"(a), "v"(b)); }
__device__ __forceinline__ void mfma_fp8_drain() { asm volatile("s_nop 15\n\ts_nop 7" ::: "memory"); __builtin_amdgcn_sched_barrier(0); }
template <class Epi, class Sched, bool ALIGN_EPI = false, bool SP2 = false, bool FP8 = false, bool GATHER = false>
__device__ __forceinline__ void gemm_phase(PG8_LAS unsigned char* lds, const Gemm g, const Sched& S, const Epi& E) {
    const int tid = threadIdx.x, wid = __builtin_amdgcn_readfirstlane(tid >> 6), lane = tid & 63, wr = wid >> 2, wc = wid & 3, fr = lane & 15, fq = lane >> 4;
    const int K = g.K, nt = K / BK;
    static_assert(!GATHER || SP2, "GATHER is implemented for the SP2 loop only");
    const unsigned rowA = (unsigned)(g.lda ? g.lda : K) * 2u;
    unsigned voffA[2], voffB[2]; int gR0 = 0; unsigned gC = 0u;
#pragma unroll
    for (int i = 0; i < 2; ++i) { int R, C; stage_rc(tid * 16 + i * 8192, R, C); const int Rb = Epi::PERM ? ((R & ~31) + perm32(R & 31)) : R;
        voffA[i] = (unsigned)R * rowA + (unsigned)C * 2u; voffB[i] = (unsigned)(Rb * K + C) * 2u; if (i == 0) { gR0 = R; gC = (unsigned)C * 2u; } }
    unsigned gA[2][2] = {{0u, 0u}, {0u, 0u}}, ngA[2][2] = {{0u, 0u}, {0u, 0u}};
#define PG8_GLOAD(dst, ui_) do { _Pragma("unroll") for (int h_ = 0; h_ < 2; ++h_) _Pragma("unroll") for (int i_ = 0; i_ < 2; ++i_) \
        dst[h_][i_] = (unsigned)S.gtab[(ui_) * 256 + 128 * h_ + gR0 + 64 * i_] * rowA + gC; } while (0)
#define PG8_VA(h) (GATHER ? gA[h] : voffA)
    const unsigned kstep = (unsigned)(BK * 2);
    const unsigned hstep = (unsigned)HALF * (unsigned)K * 2u;
    const unsigned tstep = 2u * hstep;
    const unsigned hstepA = (unsigned)HALF * rowA, tstepA = 2u * hstepA;
    const unsigned hsA = GATHER ? 0u : hstepA;
    const unsigned ldsw = (unsigned)wid * 1024u;
    const int aoff = lds_byte(wr * 64 + fr, fq * 8), boff = lds_byte(wc * 32 + fr, fq * 8);
#define PG8_SA(b, h) (((b) * 2 + (h)) * HTB)
#define PG8_SB(b, h) ((4 + (b) * 2 + (h)) * HTB)
#define PG8_STAGE(rs, bufoff, goff, voff) do { _Pragma("unroll") for (int _i = 0; _i < 2; ++_i) \
        __builtin_amdgcn_raw_ptr_buffer_load_lds(rs, (PG8_LAS void*)(lds + (bufoff) + ldsw + _i * 8192), 16, (int)(voff)[_i], (int)(goff), 0, 0); } while (0)
#define PG8_LDA(dst, b, h) do { _Pragma("unroll") for (int m = 0; m < 4; ++m) _Pragma("unroll") for (int k = 0; k < 2; ++k) dst[m][k] = *(const PG8_LAS bf16x8*)(lds + PG8_SA(b, h) + aoff + m * 2048 + k * 1024); } while (0)
#define PG8_LDB(dst, b, h) do { _Pragma("unroll") for (int n = 0; n < 2; ++n) _Pragma("unroll") for (int k = 0; k < 2; ++k) dst[n][k] = *(const PG8_LAS bf16x8*)(lds + PG8_SB(b, h) + boff + n * 2048 + k * 1024); } while (0)
#define PG8_MMA(ai, bj, At, Bt) do { __builtin_amdgcn_s_setprio(1); _Pragma("unroll") for (int m = 0; m < 4; ++m) _Pragma("unroll") for (int n = 0; n < 2; ++n) { \
        if constexpr (FP8) { mfma_fp8_inplace(acc[ai][bj][m][n], cat8(Bt[n][0], Bt[n][1]), cat8(At[m][0], At[m][1])); } \
        else { _Pragma("unroll") for (int k = 0; k < 2; ++k) acc[ai][bj][m][n] = __builtin_amdgcn_mfma_f32_16x16x32_bf16(Bt[n][k], At[m][k], acc[ai][bj][m][n], 0, 0, 0); } } \
        __builtin_amdgcn_s_setprio(0); } while (0)
#define PG8_WAIT_V(n) asm volatile("s_waitcnt vmcnt(" #n ")" ::: "memory")
#define PG8_WAIT_L(n) asm volatile("s_waitcnt lgkmcnt(" #n ")" ::: "memory")
#define PG8_BAR __builtin_amdgcn_s_barrier()
#define PG8_SCHED __builtin_amdgcn_sched_barrier(0)
    Unit cur, nxt; int ui = 0;
    if (!S.next(0, cur)) return;
    f32x4 acc[2][2][4][2];
#pragma unroll
    for (int a = 0; a < 2; ++a)
#pragma unroll
        for (int b = 0; b < 2; ++b)
#pragma unroll
            for (int m = 0; m < 4; ++m)
#pragma unroll
                for (int n = 0; n < 2; ++n) acc[a][b][m][n] = (f32x4){0.f, 0.f, 0.f, 0.f};
    bf16x8 At[4][2], B0[2][2], B1[2][2];
    unsigned cA = GATHER ? 0u : (unsigned)cur.pm * tstepA, cB = (unsigned)cur.e * (unsigned)g.bstride + (unsigned)cur.pn * tstep;
    const __amdgpu_buffer_rsrc_t rsA = __builtin_amdgcn_make_buffer_rsrc((void*)g.A, 0, 0x7fffffff, 0x00020000), rsB = __builtin_amdgcn_make_buffer_rsrc((void*)g.Bt, 0, 0x7fffffff, 0x00020000);
    S.a_ready(cur);
    if constexpr (GATHER) PG8_GLOAD(gA, 0);
    if constexpr (SP2) {
        PG8_STAGE(rsB, PG8_SB(0, 0), cB, voffB); PG8_STAGE(rsB, PG8_SB(0, 1), cB + hstep, voffB); PG8_STAGE(rsA, PG8_SA(0, 0), cA, PG8_VA(0)); PG8_STAGE(rsA, PG8_SA(0, 1), cA + hsA, PG8_VA(1));
        if (wr == 1) PG8_BAR;
        PG8_WAIT_V(2); PG8_BAR;
        PG8_STAGE(rsB, PG8_SB(1, 0), cB + kstep, voffB); PG8_STAGE(rsA, PG8_SA(1, 0), cA + kstep, PG8_VA(0)); PG8_STAGE(rsB, PG8_SB(1, 1), cB + hstep + kstep, voffB);
        PG8_WAIT_V(6); PG8_BAR;
    } else {
        PG8_STAGE(rsB, PG8_SB(0, 0), cB, voffB); PG8_STAGE(rsA, PG8_SA(0, 0), cA, PG8_VA(0)); PG8_STAGE(rsB, PG8_SB(0, 1), cB + hstep, voffB); PG8_STAGE(rsA, PG8_SA(0, 1), cA + hsA, PG8_VA(1));
        if (wr == 1) PG8_BAR;
        PG8_WAIT_V(4); PG8_BAR;
        PG8_STAGE(rsB, PG8_SB(1, 0), cB + kstep, voffB); PG8_STAGE(rsA, PG8_SA(1, 0), cA + kstep, PG8_VA(0)); PG8_STAGE(rsB, PG8_SB(1, 1), cB + hstep + kstep, voffB);
        PG8_WAIT_V(6); PG8_BAR;
    }
    for (;;) {
        const bool has_next = S.next(ui + 1, nxt);
        if constexpr (GATHER) { if (has_next) PG8_GLOAD(ngA, ui + 1); else { ngA[0][0] = gA[0][0]; ngA[0][1] = gA[0][1]; ngA[1][0] = gA[1][0]; ngA[1][1] = gA[1][1]; } }
        const unsigned nA = (has_next && !GATHER) ? (unsigned)nxt.pm * tstepA : cA, nB = has_next ? (unsigned)nxt.e * (unsigned)g.bstride + (unsigned)nxt.pn * tstep : cB;
        for (int t = 0; t < nt; t += 2) {
            const bool last = (t == nt - 2);
            const unsigned a1 = cA + (unsigned)(t + 1) * kstep;
            const unsigned a2 = last ? nA : cA + (unsigned)(t + 2) * kstep, b2 = last ? nB : cB + (unsigned)(t + 2) * kstep;
            const unsigned a3 = a2 + kstep, b3 = b2 + kstep;
            if (last && has_next) S.a_ready(nxt);
            if constexpr (SP2) {
            PG8_LDB(B0, 0, 0); PG8_LDB(B1, 0, 1); PG8_SCHED; PG8_LDA(At, 0, 0); PG8_STAGE(rsA, PG8_SA(1, 1), a1 + hsA, PG8_VA(1));
            if constexpr (GATHER) { if (last) { gA[0][0] = ngA[0][0]; gA[0][1] = ngA[0][1]; gA[1][0] = ngA[1][0]; gA[1][1] = ngA[1][1]; } }
            PG8_WAIT_V(8); PG8_WAIT_L(0); PG8_BAR; PG8_MMA(0, 0, At, B0); PG8_MMA(0, 1, At, B1); PG8_BAR; PG8_SCHED;
            PG8_LDA(At, 0, 1); PG8_STAGE(rsB, PG8_SB(0, 0), b2, voffB); PG8_STAGE(rsB, PG8_SB(0, 1), b2 + hstep, voffB); PG8_STAGE(rsA, PG8_SA(0, 0), a2, PG8_VA(0));
            PG8_WAIT_V(8); PG8_WAIT_L(0); PG8_BAR; PG8_MMA(1, 0, At, B0); PG8_MMA(1, 1, At, B1); PG8_BAR; PG8_SCHED;
            PG8_LDB(B0, 1, 0); PG8_LDB(B1, 1, 1); PG8_SCHED; PG8_LDA(At, 1, 0); PG8_STAGE(rsA, PG8_SA(0, 1), a2 + hsA, PG8_VA(1));
            PG8_WAIT_V(8); PG8_WAIT_L(0); PG8_BAR; PG8_MMA(0, 0, At, B0); PG8_MMA(0, 1, At, B1); PG8_BAR; PG8_SCHED;
            PG8_LDA(At, 1, 1); PG8_STAGE(rsB, PG8_SB(1, 0), b3, voffB); PG8_STAGE(rsB, PG8_SB(1, 1), b3 + hstep, voffB); PG8_STAGE(rsA, PG8_SA(1, 0), a3, PG8_VA(0));
            PG8_WAIT_V(8); PG8_WAIT_L(0); PG8_BAR; PG8_MMA(1, 0, At, B0); PG8_MMA(1, 1, At, B1); PG8_BAR; PG8_SCHED;
            } else {
            PG8_LDB(B0, 0, 0); PG8_SCHED; PG8_LDA(At, 0, 0); PG8_STAGE(rsA, PG8_SA(1, 1), a1 + hsA, PG8_VA(1));
            PG8_WAIT_L(8); PG8_BAR; PG8_WAIT_L(0); PG8_MMA(0, 0, At, B0); PG8_BAR; PG8_SCHED;
            PG8_LDB(B1, 0, 1); PG8_STAGE(rsB, PG8_SB(0, 0), b2, voffB);
            PG8_BAR; PG8_WAIT_L(0); PG8_MMA(0, 1, At, B1); PG8_BAR;
            PG8_LDA(At, 0, 1); PG8_STAGE(rsA, PG8_SA(0, 0), a2, PG8_VA(0));
            PG8_BAR; PG8_WAIT_L(0); PG8_MMA(1, 0, At, B0); PG8_BAR; PG8_SCHED;
            PG8_STAGE(rsB, PG8_SB(0, 1), b2 + hstep, voffB);
            PG8_WAIT_V(6); PG8_BAR; PG8_MMA(1, 1, At, B1); PG8_BAR;
            PG8_LDB(B0, 1, 0); PG8_SCHED; PG8_LDA(At, 1, 0); PG8_STAGE(rsA, PG8_SA(0, 1), a2 + hsA, PG8_VA(1));
            PG8_WAIT_L(8); PG8_BAR; PG8_WAIT_L(0); PG8_MMA(0, 0, At, B0); PG8_BAR; PG8_SCHED;
            PG8_LDB(B1, 1, 1); PG8_STAGE(rsB, PG8_SB(1, 0), b3, voffB);
            PG8_BAR; PG8_WAIT_L(0); PG8_MMA(0, 1, At, B1); PG8_BAR;
            PG8_LDA(At, 1, 1); PG8_STAGE(rsA, PG8_SA(1, 0), a3, PG8_VA(0));
            PG8_BAR; PG8_WAIT_L(0); PG8_MMA(1, 0, At, B0); PG8_BAR; PG8_SCHED;
            PG8_STAGE(rsB, PG8_SB(1, 1), b3 + hstep, voffB);
            PG8_WAIT_V(6); PG8_BAR; PG8_MMA(1, 1, At, B1); PG8_BAR;
            }
        }
        if constexpr (ALIGN_EPI) { if (wr == 0) PG8_BAR; }
        if constexpr (FP8) mfma_fp8_drain();
        if constexpr (!Epi::AFTER_DRAIN) { E(acc, cur, wr, wc, fr, fq); S.done(cur); }
        if (!has_next) break;
#pragma unroll
        for (int a = 0; a < 2; ++a)
#pragma unroll
            for (int b = 0; b < 2; ++b)
#pragma unroll
                for (int m = 0; m < 4; ++m)
#pragma unroll
                    for (int n = 0; n < 2; ++n) acc[a][b][m][n] = (f32x4){0.f, 0.f, 0.f, 0.f};
        cur = nxt; cA = nA; cB = nB; ++ui;
        if constexpr (ALIGN_EPI) { if (wr == 1) PG8_BAR; }
    }
    PG8_WAIT_V(0);
    if constexpr (!ALIGN_EPI) { if (wr == 0) PG8_BAR; }
    PG8_BAR;
    if constexpr (Epi::AFTER_DRAIN) { E.fused(acc, cur, wr, wc, fr, fq, lds, wid, lane); S.done(cur); }
#undef PG8_SA
#undef PG8_GLOAD
#undef PG8_VA
#undef PG8_SB
#undef PG8_STAGE
#undef PG8_LDA
#undef PG8_LDB
#undef PG8_MMA
#undef PG8_WAIT_V
#undef PG8_WAIT_L
#undef PG8_BAR
#undef PG8_SCHED
}
}

#define GAS __attribute__((address_space(1)))
#define LAS __attribute__((address_space(3)))
#define XB_TMO      128
#define XB_XCNT(j)  (256  + 64 * (j))
#define XB_XSUB(j)  (1280 + 64 * (j))
#define XB_XGEN(j)  (2304 + 64 * (j))
#define XB_TOP      3328
#define XB_TOPGEN   3392
#define XCD_BAR_WORDS 3456
#define XB_SPIN_CAP (1u << 18)

__device__ __forceinline__ unsigned xb_ld(unsigned* p)              { return __hip_atomic_load(p, __ATOMIC_RELAXED, __HIP_MEMORY_SCOPE_AGENT); }
__device__ __forceinline__ unsigned xb_add(unsigned* p, unsigned v) { return __hip_atomic_fetch_add(p, v, __ATOMIC_RELAXED, __HIP_MEMORY_SCOPE_AGENT); }
__device__ __forceinline__ unsigned xb_xcc_id() { return (unsigned)__builtin_amdgcn_s_getreg((3 << 11) | 20) & 0xFu; }
#define XB_SPIN(cond, bar) do { unsigned _sp = 0; while (cond) { __builtin_amdgcn_s_sleep(1); \
    if ((++_sp & 255u) == 0u) { if (xb_ld(&(bar)[XB_TMO])) break; if (_sp > XB_SPIN_CAP) { atomicAdd(&(bar)[XB_TMO], 1u); break; } } } } while (0)

struct XcdBarrier {
    unsigned* bar; unsigned x;
    volatile LAS unsigned* st;
};

__device__ __forceinline__ XcdBarrier xcd_barrier_post(unsigned* bar, volatile LAS unsigned* st) {
    XcdBarrier b; b.bar = bar; b.x = xb_xcc_id(); b.st = st;
    if (threadIdx.x == 0) (void)xb_add(&bar[XB_XCNT(b.x)], 1u);
    return b;
}
__device__ __forceinline__ void xcd_barrier_complete(unsigned* bar, unsigned x, unsigned& nloc, unsigned& nx) {
    const unsigned G = gridDim.x * gridDim.y * gridDim.z;
    unsigned sum, cnt, mine, sp = 0u;
    for (;;) {
        sum = 0u; cnt = 0u; mine = 0u;
#pragma unroll
        for (unsigned j = 0; j < 16; ++j) { const unsigned c = xb_ld(&bar[XB_XCNT(j)]); sum += c; cnt += (c > 0u) ? 1u : 0u; mine = (j == x) ? c : mine; }
        if (sum == G) break;
        __builtin_amdgcn_s_sleep(1);
        if ((++sp & 255u) == 0u) { if (xb_ld(&bar[XB_TMO])) break; if (sp > XB_SPIN_CAP) { atomicAdd(&bar[XB_TMO], 1u); break; } }
    }
    nloc = mine > 0u ? mine : 1u; nx = cnt > 0u ? cnt : 1u;
}

__device__ __forceinline__ void xcd_barrier(const XcdBarrier& b) {
    asm volatile("s_waitcnt vmcnt(0)" ::: "memory");
    __syncthreads();
    if (threadIdx.x == 0) {
        unsigned* bar = b.bar;
        __builtin_amdgcn_s_waitcnt(0);
        unsigned nloc = b.st[0], nx = b.st[1];
        if (nloc == 0u) { xcd_barrier_complete(bar, b.x, nloc, nx); b.st[0] = nloc; b.st[1] = nx; }
        const unsigned old = xb_add(&bar[XB_XSUB(b.x)], 1u);
        const unsigned gen = old / nloc;
        if (old + 1u == (gen + 1u) * nloc) {
            __builtin_amdgcn_fence(__ATOMIC_RELEASE, "agent");
            asm volatile("s_waitcnt vmcnt(0)" ::: "memory");
            const unsigned og = xb_add(&bar[XB_TOP], 1u);
            const unsigned tg = og / nx;
            if (og + 1u == (tg + 1u) * nx) xb_add(&bar[XB_TOPGEN], 1u);
            else XB_SPIN(xb_ld(&bar[XB_TOPGEN]) == tg, bar);
            __builtin_amdgcn_fence(__ATOMIC_ACQUIRE, "agent");
            xb_add(&bar[XB_XGEN(b.x)], 1u);
            asm volatile("s_waitcnt vmcnt(0)" ::: "memory");
        } else {
            XB_SPIN(xb_ld(&bar[XB_XGEN(b.x)]) == gen, bar);
            __builtin_amdgcn_fence(__ATOMIC_ACQUIRE, "agent");
            asm volatile("s_waitcnt vmcnt(0)" ::: "memory");
        }
    }
    __syncthreads();
}

template <int MODE  >
__device__ __forceinline__ void transpose_item(const float* __restrict__ W, int K, int N, bf16_t* __restrict__ WT, const float* __restrict__ gain, float* scr, int item, int lane) {
    const int nblk = N / 32, kb = item / nblk, nb = item % nblk, k0 = 64 * kb, n0 = 32 * nb;
#pragma unroll
    for (int i = 0; i < 8; ++i) { const int kk = 8 * i + (lane >> 3), n4 = (lane & 7) * 4; f32x4 v = *(const f32x4*)(W + (size_t)(k0 + kk) * N + n0 + n4);
        if (gain) { const float g = gain[k0 + kk]; v = v * g; }
        float* s = scr + kk * 33 + n4; s[0] = v[0]; s[1] = v[1]; s[2] = v[2]; s[3] = v[3]; }
    asm volatile("s_waitcnt lgkmcnt(0)" ::: "memory");
    const int c = lane & 7;
#pragma unroll
    for (int j = 0; j < 4; ++j) { const int n = (lane >> 3) + 8 * j; const float* s = scr + (8 * c) * 33 + n;
        u32x4 o; o.x = pk2(s[0 * 33], s[1 * 33]); o.y = pk2(s[2 * 33], s[3 * 33]); o.z = pk2(s[4 * 33], s[5 * 33]); o.w = pk2(s[6 * 33], s[7 * 33]);
        int row = n0 + n;
        if (MODE == 1) { const int f = row & 1023; row = ((f >> 7) << 8) + ((row >> 10) << 7) + (f & 127); }
        *(u32x4*)(WT + (size_t)row * K + k0 + 8 * c) = o; }
    asm volatile("s_waitcnt lgkmcnt(0)" ::: "memory");
}
template <int MODE>
__device__ __forceinline__ void transpose_item_fp8(const float* __restrict__ W, int K, int N, unsigned char* __restrict__ WT, float* scr, int item, int lane) {
    const int nblk = N / 32, kb = item / nblk, nb = item % nblk, k0 = 64 * kb, n0 = 32 * nb;
#pragma unroll
    for (int i = 0; i < 8; ++i) { const int kk = 8 * i + (lane >> 3), n4 = (lane & 7) * 4; const f32x4 v = *(const f32x4*)(W + (size_t)(k0 + kk) * N + n0 + n4) * W8_SCALE;
        float* s = scr + kk * 33 + n4; s[0] = v[0]; s[1] = v[1]; s[2] = v[2]; s[3] = v[3]; }
    asm volatile("s_waitcnt lgkmcnt(0)" ::: "memory");
    const int c = lane & 7;
#pragma unroll
    for (int j = 0; j < 4; ++j) { const int n = (lane >> 3) + 8 * j; const float* s = scr + (8 * c) * 33 + n;
        u32x2 o; o.x = pk4_fp8(s[0 * 33], s[1 * 33], s[2 * 33], s[3 * 33]); o.y = pk4_fp8(s[4 * 33], s[5 * 33], s[6 * 33], s[7 * 33]);
        int row = n0 + n;
        if (MODE == 1) { const int f = row & 1023; row = ((f >> 7) << 8) + ((row >> 10) << 7) + (f & 127); }
        *(u32x2*)(WT + (size_t)row * K + k0 + 8 * c) = o; }
    asm volatile("s_waitcnt lgkmcnt(0)" ::: "memory");
}
__device__ __forceinline__ void phase_prologue(const Params& p, unsigned char* lds) {
    const int tid = threadIdx.x, lane = tid & 63, wave = tid >> 6;
    float* scr = (float*)(lds + wave * 16384);
    const int gw = blockIdx.x * NWAVES + wave, NGW = gridDim.x * NWAVES;
    unsigned char* ws = p.ws;
    constexpr int I_WIN = (DM / 64) * (INC / 32), I_UQ = (QLORA / 64) * (768 / 32), I_UKV = (KVLORA / 64) * (1024 / 32), I_OM = (512 / 64) * (DM / 32), I_OC = I_OM, I_WO = (DM / 64) * (DM / 32);
    constexpr int I_W1 = (DM / 64) * (2048 / 32), I_W2 = (DFF / 64) * (DM / 32);
    constexpr int NSMALL = I_WIN + I_UQ + I_UKV + I_OM + I_OC + I_WO;
    constexpr int NITEMS = NSMALL;
    for (int it = gw; it < NITEMS; it += NGW) {
        int r = it;
        if (r < I_WIN) { transpose_item<0>(p.w_in, DM, INC, (bf16_t*)(ws + WS_WIN), p.norm1_g, scr, r, lane); continue; } r -= I_WIN;
        if (r < I_UQ) { transpose_item<0>(p.w_uq, QLORA, 768, (bf16_t*)(ws + WS_WUQ), p.q_a_g, scr, r, lane); continue; } r -= I_UQ;
        if (r < I_UKV) { transpose_item<0>(p.w_ukv, KVLORA, 1024, (bf16_t*)(ws + WS_WUKV), p.kv_a_g, scr, r, lane); continue; } r -= I_UKV;
        if (r < I_OM) { transpose_item<0>(p.w_o_mla, 512, DM, (bf16_t*)(ws + WS_WOMLA), nullptr, scr, r, lane); continue; } r -= I_OM;
        if (r < I_OC) { transpose_item<0>(p.w_o_conv, 512, DM, (bf16_t*)(ws + WS_WOCONV), nullptr, scr, r, lane); continue; } r -= I_OC;
        transpose_item<0>(p.w_o, DM, DM, (bf16_t*)(ws + WS_WO), nullptr, scr, r, lane);
    }
    { u32x4* z = (u32x4*)((bf16_t*)(ws + WS_WIN) + (size_t)INC * DM); const int nz = (INCP - INC) * DM * 2 / 16;
      for (int i = blockIdx.x * NTHREADS + tid; i < nz; i += gridDim.x * NTHREADS) z[i] = (u32x4){0u, 0u, 0u, 0u}; }
    { int* rt = (int*)(ws + WS_RT2); int* rs = (int*)(ws + WS_RT2 + 4 * MiB); float* rr = (float*)(ws + WS_RT2 + 6 * MiB);
      for (int i = blockIdx.x * NTHREADS + tid; i < NE * CAP; i += gridDim.x * NTHREADS) { rt[i] = 0; rs[i] = -1; rr[i] = 0.f; } }
    { u32x4* GF = (u32x4*)(ws + WS_GF);
      for (int i = blockIdx.x * NTHREADS + tid; i < 64 * 64; i += gridDim.x * NTHREADS) { const int ks = i >> 6, ln = i & 63, r = ln & 31, h = ln >> 5; float v[8], lo[8]; unsigned hi[4];
#pragma unroll
          for (int j = 0; j < 8; ++j) { const int k = 16 * ks + 8 * h + j; v[j] = p.norm2_g[k] * p.router_w[(size_t)k * NE + r]; }
#pragma unroll
          for (int j = 0; j < 4; ++j) { hi[j] = pk2(v[2 * j], v[2 * j + 1]); lo[2 * j] = v[2 * j] - bf_lo(hi[j]); lo[2 * j + 1] = v[2 * j + 1] - bf_hi(hi[j]); }
          GF[(ks * 2 + 0) * 64 + ln] = (u32x4){hi[0], hi[1], hi[2], hi[3]}; GF[(ks * 2 + 1) * 64 + ln] = (u32x4){pk2(lo[0], lo[1]), pk2(lo[2], lo[3]), pk2(lo[4], lo[5]), pk2(lo[6], lo[7])}; } }
    bf16_t* XN = (bf16_t*)(ws + WS_XN);
    for (int m = gw; m < NTOK; m += NGW) {
        const f32x4* xr = (const f32x4*)(p.x + (size_t)m * DM) + lane; f32x4 v[4]; float s = 0.f;
#pragma unroll
        for (int j = 0; j < 4; ++j) { v[j] = xr[64 * j]; s += (v[j][0] * v[j][0] + v[j][1] * v[j][1]) + (v[j][2] * v[j][2] + v[j][3] * v[j][3]); }
        const float rstd = rsqrtf(wave_sum(s) * (1.f / DM) + EPS);
        u32x2* o = (u32x2*)(XN + (size_t)m * DM) + lane;
#pragma unroll
        for (int j = 0; j < 4; ++j) { u32x2 w; w.x = pk2(v[j][0] * rstd, v[j][1] * rstd); w.y = pk2(v[j][2] * rstd, v[j][3] * rstd); o[64 * j] = w; }
    }
}

constexpr float QSCALE = 0.10206207261596575f * 1.4426950408889634f;
struct TokRaw { u32x2 cq; unsigned ckv; u32x4 u[3], c[3], bg, qa, ka, va; unsigned q1, q2, k1, k2; float pos, m0, m2; };
__device__ __forceinline__ void tokb_load(TokRaw& r, const Params& p, int t, int lane, int h, int sub) {
    const bf16_t* PROJ = (const bf16_t*)(p.ws + WS_PROJ); const bf16_t* pr = PROJ + (size_t)t * INCP; const int s = t & (SEQ - 1);
    r.pos = (float)p.pos[t];
    r.cq = *(const u32x2*)(pr + OFF_CQ + 4 * lane); r.ckv = *(const unsigned*)(pr + OFF_CKV + 2 * lane);
    r.m0 = s > 0 ? 1.f : 0.f; r.m2 = s < SEQ - 1 ? 1.f : 0.f;
    const bf16_t* pm = s > 0 ? pr - INCP : pr; const bf16_t* pp = s < SEQ - 1 ? pr + INCP : pr;
    r.u[0] = *(const u32x4*)(pm + OFF_U + 8 * lane); r.c[0] = *(const u32x4*)(pm + OFF_C + 8 * lane);
    r.u[1] = *(const u32x4*)(pr + OFF_U + 8 * lane); r.c[1] = *(const u32x4*)(pr + OFF_C + 8 * lane);
    r.u[2] = *(const u32x4*)(pp + OFF_U + 8 * lane); r.c[2] = *(const u32x4*)(pp + OFF_C + 8 * lane);
    r.bg = *(const u32x4*)(pr + OFF_B + 8 * lane);
    const bf16_t* qp = (const bf16_t*)(p.ws + WS_QPRE) + (size_t)t * 768 + h * DQK; r.qa = *(const u32x4*)(qp + sub * 8); r.q1 = *(const unsigned*)(qp + 64 + 2 * sub); r.q2 = *(const unsigned*)(qp + 80 + 2 * sub);
    const bf16_t* kp = (const bf16_t*)(p.ws + WS_KVPRE) + (size_t)t * 1024 + h * 128; r.ka = *(const u32x4*)(kp + sub * 8); r.va = *(const u32x4*)(kp + 64 + sub * 8);
    const bf16_t* kr = pr + OFF_KR; r.k1 = *(const unsigned*)(kr + 2 * sub); r.k2 = *(const unsigned*)(kr + 16 + 2 * sub);
}
__device__ __forceinline__ void mulpair8(const u32x4 u, const u32x4 c, float (&o)[8]) {
    o[0] = bf_lo(u.x) * bf_lo(c.x); o[1] = bf_hi(u.x) * bf_hi(c.x); o[2] = bf_lo(u.y) * bf_lo(c.y); o[3] = bf_hi(u.y) * bf_hi(c.y);
    o[4] = bf_lo(u.z) * bf_lo(c.z); o[5] = bf_hi(u.z) * bf_hi(c.z); o[6] = bf_lo(u.w) * bf_lo(c.w); o[7] = bf_hi(u.w) * bf_hi(c.w); }
__device__ __forceinline__ void tokb_compute(const TokRaw& r, const Params& p, int t, int lane, int h, int sub, const float (&qg)[12], const float (&kg)[12], float if0, float if1,
                                             const float (&cw0)[8], const float (&cw1)[8], const float (&cw2)[8]) {
    bf16_t* Q = (bf16_t*)(p.ws + WS_Q); bf16_t* Kb = (bf16_t*)(p.ws + WS_K); bf16_t* V = (bf16_t*)(p.ws + WS_V); bf16_t* YB = (bf16_t*)(p.ws + WS_YBIN);
    const int b = t >> 13, s = t & (SEQ - 1);
    float rs_q, rs_kv;
    { const float a = bf_lo(r.cq.x), bq = bf_hi(r.cq.x), c = bf_lo(r.cq.y), d = bf_hi(r.cq.y); rs_q = rsqrtf(wave_sum(a * a + bq * bq + c * c + d * d) * (1.f / QLORA) + EPS); }
    { const float a = bf_lo(r.ckv), bq = bf_hi(r.ckv); rs_kv = rsqrtf(wave_sum(a * a + bq * bq) * (1.f / KVLORA) + EPS); }
    { float cu0[8], cu1[8], cu2[8], bb[8]; mulpair8(r.u[0], r.c[0], cu0); mulpair8(r.u[1], r.c[1], cu1); mulpair8(r.u[2], r.c[2], cu2);
      bb[0] = bf_lo(r.bg.x); bb[1] = bf_hi(r.bg.x); bb[2] = bf_lo(r.bg.y); bb[3] = bf_hi(r.bg.y); bb[4] = bf_lo(r.bg.z); bb[5] = bf_hi(r.bg.z); bb[6] = bf_lo(r.bg.w); bb[7] = bf_hi(r.bg.w); float y[8];
#pragma unroll
      for (int j = 0; j < 8; ++j) y[j] = bb[j] * (cw0[j] * r.m0 * cu0[j] + cw1[j] * cu1[j] + cw2[j] * r.m2 * cu2[j]);
      u32x4 o; o.x = pk2(y[0], y[1]); o.y = pk2(y[2], y[3]); o.z = pk2(y[4], y[5]); o.w = pk2(y[6], y[7]); *(u32x4*)(YB + (size_t)t * CONVW + 8 * lane) = o; }
    float c0, s0, c1, s1; sincosf(r.pos * if0, &s0, &c0); sincosf(r.pos * if1, &s1, &c1);
    const size_t rowi = ((size_t)(b * NH + h) * SEQ + s);
    { float v[12] = {bf_lo(r.qa.x), bf_hi(r.qa.x), bf_lo(r.qa.y), bf_hi(r.qa.y), bf_lo(r.qa.z), bf_hi(r.qa.z), bf_lo(r.qa.w), bf_hi(r.qa.w), bf_lo(r.q1), bf_hi(r.q1), bf_lo(r.q2), bf_hi(r.q2)}; float ss = 0.f;
#pragma unroll
      for (int j = 0; j < 12; ++j) { v[j] *= rs_q; ss += v[j] * v[j]; }
      ss += __shfl_xor(ss, 1); ss += __shfl_xor(ss, 2); ss += __shfl_xor(ss, 4);
      const float rstd = rsqrtf(ss * (1.f / DQK) + EPS);
#pragma unroll
      for (int j = 0; j < 12; ++j) v[j] *= rstd * qg[j] * QSCALE;
      const float o8 = v[8] * c0 - v[10] * s0, o9 = v[9] * c1 - v[11] * s1, o10 = v[8] * s0 + v[10] * c0, o11 = v[9] * s1 + v[11] * c1;
      bf16_t* qo = Q + rowi * DQK; u32x4 w; w.x = pk2(v[0], v[1]); w.y = pk2(v[2], v[3]); w.z = pk2(v[4], v[5]); w.w = pk2(v[6], v[7]);
      *(u32x4*)(qo + sub * 8) = w; *(unsigned*)(qo + 64 + 2 * sub) = pk2(o8, o9); *(unsigned*)(qo + 80 + 2 * sub) = pk2(o10, o11); }
    { float v[12] = {bf_lo(r.ka.x) * rs_kv, bf_hi(r.ka.x) * rs_kv, bf_lo(r.ka.y) * rs_kv, bf_hi(r.ka.y) * rs_kv, bf_lo(r.ka.z) * rs_kv, bf_hi(r.ka.z) * rs_kv, bf_lo(r.ka.w) * rs_kv, bf_hi(r.ka.w) * rs_kv,
                   bf_lo(r.k1), bf_hi(r.k1), bf_lo(r.k2), bf_hi(r.k2)}; float ss = 0.f;
#pragma unroll
      for (int j = 0; j < 12; ++j) ss += v[j] * v[j];
      ss += __shfl_xor(ss, 1); ss += __shfl_xor(ss, 2); ss += __shfl_xor(ss, 4);
      const float rstd = rsqrtf(ss * (1.f / DQK) + EPS);
#pragma unroll
      for (int j = 0; j < 12; ++j) v[j] *= rstd * kg[j];
      const float o8 = v[8] * c0 - v[10] * s0, o9 = v[9] * c1 - v[11] * s1, o10 = v[8] * s0 + v[10] * c0, o11 = v[9] * s1 + v[11] * c1;
      bf16_t* ko = Kb + rowi * 128; u32x4 w; w.x = pk2(v[0], v[1]); w.y = pk2(v[2], v[3]); w.z = pk2(v[4], v[5]); w.w = pk2(v[6], v[7]);
      *(u32x4*)(ko + sub * 8) = w; *(unsigned*)(ko + 64 + 2 * sub) = pk2(o8, o9); *(unsigned*)(ko + 80 + 2 * sub) = pk2(o10, o11);
      if (sub < 4) *(u32x4*)(ko + 96 + sub * 8) = (u32x4){0u, 0u, 0u, 0u};
      u32x4 wv; wv.x = pk2(bf_lo(r.va.x) * rs_kv, bf_hi(r.va.x) * rs_kv); wv.y = pk2(bf_lo(r.va.y) * rs_kv, bf_hi(r.va.y) * rs_kv); wv.z = pk2(bf_lo(r.va.z) * rs_kv, bf_hi(r.va.z) * rs_kv); wv.w = pk2(bf_lo(r.va.w) * rs_kv, bf_hi(r.va.w) * rs_kv);
      *(u32x4*)(V + rowi * DV + sub * 8) = wv; }
}
__device__ __forceinline__ void phase_tok_b(const Params& p) {
    const int tid = threadIdx.x, lane = tid & 63, wave = tid >> 6, h = lane >> 3, sub = lane & 7;
    const int gw = blockIdx.x * NWAVES + wave, NGW = gridDim.x * NWAVES;
    float qg[12], kg[12];
#pragma unroll
    for (int j = 0; j < 8; ++j) { qg[j] = p.q_g[sub * 8 + j]; kg[j] = p.k_g[sub * 8 + j]; }
    qg[8] = p.q_g[64 + 2 * sub]; qg[9] = p.q_g[65 + 2 * sub]; qg[10] = p.q_g[80 + 2 * sub]; qg[11] = p.q_g[81 + 2 * sub];
    kg[8] = p.k_g[64 + 2 * sub]; kg[9] = p.k_g[65 + 2 * sub]; kg[10] = p.k_g[80 + 2 * sub]; kg[11] = p.k_g[81 + 2 * sub];
    const float if0 = exp2f(-(float)(2 * sub) * (13.287712379549449f / 16.f)), if1 = exp2f(-(float)(2 * sub + 1) * (13.287712379549449f / 16.f));
    float cw0[8], cw1[8], cw2[8];
#pragma unroll
    for (int j = 0; j < 8; ++j) { cw0[j] = p.conv_w[8 * lane + j]; cw1[j] = p.conv_w[CONVW + 8 * lane + j]; cw2[j] = p.conv_w[2 * CONVW + 8 * lane + j]; }
    for (int t = gw; t < NTOK; t += 2 * NGW) {
        const int t1 = t + NGW; const bool two = t1 < NTOK;
        TokRaw r0, r1; tokb_load(r0, p, t, lane, h, sub); tokb_load(r1, p, two ? t1 : t, lane, h, sub);
        tokb_compute(r0, p, t, lane, h, sub, qg, kg, if0, if1, cw0, cw1, cw2);
        if (two) tokb_compute(r1, p, t1, lane, h, sub, qg, kg, if0, if1, cw0, cw1, cw2);
    }
}

constexpr int WC_EXP_ITEMS = NE * 1536, WC_TILE_F = 32 * 68;
struct WcItem { const float* W; unsigned char* WT; int N, k0, n0, mode; };
__device__ __forceinline__ WcItem wc_decode(const Params& p, int x) {
    WcItem it; const int e = x / 1536, r = x - e * 1536;
    if (r < 1024) { it.W = p.w1 + (size_t)e * DM * 2048; it.WT = p.ws + WS_W1 + (size_t)e * 2048 * DM; it.N = 2048; it.k0 = 64 * (r >> 6); it.n0 = 32 * (r & 63); it.mode = 1; }
    else { const int q = r - 1024; it.W = p.w2 + (size_t)e * DFF * DM; it.WT = p.ws + WS_W2 + (size_t)e * DM * DFF; it.N = DM; it.k0 = 64 * (q >> 5); it.n0 = 32 * (q & 31); it.mode = 0; }
    return it;
}
struct WConv { float* tile; int x0, nitems, cs; f32x4 pend; };
__device__ __forceinline__ void wconv_step(WConv& c, const Params& p, int lane) {
    const int cs = c.cs, nst = 8 * c.nitems;
    if (cs > 0 && cs <= nst) {
        const int kk = 8 * ((cs - 1) & 7) + (lane >> 3), n4 = (lane & 7) * 4; float* t = c.tile + n4 * 68 + kk;
        t[0] = c.pend[0] * W8_SCALE; t[68] = c.pend[1] * W8_SCALE; t[136] = c.pend[2] * W8_SCALE; t[204] = c.pend[3] * W8_SCALE;
        if ((cs & 7) == 0) {
            const WcItem it = wc_decode(p, c.x0 + (cs >> 3) - 1); const int c8 = lane & 7;
#pragma unroll
            for (int j = 0; j < 4; ++j) { const int n = (lane >> 3) + 8 * j; const f32x4 a = *(const f32x4*)(c.tile + n * 68 + 8 * c8), b = *(const f32x4*)(c.tile + n * 68 + 8 * c8 + 4);
                u32x2 o; o.x = pk4_fp8(a[0], a[1], a[2], a[3]); o.y = pk4_fp8(b[0], b[1], b[2], b[3]);
                int row = it.n0 + n; if (it.mode == 1) { const int f = row & 1023; row = ((f >> 7) << 8) + ((row >> 10) << 7) + (f & 127); }
                *(u32x2*)(it.WT + (size_t)row * DM + it.k0 + 8 * c8) = o; }
        }
    }
    if (cs < nst) {
        const WcItem it = wc_decode(p, c.x0 + (cs >> 3)); const int kk = 8 * (cs & 7) + (lane >> 3), n4 = (lane & 7) * 4;
        c.pend = *(const f32x4*)(it.W + (size_t)(it.k0 + kk) * it.N + it.n0 + n4);
    }
    c.cs = cs + 1;
}

namespace att {
constexpr int NW = 8, QBLK = 32, KVBLK = 64;
constexpr float SCALE = 0.10206207261596575f;
constexpr float QSC = SCALE * 1.4426950408889634f;
constexpr int LDQ = DQK, LDK = 128, LDV = DV;
constexpr int SHM_V = KVBLK * DV * 2, SHM_K = KVBLK * 256, SHM_ATTN = 2 * SHM_V + 2 * SHM_K + NW * 64 * 4;
#define KSWZ(row, colB) ((row) * 256 + ((colB) ^ (((row) & 7) << 4)))
#define SBAR() __builtin_amdgcn_sched_barrier(0)
__device__ __forceinline__ int crow(int r, int hi) { return (r & 3) + 8 * (r >> 2) + 4 * hi; }
__device__ __forceinline__ float fadd_s(float a, float b) { float r; asm("v_add_f32_e32 %0, %1, %2" : "=v"(r) : "v"(a), "v"(b)); return r; }
__device__ __forceinline__ unsigned cvtpk(float lo, float hi) { unsigned r; asm volatile("v_cvt_pk_bf16_f32 %0, %1, %2" : "=v"(r) : "v"(lo), "v"(hi)); return r; }
#define EXPH(P) do { _Pragma("unroll") for (int r = 0; r < 16; ++r) P[r] = __builtin_amdgcn_exp2f(P[r]); } while (0)
__device__ __forceinline__ void finishSM(f32x16& p0, f32x16& p1, float& l_reg, bf16x8& pa0, bf16x8& pa1, bf16x8& pa2, bf16x8& pa3) {
    EXPH(p1);
    float ps0 = p0[0], ps1 = p1[0];
#pragma unroll
    for (int r = 1; r < 16; ++r) { ps0 = fadd_s(ps0, p0[r]); ps1 = fadd_s(ps1, p1[r]); }
    l_reg += ps0 + ps1;
#define PK4(P, BASE, OUT) do { unsigned a0 = cvtpk(P[BASE + 0], P[BASE + 1]), a1 = cvtpk(P[BASE + 2], P[BASE + 3]);   \
    unsigned b0 = cvtpk(P[BASE + 4], P[BASE + 5]), b1 = cvtpk(P[BASE + 6], P[BASE + 7]);                              \
    auto r0 = __builtin_amdgcn_permlane32_swap(a0, b0, false, false); auto r1 = __builtin_amdgcn_permlane32_swap(a1, b1, false, false); \
    u32x4 w = {r0[0], r1[0], r0[1], r1[1]}; OUT = *reinterpret_cast<bf16x8*>(&w); } while (0)
    PK4(p0, 0, pa0); PK4(p0, 8, pa1); PK4(p1, 0, pa2); PK4(p1, 8, pa3);
#undef PK4
}
__device__ __forceinline__ void qkt(f32x16& p0, f32x16& p1, const unsigned char* Ks, const bf16x8* qr, int r32, int hi) {
    p0 = f32x16{}; p1 = f32x16{};
#pragma unroll
    for (int d0 = 0; d0 < 6; ++d0) { const int cb = (d0 * 16 + hi * 8) * 2;
        const bf16x8 b0 = *reinterpret_cast<const bf16x8*>(Ks + KSWZ(r32, cb));
        const bf16x8 b1 = *reinterpret_cast<const bf16x8*>(Ks + KSWZ(32 + r32, cb));
        p0 = __builtin_amdgcn_mfma_f32_32x32x16_bf16(b0, qr[d0], p0, 0, 0, 0);
        p1 = __builtin_amdgcn_mfma_f32_32x32x16_bf16(b1, qr[d0], p1, 0, 0, 0); }
}
__device__ __forceinline__ int v_st(int k, int c) { const int kk = (k & ~0xC) | ((k & 4) << 1) | ((k & 8) >> 1); return ((kk >> 3) * 2 + (c >> 5)) * 512 + ((kk & 7) * 32 + (c & 31)) * 2; }
__device__ __forceinline__ int v_rd_base(int lane) { return ((lane & 3) << 3) | (((lane >> 2) & 3) << 6) | (((lane >> 4) & 1) << 5) | (((lane >> 5) & 1) << 8); }
constexpr int v_rd_off(int d0, int ks, int half) { return d0 * 512 + ks * 2048 + half * 1024; }
template <int OFF> __device__ __forceinline__ s16x4 tr_read(int vb) { s16x4 r; asm volatile("ds_read_b64_tr_b16 %0, %1 offset:%2" : "=&v"(r) : "v"(vb), "i"(OFF) : "memory"); return r; }
template <int D0> __device__ __forceinline__ void pv_one(f32x16& od, int vb, bf16x8 pa0, bf16x8 pa1, bf16x8 pa2, bf16x8 pa3) {
    const s16x4 l0 = tr_read<v_rd_off(D0, 0, 0)>(vb), h0 = tr_read<v_rd_off(D0, 0, 1)>(vb), l1 = tr_read<v_rd_off(D0, 1, 0)>(vb), h1 = tr_read<v_rd_off(D0, 1, 1)>(vb);
    const s16x4 l2 = tr_read<v_rd_off(D0, 2, 0)>(vb), h2 = tr_read<v_rd_off(D0, 2, 1)>(vb), l3 = tr_read<v_rd_off(D0, 3, 0)>(vb), h3 = tr_read<v_rd_off(D0, 3, 1)>(vb);
    asm volatile("s_waitcnt lgkmcnt(0)" ::: "memory"); SBAR();
#define PK(L, H) (bf16x8){L[0], L[1], L[2], L[3], H[0], H[1], H[2], H[3]}
    od = __builtin_amdgcn_mfma_f32_32x32x16_bf16(pa0, PK(l0, h0), od, 0, 0, 0);
    od = __builtin_amdgcn_mfma_f32_32x32x16_bf16(pa1, PK(l1, h1), od, 0, 0, 0);
    od = __builtin_amdgcn_mfma_f32_32x32x16_bf16(pa2, PK(l2, h2), od, 0, 0, 0);
    od = __builtin_amdgcn_mfma_f32_32x32x16_bf16(pa3, PK(l3, h3), od, 0, 0, 0);
#undef PK
}
__device__ __forceinline__ void pv_d0(f32x16* o, int vb, bf16x8 pa0, bf16x8 pa1, bf16x8 pa2, bf16x8 pa3) { pv_one<0>(o[0], vb, pa0, pa1, pa2, pa3); pv_one<1>(o[1], vb, pa0, pa1, pa2, pa3); }
struct VFrag { s16x4 l0, h0, l1, h1, l2, h2, l3, h3; };
template <int D0> __device__ __forceinline__ void vread(VFrag& f, int vb) {
    f.l0 = tr_read<v_rd_off(D0, 0, 0)>(vb); f.h0 = tr_read<v_rd_off(D0, 0, 1)>(vb); f.l1 = tr_read<v_rd_off(D0, 1, 0)>(vb); f.h1 = tr_read<v_rd_off(D0, 1, 1)>(vb);
    f.l2 = tr_read<v_rd_off(D0, 2, 0)>(vb); f.h2 = tr_read<v_rd_off(D0, 2, 1)>(vb); f.l3 = tr_read<v_rd_off(D0, 3, 0)>(vb); f.h3 = tr_read<v_rd_off(D0, 3, 1)>(vb); }
__device__ __forceinline__ void vmma(f32x16& od, const VFrag& f, bf16x8 pa0, bf16x8 pa1, bf16x8 pa2, bf16x8 pa3) {
#define PK(L, H) (bf16x8){L[0], L[1], L[2], L[3], H[0], H[1], H[2], H[3]}
    od = __builtin_amdgcn_mfma_f32_32x32x16_bf16(pa0, PK(f.l0, f.h0), od, 0, 0, 0);
    od = __builtin_amdgcn_mfma_f32_32x32x16_bf16(pa1, PK(f.l1, f.h1), od, 0, 0, 0);
    od = __builtin_amdgcn_mfma_f32_32x32x16_bf16(pa2, PK(f.l2, f.h2), od, 0, 0, 0);
    od = __builtin_amdgcn_mfma_f32_32x32x16_bf16(pa3, PK(f.l3, f.h3), od, 0, 0, 0);
#undef PK
}
#define EXPQ(P, B) do { _Pragma("unroll") for (int r = (B); r < (B) + 8; ++r) P[r] = __builtin_amdgcn_exp2f(P[r]); } while (0)
#define LWAIT() do { asm volatile("s_waitcnt lgkmcnt(0)" ::: "memory"); SBAR(); } while (0)
#define PV_STEP(vb, PN) do { LWAIT(); VFrag f1_; vread<1>(f1_, (vb)); vmma(o[0], f0, pa0, pa1, pa2, pa3); EXPQ(PN, 0); LWAIT(); vmma(o[1], f1_, pa0, pa1, pa2, pa3); EXPQ(PN, 8); SBAR(); } while (0)

__device__ __forceinline__ void attn_unit(const bf16_t* __restrict__ Qb, const bf16_t* __restrict__ Kh, const bf16_t* __restrict__ Vh, bf16_t* __restrict__ Ob, int seq, unsigned char* lds, WConv& wc, const Params& prm) {
    const int tid = threadIdx.x, wid = __builtin_amdgcn_readfirstlane(tid >> 6), lane = tid & 63, r32 = lane & 31, hi = lane >> 5;
    unsigned char* V_lds = lds; unsigned char* K_lds = lds + 2 * SHM_V;
    float* wsf = (float*)(lds + 2 * SHM_V + 2 * SHM_K) + wid * 64; float* li_l = wsf;
    float l_reg = 0; f32x16 o[2] = {}; bf16x8 qr[6];
    const bf16_t* Qw = Qb + (size_t)(wid * QBLK + r32) * LDQ + hi * 8;
#pragma unroll
    for (int d0 = 0; d0 < 6; ++d0) qr[d0] = *reinterpret_cast<const bf16x8*>(Qw + d0 * 16);
    const int kr0 = 8 * wid + (lane >> 4), kcp = lane & 15;
    const bf16_t* ksrc0 = Kh + (size_t)kr0 * LDK + ((kcp ^ (kr0 & 7)) * 8);
    const bf16_t* ksrc1 = Kh + (size_t)(kr0 + 4) * LDK + ((kcp ^ ((kr0 + 4) & 7)) * 8);
    const int vkk = 8 * wid + ((lane >> 2) & 7), vk = (vkk & ~0xC) | ((vkk & 4) << 1) | ((vkk & 8) >> 1), vcc = 32 * (lane >> 5) + 8 * (lane & 3);
    const bf16_t* vsrc = Vh + (size_t)vk * LDV + vcc;
    typedef __attribute__((address_space(3))) unsigned* lds_u32p;
#define DMA_K(t, slot) do { __builtin_amdgcn_global_load_lds((const unsigned*)(ksrc0 + (size_t)(t) * KVBLK * LDK), (lds_u32p)(K_lds + (slot) * SHM_K + wid * 2048 + lane * 16), 16, 0, 0); \
                            __builtin_amdgcn_global_load_lds((const unsigned*)(ksrc1 + (size_t)(t) * KVBLK * LDK), (lds_u32p)(K_lds + (slot) * SHM_K + wid * 2048 + 1024 + lane * 16), 16, 0, 0); } while (0)
#define DMA_V(t, slot) __builtin_amdgcn_global_load_lds((const unsigned*)(vsrc + (size_t)(t) * KVBLK * LDV), (lds_u32p)(V_lds + (slot) * SHM_V + wid * 1024 + lane * 16), 16, 0, 0)
    const int vb0 = (int)(uintptr_t)V_lds + v_rd_base(lane);
    f32x16 pA0, pA1, pB0, pB1; bf16x8 pa0, pa1, pa2, pa3; const int NT = seq / KVBLK;
    DMA_K(0, 0); DMA_V(0, 0); DMA_K(1, 1);
    asm volatile("s_waitcnt vmcnt(0)" ::: "memory"); __syncthreads();
    qkt(pA0, pA1, K_lds, qr, r32, hi); EXPH(pA0); SBAR();
    __syncthreads();
    VFrag f0;
    for (int j = 0; j + 2 < NT; j += 2) {
        DMA_K(j + 2, 0); DMA_V(j + 1, 1); wconv_step(wc, prm, lane); SBAR();
        vread<0>(f0, vb0);
        qkt(pB0, pB1, K_lds + SHM_K, qr, r32, hi);
        finishSM(pA0, pA1, l_reg, pa0, pa1, pa2, pa3); SBAR();
        PV_STEP(vb0, pB0);
        asm volatile("s_waitcnt vmcnt(0)" ::: "memory"); __syncthreads();
        DMA_K(j + 3, 1); DMA_V(j + 2, 0); wconv_step(wc, prm, lane); SBAR();
        vread<0>(f0, vb0 + SHM_V);
        qkt(pA0, pA1, K_lds, qr, r32, hi);
        finishSM(pB0, pB1, l_reg, pa0, pa1, pa2, pa3); SBAR();
        PV_STEP(vb0 + SHM_V, pA0);
        asm volatile("s_waitcnt vmcnt(0)" ::: "memory"); __syncthreads();
    }
    DMA_V(NT - 1, 1); wconv_step(wc, prm, lane); SBAR();
    vread<0>(f0, vb0);
    qkt(pB0, pB1, K_lds + SHM_K, qr, r32, hi);
    finishSM(pA0, pA1, l_reg, pa0, pa1, pa2, pa3); SBAR();
    PV_STEP(vb0, pB0);
    asm volatile("s_waitcnt vmcnt(0)" ::: "memory"); __syncthreads();
    finishSM(pB0, pB1, l_reg, pa0, pa1, pa2, pa3); SBAR();
    pv_d0(o, vb0 + SHM_V, pa0, pa1, pa2, pa3);
    { auto rr = __builtin_amdgcn_permlane32_swap(__float_as_uint(l_reg), __float_as_uint(l_reg), false, false); l_reg = __uint_as_float(rr[0]) + __uint_as_float(rr[1]); }
    if (hi == 0) li_l[r32] = l_reg; asm volatile("s_waitcnt lgkmcnt(0)" ::: "memory");
    float rli[16];
#pragma unroll
    for (int r = 0; r < 16; ++r) rli[r] = __builtin_amdgcn_rcpf(li_l[crow(r, hi)]);
    bf16_t* Ow = Ob + (size_t)(wid * QBLK) * 512;
#pragma unroll
    for (int r = 0; r < 16; ++r) { const int orow = crow(r, hi);
#pragma unroll
        for (int d0 = 0; d0 < 2; ++d0) Ow[(size_t)orow * 512 + d0 * 32 + r32] = (bf16_t)(pk2(o[d0][r] * rli[r], 0.f) & 0xffffu); }
    __syncthreads();
#undef DMA_K
#undef DMA_V
}
#undef KSWZ
#undef SBAR
}

__device__ __forceinline__ void phase_attn(const Params& p, unsigned char* lds) {
    const bf16_t* Q = (const bf16_t*)(p.ws + WS_Q); const bf16_t* Kb = (const bf16_t*)(p.ws + WS_K); const bf16_t* V = (const bf16_t*)(p.ws + WS_V); bf16_t* AO = (bf16_t*)(p.ws + WS_AO);
    constexpr int NQB = SEQ / 256, NU = 2 * NH * NQB;
    const int lane = threadIdx.x & 63, wave = __builtin_amdgcn_readfirstlane(threadIdx.x >> 6), gw = blockIdx.x * NWAVES + wave, NGW = gridDim.x * NWAVES;
    const int ipw = (WC_EXP_ITEMS + NGW - 1) / NGW, nun = ((int)blockIdx.x < NU) ? (NU - 1 - (int)blockIdx.x) / (int)gridDim.x + 1 : 0, steps = nun * (SEQ / att::KVBLK - 1);
    int cov = (steps - 1) / 8; cov = cov < 0 ? 0 : (cov > ipw ? ipw : cov);
    WConv wc; wc.tile = (float*)(lds + att::SHM_ATTN) + wave * WC_TILE_F; wc.x0 = gw * ipw; wc.cs = 0; wc.pend = (f32x4){0.f, 0.f, 0.f, 0.f};
    { const int left = WC_EXP_ITEMS - wc.x0; wc.nitems = left < 0 ? 0 : (left < cov ? left : cov); }
    if (wave >= 4) __builtin_amdgcn_s_setprio(1);
    const bool xmap = false;
    for (int u0 = blockIdx.x, rnd = 0; u0 < NU; u0 += gridDim.x, ++rnd) {
        const int u = xmap ? (((int)blockIdx.x & 7) + 8 * rnd) * NQB + ((int)blockIdx.x >> 3) : u0;
        const int qb = u % NQB, h = (u / NQB) % NH, b = u / (NQB * NH); const size_t bh = (size_t)(b * NH + h) * SEQ;
        att::attn_unit(Q + (bh + (size_t)qb * 256) * DQK, Kb + bh * 128, V + bh * DV, AO + ((size_t)b * SEQ + (size_t)qb * 256) * 512 + h * DV, SEQ, lds, wc, p);
    }
    __builtin_amdgcn_s_setprio(0);
    while (wc.cs <= 8 * wc.nitems) wconv_step(wc, p, lane);
}
__device__ __forceinline__ void wconv_cleanup(const Params& p, unsigned char* lds) {
    constexpr int NQB = SEQ / 256, NU = 2 * NH * NQB;
    const int lane = threadIdx.x & 63, wave = threadIdx.x >> 6, gw = blockIdx.x * NWAVES + wave, NGW = gridDim.x * NWAVES;
    const int ipw = (WC_EXP_ITEMS + NGW - 1) / NGW, nun = ((int)blockIdx.x < NU) ? (NU - 1 - (int)blockIdx.x) / (int)gridDim.x + 1 : 0, steps = nun * (SEQ / att::KVBLK - 1);
    int cov = (steps - 1) / 8; cov = cov < 0 ? 0 : (cov > ipw ? ipw : cov);
    float* scr = (float*)(lds + wave * 16384);
    for (int i = cov; i < ipw; ++i) { const int x = gw * ipw + i; if (x >= WC_EXP_ITEMS) break; const WcItem it = wc_decode(p, x); const int r = x % 1536;
        if (it.mode == 1) transpose_item_fp8<1>(it.W, DM, 2048, it.WT, scr, r, lane); else transpose_item_fp8<0>(it.W, DFF, DM, it.WT, scr, r - 1024, lane); }
    __syncthreads();
}

__device__ __forceinline__ int crow16(int r, int hi) { return (r & 3) + 8 * (r >> 2) + 4 * hi; }
__device__ __forceinline__ void phase_router(const Params& p, unsigned char* lds) {
    const int tid = threadIdx.x, lane = tid & 63, wid = tid >> 6, tile = wid >> 2, kq = wid & 3, c = lane & 31, h = lane >> 5;
    float* red = (float*)lds;
    float* ssb = red + 2 * 4 * 16 * 64;
    int* lcnt = (int*)(ssb + 2 * 4 * 64);
    int* lbase = lcnt + 32;
    unsigned* gcnt = (unsigned*)(p.ws + WS_CTL) + CW_CNT;
    int* row_tok = (int*)(p.ws + WS_RT2); float* row_w = (float*)(p.ws + WS_RT2 + 2 * MiB); int* row_slot = (int*)(p.ws + WS_RT2 + 4 * MiB); float* row_rstd = (float*)(p.ws + WS_RT2 + 6 * MiB);
    const u32x4* GF = (const u32x4*)(p.ws + WS_GF);
    for (int tg = blockIdx.x; tg < NTOK / 64; tg += gridDim.x) {
        if (tid < 32) lcnt[tid] = 0;
        const int token = tg * 64 + tile * 32 + c;
        const float* xrow = p.out + (size_t)token * DM + kq * 256 + 8 * h; const float* g2p = p.norm2_g + kq * 256 + 8 * h;
        unsigned char* hrow = p.ws + WS_H8 + (size_t)token * DM + kq * 256 + 8 * h;
        f32x16 acc = {}; float ss = 0.f;
#pragma unroll 2
        for (int s = 0; s < 16; ++s) {
            const f32x4 a = *(const f32x4*)(xrow + 16 * s), b = *(const f32x4*)(xrow + 16 * s + 4); const f32x4 ga = *(const f32x4*)(g2p + 16 * s), gb = *(const f32x4*)(g2p + 16 * s + 4);
            ss += (a[0] * a[0] + a[1] * a[1]) + (a[2] * a[2] + a[3] * a[3]) + (b[0] * b[0] + b[1] * b[1]) + (b[2] * b[2] + b[3] * b[3]);
            u32x4 xh; xh.x = pk2(a[0], a[1]); xh.y = pk2(a[2], a[3]); xh.z = pk2(b[0], b[1]); xh.w = pk2(b[2], b[3]);
            u32x4 xl; xl.x = pk2(a[0] - bf_lo(xh.x), a[1] - bf_hi(xh.x)); xl.y = pk2(a[2] - bf_lo(xh.y), a[3] - bf_hi(xh.y)); xl.z = pk2(b[0] - bf_lo(xh.z), b[1] - bf_hi(xh.z)); xl.w = pk2(b[2] - bf_lo(xh.w), b[3] - bf_hi(xh.w));
            u32x2 h8; h8.x = pk4_fp8(a[0] * ga[0], a[1] * ga[1], a[2] * ga[2], a[3] * ga[3]); h8.y = pk4_fp8(b[0] * gb[0], b[1] * gb[1], b[2] * gb[2], b[3] * gb[3]); *(u32x2*)(hrow + 16 * s) = h8;
            const u32x4 gh = GF[((kq * 16 + s) * 2 + 0) * 64 + lane], gl = GF[((kq * 16 + s) * 2 + 1) * 64 + lane];
            acc = __builtin_amdgcn_mfma_f32_32x32x16_bf16(__builtin_bit_cast(bf16x8, gh), __builtin_bit_cast(bf16x8, xh), acc, 0, 0, 0);
            acc = __builtin_amdgcn_mfma_f32_32x32x16_bf16(__builtin_bit_cast(bf16x8, gh), __builtin_bit_cast(bf16x8, xl), acc, 0, 0, 0);
            acc = __builtin_amdgcn_mfma_f32_32x32x16_bf16(__builtin_bit_cast(bf16x8, gl), __builtin_bit_cast(bf16x8, xh), acc, 0, 0, 0);
        }
#pragma unroll
        for (int r = 0; r < 16; ++r) red[((tile * 4 + kq) * 16 + r) * 64 + lane] = acc[r];
        ssb[(tile * 4 + kq) * 64 + lane] = ss;
        __syncthreads();
        int te[4] = {0, 0, 0, 0}, rl[4] = {0, 0, 0, 0}; float tw[4] = {0.f, 0.f, 0.f, 0.f}; float rstd = 0.f;
        if (kq == 0) {
            float v[16]; float st = 0.f;
#pragma unroll
            for (int q = 0; q < 4; ++q) st += ssb[(tile * 4 + q) * 64 + lane];
            { auto rr = __builtin_amdgcn_permlane32_swap(__float_as_uint(st), __float_as_uint(st), false, false); st = __uint_as_float(rr[0]) + __uint_as_float(rr[1]); }
            rstd = rsqrtf(st * (1.f / DM) + EPS);
#pragma unroll
            for (int r = 0; r < 16; ++r) { float sacc = 0.f;
#pragma unroll
                for (int q = 0; q < 4; ++q) sacc += red[((tile * 4 + q) * 16 + r) * 64 + lane];
                v[r] = sacc * rstd + p.router_b[crow16(r, h)]; }
            float lv[4]; int le[4];
#pragma unroll
            for (int k = 0; k < 4; ++k) { float best = v[0]; int bi = 0;
#pragma unroll
                for (int r = 1; r < 16; ++r) { const bool gt = v[r] > best; best = gt ? v[r] : best; bi = gt ? r : bi; }
                lv[k] = best; le[k] = (bi & 3) + 8 * (bi >> 2) + 4 * h;
#pragma unroll
                for (int r = 0; r < 16; ++r) v[r] = (r == bi) ? -INFINITY : v[r]; }
            float cv[8]; int ce[8];
#pragma unroll
            for (int k = 0; k < 4; ++k) { auto rv = __builtin_amdgcn_permlane32_swap(__float_as_uint(lv[k]), __float_as_uint(lv[k]), false, false); auto re = __builtin_amdgcn_permlane32_swap((unsigned)le[k], (unsigned)le[k], false, false);
                cv[k] = __uint_as_float(rv[0]); cv[4 + k] = __uint_as_float(rv[1]); ce[k] = (int)re[0]; ce[4 + k] = (int)re[1]; }
            float tv[4];
#pragma unroll
            for (int k = 0; k < 4; ++k) { float best = cv[0]; int be = ce[0]; int bi = 0;
#pragma unroll
                for (int r = 1; r < 8; ++r) { const bool gt = (cv[r] > best) || (cv[r] == best && ce[r] < be); best = gt ? cv[r] : best; be = gt ? ce[r] : be; bi = gt ? r : bi; }
                tv[k] = best; te[k] = be;
#pragma unroll
                for (int r = 0; r < 8; ++r) cv[r] = (r == bi) ? -INFINITY : cv[r]; }
            const float e1 = __expf(tv[1] - tv[0]), e2 = __expf(tv[2] - tv[0]), e3 = __expf(tv[3] - tv[0]); const float inv = 1.f / (1.f + e1 + e2 + e3);
            tw[0] = inv; tw[1] = e1 * inv; tw[2] = e2 * inv; tw[3] = e3 * inv;
            if (h == 0) {
#pragma unroll
                for (int k = 0; k < 4; ++k) rl[k] = atomicAdd(&lcnt[te[k]], 1); }
        }
        __syncthreads();
        if (tid < 32) lbase[tid] = (int)atomicAdd(&gcnt[tid], (unsigned)lcnt[tid]);
        __syncthreads();
        if (kq == 0 && h == 0) {
#pragma unroll
            for (int k = 0; k < 4; ++k) { const int idx = te[k] * CAP + lbase[te[k]] + rl[k]; row_tok[idx] = token; row_w[idx] = tw[k]; row_slot[idx] = token * 4 + k; row_rstd[idx] = rstd; } }
        __syncthreads();
    }
}

__device__ __forceinline__ void build_block_table(const Params& p, int* bs) {
    const unsigned* gcnt = (const unsigned*)(p.ws + WS_CTL) + CW_CNT;
    if (threadIdx.x == 0) { int acc = 0; for (int e = 0; e < NE; ++e) { bs[e] = acc; acc += ((int)__hip_atomic_load(gcnt + e, __ATOMIC_RELAXED, __HIP_MEMORY_SCOPE_AGENT) + 255) >> 8; } bs[NE] = acc; }
    __syncthreads();
}

__device__ __forceinline__ pg8::MoeOrder make_moe_order(const Params& p, unsigned char* lds, int N, bool gather) {
    int* bs = (int*)(lds + 131072); int* utab = (int*)(lds + 131072 + 256); int* gtab = (int*)(lds + 131072 + 512);
    build_block_table(p, bs);
    const int nmb = __builtin_amdgcn_readfirstlane(bs[NE]);
    pg8::MoeOrder S; S.so.init(nmb * 256, N, (int)gridDim.x, (int)blockIdx.x); S.utab = (const PG8_LAS int*)utab; S.gtab = (const PG8_LAS int*)gtab;
    const int* row_tok = (const int*)(p.ws + WS_RT2);
    for (int i = 0; i < pg8::MOE_MAXU; ++i) { pg8::Unit u; if (!S.so.next(i, u)) break; int e = 0; for (int k = 1; k < NE; ++k) if (bs[k] <= u.pm) e = k;
        const int rb = e * CAP + (u.pm - bs[e]) * 256;
        if (threadIdx.x == 0) utab[i] = e | (rb << 8);
        if (gather && threadIdx.x < 256) gtab[i * 256 + threadIdx.x] = row_tok[rb + threadIdx.x]; }
    __syncthreads();
    return S;
}
__device__ __forceinline__ void phase_moe1(const Params& p, unsigned char* lds) {
    const pg8::MoeOrder S = make_moe_order(p, lds, 2048, true);
    pg8::Gemm g{(const bf16_t*)(p.ws + WS_H8), (const bf16_t*)(p.ws + WS_W1), 0, 2048, DM / 2, (size_t)2048 * DM, 0};
    pg8::EpiSwiglu E{p.ws + WS_ACT, p.b1, (const float*)(p.ws + WS_RT2 + 6 * MiB)};
    pg8::gemm_phase<pg8::EpiSwiglu, pg8::MoeOrder, true, true, true, true>((PG8_LAS unsigned char*)lds, g, S, E);
}
__device__ __forceinline__ void phase_moe2(const Params& p, unsigned char* lds) {
    const pg8::MoeOrder S = make_moe_order(p, lds, DM, false);
    pg8::Gemm g{(const bf16_t*)(p.ws + WS_ACT), (const bf16_t*)(p.ws + WS_W2), 0, DM, DFF / 2, (size_t)DM * DFF, 0};
    pg8::EpiMoeOut E{p.ws + WS_YS, p.b2, (const float*)(p.ws + WS_RT2 + 2 * MiB), (const int*)(p.ws + WS_RT2 + 4 * MiB)};
    pg8::gemm_phase<pg8::EpiMoeOut, pg8::MoeOrder, true, true, true>((PG8_LAS unsigned char*)lds, g, S, E);
}

__device__ __forceinline__ float fp8_to_f32(unsigned w, int byte) {
    return byte == 0 ? __builtin_amdgcn_cvt_f32_fp8((int)w, 0) : byte == 1 ? __builtin_amdgcn_cvt_f32_fp8((int)w, 1) : byte == 2 ? __builtin_amdgcn_cvt_f32_fp8((int)w, 2) : __builtin_amdgcn_cvt_f32_fp8((int)w, 3); }
__device__ __forceinline__ void phase_combine(const Params& p) {
    const int tid = threadIdx.x, lane = tid & 63, wave = tid >> 6;
    const int gw = blockIdx.x * NWAVES + wave, NGW = gridDim.x * NWAVES;
    const unsigned char* YS = p.ws + WS_YS;
    for (int t = gw; t < NTOK; t += NGW) {
        f32x4* orow = (f32x4*)(p.out + (size_t)t * DM) + lane;
        f32x4 v[4]; unsigned w[4][4];
#pragma unroll
        for (int j = 0; j < 4; ++j) { v[j] = orow[64 * j];
#pragma unroll
            for (int k = 0; k < 4; ++k) w[j][k] = *((const unsigned*)(YS + ((size_t)t * 4 + k) * DM) + lane + 64 * j); }
#pragma unroll
        for (int j = 0; j < 4; ++j) { f32x4 s = {0.f, 0.f, 0.f, 0.f};
#pragma unroll
            for (int k = 0; k < 4; ++k) { s[0] += fp8_to_f32(w[j][k], 0); s[1] += fp8_to_f32(w[j][k], 1); s[2] += fp8_to_f32(w[j][k], 2); s[3] += fp8_to_f32(w[j][k], 3); }
            orow[64 * j] = v[j] + s * YS_INV; }
    }
}

template <class Epi>
__device__ __forceinline__ void dense_gemm(unsigned char* lds, const bf16_t* A, const bf16_t* Bt, int M, int N, int K, const Epi& E, int lda = 0) {
    pg8::Gemm g{A, Bt, M, N, K, 0, lda}; pg8::StaticOrder S; S.init(M, N, (int)gridDim.x, (int)blockIdx.x);
    pg8::gemm_phase<Epi, pg8::StaticOrder, true, true>((PG8_LAS unsigned char*)lds, g, S, E);
}

constexpr int NPHASE = 13;
__global__ void __launch_bounds__(NTHREADS, 2) mk_fwd(Params p) {
    extern __shared__ __attribute__((aligned(16))) unsigned char lds[];
    cg::grid_group grid = cg::this_grid();
    unsigned char* ws = p.ws;
    volatile LAS unsigned* MISC = (volatile LAS unsigned*)((LAS unsigned char*)lds + MISC_OFF);
    if (threadIdx.x < 32) MISC[threadIdx.x] = 0u;
    __syncthreads();
    XcdBarrier bar = xcd_barrier_post((unsigned*)(ws + WS_CTL) + CW_BAR, MISC + 8);
    const int lo = p.ph_lo, hi = p.ph_hi;
    if (lo < 0) grid.sync();
#define IN(k) (lo <= (k) && (k) < hi)
#define SEAM(k) do { if (IN(k) && IN((k) + 1)) xcd_barrier(bar); } while (0)
    if (IN(0)) phase_prologue(p, lds);
    SEAM(0);
    if (IN(1)) { pg8::EpiProj E{(bf16_t*)(ws + WS_PROJ)}; dense_gemm(lds, (const bf16_t*)(ws + WS_XN), (const bf16_t*)(ws + WS_WIN), NTOK, INCP, DM, E); }
    if (IN(1) && IN(3)) xcd_barrier(bar);
    if (IN(3)) { pg8::EpiBf16 Eq{(bf16_t*)(ws + WS_QPRE), 768}; dense_gemm(lds, (const bf16_t*)(ws + WS_PROJ) + OFF_CQ, (const bf16_t*)(ws + WS_WUQ), NTOK, 768, QLORA, Eq, INCP);
                 pg8::EpiBf16 Ek{(bf16_t*)(ws + WS_KVPRE), 1024}; dense_gemm(lds, (const bf16_t*)(ws + WS_PROJ) + OFF_CKV, (const bf16_t*)(ws + WS_WUKV), NTOK, 1024, KVLORA, Ek, INCP); }
    SEAM(3);
    if (IN(4)) phase_tok_b(p);
    SEAM(4);
    if (IN(5)) phase_attn(p, lds);
    SEAM(5);
    if (IN(6)) { pg8::EpiGateA E{(bf16_t*)(ws + WS_M1), (const bf16_t*)(ws + WS_PROJ)}; dense_gemm(lds, (const bf16_t*)(ws + WS_AO), (const bf16_t*)(ws + WS_WOMLA), NTOK, DM, 512, E); }
    if (IN(7)) { pg8::EpiGateB E{(const bf16_t*)(ws + WS_M1), (const bf16_t*)(ws + WS_PROJ), (bf16_t*)(ws + WS_MERGED)}; dense_gemm(lds, (const bf16_t*)(ws + WS_YBIN), (const bf16_t*)(ws + WS_WOCONV), NTOK, DM, 512, E); }
    SEAM(7);
    if (IN(8)) { pg8::EpiResid E{p.x, p.out}; dense_gemm(lds, (const bf16_t*)(ws + WS_MERGED), (const bf16_t*)(ws + WS_WO), NTOK, DM, DM, E); }
    SEAM(8);
    if (IN(9)) { wconv_cleanup(p, lds); phase_router(p, lds); }
    if (IN(9) && IN(11)) xcd_barrier(bar);
    if (IN(11)) phase_moe1(p, lds);
    SEAM(11);
    if (IN(12)) phase_moe2(p, lds);
    SEAM(12);
    if (IN(13)) phase_combine(p);
#undef IN
#undef SEAM
}

extern "C" void kernel_launch(void* const* d_in, const int* in_sizes, int n_in, void* d_out, int out_size,
                              void* d_ws, size_t ws_size, hipStream_t stream) {
    static int grid_blocks = 0;
    if (!grid_blocks) {
        int dev = 0, cus = 0, per_cu = 0;
        (void)hipGetDevice(&dev);
        (void)hipDeviceGetAttribute(&cus, hipDeviceAttributeMultiprocessorCount, dev);
        (void)hipFuncSetAttribute((const void*)mk_fwd, hipFuncAttributeMaxDynamicSharedMemorySize, LDS_BYTES);
        (void)hipOccupancyMaxActiveBlocksPerMultiprocessor(&per_cu, (const void*)mk_fwd, NTHREADS, LDS_BYTES);
        if (per_cu < 1) { fprintf(stderr, "kernel_launch: occupancy query says %d blocks/CU\n", per_cu); per_cu = 1; }
        grid_blocks = cus;
        if (ws_size < WS_END2 || n_in != 21) fprintf(stderr, "kernel_launch: ws %zu < %zu or n_in %d != 21\n", ws_size, (size_t)WS_END2, n_in);
    }
    (void)hipMemsetAsync((char*)d_ws + WS_CTL, 0, 1 * MiB, stream);
    Params p{};
    p.x = (const float*)d_in[0]; p.pos = (const int*)d_in[1]; p.norm1_g = (const float*)d_in[2]; p.w_in = (const float*)d_in[3]; p.q_a_g = (const float*)d_in[4];
    p.kv_a_g = (const float*)d_in[5]; p.w_uq = (const float*)d_in[6]; p.w_ukv = (const float*)d_in[7]; p.q_g = (const float*)d_in[8]; p.k_g = (const float*)d_in[9];
    p.conv_w = (const float*)d_in[10]; p.w_o_mla = (const float*)d_in[11]; p.w_o_conv = (const float*)d_in[12]; p.w_o = (const float*)d_in[13]; p.norm2_g = (const float*)d_in[14];
    p.router_w = (const float*)d_in[15]; p.router_b = (const float*)d_in[16]; p.w1 = (const float*)d_in[17]; p.b1 = (const float*)d_in[18]; p.w2 = (const float*)d_in[19]; p.b2 = (const float*)d_in[20];
    p.out = (float*)d_out; p.ws = (unsigned char*)d_ws; p.ph_lo = 0; p.ph_hi = NPHASE + 1;
    void* args[] = {&p};
    hipError_t e = hipLaunchCooperativeKernel((const void*)mk_fwd, dim3(grid_blocks), dim3(NTHREADS), args, LDS_BYTES, stream);
    if (e != hipSuccess) fprintf(stderr, "cooperative launch failed: %s (grid %d)\n", hipGetErrorString(e), grid_blocks);
}
```

```cpp
#include <hip/hip_runtime.h>
#include <hip/hip_cooperative_groups.h>
#include <cstdio>
#include <cstdint>
namespace cg = cooperative_groups;

typedef unsigned short bf16_t;
typedef short bf16x8 __attribute__((ext_vector_type(8)));
typedef short s16x4 __attribute__((ext_vector_type(4)));
typedef float f32x4 __attribute__((ext_vector_type(4)));
typedef float f32x2 __attribute__((ext_vector_type(2)));
typedef float f32x16 __attribute__((ext_vector_type(16)));
typedef unsigned u32x4 __attribute__((ext_vector_type(4)));
typedef unsigned u32x2 __attribute__((ext_vector_type(2)));
typedef __bf16 bf16x2_t __attribute__((ext_vector_type(2)));

constexpr int NTOK = 16384, DM = 1024, SEQ = 8192;
constexpr int INC = 4000, INCP = 4096;
constexpr int OFF_CQ = 0, OFF_CKV = 256, OFF_KR = 384, OFF_U = 416, OFF_C = 928, OFF_B = 1440, OFF_GA = 1952, OFF_GB = 2976;
constexpr int NH = 8, DQK = 96, DV = 64, NE = 32, TOPK = 4, DFF = 1024;
constexpr int QLORA = 256, KVLORA = 128, CONVW = 512;
constexpr int NPAIR = NTOK * TOPK;
constexpr int MAXROWS = 73728;
constexpr float EPS = 1e-6f;
constexpr float QSCALE = 0.10206207261596575f * 1.4426950408889634f;
constexpr int CAP = 16384;
constexpr int NTHREADS = 512, NWAVES = 8;
constexpr int LDS_BYTES = 147456;

constexpr size_t MiB = 1ull << 20;
constexpr size_t WS_CTL = 0;
constexpr size_t WS_WIN = 1 * MiB;
constexpr size_t WS_WUQ = 9 * MiB;
constexpr size_t WS_WUKV = WS_WUQ + 512 * 1024;
constexpr size_t WS_WOMLA = 10 * MiB;
constexpr size_t WS_WOCONV = 11 * MiB;
constexpr size_t WS_WO = 12 * MiB;
constexpr size_t WS_ROUTE = 14 * MiB;
constexpr size_t WS_W1 = 18 * MiB;
constexpr size_t WS_W2 = 146 * MiB;
constexpr size_t WS_XN = 210 * MiB;
constexpr size_t WS_PROJ = 242 * MiB;
constexpr size_t WS_CQN = 370 * MiB;
constexpr size_t WS_CKVN = 378 * MiB;
constexpr size_t WS_YBIN = 386 * MiB;
constexpr size_t WS_QPRE = 402 * MiB;
constexpr size_t WS_KVPRE = 450 * MiB;
constexpr size_t WS_Q = 514 * MiB;
constexpr size_t WS_K = 538 * MiB;
constexpr size_t WS_V = 570 * MiB;
constexpr size_t WS_AO = 586 * MiB;
constexpr size_t WS_M1 = 602 * MiB;
constexpr size_t WS_MERGED = 666 * MiB;
constexpr size_t WS_YS = 698 * MiB;
constexpr size_t WS_END = 826 * MiB;
constexpr size_t WS_ACT = WS_PROJ;
constexpr size_t WS_H8 = WS_XN;
constexpr size_t WS_GF = 830 * MiB;
constexpr size_t WS_RT2 = 832 * MiB;
constexpr size_t WS_SSQ = 840 * MiB;
constexpr size_t WS_CS = 841 * MiB;
constexpr size_t WS_END2 = 844 * MiB;
constexpr size_t RT_PAIR_E = 0, RT_PAIR_RANK = 262144, RT_PAIR_W = 524288, RT_ROW_TOK = 786432, RT_ROW_W = 786432 + 294912, RT_ROW_SLOT = 786432 + 2 * 294912;
constexpr int CW_CNT = 64;
constexpr int CW_BAR = 4096;
constexpr int MISC_OFF = LDS_BYTES - 256;

struct Params {
    const float* x; const int* pos; const float* norm1_g; const float* w_in; const float* q_a_g; const float* kv_a_g;
    const float* w_uq; const float* w_ukv; const float* q_g; const float* k_g; const float* conv_w; const float* w_o_mla;
    const float* w_o_conv; const float* w_o; const float* norm2_g; const float* router_w; const float* router_b;
    const float* w1; const float* b1; const float* w2; const float* b2;
    float* out; unsigned char* ws; int ph_lo, ph_hi;
};

__device__ __forceinline__ unsigned pk2(float lo, float hi) { f32x2 v = {lo, hi}; bf16x2_t b = __builtin_convertvector(v, bf16x2_t); return __builtin_bit_cast(unsigned, b); }
__device__ __forceinline__ float bf_lo(unsigned w) { return __uint_as_float(w << 16); }
__device__ __forceinline__ float bf_hi(unsigned w) { return __uint_as_float(w & 0xffff0000u); }
__device__ __forceinline__ float bf1(bf16_t h) { return __uint_as_float((unsigned)h << 16); }
__device__ __forceinline__ float wave_sum(float v) {
#pragma unroll
    for (int o = 1; o < 64; o <<= 1) v += __shfl_xor(v, o);
    return v;
}
__device__ __forceinline__ unsigned pk4_fp8(float a, float b, float c, float d) { unsigned w = 0u; w = (unsigned)__builtin_amdgcn_cvt_pk_fp8_f32(a, b, (int)w, false); w = (unsigned)__builtin_amdgcn_cvt_pk_fp8_f32(c, d, (int)w, true); return w; }
constexpr float W8_SCALE = 32.f, W8_INV = 1.f / 32.f, YS_SCALE = 8.f, YS_INV = 0.125f;
__device__ __forceinline__ float sigmoidf_(float v) { return __builtin_amdgcn_rcpf(1.f + __builtin_amdgcn_exp2f(v * -1.4426950408889634f)); }

namespace pg8 {
#define PG8_LAS __attribute__((address_space(3)))
constexpr int BM = 256, BK = 64, HALF = 128, HTB = HALF * BK * 2  , STAGE_BYTES = 8 * HTB, NXCD = 8, WGM = 8;

__host__ __device__ __forceinline__ int lds_byte(int r, int c) { const int st = (r >> 4) * 2 + (c >> 5), rr = r & 15, cc = c & 31, ob = rr * 64 + cc * 2; return st * 1024 + (ob ^ (((ob >> 9) & 1) << 5)); }
__host__ __device__ __forceinline__ void stage_rc(int b, int& R, int& C) { const int st = b / 1024, sb = b % 1024, swz = sb ^ (((sb >> 9) & 1) << 5); R = (st >> 1) * 16 + swz / 64; C = (st & 1) * 32 + (swz % 64) / 2; }
__host__ __device__ __forceinline__ int perm32(int rho) { const int n = rho >> 4, i = rho & 15; return 8 * (i >> 2) + 4 * n + (i & 3); }

struct Unit { int pm, pn, e, rb; };
struct Gemm { const bf16_t* A; const bf16_t* Bt; int M, N, K; size_t bstride; int lda; };

struct StaticOrder {
    int nM, nN, nwg, G, c;
    __host__ __device__ void init(int M, int N, int G_, int c_) { nM = M / BM; nN = N / BM; nwg = nM * nN; G = G_; c = c_; }
    __host__ __device__ bool next(int i, Unit& u) const {
        const long L = (long)i * G + c; if (L >= nwg) return false;
        int wgid = (int)L; { const int q = nwg / NXCD, r = nwg % NXCD, xcd = wgid % NXCD, off = wgid / NXCD; wgid = (xcd < r ? xcd * (q + 1) : r * (q + 1) + (xcd - r) * q) + off; }
        const int nig = WGM * nN, gid = wgid / nig, fm = gid * WGM, gsz = (nM - fm) < WGM ? (nM - fm) : WGM;
        u.pm = fm + ((wgid % nig) % gsz); u.pn = (wgid % nig) / gsz; u.e = 0; u.rb = 0; return true;
    }
    __device__ __forceinline__ void a_ready(const Unit&) const {}
    __device__ __forceinline__ void done(const Unit&) const {}
};


struct EpiProj {
    static constexpr bool PERM = true, AFTER_DRAIN = false;
    bf16_t* O; float* ssq;
    __device__ __forceinline__ void operator()(const f32x4 (&acc)[2][2][4][2], const Unit& u, int wr, int wc, int fr, int fq) const {
        const int row0 = u.pm * BM + wr * 64 + fr, col0 = u.pn * BM + wc * 32 + 8 * fq;
#pragma unroll
        for (int ai = 0; ai < 2; ++ai)
#pragma unroll
            for (int m = 0; m < 4; ++m) { const int row = row0 + ai * HALF + m * 16; bf16_t* rowp = O + (size_t)row * INCP + col0;
#pragma unroll
                for (int bj = 0; bj < 2; ++bj) { f32x4 v0 = acc[ai][bj][m][0], v1 = acc[ai][bj][m][1]; const int col = col0 + bj * HALF;
                    if (col >= OFF_GA && col < INC) {
#pragma unroll
                        for (int j = 0; j < 4; ++j) { v0[j] = sigmoidf_(v0[j]); v1[j] = sigmoidf_(v1[j]); } }
                    u32x4 w; w.x = pk2(v0[0], v0[1]); w.y = pk2(v0[2], v0[3]); w.z = pk2(v1[0], v1[1]); w.w = pk2(v1[2], v1[3]);
                    *(u32x4*)(rowp + bj * HALF) = w;
                    const int which = u.pn == 0 ? 0 : (u.pn == 1 ? (bj == 0 ? 1 : (wc == 0 ? 2 : -1)) : -1);
                    if (which >= 0) { float s = (v0[0] * v0[0] + v0[1] * v0[1]) + (v0[2] * v0[2] + v0[3] * v0[3]) + (v1[0] * v1[0] + v1[1] * v1[1]) + (v1[2] * v1[2] + v1[3] * v1[3]);
                        s += __shfl_xor(s, 16); s += __shfl_xor(s, 32); if (fq == 0) atomicAdd(ssq + which * NTOK + row, s); } } }
    }
};
struct EpiBf16 {
    static constexpr bool PERM = true, AFTER_DRAIN = false;
    bf16_t* O; int ldc;
    __device__ __forceinline__ void operator()(const f32x4 (&acc)[2][2][4][2], const Unit& u, int wr, int wc, int fr, int fq) const {
        const int row0 = u.pm * BM + wr * 64 + fr, col0 = u.pn * BM + wc * 32 + 8 * fq;
#pragma unroll
        for (int ai = 0; ai < 2; ++ai)
#pragma unroll
            for (int m = 0; m < 4; ++m) { bf16_t* rowp = O + (size_t)(row0 + ai * HALF + m * 16) * ldc + col0;
#pragma unroll
                for (int bj = 0; bj < 2; ++bj) { const f32x4 v0 = acc[ai][bj][m][0], v1 = acc[ai][bj][m][1];
                    u32x4 w; w.x = pk2(v0[0], v0[1]); w.y = pk2(v0[2], v0[3]); w.z = pk2(v1[0], v1[1]); w.w = pk2(v1[2], v1[3]); *(u32x4*)(rowp + bj * HALF) = w; } }
    }
};
__device__ __forceinline__ void epi_bar() { asm volatile("s_waitcnt lgkmcnt(0)" ::: "memory"); __builtin_amdgcn_s_barrier(); asm volatile("" ::: "memory"); }
__device__ __forceinline__ u32x2 pk4bf(const f32x4 v) { u32x2 w; w.x = pk2(v[0], v[1]); w.y = pk2(v[2], v[3]); return w; }
struct EpiQ {
    static constexpr bool PERM = false, AFTER_DRAIN = false;
    bf16_t* Q; const float* ssq_cq; const float* qg; const float* cs; float* hs;
    __device__ __forceinline__ void operator()(f32x4 (&acc)[2][2][4][2], const Unit& u, int wr, int wc, int fr, int fq) const {
        int lr0 = wr * 64 + fr; asm volatile("" : "+v"(lr0), "+v"(fq));
        const int t0 = u.pm * BM + lr0;
        hs[threadIdx.x] = 0.f; epi_bar();
#pragma unroll
        for (int ai = 0; ai < 2; ++ai)
#pragma unroll
            for (int m = 0; m < 4; ++m) { const float rq = rsqrtf(ssq_cq[t0 + ai * HALF + m * 16] * (1.f / QLORA) + EPS);
#pragma unroll
                for (int bj = 0; bj < 2; ++bj) { const f32x4 x0 = acc[ai][bj][m][0] * rq, x1 = acc[ai][bj][m][1] * rq; acc[ai][bj][m][0] = x0; acc[ai][bj][m][1] = x1;
                    float s = (x0[0] * x0[0] + x0[1] * x0[1]) + (x0[2] * x0[2] + x0[3] * x0[3]) + (x1[0] * x1[0] + x1[1] * x1[1]) + (x1[2] * x1[2] + x1[3] * x1[3]);
                    s += __shfl_xor(s, 16); s += __shfl_xor(s, 32); if (fq == 0 && wc < 3) atomicAdd(&hs[(lr0 + ai * HALF + m * 16) * 2 + bj], s); } }
        epi_bar();
        if (wc < 3) {
            const f32x4 g0 = *(const f32x4*)(qg + 32 * wc + 4 * fq), g1 = *(const f32x4*)(qg + 32 * wc + 16 + 4 * fq);
#pragma unroll
            for (int ai = 0; ai < 2; ++ai)
#pragma unroll
                for (int m = 0; m < 4; ++m) { const int lr = lr0 + ai * HALF + m * 16, t = u.pm * BM + lr, b = t >> 13, s = t & (SEQ - 1);
                    f32x4 c4 = {0.f, 0.f, 0.f, 0.f}, s4 = {0.f, 0.f, 0.f, 0.f}; if (wc == 2) { c4 = *(const f32x4*)(cs + (size_t)t * 32 + 4 * fq); s4 = *(const f32x4*)(cs + (size_t)t * 32 + 16 + 4 * fq); }
#pragma unroll
                    for (int bj = 0; bj < 2; ++bj) { const float rstd = rsqrtf(hs[lr * 2 + bj] * (1.f / DQK) + EPS) * QSCALE; f32x4 x0 = acc[ai][bj][m][0] * rstd * g0, x1 = acc[ai][bj][m][1] * rstd * g1;
                        if (wc == 2) { const f32x4 o0 = x0 * c4 - x1 * s4, o1 = x0 * s4 + x1 * c4; x0 = o0; x1 = o1; }
                        bf16_t* qp = Q + ((size_t)(b * NH + 2 * u.pn + bj) * SEQ + s) * DQK + 32 * wc + 4 * fq; *(u32x2*)qp = pk4bf(x0); *(u32x2*)(qp + 16) = pk4bf(x1); }
                    asm volatile("" ::: "memory"); }
        }
    }
};
struct EpiKV {
    static constexpr bool PERM = false, AFTER_DRAIN = false;
    bf16_t* K; bf16_t* V; const float* ssq_ckv; const float* ssq_kr; const float* kg; const float* cs; const bf16_t* proj; float* hs;
    __device__ __forceinline__ void operator()(f32x4 (&acc)[2][2][4][2], const Unit& u, int wr, int wc, int fr, int fq) const {
        int lr0 = wr * 64 + fr; asm volatile("" : "+v"(lr0), "+v"(fq));
        const int t0 = u.pm * BM + lr0;
        hs[threadIdx.x] = 0.f; epi_bar();
#pragma unroll
        for (int ai = 0; ai < 2; ++ai)
#pragma unroll
            for (int m = 0; m < 4; ++m) { const float rk = rsqrtf(ssq_ckv[t0 + ai * HALF + m * 16] * (1.f / KVLORA) + EPS);
#pragma unroll
                for (int bj = 0; bj < 2; ++bj) { const f32x4 x0 = acc[ai][bj][m][0] * rk, x1 = acc[ai][bj][m][1] * rk; acc[ai][bj][m][0] = x0; acc[ai][bj][m][1] = x1;
                    if (wc < 2) { float s = (x0[0] * x0[0] + x0[1] * x0[1]) + (x0[2] * x0[2] + x0[3] * x0[3]) + (x1[0] * x1[0] + x1[1] * x1[1]) + (x1[2] * x1[2] + x1[3] * x1[3]);
                        s += __shfl_xor(s, 16); s += __shfl_xor(s, 32); if (fq == 0) atomicAdd(&hs[(lr0 + ai * HALF + m * 16) * 2 + bj], s); } } }
        epi_bar();
        f32x4 g0 = {0.f, 0.f, 0.f, 0.f}, g1 = {0.f, 0.f, 0.f, 0.f};
        if (wc < 2) { g0 = *(const f32x4*)(kg + 32 * wc + 4 * fq); g1 = *(const f32x4*)(kg + 32 * wc + 16 + 4 * fq); }
        if (wc == 2) { g0 = *(const f32x4*)(kg + 64 + 4 * fq); g1 = *(const f32x4*)(kg + 80 + 4 * fq); }
#pragma unroll
        for (int ai = 0; ai < 2; ++ai)
#pragma unroll
            for (int m = 0; m < 4; ++m) { const int lr = lr0 + ai * HALF + m * 16, t = u.pm * BM + lr, b = t >> 13, s = t & (SEQ - 1); const float skr = ssq_kr[t];
                f32x4 c4 = {0.f, 0.f, 0.f, 0.f}, s4 = c4, r1 = c4, r2 = c4;
                if (wc == 2) { c4 = *(const f32x4*)(cs + (size_t)t * 32 + 4 * fq); s4 = *(const f32x4*)(cs + (size_t)t * 32 + 16 + 4 * fq);
                    const u32x2 a = *(const u32x2*)(proj + (size_t)t * INCP + OFF_KR + 4 * fq), bb = *(const u32x2*)(proj + (size_t)t * INCP + OFF_KR + 16 + 4 * fq);
                    r1 = (f32x4){bf_lo(a.x), bf_hi(a.x), bf_lo(a.y), bf_hi(a.y)} * g0; r2 = (f32x4){bf_lo(bb.x), bf_hi(bb.x), bf_lo(bb.y), bf_hi(bb.y)} * g1; }
#pragma unroll
                for (int bj = 0; bj < 2; ++bj) { const size_t rowi = (size_t)(b * NH + 2 * u.pn + bj) * SEQ + s; const float rstd = rsqrtf((hs[lr * 2 + bj] + skr) * (1.f / DQK) + EPS);
                    if (wc < 2) { bf16_t* kp = K + rowi * 128 + 32 * wc + 4 * fq; *(u32x2*)kp = pk4bf(acc[ai][bj][m][0] * rstd * g0); *(u32x2*)(kp + 16) = pk4bf(acc[ai][bj][m][1] * rstd * g1); }
                    else { bf16_t* vp = V + rowi * DV + 32 * (wc - 2) + 4 * fq; *(u32x2*)vp = pk4bf(acc[ai][bj][m][0]); *(u32x2*)(vp + 16) = pk4bf(acc[ai][bj][m][1]);
                        if (wc == 2) { const f32x4 x1 = r1 * rstd, x2 = r2 * rstd; bf16_t* kp = K + rowi * 128 + 64 + 4 * fq; *(u32x2*)kp = pk4bf(x1 * c4 - x2 * s4); *(u32x2*)(kp + 16) = pk4bf(x1 * s4 + x2 * c4); }
                        else { *(u32x4*)(K + rowi * 128 + 96 + 8 * fq) = (u32x4){0u, 0u, 0u, 0u}; } } }
                asm volatile("" ::: "memory"); }
    }
};
struct EpiF32 {
    static constexpr bool PERM = false, AFTER_DRAIN = false;
    float* O; int ldc;
    __device__ __forceinline__ void operator()(const f32x4 (&acc)[2][2][4][2], const Unit& u, int wr, int wc, int fr, int fq) const {
        const int row0 = u.pm * BM + wr * 64 + fr, col0 = u.pn * BM + wc * 32 + 4 * fq;
#pragma unroll
        for (int ai = 0; ai < 2; ++ai)
#pragma unroll
            for (int m = 0; m < 4; ++m) { float* rowp = O + (size_t)(row0 + ai * HALF + m * 16) * ldc + col0;
#pragma unroll
                for (int bj = 0; bj < 2; ++bj)
#pragma unroll
                    for (int n = 0; n < 2; ++n) *(f32x4*)(rowp + bj * HALF + n * 16) = acc[ai][bj][m][n]; }
    }
};
__device__ __forceinline__ void unpack8(const u32x4 g, float (&f)[8]) { f[0] = bf_lo(g.x); f[1] = bf_hi(g.x); f[2] = bf_lo(g.y); f[3] = bf_hi(g.y); f[4] = bf_lo(g.z); f[5] = bf_hi(g.z); f[6] = bf_lo(g.w); f[7] = bf_hi(g.w); }
struct EpiGateA {
    static constexpr bool PERM = true, AFTER_DRAIN = false;
    bf16_t* M1; const bf16_t* proj;
    __device__ __forceinline__ void operator()(const f32x4 (&acc)[2][2][4][2], const Unit& u, int wr, int wc, int fr, int fq) const {
        const int row0 = u.pm * BM + wr * 64 + fr, col0 = u.pn * BM + wc * 32 + 8 * fq;
#pragma unroll
        for (int ai = 0; ai < 2; ++ai)
#pragma unroll
            for (int m = 0; m < 4; ++m) { const size_t row = (size_t)(row0 + ai * HALF + m * 16);
#pragma unroll
                for (int bj = 0; bj < 2; ++bj) { const int col = col0 + bj * HALF; float g[8]; unpack8(*(const u32x4*)(proj + row * INCP + OFF_GA + col), g);
                    const f32x4 v0 = acc[ai][bj][m][0], v1 = acc[ai][bj][m][1];
                    u32x4 w; w.x = pk2(v0[0] * g[0], v0[1] * g[1]); w.y = pk2(v0[2] * g[2], v0[3] * g[3]); w.z = pk2(v1[0] * g[4], v1[1] * g[5]); w.w = pk2(v1[2] * g[6], v1[3] * g[7]);
                    *(u32x4*)(M1 + row * DM + col) = w; } }
    }
};
struct EpiGateB {
    static constexpr bool PERM = true, AFTER_DRAIN = false;
    const bf16_t* M1; const bf16_t* proj; bf16_t* O;
    __device__ __forceinline__ void operator()(const f32x4 (&acc)[2][2][4][2], const Unit& u, int wr, int wc, int fr, int fq) const {
        const int row0 = u.pm * BM + wr * 64 + fr, col0 = u.pn * BM + wc * 32 + 8 * fq;
#pragma unroll
        for (int ai = 0; ai < 2; ++ai)
#pragma unroll
            for (int m = 0; m < 4; ++m) { const size_t row = (size_t)(row0 + ai * HALF + m * 16);
#pragma unroll
                for (int bj = 0; bj < 2; ++bj) { const int col = col0 + bj * HALF; float g[8], b[8]; unpack8(*(const u32x4*)(proj + row * INCP + OFF_GB + col), g); unpack8(*(const u32x4*)(M1 + row * DM + col), b);
                    const f32x4 v0 = acc[ai][bj][m][0], v1 = acc[ai][bj][m][1];
                    u32x4 w; w.x = pk2(b[0] + v0[0] * g[0], b[1] + v0[1] * g[1]); w.y = pk2(b[2] + v0[2] * g[2], b[3] + v0[3] * g[3]);
                    w.z = pk2(b[4] + v1[0] * g[4], b[5] + v1[1] * g[5]); w.w = pk2(b[6] + v1[2] * g[6], b[7] + v1[3] * g[7]);
                    *(u32x4*)(O + row * DM + col) = w; } }
    }
};
struct EpiResid {
    static constexpr bool PERM = false, AFTER_DRAIN = false;
    const float* X; float* O;
    __device__ __forceinline__ void operator()(const f32x4 (&acc)[2][2][4][2], const Unit& u, int wr, int wc, int fr, int fq) const {
        const int row0 = u.pm * BM + wr * 64 + fr, col0 = u.pn * BM + wc * 32 + 4 * fq;
#pragma unroll
        for (int ai = 0; ai < 2; ++ai)
#pragma unroll
            for (int m = 0; m < 4; ++m) { const size_t off = (size_t)(row0 + ai * HALF + m * 16) * DM + col0;
#pragma unroll
                for (int bj = 0; bj < 2; ++bj)
#pragma unroll
                    for (int n = 0; n < 2; ++n) { const f32x4 b = *(const f32x4*)(X + off + bj * HALF + n * 16); *(f32x4*)(O + off + bj * HALF + n * 16) = b + acc[ai][bj][m][n]; } }
    }
};
struct EpiSwiglu {
    static constexpr bool PERM = true, AFTER_DRAIN = false;
    unsigned char* ACT; const float* b1; const float* row_rstd;
    __device__ __forceinline__ void operator()(const f32x4 (&acc)[2][2][4][2], const Unit& u, int wr, int wc, int fr, int fq) const {
        const int row0 = u.pm * BM + wr * 64 + fr, f0 = u.pn * HALF + wc * 32 + 8 * fq; const float* be = b1 + (size_t)u.e * 2048;
        const f32x4 bg0 = *(const f32x4*)(be + f0), bg1 = *(const f32x4*)(be + f0 + 4), bu0 = *(const f32x4*)(be + DFF + f0), bu1 = *(const f32x4*)(be + DFF + f0 + 4);
        float rsv[8];
#pragma unroll
        for (int i = 0; i < 8; ++i) rsv[i] = row_rstd[u.rb + wr * 64 + fr + (i >> 2) * HALF + (i & 3) * 16] * W8_INV;
#pragma unroll
        for (int ai = 0; ai < 2; ++ai)
#pragma unroll
            for (int m = 0; m < 4; ++m) { const size_t row = (size_t)(row0 + ai * HALF + m * 16); float o[8]; const float rs = rsv[ai * 4 + m];
#pragma unroll
                for (int n = 0; n < 2; ++n) { const f32x4 g4 = acc[ai][0][m][n] * rs + (n ? bg1 : bg0), u4 = acc[ai][1][m][n] * rs + (n ? bu1 : bu0);
#pragma unroll
                    for (int j = 0; j < 4; ++j) { const float g = fminf(g4[j], 7.f), uu = fminf(fmaxf(u4[j], -7.f), 7.f); o[4 * n + j] = (uu + 1.f) * (g * sigmoidf_(1.702f * g)); } }
                u32x2 w; w.x = pk4_fp8(o[0], o[1], o[2], o[3]); w.y = pk4_fp8(o[4], o[5], o[6], o[7]); *(u32x2*)(ACT + row * DFF + f0) = w; }
    }
};
struct EpiMoeOut {
    static constexpr bool PERM = true, AFTER_DRAIN = false;
    unsigned char* YS; const float* b2; const float* row_w; const int* row_slot;
    __device__ __forceinline__ void operator()(const f32x4 (&acc)[2][2][4][2], const Unit& u, int wr, int wc, int fr, int fq) const {
        const int col0 = u.pn * BM + wc * 32 + 8 * fq; const float* be = b2 + (size_t)u.e * DM; const int rbase = u.rb + wr * 64 + fr;
        int slot[8]; float w[8];
#pragma unroll
        for (int i = 0; i < 8; ++i) { const int row = rbase + (i >> 2) * HALF + (i & 3) * 16; slot[i] = row_slot[row]; w[i] = row_w[row] * (W8_INV * YS_SCALE); }
        f32x4 bv[2][2];
#pragma unroll
        for (int bj = 0; bj < 2; ++bj)
#pragma unroll
            for (int n = 0; n < 2; ++n) bv[bj][n] = *(const f32x4*)(be + col0 + bj * HALF + 4 * n) * W8_SCALE;
#pragma unroll
        for (int ai = 0; ai < 2; ++ai)
#pragma unroll
            for (int m = 0; m < 4; ++m) { const int i = ai * 4 + m;
                if (slot[i] >= 0) { unsigned char* rowp = YS + (size_t)slot[i] * DM + col0;
#pragma unroll
                    for (int bj = 0; bj < 2; ++bj) { const f32x4 v0 = (acc[ai][bj][m][0] + bv[bj][0]) * w[i], v1 = (acc[ai][bj][m][1] + bv[bj][1]) * w[i];
                        u32x2 o; o.x = pk4_fp8(v0[0], v0[1], v0[2], v0[3]); o.y = pk4_fp8(v1[0], v1[1], v1[2], v1[3]); *(u32x2*)(rowp + bj * HALF) = o; } } }
    }
};
constexpr int MOE_MAXU = 12;
struct MoeOrder {
    StaticOrder so; const PG8_LAS int* utab; const PG8_LAS int* gtab;
    __device__ __forceinline__ bool next(int i, Unit& u) const { if (i >= MOE_MAXU || !so.next(i, u)) return false; const int v = __builtin_amdgcn_readfirstlane(utab[i]); u.e = v & 31; u.rb = (int)((unsigned)v >> 8); return true; }
    __device__ __forceinline__ void a_ready(const Unit&) const {}
    __device__ __forceinline__ void done(const Unit&) const {}
};
typedef int i32x4_t __attribute__((ext_vector_type(4))); typedef int i32x8_t __attribute__((ext_vector_type(8)));
__device__ __forceinline__ i32x8_t cat8(bf16x8 lo, bf16x8 hi) { return __builtin_shufflevector(__builtin_bit_cast(i32x4_t, lo), __builtin_bit_cast(i32x4_t, hi), 0, 1, 2, 3, 4, 5, 6, 7); }
__device__ __forceinline__ void mfma_fp8_inplace(f32x4& c, const i32x8_t a, const i32x8_t b) { asm volatile("s_nop 1\n\tv_mfma_f32_16x16x128_f8f6f4 %0, %1, %2, %0" : "+v"(c) : "v"(a), "v"(b)); }
__device__ __forceinline__ void mfma_fp8_drain() { asm volatile("s_nop 15\n\ts_nop 7" ::: "memory"); __builtin_amdgcn_sched_barrier(0); }
template <class Epi, class Sched, bool ALIGN_EPI = false, bool SP2 = false, bool FP8 = false, bool GATHER = false>
__device__ __forceinline__ void gemm_phase(PG8_LAS unsigned char* lds, const Gemm g, const Sched& S, const Epi& E) {
    int tid = threadIdx.x; asm volatile("" : "+v"(tid));
    const int wid = __builtin_amdgcn_readfirstlane(tid >> 6), lane = tid & 63, wr = wid >> 2, wc = wid & 3, fr = lane & 15, fq = lane >> 4;
    const int K = g.K, nt = K / BK;
    static_assert(!GATHER || SP2, "GATHER is implemented for the SP2 loop only");
    const unsigned rowA = (unsigned)(g.lda ? g.lda : K) * 2u;
    unsigned voffA[2], voffB[2]; int gR0 = 0; unsigned gC = 0u;
#pragma unroll
    for (int i = 0; i < 2; ++i) { int R, C; stage_rc(tid * 16 + i * 8192, R, C); const int Rb = Epi::PERM ? ((R & ~31) + perm32(R & 31)) : R;
        voffA[i] = (unsigned)R * rowA + (unsigned)C * 2u; voffB[i] = (unsigned)(Rb * K + C) * 2u; if (i == 0) { gR0 = R; gC = (unsigned)C * 2u; } }
    unsigned gA[2][2] = {{0u, 0u}, {0u, 0u}}, ngA[2][2] = {{0u, 0u}, {0u, 0u}};
#define PG8_GLOAD(dst, ui_) do { _Pragma("unroll") for (int h_ = 0; h_ < 2; ++h_) _Pragma("unroll") for (int i_ = 0; i_ < 2; ++i_) \
        dst[h_][i_] = (unsigned)S.gtab[(ui_) * 256 + 128 * h_ + gR0 + 64 * i_] * rowA + gC; } while (0)
#define PG8_VA(h) (GATHER ? gA[h] : voffA)
    const unsigned kstep = (unsigned)(BK * 2);
    const unsigned hstep = (unsigned)HALF * (unsigned)K * 2u;
    const unsigned tstep = 2u * hstep;
    const unsigned hstepA = (unsigned)HALF * rowA, tstepA = 2u * hstepA;
    const unsigned hsA = GATHER ? 0u : hstepA;
    const unsigned ldsw = (unsigned)wid * 1024u;
    const int aoff = lds_byte(wr * 64 + fr, fq * 8), boff = lds_byte(wc * 32 + fr, fq * 8);
#define PG8_SA(b, h) (((b) * 2 + (h)) * HTB)
#define PG8_SB(b, h) ((4 + (b) * 2 + (h)) * HTB)
#define PG8_STAGE(rs, bufoff, goff, voff) do { _Pragma("unroll") for (int _i = 0; _i < 2; ++_i) \
        __builtin_amdgcn_raw_ptr_buffer_load_lds(rs, (PG8_LAS void*)(lds + (bufoff) + ldsw + _i * 8192), 16, (int)(voff)[_i], (int)(goff), 0, 0); } while (0)
#define PG8_LDA(dst, b, h) do { _Pragma("unroll") for (int m = 0; m < 4; ++m) _Pragma("unroll") for (int k = 0; k < 2; ++k) dst[m][k] = *(const PG8_LAS bf16x8*)(lds + PG8_SA(b, h) + aoff + m * 2048 + k * 1024); } while (0)
#define PG8_LDB(dst, b, h) do { _Pragma("unroll") for (int n = 0; n < 2; ++n) _Pragma("unroll") for (int k = 0; k < 2; ++k) dst[n][k] = *(const PG8_LAS bf16x8*)(lds + PG8_SB(b, h) + boff + n * 2048 + k * 1024); } while (0)
#define PG8_MMA(ai, bj, At, Bt) do { __builtin_amdgcn_s_setprio(1); _Pragma("unroll") for (int m = 0; m < 4; ++m) _Pragma("unroll") for (int n = 0; n < 2; ++n) { \
        if constexpr (FP8) { mfma_fp8_inplace(acc[ai][bj][m][n], cat8(Bt[n][0], Bt[n][1]), cat8(At[m][0], At[m][1])); } \
        else { _Pragma("unroll") for (int k = 0; k < 2; ++k) acc[ai][bj][m][n] = __builtin_amdgcn_mfma_f32_16x16x32_bf16(Bt[n][k], At[m][k], acc[ai][bj][m][n], 0, 0, 0); } } \
        __builtin_amdgcn_s_setprio(0); } while (0)
#define PG8_WAIT_V(n) asm volatile("s_waitcnt vmcnt(" #n ")" ::: "memory")
#define PG8_WAIT_L(n) asm volatile("s_waitcnt lgkmcnt(" #n ")" ::: "memory")
#define PG8_BAR __builtin_amdgcn_s_barrier()
#define PG8_SCHED __builtin_amdgcn_sched_barrier(0)
    Unit cur, nxt; int ui = 0;
    if (!S.next(0, cur)) return;
    f32x4 acc[2][2][4][2];
#pragma unroll
    for (int a = 0; a < 2; ++a)
#pragma unroll
        for (int b = 0; b < 2; ++b)
#pragma unroll
            for (int m = 0; m < 4; ++m)
#pragma unroll
                for (int n = 0; n < 2; ++n) acc[a][b][m][n] = (f32x4){0.f, 0.f, 0.f, 0.f};
    bf16x8 At[4][2], B0[2][2], B1[2][2];
    unsigned cA = GATHER ? 0u : (unsigned)cur.pm * tstepA, cB = (unsigned)cur.e * (unsigned)g.bstride + (unsigned)cur.pn * tstep;
    const __amdgpu_buffer_rsrc_t rsA = __builtin_amdgcn_make_buffer_rsrc((void*)g.A, 0, 0x7fffffff, 0x00020000), rsB = __builtin_amdgcn_make_buffer_rsrc((void*)g.Bt, 0, 0x7fffffff, 0x00020000);
    S.a_ready(cur);
    if constexpr (GATHER) PG8_GLOAD(gA, 0);
    if constexpr (SP2) {
        PG8_STAGE(rsB, PG8_SB(0, 0), cB, voffB); PG8_STAGE(rsB, PG8_SB(0, 1), cB + hstep, voffB); PG8_STAGE(rsA, PG8_SA(0, 0), cA, PG8_VA(0)); PG8_STAGE(rsA, PG8_SA(0, 1), cA + hsA, PG8_VA(1));
        if (wr == 1) PG8_BAR;
        PG8_WAIT_V(2); PG8_BAR;
        PG8_STAGE(rsB, PG8_SB(1, 0), cB + kstep, voffB); PG8_STAGE(rsA, PG8_SA(1, 0), cA + kstep, PG8_VA(0)); PG8_STAGE(rsB, PG8_SB(1, 1), cB + hstep + kstep, voffB);
        PG8_WAIT_V(6); PG8_BAR;
    } else {
        PG8_STAGE(rsB, PG8_SB(0, 0), cB, voffB); PG8_STAGE(rsA, PG8_SA(0, 0), cA, PG8_VA(0)); PG8_STAGE(rsB, PG8_SB(0, 1), cB + hstep, voffB); PG8_STAGE(rsA, PG8_SA(0, 1), cA + hsA, PG8_VA(1));
        if (wr == 1) PG8_BAR;
        PG8_WAIT_V(4); PG8_BAR;
        PG8_STAGE(rsB, PG8_SB(1, 0), cB + kstep, voffB); PG8_STAGE(rsA, PG8_SA(1, 0), cA + kstep, PG8_VA(0)); PG8_STAGE(rsB, PG8_SB(1, 1), cB + hstep + kstep, voffB);
        PG8_WAIT_V(6); PG8_BAR;
    }
    for (;;) {
        const bool has_next = S.next(ui + 1, nxt);
        if constexpr (GATHER) { if (has_next) PG8_GLOAD(ngA, ui + 1); else { ngA[0][0] = gA[0][0]; ngA[0][1] = gA[0][1]; ngA[1][0] = gA[1][0]; ngA[1][1] = gA[1][1]; } }
        const unsigned nA = (has_next && !GATHER) ? (unsigned)nxt.pm * tstepA : cA, nB = has_next ? (unsigned)nxt.e * (unsigned)g.bstride + (unsigned)nxt.pn * tstep : cB;
        for (int t = 0; t < nt; t += 2) {
            const bool last = (t == nt - 2);
            const unsigned a1 = cA + (unsigned)(t + 1) * kstep;
            const unsigned a2 = last ? nA : cA + (unsigned)(t + 2) * kstep, b2 = last ? nB : cB + (unsigned)(t + 2) * kstep;
            const unsigned a3 = a2 + kstep, b3 = b2 + kstep;
            if (last && has_next) S.a_ready(nxt);
            if constexpr (SP2) {
            PG8_LDB(B0, 0, 0); PG8_LDB(B1, 0, 1); PG8_SCHED; PG8_LDA(At, 0, 0); PG8_STAGE(rsA, PG8_SA(1, 1), a1 + hsA, PG8_VA(1));
            if constexpr (GATHER) { if (last) { gA[0][0] = ngA[0][0]; gA[0][1] = ngA[0][1]; gA[1][0] = ngA[1][0]; gA[1][1] = ngA[1][1]; } }
            PG8_WAIT_V(8); PG8_WAIT_L(0); PG8_BAR; PG8_MMA(0, 0, At, B0); PG8_MMA(0, 1, At, B1); PG8_BAR; PG8_SCHED;
            PG8_LDA(At, 0, 1); PG8_STAGE(rsB, PG8_SB(0, 0), b2, voffB); PG8_STAGE(rsB, PG8_SB(0, 1), b2 + hstep, voffB); PG8_STAGE(rsA, PG8_SA(0, 0), a2, PG8_VA(0));
            PG8_WAIT_V(8); PG8_WAIT_L(0); PG8_BAR; PG8_MMA(1, 0, At, B0); PG8_MMA(1, 1, At, B1); PG8_BAR; PG8_SCHED;
            PG8_LDB(B0, 1, 0); PG8_LDB(B1, 1, 1); PG8_SCHED; PG8_LDA(At, 1, 0); PG8_STAGE(rsA, PG8_SA(0, 1), a2 + hsA, PG8_VA(1));
            PG8_WAIT_V(8); PG8_WAIT_L(0); PG8_BAR; PG8_MMA(0, 0, At, B0); PG8_MMA(0, 1, At, B1); PG8_BAR; PG8_SCHED;
            PG8_LDA(At, 1, 1); PG8_STAGE(rsB, PG8_SB(1, 0), b3, voffB); PG8_STAGE(rsB, PG8_SB(1, 1), b3 + hstep, voffB); PG8_STAGE(rsA, PG8_SA(1, 0), a3, PG8_VA(0));
            PG8_WAIT_V(8); PG8_WAIT_L(0); PG8_BAR; PG8_MMA(1, 0, At, B0); PG8_MMA(1, 1, At, B1); PG8_BAR; PG8_SCHED;
            } else {
            PG8_LDB(B0, 0, 0); PG8_SCHED; PG8_LDA(At, 0, 0); PG8_STAGE(rsA, PG8_SA(1, 1), a1 + hsA, PG8_VA(1));
            PG8_WAIT_L(8); PG8_BAR; PG8_WAIT_L(0); PG8_MMA(0, 0, At, B0); PG8_BAR; PG8_SCHED;
            PG8_LDB(B1, 0, 1); PG8_STAGE(rsB, PG8_SB(0, 0), b2, voffB);
            PG8_BAR; PG8_WAIT_L(0); PG8_MMA(0, 1, At, B1); PG8_BAR;
            PG8_LDA(At, 0, 1); PG8_STAGE(rsA, PG8_SA(0, 0), a2, PG8_VA(0));
            PG8_BAR; PG8_WAIT_L(0); PG8_MMA(1, 0, At, B0); PG8_BAR; PG8_SCHED;
            PG8_STAGE(rsB, PG8_SB(0, 1), b2 + hstep, voffB);
            PG8_WAIT_V(6); PG8_BAR; PG8_MMA(1, 1, At, B1); PG8_BAR;
            PG8_LDB(B0, 1, 0); PG8_SCHED; PG8_LDA(At, 1, 0); PG8_STAGE(rsA, PG8_SA(0, 1), a2 + hsA, PG8_VA(1));
            PG8_WAIT_L(8); PG8_BAR; PG8_WAIT_L(0); PG8_MMA(0, 0, At, B0); PG8_BAR; PG8_SCHED;
            PG8_LDB(B1, 1, 1); PG8_STAGE(rsB, PG8_SB(1, 0), b3, voffB);
            PG8_BAR; PG8_WAIT_L(0); PG8_MMA(0, 1, At, B1); PG8_BAR;
            PG8_LDA(At, 1, 1); PG8_STAGE(rsA, PG8_SA(1, 0), a3, PG8_VA(0));
            PG8_BAR; PG8_WAIT_L(0); PG8_MMA(1, 0, At, B0); PG8_BAR; PG8_SCHED;
            PG8_STAGE(rsB, PG8_SB(1, 1), b3 + hstep, voffB);
            PG8_WAIT_V(6); PG8_BAR; PG8_MMA(1, 1, At, B1); PG8_BAR;
            }
        }
        if constexpr (ALIGN_EPI) { if (wr == 0) PG8_BAR; }
        if constexpr (FP8) mfma_fp8_drain();
        if constexpr (!Epi::AFTER_DRAIN) { E(acc, cur, wr, wc, fr, fq); S.done(cur); }
        if (!has_next) break;
#pragma unroll
        for (int a = 0; a < 2; ++a)
#pragma unroll
            for (int b = 0; b < 2; ++b)
#pragma unroll
                for (int m = 0; m < 4; ++m)
#pragma unroll
                    for (int n = 0; n < 2; ++n) acc[a][b][m][n] = (f32x4){0.f, 0.f, 0.f, 0.f};
        cur = nxt; cA = nA; cB = nB; ++ui;
        if constexpr (ALIGN_EPI) { if (wr == 1) PG8_BAR; }
    }
    PG8_WAIT_V(0);
    if constexpr (!ALIGN_EPI) { if (wr == 0) PG8_BAR; }
    PG8_BAR;
    if constexpr (Epi::AFTER_DRAIN) { E.fused(acc, cur, wr, wc, fr, fq, lds, wid, lane); S.done(cur); }
#undef PG8_SA
#undef PG8_GLOAD
#undef PG8_VA
#undef PG8_SB
#undef PG8_STAGE
#undef PG8_LDA
#undef PG8_LDB
#undef PG8_MMA
#undef PG8_WAIT_V
#undef PG8_WAIT_L
#undef PG8_BAR
#undef PG8_SCHED
}
}

#define GAS __attribute__((address_space(1)))
#define LAS __attribute__((address_space(3)))
#define XB_TMO      128
#define XB_XCNT(j)  (256  + 64 * (j))
#define XB_XSUB(j)  (1280 + 64 * (j))
#define XB_XGEN(j)  (2304 + 64 * (j))
#define XB_TOP      3328
#define XB_TOPGEN   3392
#define XCD_BAR_WORDS 3456
#define XB_SPIN_CAP (1u << 18)

__device__ __forceinline__ unsigned xb_ld(unsigned* p)              { return __hip_atomic_load(p, __ATOMIC_RELAXED, __HIP_MEMORY_SCOPE_AGENT); }
__device__ __forceinline__ unsigned xb_add(unsigned* p, unsigned v) { return __hip_atomic_fetch_add(p, v, __ATOMIC_RELAXED, __HIP_MEMORY_SCOPE_AGENT); }
__device__ __forceinline__ unsigned xb_xcc_id() { return (unsigned)__builtin_amdgcn_s_getreg((3 << 11) | 20) & 0xFu; }
#define XB_SPIN(cond, bar) do { unsigned _sp = 0; while (cond) { __builtin_amdgcn_s_sleep(1); \
    if ((++_sp & 255u) == 0u) { if (xb_ld(&(bar)[XB_TMO])) break; if (_sp > XB_SPIN_CAP) { atomicAdd(&(bar)[XB_TMO], 1u); break; } } } } while (0)

struct XcdBarrier {
    unsigned* bar; unsigned x;
    volatile LAS unsigned* st;
};

__device__ __forceinline__ XcdBarrier xcd_barrier_post(unsigned* bar, volatile LAS unsigned* st) {
    XcdBarrier b; b.bar = bar; b.x = xb_xcc_id(); b.st = st;
    if (threadIdx.x == 0) (void)xb_add(&bar[XB_XCNT(b.x)], 1u);
    return b;
}
__device__ __forceinline__ void xcd_barrier_complete(unsigned* bar, unsigned x, unsigned& nloc, unsigned& nx) {
    const unsigned G = gridDim.x * gridDim.y * gridDim.z;
    unsigned sum, cnt, mine, sp = 0u;
    for (;;) {
        sum = 0u; cnt = 0u; mine = 0u;
#pragma unroll
        for (unsigned j = 0; j < 16; ++j) { const unsigned c = xb_ld(&bar[XB_XCNT(j)]); sum += c; cnt += (c > 0u) ? 1u : 0u; mine = (j == x) ? c : mine; }
        if (sum == G) break;
        __builtin_amdgcn_s_sleep(1);
        if ((++sp & 255u) == 0u) { if (xb_ld(&bar[XB_TMO])) break; if (sp > XB_SPIN_CAP) { atomicAdd(&bar[XB_TMO], 1u); break; } }
    }
    nloc = mine > 0u ? mine : 1u; nx = cnt > 0u ? cnt : 1u;
}

__device__ __forceinline__ void xcd_barrier(const XcdBarrier& b) {
    asm volatile("s_waitcnt vmcnt(0)" ::: "memory");
    __syncthreads();
    if (threadIdx.x == 0) {
        unsigned* bar = b.bar;
        __builtin_amdgcn_s_waitcnt(0);
        unsigned nloc = b.st[0], nx = b.st[1];
        if (nloc == 0u) { xcd_barrier_complete(bar, b.x, nloc, nx); b.st[0] = nloc; b.st[1] = nx; }
        const unsigned old = xb_add(&bar[XB_XSUB(b.x)], 1u);
        const unsigned gen = old / nloc;
        if (old + 1u == (gen + 1u) * nloc) {
            __builtin_amdgcn_fence(__ATOMIC_RELEASE, "agent");
            asm volatile("s_waitcnt vmcnt(0)" ::: "memory");
            const unsigned og = xb_add(&bar[XB_TOP], 1u);
            const unsigned tg = og / nx;
            if (og + 1u == (tg + 1u) * nx) xb_add(&bar[XB_TOPGEN], 1u);
            else XB_SPIN(xb_ld(&bar[XB_TOPGEN]) == tg, bar);
            __builtin_amdgcn_fence(__ATOMIC_ACQUIRE, "agent");
            xb_add(&bar[XB_XGEN(b.x)], 1u);
            asm volatile("s_waitcnt vmcnt(0)" ::: "memory");
        } else {
            XB_SPIN(xb_ld(&bar[XB_XGEN(b.x)]) == gen, bar);
            __builtin_amdgcn_fence(__ATOMIC_ACQUIRE, "agent");
            asm volatile("s_waitcnt vmcnt(0)" ::: "memory");
        }
    }
    __syncthreads();
}

template <int MODE  >
__device__ __forceinline__ void transpose_item(const float* __restrict__ W, int K, int N, bf16_t* __restrict__ WT, const float* __restrict__ gain, float* scr, int item, int lane) {
    const int nblk = N / 32, kb = item / nblk, nb = item % nblk, k0 = 64 * kb, n0 = 32 * nb;
#pragma unroll
    for (int i = 0; i < 8; ++i) { const int kk = 8 * i + (lane >> 3), n4 = (lane & 7) * 4; f32x4 v = *(const f32x4*)(W + (size_t)(k0 + kk) * N + n0 + n4);
        if (gain) { const float g = gain[k0 + kk]; v = v * g; }
        float* s = scr + kk * 33 + n4; s[0] = v[0]; s[1] = v[1]; s[2] = v[2]; s[3] = v[3]; }
    asm volatile("s_waitcnt lgkmcnt(0)" ::: "memory");
    const int c = lane & 7;
#pragma unroll
    for (int j = 0; j < 4; ++j) { const int n = (lane >> 3) + 8 * j; const float* s = scr + (8 * c) * 33 + n;
        u32x4 o; o.x = pk2(s[0 * 33], s[1 * 33]); o.y = pk2(s[2 * 33], s[3 * 33]); o.z = pk2(s[4 * 33], s[5 * 33]); o.w = pk2(s[6 * 33], s[7 * 33]);
        int row = n0 + n;
        if (MODE == 1) { const int f = row & 1023; row = ((f >> 7) << 8) + ((row >> 10) << 7) + (f & 127); }
        if (MODE == 2) { const int hh = row / DQK; row = hh * 128 + (row - hh * DQK); }
        *(u32x4*)(WT + (size_t)row * K + k0 + 8 * c) = o; }
    asm volatile("s_waitcnt lgkmcnt(0)" ::: "memory");
}
template <int MODE>
__device__ __forceinline__ void transpose_item_fp8(const float* __restrict__ W, int K, int N, unsigned char* __restrict__ WT, float* scr, int item, int lane) {
    const int nblk = N / 32, kb = item / nblk, nb = item % nblk, k0 = 64 * kb, n0 = 32 * nb;
#pragma unroll
    for (int i = 0; i < 8; ++i) { const int kk = 8 * i + (lane >> 3), n4 = (lane & 7) * 4; const f32x4 v = *(const f32x4*)(W + (size_t)(k0 + kk) * N + n0 + n4) * W8_SCALE;
        float* s = scr + kk * 33 + n4; s[0] = v[0]; s[1] = v[1]; s[2] = v[2]; s[3] = v[3]; }
    asm volatile("s_waitcnt lgkmcnt(0)" ::: "memory");
    const int c = lane & 7;
#pragma unroll
    for (int j = 0; j < 4; ++j) { const int n = (lane >> 3) + 8 * j; const float* s = scr + (8 * c) * 33 + n;
        u32x2 o; o.x = pk4_fp8(s[0 * 33], s[1 * 33], s[2 * 33], s[3 * 33]); o.y = pk4_fp8(s[4 * 33], s[5 * 33], s[6 * 33], s[7 * 33]);
        int row = n0 + n;
        if (MODE == 1) { const int f = row & 1023; row = ((f >> 7) << 8) + ((row >> 10) << 7) + (f & 127); }
        *(u32x2*)(WT + (size_t)row * K + k0 + 8 * c) = o; }
    asm volatile("s_waitcnt lgkmcnt(0)" ::: "memory");
}
__device__ __forceinline__ void phase_prologue(const Params& p, unsigned char* lds) {
    const int tid = threadIdx.x, lane = tid & 63, wave = tid >> 6;
    float* scr = (float*)(lds + wave * 16384);
    const int gw = blockIdx.x * NWAVES + wave, NGW = gridDim.x * NWAVES;
    unsigned char* ws = p.ws;
    constexpr int I_WIN = (DM / 64) * (INC / 32), I_UQ = (QLORA / 64) * (768 / 32), I_UKV = (KVLORA / 64) * (1024 / 32), I_OM = (512 / 64) * (DM / 32), I_OC = I_OM, I_WO = (DM / 64) * (DM / 32);
    constexpr int I_W1 = (DM / 64) * (2048 / 32), I_W2 = (DFF / 64) * (DM / 32);
    constexpr int NSMALL = I_WIN + I_UQ + I_UKV + I_OM + I_OC + I_WO;
    constexpr int NITEMS = NSMALL;
    for (int it = gw; it < NITEMS; it += NGW) {
        int r = it;
        if (r < I_WIN) { transpose_item<0>(p.w_in, DM, INC, (bf16_t*)(ws + WS_WIN), p.norm1_g, scr, r, lane); continue; } r -= I_WIN;
        if (r < I_UQ) { transpose_item<2>(p.w_uq, QLORA, 768, (bf16_t*)(ws + WS_WUQ), p.q_a_g, scr, r, lane); continue; } r -= I_UQ;
        if (r < I_UKV) { transpose_item<0>(p.w_ukv, KVLORA, 1024, (bf16_t*)(ws + WS_WUKV), p.kv_a_g, scr, r, lane); continue; } r -= I_UKV;
        if (r < I_OM) { transpose_item<0>(p.w_o_mla, 512, DM, (bf16_t*)(ws + WS_WOMLA), nullptr, scr, r, lane); continue; } r -= I_OM;
        if (r < I_OC) { transpose_item<0>(p.w_o_conv, 512, DM, (bf16_t*)(ws + WS_WOCONV), nullptr, scr, r, lane); continue; } r -= I_OC;
        transpose_item<0>(p.w_o, DM, DM, (bf16_t*)(ws + WS_WO), nullptr, scr, r, lane);
    }
    { u32x4* z = (u32x4*)((bf16_t*)(ws + WS_WIN) + (size_t)INC * DM); const int nz = (INCP - INC) * DM * 2 / 16;
      for (int i = blockIdx.x * NTHREADS + tid; i < nz; i += gridDim.x * NTHREADS) z[i] = (u32x4){0u, 0u, 0u, 0u}; }
    { u32x4* wq = (u32x4*)(ws + WS_WUQ); for (int i = blockIdx.x * NTHREADS + tid; i < NH * 32 * QLORA * 2 / 16; i += gridDim.x * NTHREADS) { const int hh = i / (32 * QLORA * 2 / 16), q = i - hh * (32 * QLORA * 2 / 16); wq[(hh * 128 + 96) * (QLORA * 2 / 16) + q] = (u32x4){0u, 0u, 0u, 0u}; } }
    { float* sq = (float*)(ws + WS_SSQ); for (int i = blockIdx.x * NTHREADS + tid; i < 3 * NTOK; i += gridDim.x * NTHREADS) sq[i] = 0.f; }
    { float* csd = (float*)(ws + WS_CS); for (int i = blockIdx.x * NTHREADS + tid; i < NTOK * 16; i += gridDim.x * NTHREADS) { const int t = i >> 4, j = i & 15; float sn, cn; sincosf((float)p.pos[t] * exp2f(-(float)j * (13.287712379549449f / 16.f)), &sn, &cn); csd[t * 32 + j] = cn; csd[t * 32 + 16 + j] = sn; } }
    { int* rt = (int*)(ws + WS_RT2); int* rs = (int*)(ws + WS_RT2 + 4 * MiB); float* rr = (float*)(ws + WS_RT2 + 6 * MiB);
      for (int i = blockIdx.x * NTHREADS + tid; i < NE * CAP; i += gridDim.x * NTHREADS) { rt[i] = 0; rs[i] = -1; rr[i] = 0.f; } }
    { u32x4* GF = (u32x4*)(ws + WS_GF);
      for (int i = blockIdx.x * NTHREADS + tid; i < 64 * 64; i += gridDim.x * NTHREADS) { const int ks = i >> 6, ln = i & 63, r = ln & 31, h = ln >> 5; float v[8], lo[8]; unsigned hi[4];
#pragma unroll
          for (int j = 0; j < 8; ++j) { const int k = 16 * ks + 8 * h + j; v[j] = p.norm2_g[k] * p.router_w[(size_t)k * NE + r]; }
#pragma unroll
          for (int j = 0; j < 4; ++j) { hi[j] = pk2(v[2 * j], v[2 * j + 1]); lo[2 * j] = v[2 * j] - bf_lo(hi[j]); lo[2 * j + 1] = v[2 * j + 1] - bf_hi(hi[j]); }
          GF[(ks * 2 + 0) * 64 + ln] = (u32x4){hi[0], hi[1], hi[2], hi[3]}; GF[(ks * 2 + 1) * 64 + ln] = (u32x4){pk2(lo[0], lo[1]), pk2(lo[2], lo[3]), pk2(lo[4], lo[5]), pk2(lo[6], lo[7])}; } }
    bf16_t* XN = (bf16_t*)(ws + WS_XN);
    for (int m = gw; m < NTOK; m += NGW) {
        const f32x4* xr = (const f32x4*)(p.x + (size_t)m * DM) + lane; f32x4 v[4]; float s = 0.f;
#pragma unroll
        for (int j = 0; j < 4; ++j) { v[j] = xr[64 * j]; s += (v[j][0] * v[j][0] + v[j][1] * v[j][1]) + (v[j][2] * v[j][2] + v[j][3] * v[j][3]); }
        const float rstd = rsqrtf(wave_sum(s) * (1.f / DM) + EPS);
        u32x2* o = (u32x2*)(XN + (size_t)m * DM) + lane;
#pragma unroll
        for (int j = 0; j < 4; ++j) { u32x2 w; w.x = pk2(v[j][0] * rstd, v[j][1] * rstd); w.y = pk2(v[j][2] * rstd, v[j][3] * rstd); o[64 * j] = w; }
    }
}

struct ConvRaw { u32x4 u[3], c[3], bg; float m0, m2; };
__device__ __forceinline__ void conv_load(ConvRaw& r, const Params& p, int t, int lane) {
    const bf16_t* pr = (const bf16_t*)(p.ws + WS_PROJ) + (size_t)t * INCP; const int s = t & (SEQ - 1);
    r.m0 = s > 0 ? 1.f : 0.f; r.m2 = s < SEQ - 1 ? 1.f : 0.f;
    const bf16_t* pm = s > 0 ? pr - INCP : pr; const bf16_t* pp = s < SEQ - 1 ? pr + INCP : pr;
    r.u[0] = *(const u32x4*)(pm + OFF_U + 8 * lane); r.c[0] = *(const u32x4*)(pm + OFF_C + 8 * lane);
    r.u[1] = *(const u32x4*)(pr + OFF_U + 8 * lane); r.c[1] = *(const u32x4*)(pr + OFF_C + 8 * lane);
    r.u[2] = *(const u32x4*)(pp + OFF_U + 8 * lane); r.c[2] = *(const u32x4*)(pp + OFF_C + 8 * lane);
    r.bg = *(const u32x4*)(pr + OFF_B + 8 * lane);
}
__device__ __forceinline__ void mulpair8(const u32x4 u, const u32x4 c, float (&o)[8]) {
    o[0] = bf_lo(u.x) * bf_lo(c.x); o[1] = bf_hi(u.x) * bf_hi(c.x); o[2] = bf_lo(u.y) * bf_lo(c.y); o[3] = bf_hi(u.y) * bf_hi(c.y);
    o[4] = bf_lo(u.z) * bf_lo(c.z); o[5] = bf_hi(u.z) * bf_hi(c.z); o[6] = bf_lo(u.w) * bf_lo(c.w); o[7] = bf_hi(u.w) * bf_hi(c.w); }
__device__ __forceinline__ void conv_store(const ConvRaw& r, const Params& p, int t, int lane, const float (&cw0)[8], const float (&cw1)[8], const float (&cw2)[8]) {
    float cu0[8], cu1[8], cu2[8], bb[8], y[8]; mulpair8(r.u[0], r.c[0], cu0); mulpair8(r.u[1], r.c[1], cu1); mulpair8(r.u[2], r.c[2], cu2);
    bb[0] = bf_lo(r.bg.x); bb[1] = bf_hi(r.bg.x); bb[2] = bf_lo(r.bg.y); bb[3] = bf_hi(r.bg.y); bb[4] = bf_lo(r.bg.z); bb[5] = bf_hi(r.bg.z); bb[6] = bf_lo(r.bg.w); bb[7] = bf_hi(r.bg.w);
#pragma unroll
    for (int j = 0; j < 8; ++j) y[j] = bb[j] * (cw0[j] * r.m0 * cu0[j] + cw1[j] * cu1[j] + cw2[j] * r.m2 * cu2[j]);
    u32x4 o; o.x = pk2(y[0], y[1]); o.y = pk2(y[2], y[3]); o.z = pk2(y[4], y[5]); o.w = pk2(y[6], y[7]); *(u32x4*)((bf16_t*)(p.ws + WS_YBIN) + (size_t)t * CONVW + 8 * lane) = o;
}
__device__ __forceinline__ void phase_conv(const Params& p) {
    int tid = threadIdx.x; asm volatile("" : "+v"(tid)); const int lane = tid & 63, wave = tid >> 6;
    const int gw = blockIdx.x * NWAVES + wave, NGW = gridDim.x * NWAVES;
    float cw0[8], cw1[8], cw2[8];
#pragma unroll
    for (int j = 0; j < 8; ++j) { cw0[j] = p.conv_w[8 * lane + j]; cw1[j] = p.conv_w[CONVW + 8 * lane + j]; cw2[j] = p.conv_w[2 * CONVW + 8 * lane + j]; }
    for (int t = gw; t < NTOK; t += 2 * NGW) {
        const int t1 = t + NGW; const bool two = t1 < NTOK;
        ConvRaw r0, r1; conv_load(r0, p, t, lane); conv_load(r1, p, two ? t1 : t, lane);
        conv_store(r0, p, t, lane, cw0, cw1, cw2);
        if (two) conv_store(r1, p, t1, lane, cw0, cw1, cw2);
    }
}

constexpr int WC_EXP_ITEMS = NE * 1536, WC_TILE_F = 32 * 68;
struct WcItem { const float* W; unsigned char* WT; int N, k0, n0, mode; };
__device__ __forceinline__ WcItem wc_decode(const Params& p, int x) {
    WcItem it; const int e = x / 1536, r = x - e * 1536;
    if (r < 1024) { it.W = p.w1 + (size_t)e * DM * 2048; it.WT = p.ws + WS_W1 + (size_t)e * 2048 * DM; it.N = 2048; it.k0 = 64 * (r >> 6); it.n0 = 32 * (r & 63); it.mode = 1; }
    else { const int q = r - 1024; it.W = p.w2 + (size_t)e * DFF * DM; it.WT = p.ws + WS_W2 + (size_t)e * DM * DFF; it.N = DM; it.k0 = 64 * (q >> 5); it.n0 = 32 * (q & 31); it.mode = 0; }
    return it;
}
struct WConv { float* tile; int x0, nitems, cs; f32x4 pend; };
__device__ __forceinline__ void wconv_step(WConv& c, const Params& p, int lane) {
    const int cs = c.cs, nst = 8 * c.nitems;
    if (cs > 0 && cs <= nst) {
        const int kk = 8 * ((cs - 1) & 7) + (lane >> 3), n4 = (lane & 7) * 4; float* t = c.tile + n4 * 68 + kk;
        t[0] = c.pend[0] * W8_SCALE; t[68] = c.pend[1] * W8_SCALE; t[136] = c.pend[2] * W8_SCALE; t[204] = c.pend[3] * W8_SCALE;
        if ((cs & 7) == 0) {
            const WcItem it = wc_decode(p, c.x0 + (cs >> 3) - 1); const int c8 = lane & 7;
#pragma unroll
            for (int j = 0; j < 4; ++j) { const int n = (lane >> 3) + 8 * j; const f32x4 a = *(const f32x4*)(c.tile + n * 68 + 8 * c8), b = *(const f32x4*)(c.tile + n * 68 + 8 * c8 + 4);
                u32x2 o; o.x = pk4_fp8(a[0], a[1], a[2], a[3]); o.y = pk4_fp8(b[0], b[1], b[2], b[3]);
                int row = it.n0 + n; if (it.mode == 1) { const int f = row & 1023; row = ((f >> 7) << 8) + ((row >> 10) << 7) + (f & 127); }
                *(u32x2*)(it.WT + (size_t)row * DM + it.k0 + 8 * c8) = o; }
        }
    }
    if (cs < nst) {
        const WcItem it = wc_decode(p, c.x0 + (cs >> 3)); const int kk = 8 * (cs & 7) + (lane >> 3), n4 = (lane & 7) * 4;
        c.pend = *(const f32x4*)(it.W + (size_t)(it.k0 + kk) * it.N + it.n0 + n4);
    }
    c.cs = cs + 1;
}

namespace att {
constexpr int NW = 8, QBLK = 32, KVBLK = 64;
constexpr float SCALE = 0.10206207261596575f;
constexpr float QSC = SCALE * 1.4426950408889634f;
constexpr int LDQ = DQK, LDK = 128, LDV = DV;
constexpr int SHM_V = KVBLK * DV * 2, SHM_K = KVBLK * 256, SHM_ATTN = 2 * SHM_V + 2 * SHM_K + NW * 64 * 4;
#define KSWZ(row, colB) ((row) * 256 + ((colB) ^ (((row) & 7) << 4)))
#define SBAR() __builtin_amdgcn_sched_barrier(0)
__device__ __forceinline__ int crow(int r, int hi) { return (r & 3) + 8 * (r >> 2) + 4 * hi; }
__device__ __forceinline__ float fadd_s(float a, float b) { float r; asm("v_add_f32_e32 %0, %1, %2" : "=v"(r) : "v"(a), "v"(b)); return r; }
__device__ __forceinline__ unsigned cvtpk(float lo, float hi) { unsigned r; asm volatile("v_cvt_pk_bf16_f32 %0, %1, %2" : "=v"(r) : "v"(lo), "v"(hi)); return r; }
#define EXPH(P) do { _Pragma("unroll") for (int r = 0; r < 16; ++r) P[r] = __builtin_amdgcn_exp2f(P[r]); } while (0)
__device__ __forceinline__ void finishSM(f32x16& p0, f32x16& p1, float& l_reg, bf16x8& pa0, bf16x8& pa1, bf16x8& pa2, bf16x8& pa3) {
    EXPH(p1);
    float ps0 = p0[0], ps1 = p1[0];
#pragma unroll
    for (int r = 1; r < 16; ++r) { ps0 = fadd_s(ps0, p0[r]); ps1 = fadd_s(ps1, p1[r]); }
    l_reg += ps0 + ps1;
#define PK4(P, BASE, OUT) do { unsigned a0 = cvtpk(P[BASE + 0], P[BASE + 1]), a1 = cvtpk(P[BASE + 2], P[BASE + 3]);   \
    unsigned b0 = cvtpk(P[BASE + 4], P[BASE + 5]), b1 = cvtpk(P[BASE + 6], P[BASE + 7]);                              \
    auto r0 = __builtin_amdgcn_permlane32_swap(a0, b0, false, false); auto r1 = __builtin_amdgcn_permlane32_swap(a1, b1, false, false); \
    u32x4 w = {r0[0], r1[0], r0[1], r1[1]}; OUT = *reinterpret_cast<bf16x8*>(&w); } while (0)
    PK4(p0, 0, pa0); PK4(p0, 8, pa1); PK4(p1, 0, pa2); PK4(p1, 8, pa3);
#undef PK4
}
__device__ __forceinline__ void qkt(f32x16& p0, f32x16& p1, const unsigned char* Ks, const bf16x8* qr, int r32, int hi) {
    p0 = f32x16{}; p1 = f32x16{};
#pragma unroll
    for (int d0 = 0; d0 < 6; ++d0) { const int cb = (d0 * 16 + hi * 8) * 2;
        const bf16x8 b0 = *reinterpret_cast<const bf16x8*>(Ks + KSWZ(r32, cb));
        const bf16x8 b1 = *reinterpret_cast<const bf16x8*>(Ks + KSWZ(32 + r32, cb));
        p0 = __builtin_amdgcn_mfma_f32_32x32x16_bf16(b0, qr[d0], p0, 0, 0, 0);
        p1 = __builtin_amdgcn_mfma_f32_32x32x16_bf16(b1, qr[d0], p1, 0, 0, 0); }
}
__device__ __forceinline__ int v_st(int k, int c) { const int kk = (k & ~0xC) | ((k & 4) << 1) | ((k & 8) >> 1); return ((kk >> 3) * 2 + (c >> 5)) * 512 + ((kk & 7) * 32 + (c & 31)) * 2; }
__device__ __forceinline__ int v_rd_base(int lane) { return ((lane & 3) << 3) | (((lane >> 2) & 3) << 6) | (((lane >> 4) & 1) << 5) | (((lane >> 5) & 1) << 8); }
constexpr int v_rd_off(int d0, int ks, int half) { return d0 * 512 + ks * 2048 + half * 1024; }
template <int OFF> __device__ __forceinline__ s16x4 tr_read(int vb) { s16x4 r; asm volatile("ds_read_b64_tr_b16 %0, %1 offset:%2" : "=&v"(r) : "v"(vb), "i"(OFF) : "memory"); return r; }
template <int D0> __device__ __forceinline__ void pv_one(f32x16& od, int vb, bf16x8 pa0, bf16x8 pa1, bf16x8 pa2, bf16x8 pa3) {
    const s16x4 l0 = tr_read<v_rd_off(D0, 0, 0)>(vb), h0 = tr_read<v_rd_off(D0, 0, 1)>(vb), l1 = tr_read<v_rd_off(D0, 1, 0)>(vb), h1 = tr_read<v_rd_off(D0, 1, 1)>(vb);
    const s16x4 l2 = tr_read<v_rd_off(D0, 2, 0)>(vb), h2 = tr_read<v_rd_off(D0, 2, 1)>(vb), l3 = tr_read<v_rd_off(D0, 3, 0)>(vb), h3 = tr_read<v_rd_off(D0, 3, 1)>(vb);
    asm volatile("s_waitcnt lgkmcnt(0)" ::: "memory"); SBAR();
#define PK(L, H) (bf16x8){L[0], L[1], L[2], L[3], H[0], H[1], H[2], H[3]}
    od = __builtin_amdgcn_mfma_f32_32x32x16_bf16(pa0, PK(l0, h0), od, 0, 0, 0);
    od = __builtin_amdgcn_mfma_f32_32x32x16_bf16(pa1, PK(l1, h1), od, 0, 0, 0);
    od = __builtin_amdgcn_mfma_f32_32x32x16_bf16(pa2, PK(l2, h2), od, 0, 0, 0);
    od = __builtin_amdgcn_mfma_f32_32x32x16_bf16(pa3, PK(l3, h3), od, 0, 0, 0);
#undef PK
}
__device__ __forceinline__ void pv_d0(f32x16* o, int vb, bf16x8 pa0, bf16x8 pa1, bf16x8 pa2, bf16x8 pa3) { pv_one<0>(o[0], vb, pa0, pa1, pa2, pa3); pv_one<1>(o[1], vb, pa0, pa1, pa2, pa3); }
struct VFrag { s16x4 l0, h0, l1, h1, l2, h2, l3, h3; };
template <int D0> __device__ __forceinline__ void vread(VFrag& f, int vb) {
    f.l0 = tr_read<v_rd_off(D0, 0, 0)>(vb); f.h0 = tr_read<v_rd_off(D0, 0, 1)>(vb); f.l1 = tr_read<v_rd_off(D0, 1, 0)>(vb); f.h1 = tr_read<v_rd_off(D0, 1, 1)>(vb);
    f.l2 = tr_read<v_rd_off(D0, 2, 0)>(vb); f.h2 = tr_read<v_rd_off(D0, 2, 1)>(vb); f.l3 = tr_read<v_rd_off(D0, 3, 0)>(vb); f.h3 = tr_read<v_rd_off(D0, 3, 1)>(vb); }
__device__ __forceinline__ void vmma(f32x16& od, const VFrag& f, bf16x8 pa0, bf16x8 pa1, bf16x8 pa2, bf16x8 pa3) {
#define PK(L, H) (bf16x8){L[0], L[1], L[2], L[3], H[0], H[1], H[2], H[3]}
    od = __builtin_amdgcn_mfma_f32_32x32x16_bf16(pa0, PK(f.l0, f.h0), od, 0, 0, 0);
    od = __builtin_amdgcn_mfma_f32_32x32x16_bf16(pa1, PK(f.l1, f.h1), od, 0, 0, 0);
    od = __builtin_amdgcn_mfma_f32_32x32x16_bf16(pa2, PK(f.l2, f.h2), od, 0, 0, 0);
    od = __builtin_amdgcn_mfma_f32_32x32x16_bf16(pa3, PK(f.l3, f.h3), od, 0, 0, 0);
#undef PK
}
#define EXPQ(P, B) do { _Pragma("unroll") for (int r = (B); r < (B) + 8; ++r) P[r] = __builtin_amdgcn_exp2f(P[r]); } while (0)
#define LWAIT() do { asm volatile("s_waitcnt lgkmcnt(0)" ::: "memory"); SBAR(); } while (0)
#define PV_STEP(vb, PN) do { LWAIT(); VFrag f1_; vread<1>(f1_, (vb)); vmma(o[0], f0, pa0, pa1, pa2, pa3); EXPQ(PN, 0); LWAIT(); vmma(o[1], f1_, pa0, pa1, pa2, pa3); EXPQ(PN, 8); SBAR(); } while (0)

__device__ __forceinline__ void attn_unit(const bf16_t* __restrict__ Qb, const bf16_t* __restrict__ Kh, const bf16_t* __restrict__ Vh, bf16_t* __restrict__ Ob, int seq, unsigned char* lds, WConv& wc, const Params& prm) {
    const int tid = threadIdx.x, wid = __builtin_amdgcn_readfirstlane(tid >> 6), lane = tid & 63, r32 = lane & 31, hi = lane >> 5;
    unsigned char* V_lds = lds; unsigned char* K_lds = lds + 2 * SHM_V;
    float* wsf = (float*)(lds + 2 * SHM_V + 2 * SHM_K) + wid * 64; float* li_l = wsf;
    float l_reg = 0; f32x16 o[2] = {}; bf16x8 qr[6];
    const bf16_t* Qw = Qb + (size_t)(wid * QBLK + r32) * LDQ + hi * 8;
#pragma unroll
    for (int d0 = 0; d0 < 6; ++d0) qr[d0] = *reinterpret_cast<const bf16x8*>(Qw + d0 * 16);
    const int kr0 = 8 * wid + (lane >> 4), kcp = lane & 15;
    const bf16_t* ksrc0 = Kh + (size_t)kr0 * LDK + ((kcp ^ (kr0 & 7)) * 8);
    const bf16_t* ksrc1 = Kh + (size_t)(kr0 + 4) * LDK + ((kcp ^ ((kr0 + 4) & 7)) * 8);
    const int vkk = 8 * wid + ((lane >> 2) & 7), vk = (vkk & ~0xC) | ((vkk & 4) << 1) | ((vkk & 8) >> 1), vcc = 32 * (lane >> 5) + 8 * (lane & 3);
    const bf16_t* vsrc = Vh + (size_t)vk * LDV + vcc;
    typedef __attribute__((address_space(3))) unsigned* lds_u32p;
#define DMA_K(t, slot) do { __builtin_amdgcn_global_load_lds((const unsigned*)(ksrc0 + (size_t)(t) * KVBLK * LDK), (lds_u32p)(K_lds + (slot) * SHM_K + wid * 2048 + lane * 16), 16, 0, 0); \
                            __builtin_amdgcn_global_load_lds((const unsigned*)(ksrc1 + (size_t)(t) * KVBLK * LDK), (lds_u32p)(K_lds + (slot) * SHM_K + wid * 2048 + 1024 + lane * 16), 16, 0, 0); } while (0)
#define DMA_V(t, slot) __builtin_amdgcn_global_load_lds((const unsigned*)(vsrc + (size_t)(t) * KVBLK * LDV), (lds_u32p)(V_lds + (slot) * SHM_V + wid * 1024 + lane * 16), 16, 0, 0)
    const int vb0 = (int)(uintptr_t)V_lds + v_rd_base(lane);
    f32x16 pA0, pA1, pB0, pB1; bf16x8 pa0, pa1, pa2, pa3; const int NT = seq / KVBLK;
    DMA_K(0, 0); DMA_V(0, 0); DMA_K(1, 1);
    asm volatile("s_waitcnt vmcnt(0)" ::: "memory"); __syncthreads();
    qkt(pA0, pA1, K_lds, qr, r32, hi); EXPH(pA0); SBAR();
    __syncthreads();
    VFrag f0;
    for (int j = 0; j + 2 < NT; j += 2) {
        DMA_K(j + 2, 0); DMA_V(j + 1, 1); wconv_step(wc, prm, lane); SBAR();
        vread<0>(f0, vb0);
        qkt(pB0, pB1, K_lds + SHM_K, qr, r32, hi);
        finishSM(pA0, pA1, l_reg, pa0, pa1, pa2, pa3); SBAR();
        PV_STEP(vb0, pB0);
        asm volatile("s_waitcnt vmcnt(0)" ::: "memory"); __syncthreads();
        DMA_K(j + 3, 1); DMA_V(j + 2, 0); wconv_step(wc, prm, lane); SBAR();
        vread<0>(f0, vb0 + SHM_V);
        qkt(pA0, pA1, K_lds, qr, r32, hi);
        finishSM(pB0, pB1, l_reg, pa0, pa1, pa2, pa3); SBAR();
        PV_STEP(vb0 + SHM_V, pA0);
        asm volatile("s_waitcnt vmcnt(0)" ::: "memory"); __syncthreads();
    }
    DMA_V(NT - 1, 1); wconv_step(wc, prm, lane); SBAR();
    vread<0>(f0, vb0);
    qkt(pB0, pB1, K_lds + SHM_K, qr, r32, hi);
    finishSM(pA0, pA1, l_reg, pa0, pa1, pa2, pa3); SBAR();
    PV_STEP(vb0, pB0);
    asm volatile("s_waitcnt vmcnt(0)" ::: "memory"); __syncthreads();
    finishSM(pB0, pB1, l_reg, pa0, pa1, pa2, pa3); SBAR();
    pv_d0(o, vb0 + SHM_V, pa0, pa1, pa2, pa3);
    { auto rr = __builtin_amdgcn_permlane32_swap(__float_as_uint(l_reg), __float_as_uint(l_reg), false, false); l_reg = __uint_as_float(rr[0]) + __uint_as_float(rr[1]); }
    if (hi == 0) li_l[r32] = l_reg; asm volatile("s_waitcnt lgkmcnt(0)" ::: "memory");
    float rli[16];
#pragma unroll
    for (int r = 0; r < 16; ++r) rli[r] = __builtin_amdgcn_rcpf(li_l[crow(r, hi)]);
    bf16_t* Ow = Ob + (size_t)(wid * QBLK) * 512;
#pragma unroll
    for (int r = 0; r < 16; ++r) { const int orow = crow(r, hi);
#pragma unroll
        for (int d0 = 0; d0 < 2; ++d0) Ow[(size_t)orow * 512 + d0 * 32 + r32] = (bf16_t)(pk2(o[d0][r] * rli[r], 0.f) & 0xffffu); }
    __syncthreads();
#undef DMA_K
#undef DMA_V
}
#undef KSWZ
#undef SBAR
}

__device__ __forceinline__ void phase_attn(const Params& p, unsigned char* lds) {
    const bf16_t* Q = (const bf16_t*)(p.ws + WS_Q); const bf16_t* Kb = (const bf16_t*)(p.ws + WS_K); const bf16_t* V = (const bf16_t*)(p.ws + WS_V); bf16_t* AO = (bf16_t*)(p.ws + WS_AO);
    constexpr int NQB = SEQ / 256, NU = 2 * NH * NQB;
    const int lane = threadIdx.x & 63, wave = __builtin_amdgcn_readfirstlane(threadIdx.x >> 6), gw = blockIdx.x * NWAVES + wave, NGW = gridDim.x * NWAVES;
    const int ipw = (WC_EXP_ITEMS + NGW - 1) / NGW, nun = ((int)blockIdx.x < NU) ? (NU - 1 - (int)blockIdx.x) / (int)gridDim.x + 1 : 0, steps = nun * (SEQ / att::KVBLK - 1);
    int cov = (steps - 1) / 8; cov = cov < 0 ? 0 : (cov > ipw ? ipw : cov);
    WConv wc; wc.tile = (float*)(lds + att::SHM_ATTN) + wave * WC_TILE_F; wc.x0 = gw * ipw; wc.cs = 0; wc.pend = (f32x4){0.f, 0.f, 0.f, 0.f};
    { const int left = WC_EXP_ITEMS - wc.x0; wc.nitems = left < 0 ? 0 : (left < cov ? left : cov); }
    if (wave >= 4) __builtin_amdgcn_s_setprio(1);
    const bool xmap = false;
    for (int u0 = blockIdx.x, rnd = 0; u0 < NU; u0 += gridDim.x, ++rnd) {
        const int u = xmap ? (((int)blockIdx.x & 7) + 8 * rnd) * NQB + ((int)blockIdx.x >> 3) : u0;
        const int qb = u % NQB, h = (u / NQB) % NH, b = u / (NQB * NH); const size_t bh = (size_t)(b * NH + h) * SEQ;
        att::attn_unit(Q + (bh + (size_t)qb * 256) * DQK, Kb + bh * 128, V + bh * DV, AO + ((size_t)b * SEQ + (size_t)qb * 256) * 512 + h * DV, SEQ, lds, wc, p);
    }
    __builtin_amdgcn_s_setprio(0);
    while (wc.cs <= 8 * wc.nitems) wconv_step(wc, p, lane);
}
__device__ __forceinline__ void wconv_cleanup(const Params& p, unsigned char* lds) {
    constexpr int NQB = SEQ / 256, NU = 2 * NH * NQB;
    const int lane = threadIdx.x & 63, wave = threadIdx.x >> 6, gw = blockIdx.x * NWAVES + wave, NGW = gridDim.x * NWAVES;
    const int ipw = (WC_EXP_ITEMS + NGW - 1) / NGW, nun = ((int)blockIdx.x < NU) ? (NU - 1 - (int)blockIdx.x) / (int)gridDim.x + 1 : 0, steps = nun * (SEQ / att::KVBLK - 1);
    int cov = (steps - 1) / 8; cov = cov < 0 ? 0 : (cov > ipw ? ipw : cov);
    float* scr = (float*)(lds + wave * 16384);
    for (int i = cov; i < ipw; ++i) { const int x = gw * ipw + i; if (x >= WC_EXP_ITEMS) break; const WcItem it = wc_decode(p, x); const int r = x % 1536;
        if (it.mode == 1) transpose_item_fp8<1>(it.W, DM, 2048, it.WT, scr, r, lane); else transpose_item_fp8<0>(it.W, DFF, DM, it.WT, scr, r - 1024, lane); }
    __syncthreads();
}

__device__ __forceinline__ int crow16(int r, int hi) { return (r & 3) + 8 * (r >> 2) + 4 * hi; }
__device__ __forceinline__ void phase_router(const Params& p, unsigned char* lds) {
    const int tid = threadIdx.x, lane = tid & 63, wid = tid >> 6, tile = wid >> 2, kq = wid & 3, c = lane & 31, h = lane >> 5;
    float* red = (float*)lds;
    float* ssb = red + 2 * 4 * 16 * 64;
    int* lcnt = (int*)(ssb + 2 * 4 * 64);
    int* lbase = lcnt + 32;
    unsigned* gcnt = (unsigned*)(p.ws + WS_CTL) + CW_CNT;
    int* row_tok = (int*)(p.ws + WS_RT2); float* row_w = (float*)(p.ws + WS_RT2 + 2 * MiB); int* row_slot = (int*)(p.ws + WS_RT2 + 4 * MiB); float* row_rstd = (float*)(p.ws + WS_RT2 + 6 * MiB);
    const u32x4* GF = (const u32x4*)(p.ws + WS_GF);
    for (int tg = blockIdx.x; tg < NTOK / 64; tg += gridDim.x) {
        if (tid < 32) lcnt[tid] = 0;
        const int token = tg * 64 + tile * 32 + c;
        const float* xrow = p.out + (size_t)token * DM + kq * 256 + 8 * h; const float* g2p = p.norm2_g + kq * 256 + 8 * h;
        unsigned char* hrow = p.ws + WS_H8 + (size_t)token * DM + kq * 256 + 8 * h;
        f32x16 acc = {}; float ss = 0.f;
#pragma unroll 2
        for (int s = 0; s < 16; ++s) {
            const f32x4 a = *(const f32x4*)(xrow + 16 * s), b = *(const f32x4*)(xrow + 16 * s + 4); const f32x4 ga = *(const f32x4*)(g2p + 16 * s), gb = *(const f32x4*)(g2p + 16 * s + 4);
            ss += (a[0] * a[0] + a[1] * a[1]) + (a[2] * a[2] + a[3] * a[3]) + (b[0] * b[0] + b[1] * b[1]) + (b[2] * b[2] + b[3] * b[3]);
            u32x4 xh; xh.x = pk2(a[0], a[1]); xh.y = pk2(a[2], a[3]); xh.z = pk2(b[0], b[1]); xh.w = pk2(b[2], b[3]);
            u32x4 xl; xl.x = pk2(a[0] - bf_lo(xh.x), a[1] - bf_hi(xh.x)); xl.y = pk2(a[2] - bf_lo(xh.y), a[3] - bf_hi(xh.y)); xl.z = pk2(b[0] - bf_lo(xh.z), b[1] - bf_hi(xh.z)); xl.w = pk2(b[2] - bf_lo(xh.w), b[3] - bf_hi(xh.w));
            u32x2 h8; h8.x = pk4_fp8(a[0] * ga[0], a[1] * ga[1], a[2] * ga[2], a[3] * ga[3]); h8.y = pk4_fp8(b[0] * gb[0], b[1] * gb[1], b[2] * gb[2], b[3] * gb[3]); *(u32x2*)(hrow + 16 * s) = h8;
            const u32x4 gh = GF[((kq * 16 + s) * 2 + 0) * 64 + lane], gl = GF[((kq * 16 + s) * 2 + 1) * 64 + lane];
            acc = __builtin_amdgcn_mfma_f32_32x32x16_bf16(__builtin_bit_cast(bf16x8, gh), __builtin_bit_cast(bf16x8, xh), acc, 0, 0, 0);
            acc = __builtin_amdgcn_mfma_f32_32x32x16_bf16(__builtin_bit_cast(bf16x8, gh), __builtin_bit_cast(bf16x8, xl), acc, 0, 0, 0);
            acc = __builtin_amdgcn_mfma_f32_32x32x16_bf16(__builtin_bit_cast(bf16x8, gl), __builtin_bit_cast(bf16x8, xh), acc, 0, 0, 0);
        }
#pragma unroll
        for (int r = 0; r < 16; ++r) red[((tile * 4 + kq) * 16 + r) * 64 + lane] = acc[r];
        ssb[(tile * 4 + kq) * 64 + lane] = ss;
        __syncthreads();
        int te[4] = {0, 0, 0, 0}, rl[4] = {0, 0, 0, 0}; float tw[4] = {0.f, 0.f, 0.f, 0.f}; float rstd = 0.f;
        if (kq == 0) {
            float v[16]; float st = 0.f;
#pragma unroll
            for (int q = 0; q < 4; ++q) st += ssb[(tile * 4 + q) * 64 + lane];
            { auto rr = __builtin_amdgcn_permlane32_swap(__float_as_uint(st), __float_as_uint(st), false, false); st = __uint_as_float(rr[0]) + __uint_as_float(rr[1]); }
            rstd = rsqrtf(st * (1.f / DM) + EPS);
#pragma unroll
            for (int r = 0; r < 16; ++r) { float sacc = 0.f;
#pragma unroll
                for (int q = 0; q < 4; ++q) sacc += red[((tile * 4 + q) * 16 + r) * 64 + lane];
                v[r] = sacc * rstd + p.router_b[crow16(r, h)]; }
            float lv[4]; int le[4];
#pragma unroll
            for (int k = 0; k < 4; ++k) { float best = v[0]; int bi = 0;
#pragma unroll
                for (int r = 1; r < 16; ++r) { const bool gt = v[r] > best; best = gt ? v[r] : best; bi = gt ? r : bi; }
                lv[k] = best; le[k] = (bi & 3) + 8 * (bi >> 2) + 4 * h;
#pragma unroll
                for (int r = 0; r < 16; ++r) v[r] = (r == bi) ? -INFINITY : v[r]; }
            float cv[8]; int ce[8];
#pragma unroll
            for (int k = 0; k < 4; ++k) { auto rv = __builtin_amdgcn_permlane32_swap(__float_as_uint(lv[k]), __float_as_uint(lv[k]), false, false); auto re = __builtin_amdgcn_permlane32_swap((unsigned)le[k], (unsigned)le[k], false, false);
                cv[k] = __uint_as_float(rv[0]); cv[4 + k] = __uint_as_float(rv[1]); ce[k] = (int)re[0]; ce[4 + k] = (int)re[1]; }
            float tv[4];
#pragma unroll
            for (int k = 0; k < 4; ++k) { float best = cv[0]; int be = ce[0]; int bi = 0;
#pragma unroll
                for (int r = 1; r < 8; ++r) { const bool gt = (cv[r] > best) || (cv[r] == best && ce[r] < be); best = gt ? cv[r] : best; be = gt ? ce[r] : be; bi = gt ? r : bi; }
                tv[k] = best; te[k] = be;
#pragma unroll
                for (int r = 0; r < 8; ++r) cv[r] = (r == bi) ? -INFINITY : cv[r]; }
            const float e1 = __expf(tv[1] - tv[0]), e2 = __expf(tv[2] - tv[0]), e3 = __expf(tv[3] - tv[0]); const float inv = 1.f / (1.f + e1 + e2 + e3);
            tw[0] = inv; tw[1] = e1 * inv; tw[2] = e2 * inv; tw[3] = e3 * inv;
            if (h == 0) {
#pragma unroll
                for (int k = 0; k < 4; ++k) rl[k] = atomicAdd(&lcnt[te[k]], 1); }
        }
        __syncthreads();
        if (tid < 32) lbase[tid] = (int)atomicAdd(&gcnt[tid], (unsigned)lcnt[tid]);
        __syncthreads();
        if (kq == 0 && h == 0) {
#pragma unroll
            for (int k = 0; k < 4; ++k) { const int idx = te[k] * CAP + lbase[te[k]] + rl[k]; row_tok[idx] = token; row_w[idx] = tw[k]; row_slot[idx] = token * 4 + k; row_rstd[idx] = rstd; } }
        __syncthreads();
    }
}

__device__ __forceinline__ void build_block_table(const Params& p, int* bs) {
    const unsigned* gcnt = (const unsigned*)(p.ws + WS_CTL) + CW_CNT;
    if (threadIdx.x == 0) { int acc = 0; for (int e = 0; e < NE; ++e) { bs[e] = acc; acc += ((int)__hip_atomic_load(gcnt + e, __ATOMIC_RELAXED, __HIP_MEMORY_SCOPE_AGENT) + 255) >> 8; } bs[NE] = acc; }
    __syncthreads();
}

__device__ __forceinline__ pg8::MoeOrder make_moe_order(const Params& p, unsigned char* lds, int N, bool gather) {
    int* bs = (int*)(lds + 131072); int* utab = (int*)(lds + 131072 + 256); int* gtab = (int*)(lds + 131072 + 512);
    build_block_table(p, bs);
    const int nmb = __builtin_amdgcn_readfirstlane(bs[NE]);
    pg8::MoeOrder S; S.so.init(nmb * 256, N, (int)gridDim.x, (int)blockIdx.x); S.utab = (const PG8_LAS int*)utab; S.gtab = (const PG8_LAS int*)gtab;
    const int* row_tok = (const int*)(p.ws + WS_RT2);
    for (int i = 0; i < pg8::MOE_MAXU; ++i) { pg8::Unit u; if (!S.so.next(i, u)) break; int e = 0; for (int k = 1; k < NE; ++k) if (bs[k] <= u.pm) e = k;
        const int rb = e * CAP + (u.pm - bs[e]) * 256;
        if (threadIdx.x == 0) utab[i] = e | (rb << 8);
        if (gather && threadIdx.x < 256) gtab[i * 256 + threadIdx.x] = row_tok[rb + threadIdx.x]; }
    __syncthreads();
    return S;
}
__device__ __forceinline__ void phase_moe1(const Params& p, unsigned char* lds) {
    const pg8::MoeOrder S = make_moe_order(p, lds, 2048, true);
    pg8::Gemm g{(const bf16_t*)(p.ws + WS_H8), (const bf16_t*)(p.ws + WS_W1), 0, 2048, DM / 2, (size_t)2048 * DM, 0};
    pg8::EpiSwiglu E{p.ws + WS_ACT, p.b1, (const float*)(p.ws + WS_RT2 + 6 * MiB)};
    pg8::gemm_phase<pg8::EpiSwiglu, pg8::MoeOrder, true, true, true, true>((PG8_LAS unsigned char*)lds, g, S, E);
}
__device__ __forceinline__ void phase_moe2(const Params& p, unsigned char* lds) {
    const pg8::MoeOrder S = make_moe_order(p, lds, DM, false);
    pg8::Gemm g{(const bf16_t*)(p.ws + WS_ACT), (const bf16_t*)(p.ws + WS_W2), 0, DM, DFF / 2, (size_t)DM * DFF, 0};
    pg8::EpiMoeOut E{p.ws + WS_YS, p.b2, (const float*)(p.ws + WS_RT2 + 2 * MiB), (const int*)(p.ws + WS_RT2 + 4 * MiB)};
    pg8::gemm_phase<pg8::EpiMoeOut, pg8::MoeOrder, true, true, true>((PG8_LAS unsigned char*)lds, g, S, E);
}

__device__ __forceinline__ float fp8_to_f32(unsigned w, int byte) {
    return byte == 0 ? __builtin_amdgcn_cvt_f32_fp8((int)w, 0) : byte == 1 ? __builtin_amdgcn_cvt_f32_fp8((int)w, 1) : byte == 2 ? __builtin_amdgcn_cvt_f32_fp8((int)w, 2) : __builtin_amdgcn_cvt_f32_fp8((int)w, 3); }
__device__ __forceinline__ void phase_combine(const Params& p) {
    const int tid = threadIdx.x, lane = tid & 63, wave = tid >> 6;
    const int gw = blockIdx.x * NWAVES + wave, NGW = gridDim.x * NWAVES;
    const unsigned char* YS = p.ws + WS_YS;
    for (int t = gw; t < NTOK; t += NGW) {
        f32x4* orow = (f32x4*)(p.out + (size_t)t * DM) + lane;
        f32x4 v[4]; unsigned w[4][4];
#pragma unroll
        for (int j = 0; j < 4; ++j) { v[j] = orow[64 * j];
#pragma unroll
            for (int k = 0; k < 4; ++k) w[j][k] = *((const unsigned*)(YS + ((size_t)t * 4 + k) * DM) + lane + 64 * j); }
#pragma unroll
        for (int j = 0; j < 4; ++j) { f32x4 s = {0.f, 0.f, 0.f, 0.f};
#pragma unroll
            for (int k = 0; k < 4; ++k) { s[0] += fp8_to_f32(w[j][k], 0); s[1] += fp8_to_f32(w[j][k], 1); s[2] += fp8_to_f32(w[j][k], 2); s[3] += fp8_to_f32(w[j][k], 3); }
            orow[64 * j] = v[j] + s * YS_INV; }
    }
}

template <class Epi>
__device__ __forceinline__ void dense_gemm(unsigned char* lds, const bf16_t* A, const bf16_t* Bt, int M, int N, int K, const Epi& E, int lda = 0) {
    pg8::Gemm g{A, Bt, M, N, K, 0, lda}; pg8::StaticOrder S; S.init(M, N, (int)gridDim.x, (int)blockIdx.x);
    pg8::gemm_phase<Epi, pg8::StaticOrder, true, true>((PG8_LAS unsigned char*)lds, g, S, E);
}

constexpr int NPHASE = 13;
__global__ void __launch_bounds__(NTHREADS, 2) mk_fwd(Params p) {
    extern __shared__ __attribute__((aligned(16))) unsigned char lds[];
    cg::grid_group grid = cg::this_grid();
    unsigned char* ws = p.ws;
    volatile LAS unsigned* MISC = (volatile LAS unsigned*)((LAS unsigned char*)lds + MISC_OFF);
    if (threadIdx.x < 32) MISC[threadIdx.x] = 0u;
    __syncthreads();
    XcdBarrier bar = xcd_barrier_post((unsigned*)(ws + WS_CTL) + CW_BAR, MISC + 8);
    const int lo = p.ph_lo, hi = p.ph_hi;
    if (lo < 0) grid.sync();
#define IN(k) (lo <= (k) && (k) < hi)
#define SEAM(k) do { if (IN(k) && IN((k) + 1)) xcd_barrier(bar); } while (0)
    if (IN(0)) phase_prologue(p, lds);
    SEAM(0);
    if (IN(1)) { pg8::EpiProj E{(bf16_t*)(ws + WS_PROJ), (float*)(ws + WS_SSQ)}; dense_gemm(lds, (const bf16_t*)(ws + WS_XN), (const bf16_t*)(ws + WS_WIN), NTOK, INCP, DM, E); }
    if (IN(1) && IN(3)) xcd_barrier(bar);
    if (IN(3)) { const float* ssq = (const float*)(ws + WS_SSQ); const float* cst = (const float*)(ws + WS_CS); float* hs = (float*)(lds + 131072);
                 pg8::EpiQ Eq{(bf16_t*)(ws + WS_Q), ssq, p.q_g, cst, hs}; dense_gemm(lds, (const bf16_t*)(ws + WS_PROJ) + OFF_CQ, (const bf16_t*)(ws + WS_WUQ), NTOK, 1024, QLORA, Eq, INCP);
                 pg8::EpiKV Ek{(bf16_t*)(ws + WS_K), (bf16_t*)(ws + WS_V), ssq + NTOK, ssq + 2 * NTOK, p.k_g, cst, (const bf16_t*)(ws + WS_PROJ), hs}; dense_gemm(lds, (const bf16_t*)(ws + WS_PROJ) + OFF_CKV, (const bf16_t*)(ws + WS_WUKV), NTOK, 1024, KVLORA, Ek, INCP);
                 phase_conv(p); }
    if (IN(3) && IN(5)) xcd_barrier(bar);
    if (IN(5)) phase_attn(p, lds);
    SEAM(5);
    if (IN(6)) { pg8::EpiGateA E{(bf16_t*)(ws + WS_M1), (const bf16_t*)(ws + WS_PROJ)}; dense_gemm(lds, (const bf16_t*)(ws + WS_AO), (const bf16_t*)(ws + WS_WOMLA), NTOK, DM, 512, E); }
    if (IN(7)) { pg8::EpiGateB E{(const bf16_t*)(ws + WS_M1), (const bf16_t*)(ws + WS_PROJ), (bf16_t*)(ws + WS_MERGED)}; dense_gemm(lds, (const bf16_t*)(ws + WS_YBIN), (const bf16_t*)(ws + WS_WOCONV), NTOK, DM, 512, E); }
    SEAM(7);
    if (IN(8)) { pg8::EpiResid E{p.x, p.out}; dense_gemm(lds, (const bf16_t*)(ws + WS_MERGED), (const bf16_t*)(ws + WS_WO), NTOK, DM, DM, E); }
    SEAM(8);
    if (IN(9)) { wconv_cleanup(p, lds); phase_router(p, lds); }
    if (IN(9) && IN(11)) xcd_barrier(bar);
    if (IN(11)) phase_moe1(p, lds);
    SEAM(11);
    if (IN(12)) phase_moe2(p, lds);
    SEAM(12);
    if (IN(13)) phase_combine(p);
#undef IN
#undef SEAM
}

extern "C" void kernel_launch(void* const* d_in, const int* in_sizes, int n_in, void* d_out, int out_size,
                              void* d_ws, size_t ws_size, hipStream_t stream) {
    static int grid_blocks = 0;
    if (!grid_blocks) {
        int dev = 0, cus = 0, per_cu = 0;
        (void)hipGetDevice(&dev);
        (void)hipDeviceGetAttribute(&cus, hipDeviceAttributeMultiprocessorCount, dev);
        (void)hipFuncSetAttribute((const void*)mk_fwd, hipFuncAttributeMaxDynamicSharedMemorySize, LDS_BYTES);
        (void)hipOccupancyMaxActiveBlocksPerMultiprocessor(&per_cu, (const void*)mk_fwd, NTHREADS, LDS_BYTES);
        if (per_cu < 1) { fprintf(stderr, "kernel_launch: occupancy query says %d blocks/CU\n", per_cu); per_cu = 1; }
        grid_blocks = cus;
        if (ws_size < WS_END2 || n_in != 21) fprintf(stderr, "kernel_launch: ws %zu < %zu or n_in %d != 21\n", ws_size, (size_t)WS_END2, n_in);
    }
    (void)hipMemsetAsync((char*)d_ws + WS_CTL, 0, 1 * MiB, stream);
    Params p{};
    p.x = (const float*)d_in[0]; p.pos = (const int*)d_in[1]; p.norm1_g = (const float*)d_in[2]; p.w_in = (const float*)d_in[3]; p.q_a_g = (const float*)d_in[4];
    p.kv_a_g = (const float*)d_in[5]; p.w_uq = (const float*)d_in[6]; p.w_ukv = (const float*)d_in[7]; p.q_g = (const float*)d_in[8]; p.k_g = (const float*)d_in[9];
    p.conv_w = (const float*)d_in[10]; p.w_o_mla = (const float*)d_in[11]; p.w_o_conv = (const float*)d_in[12]; p.w_o = (const float*)d_in[13]; p.norm2_g = (const float*)d_in[14];
    p.router_w = (const float*)d_in[15]; p.router_b = (const float*)d_in[16]; p.w1 = (const float*)d_in[17]; p.b1 = (const float*)d_in[18]; p.w2 = (const float*)d_in[19]; p.b2 = (const float*)d_in[20];
    p.out = (float*)d_out; p.ws = (unsigned char*)d_ws; p.ph_lo = 0; p.ph_hi = NPHASE + 1;
    void* args[] = {&p};
    hipError_t e = hipLaunchCooperativeKernel((const void*)mk_fwd, dim3(grid_blocks), dim3(NTHREADS), args, LDS_BYTES, stream);
    if (e != hipSuccess) fprintf(stderr, "cooperative launch failed: %s (grid %d)\n", hipGetErrorString(e), grid_blocks);
}
```

```cpp
#include <hip/hip_runtime.h>
#include <hip/hip_cooperative_groups.h>
#include <cstdio>
#include <cstdint>
namespace cg = cooperative_groups;

typedef unsigned short bf16_t;
typedef short bf16x8 __attribute__((ext_vector_type(8)));
typedef short s16x4 __attribute__((ext_vector_type(4)));
typedef float f32x4 __attribute__((ext_vector_type(4)));
typedef float f32x2 __attribute__((ext_vector_type(2)));
typedef float f32x16 __attribute__((ext_vector_type(16)));
typedef unsigned u32x4 __attribute__((ext_vector_type(4)));
typedef unsigned u32x2 __attribute__((ext_vector_type(2)));
typedef __bf16 bf16x2_t __attribute__((ext_vector_type(2)));

constexpr int NTOK = 16384, DM = 1024, SEQ = 8192;
constexpr int INC = 4000, INCP = 4096;
constexpr int OFF_CQ = 0, OFF_CKV = 256, OFF_KR = 384, OFF_U = 416, OFF_C = 928, OFF_B = 1440, OFF_GA = 1952, OFF_GB = 2976;
constexpr int NH = 8, DQK = 96, DV = 64, NE = 32, TOPK = 4, DFF = 1024;
constexpr int QLORA = 256, KVLORA = 128, CONVW = 512;
constexpr int NPAIR = NTOK * TOPK;
constexpr int MAXROWS = 73728;
constexpr float EPS = 1e-6f;
constexpr float QSCALE = 0.10206207261596575f * 1.4426950408889634f;
constexpr int CAP = 16384;
constexpr int NTHREADS = 512, NWAVES = 8;
constexpr int LDS_BYTES = 147456;

constexpr size_t MiB = 1ull << 20;
constexpr size_t WS_CTL = 0;
constexpr size_t WS_WIN = 1 * MiB;
constexpr size_t WS_WUQ = 9 * MiB;
constexpr size_t WS_WUKV = WS_WUQ + 512 * 1024;
constexpr size_t WS_WOMLA = 10 * MiB;
constexpr size_t WS_WOCONV = 11 * MiB;
constexpr size_t WS_WO = 12 * MiB;
constexpr size_t WS_ROUTE = 14 * MiB;
constexpr size_t WS_W1 = 18 * MiB;
constexpr size_t WS_W2 = 146 * MiB;
constexpr size_t WS_XN = 210 * MiB;
constexpr size_t WS_PROJ = 242 * MiB;
constexpr size_t WS_CQN = 370 * MiB;
constexpr size_t WS_CKVN = 378 * MiB;
constexpr size_t WS_YBIN = 386 * MiB;
constexpr size_t WS_QPRE = 402 * MiB;
constexpr size_t WS_KVPRE = 450 * MiB;
constexpr size_t WS_Q = 514 * MiB;
constexpr size_t WS_K = 538 * MiB;
constexpr size_t WS_V = 570 * MiB;
constexpr size_t WS_AO = 586 * MiB;
constexpr size_t WS_M1 = 602 * MiB;
constexpr size_t WS_MERGED = 666 * MiB;
constexpr size_t WS_YS = 698 * MiB;
constexpr size_t WS_END = 826 * MiB;
constexpr size_t WS_ACT = WS_PROJ;
constexpr size_t WS_H8 = WS_XN;
constexpr size_t WS_GF = 830 * MiB;
constexpr size_t WS_RT2 = 832 * MiB;
constexpr size_t WS_SSQ = 840 * MiB;
constexpr size_t WS_CS = 841 * MiB;
constexpr size_t WS_END2 = 844 * MiB;
constexpr size_t RT_PAIR_E = 0, RT_PAIR_RANK = 262144, RT_PAIR_W = 524288, RT_ROW_TOK = 786432, RT_ROW_W = 786432 + 294912, RT_ROW_SLOT = 786432 + 2 * 294912;
constexpr int CW_CNT = 64;
constexpr int CW_BAR = 4096;
constexpr int MISC_OFF = LDS_BYTES - 256;

struct Params {
    const float* x; const int* pos; const float* norm1_g; const float* w_in; const float* q_a_g; const float* kv_a_g;
    const float* w_uq; const float* w_ukv; const float* q_g; const float* k_g; const float* conv_w; const float* w_o_mla;
    const float* w_o_conv; const float* w_o; const float* norm2_g; const float* router_w; const float* router_b;
    const float* w1; const float* b1; const float* w2; const float* b2;
    float* out; unsigned char* ws; int ph_lo, ph_hi;
};

__device__ __forceinline__ unsigned pk2(float lo, float hi) { f32x2 v = {lo, hi}; bf16x2_t b = __builtin_convertvector(v, bf16x2_t); return __builtin_bit_cast(unsigned, b); }
__device__ __forceinline__ float bf_lo(unsigned w) { return __uint_as_float(w << 16); }
__device__ __forceinline__ float bf_hi(unsigned w) { return __uint_as_float(w & 0xffff0000u); }
__device__ __forceinline__ float bf1(bf16_t h) { return __uint_as_float((unsigned)h << 16); }
__device__ __forceinline__ float wave_sum(float v) {
#pragma unroll
    for (int o = 1; o < 64; o <<= 1) v += __shfl_xor(v, o);
    return v;
}
__device__ __forceinline__ unsigned pk4_fp8(float a, float b, float c, float d) { unsigned w = 0u; w = (unsigned)__builtin_amdgcn_cvt_pk_fp8_f32(a, b, (int)w, false); w = (unsigned)__builtin_amdgcn_cvt_pk_fp8_f32(c, d, (int)w, true); return w; }
constexpr float Q8_SCALE = 4.f, K8_SCALE = 0.25f;
constexpr float W8_SCALE = 32.f, W8_INV = 1.f / 32.f, YS_SCALE = 8.f, YS_INV = 0.125f;
__device__ __forceinline__ float sigmoidf_(float v) { return __builtin_amdgcn_rcpf(1.f + __builtin_amdgcn_exp2f(v * -1.4426950408889634f)); }

namespace pg8 {
#define PG8_LAS __attribute__((address_space(3)))
constexpr int BM = 256, BK = 64, HALF = 128, HTB = HALF * BK * 2  , STAGE_BYTES = 8 * HTB, NXCD = 8, WGM = 8;

__host__ __device__ __forceinline__ int lds_byte(int r, int c) { const int st = (r >> 4) * 2 + (c >> 5), rr = r & 15, cc = c & 31, ob = rr * 64 + cc * 2; return st * 1024 + (ob ^ (((ob >> 9) & 1) << 5)); }
__host__ __device__ __forceinline__ void stage_rc(int b, int& R, int& C) { const int st = b / 1024, sb = b % 1024, swz = sb ^ (((sb >> 9) & 1) << 5); R = (st >> 1) * 16 + swz / 64; C = (st & 1) * 32 + (swz % 64) / 2; }
__host__ __device__ __forceinline__ int perm32(int rho) { const int n = rho >> 4, i = rho & 15; return 8 * (i >> 2) + 4 * n + (i & 3); }

struct Unit { int pm, pn, e, rb; };
struct Gemm { const bf16_t* A; const bf16_t* Bt; int M, N, K; size_t bstride; int lda; };

struct StaticOrder {
    int nM, nN, nwg, G, c;
    __host__ __device__ void init(int M, int N, int G_, int c_) { nM = M / BM; nN = N / BM; nwg = nM * nN; G = G_; c = c_; }
    __host__ __device__ bool next(int i, Unit& u) const {
        const long L = (long)i * G + c; if (L >= nwg) return false;
        int wgid = (int)L; { const int q = nwg / NXCD, r = nwg % NXCD, xcd = wgid % NXCD, off = wgid / NXCD; wgid = (xcd < r ? xcd * (q + 1) : r * (q + 1) + (xcd - r) * q) + off; }
        const int nig = WGM * nN, gid = wgid / nig, fm = gid * WGM, gsz = (nM - fm) < WGM ? (nM - fm) : WGM;
        u.pm = fm + ((wgid % nig) % gsz); u.pn = (wgid % nig) / gsz; u.e = 0; u.rb = 0; return true;
    }
    __device__ __forceinline__ void a_ready(const Unit&) const {}
    __device__ __forceinline__ void done(const Unit&) const {}
};


struct EpiProj {
    static constexpr bool PERM = true, AFTER_DRAIN = false;
    bf16_t* O; float* ssq;
    __device__ __forceinline__ void operator()(const f32x4 (&acc)[2][2][4][2], const Unit& u, int wr, int wc, int fr, int fq) const {
        const int row0 = u.pm * BM + wr * 64 + fr, col0 = u.pn * BM + wc * 32 + 8 * fq;
#pragma unroll
        for (int ai = 0; ai < 2; ++ai)
#pragma unroll
            for (int m = 0; m < 4; ++m) { const int row = row0 + ai * HALF + m * 16; bf16_t* rowp = O + (size_t)row * INCP + col0;
#pragma unroll
                for (int bj = 0; bj < 2; ++bj) { f32x4 v0 = acc[ai][bj][m][0], v1 = acc[ai][bj][m][1]; const int col = col0 + bj * HALF;
                    if (col >= OFF_GA && col < INC) {
#pragma unroll
                        for (int j = 0; j < 4; ++j) { v0[j] = sigmoidf_(v0[j]); v1[j] = sigmoidf_(v1[j]); } }
                    u32x4 w; w.x = pk2(v0[0], v0[1]); w.y = pk2(v0[2], v0[3]); w.z = pk2(v1[0], v1[1]); w.w = pk2(v1[2], v1[3]);
                    *(u32x4*)(rowp + bj * HALF) = w;
                    const int which = u.pn == 0 ? 0 : (u.pn == 1 ? (bj == 0 ? 1 : (wc == 0 ? 2 : -1)) : -1);
                    if (which >= 0) { float s = (v0[0] * v0[0] + v0[1] * v0[1]) + (v0[2] * v0[2] + v0[3] * v0[3]) + (v1[0] * v1[0] + v1[1] * v1[1]) + (v1[2] * v1[2] + v1[3] * v1[3]);
                        s += __shfl_xor(s, 16); s += __shfl_xor(s, 32); if (fq == 0) ssq[(size_t)row * 16 + (which == 0 ? wc * 2 + bj : (which == 1 ? 8 + wc : 12))] = s; } } }
    }
};
struct EpiBf16 {
    static constexpr bool PERM = true, AFTER_DRAIN = false;
    bf16_t* O; int ldc;
    __device__ __forceinline__ void operator()(const f32x4 (&acc)[2][2][4][2], const Unit& u, int wr, int wc, int fr, int fq) const {
        const int row0 = u.pm * BM + wr * 64 + fr, col0 = u.pn * BM + wc * 32 + 8 * fq;
#pragma unroll
        for (int ai = 0; ai < 2; ++ai)
#pragma unroll
            for (int m = 0; m < 4; ++m) { bf16_t* rowp = O + (size_t)(row0 + ai * HALF + m * 16) * ldc + col0;
#pragma unroll
                for (int bj = 0; bj < 2; ++bj) { const f32x4 v0 = acc[ai][bj][m][0], v1 = acc[ai][bj][m][1];
                    u32x4 w; w.x = pk2(v0[0], v0[1]); w.y = pk2(v0[2], v0[3]); w.z = pk2(v1[0], v1[1]); w.w = pk2(v1[2], v1[3]); *(u32x4*)(rowp + bj * HALF) = w; } }
    }
};
__device__ __forceinline__ void epi_bar() { asm volatile("s_waitcnt lgkmcnt(0)" ::: "memory"); __builtin_amdgcn_s_barrier(); asm volatile("" ::: "memory"); }
__device__ __forceinline__ u32x2 pk4bf(const f32x4 v) { u32x2 w; w.x = pk2(v[0], v[1]); w.y = pk2(v[2], v[3]); return w; }
struct EpiQ {
    static constexpr bool PERM = false, AFTER_DRAIN = false;
    unsigned char* Q; const float* ssq_cq; const float* qg; const float* cs; float* hs;
    __device__ __forceinline__ void operator()(f32x4 (&acc)[2][2][4][2], const Unit& u, int wr, int wc, int fr, int fq) const {
        int lr0 = wr * 64 + fr; asm volatile("" : "+v"(lr0), "+v"(fq));
        const int t0 = u.pm * BM + lr0;
#pragma unroll
        for (int ai = 0; ai < 2; ++ai)
#pragma unroll
            for (int m = 0; m < 4; ++m) { const f32x4 sa = *(const f32x4*)(ssq_cq + (size_t)(t0 + ai * HALF + m * 16) * 16), sb = *(const f32x4*)(ssq_cq + (size_t)(t0 + ai * HALF + m * 16) * 16 + 4);
                const float rq = rsqrtf((((sa[0] + sa[1]) + (sa[2] + sa[3])) + ((sb[0] + sb[1]) + (sb[2] + sb[3]))) * (1.f / QLORA) + EPS);
#pragma unroll
                for (int bj = 0; bj < 2; ++bj) { const f32x4 x0 = acc[ai][bj][m][0] * rq, x1 = acc[ai][bj][m][1] * rq; acc[ai][bj][m][0] = x0; acc[ai][bj][m][1] = x1;
                    float s = (x0[0] * x0[0] + x0[1] * x0[1]) + (x0[2] * x0[2] + x0[3] * x0[3]) + (x1[0] * x1[0] + x1[1] * x1[1]) + (x1[2] * x1[2] + x1[3] * x1[3]);
                    s += __shfl_xor(s, 16); s += __shfl_xor(s, 32); if (fq == 0) hs[((lr0 + ai * HALF + m * 16) * 2 + bj) * 4 + wc] = s; } }
        epi_bar();
        {
            f32x4 g0 = {0.f, 0.f, 0.f, 0.f}, g1 = g0; if (wc < 3) { g0 = *(const f32x4*)(qg + 32 * wc + 4 * fq); g1 = *(const f32x4*)(qg + 32 * wc + 16 + 4 * fq); }
#pragma unroll
            for (int ai = 0; ai < 2; ++ai)
#pragma unroll
                for (int m = 0; m < 4; ++m) { const int lr = lr0 + ai * HALF + m * 16, t = u.pm * BM + lr, b = t >> 13, s = t & (SEQ - 1);
                    f32x4 c4 = {0.f, 0.f, 0.f, 0.f}, s4 = {0.f, 0.f, 0.f, 0.f}; if (wc == 2) { c4 = *(const f32x4*)(cs + (size_t)t * 32 + 4 * fq); s4 = *(const f32x4*)(cs + (size_t)t * 32 + 16 + 4 * fq); }
#pragma unroll
                    for (int bj = 0; bj < 2; ++bj) { const f32x4 h4 = *(const f32x4*)(hs + (lr * 2 + bj) * 4); const float rstd = rsqrtf(((h4[0] + h4[1]) + h4[2]) * (1.f / DQK) + EPS) * (QSCALE * Q8_SCALE); f32x4 x0 = acc[ai][bj][m][0] * rstd * g0, x1 = acc[ai][bj][m][1] * rstd * g1;
                        if (wc == 2) { const f32x4 o0 = x0 * c4 - x1 * s4, o1 = x0 * s4 + x1 * c4; x0 = o0; x1 = o1; }
                        unsigned char* qp = Q + ((size_t)(b * NH + 2 * u.pn + bj) * SEQ + s) * 128 + 32 * wc + 4 * fq; *(unsigned*)qp = pk4_fp8(x0[0], x0[1], x0[2], x0[3]); *(unsigned*)(qp + 16) = pk4_fp8(x1[0], x1[1], x1[2], x1[3]); }
                    asm volatile("" ::: "memory"); }
        }
    }
};
struct EpiKV {
    static constexpr bool PERM = false, AFTER_DRAIN = false;
    unsigned char* K; bf16_t* V; const float* ssq; const float* kg; const float* cs; const bf16_t* proj; float* hs;
    __device__ __forceinline__ void operator()(f32x4 (&acc)[2][2][4][2], const Unit& u, int wr, int wc, int fr, int fq) const {
        int lr0 = wr * 64 + fr; asm volatile("" : "+v"(lr0), "+v"(fq));
        const int t0 = u.pm * BM + lr0;
#pragma unroll
        for (int ai = 0; ai < 2; ++ai)
#pragma unroll
            for (int m = 0; m < 4; ++m) { const f32x4 sa = *(const f32x4*)(ssq + (size_t)(t0 + ai * HALF + m * 16) * 16 + 8); const float rk = rsqrtf(((sa[0] + sa[1]) + (sa[2] + sa[3])) * (1.f / KVLORA) + EPS);
#pragma unroll
                for (int bj = 0; bj < 2; ++bj) { const f32x4 x0 = acc[ai][bj][m][0] * rk, x1 = acc[ai][bj][m][1] * rk; acc[ai][bj][m][0] = x0; acc[ai][bj][m][1] = x1;
                    if (wc < 2) { float s = (x0[0] * x0[0] + x0[1] * x0[1]) + (x0[2] * x0[2] + x0[3] * x0[3]) + (x1[0] * x1[0] + x1[1] * x1[1]) + (x1[2] * x1[2] + x1[3] * x1[3]);
                        s += __shfl_xor(s, 16); s += __shfl_xor(s, 32); if (fq == 0) hs[((lr0 + ai * HALF + m * 16) * 2 + bj) * 4 + wc] = s; } } }
        epi_bar();
        f32x4 g0 = {0.f, 0.f, 0.f, 0.f}, g1 = {0.f, 0.f, 0.f, 0.f};
        if (wc < 2) { g0 = *(const f32x4*)(kg + 32 * wc + 4 * fq); g1 = *(const f32x4*)(kg + 32 * wc + 16 + 4 * fq); }
        if (wc == 2) { g0 = *(const f32x4*)(kg + 64 + 4 * fq); g1 = *(const f32x4*)(kg + 80 + 4 * fq); }
#pragma unroll
        for (int ai = 0; ai < 2; ++ai)
#pragma unroll
            for (int m = 0; m < 4; ++m) { const int lr = lr0 + ai * HALF + m * 16, t = u.pm * BM + lr, b = t >> 13, s = t & (SEQ - 1); const float skr = ssq[(size_t)t * 16 + 12];
                f32x4 c4 = {0.f, 0.f, 0.f, 0.f}, s4 = c4, r1 = c4, r2 = c4;
                if (wc == 2) { c4 = *(const f32x4*)(cs + (size_t)t * 32 + 4 * fq); s4 = *(const f32x4*)(cs + (size_t)t * 32 + 16 + 4 * fq);
                    const u32x2 a = *(const u32x2*)(proj + (size_t)t * INCP + OFF_KR + 4 * fq), bb = *(const u32x2*)(proj + (size_t)t * INCP + OFF_KR + 16 + 4 * fq);
                    r1 = (f32x4){bf_lo(a.x), bf_hi(a.x), bf_lo(a.y), bf_hi(a.y)} * g0; r2 = (f32x4){bf_lo(bb.x), bf_hi(bb.x), bf_lo(bb.y), bf_hi(bb.y)} * g1; }
#pragma unroll
                for (int bj = 0; bj < 2; ++bj) { const size_t rowi = (size_t)(b * NH + 2 * u.pn + bj) * SEQ + s; const f32x2 h2 = *(const f32x2*)(hs + (lr * 2 + bj) * 4); const float rstd = rsqrtf(((h2[0] + h2[1]) + skr) * (1.f / DQK) + EPS) * K8_SCALE;
                    if (wc < 2) { unsigned char* kp = K + rowi * 128 + 32 * wc + 4 * fq; const f32x4 y0 = acc[ai][bj][m][0] * rstd * g0, y1 = acc[ai][bj][m][1] * rstd * g1; *(unsigned*)kp = pk4_fp8(y0[0], y0[1], y0[2], y0[3]); *(unsigned*)(kp + 16) = pk4_fp8(y1[0], y1[1], y1[2], y1[3]); }
                    else { bf16_t* vp = V + rowi * DV + 32 * (wc - 2) + 4 * fq; *(u32x2*)vp = pk4bf(acc[ai][bj][m][0]); *(u32x2*)(vp + 16) = pk4bf(acc[ai][bj][m][1]);
                        if (wc == 2) { const f32x4 x1 = r1 * rstd, x2 = r2 * rstd, y1 = x1 * c4 - x2 * s4, y2 = x1 * s4 + x2 * c4; unsigned char* kp = K + rowi * 128 + 64 + 4 * fq; *(unsigned*)kp = pk4_fp8(y1[0], y1[1], y1[2], y1[3]); *(unsigned*)(kp + 16) = pk4_fp8(y2[0], y2[1], y2[2], y2[3]); }
                        else { *(u32x2*)(K + rowi * 128 + 96 + 8 * fq) = (u32x2){0u, 0u}; } } }
                asm volatile("" ::: "memory"); }
    }
};
struct EpiF32 {
    static constexpr bool PERM = false, AFTER_DRAIN = false;
    float* O; int ldc;
    __device__ __forceinline__ void operator()(const f32x4 (&acc)[2][2][4][2], const Unit& u, int wr, int wc, int fr, int fq) const {
        const int row0 = u.pm * BM + wr * 64 + fr, col0 = u.pn * BM + wc * 32 + 4 * fq;
#pragma unroll
        for (int ai = 0; ai < 2; ++ai)
#pragma unroll
            for (int m = 0; m < 4; ++m) { float* rowp = O + (size_t)(row0 + ai * HALF + m * 16) * ldc + col0;
#pragma unroll
                for (int bj = 0; bj < 2; ++bj)
#pragma unroll
                    for (int n = 0; n < 2; ++n) *(f32x4*)(rowp + bj * HALF + n * 16) = acc[ai][bj][m][n]; }
    }
};
__device__ __forceinline__ void unpack8(const u32x4 g, float (&f)[8]) { f[0] = bf_lo(g.x); f[1] = bf_hi(g.x); f[2] = bf_lo(g.y); f[3] = bf_hi(g.y); f[4] = bf_lo(g.z); f[5] = bf_hi(g.z); f[6] = bf_lo(g.w); f[7] = bf_hi(g.w); }
struct EpiGateA {
    static constexpr bool PERM = true, AFTER_DRAIN = false;
    bf16_t* M1; const bf16_t* proj;
    __device__ __forceinline__ void operator()(const f32x4 (&acc)[2][2][4][2], const Unit& u, int wr, int wc, int fr, int fq) const {
        const int row0 = u.pm * BM + wr * 64 + fr, col0 = u.pn * BM + wc * 32 + 8 * fq;
#pragma unroll
        for (int ai = 0; ai < 2; ++ai)
#pragma unroll
            for (int m = 0; m < 4; ++m) { const size_t row = (size_t)(row0 + ai * HALF + m * 16);
#pragma unroll
                for (int bj = 0; bj < 2; ++bj) { const int col = col0 + bj * HALF; float g[8]; unpack8(*(const u32x4*)(proj + row * INCP + OFF_GA + col), g);
                    const f32x4 v0 = acc[ai][bj][m][0], v1 = acc[ai][bj][m][1];
                    u32x4 w; w.x = pk2(v0[0] * g[0], v0[1] * g[1]); w.y = pk2(v0[2] * g[2], v0[3] * g[3]); w.z = pk2(v1[0] * g[4], v1[1] * g[5]); w.w = pk2(v1[2] * g[6], v1[3] * g[7]);
                    *(u32x4*)(M1 + row * DM + col) = w; } }
    }
};
struct EpiGateB {
    static constexpr bool PERM = true, AFTER_DRAIN = false;
    const bf16_t* M1; const bf16_t* proj; bf16_t* O;
    __device__ __forceinline__ void operator()(const f32x4 (&acc)[2][2][4][2], const Unit& u, int wr, int wc, int fr, int fq) const {
        const int row0 = u.pm * BM + wr * 64 + fr, col0 = u.pn * BM + wc * 32 + 8 * fq;
#pragma unroll
        for (int ai = 0; ai < 2; ++ai)
#pragma unroll
            for (int m = 0; m < 4; ++m) { const size_t row = (size_t)(row0 + ai * HALF + m * 16);
#pragma unroll
                for (int bj = 0; bj < 2; ++bj) { const int col = col0 + bj * HALF; float g[8], b[8]; unpack8(*(const u32x4*)(proj + row * INCP + OFF_GB + col), g); unpack8(*(const u32x4*)(M1 + row * DM + col), b);
                    const f32x4 v0 = acc[ai][bj][m][0], v1 = acc[ai][bj][m][1];
                    u32x4 w; w.x = pk2(b[0] + v0[0] * g[0], b[1] + v0[1] * g[1]); w.y = pk2(b[2] + v0[2] * g[2], b[3] + v0[3] * g[3]);
                    w.z = pk2(b[4] + v1[0] * g[4], b[5] + v1[1] * g[5]); w.w = pk2(b[6] + v1[2] * g[6], b[7] + v1[3] * g[7]);
                    *(u32x4*)(O + row * DM + col) = w; } }
    }
};
struct EpiResid {
    static constexpr bool PERM = false, AFTER_DRAIN = false;
    const float* X; float* O;
    __device__ __forceinline__ void operator()(const f32x4 (&acc)[2][2][4][2], const Unit& u, int wr, int wc, int fr, int fq) const {
        const int row0 = u.pm * BM + wr * 64 + fr, col0 = u.pn * BM + wc * 32 + 4 * fq;
#pragma unroll
        for (int ai = 0; ai < 2; ++ai)
#pragma unroll
            for (int m = 0; m < 4; ++m) { const size_t off = (size_t)(row0 + ai * HALF + m * 16) * DM + col0;
#pragma unroll
                for (int bj = 0; bj < 2; ++bj)
#pragma unroll
                    for (int n = 0; n < 2; ++n) { const f32x4 b = *(const f32x4*)(X + off + bj * HALF + n * 16); *(f32x4*)(O + off + bj * HALF + n * 16) = b + acc[ai][bj][m][n]; } }
    }
};
struct EpiSwiglu {
    static constexpr bool PERM = true, AFTER_DRAIN = false;
    unsigned char* ACT; const float* b1; const float* row_rstd;
    __device__ __forceinline__ void operator()(const f32x4 (&acc)[2][2][4][2], const Unit& u, int wr, int wc, int fr, int fq) const {
        const int row0 = u.pm * BM + wr * 64 + fr, f0 = u.pn * HALF + wc * 32 + 8 * fq; const float* be = b1 + (size_t)u.e * 2048;
        const f32x4 bg0 = *(const f32x4*)(be + f0), bg1 = *(const f32x4*)(be + f0 + 4), bu0 = *(const f32x4*)(be + DFF + f0), bu1 = *(const f32x4*)(be + DFF + f0 + 4);
        float rsv[8];
#pragma unroll
        for (int i = 0; i < 8; ++i) rsv[i] = row_rstd[u.rb + wr * 64 + fr + (i >> 2) * HALF + (i & 3) * 16] * W8_INV;
#pragma unroll
        for (int ai = 0; ai < 2; ++ai)
#pragma unroll
            for (int m = 0; m < 4; ++m) { const size_t row = (size_t)(row0 + ai * HALF + m * 16); float o[8]; const float rs = rsv[ai * 4 + m];
#pragma unroll
                for (int n = 0; n < 2; ++n) { const f32x4 g4 = acc[ai][0][m][n] * rs + (n ? bg1 : bg0), u4 = acc[ai][1][m][n] * rs + (n ? bu1 : bu0);
#pragma unroll
                    for (int j = 0; j < 4; ++j) { const float g = fminf(g4[j], 7.f), uu = fminf(fmaxf(u4[j], -7.f), 7.f); o[4 * n + j] = (uu + 1.f) * (g * sigmoidf_(1.702f * g)); } }
                u32x2 w; w.x = pk4_fp8(o[0], o[1], o[2], o[3]); w.y = pk4_fp8(o[4], o[5], o[6], o[7]); *(u32x2*)(ACT + row * DFF + f0) = w; }
    }
};
struct EpiMoeOut {
    static constexpr bool PERM = true, AFTER_DRAIN = false;
    unsigned char* YS; const float* b2; const float* row_w; const int* row_slot;
    __device__ __forceinline__ void operator()(const f32x4 (&acc)[2][2][4][2], const Unit& u, int wr, int wc, int fr, int fq) const {
        const int col0 = u.pn * BM + wc * 32 + 8 * fq; const float* be = b2 + (size_t)u.e * DM; const int rbase = u.rb + wr * 64 + fr;
        int slot[8]; float w[8];
#pragma unroll
        for (int i = 0; i < 8; ++i) { const int row = rbase + (i >> 2) * HALF + (i & 3) * 16; slot[i] = row_slot[row]; w[i] = row_w[row] * (W8_INV * YS_SCALE); }
        f32x4 bv[2][2];
#pragma unroll
        for (int bj = 0; bj < 2; ++bj)
#pragma unroll
            for (int n = 0; n < 2; ++n) bv[bj][n] = *(const f32x4*)(be + col0 + bj * HALF + 4 * n) * W8_SCALE;
#pragma unroll
        for (int ai = 0; ai < 2; ++ai)
#pragma unroll
            for (int m = 0; m < 4; ++m) { const int i = ai * 4 + m;
                if (slot[i] >= 0) { unsigned char* rowp = YS + (size_t)slot[i] * DM + col0;
#pragma unroll
                    for (int bj = 0; bj < 2; ++bj) { const f32x4 v0 = (acc[ai][bj][m][0] + bv[bj][0]) * w[i], v1 = (acc[ai][bj][m][1] + bv[bj][1]) * w[i];
                        u32x2 o; o.x = pk4_fp8(v0[0], v0[1], v0[2], v0[3]); o.y = pk4_fp8(v1[0], v1[1], v1[2], v1[3]); *(u32x2*)(rowp + bj * HALF) = o; } } }
    }
};
constexpr int MOE_MAXU = 12;
struct MoeOrder {
    StaticOrder so; const PG8_LAS int* utab; const PG8_LAS int* gtab;
    __device__ __forceinline__ bool next(int i, Unit& u) const { if (i >= MOE_MAXU || !so.next(i, u)) return false; const int v = __builtin_amdgcn_readfirstlane(utab[i]); u.e = v & 31; u.rb = (int)((unsigned)v >> 8); return true; }
    __device__ __forceinline__ void a_ready(const Unit&) const {}
    __device__ __forceinline__ void done(const Unit&) const {}
};
typedef int i32x4_t __attribute__((ext_vector_type(4))); typedef int i32x8_t __attribute__((ext_vector_type(8)));
__device__ __forceinline__ i32x8_t cat8(bf16x8 lo, bf16x8 hi) { return __builtin_shufflevector(__builtin_bit_cast(i32x4_t, lo), __builtin_bit_cast(i32x4_t, hi), 0, 1, 2, 3, 4, 5, 6, 7); }
__device__ __forceinline__ void mfma_fp8_inplace(f32x4& c, const i32x8_t a, const i32x8_t b) { asm volatile("s_nop 1\n\tv_mfma_f32_16x16x128_f8f6f4 %0, %1, %2, %0" : "+v"(c) : "v"(a), "v"(b)); }
__device__ __forceinline__ void mfma_fp8_drain() { asm volatile("s_nop 15\n\ts_nop 7" ::: "memory"); __builtin_amdgcn_sched_barrier(0); }
template <class Epi, class Sched, bool ALIGN_EPI = false, bool SP2 = false, bool FP8 = false, bool GATHER = false>
__device__ __forceinline__ void gemm_phase(PG8_LAS unsigned char* lds, const Gemm g, const Sched& S, const Epi& E) {
    int tid = threadIdx.x; asm volatile("" : "+v"(tid));
    const int wid = __builtin_amdgcn_readfirstlane(tid >> 6), lane = tid & 63, wr = wid >> 2, wc = wid & 3, fr = lane & 15, fq = lane >> 4;
    const int K = g.K, nt = K / BK;
    static_assert(!GATHER || SP2, "GATHER is implemented for the SP2 loop only");
    const unsigned rowA = (unsigned)(g.lda ? g.lda : K) * 2u;
    unsigned voffA[2], voffB[2]; int gR0 = 0; unsigned gC = 0u;
#pragma unroll
    for (int i = 0; i < 2; ++i) { int R, C; stage_rc(tid * 16 + i * 8192, R, C); const int Rb = Epi::PERM ? ((R & ~31) + perm32(R & 31)) : R;
        voffA[i] = (unsigned)R * rowA + (unsigned)C * 2u; voffB[i] = (unsigned)(Rb * K + C) * 2u; if (i == 0) { gR0 = R; gC = (unsigned)C * 2u; } }
    unsigned gA[2][2] = {{0u, 0u}, {0u, 0u}}, ngA[2][2] = {{0u, 0u}, {0u, 0u}};
#define PG8_GLOAD(dst, ui_) do { _Pragma("unroll") for (int h_ = 0; h_ < 2; ++h_) _Pragma("unroll") for (int i_ = 0; i_ < 2; ++i_) \
        dst[h_][i_] = (unsigned)S.gtab[(ui_) * 256 + 128 * h_ + gR0 + 64 * i_] * rowA + gC; } while (0)
#define PG8_VA(h) (GATHER ? gA[h] : voffA)
    const unsigned kstep = (unsigned)(BK * 2);
    const unsigned hstep = (unsigned)HALF * (unsigned)K * 2u;
    const unsigned tstep = 2u * hstep;
    const unsigned hstepA = (unsigned)HALF * rowA, tstepA = 2u * hstepA;
    const unsigned hsA = GATHER ? 0u : hstepA;
    const unsigned ldsw = (unsigned)wid * 1024u;
    const int aoff = lds_byte(wr * 64 + fr, fq * 8), boff = lds_byte(wc * 32 + fr, fq * 8);
#define PG8_SA(b, h) (((b) * 2 + (h)) * HTB)
#define PG8_SB(b, h) ((4 + (b) * 2 + (h)) * HTB)
#define PG8_STAGE(rs, bufoff, goff, voff) do { _Pragma("unroll") for (int _i = 0; _i < 2; ++_i) \
        __builtin_amdgcn_raw_ptr_buffer_load_lds(rs, (PG8_LAS void*)(lds + (bufoff) + ldsw + _i * 8192), 16, (int)(voff)[_i], (int)(goff), 0, 0); } while (0)
#define PG8_LDA(dst, b, h) do { _Pragma("unroll") for (int m = 0; m < 4; ++m) _Pragma("unroll") for (int k = 0; k < 2; ++k) dst[m][k] = *(const PG8_LAS bf16x8*)(lds + PG8_SA(b, h) + aoff + m * 2048 + k * 1024); } while (0)
#define PG8_LDB(dst, b, h) do { _Pragma("unroll") for (int n = 0; n < 2; ++n) _Pragma("unroll") for (int k = 0; k < 2; ++k) dst[n][k] = *(const PG8_LAS bf16x8*)(lds + PG8_SB(b, h) + boff + n * 2048 + k * 1024); } while (0)
#define PG8_MMA(ai, bj, At, Bt) do { __builtin_amdgcn_s_setprio(1); _Pragma("unroll") for (int m = 0; m < 4; ++m) _Pragma("unroll") for (int n = 0; n < 2; ++n) { \
        if constexpr (FP8) { mfma_fp8_inplace(acc[ai][bj][m][n], cat8(Bt[n][0], Bt[n][1]), cat8(At[m][0], At[m][1])); } \
        else { _Pragma("unroll") for (int k = 0; k < 2; ++k) acc[ai][bj][m][n] = __builtin_amdgcn_mfma_f32_16x16x32_bf16(Bt[n][k], At[m][k], acc[ai][bj][m][n], 0, 0, 0); } } \
        __builtin_amdgcn_s_setprio(0); } while (0)
#define PG8_WAIT_V(n) asm volatile("s_waitcnt vmcnt(" #n ")" ::: "memory")
#define PG8_WAIT_L(n) asm volatile("s_waitcnt lgkmcnt(" #n ")" ::: "memory")
#define PG8_BAR __builtin_amdgcn_s_barrier()
#define PG8_SCHED __builtin_amdgcn_sched_barrier(0)
    Unit cur, nxt; int ui = 0;
    if (!S.next(0, cur)) return;
    f32x4 acc[2][2][4][2];
#pragma unroll
    for (int a = 0; a < 2; ++a)
#pragma unroll
        for (int b = 0; b < 2; ++b)
#pragma unroll
            for (int m = 0; m < 4; ++m)
#pragma unroll
                for (int n = 0; n < 2; ++n) acc[a][b][m][n] = (f32x4){0.f, 0.f, 0.f, 0.f};
    bf16x8 At[4][2], B0[2][2], B1[2][2];
    unsigned cA = GATHER ? 0u : (unsigned)cur.pm * tstepA, cB = (unsigned)cur.e * (unsigned)g.bstride + (unsigned)cur.pn * tstep;
    const __amdgpu_buffer_rsrc_t rsA = __builtin_amdgcn_make_buffer_rsrc((void*)g.A, 0, 0x7fffffff, 0x00020000), rsB = __builtin_amdgcn_make_buffer_rsrc((void*)g.Bt, 0, 0x7fffffff, 0x00020000);
    S.a_ready(cur);
    if constexpr (GATHER) PG8_GLOAD(gA, 0);
    if constexpr (SP2) {
        PG8_STAGE(rsB, PG8_SB(0, 0), cB, voffB); PG8_STAGE(rsB, PG8_SB(0, 1), cB + hstep, voffB); PG8_STAGE(rsA, PG8_SA(0, 0), cA, PG8_VA(0)); PG8_STAGE(rsA, PG8_SA(0, 1), cA + hsA, PG8_VA(1));
        if (wr == 1) PG8_BAR;
        PG8_WAIT_V(2); PG8_BAR;
        PG8_STAGE(rsB, PG8_SB(1, 0), cB + kstep, voffB); PG8_STAGE(rsA, PG8_SA(1, 0), cA + kstep, PG8_VA(0)); PG8_STAGE(rsB, PG8_SB(1, 1), cB + hstep + kstep, voffB);
        PG8_WAIT_V(6); PG8_BAR;
    } else {
        PG8_STAGE(rsB, PG8_SB(0, 0), cB, voffB); PG8_STAGE(rsA, PG8_SA(0, 0), cA, PG8_VA(0)); PG8_STAGE(rsB, PG8_SB(0, 1), cB + hstep, voffB); PG8_STAGE(rsA, PG8_SA(0, 1), cA + hsA, PG8_VA(1));
        if (wr == 1) PG8_BAR;
        PG8_WAIT_V(4); PG8_BAR;
        PG8_STAGE(rsB, PG8_SB(1, 0), cB + kstep, voffB); PG8_STAGE(rsA, PG8_SA(1, 0), cA + kstep, PG8_VA(0)); PG8_STAGE(rsB, PG8_SB(1, 1), cB + hstep + kstep, voffB);
        PG8_WAIT_V(6); PG8_BAR;
    }
    for (;;) {
        const bool has_next = S.next(ui + 1, nxt);
        if constexpr (GATHER) { if (has_next) PG8_GLOAD(ngA, ui + 1); else { ngA[0][0] = gA[0][0]; ngA[0][1] = gA[0][1]; ngA[1][0] = gA[1][0]; ngA[1][1] = gA[1][1]; } }
        const unsigned nA = (has_next && !GATHER) ? (unsigned)nxt.pm * tstepA : cA, nB = has_next ? (unsigned)nxt.e * (unsigned)g.bstride + (unsigned)nxt.pn * tstep : cB;
        for (int t = 0; t < nt; t += 2) {
            const bool last = (t == nt - 2);
            const unsigned a1 = cA + (unsigned)(t + 1) * kstep;
            const unsigned a2 = last ? nA : cA + (unsigned)(t + 2) * kstep, b2 = last ? nB : cB + (unsigned)(t + 2) * kstep;
            const unsigned a3 = a2 + kstep, b3 = b2 + kstep;
            if (last && has_next) S.a_ready(nxt);
            if constexpr (SP2) {
            PG8_LDB(B0, 0, 0); PG8_LDB(B1, 0, 1); PG8_SCHED; PG8_LDA(At, 0, 0); PG8_STAGE(rsA, PG8_SA(1, 1), a1 + hsA, PG8_VA(1));
            if constexpr (GATHER) { if (last) { gA[0][0] = ngA[0][0]; gA[0][1] = ngA[0][1]; gA[1][0] = ngA[1][0]; gA[1][1] = ngA[1][1]; } }
            PG8_WAIT_V(8); PG8_WAIT_L(0); PG8_BAR; PG8_MMA(0, 0, At, B0); PG8_MMA(0, 1, At, B1); PG8_BAR; PG8_SCHED;
            PG8_LDA(At, 0, 1); PG8_STAGE(rsB, PG8_SB(0, 0), b2, voffB); PG8_STAGE(rsB, PG8_SB(0, 1), b2 + hstep, voffB); PG8_STAGE(rsA, PG8_SA(0, 0), a2, PG8_VA(0));
            PG8_WAIT_V(8); PG8_WAIT_L(0); PG8_BAR; PG8_MMA(1, 0, At, B0); PG8_MMA(1, 1, At, B1); PG8_BAR; PG8_SCHED;
            PG8_LDB(B0, 1, 0); PG8_LDB(B1, 1, 1); PG8_SCHED; PG8_LDA(At, 1, 0); PG8_STAGE(rsA, PG8_SA(0, 1), a2 + hsA, PG8_VA(1));
            PG8_WAIT_V(8); PG8_WAIT_L(0); PG8_BAR; PG8_MMA(0, 0, At, B0); PG8_MMA(0, 1, At, B1); PG8_BAR; PG8_SCHED;
            PG8_LDA(At, 1, 1); PG8_STAGE(rsB, PG8_SB(1, 0), b3, voffB); PG8_STAGE(rsB, PG8_SB(1, 1), b3 + hstep, voffB); PG8_STAGE(rsA, PG8_SA(1, 0), a3, PG8_VA(0));
            PG8_WAIT_V(8); PG8_WAIT_L(0); PG8_BAR; PG8_MMA(1, 0, At, B0); PG8_MMA(1, 1, At, B1); PG8_BAR; PG8_SCHED;
            } else {
            PG8_LDB(B0, 0, 0); PG8_SCHED; PG8_LDA(At, 0, 0); PG8_STAGE(rsA, PG8_SA(1, 1), a1 + hsA, PG8_VA(1));
            PG8_WAIT_L(8); PG8_BAR; PG8_WAIT_L(0); PG8_MMA(0, 0, At, B0); PG8_BAR; PG8_SCHED;
            PG8_LDB(B1, 0, 1); PG8_STAGE(rsB, PG8_SB(0, 0), b2, voffB);
            PG8_BAR; PG8_WAIT_L(0); PG8_MMA(0, 1, At, B1); PG8_BAR;
            PG8_LDA(At, 0, 1); PG8_STAGE(rsA, PG8_SA(0, 0), a2, PG8_VA(0));
            PG8_BAR; PG8_WAIT_L(0); PG8_MMA(1, 0, At, B0); PG8_BAR; PG8_SCHED;
            PG8_STAGE(rsB, PG8_SB(0, 1), b2 + hstep, voffB);
            PG8_WAIT_V(6); PG8_BAR; PG8_MMA(1, 1, At, B1); PG8_BAR;
            PG8_LDB(B0, 1, 0); PG8_SCHED; PG8_LDA(At, 1, 0); PG8_STAGE(rsA, PG8_SA(0, 1), a2 + hsA, PG8_VA(1));
            PG8_WAIT_L(8); PG8_BAR; PG8_WAIT_L(0); PG8_MMA(0, 0, At, B0); PG8_BAR; PG8_SCHED;
            PG8_LDB(B1, 1, 1); PG8_STAGE(rsB, PG8_SB(1, 0), b3, voffB);
            PG8_BAR; PG8_WAIT_L(0); PG8_MMA(0, 1, At, B1); PG8_BAR;
            PG8_LDA(At, 1, 1); PG8_STAGE(rsA, PG8_SA(1, 0), a3, PG8_VA(0));
            PG8_BAR; PG8_WAIT_L(0); PG8_MMA(1, 0, At, B0); PG8_BAR; PG8_SCHED;
            PG8_STAGE(rsB, PG8_SB(1, 1), b3 + hstep, voffB);
            PG8_WAIT_V(6); PG8_BAR; PG8_MMA(1, 1, At, B1); PG8_BAR;
            }
        }
        if constexpr (ALIGN_EPI) { if (wr == 0) PG8_BAR; }
        if constexpr (FP8) mfma_fp8_drain();
        if constexpr (!Epi::AFTER_DRAIN) { E(acc, cur, wr, wc, fr, fq); S.done(cur); }
        if (!has_next) break;
#pragma unroll
        for (int a = 0; a < 2; ++a)
#pragma unroll
            for (int b = 0; b < 2; ++b)
#pragma unroll
                for (int m = 0; m < 4; ++m)
#pragma unroll
                    for (int n = 0; n < 2; ++n) acc[a][b][m][n] = (f32x4){0.f, 0.f, 0.f, 0.f};
        cur = nxt; cA = nA; cB = nB; ++ui;
        if constexpr (ALIGN_EPI) { if (wr == 1) PG8_BAR; }
    }
    PG8_WAIT_V(0);
    if constexpr (!ALIGN_EPI) { if (wr == 0) PG8_BAR; }
    PG8_BAR;
    if constexpr (Epi::AFTER_DRAIN) { E.fused(acc, cur, wr, wc, fr, fq, lds, wid, lane); S.done(cur); }
#undef PG8_SA
#undef PG8_GLOAD
#undef PG8_VA
#undef PG8_SB
#undef PG8_STAGE
#undef PG8_LDA
#undef PG8_LDB
#undef PG8_MMA
#undef PG8_WAIT_V
#undef PG8_WAIT_L
#undef PG8_BAR
#undef PG8_SCHED
}
}

#define GAS __attribute__((address_space(1)))
#define LAS __attribute__((address_space(3)))
#define XB_TMO      128
#define XB_XCNT(j)  (256  + 64 * (j))
#define XB_XSUB(j)  (1280 + 64 * (j))
#define XB_XGEN(j)  (2304 + 64 * (j))
#define XB_TOP      3328
#define XB_TOPGEN   3392
#define XCD_BAR_WORDS 3456
#define XB_SPIN_CAP (1u << 18)

__device__ __forceinline__ unsigned xb_ld(unsigned* p)              { return __hip_atomic_load(p, __ATOMIC_RELAXED, __HIP_MEMORY_SCOPE_AGENT); }
__device__ __forceinline__ unsigned xb_add(unsigned* p, unsigned v) { return __hip_atomic_fetch_add(p, v, __ATOMIC_RELAXED, __HIP_MEMORY_SCOPE_AGENT); }
__device__ __forceinline__ unsigned xb_xcc_id() { return (unsigned)__builtin_amdgcn_s_getreg((3 << 11) | 20) & 0xFu; }
#define XB_SPIN(cond, bar) do { unsigned _sp = 0; while (cond) { __builtin_amdgcn_s_sleep(1); \
    if ((++_sp & 255u) == 0u) { if (xb_ld(&(bar)[XB_TMO])) break; if (_sp > XB_SPIN_CAP) { atomicAdd(&(bar)[XB_TMO], 1u); break; } } } } while (0)

struct XcdBarrier {
    unsigned* bar; unsigned x;
    volatile LAS unsigned* st;
};

__device__ __forceinline__ XcdBarrier xcd_barrier_post(unsigned* bar, volatile LAS unsigned* st) {
    XcdBarrier b; b.bar = bar; b.x = xb_xcc_id(); b.st = st;
    if (threadIdx.x == 0) (void)xb_add(&bar[XB_XCNT(b.x)], 1u);
    return b;
}
__device__ __forceinline__ void xcd_barrier_complete(unsigned* bar, unsigned x, unsigned& nloc, unsigned& nx) {
    const unsigned G = gridDim.x * gridDim.y * gridDim.z;
    unsigned sum, cnt, mine, sp = 0u;
    for (;;) {
        sum = 0u; cnt = 0u; mine = 0u;
#pragma unroll
        for (unsigned j = 0; j < 16; ++j) { const unsigned c = xb_ld(&bar[XB_XCNT(j)]); sum += c; cnt += (c > 0u) ? 1u : 0u; mine = (j == x) ? c : mine; }
        if (sum == G) break;
        __builtin_amdgcn_s_sleep(1);
        if ((++sp & 255u) == 0u) { if (xb_ld(&bar[XB_TMO])) break; if (sp > XB_SPIN_CAP) { atomicAdd(&bar[XB_TMO], 1u); break; } }
    }
    nloc = mine > 0u ? mine : 1u; nx = cnt > 0u ? cnt : 1u;
}

__device__ __forceinline__ void xcd_barrier(const XcdBarrier& b) {
    asm volatile("s_waitcnt vmcnt(0)" ::: "memory");
    __syncthreads();
    if (threadIdx.x == 0) {
        unsigned* bar = b.bar;
        __builtin_amdgcn_s_waitcnt(0);
        unsigned nloc = b.st[0], nx = b.st[1];
        if (nloc == 0u) { xcd_barrier_complete(bar, b.x, nloc, nx); b.st[0] = nloc; b.st[1] = nx; }
        const unsigned old = xb_add(&bar[XB_XSUB(b.x)], 1u);
        const unsigned gen = old / nloc;
        if (old + 1u == (gen + 1u) * nloc) {
            __builtin_amdgcn_fence(__ATOMIC_RELEASE, "agent");
            asm volatile("s_waitcnt vmcnt(0)" ::: "memory");
            const unsigned og = xb_add(&bar[XB_TOP], 1u);
            const unsigned tg = og / nx;
            if (og + 1u == (tg + 1u) * nx) xb_add(&bar[XB_TOPGEN], 1u);
            else XB_SPIN(xb_ld(&bar[XB_TOPGEN]) == tg, bar);
            __builtin_amdgcn_fence(__ATOMIC_ACQUIRE, "agent");
            xb_add(&bar[XB_XGEN(b.x)], 1u);
            asm volatile("s_waitcnt vmcnt(0)" ::: "memory");
        } else {
            XB_SPIN(xb_ld(&bar[XB_XGEN(b.x)]) == gen, bar);
            __builtin_amdgcn_fence(__ATOMIC_ACQUIRE, "agent");
            asm volatile("s_waitcnt vmcnt(0)" ::: "memory");
        }
    }
    __syncthreads();
}

template <int MODE  >
__device__ __forceinline__ void transpose_item(const float* __restrict__ W, int K, int N, bf16_t* __restrict__ WT, const float* __restrict__ gain, float* scr, int item, int lane) {
    const int nblk = N / 32, kb = item / nblk, nb = item % nblk, k0 = 64 * kb, n0 = 32 * nb;
#pragma unroll
    for (int i = 0; i < 8; ++i) { const int kk = 8 * i + (lane >> 3), n4 = (lane & 7) * 4; f32x4 v = *(const f32x4*)(W + (size_t)(k0 + kk) * N + n0 + n4);
        if (gain) { const float g = gain[k0 + kk]; v = v * g; }
        float* s = scr + kk * 33 + n4; s[0] = v[0]; s[1] = v[1]; s[2] = v[2]; s[3] = v[3]; }
    asm volatile("s_waitcnt lgkmcnt(0)" ::: "memory");
    const int c = lane & 7;
#pragma unroll
    for (int j = 0; j < 4; ++j) { const int n = (lane >> 3) + 8 * j; const float* s = scr + (8 * c) * 33 + n;
        u32x4 o; o.x = pk2(s[0 * 33], s[1 * 33]); o.y = pk2(s[2 * 33], s[3 * 33]); o.z = pk2(s[4 * 33], s[5 * 33]); o.w = pk2(s[6 * 33], s[7 * 33]);
        int row = n0 + n;
        if (MODE == 1) { const int f = row & 1023; row = ((f >> 7) << 8) + ((row >> 10) << 7) + (f & 127); }
        if (MODE == 2) { const int hh = row / DQK; row = hh * 128 + (row - hh * DQK); }
        *(u32x4*)(WT + (size_t)row * K + k0 + 8 * c) = o; }
    asm volatile("s_waitcnt lgkmcnt(0)" ::: "memory");
}
template <int MODE>
__device__ __forceinline__ void transpose_item_fp8(const float* __restrict__ W, int K, int N, unsigned char* __restrict__ WT, float* scr, int item, int lane) {
    const int nblk = N / 32, kb = item / nblk, nb = item % nblk, k0 = 64 * kb, n0 = 32 * nb;
#pragma unroll
    for (int i = 0; i < 8; ++i) { const int kk = 8 * i + (lane >> 3), n4 = (lane & 7) * 4; const f32x4 v = *(const f32x4*)(W + (size_t)(k0 + kk) * N + n0 + n4) * W8_SCALE;
        float* s = scr + kk * 33 + n4; s[0] = v[0]; s[1] = v[1]; s[2] = v[2]; s[3] = v[3]; }
    asm volatile("s_waitcnt lgkmcnt(0)" ::: "memory");
    const int c = lane & 7;
#pragma unroll
    for (int j = 0; j < 4; ++j) { const int n = (lane >> 3) + 8 * j; const float* s = scr + (8 * c) * 33 + n;
        u32x2 o; o.x = pk4_fp8(s[0 * 33], s[1 * 33], s[2 * 33], s[3 * 33]); o.y = pk4_fp8(s[4 * 33], s[5 * 33], s[6 * 33], s[7 * 33]);
        int row = n0 + n;
        if (MODE == 1) { const int f = row & 1023; row = ((f >> 7) << 8) + ((row >> 10) << 7) + (f & 127); }
        *(u32x2*)(WT + (size_t)row * K + k0 + 8 * c) = o; }
    asm volatile("s_waitcnt lgkmcnt(0)" ::: "memory");
}
__device__ __forceinline__ void phase_prologue(const Params& p, unsigned char* lds) {
    const int tid = threadIdx.x, lane = tid & 63, wave = tid >> 6;
    float* scr = (float*)(lds + wave * 16384);
    const int gw = blockIdx.x * NWAVES + wave, NGW = gridDim.x * NWAVES;
    unsigned char* ws = p.ws;
    constexpr int I_WIN = (DM / 64) * (INC / 32), I_UQ = (QLORA / 64) * (768 / 32), I_UKV = (KVLORA / 64) * (1024 / 32), I_OM = (512 / 64) * (DM / 32), I_OC = I_OM, I_WO = (DM / 64) * (DM / 32);
    constexpr int I_W1 = (DM / 64) * (2048 / 32), I_W2 = (DFF / 64) * (DM / 32);
    constexpr int NSMALL = I_WIN + I_UQ + I_UKV + I_OM + I_OC + I_WO;
    constexpr int NITEMS = NSMALL;
    for (int it = gw; it < NITEMS; it += NGW) {
        int r = it;
        if (r < I_WIN) { transpose_item<0>(p.w_in, DM, INC, (bf16_t*)(ws + WS_WIN), p.norm1_g, scr, r, lane); continue; } r -= I_WIN;
        if (r < I_UQ) { transpose_item<2>(p.w_uq, QLORA, 768, (bf16_t*)(ws + WS_WUQ), p.q_a_g, scr, r, lane); continue; } r -= I_UQ;
        if (r < I_UKV) { transpose_item<0>(p.w_ukv, KVLORA, 1024, (bf16_t*)(ws + WS_WUKV), p.kv_a_g, scr, r, lane); continue; } r -= I_UKV;
        if (r < I_OM) { transpose_item<0>(p.w_o_mla, 512, DM, (bf16_t*)(ws + WS_WOMLA), nullptr, scr, r, lane); continue; } r -= I_OM;
        if (r < I_OC) { transpose_item<0>(p.w_o_conv, 512, DM, (bf16_t*)(ws + WS_WOCONV), nullptr, scr, r, lane); continue; } r -= I_OC;
        transpose_item<0>(p.w_o, DM, DM, (bf16_t*)(ws + WS_WO), nullptr, scr, r, lane);
    }
    { u32x4* z = (u32x4*)((bf16_t*)(ws + WS_WIN) + (size_t)INC * DM); const int nz = (INCP - INC) * DM * 2 / 16;
      for (int i = blockIdx.x * NTHREADS + tid; i < nz; i += gridDim.x * NTHREADS) z[i] = (u32x4){0u, 0u, 0u, 0u}; }
    { u32x4* wq = (u32x4*)(ws + WS_WUQ); for (int i = blockIdx.x * NTHREADS + tid; i < NH * 32 * QLORA * 2 / 16; i += gridDim.x * NTHREADS) { const int hh = i / (32 * QLORA * 2 / 16), q = i - hh * (32 * QLORA * 2 / 16); wq[(hh * 128 + 96) * (QLORA * 2 / 16) + q] = (u32x4){0u, 0u, 0u, 0u}; } }
    { float* csd = (float*)(ws + WS_CS); for (int i = blockIdx.x * NTHREADS + tid; i < NTOK * 16; i += gridDim.x * NTHREADS) { const int t = i >> 4, j = i & 15; float sn, cn; sincosf((float)p.pos[t] * exp2f(-(float)j * (13.287712379549449f / 16.f)), &sn, &cn); csd[t * 32 + j] = cn; csd[t * 32 + 16 + j] = sn; } }
    { int* rt = (int*)(ws + WS_RT2); int* rs = (int*)(ws + WS_RT2 + 4 * MiB); float* rr = (float*)(ws + WS_RT2 + 6 * MiB);
      for (int i = blockIdx.x * NTHREADS + tid; i < NE * CAP; i += gridDim.x * NTHREADS) { rt[i] = 0; rs[i] = -1; rr[i] = 0.f; } }
    { u32x4* GF = (u32x4*)(ws + WS_GF);
      for (int i = blockIdx.x * NTHREADS + tid; i < 64 * 64; i += gridDim.x * NTHREADS) { const int ks = i >> 6, ln = i & 63, r = ln & 31, h = ln >> 5; float v[8], lo[8]; unsigned hi[4];
#pragma unroll
          for (int j = 0; j < 8; ++j) { const int k = 16 * ks + 8 * h + j; v[j] = p.norm2_g[k] * p.router_w[(size_t)k * NE + r]; }
#pragma unroll
          for (int j = 0; j < 4; ++j) { hi[j] = pk2(v[2 * j], v[2 * j + 1]); lo[2 * j] = v[2 * j] - bf_lo(hi[j]); lo[2 * j + 1] = v[2 * j + 1] - bf_hi(hi[j]); }
          GF[(ks * 2 + 0) * 64 + ln] = (u32x4){hi[0], hi[1], hi[2], hi[3]}; GF[(ks * 2 + 1) * 64 + ln] = (u32x4){pk2(lo[0], lo[1]), pk2(lo[2], lo[3]), pk2(lo[4], lo[5]), pk2(lo[6], lo[7])}; } }
    bf16_t* XN = (bf16_t*)(ws + WS_XN);
    for (int m = gw; m < NTOK; m += NGW) {
        const f32x4* xr = (const f32x4*)(p.x + (size_t)m * DM) + lane; f32x4 v[4]; float s = 0.f;
#pragma unroll
        for (int j = 0; j < 4; ++j) { v[j] = xr[64 * j]; s += (v[j][0] * v[j][0] + v[j][1] * v[j][1]) + (v[j][2] * v[j][2] + v[j][3] * v[j][3]); }
        const float rstd = rsqrtf(wave_sum(s) * (1.f / DM) + EPS);
        u32x2* o = (u32x2*)(XN + (size_t)m * DM) + lane;
#pragma unroll
        for (int j = 0; j < 4; ++j) { u32x2 w; w.x = pk2(v[j][0] * rstd, v[j][1] * rstd); w.y = pk2(v[j][2] * rstd, v[j][3] * rstd); o[64 * j] = w; }
    }
}

struct ConvRaw { u32x4 u[3], c[3], bg; float m0, m2; };
__device__ __forceinline__ void conv_load(ConvRaw& r, const Params& p, int t, int lane) {
    const bf16_t* pr = (const bf16_t*)(p.ws + WS_PROJ) + (size_t)t * INCP; const int s = t & (SEQ - 1);
    r.m0 = s > 0 ? 1.f : 0.f; r.m2 = s < SEQ - 1 ? 1.f : 0.f;
    const bf16_t* pm = s > 0 ? pr - INCP : pr; const bf16_t* pp = s < SEQ - 1 ? pr + INCP : pr;
    r.u[0] = *(const u32x4*)(pm + OFF_U + 8 * lane); r.c[0] = *(const u32x4*)(pm + OFF_C + 8 * lane);
    r.u[1] = *(const u32x4*)(pr + OFF_U + 8 * lane); r.c[1] = *(const u32x4*)(pr + OFF_C + 8 * lane);
    r.u[2] = *(const u32x4*)(pp + OFF_U + 8 * lane); r.c[2] = *(const u32x4*)(pp + OFF_C + 8 * lane);
    r.bg = *(const u32x4*)(pr + OFF_B + 8 * lane);
}
__device__ __forceinline__ void mulpair8(const u32x4 u, const u32x4 c, float (&o)[8]) {
    o[0] = bf_lo(u.x) * bf_lo(c.x); o[1] = bf_hi(u.x) * bf_hi(c.x); o[2] = bf_lo(u.y) * bf_lo(c.y); o[3] = bf_hi(u.y) * bf_hi(c.y);
    o[4] = bf_lo(u.z) * bf_lo(c.z); o[5] = bf_hi(u.z) * bf_hi(c.z); o[6] = bf_lo(u.w) * bf_lo(c.w); o[7] = bf_hi(u.w) * bf_hi(c.w); }
__device__ __forceinline__ void conv_store(const ConvRaw& r, const Params& p, int t, int lane, const float (&cw0)[8], const float (&cw1)[8], const float (&cw2)[8]) {
    float cu0[8], cu1[8], cu2[8], bb[8], y[8]; mulpair8(r.u[0], r.c[0], cu0); mulpair8(r.u[1], r.c[1], cu1); mulpair8(r.u[2], r.c[2], cu2);
    bb[0] = bf_lo(r.bg.x); bb[1] = bf_hi(r.bg.x); bb[2] = bf_lo(r.bg.y); bb[3] = bf_hi(r.bg.y); bb[4] = bf_lo(r.bg.z); bb[5] = bf_hi(r.bg.z); bb[6] = bf_lo(r.bg.w); bb[7] = bf_hi(r.bg.w);
#pragma unroll
    for (int j = 0; j < 8; ++j) y[j] = bb[j] * (cw0[j] * r.m0 * cu0[j] + cw1[j] * cu1[j] + cw2[j] * r.m2 * cu2[j]);
    u32x4 o; o.x = pk2(y[0], y[1]); o.y = pk2(y[2], y[3]); o.z = pk2(y[4], y[5]); o.w = pk2(y[6], y[7]); *(u32x4*)((bf16_t*)(p.ws + WS_YBIN) + (size_t)t * CONVW + 8 * lane) = o;
}
__device__ __forceinline__ void phase_conv(const Params& p) {
    int tid = threadIdx.x; asm volatile("" : "+v"(tid)); const int lane = tid & 63, wave = tid >> 6;
    const int gw = blockIdx.x * NWAVES + wave, NGW = gridDim.x * NWAVES;
    float cw0[8], cw1[8], cw2[8];
#pragma unroll
    for (int j = 0; j < 8; ++j) { cw0[j] = p.conv_w[8 * lane + j]; cw1[j] = p.conv_w[CONVW + 8 * lane + j]; cw2[j] = p.conv_w[2 * CONVW + 8 * lane + j]; }
    for (int t = gw; t < NTOK; t += 2 * NGW) {
        const int t1 = t + NGW; const bool two = t1 < NTOK;
        ConvRaw r0, r1; conv_load(r0, p, t, lane); conv_load(r1, p, two ? t1 : t, lane);
        conv_store(r0, p, t, lane, cw0, cw1, cw2);
        if (two) conv_store(r1, p, t1, lane, cw0, cw1, cw2);
    }
}

constexpr int WC_EXP_ITEMS = NE * 1536, WC_TILE_F = 32 * 68;
struct WcItem { const float* W; unsigned char* WT; int N, k0, n0, mode; };
__device__ __forceinline__ WcItem wc_decode(const Params& p, int x) {
    WcItem it; const int e = x / 1536, r = x - e * 1536;
    if (r < 1024) { it.W = p.w1 + (size_t)e * DM * 2048; it.WT = p.ws + WS_W1 + (size_t)e * 2048 * DM; it.N = 2048; it.k0 = 64 * (r >> 6); it.n0 = 32 * (r & 63); it.mode = 1; }
    else { const int q = r - 1024; it.W = p.w2 + (size_t)e * DFF * DM; it.WT = p.ws + WS_W2 + (size_t)e * DM * DFF; it.N = DM; it.k0 = 64 * (q >> 5); it.n0 = 32 * (q & 31); it.mode = 0; }
    return it;
}
struct WConv { float* tile; int x0, nitems, cs; f32x4 pend; };
__device__ __forceinline__ void wconv_step(WConv& c, const Params& p, int lane) {
    const int cs = c.cs, nst = 8 * c.nitems;
    if (cs > 0 && cs <= nst) {
        const int kk = 8 * ((cs - 1) & 7) + (lane >> 3), n4 = (lane & 7) * 4; float* t = c.tile + n4 * 68 + kk;
        t[0] = c.pend[0] * W8_SCALE; t[68] = c.pend[1] * W8_SCALE; t[136] = c.pend[2] * W8_SCALE; t[204] = c.pend[3] * W8_SCALE;
        if ((cs & 7) == 0) {
            const WcItem it = wc_decode(p, c.x0 + (cs >> 3) - 1); const int c8 = lane & 7;
#pragma unroll
            for (int j = 0; j < 4; ++j) { const int n = (lane >> 3) + 8 * j; const f32x4 a = *(const f32x4*)(c.tile + n * 68 + 8 * c8), b = *(const f32x4*)(c.tile + n * 68 + 8 * c8 + 4);
                u32x2 o; o.x = pk4_fp8(a[0], a[1], a[2], a[3]); o.y = pk4_fp8(b[0], b[1], b[2], b[3]);
                int row = it.n0 + n; if (it.mode == 1) { const int f = row & 1023; row = ((f >> 7) << 8) + ((row >> 10) << 7) + (f & 127); }
                *(u32x2*)(it.WT + (size_t)row * DM + it.k0 + 8 * c8) = o; }
        }
    }
    if (cs < nst) {
        const WcItem it = wc_decode(p, c.x0 + (cs >> 3)); const int kk = 8 * (cs & 7) + (lane >> 3), n4 = (lane & 7) * 4;
        c.pend = *(const f32x4*)(it.W + (size_t)(it.k0 + kk) * it.N + it.n0 + n4);
    }
    c.cs = cs + 1;
}

namespace att {
constexpr int NW = 8, QBLK = 32, KVBLK = 64;
constexpr float SCALE = 0.10206207261596575f;
constexpr float QSC = SCALE * 1.4426950408889634f;
constexpr int LDQ = 128, LDK = 128, LDV = DV;
constexpr int SHM_V = KVBLK * DV * 2, SHM_K = KVBLK * 128, SHM_ATTN = 2 * SHM_V + 2 * SHM_K + NW * 64 * 4;
#define KSWZ(row, colB) ((row) * 256 + ((colB) ^ (((row) & 7) << 4)))
#define SBAR() __builtin_amdgcn_sched_barrier(0)
__device__ __forceinline__ int crow(int r, int hi) { return (r & 3) + 8 * (r >> 2) + 4 * hi; }
__device__ __forceinline__ float fadd_s(float a, float b) { float r; asm("v_add_f32_e32 %0, %1, %2" : "=v"(r) : "v"(a), "v"(b)); return r; }
__device__ __forceinline__ unsigned cvtpk(float lo, float hi) { unsigned r; asm volatile("v_cvt_pk_bf16_f32 %0, %1, %2" : "=v"(r) : "v"(lo), "v"(hi)); return r; }
#define EXPH(P) do { _Pragma("unroll") for (int r = 0; r < 16; ++r) P[r] = __builtin_amdgcn_exp2f(P[r]); } while (0)
__device__ __forceinline__ void finishSM(f32x16& p0, f32x16& p1, float& l_reg, bf16x8& pa0, bf16x8& pa1, bf16x8& pa2, bf16x8& pa3) {
    EXPH(p1);
    float ps0 = p0[0], ps1 = p1[0];
#pragma unroll
    for (int r = 1; r < 16; ++r) { ps0 = fadd_s(ps0, p0[r]); ps1 = fadd_s(ps1, p1[r]); }
    l_reg += ps0 + ps1;
#define PK4(P, BASE, OUT) do { u32x4 w = {cvtpk(P[BASE + 0], P[BASE + 1]), cvtpk(P[BASE + 2], P[BASE + 3]), cvtpk(P[BASE + 4], P[BASE + 5]), cvtpk(P[BASE + 6], P[BASE + 7])}; OUT = *reinterpret_cast<bf16x8*>(&w); } while (0)
    PK4(p0, 0, pa0); PK4(p0, 8, pa1); PK4(p1, 0, pa2); PK4(p1, 8, pa3);
#undef PK4
}
typedef int i32x4a __attribute__((ext_vector_type(4))); typedef int i32x8a __attribute__((ext_vector_type(8)));
__device__ __forceinline__ void qkt(f32x16& p0, f32x16& p1, const unsigned char* Ks, const i32x8a* qf, int r32, int hi) {
    const f32x16 z = {};
#pragma unroll
    for (int kh = 0; kh < 2; ++kh) { const int row = kh * 32 + r32, sw = (row >> 1) & 7; const unsigned char* rb = Ks + row * 128; f32x16 acc = z;
#pragma unroll
        for (int s = 0; s < 2; ++s) { const int c0 = 4 * s + 2 * hi; const i32x4a lo = *reinterpret_cast<const i32x4a*>(rb + ((c0 ^ sw) << 4)), hh = *reinterpret_cast<const i32x4a*>(rb + (((c0 + 1) ^ sw) << 4));
            acc = __builtin_amdgcn_mfma_scale_f32_32x32x64_f8f6f4(__builtin_shufflevector(lo, hh, 0, 1, 2, 3, 4, 5, 6, 7), qf[s], acc, 0, 0, 0, 0, 0, 0); }
        if (kh == 0) p0 = acc; else p1 = acc; }
}
__device__ __forceinline__ int v_st(int k, int c) { const int kk = (k & ~0xC) | ((k & 4) << 1) | ((k & 8) >> 1); return ((kk >> 3) * 2 + (c >> 5)) * 512 + ((kk & 7) * 32 + (c & 31)) * 2; }
__device__ __forceinline__ int v_rd_base(int lane) { return ((lane & 3) << 3) | (((lane >> 2) & 3) << 6) | (((lane >> 4) & 1) << 5) | (((lane >> 5) & 1) << 8); }
constexpr int v_rd_off(int d0, int ks, int half) { return d0 * 512 + ks * 2048 + half * 1024; }
template <int OFF> __device__ __forceinline__ s16x4 tr_read(int vb) { s16x4 r; asm volatile("ds_read_b64_tr_b16 %0, %1 offset:%2" : "=&v"(r) : "v"(vb), "i"(OFF) : "memory"); return r; }
template <int D0> __device__ __forceinline__ void pv_one(f32x16& od, int vb, bf16x8 pa0, bf16x8 pa1, bf16x8 pa2, bf16x8 pa3) {
    const s16x4 l0 = tr_read<v_rd_off(D0, 0, 0)>(vb), h0 = tr_read<v_rd_off(D0, 0, 1)>(vb), l1 = tr_read<v_rd_off(D0, 1, 0)>(vb), h1 = tr_read<v_rd_off(D0, 1, 1)>(vb);
    const s16x4 l2 = tr_read<v_rd_off(D0, 2, 0)>(vb), h2 = tr_read<v_rd_off(D0, 2, 1)>(vb), l3 = tr_read<v_rd_off(D0, 3, 0)>(vb), h3 = tr_read<v_rd_off(D0, 3, 1)>(vb);
    asm volatile("s_waitcnt lgkmcnt(0)" ::: "memory"); SBAR();
#define PK(L, H) (bf16x8){L[0], L[1], L[2], L[3], H[0], H[1], H[2], H[3]}
    od = __builtin_amdgcn_mfma_f32_32x32x16_bf16(PK(l0, h0), pa0, od, 0, 0, 0);
    od = __builtin_amdgcn_mfma_f32_32x32x16_bf16(PK(l1, h1), pa1, od, 0, 0, 0);
    od = __builtin_amdgcn_mfma_f32_32x32x16_bf16(PK(l2, h2), pa2, od, 0, 0, 0);
    od = __builtin_amdgcn_mfma_f32_32x32x16_bf16(PK(l3, h3), pa3, od, 0, 0, 0);
#undef PK
}
__device__ __forceinline__ void pv_d0(f32x16* o, int vb, bf16x8 pa0, bf16x8 pa1, bf16x8 pa2, bf16x8 pa3) { pv_one<0>(o[0], vb, pa0, pa1, pa2, pa3); pv_one<1>(o[1], vb, pa0, pa1, pa2, pa3); }
struct VFrag { s16x4 l0, h0, l1, h1, l2, h2, l3, h3; };
template <int D0> __device__ __forceinline__ void vread(VFrag& f, int vb) {
    f.l0 = tr_read<v_rd_off(D0, 0, 0)>(vb); f.h0 = tr_read<v_rd_off(D0, 0, 1)>(vb); f.l1 = tr_read<v_rd_off(D0, 1, 0)>(vb); f.h1 = tr_read<v_rd_off(D0, 1, 1)>(vb);
    f.l2 = tr_read<v_rd_off(D0, 2, 0)>(vb); f.h2 = tr_read<v_rd_off(D0, 2, 1)>(vb); f.l3 = tr_read<v_rd_off(D0, 3, 0)>(vb); f.h3 = tr_read<v_rd_off(D0, 3, 1)>(vb); }
__device__ __forceinline__ void vmma(f32x16& od, const VFrag& f, bf16x8 pa0, bf16x8 pa1, bf16x8 pa2, bf16x8 pa3) {
#define PK(L, H) (bf16x8){L[0], L[1], L[2], L[3], H[0], H[1], H[2], H[3]}
    od = __builtin_amdgcn_mfma_f32_32x32x16_bf16(PK(f.l0, f.h0), pa0, od, 0, 0, 0);
    od = __builtin_amdgcn_mfma_f32_32x32x16_bf16(PK(f.l1, f.h1), pa1, od, 0, 0, 0);
    od = __builtin_amdgcn_mfma_f32_32x32x16_bf16(PK(f.l2, f.h2), pa2, od, 0, 0, 0);
    od = __builtin_amdgcn_mfma_f32_32x32x16_bf16(PK(f.l3, f.h3), pa3, od, 0, 0, 0);
#undef PK
}
#define EXPQ(P, B) do { _Pragma("unroll") for (int r = (B); r < (B) + 8; ++r) P[r] = __builtin_amdgcn_exp2f(P[r]); } while (0)
#define LWAIT() do { asm volatile("s_waitcnt lgkmcnt(0)" ::: "memory"); SBAR(); } while (0)
#define PV_STEP(vb, PN) do { LWAIT(); VFrag f1_; vread<1>(f1_, (vb)); vmma(o[0], f0, pa0, pa1, pa2, pa3); EXPQ(PN, 0); LWAIT(); vmma(o[1], f1_, pa0, pa1, pa2, pa3); EXPQ(PN, 8); SBAR(); } while (0)

__device__ __forceinline__ void attn_unit(const unsigned char* __restrict__ Qb, const unsigned char* __restrict__ Kh, const bf16_t* __restrict__ Vh, bf16_t* __restrict__ Ob, int seq, unsigned char* lds, WConv& wc, const Params& prm) {
    const int tid = threadIdx.x, wid = __builtin_amdgcn_readfirstlane(tid >> 6), lane = tid & 63, r32 = lane & 31, hi = lane >> 5;
    unsigned char* V_lds = lds; unsigned char* K_lds = lds + 2 * SHM_V;
    float l_reg = 0; f32x16 o[2] = {}; i32x8a qr[2];
    { const unsigned char* Qw = Qb + (size_t)(wid * QBLK + r32) * LDQ + hi * 32;
#pragma unroll
      for (int s = 0; s < 2; ++s) { const i32x4a lo = *reinterpret_cast<const i32x4a*>(Qw + 64 * s), hh = *reinterpret_cast<const i32x4a*>(Qw + 64 * s + 16); qr[s] = __builtin_shufflevector(lo, hh, 0, 1, 2, 3, 4, 5, 6, 7); } }
    const int kr0 = 8 * wid + (lane >> 3), kcp = lane & 7;
    const unsigned char* ksrc0 = Kh + (size_t)kr0 * LDK + ((kcp ^ ((kr0 >> 1) & 7)) * 16);
    const int vk = 8 * wid + ((lane >> 2) & 7), vcc = 32 * (lane >> 5) + 8 * (lane & 3);
    const bf16_t* vsrc = Vh + (size_t)vk * LDV + vcc;
    typedef __attribute__((address_space(3))) unsigned* lds_u32p;
#define DMA_K(t, slot) __builtin_amdgcn_global_load_lds((const unsigned*)(ksrc0 + (size_t)(t) * KVBLK * LDK), (lds_u32p)(K_lds + (slot) * SHM_K + wid * 1024 + lane * 16), 16, 0, 0)
#define DMA_V(t, slot) __builtin_amdgcn_global_load_lds((const unsigned*)(vsrc + (size_t)(t) * KVBLK * LDV), (lds_u32p)(V_lds + (slot) * SHM_V + wid * 1024 + lane * 16), 16, 0, 0)
    const int vb0 = (int)(uintptr_t)V_lds + v_rd_base(lane);
    f32x16 pA0, pA1, pB0, pB1; bf16x8 pa0, pa1, pa2, pa3; const int NT = seq / KVBLK;
    DMA_K(0, 0); DMA_V(0, 0); DMA_K(1, 1);
    asm volatile("s_waitcnt vmcnt(0)" ::: "memory"); __syncthreads();
    qkt(pA0, pA1, K_lds, qr, r32, hi); EXPH(pA0); SBAR();
    __syncthreads();
    VFrag f0;
    for (int j = 0; j + 2 < NT; j += 2) {
        DMA_K(j + 2, 0); DMA_V(j + 1, 1); wconv_step(wc, prm, lane); SBAR();
        vread<0>(f0, vb0);
        qkt(pB0, pB1, K_lds + SHM_K, qr, r32, hi);
        finishSM(pA0, pA1, l_reg, pa0, pa1, pa2, pa3); SBAR();
        PV_STEP(vb0, pB0);
        asm volatile("s_waitcnt vmcnt(0)" ::: "memory"); __syncthreads();
        DMA_K(j + 3, 1); DMA_V(j + 2, 0); wconv_step(wc, prm, lane); SBAR();
        vread<0>(f0, vb0 + SHM_V);
        qkt(pA0, pA1, K_lds, qr, r32, hi);
        finishSM(pB0, pB1, l_reg, pa0, pa1, pa2, pa3); SBAR();
        PV_STEP(vb0 + SHM_V, pA0);
        asm volatile("s_waitcnt vmcnt(0)" ::: "memory"); __syncthreads();
    }
    DMA_V(NT - 1, 1); wconv_step(wc, prm, lane); SBAR();
    vread<0>(f0, vb0);
    qkt(pB0, pB1, K_lds + SHM_K, qr, r32, hi);
    finishSM(pA0, pA1, l_reg, pa0, pa1, pa2, pa3); SBAR();
    PV_STEP(vb0, pB0);
    asm volatile("s_waitcnt vmcnt(0)" ::: "memory"); __syncthreads();
    finishSM(pB0, pB1, l_reg, pa0, pa1, pa2, pa3); SBAR();
    pv_d0(o, vb0 + SHM_V, pa0, pa1, pa2, pa3);
    { auto rr = __builtin_amdgcn_permlane32_swap(__float_as_uint(l_reg), __float_as_uint(l_reg), false, false); l_reg = __uint_as_float(rr[0]) + __uint_as_float(rr[1]); }
    const float rl = __builtin_amdgcn_rcpf(l_reg);
    bf16_t* Ow = Ob + (size_t)(wid * QBLK + r32) * 512 + 4 * hi;
#pragma unroll
    for (int d0 = 0; d0 < 2; ++d0)
#pragma unroll
        for (int g = 0; g < 4; ++g) { u32x2 w; w.x = pk2(o[d0][4 * g] * rl, o[d0][4 * g + 1] * rl); w.y = pk2(o[d0][4 * g + 2] * rl, o[d0][4 * g + 3] * rl); *(u32x2*)(Ow + d0 * 32 + 8 * g) = w; }
    __syncthreads();
#undef DMA_K
#undef DMA_V
}
#undef KSWZ
#undef SBAR
}

__device__ __forceinline__ void phase_attn(const Params& p, unsigned char* lds) {
    const unsigned char* Q = p.ws + WS_Q; const unsigned char* Kb = p.ws + WS_K; const bf16_t* V = (const bf16_t*)(p.ws + WS_V); bf16_t* AO = (bf16_t*)(p.ws + WS_AO);
    constexpr int NQB = SEQ / 256, NU = 2 * NH * NQB;
    const int lane = threadIdx.x & 63, wave = __builtin_amdgcn_readfirstlane(threadIdx.x >> 6), gw = blockIdx.x * NWAVES + wave, NGW = gridDim.x * NWAVES;
    const int ipw = (WC_EXP_ITEMS + NGW - 1) / NGW, nun = ((int)blockIdx.x < NU) ? (NU - 1 - (int)blockIdx.x) / (int)gridDim.x + 1 : 0, steps = nun * (SEQ / att::KVBLK - 1);
    int cov = (steps - 1) / 8; cov = cov < 0 ? 0 : (cov > ipw ? ipw : cov);
    WConv wc; wc.tile = (float*)(lds + att::SHM_ATTN) + wave * WC_TILE_F; wc.x0 = gw * ipw; wc.cs = 0; wc.pend = (f32x4){0.f, 0.f, 0.f, 0.f};
    { const int left = WC_EXP_ITEMS - wc.x0; wc.nitems = left < 0 ? 0 : (left < cov ? left : cov); }
    if (wave >= 4) __builtin_amdgcn_s_setprio(1);
    const bool xmap = false;
    for (int u0 = blockIdx.x, rnd = 0; u0 < NU; u0 += gridDim.x, ++rnd) {
        const int u = xmap ? (((int)blockIdx.x & 7) + 8 * rnd) * NQB + ((int)blockIdx.x >> 3) : u0;
        const int qb = u % NQB, h = (u / NQB) % NH, b = u / (NQB * NH); const size_t bh = (size_t)(b * NH + h) * SEQ;
        att::attn_unit(Q + (bh + (size_t)qb * 256) * 128, Kb + bh * 128, V + bh * DV, AO + ((size_t)b * SEQ + (size_t)qb * 256) * 512 + h * DV, SEQ, lds, wc, p);
    }
    __builtin_amdgcn_s_setprio(0);
    while (wc.cs <= 8 * wc.nitems) wconv_step(wc, p, lane);
}
__device__ __forceinline__ void wconv_cleanup(const Params& p, unsigned char* lds) {
    constexpr int NQB = SEQ / 256, NU = 2 * NH * NQB;
    const int lane = threadIdx.x & 63, wave = threadIdx.x >> 6, gw = blockIdx.x * NWAVES + wave, NGW = gridDim.x * NWAVES;
    const int ipw = (WC_EXP_ITEMS + NGW - 1) / NGW, nun = ((int)blockIdx.x < NU) ? (NU - 1 - (int)blockIdx.x) / (int)gridDim.x + 1 : 0, steps = nun * (SEQ / att::KVBLK - 1);
    int cov = (steps - 1) / 8; cov = cov < 0 ? 0 : (cov > ipw ? ipw : cov);
    float* scr = (float*)(lds + wave * 16384);
    for (int i = cov; i < ipw; ++i) { const int x = gw * ipw + i; if (x >= WC_EXP_ITEMS) break; const WcItem it = wc_decode(p, x); const int r = x % 1536;
        if (it.mode == 1) transpose_item_fp8<1>(it.W, DM, 2048, it.WT, scr, r, lane); else transpose_item_fp8<0>(it.W, DFF, DM, it.WT, scr, r - 1024, lane); }
    __syncthreads();
}

__device__ __forceinline__ int crow16(int r, int hi) { return (r & 3) + 8 * (r >> 2) + 4 * hi; }
__device__ __forceinline__ void phase_router(const Params& p, unsigned char* lds) {
    const int tid = threadIdx.x, lane = tid & 63, wid = tid >> 6, tile = wid >> 2, kq = wid & 3, c = lane & 31, h = lane >> 5;
    float* red = (float*)lds;
    float* ssb = red + 2 * 4 * 16 * 64;
    int* lcnt = (int*)(ssb + 2 * 4 * 64);
    int* lbase = lcnt + 32;
    unsigned* gcnt = (unsigned*)(p.ws + WS_CTL) + CW_CNT;
    int* row_tok = (int*)(p.ws + WS_RT2); float* row_w = (float*)(p.ws + WS_RT2 + 2 * MiB); int* row_slot = (int*)(p.ws + WS_RT2 + 4 * MiB); float* row_rstd = (float*)(p.ws + WS_RT2 + 6 * MiB);
    const u32x4* GF = (const u32x4*)(p.ws + WS_GF);
    for (int tg = blockIdx.x; tg < NTOK / 64; tg += gridDim.x) {
        if (tid < 32) lcnt[tid] = 0;
        const int token = tg * 64 + tile * 32 + c;
        const float* xrow = p.out + (size_t)token * DM + kq * 256 + 8 * h; const float* g2p = p.norm2_g + kq * 256 + 8 * h;
        unsigned char* hrow = p.ws + WS_H8 + (size_t)token * DM + kq * 256 + 8 * h;
        f32x16 acc = {}; float ss = 0.f;
#pragma unroll 2
        for (int s = 0; s < 16; ++s) {
            const f32x4 a = *(const f32x4*)(xrow + 16 * s), b = *(const f32x4*)(xrow + 16 * s + 4); const f32x4 ga = *(const f32x4*)(g2p + 16 * s), gb = *(const f32x4*)(g2p + 16 * s + 4);
            ss += (a[0] * a[0] + a[1] * a[1]) + (a[2] * a[2] + a[3] * a[3]) + (b[0] * b[0] + b[1] * b[1]) + (b[2] * b[2] + b[3] * b[3]);
            u32x4 xh; xh.x = pk2(a[0], a[1]); xh.y = pk2(a[2], a[3]); xh.z = pk2(b[0], b[1]); xh.w = pk2(b[2], b[3]);
            u32x4 xl; xl.x = pk2(a[0] - bf_lo(xh.x), a[1] - bf_hi(xh.x)); xl.y = pk2(a[2] - bf_lo(xh.y), a[3] - bf_hi(xh.y)); xl.z = pk2(b[0] - bf_lo(xh.z), b[1] - bf_hi(xh.z)); xl.w = pk2(b[2] - bf_lo(xh.w), b[3] - bf_hi(xh.w));
            u32x2 h8; h8.x = pk4_fp8(a[0] * ga[0], a[1] * ga[1], a[2] * ga[2], a[3] * ga[3]); h8.y = pk4_fp8(b[0] * gb[0], b[1] * gb[1], b[2] * gb[2], b[3] * gb[3]); *(u32x2*)(hrow + 16 * s) = h8;
            const u32x4 gh = GF[((kq * 16 + s) * 2 + 0) * 64 + lane], gl = GF[((kq * 16 + s) * 2 + 1) * 64 + lane];
            acc = __builtin_amdgcn_mfma_f32_32x32x16_bf16(__builtin_bit_cast(bf16x8, gh), __builtin_bit_cast(bf16x8, xh), acc, 0, 0, 0);
            acc = __builtin_amdgcn_mfma_f32_32x32x16_bf16(__builtin_bit_cast(bf16x8, gh), __builtin_bit_cast(bf16x8, xl), acc, 0, 0, 0);
            acc = __builtin_amdgcn_mfma_f32_32x32x16_bf16(__builtin_bit_cast(bf16x8, gl), __builtin_bit_cast(bf16x8, xh), acc, 0, 0, 0);
        }
#pragma unroll
        for (int r = 0; r < 16; ++r) red[((tile * 4 + kq) * 16 + r) * 64 + lane] = acc[r];
        ssb[(tile * 4 + kq) * 64 + lane] = ss;
        __syncthreads();
        int te[4] = {0, 0, 0, 0}, rl[4] = {0, 0, 0, 0}; float tw[4] = {0.f, 0.f, 0.f, 0.f}; float rstd = 0.f;
        if (kq == 0) {
            float v[16]; float st = 0.f;
#pragma unroll
            for (int q = 0; q < 4; ++q) st += ssb[(tile * 4 + q) * 64 + lane];
            { auto rr = __builtin_amdgcn_permlane32_swap(__float_as_uint(st), __float_as_uint(st), false, false); st = __uint_as_float(rr[0]) + __uint_as_float(rr[1]); }
            rstd = rsqrtf(st * (1.f / DM) + EPS);
#pragma unroll
            for (int r = 0; r < 16; ++r) { float sacc = 0.f;
#pragma unroll
                for (int q = 0; q < 4; ++q) sacc += red[((tile * 4 + q) * 16 + r) * 64 + lane];
                v[r] = sacc * rstd + p.router_b[crow16(r, h)]; }
            float lv[4]; int le[4];
#pragma unroll
            for (int k = 0; k < 4; ++k) { float best = v[0]; int bi = 0;
#pragma unroll
                for (int r = 1; r < 16; ++r) { const bool gt = v[r] > best; best = gt ? v[r] : best; bi = gt ? r : bi; }
                lv[k] = best; le[k] = (bi & 3) + 8 * (bi >> 2) + 4 * h;
#pragma unroll
                for (int r = 0; r < 16; ++r) v[r] = (r == bi) ? -INFINITY : v[r]; }
            float cv[8]; int ce[8];
#pragma unroll
            for (int k = 0; k < 4; ++k) { auto rv = __builtin_amdgcn_permlane32_swap(__float_as_uint(lv[k]), __float_as_uint(lv[k]), false, false); auto re = __builtin_amdgcn_permlane32_swap((unsigned)le[k], (unsigned)le[k], false, false);
                cv[k] = __uint_as_float(rv[0]); cv[4 + k] = __uint_as_float(rv[1]); ce[k] = (int)re[0]; ce[4 + k] = (int)re[1]; }
            float tv[4];
#pragma unroll
            for (int k = 0; k < 4; ++k) { float best = cv[0]; int be = ce[0]; int bi = 0;
#pragma unroll
                for (int r = 1; r < 8; ++r) { const bool gt = (cv[r] > best) || (cv[r] == best && ce[r] < be); best = gt ? cv[r] : best; be = gt ? ce[r] : be; bi = gt ? r : bi; }
                tv[k] = best; te[k] = be;
#pragma unroll
                for (int r = 0; r < 8; ++r) cv[r] = (r == bi) ? -INFINITY : cv[r]; }
            const float e1 = __expf(tv[1] - tv[0]), e2 = __expf(tv[2] - tv[0]), e3 = __expf(tv[3] - tv[0]); const float inv = 1.f / (1.f + e1 + e2 + e3);
            tw[0] = inv; tw[1] = e1 * inv; tw[2] = e2 * inv; tw[3] = e3 * inv;
            if (h == 0) {
#pragma unroll
                for (int k = 0; k < 4; ++k) rl[k] = atomicAdd(&lcnt[te[k]], 1); }
        }
        __syncthreads();
        if (tid < 32) lbase[tid] = (int)atomicAdd(&gcnt[tid], (unsigned)lcnt[tid]);
        __syncthreads();
        if (kq == 0 && h == 0) {
#pragma unroll
            for (int k = 0; k < 4; ++k) { const int idx = te[k] * CAP + lbase[te[k]] + rl[k]; row_tok[idx] = token; row_w[idx] = tw[k]; row_slot[idx] = token * 4 + k; row_rstd[idx] = rstd; } }
        __syncthreads();
    }
}

__device__ __forceinline__ void build_block_table(const Params& p, int* bs) {
    const unsigned* gcnt = (const unsigned*)(p.ws + WS_CTL) + CW_CNT;
    if (threadIdx.x == 0) { int acc = 0; for (int e = 0; e < NE; ++e) { bs[e] = acc; acc += ((int)__hip_atomic_load(gcnt + e, __ATOMIC_RELAXED, __HIP_MEMORY_SCOPE_AGENT) + 255) >> 8; } bs[NE] = acc; }
    __syncthreads();
}

__device__ __forceinline__ pg8::MoeOrder make_moe_order(const Params& p, unsigned char* lds, int N, bool gather) {
    int* bs = (int*)(lds + 131072); int* utab = (int*)(lds + 131072 + 256); int* gtab = (int*)(lds + 131072 + 512);
    build_block_table(p, bs);
    const int nmb = __builtin_amdgcn_readfirstlane(bs[NE]);
    pg8::MoeOrder S; S.so.init(nmb * 256, N, (int)gridDim.x, (int)blockIdx.x); S.utab = (const PG8_LAS int*)utab; S.gtab = (const PG8_LAS int*)gtab;
    const int* row_tok = (const int*)(p.ws + WS_RT2);
    for (int i = 0; i < pg8::MOE_MAXU; ++i) { pg8::Unit u; if (!S.so.next(i, u)) break; int e = 0; for (int k = 1; k < NE; ++k) if (bs[k] <= u.pm) e = k;
        const int rb = e * CAP + (u.pm - bs[e]) * 256;
        if (threadIdx.x == 0) utab[i] = e | (rb << 8);
        if (gather && threadIdx.x < 256) gtab[i * 256 + threadIdx.x] = row_tok[rb + threadIdx.x]; }
    __syncthreads();
    return S;
}
__device__ __forceinline__ void phase_moe1(const Params& p, unsigned char* lds) {
    const pg8::MoeOrder S = make_moe_order(p, lds, 2048, true);
    pg8::Gemm g{(const bf16_t*)(p.ws + WS_H8), (const bf16_t*)(p.ws + WS_W1), 0, 2048, DM / 2, (size_t)2048 * DM, 0};
    pg8::EpiSwiglu E{p.ws + WS_ACT, p.b1, (const float*)(p.ws + WS_RT2 + 6 * MiB)};
    pg8::gemm_phase<pg8::EpiSwiglu, pg8::MoeOrder, true, true, true, true>((PG8_LAS unsigned char*)lds, g, S, E);
}
__device__ __forceinline__ void phase_moe2(const Params& p, unsigned char* lds) {
    const pg8::MoeOrder S = make_moe_order(p, lds, DM, false);
    pg8::Gemm g{(const bf16_t*)(p.ws + WS_ACT), (const bf16_t*)(p.ws + WS_W2), 0, DM, DFF / 2, (size_t)DM * DFF, 0};
    pg8::EpiMoeOut E{p.ws + WS_YS, p.b2, (const float*)(p.ws + WS_RT2 + 2 * MiB), (const int*)(p.ws + WS_RT2 + 4 * MiB)};
    pg8::gemm_phase<pg8::EpiMoeOut, pg8::MoeOrder, true, true, true>((PG8_LAS unsigned char*)lds, g, S, E);
}

__device__ __forceinline__ float fp8_to_f32(unsigned w, int byte) {
    return byte == 0 ? __builtin_amdgcn_cvt_f32_fp8((int)w, 0) : byte == 1 ? __builtin_amdgcn_cvt_f32_fp8((int)w, 1) : byte == 2 ? __builtin_amdgcn_cvt_f32_fp8((int)w, 2) : __builtin_amdgcn_cvt_f32_fp8((int)w, 3); }
__device__ __forceinline__ void phase_combine(const Params& p) {
    const int tid = threadIdx.x, lane = tid & 63, wave = tid >> 6;
    const int gw = blockIdx.x * NWAVES + wave, NGW = gridDim.x * NWAVES;
    const unsigned char* YS = p.ws + WS_YS;
    for (int t = gw; t < NTOK; t += NGW) {
        f32x4* orow = (f32x4*)(p.out + (size_t)t * DM) + lane;
        f32x4 v[4]; unsigned w[4][4];
#pragma unroll
        for (int j = 0; j < 4; ++j) { v[j] = orow[64 * j];
#pragma unroll
            for (int k = 0; k < 4; ++k) w[j][k] = *((const unsigned*)(YS + ((size_t)t * 4 + k) * DM) + lane + 64 * j); }
#pragma unroll
        for (int j = 0; j < 4; ++j) { f32x4 s = {0.f, 0.f, 0.f, 0.f};
#pragma unroll
            for (int k = 0; k < 4; ++k) { s[0] += fp8_to_f32(w[j][k], 0); s[1] += fp8_to_f32(w[j][k], 1); s[2] += fp8_to_f32(w[j][k], 2); s[3] += fp8_to_f32(w[j][k], 3); }
            orow[64 * j] = v[j] + s * YS_INV; }
    }
}

template <class Epi>
__device__ __forceinline__ void dense_gemm(unsigned char* lds, const bf16_t* A, const bf16_t* Bt, int M, int N, int K, const Epi& E, int lda = 0) {
    pg8::Gemm g{A, Bt, M, N, K, 0, lda}; pg8::StaticOrder S; S.init(M, N, (int)gridDim.x, (int)blockIdx.x);
    pg8::gemm_phase<Epi, pg8::StaticOrder, true, true>((PG8_LAS unsigned char*)lds, g, S, E);
}

constexpr int NPHASE = 13;
__global__ void __launch_bounds__(NTHREADS, 2) mk_fwd(Params p) {
    extern __shared__ __attribute__((aligned(16))) unsigned char lds[];
    cg::grid_group grid = cg::this_grid();
    unsigned char* ws = p.ws;
    volatile LAS unsigned* MISC = (volatile LAS unsigned*)((LAS unsigned char*)lds + MISC_OFF);
    if (threadIdx.x < 32) MISC[threadIdx.x] = 0u;
    __syncthreads();
    XcdBarrier bar = xcd_barrier_post((unsigned*)(ws + WS_CTL) + CW_BAR, MISC + 8);
    const int lo = p.ph_lo, hi = p.ph_hi;
    if (lo < 0) grid.sync();
#define IN(k) (lo <= (k) && (k) < hi)
#define SEAM(k) do { if (IN(k) && IN((k) + 1)) xcd_barrier(bar); } while (0)
    if (IN(0)) phase_prologue(p, lds);
    SEAM(0);
    if (IN(1)) { pg8::EpiProj E{(bf16_t*)(ws + WS_PROJ), (float*)(ws + WS_SSQ)}; dense_gemm(lds, (const bf16_t*)(ws + WS_XN), (const bf16_t*)(ws + WS_WIN), NTOK, INCP, DM, E); }
    if (IN(1) && IN(3)) xcd_barrier(bar);
    if (IN(3)) { const float* ssq = (const float*)(ws + WS_SSQ); const float* cst = (const float*)(ws + WS_CS); float* hs = (float*)(lds + 131072);
                 pg8::EpiQ Eq{ws + WS_Q, ssq, p.q_g, cst, hs}; dense_gemm(lds, (const bf16_t*)(ws + WS_PROJ) + OFF_CQ, (const bf16_t*)(ws + WS_WUQ), NTOK, 1024, QLORA, Eq, INCP);
                 pg8::EpiKV Ek{ws + WS_K, (bf16_t*)(ws + WS_V), ssq, p.k_g, cst, (const bf16_t*)(ws + WS_PROJ), hs}; dense_gemm(lds, (const bf16_t*)(ws + WS_PROJ) + OFF_CKV, (const bf16_t*)(ws + WS_WUKV), NTOK, 1024, KVLORA, Ek, INCP);
                 phase_conv(p); }
    if (IN(3) && IN(5)) xcd_barrier(bar);
    if (IN(5)) phase_attn(p, lds);
    SEAM(5);
    if (IN(6)) { pg8::EpiGateA E{(bf16_t*)(ws + WS_M1), (const bf16_t*)(ws + WS_PROJ)}; dense_gemm(lds, (const bf16_t*)(ws + WS_AO), (const bf16_t*)(ws + WS_WOMLA), NTOK, DM, 512, E); }
    if (IN(7)) { pg8::EpiGateB E{(const bf16_t*)(ws + WS_M1), (const bf16_t*)(ws + WS_PROJ), (bf16_t*)(ws + WS_MERGED)}; dense_gemm(lds, (const bf16_t*)(ws + WS_YBIN), (const bf16_t*)(ws + WS_WOCONV), NTOK, DM, 512, E); }
    SEAM(7);
    if (IN(8)) { pg8::EpiResid E{p.x, p.out}; dense_gemm(lds, (const bf16_t*)(ws + WS_MERGED), (const bf16_t*)(ws + WS_WO), NTOK, DM, DM, E); }
    SEAM(8);
    if (IN(9)) { wconv_cleanup(p, lds); phase_router(p, lds); }
    if (IN(9) && IN(11)) xcd_barrier(bar);
    if (IN(11)) phase_moe1(p, lds);
    SEAM(11);
    if (IN(12)) phase_moe2(p, lds);
    SEAM(12);
    if (IN(13)) phase_combine(p);
#undef IN
#undef SEAM
}

extern "C" void kernel_launch(void* const* d_in, const int* in_sizes, int n_in, void* d_out, int out_size,
                              void* d_ws, size_t ws_size, hipStream_t stream) {
    static int grid_blocks = 0;
    if (!grid_blocks) {
        int dev = 0, cus = 0, per_cu = 0;
        (void)hipGetDevice(&dev);
        (void)hipDeviceGetAttribute(&cus, hipDeviceAttributeMultiprocessorCount, dev);
        (void)hipFuncSetAttribute((const void*)mk_fwd, hipFuncAttributeMaxDynamicSharedMemorySize, LDS_BYTES);
        (void)hipOccupancyMaxActiveBlocksPerMultiprocessor(&per_cu, (const void*)mk_fwd, NTHREADS, LDS_BYTES);
        if (per_cu < 1) { fprintf(stderr, "kernel_launch: occupancy query says %d blocks/CU\n", per_cu); per_cu = 1; }
        grid_blocks = cus;
        if (ws_size < WS_END2 || n_in != 21) fprintf(stderr, "kernel_launch: ws %zu < %zu or n_in %d != 21\n", ws_size, (size_t)WS_END2, n_in);
    }
    (void)hipMemsetAsync((char*)d_ws + WS_CTL, 0, 1 * MiB, stream);
    Params p{};
    p.x = (const float*)d_in[0]; p.pos = (const int*)d_in[1]; p.norm1_g = (const float*)d_in[2]; p.w_in = (const float*)d_in[3]; p.q_a_g = (const float*)d_in[4];
    p.kv_a_g = (const float*)d_in[5]; p.w_uq = (const float*)d_in[6]; p.w_ukv = (const float*)d_in[7]; p.q_g = (const float*)d_in[8]; p.k_g = (const float*)d_in[9];
    p.conv_w = (const float*)d_in[10]; p.w_o_mla = (const float*)d_in[11]; p.w_o_conv = (const float*)d_in[12]; p.w_o = (const float*)d_in[13]; p.norm2_g = (const float*)d_in[14];
    p.router_w = (const float*)d_in[15]; p.router_b = (const float*)d_in[16]; p.w1 = (const float*)d_in[17]; p.b1 = (const float*)d_in[18]; p.w2 = (const float*)d_in[19]; p.b2 = (const float*)d_in[20];
    p.out = (float*)d_out; p.ws = (unsigned char*)d_ws; p.ph_lo = 0; p.ph_hi = NPHASE + 1;
    void* args[] = {&p};
    hipError_t e = hipLaunchCooperativeKernel((const void*)mk_fwd, dim3(grid_blocks), dim3(NTHREADS), args, LDS_BYTES, stream);
    if (e != hipSuccess) fprintf(stderr, "cooperative launch failed: %s (grid %d)\n", hipGetErrorString(e), grid_blocks);
}
```

```cpp
#include <hip/hip_runtime.h>
#include <hip/hip_cooperative_groups.h>
#include <cstdio>
#include <cstdint>
namespace cg = cooperative_groups;

typedef unsigned short bf16_t;
typedef short bf16x8 __attribute__((ext_vector_type(8)));
typedef short s16x4 __attribute__((ext_vector_type(4)));
typedef float f32x4 __attribute__((ext_vector_type(4)));
typedef float f32x2 __attribute__((ext_vector_type(2)));
typedef float f32x16 __attribute__((ext_vector_type(16)));
typedef unsigned u32x4 __attribute__((ext_vector_type(4)));
typedef unsigned u32x2 __attribute__((ext_vector_type(2)));
typedef __bf16 bf16x2_t __attribute__((ext_vector_type(2)));

constexpr int NTOK = 16384, DM = 1024, SEQ = 8192;
constexpr int INC = 4000, INCP = 4096;
constexpr int OFF_CQ = 0, OFF_CKV = 256, OFF_KR = 384, OFF_U = 416, OFF_C = 928, OFF_B = 1440, OFF_GA = 1952, OFF_GB = 2976;
constexpr int NH = 8, DQK = 96, DV = 64, NE = 32, TOPK = 4, DFF = 1024;
constexpr int QLORA = 256, KVLORA = 128, CONVW = 512;
constexpr int NPAIR = NTOK * TOPK;
constexpr int MAXROWS = 73728;
constexpr float EPS = 1e-6f;
constexpr float QSCALE = 0.10206207261596575f * 1.4426950408889634f;
constexpr int CAP = 16384;
constexpr int NTHREADS = 512, NWAVES = 8;
constexpr int LDS_BYTES = 147456;

constexpr size_t MiB = 1ull << 20;
constexpr size_t WS_CTL = 0;
constexpr size_t WS_WIN = 1 * MiB;
constexpr size_t WS_WUQ = 9 * MiB;
constexpr size_t WS_WUKV = WS_WUQ + 512 * 1024;
constexpr size_t WS_WOMLA = 10 * MiB;
constexpr size_t WS_WOCONV = 11 * MiB;
constexpr size_t WS_WO = 12 * MiB;
constexpr size_t WS_ROUTE = 14 * MiB;
constexpr size_t WS_W1 = 18 * MiB;
constexpr size_t WS_W2 = 146 * MiB;
constexpr size_t WS_XN = 210 * MiB;
constexpr size_t WS_PROJ = 242 * MiB;
constexpr size_t WS_CQN = 370 * MiB;
constexpr size_t WS_CKVN = 378 * MiB;
constexpr size_t WS_YBIN = 386 * MiB;
constexpr size_t WS_QPRE = 402 * MiB;
constexpr size_t WS_KVPRE = 450 * MiB;
constexpr size_t WS_Q = 514 * MiB;
constexpr size_t WS_K = 538 * MiB;
constexpr size_t WS_V = 570 * MiB;
constexpr size_t WS_AO = 586 * MiB;
constexpr size_t WS_M1 = 602 * MiB;
constexpr size_t WS_MERGED = 666 * MiB;
constexpr size_t WS_YS = 698 * MiB;
constexpr size_t WS_END = 826 * MiB;
constexpr size_t WS_ACT = WS_PROJ;
constexpr size_t WS_H8 = WS_XN;
constexpr size_t WS_GF = 830 * MiB;
constexpr size_t WS_RT2 = 832 * MiB;
constexpr size_t WS_SSQ = 840 * MiB;
constexpr size_t WS_CS = 841 * MiB;
constexpr size_t WS_SHIFT = 843 * MiB;
constexpr size_t WS_END2 = 844 * MiB;
constexpr size_t RT_PAIR_E = 0, RT_PAIR_RANK = 262144, RT_PAIR_W = 524288, RT_ROW_TOK = 786432, RT_ROW_W = 786432 + 294912, RT_ROW_SLOT = 786432 + 2 * 294912;
constexpr int CW_CNT = 64;
constexpr int CW_BAR = 4096;
constexpr int MISC_OFF = LDS_BYTES - 256;

struct Params {
    const float* x; const int* pos; const float* norm1_g; const float* w_in; const float* q_a_g; const float* kv_a_g;
    const float* w_uq; const float* w_ukv; const float* q_g; const float* k_g; const float* conv_w; const float* w_o_mla;
    const float* w_o_conv; const float* w_o; const float* norm2_g; const float* router_w; const float* router_b;
    const float* w1; const float* b1; const float* w2; const float* b2;
    float* out; unsigned char* ws; int ph_lo, ph_hi;
};

__device__ __forceinline__ unsigned pk2(float lo, float hi) { f32x2 v = {lo, hi}; bf16x2_t b = __builtin_convertvector(v, bf16x2_t); return __builtin_bit_cast(unsigned, b); }
__device__ __forceinline__ float bf_lo(unsigned w) { return __uint_as_float(w << 16); }
__device__ __forceinline__ float bf_hi(unsigned w) { return __uint_as_float(w & 0xffff0000u); }
__device__ __forceinline__ float bf1(bf16_t h) { return __uint_as_float((unsigned)h << 16); }
__device__ __forceinline__ float wave_sum(float v) {
#pragma unroll
    for (int o = 1; o < 64; o <<= 1) v += __shfl_xor(v, o);
    return v;
}
__device__ __forceinline__ unsigned pk4_fp8(float a, float b, float c, float d) { unsigned w = 0u; w = (unsigned)__builtin_amdgcn_cvt_pk_fp8_f32(a, b, (int)w, false); w = (unsigned)__builtin_amdgcn_cvt_pk_fp8_f32(c, d, (int)w, true); return w; }
constexpr float Q8_SCALE = 4.f, K8_SCALE = 0.25f;
constexpr float W8_SCALE = 32.f, W8_INV = 1.f / 32.f, YS_SCALE = 8.f, YS_INV = 0.125f;
__device__ __forceinline__ float sigmoidf_(float v) { return __builtin_amdgcn_rcpf(1.f + __builtin_amdgcn_exp2f(v * -1.4426950408889634f)); }

namespace pg8 {
#define PG8_LAS __attribute__((address_space(3)))
constexpr int BM = 256, BK = 64, HALF = 128, HTB = HALF * BK * 2  , STAGE_BYTES = 8 * HTB, NXCD = 8, WGM = 8;

__host__ __device__ __forceinline__ int lds_byte(int r, int c) { const int st = (r >> 4) * 2 + (c >> 5), rr = r & 15, cc = c & 31, ob = rr * 64 + cc * 2; return st * 1024 + (ob ^ (((ob >> 9) & 1) << 5)); }
__host__ __device__ __forceinline__ void stage_rc(int b, int& R, int& C) { const int st = b / 1024, sb = b % 1024, swz = sb ^ (((sb >> 9) & 1) << 5); R = (st >> 1) * 16 + swz / 64; C = (st & 1) * 32 + (swz % 64) / 2; }
__host__ __device__ __forceinline__ int perm32(int rho) { const int n = rho >> 4, i = rho & 15; return 8 * (i >> 2) + 4 * n + (i & 3); }

struct Unit { int pm, pn, e, rb; };
struct Gemm { const bf16_t* A; const bf16_t* Bt; int M, N, K; size_t bstride; int lda, ldb; };

struct StaticOrder {
    int nM, nN, nwg, G, c;
    __host__ __device__ void init(int M, int N, int G_, int c_) { nM = M / BM; nN = N / BM; nwg = nM * nN; G = G_; c = c_; }
    __host__ __device__ bool next(int i, Unit& u) const {
        const long L = (long)i * G + c; if (L >= nwg) return false;
        int wgid = (int)L; { const int q = nwg / NXCD, r = nwg % NXCD, xcd = wgid % NXCD, off = wgid / NXCD; wgid = (xcd < r ? xcd * (q + 1) : r * (q + 1) + (xcd - r) * q) + off; }
        const int nig = WGM * nN, gid = wgid / nig, fm = gid * WGM, gsz = (nM - fm) < WGM ? (nM - fm) : WGM;
        u.pm = fm + ((wgid % nig) % gsz); u.pn = (wgid % nig) / gsz; u.e = 0; u.rb = 0; return true;
    }
    __device__ __forceinline__ void a_ready(const Unit&) const {}
    __device__ __forceinline__ void done(const Unit&) const {}
};


struct EpiProj {
    static constexpr bool PERM = true, AFTER_DRAIN = false;
    bf16_t* O; float* ssq;
    __device__ __forceinline__ void operator()(const f32x4 (&acc)[2][2][4][2], const Unit& u, int wr, int wc, int fr, int fq) const {
        const int row0 = u.pm * BM + wr * 64 + fr, col0 = u.pn * BM + wc * 32 + 8 * fq;
#pragma unroll
        for (int ai = 0; ai < 2; ++ai)
#pragma unroll
            for (int m = 0; m < 4; ++m) { const int row = row0 + ai * HALF + m * 16; bf16_t* rowp = O + (size_t)row * INCP + col0;
#pragma unroll
                for (int bj = 0; bj < 2; ++bj) { f32x4 v0 = acc[ai][bj][m][0], v1 = acc[ai][bj][m][1]; const int col = col0 + bj * HALF;
                    if (col >= OFF_GA && col < INC) {
#pragma unroll
                        for (int j = 0; j < 4; ++j) { v0[j] = sigmoidf_(v0[j]); v1[j] = sigmoidf_(v1[j]); } }
                    u32x4 w; w.x = pk2(v0[0], v0[1]); w.y = pk2(v0[2], v0[3]); w.z = pk2(v1[0], v1[1]); w.w = pk2(v1[2], v1[3]);
                    *(u32x4*)(rowp + bj * HALF) = w;
                    const int which = u.pn == 0 ? 0 : (u.pn == 1 ? (bj == 0 ? 1 : (wc == 0 ? 2 : -1)) : -1);
                    if (which >= 0) { float s = (v0[0] * v0[0] + v0[1] * v0[1]) + (v0[2] * v0[2] + v0[3] * v0[3]) + (v1[0] * v1[0] + v1[1] * v1[1]) + (v1[2] * v1[2] + v1[3] * v1[3]);
                        s += __shfl_xor(s, 16); s += __shfl_xor(s, 32); if (fq == 0) ssq[(size_t)row * 16 + (which == 0 ? wc * 2 + bj : (which == 1 ? 8 + wc : 12))] = s; } } }
    }
};
struct EpiBf16 {
    static constexpr bool PERM = true, AFTER_DRAIN = false;
    bf16_t* O; int ldc;
    __device__ __forceinline__ void operator()(const f32x4 (&acc)[2][2][4][2], const Unit& u, int wr, int wc, int fr, int fq) const {
        const int row0 = u.pm * BM + wr * 64 + fr, col0 = u.pn * BM + wc * 32 + 8 * fq;
#pragma unroll
        for (int ai = 0; ai < 2; ++ai)
#pragma unroll
            for (int m = 0; m < 4; ++m) { bf16_t* rowp = O + (size_t)(row0 + ai * HALF + m * 16) * ldc + col0;
#pragma unroll
                for (int bj = 0; bj < 2; ++bj) { const f32x4 v0 = acc[ai][bj][m][0], v1 = acc[ai][bj][m][1];
                    u32x4 w; w.x = pk2(v0[0], v0[1]); w.y = pk2(v0[2], v0[3]); w.z = pk2(v1[0], v1[1]); w.w = pk2(v1[2], v1[3]); *(u32x4*)(rowp + bj * HALF) = w; } }
    }
};
__device__ __forceinline__ void epi_bar() { asm volatile("s_waitcnt lgkmcnt(0)" ::: "memory"); __builtin_amdgcn_s_barrier(); asm volatile("" ::: "memory"); }
__device__ __forceinline__ u32x2 pk4bf(const f32x4 v) { u32x2 w; w.x = pk2(v[0], v[1]); w.y = pk2(v[2], v[3]); return w; }
struct EpiQ {
    static constexpr bool PERM = false, AFTER_DRAIN = false;
    unsigned char* Q; const float* ssq_cq; const float* qg; const float* cs; float* hs;
    __device__ __forceinline__ void operator()(f32x4 (&acc)[2][2][4][2], const Unit& u, int wr, int wc, int fr, int fq) const {
        int lr0 = wr * 64 + fr; asm volatile("" : "+v"(lr0), "+v"(fq));
        const int t0 = u.pm * BM + lr0;
#pragma unroll
        for (int ai = 0; ai < 2; ++ai)
#pragma unroll
            for (int m = 0; m < 4; ++m) { const f32x4 sa = *(const f32x4*)(ssq_cq + (size_t)(t0 + ai * HALF + m * 16) * 16), sb = *(const f32x4*)(ssq_cq + (size_t)(t0 + ai * HALF + m * 16) * 16 + 4);
                const float rq = rsqrtf((((sa[0] + sa[1]) + (sa[2] + sa[3])) + ((sb[0] + sb[1]) + (sb[2] + sb[3]))) * (1.f / QLORA) + EPS);
#pragma unroll
                for (int bj = 0; bj < 2; ++bj) { const f32x4 x0 = acc[ai][bj][m][0] * rq, x1 = acc[ai][bj][m][1] * rq; acc[ai][bj][m][0] = x0; acc[ai][bj][m][1] = x1;
                    float s = (x0[0] * x0[0] + x0[1] * x0[1]) + (x0[2] * x0[2] + x0[3] * x0[3]) + (x1[0] * x1[0] + x1[1] * x1[1]) + (x1[2] * x1[2] + x1[3] * x1[3]);
                    s += __shfl_xor(s, 16); s += __shfl_xor(s, 32); if (fq == 0) hs[((lr0 + ai * HALF + m * 16) * 2 + bj) * 4 + wc] = s; } }
        epi_bar();
        {
            f32x4 g0 = {0.f, 0.f, 0.f, 0.f}, g1 = g0; if (wc < 3) { g0 = *(const f32x4*)(qg + 32 * wc + 4 * fq); g1 = *(const f32x4*)(qg + 32 * wc + 16 + 4 * fq); }
#pragma unroll
            for (int ai = 0; ai < 2; ++ai)
#pragma unroll
                for (int m = 0; m < 4; ++m) { const int lr = lr0 + ai * HALF + m * 16, t = u.pm * BM + lr, b = t >> 13, s = t & (SEQ - 1);
                    f32x4 c4 = {0.f, 0.f, 0.f, 0.f}, s4 = {0.f, 0.f, 0.f, 0.f}; if (wc == 2) { c4 = *(const f32x4*)(cs + (size_t)t * 32 + 4 * fq); s4 = *(const f32x4*)(cs + (size_t)t * 32 + 16 + 4 * fq); }
#pragma unroll
                    for (int bj = 0; bj < 2; ++bj) { const f32x4 h4 = *(const f32x4*)(hs + (lr * 2 + bj) * 4); const float rstd = rsqrtf(((h4[0] + h4[1]) + h4[2]) * (1.f / DQK) + EPS) * (QSCALE * Q8_SCALE); f32x4 x0 = acc[ai][bj][m][0] * rstd * g0, x1 = acc[ai][bj][m][1] * rstd * g1;
                        if (wc == 2) { const f32x4 o0 = x0 * c4 - x1 * s4, o1 = x0 * s4 + x1 * c4; x0 = o0; x1 = o1; }
                        if (wc == 3 && fq == 0) x0[0] = Q8_SCALE;
                        unsigned char* qp = Q + ((size_t)(b * NH + 2 * u.pn + bj) * SEQ + s) * 128 + 32 * wc + 4 * fq; *(unsigned*)qp = pk4_fp8(x0[0], x0[1], x0[2], x0[3]); *(unsigned*)(qp + 16) = pk4_fp8(x1[0], x1[1], x1[2], x1[3]); }
                    asm volatile("" ::: "memory"); }
        }
    }
};
struct EpiK {
    static constexpr bool PERM = false, AFTER_DRAIN = false;
    unsigned char* K; const float* ssq; const float* kg; const float* cs; const bf16_t* proj; float* hs; const float* shiftp;
    __device__ __forceinline__ void operator()(f32x4 (&acc)[2][2][4][2], const Unit& u, int wr, int wc, int fr, int fq) const {
        int lr0 = wr * 64 + fr; asm volatile("" : "+v"(lr0), "+v"(fq));
        const int t0 = u.pm * BM + lr0, wp = wc & 1, wh = wc >> 1;
#pragma unroll
        for (int ai = 0; ai < 2; ++ai)
#pragma unroll
            for (int m = 0; m < 4; ++m) { const f32x4 sa = *(const f32x4*)(ssq + (size_t)(t0 + ai * HALF + m * 16) * 16 + 8); const float rk = rsqrtf(((sa[0] + sa[1]) + (sa[2] + sa[3])) * (1.f / KVLORA) + EPS);
#pragma unroll
                for (int bj = 0; bj < 2; ++bj) { const f32x4 x0 = acc[ai][bj][m][0] * rk, x1 = acc[ai][bj][m][1] * rk; acc[ai][bj][m][0] = x0; acc[ai][bj][m][1] = x1;
                    float s = (x0[0] * x0[0] + x0[1] * x0[1]) + (x0[2] * x0[2] + x0[3] * x0[3]) + (x1[0] * x1[0] + x1[1] * x1[1]) + (x1[2] * x1[2] + x1[3] * x1[3]);
                    s += __shfl_xor(s, 16); s += __shfl_xor(s, 32); if (fq == 0) hs[((lr0 + ai * HALF + m * 16) * 4 + 2 * bj + wh) * 2 + wp] = s; } }
        epi_bar();
        const f32x4 g0 = *(const f32x4*)(kg + 32 * wp + 4 * fq), g1 = *(const f32x4*)(kg + 32 * wp + 16 + 4 * fq);
        f32x4 gr0 = {0.f, 0.f, 0.f, 0.f}, gr1 = gr0; if (wp == 1) { gr0 = *(const f32x4*)(kg + 64 + 4 * fq); gr1 = *(const f32x4*)(kg + 80 + 4 * fq); }
        const unsigned kpad = (fq == 0) ? pk4_fp8(-shiftp[0] * K8_SCALE, 0.f, 0.f, 0.f) : 0u;
#pragma unroll
        for (int ai = 0; ai < 2; ++ai)
#pragma unroll
            for (int m = 0; m < 4; ++m) { const int lr = lr0 + ai * HALF + m * 16, t = u.pm * BM + lr, b = t >> 13, s = t & (SEQ - 1); const float skr = ssq[(size_t)t * 16 + 12];
                f32x4 c4 = {0.f, 0.f, 0.f, 0.f}, s4 = c4, r1 = c4, r2 = c4;
                if (wp == 1) { c4 = *(const f32x4*)(cs + (size_t)t * 32 + 4 * fq); s4 = *(const f32x4*)(cs + (size_t)t * 32 + 16 + 4 * fq);
                    const u32x2 a = *(const u32x2*)(proj + (size_t)t * INCP + OFF_KR + 4 * fq), bb = *(const u32x2*)(proj + (size_t)t * INCP + OFF_KR + 16 + 4 * fq);
                    r1 = (f32x4){bf_lo(a.x), bf_hi(a.x), bf_lo(a.y), bf_hi(a.y)} * gr0; r2 = (f32x4){bf_lo(bb.x), bf_hi(bb.x), bf_lo(bb.y), bf_hi(bb.y)} * gr1; }
#pragma unroll
                for (int bj = 0; bj < 2; ++bj) { const size_t rowi = (size_t)(b * NH + 4 * u.pn + 2 * bj + wh) * SEQ + s; const f32x2 h2 = *(const f32x2*)(hs + (lr * 4 + 2 * bj + wh) * 2);
                    const float rstd = rsqrtf(((h2[0] + h2[1]) + skr) * (1.f / DQK) + EPS) * K8_SCALE;
                    unsigned char* kp = K + rowi * 128; const f32x4 y0 = acc[ai][bj][m][0] * rstd * g0, y1 = acc[ai][bj][m][1] * rstd * g1;
                    *(unsigned*)(kp + 32 * wp + 4 * fq) = pk4_fp8(y0[0], y0[1], y0[2], y0[3]); *(unsigned*)(kp + 32 * wp + 16 + 4 * fq) = pk4_fp8(y1[0], y1[1], y1[2], y1[3]);
                    if (wp == 1) { const f32x4 x1 = r1 * rstd, x2 = r2 * rstd, z1 = x1 * c4 - x2 * s4, z2 = x1 * s4 + x2 * c4; *(unsigned*)(kp + 64 + 4 * fq) = pk4_fp8(z1[0], z1[1], z1[2], z1[3]); *(unsigned*)(kp + 80 + 4 * fq) = pk4_fp8(z2[0], z2[1], z2[2], z2[3]); }
                    else { *(u32x2*)(kp + 96 + 8 * fq) = (u32x2){kpad, 0u}; } }
                asm volatile("" ::: "memory"); }
    }
};
struct EpiVT {
    static constexpr bool PERM = true, AFTER_DRAIN = false;
    unsigned char* VT; const float* ssq;
    __device__ __forceinline__ void operator()(f32x4 (&acc)[2][2][4][2], const Unit& u, int wr, int wc, int fr, int fq) const {
        int tok0 = u.pn * BM + wc * 32 + 8 * fq; asm volatile("" : "+v"(tok0), "+v"(fr));
        float rs[2][8];
#pragma unroll
        for (int bj = 0; bj < 2; ++bj)
#pragma unroll
            for (int i = 0; i < 8; ++i) { const f32x4 sa = *(const f32x4*)(ssq + (size_t)(tok0 + bj * HALF + i) * 16 + 8); rs[bj][i] = rsqrtf(((sa[0] + sa[1]) + (sa[2] + sa[3])) * (1.f / KVLORA) + EPS); }
#pragma unroll
        for (int ai = 0; ai < 2; ++ai)
#pragma unroll
            for (int m = 0; m < 4; ++m) { const int row = u.pm * BM + ai * HALF + wr * 64 + m * 16 + fr, h = row >> 6, d = row & 63;
#pragma unroll
                for (int bj = 0; bj < 2; ++bj) { const int tok = tok0 + bj * HALF, b = tok >> 13, s = tok & (SEQ - 1); const f32x4 v0 = acc[ai][bj][m][0], v1 = acc[ai][bj][m][1];
                    const int k0 = s & 63, j0 = 4 * ((k0 >> 3) & 3) + 16 * (k0 >> 5), r32v = d & 31, off = (j0 & 15) + 16 * ((j0 >> 4) ^ ((r32v >> 3) & 1));
                    unsigned char* tp = VT + ((size_t)(b * NH + h) * (SEQ / 64) + (s >> 6)) * 4096 + (((d >> 5) * 32 + r32v) << 5) + off;
                    *(unsigned*)tp = pk4_fp8(v0[0] * rs[bj][0], v0[1] * rs[bj][1], v0[2] * rs[bj][2], v0[3] * rs[bj][3]);
                    *(unsigned*)(tp + 2048) = pk4_fp8(v1[0] * rs[bj][4], v1[1] * rs[bj][5], v1[2] * rs[bj][6], v1[3] * rs[bj][7]); } }
    }
};
struct EpiF32 {
    static constexpr bool PERM = false, AFTER_DRAIN = false;
    float* O; int ldc;
    __device__ __forceinline__ void operator()(const f32x4 (&acc)[2][2][4][2], const Unit& u, int wr, int wc, int fr, int fq) const {
        const int row0 = u.pm * BM + wr * 64 + fr, col0 = u.pn * BM + wc * 32 + 4 * fq;
#pragma unroll
        for (int ai = 0; ai < 2; ++ai)
#pragma unroll
            for (int m = 0; m < 4; ++m) { float* rowp = O + (size_t)(row0 + ai * HALF + m * 16) * ldc + col0;
#pragma unroll
                for (int bj = 0; bj < 2; ++bj)
#pragma unroll
                    for (int n = 0; n < 2; ++n) *(f32x4*)(rowp + bj * HALF + n * 16) = acc[ai][bj][m][n]; }
    }
};
__device__ __forceinline__ void unpack8(const u32x4 g, float (&f)[8]) { f[0] = bf_lo(g.x); f[1] = bf_hi(g.x); f[2] = bf_lo(g.y); f[3] = bf_hi(g.y); f[4] = bf_lo(g.z); f[5] = bf_hi(g.z); f[6] = bf_lo(g.w); f[7] = bf_hi(g.w); }
struct EpiGateA {
    static constexpr bool PERM = true, AFTER_DRAIN = false;
    bf16_t* M1; const bf16_t* proj;
    __device__ __forceinline__ void operator()(const f32x4 (&acc)[2][2][4][2], const Unit& u, int wr, int wc, int fr, int fq) const {
        const int row0 = u.pm * BM + wr * 64 + fr, col0 = u.pn * BM + wc * 32 + 8 * fq;
#pragma unroll
        for (int ai = 0; ai < 2; ++ai)
#pragma unroll
            for (int m = 0; m < 4; ++m) { const size_t row = (size_t)(row0 + ai * HALF + m * 16);
#pragma unroll
                for (int bj = 0; bj < 2; ++bj) { const int col = col0 + bj * HALF; float g[8]; unpack8(*(const u32x4*)(proj + row * INCP + OFF_GA + col), g);
                    const f32x4 v0 = acc[ai][bj][m][0], v1 = acc[ai][bj][m][1];
                    u32x4 w; w.x = pk2(v0[0] * g[0], v0[1] * g[1]); w.y = pk2(v0[2] * g[2], v0[3] * g[3]); w.z = pk2(v1[0] * g[4], v1[1] * g[5]); w.w = pk2(v1[2] * g[6], v1[3] * g[7]);
                    *(u32x4*)(M1 + row * DM + col) = w; } }
    }
};
struct EpiGateB {
    static constexpr bool PERM = true, AFTER_DRAIN = false;
    const bf16_t* M1; const bf16_t* proj; bf16_t* O;
    __device__ __forceinline__ void operator()(const f32x4 (&acc)[2][2][4][2], const Unit& u, int wr, int wc, int fr, int fq) const {
        const int row0 = u.pm * BM + wr * 64 + fr, col0 = u.pn * BM + wc * 32 + 8 * fq;
#pragma unroll
        for (int ai = 0; ai < 2; ++ai)
#pragma unroll
            for (int m = 0; m < 4; ++m) { const size_t row = (size_t)(row0 + ai * HALF + m * 16);
#pragma unroll
                for (int bj = 0; bj < 2; ++bj) { const int col = col0 + bj * HALF; float g[8], b[8]; unpack8(*(const u32x4*)(proj + row * INCP + OFF_GB + col), g); unpack8(*(const u32x4*)(M1 + row * DM + col), b);
                    const f32x4 v0 = acc[ai][bj][m][0], v1 = acc[ai][bj][m][1];
                    u32x4 w; w.x = pk2(b[0] + v0[0] * g[0], b[1] + v0[1] * g[1]); w.y = pk2(b[2] + v0[2] * g[2], b[3] + v0[3] * g[3]);
                    w.z = pk2(b[4] + v1[0] * g[4], b[5] + v1[1] * g[5]); w.w = pk2(b[6] + v1[2] * g[6], b[7] + v1[3] * g[7]);
                    *(u32x4*)(O + row * DM + col) = w; } }
    }
};
struct EpiResid {
    static constexpr bool PERM = false, AFTER_DRAIN = false;
    const float* X; float* O;
    __device__ __forceinline__ void operator()(const f32x4 (&acc)[2][2][4][2], const Unit& u, int wr, int wc, int fr, int fq) const {
        const int row0 = u.pm * BM + wr * 64 + fr, col0 = u.pn * BM + wc * 32 + 4 * fq;
#pragma unroll
        for (int ai = 0; ai < 2; ++ai)
#pragma unroll
            for (int m = 0; m < 4; ++m) { const size_t off = (size_t)(row0 + ai * HALF + m * 16) * DM + col0;
#pragma unroll
                for (int bj = 0; bj < 2; ++bj)
#pragma unroll
                    for (int n = 0; n < 2; ++n) { const f32x4 b = *(const f32x4*)(X + off + bj * HALF + n * 16); *(f32x4*)(O + off + bj * HALF + n * 16) = b + acc[ai][bj][m][n]; } }
    }
};
struct EpiSwiglu {
    static constexpr bool PERM = true, AFTER_DRAIN = false;
    unsigned char* ACT; const float* b1; const float* row_rstd;
    __device__ __forceinline__ void operator()(const f32x4 (&acc)[2][2][4][2], const Unit& u, int wr, int wc, int fr, int fq) const {
        const int row0 = u.pm * BM + wr * 64 + fr, f0 = u.pn * HALF + wc * 32 + 8 * fq; const float* be = b1 + (size_t)u.e * 2048;
        const f32x4 bg0 = *(const f32x4*)(be + f0), bg1 = *(const f32x4*)(be + f0 + 4), bu0 = *(const f32x4*)(be + DFF + f0), bu1 = *(const f32x4*)(be + DFF + f0 + 4);
        float rsv[8];
#pragma unroll
        for (int i = 0; i < 8; ++i) rsv[i] = row_rstd[u.rb + wr * 64 + fr + (i >> 2) * HALF + (i & 3) * 16] * W8_INV;
#pragma unroll
        for (int ai = 0; ai < 2; ++ai)
#pragma unroll
            for (int m = 0; m < 4; ++m) { const size_t row = (size_t)(row0 + ai * HALF + m * 16); float o[8]; const float rs = rsv[ai * 4 + m];
#pragma unroll
                for (int n = 0; n < 2; ++n) { const f32x4 g4 = acc[ai][0][m][n] * rs + (n ? bg1 : bg0), u4 = acc[ai][1][m][n] * rs + (n ? bu1 : bu0);
#pragma unroll
                    for (int j = 0; j < 4; ++j) { const float g = fminf(g4[j], 7.f), uu = fminf(fmaxf(u4[j], -7.f), 7.f); o[4 * n + j] = (uu + 1.f) * (g * sigmoidf_(1.702f * g)); } }
                u32x2 w; w.x = pk4_fp8(o[0], o[1], o[2], o[3]); w.y = pk4_fp8(o[4], o[5], o[6], o[7]); *(u32x2*)(ACT + row * DFF + f0) = w; }
    }
};
struct EpiMoeOut {
    static constexpr bool PERM = true, AFTER_DRAIN = false;
    unsigned char* YS; const float* b2; const float* row_w; const int* row_slot;
    __device__ __forceinline__ void operator()(const f32x4 (&acc)[2][2][4][2], const Unit& u, int wr, int wc, int fr, int fq) const {
        const int col0 = u.pn * BM + wc * 32 + 8 * fq; const float* be = b2 + (size_t)u.e * DM; const int rbase = u.rb + wr * 64 + fr;
        int slot[8]; float w[8];
#pragma unroll
        for (int i = 0; i < 8; ++i) { const int row = rbase + (i >> 2) * HALF + (i & 3) * 16; slot[i] = row_slot[row]; w[i] = row_w[row] * (W8_INV * YS_SCALE); }
        f32x4 bv[2][2];
#pragma unroll
        for (int bj = 0; bj < 2; ++bj)
#pragma unroll
            for (int n = 0; n < 2; ++n) bv[bj][n] = *(const f32x4*)(be + col0 + bj * HALF + 4 * n) * W8_SCALE;
#pragma unroll
        for (int ai = 0; ai < 2; ++ai)
#pragma unroll
            for (int m = 0; m < 4; ++m) { const int i = ai * 4 + m;
                if (slot[i] >= 0) { unsigned char* rowp = YS + (size_t)slot[i] * DM + col0;
#pragma unroll
                    for (int bj = 0; bj < 2; ++bj) { const f32x4 v0 = (acc[ai][bj][m][0] + bv[bj][0]) * w[i], v1 = (acc[ai][bj][m][1] + bv[bj][1]) * w[i];
                        u32x2 o; o.x = pk4_fp8(v0[0], v0[1], v0[2], v0[3]); o.y = pk4_fp8(v1[0], v1[1], v1[2], v1[3]); *(u32x2*)(rowp + bj * HALF) = o; } } }
    }
};
constexpr int MOE_MAXU = 12;
struct MoeOrder {
    StaticOrder so; const PG8_LAS int* utab; const PG8_LAS int* gtab;
    __device__ __forceinline__ bool next(int i, Unit& u) const { if (i >= MOE_MAXU || !so.next(i, u)) return false; const int v = __builtin_amdgcn_readfirstlane(utab[i]); u.e = v & 31; u.rb = (int)((unsigned)v >> 8); return true; }
    __device__ __forceinline__ void a_ready(const Unit&) const {}
    __device__ __forceinline__ void done(const Unit&) const {}
};
typedef int i32x4_t __attribute__((ext_vector_type(4))); typedef int i32x8_t __attribute__((ext_vector_type(8)));
__device__ __forceinline__ i32x8_t cat8(bf16x8 lo, bf16x8 hi) { return __builtin_shufflevector(__builtin_bit_cast(i32x4_t, lo), __builtin_bit_cast(i32x4_t, hi), 0, 1, 2, 3, 4, 5, 6, 7); }
__device__ __forceinline__ void mfma_fp8_inplace(f32x4& c, const i32x8_t a, const i32x8_t b) { asm volatile("s_nop 1\n\tv_mfma_f32_16x16x128_f8f6f4 %0, %1, %2, %0" : "+v"(c) : "v"(a), "v"(b)); }
__device__ __forceinline__ void mfma_fp8_drain() { asm volatile("s_nop 15\n\ts_nop 7" ::: "memory"); __builtin_amdgcn_sched_barrier(0); }
template <class Epi, class Sched, bool ALIGN_EPI = false, bool SP2 = false, bool FP8 = false, bool GATHER = false>
__device__ __forceinline__ void gemm_phase(PG8_LAS unsigned char* lds, const Gemm g, const Sched& S, const Epi& E) {
    int tid = threadIdx.x; asm volatile("" : "+v"(tid));
    const int wid = __builtin_amdgcn_readfirstlane(tid >> 6), lane = tid & 63, wr = wid >> 2, wc = wid & 3, fr = lane & 15, fq = lane >> 4;
    const int K = g.K, nt = K / BK;
    static_assert(!GATHER || SP2, "GATHER is implemented for the SP2 loop only");
    const unsigned rowA = (unsigned)(g.lda ? g.lda : K) * 2u, rowB = (unsigned)(g.ldb ? g.ldb : K) * 2u;
    unsigned voffA[2], voffB[2]; int gR0 = 0; unsigned gC = 0u;
#pragma unroll
    for (int i = 0; i < 2; ++i) { int R, C; stage_rc(tid * 16 + i * 8192, R, C); const int Rb = Epi::PERM ? ((R & ~31) + perm32(R & 31)) : R;
        voffA[i] = (unsigned)R * rowA + (unsigned)C * 2u; voffB[i] = (unsigned)Rb * rowB + (unsigned)C * 2u; if (i == 0) { gR0 = R; gC = (unsigned)C * 2u; } }
    unsigned gA[2][2] = {{0u, 0u}, {0u, 0u}}, ngA[2][2] = {{0u, 0u}, {0u, 0u}};
#define PG8_GLOAD(dst, ui_) do { _Pragma("unroll") for (int h_ = 0; h_ < 2; ++h_) _Pragma("unroll") for (int i_ = 0; i_ < 2; ++i_) \
        dst[h_][i_] = (unsigned)S.gtab[(ui_) * 256 + 128 * h_ + gR0 + 64 * i_] * rowA + gC; } while (0)
#define PG8_VA(h) (GATHER ? gA[h] : voffA)
    const unsigned kstep = (unsigned)(BK * 2);
    const unsigned hstep = (unsigned)HALF * rowB;
    const unsigned tstep = 2u * hstep;
    const unsigned hstepA = (unsigned)HALF * rowA, tstepA = 2u * hstepA;
    const unsigned hsA = GATHER ? 0u : hstepA;
    const unsigned ldsw = (unsigned)wid * 1024u;
    const int aoff = lds_byte(wr * 64 + fr, fq * 8), boff = lds_byte(wc * 32 + fr, fq * 8);
#define PG8_SA(b, h) (((b) * 2 + (h)) * HTB)
#define PG8_SB(b, h) ((4 + (b) * 2 + (h)) * HTB)
#define PG8_STAGE(rs, bufoff, goff, voff) do { _Pragma("unroll") for (int _i = 0; _i < 2; ++_i) \
        __builtin_amdgcn_raw_ptr_buffer_load_lds(rs, (PG8_LAS void*)(lds + (bufoff) + ldsw + _i * 8192), 16, (int)(voff)[_i], (int)(goff), 0, 0); } while (0)
#define PG8_LDA(dst, b, h) do { _Pragma("unroll") for (int m = 0; m < 4; ++m) _Pragma("unroll") for (int k = 0; k < 2; ++k) dst[m][k] = *(const PG8_LAS bf16x8*)(lds + PG8_SA(b, h) + aoff + m * 2048 + k * 1024); } while (0)
#define PG8_LDB(dst, b, h) do { _Pragma("unroll") for (int n = 0; n < 2; ++n) _Pragma("unroll") for (int k = 0; k < 2; ++k) dst[n][k] = *(const PG8_LAS bf16x8*)(lds + PG8_SB(b, h) + boff + n * 2048 + k * 1024); } while (0)
#define PG8_MMA(ai, bj, At, Bt) do { __builtin_amdgcn_s_setprio(1); _Pragma("unroll") for (int m = 0; m < 4; ++m) _Pragma("unroll") for (int n = 0; n < 2; ++n) { \
        if constexpr (FP8) { mfma_fp8_inplace(acc[ai][bj][m][n], cat8(Bt[n][0], Bt[n][1]), cat8(At[m][0], At[m][1])); } \
        else { _Pragma("unroll") for (int k = 0; k < 2; ++k) acc[ai][bj][m][n] = __builtin_amdgcn_mfma_f32_16x16x32_bf16(Bt[n][k], At[m][k], acc[ai][bj][m][n], 0, 0, 0); } } \
        __builtin_amdgcn_s_setprio(0); } while (0)
#define PG8_WAIT_V(n) asm volatile("s_waitcnt vmcnt(" #n ")" ::: "memory")
#define PG8_WAIT_L(n) asm volatile("s_waitcnt lgkmcnt(" #n ")" ::: "memory")
#define PG8_BAR __builtin_amdgcn_s_barrier()
#define PG8_SCHED __builtin_amdgcn_sched_barrier(0)
    Unit cur, nxt; int ui = 0;
    if (!S.next(0, cur)) return;
    f32x4 acc[2][2][4][2];
#pragma unroll
    for (int a = 0; a < 2; ++a)
#pragma unroll
        for (int b = 0; b < 2; ++b)
#pragma unroll
            for (int m = 0; m < 4; ++m)
#pragma unroll
                for (int n = 0; n < 2; ++n) acc[a][b][m][n] = (f32x4){0.f, 0.f, 0.f, 0.f};
    bf16x8 At[4][2], B0[2][2], B1[2][2];
    unsigned cA = GATHER ? 0u : (unsigned)cur.pm * tstepA, cB = (unsigned)cur.e * (unsigned)g.bstride + (unsigned)cur.pn * tstep;
    const __amdgpu_buffer_rsrc_t rsA = __builtin_amdgcn_make_buffer_rsrc((void*)g.A, 0, 0x7fffffff, 0x00020000), rsB = __builtin_amdgcn_make_buffer_rsrc((void*)g.Bt, 0, 0x7fffffff, 0x00020000);
    S.a_ready(cur);
    if constexpr (GATHER) PG8_GLOAD(gA, 0);
    if constexpr (SP2) {
        PG8_STAGE(rsB, PG8_SB(0, 0), cB, voffB); PG8_STAGE(rsB, PG8_SB(0, 1), cB + hstep, voffB); PG8_STAGE(rsA, PG8_SA(0, 0), cA, PG8_VA(0)); PG8_STAGE(rsA, PG8_SA(0, 1), cA + hsA, PG8_VA(1));
        if (wr == 1) PG8_BAR;
        PG8_WAIT_V(2); PG8_BAR;
        PG8_STAGE(rsB, PG8_SB(1, 0), cB + kstep, voffB); PG8_STAGE(rsA, PG8_SA(1, 0), cA + kstep, PG8_VA(0)); PG8_STAGE(rsB, PG8_SB(1, 1), cB + hstep + kstep, voffB);
        PG8_WAIT_V(6); PG8_BAR;
    } else {
        PG8_STAGE(rsB, PG8_SB(0, 0), cB, voffB); PG8_STAGE(rsA, PG8_SA(0, 0), cA, PG8_VA(0)); PG8_STAGE(rsB, PG8_SB(0, 1), cB + hstep, voffB); PG8_STAGE(rsA, PG8_SA(0, 1), cA + hsA, PG8_VA(1));
        if (wr == 1) PG8_BAR;
        PG8_WAIT_V(4); PG8_BAR;
        PG8_STAGE(rsB, PG8_SB(1, 0), cB + kstep, voffB); PG8_STAGE(rsA, PG8_SA(1, 0), cA + kstep, PG8_VA(0)); PG8_STAGE(rsB, PG8_SB(1, 1), cB + hstep + kstep, voffB);
        PG8_WAIT_V(6); PG8_BAR;
    }
    for (;;) {
        const bool has_next = S.next(ui + 1, nxt);
        if constexpr (GATHER) { if (has_next) PG8_GLOAD(ngA, ui + 1); else { ngA[0][0] = gA[0][0]; ngA[0][1] = gA[0][1]; ngA[1][0] = gA[1][0]; ngA[1][1] = gA[1][1]; } }
        const unsigned nA = (has_next && !GATHER) ? (unsigned)nxt.pm * tstepA : cA, nB = has_next ? (unsigned)nxt.e * (unsigned)g.bstride + (unsigned)nxt.pn * tstep : cB;
        for (int t = 0; t < nt; t += 2) {
            const bool last = (t == nt - 2);
            const unsigned a1 = cA + (unsigned)(t + 1) * kstep;
            const unsigned a2 = last ? nA : cA + (unsigned)(t + 2) * kstep, b2 = last ? nB : cB + (unsigned)(t + 2) * kstep;
            const unsigned a3 = a2 + kstep, b3 = b2 + kstep;
            if (last && has_next) S.a_ready(nxt);
            if constexpr (SP2) {
            PG8_LDB(B0, 0, 0); PG8_LDB(B1, 0, 1); PG8_SCHED; PG8_LDA(At, 0, 0); PG8_STAGE(rsA, PG8_SA(1, 1), a1 + hsA, PG8_VA(1));
            if constexpr (GATHER) { if (last) { gA[0][0] = ngA[0][0]; gA[0][1] = ngA[0][1]; gA[1][0] = ngA[1][0]; gA[1][1] = ngA[1][1]; } }
            PG8_WAIT_V(8); PG8_WAIT_L(0); PG8_BAR; PG8_MMA(0, 0, At, B0); PG8_MMA(0, 1, At, B1); PG8_BAR; PG8_SCHED;
            PG8_LDA(At, 0, 1); PG8_STAGE(rsB, PG8_SB(0, 0), b2, voffB); PG8_STAGE(rsB, PG8_SB(0, 1), b2 + hstep, voffB); PG8_STAGE(rsA, PG8_SA(0, 0), a2, PG8_VA(0));
            PG8_WAIT_V(8); PG8_WAIT_L(0); PG8_BAR; PG8_MMA(1, 0, At, B0); PG8_MMA(1, 1, At, B1); PG8_BAR; PG8_SCHED;
            PG8_LDB(B0, 1, 0); PG8_LDB(B1, 1, 1); PG8_SCHED; PG8_LDA(At, 1, 0); PG8_STAGE(rsA, PG8_SA(0, 1), a2 + hsA, PG8_VA(1));
            PG8_WAIT_V(8); PG8_WAIT_L(0); PG8_BAR; PG8_MMA(0, 0, At, B0); PG8_MMA(0, 1, At, B1); PG8_BAR; PG8_SCHED;
            PG8_LDA(At, 1, 1); PG8_STAGE(rsB, PG8_SB(1, 0), b3, voffB); PG8_STAGE(rsB, PG8_SB(1, 1), b3 + hstep, voffB); PG8_STAGE(rsA, PG8_SA(1, 0), a3, PG8_VA(0));
            PG8_WAIT_V(8); PG8_WAIT_L(0); PG8_BAR; PG8_MMA(1, 0, At, B0); PG8_MMA(1, 1, At, B1); PG8_BAR; PG8_SCHED;
            } else {
            PG8_LDB(B0, 0, 0); PG8_SCHED; PG8_LDA(At, 0, 0); PG8_STAGE(rsA, PG8_SA(1, 1), a1 + hsA, PG8_VA(1));
            PG8_WAIT_L(8); PG8_BAR; PG8_WAIT_L(0); PG8_MMA(0, 0, At, B0); PG8_BAR; PG8_SCHED;
            PG8_LDB(B1, 0, 1); PG8_STAGE(rsB, PG8_SB(0, 0), b2, voffB);
            PG8_BAR; PG8_WAIT_L(0); PG8_MMA(0, 1, At, B1); PG8_BAR;
            PG8_LDA(At, 0, 1); PG8_STAGE(rsA, PG8_SA(0, 0), a2, PG8_VA(0));
            PG8_BAR; PG8_WAIT_L(0); PG8_MMA(1, 0, At, B0); PG8_BAR; PG8_SCHED;
            PG8_STAGE(rsB, PG8_SB(0, 1), b2 + hstep, voffB);
            PG8_WAIT_V(6); PG8_BAR; PG8_MMA(1, 1, At, B1); PG8_BAR;
            PG8_LDB(B0, 1, 0); PG8_SCHED; PG8_LDA(At, 1, 0); PG8_STAGE(rsA, PG8_SA(0, 1), a2 + hsA, PG8_VA(1));
            PG8_WAIT_L(8); PG8_BAR; PG8_WAIT_L(0); PG8_MMA(0, 0, At, B0); PG8_BAR; PG8_SCHED;
            PG8_LDB(B1, 1, 1); PG8_STAGE(rsB, PG8_SB(1, 0), b3, voffB);
            PG8_BAR; PG8_WAIT_L(0); PG8_MMA(0, 1, At, B1); PG8_BAR;
            PG8_LDA(At, 1, 1); PG8_STAGE(rsA, PG8_SA(1, 0), a3, PG8_VA(0));
            PG8_BAR; PG8_WAIT_L(0); PG8_MMA(1, 0, At, B0); PG8_BAR; PG8_SCHED;
            PG8_STAGE(rsB, PG8_SB(1, 1), b3 + hstep, voffB);
            PG8_WAIT_V(6); PG8_BAR; PG8_MMA(1, 1, At, B1); PG8_BAR;
            }
        }
        if constexpr (ALIGN_EPI) { if (wr == 0) PG8_BAR; }
        if constexpr (FP8) mfma_fp8_drain();
        if constexpr (!Epi::AFTER_DRAIN) { E(acc, cur, wr, wc, fr, fq); S.done(cur); }
        if (!has_next) break;
#pragma unroll
        for (int a = 0; a < 2; ++a)
#pragma unroll
            for (int b = 0; b < 2; ++b)
#pragma unroll
                for (int m = 0; m < 4; ++m)
#pragma unroll
                    for (int n = 0; n < 2; ++n) acc[a][b][m][n] = (f32x4){0.f, 0.f, 0.f, 0.f};
        cur = nxt; cA = nA; cB = nB; ++ui;
        if constexpr (ALIGN_EPI) { if (wr == 1) PG8_BAR; }
    }
    PG8_WAIT_V(0);
    if constexpr (!ALIGN_EPI) { if (wr == 0) PG8_BAR; }
    PG8_BAR;
    if constexpr (Epi::AFTER_DRAIN) { E.fused(acc, cur, wr, wc, fr, fq, lds, wid, lane); S.done(cur); }
#undef PG8_SA
#undef PG8_GLOAD
#undef PG8_VA
#undef PG8_SB
#undef PG8_STAGE
#undef PG8_LDA
#undef PG8_LDB
#undef PG8_MMA
#undef PG8_WAIT_V
#undef PG8_WAIT_L
#undef PG8_BAR
#undef PG8_SCHED
}
}

#define GAS __attribute__((address_space(1)))
#define LAS __attribute__((address_space(3)))
#define XB_TMO      128
#define XB_XCNT(j)  (256  + 64 * (j))
#define XB_XSUB(j)  (1280 + 64 * (j))
#define XB_XGEN(j)  (2304 + 64 * (j))
#define XB_TOP      3328
#define XB_TOPGEN   3392
#define XCD_BAR_WORDS 3456
#define XB_SPIN_CAP (1u << 18)

__device__ __forceinline__ unsigned xb_ld(unsigned* p)              { return __hip_atomic_load(p, __ATOMIC_RELAXED, __HIP_MEMORY_SCOPE_AGENT); }
__device__ __forceinline__ unsigned xb_add(unsigned* p, unsigned v) { return __hip_atomic_fetch_add(p, v, __ATOMIC_RELAXED, __HIP_MEMORY_SCOPE_AGENT); }
__device__ __forceinline__ unsigned xb_xcc_id() { return (unsigned)__builtin_amdgcn_s_getreg((3 << 11) | 20) & 0xFu; }
#define XB_SPIN(cond, bar) do { unsigned _sp = 0; while (cond) { __builtin_amdgcn_s_sleep(1); \
    if ((++_sp & 255u) == 0u) { if (xb_ld(&(bar)[XB_TMO])) break; if (_sp > XB_SPIN_CAP) { atomicAdd(&(bar)[XB_TMO], 1u); break; } } } } while (0)

struct XcdBarrier {
    unsigned* bar; unsigned x;
    volatile LAS unsigned* st;
};

__device__ __forceinline__ XcdBarrier xcd_barrier_post(unsigned* bar, volatile LAS unsigned* st) {
    XcdBarrier b; b.bar = bar; b.x = xb_xcc_id(); b.st = st;
    if (threadIdx.x == 0) (void)xb_add(&bar[XB_XCNT(b.x)], 1u);
    return b;
}
__device__ __forceinline__ void xcd_barrier_complete(unsigned* bar, unsigned x, unsigned& nloc, unsigned& nx) {
    const unsigned G = gridDim.x * gridDim.y * gridDim.z;
    unsigned sum, cnt, mine, sp = 0u;
    for (;;) {
        sum = 0u; cnt = 0u; mine = 0u;
#pragma unroll
        for (unsigned j = 0; j < 16; ++j) { const unsigned c = xb_ld(&bar[XB_XCNT(j)]); sum += c; cnt += (c > 0u) ? 1u : 0u; mine = (j == x) ? c : mine; }
        if (sum == G) break;
        __builtin_amdgcn_s_sleep(1);
        if ((++sp & 255u) == 0u) { if (xb_ld(&bar[XB_TMO])) break; if (sp > XB_SPIN_CAP) { atomicAdd(&bar[XB_TMO], 1u); break; } }
    }
    nloc = mine > 0u ? mine : 1u; nx = cnt > 0u ? cnt : 1u;
}

__device__ __forceinline__ void xcd_barrier(const XcdBarrier& b) {
    asm volatile("s_waitcnt vmcnt(0)" ::: "memory");
    __syncthreads();
    if (threadIdx.x == 0) {
        unsigned* bar = b.bar;
        __builtin_amdgcn_s_waitcnt(0);
        unsigned nloc = b.st[0], nx = b.st[1];
        if (nloc == 0u) { xcd_barrier_complete(bar, b.x, nloc, nx); b.st[0] = nloc; b.st[1] = nx; }
        const unsigned old = xb_add(&bar[XB_XSUB(b.x)], 1u);
        const unsigned gen = old / nloc;
        if (old + 1u == (gen + 1u) * nloc) {
            __builtin_amdgcn_fence(__ATOMIC_RELEASE, "agent");
            asm volatile("s_waitcnt vmcnt(0)" ::: "memory");
            const unsigned og = xb_add(&bar[XB_TOP], 1u);
            const unsigned tg = og / nx;
            if (og + 1u == (tg + 1u) * nx) xb_add(&bar[XB_TOPGEN], 1u);
            else XB_SPIN(xb_ld(&bar[XB_TOPGEN]) == tg, bar);
            __builtin_amdgcn_fence(__ATOMIC_ACQUIRE, "agent");
            xb_add(&bar[XB_XGEN(b.x)], 1u);
            asm volatile("s_waitcnt vmcnt(0)" ::: "memory");
        } else {
            XB_SPIN(xb_ld(&bar[XB_XGEN(b.x)]) == gen, bar);
            __builtin_amdgcn_fence(__ATOMIC_ACQUIRE, "agent");
            asm volatile("s_waitcnt vmcnt(0)" ::: "memory");
        }
    }
    __syncthreads();
}

template <int MODE  >
__device__ __forceinline__ void transpose_item(const float* __restrict__ W, int K, int N, bf16_t* __restrict__ WT, const float* __restrict__ gain, float* scr, int item, int lane) {
    const int nblk = N / 32, kb = item / nblk, nb = item % nblk, k0 = 64 * kb, n0 = 32 * nb;
#pragma unroll
    for (int i = 0; i < 8; ++i) { const int kk = 8 * i + (lane >> 3), n4 = (lane & 7) * 4; f32x4 v = *(const f32x4*)(W + (size_t)(k0 + kk) * N + n0 + n4);
        if (gain) { const float g = gain[k0 + kk]; v = v * g; }
        float* s = scr + kk * 33 + n4; s[0] = v[0]; s[1] = v[1]; s[2] = v[2]; s[3] = v[3]; }
    asm volatile("s_waitcnt lgkmcnt(0)" ::: "memory");
    const int c = lane & 7;
#pragma unroll
    for (int j = 0; j < 4; ++j) { const int n = (lane >> 3) + 8 * j; const float* s = scr + (8 * c) * 33 + n;
        u32x4 o; o.x = pk2(s[0 * 33], s[1 * 33]); o.y = pk2(s[2 * 33], s[3 * 33]); o.z = pk2(s[4 * 33], s[5 * 33]); o.w = pk2(s[6 * 33], s[7 * 33]);
        int row = n0 + n;
        if (MODE == 1) { const int f = row & 1023; row = ((f >> 7) << 8) + ((row >> 10) << 7) + (f & 127); }
        if (MODE == 2) { const int hh = row / DQK; row = hh * 128 + (row - hh * DQK); }
        if (MODE == 3) { const int hh = row >> 7, ii = row & 127; row = ((ii >> 6) << 9) + hh * 64 + (ii & 63); }
        *(u32x4*)(WT + (size_t)row * K + k0 + 8 * c) = o; }
    asm volatile("s_waitcnt lgkmcnt(0)" ::: "memory");
}
template <int MODE>
__device__ __forceinline__ void transpose_item_fp8(const float* __restrict__ W, int K, int N, unsigned char* __restrict__ WT, float* scr, int item, int lane) {
    const int nblk = N / 32, kb = item / nblk, nb = item % nblk, k0 = 64 * kb, n0 = 32 * nb;
#pragma unroll
    for (int i = 0; i < 8; ++i) { const int kk = 8 * i + (lane >> 3), n4 = (lane & 7) * 4; const f32x4 v = *(const f32x4*)(W + (size_t)(k0 + kk) * N + n0 + n4) * W8_SCALE;
        float* s = scr + kk * 33 + n4; s[0] = v[0]; s[1] = v[1]; s[2] = v[2]; s[3] = v[3]; }
    asm volatile("s_waitcnt lgkmcnt(0)" ::: "memory");
    const int c = lane & 7;
#pragma unroll
    for (int j = 0; j < 4; ++j) { const int n = (lane >> 3) + 8 * j; const float* s = scr + (8 * c) * 33 + n;
        u32x2 o; o.x = pk4_fp8(s[0 * 33], s[1 * 33], s[2 * 33], s[3 * 33]); o.y = pk4_fp8(s[4 * 33], s[5 * 33], s[6 * 33], s[7 * 33]);
        int row = n0 + n;
        if (MODE == 1) { const int f = row & 1023; row = ((f >> 7) << 8) + ((row >> 10) << 7) + (f & 127); }
        *(u32x2*)(WT + (size_t)row * K + k0 + 8 * c) = o; }
    asm volatile("s_waitcnt lgkmcnt(0)" ::: "memory");
}
__device__ __forceinline__ void phase_prologue(const Params& p, unsigned char* lds) {
    const int tid = threadIdx.x, lane = tid & 63, wave = tid >> 6;
    float* scr = (float*)(lds + wave * 16384);
    const int gw = blockIdx.x * NWAVES + wave, NGW = gridDim.x * NWAVES;
    unsigned char* ws = p.ws;
    constexpr int I_WIN = (DM / 64) * (INC / 32), I_UQ = (QLORA / 64) * (768 / 32), I_UKV = (KVLORA / 64) * (1024 / 32), I_OM = (512 / 64) * (DM / 32), I_OC = I_OM, I_WO = (DM / 64) * (DM / 32);
    constexpr int I_W1 = (DM / 64) * (2048 / 32), I_W2 = (DFF / 64) * (DM / 32);
    constexpr int NSMALL = I_WIN + I_UQ + I_UKV + I_OM + I_OC + I_WO;
    constexpr int NITEMS = NSMALL;
    for (int it = gw; it < NITEMS; it += NGW) {
        int r = it;
        if (r < I_WIN) { transpose_item<0>(p.w_in, DM, INC, (bf16_t*)(ws + WS_WIN), p.norm1_g, scr, r, lane); continue; } r -= I_WIN;
        if (r < I_UQ) { transpose_item<2>(p.w_uq, QLORA, 768, (bf16_t*)(ws + WS_WUQ), p.q_a_g, scr, r, lane); continue; } r -= I_UQ;
        if (r < I_UKV) { transpose_item<3>(p.w_ukv, KVLORA, 1024, (bf16_t*)(ws + WS_WUKV), p.kv_a_g, scr, r, lane); continue; } r -= I_UKV;
        if (r < I_OM) { transpose_item<0>(p.w_o_mla, 512, DM, (bf16_t*)(ws + WS_WOMLA), nullptr, scr, r, lane); continue; } r -= I_OM;
        if (r < I_OC) { transpose_item<0>(p.w_o_conv, 512, DM, (bf16_t*)(ws + WS_WOCONV), nullptr, scr, r, lane); continue; } r -= I_OC;
        transpose_item<0>(p.w_o, DM, DM, (bf16_t*)(ws + WS_WO), nullptr, scr, r, lane);
    }
    { u32x4* z = (u32x4*)((bf16_t*)(ws + WS_WIN) + (size_t)INC * DM); const int nz = (INCP - INC) * DM * 2 / 16;
      for (int i = blockIdx.x * NTHREADS + tid; i < nz; i += gridDim.x * NTHREADS) z[i] = (u32x4){0u, 0u, 0u, 0u}; }
    { u32x4* wq = (u32x4*)(ws + WS_WUQ); for (int i = blockIdx.x * NTHREADS + tid; i < NH * 32 * QLORA * 2 / 16; i += gridDim.x * NTHREADS) { const int hh = i / (32 * QLORA * 2 / 16), q = i - hh * (32 * QLORA * 2 / 16); wq[(hh * 128 + 96) * (QLORA * 2 / 16) + q] = (u32x4){0u, 0u, 0u, 0u}; } }
    { float* csd = (float*)(ws + WS_CS); for (int i = blockIdx.x * NTHREADS + tid; i < NTOK * 16; i += gridDim.x * NTHREADS) { const int t = i >> 4, j = i & 15; float sn, cn; sincosf((float)p.pos[t] * exp2f(-(float)j * (13.287712379549449f / 16.f)), &sn, &cn); csd[t * 32 + j] = cn; csd[t * 32 + 16 + j] = sn; } }
    if (blockIdx.x == 0 && tid < 64) { float gq = fabsf(p.q_g[tid]), gk = fabsf(p.k_g[tid]); if (tid < 32) { gq = fmaxf(gq, fabsf(p.q_g[64 + tid])); gk = fmaxf(gk, fabsf(p.k_g[64 + tid])); }
#pragma unroll
        for (int o = 1; o < 64; o <<= 1) { gq = fmaxf(gq, __shfl_xor(gq, o)); gk = fmaxf(gk, __shfl_xor(gk, o)); }
        if (tid == 0) *(float*)(ws + WS_SHIFT) = fmaxf(2.f, ceilf(14.135f * gq * gk + 0.5f - 15.f)); }
    { int* rt = (int*)(ws + WS_RT2); int* rs = (int*)(ws + WS_RT2 + 4 * MiB); float* rr = (float*)(ws + WS_RT2 + 6 * MiB);
      for (int i = blockIdx.x * NTHREADS + tid; i < NE * CAP; i += gridDim.x * NTHREADS) { rt[i] = 0; rs[i] = -1; rr[i] = 0.f; } }
    { u32x4* GF = (u32x4*)(ws + WS_GF);
      for (int i = blockIdx.x * NTHREADS + tid; i < 64 * 64; i += gridDim.x * NTHREADS) { const int ks = i >> 6, ln = i & 63, r = ln & 31, h = ln >> 5; float v[8], lo[8]; unsigned hi[4];
#pragma unroll
          for (int j = 0; j < 8; ++j) { const int k = 16 * ks + 8 * h + j; v[j] = p.norm2_g[k] * p.router_w[(size_t)k * NE + r]; }
#pragma unroll
          for (int j = 0; j < 4; ++j) { hi[j] = pk2(v[2 * j], v[2 * j + 1]); lo[2 * j] = v[2 * j] - bf_lo(hi[j]); lo[2 * j + 1] = v[2 * j + 1] - bf_hi(hi[j]); }
          GF[(ks * 2 + 0) * 64 + ln] = (u32x4){hi[0], hi[1], hi[2], hi[3]}; GF[(ks * 2 + 1) * 64 + ln] = (u32x4){pk2(lo[0], lo[1]), pk2(lo[2], lo[3]), pk2(lo[4], lo[5]), pk2(lo[6], lo[7])}; } }
    bf16_t* XN = (bf16_t*)(ws + WS_XN);
    for (int m = gw; m < NTOK; m += NGW) {
        const f32x4* xr = (const f32x4*)(p.x + (size_t)m * DM) + lane; f32x4 v[4]; float s = 0.f;
#pragma unroll
        for (int j = 0; j < 4; ++j) { v[j] = xr[64 * j]; s += (v[j][0] * v[j][0] + v[j][1] * v[j][1]) + (v[j][2] * v[j][2] + v[j][3] * v[j][3]); }
        const float rstd = rsqrtf(wave_sum(s) * (1.f / DM) + EPS);
        u32x2* o = (u32x2*)(XN + (size_t)m * DM) + lane;
#pragma unroll
        for (int j = 0; j < 4; ++j) { u32x2 w; w.x = pk2(v[j][0] * rstd, v[j][1] * rstd); w.y = pk2(v[j][2] * rstd, v[j][3] * rstd); o[64 * j] = w; }
    }
}

struct ConvRaw { u32x4 u[3], c[3], bg; float m0, m2; };
__device__ __forceinline__ void conv_load(ConvRaw& r, const Params& p, int t, int lane) {
    const bf16_t* pr = (const bf16_t*)(p.ws + WS_PROJ) + (size_t)t * INCP; const int s = t & (SEQ - 1);
    r.m0 = s > 0 ? 1.f : 0.f; r.m2 = s < SEQ - 1 ? 1.f : 0.f;
    const bf16_t* pm = s > 0 ? pr - INCP : pr; const bf16_t* pp = s < SEQ - 1 ? pr + INCP : pr;
    r.u[0] = *(const u32x4*)(pm + OFF_U + 8 * lane); r.c[0] = *(const u32x4*)(pm + OFF_C + 8 * lane);
    r.u[1] = *(const u32x4*)(pr + OFF_U + 8 * lane); r.c[1] = *(const u32x4*)(pr + OFF_C + 8 * lane);
    r.u[2] = *(const u32x4*)(pp + OFF_U + 8 * lane); r.c[2] = *(const u32x4*)(pp + OFF_C + 8 * lane);
    r.bg = *(const u32x4*)(pr + OFF_B + 8 * lane);
}
__device__ __forceinline__ void mulpair8(const u32x4 u, const u32x4 c, float (&o)[8]) {
    o[0] = bf_lo(u.x) * bf_lo(c.x); o[1] = bf_hi(u.x) * bf_hi(c.x); o[2] = bf_lo(u.y) * bf_lo(c.y); o[3] = bf_hi(u.y) * bf_hi(c.y);
    o[4] = bf_lo(u.z) * bf_lo(c.z); o[5] = bf_hi(u.z) * bf_hi(c.z); o[6] = bf_lo(u.w) * bf_lo(c.w); o[7] = bf_hi(u.w) * bf_hi(c.w); }
__device__ __forceinline__ void conv_store(const ConvRaw& r, const Params& p, int t, int lane, const float (&cw0)[8], const float (&cw1)[8], const float (&cw2)[8]) {
    float cu0[8], cu1[8], cu2[8], bb[8], y[8]; mulpair8(r.u[0], r.c[0], cu0); mulpair8(r.u[1], r.c[1], cu1); mulpair8(r.u[2], r.c[2], cu2);
    bb[0] = bf_lo(r.bg.x); bb[1] = bf_hi(r.bg.x); bb[2] = bf_lo(r.bg.y); bb[3] = bf_hi(r.bg.y); bb[4] = bf_lo(r.bg.z); bb[5] = bf_hi(r.bg.z); bb[6] = bf_lo(r.bg.w); bb[7] = bf_hi(r.bg.w);
#pragma unroll
    for (int j = 0; j < 8; ++j) y[j] = bb[j] * (cw0[j] * r.m0 * cu0[j] + cw1[j] * cu1[j] + cw2[j] * r.m2 * cu2[j]);
    u32x4 o; o.x = pk2(y[0], y[1]); o.y = pk2(y[2], y[3]); o.z = pk2(y[4], y[5]); o.w = pk2(y[6], y[7]); *(u32x4*)((bf16_t*)(p.ws + WS_YBIN) + (size_t)t * CONVW + 8 * lane) = o;
}
__device__ __forceinline__ void phase_conv(const Params& p) {
    int tid = threadIdx.x; asm volatile("" : "+v"(tid)); const int lane = tid & 63, wave = tid >> 6;
    const int gw = blockIdx.x * NWAVES + wave, NGW = gridDim.x * NWAVES;
    float cw0[8], cw1[8], cw2[8];
#pragma unroll
    for (int j = 0; j < 8; ++j) { cw0[j] = p.conv_w[8 * lane + j]; cw1[j] = p.conv_w[CONVW + 8 * lane + j]; cw2[j] = p.conv_w[2 * CONVW + 8 * lane + j]; }
    for (int t = gw; t < NTOK; t += 2 * NGW) {
        const int t1 = t + NGW; const bool two = t1 < NTOK;
        ConvRaw r0, r1; conv_load(r0, p, t, lane); conv_load(r1, p, two ? t1 : t, lane);
        conv_store(r0, p, t, lane, cw0, cw1, cw2);
        if (two) conv_store(r1, p, t1, lane, cw0, cw1, cw2);
    }
}

constexpr int WC_EXP_ITEMS = NE * 1536, WC_TILE_F = 32 * 68;
struct WcItem { const float* W; unsigned char* WT; int N, k0, n0, mode; };
__device__ __forceinline__ WcItem wc_decode(const Params& p, int x) {
    WcItem it; const int e = x / 1536, r = x - e * 1536;
    if (r < 1024) { it.W = p.w1 + (size_t)e * DM * 2048; it.WT = p.ws + WS_W1 + (size_t)e * 2048 * DM; it.N = 2048; it.k0 = 64 * (r >> 6); it.n0 = 32 * (r & 63); it.mode = 1; }
    else { const int q = r - 1024; it.W = p.w2 + (size_t)e * DFF * DM; it.WT = p.ws + WS_W2 + (size_t)e * DM * DFF; it.N = DM; it.k0 = 64 * (q >> 5); it.n0 = 32 * (q & 31); it.mode = 0; }
    return it;
}
struct WConv { float* tile; int x0, nitems, cs; f32x4 pend; };
__device__ __forceinline__ void wconv_step(WConv& c, const Params& p, int lane) {
    const int cs = c.cs, nst = 8 * c.nitems;
    if (cs > 0 && cs <= nst) {
        const int kk = 8 * ((cs - 1) & 7) + (lane >> 3), n4 = (lane & 7) * 4; float* t = c.tile + n4 * 68 + kk;
        t[0] = c.pend[0] * W8_SCALE; t[68] = c.pend[1] * W8_SCALE; t[136] = c.pend[2] * W8_SCALE; t[204] = c.pend[3] * W8_SCALE;
        if ((cs & 7) == 0) {
            const WcItem it = wc_decode(p, c.x0 + (cs >> 3) - 1); const int c8 = lane & 7;
#pragma unroll
            for (int j = 0; j < 4; ++j) { const int n = (lane >> 3) + 8 * j; const f32x4 a = *(const f32x4*)(c.tile + n * 68 + 8 * c8), b = *(const f32x4*)(c.tile + n * 68 + 8 * c8 + 4);
                u32x2 o; o.x = pk4_fp8(a[0], a[1], a[2], a[3]); o.y = pk4_fp8(b[0], b[1], b[2], b[3]);
                int row = it.n0 + n; if (it.mode == 1) { const int f = row & 1023; row = ((f >> 7) << 8) + ((row >> 10) << 7) + (f & 127); }
                *(u32x2*)(it.WT + (size_t)row * DM + it.k0 + 8 * c8) = o; }
        }
    }
    if (cs < nst) {
        const WcItem it = wc_decode(p, c.x0 + (cs >> 3)); const int kk = 8 * (cs & 7) + (lane >> 3), n4 = (lane & 7) * 4;
        c.pend = *(const f32x4*)(it.W + (size_t)(it.k0 + kk) * it.N + it.n0 + n4);
    }
    c.cs = cs + 1;
}

namespace att {
constexpr int NW = 8, QBLK = 32, KVBLK = 64;
constexpr float SCALE = 0.10206207261596575f;
constexpr float QSC = SCALE * 1.4426950408889634f;
constexpr int LDQ = 128, LDK = 128;
constexpr int SHM_V = KVBLK * DV, SHM_K = KVBLK * 128, SHM_ATTN = 2 * SHM_V + 2 * SHM_K + NW * 64 * 4;
#define KSWZ(row, colB) ((row) * 256 + ((colB) ^ (((row) & 7) << 4)))
#define SBAR() __builtin_amdgcn_sched_barrier(0)
__device__ __forceinline__ int crow(int r, int hi) { return (r & 3) + 8 * (r >> 2) + 4 * hi; }
__device__ __forceinline__ float fadd_s(float a, float b) { float r; asm("v_add_f32_e32 %0, %1, %2" : "=v"(r) : "v"(a), "v"(b)); return r; }
__device__ __forceinline__ unsigned cvtpk(float lo, float hi) { unsigned r; asm volatile("v_cvt_pk_bf16_f32 %0, %1, %2" : "=v"(r) : "v"(lo), "v"(hi)); return r; }
typedef int i32x4a __attribute__((ext_vector_type(4))); typedef int i32x8a __attribute__((ext_vector_type(8)));
#define EXPH(P) do { _Pragma("unroll") for (int r = 0; r < 16; ++r) P[r] = __builtin_amdgcn_exp2f(P[r]); } while (0)
__device__ __forceinline__ unsigned pk4_bf8(float a, float b, float c, float d) { unsigned w = 0u; w = (unsigned)__builtin_amdgcn_cvt_pk_bf8_f32(a, b, (int)w, false); w = (unsigned)__builtin_amdgcn_cvt_pk_bf8_f32(c, d, (int)w, true); return w; }
__device__ __forceinline__ void finishSM(f32x16& p0, f32x16& p1, float& l_reg, i32x8a& pf) {
    EXPH(p1); SBAR();
    float ps0 = p0[0], ps1 = p1[0];
#pragma unroll
    for (int r = 1; r < 16; ++r) { ps0 = fadd_s(ps0, p0[r]); ps1 = fadd_s(ps1, p1[r]); }
    l_reg += ps0 + ps1;
#pragma unroll
    for (int q = 0; q < 4; ++q) { pf[q] = (int)pk4_bf8(p0[4 * q], p0[4 * q + 1], p0[4 * q + 2], p0[4 * q + 3]); pf[4 + q] = (int)pk4_bf8(p1[4 * q], p1[4 * q + 1], p1[4 * q + 2], p1[4 * q + 3]); }
}
__device__ __forceinline__ void qkt(f32x16& p0, f32x16& p1, const unsigned char* Ks, const i32x8a* qf, int r32, int hi) {
    const f32x16 z = {};
#pragma unroll
    for (int kh = 0; kh < 2; ++kh) { const int row = kh * 32 + r32, sw = (row >> 1) & 7; const unsigned char* rb = Ks + row * 128; f32x16 acc = z;
#pragma unroll
        for (int s = 0; s < 2; ++s) { const int c0 = 4 * s + 2 * hi; const i32x4a lo = *reinterpret_cast<const i32x4a*>(rb + ((c0 ^ sw) << 4)), hh = *reinterpret_cast<const i32x4a*>(rb + (((c0 + 1) ^ sw) << 4));
            acc = __builtin_amdgcn_mfma_scale_f32_32x32x64_f8f6f4(__builtin_shufflevector(lo, hh, 0, 1, 2, 3, 4, 5, 6, 7), qf[s], acc, 0, 0, 0, 0, 0, 0); }
        if (kh == 0) p0 = acc; else p1 = acc; }
}
__device__ __forceinline__ i32x8a vfrag(const unsigned char* Vs, int d0, int r32, int hi) {
    const unsigned char* b = Vs + (((hi * 2 + d0) * 32 + r32) << 5); const int sw = (r32 >> 3) & 1;
    const i32x4a lo = *reinterpret_cast<const i32x4a*>(b + (sw << 4)), hh = *reinterpret_cast<const i32x4a*>(b + ((sw ^ 1) << 4));
    return __builtin_shufflevector(lo, hh, 0, 1, 2, 3, 4, 5, 6, 7);
}
__device__ __forceinline__ void pv8(f32x16& od, const i32x8a v, const i32x8a pfr) { asm volatile("s_nop 1\n\tv_mfma_f32_32x32x64_f8f6f4 %0, %1, %2, %0 blgp:1" : "+v"(od) : "v"(v), "v"(pfr)); }
#define EXPQ(P, B) do { _Pragma("unroll") for (int r = (B); r < (B) + 8; ++r) P[r] = __builtin_amdgcn_exp2f(P[r]); } while (0)
#define PV_STEP(Vs, PN) do { const i32x8a v0_ = vfrag((Vs), 0, r32, hi), v1_ = vfrag((Vs), 1, r32, hi); pv8(o[0], v0_, pf); EXPQ(PN, 0); pv8(o[1], v1_, pf); EXPQ(PN, 8); SBAR(); } while (0)

__device__ __forceinline__ void attn_unit(const unsigned char* __restrict__ Qb, const unsigned char* __restrict__ Kh, const unsigned char* __restrict__ Vth, bf16_t* __restrict__ Ob, int seq, unsigned char* lds, WConv& wc, const Params& prm) {
    const int tid = threadIdx.x, wid = __builtin_amdgcn_readfirstlane(tid >> 6), lane = tid & 63, r32 = lane & 31, hi = lane >> 5;
    unsigned char* V_lds = lds; unsigned char* K_lds = lds + 2 * SHM_V;
    float l_reg = 0; f32x16 o[2] = {}; i32x8a qr[2];
    { const unsigned char* Qw = Qb + (size_t)(wid * QBLK + r32) * LDQ + hi * 32;
#pragma unroll
      for (int s = 0; s < 2; ++s) { const i32x4a lo = *reinterpret_cast<const i32x4a*>(Qw + 64 * s), hh = *reinterpret_cast<const i32x4a*>(Qw + 64 * s + 16); qr[s] = __builtin_shufflevector(lo, hh, 0, 1, 2, 3, 4, 5, 6, 7); } }
    const int kr0 = 8 * wid + (lane >> 3), kcp = lane & 7;
    const unsigned char* ksrc0 = Kh + (size_t)kr0 * LDK + ((kcp ^ ((kr0 >> 1) & 7)) * 16);
    const unsigned char* vsrc = Vth + (wid & 3) * 1024 + lane * 16;
    typedef __attribute__((address_space(3))) unsigned* lds_u32p;
#define DMA_K(t, slot) __builtin_amdgcn_global_load_lds((const unsigned*)(ksrc0 + (size_t)(t) * KVBLK * LDK), (lds_u32p)(K_lds + (slot) * SHM_K + wid * 1024 + lane * 16), 16, 0, 0)
#define DMA_V(t, slot) do { if (wid < 4) __builtin_amdgcn_global_load_lds((const unsigned*)(vsrc + (size_t)(t) * 4096), (lds_u32p)(V_lds + (slot) * SHM_V + wid * 1024 + lane * 16), 16, 0, 0); } while (0)
    f32x16 pA0, pA1, pB0, pB1; i32x8a pf; const int NT = seq / KVBLK;
    DMA_K(0, 0); DMA_V(0, 0); DMA_K(1, 1);
    asm volatile("s_waitcnt vmcnt(0)" ::: "memory"); __syncthreads();
    qkt(pA0, pA1, K_lds, qr, r32, hi); EXPH(pA0); SBAR();
    __syncthreads();
    for (int j = 0; j + 2 < NT; j += 2) {
        DMA_K(j + 2, 0); DMA_V(j + 1, 1); wconv_step(wc, prm, lane); SBAR();
        qkt(pB0, pB1, K_lds + SHM_K, qr, r32, hi);
        finishSM(pA0, pA1, l_reg, pf); SBAR();
        PV_STEP(V_lds, pB0);
        asm volatile("s_waitcnt vmcnt(0)" ::: "memory"); __syncthreads();
        DMA_K(j + 3, 1); DMA_V(j + 2, 0); wconv_step(wc, prm, lane); SBAR();
        qkt(pA0, pA1, K_lds, qr, r32, hi);
        finishSM(pB0, pB1, l_reg, pf); SBAR();
        PV_STEP(V_lds + SHM_V, pA0);
        asm volatile("s_waitcnt vmcnt(0)" ::: "memory"); __syncthreads();
    }
    DMA_V(NT - 1, 1); wconv_step(wc, prm, lane); SBAR();
    qkt(pB0, pB1, K_lds + SHM_K, qr, r32, hi);
    finishSM(pA0, pA1, l_reg, pf); SBAR();
    PV_STEP(V_lds, pB0);
    asm volatile("s_waitcnt vmcnt(0)" ::: "memory"); __syncthreads();
    finishSM(pB0, pB1, l_reg, pf); SBAR();
    { const i32x8a v0_ = vfrag(V_lds + SHM_V, 0, r32, hi), v1_ = vfrag(V_lds + SHM_V, 1, r32, hi); pv8(o[0], v0_, pf); pv8(o[1], v1_, pf); }
    asm volatile("s_nop 15\n\ts_nop 7" ::: "memory"); SBAR();
    { auto rr = __builtin_amdgcn_permlane32_swap(__float_as_uint(l_reg), __float_as_uint(l_reg), false, false); l_reg = __uint_as_float(rr[0]) + __uint_as_float(rr[1]); }
    const float rl = __builtin_amdgcn_rcpf(l_reg);
    bf16_t* Ow = Ob + (size_t)(wid * QBLK + r32) * 512 + 4 * hi;
#pragma unroll
    for (int d0 = 0; d0 < 2; ++d0)
#pragma unroll
        for (int g = 0; g < 4; ++g) { u32x2 w; w.x = pk2(o[d0][4 * g] * rl, o[d0][4 * g + 1] * rl); w.y = pk2(o[d0][4 * g + 2] * rl, o[d0][4 * g + 3] * rl); *(u32x2*)(Ow + d0 * 32 + 8 * g) = w; }
    __syncthreads();
#undef DMA_K
#undef DMA_V
}
#undef KSWZ
#undef SBAR
}

__device__ __forceinline__ void phase_attn(const Params& p, unsigned char* lds) {
    const unsigned char* Q = p.ws + WS_Q; const unsigned char* Kb = p.ws + WS_K; const unsigned char* VT = p.ws + WS_V; bf16_t* AO = (bf16_t*)(p.ws + WS_AO);
    constexpr int NQB = SEQ / 256, NU = 2 * NH * NQB;
    const int lane = threadIdx.x & 63, wave = __builtin_amdgcn_readfirstlane(threadIdx.x >> 6), gw = blockIdx.x * NWAVES + wave, NGW = gridDim.x * NWAVES;
    const int ipw = (WC_EXP_ITEMS + NGW - 1) / NGW, nun = ((int)blockIdx.x < NU) ? (NU - 1 - (int)blockIdx.x) / (int)gridDim.x + 1 : 0, steps = nun * (SEQ / att::KVBLK - 1);
    int cov = (steps - 1) / 8; cov = cov < 0 ? 0 : (cov > ipw ? ipw : cov);
    WConv wc; wc.tile = (float*)(lds + att::SHM_ATTN) + wave * WC_TILE_F; wc.x0 = gw * ipw; wc.cs = 0; wc.pend = (f32x4){0.f, 0.f, 0.f, 0.f};
    { const int left = WC_EXP_ITEMS - wc.x0; wc.nitems = left < 0 ? 0 : (left < cov ? left : cov); }
    if (wave >= 4) __builtin_amdgcn_s_setprio(1);
    const bool xmap = false;
    for (int u0 = blockIdx.x, rnd = 0; u0 < NU; u0 += gridDim.x, ++rnd) {
        const int u = xmap ? (((int)blockIdx.x & 7) + 8 * rnd) * NQB + ((int)blockIdx.x >> 3) : u0;
        const int qb = u % NQB, h = (u / NQB) % NH, b = u / (NQB * NH); const size_t bh = (size_t)(b * NH + h) * SEQ;
        att::attn_unit(Q + (bh + (size_t)qb * 256) * 128, Kb + bh * 128, VT + bh * DV, AO + ((size_t)b * SEQ + (size_t)qb * 256) * 512 + h * DV, SEQ, lds, wc, p);
    }
    __builtin_amdgcn_s_setprio(0);
    while (wc.cs <= 8 * wc.nitems) wconv_step(wc, p, lane);
}
__device__ __forceinline__ void wconv_cleanup(const Params& p, unsigned char* lds) {
    constexpr int NQB = SEQ / 256, NU = 2 * NH * NQB;
    const int lane = threadIdx.x & 63, wave = threadIdx.x >> 6, gw = blockIdx.x * NWAVES + wave, NGW = gridDim.x * NWAVES;
    const int ipw = (WC_EXP_ITEMS + NGW - 1) / NGW, nun = ((int)blockIdx.x < NU) ? (NU - 1 - (int)blockIdx.x) / (int)gridDim.x + 1 : 0, steps = nun * (SEQ / att::KVBLK - 1);
    int cov = (steps - 1) / 8; cov = cov < 0 ? 0 : (cov > ipw ? ipw : cov);
    float* scr = (float*)(lds + wave * 16384);
    for (int i = cov; i < ipw; ++i) { const int x = gw * ipw + i; if (x >= WC_EXP_ITEMS) break; const WcItem it = wc_decode(p, x); const int r = x % 1536;
        if (it.mode == 1) transpose_item_fp8<1>(it.W, DM, 2048, it.WT, scr, r, lane); else transpose_item_fp8<0>(it.W, DFF, DM, it.WT, scr, r - 1024, lane); }
    __syncthreads();
}

__device__ __forceinline__ int crow16(int r, int hi) { return (r & 3) + 8 * (r >> 2) + 4 * hi; }
__device__ __forceinline__ void phase_router(const Params& p, unsigned char* lds) {
    const int tid = threadIdx.x, lane = tid & 63, wid = tid >> 6, tile = wid >> 2, kq = wid & 3, c = lane & 31, h = lane >> 5;
    float* red = (float*)lds;
    float* ssb = red + 2 * 4 * 16 * 64;
    int* lcnt = (int*)(ssb + 2 * 4 * 64);
    int* lbase = lcnt + 32;
    unsigned* gcnt = (unsigned*)(p.ws + WS_CTL) + CW_CNT;
    int* row_tok = (int*)(p.ws + WS_RT2); float* row_w = (float*)(p.ws + WS_RT2 + 2 * MiB); int* row_slot = (int*)(p.ws + WS_RT2 + 4 * MiB); float* row_rstd = (float*)(p.ws + WS_RT2 + 6 * MiB);
    const u32x4* GF = (const u32x4*)(p.ws + WS_GF);
    for (int tg = blockIdx.x; tg < NTOK / 64; tg += gridDim.x) {
        if (tid < 32) lcnt[tid] = 0;
        const int token = tg * 64 + tile * 32 + c;
        const float* xrow = p.out + (size_t)token * DM + kq * 256 + 8 * h; const float* g2p = p.norm2_g + kq * 256 + 8 * h;
        unsigned char* hrow = p.ws + WS_H8 + (size_t)token * DM + kq * 256 + 8 * h;
        f32x16 acc = {}; float ss = 0.f;
#pragma unroll 2
        for (int s = 0; s < 16; ++s) {
            const f32x4 a = *(const f32x4*)(xrow + 16 * s), b = *(const f32x4*)(xrow + 16 * s + 4); const f32x4 ga = *(const f32x4*)(g2p + 16 * s), gb = *(const f32x4*)(g2p + 16 * s + 4);
            ss += (a[0] * a[0] + a[1] * a[1]) + (a[2] * a[2] + a[3] * a[3]) + (b[0] * b[0] + b[1] * b[1]) + (b[2] * b[2] + b[3] * b[3]);
            u32x4 xh; xh.x = pk2(a[0], a[1]); xh.y = pk2(a[2], a[3]); xh.z = pk2(b[0], b[1]); xh.w = pk2(b[2], b[3]);
            u32x4 xl; xl.x = pk2(a[0] - bf_lo(xh.x), a[1] - bf_hi(xh.x)); xl.y = pk2(a[2] - bf_lo(xh.y), a[3] - bf_hi(xh.y)); xl.z = pk2(b[0] - bf_lo(xh.z), b[1] - bf_hi(xh.z)); xl.w = pk2(b[2] - bf_lo(xh.w), b[3] - bf_hi(xh.w));
            u32x2 h8; h8.x = pk4_fp8(a[0] * ga[0], a[1] * ga[1], a[2] * ga[2], a[3] * ga[3]); h8.y = pk4_fp8(b[0] * gb[0], b[1] * gb[1], b[2] * gb[2], b[3] * gb[3]); *(u32x2*)(hrow + 16 * s) = h8;
            const u32x4 gh = GF[((kq * 16 + s) * 2 + 0) * 64 + lane], gl = GF[((kq * 16 + s) * 2 + 1) * 64 + lane];
            acc = __builtin_amdgcn_mfma_f32_32x32x16_bf16(__builtin_bit_cast(bf16x8, gh), __builtin_bit_cast(bf16x8, xh), acc, 0, 0, 0);
            acc = __builtin_amdgcn_mfma_f32_32x32x16_bf16(__builtin_bit_cast(bf16x8, gh), __builtin_bit_cast(bf16x8, xl), acc, 0, 0, 0);
            acc = __builtin_amdgcn_mfma_f32_32x32x16_bf16(__builtin_bit_cast(bf16x8, gl), __builtin_bit_cast(bf16x8, xh), acc, 0, 0, 0);
        }
#pragma unroll
        for (int r = 0; r < 16; ++r) red[((tile * 4 + kq) * 16 + r) * 64 + lane] = acc[r];
        ssb[(tile * 4 + kq) * 64 + lane] = ss;
        __syncthreads();
        int te[4] = {0, 0, 0, 0}, rl[4] = {0, 0, 0, 0}; float tw[4] = {0.f, 0.f, 0.f, 0.f}; float rstd = 0.f;
        if (kq == 0) {
            float v[16]; float st = 0.f;
#pragma unroll
            for (int q = 0; q < 4; ++q) st += ssb[(tile * 4 + q) * 64 + lane];
            { auto rr = __builtin_amdgcn_permlane32_swap(__float_as_uint(st), __float_as_uint(st), false, false); st = __uint_as_float(rr[0]) + __uint_as_float(rr[1]); }
            rstd = rsqrtf(st * (1.f / DM) + EPS);
#pragma unroll
            for (int r = 0; r < 16; ++r) { float sacc = 0.f;
#pragma unroll
                for (int q = 0; q < 4; ++q) sacc += red[((tile * 4 + q) * 16 + r) * 64 + lane];
                v[r] = sacc * rstd + p.router_b[crow16(r, h)]; }
            float lv[4]; int le[4];
#pragma unroll
            for (int k = 0; k < 4; ++k) { float best = v[0]; int bi = 0;
#pragma unroll
                for (int r = 1; r < 16; ++r) { const bool gt = v[r] > best; best = gt ? v[r] : best; bi = gt ? r : bi; }
                lv[k] = best; le[k] = (bi & 3) + 8 * (bi >> 2) + 4 * h;
#pragma unroll
                for (int r = 0; r < 16; ++r) v[r] = (r == bi) ? -INFINITY : v[r]; }
            float cv[8]; int ce[8];
#pragma unroll
            for (int k = 0; k < 4; ++k) { auto rv = __builtin_amdgcn_permlane32_swap(__float_as_uint(lv[k]), __float_as_uint(lv[k]), false, false); auto re = __builtin_amdgcn_permlane32_swap((unsigned)le[k], (unsigned)le[k], false, false);
                cv[k] = __uint_as_float(rv[0]); cv[4 + k] = __uint_as_float(rv[1]); ce[k] = (int)re[0]; ce[4 + k] = (int)re[1]; }
            float tv[4];
#pragma unroll
            for (int k = 0; k < 4; ++k) { float best = cv[0]; int be = ce[0]; int bi = 0;
#pragma unroll
                for (int r = 1; r < 8; ++r) { const bool gt = (cv[r] > best) || (cv[r] == best && ce[r] < be); best = gt ? cv[r] : best; be = gt ? ce[r] : be; bi = gt ? r : bi; }
                tv[k] = best; te[k] = be;
#pragma unroll
                for (int r = 0; r < 8; ++r) cv[r] = (r == bi) ? -INFINITY : cv[r]; }
            const float e1 = __expf(tv[1] - tv[0]), e2 = __expf(tv[2] - tv[0]), e3 = __expf(tv[3] - tv[0]); const float inv = 1.f / (1.f + e1 + e2 + e3);
            tw[0] = inv; tw[1] = e1 * inv; tw[2] = e2 * inv; tw[3] = e3 * inv;
            if (h == 0) {
#pragma unroll
                for (int k = 0; k < 4; ++k) rl[k] = atomicAdd(&lcnt[te[k]], 1); }
        }
        __syncthreads();
        if (tid < 32) lbase[tid] = (int)atomicAdd(&gcnt[tid], (unsigned)lcnt[tid]);
        __syncthreads();
        if (kq == 0 && h == 0) {
#pragma unroll
            for (int k = 0; k < 4; ++k) { const int idx = te[k] * CAP + lbase[te[k]] + rl[k]; row_tok[idx] = token; row_w[idx] = tw[k]; row_slot[idx] = token * 4 + k; row_rstd[idx] = rstd; } }
        __syncthreads();
    }
}

__device__ __forceinline__ void build_block_table(const Params& p, int* bs) {
    const unsigned* gcnt = (const unsigned*)(p.ws + WS_CTL) + CW_CNT;
    if (threadIdx.x == 0) { int acc = 0; for (int e = 0; e < NE; ++e) { bs[e] = acc; acc += ((int)__hip_atomic_load(gcnt + e, __ATOMIC_RELAXED, __HIP_MEMORY_SCOPE_AGENT) + 255) >> 8; } bs[NE] = acc; }
    __syncthreads();
}

__device__ __forceinline__ pg8::MoeOrder make_moe_order(const Params& p, unsigned char* lds, int N, bool gather) {
    int* bs = (int*)(lds + 131072); int* utab = (int*)(lds + 131072 + 256); int* gtab = (int*)(lds + 131072 + 512);
    build_block_table(p, bs);
    const int nmb = __builtin_amdgcn_readfirstlane(bs[NE]);
    pg8::MoeOrder S; S.so.init(nmb * 256, N, (int)gridDim.x, (int)blockIdx.x); S.utab = (const PG8_LAS int*)utab; S.gtab = (const PG8_LAS int*)gtab;
    const int* row_tok = (const int*)(p.ws + WS_RT2);
    for (int i = 0; i < pg8::MOE_MAXU; ++i) { pg8::Unit u; if (!S.so.next(i, u)) break; int e = 0; for (int k = 1; k < NE; ++k) if (bs[k] <= u.pm) e = k;
        const int rb = e * CAP + (u.pm - bs[e]) * 256;
        if (threadIdx.x == 0) utab[i] = e | (rb << 8);
        if (gather && threadIdx.x < 256) gtab[i * 256 + threadIdx.x] = row_tok[rb + threadIdx.x]; }
    __syncthreads();
    return S;
}
__device__ __forceinline__ void phase_moe1(const Params& p, unsigned char* lds) {
    const pg8::MoeOrder S = make_moe_order(p, lds, 2048, true);
    pg8::Gemm g{(const bf16_t*)(p.ws + WS_H8), (const bf16_t*)(p.ws + WS_W1), 0, 2048, DM / 2, (size_t)2048 * DM, 0, 0};
    pg8::EpiSwiglu E{p.ws + WS_ACT, p.b1, (const float*)(p.ws + WS_RT2 + 6 * MiB)};
    pg8::gemm_phase<pg8::EpiSwiglu, pg8::MoeOrder, true, true, true, true>((PG8_LAS unsigned char*)lds, g, S, E);
}
__device__ __forceinline__ void phase_moe2(const Params& p, unsigned char* lds) {
    const pg8::MoeOrder S = make_moe_order(p, lds, DM, false);
    pg8::Gemm g{(const bf16_t*)(p.ws + WS_ACT), (const bf16_t*)(p.ws + WS_W2), 0, DM, DFF / 2, (size_t)DM * DFF, 0, 0};
    pg8::EpiMoeOut E{p.ws + WS_YS, p.b2, (const float*)(p.ws + WS_RT2 + 2 * MiB), (const int*)(p.ws + WS_RT2 + 4 * MiB)};
    pg8::gemm_phase<pg8::EpiMoeOut, pg8::MoeOrder, true, true, true>((PG8_LAS unsigned char*)lds, g, S, E);
}

__device__ __forceinline__ float fp8_to_f32(unsigned w, int byte) {
    return byte == 0 ? __builtin_amdgcn_cvt_f32_fp8((int)w, 0) : byte == 1 ? __builtin_amdgcn_cvt_f32_fp8((int)w, 1) : byte == 2 ? __builtin_amdgcn_cvt_f32_fp8((int)w, 2) : __builtin_amdgcn_cvt_f32_fp8((int)w, 3); }
__device__ __forceinline__ void phase_combine(const Params& p) {
    const int tid = threadIdx.x, lane = tid & 63, wave = tid >> 6;
    const int gw = blockIdx.x * NWAVES + wave, NGW = gridDim.x * NWAVES;
    const unsigned char* YS = p.ws + WS_YS;
    for (int t = gw; t < NTOK; t += NGW) {
        f32x4* orow = (f32x4*)(p.out + (size_t)t * DM) + lane;
        f32x4 v[4]; unsigned w[4][4];
#pragma unroll
        for (int j = 0; j < 4; ++j) { v[j] = orow[64 * j];
#pragma unroll
            for (int k = 0; k < 4; ++k) w[j][k] = *((const unsigned*)(YS + ((size_t)t * 4 + k) * DM) + lane + 64 * j); }
#pragma unroll
        for (int j = 0; j < 4; ++j) { f32x4 s = {0.f, 0.f, 0.f, 0.f};
#pragma unroll
            for (int k = 0; k < 4; ++k) { s[0] += fp8_to_f32(w[j][k], 0); s[1] += fp8_to_f32(w[j][k], 1); s[2] += fp8_to_f32(w[j][k], 2); s[3] += fp8_to_f32(w[j][k], 3); }
            orow[64 * j] = v[j] + s * YS_INV; }
    }
}

template <class Epi>
__device__ __forceinline__ void dense_gemm(unsigned char* lds, const bf16_t* A, const bf16_t* Bt, int M, int N, int K, const Epi& E, int lda = 0, int ldb = 0, int cshift = 0) {
    pg8::Gemm g{A, Bt, M, N, K, 0, lda, ldb}; pg8::StaticOrder S; S.init(M, N, (int)gridDim.x, (int)((blockIdx.x + cshift) % gridDim.x));
    pg8::gemm_phase<Epi, pg8::StaticOrder, true, true>((PG8_LAS unsigned char*)lds, g, S, E);
}

constexpr int NPHASE = 13;
__global__ void __launch_bounds__(NTHREADS, 2) mk_fwd(Params p) {
    extern __shared__ __attribute__((aligned(16))) unsigned char lds[];
    cg::grid_group grid = cg::this_grid();
    unsigned char* ws = p.ws;
    volatile LAS unsigned* MISC = (volatile LAS unsigned*)((LAS unsigned char*)lds + MISC_OFF);
    if (threadIdx.x < 32) MISC[threadIdx.x] = 0u;
    __syncthreads();
    XcdBarrier bar = xcd_barrier_post((unsigned*)(ws + WS_CTL) + CW_BAR, MISC + 8);
    const int lo = p.ph_lo, hi = p.ph_hi;
    if (lo < 0) grid.sync();
#define IN(k) (lo <= (k) && (k) < hi)
#define SEAM(k) do { if (IN(k) && IN((k) + 1)) xcd_barrier(bar); } while (0)
    if (IN(0)) phase_prologue(p, lds);
    SEAM(0);
    if (IN(1)) { pg8::EpiProj E{(bf16_t*)(ws + WS_PROJ), (float*)(ws + WS_SSQ)}; dense_gemm(lds, (const bf16_t*)(ws + WS_XN), (const bf16_t*)(ws + WS_WIN), NTOK, INCP, DM, E); }
    if (IN(1) && IN(3)) xcd_barrier(bar);
    if (IN(3)) { const float* ssq = (const float*)(ws + WS_SSQ); const float* cst = (const float*)(ws + WS_CS); float* hs = (float*)(lds + 131072);
                 pg8::EpiQ Eq{ws + WS_Q, ssq, p.q_g, cst, hs}; dense_gemm(lds, (const bf16_t*)(ws + WS_PROJ) + OFF_CQ, (const bf16_t*)(ws + WS_WUQ), NTOK, 1024, QLORA, Eq, INCP);
                 pg8::EpiK Ek{ws + WS_K, ssq, p.k_g, cst, (const bf16_t*)(ws + WS_PROJ), hs, (const float*)(ws + WS_SHIFT)}; dense_gemm(lds, (const bf16_t*)(ws + WS_PROJ) + OFF_CKV, (const bf16_t*)(ws + WS_WUKV), NTOK, 512, KVLORA, Ek, INCP);
                 pg8::EpiVT Ev{ws + WS_V, ssq}; dense_gemm(lds, (const bf16_t*)(ws + WS_WUKV) + 512 * KVLORA, (const bf16_t*)(ws + WS_PROJ) + OFF_CKV, 512, NTOK, KVLORA, Ev, 0, INCP, (int)gridDim.x / 2);
                 phase_conv(p); }
    if (IN(3) && IN(5)) xcd_barrier(bar);
    if (IN(5)) phase_attn(p, lds);
    SEAM(5);
    if (IN(6)) { pg8::EpiGateA E{(bf16_t*)(ws + WS_M1), (const bf16_t*)(ws + WS_PROJ)}; dense_gemm(lds, (const bf16_t*)(ws + WS_AO), (const bf16_t*)(ws + WS_WOMLA), NTOK, DM, 512, E); }
    if (IN(7)) { pg8::EpiGateB E{(const bf16_t*)(ws + WS_M1), (const bf16_t*)(ws + WS_PROJ), (bf16_t*)(ws + WS_MERGED)}; dense_gemm(lds, (const bf16_t*)(ws + WS_YBIN), (const bf16_t*)(ws + WS_WOCONV), NTOK, DM, 512, E); }
    SEAM(7);
    if (IN(8)) { pg8::EpiResid E{p.x, p.out}; dense_gemm(lds, (const bf16_t*)(ws + WS_MERGED), (const bf16_t*)(ws + WS_WO), NTOK, DM, DM, E); }
    SEAM(8);
    if (IN(9)) { wconv_cleanup(p, lds); phase_router(p, lds); }
    if (IN(9) && IN(11)) xcd_barrier(bar);
    if (IN(11)) phase_moe1(p, lds);
    SEAM(11);
    if (IN(12)) phase_moe2(p, lds);
    SEAM(12);
    if (IN(13)) phase_combine(p);
#undef IN
#undef SEAM
}

extern "C" void kernel_launch(void* const* d_in, const int* in_sizes, int n_in, void* d_out, int out_size,
                              void* d_ws, size_t ws_size, hipStream_t stream) {
    static int grid_blocks = 0;
    if (!grid_blocks) {
        int dev = 0, cus = 0, per_cu = 0;
        (void)hipGetDevice(&dev);
        (void)hipDeviceGetAttribute(&cus, hipDeviceAttributeMultiprocessorCount, dev);
        (void)hipFuncSetAttribute((const void*)mk_fwd, hipFuncAttributeMaxDynamicSharedMemorySize, LDS_BYTES);
        (void)hipOccupancyMaxActiveBlocksPerMultiprocessor(&per_cu, (const void*)mk_fwd, NTHREADS, LDS_BYTES);
        if (per_cu < 1) { fprintf(stderr, "kernel_launch: occupancy query says %d blocks/CU\n", per_cu); per_cu = 1; }
        grid_blocks = cus;
        if (ws_size < WS_END2 || n_in != 21) fprintf(stderr, "kernel_launch: ws %zu < %zu or n_in %d != 21\n", ws_size, (size_t)WS_END2, n_in);
    }
    (void)hipMemsetAsync((char*)d_ws + WS_CTL, 0, 1 * MiB, stream);
    Params p{};
    p.x = (const float*)d_in[0]; p.pos = (const int*)d_in[1]; p.norm1_g = (const float*)d_in[2]; p.w_in = (const float*)d_in[3]; p.q_a_g = (const float*)d_in[4];
    p.kv_a_g = (const float*)d_in[5]; p.w_uq = (const float*)d_in[6]; p.w_ukv = (const float*)d_in[7]; p.q_g = (const float*)d_in[8]; p.k_g = (const float*)d_in[9];
    p.conv_w = (const float*)d_in[10]; p.w_o_mla = (const float*)d_in[11]; p.w_o_conv = (const float*)d_in[12]; p.w_o = (const float*)d_in[13]; p.norm2_g = (const float*)d_in[14];
    p.router_w = (const float*)d_in[15]; p.router_b = (const float*)d_in[16]; p.w1 = (const float*)d_in[17]; p.b1 = (const float*)d_in[18]; p.w2 = (const float*)d_in[19]; p.b2 = (const float*)d_in[20];
    p.out = (float*)d_out; p.ws = (unsigned char*)d_ws; p.ph_lo = 0; p.ph_hi = NPHASE + 1;
    void* args[] = {&p};
    hipError_t e = hipLaunchCooperativeKernel((const void*)mk_fwd, dim3(grid_blocks), dim3(NTHREADS), args, LDS_BYTES, stream);
    if (e != hipSuccess) fprintf(stderr, "cooperative launch failed: %s (grid %d)\n", hipGetErrorString(e), grid_blocks);
}
```

```cpp
#include <hip/hip_runtime.h>
#include <hip/hip_cooperative_groups.h>
#include <cstdio>
#include <cstdint>
namespace cg = cooperative_groups;

typedef unsigned short bf16_t;
typedef short bf16x8 __attribute__((ext_vector_type(8)));
typedef short s16x4 __attribute__((ext_vector_type(4)));
typedef float f32x4 __attribute__((ext_vector_type(4)));
typedef float f32x2 __attribute__((ext_vector_type(2)));
typedef float f32x16 __attribute__((ext_vector_type(16)));
typedef unsigned u32x4 __attribute__((ext_vector_type(4)));
typedef unsigned u32x2 __attribute__((ext_vector_type(2)));
typedef __bf16 bf16x2_t __attribute__((ext_vector_type(2)));

constexpr int NTOK = 16384, DM = 1024, SEQ = 8192;
constexpr int INC = 4000, INCP = 4096;
constexpr int OFF_CQ = 0, OFF_CKV = 256, OFF_KR = 384, OFF_U = 416, OFF_C = 928, OFF_B = 1440, OFF_GA = 1952, OFF_GB = 2976;
constexpr int NH = 8, DQK = 96, DV = 64, NE = 32, TOPK = 4, DFF = 1024;
constexpr int QLORA = 256, KVLORA = 128, CONVW = 512;
constexpr int NPAIR = NTOK * TOPK;
constexpr int MAXROWS = 73728;
constexpr float EPS = 1e-6f;
constexpr float QSCALE = 0.10206207261596575f * 1.4426950408889634f;
constexpr int CAP = 16384;
constexpr int NTHREADS = 512, NWAVES = 8;
constexpr int LDS_BYTES = 147456;

constexpr size_t MiB = 1ull << 20;
constexpr size_t WS_CTL = 0;
constexpr size_t WS_WIN = 1 * MiB;
constexpr size_t WS_WUQ = 9 * MiB;
constexpr size_t WS_WUKV = WS_WUQ + 512 * 1024;
constexpr size_t WS_WOMLA = 10 * MiB;
constexpr size_t WS_WOCONV = 11 * MiB;
constexpr size_t WS_WO = 12 * MiB;
constexpr size_t WS_ROUTE = 14 * MiB;
constexpr size_t WS_W1 = 18 * MiB;
constexpr size_t WS_W2 = 146 * MiB;
constexpr size_t WS_XN = 210 * MiB;
constexpr size_t WS_PROJ = 242 * MiB;
constexpr size_t WS_CQN = 370 * MiB;
constexpr size_t WS_CKVN = 378 * MiB;
constexpr size_t WS_YBIN = 386 * MiB;
constexpr size_t WS_QPRE = 402 * MiB;
constexpr size_t WS_KVPRE = 450 * MiB;
constexpr size_t WS_Q = 514 * MiB;
constexpr size_t WS_K = 538 * MiB;
constexpr size_t WS_V = 570 * MiB;
constexpr size_t WS_AO = 586 * MiB;
constexpr size_t WS_M1 = 602 * MiB;
constexpr size_t WS_MERGED = 666 * MiB;
constexpr size_t WS_YS = 698 * MiB;
constexpr size_t WS_END = 826 * MiB;
constexpr size_t WS_ACT = WS_PROJ;
constexpr size_t WS_H8 = WS_XN;
constexpr size_t WS_GF = 830 * MiB;
constexpr size_t WS_RT2 = 832 * MiB;
constexpr size_t WS_SSQ = 840 * MiB;
constexpr size_t WS_CS = 841 * MiB;
constexpr size_t WS_SHIFT = 843 * MiB;
constexpr size_t WS_END2 = 844 * MiB;
constexpr size_t RT_PAIR_E = 0, RT_PAIR_RANK = 262144, RT_PAIR_W = 524288, RT_ROW_TOK = 786432, RT_ROW_W = 786432 + 294912, RT_ROW_SLOT = 786432 + 2 * 294912;
constexpr int CW_CNT = 64;
constexpr int CW_BAR = 4096;
constexpr int MISC_OFF = LDS_BYTES - 256;

struct Params {
    const float* x; const int* pos; const float* norm1_g; const float* w_in; const float* q_a_g; const float* kv_a_g;
    const float* w_uq; const float* w_ukv; const float* q_g; const float* k_g; const float* conv_w; const float* w_o_mla;
    const float* w_o_conv; const float* w_o; const float* norm2_g; const float* router_w; const float* router_b;
    const float* w1; const float* b1; const float* w2; const float* b2;
    float* out; unsigned char* ws; int ph_lo, ph_hi;
};

__device__ __forceinline__ unsigned pk2(float lo, float hi) { f32x2 v = {lo, hi}; bf16x2_t b = __builtin_convertvector(v, bf16x2_t); return __builtin_bit_cast(unsigned, b); }
__device__ __forceinline__ float bf_lo(unsigned w) { return __uint_as_float(w << 16); }
__device__ __forceinline__ float bf_hi(unsigned w) { return __uint_as_float(w & 0xffff0000u); }
__device__ __forceinline__ float bf1(bf16_t h) { return __uint_as_float((unsigned)h << 16); }
__device__ __forceinline__ float wave_sum(float v) {
#pragma unroll
    for (int o = 1; o < 64; o <<= 1) v += __shfl_xor(v, o);
    return v;
}
__device__ __forceinline__ unsigned pk4_fp8(float a, float b, float c, float d) { unsigned w = 0u; w = (unsigned)__builtin_amdgcn_cvt_pk_fp8_f32(a, b, (int)w, false); w = (unsigned)__builtin_amdgcn_cvt_pk_fp8_f32(c, d, (int)w, true); return w; }
constexpr float Q8_SCALE = 4.f, K8_SCALE = 0.25f;
constexpr float W8_SCALE = 32.f, W8_INV = 1.f / 32.f, YS_SCALE = 8.f, YS_INV = 0.125f;
__device__ __forceinline__ float sigmoidf_(float v) { return __builtin_amdgcn_rcpf(1.f + __builtin_amdgcn_exp2f(v * -1.4426950408889634f)); }

namespace pg8 {
#define PG8_LAS __attribute__((address_space(3)))
constexpr int BM = 256, BK = 64, HALF = 128, HTB = HALF * BK * 2  , STAGE_BYTES = 8 * HTB, NXCD = 8, WGM = 8;

__host__ __device__ __forceinline__ int lds_byte(int r, int c) { const int st = (r >> 4) * 2 + (c >> 5), rr = r & 15, cc = c & 31, ob = rr * 64 + cc * 2; return st * 1024 + (ob ^ (((ob >> 9) & 1) << 5)); }
__host__ __device__ __forceinline__ void stage_rc(int b, int& R, int& C) { const int st = b / 1024, sb = b % 1024, swz = sb ^ (((sb >> 9) & 1) << 5); R = (st >> 1) * 16 + swz / 64; C = (st & 1) * 32 + (swz % 64) / 2; }
__host__ __device__ __forceinline__ int perm32(int rho) { const int n = rho >> 4, i = rho & 15; return 8 * (i >> 2) + 4 * n + (i & 3); }

struct Unit { int pm, pn, e, rb; };
struct Gemm { const bf16_t* A; const bf16_t* Bt; int M, N, K; size_t bstride; int lda, ldb; };

struct StaticOrder {
    int nM, nN, nwg, G, c;
    __host__ __device__ void init(int M, int N, int G_, int c_) { nM = M / BM; nN = N / BM; nwg = nM * nN; G = G_; c = c_; }
    __host__ __device__ bool next(int i, Unit& u) const {
        const long L = (long)i * G + c; if (L >= nwg) return false;
        int wgid = (int)L; { const int q = nwg / NXCD, r = nwg % NXCD, xcd = wgid % NXCD, off = wgid / NXCD; wgid = (xcd < r ? xcd * (q + 1) : r * (q + 1) + (xcd - r) * q) + off; }
        const int nig = WGM * nN, gid = wgid / nig, fm = gid * WGM, gsz = (nM - fm) < WGM ? (nM - fm) : WGM;
        u.pm = fm + ((wgid % nig) % gsz); u.pn = (wgid % nig) / gsz; u.e = 0; u.rb = 0; return true;
    }
    __device__ __forceinline__ void a_ready(const Unit&) const {}
    __device__ __forceinline__ void done(const Unit&) const {}
};


struct EpiProj {
    static constexpr bool PERM = true, AFTER_DRAIN = false;
    bf16_t* O; float* ssq;
    __device__ __forceinline__ void operator()(const f32x4 (&acc)[2][2][4][2], const Unit& u, int wr, int wc, int fr, int fq) const {
        const int row0 = u.pm * BM + wr * 64 + fr, col0 = u.pn * BM + wc * 32 + 8 * fq;
#pragma unroll
        for (int ai = 0; ai < 2; ++ai)
#pragma unroll
            for (int m = 0; m < 4; ++m) { const int row = row0 + ai * HALF + m * 16; bf16_t* rowp = O + (size_t)row * INCP + col0;
#pragma unroll
                for (int bj = 0; bj < 2; ++bj) { f32x4 v0 = acc[ai][bj][m][0], v1 = acc[ai][bj][m][1]; const int col = col0 + bj * HALF;
                    if (col >= OFF_GA && col < INC) {
#pragma unroll
                        for (int j = 0; j < 4; ++j) { v0[j] = sigmoidf_(v0[j]); v1[j] = sigmoidf_(v1[j]); } }
                    u32x4 w; w.x = pk2(v0[0], v0[1]); w.y = pk2(v0[2], v0[3]); w.z = pk2(v1[0], v1[1]); w.w = pk2(v1[2], v1[3]);
                    *(u32x4*)(rowp + bj * HALF) = w;
                    const int which = u.pn == 0 ? 0 : (u.pn == 1 ? (bj == 0 ? 1 : (wc == 0 ? 2 : -1)) : -1);
                    if (which >= 0) { float s = (v0[0] * v0[0] + v0[1] * v0[1]) + (v0[2] * v0[2] + v0[3] * v0[3]) + (v1[0] * v1[0] + v1[1] * v1[1]) + (v1[2] * v1[2] + v1[3] * v1[3]);
                        s += __shfl_xor(s, 16); s += __shfl_xor(s, 32); if (fq == 0) ssq[(size_t)row * 16 + (which == 0 ? wc * 2 + bj : (which == 1 ? 8 + wc : 12))] = s; } } }
    }
};
struct EpiBf16 {
    static constexpr bool PERM = true, AFTER_DRAIN = false;
    bf16_t* O; int ldc;
    __device__ __forceinline__ void operator()(const f32x4 (&acc)[2][2][4][2], const Unit& u, int wr, int wc, int fr, int fq) const {
        const int row0 = u.pm * BM + wr * 64 + fr, col0 = u.pn * BM + wc * 32 + 8 * fq;
#pragma unroll
        for (int ai = 0; ai < 2; ++ai)
#pragma unroll
            for (int m = 0; m < 4; ++m) { bf16_t* rowp = O + (size_t)(row0 + ai * HALF + m * 16) * ldc + col0;
#pragma unroll
                for (int bj = 0; bj < 2; ++bj) { const f32x4 v0 = acc[ai][bj][m][0], v1 = acc[ai][bj][m][1];
                    u32x4 w; w.x = pk2(v0[0], v0[1]); w.y = pk2(v0[2], v0[3]); w.z = pk2(v1[0], v1[1]); w.w = pk2(v1[2], v1[3]); *(u32x4*)(rowp + bj * HALF) = w; } }
    }
};
__device__ __forceinline__ void epi_bar() { asm volatile("s_waitcnt lgkmcnt(0)" ::: "memory"); __builtin_amdgcn_s_barrier(); asm volatile("" ::: "memory"); }
__device__ __forceinline__ u32x2 pk4bf(const f32x4 v) { u32x2 w; w.x = pk2(v[0], v[1]); w.y = pk2(v[2], v[3]); return w; }
struct EpiQ {
    static constexpr bool PERM = false, AFTER_DRAIN = false;
    unsigned char* Q; const float* ssq_cq; const float* qg; const float* cs; float* hs;
    __device__ __forceinline__ void operator()(f32x4 (&acc)[2][2][4][2], const Unit& u, int wr, int wc, int fr, int fq) const {
        int lr0 = wr * 64 + fr; asm volatile("" : "+v"(lr0), "+v"(fq));
        const int t0 = u.pm * BM + lr0;
#pragma unroll
        for (int ai = 0; ai < 2; ++ai)
#pragma unroll
            for (int m = 0; m < 4; ++m) { const f32x4 sa = *(const f32x4*)(ssq_cq + (size_t)(t0 + ai * HALF + m * 16) * 16), sb = *(const f32x4*)(ssq_cq + (size_t)(t0 + ai * HALF + m * 16) * 16 + 4);
                const float rq = rsqrtf((((sa[0] + sa[1]) + (sa[2] + sa[3])) + ((sb[0] + sb[1]) + (sb[2] + sb[3]))) * (1.f / QLORA) + EPS);
#pragma unroll
                for (int bj = 0; bj < 2; ++bj) { const f32x4 x0 = acc[ai][bj][m][0] * rq, x1 = acc[ai][bj][m][1] * rq; acc[ai][bj][m][0] = x0; acc[ai][bj][m][1] = x1;
                    float s = (x0[0] * x0[0] + x0[1] * x0[1]) + (x0[2] * x0[2] + x0[3] * x0[3]) + (x1[0] * x1[0] + x1[1] * x1[1]) + (x1[2] * x1[2] + x1[3] * x1[3]);
                    s += __shfl_xor(s, 16); s += __shfl_xor(s, 32); if (fq == 0) hs[((lr0 + ai * HALF + m * 16) * 2 + bj) * 4 + wc] = s; } }
        epi_bar();
        {
            f32x4 g0 = {0.f, 0.f, 0.f, 0.f}, g1 = g0; if (wc < 3) { g0 = *(const f32x4*)(qg + 32 * wc + 4 * fq); g1 = *(const f32x4*)(qg + 32 * wc + 16 + 4 * fq); }
#pragma unroll
            for (int ai = 0; ai < 2; ++ai)
#pragma unroll
                for (int m = 0; m < 4; ++m) { const int lr = lr0 + ai * HALF + m * 16, t = u.pm * BM + lr, b = t >> 13, s = t & (SEQ - 1);
                    f32x4 c4 = {0.f, 0.f, 0.f, 0.f}, s4 = {0.f, 0.f, 0.f, 0.f}; if (wc == 2) { c4 = *(const f32x4*)(cs + (size_t)t * 32 + 4 * fq); s4 = *(const f32x4*)(cs + (size_t)t * 32 + 16 + 4 * fq); }
#pragma unroll
                    for (int bj = 0; bj < 2; ++bj) { const f32x4 h4 = *(const f32x4*)(hs + (lr * 2 + bj) * 4); const float rstd = rsqrtf(((h4[0] + h4[1]) + h4[2]) * (1.f / DQK) + EPS) * (QSCALE * Q8_SCALE); f32x4 x0 = acc[ai][bj][m][0] * rstd * g0, x1 = acc[ai][bj][m][1] * rstd * g1;
                        if (wc == 2) { const f32x4 o0 = x0 * c4 - x1 * s4, o1 = x0 * s4 + x1 * c4; x0 = o0; x1 = o1; }
                        if (wc == 3 && fq == 0) x0[0] = Q8_SCALE;
                        unsigned char* qp = Q + ((size_t)(b * NH + 2 * u.pn + bj) * SEQ + s) * 128 + 32 * wc + 4 * fq; *(unsigned*)qp = pk4_fp8(x0[0], x0[1], x0[2], x0[3]); *(unsigned*)(qp + 16) = pk4_fp8(x1[0], x1[1], x1[2], x1[3]); }
                    asm volatile("" ::: "memory"); }
        }
    }
};
struct EpiK {
    static constexpr bool PERM = false, AFTER_DRAIN = false;
    unsigned char* K; const float* ssq; const float* kg; const float* cs; const bf16_t* proj; float* hs; const float* shiftp;
    __device__ __forceinline__ void operator()(f32x4 (&acc)[2][2][4][2], const Unit& u, int wr, int wc, int fr, int fq) const {
        int lr0 = wr * 64 + fr; asm volatile("" : "+v"(lr0), "+v"(fq));
        const int t0 = u.pm * BM + lr0, wp = wc & 1, wh = wc >> 1;
#pragma unroll
        for (int ai = 0; ai < 2; ++ai)
#pragma unroll
            for (int m = 0; m < 4; ++m) { const f32x4 sa = *(const f32x4*)(ssq + (size_t)(t0 + ai * HALF + m * 16) * 16 + 8); const float rk = rsqrtf(((sa[0] + sa[1]) + (sa[2] + sa[3])) * (1.f / KVLORA) + EPS);
#pragma unroll
                for (int bj = 0; bj < 2; ++bj) { const f32x4 x0 = acc[ai][bj][m][0] * rk, x1 = acc[ai][bj][m][1] * rk; acc[ai][bj][m][0] = x0; acc[ai][bj][m][1] = x1;
                    float s = (x0[0] * x0[0] + x0[1] * x0[1]) + (x0[2] * x0[2] + x0[3] * x0[3]) + (x1[0] * x1[0] + x1[1] * x1[1]) + (x1[2] * x1[2] + x1[3] * x1[3]);
                    s += __shfl_xor(s, 16); s += __shfl_xor(s, 32); if (fq == 0) hs[((lr0 + ai * HALF + m * 16) * 4 + 2 * bj + wh) * 2 + wp] = s; } }
        epi_bar();
        const f32x4 g0 = *(const f32x4*)(kg + 32 * wp + 4 * fq), g1 = *(const f32x4*)(kg + 32 * wp + 16 + 4 * fq);
        f32x4 gr0 = {0.f, 0.f, 0.f, 0.f}, gr1 = gr0; if (wp == 1) { gr0 = *(const f32x4*)(kg + 64 + 4 * fq); gr1 = *(const f32x4*)(kg + 80 + 4 * fq); }
        const unsigned kpad = (fq == 0) ? pk4_fp8(-shiftp[0] * K8_SCALE, 0.f, 0.f, 0.f) : 0u;
#pragma unroll
        for (int ai = 0; ai < 2; ++ai)
#pragma unroll
            for (int m = 0; m < 4; ++m) { const int lr = lr0 + ai * HALF + m * 16, t = u.pm * BM + lr, b = t >> 13, s = t & (SEQ - 1); const float skr = ssq[(size_t)t * 16 + 12];
                f32x4 c4 = {0.f, 0.f, 0.f, 0.f}, s4 = c4, r1 = c4, r2 = c4;
                if (wp == 1) { c4 = *(const f32x4*)(cs + (size_t)t * 32 + 4 * fq); s4 = *(const f32x4*)(cs + (size_t)t * 32 + 16 + 4 * fq);
                    const u32x2 a = *(const u32x2*)(proj + (size_t)t * INCP + OFF_KR + 4 * fq), bb = *(const u32x2*)(proj + (size_t)t * INCP + OFF_KR + 16 + 4 * fq);
                    r1 = (f32x4){bf_lo(a.x), bf_hi(a.x), bf_lo(a.y), bf_hi(a.y)} * gr0; r2 = (f32x4){bf_lo(bb.x), bf_hi(bb.x), bf_lo(bb.y), bf_hi(bb.y)} * gr1; }
#pragma unroll
                for (int bj = 0; bj < 2; ++bj) { const size_t rowi = (size_t)(b * NH + 4 * u.pn + 2 * bj + wh) * SEQ + s; const f32x2 h2 = *(const f32x2*)(hs + (lr * 4 + 2 * bj + wh) * 2);
                    const float rstd = rsqrtf(((h2[0] + h2[1]) + skr) * (1.f / DQK) + EPS) * K8_SCALE;
                    unsigned char* kp = K + rowi * 128; const f32x4 y0 = acc[ai][bj][m][0] * rstd * g0, y1 = acc[ai][bj][m][1] * rstd * g1;
                    *(unsigned*)(kp + 32 * wp + 4 * fq) = pk4_fp8(y0[0], y0[1], y0[2], y0[3]); *(unsigned*)(kp + 32 * wp + 16 + 4 * fq) = pk4_fp8(y1[0], y1[1], y1[2], y1[3]);
                    if (wp == 1) { const f32x4 x1 = r1 * rstd, x2 = r2 * rstd, z1 = x1 * c4 - x2 * s4, z2 = x1 * s4 + x2 * c4; *(unsigned*)(kp + 64 + 4 * fq) = pk4_fp8(z1[0], z1[1], z1[2], z1[3]); *(unsigned*)(kp + 80 + 4 * fq) = pk4_fp8(z2[0], z2[1], z2[2], z2[3]); }
                    else { *(u32x2*)(kp + 96 + 8 * fq) = (u32x2){kpad, 0u}; } }
                asm volatile("" ::: "memory"); }
    }
};
struct EpiVT {
    static constexpr bool PERM = true, AFTER_DRAIN = false;
    unsigned char* VT; const float* ssq;
    __device__ __forceinline__ void operator()(f32x4 (&acc)[2][2][4][2], const Unit& u, int wr, int wc, int fr, int fq) const {
        int tok0 = u.pn * BM + wc * 32 + 8 * fq; asm volatile("" : "+v"(tok0), "+v"(fr));
        float rs[2][8];
#pragma unroll
        for (int bj = 0; bj < 2; ++bj)
#pragma unroll
            for (int i = 0; i < 8; ++i) { const f32x4 sa = *(const f32x4*)(ssq + (size_t)(tok0 + bj * HALF + i) * 16 + 8); rs[bj][i] = rsqrtf(((sa[0] + sa[1]) + (sa[2] + sa[3])) * (1.f / KVLORA) + EPS); }
#pragma unroll
        for (int ai = 0; ai < 2; ++ai)
#pragma unroll
            for (int m = 0; m < 4; ++m) { const int row = u.pm * BM + ai * HALF + wr * 64 + m * 16 + fr, h = row >> 6, d = row & 63;
#pragma unroll
                for (int bj = 0; bj < 2; ++bj) { const int tok = tok0 + bj * HALF, b = tok >> 13, s = tok & (SEQ - 1); const f32x4 v0 = acc[ai][bj][m][0], v1 = acc[ai][bj][m][1];
                    const int k0 = s & 63, j0 = 4 * ((k0 >> 3) & 3) + 16 * (k0 >> 5), r32v = d & 31, off = (j0 & 15) + 16 * ((j0 >> 4) ^ ((r32v >> 3) & 1));
                    unsigned char* tp = VT + ((size_t)(b * NH + h) * (SEQ / 64) + (s >> 6)) * 4096 + (((d >> 5) * 32 + r32v) << 5) + off;
                    *(unsigned*)tp = pk4_fp8(v0[0] * rs[bj][0], v0[1] * rs[bj][1], v0[2] * rs[bj][2], v0[3] * rs[bj][3]);
                    *(unsigned*)(tp + 2048) = pk4_fp8(v1[0] * rs[bj][4], v1[1] * rs[bj][5], v1[2] * rs[bj][6], v1[3] * rs[bj][7]); } }
    }
};
struct EpiF32 {
    static constexpr bool PERM = false, AFTER_DRAIN = false;
    float* O; int ldc;
    __device__ __forceinline__ void operator()(const f32x4 (&acc)[2][2][4][2], const Unit& u, int wr, int wc, int fr, int fq) const {
        const int row0 = u.pm * BM + wr * 64 + fr, col0 = u.pn * BM + wc * 32 + 4 * fq;
#pragma unroll
        for (int ai = 0; ai < 2; ++ai)
#pragma unroll
            for (int m = 0; m < 4; ++m) { float* rowp = O + (size_t)(row0 + ai * HALF + m * 16) * ldc + col0;
#pragma unroll
                for (int bj = 0; bj < 2; ++bj)
#pragma unroll
                    for (int n = 0; n < 2; ++n) *(f32x4*)(rowp + bj * HALF + n * 16) = acc[ai][bj][m][n]; }
    }
};
__device__ __forceinline__ void unpack8(const u32x4 g, float (&f)[8]) { f[0] = bf_lo(g.x); f[1] = bf_hi(g.x); f[2] = bf_lo(g.y); f[3] = bf_hi(g.y); f[4] = bf_lo(g.z); f[5] = bf_hi(g.z); f[6] = bf_lo(g.w); f[7] = bf_hi(g.w); }
struct EpiGateA {
    static constexpr bool PERM = true, AFTER_DRAIN = false;
    bf16_t* M1; const bf16_t* proj;
    __device__ __forceinline__ void operator()(const f32x4 (&acc)[2][2][4][2], const Unit& u, int wr, int wc, int fr, int fq) const {
        const int row0 = u.pm * BM + wr * 64 + fr, col0 = u.pn * BM + wc * 32 + 8 * fq;
#pragma unroll
        for (int ai = 0; ai < 2; ++ai)
#pragma unroll
            for (int m = 0; m < 4; ++m) { const size_t row = (size_t)(row0 + ai * HALF + m * 16);
#pragma unroll
                for (int bj = 0; bj < 2; ++bj) { const int col = col0 + bj * HALF; float g[8]; unpack8(*(const u32x4*)(proj + row * INCP + OFF_GA + col), g);
                    const f32x4 v0 = acc[ai][bj][m][0], v1 = acc[ai][bj][m][1];
                    u32x4 w; w.x = pk2(v0[0] * g[0], v0[1] * g[1]); w.y = pk2(v0[2] * g[2], v0[3] * g[3]); w.z = pk2(v1[0] * g[4], v1[1] * g[5]); w.w = pk2(v1[2] * g[6], v1[3] * g[7]);
                    *(u32x4*)(M1 + row * DM + col) = w; } }
    }
};
struct EpiGateB {
    static constexpr bool PERM = true, AFTER_DRAIN = false;
    const bf16_t* M1; const bf16_t* proj; bf16_t* O;
    __device__ __forceinline__ void operator()(const f32x4 (&acc)[2][2][4][2], const Unit& u, int wr, int wc, int fr, int fq) const {
        const int row0 = u.pm * BM + wr * 64 + fr, col0 = u.pn * BM + wc * 32 + 8 * fq;
#pragma unroll
        for (int ai = 0; ai < 2; ++ai)
#pragma unroll
            for (int m = 0; m < 4; ++m) { const size_t row = (size_t)(row0 + ai * HALF + m * 16);
#pragma unroll
                for (int bj = 0; bj < 2; ++bj) { const int col = col0 + bj * HALF; float g[8], b[8]; unpack8(*(const u32x4*)(proj + row * INCP + OFF_GB + col), g); unpack8(*(const u32x4*)(M1 + row * DM + col), b);
                    const f32x4 v0 = acc[ai][bj][m][0], v1 = acc[ai][bj][m][1];
                    u32x4 w; w.x = pk2(b[0] + v0[0] * g[0], b[1] + v0[1] * g[1]); w.y = pk2(b[2] + v0[2] * g[2], b[3] + v0[3] * g[3]);
                    w.z = pk2(b[4] + v1[0] * g[4], b[5] + v1[1] * g[5]); w.w = pk2(b[6] + v1[2] * g[6], b[7] + v1[3] * g[7]);
                    *(u32x4*)(O + row * DM + col) = w; } }
    }
};
struct EpiResid {
    static constexpr bool PERM = false, AFTER_DRAIN = false;
    const float* X; float* O;
    __device__ __forceinline__ void operator()(const f32x4 (&acc)[2][2][4][2], const Unit& u, int wr, int wc, int fr, int fq) const {
        const int row0 = u.pm * BM + wr * 64 + fr, col0 = u.pn * BM + wc * 32 + 4 * fq;
#pragma unroll
        for (int ai = 0; ai < 2; ++ai)
#pragma unroll
            for (int m = 0; m < 4; ++m) { const size_t off = (size_t)(row0 + ai * HALF + m * 16) * DM + col0;
#pragma unroll
                for (int bj = 0; bj < 2; ++bj)
#pragma unroll
                    for (int n = 0; n < 2; ++n) { const f32x4 b = *(const f32x4*)(X + off + bj * HALF + n * 16); *(f32x4*)(O + off + bj * HALF + n * 16) = b + acc[ai][bj][m][n]; } }
    }
};
struct EpiSwiglu {
    static constexpr bool PERM = true, AFTER_DRAIN = false;
    unsigned char* ACT; const float* b1; const float* row_rstd;
    __device__ __forceinline__ void operator()(const f32x4 (&acc)[2][2][4][2], const Unit& u, int wr, int wc, int fr, int fq) const {
        const int row0 = u.pm * BM + wr * 64 + fr, f0 = u.pn * HALF + wc * 32 + 8 * fq; const float* be = b1 + (size_t)u.e * 2048;
        const f32x4 bg0 = *(const f32x4*)(be + f0), bg1 = *(const f32x4*)(be + f0 + 4), bu0 = *(const f32x4*)(be + DFF + f0), bu1 = *(const f32x4*)(be + DFF + f0 + 4);
        float rsv[8];
#pragma unroll
        for (int i = 0; i < 8; ++i) rsv[i] = row_rstd[u.rb + wr * 64 + fr + (i >> 2) * HALF + (i & 3) * 16] * W8_INV;
#pragma unroll
        for (int ai = 0; ai < 2; ++ai)
#pragma unroll
            for (int m = 0; m < 4; ++m) { const size_t row = (size_t)(row0 + ai * HALF + m * 16); float o[8]; const float rs = rsv[ai * 4 + m];
#pragma unroll
                for (int n = 0; n < 2; ++n) { const f32x4 g4 = acc[ai][0][m][n] * rs + (n ? bg1 : bg0), u4 = acc[ai][1][m][n] * rs + (n ? bu1 : bu0);
#pragma unroll
                    for (int j = 0; j < 4; ++j) { const float g = fminf(g4[j], 7.f), uu = fminf(fmaxf(u4[j], -7.f), 7.f); o[4 * n + j] = (uu + 1.f) * (g * sigmoidf_(1.702f * g)); } }
                u32x2 w; w.x = pk4_fp8(o[0], o[1], o[2], o[3]); w.y = pk4_fp8(o[4], o[5], o[6], o[7]); *(u32x2*)(ACT + row * DFF + f0) = w; }
    }
};
struct EpiMoeOut {
    static constexpr bool PERM = true, AFTER_DRAIN = false;
    unsigned char* YS; const float* b2; const float* row_w; const int* row_slot;
    __device__ __forceinline__ void operator()(const f32x4 (&acc)[2][2][4][2], const Unit& u, int wr, int wc, int fr, int fq) const {
        const int col0 = u.pn * BM + wc * 32 + 8 * fq; const float* be = b2 + (size_t)u.e * DM; const int rbase = u.rb + wr * 64 + fr;
        int slot[8]; float w[8];
#pragma unroll
        for (int i = 0; i < 8; ++i) { const int row = rbase + (i >> 2) * HALF + (i & 3) * 16; slot[i] = row_slot[row]; w[i] = row_w[row] * (W8_INV * YS_SCALE); }
        f32x4 bv[2][2];
#pragma unroll
        for (int bj = 0; bj < 2; ++bj)
#pragma unroll
            for (int n = 0; n < 2; ++n) bv[bj][n] = *(const f32x4*)(be + col0 + bj * HALF + 4 * n) * W8_SCALE;
#pragma unroll
        for (int ai = 0; ai < 2; ++ai)
#pragma unroll
            for (int m = 0; m < 4; ++m) { const int i = ai * 4 + m;
                if (slot[i] >= 0) { unsigned char* rowp = YS + (size_t)slot[i] * DM + col0;
#pragma unroll
                    for (int bj = 0; bj < 2; ++bj) { const f32x4 v0 = (acc[ai][bj][m][0] + bv[bj][0]) * w[i], v1 = (acc[ai][bj][m][1] + bv[bj][1]) * w[i];
                        u32x2 o; o.x = pk4_fp8(v0[0], v0[1], v0[2], v0[3]); o.y = pk4_fp8(v1[0], v1[1], v1[2], v1[3]); *(u32x2*)(rowp + bj * HALF) = o; } } }
    }
};
constexpr int MOE_MAXU = 12;
struct MoeOrder {
    StaticOrder so; const PG8_LAS int* utab; const PG8_LAS int* gtab;
    __device__ __forceinline__ bool next(int i, Unit& u) const { if (i >= MOE_MAXU || !so.next(i, u)) return false; const int v = __builtin_amdgcn_readfirstlane(utab[i]); u.e = v & 31; u.rb = (int)((unsigned)v >> 8); return true; }
    __device__ __forceinline__ void a_ready(const Unit&) const {}
    __device__ __forceinline__ void done(const Unit&) const {}
};
typedef int i32x4_t __attribute__((ext_vector_type(4))); typedef int i32x8_t __attribute__((ext_vector_type(8)));
__device__ __forceinline__ i32x8_t cat8(bf16x8 lo, bf16x8 hi) { return __builtin_shufflevector(__builtin_bit_cast(i32x4_t, lo), __builtin_bit_cast(i32x4_t, hi), 0, 1, 2, 3, 4, 5, 6, 7); }
__device__ __forceinline__ void mfma_fp8_inplace(f32x4& c, const i32x8_t a, const i32x8_t b) { asm volatile("s_nop 1\n\tv_mfma_f32_16x16x128_f8f6f4 %0, %1, %2, %0" : "+v"(c) : "v"(a), "v"(b)); }
__device__ __forceinline__ void mfma_fp8_drain() { asm volatile("s_nop 15\n\ts_nop 7" ::: "memory"); __builtin_amdgcn_sched_barrier(0); }
template <class Epi, class Sched, bool ALIGN_EPI = false, bool SP2 = false, bool FP8 = false, bool GATHER = false>
__device__ __forceinline__ void gemm_phase(PG8_LAS unsigned char* lds, const Gemm g, const Sched& S, const Epi& E) {
    int tid = threadIdx.x; asm volatile("" : "+v"(tid));
    const int wid = __builtin_amdgcn_readfirstlane(tid >> 6), lane = tid & 63, wr = wid >> 2, wc = wid & 3, fr = lane & 15, fq = lane >> 4;
    const int K = g.K, nt = K / BK;
    static_assert(!GATHER || SP2, "GATHER is implemented for the SP2 loop only");
    const unsigned rowA = (unsigned)(g.lda ? g.lda : K) * 2u, rowB = (unsigned)(g.ldb ? g.ldb : K) * 2u;
    unsigned voffA[2], voffB[2]; int gR0 = 0; unsigned gC = 0u;
#pragma unroll
    for (int i = 0; i < 2; ++i) { int R, C; stage_rc(tid * 16 + i * 8192, R, C); const int Rb = Epi::PERM ? ((R & ~31) + perm32(R & 31)) : R;
        voffA[i] = (unsigned)R * rowA + (unsigned)C * 2u; voffB[i] = (unsigned)Rb * rowB + (unsigned)C * 2u; if (i == 0) { gR0 = R; gC = (unsigned)C * 2u; } }
    unsigned gA[2][2] = {{0u, 0u}, {0u, 0u}}, ngA[2][2] = {{0u, 0u}, {0u, 0u}};
#define PG8_GLOAD(dst, ui_) do { _Pragma("unroll") for (int h_ = 0; h_ < 2; ++h_) _Pragma("unroll") for (int i_ = 0; i_ < 2; ++i_) \
        dst[h_][i_] = (unsigned)S.gtab[(ui_) * 256 + 128 * h_ + gR0 + 64 * i_] * rowA + gC; } while (0)
#define PG8_VA(h) (GATHER ? gA[h] : voffA)
    const unsigned kstep = (unsigned)(BK * 2);
    const unsigned hstep = (unsigned)HALF * rowB;
    const unsigned tstep = 2u * hstep;
    const unsigned hstepA = (unsigned)HALF * rowA, tstepA = 2u * hstepA;
    const unsigned hsA = GATHER ? 0u : hstepA;
    const unsigned ldsw = (unsigned)wid * 1024u;
    const int aoff = lds_byte(wr * 64 + fr, fq * 8), boff = lds_byte(wc * 32 + fr, fq * 8);
#define PG8_SA(b, h) (((b) * 2 + (h)) * HTB)
#define PG8_SB(b, h) ((4 + (b) * 2 + (h)) * HTB)
#define PG8_STAGE(rs, bufoff, goff, voff) do { _Pragma("unroll") for (int _i = 0; _i < 2; ++_i) \
        __builtin_amdgcn_raw_ptr_buffer_load_lds(rs, (PG8_LAS void*)(lds + (bufoff) + ldsw + _i * 8192), 16, (int)(voff)[_i], (int)(goff), 0, 0); } while (0)
#define PG8_LDA(dst, b, h) do { _Pragma("unroll") for (int m = 0; m < 4; ++m) _Pragma("unroll") for (int k = 0; k < 2; ++k) dst[m][k] = *(const PG8_LAS bf16x8*)(lds + PG8_SA(b, h) + aoff + m * 2048 + k * 1024); } while (0)
#define PG8_LDB(dst, b, h) do { _Pragma("unroll") for (int n = 0; n < 2; ++n) _Pragma("unroll") for (int k = 0; k < 2; ++k) dst[n][k] = *(const PG8_LAS bf16x8*)(lds + PG8_SB(b, h) + boff + n * 2048 + k * 1024); } while (0)
#define PG8_MMA(ai, bj, At, Bt) do { __builtin_amdgcn_s_setprio(1); _Pragma("unroll") for (int m = 0; m < 4; ++m) _Pragma("unroll") for (int n = 0; n < 2; ++n) { \
        if constexpr (FP8) { mfma_fp8_inplace(acc[ai][bj][m][n], cat8(Bt[n][0], Bt[n][1]), cat8(At[m][0], At[m][1])); } \
        else { _Pragma("unroll") for (int k = 0; k < 2; ++k) acc[ai][bj][m][n] = __builtin_amdgcn_mfma_f32_16x16x32_bf16(Bt[n][k], At[m][k], acc[ai][bj][m][n], 0, 0, 0); } } \
        __builtin_amdgcn_s_setprio(0); } while (0)
#define PG8_WAIT_V(n) asm volatile("s_waitcnt vmcnt(" #n ")" ::: "memory")
#define PG8_WAIT_L(n) asm volatile("s_waitcnt lgkmcnt(" #n ")" ::: "memory")
#define PG8_BAR __builtin_amdgcn_s_barrier()
#define PG8_SCHED __builtin_amdgcn_sched_barrier(0)
    Unit cur, nxt; int ui = 0;
    if (!S.next(0, cur)) return;
    f32x4 acc[2][2][4][2];
#pragma unroll
    for (int a = 0; a < 2; ++a)
#pragma unroll
        for (int b = 0; b < 2; ++b)
#pragma unroll
            for (int m = 0; m < 4; ++m)
#pragma unroll
                for (int n = 0; n < 2; ++n) acc[a][b][m][n] = (f32x4){0.f, 0.f, 0.f, 0.f};
    bf16x8 At[4][2], B0[2][2], B1[2][2];
    unsigned cA = GATHER ? 0u : (unsigned)cur.pm * tstepA, cB = (unsigned)cur.e * (unsigned)g.bstride + (unsigned)cur.pn * tstep;
    const __amdgpu_buffer_rsrc_t rsA = __builtin_amdgcn_make_buffer_rsrc((void*)g.A, 0, 0x7fffffff, 0x00020000), rsB = __builtin_amdgcn_make_buffer_rsrc((void*)g.Bt, 0, 0x7fffffff, 0x00020000);
    S.a_ready(cur);
    if constexpr (GATHER) PG8_GLOAD(gA, 0);
    if constexpr (SP2) {
        PG8_STAGE(rsB, PG8_SB(0, 0), cB, voffB); PG8_STAGE(rsB, PG8_SB(0, 1), cB + hstep, voffB); PG8_STAGE(rsA, PG8_SA(0, 0), cA, PG8_VA(0)); PG8_STAGE(rsA, PG8_SA(0, 1), cA + hsA, PG8_VA(1));
        if (wr == 1) PG8_BAR;
        PG8_WAIT_V(2); PG8_BAR;
        PG8_STAGE(rsB, PG8_SB(1, 0), cB + kstep, voffB); PG8_STAGE(rsA, PG8_SA(1, 0), cA + kstep, PG8_VA(0)); PG8_STAGE(rsB, PG8_SB(1, 1), cB + hstep + kstep, voffB);
        PG8_WAIT_V(6); PG8_BAR;
    } else {
        PG8_STAGE(rsB, PG8_SB(0, 0), cB, voffB); PG8_STAGE(rsA, PG8_SA(0, 0), cA, PG8_VA(0)); PG8_STAGE(rsB, PG8_SB(0, 1), cB + hstep, voffB); PG8_STAGE(rsA, PG8_SA(0, 1), cA + hsA, PG8_VA(1));
        if (wr == 1) PG8_BAR;
        PG8_WAIT_V(4); PG8_BAR;
        PG8_STAGE(rsB, PG8_SB(1, 0), cB + kstep, voffB); PG8_STAGE(rsA, PG8_SA(1, 0), cA + kstep, PG8_VA(0)); PG8_STAGE(rsB, PG8_SB(1, 1), cB + hstep + kstep, voffB);
        PG8_WAIT_V(6); PG8_BAR;
    }
    for (;;) {
        const bool has_next = S.next(ui + 1, nxt);
        if constexpr (GATHER) { if (has_next) PG8_GLOAD(ngA, ui + 1); else { ngA[0][0] = gA[0][0]; ngA[0][1] = gA[0][1]; ngA[1][0] = gA[1][0]; ngA[1][1] = gA[1][1]; } }
        const unsigned nA = (has_next && !GATHER) ? (unsigned)nxt.pm * tstepA : cA, nB = has_next ? (unsigned)nxt.e * (unsigned)g.bstride + (unsigned)nxt.pn * tstep : cB;
        for (int t = 0; t < nt; t += 2) {
            const bool last = (t == nt - 2);
            const unsigned a1 = cA + (unsigned)(t + 1) * kstep;
            const unsigned a2 = last ? nA : cA + (unsigned)(t + 2) * kstep, b2 = last ? nB : cB + (unsigned)(t + 2) * kstep;
            const unsigned a3 = a2 + kstep, b3 = b2 + kstep;
            if (last && has_next) S.a_ready(nxt);
            if constexpr (SP2) {
            PG8_LDB(B0, 0, 0); PG8_LDB(B1, 0, 1); PG8_SCHED; PG8_LDA(At, 0, 0); PG8_STAGE(rsA, PG8_SA(1, 1), a1 + hsA, PG8_VA(1));
            if constexpr (GATHER) { if (last) { gA[0][0] = ngA[0][0]; gA[0][1] = ngA[0][1]; gA[1][0] = ngA[1][0]; gA[1][1] = ngA[1][1]; } }
            PG8_WAIT_V(8); PG8_WAIT_L(0); PG8_BAR; PG8_MMA(0, 0, At, B0); PG8_MMA(0, 1, At, B1); PG8_BAR; PG8_SCHED;
            PG8_LDA(At, 0, 1); PG8_STAGE(rsB, PG8_SB(0, 0), b2, voffB); PG8_STAGE(rsB, PG8_SB(0, 1), b2 + hstep, voffB); PG8_STAGE(rsA, PG8_SA(0, 0), a2, PG8_VA(0));
            PG8_WAIT_V(8); PG8_WAIT_L(0); PG8_BAR; PG8_MMA(1, 0, At, B0); PG8_MMA(1, 1, At, B1); PG8_BAR; PG8_SCHED;
            PG8_LDB(B0, 1, 0); PG8_LDB(B1, 1, 1); PG8_SCHED; PG8_LDA(At, 1, 0); PG8_STAGE(rsA, PG8_SA(0, 1), a2 + hsA, PG8_VA(1));
            PG8_WAIT_V(8); PG8_WAIT_L(0); PG8_BAR; PG8_MMA(0, 0, At, B0); PG8_MMA(0, 1, At, B1); PG8_BAR; PG8_SCHED;
            PG8_LDA(At, 1, 1); PG8_STAGE(rsB, PG8_SB(1, 0), b3, voffB); PG8_STAGE(rsB, PG8_SB(1, 1), b3 + hstep, voffB); PG8_STAGE(rsA, PG8_SA(1, 0), a3, PG8_VA(0));
            PG8_WAIT_V(8); PG8_WAIT_L(0); PG8_BAR; PG8_MMA(1, 0, At, B0); PG8_MMA(1, 1, At, B1); PG8_BAR; PG8_SCHED;
            } else {
            PG8_LDB(B0, 0, 0); PG8_SCHED; PG8_LDA(At, 0, 0); PG8_STAGE(rsA, PG8_SA(1, 1), a1 + hsA, PG8_VA(1));
            PG8_WAIT_L(8); PG8_BAR; PG8_WAIT_L(0); PG8_MMA(0, 0, At, B0); PG8_BAR; PG8_SCHED;
            PG8_LDB(B1, 0, 1); PG8_STAGE(rsB, PG8_SB(0, 0), b2, voffB);
            PG8_BAR; PG8_WAIT_L(0); PG8_MMA(0, 1, At, B1); PG8_BAR;
            PG8_LDA(At, 0, 1); PG8_STAGE(rsA, PG8_SA(0, 0), a2, PG8_VA(0));
            PG8_BAR; PG8_WAIT_L(0); PG8_MMA(1, 0, At, B0); PG8_BAR; PG8_SCHED;
            PG8_STAGE(rsB, PG8_SB(0, 1), b2 + hstep, voffB);
            PG8_WAIT_V(6); PG8_BAR; PG8_MMA(1, 1, At, B1); PG8_BAR;
            PG8_LDB(B0, 1, 0); PG8_SCHED; PG8_LDA(At, 1, 0); PG8_STAGE(rsA, PG8_SA(0, 1), a2 + hsA, PG8_VA(1));
            PG8_WAIT_L(8); PG8_BAR; PG8_WAIT_L(0); PG8_MMA(0, 0, At, B0); PG8_BAR; PG8_SCHED;
            PG8_LDB(B1, 1, 1); PG8_STAGE(rsB, PG8_SB(1, 0), b3, voffB);
            PG8_BAR; PG8_WAIT_L(0); PG8_MMA(0, 1, At, B1); PG8_BAR;
            PG8_LDA(At, 1, 1); PG8_STAGE(rsA, PG8_SA(1, 0), a3, PG8_VA(0));
            PG8_BAR; PG8_WAIT_L(0); PG8_MMA(1, 0, At, B0); PG8_BAR; PG8_SCHED;
            PG8_STAGE(rsB, PG8_SB(1, 1), b3 + hstep, voffB);
            PG8_WAIT_V(6); PG8_BAR; PG8_MMA(1, 1, At, B1); PG8_BAR;
            }
        }
        if constexpr (ALIGN_EPI) { if (wr == 0) PG8_BAR; }
        if constexpr (FP8) mfma_fp8_drain();
        if constexpr (!Epi::AFTER_DRAIN) { E(acc, cur, wr, wc, fr, fq); S.done(cur); }
        if (!has_next) break;
#pragma unroll
        for (int a = 0; a < 2; ++a)
#pragma unroll
            for (int b = 0; b < 2; ++b)
#pragma unroll
                for (int m = 0; m < 4; ++m)
#pragma unroll
                    for (int n = 0; n < 2; ++n) acc[a][b][m][n] = (f32x4){0.f, 0.f, 0.f, 0.f};
        cur = nxt; cA = nA; cB = nB; ++ui;
        if constexpr (ALIGN_EPI) { if (wr == 1) PG8_BAR; }
    }
    PG8_WAIT_V(0);
    if constexpr (!ALIGN_EPI) { if (wr == 0) PG8_BAR; }
    PG8_BAR;
    if constexpr (Epi::AFTER_DRAIN) { E.fused(acc, cur, wr, wc, fr, fq, lds, wid, lane); S.done(cur); }
#undef PG8_SA
#undef PG8_GLOAD
#undef PG8_VA
#undef PG8_SB
#undef PG8_STAGE
#undef PG8_LDA
#undef PG8_LDB
#undef PG8_MMA
#undef PG8_WAIT_V
#undef PG8_WAIT_L
#undef PG8_BAR
#undef PG8_SCHED
}
}

#define GAS __attribute__((address_space(1)))
#define LAS __attribute__((address_space(3)))
#define XB_TMO      128
#define XB_XCNT(j)  (256  + 64 * (j))
#define XB_XSUB(j)  (1280 + 64 * (j))
#define XB_XGEN(j)  (2304 + 64 * (j))
#define XB_TOP      3328
#define XB_TOPGEN   3392
#define XCD_BAR_WORDS 3456
#define XB_SPIN_CAP (1u << 18)

__device__ __forceinline__ unsigned xb_ld(unsigned* p)              { return __hip_atomic_load(p, __ATOMIC_RELAXED, __HIP_MEMORY_SCOPE_AGENT); }
__device__ __forceinline__ unsigned xb_add(unsigned* p, unsigned v) { return __hip_atomic_fetch_add(p, v, __ATOMIC_RELAXED, __HIP_MEMORY_SCOPE_AGENT); }
__device__ __forceinline__ unsigned xb_xcc_id() { return (unsigned)__builtin_amdgcn_s_getreg((3 << 11) | 20) & 0xFu; }
#define XB_SPIN(cond, bar) do { unsigned _sp = 0; while (cond) { __builtin_amdgcn_s_sleep(1); \
    if ((++_sp & 255u) == 0u) { if (xb_ld(&(bar)[XB_TMO])) break; if (_sp > XB_SPIN_CAP) { atomicAdd(&(bar)[XB_TMO], 1u); break; } } } } while (0)

struct XcdBarrier {
    unsigned* bar; unsigned x;
    volatile LAS unsigned* st;
};

__device__ __forceinline__ XcdBarrier xcd_barrier_post(unsigned* bar, volatile LAS unsigned* st) {
    XcdBarrier b; b.bar = bar; b.x = xb_xcc_id(); b.st = st;
    if (threadIdx.x == 0) (void)xb_add(&bar[XB_XCNT(b.x)], 1u);
    return b;
}
__device__ __forceinline__ void xcd_barrier_complete(unsigned* bar, unsigned x, unsigned& nloc, unsigned& nx) {
    const unsigned G = gridDim.x * gridDim.y * gridDim.z;
    unsigned sum, cnt, mine, sp = 0u;
    for (;;) {
        sum = 0u; cnt = 0u; mine = 0u;
#pragma unroll
        for (unsigned j = 0; j < 16; ++j) { const unsigned c = xb_ld(&bar[XB_XCNT(j)]); sum += c; cnt += (c > 0u) ? 1u : 0u; mine = (j == x) ? c : mine; }
        if (sum == G) break;
        __builtin_amdgcn_s_sleep(1);
        if ((++sp & 255u) == 0u) { if (xb_ld(&bar[XB_TMO])) break; if (sp > XB_SPIN_CAP) { atomicAdd(&bar[XB_TMO], 1u); break; } }
    }
    nloc = mine > 0u ? mine : 1u; nx = cnt > 0u ? cnt : 1u;
}

__device__ __forceinline__ void xcd_barrier(const XcdBarrier& b) {
    asm volatile("s_waitcnt vmcnt(0)" ::: "memory");
    __syncthreads();
    if (threadIdx.x == 0) {
        unsigned* bar = b.bar;
        __builtin_amdgcn_s_waitcnt(0);
        unsigned nloc = b.st[0], nx = b.st[1];
        if (nloc == 0u) { xcd_barrier_complete(bar, b.x, nloc, nx); b.st[0] = nloc; b.st[1] = nx; }
        const unsigned old = xb_add(&bar[XB_XSUB(b.x)], 1u);
        const unsigned gen = old / nloc;
        if (old + 1u == (gen + 1u) * nloc) {
            __builtin_amdgcn_fence(__ATOMIC_RELEASE, "agent");
            asm volatile("s_waitcnt vmcnt(0)" ::: "memory");
            const unsigned og = xb_add(&bar[XB_TOP], 1u);
            const unsigned tg = og / nx;
            if (og + 1u == (tg + 1u) * nx) xb_add(&bar[XB_TOPGEN], 1u);
            else XB_SPIN(xb_ld(&bar[XB_TOPGEN]) == tg, bar);
            __builtin_amdgcn_fence(__ATOMIC_ACQUIRE, "agent");
            xb_add(&bar[XB_XGEN(b.x)], 1u);
            asm volatile("s_waitcnt vmcnt(0)" ::: "memory");
        } else {
            XB_SPIN(xb_ld(&bar[XB_XGEN(b.x)]) == gen, bar);
            __builtin_amdgcn_fence(__ATOMIC_ACQUIRE, "agent");
            asm volatile("s_waitcnt vmcnt(0)" ::: "memory");
        }
    }
    __syncthreads();
}

template <int MODE  >
__device__ __forceinline__ void transpose_item(const float* __restrict__ W, int K, int N, bf16_t* __restrict__ WT, const float* __restrict__ gain, float* scr, int item, int lane) {
    const int nblk = N / 32, kb = item / nblk, nb = item % nblk, k0 = 64 * kb, n0 = 32 * nb;
#pragma unroll
    for (int i = 0; i < 8; ++i) { const int kk = 8 * i + (lane >> 3), n4 = (lane & 7) * 4; f32x4 v = *(const f32x4*)(W + (size_t)(k0 + kk) * N + n0 + n4);
        if (gain) { const float g = gain[k0 + kk]; v = v * g; }
        float* s = scr + kk * 33 + n4; s[0] = v[0]; s[1] = v[1]; s[2] = v[2]; s[3] = v[3]; }
    asm volatile("s_waitcnt lgkmcnt(0)" ::: "memory");
    const int c = lane & 7;
#pragma unroll
    for (int j = 0; j < 4; ++j) { const int n = (lane >> 3) + 8 * j; const float* s = scr + (8 * c) * 33 + n;
        u32x4 o; o.x = pk2(s[0 * 33], s[1 * 33]); o.y = pk2(s[2 * 33], s[3 * 33]); o.z = pk2(s[4 * 33], s[5 * 33]); o.w = pk2(s[6 * 33], s[7 * 33]);
        int row = n0 + n;
        if (MODE == 1) { const int f = row & 1023; row = ((f >> 7) << 8) + ((row >> 10) << 7) + (f & 127); }
        if (MODE == 2) { const int hh = row / DQK; row = hh * 128 + (row - hh * DQK); }
        if (MODE == 3) { const int hh = row >> 7, ii = row & 127; row = ((ii >> 6) << 9) + hh * 64 + (ii & 63); }
        *(u32x4*)(WT + (size_t)row * K + k0 + 8 * c) = o; }
    asm volatile("s_waitcnt lgkmcnt(0)" ::: "memory");
}
template <int MODE>
__device__ __forceinline__ void transpose_item_fp8(const float* __restrict__ W, int K, int N, unsigned char* __restrict__ WT, float* scr, int item, int lane) {
    const int nblk = N / 32, kb = item / nblk, nb = item % nblk, k0 = 64 * kb, n0 = 32 * nb;
#pragma unroll
    for (int i = 0; i < 8; ++i) { const int kk = 8 * i + (lane >> 3), n4 = (lane & 7) * 4; const f32x4 v = *(const f32x4*)(W + (size_t)(k0 + kk) * N + n0 + n4) * W8_SCALE;
        float* s = scr + kk * 33 + n4; s[0] = v[0]; s[1] = v[1]; s[2] = v[2]; s[3] = v[3]; }
    asm volatile("s_waitcnt lgkmcnt(0)" ::: "memory");
    const int c = lane & 7;
#pragma unroll
    for (int j = 0; j < 4; ++j) { const int n = (lane >> 3) + 8 * j; const float* s = scr + (8 * c) * 33 + n;
        u32x2 o; o.x = pk4_fp8(s[0 * 33], s[1 * 33], s[2 * 33], s[3 * 33]); o.y = pk4_fp8(s[4 * 33], s[5 * 33], s[6 * 33], s[7 * 33]);
        int row = n0 + n;
        if (MODE == 1) { const int f = row & 1023; row = ((f >> 7) << 8) + ((row >> 10) << 7) + (f & 127); }
        *(u32x2*)(WT + (size_t)row * K + k0 + 8 * c) = o; }
    asm volatile("s_waitcnt lgkmcnt(0)" ::: "memory");
}
__device__ __forceinline__ void phase_prologue(const Params& p, unsigned char* lds) {
    const int tid = threadIdx.x, lane = tid & 63, wave = tid >> 6;
    float* scr = (float*)(lds + wave * 16384);
    const int gw = blockIdx.x * NWAVES + wave, NGW = gridDim.x * NWAVES;
    unsigned char* ws = p.ws;
    constexpr int I_WIN = (DM / 64) * (INC / 32), I_UQ = (QLORA / 64) * (768 / 32), I_UKV = (KVLORA / 64) * (1024 / 32), I_OM = (512 / 64) * (DM / 32), I_OC = I_OM, I_WO = (DM / 64) * (DM / 32);
    constexpr int I_W1 = (DM / 64) * (2048 / 32), I_W2 = (DFF / 64) * (DM / 32);
    constexpr int NSMALL = I_WIN + I_UQ + I_UKV + I_OM + I_OC + I_WO;
    constexpr int NITEMS = NSMALL;
    for (int it = gw; it < NITEMS; it += NGW) {
        int r = it;
        if (r < I_WIN) { transpose_item<0>(p.w_in, DM, INC, (bf16_t*)(ws + WS_WIN), p.norm1_g, scr, r, lane); continue; } r -= I_WIN;
        if (r < I_UQ) { transpose_item<2>(p.w_uq, QLORA, 768, (bf16_t*)(ws + WS_WUQ), p.q_a_g, scr, r, lane); continue; } r -= I_UQ;
        if (r < I_UKV) { transpose_item<3>(p.w_ukv, KVLORA, 1024, (bf16_t*)(ws + WS_WUKV), p.kv_a_g, scr, r, lane); continue; } r -= I_UKV;
        if (r < I_OM) { transpose_item<0>(p.w_o_mla, 512, DM, (bf16_t*)(ws + WS_WOMLA), nullptr, scr, r, lane); continue; } r -= I_OM;
        if (r < I_OC) { transpose_item<0>(p.w_o_conv, 512, DM, (bf16_t*)(ws + WS_WOCONV), nullptr, scr, r, lane); continue; } r -= I_OC;
        transpose_item<0>(p.w_o, DM, DM, (bf16_t*)(ws + WS_WO), nullptr, scr, r, lane);
    }
    { u32x4* z = (u32x4*)((bf16_t*)(ws + WS_WIN) + (size_t)INC * DM); const int nz = (INCP - INC) * DM * 2 / 16;
      for (int i = blockIdx.x * NTHREADS + tid; i < nz; i += gridDim.x * NTHREADS) z[i] = (u32x4){0u, 0u, 0u, 0u}; }
    { u32x4* wq = (u32x4*)(ws + WS_WUQ); for (int i = blockIdx.x * NTHREADS + tid; i < NH * 32 * QLORA * 2 / 16; i += gridDim.x * NTHREADS) { const int hh = i / (32 * QLORA * 2 / 16), q = i - hh * (32 * QLORA * 2 / 16); wq[(hh * 128 + 96) * (QLORA * 2 / 16) + q] = (u32x4){0u, 0u, 0u, 0u}; } }
    { float* csd = (float*)(ws + WS_CS); for (int i = blockIdx.x * NTHREADS + tid; i < NTOK * 16; i += gridDim.x * NTHREADS) { const int t = i >> 4, j = i & 15; float sn, cn; sincosf((float)p.pos[t] * exp2f(-(float)j * (13.287712379549449f / 16.f)), &sn, &cn); csd[t * 32 + j] = cn; csd[t * 32 + 16 + j] = sn; } }
    if (blockIdx.x == 0 && tid < 64) { float gq = fabsf(p.q_g[tid]), gk = fabsf(p.k_g[tid]); if (tid < 32) { gq = fmaxf(gq, fabsf(p.q_g[64 + tid])); gk = fmaxf(gk, fabsf(p.k_g[64 + tid])); }
#pragma unroll
        for (int o = 1; o < 64; o <<= 1) { gq = fmaxf(gq, __shfl_xor(gq, o)); gk = fmaxf(gk, __shfl_xor(gk, o)); }
        if (tid == 0) *(float*)(ws + WS_SHIFT) = fmaxf(2.f, ceilf(14.135f * gq * gk + 0.5f - 15.f)); }
    { int* rt = (int*)(ws + WS_RT2); int* rs = (int*)(ws + WS_RT2 + 4 * MiB); float* rr = (float*)(ws + WS_RT2 + 6 * MiB);
      for (int i = blockIdx.x * NTHREADS + tid; i < NE * CAP; i += gridDim.x * NTHREADS) { rt[i] = 0; rs[i] = -1; rr[i] = 0.f; } }
    { u32x4* GF = (u32x4*)(ws + WS_GF);
      for (int i = blockIdx.x * NTHREADS + tid; i < 64 * 64; i += gridDim.x * NTHREADS) { const int ks = i >> 6, ln = i & 63, r = ln & 31, h = ln >> 5; float v[8], lo[8]; unsigned hi[4];
#pragma unroll
          for (int j = 0; j < 8; ++j) { const int k = 16 * ks + 8 * h + j; v[j] = p.norm2_g[k] * p.router_w[(size_t)k * NE + r]; }
#pragma unroll
          for (int j = 0; j < 4; ++j) { hi[j] = pk2(v[2 * j], v[2 * j + 1]); lo[2 * j] = v[2 * j] - bf_lo(hi[j]); lo[2 * j + 1] = v[2 * j + 1] - bf_hi(hi[j]); }
          GF[(ks * 2 + 0) * 64 + ln] = (u32x4){hi[0], hi[1], hi[2], hi[3]}; GF[(ks * 2 + 1) * 64 + ln] = (u32x4){pk2(lo[0], lo[1]), pk2(lo[2], lo[3]), pk2(lo[4], lo[5]), pk2(lo[6], lo[7])}; } }
    bf16_t* XN = (bf16_t*)(ws + WS_XN);
    for (int m = gw; m < NTOK; m += NGW) {
        const f32x4* xr = (const f32x4*)(p.x + (size_t)m * DM) + lane; f32x4 v[4]; float s = 0.f;
#pragma unroll
        for (int j = 0; j < 4; ++j) { v[j] = xr[64 * j]; s += (v[j][0] * v[j][0] + v[j][1] * v[j][1]) + (v[j][2] * v[j][2] + v[j][3] * v[j][3]); }
        const float rstd = rsqrtf(wave_sum(s) * (1.f / DM) + EPS);
        u32x2* o = (u32x2*)(XN + (size_t)m * DM) + lane;
#pragma unroll
        for (int j = 0; j < 4; ++j) { u32x2 w; w.x = pk2(v[j][0] * rstd, v[j][1] * rstd); w.y = pk2(v[j][2] * rstd, v[j][3] * rstd); o[64 * j] = w; }
    }
}

struct ConvRaw { u32x4 u[3], c[3], bg; float m0, m2; };
__device__ __forceinline__ void conv_load(ConvRaw& r, const Params& p, int t, int lane) {
    const bf16_t* pr = (const bf16_t*)(p.ws + WS_PROJ) + (size_t)t * INCP; const int s = t & (SEQ - 1);
    r.m0 = s > 0 ? 1.f : 0.f; r.m2 = s < SEQ - 1 ? 1.f : 0.f;
    const bf16_t* pm = s > 0 ? pr - INCP : pr; const bf16_t* pp = s < SEQ - 1 ? pr + INCP : pr;
    r.u[0] = *(const u32x4*)(pm + OFF_U + 8 * lane); r.c[0] = *(const u32x4*)(pm + OFF_C + 8 * lane);
    r.u[1] = *(const u32x4*)(pr + OFF_U + 8 * lane); r.c[1] = *(const u32x4*)(pr + OFF_C + 8 * lane);
    r.u[2] = *(const u32x4*)(pp + OFF_U + 8 * lane); r.c[2] = *(const u32x4*)(pp + OFF_C + 8 * lane);
    r.bg = *(const u32x4*)(pr + OFF_B + 8 * lane);
}
__device__ __forceinline__ void mulpair8(const u32x4 u, const u32x4 c, float (&o)[8]) {
    o[0] = bf_lo(u.x) * bf_lo(c.x); o[1] = bf_hi(u.x) * bf_hi(c.x); o[2] = bf_lo(u.y) * bf_lo(c.y); o[3] = bf_hi(u.y) * bf_hi(c.y);
    o[4] = bf_lo(u.z) * bf_lo(c.z); o[5] = bf_hi(u.z) * bf_hi(c.z); o[6] = bf_lo(u.w) * bf_lo(c.w); o[7] = bf_hi(u.w) * bf_hi(c.w); }
__device__ __forceinline__ void conv_store(const ConvRaw& r, const Params& p, int t, int lane, const float (&cw0)[8], const float (&cw1)[8], const float (&cw2)[8]) {
    float cu0[8], cu1[8], cu2[8], bb[8], y[8]; mulpair8(r.u[0], r.c[0], cu0); mulpair8(r.u[1], r.c[1], cu1); mulpair8(r.u[2], r.c[2], cu2);
    bb[0] = bf_lo(r.bg.x); bb[1] = bf_hi(r.bg.x); bb[2] = bf_lo(r.bg.y); bb[3] = bf_hi(r.bg.y); bb[4] = bf_lo(r.bg.z); bb[5] = bf_hi(r.bg.z); bb[6] = bf_lo(r.bg.w); bb[7] = bf_hi(r.bg.w);
#pragma unroll
    for (int j = 0; j < 8; ++j) y[j] = bb[j] * (cw0[j] * r.m0 * cu0[j] + cw1[j] * cu1[j] + cw2[j] * r.m2 * cu2[j]);
    u32x4 o; o.x = pk2(y[0], y[1]); o.y = pk2(y[2], y[3]); o.z = pk2(y[4], y[5]); o.w = pk2(y[6], y[7]); *(u32x4*)((bf16_t*)(p.ws + WS_YBIN) + (size_t)t * CONVW + 8 * lane) = o;
}
__device__ __forceinline__ void phase_conv(const Params& p) {
    int tid = threadIdx.x; asm volatile("" : "+v"(tid)); const int lane = tid & 63, wave = tid >> 6;
    const int gw = blockIdx.x * NWAVES + wave, NGW = gridDim.x * NWAVES;
    float cw0[8], cw1[8], cw2[8];
#pragma unroll
    for (int j = 0; j < 8; ++j) { cw0[j] = p.conv_w[8 * lane + j]; cw1[j] = p.conv_w[CONVW + 8 * lane + j]; cw2[j] = p.conv_w[2 * CONVW + 8 * lane + j]; }
    for (int t = gw; t < NTOK; t += 2 * NGW) {
        const int t1 = t + NGW; const bool two = t1 < NTOK;
        ConvRaw r0, r1; conv_load(r0, p, t, lane); conv_load(r1, p, two ? t1 : t, lane);
        conv_store(r0, p, t, lane, cw0, cw1, cw2);
        if (two) conv_store(r1, p, t1, lane, cw0, cw1, cw2);
    }
}

constexpr int WC_EXP_ITEMS = NE * 1536, WC_RAW_B = 9 * 1024;
struct WcItem { const float* W; unsigned char* WT; int N, k0, n0, mode; };
__device__ __forceinline__ WcItem wc_decode(const Params& p, int x) {
    WcItem it; const int e = x / 1536, r = x - e * 1536;
    if (r < 1024) { it.W = p.w1 + (size_t)e * DM * 2048; it.WT = p.ws + WS_W1 + (size_t)e * 2048 * DM; it.N = 2048; it.k0 = 64 * (r >> 6); it.n0 = 32 * (r & 63); it.mode = 1; }
    else { const int q = r - 1024; it.W = p.w2 + (size_t)e * DFF * DM; it.WT = p.ws + WS_W2 + (size_t)e * DM * DFF; it.N = DM; it.k0 = 64 * (q >> 5); it.n0 = 32 * (q & 31); it.mode = 0; }
    return it;
}
struct WConv { unsigned char* raw; int x0, nitems, cs; };
__device__ __forceinline__ bool wconv_step(WConv& c, const Params& p, int lane) {
    typedef __attribute__((address_space(3))) unsigned* lds_u32p;
    const int cs = c.cs, nst = 8 * c.nitems, fi = cs - 9;
    if (fi >= 0 && (fi & 7) == 0 && (fi >> 3) < c.nitems) {
        const int i = fi >> 3; const WcItem it = wc_decode(p, c.x0 + i); const int c8 = lane & 7, nr = lane >> 3, lv = (nr >> 2) | (c8 << 1);
        int sl = (8 * i) % 9 + c8; sl -= (sl >= 9) ? 9 : 0;
        const unsigned char* rb = c.raw + sl * 1024 + (nr & 3) * 4;
        float v[4][8];
#pragma unroll
        for (int j = 0; j < 4; ++j)
#pragma unroll
            for (int k = 0; k < 8; ++k) v[j][k] = *(const float*)(rb + (((k * 8 + 2 * j) ^ lv) << 4));
#pragma unroll
        for (int j = 0; j < 4; ++j) {
            u32x2 o; o.x = pk4_fp8(v[j][0] * W8_SCALE, v[j][1] * W8_SCALE, v[j][2] * W8_SCALE, v[j][3] * W8_SCALE); o.y = pk4_fp8(v[j][4] * W8_SCALE, v[j][5] * W8_SCALE, v[j][6] * W8_SCALE, v[j][7] * W8_SCALE);
            int row = it.n0 + nr + 8 * j; if (it.mode == 1) { const int f = row & 1023; row = ((f >> 7) << 8) + ((row >> 10) << 7) + (f & 127); }
            *(u32x2*)(it.WT + (size_t)row * DM + it.k0 + 8 * c8) = o; }
    }
    const bool issue = cs < nst;
    if (issue) {
        const WcItem it = wc_decode(p, c.x0 + (cs >> 3)); const int q = cs & 7, sv = lane ^ (q << 1), kk = sv >> 3, n4 = (sv & 7) * 4;
        __builtin_amdgcn_global_load_lds((const unsigned*)(it.W + (size_t)(it.k0 + 8 * q + kk) * it.N + it.n0 + n4), (lds_u32p)(c.raw + (cs % 9) * 1024 + lane * 16), 16, 0, 0);
    }
    c.cs = cs + 1;
    return issue;
}

namespace att {
constexpr int NW = 8, QBLK = 32, KVBLK = 64;
constexpr float SCALE = 0.10206207261596575f;
constexpr float QSC = SCALE * 1.4426950408889634f;
constexpr int LDQ = 128, LDK = 128;
constexpr int SHM_V = KVBLK * DV, SHM_K = KVBLK * 128, SHM_ATTN = 2 * SHM_V + 2 * SHM_K + NW * 64 * 4;
#define KSWZ(row, colB) ((row) * 256 + ((colB) ^ (((row) & 7) << 4)))
#define SBAR() __builtin_amdgcn_sched_barrier(0)
__device__ __forceinline__ int crow(int r, int hi) { return (r & 3) + 8 * (r >> 2) + 4 * hi; }
__device__ __forceinline__ float fadd_s(float a, float b) { float r; asm("v_add_f32_e32 %0, %1, %2" : "=v"(r) : "v"(a), "v"(b)); return r; }
__device__ __forceinline__ unsigned cvtpk(float lo, float hi) { unsigned r; asm volatile("v_cvt_pk_bf16_f32 %0, %1, %2" : "=v"(r) : "v"(lo), "v"(hi)); return r; }
typedef int i32x4a __attribute__((ext_vector_type(4))); typedef int i32x8a __attribute__((ext_vector_type(8)));
#define EXPH(P) do { _Pragma("unroll") for (int r = 0; r < 16; ++r) P[r] = __builtin_amdgcn_exp2f(P[r]); } while (0)
__device__ __forceinline__ unsigned pk4_bf8(float a, float b, float c, float d) { unsigned w = 0u; w = (unsigned)__builtin_amdgcn_cvt_pk_bf8_f32(a, b, (int)w, false); w = (unsigned)__builtin_amdgcn_cvt_pk_bf8_f32(c, d, (int)w, true); return w; }
__device__ __forceinline__ void finishSM(f32x16& p0, f32x16& p1, float& l_reg, i32x8a& pf) {
    EXPH(p1); SBAR();
    float ps0 = p0[0], ps1 = p1[0];
#pragma unroll
    for (int r = 1; r < 16; ++r) { ps0 = fadd_s(ps0, p0[r]); ps1 = fadd_s(ps1, p1[r]); }
    l_reg += ps0 + ps1;
#pragma unroll
    for (int q = 0; q < 4; ++q) {
        pf[q] = __builtin_amdgcn_cvt_pk_bf8_f32(p0[4 * q], p0[4 * q + 1], pf[q], false); pf[q] = __builtin_amdgcn_cvt_pk_bf8_f32(p0[4 * q + 2], p0[4 * q + 3], pf[q], true);
        pf[4 + q] = __builtin_amdgcn_cvt_pk_bf8_f32(p1[4 * q], p1[4 * q + 1], pf[4 + q], false); pf[4 + q] = __builtin_amdgcn_cvt_pk_bf8_f32(p1[4 * q + 2], p1[4 * q + 3], pf[4 + q], true); }
}
__device__ __forceinline__ void qkt(f32x16& p0, f32x16& p1, const unsigned char* Ks, const i32x8a* qf, int r32, int hi) {
    const f32x16 z = {};
#pragma unroll
    for (int kh = 0; kh < 2; ++kh) { const int row = kh * 32 + r32, sw = (row >> 1) & 7; const unsigned char* rb = Ks + row * 128; f32x16 acc = z;
#pragma unroll
        for (int s = 0; s < 2; ++s) { const int c0 = 4 * s + 2 * hi; const i32x4a lo = *reinterpret_cast<const i32x4a*>(rb + ((c0 ^ sw) << 4)), hh = *reinterpret_cast<const i32x4a*>(rb + (((c0 + 1) ^ sw) << 4));
            acc = __builtin_amdgcn_mfma_scale_f32_32x32x64_f8f6f4(__builtin_shufflevector(lo, hh, 0, 1, 2, 3, 4, 5, 6, 7), qf[s], acc, 0, 0, 0, 0, 0, 0); }
        if (kh == 0) p0 = acc; else p1 = acc; }
}
__device__ __forceinline__ i32x8a kfrag(const unsigned char* Ks, int kh, int s, int r32, int hi) {
    const int row = kh * 32 + r32, sw = (row >> 1) & 7, c0 = 4 * s + 2 * hi; const unsigned char* rb = Ks + row * 128;
    const i32x4a lo = *reinterpret_cast<const i32x4a*>(rb + ((c0 ^ sw) << 4)), hh = *reinterpret_cast<const i32x4a*>(rb + (((c0 + 1) ^ sw) << 4));
    return __builtin_shufflevector(lo, hh, 0, 1, 2, 3, 4, 5, 6, 7);
}
__device__ __forceinline__ i32x8a vfrag(const unsigned char* Vs, int d0, int r32, int hi) {
    const unsigned char* b = Vs + (((hi * 2 + d0) * 32 + r32) << 5); const int sw = (r32 >> 3) & 1;
    const i32x4a lo = *reinterpret_cast<const i32x4a*>(b + (sw << 4)), hh = *reinterpret_cast<const i32x4a*>(b + ((sw ^ 1) << 4));
    return __builtin_shufflevector(lo, hh, 0, 1, 2, 3, 4, 5, 6, 7);
}
__device__ __forceinline__ void pv8(f32x16& od, const i32x8a v, const i32x8a pfr) { asm volatile("s_nop 1\n\tv_mfma_f32_32x32x64_f8f6f4 %0, %1, %2, %0 blgp:1" : "+v"(od) : "v"(v), "v"(pfr)); }
#define EXPQ(P, B) do { _Pragma("unroll") for (int r = (B); r < (B) + 8; ++r) P[r] = __builtin_amdgcn_exp2f(P[r]); } while (0)
#define PV_STEP(Vs, PN) do { const i32x8a v0_ = vfrag((Vs), 0, r32, hi), v1_ = vfrag((Vs), 1, r32, hi); pv8(o[0], v0_, pf); EXPQ(PN, 0); pv8(o[1], v1_, pf); EXPQ(PN, 8); SBAR(); } while (0)

__device__ __forceinline__ void attn_unit(const unsigned char* __restrict__ Qb, const unsigned char* __restrict__ Kh, const unsigned char* __restrict__ Vth, bf16_t* __restrict__ Ob, int seq, unsigned char* lds, WConv& wc, const Params& prm) {
    const int tid = threadIdx.x, wid = __builtin_amdgcn_readfirstlane(tid >> 6), lane = tid & 63, r32 = lane & 31, hi = lane >> 5;
    unsigned char* V_lds = lds; unsigned char* K_lds = lds + 2 * SHM_V;
    f32x16 o[2] = {}; i32x8a qr[2];
    { const unsigned char* Qw = Qb + (size_t)(wid * QBLK + r32) * LDQ + hi * 32;
#pragma unroll
      for (int s = 0; s < 2; ++s) { const i32x4a lo = *reinterpret_cast<const i32x4a*>(Qw + 64 * s), hh = *reinterpret_cast<const i32x4a*>(Qw + 64 * s + 16); qr[s] = __builtin_shufflevector(lo, hh, 0, 1, 2, 3, 4, 5, 6, 7); } }
    const int kr0 = 8 * wid + (lane >> 3), kcp = lane & 7;
    const unsigned char* ksrc0 = Kh + (size_t)kr0 * LDK + ((kcp ^ ((kr0 >> 1) & 7)) * 16);
    const unsigned char* vsrc = Vth + (wid & 3) * 1024 + lane * 16;
    typedef __attribute__((address_space(3))) unsigned* lds_u32p;
#define DMA_K(t, slot) __builtin_amdgcn_global_load_lds((const unsigned*)(ksrc0 + (size_t)(t) * KVBLK * LDK), (lds_u32p)(K_lds + (slot) * SHM_K + wid * 1024 + lane * 16), 16, 0, 0)
#define DMA_V(t, slot) do { if (wid < 4) __builtin_amdgcn_global_load_lds((const unsigned*)(vsrc + (size_t)(t) * 4096), (lds_u32p)(V_lds + (slot) * SHM_V + wid * 1024 + lane * 16), 16, 0, 0); } while (0)
    f32x16 pA0, pA1, pB0, pB1; i32x8a pf = {}; const int NT = seq / KVBLK;
    typedef float f32x4v __attribute__((ext_vector_type(4)));
    i32x8a ones; { const int c4 = ((lane & 1) == ((lane >> 4) & 1)) ? 0x22222222 : 0; ones = (i32x8a){c4, c4, c4, c4, 0, 0, 0, 0}; }
    f32x4v lsum = {0.f, 0.f, 0.f, 0.f};
    const f32x16 zacc = {};
#define QKM(ACC, KF, S, CIN) ACC = __builtin_amdgcn_mfma_scale_f32_32x32x64_f8f6f4(KF, qr[S], CIN, 0, 0, 0, 0, 0, 0)
#define ROWSUM() lsum = __builtin_amdgcn_mfma_scale_f32_16x16x128_f8f6f4(ones, pf, lsum, 4, 1, 0, 0, 0, 0)
#define CVT8(P, Q0) do { _Pragma("unroll") for (int q_ = 0; q_ < 4; ++q_) { pf[(Q0) + q_] = __builtin_amdgcn_cvt_pk_bf8_f32(P[4 * q_], P[4 * q_ + 1], pf[(Q0) + q_], false); pf[(Q0) + q_] = __builtin_amdgcn_cvt_pk_bf8_f32(P[4 * q_ + 2], P[4 * q_ + 3], pf[(Q0) + q_], true); } } while (0)
#define WAITW(ISS) do { if (ISS) asm volatile("s_waitcnt vmcnt(1)" ::: "memory"); else asm volatile("s_waitcnt vmcnt(0)" ::: "memory"); } while (0)
#define BARE_BAR() asm volatile("s_barrier" ::: "memory")
#define PIN(P) asm volatile("" : "+v"(P))
#define STEP(Ks, Vs, PC0, PC1, PX0, PX1) do { \
        const i32x8a k00_ = kfrag((Ks), 0, 0, r32, hi), k01_ = kfrag((Ks), 0, 1, r32, hi), k10_ = kfrag((Ks), 1, 0, r32, hi), k11_ = kfrag((Ks), 1, 1, r32, hi); SBAR(); \
        QKM(PX0, k00_, 0, zacc); PIN(PX0); EXPQ(PC1, 0); PIN(PC1); SBAR(); \
        QKM(PX0, k01_, 1, PX0); PIN(PX0); EXPQ(PC1, 8); PIN(PC1); SBAR(); \
        QKM(PX1, k10_, 0, zacc); PIN(PX1); CVT8(PC0, 0); PIN(pf); SBAR(); \
        QKM(PX1, k11_, 1, PX1); PIN(PX1); CVT8(PC1, 4); PIN(pf); const i32x8a v0_ = vfrag((Vs), 0, r32, hi), v1_ = vfrag((Vs), 1, r32, hi); SBAR(); \
        ROWSUM(); PIN(lsum); pv8(o[0], v0_, pf); EXPQ(PX0, 0); PIN(PX0); SBAR(); \
        pv8(o[1], v1_, pf); EXPQ(PX0, 8); PIN(PX0); SBAR(); } while (0)
    DMA_K(0, 0); DMA_V(0, 0); DMA_K(1, 1);
    asm volatile("s_waitcnt vmcnt(0)" ::: "memory"); __syncthreads();
    qkt(pA0, pA1, K_lds, qr, r32, hi); EXPH(pA0); SBAR();
    __syncthreads();
    for (int j = 0; j + 2 < NT; j += 2) {
        DMA_K(j + 2, 0); DMA_V(j + 1, 1); const bool wlA = wconv_step(wc, prm, lane); SBAR();
        STEP(K_lds + SHM_K, V_lds, pA0, pA1, pB0, pB1);
        WAITW(wlA); BARE_BAR();
        DMA_K(j + 3, 1); DMA_V(j + 2, 0); const bool wlB = wconv_step(wc, prm, lane); SBAR();
        STEP(K_lds, V_lds + SHM_V, pB0, pB1, pA0, pA1);
        WAITW(wlB); BARE_BAR();
    }
    DMA_V(NT - 1, 1); const bool wlT = wconv_step(wc, prm, lane); SBAR();
    STEP(K_lds + SHM_K, V_lds, pA0, pA1, pB0, pB1);
    WAITW(wlT); BARE_BAR();
    EXPH(pB1); SBAR(); CVT8(pB0, 0); CVT8(pB1, 4); SBAR();
    { const i32x8a v0_ = vfrag(V_lds + SHM_V, 0, r32, hi), v1_ = vfrag(V_lds + SHM_V, 1, r32, hi); ROWSUM(); pv8(o[0], v0_, pf); pv8(o[1], v1_, pf); }
    asm volatile("s_nop 15\n\ts_nop 7" ::: "memory"); SBAR();
    const float l_reg = (lane & 16) ? lsum[1] : lsum[0];
#undef STEP
#undef PIN
#undef WAITW
#undef BARE_BAR
#undef QKM
#undef ROWSUM
#undef CVT8
    const float rl = __builtin_amdgcn_rcpf(l_reg);
    bf16_t* Ow = Ob + (size_t)(wid * QBLK + r32) * 512 + 4 * hi;
#pragma unroll
    for (int d0 = 0; d0 < 2; ++d0)
#pragma unroll
        for (int g = 0; g < 4; ++g) { u32x2 w; w.x = pk2(o[d0][4 * g] * rl, o[d0][4 * g + 1] * rl); w.y = pk2(o[d0][4 * g + 2] * rl, o[d0][4 * g + 3] * rl); *(u32x2*)(Ow + d0 * 32 + 8 * g) = w; }
    __syncthreads();
#undef DMA_K
#undef DMA_V
}
#undef KSWZ
#undef SBAR
}

__device__ __forceinline__ void phase_attn(const Params& p, unsigned char* lds) {
    const unsigned char* Q = p.ws + WS_Q; const unsigned char* Kb = p.ws + WS_K; const unsigned char* VT = p.ws + WS_V; bf16_t* AO = (bf16_t*)(p.ws + WS_AO);
    constexpr int NQB = SEQ / 256, NU = 2 * NH * NQB;
    const int lane = threadIdx.x & 63, wave = __builtin_amdgcn_readfirstlane(threadIdx.x >> 6), gw = blockIdx.x * NWAVES + wave, NGW = gridDim.x * NWAVES;
    const int ipw = (WC_EXP_ITEMS + NGW - 1) / NGW, nun = ((int)blockIdx.x < NU) ? (NU - 1 - (int)blockIdx.x) / (int)gridDim.x + 1 : 0, steps = nun * (SEQ / att::KVBLK - 1);
    int cov = (steps - 2) / 8; cov = cov < 0 ? 0 : (cov > ipw ? ipw : cov);
    WConv wc; wc.raw = lds + att::SHM_ATTN + wave * WC_RAW_B; wc.x0 = gw * ipw; wc.cs = 0;
    { const int left = WC_EXP_ITEMS - wc.x0; wc.nitems = left < 0 ? 0 : (left < cov ? left : cov); }
    if (wave >= 4) __builtin_amdgcn_s_setprio(1);
    const bool xmap = false;
    for (int u0 = blockIdx.x, rnd = 0; u0 < NU; u0 += gridDim.x, ++rnd) {
        const int u = xmap ? (((int)blockIdx.x & 7) + 8 * rnd) * NQB + ((int)blockIdx.x >> 3) : u0;
        const int qb = u % NQB, h = (u / NQB) % NH, b = u / (NQB * NH); const size_t bh = (size_t)(b * NH + h) * SEQ;
        att::attn_unit(Q + (bh + (size_t)qb * 256) * 128, Kb + bh * 128, VT + bh * DV, AO + ((size_t)b * SEQ + (size_t)qb * 256) * 512 + h * DV, SEQ, lds, wc, p);
    }
    __builtin_amdgcn_s_setprio(0);
    while (wc.cs < 8 * wc.nitems + 2) { wconv_step(wc, p, lane); asm volatile("s_waitcnt vmcnt(0)" ::: "memory"); }
}
__device__ __forceinline__ void wconv_cleanup(const Params& p, unsigned char* lds) {
    constexpr int NQB = SEQ / 256, NU = 2 * NH * NQB;
    const int lane = threadIdx.x & 63, wave = threadIdx.x >> 6, gw = blockIdx.x * NWAVES + wave, NGW = gridDim.x * NWAVES;
    const int ipw = (WC_EXP_ITEMS + NGW - 1) / NGW, nun = ((int)blockIdx.x < NU) ? (NU - 1 - (int)blockIdx.x) / (int)gridDim.x + 1 : 0, steps = nun * (SEQ / att::KVBLK - 1);
    int cov = (steps - 2) / 8; cov = cov < 0 ? 0 : (cov > ipw ? ipw : cov);
    float* scr = (float*)(lds + wave * 16384);
    for (int i = cov; i < ipw; ++i) { const int x = gw * ipw + i; if (x >= WC_EXP_ITEMS) break; const WcItem it = wc_decode(p, x); const int r = x % 1536;
        if (it.mode == 1) transpose_item_fp8<1>(it.W, DM, 2048, it.WT, scr, r, lane); else transpose_item_fp8<0>(it.W, DFF, DM, it.WT, scr, r - 1024, lane); }
    __syncthreads();
}

__device__ __forceinline__ int crow16(int r, int hi) { return (r & 3) + 8 * (r >> 2) + 4 * hi; }
__device__ __forceinline__ void phase_router(const Params& p, unsigned char* lds) {
    const int tid = threadIdx.x, lane = tid & 63, wid = tid >> 6, tile = wid >> 2, kq = wid & 3, c = lane & 31, h = lane >> 5;
    float* red = (float*)lds;
    float* ssb = red + 2 * 4 * 16 * 64;
    int* lcnt = (int*)(ssb + 2 * 4 * 64);
    int* lbase = lcnt + 32;
    unsigned* gcnt = (unsigned*)(p.ws + WS_CTL) + CW_CNT;
    int* row_tok = (int*)(p.ws + WS_RT2); float* row_w = (float*)(p.ws + WS_RT2 + 2 * MiB); int* row_slot = (int*)(p.ws + WS_RT2 + 4 * MiB); float* row_rstd = (float*)(p.ws + WS_RT2 + 6 * MiB);
    const u32x4* GF = (const u32x4*)(p.ws + WS_GF);
    for (int tg = blockIdx.x; tg < NTOK / 64; tg += gridDim.x) {
        if (tid < 32) lcnt[tid] = 0;
        const int token = tg * 64 + tile * 32 + c;
        const float* xrow = p.out + (size_t)token * DM + kq * 256 + 8 * h; const float* g2p = p.norm2_g + kq * 256 + 8 * h;
        unsigned char* hrow = p.ws + WS_H8 + (size_t)token * DM + kq * 256 + 8 * h;
        f32x16 acc = {}; float ss = 0.f;
#pragma unroll 2
        for (int s = 0; s < 16; ++s) {
            const f32x4 a = *(const f32x4*)(xrow + 16 * s), b = *(const f32x4*)(xrow + 16 * s + 4); const f32x4 ga = *(const f32x4*)(g2p + 16 * s), gb = *(const f32x4*)(g2p + 16 * s + 4);
            ss += (a[0] * a[0] + a[1] * a[1]) + (a[2] * a[2] + a[3] * a[3]) + (b[0] * b[0] + b[1] * b[1]) + (b[2] * b[2] + b[3] * b[3]);
            u32x4 xh; xh.x = pk2(a[0], a[1]); xh.y = pk2(a[2], a[3]); xh.z = pk2(b[0], b[1]); xh.w = pk2(b[2], b[3]);
            u32x4 xl; xl.x = pk2(a[0] - bf_lo(xh.x), a[1] - bf_hi(xh.x)); xl.y = pk2(a[2] - bf_lo(xh.y), a[3] - bf_hi(xh.y)); xl.z = pk2(b[0] - bf_lo(xh.z), b[1] - bf_hi(xh.z)); xl.w = pk2(b[2] - bf_lo(xh.w), b[3] - bf_hi(xh.w));
            u32x2 h8; h8.x = pk4_fp8(a[0] * ga[0], a[1] * ga[1], a[2] * ga[2], a[3] * ga[3]); h8.y = pk4_fp8(b[0] * gb[0], b[1] * gb[1], b[2] * gb[2], b[3] * gb[3]); *(u32x2*)(hrow + 16 * s) = h8;
            const u32x4 gh = GF[((kq * 16 + s) * 2 + 0) * 64 + lane], gl = GF[((kq * 16 + s) * 2 + 1) * 64 + lane];
            acc = __builtin_amdgcn_mfma_f32_32x32x16_bf16(__builtin_bit_cast(bf16x8, gh), __builtin_bit_cast(bf16x8, xh), acc, 0, 0, 0);
            acc = __builtin_amdgcn_mfma_f32_32x32x16_bf16(__builtin_bit_cast(bf16x8, gh), __builtin_bit_cast(bf16x8, xl), acc, 0, 0, 0);
            acc = __builtin_amdgcn_mfma_f32_32x32x16_bf16(__builtin_bit_cast(bf16x8, gl), __builtin_bit_cast(bf16x8, xh), acc, 0, 0, 0);
        }
#pragma unroll
        for (int r = 0; r < 16; ++r) red[((tile * 4 + kq) * 16 + r) * 64 + lane] = acc[r];
        ssb[(tile * 4 + kq) * 64 + lane] = ss;
        __syncthreads();
        int te[4] = {0, 0, 0, 0}, rl[4] = {0, 0, 0, 0}; float tw[4] = {0.f, 0.f, 0.f, 0.f}; float rstd = 0.f;
        if (kq == 0) {
            float v[16]; float st = 0.f;
#pragma unroll
            for (int q = 0; q < 4; ++q) st += ssb[(tile * 4 + q) * 64 + lane];
            { auto rr = __builtin_amdgcn_permlane32_swap(__float_as_uint(st), __float_as_uint(st), false, false); st = __uint_as_float(rr[0]) + __uint_as_float(rr[1]); }
            rstd = rsqrtf(st * (1.f / DM) + EPS);
#pragma unroll
            for (int r = 0; r < 16; ++r) { float sacc = 0.f;
#pragma unroll
                for (int q = 0; q < 4; ++q) sacc += red[((tile * 4 + q) * 16 + r) * 64 + lane];
                v[r] = sacc * rstd + p.router_b[crow16(r, h)]; }
            float lv[4]; int le[4];
#pragma unroll
            for (int k = 0; k < 4; ++k) { float best = v[0]; int bi = 0;
#pragma unroll
                for (int r = 1; r < 16; ++r) { const bool gt = v[r] > best; best = gt ? v[r] : best; bi = gt ? r : bi; }
                lv[k] = best; le[k] = (bi & 3) + 8 * (bi >> 2) + 4 * h;
#pragma unroll
                for (int r = 0; r < 16; ++r) v[r] = (r == bi) ? -INFINITY : v[r]; }
            float cv[8]; int ce[8];
#pragma unroll
            for (int k = 0; k < 4; ++k) { auto rv = __builtin_amdgcn_permlane32_swap(__float_as_uint(lv[k]), __float_as_uint(lv[k]), false, false); auto re = __builtin_amdgcn_permlane32_swap((unsigned)le[k], (unsigned)le[k], false, false);
                cv[k] = __uint_as_float(rv[0]); cv[4 + k] = __uint_as_float(rv[1]); ce[k] = (int)re[0]; ce[4 + k] = (int)re[1]; }
            float tv[4];
#pragma unroll
            for (int k = 0; k < 4; ++k) { float best = cv[0]; int be = ce[0]; int bi = 0;
#pragma unroll
                for (int r = 1; r < 8; ++r) { const bool gt = (cv[r] > best) || (cv[r] == best && ce[r] < be); best = gt ? cv[r] : best; be = gt ? ce[r] : be; bi = gt ? r : bi; }
                tv[k] = best; te[k] = be;
#pragma unroll
                for (int r = 0; r < 8; ++r) cv[r] = (r == bi) ? -INFINITY : cv[r]; }
            const float e1 = __expf(tv[1] - tv[0]), e2 = __expf(tv[2] - tv[0]), e3 = __expf(tv[3] - tv[0]); const float inv = 1.f / (1.f + e1 + e2 + e3);
            tw[0] = inv; tw[1] = e1 * inv; tw[2] = e2 * inv; tw[3] = e3 * inv;
            if (h == 0) {
#pragma unroll
                for (int k = 0; k < 4; ++k) rl[k] = atomicAdd(&lcnt[te[k]], 1); }
        }
        __syncthreads();
        if (tid < 32) lbase[tid] = (int)atomicAdd(&gcnt[tid], (unsigned)lcnt[tid]);
        __syncthreads();
        if (kq == 0 && h == 0) {
#pragma unroll
            for (int k = 0; k < 4; ++k) { const int idx = te[k] * CAP + lbase[te[k]] + rl[k]; row_tok[idx] = token; row_w[idx] = tw[k]; row_slot[idx] = token * 4 + k; row_rstd[idx] = rstd; } }
        __syncthreads();
    }
}

__device__ __forceinline__ void build_block_table(const Params& p, int* bs) {
    const unsigned* gcnt = (const unsigned*)(p.ws + WS_CTL) + CW_CNT;
    if (threadIdx.x == 0) { int acc = 0; for (int e = 0; e < NE; ++e) { bs[e] = acc; acc += ((int)__hip_atomic_load(gcnt + e, __ATOMIC_RELAXED, __HIP_MEMORY_SCOPE_AGENT) + 255) >> 8; } bs[NE] = acc; }
    __syncthreads();
}

__device__ __forceinline__ pg8::MoeOrder make_moe_order(const Params& p, unsigned char* lds, int N, bool gather) {
    int* bs = (int*)(lds + 131072); int* utab = (int*)(lds + 131072 + 256); int* gtab = (int*)(lds + 131072 + 512);
    build_block_table(p, bs);
    const int nmb = __builtin_amdgcn_readfirstlane(bs[NE]);
    pg8::MoeOrder S; S.so.init(nmb * 256, N, (int)gridDim.x, (int)blockIdx.x); S.utab = (const PG8_LAS int*)utab; S.gtab = (const PG8_LAS int*)gtab;
    const int* row_tok = (const int*)(p.ws + WS_RT2);
    for (int i = 0; i < pg8::MOE_MAXU; ++i) { pg8::Unit u; if (!S.so.next(i, u)) break; int e = 0; for (int k = 1; k < NE; ++k) if (bs[k] <= u.pm) e = k;
        const int rb = e * CAP + (u.pm - bs[e]) * 256;
        if (threadIdx.x == 0) utab[i] = e | (rb << 8);
        if (gather && threadIdx.x < 256) gtab[i * 256 + threadIdx.x] = row_tok[rb + threadIdx.x]; }
    __syncthreads();
    return S;
}
__device__ __forceinline__ void phase_moe1(const Params& p, unsigned char* lds) {
    const pg8::MoeOrder S = make_moe_order(p, lds, 2048, true);
    pg8::Gemm g{(const bf16_t*)(p.ws + WS_H8), (const bf16_t*)(p.ws + WS_W1), 0, 2048, DM / 2, (size_t)2048 * DM, 0, 0};
    pg8::EpiSwiglu E{p.ws + WS_ACT, p.b1, (const float*)(p.ws + WS_RT2 + 6 * MiB)};
    pg8::gemm_phase<pg8::EpiSwiglu, pg8::MoeOrder, true, true, true, true>((PG8_LAS unsigned char*)lds, g, S, E);
}
__device__ __forceinline__ void phase_moe2(const Params& p, unsigned char* lds) {
    const pg8::MoeOrder S = make_moe_order(p, lds, DM, false);
    pg8::Gemm g{(const bf16_t*)(p.ws + WS_ACT), (const bf16_t*)(p.ws + WS_W2), 0, DM, DFF / 2, (size_t)DM * DFF, 0, 0};
    pg8::EpiMoeOut E{p.ws + WS_YS, p.b2, (const float*)(p.ws + WS_RT2 + 2 * MiB), (const int*)(p.ws + WS_RT2 + 4 * MiB)};
    pg8::gemm_phase<pg8::EpiMoeOut, pg8::MoeOrder, true, true, true>((PG8_LAS unsigned char*)lds, g, S, E);
}

__device__ __forceinline__ float fp8_to_f32(unsigned w, int byte) {
    return byte == 0 ? __builtin_amdgcn_cvt_f32_fp8((int)w, 0) : byte == 1 ? __builtin_amdgcn_cvt_f32_fp8((int)w, 1) : byte == 2 ? __builtin_amdgcn_cvt_f32_fp8((int)w, 2) : __builtin_amdgcn_cvt_f32_fp8((int)w, 3); }
__device__ __forceinline__ void phase_combine(const Params& p) {
    const int tid = threadIdx.x, lane = tid & 63, wave = tid >> 6;
    const int gw = blockIdx.x * NWAVES + wave, NGW = gridDim.x * NWAVES;
    const unsigned char* YS = p.ws + WS_YS;
    for (int t = gw; t < NTOK; t += NGW) {
        f32x4* orow = (f32x4*)(p.out + (size_t)t * DM) + lane;
        f32x4 v[4]; unsigned w[4][4];
#pragma unroll
        for (int j = 0; j < 4; ++j) { v[j] = orow[64 * j];
#pragma unroll
            for (int k = 0; k < 4; ++k) w[j][k] = *((const unsigned*)(YS + ((size_t)t * 4 + k) * DM) + lane + 64 * j); }
#pragma unroll
        for (int j = 0; j < 4; ++j) { f32x4 s = {0.f, 0.f, 0.f, 0.f};
#pragma unroll
            for (int k = 0; k < 4; ++k) { s[0] += fp8_to_f32(w[j][k], 0); s[1] += fp8_to_f32(w[j][k], 1); s[2] += fp8_to_f32(w[j][k], 2); s[3] += fp8_to_f32(w[j][k], 3); }
            orow[64 * j] = v[j] + s * YS_INV; }
    }
}

template <class Epi>
__device__ __forceinline__ void dense_gemm(unsigned char* lds, const bf16_t* A, const bf16_t* Bt, int M, int N, int K, const Epi& E, int lda = 0, int ldb = 0, int cshift = 0) {
    pg8::Gemm g{A, Bt, M, N, K, 0, lda, ldb}; pg8::StaticOrder S; S.init(M, N, (int)gridDim.x, (int)((blockIdx.x + cshift) % gridDim.x));
    pg8::gemm_phase<Epi, pg8::StaticOrder, true, true>((PG8_LAS unsigned char*)lds, g, S, E);
}

constexpr int NPHASE = 13;
__global__ void __launch_bounds__(NTHREADS, 2) mk_fwd(Params p) {
    extern __shared__ __attribute__((aligned(16))) unsigned char lds[];
    cg::grid_group grid = cg::this_grid();
    unsigned char* ws = p.ws;
    volatile LAS unsigned* MISC = (volatile LAS unsigned*)((LAS unsigned char*)lds + MISC_OFF);
    if (threadIdx.x < 32) MISC[threadIdx.x] = 0u;
    __syncthreads();
    XcdBarrier bar = xcd_barrier_post((unsigned*)(ws + WS_CTL) + CW_BAR, MISC + 8);
    const int lo = p.ph_lo, hi = p.ph_hi;
    if (lo < 0) grid.sync();
#define IN(k) (lo <= (k) && (k) < hi)
#define SEAM(k) do { if (IN(k) && IN((k) + 1)) xcd_barrier(bar); } while (0)
    if (IN(0)) phase_prologue(p, lds);
    SEAM(0);
    if (IN(1)) { pg8::EpiProj E{(bf16_t*)(ws + WS_PROJ), (float*)(ws + WS_SSQ)}; dense_gemm(lds, (const bf16_t*)(ws + WS_XN), (const bf16_t*)(ws + WS_WIN), NTOK, INCP, DM, E); }
    if (IN(1) && IN(3)) xcd_barrier(bar);
    if (IN(3)) { const float* ssq = (const float*)(ws + WS_SSQ); const float* cst = (const float*)(ws + WS_CS); float* hs = (float*)(lds + 131072);
                 pg8::EpiQ Eq{ws + WS_Q, ssq, p.q_g, cst, hs}; dense_gemm(lds, (const bf16_t*)(ws + WS_PROJ) + OFF_CQ, (const bf16_t*)(ws + WS_WUQ), NTOK, 1024, QLORA, Eq, INCP);
                 pg8::EpiK Ek{ws + WS_K, ssq, p.k_g, cst, (const bf16_t*)(ws + WS_PROJ), hs, (const float*)(ws + WS_SHIFT)}; dense_gemm(lds, (const bf16_t*)(ws + WS_PROJ) + OFF_CKV, (const bf16_t*)(ws + WS_WUKV), NTOK, 512, KVLORA, Ek, INCP);
                 pg8::EpiVT Ev{ws + WS_V, ssq}; dense_gemm(lds, (const bf16_t*)(ws + WS_WUKV) + 512 * KVLORA, (const bf16_t*)(ws + WS_PROJ) + OFF_CKV, 512, NTOK, KVLORA, Ev, 0, INCP, (int)gridDim.x / 2);
                 phase_conv(p); }
    if (IN(3) && IN(5)) xcd_barrier(bar);
    if (IN(5)) phase_attn(p, lds);
    SEAM(5);
    if (IN(6)) { pg8::EpiGateA E{(bf16_t*)(ws + WS_M1), (const bf16_t*)(ws + WS_PROJ)}; dense_gemm(lds, (const bf16_t*)(ws + WS_AO), (const bf16_t*)(ws + WS_WOMLA), NTOK, DM, 512, E); }
    if (IN(7)) { pg8::EpiGateB E{(const bf16_t*)(ws + WS_M1), (const bf16_t*)(ws + WS_PROJ), (bf16_t*)(ws + WS_MERGED)}; dense_gemm(lds, (const bf16_t*)(ws + WS_YBIN), (const bf16_t*)(ws + WS_WOCONV), NTOK, DM, 512, E); }
    SEAM(7);
    if (IN(8)) { pg8::EpiResid E{p.x, p.out}; dense_gemm(lds, (const bf16_t*)(ws + WS_MERGED), (const bf16_t*)(ws + WS_WO), NTOK, DM, DM, E); }
    SEAM(8);
    if (IN(9)) { wconv_cleanup(p, lds); phase_router(p, lds); }
    if (IN(9) && IN(11)) xcd_barrier(bar);
    if (IN(11)) phase_moe1(p, lds);
    SEAM(11);
    if (IN(12)) phase_moe2(p, lds);
    SEAM(12);
    if (IN(13)) phase_combine(p);
#undef IN
#undef SEAM
}

extern "C" void kernel_launch(void* const* d_in, const int* in_sizes, int n_in, void* d_out, int out_size,
                              void* d_ws, size_t ws_size, hipStream_t stream) {
    static int grid_blocks = 0;
    if (!grid_blocks) {
        int dev = 0, cus = 0, per_cu = 0;
        (void)hipGetDevice(&dev);
        (void)hipDeviceGetAttribute(&cus, hipDeviceAttributeMultiprocessorCount, dev);
        (void)hipFuncSetAttribute((const void*)mk_fwd, hipFuncAttributeMaxDynamicSharedMemorySize, LDS_BYTES);
        (void)hipOccupancyMaxActiveBlocksPerMultiprocessor(&per_cu, (const void*)mk_fwd, NTHREADS, LDS_BYTES);
        if (per_cu < 1) { fprintf(stderr, "kernel_launch: occupancy query says %d blocks/CU\n", per_cu); per_cu = 1; }
        grid_blocks = cus;
        if (ws_size < WS_END2 || n_in != 21) fprintf(stderr, "kernel_launch: ws %zu < %zu or n_in %d != 21\n", ws_size, (size_t)WS_END2, n_in);
    }
    (void)hipMemsetAsync((char*)d_ws + WS_CTL, 0, 1 * MiB, stream);
    Params p{};
    p.x = (const float*)d_in[0]; p.pos = (const int*)d_in[1]; p.norm1_g = (const float*)d_in[2]; p.w_in = (const float*)d_in[3]; p.q_a_g = (const float*)d_in[4];
    p.kv_a_g = (const float*)d_in[5]; p.w_uq = (const float*)d_in[6]; p.w_ukv = (const float*)d_in[7]; p.q_g = (const float*)d_in[8]; p.k_g = (const float*)d_in[9];
    p.conv_w = (const float*)d_in[10]; p.w_o_mla = (const float*)d_in[11]; p.w_o_conv = (const float*)d_in[12]; p.w_o = (const float*)d_in[13]; p.norm2_g = (const float*)d_in[14];
    p.router_w = (const float*)d_in[15]; p.router_b = (const float*)d_in[16]; p.w1 = (const float*)d_in[17]; p.b1 = (const float*)d_in[18]; p.w2 = (const float*)d_in[19]; p.b2 = (const float*)d_in[20];
    p.out = (float*)d_out; p.ws = (unsigned char*)d_ws; p.ph_lo = 0; p.ph_hi = NPHASE + 1;
    void* args[] = {&p};
    hipError_t e = hipLaunchCooperativeKernel((const void*)mk_fwd, dim3(grid_blocks), dim3(NTHREADS), args, LDS_BYTES, stream);
    if (e != hipSuccess) fprintf(stderr, "cooperative launch failed: %s (grid %d)\n", hipGetErrorString(e), grid_blocks);
}
```

```cpp
#include <hip/hip_runtime.h>
#include <hip/hip_cooperative_groups.h>
#include <cstdio>
#include <cstdint>
namespace cg = cooperative_groups;

typedef unsigned short bf16_t;
typedef short bf16x8 __attribute__((ext_vector_type(8)));
typedef short s16x4 __attribute__((ext_vector_type(4)));
typedef float f32x4 __attribute__((ext_vector_type(4)));
typedef float f32x2 __attribute__((ext_vector_type(2)));
typedef float f32x16 __attribute__((ext_vector_type(16)));
typedef unsigned u32x4 __attribute__((ext_vector_type(4)));
typedef unsigned u32x2 __attribute__((ext_vector_type(2)));
typedef __bf16 bf16x2_t __attribute__((ext_vector_type(2)));

constexpr int NTOK = 16384, DM = 1024, SEQ = 8192;
constexpr int INC = 4000, INCP = 4096;
constexpr int OFF_CQ = 0, OFF_CKV = 256, OFF_KR = 384, OFF_U = 416, OFF_C = 928, OFF_B = 1440, OFF_GA = 1952, OFF_GB = 2976;
constexpr int NH = 8, DQK = 96, DV = 64, NE = 32, TOPK = 4, DFF = 1024;
constexpr int QLORA = 256, KVLORA = 128, CONVW = 512;
constexpr int NPAIR = NTOK * TOPK;
constexpr int MAXROWS = 73728;
constexpr float EPS = 1e-6f;
constexpr float QSCALE = 0.10206207261596575f * 1.4426950408889634f;
constexpr int CAP = 16384;
constexpr int NTHREADS = 512, NWAVES = 8;
constexpr int LDS_BYTES = 147456;

constexpr size_t MiB = 1ull << 20;
constexpr size_t WS_CTL = 0;
constexpr size_t WS_WIN = 1 * MiB;
constexpr size_t WS_WUQ = 9 * MiB;
constexpr size_t WS_WUKV = WS_WUQ + 512 * 1024;
constexpr size_t WS_WOMLA = 10 * MiB;
constexpr size_t WS_WOCONV = 11 * MiB;
constexpr size_t WS_WO = 12 * MiB;
constexpr size_t WS_ROUTE = 14 * MiB;
constexpr size_t WS_W1 = 18 * MiB;
constexpr size_t WS_W2 = 146 * MiB;
constexpr size_t WS_XN = 210 * MiB;
constexpr size_t WS_PROJ = 242 * MiB;
constexpr size_t WS_CQN = 370 * MiB;
constexpr size_t WS_CKVN = 378 * MiB;
constexpr size_t WS_YBIN = 386 * MiB;
constexpr size_t WS_QPRE = 402 * MiB;
constexpr size_t WS_KVPRE = 450 * MiB;
constexpr size_t WS_Q = 514 * MiB;
constexpr size_t WS_K = 538 * MiB;
constexpr size_t WS_V = 570 * MiB;
constexpr size_t WS_AO = 586 * MiB;
constexpr size_t WS_M1 = 602 * MiB;
constexpr size_t WS_MERGED = 666 * MiB;
constexpr size_t WS_YS = 698 * MiB;
constexpr size_t WS_END = 826 * MiB;
constexpr size_t WS_ACT = WS_PROJ;
constexpr size_t WS_X1B = WS_M1;
constexpr size_t WS_H8 = WS_XN;
constexpr size_t WS_GF = 830 * MiB;
constexpr size_t WS_RT2 = 832 * MiB;
constexpr size_t WS_SSQ = 840 * MiB;
constexpr size_t WS_CS = 841 * MiB;
constexpr size_t WS_SHIFT = 843 * MiB;
constexpr size_t WS_END2 = 844 * MiB;
constexpr size_t RT_PAIR_E = 0, RT_PAIR_RANK = 262144, RT_PAIR_W = 524288, RT_ROW_TOK = 786432, RT_ROW_W = 786432 + 294912, RT_ROW_SLOT = 786432 + 2 * 294912;
constexpr int CW_CNT = 64;
constexpr int CW_BAR = 4096;
constexpr int MISC_OFF = LDS_BYTES - 256;

struct Params {
    const float* x; const int* pos; const float* norm1_g; const float* w_in; const float* q_a_g; const float* kv_a_g;
    const float* w_uq; const float* w_ukv; const float* q_g; const float* k_g; const float* conv_w; const float* w_o_mla;
    const float* w_o_conv; const float* w_o; const float* norm2_g; const float* router_w; const float* router_b;
    const float* w1; const float* b1; const float* w2; const float* b2;
    float* out; unsigned char* ws; int ph_lo, ph_hi;
};

__device__ __forceinline__ unsigned pk2(float lo, float hi) { f32x2 v = {lo, hi}; bf16x2_t b = __builtin_convertvector(v, bf16x2_t); return __builtin_bit_cast(unsigned, b); }
__device__ __forceinline__ float bf_lo(unsigned w) { return __uint_as_float(w << 16); }
__device__ __forceinline__ float bf_hi(unsigned w) { return __uint_as_float(w & 0xffff0000u); }
__device__ __forceinline__ float bf1(bf16_t h) { return __uint_as_float((unsigned)h << 16); }
__device__ __forceinline__ float wave_sum(float v) {
#pragma unroll
    for (int o = 1; o < 64; o <<= 1) v += __shfl_xor(v, o);
    return v;
}
__device__ __forceinline__ unsigned pk4_fp8(float a, float b, float c, float d) { unsigned w = 0u; w = (unsigned)__builtin_amdgcn_cvt_pk_fp8_f32(a, b, (int)w, false); w = (unsigned)__builtin_amdgcn_cvt_pk_fp8_f32(c, d, (int)w, true); return w; }
constexpr float Q8_SCALE = 4.f, K8_SCALE = 0.25f;
constexpr float W8_SCALE = 32.f, W8_INV = 1.f / 32.f, YS_SCALE = 8.f, YS_INV = 0.125f;
__device__ __forceinline__ float sigmoidf_(float v) { return __builtin_amdgcn_rcpf(1.f + __builtin_amdgcn_exp2f(v * -1.4426950408889634f)); }

namespace pg8 {
#define PG8_LAS __attribute__((address_space(3)))
constexpr int BM = 256, BK = 64, HALF = 128, HTB = HALF * BK * 2  , STAGE_BYTES = 8 * HTB, NXCD = 8, WGM = 8;

__host__ __device__ __forceinline__ int lds_byte(int r, int c) { const int st = (r >> 4) * 2 + (c >> 5), rr = r & 15, cc = c & 31, ob = rr * 64 + cc * 2; return st * 1024 + (ob ^ (((ob >> 9) & 1) << 5)); }
__host__ __device__ __forceinline__ void stage_rc(int b, int& R, int& C) { const int st = b / 1024, sb = b % 1024, swz = sb ^ (((sb >> 9) & 1) << 5); R = (st >> 1) * 16 + swz / 64; C = (st & 1) * 32 + (swz % 64) / 2; }
__host__ __device__ __forceinline__ int perm32(int rho) { const int n = rho >> 4, i = rho & 15; return 8 * (i >> 2) + 4 * n + (i & 3); }

struct Unit { int pm, pn, e, rb; };
struct Gemm { const bf16_t* A; const bf16_t* Bt; int M, N, K; size_t bstride; int lda, ldb; };

struct StaticOrder {
    int nM, nN, nwg, G, c;
    __host__ __device__ void init(int M, int N, int G_, int c_) { nM = M / BM; nN = N / BM; nwg = nM * nN; G = G_; c = c_; }
    __host__ __device__ bool next(int i, Unit& u) const {
        const long L = (long)i * G + c; if (L >= nwg) return false;
        int wgid = (int)L; { const int q = nwg / NXCD, r = nwg % NXCD, xcd = wgid % NXCD, off = wgid / NXCD; wgid = (xcd < r ? xcd * (q + 1) : r * (q + 1) + (xcd - r) * q) + off; }
        const int nig = WGM * nN, gid = wgid / nig, fm = gid * WGM, gsz = (nM - fm) < WGM ? (nM - fm) : WGM;
        u.pm = fm + ((wgid % nig) % gsz); u.pn = (wgid % nig) / gsz; u.e = 0; u.rb = 0; return true;
    }
    __device__ __forceinline__ void a_ready(const Unit&) const {}
    __device__ __forceinline__ void done(const Unit&) const {}
};


struct EpiProj {
    static constexpr bool PERM = true, AFTER_DRAIN = false;
    bf16_t* O; float* ssq;
    __device__ __forceinline__ void operator()(const f32x4 (&acc)[2][2][4][2], const Unit& u, int wr, int wc, int fr, int fq) const {
        const int row0 = u.pm * BM + wr * 64 + fr, col0 = u.pn * BM + wc * 32 + 8 * fq;
#pragma unroll
        for (int ai = 0; ai < 2; ++ai)
#pragma unroll
            for (int m = 0; m < 4; ++m) { const int row = row0 + ai * HALF + m * 16; bf16_t* rowp = O + (size_t)row * INCP + col0;
#pragma unroll
                for (int bj = 0; bj < 2; ++bj) { f32x4 v0 = acc[ai][bj][m][0], v1 = acc[ai][bj][m][1]; const int col = col0 + bj * HALF;
                    if (col >= OFF_GA && col < INC) {
#pragma unroll
                        for (int j = 0; j < 4; ++j) { v0[j] = sigmoidf_(v0[j]); v1[j] = sigmoidf_(v1[j]); } }
                    u32x4 w; w.x = pk2(v0[0], v0[1]); w.y = pk2(v0[2], v0[3]); w.z = pk2(v1[0], v1[1]); w.w = pk2(v1[2], v1[3]);
                    *(u32x4*)(rowp + bj * HALF) = w;
                    const int which = u.pn == 0 ? 0 : (u.pn == 1 ? (bj == 0 ? 1 : (wc == 0 ? 2 : -1)) : -1);
                    if (which >= 0) { float s = (v0[0] * v0[0] + v0[1] * v0[1]) + (v0[2] * v0[2] + v0[3] * v0[3]) + (v1[0] * v1[0] + v1[1] * v1[1]) + (v1[2] * v1[2] + v1[3] * v1[3]);
                        s += __shfl_xor(s, 16); s += __shfl_xor(s, 32); if (fq == 0) ssq[(size_t)row * 16 + (which == 0 ? wc * 2 + bj : (which == 1 ? 8 + wc : 12))] = s; } } }
    }
};
struct EpiBf16 {
    static constexpr bool PERM = true, AFTER_DRAIN = false;
    bf16_t* O; int ldc;
    __device__ __forceinline__ void operator()(const f32x4 (&acc)[2][2][4][2], const Unit& u, int wr, int wc, int fr, int fq) const {
        const int row0 = u.pm * BM + wr * 64 + fr, col0 = u.pn * BM + wc * 32 + 8 * fq;
#pragma unroll
        for (int ai = 0; ai < 2; ++ai)
#pragma unroll
            for (int m = 0; m < 4; ++m) { bf16_t* rowp = O + (size_t)(row0 + ai * HALF + m * 16) * ldc + col0;
#pragma unroll
                for (int bj = 0; bj < 2; ++bj) { const f32x4 v0 = acc[ai][bj][m][0], v1 = acc[ai][bj][m][1];
                    u32x4 w; w.x = pk2(v0[0], v0[1]); w.y = pk2(v0[2], v0[3]); w.z = pk2(v1[0], v1[1]); w.w = pk2(v1[2], v1[3]); *(u32x4*)(rowp + bj * HALF) = w; } }
    }
};
__device__ __forceinline__ void epi_bar() { asm volatile("s_waitcnt lgkmcnt(0)" ::: "memory"); __builtin_amdgcn_s_barrier(); asm volatile("" ::: "memory"); }
__device__ __forceinline__ u32x2 pk4bf(const f32x4 v) { u32x2 w; w.x = pk2(v[0], v[1]); w.y = pk2(v[2], v[3]); return w; }
struct EpiQ {
    static constexpr bool PERM = false, AFTER_DRAIN = false;
    unsigned char* Q; const float* ssq_cq; const float* qg; const float* cs; float* hs;
    __device__ __forceinline__ void operator()(f32x4 (&acc)[2][2][4][2], const Unit& u, int wr, int wc, int fr, int fq) const {
        int lr0 = wr * 64 + fr; asm volatile("" : "+v"(lr0), "+v"(fq));
        const int t0 = u.pm * BM + lr0;
#pragma unroll
        for (int ai = 0; ai < 2; ++ai)
#pragma unroll
            for (int m = 0; m < 4; ++m) { const f32x4 sa = *(const f32x4*)(ssq_cq + (size_t)(t0 + ai * HALF + m * 16) * 16), sb = *(const f32x4*)(ssq_cq + (size_t)(t0 + ai * HALF + m * 16) * 16 + 4);
                const float rq = rsqrtf((((sa[0] + sa[1]) + (sa[2] + sa[3])) + ((sb[0] + sb[1]) + (sb[2] + sb[3]))) * (1.f / QLORA) + EPS);
#pragma unroll
                for (int bj = 0; bj < 2; ++bj) { const f32x4 x0 = acc[ai][bj][m][0] * rq, x1 = acc[ai][bj][m][1] * rq; acc[ai][bj][m][0] = x0; acc[ai][bj][m][1] = x1;
                    float s = (x0[0] * x0[0] + x0[1] * x0[1]) + (x0[2] * x0[2] + x0[3] * x0[3]) + (x1[0] * x1[0] + x1[1] * x1[1]) + (x1[2] * x1[2] + x1[3] * x1[3]);
                    s += __shfl_xor(s, 16); s += __shfl_xor(s, 32); if (fq == 0) hs[((lr0 + ai * HALF + m * 16) * 2 + bj) * 4 + wc] = s; } }
        epi_bar();
        {
            f32x4 g0 = {0.f, 0.f, 0.f, 0.f}, g1 = g0; if (wc < 3) { g0 = *(const f32x4*)(qg + 32 * wc + 4 * fq); g1 = *(const f32x4*)(qg + 32 * wc + 16 + 4 * fq); }
#pragma unroll
            for (int ai = 0; ai < 2; ++ai)
#pragma unroll
                for (int m = 0; m < 4; ++m) { const int lr = lr0 + ai * HALF + m * 16, t = u.pm * BM + lr, b = t >> 13, s = t & (SEQ - 1);
                    f32x4 c4 = {0.f, 0.f, 0.f, 0.f}, s4 = {0.f, 0.f, 0.f, 0.f}; if (wc == 2) { c4 = *(const f32x4*)(cs + (size_t)t * 32 + 4 * fq); s4 = *(const f32x4*)(cs + (size_t)t * 32 + 16 + 4 * fq); }
#pragma unroll
                    for (int bj = 0; bj < 2; ++bj) { const f32x4 h4 = *(const f32x4*)(hs + (lr * 2 + bj) * 4); const float rstd = rsqrtf(((h4[0] + h4[1]) + h4[2]) * (1.f / DQK) + EPS) * (QSCALE * Q8_SCALE); f32x4 x0 = acc[ai][bj][m][0] * rstd * g0, x1 = acc[ai][bj][m][1] * rstd * g1;
                        if (wc == 2) { const f32x4 o0 = x0 * c4 - x1 * s4, o1 = x0 * s4 + x1 * c4; x0 = o0; x1 = o1; }
                        if (wc == 3 && fq == 0) x0[0] = Q8_SCALE;
                        unsigned char* qp = Q + ((size_t)(b * NH + 2 * u.pn + bj) * SEQ + s) * 128 + 32 * wc + 4 * fq; *(unsigned*)qp = pk4_fp8(x0[0], x0[1], x0[2], x0[3]); *(unsigned*)(qp + 16) = pk4_fp8(x1[0], x1[1], x1[2], x1[3]); }
                    asm volatile("" ::: "memory"); }
        }
    }
};
struct EpiK {
    static constexpr bool PERM = false, AFTER_DRAIN = false;
    unsigned char* K; const float* ssq; const float* kg; const float* cs; const bf16_t* proj; float* hs; const float* shiftp;
    __device__ __forceinline__ void operator()(f32x4 (&acc)[2][2][4][2], const Unit& u, int wr, int wc, int fr, int fq) const {
        int lr0 = wr * 64 + fr; asm volatile("" : "+v"(lr0), "+v"(fq));
        const int t0 = u.pm * BM + lr0, wp = wc & 1, wh = wc >> 1;
#pragma unroll
        for (int ai = 0; ai < 2; ++ai)
#pragma unroll
            for (int m = 0; m < 4; ++m) { const f32x4 sa = *(const f32x4*)(ssq + (size_t)(t0 + ai * HALF + m * 16) * 16 + 8); const float rk = rsqrtf(((sa[0] + sa[1]) + (sa[2] + sa[3])) * (1.f / KVLORA) + EPS);
#pragma unroll
                for (int bj = 0; bj < 2; ++bj) { const f32x4 x0 = acc[ai][bj][m][0] * rk, x1 = acc[ai][bj][m][1] * rk; acc[ai][bj][m][0] = x0; acc[ai][bj][m][1] = x1;
                    float s = (x0[0] * x0[0] + x0[1] * x0[1]) + (x0[2] * x0[2] + x0[3] * x0[3]) + (x1[0] * x1[0] + x1[1] * x1[1]) + (x1[2] * x1[2] + x1[3] * x1[3]);
                    s += __shfl_xor(s, 16); s += __shfl_xor(s, 32); if (fq == 0) hs[((lr0 + ai * HALF + m * 16) * 4 + 2 * bj + wh) * 2 + wp] = s; } }
        epi_bar();
        const f32x4 g0 = *(const f32x4*)(kg + 32 * wp + 4 * fq), g1 = *(const f32x4*)(kg + 32 * wp + 16 + 4 * fq);
        f32x4 gr0 = {0.f, 0.f, 0.f, 0.f}, gr1 = gr0; if (wp == 1) { gr0 = *(const f32x4*)(kg + 64 + 4 * fq); gr1 = *(const f32x4*)(kg + 80 + 4 * fq); }
        const unsigned kpad = (fq == 0) ? pk4_fp8(-shiftp[0] * K8_SCALE, 0.f, 0.f, 0.f) : 0u;
#pragma unroll
        for (int ai = 0; ai < 2; ++ai)
#pragma unroll
            for (int m = 0; m < 4; ++m) { const int lr = lr0 + ai * HALF + m * 16, t = u.pm * BM + lr, b = t >> 13, s = t & (SEQ - 1); const float skr = ssq[(size_t)t * 16 + 12];
                f32x4 c4 = {0.f, 0.f, 0.f, 0.f}, s4 = c4, r1 = c4, r2 = c4;
                if (wp == 1) { c4 = *(const f32x4*)(cs + (size_t)t * 32 + 4 * fq); s4 = *(const f32x4*)(cs + (size_t)t * 32 + 16 + 4 * fq);
                    const u32x2 a = *(const u32x2*)(proj + (size_t)t * INCP + OFF_KR + 4 * fq), bb = *(const u32x2*)(proj + (size_t)t * INCP + OFF_KR + 16 + 4 * fq);
                    r1 = (f32x4){bf_lo(a.x), bf_hi(a.x), bf_lo(a.y), bf_hi(a.y)} * gr0; r2 = (f32x4){bf_lo(bb.x), bf_hi(bb.x), bf_lo(bb.y), bf_hi(bb.y)} * gr1; }
#pragma unroll
                for (int bj = 0; bj < 2; ++bj) { const size_t rowi = (size_t)(b * NH + 4 * u.pn + 2 * bj + wh) * SEQ + s; const f32x2 h2 = *(const f32x2*)(hs + (lr * 4 + 2 * bj + wh) * 2);
                    const float rstd = rsqrtf(((h2[0] + h2[1]) + skr) * (1.f / DQK) + EPS) * K8_SCALE;
                    unsigned char* kp = K + rowi * 128; const f32x4 y0 = acc[ai][bj][m][0] * rstd * g0, y1 = acc[ai][bj][m][1] * rstd * g1;
                    *(unsigned*)(kp + 32 * wp + 4 * fq) = pk4_fp8(y0[0], y0[1], y0[2], y0[3]); *(unsigned*)(kp + 32 * wp + 16 + 4 * fq) = pk4_fp8(y1[0], y1[1], y1[2], y1[3]);
                    if (wp == 1) { const f32x4 x1 = r1 * rstd, x2 = r2 * rstd, z1 = x1 * c4 - x2 * s4, z2 = x1 * s4 + x2 * c4; *(unsigned*)(kp + 64 + 4 * fq) = pk4_fp8(z1[0], z1[1], z1[2], z1[3]); *(unsigned*)(kp + 80 + 4 * fq) = pk4_fp8(z2[0], z2[1], z2[2], z2[3]); }
                    else { *(u32x2*)(kp + 96 + 8 * fq) = (u32x2){kpad, 0u}; } }
                asm volatile("" ::: "memory"); }
    }
};
struct EpiVT {
    static constexpr bool PERM = true, AFTER_DRAIN = false;
    unsigned char* VT; const float* ssq;
    __device__ __forceinline__ void operator()(f32x4 (&acc)[2][2][4][2], const Unit& u, int wr, int wc, int fr, int fq) const {
        int tok0 = u.pn * BM + wc * 32 + 8 * fq; asm volatile("" : "+v"(tok0), "+v"(fr));
        float rs[2][8];
#pragma unroll
        for (int bj = 0; bj < 2; ++bj)
#pragma unroll
            for (int i = 0; i < 8; ++i) { const f32x4 sa = *(const f32x4*)(ssq + (size_t)(tok0 + bj * HALF + i) * 16 + 8); rs[bj][i] = rsqrtf(((sa[0] + sa[1]) + (sa[2] + sa[3])) * (1.f / KVLORA) + EPS); }
#pragma unroll
        for (int ai = 0; ai < 2; ++ai)
#pragma unroll
            for (int m = 0; m < 4; ++m) { const int row = u.pm * BM + ai * HALF + wr * 64 + m * 16 + fr, h = row >> 6, d = row & 63;
#pragma unroll
                for (int bj = 0; bj < 2; ++bj) { const int tok = tok0 + bj * HALF, b = tok >> 13, s = tok & (SEQ - 1); const f32x4 v0 = acc[ai][bj][m][0], v1 = acc[ai][bj][m][1];
                    const int k0 = s & 63, j0 = 4 * ((k0 >> 3) & 3) + 16 * (k0 >> 5), r32v = d & 31, off = (j0 & 15) + 16 * ((j0 >> 4) ^ ((r32v >> 3) & 1));
                    unsigned char* tp = VT + ((size_t)(b * NH + h) * (SEQ / 64) + (s >> 6)) * 4096 + (((d >> 5) * 32 + r32v) << 5) + off;
                    *(unsigned*)tp = pk4_fp8(v0[0] * rs[bj][0], v0[1] * rs[bj][1], v0[2] * rs[bj][2], v0[3] * rs[bj][3]);
                    *(unsigned*)(tp + 2048) = pk4_fp8(v1[0] * rs[bj][4], v1[1] * rs[bj][5], v1[2] * rs[bj][6], v1[3] * rs[bj][7]); } }
    }
};
struct EpiF32 {
    static constexpr bool PERM = false, AFTER_DRAIN = false;
    float* O; int ldc;
    __device__ __forceinline__ void operator()(const f32x4 (&acc)[2][2][4][2], const Unit& u, int wr, int wc, int fr, int fq) const {
        const int row0 = u.pm * BM + wr * 64 + fr, col0 = u.pn * BM + wc * 32 + 4 * fq;
#pragma unroll
        for (int ai = 0; ai < 2; ++ai)
#pragma unroll
            for (int m = 0; m < 4; ++m) { float* rowp = O + (size_t)(row0 + ai * HALF + m * 16) * ldc + col0;
#pragma unroll
                for (int bj = 0; bj < 2; ++bj)
#pragma unroll
                    for (int n = 0; n < 2; ++n) *(f32x4*)(rowp + bj * HALF + n * 16) = acc[ai][bj][m][n]; }
    }
};
__device__ __forceinline__ void unpack8(const u32x4 g, float (&f)[8]) { f[0] = bf_lo(g.x); f[1] = bf_hi(g.x); f[2] = bf_lo(g.y); f[3] = bf_hi(g.y); f[4] = bf_lo(g.z); f[5] = bf_hi(g.z); f[6] = bf_lo(g.w); f[7] = bf_hi(g.w); }
struct EpiGateA {
    static constexpr bool PERM = true, AFTER_DRAIN = false;
    bf16_t* M1; const bf16_t* proj;
    __device__ __forceinline__ void operator()(const f32x4 (&acc)[2][2][4][2], const Unit& u, int wr, int wc, int fr, int fq) const {
        const int row0 = u.pm * BM + wr * 64 + fr, col0 = u.pn * BM + wc * 32 + 8 * fq;
#pragma unroll
        for (int ai = 0; ai < 2; ++ai)
#pragma unroll
            for (int m = 0; m < 4; ++m) { const size_t row = (size_t)(row0 + ai * HALF + m * 16);
#pragma unroll
                for (int bj = 0; bj < 2; ++bj) { const int col = col0 + bj * HALF; float g[8]; unpack8(*(const u32x4*)(proj + row * INCP + OFF_GA + col), g);
                    const f32x4 v0 = acc[ai][bj][m][0], v1 = acc[ai][bj][m][1];
                    u32x4 w; w.x = pk2(v0[0] * g[0], v0[1] * g[1]); w.y = pk2(v0[2] * g[2], v0[3] * g[3]); w.z = pk2(v1[0] * g[4], v1[1] * g[5]); w.w = pk2(v1[2] * g[6], v1[3] * g[7]);
                    *(u32x4*)(M1 + row * DM + col) = w; } }
    }
};
struct EpiGateB {
    static constexpr bool PERM = true, AFTER_DRAIN = false;
    const bf16_t* M1; const bf16_t* proj; bf16_t* O;
    __device__ __forceinline__ void operator()(const f32x4 (&acc)[2][2][4][2], const Unit& u, int wr, int wc, int fr, int fq) const {
        const int row0 = u.pm * BM + wr * 64 + fr, col0 = u.pn * BM + wc * 32 + 8 * fq;
#pragma unroll
        for (int ai = 0; ai < 2; ++ai)
#pragma unroll
            for (int m = 0; m < 4; ++m) { const size_t row = (size_t)(row0 + ai * HALF + m * 16);
#pragma unroll
                for (int bj = 0; bj < 2; ++bj) { const int col = col0 + bj * HALF; float g[8], b[8]; unpack8(*(const u32x4*)(proj + row * INCP + OFF_GB + col), g); unpack8(*(const u32x4*)(M1 + row * DM + col), b);
                    const f32x4 v0 = acc[ai][bj][m][0], v1 = acc[ai][bj][m][1];
                    u32x4 w; w.x = pk2(b[0] + v0[0] * g[0], b[1] + v0[1] * g[1]); w.y = pk2(b[2] + v0[2] * g[2], b[3] + v0[3] * g[3]);
                    w.z = pk2(b[4] + v1[0] * g[4], b[5] + v1[1] * g[5]); w.w = pk2(b[6] + v1[2] * g[6], b[7] + v1[3] * g[7]);
                    *(u32x4*)(O + row * DM + col) = w; } }
    }
};
struct EpiResid {
    static constexpr bool PERM = false, AFTER_DRAIN = false;
    const float* X; bf16_t* O;
    __device__ __forceinline__ void operator()(const f32x4 (&acc)[2][2][4][2], const Unit& u, int wr, int wc, int fr, int fq) const {
        const int row0 = u.pm * BM + wr * 64 + fr, col0 = u.pn * BM + wc * 32 + 4 * fq;
#pragma unroll
        for (int ai = 0; ai < 2; ++ai)
#pragma unroll
            for (int m = 0; m < 4; ++m) { const size_t off = (size_t)(row0 + ai * HALF + m * 16) * DM + col0;
#pragma unroll
                for (int bj = 0; bj < 2; ++bj)
#pragma unroll
                    for (int n = 0; n < 2; ++n) { const f32x4 b = *(const f32x4*)(X + off + bj * HALF + n * 16) + acc[ai][bj][m][n]; u32x2 w; w.x = pk2(b[0], b[1]); w.y = pk2(b[2], b[3]); *(u32x2*)(O + off + bj * HALF + n * 16) = w; } }
    }
};
struct EpiSwiglu {
    static constexpr bool PERM = true, AFTER_DRAIN = false;
    unsigned char* ACT; const float* b1; const float* row_rstd;
    __device__ __forceinline__ void operator()(const f32x4 (&acc)[2][2][4][2], const Unit& u, int wr, int wc, int fr, int fq) const {
        const int row0 = u.pm * BM + wr * 64 + fr, f0 = u.pn * HALF + wc * 32 + 8 * fq; const float* be = b1 + (size_t)u.e * 2048;
        const f32x4 bg0 = *(const f32x4*)(be + f0), bg1 = *(const f32x4*)(be + f0 + 4), bu0 = *(const f32x4*)(be + DFF + f0), bu1 = *(const f32x4*)(be + DFF + f0 + 4);
        float rsv[8];
#pragma unroll
        for (int i = 0; i < 8; ++i) rsv[i] = row_rstd[u.rb + wr * 64 + fr + (i >> 2) * HALF + (i & 3) * 16] * W8_INV;
#pragma unroll
        for (int ai = 0; ai < 2; ++ai)
#pragma unroll
            for (int m = 0; m < 4; ++m) { const size_t row = (size_t)(row0 + ai * HALF + m * 16); float o[8]; const float rs = rsv[ai * 4 + m];
#pragma unroll
                for (int n = 0; n < 2; ++n) { const f32x4 g4 = acc[ai][0][m][n] * rs + (n ? bg1 : bg0), u4 = acc[ai][1][m][n] * rs + (n ? bu1 : bu0);
#pragma unroll
                    for (int j = 0; j < 4; ++j) { const float g = fminf(g4[j], 7.f), uu = fminf(fmaxf(u4[j], -7.f), 7.f); o[4 * n + j] = (uu + 1.f) * (g * sigmoidf_(1.702f * g)); } }
                u32x2 w; w.x = pk4_fp8(o[0], o[1], o[2], o[3]); w.y = pk4_fp8(o[4], o[5], o[6], o[7]); *(u32x2*)(ACT + row * DFF + f0) = w; }
    }
};
struct EpiMoeOut {
    static constexpr bool PERM = true, AFTER_DRAIN = false;
    unsigned char* YS; const float* b2; const float* row_w; const int* row_slot;
    __device__ __forceinline__ void operator()(const f32x4 (&acc)[2][2][4][2], const Unit& u, int wr, int wc, int fr, int fq) const {
        const int col0 = u.pn * BM + wc * 32 + 8 * fq; const float* be = b2 + (size_t)u.e * DM; const int rbase = u.rb + wr * 64 + fr;
        int slot[8]; float w[8];
#pragma unroll
        for (int i = 0; i < 8; ++i) { const int row = rbase + (i >> 2) * HALF + (i & 3) * 16; slot[i] = row_slot[row]; w[i] = row_w[row] * (W8_INV * YS_SCALE); }
        f32x4 bv[2][2];
#pragma unroll
        for (int bj = 0; bj < 2; ++bj)
#pragma unroll
            for (int n = 0; n < 2; ++n) bv[bj][n] = *(const f32x4*)(be + col0 + bj * HALF + 4 * n) * W8_SCALE;
#pragma unroll
        for (int ai = 0; ai < 2; ++ai)
#pragma unroll
            for (int m = 0; m < 4; ++m) { const int i = ai * 4 + m;
                if (slot[i] >= 0) { unsigned char* rowp = YS + (size_t)slot[i] * DM + col0;
#pragma unroll
                    for (int bj = 0; bj < 2; ++bj) { const f32x4 v0 = (acc[ai][bj][m][0] + bv[bj][0]) * w[i], v1 = (acc[ai][bj][m][1] + bv[bj][1]) * w[i];
                        u32x2 o; o.x = pk4_fp8(v0[0], v0[1], v0[2], v0[3]); o.y = pk4_fp8(v1[0], v1[1], v1[2], v1[3]); *(u32x2*)(rowp + bj * HALF) = o; } } }
    }
};
constexpr int MOE_MAXU = 12;
struct MoeOrder {
    StaticOrder so; const PG8_LAS int* utab; const PG8_LAS int* gtab;
    __device__ __forceinline__ bool next(int i, Unit& u) const { if (i >= MOE_MAXU || !so.next(i, u)) return false; const int v = __builtin_amdgcn_readfirstlane(utab[i]); u.e = v & 31; u.rb = (int)((unsigned)v >> 8); return true; }
    __device__ __forceinline__ void a_ready(const Unit&) const {}
    __device__ __forceinline__ void done(const Unit&) const {}
};
typedef int i32x4_t __attribute__((ext_vector_type(4))); typedef int i32x8_t __attribute__((ext_vector_type(8)));
__device__ __forceinline__ i32x8_t cat8(bf16x8 lo, bf16x8 hi) { return __builtin_shufflevector(__builtin_bit_cast(i32x4_t, lo), __builtin_bit_cast(i32x4_t, hi), 0, 1, 2, 3, 4, 5, 6, 7); }
__device__ __forceinline__ void mfma_fp8_inplace(f32x4& c, const i32x8_t a, const i32x8_t b) { asm volatile("s_nop 1\n\tv_mfma_f32_16x16x128_f8f6f4 %0, %1, %2, %0" : "+v"(c) : "v"(a), "v"(b)); }
__device__ __forceinline__ void mfma_fp8_drain() { asm volatile("s_nop 15\n\ts_nop 7" ::: "memory"); __builtin_amdgcn_sched_barrier(0); }
template <class Epi, class Sched, bool ALIGN_EPI = false, bool SP2 = false, bool FP8 = false, bool GATHER = false>
__device__ __forceinline__ void gemm_phase(PG8_LAS unsigned char* lds, const Gemm g, const Sched& S, const Epi& E) {
    int tid = threadIdx.x; asm volatile("" : "+v"(tid));
    const int wid = __builtin_amdgcn_readfirstlane(tid >> 6), lane = tid & 63, wr = wid >> 2, wc = wid & 3, fr = lane & 15, fq = lane >> 4;
    const int K = g.K, nt = K / BK;
    static_assert(!GATHER || SP2, "GATHER is implemented for the SP2 loop only");
    const unsigned rowA = (unsigned)(g.lda ? g.lda : K) * 2u, rowB = (unsigned)(g.ldb ? g.ldb : K) * 2u;
    unsigned voffA[2], voffB[2]; int gR0 = 0; unsigned gC = 0u;
#pragma unroll
    for (int i = 0; i < 2; ++i) { int R, C; stage_rc(tid * 16 + i * 8192, R, C); const int Rb = Epi::PERM ? ((R & ~31) + perm32(R & 31)) : R;
        voffA[i] = (unsigned)R * rowA + (unsigned)C * 2u; voffB[i] = (unsigned)Rb * rowB + (unsigned)C * 2u; if (i == 0) { gR0 = R; gC = (unsigned)C * 2u; } }
    unsigned gA[2][2] = {{0u, 0u}, {0u, 0u}}, ngA[2][2] = {{0u, 0u}, {0u, 0u}};
#define PG8_GLOAD(dst, ui_) do { _Pragma("unroll") for (int h_ = 0; h_ < 2; ++h_) _Pragma("unroll") for (int i_ = 0; i_ < 2; ++i_) \
        dst[h_][i_] = (unsigned)S.gtab[(ui_) * 256 + 128 * h_ + gR0 + 64 * i_] * rowA + gC; } while (0)
#define PG8_VA(h) (GATHER ? gA[h] : voffA)
    const unsigned kstep = (unsigned)(BK * 2);
    const unsigned hstep = (unsigned)HALF * rowB;
    const unsigned tstep = 2u * hstep;
    const unsigned hstepA = (unsigned)HALF * rowA, tstepA = 2u * hstepA;
    const unsigned hsA = GATHER ? 0u : hstepA;
    const unsigned ldsw = (unsigned)wid * 1024u;
    const int aoff = lds_byte(wr * 64 + fr, fq * 8), boff = lds_byte(wc * 32 + fr, fq * 8);
#define PG8_SA(b, h) (((b) * 2 + (h)) * HTB)
#define PG8_SB(b, h) ((4 + (b) * 2 + (h)) * HTB)
#define PG8_STAGE(rs, bufoff, goff, voff) do { _Pragma("unroll") for (int _i = 0; _i < 2; ++_i) \
        __builtin_amdgcn_raw_ptr_buffer_load_lds(rs, (PG8_LAS void*)(lds + (bufoff) + ldsw + _i * 8192), 16, (int)(voff)[_i], (int)(goff), 0, 0); } while (0)
#define PG8_LDA(dst, b, h) do { _Pragma("unroll") for (int m = 0; m < 4; ++m) _Pragma("unroll") for (int k = 0; k < 2; ++k) dst[m][k] = *(const PG8_LAS bf16x8*)(lds + PG8_SA(b, h) + aoff + m * 2048 + k * 1024); } while (0)
#define PG8_LDB(dst, b, h) do { _Pragma("unroll") for (int n = 0; n < 2; ++n) _Pragma("unroll") for (int k = 0; k < 2; ++k) dst[n][k] = *(const PG8_LAS bf16x8*)(lds + PG8_SB(b, h) + boff + n * 2048 + k * 1024); } while (0)
#define PG8_MMA(ai, bj, At, Bt) do { __builtin_amdgcn_s_setprio(1); _Pragma("unroll") for (int m = 0; m < 4; ++m) _Pragma("unroll") for (int n = 0; n < 2; ++n) { \
        if constexpr (FP8) { mfma_fp8_inplace(acc[ai][bj][m][n], cat8(Bt[n][0], Bt[n][1]), cat8(At[m][0], At[m][1])); } \
        else { _Pragma("unroll") for (int k = 0; k < 2; ++k) acc[ai][bj][m][n] = __builtin_amdgcn_mfma_f32_16x16x32_bf16(Bt[n][k], At[m][k], acc[ai][bj][m][n], 0, 0, 0); } } \
        __builtin_amdgcn_s_setprio(0); } while (0)
#define PG8_WAIT_V(n) asm volatile("s_waitcnt vmcnt(" #n ")" ::: "memory")
#define PG8_WAIT_L(n) asm volatile("s_waitcnt lgkmcnt(" #n ")" ::: "memory")
#define PG8_BAR __builtin_amdgcn_s_barrier()
#define PG8_SCHED __builtin_amdgcn_sched_barrier(0)
    Unit cur, nxt; int ui = 0;
    if (!S.next(0, cur)) return;
    f32x4 acc[2][2][4][2];
#pragma unroll
    for (int a = 0; a < 2; ++a)
#pragma unroll
        for (int b = 0; b < 2; ++b)
#pragma unroll
            for (int m = 0; m < 4; ++m)
#pragma unroll
                for (int n = 0; n < 2; ++n) acc[a][b][m][n] = (f32x4){0.f, 0.f, 0.f, 0.f};
    bf16x8 At[4][2], B0[2][2], B1[2][2];
    unsigned cA = GATHER ? 0u : (unsigned)cur.pm * tstepA, cB = (unsigned)cur.e * (unsigned)g.bstride + (unsigned)cur.pn * tstep;
    const __amdgpu_buffer_rsrc_t rsA = __builtin_amdgcn_make_buffer_rsrc((void*)g.A, 0, 0x7fffffff, 0x00020000), rsB = __builtin_amdgcn_make_buffer_rsrc((void*)g.Bt, 0, 0x7fffffff, 0x00020000);
    S.a_ready(cur);
    if constexpr (GATHER) PG8_GLOAD(gA, 0);
    if constexpr (SP2) {
        PG8_STAGE(rsB, PG8_SB(0, 0), cB, voffB); PG8_STAGE(rsB, PG8_SB(0, 1), cB + hstep, voffB); PG8_STAGE(rsA, PG8_SA(0, 0), cA, PG8_VA(0)); PG8_STAGE(rsA, PG8_SA(0, 1), cA + hsA, PG8_VA(1));
        if (wr == 1) PG8_BAR;
        PG8_WAIT_V(2); PG8_BAR;
        PG8_STAGE(rsB, PG8_SB(1, 0), cB + kstep, voffB); PG8_STAGE(rsA, PG8_SA(1, 0), cA + kstep, PG8_VA(0)); PG8_STAGE(rsB, PG8_SB(1, 1), cB + hstep + kstep, voffB);
        PG8_WAIT_V(6); PG8_BAR;
    } else {
        PG8_STAGE(rsB, PG8_SB(0, 0), cB, voffB); PG8_STAGE(rsA, PG8_SA(0, 0), cA, PG8_VA(0)); PG8_STAGE(rsB, PG8_SB(0, 1), cB + hstep, voffB); PG8_STAGE(rsA, PG8_SA(0, 1), cA + hsA, PG8_VA(1));
        if (wr == 1) PG8_BAR;
        PG8_WAIT_V(4); PG8_BAR;
        PG8_STAGE(rsB, PG8_SB(1, 0), cB + kstep, voffB); PG8_STAGE(rsA, PG8_SA(1, 0), cA + kstep, PG8_VA(0)); PG8_STAGE(rsB, PG8_SB(1, 1), cB + hstep + kstep, voffB);
        PG8_WAIT_V(6); PG8_BAR;
    }
    for (;;) {
        const bool has_next = S.next(ui + 1, nxt);
        if constexpr (GATHER) { if (has_next) PG8_GLOAD(ngA, ui + 1); else { ngA[0][0] = gA[0][0]; ngA[0][1] = gA[0][1]; ngA[1][0] = gA[1][0]; ngA[1][1] = gA[1][1]; } }
        const unsigned nA = (has_next && !GATHER) ? (unsigned)nxt.pm * tstepA : cA, nB = has_next ? (unsigned)nxt.e * (unsigned)g.bstride + (unsigned)nxt.pn * tstep : cB;
        for (int t = 0; t < nt; t += 2) {
            const bool last = (t == nt - 2);
            const unsigned a1 = cA + (unsigned)(t + 1) * kstep;
            const unsigned a2 = last ? nA : cA + (unsigned)(t + 2) * kstep, b2 = last ? nB : cB + (unsigned)(t + 2) * kstep;
            const unsigned a3 = a2 + kstep, b3 = b2 + kstep;
            if (last && has_next) S.a_ready(nxt);
            if constexpr (SP2) {
            PG8_LDB(B0, 0, 0); PG8_LDB(B1, 0, 1); PG8_SCHED; PG8_LDA(At, 0, 0); PG8_STAGE(rsA, PG8_SA(1, 1), a1 + hsA, PG8_VA(1));
            if constexpr (GATHER) { if (last) { gA[0][0] = ngA[0][0]; gA[0][1] = ngA[0][1]; gA[1][0] = ngA[1][0]; gA[1][1] = ngA[1][1]; } }
            PG8_WAIT_V(8); PG8_WAIT_L(0); PG8_BAR; PG8_MMA(0, 0, At, B0); PG8_MMA(0, 1, At, B1); PG8_BAR; PG8_SCHED;
            PG8_LDA(At, 0, 1); PG8_STAGE(rsB, PG8_SB(0, 0), b2, voffB); PG8_STAGE(rsB, PG8_SB(0, 1), b2 + hstep, voffB); PG8_STAGE(rsA, PG8_SA(0, 0), a2, PG8_VA(0));
            PG8_WAIT_V(8); PG8_WAIT_L(0); PG8_BAR; PG8_MMA(1, 0, At, B0); PG8_MMA(1, 1, At, B1); PG8_BAR; PG8_SCHED;
            PG8_LDB(B0, 1, 0); PG8_LDB(B1, 1, 1); PG8_SCHED; PG8_LDA(At, 1, 0); PG8_STAGE(rsA, PG8_SA(0, 1), a2 + hsA, PG8_VA(1));
            PG8_WAIT_V(8); PG8_WAIT_L(0); PG8_BAR; PG8_MMA(0, 0, At, B0); PG8_MMA(0, 1, At, B1); PG8_BAR; PG8_SCHED;
            PG8_LDA(At, 1, 1); PG8_STAGE(rsB, PG8_SB(1, 0), b3, voffB); PG8_STAGE(rsB, PG8_SB(1, 1), b3 + hstep, voffB); PG8_STAGE(rsA, PG8_SA(1, 0), a3, PG8_VA(0));
            PG8_WAIT_V(8); PG8_WAIT_L(0); PG8_BAR; PG8_MMA(1, 0, At, B0); PG8_MMA(1, 1, At, B1); PG8_BAR; PG8_SCHED;
            } else {
            PG8_LDB(B0, 0, 0); PG8_SCHED; PG8_LDA(At, 0, 0); PG8_STAGE(rsA, PG8_SA(1, 1), a1 + hsA, PG8_VA(1));
            PG8_WAIT_L(8); PG8_BAR; PG8_WAIT_L(0); PG8_MMA(0, 0, At, B0); PG8_BAR; PG8_SCHED;
            PG8_LDB(B1, 0, 1); PG8_STAGE(rsB, PG8_SB(0, 0), b2, voffB);
            PG8_BAR; PG8_WAIT_L(0); PG8_MMA(0, 1, At, B1); PG8_BAR;
            PG8_LDA(At, 0, 1); PG8_STAGE(rsA, PG8_SA(0, 0), a2, PG8_VA(0));
            PG8_BAR; PG8_WAIT_L(0); PG8_MMA(1, 0, At, B0); PG8_BAR; PG8_SCHED;
            PG8_STAGE(rsB, PG8_SB(0, 1), b2 + hstep, voffB);
            PG8_WAIT_V(6); PG8_BAR; PG8_MMA(1, 1, At, B1); PG8_BAR;
            PG8_LDB(B0, 1, 0); PG8_SCHED; PG8_LDA(At, 1, 0); PG8_STAGE(rsA, PG8_SA(0, 1), a2 + hsA, PG8_VA(1));
            PG8_WAIT_L(8); PG8_BAR; PG8_WAIT_L(0); PG8_MMA(0, 0, At, B0); PG8_BAR; PG8_SCHED;
            PG8_LDB(B1, 1, 1); PG8_STAGE(rsB, PG8_SB(1, 0), b3, voffB);
            PG8_BAR; PG8_WAIT_L(0); PG8_MMA(0, 1, At, B1); PG8_BAR;
            PG8_LDA(At, 1, 1); PG8_STAGE(rsA, PG8_SA(1, 0), a3, PG8_VA(0));
            PG8_BAR; PG8_WAIT_L(0); PG8_MMA(1, 0, At, B0); PG8_BAR; PG8_SCHED;
            PG8_STAGE(rsB, PG8_SB(1, 1), b3 + hstep, voffB);
            PG8_WAIT_V(6); PG8_BAR; PG8_MMA(1, 1, At, B1); PG8_BAR;
            }
        }
        if constexpr (ALIGN_EPI) { if (wr == 0) PG8_BAR; }
        if constexpr (FP8) mfma_fp8_drain();
        if constexpr (!Epi::AFTER_DRAIN) { E(acc, cur, wr, wc, fr, fq); S.done(cur); }
        if (!has_next) break;
#pragma unroll
        for (int a = 0; a < 2; ++a)
#pragma unroll
            for (int b = 0; b < 2; ++b)
#pragma unroll
                for (int m = 0; m < 4; ++m)
#pragma unroll
                    for (int n = 0; n < 2; ++n) acc[a][b][m][n] = (f32x4){0.f, 0.f, 0.f, 0.f};
        cur = nxt; cA = nA; cB = nB; ++ui;
        if constexpr (ALIGN_EPI) { if (wr == 1) PG8_BAR; }
    }
    PG8_WAIT_V(0);
    if constexpr (!ALIGN_EPI) { if (wr == 0) PG8_BAR; }
    PG8_BAR;
    if constexpr (Epi::AFTER_DRAIN) { E.fused(acc, cur, wr, wc, fr, fq, lds, wid, lane); S.done(cur); }
#undef PG8_SA
#undef PG8_GLOAD
#undef PG8_VA
#undef PG8_SB
#undef PG8_STAGE
#undef PG8_LDA
#undef PG8_LDB
#undef PG8_MMA
#undef PG8_WAIT_V
#undef PG8_WAIT_L
#undef PG8_BAR
#undef PG8_SCHED
}
}

#define GAS __attribute__((address_space(1)))
#define LAS __attribute__((address_space(3)))
#define XB_TMO      128
#define XB_XCNT(j)  (256  + 64 * (j))
#define XB_XSUB(j)  (1280 + 64 * (j))
#define XB_XGEN(j)  (2304 + 64 * (j))
#define XB_TOP      3328
#define XB_TOPGEN   3392
#define XCD_BAR_WORDS 3456
#define XB_SPIN_CAP (1u << 18)

__device__ __forceinline__ unsigned xb_ld(unsigned* p)              { return __hip_atomic_load(p, __ATOMIC_RELAXED, __HIP_MEMORY_SCOPE_AGENT); }
__device__ __forceinline__ unsigned xb_add(unsigned* p, unsigned v) { return __hip_atomic_fetch_add(p, v, __ATOMIC_RELAXED, __HIP_MEMORY_SCOPE_AGENT); }
__device__ __forceinline__ unsigned xb_xcc_id() { return (unsigned)__builtin_amdgcn_s_getreg((3 << 11) | 20) & 0xFu; }
#define XB_SPIN(cond, bar) do { unsigned _sp = 0; while (cond) { __builtin_amdgcn_s_sleep(1); \
    if ((++_sp & 255u) == 0u) { if (xb_ld(&(bar)[XB_TMO])) break; if (_sp > XB_SPIN_CAP) { atomicAdd(&(bar)[XB_TMO], 1u); break; } } } } while (0)

struct XcdBarrier {
    unsigned* bar; unsigned x;
    volatile LAS unsigned* st;
};

__device__ __forceinline__ XcdBarrier xcd_barrier_post(unsigned* bar, volatile LAS unsigned* st) {
    XcdBarrier b; b.bar = bar; b.x = xb_xcc_id(); b.st = st;
    if (threadIdx.x == 0) (void)xb_add(&bar[XB_XCNT(b.x)], 1u);
    return b;
}
__device__ __forceinline__ void xcd_barrier_complete(unsigned* bar, unsigned x, unsigned& nloc, unsigned& nx) {
    const unsigned G = gridDim.x * gridDim.y * gridDim.z;
    unsigned sum, cnt, mine, sp = 0u;
    for (;;) {
        sum = 0u; cnt = 0u; mine = 0u;
#pragma unroll
        for (unsigned j = 0; j < 16; ++j) { const unsigned c = xb_ld(&bar[XB_XCNT(j)]); sum += c; cnt += (c > 0u) ? 1u : 0u; mine = (j == x) ? c : mine; }
        if (sum == G) break;
        __builtin_amdgcn_s_sleep(1);
        if ((++sp & 255u) == 0u) { if (xb_ld(&bar[XB_TMO])) break; if (sp > XB_SPIN_CAP) { atomicAdd(&bar[XB_TMO], 1u); break; } }
    }
    nloc = mine > 0u ? mine : 1u; nx = cnt > 0u ? cnt : 1u;
}

__device__ __forceinline__ void xcd_barrier(const XcdBarrier& b) {
    asm volatile("s_waitcnt vmcnt(0)" ::: "memory");
    __syncthreads();
    if (threadIdx.x == 0) {
        unsigned* bar = b.bar;
        __builtin_amdgcn_s_waitcnt(0);
        unsigned nloc = b.st[0], nx = b.st[1];
        if (nloc == 0u) { xcd_barrier_complete(bar, b.x, nloc, nx); b.st[0] = nloc; b.st[1] = nx; }
        const unsigned old = xb_add(&bar[XB_XSUB(b.x)], 1u);
        const unsigned gen = old / nloc;
        if (old + 1u == (gen + 1u) * nloc) {
            __builtin_amdgcn_fence(__ATOMIC_RELEASE, "agent");
            asm volatile("s_waitcnt vmcnt(0)" ::: "memory");
            const unsigned og = xb_add(&bar[XB_TOP], 1u);
            const unsigned tg = og / nx;
            if (og + 1u == (tg + 1u) * nx) xb_add(&bar[XB_TOPGEN], 1u);
            else XB_SPIN(xb_ld(&bar[XB_TOPGEN]) == tg, bar);
            __builtin_amdgcn_fence(__ATOMIC_ACQUIRE, "agent");
            xb_add(&bar[XB_XGEN(b.x)], 1u);
            asm volatile("s_waitcnt vmcnt(0)" ::: "memory");
        } else {
            XB_SPIN(xb_ld(&bar[XB_XGEN(b.x)]) == gen, bar);
            __builtin_amdgcn_fence(__ATOMIC_ACQUIRE, "agent");
            asm volatile("s_waitcnt vmcnt(0)" ::: "memory");
        }
    }
    __syncthreads();
}

template <int MODE  >
__device__ __forceinline__ void transpose_item(const float* __restrict__ W, int K, int N, bf16_t* __restrict__ WT, const float* __restrict__ gain, float* scr, int item, int lane) {
    const int nblk = N / 32, kb = item / nblk, nb = item % nblk, k0 = 64 * kb, n0 = 32 * nb;
#pragma unroll
    for (int i = 0; i < 8; ++i) { const int kk = 8 * i + (lane >> 3), n4 = (lane & 7) * 4; f32x4 v = *(const f32x4*)(W + (size_t)(k0 + kk) * N + n0 + n4);
        if (gain) { const float g = gain[k0 + kk]; v = v * g; }
        float* s = scr + kk * 33 + n4; s[0] = v[0]; s[1] = v[1]; s[2] = v[2]; s[3] = v[3]; }
    asm volatile("s_waitcnt lgkmcnt(0)" ::: "memory");
    const int c = lane & 7;
#pragma unroll
    for (int j = 0; j < 4; ++j) { const int n = (lane >> 3) + 8 * j; const float* s = scr + (8 * c) * 33 + n;
        u32x4 o; o.x = pk2(s[0 * 33], s[1 * 33]); o.y = pk2(s[2 * 33], s[3 * 33]); o.z = pk2(s[4 * 33], s[5 * 33]); o.w = pk2(s[6 * 33], s[7 * 33]);
        int row = n0 + n;
        if (MODE == 1) { const int f = row & 1023; row = ((f >> 7) << 8) + ((row >> 10) << 7) + (f & 127); }
        if (MODE == 2) { const int hh = row / DQK; row = hh * 128 + (row - hh * DQK); }
        if (MODE == 3) { const int hh = row >> 7, ii = row & 127; row = ((ii >> 6) << 9) + hh * 64 + (ii & 63); }
        *(u32x4*)(WT + (size_t)row * K + k0 + 8 * c) = o; }
    asm volatile("s_waitcnt lgkmcnt(0)" ::: "memory");
}
template <int MODE>
__device__ __forceinline__ void transpose_item_fp8(const float* __restrict__ W, int K, int N, unsigned char* __restrict__ WT, float* scr, int item, int lane) {
    const int nblk = N / 32, kb = item / nblk, nb = item % nblk, k0 = 64 * kb, n0 = 32 * nb;
#pragma unroll
    for (int i = 0; i < 8; ++i) { const int kk = 8 * i + (lane >> 3), n4 = (lane & 7) * 4; const f32x4 v = *(const f32x4*)(W + (size_t)(k0 + kk) * N + n0 + n4) * W8_SCALE;
        float* s = scr + kk * 33 + n4; s[0] = v[0]; s[1] = v[1]; s[2] = v[2]; s[3] = v[3]; }
    asm volatile("s_waitcnt lgkmcnt(0)" ::: "memory");
    const int c = lane & 7;
#pragma unroll
    for (int j = 0; j < 4; ++j) { const int n = (lane >> 3) + 8 * j; const float* s = scr + (8 * c) * 33 + n;
        u32x2 o; o.x = pk4_fp8(s[0 * 33], s[1 * 33], s[2 * 33], s[3 * 33]); o.y = pk4_fp8(s[4 * 33], s[5 * 33], s[6 * 33], s[7 * 33]);
        int row = n0 + n;
        if (MODE == 1) { const int f = row & 1023; row = ((f >> 7) << 8) + ((row >> 10) << 7) + (f & 127); }
        *(u32x2*)(WT + (size_t)row * K + k0 + 8 * c) = o; }
    asm volatile("s_waitcnt lgkmcnt(0)" ::: "memory");
}
__device__ __forceinline__ void phase_prologue(const Params& p, unsigned char* lds) {
    const int tid = threadIdx.x, lane = tid & 63, wave = tid >> 6;
    float* scr = (float*)(lds + wave * 16384);
    const int gw = blockIdx.x * NWAVES + wave, NGW = gridDim.x * NWAVES;
    unsigned char* ws = p.ws;
    constexpr int I_WIN = (DM / 64) * (INC / 32), I_UQ = (QLORA / 64) * (768 / 32), I_UKV = (KVLORA / 64) * (1024 / 32), I_OM = (512 / 64) * (DM / 32), I_OC = I_OM, I_WO = (DM / 64) * (DM / 32);
    constexpr int I_W1 = (DM / 64) * (2048 / 32), I_W2 = (DFF / 64) * (DM / 32);
    constexpr int NSMALL = I_WIN + I_UQ + I_UKV + I_OM + I_OC + I_WO;
    constexpr int NITEMS = NSMALL;
    for (int it = gw; it < NITEMS; it += NGW) {
        int r = it;
        if (r < I_WIN) { transpose_item<0>(p.w_in, DM, INC, (bf16_t*)(ws + WS_WIN), p.norm1_g, scr, r, lane); continue; } r -= I_WIN;
        if (r < I_UQ) { transpose_item<2>(p.w_uq, QLORA, 768, (bf16_t*)(ws + WS_WUQ), p.q_a_g, scr, r, lane); continue; } r -= I_UQ;
        if (r < I_UKV) { transpose_item<3>(p.w_ukv, KVLORA, 1024, (bf16_t*)(ws + WS_WUKV), p.kv_a_g, scr, r, lane); continue; } r -= I_UKV;
        if (r < I_OM) { transpose_item<0>(p.w_o_mla, 512, DM, (bf16_t*)(ws + WS_WOMLA), nullptr, scr, r, lane); continue; } r -= I_OM;
        if (r < I_OC) { transpose_item<0>(p.w_o_conv, 512, DM, (bf16_t*)(ws + WS_WOCONV), nullptr, scr, r, lane); continue; } r -= I_OC;
        transpose_item<0>(p.w_o, DM, DM, (bf16_t*)(ws + WS_WO), nullptr, scr, r, lane);
    }
    { u32x4* z = (u32x4*)((bf16_t*)(ws + WS_WIN) + (size_t)INC * DM); const int nz = (INCP - INC) * DM * 2 / 16;
      for (int i = blockIdx.x * NTHREADS + tid; i < nz; i += gridDim.x * NTHREADS) z[i] = (u32x4){0u, 0u, 0u, 0u}; }
    { u32x4* wq = (u32x4*)(ws + WS_WUQ); for (int i = blockIdx.x * NTHREADS + tid; i < NH * 32 * QLORA * 2 / 16; i += gridDim.x * NTHREADS) { const int hh = i / (32 * QLORA * 2 / 16), q = i - hh * (32 * QLORA * 2 / 16); wq[(hh * 128 + 96) * (QLORA * 2 / 16) + q] = (u32x4){0u, 0u, 0u, 0u}; } }
    { float* csd = (float*)(ws + WS_CS); for (int i = blockIdx.x * NTHREADS + tid; i < NTOK * 16; i += gridDim.x * NTHREADS) { const int t = i >> 4, j = i & 15; float sn, cn; sincosf((float)p.pos[t] * exp2f(-(float)j * (13.287712379549449f / 16.f)), &sn, &cn); csd[t * 32 + j] = cn; csd[t * 32 + 16 + j] = sn; } }
    if (blockIdx.x == 0 && tid < 64) { float gq = fabsf(p.q_g[tid]), gk = fabsf(p.k_g[tid]); if (tid < 32) { gq = fmaxf(gq, fabsf(p.q_g[64 + tid])); gk = fmaxf(gk, fabsf(p.k_g[64 + tid])); }
#pragma unroll
        for (int o = 1; o < 64; o <<= 1) { gq = fmaxf(gq, __shfl_xor(gq, o)); gk = fmaxf(gk, __shfl_xor(gk, o)); }
        if (tid == 0) *(float*)(ws + WS_SHIFT) = fmaxf(2.f, ceilf(14.135f * gq * gk + 0.5f - 15.f)); }
    { int* rt = (int*)(ws + WS_RT2); int* rs = (int*)(ws + WS_RT2 + 4 * MiB); float* rr = (float*)(ws + WS_RT2 + 6 * MiB);
      for (int i = blockIdx.x * NTHREADS + tid; i < NE * CAP; i += gridDim.x * NTHREADS) { rt[i] = 0; rs[i] = -1; rr[i] = 0.f; } }
    { u32x4* GF = (u32x4*)(ws + WS_GF);
      for (int i = blockIdx.x * NTHREADS + tid; i < 64 * 64; i += gridDim.x * NTHREADS) { const int ks = i >> 6, ln = i & 63, r = ln & 31, h = ln >> 5; float v[8], lo[8]; unsigned hi[4];
#pragma unroll
          for (int j = 0; j < 8; ++j) { const int k = 16 * ks + 8 * h + j; v[j] = p.norm2_g[k] * p.router_w[(size_t)k * NE + r]; }
#pragma unroll
          for (int j = 0; j < 4; ++j) { hi[j] = pk2(v[2 * j], v[2 * j + 1]); lo[2 * j] = v[2 * j] - bf_lo(hi[j]); lo[2 * j + 1] = v[2 * j + 1] - bf_hi(hi[j]); }
          GF[(ks * 2 + 0) * 64 + ln] = (u32x4){hi[0], hi[1], hi[2], hi[3]}; GF[(ks * 2 + 1) * 64 + ln] = (u32x4){pk2(lo[0], lo[1]), pk2(lo[2], lo[3]), pk2(lo[4], lo[5]), pk2(lo[6], lo[7])}; } }
    bf16_t* XN = (bf16_t*)(ws + WS_XN);
    for (int m = gw; m < NTOK; m += NGW) {
        const f32x4* xr = (const f32x4*)(p.x + (size_t)m * DM) + lane; f32x4 v[4]; float s = 0.f;
#pragma unroll
        for (int j = 0; j < 4; ++j) { v[j] = xr[64 * j]; s += (v[j][0] * v[j][0] + v[j][1] * v[j][1]) + (v[j][2] * v[j][2] + v[j][3] * v[j][3]); }
        const float rstd = rsqrtf(wave_sum(s) * (1.f / DM) + EPS);
        u32x2* o = (u32x2*)(XN + (size_t)m * DM) + lane;
#pragma unroll
        for (int j = 0; j < 4; ++j) { u32x2 w; w.x = pk2(v[j][0] * rstd, v[j][1] * rstd); w.y = pk2(v[j][2] * rstd, v[j][3] * rstd); o[64 * j] = w; }
    }
}

struct ConvRaw { u32x4 u[3], c[3], bg; float m0, m2; };
__device__ __forceinline__ void conv_load(ConvRaw& r, const Params& p, int t, int lane) {
    const bf16_t* pr = (const bf16_t*)(p.ws + WS_PROJ) + (size_t)t * INCP; const int s = t & (SEQ - 1);
    r.m0 = s > 0 ? 1.f : 0.f; r.m2 = s < SEQ - 1 ? 1.f : 0.f;
    const bf16_t* pm = s > 0 ? pr - INCP : pr; const bf16_t* pp = s < SEQ - 1 ? pr + INCP : pr;
    r.u[0] = *(const u32x4*)(pm + OFF_U + 8 * lane); r.c[0] = *(const u32x4*)(pm + OFF_C + 8 * lane);
    r.u[1] = *(const u32x4*)(pr + OFF_U + 8 * lane); r.c[1] = *(const u32x4*)(pr + OFF_C + 8 * lane);
    r.u[2] = *(const u32x4*)(pp + OFF_U + 8 * lane); r.c[2] = *(const u32x4*)(pp + OFF_C + 8 * lane);
    r.bg = *(const u32x4*)(pr + OFF_B + 8 * lane);
}
__device__ __forceinline__ void mulpair8(const u32x4 u, const u32x4 c, float (&o)[8]) {
    o[0] = bf_lo(u.x) * bf_lo(c.x); o[1] = bf_hi(u.x) * bf_hi(c.x); o[2] = bf_lo(u.y) * bf_lo(c.y); o[3] = bf_hi(u.y) * bf_hi(c.y);
    o[4] = bf_lo(u.z) * bf_lo(c.z); o[5] = bf_hi(u.z) * bf_hi(c.z); o[6] = bf_lo(u.w) * bf_lo(c.w); o[7] = bf_hi(u.w) * bf_hi(c.w); }
__device__ __forceinline__ void conv_store(const ConvRaw& r, const Params& p, int t, int lane, const float (&cw0)[8], const float (&cw1)[8], const float (&cw2)[8]) {
    float cu0[8], cu1[8], cu2[8], bb[8], y[8]; mulpair8(r.u[0], r.c[0], cu0); mulpair8(r.u[1], r.c[1], cu1); mulpair8(r.u[2], r.c[2], cu2);
    bb[0] = bf_lo(r.bg.x); bb[1] = bf_hi(r.bg.x); bb[2] = bf_lo(r.bg.y); bb[3] = bf_hi(r.bg.y); bb[4] = bf_lo(r.bg.z); bb[5] = bf_hi(r.bg.z); bb[6] = bf_lo(r.bg.w); bb[7] = bf_hi(r.bg.w);
#pragma unroll
    for (int j = 0; j < 8; ++j) y[j] = bb[j] * (cw0[j] * r.m0 * cu0[j] + cw1[j] * cu1[j] + cw2[j] * r.m2 * cu2[j]);
    u32x4 o; o.x = pk2(y[0], y[1]); o.y = pk2(y[2], y[3]); o.z = pk2(y[4], y[5]); o.w = pk2(y[6], y[7]); *(u32x4*)((bf16_t*)(p.ws + WS_YBIN) + (size_t)t * CONVW + 8 * lane) = o;
}
__device__ __forceinline__ void phase_conv(const Params& p) {
    int tid = threadIdx.x; asm volatile("" : "+v"(tid)); const int lane = tid & 63, wave = tid >> 6;
    const int gw = blockIdx.x * NWAVES + wave, NGW = gridDim.x * NWAVES;
    float cw0[8], cw1[8], cw2[8];
#pragma unroll
    for (int j = 0; j < 8; ++j) { cw0[j] = p.conv_w[8 * lane + j]; cw1[j] = p.conv_w[CONVW + 8 * lane + j]; cw2[j] = p.conv_w[2 * CONVW + 8 * lane + j]; }
    for (int t = gw; t < NTOK; t += 2 * NGW) {
        const int t1 = t + NGW; const bool two = t1 < NTOK;
        ConvRaw r0, r1; conv_load(r0, p, t, lane); conv_load(r1, p, two ? t1 : t, lane);
        conv_store(r0, p, t, lane, cw0, cw1, cw2);
        if (two) conv_store(r1, p, t1, lane, cw0, cw1, cw2);
    }
}

constexpr int WC_EXP_ITEMS = NE * 1536, WC_RAW_B = 9 * 1024;
struct WcItem { const float* W; unsigned char* WT; int N, k0, n0, mode; };
__device__ __forceinline__ WcItem wc_decode(const Params& p, int x) {
    WcItem it; const int e = x / 1536, r = x - e * 1536;
    if (r < 1024) { it.W = p.w1 + (size_t)e * DM * 2048; it.WT = p.ws + WS_W1 + (size_t)e * 2048 * DM; it.N = 2048; it.k0 = 64 * (r >> 6); it.n0 = 32 * (r & 63); it.mode = 1; }
    else { const int q = r - 1024; it.W = p.w2 + (size_t)e * DFF * DM; it.WT = p.ws + WS_W2 + (size_t)e * DM * DFF; it.N = DM; it.k0 = 64 * (q >> 5); it.n0 = 32 * (q & 31); it.mode = 0; }
    return it;
}
struct WConv { unsigned char* raw; int x0, nitems, cs, slot, N; const float* src; };
__device__ __forceinline__ bool wconv_step(WConv& c, const Params& p, int lane) {
    typedef __attribute__((address_space(3))) unsigned* lds_u32p;
    const int cs = c.cs, nst = 8 * c.nitems, fi = cs - 9;
    if (fi >= 0 && (fi & 7) == 0 && (fi >> 3) < c.nitems) {
        const int i = fi >> 3; const WcItem it = wc_decode(p, c.x0 + i); const int c8 = lane & 7, nr = lane >> 3, lv = (nr >> 2) | (c8 << 1);
        int sl = c.slot + c8; sl -= (sl >= 9) ? 9 : 0;
        const unsigned char* rb = c.raw + sl * 1024 + (nr & 3) * 4;
        float v[4][8];
#pragma unroll
        for (int j = 0; j < 4; ++j)
#pragma unroll
            for (int k = 0; k < 8; ++k) v[j][k] = *(const float*)(rb + (((k * 8 + 2 * j) ^ lv) << 4));
#pragma unroll
        for (int j = 0; j < 4; ++j) {
            u32x2 o; o.x = pk4_fp8(v[j][0] * W8_SCALE, v[j][1] * W8_SCALE, v[j][2] * W8_SCALE, v[j][3] * W8_SCALE); o.y = pk4_fp8(v[j][4] * W8_SCALE, v[j][5] * W8_SCALE, v[j][6] * W8_SCALE, v[j][7] * W8_SCALE);
            int row = it.n0 + nr + 8 * j; if (it.mode == 1) { const int f = row & 1023; row = ((f >> 7) << 8) + ((row >> 10) << 7) + (f & 127); }
            *(u32x2*)(it.WT + (size_t)row * DM + it.k0 + 8 * c8) = o; }
    }
    const bool issue = cs < nst;
    if (issue) {
        const int q = cs & 7;
        if (q == 0) { const WcItem it = wc_decode(p, c.x0 + (cs >> 3)); c.src = it.W + (size_t)it.k0 * it.N + it.n0; c.N = it.N; }
        const int sv = lane ^ (q << 1), kk = sv >> 3, n4 = (sv & 7) * 4;
        __builtin_amdgcn_global_load_lds((const unsigned*)(c.src + (size_t)(8 * q + kk) * c.N + n4), (lds_u32p)(c.raw + c.slot * 1024 + lane * 16), 16, 0, 0);
    }
    c.cs = cs + 1; c.slot = (c.slot == 8) ? 0 : c.slot + 1;
    return issue;
}

namespace att {
constexpr int NW = 8, QBLK = 32, KVBLK = 64;
constexpr float SCALE = 0.10206207261596575f;
constexpr float QSC = SCALE * 1.4426950408889634f;
constexpr int LDQ = 128, LDK = 128;
constexpr int SHM_V = KVBLK * DV, SHM_K = KVBLK * 128, SHM_ATTN = 2 * SHM_V + 2 * SHM_K + NW * 64 * 4;
#define KSWZ(row, colB) ((row) * 256 + ((colB) ^ (((row) & 7) << 4)))
#define SBAR() __builtin_amdgcn_sched_barrier(0)
__device__ __forceinline__ int crow(int r, int hi) { return (r & 3) + 8 * (r >> 2) + 4 * hi; }
__device__ __forceinline__ float fadd_s(float a, float b) { float r; asm("v_add_f32_e32 %0, %1, %2" : "=v"(r) : "v"(a), "v"(b)); return r; }
__device__ __forceinline__ unsigned cvtpk(float lo, float hi) { unsigned r; asm volatile("v_cvt_pk_bf16_f32 %0, %1, %2" : "=v"(r) : "v"(lo), "v"(hi)); return r; }
typedef int i32x4a __attribute__((ext_vector_type(4))); typedef int i32x8a __attribute__((ext_vector_type(8)));
#define EXPH(P) do { _Pragma("unroll") for (int r = 0; r < 16; ++r) P[r] = __builtin_amdgcn_exp2f(P[r]); } while (0)
__device__ __forceinline__ unsigned pk4_bf8(float a, float b, float c, float d) { unsigned w = 0u; w = (unsigned)__builtin_amdgcn_cvt_pk_bf8_f32(a, b, (int)w, false); w = (unsigned)__builtin_amdgcn_cvt_pk_bf8_f32(c, d, (int)w, true); return w; }
__device__ __forceinline__ void finishSM(f32x16& p0, f32x16& p1, float& l_reg, i32x8a& pf) {
    EXPH(p1); SBAR();
    float ps0 = p0[0], ps1 = p1[0];
#pragma unroll
    for (int r = 1; r < 16; ++r) { ps0 = fadd_s(ps0, p0[r]); ps1 = fadd_s(ps1, p1[r]); }
    l_reg += ps0 + ps1;
#pragma unroll
    for (int q = 0; q < 4; ++q) {
        pf[q] = __builtin_amdgcn_cvt_pk_bf8_f32(p0[4 * q], p0[4 * q + 1], pf[q], false); pf[q] = __builtin_amdgcn_cvt_pk_bf8_f32(p0[4 * q + 2], p0[4 * q + 3], pf[q], true);
        pf[4 + q] = __builtin_amdgcn_cvt_pk_bf8_f32(p1[4 * q], p1[4 * q + 1], pf[4 + q], false); pf[4 + q] = __builtin_amdgcn_cvt_pk_bf8_f32(p1[4 * q + 2], p1[4 * q + 3], pf[4 + q], true); }
}
__device__ __forceinline__ void qkt(f32x16& p0, f32x16& p1, const unsigned char* Ks, const i32x8a* qf, int r32, int hi) {
    const f32x16 z = {};
#pragma unroll
    for (int kh = 0; kh < 2; ++kh) { const int row = kh * 32 + r32, sw = (row >> 1) & 7; const unsigned char* rb = Ks + row * 128; f32x16 acc = z;
#pragma unroll
        for (int s = 0; s < 2; ++s) { const int c0 = 4 * s + 2 * hi; const i32x4a lo = *reinterpret_cast<const i32x4a*>(rb + ((c0 ^ sw) << 4)), hh = *reinterpret_cast<const i32x4a*>(rb + (((c0 + 1) ^ sw) << 4));
            acc = __builtin_amdgcn_mfma_scale_f32_32x32x64_f8f6f4(__builtin_shufflevector(lo, hh, 0, 1, 2, 3, 4, 5, 6, 7), qf[s], acc, 0, 0, 0, 0, 0, 0); }
        if (kh == 0) p0 = acc; else p1 = acc; }
}
__device__ __forceinline__ i32x8a kfrag(const unsigned char* Ks, int kh, int s, int r32, int hi) {
    const int row = kh * 32 + r32, sw = (row >> 1) & 7, c0 = 4 * s + 2 * hi; const unsigned char* rb = Ks + row * 128;
    const i32x4a lo = *reinterpret_cast<const i32x4a*>(rb + ((c0 ^ sw) << 4)), hh = *reinterpret_cast<const i32x4a*>(rb + (((c0 + 1) ^ sw) << 4));
    return __builtin_shufflevector(lo, hh, 0, 1, 2, 3, 4, 5, 6, 7);
}
__device__ __forceinline__ i32x8a vfrag(const unsigned char* Vs, int d0, int r32, int hi) {
    const unsigned char* b = Vs + (((hi * 2 + d0) * 32 + r32) << 5); const int sw = (r32 >> 3) & 1;
    const i32x4a lo = *reinterpret_cast<const i32x4a*>(b + (sw << 4)), hh = *reinterpret_cast<const i32x4a*>(b + ((sw ^ 1) << 4));
    return __builtin_shufflevector(lo, hh, 0, 1, 2, 3, 4, 5, 6, 7);
}
__device__ __forceinline__ void pv8(f32x16& od, const i32x8a v, const i32x8a pfr) { asm volatile("s_nop 1\n\tv_mfma_f32_32x32x64_f8f6f4 %0, %1, %2, %0 blgp:1" : "+v"(od) : "v"(v), "v"(pfr)); }
#define EXPQ(P, B) do { _Pragma("unroll") for (int r = (B); r < (B) + 8; ++r) P[r] = __builtin_amdgcn_exp2f(P[r]); } while (0)
#define PV_STEP(Vs, PN) do { const i32x8a v0_ = vfrag((Vs), 0, r32, hi), v1_ = vfrag((Vs), 1, r32, hi); pv8(o[0], v0_, pf); EXPQ(PN, 0); pv8(o[1], v1_, pf); EXPQ(PN, 8); SBAR(); } while (0)

__device__ __forceinline__ void attn_unit(const unsigned char* __restrict__ Qb, const unsigned char* __restrict__ Kh, const unsigned char* __restrict__ Vth, bf16_t* __restrict__ Ob, int seq, unsigned char* lds, WConv& wc, const Params& prm) {
    const int tid = threadIdx.x, wid = __builtin_amdgcn_readfirstlane(tid >> 6), lane = tid & 63, r32 = lane & 31, hi = lane >> 5;
    unsigned char* V_lds = lds; unsigned char* K_lds = lds + 2 * SHM_V;
    f32x16 o[2] = {}; i32x8a qr[2];
    { const unsigned char* Qw = Qb + (size_t)(wid * QBLK + r32) * LDQ + hi * 32;
#pragma unroll
      for (int s = 0; s < 2; ++s) { const i32x4a lo = *reinterpret_cast<const i32x4a*>(Qw + 64 * s), hh = *reinterpret_cast<const i32x4a*>(Qw + 64 * s + 16); qr[s] = __builtin_shufflevector(lo, hh, 0, 1, 2, 3, 4, 5, 6, 7); } }
    const int kr0 = 8 * wid + (lane >> 3), kcp = lane & 7;
    const unsigned char* ksrc0 = Kh + (size_t)kr0 * LDK + ((kcp ^ ((kr0 >> 1) & 7)) * 16);
    const unsigned char* vsrc = Vth + (wid & 3) * 1024 + lane * 16;
    typedef __attribute__((address_space(3))) unsigned* lds_u32p;
#define DMA_K(t, slot) __builtin_amdgcn_global_load_lds((const unsigned*)(ksrc0 + (size_t)(t) * KVBLK * LDK), (lds_u32p)(K_lds + (slot) * SHM_K + wid * 1024 + lane * 16), 16, 0, 0)
#define DMA_V(t, slot) do { if (wid < 4) __builtin_amdgcn_global_load_lds((const unsigned*)(vsrc + (size_t)(t) * 4096), (lds_u32p)(V_lds + (slot) * SHM_V + wid * 1024 + lane * 16), 16, 0, 0); } while (0)
    f32x16 pA0, pA1, pB0, pB1; i32x8a pf = {}; const int NT = seq / KVBLK;
    typedef float f32x4v __attribute__((ext_vector_type(4)));
    i32x8a ones; { const int c4 = ((lane & 1) == ((lane >> 4) & 1)) ? 0x22222222 : 0; ones = (i32x8a){c4, c4, c4, c4, 0, 0, 0, 0}; }
    f32x4v lsum = {0.f, 0.f, 0.f, 0.f};
    const f32x16 zacc = {};
#define QKM(ACC, KF, S, CIN) ACC = __builtin_amdgcn_mfma_scale_f32_32x32x64_f8f6f4(KF, qr[S], CIN, 0, 0, 0, 0, 0, 0)
#define ROWSUM() lsum = __builtin_amdgcn_mfma_scale_f32_16x16x128_f8f6f4(ones, pf, lsum, 4, 1, 0, 0, 0, 0)
#define CVT8(P, Q0) do { _Pragma("unroll") for (int q_ = 0; q_ < 4; ++q_) { pf[(Q0) + q_] = __builtin_amdgcn_cvt_pk_bf8_f32(P[4 * q_], P[4 * q_ + 1], pf[(Q0) + q_], false); pf[(Q0) + q_] = __builtin_amdgcn_cvt_pk_bf8_f32(P[4 * q_ + 2], P[4 * q_ + 3], pf[(Q0) + q_], true); } } while (0)
#define WAITW(ISS) do { if (ISS) asm volatile("s_waitcnt vmcnt(1)" ::: "memory"); else asm volatile("s_waitcnt vmcnt(0)" ::: "memory"); } while (0)
#define BARE_BAR() asm volatile("s_barrier" ::: "memory")
#define PIN(P) asm volatile("" : "+v"(P))
#define STEP(Ks, Vs, PC0, PC1, PX0, PX1) do { \
        const i32x8a k00_ = kfrag((Ks), 0, 0, r32, hi), k01_ = kfrag((Ks), 0, 1, r32, hi), k10_ = kfrag((Ks), 1, 0, r32, hi), k11_ = kfrag((Ks), 1, 1, r32, hi); SBAR(); \
        QKM(PX0, k00_, 0, zacc); PIN(PX0); EXPQ(PC1, 0); PIN(PC1); SBAR(); \
        QKM(PX0, k01_, 1, PX0); PIN(PX0); EXPQ(PC1, 8); PIN(PC1); SBAR(); \
        QKM(PX1, k10_, 0, zacc); PIN(PX1); CVT8(PC0, 0); PIN(pf); SBAR(); \
        QKM(PX1, k11_, 1, PX1); PIN(PX1); CVT8(PC1, 4); PIN(pf); const i32x8a v0_ = vfrag((Vs), 0, r32, hi), v1_ = vfrag((Vs), 1, r32, hi); SBAR(); \
        ROWSUM(); PIN(lsum); pv8(o[0], v0_, pf); EXPQ(PX0, 0); PIN(PX0); SBAR(); \
        pv8(o[1], v1_, pf); EXPQ(PX0, 8); PIN(PX0); SBAR(); } while (0)
    DMA_K(0, 0); DMA_V(0, 0); DMA_K(1, 1);
    asm volatile("s_waitcnt vmcnt(0)" ::: "memory"); __syncthreads();
    qkt(pA0, pA1, K_lds, qr, r32, hi); EXPH(pA0); SBAR();
    __syncthreads();
    for (int j = 0; j + 2 < NT; j += 2) {
        DMA_K(j + 2, 0); DMA_V(j + 1, 1); const bool wlA = wconv_step(wc, prm, lane); SBAR();
        STEP(K_lds + SHM_K, V_lds, pA0, pA1, pB0, pB1);
        WAITW(wlA); BARE_BAR();
        DMA_K(j + 3, 1); DMA_V(j + 2, 0); const bool wlB = wconv_step(wc, prm, lane); SBAR();
        STEP(K_lds, V_lds + SHM_V, pB0, pB1, pA0, pA1);
        WAITW(wlB); BARE_BAR();
    }
    DMA_V(NT - 1, 1); const bool wlT = wconv_step(wc, prm, lane); SBAR();
    STEP(K_lds + SHM_K, V_lds, pA0, pA1, pB0, pB1);
    WAITW(wlT); BARE_BAR();
    EXPH(pB1); SBAR(); CVT8(pB0, 0); CVT8(pB1, 4); SBAR();
    { const i32x8a v0_ = vfrag(V_lds + SHM_V, 0, r32, hi), v1_ = vfrag(V_lds + SHM_V, 1, r32, hi); ROWSUM(); pv8(o[0], v0_, pf); pv8(o[1], v1_, pf); }
    asm volatile("s_nop 15\n\ts_nop 7" ::: "memory"); SBAR();
    const float l_reg = (lane & 16) ? lsum[1] : lsum[0];
#undef STEP
#undef PIN
#undef WAITW
#undef BARE_BAR
#undef QKM
#undef ROWSUM
#undef CVT8
    const float rl = __builtin_amdgcn_rcpf(l_reg);
    bf16_t* Ow = Ob + (size_t)(wid * QBLK + r32) * 512 + 4 * hi;
#pragma unroll
    for (int d0 = 0; d0 < 2; ++d0)
#pragma unroll
        for (int g = 0; g < 4; ++g) { u32x2 w; w.x = pk2(o[d0][4 * g] * rl, o[d0][4 * g + 1] * rl); w.y = pk2(o[d0][4 * g + 2] * rl, o[d0][4 * g + 3] * rl); *(u32x2*)(Ow + d0 * 32 + 8 * g) = w; }
    __syncthreads();
#undef DMA_K
#undef DMA_V
}
#undef KSWZ
#undef SBAR
}

__device__ __forceinline__ void phase_attn(const Params& p, unsigned char* lds) {
    const unsigned char* Q = p.ws + WS_Q; const unsigned char* Kb = p.ws + WS_K; const unsigned char* VT = p.ws + WS_V; bf16_t* AO = (bf16_t*)(p.ws + WS_AO);
    constexpr int NQB = SEQ / 256, NU = 2 * NH * NQB;
    const int lane = threadIdx.x & 63, wave = __builtin_amdgcn_readfirstlane(threadIdx.x >> 6), gw = blockIdx.x * NWAVES + wave, NGW = gridDim.x * NWAVES;
    const int ipw = (WC_EXP_ITEMS + NGW - 1) / NGW, nun = ((int)blockIdx.x < NU) ? (NU - 1 - (int)blockIdx.x) / (int)gridDim.x + 1 : 0, steps = nun * (SEQ / att::KVBLK - 1);
    int cov = (steps - 2) / 8; cov = cov < 0 ? 0 : (cov > ipw ? ipw : cov);
    WConv wc; wc.raw = lds + att::SHM_ATTN + wave * WC_RAW_B; wc.x0 = gw * ipw; wc.cs = 0; wc.slot = 0; wc.N = 0; wc.src = p.w1;
    { const int left = WC_EXP_ITEMS - wc.x0; wc.nitems = left < 0 ? 0 : (left < cov ? left : cov); }
    if (wave >= 4) __builtin_amdgcn_s_setprio(1);
    const bool xmap = false;
    for (int u0 = blockIdx.x, rnd = 0; u0 < NU; u0 += gridDim.x, ++rnd) {
        const int u = xmap ? (((int)blockIdx.x & 7) + 8 * rnd) * NQB + ((int)blockIdx.x >> 3) : u0;
        const int qb = u % NQB, h = (u / NQB) % NH, b = u / (NQB * NH); const size_t bh = (size_t)(b * NH + h) * SEQ;
        att::attn_unit(Q + (bh + (size_t)qb * 256) * 128, Kb + bh * 128, VT + bh * DV, AO + ((size_t)b * SEQ + (size_t)qb * 256) * 512 + h * DV, SEQ, lds, wc, p);
    }
    __builtin_amdgcn_s_setprio(0);
    while (wc.cs < 8 * wc.nitems + 2) { wconv_step(wc, p, lane); asm volatile("s_waitcnt vmcnt(0)" ::: "memory"); }
}
__device__ __forceinline__ void wconv_cleanup(const Params& p, unsigned char* lds) {
    constexpr int NQB = SEQ / 256, NU = 2 * NH * NQB;
    const int lane = threadIdx.x & 63, wave = threadIdx.x >> 6, gw = blockIdx.x * NWAVES + wave, NGW = gridDim.x * NWAVES;
    const int ipw = (WC_EXP_ITEMS + NGW - 1) / NGW, nun = ((int)blockIdx.x < NU) ? (NU - 1 - (int)blockIdx.x) / (int)gridDim.x + 1 : 0, steps = nun * (SEQ / att::KVBLK - 1);
    int cov = (steps - 2) / 8; cov = cov < 0 ? 0 : (cov > ipw ? ipw : cov);
    float* scr = (float*)(lds + wave * 16384);
    for (int i = cov; i < ipw; ++i) { const int x = gw * ipw + i; if (x >= WC_EXP_ITEMS) break; const WcItem it = wc_decode(p, x); const int r = x % 1536;
        if (it.mode == 1) transpose_item_fp8<1>(it.W, DM, 2048, it.WT, scr, r, lane); else transpose_item_fp8<0>(it.W, DFF, DM, it.WT, scr, r - 1024, lane); }
    __syncthreads();
}

__device__ __forceinline__ int crow16(int r, int hi) { return (r & 3) + 8 * (r >> 2) + 4 * hi; }
__device__ __forceinline__ void phase_router(const Params& p, unsigned char* lds) {
    const int tid = threadIdx.x, lane = tid & 63, wid = tid >> 6, tile = wid >> 2, kq = wid & 3, c = lane & 31, h = lane >> 5;
    float* red = (float*)lds;
    float* ssb = red + 2 * 4 * 16 * 64;
    int* lcnt = (int*)(ssb + 2 * 4 * 64);
    int* lbase = lcnt + 32;
    unsigned* gcnt = (unsigned*)(p.ws + WS_CTL) + CW_CNT;
    int* row_tok = (int*)(p.ws + WS_RT2); float* row_w = (float*)(p.ws + WS_RT2 + 2 * MiB); int* row_slot = (int*)(p.ws + WS_RT2 + 4 * MiB); float* row_rstd = (float*)(p.ws + WS_RT2 + 6 * MiB);
    const u32x4* GF = (const u32x4*)(p.ws + WS_GF);
    for (int tg = blockIdx.x; tg < NTOK / 64; tg += gridDim.x) {
        if (tid < 32) lcnt[tid] = 0;
        const int token = tg * 64 + tile * 32 + c;
        const bf16_t* xrow = (const bf16_t*)(p.ws + WS_X1B) + (size_t)token * DM + kq * 256 + 8 * h; const float* g2p = p.norm2_g + kq * 256 + 8 * h;
        unsigned char* hrow = p.ws + WS_H8 + (size_t)token * DM + kq * 256 + 8 * h;
        f32x16 acc = {}; float ss = 0.f;
#pragma unroll 2
        for (int s = 0; s < 16; ++s) {
            const u32x4 xh = *(const u32x4*)(xrow + 16 * s); const f32x4 ga = *(const f32x4*)(g2p + 16 * s), gb = *(const f32x4*)(g2p + 16 * s + 4);
            const f32x4 a = {bf_lo(xh.x), bf_hi(xh.x), bf_lo(xh.y), bf_hi(xh.y)}, b = {bf_lo(xh.z), bf_hi(xh.z), bf_lo(xh.w), bf_hi(xh.w)};
            ss += (a[0] * a[0] + a[1] * a[1]) + (a[2] * a[2] + a[3] * a[3]) + (b[0] * b[0] + b[1] * b[1]) + (b[2] * b[2] + b[3] * b[3]);
            u32x2 h8; h8.x = pk4_fp8(a[0] * ga[0], a[1] * ga[1], a[2] * ga[2], a[3] * ga[3]); h8.y = pk4_fp8(b[0] * gb[0], b[1] * gb[1], b[2] * gb[2], b[3] * gb[3]); *(u32x2*)(hrow + 16 * s) = h8;
            const u32x4 gh = GF[((kq * 16 + s) * 2 + 0) * 64 + lane], gl = GF[((kq * 16 + s) * 2 + 1) * 64 + lane];
            acc = __builtin_amdgcn_mfma_f32_32x32x16_bf16(__builtin_bit_cast(bf16x8, gh), __builtin_bit_cast(bf16x8, xh), acc, 0, 0, 0);
            acc = __builtin_amdgcn_mfma_f32_32x32x16_bf16(__builtin_bit_cast(bf16x8, gl), __builtin_bit_cast(bf16x8, xh), acc, 0, 0, 0);
        }
#pragma unroll
        for (int r = 0; r < 16; ++r) red[((tile * 4 + kq) * 16 + r) * 64 + lane] = acc[r];
        ssb[(tile * 4 + kq) * 64 + lane] = ss;
        __syncthreads();
        int te[4] = {0, 0, 0, 0}, rl[4] = {0, 0, 0, 0}; float tw[4] = {0.f, 0.f, 0.f, 0.f}; float rstd = 0.f;
        if (kq == 0) {
            float v[16]; float st = 0.f;
#pragma unroll
            for (int q = 0; q < 4; ++q) st += ssb[(tile * 4 + q) * 64 + lane];
            { auto rr = __builtin_amdgcn_permlane32_swap(__float_as_uint(st), __float_as_uint(st), false, false); st = __uint_as_float(rr[0]) + __uint_as_float(rr[1]); }
            rstd = rsqrtf(st * (1.f / DM) + EPS);
#pragma unroll
            for (int r = 0; r < 16; ++r) { float sacc = 0.f;
#pragma unroll
                for (int q = 0; q < 4; ++q) sacc += red[((tile * 4 + q) * 16 + r) * 64 + lane];
                v[r] = sacc * rstd + p.router_b[crow16(r, h)]; }
            float lv[4]; int le[4];
#pragma unroll
            for (int k = 0; k < 4; ++k) { float best = v[0]; int bi = 0;
#pragma unroll
                for (int r = 1; r < 16; ++r) { const bool gt = v[r] > best; best = gt ? v[r] : best; bi = gt ? r : bi; }
                lv[k] = best; le[k] = (bi & 3) + 8 * (bi >> 2) + 4 * h;
#pragma unroll
                for (int r = 0; r < 16; ++r) v[r] = (r == bi) ? -INFINITY : v[r]; }
            float cv[8]; int ce[8];
#pragma unroll
            for (int k = 0; k < 4; ++k) { auto rv = __builtin_amdgcn_permlane32_swap(__float_as_uint(lv[k]), __float_as_uint(lv[k]), false, false); auto re = __builtin_amdgcn_permlane32_swap((unsigned)le[k], (unsigned)le[k], false, false);
                cv[k] = __uint_as_float(rv[0]); cv[4 + k] = __uint_as_float(rv[1]); ce[k] = (int)re[0]; ce[4 + k] = (int)re[1]; }
            float tv[4];
#pragma unroll
            for (int k = 0; k < 4; ++k) { float best = cv[0]; int be = ce[0]; int bi = 0;
#pragma unroll
                for (int r = 1; r < 8; ++r) { const bool gt = (cv[r] > best) || (cv[r] == best && ce[r] < be); best = gt ? cv[r] : best; be = gt ? ce[r] : be; bi = gt ? r : bi; }
                tv[k] = best; te[k] = be;
#pragma unroll
                for (int r = 0; r < 8; ++r) cv[r] = (r == bi) ? -INFINITY : cv[r]; }
            const float e1 = __expf(tv[1] - tv[0]), e2 = __expf(tv[2] - tv[0]), e3 = __expf(tv[3] - tv[0]); const float inv = 1.f / (1.f + e1 + e2 + e3);
            tw[0] = inv; tw[1] = e1 * inv; tw[2] = e2 * inv; tw[3] = e3 * inv;
            if (h == 0) {
#pragma unroll
                for (int k = 0; k < 4; ++k) rl[k] = atomicAdd(&lcnt[te[k]], 1); }
        }
        __syncthreads();
        if (tid < 32) lbase[tid] = (int)atomicAdd(&gcnt[tid], (unsigned)lcnt[tid]);
        __syncthreads();
        if (kq == 0 && h == 0) {
#pragma unroll
            for (int k = 0; k < 4; ++k) { const int idx = te[k] * CAP + lbase[te[k]] + rl[k]; row_tok[idx] = token; row_w[idx] = tw[k]; row_slot[idx] = token * 4 + k; row_rstd[idx] = rstd; } }
        __syncthreads();
    }
}

__device__ __forceinline__ void build_block_table(const Params& p, int* bs) {
    const unsigned* gcnt = (const unsigned*)(p.ws + WS_CTL) + CW_CNT;
    if (threadIdx.x == 0) { int acc = 0; for (int e = 0; e < NE; ++e) { bs[e] = acc; acc += ((int)__hip_atomic_load(gcnt + e, __ATOMIC_RELAXED, __HIP_MEMORY_SCOPE_AGENT) + 255) >> 8; } bs[NE] = acc; }
    __syncthreads();
}

__device__ __forceinline__ pg8::MoeOrder make_moe_order(const Params& p, unsigned char* lds, int N, bool gather) {
    int* bs = (int*)(lds + 131072); int* utab = (int*)(lds + 131072 + 256); int* gtab = (int*)(lds + 131072 + 512);
    build_block_table(p, bs);
    const int nmb = __builtin_amdgcn_readfirstlane(bs[NE]);
    pg8::MoeOrder S; S.so.init(nmb * 256, N, (int)gridDim.x, (int)blockIdx.x); S.utab = (const PG8_LAS int*)utab; S.gtab = (const PG8_LAS int*)gtab;
    const int* row_tok = (const int*)(p.ws + WS_RT2);
    for (int i = 0; i < pg8::MOE_MAXU; ++i) { pg8::Unit u; if (!S.so.next(i, u)) break; int e = 0; for (int k = 1; k < NE; ++k) if (bs[k] <= u.pm) e = k;
        const int rb = e * CAP + (u.pm - bs[e]) * 256;
        if (threadIdx.x == 0) utab[i] = e | (rb << 8);
        if (gather && threadIdx.x < 256) gtab[i * 256 + threadIdx.x] = row_tok[rb + threadIdx.x]; }
    __syncthreads();
    return S;
}
__device__ __forceinline__ void phase_moe1(const Params& p, unsigned char* lds) {
    const pg8::MoeOrder S = make_moe_order(p, lds, 2048, true);
    pg8::Gemm g{(const bf16_t*)(p.ws + WS_H8), (const bf16_t*)(p.ws + WS_W1), 0, 2048, DM / 2, (size_t)2048 * DM, 0, 0};
    pg8::EpiSwiglu E{p.ws + WS_ACT, p.b1, (const float*)(p.ws + WS_RT2 + 6 * MiB)};
    pg8::gemm_phase<pg8::EpiSwiglu, pg8::MoeOrder, true, true, true, true>((PG8_LAS unsigned char*)lds, g, S, E);
}
__device__ __forceinline__ void phase_moe2(const Params& p, unsigned char* lds) {
    const pg8::MoeOrder S = make_moe_order(p, lds, DM, false);
    pg8::Gemm g{(const bf16_t*)(p.ws + WS_ACT), (const bf16_t*)(p.ws + WS_W2), 0, DM, DFF / 2, (size_t)DM * DFF, 0, 0};
    pg8::EpiMoeOut E{p.ws + WS_YS, p.b2, (const float*)(p.ws + WS_RT2 + 2 * MiB), (const int*)(p.ws + WS_RT2 + 4 * MiB)};
    pg8::gemm_phase<pg8::EpiMoeOut, pg8::MoeOrder, true, true, true>((PG8_LAS unsigned char*)lds, g, S, E);
}

__device__ __forceinline__ float fp8_to_f32(unsigned w, int byte) {
    return byte == 0 ? __builtin_amdgcn_cvt_f32_fp8((int)w, 0) : byte == 1 ? __builtin_amdgcn_cvt_f32_fp8((int)w, 1) : byte == 2 ? __builtin_amdgcn_cvt_f32_fp8((int)w, 2) : __builtin_amdgcn_cvt_f32_fp8((int)w, 3); }
__device__ __forceinline__ void phase_combine(const Params& p) {
    const int tid = threadIdx.x, lane = tid & 63, wave = tid >> 6;
    const int gw = blockIdx.x * NWAVES + wave, NGW = gridDim.x * NWAVES;
    const unsigned char* YS = p.ws + WS_YS;
    for (int t = gw; t < NTOK; t += NGW) {
        f32x4* orow = (f32x4*)(p.out + (size_t)t * DM) + lane; const u32x2* xrow = (const u32x2*)((const bf16_t*)(p.ws + WS_X1B) + (size_t)t * DM) + lane;
        f32x4 v[4]; unsigned w[4][4];
#pragma unroll
        for (int j = 0; j < 4; ++j) { const u32x2 xb = xrow[64 * j]; v[j] = (f32x4){bf_lo(xb.x), bf_hi(xb.x), bf_lo(xb.y), bf_hi(xb.y)};
#pragma unroll
            for (int k = 0; k < 4; ++k) w[j][k] = *((const unsigned*)(YS + ((size_t)t * 4 + k) * DM) + lane + 64 * j); }
#pragma unroll
        for (int j = 0; j < 4; ++j) { f32x4 s = {0.f, 0.f, 0.f, 0.f};
#pragma unroll
            for (int k = 0; k < 4; ++k) { s[0] += fp8_to_f32(w[j][k], 0); s[1] += fp8_to_f32(w[j][k], 1); s[2] += fp8_to_f32(w[j][k], 2); s[3] += fp8_to_f32(w[j][k], 3); }
            orow[64 * j] = v[j] + s * YS_INV; }
    }
}

template <class Epi>
__device__ __forceinline__ void dense_gemm(unsigned char* lds, const bf16_t* A, const bf16_t* Bt, int M, int N, int K, const Epi& E, int lda = 0, int ldb = 0, int cshift = 0) {
    pg8::Gemm g{A, Bt, M, N, K, 0, lda, ldb}; pg8::StaticOrder S; S.init(M, N, (int)gridDim.x, (int)((blockIdx.x + cshift) % gridDim.x));
    pg8::gemm_phase<Epi, pg8::StaticOrder, true, true>((PG8_LAS unsigned char*)lds, g, S, E);
}

constexpr int NPHASE = 13;
__global__ void __launch_bounds__(NTHREADS, 2) mk_fwd(Params p) {
    extern __shared__ __attribute__((aligned(16))) unsigned char lds[];
    cg::grid_group grid = cg::this_grid();
    unsigned char* ws = p.ws;
    volatile LAS unsigned* MISC = (volatile LAS unsigned*)((LAS unsigned char*)lds + MISC_OFF);
    if (threadIdx.x < 32) MISC[threadIdx.x] = 0u;
    __syncthreads();
    XcdBarrier bar = xcd_barrier_post((unsigned*)(ws + WS_CTL) + CW_BAR, MISC + 8);
    const int lo = p.ph_lo, hi = p.ph_hi;
    if (lo < 0) grid.sync();
#define IN(k) (lo <= (k) && (k) < hi)
#define SEAM(k) do { if (IN(k) && IN((k) + 1)) xcd_barrier(bar); } while (0)
    if (IN(0)) phase_prologue(p, lds);
    SEAM(0);
    if (IN(1)) { pg8::EpiProj E{(bf16_t*)(ws + WS_PROJ), (float*)(ws + WS_SSQ)}; dense_gemm(lds, (const bf16_t*)(ws + WS_XN), (const bf16_t*)(ws + WS_WIN), NTOK, INCP, DM, E); }
    if (IN(1) && IN(3)) xcd_barrier(bar);
    if (IN(3)) { const float* ssq = (const float*)(ws + WS_SSQ); const float* cst = (const float*)(ws + WS_CS); float* hs = (float*)(lds + 131072);
                 pg8::EpiQ Eq{ws + WS_Q, ssq, p.q_g, cst, hs}; dense_gemm(lds, (const bf16_t*)(ws + WS_PROJ) + OFF_CQ, (const bf16_t*)(ws + WS_WUQ), NTOK, 1024, QLORA, Eq, INCP);
                 pg8::EpiK Ek{ws + WS_K, ssq, p.k_g, cst, (const bf16_t*)(ws + WS_PROJ), hs, (const float*)(ws + WS_SHIFT)}; dense_gemm(lds, (const bf16_t*)(ws + WS_PROJ) + OFF_CKV, (const bf16_t*)(ws + WS_WUKV), NTOK, 512, KVLORA, Ek, INCP);
                 pg8::EpiVT Ev{ws + WS_V, ssq}; dense_gemm(lds, (const bf16_t*)(ws + WS_WUKV) + 512 * KVLORA, (const bf16_t*)(ws + WS_PROJ) + OFF_CKV, 512, NTOK, KVLORA, Ev, 0, INCP, (int)gridDim.x / 2);
                 phase_conv(p); }
    if (IN(3) && IN(5)) xcd_barrier(bar);
    if (IN(5)) phase_attn(p, lds);
    SEAM(5);
    if (IN(6)) { pg8::EpiGateA E{(bf16_t*)(ws + WS_M1), (const bf16_t*)(ws + WS_PROJ)}; dense_gemm(lds, (const bf16_t*)(ws + WS_AO), (const bf16_t*)(ws + WS_WOMLA), NTOK, DM, 512, E); }
    if (IN(7)) { pg8::EpiGateB E{(const bf16_t*)(ws + WS_M1), (const bf16_t*)(ws + WS_PROJ), (bf16_t*)(ws + WS_MERGED)}; dense_gemm(lds, (const bf16_t*)(ws + WS_YBIN), (const bf16_t*)(ws + WS_WOCONV), NTOK, DM, 512, E); }
    SEAM(7);
    if (IN(8)) { pg8::EpiResid E{p.x, (bf16_t*)(ws + WS_X1B)}; dense_gemm(lds, (const bf16_t*)(ws + WS_MERGED), (const bf16_t*)(ws + WS_WO), NTOK, DM, DM, E); }
    SEAM(8);
    if (IN(9)) { wconv_cleanup(p, lds); phase_router(p, lds); }
    if (IN(9) && IN(11)) xcd_barrier(bar);
    if (IN(11)) phase_moe1(p, lds);
    SEAM(11);
    if (IN(12)) phase_moe2(p, lds);
    SEAM(12);
    if (IN(13)) phase_combine(p);
#undef IN
#undef SEAM
}

extern "C" void kernel_launch(void* const* d_in, const int* in_sizes, int n_in, void* d_out, int out_size,
                              void* d_ws, size_t ws_size, hipStream_t stream) {
    static int grid_blocks = 0;
    if (!grid_blocks) {
        int dev = 0, cus = 0, per_cu = 0;
        (void)hipGetDevice(&dev);
        (void)hipDeviceGetAttribute(&cus, hipDeviceAttributeMultiprocessorCount, dev);
        (void)hipFuncSetAttribute((const void*)mk_fwd, hipFuncAttributeMaxDynamicSharedMemorySize, LDS_BYTES);
        (void)hipOccupancyMaxActiveBlocksPerMultiprocessor(&per_cu, (const void*)mk_fwd, NTHREADS, LDS_BYTES);
        if (per_cu < 1) { fprintf(stderr, "kernel_launch: occupancy query says %d blocks/CU\n", per_cu); per_cu = 1; }
        grid_blocks = cus;
        if (ws_size < WS_END2 || n_in != 21) fprintf(stderr, "kernel_launch: ws %zu < %zu or n_in %d != 21\n", ws_size, (size_t)WS_END2, n_in);
    }
    (void)hipMemsetAsync((char*)d_ws + WS_CTL, 0, 1 * MiB, stream);
    Params p{};
    p.x = (const float*)d_in[0]; p.pos = (const int*)d_in[1]; p.norm1_g = (const float*)d_in[2]; p.w_in = (const float*)d_in[3]; p.q_a_g = (const float*)d_in[4];
    p.kv_a_g = (const float*)d_in[5]; p.w_uq = (const float*)d_in[6]; p.w_ukv = (const float*)d_in[7]; p.q_g = (const float*)d_in[8]; p.k_g = (const float*)d_in[9];
    p.conv_w = (const float*)d_in[10]; p.w_o_mla = (const float*)d_in[11]; p.w_o_conv = (const float*)d_in[12]; p.w_o = (const float*)d_in[13]; p.norm2_g = (const float*)d_in[14];
    p.router_w = (const float*)d_in[15]; p.router_b = (const float*)d_in[16]; p.w1 = (const float*)d_in[17]; p.b1 = (const float*)d_in[18]; p.w2 = (const float*)d_in[19]; p.b2 = (const float*)d_in[20];
    p.out = (float*)d_out; p.ws = (unsigned char*)d_ws; p.ph_lo = 0; p.ph_hi = NPHASE + 1;
    void* args[] = {&p};
    hipError_t e = hipLaunchCooperativeKernel((const void*)mk_fwd, dim3(grid_blocks), dim3(NTHREADS), args, LDS_BYTES, stream);
    if (e != hipSuccess) fprintf(stderr, "cooperative launch failed: %s (grid %d)\n", hipGetErrorString(e), grid_blocks);
}
```

```cpp
#include <hip/hip_runtime.h>
#include <hip/hip_cooperative_groups.h>
#include <cstdio>
#include <cstdint>
namespace cg = cooperative_groups;

typedef unsigned short bf16_t;
typedef short bf16x8 __attribute__((ext_vector_type(8)));
typedef short s16x4 __attribute__((ext_vector_type(4)));
typedef float f32x4 __attribute__((ext_vector_type(4)));
typedef float f32x2 __attribute__((ext_vector_type(2)));
typedef float f32x16 __attribute__((ext_vector_type(16)));
typedef unsigned u32x4 __attribute__((ext_vector_type(4)));
typedef unsigned u32x2 __attribute__((ext_vector_type(2)));
typedef __bf16 bf16x2_t __attribute__((ext_vector_type(2)));

constexpr int NTOK = 16384, DM = 1024, SEQ = 8192;
constexpr int INC = 4000, INCP = 4096;
constexpr int OFF_CQ = 0, OFF_CKV = 256, OFF_KR = 384, OFF_U = 416, OFF_C = 928, OFF_B = 1440, OFF_GA = 1952, OFF_GB = 2976;
constexpr int NH = 8, DQK = 96, DV = 64, NE = 32, TOPK = 4, DFF = 1024;
constexpr int QLORA = 256, KVLORA = 128, CONVW = 512;
constexpr int NPAIR = NTOK * TOPK;
constexpr int MAXROWS = 73728;
constexpr float EPS = 1e-6f;
constexpr float QSCALE = 0.10206207261596575f * 1.4426950408889634f;
constexpr int CAP = 16384;
constexpr int NTHREADS = 512, NWAVES = 8;
constexpr int LDS_BYTES = 147456;

constexpr size_t MiB = 1ull << 20;
constexpr size_t WS_CTL = 0;
constexpr size_t WS_WIN = 1 * MiB;
constexpr size_t WS_WUQ = 9 * MiB;
constexpr size_t WS_WUKV = WS_WUQ + 512 * 1024;
constexpr size_t WS_WOMLA = 10 * MiB;
constexpr size_t WS_WOCONV = 11 * MiB;
constexpr size_t WS_WO = 12 * MiB;
constexpr size_t WS_ROUTE = 14 * MiB;
constexpr size_t WS_W1 = 18 * MiB;
constexpr size_t WS_W2 = 146 * MiB;
constexpr size_t WS_XN = 210 * MiB;
constexpr size_t WS_PROJ = 242 * MiB;
constexpr size_t WS_CQN = 370 * MiB;
constexpr size_t WS_CKVN = 378 * MiB;
constexpr size_t WS_YBIN = 386 * MiB;
constexpr size_t WS_QPRE = 402 * MiB;
constexpr size_t WS_KVPRE = 450 * MiB;
constexpr size_t WS_Q = 514 * MiB;
constexpr size_t WS_K = 538 * MiB;
constexpr size_t WS_V = 570 * MiB;
constexpr size_t WS_AO = 586 * MiB;
constexpr size_t WS_M1 = 602 * MiB;
constexpr size_t WS_MERGED = 666 * MiB;
constexpr size_t WS_YS = 698 * MiB;
constexpr size_t WS_END = 826 * MiB;
constexpr size_t WS_ACT = WS_PROJ;
constexpr size_t WS_X1B = WS_M1;
constexpr size_t WS_H8 = WS_XN;
constexpr size_t WS_GF = 830 * MiB;
constexpr size_t WS_RT2 = 832 * MiB;
constexpr size_t WS_SSQ = 840 * MiB;
constexpr size_t WS_CS = 841 * MiB;
constexpr size_t WS_SHIFT = 843 * MiB;
constexpr size_t WS_END2 = 844 * MiB;
constexpr size_t RT_PAIR_E = 0, RT_PAIR_RANK = 262144, RT_PAIR_W = 524288, RT_ROW_TOK = 786432, RT_ROW_W = 786432 + 294912, RT_ROW_SLOT = 786432 + 2 * 294912;
constexpr int CW_CNT = 64;
constexpr int CW_BAR = 4096;
constexpr int MISC_OFF = LDS_BYTES - 256;

struct Params {
    const float* x; const int* pos; const float* norm1_g; const float* w_in; const float* q_a_g; const float* kv_a_g;
    const float* w_uq; const float* w_ukv; const float* q_g; const float* k_g; const float* conv_w; const float* w_o_mla;
    const float* w_o_conv; const float* w_o; const float* norm2_g; const float* router_w; const float* router_b;
    const float* w1; const float* b1; const float* w2; const float* b2;
    float* out; unsigned char* ws; int ph_lo, ph_hi;
};

__device__ __forceinline__ unsigned pk2(float lo, float hi) { f32x2 v = {lo, hi}; bf16x2_t b = __builtin_convertvector(v, bf16x2_t); return __builtin_bit_cast(unsigned, b); }
__device__ __forceinline__ float bf_lo(unsigned w) { return __uint_as_float(w << 16); }
__device__ __forceinline__ float bf_hi(unsigned w) { return __uint_as_float(w & 0xffff0000u); }
__device__ __forceinline__ float bf1(bf16_t h) { return __uint_as_float((unsigned)h << 16); }
__device__ __forceinline__ float wave_sum(float v) {
#pragma unroll
    for (int o = 1; o < 64; o <<= 1) v += __shfl_xor(v, o);
    return v;
}
__device__ __forceinline__ unsigned pk4_fp8(float a, float b, float c, float d) { unsigned w = 0u; w = (unsigned)__builtin_amdgcn_cvt_pk_fp8_f32(a, b, (int)w, false); w = (unsigned)__builtin_amdgcn_cvt_pk_fp8_f32(c, d, (int)w, true); return w; }
constexpr float Q8_SCALE = 4.f, K8_SCALE = 0.25f;
constexpr float W8_SCALE = 32.f, W8_INV = 1.f / 32.f, YS_SCALE = 8.f, YS_INV = 0.125f;
__device__ __forceinline__ float sigmoidf_(float v) { return __builtin_amdgcn_rcpf(1.f + __builtin_amdgcn_exp2f(v * -1.4426950408889634f)); }

namespace pg8 {
#define PG8_LAS __attribute__((address_space(3)))
constexpr int BM = 256, BK = 64, HALF = 128, HTB = HALF * BK * 2  , STAGE_BYTES = 8 * HTB, NXCD = 8, WGM = 8;

__host__ __device__ __forceinline__ int lds_byte(int r, int c) { const int st = (r >> 4) * 2 + (c >> 5), rr = r & 15, cc = c & 31, ob = rr * 64 + cc * 2; return st * 1024 + (ob ^ (((ob >> 9) & 1) << 5)); }
__host__ __device__ __forceinline__ void stage_rc(int b, int& R, int& C) { const int st = b / 1024, sb = b % 1024, swz = sb ^ (((sb >> 9) & 1) << 5); R = (st >> 1) * 16 + swz / 64; C = (st & 1) * 32 + (swz % 64) / 2; }
__host__ __device__ __forceinline__ int perm32(int rho) { const int n = rho >> 4, i = rho & 15; return 8 * (i >> 2) + 4 * n + (i & 3); }

struct Unit { int pm, pn, e, rb; };
struct Gemm { const bf16_t* A; const bf16_t* Bt; int M, N, K; size_t bstride; int lda, ldb; };

struct StaticOrder {
    int nM, nN, nwg, G, c;
    __host__ __device__ void init(int M, int N, int G_, int c_) { nM = M / BM; nN = N / BM; nwg = nM * nN; G = G_; c = c_; }
    __host__ __device__ bool next(int i, Unit& u) const {
        const long L = (long)i * G + c; if (L >= nwg) return false;
        int wgid = (int)L; { const int q = nwg / NXCD, r = nwg % NXCD, xcd = wgid % NXCD, off = wgid / NXCD; wgid = (xcd < r ? xcd * (q + 1) : r * (q + 1) + (xcd - r) * q) + off; }
        const int nig = WGM * nN, gid = wgid / nig, fm = gid * WGM, gsz = (nM - fm) < WGM ? (nM - fm) : WGM;
        u.pm = fm + ((wgid % nig) % gsz); u.pn = (wgid % nig) / gsz; u.e = 0; u.rb = 0; return true;
    }
    __device__ __forceinline__ void a_ready(const Unit&) const {}
    __device__ __forceinline__ void done(const Unit&) const {}
};


struct EpiProj {
    static constexpr bool PERM = true, AFTER_DRAIN = false;
    bf16_t* O; float* ssq;
    __device__ __forceinline__ void operator()(const f32x4 (&acc)[2][2][4][2], const Unit& u, int wr, int wc, int fr, int fq) const {
        const int row0 = u.pm * BM + wr * 64 + fr, col0 = u.pn * BM + wc * 32 + 8 * fq;
#pragma unroll
        for (int ai = 0; ai < 2; ++ai)
#pragma unroll
            for (int m = 0; m < 4; ++m) { const int row = row0 + ai * HALF + m * 16; bf16_t* rowp = O + (size_t)row * INCP + col0;
#pragma unroll
                for (int bj = 0; bj < 2; ++bj) { f32x4 v0 = acc[ai][bj][m][0], v1 = acc[ai][bj][m][1]; const int col = col0 + bj * HALF;
                    if (col >= OFF_GA && col < INC) {
#pragma unroll
                        for (int j = 0; j < 4; ++j) { v0[j] = sigmoidf_(v0[j]); v1[j] = sigmoidf_(v1[j]); } }
                    u32x4 w; w.x = pk2(v0[0], v0[1]); w.y = pk2(v0[2], v0[3]); w.z = pk2(v1[0], v1[1]); w.w = pk2(v1[2], v1[3]);
                    *(u32x4*)(rowp + bj * HALF) = w;
                    const int which = u.pn == 0 ? 0 : (u.pn == 1 ? (bj == 0 ? 1 : (wc == 0 ? 2 : -1)) : -1);
                    if (which >= 0) { float s = (v0[0] * v0[0] + v0[1] * v0[1]) + (v0[2] * v0[2] + v0[3] * v0[3]) + (v1[0] * v1[0] + v1[1] * v1[1]) + (v1[2] * v1[2] + v1[3] * v1[3]);
                        s += __shfl_xor(s, 16); s += __shfl_xor(s, 32); if (fq == 0) ssq[(size_t)row * 16 + (which == 0 ? wc * 2 + bj : (which == 1 ? 8 + wc : 12))] = s; } } }
    }
};
struct EpiBf16 {
    static constexpr bool PERM = true, AFTER_DRAIN = false;
    bf16_t* O; int ldc;
    __device__ __forceinline__ void operator()(const f32x4 (&acc)[2][2][4][2], const Unit& u, int wr, int wc, int fr, int fq) const {
        const int row0 = u.pm * BM + wr * 64 + fr, col0 = u.pn * BM + wc * 32 + 8 * fq;
#pragma unroll
        for (int ai = 0; ai < 2; ++ai)
#pragma unroll
            for (int m = 0; m < 4; ++m) { bf16_t* rowp = O + (size_t)(row0 + ai * HALF + m * 16) * ldc + col0;
#pragma unroll
                for (int bj = 0; bj < 2; ++bj) { const f32x4 v0 = acc[ai][bj][m][0], v1 = acc[ai][bj][m][1];
                    u32x4 w; w.x = pk2(v0[0], v0[1]); w.y = pk2(v0[2], v0[3]); w.z = pk2(v1[0], v1[1]); w.w = pk2(v1[2], v1[3]); *(u32x4*)(rowp + bj * HALF) = w; } }
    }
};
__device__ __forceinline__ void epi_bar() { asm volatile("s_waitcnt lgkmcnt(0)" ::: "memory"); __builtin_amdgcn_s_barrier(); asm volatile("" ::: "memory"); }
__device__ __forceinline__ u32x2 pk4bf(const f32x4 v) { u32x2 w; w.x = pk2(v[0], v[1]); w.y = pk2(v[2], v[3]); return w; }
struct EpiQ {
    static constexpr bool PERM = false, AFTER_DRAIN = false;
    unsigned char* Q; const float* ssq_cq; const float* qg; const float* cs; float* hs;
    __device__ __forceinline__ void operator()(f32x4 (&acc)[2][2][4][2], const Unit& u, int wr, int wc, int fr, int fq) const {
        int lr0 = wr * 64 + fr; asm volatile("" : "+v"(lr0), "+v"(fq));
        const int t0 = u.pm * BM + lr0;
#pragma unroll
        for (int ai = 0; ai < 2; ++ai)
#pragma unroll
            for (int m = 0; m < 4; ++m) { const f32x4 sa = *(const f32x4*)(ssq_cq + (size_t)(t0 + ai * HALF + m * 16) * 16), sb = *(const f32x4*)(ssq_cq + (size_t)(t0 + ai * HALF + m * 16) * 16 + 4);
                const float rq = rsqrtf((((sa[0] + sa[1]) + (sa[2] + sa[3])) + ((sb[0] + sb[1]) + (sb[2] + sb[3]))) * (1.f / QLORA) + EPS);
#pragma unroll
                for (int bj = 0; bj < 2; ++bj) { const f32x4 x0 = acc[ai][bj][m][0] * rq, x1 = acc[ai][bj][m][1] * rq; acc[ai][bj][m][0] = x0; acc[ai][bj][m][1] = x1;
                    float s = (x0[0] * x0[0] + x0[1] * x0[1]) + (x0[2] * x0[2] + x0[3] * x0[3]) + (x1[0] * x1[0] + x1[1] * x1[1]) + (x1[2] * x1[2] + x1[3] * x1[3]);
                    s += __shfl_xor(s, 16); s += __shfl_xor(s, 32); if (fq == 0) hs[((lr0 + ai * HALF + m * 16) * 2 + bj) * 4 + wc] = s; } }
        epi_bar();
        {
            f32x4 g0 = {0.f, 0.f, 0.f, 0.f}, g1 = g0; if (wc < 3) { g0 = *(const f32x4*)(qg + 32 * wc + 4 * fq); g1 = *(const f32x4*)(qg + 32 * wc + 16 + 4 * fq); }
#pragma unroll
            for (int ai = 0; ai < 2; ++ai)
#pragma unroll
                for (int m = 0; m < 4; ++m) { const int lr = lr0 + ai * HALF + m * 16, t = u.pm * BM + lr, b = t >> 13, s = t & (SEQ - 1);
                    f32x4 c4 = {0.f, 0.f, 0.f, 0.f}, s4 = {0.f, 0.f, 0.f, 0.f}; if (wc == 2) { c4 = *(const f32x4*)(cs + (size_t)t * 32 + 4 * fq); s4 = *(const f32x4*)(cs + (size_t)t * 32 + 16 + 4 * fq); }
#pragma unroll
                    for (int bj = 0; bj < 2; ++bj) { const f32x4 h4 = *(const f32x4*)(hs + (lr * 2 + bj) * 4); const float rstd = rsqrtf(((h4[0] + h4[1]) + h4[2]) * (1.f / DQK) + EPS) * (QSCALE * Q8_SCALE); f32x4 x0 = acc[ai][bj][m][0] * rstd * g0, x1 = acc[ai][bj][m][1] * rstd * g1;
                        if (wc == 2) { const f32x4 o0 = x0 * c4 - x1 * s4, o1 = x0 * s4 + x1 * c4; x0 = o0; x1 = o1; }
                        if (wc == 3 && fq == 0) x0[0] = Q8_SCALE;
                        unsigned char* qp = Q + ((size_t)(b * NH + 2 * u.pn + bj) * SEQ + s) * 128 + 32 * wc + 4 * fq; *(unsigned*)qp = pk4_fp8(x0[0], x0[1], x0[2], x0[3]); *(unsigned*)(qp + 16) = pk4_fp8(x1[0], x1[1], x1[2], x1[3]); }
                    asm volatile("" ::: "memory"); }
        }
    }
};
struct EpiK {
    static constexpr bool PERM = false, AFTER_DRAIN = false;
    unsigned char* K; const float* ssq; const float* kg; const float* cs; const bf16_t* proj; float* hs; const float* shiftp;
    __device__ __forceinline__ void operator()(f32x4 (&acc)[2][2][4][2], const Unit& u, int wr, int wc, int fr, int fq) const {
        int lr0 = wr * 64 + fr; asm volatile("" : "+v"(lr0), "+v"(fq));
        const int t0 = u.pm * BM + lr0, wp = wc & 1, wh = wc >> 1;
#pragma unroll
        for (int ai = 0; ai < 2; ++ai)
#pragma unroll
            for (int m = 0; m < 4; ++m) { const f32x4 sa = *(const f32x4*)(ssq + (size_t)(t0 + ai * HALF + m * 16) * 16 + 8); const float rk = rsqrtf(((sa[0] + sa[1]) + (sa[2] + sa[3])) * (1.f / KVLORA) + EPS);
#pragma unroll
                for (int bj = 0; bj < 2; ++bj) { const f32x4 x0 = acc[ai][bj][m][0] * rk, x1 = acc[ai][bj][m][1] * rk; acc[ai][bj][m][0] = x0; acc[ai][bj][m][1] = x1;
                    float s = (x0[0] * x0[0] + x0[1] * x0[1]) + (x0[2] * x0[2] + x0[3] * x0[3]) + (x1[0] * x1[0] + x1[1] * x1[1]) + (x1[2] * x1[2] + x1[3] * x1[3]);
                    s += __shfl_xor(s, 16); s += __shfl_xor(s, 32); if (fq == 0) hs[((lr0 + ai * HALF + m * 16) * 4 + 2 * bj + wh) * 2 + wp] = s; } }
        epi_bar();
        const f32x4 g0 = *(const f32x4*)(kg + 32 * wp + 4 * fq), g1 = *(const f32x4*)(kg + 32 * wp + 16 + 4 * fq);
        f32x4 gr0 = {0.f, 0.f, 0.f, 0.f}, gr1 = gr0; if (wp == 1) { gr0 = *(const f32x4*)(kg + 64 + 4 * fq); gr1 = *(const f32x4*)(kg + 80 + 4 * fq); }
        const unsigned kpad = (fq == 0) ? pk4_fp8(-shiftp[0] * K8_SCALE, 0.f, 0.f, 0.f) : 0u;
#pragma unroll
        for (int ai = 0; ai < 2; ++ai)
#pragma unroll
            for (int m = 0; m < 4; ++m) { const int lr = lr0 + ai * HALF + m * 16, t = u.pm * BM + lr, b = t >> 13, s = t & (SEQ - 1); const float skr = ssq[(size_t)t * 16 + 12];
                f32x4 c4 = {0.f, 0.f, 0.f, 0.f}, s4 = c4, r1 = c4, r2 = c4;
                if (wp == 1) { c4 = *(const f32x4*)(cs + (size_t)t * 32 + 4 * fq); s4 = *(const f32x4*)(cs + (size_t)t * 32 + 16 + 4 * fq);
                    const u32x2 a = *(const u32x2*)(proj + (size_t)t * INCP + OFF_KR + 4 * fq), bb = *(const u32x2*)(proj + (size_t)t * INCP + OFF_KR + 16 + 4 * fq);
                    r1 = (f32x4){bf_lo(a.x), bf_hi(a.x), bf_lo(a.y), bf_hi(a.y)} * gr0; r2 = (f32x4){bf_lo(bb.x), bf_hi(bb.x), bf_lo(bb.y), bf_hi(bb.y)} * gr1; }
#pragma unroll
                for (int bj = 0; bj < 2; ++bj) { const size_t rowi = (size_t)(b * NH + 4 * u.pn + 2 * bj + wh) * SEQ + s; const f32x2 h2 = *(const f32x2*)(hs + (lr * 4 + 2 * bj + wh) * 2);
                    const float rstd = rsqrtf(((h2[0] + h2[1]) + skr) * (1.f / DQK) + EPS) * K8_SCALE;
                    unsigned char* kp = K + rowi * 128; const f32x4 y0 = acc[ai][bj][m][0] * rstd * g0, y1 = acc[ai][bj][m][1] * rstd * g1;
                    *(unsigned*)(kp + 32 * wp + 4 * fq) = pk4_fp8(y0[0], y0[1], y0[2], y0[3]); *(unsigned*)(kp + 32 * wp + 16 + 4 * fq) = pk4_fp8(y1[0], y1[1], y1[2], y1[3]);
                    if (wp == 1) { const f32x4 x1 = r1 * rstd, x2 = r2 * rstd, z1 = x1 * c4 - x2 * s4, z2 = x1 * s4 + x2 * c4; *(unsigned*)(kp + 64 + 4 * fq) = pk4_fp8(z1[0], z1[1], z1[2], z1[3]); *(unsigned*)(kp + 80 + 4 * fq) = pk4_fp8(z2[0], z2[1], z2[2], z2[3]); }
                    else { *(u32x2*)(kp + 96 + 8 * fq) = (u32x2){kpad, 0u}; } }
                asm volatile("" ::: "memory"); }
    }
};
struct EpiVT {
    static constexpr bool PERM = true, AFTER_DRAIN = false;
    unsigned char* VT; const float* ssq;
    __device__ __forceinline__ void operator()(f32x4 (&acc)[2][2][4][2], const Unit& u, int wr, int wc, int fr, int fq) const {
        int tok0 = u.pn * BM + wc * 32 + 8 * fq; asm volatile("" : "+v"(tok0), "+v"(fr));
        float rs[2][8];
#pragma unroll
        for (int bj = 0; bj < 2; ++bj)
#pragma unroll
            for (int i = 0; i < 8; ++i) { const f32x4 sa = *(const f32x4*)(ssq + (size_t)(tok0 + bj * HALF + i) * 16 + 8); rs[bj][i] = rsqrtf(((sa[0] + sa[1]) + (sa[2] + sa[3])) * (1.f / KVLORA) + EPS); }
#pragma unroll
        for (int ai = 0; ai < 2; ++ai)
#pragma unroll
            for (int m = 0; m < 4; ++m) { const int row = u.pm * BM + ai * HALF + wr * 64 + m * 16 + fr, h = row >> 6, d = row & 63;
#pragma unroll
                for (int bj = 0; bj < 2; ++bj) { const int tok = tok0 + bj * HALF, b = tok >> 13, s = tok & (SEQ - 1); const f32x4 v0 = acc[ai][bj][m][0], v1 = acc[ai][bj][m][1];
                    const int k0 = s & 63, j0 = 4 * ((k0 >> 3) & 3) + 16 * (k0 >> 5), r32v = d & 31, off = (j0 & 15) + 16 * ((j0 >> 4) ^ ((r32v >> 3) & 1));
                    unsigned char* tp = VT + ((size_t)(b * NH + h) * (SEQ / 64) + (s >> 6)) * 4096 + (((d >> 5) * 32 + r32v) << 5) + off;
                    *(unsigned*)tp = pk4_fp8(v0[0] * rs[bj][0], v0[1] * rs[bj][1], v0[2] * rs[bj][2], v0[3] * rs[bj][3]);
                    *(unsigned*)(tp + 2048) = pk4_fp8(v1[0] * rs[bj][4], v1[1] * rs[bj][5], v1[2] * rs[bj][6], v1[3] * rs[bj][7]); } }
    }
};
struct EpiF32 {
    static constexpr bool PERM = false, AFTER_DRAIN = false;
    float* O; int ldc;
    __device__ __forceinline__ void operator()(const f32x4 (&acc)[2][2][4][2], const Unit& u, int wr, int wc, int fr, int fq) const {
        const int row0 = u.pm * BM + wr * 64 + fr, col0 = u.pn * BM + wc * 32 + 4 * fq;
#pragma unroll
        for (int ai = 0; ai < 2; ++ai)
#pragma unroll
            for (int m = 0; m < 4; ++m) { float* rowp = O + (size_t)(row0 + ai * HALF + m * 16) * ldc + col0;
#pragma unroll
                for (int bj = 0; bj < 2; ++bj)
#pragma unroll
                    for (int n = 0; n < 2; ++n) *(f32x4*)(rowp + bj * HALF + n * 16) = acc[ai][bj][m][n]; }
    }
};
__device__ __forceinline__ void unpack8(const u32x4 g, float (&f)[8]) { f[0] = bf_lo(g.x); f[1] = bf_hi(g.x); f[2] = bf_lo(g.y); f[3] = bf_hi(g.y); f[4] = bf_lo(g.z); f[5] = bf_hi(g.z); f[6] = bf_lo(g.w); f[7] = bf_hi(g.w); }
struct EpiGateA {
    static constexpr bool PERM = true, AFTER_DRAIN = false;
    bf16_t* M1; const bf16_t* proj;
    __device__ __forceinline__ void operator()(const f32x4 (&acc)[2][2][4][2], const Unit& u, int wr, int wc, int fr, int fq) const {
        const int row0 = u.pm * BM + wr * 64 + fr, col0 = u.pn * BM + wc * 32 + 8 * fq;
#pragma unroll
        for (int ai = 0; ai < 2; ++ai)
#pragma unroll
            for (int m = 0; m < 4; ++m) { const size_t row = (size_t)(row0 + ai * HALF + m * 16);
#pragma unroll
                for (int bj = 0; bj < 2; ++bj) { const int col = col0 + bj * HALF; float g[8]; unpack8(*(const u32x4*)(proj + row * INCP + OFF_GA + col), g);
                    const f32x4 v0 = acc[ai][bj][m][0], v1 = acc[ai][bj][m][1];
                    u32x4 w; w.x = pk2(v0[0] * g[0], v0[1] * g[1]); w.y = pk2(v0[2] * g[2], v0[3] * g[3]); w.z = pk2(v1[0] * g[4], v1[1] * g[5]); w.w = pk2(v1[2] * g[6], v1[3] * g[7]);
                    *(u32x4*)(M1 + row * DM + col) = w; } }
    }
};
struct EpiGateB {
    static constexpr bool PERM = true, AFTER_DRAIN = false;
    const bf16_t* M1; const bf16_t* proj; bf16_t* O;
    __device__ __forceinline__ void operator()(const f32x4 (&acc)[2][2][4][2], const Unit& u, int wr, int wc, int fr, int fq) const {
        const int row0 = u.pm * BM + wr * 64 + fr, col0 = u.pn * BM + wc * 32 + 8 * fq;
#pragma unroll
        for (int ai = 0; ai < 2; ++ai)
#pragma unroll
            for (int m = 0; m < 4; ++m) { const size_t row = (size_t)(row0 + ai * HALF + m * 16);
#pragma unroll
                for (int bj = 0; bj < 2; ++bj) { const int col = col0 + bj * HALF; float g[8], b[8]; unpack8(*(const u32x4*)(proj + row * INCP + OFF_GB + col), g); unpack8(*(const u32x4*)(M1 + row * DM + col), b);
                    const f32x4 v0 = acc[ai][bj][m][0], v1 = acc[ai][bj][m][1];
                    u32x4 w; w.x = pk2(b[0] + v0[0] * g[0], b[1] + v0[1] * g[1]); w.y = pk2(b[2] + v0[2] * g[2], b[3] + v0[3] * g[3]);
                    w.z = pk2(b[4] + v1[0] * g[4], b[5] + v1[1] * g[5]); w.w = pk2(b[6] + v1[2] * g[6], b[7] + v1[3] * g[7]);
                    *(u32x4*)(O + row * DM + col) = w; } }
    }
};
struct EpiResid {
    static constexpr bool PERM = false, AFTER_DRAIN = false;
    const float* X; bf16_t* O;
    __device__ __forceinline__ void operator()(const f32x4 (&acc)[2][2][4][2], const Unit& u, int wr, int wc, int fr, int fq) const {
        const int row0 = u.pm * BM + wr * 64 + fr, col0 = u.pn * BM + wc * 32 + 4 * fq;
#pragma unroll
        for (int ai = 0; ai < 2; ++ai)
#pragma unroll
            for (int m = 0; m < 4; ++m) { const size_t off = (size_t)(row0 + ai * HALF + m * 16) * DM + col0;
#pragma unroll
                for (int bj = 0; bj < 2; ++bj)
#pragma unroll
                    for (int n = 0; n < 2; ++n) { const f32x4 b = *(const f32x4*)(X + off + bj * HALF + n * 16) + acc[ai][bj][m][n]; u32x2 w; w.x = pk2(b[0], b[1]); w.y = pk2(b[2], b[3]); *(u32x2*)(O + off + bj * HALF + n * 16) = w; } }
    }
};
struct EpiSwiglu {
    static constexpr bool PERM = true, AFTER_DRAIN = false;
    unsigned char* ACT; const float* b1; const float* row_rstd;
    __device__ __forceinline__ void operator()(const f32x4 (&acc)[2][2][4][2], const Unit& u, int wr, int wc, int fr, int fq) const {
        const int row0 = u.pm * BM + wr * 64 + fr, f0 = u.pn * HALF + wc * 32 + 8 * fq; const float* be = b1 + (size_t)u.e * 2048;
        const f32x4 bg0 = *(const f32x4*)(be + f0), bg1 = *(const f32x4*)(be + f0 + 4), bu0 = *(const f32x4*)(be + DFF + f0), bu1 = *(const f32x4*)(be + DFF + f0 + 4);
        float rsv[8];
#pragma unroll
        for (int i = 0; i < 8; ++i) rsv[i] = row_rstd[u.rb + wr * 64 + fr + (i >> 2) * HALF + (i & 3) * 16] * W8_INV;
#pragma unroll
        for (int ai = 0; ai < 2; ++ai)
#pragma unroll
            for (int m = 0; m < 4; ++m) { const size_t row = (size_t)(row0 + ai * HALF + m * 16); float o[8]; const float rs = rsv[ai * 4 + m];
#pragma unroll
                for (int n = 0; n < 2; ++n) { const f32x4 g4 = acc[ai][0][m][n] * rs + (n ? bg1 : bg0), u4 = acc[ai][1][m][n] * rs + (n ? bu1 : bu0);
#pragma unroll
                    for (int j = 0; j < 4; ++j) { const float g = fminf(g4[j], 7.f), uu = fminf(fmaxf(u4[j], -7.f), 7.f); o[4 * n + j] = (uu + 1.f) * (g * sigmoidf_(1.702f * g)); } }
                u32x2 w; w.x = pk4_fp8(o[0], o[1], o[2], o[3]); w.y = pk4_fp8(o[4], o[5], o[6], o[7]); *(u32x2*)(ACT + row * DFF + f0) = w; }
    }
};
struct EpiMoeOut {
    static constexpr bool PERM = true, AFTER_DRAIN = false;
    unsigned char* YS; const float* b2; const float* row_w; const int* row_slot;
    __device__ __forceinline__ void operator()(const f32x4 (&acc)[2][2][4][2], const Unit& u, int wr, int wc, int fr, int fq) const {
        const int col0 = u.pn * BM + wc * 32 + 8 * fq; const float* be = b2 + (size_t)u.e * DM; const int rbase = u.rb + wr * 64 + fr;
        int slot[8]; float w[8];
#pragma unroll
        for (int i = 0; i < 8; ++i) { const int row = rbase + (i >> 2) * HALF + (i & 3) * 16; slot[i] = row_slot[row]; w[i] = row_w[row] * (W8_INV * YS_SCALE); }
        f32x4 bv[2][2];
#pragma unroll
        for (int bj = 0; bj < 2; ++bj)
#pragma unroll
            for (int n = 0; n < 2; ++n) bv[bj][n] = *(const f32x4*)(be + col0 + bj * HALF + 4 * n) * W8_SCALE;
#pragma unroll
        for (int ai = 0; ai < 2; ++ai)
#pragma unroll
            for (int m = 0; m < 4; ++m) { const int i = ai * 4 + m;
                if (slot[i] >= 0) { unsigned char* rowp = YS + (size_t)slot[i] * DM + col0;
#pragma unroll
                    for (int bj = 0; bj < 2; ++bj) { const f32x4 v0 = (acc[ai][bj][m][0] + bv[bj][0]) * w[i], v1 = (acc[ai][bj][m][1] + bv[bj][1]) * w[i];
                        u32x2 o; o.x = pk4_fp8(v0[0], v0[1], v0[2], v0[3]); o.y = pk4_fp8(v1[0], v1[1], v1[2], v1[3]); *(u32x2*)(rowp + bj * HALF) = o; } } }
    }
};
constexpr int MOE_MAXU = 12;
struct MoeOrder {
    StaticOrder so; const PG8_LAS int* utab; const PG8_LAS int* gtab;
    __device__ __forceinline__ bool next(int i, Unit& u) const { if (i >= MOE_MAXU || !so.next(i, u)) return false; const int v = __builtin_amdgcn_readfirstlane(utab[i]); u.e = v & 31; u.rb = (int)((unsigned)v >> 8); return true; }
    __device__ __forceinline__ void a_ready(const Unit&) const {}
    __device__ __forceinline__ void done(const Unit&) const {}
};
typedef int i32x4_t __attribute__((ext_vector_type(4))); typedef int i32x8_t __attribute__((ext_vector_type(8)));
__device__ __forceinline__ i32x8_t cat8(bf16x8 lo, bf16x8 hi) { return __builtin_shufflevector(__builtin_bit_cast(i32x4_t, lo), __builtin_bit_cast(i32x4_t, hi), 0, 1, 2, 3, 4, 5, 6, 7); }
__device__ __forceinline__ void mfma_fp8_inplace(f32x4& c, const i32x8_t a, const i32x8_t b) { asm volatile("s_nop 1\n\tv_mfma_f32_16x16x128_f8f6f4 %0, %1, %2, %0" : "+v"(c) : "v"(a), "v"(b)); }
__device__ __forceinline__ void mfma_fp8_drain() { asm volatile("s_nop 15\n\ts_nop 7" ::: "memory"); __builtin_amdgcn_sched_barrier(0); }
template <class Epi, class Sched, bool ALIGN_EPI = false, bool SP2 = false, bool FP8 = false, bool GATHER = false>
__device__ __forceinline__ void gemm_phase(PG8_LAS unsigned char* lds, const Gemm g, const Sched& S, const Epi& E) {
    int tid = threadIdx.x; asm volatile("" : "+v"(tid));
    const int wid = __builtin_amdgcn_readfirstlane(tid >> 6), lane = tid & 63, wr = wid >> 2, wc = wid & 3, fr = lane & 15, fq = lane >> 4;
    const int K = g.K, nt = K / BK;
    static_assert(!GATHER || SP2, "GATHER is implemented for the SP2 loop only");
    const unsigned rowA = (unsigned)(g.lda ? g.lda : K) * 2u, rowB = (unsigned)(g.ldb ? g.ldb : K) * 2u;
    unsigned voffA[2], voffB[2]; int gR0 = 0; unsigned gC = 0u;
#pragma unroll
    for (int i = 0; i < 2; ++i) { int R, C; stage_rc(tid * 16 + i * 8192, R, C); const int Rb = Epi::PERM ? ((R & ~31) + perm32(R & 31)) : R;
        voffA[i] = (unsigned)R * rowA + (unsigned)C * 2u; voffB[i] = (unsigned)Rb * rowB + (unsigned)C * 2u; if (i == 0) { gR0 = R; gC = (unsigned)C * 2u; } }
    unsigned gA[2][2] = {{0u, 0u}, {0u, 0u}}, ngA[2][2] = {{0u, 0u}, {0u, 0u}};
#define PG8_GLOAD(dst, ui_) do { _Pragma("unroll") for (int h_ = 0; h_ < 2; ++h_) _Pragma("unroll") for (int i_ = 0; i_ < 2; ++i_) \
        dst[h_][i_] = (unsigned)S.gtab[(ui_) * 256 + 128 * h_ + gR0 + 64 * i_] * rowA + gC; } while (0)
#define PG8_VA(h) (GATHER ? gA[h] : voffA)
    const unsigned kstep = (unsigned)(BK * 2);
    const unsigned hstep = (unsigned)HALF * rowB;
    const unsigned tstep = 2u * hstep;
    const unsigned hstepA = (unsigned)HALF * rowA, tstepA = 2u * hstepA;
    const unsigned hsA = GATHER ? 0u : hstepA;
    const unsigned ldsw = (unsigned)wid * 1024u;
    const int aoff = lds_byte(wr * 64 + fr, fq * 8), boff = lds_byte(wc * 32 + fr, fq * 8);
#define PG8_SA(b, h) (((b) * 2 + (h)) * HTB)
#define PG8_SB(b, h) ((4 + (b) * 2 + (h)) * HTB)
#define PG8_STAGE(rs, bufoff, goff, voff) do { _Pragma("unroll") for (int _i = 0; _i < 2; ++_i) \
        __builtin_amdgcn_raw_ptr_buffer_load_lds(rs, (PG8_LAS void*)(lds + (bufoff) + ldsw + _i * 8192), 16, (int)(voff)[_i], (int)(goff), 0, 0); } while (0)
#define PG8_LDA(dst, b, h) do { _Pragma("unroll") for (int m = 0; m < 4; ++m) _Pragma("unroll") for (int k = 0; k < 2; ++k) dst[m][k] = *(const PG8_LAS bf16x8*)(lds + PG8_SA(b, h) + aoff + m * 2048 + k * 1024); } while (0)
#define PG8_LDB(dst, b, h) do { _Pragma("unroll") for (int n = 0; n < 2; ++n) _Pragma("unroll") for (int k = 0; k < 2; ++k) dst[n][k] = *(const PG8_LAS bf16x8*)(lds + PG8_SB(b, h) + boff + n * 2048 + k * 1024); } while (0)
#define PG8_MMA(ai, bj, At, Bt) do { __builtin_amdgcn_s_setprio(1); _Pragma("unroll") for (int m = 0; m < 4; ++m) _Pragma("unroll") for (int n = 0; n < 2; ++n) { \
        if constexpr (FP8) { mfma_fp8_inplace(acc[ai][bj][m][n], cat8(Bt[n][0], Bt[n][1]), cat8(At[m][0], At[m][1])); } \
        else { _Pragma("unroll") for (int k = 0; k < 2; ++k) acc[ai][bj][m][n] = __builtin_amdgcn_mfma_f32_16x16x32_bf16(Bt[n][k], At[m][k], acc[ai][bj][m][n], 0, 0, 0); } } \
        __builtin_amdgcn_s_setprio(0); } while (0)
#define PG8_WAIT_V(n) asm volatile("s_waitcnt vmcnt(" #n ")" ::: "memory")
#define PG8_WAIT_L(n) asm volatile("s_waitcnt lgkmcnt(" #n ")" ::: "memory")
#define PG8_BAR __builtin_amdgcn_s_barrier()
#define PG8_SCHED __builtin_amdgcn_sched_barrier(0)
    Unit cur, nxt; int ui = 0;
    if (!S.next(0, cur)) return;
    f32x4 acc[2][2][4][2];
#pragma unroll
    for (int a = 0; a < 2; ++a)
#pragma unroll
        for (int b = 0; b < 2; ++b)
#pragma unroll
            for (int m = 0; m < 4; ++m)
#pragma unroll
                for (int n = 0; n < 2; ++n) acc[a][b][m][n] = (f32x4){0.f, 0.f, 0.f, 0.f};
    bf16x8 At[4][2], B0[2][2], B1[2][2];
    unsigned cA = GATHER ? 0u : (unsigned)cur.pm * tstepA, cB = (unsigned)cur.e * (unsigned)g.bstride + (unsigned)cur.pn * tstep;
    const __amdgpu_buffer_rsrc_t rsA = __builtin_amdgcn_make_buffer_rsrc((void*)g.A, 0, 0x7fffffff, 0x00020000), rsB = __builtin_amdgcn_make_buffer_rsrc((void*)g.Bt, 0, 0x7fffffff, 0x00020000);
    S.a_ready(cur);
    if constexpr (GATHER) PG8_GLOAD(gA, 0);
    if constexpr (SP2) {
        PG8_STAGE(rsB, PG8_SB(0, 0), cB, voffB); PG8_STAGE(rsB, PG8_SB(0, 1), cB + hstep, voffB); PG8_STAGE(rsA, PG8_SA(0, 0), cA, PG8_VA(0)); PG8_STAGE(rsA, PG8_SA(0, 1), cA + hsA, PG8_VA(1));
        if (wr == 1) PG8_BAR;
        PG8_WAIT_V(2); PG8_BAR;
        PG8_STAGE(rsB, PG8_SB(1, 0), cB + kstep, voffB); PG8_STAGE(rsA, PG8_SA(1, 0), cA + kstep, PG8_VA(0)); PG8_STAGE(rsB, PG8_SB(1, 1), cB + hstep + kstep, voffB);
        PG8_WAIT_V(6); PG8_BAR;
    } else {
        PG8_STAGE(rsB, PG8_SB(0, 0), cB, voffB); PG8_STAGE(rsA, PG8_SA(0, 0), cA, PG8_VA(0)); PG8_STAGE(rsB, PG8_SB(0, 1), cB + hstep, voffB); PG8_STAGE(rsA, PG8_SA(0, 1), cA + hsA, PG8_VA(1));
        if (wr == 1) PG8_BAR;
        PG8_WAIT_V(4); PG8_BAR;
        PG8_STAGE(rsB, PG8_SB(1, 0), cB + kstep, voffB); PG8_STAGE(rsA, PG8_SA(1, 0), cA + kstep, PG8_VA(0)); PG8_STAGE(rsB, PG8_SB(1, 1), cB + hstep + kstep, voffB);
        PG8_WAIT_V(6); PG8_BAR;
    }
    for (;;) {
        const bool has_next = S.next(ui + 1, nxt);
        if constexpr (GATHER) { if (has_next) PG8_GLOAD(ngA, ui + 1); else { ngA[0][0] = gA[0][0]; ngA[0][1] = gA[0][1]; ngA[1][0] = gA[1][0]; ngA[1][1] = gA[1][1]; } }
        const unsigned nA = (has_next && !GATHER) ? (unsigned)nxt.pm * tstepA : cA, nB = has_next ? (unsigned)nxt.e * (unsigned)g.bstride + (unsigned)nxt.pn * tstep : cB;
        for (int t = 0; t < nt; t += 2) {
            const bool last = (t == nt - 2);
            const unsigned a1 = cA + (unsigned)(t + 1) * kstep;
            const unsigned a2 = last ? nA : cA + (unsigned)(t + 2) * kstep, b2 = last ? nB : cB + (unsigned)(t + 2) * kstep;
            const unsigned a3 = a2 + kstep, b3 = b2 + kstep;
            if (last && has_next) S.a_ready(nxt);
            if constexpr (SP2) {
            PG8_LDB(B0, 0, 0); PG8_LDB(B1, 0, 1); PG8_SCHED; PG8_LDA(At, 0, 0); PG8_STAGE(rsA, PG8_SA(1, 1), a1 + hsA, PG8_VA(1));
            if constexpr (GATHER) { if (last) { gA[0][0] = ngA[0][0]; gA[0][1] = ngA[0][1]; gA[1][0] = ngA[1][0]; gA[1][1] = ngA[1][1]; } }
            PG8_WAIT_V(8); PG8_WAIT_L(0); PG8_BAR; PG8_MMA(0, 0, At, B0); PG8_MMA(0, 1, At, B1); PG8_BAR; PG8_SCHED;
            PG8_LDA(At, 0, 1); PG8_STAGE(rsB, PG8_SB(0, 0), b2, voffB); PG8_STAGE(rsB, PG8_SB(0, 1), b2 + hstep, voffB); PG8_STAGE(rsA, PG8_SA(0, 0), a2, PG8_VA(0));
            PG8_WAIT_V(8); PG8_WAIT_L(0); PG8_BAR; PG8_MMA(1, 0, At, B0); PG8_MMA(1, 1, At, B1); PG8_BAR; PG8_SCHED;
            PG8_LDB(B0, 1, 0); PG8_LDB(B1, 1, 1); PG8_SCHED; PG8_LDA(At, 1, 0); PG8_STAGE(rsA, PG8_SA(0, 1), a2 + hsA, PG8_VA(1));
            PG8_WAIT_V(8); PG8_WAIT_L(0); PG8_BAR; PG8_MMA(0, 0, At, B0); PG8_MMA(0, 1, At, B1); PG8_BAR; PG8_SCHED;
            PG8_LDA(At, 1, 1); PG8_STAGE(rsB, PG8_SB(1, 0), b3, voffB); PG8_STAGE(rsB, PG8_SB(1, 1), b3 + hstep, voffB); PG8_STAGE(rsA, PG8_SA(1, 0), a3, PG8_VA(0));
            PG8_WAIT_V(8); PG8_WAIT_L(0); PG8_BAR; PG8_MMA(1, 0, At, B0); PG8_MMA(1, 1, At, B1); PG8_BAR; PG8_SCHED;
            } else {
            PG8_LDB(B0, 0, 0); PG8_SCHED; PG8_LDA(At, 0, 0); PG8_STAGE(rsA, PG8_SA(1, 1), a1 + hsA, PG8_VA(1));
            PG8_WAIT_L(8); PG8_BAR; PG8_WAIT_L(0); PG8_MMA(0, 0, At, B0); PG8_BAR; PG8_SCHED;
            PG8_LDB(B1, 0, 1); PG8_STAGE(rsB, PG8_SB(0, 0), b2, voffB);
            PG8_BAR; PG8_WAIT_L(0); PG8_MMA(0, 1, At, B1); PG8_BAR;
            PG8_LDA(At, 0, 1); PG8_STAGE(rsA, PG8_SA(0, 0), a2, PG8_VA(0));
            PG8_BAR; PG8_WAIT_L(0); PG8_MMA(1, 0, At, B0); PG8_BAR; PG8_SCHED;
            PG8_STAGE(rsB, PG8_SB(0, 1), b2 + hstep, voffB);
            PG8_WAIT_V(6); PG8_BAR; PG8_MMA(1, 1, At, B1); PG8_BAR;
            PG8_LDB(B0, 1, 0); PG8_SCHED; PG8_LDA(At, 1, 0); PG8_STAGE(rsA, PG8_SA(0, 1), a2 + hsA, PG8_VA(1));
            PG8_WAIT_L(8); PG8_BAR; PG8_WAIT_L(0); PG8_MMA(0, 0, At, B0); PG8_BAR; PG8_SCHED;
            PG8_LDB(B1, 1, 1); PG8_STAGE(rsB, PG8_SB(1, 0), b3, voffB);
            PG8_BAR; PG8_WAIT_L(0); PG8_MMA(0, 1, At, B1); PG8_BAR;
            PG8_LDA(At, 1, 1); PG8_STAGE(rsA, PG8_SA(1, 0), a3, PG8_VA(0));
            PG8_BAR; PG8_WAIT_L(0); PG8_MMA(1, 0, At, B0); PG8_BAR; PG8_SCHED;
            PG8_STAGE(rsB, PG8_SB(1, 1), b3 + hstep, voffB);
            PG8_WAIT_V(6); PG8_BAR; PG8_MMA(1, 1, At, B1); PG8_BAR;
            }
        }
        if constexpr (ALIGN_EPI) { if (wr == 0) PG8_BAR; }
        if constexpr (FP8) mfma_fp8_drain();
        if constexpr (!Epi::AFTER_DRAIN) { E(acc, cur, wr, wc, fr, fq); S.done(cur); }
        if (!has_next) break;
#pragma unroll
        for (int a = 0; a < 2; ++a)
#pragma unroll
            for (int b = 0; b < 2; ++b)
#pragma unroll
                for (int m = 0; m < 4; ++m)
#pragma unroll
                    for (int n = 0; n < 2; ++n) acc[a][b][m][n] = (f32x4){0.f, 0.f, 0.f, 0.f};
        cur = nxt; cA = nA; cB = nB; ++ui;
        if constexpr (ALIGN_EPI) { if (wr == 1) PG8_BAR; }
    }
    PG8_WAIT_V(0);
    if constexpr (!ALIGN_EPI) { if (wr == 0) PG8_BAR; }
    PG8_BAR;
    if constexpr (Epi::AFTER_DRAIN) { E.fused(acc, cur, wr, wc, fr, fq, lds, wid, lane); S.done(cur); }
#undef PG8_SA
#undef PG8_GLOAD
#undef PG8_VA
#undef PG8_SB
#undef PG8_STAGE
#undef PG8_LDA
#undef PG8_LDB
#undef PG8_MMA
#undef PG8_WAIT_V
#undef PG8_WAIT_L
#undef PG8_BAR
#undef PG8_SCHED
}
}

#define GAS __attribute__((address_space(1)))
#define LAS __attribute__((address_space(3)))
#define XB_TMO      128
#define XB_XCNT(j)  (256  + 64 * (j))
#define XB_XSUB(j)  (1280 + 64 * (j))
#define XB_XGEN(j)  (2304 + 64 * (j))
#define XB_TOP      3328
#define XB_TOPGEN   3392
#define XCD_BAR_WORDS 3456
#define XB_SPIN_CAP (1u << 18)

__device__ __forceinline__ unsigned xb_ld(unsigned* p)              { return __hip_atomic_load(p, __ATOMIC_RELAXED, __HIP_MEMORY_SCOPE_AGENT); }
__device__ __forceinline__ unsigned xb_add(unsigned* p, unsigned v) { return __hip_atomic_fetch_add(p, v, __ATOMIC_RELAXED, __HIP_MEMORY_SCOPE_AGENT); }
__device__ __forceinline__ unsigned xb_xcc_id() { return (unsigned)__builtin_amdgcn_s_getreg((3 << 11) | 20) & 0xFu; }
#define XB_SPIN(cond, bar) do { unsigned _sp = 0; while (cond) { __builtin_amdgcn_s_sleep(1); \
    if ((++_sp & 255u) == 0u) { if (xb_ld(&(bar)[XB_TMO])) break; if (_sp > XB_SPIN_CAP) { atomicAdd(&(bar)[XB_TMO], 1u); break; } } } } while (0)

struct XcdBarrier {
    unsigned* bar; unsigned x;
    volatile LAS unsigned* st;
};

__device__ __forceinline__ XcdBarrier xcd_barrier_post(unsigned* bar, volatile LAS unsigned* st) {
    XcdBarrier b; b.bar = bar; b.x = xb_xcc_id(); b.st = st;
    if (threadIdx.x == 0) (void)xb_add(&bar[XB_XCNT(b.x)], 1u);
    return b;
}
__device__ __forceinline__ void xcd_barrier_complete(unsigned* bar, unsigned x, unsigned& nloc, unsigned& nx) {
    const unsigned G = gridDim.x * gridDim.y * gridDim.z;
    unsigned sum, cnt, mine, sp = 0u;
    for (;;) {
        sum = 0u; cnt = 0u; mine = 0u;
#pragma unroll
        for (unsigned j = 0; j < 16; ++j) { const unsigned c = xb_ld(&bar[XB_XCNT(j)]); sum += c; cnt += (c > 0u) ? 1u : 0u; mine = (j == x) ? c : mine; }
        if (sum == G) break;
        __builtin_amdgcn_s_sleep(1);
        if ((++sp & 255u) == 0u) { if (xb_ld(&bar[XB_TMO])) break; if (sp > XB_SPIN_CAP) { atomicAdd(&bar[XB_TMO], 1u); break; } }
    }
    nloc = mine > 0u ? mine : 1u; nx = cnt > 0u ? cnt : 1u;
}

__device__ __forceinline__ void xcd_barrier(const XcdBarrier& b) {
    asm volatile("s_waitcnt vmcnt(0)" ::: "memory");
    __syncthreads();
    if (threadIdx.x == 0) {
        unsigned* bar = b.bar;
        __builtin_amdgcn_s_waitcnt(0);
        unsigned nloc = b.st[0], nx = b.st[1];
        if (nloc == 0u) { xcd_barrier_complete(bar, b.x, nloc, nx); b.st[0] = nloc; b.st[1] = nx; }
        const unsigned old = xb_add(&bar[XB_XSUB(b.x)], 1u);
        const unsigned gen = old / nloc;
        if (old + 1u == (gen + 1u) * nloc) {
            __builtin_amdgcn_fence(__ATOMIC_RELEASE, "agent");
            asm volatile("s_waitcnt vmcnt(0)" ::: "memory");
            const unsigned og = xb_add(&bar[XB_TOP], 1u);
            const unsigned tg = og / nx;
            if (og + 1u == (tg + 1u) * nx) xb_add(&bar[XB_TOPGEN], 1u);
            else XB_SPIN(xb_ld(&bar[XB_TOPGEN]) == tg, bar);
            __builtin_amdgcn_fence(__ATOMIC_ACQUIRE, "agent");
            xb_add(&bar[XB_XGEN(b.x)], 1u);
            asm volatile("s_waitcnt vmcnt(0)" ::: "memory");
        } else {
            XB_SPIN(xb_ld(&bar[XB_XGEN(b.x)]) == gen, bar);
            __builtin_amdgcn_fence(__ATOMIC_ACQUIRE, "agent");
            asm volatile("s_waitcnt vmcnt(0)" ::: "memory");
        }
    }
    __syncthreads();
}

template <int MODE  >
__device__ __forceinline__ void transpose_item(const float* __restrict__ W, int K, int N, bf16_t* __restrict__ WT, const float* __restrict__ gain, float* scr, int item, int lane) {
    const int nblk = N / 32, kb = item / nblk, nb = item % nblk, k0 = 64 * kb, n0 = 32 * nb;
#pragma unroll
    for (int i = 0; i < 8; ++i) { const int kk = 8 * i + (lane >> 3), n4 = (lane & 7) * 4; f32x4 v = *(const f32x4*)(W + (size_t)(k0 + kk) * N + n0 + n4);
        if (gain) { const float g = gain[k0 + kk]; v = v * g; }
        float* s = scr + kk * 33 + n4; s[0] = v[0]; s[1] = v[1]; s[2] = v[2]; s[3] = v[3]; }
    asm volatile("s_waitcnt lgkmcnt(0)" ::: "memory");
    const int c = lane & 7;
#pragma unroll
    for (int j = 0; j < 4; ++j) { const int n = (lane >> 3) + 8 * j; const float* s = scr + (8 * c) * 33 + n;
        u32x4 o; o.x = pk2(s[0 * 33], s[1 * 33]); o.y = pk2(s[2 * 33], s[3 * 33]); o.z = pk2(s[4 * 33], s[5 * 33]); o.w = pk2(s[6 * 33], s[7 * 33]);
        int row = n0 + n;
        if (MODE == 1) { const int f = row & 1023; row = ((f >> 7) << 8) + ((row >> 10) << 7) + (f & 127); }
        if (MODE == 2) { const int hh = row / DQK; row = hh * 128 + (row - hh * DQK); }
        if (MODE == 3) { const int hh = row >> 7, ii = row & 127; row = ((ii >> 6) << 9) + hh * 64 + (ii & 63); }
        *(u32x4*)(WT + (size_t)row * K + k0 + 8 * c) = o; }
    asm volatile("s_waitcnt lgkmcnt(0)" ::: "memory");
}
template <int MODE>
__device__ __forceinline__ void transpose_item_fp8(const float* __restrict__ W, int K, int N, unsigned char* __restrict__ WT, float* scr, int item, int lane) {
    const int nblk = N / 32, kb = item / nblk, nb = item % nblk, k0 = 64 * kb, n0 = 32 * nb;
#pragma unroll
    for (int i = 0; i < 8; ++i) { const int kk = 8 * i + (lane >> 3), n4 = (lane & 7) * 4; const f32x4 v = *(const f32x4*)(W + (size_t)(k0 + kk) * N + n0 + n4) * W8_SCALE;
        float* s = scr + kk * 33 + n4; s[0] = v[0]; s[1] = v[1]; s[2] = v[2]; s[3] = v[3]; }
    asm volatile("s_waitcnt lgkmcnt(0)" ::: "memory");
    const int c = lane & 7;
#pragma unroll
    for (int j = 0; j < 4; ++j) { const int n = (lane >> 3) + 8 * j; const float* s = scr + (8 * c) * 33 + n;
        u32x2 o; o.x = pk4_fp8(s[0 * 33], s[1 * 33], s[2 * 33], s[3 * 33]); o.y = pk4_fp8(s[4 * 33], s[5 * 33], s[6 * 33], s[7 * 33]);
        int row = n0 + n;
        if (MODE == 1) { const int f = row & 1023; row = ((f >> 7) << 8) + ((row >> 10) << 7) + (f & 127); }
        *(u32x2*)(WT + (size_t)row * K + k0 + 8 * c) = o; }
    asm volatile("s_waitcnt lgkmcnt(0)" ::: "memory");
}
__device__ __forceinline__ void phase_prologue(const Params& p, unsigned char* lds) {
    const int tid = threadIdx.x, lane = tid & 63, wave = tid >> 6;
    float* scr = (float*)(lds + wave * 16384);
    const int gw = blockIdx.x * NWAVES + wave, NGW = gridDim.x * NWAVES;
    unsigned char* ws = p.ws;
    constexpr int I_WIN = (DM / 64) * (INC / 32), I_UQ = (QLORA / 64) * (768 / 32), I_UKV = (KVLORA / 64) * (1024 / 32), I_OM = (512 / 64) * (DM / 32), I_OC = I_OM, I_WO = (DM / 64) * (DM / 32);
    constexpr int I_W1 = (DM / 64) * (2048 / 32), I_W2 = (DFF / 64) * (DM / 32);
    constexpr int NSMALL = I_WIN + I_UQ + I_UKV + I_OM + I_OC + I_WO;
    constexpr int NITEMS = NSMALL;
    for (int it = gw; it < NITEMS; it += NGW) {
        int r = it;
        if (r < I_WIN) { transpose_item<0>(p.w_in, DM, INC, (bf16_t*)(ws + WS_WIN), p.norm1_g, scr, r, lane); continue; } r -= I_WIN;
        if (r < I_UQ) { transpose_item<2>(p.w_uq, QLORA, 768, (bf16_t*)(ws + WS_WUQ), p.q_a_g, scr, r, lane); continue; } r -= I_UQ;
        if (r < I_UKV) { transpose_item<3>(p.w_ukv, KVLORA, 1024, (bf16_t*)(ws + WS_WUKV), p.kv_a_g, scr, r, lane); continue; } r -= I_UKV;
        if (r < I_OM) { transpose_item<0>(p.w_o_mla, 512, DM, (bf16_t*)(ws + WS_WOMLA), nullptr, scr, r, lane); continue; } r -= I_OM;
        if (r < I_OC) { transpose_item<0>(p.w_o_conv, 512, DM, (bf16_t*)(ws + WS_WOCONV), nullptr, scr, r, lane); continue; } r -= I_OC;
        transpose_item<0>(p.w_o, DM, DM, (bf16_t*)(ws + WS_WO), nullptr, scr, r, lane);
    }
    { u32x4* z = (u32x4*)((bf16_t*)(ws + WS_WIN) + (size_t)INC * DM); const int nz = (INCP - INC) * DM * 2 / 16;
      for (int i = blockIdx.x * NTHREADS + tid; i < nz; i += gridDim.x * NTHREADS) z[i] = (u32x4){0u, 0u, 0u, 0u}; }
    { u32x4* wq = (u32x4*)(ws + WS_WUQ); for (int i = blockIdx.x * NTHREADS + tid; i < NH * 32 * QLORA * 2 / 16; i += gridDim.x * NTHREADS) { const int hh = i / (32 * QLORA * 2 / 16), q = i - hh * (32 * QLORA * 2 / 16); wq[(hh * 128 + 96) * (QLORA * 2 / 16) + q] = (u32x4){0u, 0u, 0u, 0u}; } }
    { float* csd = (float*)(ws + WS_CS); for (int i = blockIdx.x * NTHREADS + tid; i < NTOK * 16; i += gridDim.x * NTHREADS) { const int t = i >> 4, j = i & 15; float sn, cn; sincosf((float)p.pos[t] * exp2f(-(float)j * (13.287712379549449f / 16.f)), &sn, &cn); csd[t * 32 + j] = cn; csd[t * 32 + 16 + j] = sn; } }
    if (blockIdx.x == 0 && tid < 64) { float gq = fabsf(p.q_g[tid]), gk = fabsf(p.k_g[tid]); if (tid < 32) { gq = fmaxf(gq, fabsf(p.q_g[64 + tid])); gk = fmaxf(gk, fabsf(p.k_g[64 + tid])); }
#pragma unroll
        for (int o = 1; o < 64; o <<= 1) { gq = fmaxf(gq, __shfl_xor(gq, o)); gk = fmaxf(gk, __shfl_xor(gk, o)); }
        if (tid == 0) *(float*)(ws + WS_SHIFT) = fmaxf(2.f, ceilf(14.135f * gq * gk + 0.5f - 15.f)); }
    { int* rt = (int*)(ws + WS_RT2); int* rs = (int*)(ws + WS_RT2 + 4 * MiB); float* rr = (float*)(ws + WS_RT2 + 6 * MiB);
      for (int i = blockIdx.x * NTHREADS + tid; i < NE * CAP; i += gridDim.x * NTHREADS) { rt[i] = 0; rs[i] = -1; rr[i] = 0.f; } }
    { u32x4* GF = (u32x4*)(ws + WS_GF);
      for (int i = blockIdx.x * NTHREADS + tid; i < 64 * 64; i += gridDim.x * NTHREADS) { const int ks = i >> 6, ln = i & 63, r = ln & 31, h = ln >> 5; float v[8], lo[8]; unsigned hi[4];
#pragma unroll
          for (int j = 0; j < 8; ++j) { const int k = 16 * ks + 8 * h + j; v[j] = p.norm2_g[k] * p.router_w[(size_t)k * NE + r]; }
#pragma unroll
          for (int j = 0; j < 4; ++j) { hi[j] = pk2(v[2 * j], v[2 * j + 1]); lo[2 * j] = v[2 * j] - bf_lo(hi[j]); lo[2 * j + 1] = v[2 * j + 1] - bf_hi(hi[j]); }
          GF[(ks * 2 + 0) * 64 + ln] = (u32x4){hi[0], hi[1], hi[2], hi[3]}; GF[(ks * 2 + 1) * 64 + ln] = (u32x4){pk2(lo[0], lo[1]), pk2(lo[2], lo[3]), pk2(lo[4], lo[5]), pk2(lo[6], lo[7])}; } }
    bf16_t* XN = (bf16_t*)(ws + WS_XN);
    for (int m = gw; m < NTOK; m += NGW) {
        const f32x4* xr = (const f32x4*)(p.x + (size_t)m * DM) + lane; f32x4 v[4]; float s = 0.f;
#pragma unroll
        for (int j = 0; j < 4; ++j) { v[j] = xr[64 * j]; s += (v[j][0] * v[j][0] + v[j][1] * v[j][1]) + (v[j][2] * v[j][2] + v[j][3] * v[j][3]); }
        const float rstd = rsqrtf(wave_sum(s) * (1.f / DM) + EPS);
        u32x2* o = (u32x2*)(XN + (size_t)m * DM) + lane;
#pragma unroll
        for (int j = 0; j < 4; ++j) { u32x2 w; w.x = pk2(v[j][0] * rstd, v[j][1] * rstd); w.y = pk2(v[j][2] * rstd, v[j][3] * rstd); o[64 * j] = w; }
    }
}

struct ConvRaw { u32x4 u[3], c[3], bg; float m0, m2; };
__device__ __forceinline__ void conv_load(ConvRaw& r, const Params& p, int t, int lane) {
    const bf16_t* pr = (const bf16_t*)(p.ws + WS_PROJ) + (size_t)t * INCP; const int s = t & (SEQ - 1);
    r.m0 = s > 0 ? 1.f : 0.f; r.m2 = s < SEQ - 1 ? 1.f : 0.f;
    const bf16_t* pm = s > 0 ? pr - INCP : pr; const bf16_t* pp = s < SEQ - 1 ? pr + INCP : pr;
    r.u[0] = *(const u32x4*)(pm + OFF_U + 8 * lane); r.c[0] = *(const u32x4*)(pm + OFF_C + 8 * lane);
    r.u[1] = *(const u32x4*)(pr + OFF_U + 8 * lane); r.c[1] = *(const u32x4*)(pr + OFF_C + 8 * lane);
    r.u[2] = *(const u32x4*)(pp + OFF_U + 8 * lane); r.c[2] = *(const u32x4*)(pp + OFF_C + 8 * lane);
    r.bg = *(const u32x4*)(pr + OFF_B + 8 * lane);
}
__device__ __forceinline__ void mulpair8(const u32x4 u, const u32x4 c, float (&o)[8]) {
    o[0] = bf_lo(u.x) * bf_lo(c.x); o[1] = bf_hi(u.x) * bf_hi(c.x); o[2] = bf_lo(u.y) * bf_lo(c.y); o[3] = bf_hi(u.y) * bf_hi(c.y);
    o[4] = bf_lo(u.z) * bf_lo(c.z); o[5] = bf_hi(u.z) * bf_hi(c.z); o[6] = bf_lo(u.w) * bf_lo(c.w); o[7] = bf_hi(u.w) * bf_hi(c.w); }
__device__ __forceinline__ void conv_store(const ConvRaw& r, const Params& p, int t, int lane, const float (&cw0)[8], const float (&cw1)[8], const float (&cw2)[8]) {
    float cu0[8], cu1[8], cu2[8], bb[8], y[8]; mulpair8(r.u[0], r.c[0], cu0); mulpair8(r.u[1], r.c[1], cu1); mulpair8(r.u[2], r.c[2], cu2);
    bb[0] = bf_lo(r.bg.x); bb[1] = bf_hi(r.bg.x); bb[2] = bf_lo(r.bg.y); bb[3] = bf_hi(r.bg.y); bb[4] = bf_lo(r.bg.z); bb[5] = bf_hi(r.bg.z); bb[6] = bf_lo(r.bg.w); bb[7] = bf_hi(r.bg.w);
#pragma unroll
    for (int j = 0; j < 8; ++j) y[j] = bb[j] * (cw0[j] * r.m0 * cu0[j] + cw1[j] * cu1[j] + cw2[j] * r.m2 * cu2[j]);
    u32x4 o; o.x = pk2(y[0], y[1]); o.y = pk2(y[2], y[3]); o.z = pk2(y[4], y[5]); o.w = pk2(y[6], y[7]); *(u32x4*)((bf16_t*)(p.ws + WS_YBIN) + (size_t)t * CONVW + 8 * lane) = o;
}
__device__ __forceinline__ void phase_conv(const Params& p) {
    int tid = threadIdx.x; asm volatile("" : "+v"(tid)); const int lane = tid & 63, wave = tid >> 6;
    const int gw = blockIdx.x * NWAVES + wave, NGW = gridDim.x * NWAVES;
    float cw0[8], cw1[8], cw2[8];
#pragma unroll
    for (int j = 0; j < 8; ++j) { cw0[j] = p.conv_w[8 * lane + j]; cw1[j] = p.conv_w[CONVW + 8 * lane + j]; cw2[j] = p.conv_w[2 * CONVW + 8 * lane + j]; }
    for (int t = gw; t < NTOK; t += 2 * NGW) {
        const int t1 = t + NGW; const bool two = t1 < NTOK;
        ConvRaw r0, r1; conv_load(r0, p, t, lane); conv_load(r1, p, two ? t1 : t, lane);
        conv_store(r0, p, t, lane, cw0, cw1, cw2);
        if (two) conv_store(r1, p, t1, lane, cw0, cw1, cw2);
    }
}

constexpr int WC_EXP_ITEMS = NE * 1536, WC_RAW_B = 9 * 1024;
struct WcItem { const float* W; unsigned char* WT; int N, k0, n0, mode; };
__device__ __forceinline__ WcItem wc_decode(const Params& p, int x) {
    WcItem it; const int e = x / 1536, r = x - e * 1536;
    if (r < 1024) { it.W = p.w1 + (size_t)e * DM * 2048; it.WT = p.ws + WS_W1 + (size_t)e * 2048 * DM; it.N = 2048; it.k0 = 64 * (r >> 6); it.n0 = 32 * (r & 63); it.mode = 1; }
    else { const int q = r - 1024; it.W = p.w2 + (size_t)e * DFF * DM; it.WT = p.ws + WS_W2 + (size_t)e * DM * DFF; it.N = DM; it.k0 = 64 * (q >> 5); it.n0 = 32 * (q & 31); it.mode = 0; }
    return it;
}
struct WConv { unsigned char* raw; int x0, nitems, cs, slot, sh, soff; bool m1; };
__device__ __forceinline__ bool wconv_step(WConv& c, const Params& p, int lane) {
    typedef __attribute__((address_space(3))) unsigned* lds_u32p;
    const int cs = c.cs, nst = 8 * c.nitems, fi = cs - 9;
    if (fi >= 0 && (fi & 7) == 0 && (fi >> 3) < c.nitems) {
        const int i = fi >> 3; const WcItem it = wc_decode(p, c.x0 + i); const int c8 = lane & 7, nr = lane >> 3, lv = (nr >> 2) | (c8 << 1);
        int sl = c.slot + c8; sl -= (sl >= 9) ? 9 : 0;
        const unsigned char* rb = c.raw + sl * 1024 + (nr & 3) * 4;
        float v[4][8];
#pragma unroll
        for (int j = 0; j < 4; ++j)
#pragma unroll
            for (int k = 0; k < 8; ++k) v[j][k] = *(const float*)(rb + (((k * 8 + 2 * j) ^ lv) << 4));
#pragma unroll
        for (int j = 0; j < 4; ++j) {
            u32x2 o; o.x = pk4_fp8(v[j][0] * W8_SCALE, v[j][1] * W8_SCALE, v[j][2] * W8_SCALE, v[j][3] * W8_SCALE); o.y = pk4_fp8(v[j][4] * W8_SCALE, v[j][5] * W8_SCALE, v[j][6] * W8_SCALE, v[j][7] * W8_SCALE);
            int row = it.n0 + nr + 8 * j; if (it.mode == 1) { const int f = row & 1023; row = ((f >> 7) << 8) + ((row >> 10) << 7) + (f & 127); }
            *(u32x2*)(it.WT + (size_t)row * DM + it.k0 + 8 * c8) = o; }
    }
    const bool issue = cs < nst;
    if (issue) {
        const int q = cs & 7;
        if (q == 0) { const int x = c.x0 + (cs >> 3), e = x / 1536, r = x - e * 1536;
            if (r < 1024) { c.m1 = true; c.sh = 13; c.soff = e * (DM * 2048 * 4) + (64 * (r >> 6)) * 8192 + (32 * (r & 63)) * 4; }
            else { const int q2 = r - 1024; c.m1 = false; c.sh = 12; c.soff = e * (DFF * DM * 4) + (64 * (q2 >> 5)) * 4096 + (32 * (q2 & 31)) * 4; } }
        const int sv = lane ^ (q << 1), voff = ((sv >> 3) << c.sh) + ((sv & 7) << 4), so = c.soff + ((8 * q) << c.sh);
        typedef __attribute__((address_space(3))) void* lds_vp;
        const __amdgpu_buffer_rsrc_t rs = __builtin_amdgcn_make_buffer_rsrc((void*)(c.m1 ? p.w1 : p.w2), 0, 0x7fffffff, 0x00020000);
        __builtin_amdgcn_raw_ptr_buffer_load_lds(rs, (lds_vp)(c.raw + c.slot * 1024), 16, voff, so, 0, 0);
    }
    c.cs = cs + 1; c.slot = (c.slot == 8) ? 0 : c.slot + 1;
    return issue;
}

namespace att {
constexpr int NW = 8, QBLK = 32, KVBLK = 64;
constexpr float SCALE = 0.10206207261596575f;
constexpr float QSC = SCALE * 1.4426950408889634f;
constexpr int LDQ = 128, LDK = 128;
constexpr int SHM_V = KVBLK * DV, SHM_K = KVBLK * 128, SHM_ATTN = 2 * SHM_V + 2 * SHM_K + NW * 64 * 4;
#define KSWZ(row, colB) ((row) * 256 + ((colB) ^ (((row) & 7) << 4)))
#define SBAR() __builtin_amdgcn_sched_barrier(0)
__device__ __forceinline__ int crow(int r, int hi) { return (r & 3) + 8 * (r >> 2) + 4 * hi; }
__device__ __forceinline__ float fadd_s(float a, float b) { float r; asm("v_add_f32_e32 %0, %1, %2" : "=v"(r) : "v"(a), "v"(b)); return r; }
__device__ __forceinline__ unsigned cvtpk(float lo, float hi) { unsigned r; asm volatile("v_cvt_pk_bf16_f32 %0, %1, %2" : "=v"(r) : "v"(lo), "v"(hi)); return r; }
typedef int i32x4a __attribute__((ext_vector_type(4))); typedef int i32x8a __attribute__((ext_vector_type(8)));
#define EXPH(P) do { _Pragma("unroll") for (int r = 0; r < 16; ++r) P[r] = __builtin_amdgcn_exp2f(P[r]); } while (0)
__device__ __forceinline__ unsigned pk4_bf8(float a, float b, float c, float d) { unsigned w = 0u; w = (unsigned)__builtin_amdgcn_cvt_pk_bf8_f32(a, b, (int)w, false); w = (unsigned)__builtin_amdgcn_cvt_pk_bf8_f32(c, d, (int)w, true); return w; }
__device__ __forceinline__ void finishSM(f32x16& p0, f32x16& p1, float& l_reg, i32x8a& pf) {
    EXPH(p1); SBAR();
    float ps0 = p0[0], ps1 = p1[0];
#pragma unroll
    for (int r = 1; r < 16; ++r) { ps0 = fadd_s(ps0, p0[r]); ps1 = fadd_s(ps1, p1[r]); }
    l_reg += ps0 + ps1;
#pragma unroll
    for (int q = 0; q < 4; ++q) {
        pf[q] = __builtin_amdgcn_cvt_pk_bf8_f32(p0[4 * q], p0[4 * q + 1], pf[q], false); pf[q] = __builtin_amdgcn_cvt_pk_bf8_f32(p0[4 * q + 2], p0[4 * q + 3], pf[q], true);
        pf[4 + q] = __builtin_amdgcn_cvt_pk_bf8_f32(p1[4 * q], p1[4 * q + 1], pf[4 + q], false); pf[4 + q] = __builtin_amdgcn_cvt_pk_bf8_f32(p1[4 * q + 2], p1[4 * q + 3], pf[4 + q], true); }
}
__device__ __forceinline__ void qkt(f32x16& p0, f32x16& p1, const unsigned char* Ks, const i32x8a* qf, int r32, int hi) {
    const f32x16 z = {};
#pragma unroll
    for (int kh = 0; kh < 2; ++kh) { const int row = kh * 32 + r32, sw = (row >> 1) & 7; const unsigned char* rb = Ks + row * 128; f32x16 acc = z;
#pragma unroll
        for (int s = 0; s < 2; ++s) { const int c0 = 4 * s + 2 * hi; const i32x4a lo = *reinterpret_cast<const i32x4a*>(rb + ((c0 ^ sw) << 4)), hh = *reinterpret_cast<const i32x4a*>(rb + (((c0 + 1) ^ sw) << 4));
            acc = __builtin_amdgcn_mfma_scale_f32_32x32x64_f8f6f4(__builtin_shufflevector(lo, hh, 0, 1, 2, 3, 4, 5, 6, 7), qf[s], acc, 0, 0, 0, 0, 0, 0); }
        if (kh == 0) p0 = acc; else p1 = acc; }
}
__device__ __forceinline__ i32x8a kfrag(const unsigned char* Ks, int kh, int s, int r32, int hi) {
    const int row = kh * 32 + r32, sw = (row >> 1) & 7, c0 = 4 * s + 2 * hi; const unsigned char* rb = Ks + row * 128;
    const i32x4a lo = *reinterpret_cast<const i32x4a*>(rb + ((c0 ^ sw) << 4)), hh = *reinterpret_cast<const i32x4a*>(rb + (((c0 + 1) ^ sw) << 4));
    return __builtin_shufflevector(lo, hh, 0, 1, 2, 3, 4, 5, 6, 7);
}
__device__ __forceinline__ i32x8a vfrag(const unsigned char* Vs, int d0, int r32, int hi) {
    const unsigned char* b = Vs + (((hi * 2 + d0) * 32 + r32) << 5); const int sw = (r32 >> 3) & 1;
    const i32x4a lo = *reinterpret_cast<const i32x4a*>(b + (sw << 4)), hh = *reinterpret_cast<const i32x4a*>(b + ((sw ^ 1) << 4));
    return __builtin_shufflevector(lo, hh, 0, 1, 2, 3, 4, 5, 6, 7);
}
__device__ __forceinline__ void pv8(f32x16& od, const i32x8a v, const i32x8a pfr) { asm volatile("s_nop 1\n\tv_mfma_f32_32x32x64_f8f6f4 %0, %1, %2, %0 blgp:1" : "+v"(od) : "v"(v), "v"(pfr)); }
#define EXPQ(P, B) do { _Pragma("unroll") for (int r = (B); r < (B) + 8; ++r) P[r] = __builtin_amdgcn_exp2f(P[r]); } while (0)
#define PV_STEP(Vs, PN) do { const i32x8a v0_ = vfrag((Vs), 0, r32, hi), v1_ = vfrag((Vs), 1, r32, hi); pv8(o[0], v0_, pf); EXPQ(PN, 0); pv8(o[1], v1_, pf); EXPQ(PN, 8); SBAR(); } while (0)

__device__ __forceinline__ void attn_unit(const unsigned char* __restrict__ Qb, const unsigned char* __restrict__ Kh, const unsigned char* __restrict__ Vth, bf16_t* __restrict__ Ob, int seq, unsigned char* lds, WConv& wc, const Params& prm) {
    const int tid = threadIdx.x, wid = __builtin_amdgcn_readfirstlane(tid >> 6), lane = tid & 63, r32 = lane & 31, hi = lane >> 5;
    unsigned char* V_lds = lds; unsigned char* K_lds = lds + 2 * SHM_V;
    f32x16 o[2] = {}; i32x8a qr[2];
    { const unsigned char* Qw = Qb + (size_t)(wid * QBLK + r32) * LDQ + hi * 32;
#pragma unroll
      for (int s = 0; s < 2; ++s) { const i32x4a lo = *reinterpret_cast<const i32x4a*>(Qw + 64 * s), hh = *reinterpret_cast<const i32x4a*>(Qw + 64 * s + 16); qr[s] = __builtin_shufflevector(lo, hh, 0, 1, 2, 3, 4, 5, 6, 7); } }
    const int kr0 = 8 * wid + (lane >> 3), kcp = lane & 7;
    const int kvoff = kr0 * LDK + ((kcp ^ ((kr0 >> 1) & 7)) * 16), vvoff = (wid & 3) * 1024 + lane * 16;
    const __amdgpu_buffer_rsrc_t rsK = __builtin_amdgcn_make_buffer_rsrc((void*)Kh, 0, 0x7fffffff, 0x00020000), rsV = __builtin_amdgcn_make_buffer_rsrc((void*)Vth, 0, 0x7fffffff, 0x00020000);
    typedef __attribute__((address_space(3))) void* lds_vp;
    const unsigned char* vsrc = Vth + (wid & 3) * 1024 + lane * 16;
    typedef __attribute__((address_space(3))) unsigned* lds_u32p;
#define DMA_K(t, slot) __builtin_amdgcn_raw_ptr_buffer_load_lds(rsK, (lds_vp)(K_lds + (slot) * SHM_K + wid * 1024), 16, kvoff, (t) * (KVBLK * LDK), 0, 0)
#define DMA_V(t, slot) do { if (wid < 4) __builtin_amdgcn_raw_ptr_buffer_load_lds(rsV, (lds_vp)(V_lds + (slot) * SHM_V + wid * 1024), 16, vvoff, (t) * 4096, 0, 0); } while (0)
    f32x16 pA0, pA1, pB0, pB1; i32x8a pf = {}; const int NT = seq / KVBLK;
    typedef float f32x4v __attribute__((ext_vector_type(4)));
    i32x8a ones; { const int c4 = ((lane & 1) == ((lane >> 4) & 1)) ? 0x22222222 : 0; ones = (i32x8a){c4, c4, c4, c4, 0, 0, 0, 0}; }
    f32x4v lsum = {0.f, 0.f, 0.f, 0.f};
    const f32x16 zacc = {};
#define QKM(ACC, KF, S, CIN) ACC = __builtin_amdgcn_mfma_scale_f32_32x32x64_f8f6f4(KF, qr[S], CIN, 0, 0, 0, 0, 0, 0)
#define ROWSUM() lsum = __builtin_amdgcn_mfma_scale_f32_16x16x128_f8f6f4(ones, pf, lsum, 4, 1, 0, 0, 0, 0)
#define CVT8(P, Q0) do { _Pragma("unroll") for (int q_ = 0; q_ < 4; ++q_) { pf[(Q0) + q_] = __builtin_amdgcn_cvt_pk_bf8_f32(P[4 * q_], P[4 * q_ + 1], pf[(Q0) + q_], false); pf[(Q0) + q_] = __builtin_amdgcn_cvt_pk_bf8_f32(P[4 * q_ + 2], P[4 * q_ + 3], pf[(Q0) + q_], true); } } while (0)
#define WAITW(ISS) do { if (ISS) asm volatile("s_waitcnt vmcnt(1)" ::: "memory"); else asm volatile("s_waitcnt vmcnt(0)" ::: "memory"); } while (0)
#define BARE_BAR() asm volatile("s_barrier" ::: "memory")
#define PIN(P) asm volatile("" : "+v"(P))
#define STEP(Ks, Vs, PC0, PC1, PX0, PX1) do { \
        const i32x8a k00_ = kfrag((Ks), 0, 0, r32, hi), k01_ = kfrag((Ks), 0, 1, r32, hi), k10_ = kfrag((Ks), 1, 0, r32, hi), k11_ = kfrag((Ks), 1, 1, r32, hi); SBAR(); \
        QKM(PX0, k00_, 0, zacc); PIN(PX0); EXPQ(PC1, 0); PIN(PC1); SBAR(); \
        QKM(PX0, k01_, 1, PX0); PIN(PX0); EXPQ(PC1, 8); PIN(PC1); SBAR(); \
        QKM(PX1, k10_, 0, zacc); PIN(PX1); CVT8(PC0, 0); PIN(pf); SBAR(); \
        QKM(PX1, k11_, 1, PX1); PIN(PX1); CVT8(PC1, 4); PIN(pf); const i32x8a v0_ = vfrag((Vs), 0, r32, hi), v1_ = vfrag((Vs), 1, r32, hi); SBAR(); \
        ROWSUM(); PIN(lsum); pv8(o[0], v0_, pf); EXPQ(PX0, 0); PIN(PX0); SBAR(); \
        pv8(o[1], v1_, pf); EXPQ(PX0, 8); PIN(PX0); SBAR(); } while (0)
    DMA_K(0, 0); DMA_V(0, 0); DMA_K(1, 1);
    asm volatile("s_waitcnt vmcnt(0)" ::: "memory"); __syncthreads();
    qkt(pA0, pA1, K_lds, qr, r32, hi); EXPH(pA0); SBAR();
    __syncthreads();
    for (int j = 0; j + 2 < NT; j += 2) {
        DMA_K(j + 2, 0); DMA_V(j + 1, 1); const bool wlA = wconv_step(wc, prm, lane); SBAR();
        STEP(K_lds + SHM_K, V_lds, pA0, pA1, pB0, pB1);
        WAITW(wlA); BARE_BAR();
        DMA_K(j + 3, 1); DMA_V(j + 2, 0); const bool wlB = wconv_step(wc, prm, lane); SBAR();
        STEP(K_lds, V_lds + SHM_V, pB0, pB1, pA0, pA1);
        WAITW(wlB); BARE_BAR();
    }
    DMA_V(NT - 1, 1); const bool wlT = wconv_step(wc, prm, lane); SBAR();
    STEP(K_lds + SHM_K, V_lds, pA0, pA1, pB0, pB1);
    WAITW(wlT); BARE_BAR();
    EXPH(pB1); SBAR(); CVT8(pB0, 0); CVT8(pB1, 4); SBAR();
    { const i32x8a v0_ = vfrag(V_lds + SHM_V, 0, r32, hi), v1_ = vfrag(V_lds + SHM_V, 1, r32, hi); ROWSUM(); pv8(o[0], v0_, pf); pv8(o[1], v1_, pf); }
    asm volatile("s_nop 15\n\ts_nop 7" ::: "memory"); SBAR();
    const float l_reg = (lane & 16) ? lsum[1] : lsum[0];
#undef STEP
#undef PIN
#undef WAITW
#undef BARE_BAR
#undef QKM
#undef ROWSUM
#undef CVT8
    const float rl = __builtin_amdgcn_rcpf(l_reg);
    bf16_t* Ow = Ob + (size_t)(wid * QBLK + r32) * 512 + 4 * hi;
#pragma unroll
    for (int d0 = 0; d0 < 2; ++d0)
#pragma unroll
        for (int g = 0; g < 4; ++g) { u32x2 w; w.x = pk2(o[d0][4 * g] * rl, o[d0][4 * g + 1] * rl); w.y = pk2(o[d0][4 * g + 2] * rl, o[d0][4 * g + 3] * rl); *(u32x2*)(Ow + d0 * 32 + 8 * g) = w; }
    __syncthreads();
#undef DMA_K
#undef DMA_V
}
#undef KSWZ
#undef SBAR
}

__device__ __forceinline__ void phase_attn(const Params& p, unsigned char* lds) {
    const unsigned char* Q = p.ws + WS_Q; const unsigned char* Kb = p.ws + WS_K; const unsigned char* VT = p.ws + WS_V; bf16_t* AO = (bf16_t*)(p.ws + WS_AO);
    constexpr int NQB = SEQ / 256, NU = 2 * NH * NQB;
    const int lane = threadIdx.x & 63, wave = __builtin_amdgcn_readfirstlane(threadIdx.x >> 6), gw = blockIdx.x * NWAVES + wave, NGW = gridDim.x * NWAVES;
    const int ipw = (WC_EXP_ITEMS + NGW - 1) / NGW, nun = ((int)blockIdx.x < NU) ? (NU - 1 - (int)blockIdx.x) / (int)gridDim.x + 1 : 0, steps = nun * (SEQ / att::KVBLK - 1);
    int cov = (steps - 2) / 8; cov = cov < 0 ? 0 : (cov > ipw ? ipw : cov);
    WConv wc; wc.raw = lds + att::SHM_ATTN + wave * WC_RAW_B; wc.x0 = gw * ipw; wc.cs = 0; wc.slot = 0; wc.sh = 12; wc.soff = 0; wc.m1 = true;
    { const int left = WC_EXP_ITEMS - wc.x0; wc.nitems = left < 0 ? 0 : (left < cov ? left : cov); }
    if (wave >= 4) __builtin_amdgcn_s_setprio(1);
    const bool xmap = false;
    for (int u0 = blockIdx.x, rnd = 0; u0 < NU; u0 += gridDim.x, ++rnd) {
        const int u = xmap ? (((int)blockIdx.x & 7) + 8 * rnd) * NQB + ((int)blockIdx.x >> 3) : u0;
        const int qb = u % NQB, h = (u / NQB) % NH, b = u / (NQB * NH); const size_t bh = (size_t)(b * NH + h) * SEQ;
        att::attn_unit(Q + (bh + (size_t)qb * 256) * 128, Kb + bh * 128, VT + bh * DV, AO + ((size_t)b * SEQ + (size_t)qb * 256) * 512 + h * DV, SEQ, lds, wc, p);
    }
    __builtin_amdgcn_s_setprio(0);
    while (wc.cs < 8 * wc.nitems + 2) { wconv_step(wc, p, lane); asm volatile("s_waitcnt vmcnt(0)" ::: "memory"); }
}
__device__ __forceinline__ void wconv_cleanup(const Params& p, unsigned char* lds) {
    constexpr int NQB = SEQ / 256, NU = 2 * NH * NQB;
    const int lane = threadIdx.x & 63, wave = threadIdx.x >> 6, gw = blockIdx.x * NWAVES + wave, NGW = gridDim.x * NWAVES;
    const int ipw = (WC_EXP_ITEMS + NGW - 1) / NGW, nun = ((int)blockIdx.x < NU) ? (NU - 1 - (int)blockIdx.x) / (int)gridDim.x + 1 : 0, steps = nun * (SEQ / att::KVBLK - 1);
    int cov = (steps - 2) / 8; cov = cov < 0 ? 0 : (cov > ipw ? ipw : cov);
    float* scr = (float*)(lds + wave * 16384);
    for (int i = cov; i < ipw; ++i) { const int x = gw * ipw + i; if (x >= WC_EXP_ITEMS) break; const WcItem it = wc_decode(p, x); const int r = x % 1536;
        if (it.mode == 1) transpose_item_fp8<1>(it.W, DM, 2048, it.WT, scr, r, lane); else transpose_item_fp8<0>(it.W, DFF, DM, it.WT, scr, r - 1024, lane); }
    __syncthreads();
}

__device__ __forceinline__ int crow16(int r, int hi) { return (r & 3) + 8 * (r >> 2) + 4 * hi; }
__device__ __forceinline__ void phase_router(const Params& p, unsigned char* lds) {
    const int tid = threadIdx.x, lane = tid & 63, wid = tid >> 6, tile = wid >> 2, kq = wid & 3, c = lane & 31, h = lane >> 5;
    float* red = (float*)lds;
    float* ssb = red + 2 * 4 * 16 * 64;
    int* lcnt = (int*)(ssb + 2 * 4 * 64);
    int* lbase = lcnt + 32;
    unsigned* gcnt = (unsigned*)(p.ws + WS_CTL) + CW_CNT;
    int* row_tok = (int*)(p.ws + WS_RT2); float* row_w = (float*)(p.ws + WS_RT2 + 2 * MiB); int* row_slot = (int*)(p.ws + WS_RT2 + 4 * MiB); float* row_rstd = (float*)(p.ws + WS_RT2 + 6 * MiB);
    const u32x4* GF = (const u32x4*)(p.ws + WS_GF);
    for (int tg = blockIdx.x; tg < NTOK / 64; tg += gridDim.x) {
        if (tid < 32) lcnt[tid] = 0;
        const int token = tg * 64 + tile * 32 + c;
        const bf16_t* xrow = (const bf16_t*)(p.ws + WS_X1B) + (size_t)token * DM + kq * 256 + 8 * h; const float* g2p = p.norm2_g + kq * 256 + 8 * h;
        unsigned char* hrow = p.ws + WS_H8 + (size_t)token * DM + kq * 256 + 8 * h;
        f32x16 acc = {}; float ss = 0.f;
#pragma unroll 2
        for (int s = 0; s < 16; ++s) {
            const u32x4 xh = *(const u32x4*)(xrow + 16 * s); const f32x4 ga = *(const f32x4*)(g2p + 16 * s), gb = *(const f32x4*)(g2p + 16 * s + 4);
            const f32x4 a = {bf_lo(xh.x), bf_hi(xh.x), bf_lo(xh.y), bf_hi(xh.y)}, b = {bf_lo(xh.z), bf_hi(xh.z), bf_lo(xh.w), bf_hi(xh.w)};
            ss += (a[0] * a[0] + a[1] * a[1]) + (a[2] * a[2] + a[3] * a[3]) + (b[0] * b[0] + b[1] * b[1]) + (b[2] * b[2] + b[3] * b[3]);
            u32x2 h8; h8.x = pk4_fp8(a[0] * ga[0], a[1] * ga[1], a[2] * ga[2], a[3] * ga[3]); h8.y = pk4_fp8(b[0] * gb[0], b[1] * gb[1], b[2] * gb[2], b[3] * gb[3]); *(u32x2*)(hrow + 16 * s) = h8;
            const u32x4 gh = GF[((kq * 16 + s) * 2 + 0) * 64 + lane], gl = GF[((kq * 16 + s) * 2 + 1) * 64 + lane];
            acc = __builtin_amdgcn_mfma_f32_32x32x16_bf16(__builtin_bit_cast(bf16x8, gh), __builtin_bit_cast(bf16x8, xh), acc, 0, 0, 0);
            acc = __builtin_amdgcn_mfma_f32_32x32x16_bf16(__builtin_bit_cast(bf16x8, gl), __builtin_bit_cast(bf16x8, xh), acc, 0, 0, 0);
        }
#pragma unroll
        for (int r = 0; r < 16; ++r) red[((tile * 4 + kq) * 16 + r) * 64 + lane] = acc[r];
        ssb[(tile * 4 + kq) * 64 + lane] = ss;
        __syncthreads();
        int te[4] = {0, 0, 0, 0}, rl[4] = {0, 0, 0, 0}; float tw[4] = {0.f, 0.f, 0.f, 0.f}; float rstd = 0.f;
        if (kq == 0) {
            float v[16]; float st = 0.f;
#pragma unroll
            for (int q = 0; q < 4; ++q) st += ssb[(tile * 4 + q) * 64 + lane];
            { auto rr = __builtin_amdgcn_permlane32_swap(__float_as_uint(st), __float_as_uint(st), false, false); st = __uint_as_float(rr[0]) + __uint_as_float(rr[1]); }
            rstd = rsqrtf(st * (1.f / DM) + EPS);
#pragma unroll
            for (int r = 0; r < 16; ++r) { float sacc = 0.f;
#pragma unroll
                for (int q = 0; q < 4; ++q) sacc += red[((tile * 4 + q) * 16 + r) * 64 + lane];
                v[r] = sacc * rstd + p.router_b[crow16(r, h)]; }
            float lv[4]; int le[4];
#pragma unroll
            for (int k = 0; k < 4; ++k) { float best = v[0]; int bi = 0;
#pragma unroll
                for (int r = 1; r < 16; ++r) { const bool gt = v[r] > best; best = gt ? v[r] : best; bi = gt ? r : bi; }
                lv[k] = best; le[k] = (bi & 3) + 8 * (bi >> 2) + 4 * h;
#pragma unroll
                for (int r = 0; r < 16; ++r) v[r] = (r == bi) ? -INFINITY : v[r]; }
            float cv[8]; int ce[8];
#pragma unroll
            for (int k = 0; k < 4; ++k) { auto rv = __builtin_amdgcn_permlane32_swap(__float_as_uint(lv[k]), __float_as_uint(lv[k]), false, false); auto re = __builtin_amdgcn_permlane32_swap((unsigned)le[k], (unsigned)le[k], false, false);
                cv[k] = __uint_as_float(rv[0]); cv[4 + k] = __uint_as_float(rv[1]); ce[k] = (int)re[0]; ce[4 + k] = (int)re[1]; }
            float tv[4];
#pragma unroll
            for (int k = 0; k < 4; ++k) { float best = cv[0]; int be = ce[0]; int bi = 0;
#pragma unroll
                for (int r = 1; r < 8; ++r) { const bool gt = (cv[r] > best) || (cv[r] == best && ce[r] < be); best = gt ? cv[r] : best; be = gt ? ce[r] : be; bi = gt ? r : bi; }
                tv[k] = best; te[k] = be;
#pragma unroll
                for (int r = 0; r < 8; ++r) cv[r] = (r == bi) ? -INFINITY : cv[r]; }
            const float e1 = __expf(tv[1] - tv[0]), e2 = __expf(tv[2] - tv[0]), e3 = __expf(tv[3] - tv[0]); const float inv = 1.f / (1.f + e1 + e2 + e3);
            tw[0] = inv; tw[1] = e1 * inv; tw[2] = e2 * inv; tw[3] = e3 * inv;
            if (h == 0) {
#pragma unroll
                for (int k = 0; k < 4; ++k) rl[k] = atomicAdd(&lcnt[te[k]], 1); }
        }
        __syncthreads();
        if (tid < 32) lbase[tid] = (int)atomicAdd(&gcnt[tid], (unsigned)lcnt[tid]);
        __syncthreads();
        if (kq == 0 && h == 0) {
#pragma unroll
            for (int k = 0; k < 4; ++k) { const int idx = te[k] * CAP + lbase[te[k]] + rl[k]; row_tok[idx] = token; row_w[idx] = tw[k]; row_slot[idx] = token * 4 + k; row_rstd[idx] = rstd; } }
        __syncthreads();
    }
}

__device__ __forceinline__ void build_block_table(const Params& p, int* bs) {
    const unsigned* gcnt = (const unsigned*)(p.ws + WS_CTL) + CW_CNT;
    if (threadIdx.x == 0) { int acc = 0; for (int e = 0; e < NE; ++e) { bs[e] = acc; acc += ((int)__hip_atomic_load(gcnt + e, __ATOMIC_RELAXED, __HIP_MEMORY_SCOPE_AGENT) + 255) >> 8; } bs[NE] = acc; }
    __syncthreads();
}

__device__ __forceinline__ pg8::MoeOrder make_moe_order(const Params& p, unsigned char* lds, int N, bool gather) {
    int* bs = (int*)(lds + 131072); int* utab = (int*)(lds + 131072 + 256); int* gtab = (int*)(lds + 131072 + 512);
    build_block_table(p, bs);
    const int nmb = __builtin_amdgcn_readfirstlane(bs[NE]);
    pg8::MoeOrder S; S.so.init(nmb * 256, N, (int)gridDim.x, (int)blockIdx.x); S.utab = (const PG8_LAS int*)utab; S.gtab = (const PG8_LAS int*)gtab;
    const int* row_tok = (const int*)(p.ws + WS_RT2);
    for (int i = 0; i < pg8::MOE_MAXU; ++i) { pg8::Unit u; if (!S.so.next(i, u)) break; int e = 0; for (int k = 1; k < NE; ++k) if (bs[k] <= u.pm) e = k;
        const int rb = e * CAP + (u.pm - bs[e]) * 256;
        if (threadIdx.x == 0) utab[i] = e | (rb << 8);
        if (gather && threadIdx.x < 256) gtab[i * 256 + threadIdx.x] = row_tok[rb + threadIdx.x]; }
    __syncthreads();
    return S;
}
__device__ __forceinline__ void phase_moe1(const Params& p, unsigned char* lds) {
    const pg8::MoeOrder S = make_moe_order(p, lds, 2048, true);
    pg8::Gemm g{(const bf16_t*)(p.ws + WS_H8), (const bf16_t*)(p.ws + WS_W1), 0, 2048, DM / 2, (size_t)2048 * DM, 0, 0};
    pg8::EpiSwiglu E{p.ws + WS_ACT, p.b1, (const float*)(p.ws + WS_RT2 + 6 * MiB)};
    pg8::gemm_phase<pg8::EpiSwiglu, pg8::MoeOrder, true, true, true, true>((PG8_LAS unsigned char*)lds, g, S, E);
}
__device__ __forceinline__ void phase_moe2(const Params& p, unsigned char* lds) {
    const pg8::MoeOrder S = make_moe_order(p, lds, DM, false);
    pg8::Gemm g{(const bf16_t*)(p.ws + WS_ACT), (const bf16_t*)(p.ws + WS_W2), 0, DM, DFF / 2, (size_t)DM * DFF, 0, 0};
    pg8::EpiMoeOut E{p.ws + WS_YS, p.b2, (const float*)(p.ws + WS_RT2 + 2 * MiB), (const int*)(p.ws + WS_RT2 + 4 * MiB)};
    pg8::gemm_phase<pg8::EpiMoeOut, pg8::MoeOrder, true, true, true>((PG8_LAS unsigned char*)lds, g, S, E);
}

__device__ __forceinline__ float fp8_to_f32(unsigned w, int byte) {
    return byte == 0 ? __builtin_amdgcn_cvt_f32_fp8((int)w, 0) : byte == 1 ? __builtin_amdgcn_cvt_f32_fp8((int)w, 1) : byte == 2 ? __builtin_amdgcn_cvt_f32_fp8((int)w, 2) : __builtin_amdgcn_cvt_f32_fp8((int)w, 3); }
__device__ __forceinline__ void phase_combine(const Params& p) {
    const int tid = threadIdx.x, lane = tid & 63, wave = tid >> 6;
    const int gw = blockIdx.x * NWAVES + wave, NGW = gridDim.x * NWAVES;
    const unsigned char* YS = p.ws + WS_YS;
    for (int t = gw; t < NTOK; t += NGW) {
        f32x4* orow = (f32x4*)(p.out + (size_t)t * DM) + lane; const u32x2* xrow = (const u32x2*)((const bf16_t*)(p.ws + WS_X1B) + (size_t)t * DM) + lane;
        f32x4 v[4]; unsigned w[4][4];
#pragma unroll
        for (int j = 0; j < 4; ++j) { const u32x2 xb = xrow[64 * j]; v[j] = (f32x4){bf_lo(xb.x), bf_hi(xb.x), bf_lo(xb.y), bf_hi(xb.y)};
#pragma unroll
            for (int k = 0; k < 4; ++k) w[j][k] = *((const unsigned*)(YS + ((size_t)t * 4 + k) * DM) + lane + 64 * j); }
#pragma unroll
        for (int j = 0; j < 4; ++j) { f32x4 s = {0.f, 0.f, 0.f, 0.f};
#pragma unroll
            for (int k = 0; k < 4; ++k) { s[0] += fp8_to_f32(w[j][k], 0); s[1] += fp8_to_f32(w[j][k], 1); s[2] += fp8_to_f32(w[j][k], 2); s[3] += fp8_to_f32(w[j][k], 3); }
            orow[64 * j] = v[j] + s * YS_INV; }
    }
}

template <class Epi>
__device__ __forceinline__ void dense_gemm(unsigned char* lds, const bf16_t* A, const bf16_t* Bt, int M, int N, int K, const Epi& E, int lda = 0, int ldb = 0, int cshift = 0) {
    pg8::Gemm g{A, Bt, M, N, K, 0, lda, ldb}; pg8::StaticOrder S; S.init(M, N, (int)gridDim.x, (int)((blockIdx.x + cshift) % gridDim.x));
    pg8::gemm_phase<Epi, pg8::StaticOrder, true, true>((PG8_LAS unsigned char*)lds, g, S, E);
}

constexpr int NPHASE = 13;
__global__ void __launch_bounds__(NTHREADS, 2) mk_fwd(Params p) {
    extern __shared__ __attribute__((aligned(16))) unsigned char lds[];
    cg::grid_group grid = cg::this_grid();
    unsigned char* ws = p.ws;
    volatile LAS unsigned* MISC = (volatile LAS unsigned*)((LAS unsigned char*)lds + MISC_OFF);
    if (threadIdx.x < 32) MISC[threadIdx.x] = 0u;
    __syncthreads();
    XcdBarrier bar = xcd_barrier_post((unsigned*)(ws + WS_CTL) + CW_BAR, MISC + 8);
    const int lo = p.ph_lo, hi = p.ph_hi;
    if (lo < 0) grid.sync();
#define IN(k) (lo <= (k) && (k) < hi)
#define SEAM(k) do { if (IN(k) && IN((k) + 1)) xcd_barrier(bar); } while (0)
    if (IN(0)) phase_prologue(p, lds);
    SEAM(0);
    if (IN(1)) { pg8::EpiProj E{(bf16_t*)(ws + WS_PROJ), (float*)(ws + WS_SSQ)}; dense_gemm(lds, (const bf16_t*)(ws + WS_XN), (const bf16_t*)(ws + WS_WIN), NTOK, INCP, DM, E); }
    if (IN(1) && IN(3)) xcd_barrier(bar);
    if (IN(3)) { const float* ssq = (const float*)(ws + WS_SSQ); const float* cst = (const float*)(ws + WS_CS); float* hs = (float*)(lds + 131072);
                 pg8::EpiQ Eq{ws + WS_Q, ssq, p.q_g, cst, hs}; dense_gemm(lds, (const bf16_t*)(ws + WS_PROJ) + OFF_CQ, (const bf16_t*)(ws + WS_WUQ), NTOK, 1024, QLORA, Eq, INCP);
                 pg8::EpiK Ek{ws + WS_K, ssq, p.k_g, cst, (const bf16_t*)(ws + WS_PROJ), hs, (const float*)(ws + WS_SHIFT)}; dense_gemm(lds, (const bf16_t*)(ws + WS_PROJ) + OFF_CKV, (const bf16_t*)(ws + WS_WUKV), NTOK, 512, KVLORA, Ek, INCP);
                 pg8::EpiVT Ev{ws + WS_V, ssq}; dense_gemm(lds, (const bf16_t*)(ws + WS_WUKV) + 512 * KVLORA, (const bf16_t*)(ws + WS_PROJ) + OFF_CKV, 512, NTOK, KVLORA, Ev, 0, INCP, (int)gridDim.x / 2);
                 phase_conv(p); }
    if (IN(3) && IN(5)) xcd_barrier(bar);
    if (IN(5)) phase_attn(p, lds);
    SEAM(5);
    if (IN(6)) { pg8::EpiGateA E{(bf16_t*)(ws + WS_M1), (const bf16_t*)(ws + WS_PROJ)}; dense_gemm(lds, (const bf16_t*)(ws + WS_AO), (const bf16_t*)(ws + WS_WOMLA), NTOK, DM, 512, E); }
    if (IN(7)) { pg8::EpiGateB E{(const bf16_t*)(ws + WS_M1), (const bf16_t*)(ws + WS_PROJ), (bf16_t*)(ws + WS_MERGED)}; dense_gemm(lds, (const bf16_t*)(ws + WS_YBIN), (const bf16_t*)(ws + WS_WOCONV), NTOK, DM, 512, E); }
    SEAM(7);
    if (IN(8)) { pg8::EpiResid E{p.x, (bf16_t*)(ws + WS_X1B)}; dense_gemm(lds, (const bf16_t*)(ws + WS_MERGED), (const bf16_t*)(ws + WS_WO), NTOK, DM, DM, E); }
    SEAM(8);
    if (IN(9)) { wconv_cleanup(p, lds); phase_router(p, lds); }
    if (IN(9) && IN(11)) xcd_barrier(bar);
    if (IN(11)) phase_moe1(p, lds);
    SEAM(11);
    if (IN(12)) phase_moe2(p, lds);
    SEAM(12);
    if (IN(13)) phase_combine(p);
#undef IN
#undef SEAM
}

extern "C" void kernel_launch(void* const* d_in, const int* in_sizes, int n_in, void* d_out, int out_size,
                              void* d_ws, size_t ws_size, hipStream_t stream) {
    static int grid_blocks = 0;
    if (!grid_blocks) {
        int dev = 0, cus = 0, per_cu = 0;
        (void)hipGetDevice(&dev);
        (void)hipDeviceGetAttribute(&cus, hipDeviceAttributeMultiprocessorCount, dev);
        (void)hipFuncSetAttribute((const void*)mk_fwd, hipFuncAttributeMaxDynamicSharedMemorySize, LDS_BYTES);
        (void)hipOccupancyMaxActiveBlocksPerMultiprocessor(&per_cu, (const void*)mk_fwd, NTHREADS, LDS_BYTES);
        if (per_cu < 1) { fprintf(stderr, "kernel_launch: occupancy query says %d blocks/CU\n", per_cu); per_cu = 1; }
        grid_blocks = cus;
        if (ws_size < WS_END2 || n_in != 21) fprintf(stderr, "kernel_launch: ws %zu < %zu or n_in %d != 21\n", ws_size, (size_t)WS_END2, n_in);
    }
    (void)hipMemsetAsync((char*)d_ws + WS_CTL, 0, 1 * MiB, stream);
    Params p{};
    p.x = (const float*)d_in[0]; p.pos = (const int*)d_in[1]; p.norm1_g = (const float*)d_in[2]; p.w_in = (const float*)d_in[3]; p.q_a_g = (const float*)d_in[4];
    p.kv_a_g = (const float*)d_in[5]; p.w_uq = (const float*)d_in[6]; p.w_ukv = (const float*)d_in[7]; p.q_g = (const float*)d_in[8]; p.k_g = (const float*)d_in[9];
    p.conv_w = (const float*)d_in[10]; p.w_o_mla = (const float*)d_in[11]; p.w_o_conv = (const float*)d_in[12]; p.w_o = (const float*)d_in[13]; p.norm2_g = (const float*)d_in[14];
    p.router_w = (const float*)d_in[15]; p.router_b = (const float*)d_in[16]; p.w1 = (const float*)d_in[17]; p.b1 = (const float*)d_in[18]; p.w2 = (const float*)d_in[19]; p.b2 = (const float*)d_in[20];
    p.out = (float*)d_out; p.ws = (unsigned char*)d_ws; p.ph_lo = 0; p.ph_hi = NPHASE + 1;
    void* args[] = {&p};
    hipError_t e = hipLaunchCooperativeKernel((const void*)mk_fwd, dim3(grid_blocks), dim3(NTHREADS), args, LDS_BYTES, stream);
    if (e != hipSuccess) fprintf(stderr, "cooperative launch failed: %s (grid %d)\n", hipGetErrorString(e), grid_blocks);
}
```

```cpp
#include <hip/hip_runtime.h>
#include <hip/hip_cooperative_groups.h>
#include <cstdio>
#include <cstdint>
namespace cg = cooperative_groups;

typedef unsigned short bf16_t;
typedef short bf16x8 __attribute__((ext_vector_type(8)));
typedef short s16x4 __attribute__((ext_vector_type(4)));
typedef float f32x4 __attribute__((ext_vector_type(4)));
typedef float f32x2 __attribute__((ext_vector_type(2)));
typedef float f32x16 __attribute__((ext_vector_type(16)));
typedef unsigned u32x4 __attribute__((ext_vector_type(4)));
typedef unsigned u32x2 __attribute__((ext_vector_type(2)));
typedef __bf16 bf16x2_t __attribute__((ext_vector_type(2)));

constexpr int NTOK = 16384, DM = 1024, SEQ = 8192;
constexpr int INC = 4000, INCP = 4096;
constexpr int OFF_CQ = 0, OFF_CKV = 256, OFF_KR = 384, OFF_U = 416, OFF_C = 928, OFF_B = 1440, OFF_GA = 1952, OFF_GB = 2976;
constexpr int NH = 8, DQK = 96, DV = 64, NE = 32, TOPK = 4, DFF = 1024;
constexpr int QLORA = 256, KVLORA = 128, CONVW = 512;
constexpr int NPAIR = NTOK * TOPK;
constexpr int MAXROWS = 73728;
constexpr float EPS = 1e-6f;
constexpr float QSCALE = 0.10206207261596575f * 1.4426950408889634f;
constexpr int CAP = 16384;
constexpr int NTHREADS = 512, NWAVES = 8;
constexpr int LDS_BYTES = 147456;

constexpr size_t MiB = 1ull << 20;
constexpr size_t WS_CTL = 0;
constexpr size_t WS_WIN = 1 * MiB;
constexpr size_t WS_WUQ = 9 * MiB;
constexpr size_t WS_WUKV = WS_WUQ + 512 * 1024;
constexpr size_t WS_WOMLA = 10 * MiB;
constexpr size_t WS_WOCONV = 11 * MiB;
constexpr size_t WS_WO = 12 * MiB;
constexpr size_t WS_ROUTE = 14 * MiB;
constexpr size_t WS_W1 = 18 * MiB;
constexpr size_t WS_W2 = 146 * MiB;
constexpr size_t WS_XN = 210 * MiB;
constexpr size_t WS_PROJ = 242 * MiB;
constexpr size_t WS_CQN = 370 * MiB;
constexpr size_t WS_CKVN = 378 * MiB;
constexpr size_t WS_YBIN = 386 * MiB;
constexpr size_t WS_QPRE = 402 * MiB;
constexpr size_t WS_KVPRE = 450 * MiB;
constexpr size_t WS_Q = 514 * MiB;
constexpr size_t WS_K = 538 * MiB;
constexpr size_t WS_V = 570 * MiB;
constexpr size_t WS_AO = 586 * MiB;
constexpr size_t WS_M1 = 602 * MiB;
constexpr size_t WS_MERGED = 666 * MiB;
constexpr size_t WS_YS = 698 * MiB;
constexpr size_t WS_END = 826 * MiB;
constexpr size_t WS_ACT = WS_PROJ;
constexpr size_t WS_X1B = WS_M1;
constexpr size_t WS_H8 = WS_XN;
constexpr size_t WS_GF = 830 * MiB;
constexpr size_t WS_RT2 = 832 * MiB;
constexpr size_t WS_SSQ = 840 * MiB;
constexpr size_t WS_CS = 841 * MiB;
constexpr size_t WS_SHIFT = 843 * MiB;
constexpr size_t WS_END2 = 844 * MiB;
constexpr size_t RT_PAIR_E = 0, RT_PAIR_RANK = 262144, RT_PAIR_W = 524288, RT_ROW_TOK = 786432, RT_ROW_W = 786432 + 294912, RT_ROW_SLOT = 786432 + 2 * 294912;
constexpr int CW_CNT = 64;
constexpr int CW_BAR = 4096;
constexpr int MISC_OFF = LDS_BYTES - 256;

struct Params {
    const float* x; const int* pos; const float* norm1_g; const float* w_in; const float* q_a_g; const float* kv_a_g;
    const float* w_uq; const float* w_ukv; const float* q_g; const float* k_g; const float* conv_w; const float* w_o_mla;
    const float* w_o_conv; const float* w_o; const float* norm2_g; const float* router_w; const float* router_b;
    const float* w1; const float* b1; const float* w2; const float* b2;
    float* out; unsigned char* ws; int ph_lo, ph_hi;
};

__device__ __forceinline__ unsigned pk2(float lo, float hi) { f32x2 v = {lo, hi}; bf16x2_t b = __builtin_convertvector(v, bf16x2_t); return __builtin_bit_cast(unsigned, b); }
__device__ __forceinline__ float bf_lo(unsigned w) { return __uint_as_float(w << 16); }
__device__ __forceinline__ float bf_hi(unsigned w) { return __uint_as_float(w & 0xffff0000u); }
__device__ __forceinline__ float bf1(bf16_t h) { return __uint_as_float((unsigned)h << 16); }
__device__ __forceinline__ float wave_sum(float v) {
#pragma unroll
    for (int o = 1; o < 64; o <<= 1) v += __shfl_xor(v, o);
    return v;
}
__device__ __forceinline__ unsigned pk4_fp8(float a, float b, float c, float d) { unsigned w = 0u; w = (unsigned)__builtin_amdgcn_cvt_pk_fp8_f32(a, b, (int)w, false); w = (unsigned)__builtin_amdgcn_cvt_pk_fp8_f32(c, d, (int)w, true); return w; }
constexpr float Q8_SCALE = 4.f, K8_SCALE = 0.25f;
constexpr float W8_SCALE = 32.f, W8_INV = 1.f / 32.f, YS_SCALE = 8.f, YS_INV = 0.125f;
__device__ __forceinline__ float sigmoidf_(float v) { return __builtin_amdgcn_rcpf(1.f + __builtin_amdgcn_exp2f(v * -1.4426950408889634f)); }

namespace pg8 {
#define PG8_LAS __attribute__((address_space(3)))
constexpr int BM = 256, BK = 64, HALF = 128, HTB = HALF * BK * 2  , STAGE_BYTES = 8 * HTB, NXCD = 8, WGM = 8;

__host__ __device__ __forceinline__ int lds_byte(int r, int c) { const int st = (r >> 4) * 2 + (c >> 5), rr = r & 15, cc = c & 31, ob = rr * 64 + cc * 2; return st * 1024 + (ob ^ (((ob >> 9) & 1) << 5)); }
__host__ __device__ __forceinline__ void stage_rc(int b, int& R, int& C) { const int st = b / 1024, sb = b % 1024, swz = sb ^ (((sb >> 9) & 1) << 5); R = (st >> 1) * 16 + swz / 64; C = (st & 1) * 32 + (swz % 64) / 2; }
__host__ __device__ __forceinline__ int perm32(int rho) { const int n = rho >> 4, i = rho & 15; return 8 * (i >> 2) + 4 * n + (i & 3); }

struct Unit { int pm, pn, e, rb; };
struct Gemm { const bf16_t* A; const bf16_t* Bt; int M, N, K; size_t bstride; int lda, ldb; };

struct StaticOrder {
    int nM, nN, nwg, G, c;
    __host__ __device__ void init(int M, int N, int G_, int c_) { nM = M / BM; nN = N / BM; nwg = nM * nN; G = G_; c = c_; }
    __host__ __device__ bool next(int i, Unit& u) const {
        const long L = (long)i * G + c; if (L >= nwg) return false;
        int wgid = (int)L; { const int q = nwg / NXCD, r = nwg % NXCD, xcd = wgid % NXCD, off = wgid / NXCD; wgid = (xcd < r ? xcd * (q + 1) : r * (q + 1) + (xcd - r) * q) + off; }
        const int nig = WGM * nN, gid = wgid / nig, fm = gid * WGM, gsz = (nM - fm) < WGM ? (nM - fm) : WGM;
        u.pm = fm + ((wgid % nig) % gsz); u.pn = (wgid % nig) / gsz; u.e = 0; u.rb = 0; return true;
    }
    __device__ __forceinline__ void a_ready(const Unit&) const {}
    __device__ __forceinline__ void done(const Unit&) const {}
};


struct EpiProj {
    static constexpr bool PERM = true, AFTER_DRAIN = false;
    bf16_t* O; float* ssq;
    __device__ __forceinline__ void operator()(const f32x4 (&acc)[2][2][4][2], const Unit& u, int wr, int wc, int fr, int fq) const {
        const int row0 = u.pm * BM + wr * 64 + fr, col0 = u.pn * BM + wc * 32 + 8 * fq;
#pragma unroll
        for (int ai = 0; ai < 2; ++ai)
#pragma unroll
            for (int m = 0; m < 4; ++m) { const int row = row0 + ai * HALF + m * 16; bf16_t* rowp = O + (size_t)row * INCP + col0;
#pragma unroll
                for (int bj = 0; bj < 2; ++bj) { f32x4 v0 = acc[ai][bj][m][0], v1 = acc[ai][bj][m][1]; const int col = col0 + bj * HALF;
                    if (col >= OFF_GA && col < INC) {
#pragma unroll
                        for (int j = 0; j < 4; ++j) { v0[j] = sigmoidf_(v0[j]); v1[j] = sigmoidf_(v1[j]); } }
                    u32x4 w; w.x = pk2(v0[0], v0[1]); w.y = pk2(v0[2], v0[3]); w.z = pk2(v1[0], v1[1]); w.w = pk2(v1[2], v1[3]);
                    *(u32x4*)(rowp + bj * HALF) = w;
                    const int which = u.pn == 0 ? 0 : (u.pn == 1 ? (bj == 0 ? 1 : (wc == 0 ? 2 : -1)) : -1);
                    if (which >= 0) { float s = (v0[0] * v0[0] + v0[1] * v0[1]) + (v0[2] * v0[2] + v0[3] * v0[3]) + (v1[0] * v1[0] + v1[1] * v1[1]) + (v1[2] * v1[2] + v1[3] * v1[3]);
                        s += __shfl_xor(s, 16); s += __shfl_xor(s, 32); if (fq == 0) ssq[(size_t)row * 16 + (which == 0 ? wc * 2 + bj : (which == 1 ? 8 + wc : 12))] = s; } } }
    }
};
struct EpiBf16 {
    static constexpr bool PERM = true, AFTER_DRAIN = false;
    bf16_t* O; int ldc;
    __device__ __forceinline__ void operator()(const f32x4 (&acc)[2][2][4][2], const Unit& u, int wr, int wc, int fr, int fq) const {
        const int row0 = u.pm * BM + wr * 64 + fr, col0 = u.pn * BM + wc * 32 + 8 * fq;
#pragma unroll
        for (int ai = 0; ai < 2; ++ai)
#pragma unroll
            for (int m = 0; m < 4; ++m) { bf16_t* rowp = O + (size_t)(row0 + ai * HALF + m * 16) * ldc + col0;
#pragma unroll
                for (int bj = 0; bj < 2; ++bj) { const f32x4 v0 = acc[ai][bj][m][0], v1 = acc[ai][bj][m][1];
                    u32x4 w; w.x = pk2(v0[0], v0[1]); w.y = pk2(v0[2], v0[3]); w.z = pk2(v1[0], v1[1]); w.w = pk2(v1[2], v1[3]); *(u32x4*)(rowp + bj * HALF) = w; } }
    }
};
__device__ __forceinline__ void epi_bar() { asm volatile("s_waitcnt lgkmcnt(0)" ::: "memory"); __builtin_amdgcn_s_barrier(); asm volatile("" ::: "memory"); }
__device__ __forceinline__ u32x2 pk4bf(const f32x4 v) { u32x2 w; w.x = pk2(v[0], v[1]); w.y = pk2(v[2], v[3]); return w; }
struct EpiQ {
    static constexpr bool PERM = false, AFTER_DRAIN = false;
    unsigned char* Q; const float* ssq_cq; const float* qg; const float* cs; float* hs;
    __device__ __forceinline__ void operator()(f32x4 (&acc)[2][2][4][2], const Unit& u, int wr, int wc, int fr, int fq) const {
        int lr0 = wr * 64 + fr; asm volatile("" : "+v"(lr0), "+v"(fq));
        const int t0 = u.pm * BM + lr0;
#pragma unroll
        for (int ai = 0; ai < 2; ++ai)
#pragma unroll
            for (int m = 0; m < 4; ++m) { const f32x4 sa = *(const f32x4*)(ssq_cq + (size_t)(t0 + ai * HALF + m * 16) * 16), sb = *(const f32x4*)(ssq_cq + (size_t)(t0 + ai * HALF + m * 16) * 16 + 4);
                const float rq = rsqrtf((((sa[0] + sa[1]) + (sa[2] + sa[3])) + ((sb[0] + sb[1]) + (sb[2] + sb[3]))) * (1.f / QLORA) + EPS);
#pragma unroll
                for (int bj = 0; bj < 2; ++bj) { const f32x4 x0 = acc[ai][bj][m][0] * rq, x1 = acc[ai][bj][m][1] * rq; acc[ai][bj][m][0] = x0; acc[ai][bj][m][1] = x1;
                    float s = (x0[0] * x0[0] + x0[1] * x0[1]) + (x0[2] * x0[2] + x0[3] * x0[3]) + (x1[0] * x1[0] + x1[1] * x1[1]) + (x1[2] * x1[2] + x1[3] * x1[3]);
                    s += __shfl_xor(s, 16); s += __shfl_xor(s, 32); if (fq == 0) hs[((lr0 + ai * HALF + m * 16) * 2 + bj) * 4 + wc] = s; } }
        epi_bar();
        {
            f32x4 g0 = {0.f, 0.f, 0.f, 0.f}, g1 = g0; if (wc < 3) { g0 = *(const f32x4*)(qg + 32 * wc + 4 * fq); g1 = *(const f32x4*)(qg + 32 * wc + 16 + 4 * fq); }
#pragma unroll
            for (int ai = 0; ai < 2; ++ai)
#pragma unroll
                for (int m = 0; m < 4; ++m) { const int lr = lr0 + ai * HALF + m * 16, t = u.pm * BM + lr, b = t >> 13, s = t & (SEQ - 1);
                    f32x4 c4 = {0.f, 0.f, 0.f, 0.f}, s4 = {0.f, 0.f, 0.f, 0.f}; if (wc == 2) { c4 = *(const f32x4*)(cs + (size_t)t * 32 + 4 * fq); s4 = *(const f32x4*)(cs + (size_t)t * 32 + 16 + 4 * fq); }
#pragma unroll
                    for (int bj = 0; bj < 2; ++bj) { const f32x4 h4 = *(const f32x4*)(hs + (lr * 2 + bj) * 4); const float rstd = rsqrtf(((h4[0] + h4[1]) + h4[2]) * (1.f / DQK) + EPS) * (QSCALE * Q8_SCALE); f32x4 x0 = acc[ai][bj][m][0] * rstd * g0, x1 = acc[ai][bj][m][1] * rstd * g1;
                        if (wc == 2) { const f32x4 o0 = x0 * c4 - x1 * s4, o1 = x0 * s4 + x1 * c4; x0 = o0; x1 = o1; }
                        if (wc == 3 && fq == 0) x0[0] = Q8_SCALE;
                        unsigned char* qp = Q + ((size_t)(b * NH + 2 * u.pn + bj) * SEQ + s) * 128 + 32 * wc + 4 * fq; *(unsigned*)qp = pk4_fp8(x0[0], x0[1], x0[2], x0[3]); *(unsigned*)(qp + 16) = pk4_fp8(x1[0], x1[1], x1[2], x1[3]); }
                    asm volatile("" ::: "memory"); }
        }
    }
};
struct EpiK {
    static constexpr bool PERM = false, AFTER_DRAIN = false;
    unsigned char* K; const float* ssq; const float* kg; const float* cs; const bf16_t* proj; float* hs; const float* shiftp;
    __device__ __forceinline__ void operator()(f32x4 (&acc)[2][2][4][2], const Unit& u, int wr, int wc, int fr, int fq) const {
        int lr0 = wr * 64 + fr; asm volatile("" : "+v"(lr0), "+v"(fq));
        const int t0 = u.pm * BM + lr0, wp = wc & 1, wh = wc >> 1;
#pragma unroll
        for (int ai = 0; ai < 2; ++ai)
#pragma unroll
            for (int m = 0; m < 4; ++m) { const f32x4 sa = *(const f32x4*)(ssq + (size_t)(t0 + ai * HALF + m * 16) * 16 + 8); const float rk = rsqrtf(((sa[0] + sa[1]) + (sa[2] + sa[3])) * (1.f / KVLORA) + EPS);
#pragma unroll
                for (int bj = 0; bj < 2; ++bj) { const f32x4 x0 = acc[ai][bj][m][0] * rk, x1 = acc[ai][bj][m][1] * rk; acc[ai][bj][m][0] = x0; acc[ai][bj][m][1] = x1;
                    float s = (x0[0] * x0[0] + x0[1] * x0[1]) + (x0[2] * x0[2] + x0[3] * x0[3]) + (x1[0] * x1[0] + x1[1] * x1[1]) + (x1[2] * x1[2] + x1[3] * x1[3]);
                    s += __shfl_xor(s, 16); s += __shfl_xor(s, 32); if (fq == 0) hs[((lr0 + ai * HALF + m * 16) * 4 + 2 * bj + wh) * 2 + wp] = s; } }
        epi_bar();
        const f32x4 g0 = *(const f32x4*)(kg + 32 * wp + 4 * fq), g1 = *(const f32x4*)(kg + 32 * wp + 16 + 4 * fq);
        f32x4 gr0 = {0.f, 0.f, 0.f, 0.f}, gr1 = gr0; if (wp == 1) { gr0 = *(const f32x4*)(kg + 64 + 4 * fq); gr1 = *(const f32x4*)(kg + 80 + 4 * fq); }
        const unsigned kpad = (fq == 0) ? pk4_fp8(-shiftp[0] * K8_SCALE, 0.f, 0.f, 0.f) : 0u;
#pragma unroll
        for (int ai = 0; ai < 2; ++ai)
#pragma unroll
            for (int m = 0; m < 4; ++m) { const int lr = lr0 + ai * HALF + m * 16, t = u.pm * BM + lr, b = t >> 13, s = t & (SEQ - 1); const float skr = ssq[(size_t)t * 16 + 12];
                f32x4 c4 = {0.f, 0.f, 0.f, 0.f}, s4 = c4, r1 = c4, r2 = c4;
                if (wp == 1) { c4 = *(const f32x4*)(cs + (size_t)t * 32 + 4 * fq); s4 = *(const f32x4*)(cs + (size_t)t * 32 + 16 + 4 * fq);
                    const u32x2 a = *(const u32x2*)(proj + (size_t)t * INCP + OFF_KR + 4 * fq), bb = *(const u32x2*)(proj + (size_t)t * INCP + OFF_KR + 16 + 4 * fq);
                    r1 = (f32x4){bf_lo(a.x), bf_hi(a.x), bf_lo(a.y), bf_hi(a.y)} * gr0; r2 = (f32x4){bf_lo(bb.x), bf_hi(bb.x), bf_lo(bb.y), bf_hi(bb.y)} * gr1; }
#pragma unroll
                for (int bj = 0; bj < 2; ++bj) { const size_t rowi = (size_t)(b * NH + 4 * u.pn + 2 * bj + wh) * SEQ + s; const f32x2 h2 = *(const f32x2*)(hs + (lr * 4 + 2 * bj + wh) * 2);
                    const float rstd = rsqrtf(((h2[0] + h2[1]) + skr) * (1.f / DQK) + EPS) * K8_SCALE;
                    unsigned char* kp = K + rowi * 128; const f32x4 y0 = acc[ai][bj][m][0] * rstd * g0, y1 = acc[ai][bj][m][1] * rstd * g1;
                    *(unsigned*)(kp + 32 * wp + 4 * fq) = pk4_fp8(y0[0], y0[1], y0[2], y0[3]); *(unsigned*)(kp + 32 * wp + 16 + 4 * fq) = pk4_fp8(y1[0], y1[1], y1[2], y1[3]);
                    if (wp == 1) { const f32x4 x1 = r1 * rstd, x2 = r2 * rstd, z1 = x1 * c4 - x2 * s4, z2 = x1 * s4 + x2 * c4; *(unsigned*)(kp + 64 + 4 * fq) = pk4_fp8(z1[0], z1[1], z1[2], z1[3]); *(unsigned*)(kp + 80 + 4 * fq) = pk4_fp8(z2[0], z2[1], z2[2], z2[3]); }
                    else { *(u32x2*)(kp + 96 + 8 * fq) = (u32x2){kpad, 0u}; } }
                asm volatile("" ::: "memory"); }
    }
};
struct EpiVT {
    static constexpr bool PERM = true, AFTER_DRAIN = false;
    unsigned char* VT; const float* ssq;
    __device__ __forceinline__ void operator()(f32x4 (&acc)[2][2][4][2], const Unit& u, int wr, int wc, int fr, int fq) const {
        int tok0 = u.pn * BM + wc * 32 + 8 * fq; asm volatile("" : "+v"(tok0), "+v"(fr));
        float rs[2][8];
#pragma unroll
        for (int bj = 0; bj < 2; ++bj)
#pragma unroll
            for (int i = 0; i < 8; ++i) { const f32x4 sa = *(const f32x4*)(ssq + (size_t)(tok0 + bj * HALF + i) * 16 + 8); rs[bj][i] = rsqrtf(((sa[0] + sa[1]) + (sa[2] + sa[3])) * (1.f / KVLORA) + EPS); }
#pragma unroll
        for (int ai = 0; ai < 2; ++ai)
#pragma unroll
            for (int m = 0; m < 4; ++m) { const int row = u.pm * BM + ai * HALF + wr * 64 + m * 16 + fr, h = row >> 6, d = row & 63;
#pragma unroll
                for (int bj = 0; bj < 2; ++bj) { const int tok = tok0 + bj * HALF, b = tok >> 13, s = tok & (SEQ - 1); const f32x4 v0 = acc[ai][bj][m][0], v1 = acc[ai][bj][m][1];
                    const int k0 = s & 63, j0 = 4 * ((k0 >> 3) & 3) + 16 * (k0 >> 5), r32v = d & 31, off = (j0 & 15) + 16 * ((j0 >> 4) ^ ((r32v >> 3) & 1));
                    unsigned char* tp = VT + ((size_t)(b * NH + h) * (SEQ / 64) + (s >> 6)) * 4096 + (((d >> 5) * 32 + r32v) << 5) + off;
                    *(unsigned*)tp = pk4_fp8(v0[0] * rs[bj][0], v0[1] * rs[bj][1], v0[2] * rs[bj][2], v0[3] * rs[bj][3]);
                    *(unsigned*)(tp + 2048) = pk4_fp8(v1[0] * rs[bj][4], v1[1] * rs[bj][5], v1[2] * rs[bj][6], v1[3] * rs[bj][7]); } }
    }
};
struct EpiF32 {
    static constexpr bool PERM = false, AFTER_DRAIN = false;
    float* O; int ldc;
    __device__ __forceinline__ void operator()(const f32x4 (&acc)[2][2][4][2], const Unit& u, int wr, int wc, int fr, int fq) const {
        const int row0 = u.pm * BM + wr * 64 + fr, col0 = u.pn * BM + wc * 32 + 4 * fq;
#pragma unroll
        for (int ai = 0; ai < 2; ++ai)
#pragma unroll
            for (int m = 0; m < 4; ++m) { float* rowp = O + (size_t)(row0 + ai * HALF + m * 16) * ldc + col0;
#pragma unroll
                for (int bj = 0; bj < 2; ++bj)
#pragma unroll
                    for (int n = 0; n < 2; ++n) *(f32x4*)(rowp + bj * HALF + n * 16) = acc[ai][bj][m][n]; }
    }
};
__device__ __forceinline__ void unpack8(const u32x4 g, float (&f)[8]) { f[0] = bf_lo(g.x); f[1] = bf_hi(g.x); f[2] = bf_lo(g.y); f[3] = bf_hi(g.y); f[4] = bf_lo(g.z); f[5] = bf_hi(g.z); f[6] = bf_lo(g.w); f[7] = bf_hi(g.w); }
struct EpiGateA {
    static constexpr bool PERM = true, AFTER_DRAIN = false;
    bf16_t* M1; const bf16_t* proj;
    __device__ __forceinline__ void operator()(const f32x4 (&acc)[2][2][4][2], const Unit& u, int wr, int wc, int fr, int fq) const {
        const int row0 = u.pm * BM + wr * 64 + fr, col0 = u.pn * BM + wc * 32 + 8 * fq;
#pragma unroll
        for (int ai = 0; ai < 2; ++ai)
#pragma unroll
            for (int m = 0; m < 4; ++m) { const size_t row = (size_t)(row0 + ai * HALF + m * 16);
#pragma unroll
                for (int bj = 0; bj < 2; ++bj) { const int col = col0 + bj * HALF; float g[8]; unpack8(*(const u32x4*)(proj + row * INCP + OFF_GA + col), g);
                    const f32x4 v0 = acc[ai][bj][m][0], v1 = acc[ai][bj][m][1];
                    u32x4 w; w.x = pk2(v0[0] * g[0], v0[1] * g[1]); w.y = pk2(v0[2] * g[2], v0[3] * g[3]); w.z = pk2(v1[0] * g[4], v1[1] * g[5]); w.w = pk2(v1[2] * g[6], v1[3] * g[7]);
                    *(u32x4*)(M1 + row * DM + col) = w; } }
    }
};
struct EpiGateB {
    static constexpr bool PERM = true, AFTER_DRAIN = false;
    const bf16_t* M1; const bf16_t* proj; bf16_t* O;
    __device__ __forceinline__ void operator()(const f32x4 (&acc)[2][2][4][2], const Unit& u, int wr, int wc, int fr, int fq) const {
        const int row0 = u.pm * BM + wr * 64 + fr, col0 = u.pn * BM + wc * 32 + 8 * fq;
#pragma unroll
        for (int ai = 0; ai < 2; ++ai)
#pragma unroll
            for (int m = 0; m < 4; ++m) { const size_t row = (size_t)(row0 + ai * HALF + m * 16);
#pragma unroll
                for (int bj = 0; bj < 2; ++bj) { const int col = col0 + bj * HALF; float g[8], b[8]; unpack8(*(const u32x4*)(proj + row * INCP + OFF_GB + col), g); unpack8(*(const u32x4*)(M1 + row * DM + col), b);
                    const f32x4 v0 = acc[ai][bj][m][0], v1 = acc[ai][bj][m][1];
                    u32x4 w; w.x = pk2(b[0] + v0[0] * g[0], b[1] + v0[1] * g[1]); w.y = pk2(b[2] + v0[2] * g[2], b[3] + v0[3] * g[3]);
                    w.z = pk2(b[4] + v1[0] * g[4], b[5] + v1[1] * g[5]); w.w = pk2(b[6] + v1[2] * g[6], b[7] + v1[3] * g[7]);
                    *(u32x4*)(O + row * DM + col) = w; } }
    }
};
struct EpiResid {
    static constexpr bool PERM = false, AFTER_DRAIN = false;
    const float* X; bf16_t* O;
    __device__ __forceinline__ void operator()(const f32x4 (&acc)[2][2][4][2], const Unit& u, int wr, int wc, int fr, int fq) const {
        const int row0 = u.pm * BM + wr * 64 + fr, col0 = u.pn * BM + wc * 32 + 4 * fq;
#pragma unroll
        for (int ai = 0; ai < 2; ++ai)
#pragma unroll
            for (int m = 0; m < 4; ++m) { const size_t off = (size_t)(row0 + ai * HALF + m * 16) * DM + col0;
#pragma unroll
                for (int bj = 0; bj < 2; ++bj)
#pragma unroll
                    for (int n = 0; n < 2; ++n) { const f32x4 b = *(const f32x4*)(X + off + bj * HALF + n * 16) + acc[ai][bj][m][n]; u32x2 w; w.x = pk2(b[0], b[1]); w.y = pk2(b[2], b[3]); *(u32x2*)(O + off + bj * HALF + n * 16) = w; } }
    }
};
struct EpiSwiglu {
    static constexpr bool PERM = true, AFTER_DRAIN = false;
    unsigned char* ACT; const float* b1; const float* row_rstd;
    __device__ __forceinline__ void operator()(const f32x4 (&acc)[2][2][4][2], const Unit& u, int wr, int wc, int fr, int fq) const {
        const int row0 = u.pm * BM + wr * 64 + fr, f0 = u.pn * HALF + wc * 32 + 8 * fq; const float* be = b1 + (size_t)u.e * 2048;
        const f32x4 bg0 = *(const f32x4*)(be + f0), bg1 = *(const f32x4*)(be + f0 + 4), bu0 = *(const f32x4*)(be + DFF + f0), bu1 = *(const f32x4*)(be + DFF + f0 + 4);
        float rsv[8];
#pragma unroll
        for (int i = 0; i < 8; ++i) rsv[i] = row_rstd[u.rb + wr * 64 + fr + (i >> 2) * HALF + (i & 3) * 16] * W8_INV;
#pragma unroll
        for (int ai = 0; ai < 2; ++ai)
#pragma unroll
            for (int m = 0; m < 4; ++m) { const size_t row = (size_t)(row0 + ai * HALF + m * 16); float o[8]; const float rs = rsv[ai * 4 + m];
#pragma unroll
                for (int n = 0; n < 2; ++n) { const f32x4 g4 = acc[ai][0][m][n] * rs + (n ? bg1 : bg0), u4 = acc[ai][1][m][n] * rs + (n ? bu1 : bu0);
#pragma unroll
                    for (int j = 0; j < 4; ++j) { const float g = fminf(g4[j], 7.f), uu = fminf(fmaxf(u4[j], -7.f), 7.f); o[4 * n + j] = (uu + 1.f) * (g * sigmoidf_(1.702f * g)); } }
                u32x2 w; w.x = pk4_fp8(o[0], o[1], o[2], o[3]); w.y = pk4_fp8(o[4], o[5], o[6], o[7]); *(u32x2*)(ACT + row * DFF + f0) = w; }
    }
};
struct EpiMoeOut {
    static constexpr bool PERM = true, AFTER_DRAIN = false;
    unsigned char* YS; const float* b2; const float* row_w; const int* row_slot;
    __device__ __forceinline__ void operator()(const f32x4 (&acc)[2][2][4][2], const Unit& u, int wr, int wc, int fr, int fq) const {
        const int col0 = u.pn * BM + wc * 32 + 8 * fq; const float* be = b2 + (size_t)u.e * DM; const int rbase = u.rb + wr * 64 + fr;
        int slot[8]; float w[8];
#pragma unroll
        for (int i = 0; i < 8; ++i) { const int row = rbase + (i >> 2) * HALF + (i & 3) * 16; slot[i] = row_slot[row]; w[i] = row_w[row] * (W8_INV * YS_SCALE); }
        f32x4 bv[2][2];
#pragma unroll
        for (int bj = 0; bj < 2; ++bj)
#pragma unroll
            for (int n = 0; n < 2; ++n) bv[bj][n] = *(const f32x4*)(be + col0 + bj * HALF + 4 * n) * W8_SCALE;
#pragma unroll
        for (int ai = 0; ai < 2; ++ai)
#pragma unroll
            for (int m = 0; m < 4; ++m) { const int i = ai * 4 + m;
                if (slot[i] >= 0) { unsigned char* rowp = YS + (size_t)slot[i] * DM + col0;
#pragma unroll
                    for (int bj = 0; bj < 2; ++bj) { const f32x4 v0 = (acc[ai][bj][m][0] + bv[bj][0]) * w[i], v1 = (acc[ai][bj][m][1] + bv[bj][1]) * w[i];
                        u32x2 o; o.x = pk4_fp8(v0[0], v0[1], v0[2], v0[3]); o.y = pk4_fp8(v1[0], v1[1], v1[2], v1[3]); *(u32x2*)(rowp + bj * HALF) = o; } } }
    }
};
constexpr int MOE_MAXU = 12;
struct MoeOrder {
    StaticOrder so; const PG8_LAS int* utab; const PG8_LAS int* gtab;
    __device__ __forceinline__ bool next(int i, Unit& u) const { if (i >= MOE_MAXU || !so.next(i, u)) return false; const int v = __builtin_amdgcn_readfirstlane(utab[i]); u.e = v & 31; u.rb = (int)((unsigned)v >> 8); return true; }
    __device__ __forceinline__ void a_ready(const Unit&) const {}
    __device__ __forceinline__ void done(const Unit&) const {}
};
typedef int i32x4_t __attribute__((ext_vector_type(4))); typedef int i32x8_t __attribute__((ext_vector_type(8)));
__device__ __forceinline__ i32x8_t cat8(bf16x8 lo, bf16x8 hi) { return __builtin_shufflevector(__builtin_bit_cast(i32x4_t, lo), __builtin_bit_cast(i32x4_t, hi), 0, 1, 2, 3, 4, 5, 6, 7); }
__device__ __forceinline__ void mfma_fp8_inplace(f32x4& c, const i32x8_t a, const i32x8_t b) { asm volatile("s_nop 1\n\tv_mfma_f32_16x16x128_f8f6f4 %0, %1, %2, %0" : "+v"(c) : "v"(a), "v"(b)); }
__device__ __forceinline__ void mfma_fp8_drain() { asm volatile("s_nop 15\n\ts_nop 7" ::: "memory"); __builtin_amdgcn_sched_barrier(0); }
template <class Epi, class Sched, bool ALIGN_EPI = false, bool SP2 = false, bool FP8 = false, bool GATHER = false>
__device__ __forceinline__ void gemm_phase(PG8_LAS unsigned char* lds, const Gemm g, const Sched& S, const Epi& E) {
    int tid = threadIdx.x; asm volatile("" : "+v"(tid));
    const int wid = __builtin_amdgcn_readfirstlane(tid >> 6), lane = tid & 63, wr = wid >> 2, wc = wid & 3, fr = lane & 15, fq = lane >> 4;
    const int K = g.K, nt = K / BK;
    static_assert(!GATHER || SP2, "GATHER is implemented for the SP2 loop only");
    const unsigned rowA = (unsigned)(g.lda ? g.lda : K) * 2u, rowB = (unsigned)(g.ldb ? g.ldb : K) * 2u;
    unsigned voffA[2], voffB[2]; int gR0 = 0; unsigned gC = 0u;
#pragma unroll
    for (int i = 0; i < 2; ++i) { int R, C; stage_rc(tid * 16 + i * 8192, R, C); const int Rb = Epi::PERM ? ((R & ~31) + perm32(R & 31)) : R;
        voffA[i] = (unsigned)R * rowA + (unsigned)C * 2u; voffB[i] = (unsigned)Rb * rowB + (unsigned)C * 2u; if (i == 0) { gR0 = R; gC = (unsigned)C * 2u; } }
    unsigned gA[2][2] = {{0u, 0u}, {0u, 0u}}, ngA[2][2] = {{0u, 0u}, {0u, 0u}};
#define PG8_GLOAD(dst, ui_) do { _Pragma("unroll") for (int h_ = 0; h_ < 2; ++h_) _Pragma("unroll") for (int i_ = 0; i_ < 2; ++i_) \
        dst[h_][i_] = (unsigned)S.gtab[(ui_) * 256 + 128 * h_ + gR0 + 64 * i_] * rowA + gC; } while (0)
#define PG8_VA(h) (GATHER ? gA[h] : voffA)
    const unsigned kstep = (unsigned)(BK * 2);
    const unsigned hstep = (unsigned)HALF * rowB;
    const unsigned tstep = 2u * hstep;
    const unsigned hstepA = (unsigned)HALF * rowA, tstepA = 2u * hstepA;
    const unsigned hsA = GATHER ? 0u : hstepA;
    const unsigned ldsw = (unsigned)wid * 1024u;
    const int aoff = lds_byte(wr * 64 + fr, fq * 8), boff = lds_byte(wc * 32 + fr, fq * 8);
#define PG8_SA(b, h) (((b) * 2 + (h)) * HTB)
#define PG8_SB(b, h) ((4 + (b) * 2 + (h)) * HTB)
#define PG8_STAGE(rs, bufoff, goff, voff) do { _Pragma("unroll") for (int _i = 0; _i < 2; ++_i) \
        __builtin_amdgcn_raw_ptr_buffer_load_lds(rs, (PG8_LAS void*)(lds + (bufoff) + ldsw + _i * 8192), 16, (int)(voff)[_i], (int)(goff), 0, 0); } while (0)
#define PG8_LDA(dst, b, h) do { _Pragma("unroll") for (int m = 0; m < 4; ++m) _Pragma("unroll") for (int k = 0; k < 2; ++k) dst[m][k] = *(const PG8_LAS bf16x8*)(lds + PG8_SA(b, h) + aoff + m * 2048 + k * 1024); } while (0)
#define PG8_LDB(dst, b, h) do { _Pragma("unroll") for (int n = 0; n < 2; ++n) _Pragma("unroll") for (int k = 0; k < 2; ++k) dst[n][k] = *(const PG8_LAS bf16x8*)(lds + PG8_SB(b, h) + boff + n * 2048 + k * 1024); } while (0)
#define PG8_MMA(ai, bj, At, Bt) do { __builtin_amdgcn_s_setprio(1); _Pragma("unroll") for (int m = 0; m < 4; ++m) _Pragma("unroll") for (int n = 0; n < 2; ++n) { \
        if constexpr (FP8) { mfma_fp8_inplace(acc[ai][bj][m][n], cat8(Bt[n][0], Bt[n][1]), cat8(At[m][0], At[m][1])); } \
        else { _Pragma("unroll") for (int k = 0; k < 2; ++k) acc[ai][bj][m][n] = __builtin_amdgcn_mfma_f32_16x16x32_bf16(Bt[n][k], At[m][k], acc[ai][bj][m][n], 0, 0, 0); } } \
        __builtin_amdgcn_s_setprio(0); } while (0)
#define PG8_WAIT_V(n) asm volatile("s_waitcnt vmcnt(" #n ")" ::: "memory")
#define PG8_WAIT_L(n) asm volatile("s_waitcnt lgkmcnt(" #n ")" ::: "memory")
#define PG8_BAR __builtin_amdgcn_s_barrier()
#define PG8_SCHED __builtin_amdgcn_sched_barrier(0)
    Unit cur, nxt; int ui = 0;
    if (!S.next(0, cur)) return;
    f32x4 acc[2][2][4][2];
#pragma unroll
    for (int a = 0; a < 2; ++a)
#pragma unroll
        for (int b = 0; b < 2; ++b)
#pragma unroll
            for (int m = 0; m < 4; ++m)
#pragma unroll
                for (int n = 0; n < 2; ++n) acc[a][b][m][n] = (f32x4){0.f, 0.f, 0.f, 0.f};
    bf16x8 At[4][2], B0[2][2], B1[2][2];
    unsigned cA = GATHER ? 0u : (unsigned)cur.pm * tstepA, cB = (unsigned)cur.e * (unsigned)g.bstride + (unsigned)cur.pn * tstep;
    const __amdgpu_buffer_rsrc_t rsA = __builtin_amdgcn_make_buffer_rsrc((void*)g.A, 0, 0x7fffffff, 0x00020000), rsB = __builtin_amdgcn_make_buffer_rsrc((void*)g.Bt, 0, 0x7fffffff, 0x00020000);
    S.a_ready(cur);
    if constexpr (GATHER) PG8_GLOAD(gA, 0);
    if constexpr (SP2) {
        PG8_STAGE(rsB, PG8_SB(0, 0), cB, voffB); PG8_STAGE(rsB, PG8_SB(0, 1), cB + hstep, voffB); PG8_STAGE(rsA, PG8_SA(0, 0), cA, PG8_VA(0)); PG8_STAGE(rsA, PG8_SA(0, 1), cA + hsA, PG8_VA(1));
        if (wr == 1) PG8_BAR;
        PG8_WAIT_V(2); PG8_BAR;
        PG8_STAGE(rsB, PG8_SB(1, 0), cB + kstep, voffB); PG8_STAGE(rsA, PG8_SA(1, 0), cA + kstep, PG8_VA(0)); PG8_STAGE(rsB, PG8_SB(1, 1), cB + hstep + kstep, voffB);
        PG8_WAIT_V(6); PG8_BAR;
    } else {
        PG8_STAGE(rsB, PG8_SB(0, 0), cB, voffB); PG8_STAGE(rsA, PG8_SA(0, 0), cA, PG8_VA(0)); PG8_STAGE(rsB, PG8_SB(0, 1), cB + hstep, voffB); PG8_STAGE(rsA, PG8_SA(0, 1), cA + hsA, PG8_VA(1));
        if (wr == 1) PG8_BAR;
        PG8_WAIT_V(4); PG8_BAR;
        PG8_STAGE(rsB, PG8_SB(1, 0), cB + kstep, voffB); PG8_STAGE(rsA, PG8_SA(1, 0), cA + kstep, PG8_VA(0)); PG8_STAGE(rsB, PG8_SB(1, 1), cB + hstep + kstep, voffB);
        PG8_WAIT_V(6); PG8_BAR;
    }
    for (;;) {
        const bool has_next = S.next(ui + 1, nxt);
        if constexpr (GATHER) { if (has_next) PG8_GLOAD(ngA, ui + 1); else { ngA[0][0] = gA[0][0]; ngA[0][1] = gA[0][1]; ngA[1][0] = gA[1][0]; ngA[1][1] = gA[1][1]; } }
        const unsigned nA = (has_next && !GATHER) ? (unsigned)nxt.pm * tstepA : cA, nB = has_next ? (unsigned)nxt.e * (unsigned)g.bstride + (unsigned)nxt.pn * tstep : cB;
        for (int t = 0; t < nt; t += 2) {
            const bool last = (t == nt - 2);
            const unsigned a1 = cA + (unsigned)(t + 1) * kstep;
            const unsigned a2 = last ? nA : cA + (unsigned)(t + 2) * kstep, b2 = last ? nB : cB + (unsigned)(t + 2) * kstep;
            const unsigned a3 = a2 + kstep, b3 = b2 + kstep;
            if (last && has_next) S.a_ready(nxt);
            if constexpr (SP2) {
            PG8_LDB(B0, 0, 0); PG8_LDB(B1, 0, 1); PG8_SCHED; PG8_LDA(At, 0, 0); PG8_STAGE(rsA, PG8_SA(1, 1), a1 + hsA, PG8_VA(1));
            if constexpr (GATHER) { if (last) { gA[0][0] = ngA[0][0]; gA[0][1] = ngA[0][1]; gA[1][0] = ngA[1][0]; gA[1][1] = ngA[1][1]; } }
            PG8_WAIT_V(8); PG8_WAIT_L(0); PG8_BAR; PG8_MMA(0, 0, At, B0); PG8_MMA(0, 1, At, B1); PG8_BAR; PG8_SCHED;
            PG8_LDA(At, 0, 1); PG8_STAGE(rsB, PG8_SB(0, 0), b2, voffB); PG8_STAGE(rsB, PG8_SB(0, 1), b2 + hstep, voffB); PG8_STAGE(rsA, PG8_SA(0, 0), a2, PG8_VA(0));
            PG8_WAIT_V(8); PG8_WAIT_L(0); PG8_BAR; PG8_MMA(1, 0, At, B0); PG8_MMA(1, 1, At, B1); PG8_BAR; PG8_SCHED;
            PG8_LDB(B0, 1, 0); PG8_LDB(B1, 1, 1); PG8_SCHED; PG8_LDA(At, 1, 0); PG8_STAGE(rsA, PG8_SA(0, 1), a2 + hsA, PG8_VA(1));
            PG8_WAIT_V(8); PG8_WAIT_L(0); PG8_BAR; PG8_MMA(0, 0, At, B0); PG8_MMA(0, 1, At, B1); PG8_BAR; PG8_SCHED;
            PG8_LDA(At, 1, 1); PG8_STAGE(rsB, PG8_SB(1, 0), b3, voffB); PG8_STAGE(rsB, PG8_SB(1, 1), b3 + hstep, voffB); PG8_STAGE(rsA, PG8_SA(1, 0), a3, PG8_VA(0));
            PG8_WAIT_V(8); PG8_WAIT_L(0); PG8_BAR; PG8_MMA(1, 0, At, B0); PG8_MMA(1, 1, At, B1); PG8_BAR; PG8_SCHED;
            } else {
            PG8_LDB(B0, 0, 0); PG8_SCHED; PG8_LDA(At, 0, 0); PG8_STAGE(rsA, PG8_SA(1, 1), a1 + hsA, PG8_VA(1));
            PG8_WAIT_L(8); PG8_BAR; PG8_WAIT_L(0); PG8_MMA(0, 0, At, B0); PG8_BAR; PG8_SCHED;
            PG8_LDB(B1, 0, 1); PG8_STAGE(rsB, PG8_SB(0, 0), b2, voffB);
            PG8_BAR; PG8_WAIT_L(0); PG8_MMA(0, 1, At, B1); PG8_BAR;
            PG8_LDA(At, 0, 1); PG8_STAGE(rsA, PG8_SA(0, 0), a2, PG8_VA(0));
            PG8_BAR; PG8_WAIT_L(0); PG8_MMA(1, 0, At, B0); PG8_BAR; PG8_SCHED;
            PG8_STAGE(rsB, PG8_SB(0, 1), b2 + hstep, voffB);
            PG8_WAIT_V(6); PG8_BAR; PG8_MMA(1, 1, At, B1); PG8_BAR;
            PG8_LDB(B0, 1, 0); PG8_SCHED; PG8_LDA(At, 1, 0); PG8_STAGE(rsA, PG8_SA(0, 1), a2 + hsA, PG8_VA(1));
            PG8_WAIT_L(8); PG8_BAR; PG8_WAIT_L(0); PG8_MMA(0, 0, At, B0); PG8_BAR; PG8_SCHED;
            PG8_LDB(B1, 1, 1); PG8_STAGE(rsB, PG8_SB(1, 0), b3, voffB);
            PG8_BAR; PG8_WAIT_L(0); PG8_MMA(0, 1, At, B1); PG8_BAR;
            PG8_LDA(At, 1, 1); PG8_STAGE(rsA, PG8_SA(1, 0), a3, PG8_VA(0));
            PG8_BAR; PG8_WAIT_L(0); PG8_MMA(1, 0, At, B0); PG8_BAR; PG8_SCHED;
            PG8_STAGE(rsB, PG8_SB(1, 1), b3 + hstep, voffB);
            PG8_WAIT_V(6); PG8_BAR; PG8_MMA(1, 1, At, B1); PG8_BAR;
            }
        }
        if constexpr (ALIGN_EPI) { if (wr == 0) PG8_BAR; }
        if constexpr (FP8) mfma_fp8_drain();
        if constexpr (!Epi::AFTER_DRAIN) { E(acc, cur, wr, wc, fr, fq); S.done(cur); }
        if (!has_next) break;
#pragma unroll
        for (int a = 0; a < 2; ++a)
#pragma unroll
            for (int b = 0; b < 2; ++b)
#pragma unroll
                for (int m = 0; m < 4; ++m)
#pragma unroll
                    for (int n = 0; n < 2; ++n) acc[a][b][m][n] = (f32x4){0.f, 0.f, 0.f, 0.f};
        cur = nxt; cA = nA; cB = nB; ++ui;
        if constexpr (ALIGN_EPI) { if (wr == 1) PG8_BAR; }
    }
    PG8_WAIT_V(0);
    if constexpr (!ALIGN_EPI) { if (wr == 0) PG8_BAR; }
    PG8_BAR;
    if constexpr (Epi::AFTER_DRAIN) { E.fused(acc, cur, wr, wc, fr, fq, lds, wid, lane); S.done(cur); }
#undef PG8_SA
#undef PG8_GLOAD
#undef PG8_VA
#undef PG8_SB
#undef PG8_STAGE
#undef PG8_LDA
#undef PG8_LDB
#undef PG8_MMA
#undef PG8_WAIT_V
#undef PG8_WAIT_L
#undef PG8_BAR
#undef PG8_SCHED
}
}

#define GAS __attribute__((address_space(1)))
#define LAS __attribute__((address_space(3)))
#define XB_TMO      128
#define XB_XCNT(j)  (256  + 64 * (j))
#define XB_XSUB(j)  (1280 + 64 * (j))
#define XB_XGEN(j)  (2304 + 64 * (j))
#define XB_TOP      3328
#define XB_TOPGEN   3392
#define XCD_BAR_WORDS 3456
#define XB_SPIN_CAP (1u << 18)

__device__ __forceinline__ unsigned xb_ld(unsigned* p)              { return __hip_atomic_load(p, __ATOMIC_RELAXED, __HIP_MEMORY_SCOPE_AGENT); }
__device__ __forceinline__ unsigned xb_add(unsigned* p, unsigned v) { return __hip_atomic_fetch_add(p, v, __ATOMIC_RELAXED, __HIP_MEMORY_SCOPE_AGENT); }
__device__ __forceinline__ unsigned xb_xcc_id() { return (unsigned)__builtin_amdgcn_s_getreg((3 << 11) | 20) & 0xFu; }
#define XB_SPIN(cond, bar) do { unsigned _sp = 0; while (cond) { __builtin_amdgcn_s_sleep(1); \
    if ((++_sp & 255u) == 0u) { if (xb_ld(&(bar)[XB_TMO])) break; if (_sp > XB_SPIN_CAP) { atomicAdd(&(bar)[XB_TMO], 1u); break; } } } } while (0)

struct XcdBarrier {
    unsigned* bar; unsigned x;
    volatile LAS unsigned* st;
};

__device__ __forceinline__ XcdBarrier xcd_barrier_post(unsigned* bar, volatile LAS unsigned* st) {
    XcdBarrier b; b.bar = bar; b.x = xb_xcc_id(); b.st = st;
    if (threadIdx.x == 0) (void)xb_add(&bar[XB_XCNT(b.x)], 1u);
    return b;
}
__device__ __forceinline__ void xcd_barrier_complete(unsigned* bar, unsigned x, unsigned& nloc, unsigned& nx) {
    const unsigned G = gridDim.x * gridDim.y * gridDim.z;
    unsigned sum, cnt, mine, sp = 0u;
    for (;;) {
        sum = 0u; cnt = 0u; mine = 0u;
#pragma unroll
        for (unsigned j = 0; j < 16; ++j) { const unsigned c = xb_ld(&bar[XB_XCNT(j)]); sum += c; cnt += (c > 0u) ? 1u : 0u; mine = (j == x) ? c : mine; }
        if (sum == G) break;
        __builtin_amdgcn_s_sleep(1);
        if ((++sp & 255u) == 0u) { if (xb_ld(&bar[XB_TMO])) break; if (sp > XB_SPIN_CAP) { atomicAdd(&bar[XB_TMO], 1u); break; } }
    }
    nloc = mine > 0u ? mine : 1u; nx = cnt > 0u ? cnt : 1u;
}

__device__ __forceinline__ void xcd_barrier(const XcdBarrier& b) {
    asm volatile("s_waitcnt vmcnt(0)" ::: "memory");
    __syncthreads();
    if (threadIdx.x == 0) {
        unsigned* bar = b.bar;
        __builtin_amdgcn_s_waitcnt(0);
        unsigned nloc = b.st[0], nx = b.st[1];
        if (nloc == 0u) { xcd_barrier_complete(bar, b.x, nloc, nx); b.st[0] = nloc; b.st[1] = nx; }
        const unsigned old = xb_add(&bar[XB_XSUB(b.x)], 1u);
        const unsigned gen = old / nloc;
        if (old + 1u == (gen + 1u) * nloc) {
            __builtin_amdgcn_fence(__ATOMIC_RELEASE, "agent");
            asm volatile("s_waitcnt vmcnt(0)" ::: "memory");
            const unsigned og = xb_add(&bar[XB_TOP], 1u);
            const unsigned tg = og / nx;
            if (og + 1u == (tg + 1u) * nx) xb_add(&bar[XB_TOPGEN], 1u);
            else XB_SPIN(xb_ld(&bar[XB_TOPGEN]) == tg, bar);
            __builtin_amdgcn_fence(__ATOMIC_ACQUIRE, "agent");
            xb_add(&bar[XB_XGEN(b.x)], 1u);
            asm volatile("s_waitcnt vmcnt(0)" ::: "memory");
        } else {
            XB_SPIN(xb_ld(&bar[XB_XGEN(b.x)]) == gen, bar);
            __builtin_amdgcn_fence(__ATOMIC_ACQUIRE, "agent");
            asm volatile("s_waitcnt vmcnt(0)" ::: "memory");
        }
    }
    __syncthreads();
}

template <int MODE  >
__device__ __forceinline__ void transpose_item(const float* __restrict__ W, int K, int N, bf16_t* __restrict__ WT, const float* __restrict__ gain, float* scr, int item, int lane) {
    const int nblk = N / 32, kb = item / nblk, nb = item % nblk, k0 = 64 * kb, n0 = 32 * nb;
#pragma unroll
    for (int i = 0; i < 8; ++i) { const int kk = 8 * i + (lane >> 3), n4 = (lane & 7) * 4; f32x4 v = *(const f32x4*)(W + (size_t)(k0 + kk) * N + n0 + n4);
        if (gain) { const float g = gain[k0 + kk]; v = v * g; }
        float* s = scr + kk * 33 + n4; s[0] = v[0]; s[1] = v[1]; s[2] = v[2]; s[3] = v[3]; }
    asm volatile("s_waitcnt lgkmcnt(0)" ::: "memory");
    const int c = lane & 7;
#pragma unroll
    for (int j = 0; j < 4; ++j) { const int n = (lane >> 3) + 8 * j; const float* s = scr + (8 * c) * 33 + n;
        u32x4 o; o.x = pk2(s[0 * 33], s[1 * 33]); o.y = pk2(s[2 * 33], s[3 * 33]); o.z = pk2(s[4 * 33], s[5 * 33]); o.w = pk2(s[6 * 33], s[7 * 33]);
        int row = n0 + n;
        if (MODE == 1) { const int f = row & 1023; row = ((f >> 7) << 8) + ((row >> 10) << 7) + (f & 127); }
        if (MODE == 2) { const int hh = row / DQK; row = hh * 128 + (row - hh * DQK); }
        if (MODE == 3) { const int hh = row >> 7, ii = row & 127; row = ((ii >> 6) << 9) + hh * 64 + (ii & 63); }
        *(u32x4*)(WT + (size_t)row * K + k0 + 8 * c) = o; }
    asm volatile("s_waitcnt lgkmcnt(0)" ::: "memory");
}
template <int MODE>
__device__ __forceinline__ void transpose_item_fp8(const float* __restrict__ W, int K, int N, unsigned char* __restrict__ WT, float* scr, int item, int lane) {
    const int nblk = N / 32, kb = item / nblk, nb = item % nblk, k0 = 64 * kb, n0 = 32 * nb;
#pragma unroll
    for (int i = 0; i < 8; ++i) { const int kk = 8 * i + (lane >> 3), n4 = (lane & 7) * 4; const f32x4 v = *(const f32x4*)(W + (size_t)(k0 + kk) * N + n0 + n4) * W8_SCALE;
        float* s = scr + kk * 33 + n4; s[0] = v[0]; s[1] = v[1]; s[2] = v[2]; s[3] = v[3]; }
    asm volatile("s_waitcnt lgkmcnt(0)" ::: "memory");
    const int c = lane & 7;
#pragma unroll
    for (int j = 0; j < 4; ++j) { const int n = (lane >> 3) + 8 * j; const float* s = scr + (8 * c) * 33 + n;
        u32x2 o; o.x = pk4_fp8(s[0 * 33], s[1 * 33], s[2 * 33], s[3 * 33]); o.y = pk4_fp8(s[4 * 33], s[5 * 33], s[6 * 33], s[7 * 33]);
        int row = n0 + n;
        if (MODE == 1) { const int f = row & 1023; row = ((f >> 7) << 8) + ((row >> 10) << 7) + (f & 127); }
        *(u32x2*)(WT + (size_t)row * K + k0 + 8 * c) = o; }
    asm volatile("s_waitcnt lgkmcnt(0)" ::: "memory");
}
__device__ __forceinline__ void phase_prologue(const Params& p, unsigned char* lds) {
    const int tid = threadIdx.x, lane = tid & 63, wave = tid >> 6;
    float* scr = (float*)(lds + wave * 16384);
    const int gw = blockIdx.x * NWAVES + wave, NGW = gridDim.x * NWAVES;
    unsigned char* ws = p.ws;
    constexpr int I_WIN = (DM / 64) * (INC / 32), I_UQ = (QLORA / 64) * (768 / 32), I_UKV = (KVLORA / 64) * (1024 / 32), I_OM = (512 / 64) * (DM / 32), I_OC = I_OM, I_WO = (DM / 64) * (DM / 32);
    constexpr int I_W1 = (DM / 64) * (2048 / 32), I_W2 = (DFF / 64) * (DM / 32);
    constexpr int NSMALL = I_WIN + I_UQ + I_UKV + I_OM + I_OC + I_WO;
    constexpr int NITEMS = NSMALL;
    for (int it = gw; it < NITEMS; it += NGW) {
        int r = it;
        if (r < I_WIN) { transpose_item<0>(p.w_in, DM, INC, (bf16_t*)(ws + WS_WIN), p.norm1_g, scr, r, lane); continue; } r -= I_WIN;
        if (r < I_UQ) { transpose_item<2>(p.w_uq, QLORA, 768, (bf16_t*)(ws + WS_WUQ), p.q_a_g, scr, r, lane); continue; } r -= I_UQ;
        if (r < I_UKV) { transpose_item<3>(p.w_ukv, KVLORA, 1024, (bf16_t*)(ws + WS_WUKV), p.kv_a_g, scr, r, lane); continue; } r -= I_UKV;
        if (r < I_OM) { transpose_item<0>(p.w_o_mla, 512, DM, (bf16_t*)(ws + WS_WOMLA), nullptr, scr, r, lane); continue; } r -= I_OM;
        if (r < I_OC) { transpose_item<0>(p.w_o_conv, 512, DM, (bf16_t*)(ws + WS_WOCONV), nullptr, scr, r, lane); continue; } r -= I_OC;
        transpose_item<0>(p.w_o, DM, DM, (bf16_t*)(ws + WS_WO), nullptr, scr, r, lane);
    }
    { u32x4* z = (u32x4*)((bf16_t*)(ws + WS_WIN) + (size_t)INC * DM); const int nz = (INCP - INC) * DM * 2 / 16;
      for (int i = blockIdx.x * NTHREADS + tid; i < nz; i += gridDim.x * NTHREADS) z[i] = (u32x4){0u, 0u, 0u, 0u}; }
    { u32x4* wq = (u32x4*)(ws + WS_WUQ); for (int i = blockIdx.x * NTHREADS + tid; i < NH * 32 * QLORA * 2 / 16; i += gridDim.x * NTHREADS) { const int hh = i / (32 * QLORA * 2 / 16), q = i - hh * (32 * QLORA * 2 / 16); wq[(hh * 128 + 96) * (QLORA * 2 / 16) + q] = (u32x4){0u, 0u, 0u, 0u}; } }
    { float* csd = (float*)(ws + WS_CS); for (int i = blockIdx.x * NTHREADS + tid; i < NTOK * 16; i += gridDim.x * NTHREADS) { const int t = i >> 4, j = i & 15; float sn, cn; sincosf((float)p.pos[t] * exp2f(-(float)j * (13.287712379549449f / 16.f)), &sn, &cn); csd[t * 32 + j] = cn; csd[t * 32 + 16 + j] = sn; } }
    if (blockIdx.x == 0 && tid < 64) { float gq = fabsf(p.q_g[tid]), gk = fabsf(p.k_g[tid]); if (tid < 32) { gq = fmaxf(gq, fabsf(p.q_g[64 + tid])); gk = fmaxf(gk, fabsf(p.k_g[64 + tid])); }
#pragma unroll
        for (int o = 1; o < 64; o <<= 1) { gq = fmaxf(gq, __shfl_xor(gq, o)); gk = fmaxf(gk, __shfl_xor(gk, o)); }
        if (tid == 0) *(float*)(ws + WS_SHIFT) = fmaxf(2.f, ceilf(14.135f * gq * gk + 0.5f - 15.f)); }
    { int* rt = (int*)(ws + WS_RT2); int* rs = (int*)(ws + WS_RT2 + 4 * MiB); float* rr = (float*)(ws + WS_RT2 + 6 * MiB);
      for (int i = blockIdx.x * NTHREADS + tid; i < NE * CAP; i += gridDim.x * NTHREADS) { rt[i] = 0; rs[i] = -1; rr[i] = 0.f; } }
    { u32x4* GF = (u32x4*)(ws + WS_GF);
      for (int i = blockIdx.x * NTHREADS + tid; i < 64 * 64; i += gridDim.x * NTHREADS) { const int ks = i >> 6, ln = i & 63, r = ln & 31, h = ln >> 5; float v[8], lo[8]; unsigned hi[4];
#pragma unroll
          for (int j = 0; j < 8; ++j) { const int k = 16 * ks + 8 * h + j; v[j] = p.norm2_g[k] * p.router_w[(size_t)k * NE + r]; }
#pragma unroll
          for (int j = 0; j < 4; ++j) { hi[j] = pk2(v[2 * j], v[2 * j + 1]); lo[2 * j] = v[2 * j] - bf_lo(hi[j]); lo[2 * j + 1] = v[2 * j + 1] - bf_hi(hi[j]); }
          GF[(ks * 2 + 0) * 64 + ln] = (u32x4){hi[0], hi[1], hi[2], hi[3]}; GF[(ks * 2 + 1) * 64 + ln] = (u32x4){pk2(lo[0], lo[1]), pk2(lo[2], lo[3]), pk2(lo[4], lo[5]), pk2(lo[6], lo[7])}; } }
    bf16_t* XN = (bf16_t*)(ws + WS_XN);
    for (int m = gw; m < NTOK; m += NGW) {
        const f32x4* xr = (const f32x4*)(p.x + (size_t)m * DM) + lane; f32x4 v[4]; float s = 0.f;
#pragma unroll
        for (int j = 0; j < 4; ++j) { v[j] = xr[64 * j]; s += (v[j][0] * v[j][0] + v[j][1] * v[j][1]) + (v[j][2] * v[j][2] + v[j][3] * v[j][3]); }
        const float rstd = rsqrtf(wave_sum(s) * (1.f / DM) + EPS);
        u32x2* o = (u32x2*)(XN + (size_t)m * DM) + lane;
#pragma unroll
        for (int j = 0; j < 4; ++j) { u32x2 w; w.x = pk2(v[j][0] * rstd, v[j][1] * rstd); w.y = pk2(v[j][2] * rstd, v[j][3] * rstd); o[64 * j] = w; }
    }
}

struct ConvRaw { u32x4 u[3], c[3], bg; float m0, m2; };
__device__ __forceinline__ void conv_load(ConvRaw& r, const Params& p, int t, int lane) {
    const bf16_t* pr = (const bf16_t*)(p.ws + WS_PROJ) + (size_t)t * INCP; const int s = t & (SEQ - 1);
    r.m0 = s > 0 ? 1.f : 0.f; r.m2 = s < SEQ - 1 ? 1.f : 0.f;
    const bf16_t* pm = s > 0 ? pr - INCP : pr; const bf16_t* pp = s < SEQ - 1 ? pr + INCP : pr;
    r.u[0] = *(const u32x4*)(pm + OFF_U + 8 * lane); r.c[0] = *(const u32x4*)(pm + OFF_C + 8 * lane);
    r.u[1] = *(const u32x4*)(pr + OFF_U + 8 * lane); r.c[1] = *(const u32x4*)(pr + OFF_C + 8 * lane);
    r.u[2] = *(const u32x4*)(pp + OFF_U + 8 * lane); r.c[2] = *(const u32x4*)(pp + OFF_C + 8 * lane);
    r.bg = *(const u32x4*)(pr + OFF_B + 8 * lane);
}
__device__ __forceinline__ void mulpair8(const u32x4 u, const u32x4 c, float (&o)[8]) {
    o[0] = bf_lo(u.x) * bf_lo(c.x); o[1] = bf_hi(u.x) * bf_hi(c.x); o[2] = bf_lo(u.y) * bf_lo(c.y); o[3] = bf_hi(u.y) * bf_hi(c.y);
    o[4] = bf_lo(u.z) * bf_lo(c.z); o[5] = bf_hi(u.z) * bf_hi(c.z); o[6] = bf_lo(u.w) * bf_lo(c.w); o[7] = bf_hi(u.w) * bf_hi(c.w); }
__device__ __forceinline__ void conv_store(const ConvRaw& r, const Params& p, int t, int lane, const float (&cw0)[8], const float (&cw1)[8], const float (&cw2)[8]) {
    float cu0[8], cu1[8], cu2[8], bb[8], y[8]; mulpair8(r.u[0], r.c[0], cu0); mulpair8(r.u[1], r.c[1], cu1); mulpair8(r.u[2], r.c[2], cu2);
    bb[0] = bf_lo(r.bg.x); bb[1] = bf_hi(r.bg.x); bb[2] = bf_lo(r.bg.y); bb[3] = bf_hi(r.bg.y); bb[4] = bf_lo(r.bg.z); bb[5] = bf_hi(r.bg.z); bb[6] = bf_lo(r.bg.w); bb[7] = bf_hi(r.bg.w);
#pragma unroll
    for (int j = 0; j < 8; ++j) y[j] = bb[j] * (cw0[j] * r.m0 * cu0[j] + cw1[j] * cu1[j] + cw2[j] * r.m2 * cu2[j]);
    u32x4 o; o.x = pk2(y[0], y[1]); o.y = pk2(y[2], y[3]); o.z = pk2(y[4], y[5]); o.w = pk2(y[6], y[7]); *(u32x4*)((bf16_t*)(p.ws + WS_YBIN) + (size_t)t * CONVW + 8 * lane) = o;
}
__device__ __forceinline__ void phase_conv(const Params& p) {
    int tid = threadIdx.x; asm volatile("" : "+v"(tid)); const int lane = tid & 63, wave = tid >> 6;
    const int gw = blockIdx.x * NWAVES + wave, NGW = gridDim.x * NWAVES;
    float cw0[8], cw1[8], cw2[8];
#pragma unroll
    for (int j = 0; j < 8; ++j) { cw0[j] = p.conv_w[8 * lane + j]; cw1[j] = p.conv_w[CONVW + 8 * lane + j]; cw2[j] = p.conv_w[2 * CONVW + 8 * lane + j]; }
    for (int t = gw; t < NTOK; t += 2 * NGW) {
        const int t1 = t + NGW; const bool two = t1 < NTOK;
        ConvRaw r0, r1; conv_load(r0, p, t, lane); conv_load(r1, p, two ? t1 : t, lane);
        conv_store(r0, p, t, lane, cw0, cw1, cw2);
        if (two) conv_store(r1, p, t1, lane, cw0, cw1, cw2);
    }
}

constexpr int WC_EXP_ITEMS = NE * 1536, WC_RAW_B = 9 * 1024;
struct WcItem { const float* W; unsigned char* WT; int N, k0, n0, mode; };
__device__ __forceinline__ WcItem wc_decode(const Params& p, int x) {
    WcItem it; const int e = x / 1536, r = x - e * 1536;
    if (r < 1024) { it.W = p.w1 + (size_t)e * DM * 2048; it.WT = p.ws + WS_W1 + (size_t)e * 2048 * DM; it.N = 2048; it.k0 = 64 * (r >> 6); it.n0 = 32 * (r & 63); it.mode = 1; }
    else { const int q = r - 1024; it.W = p.w2 + (size_t)e * DFF * DM; it.WT = p.ws + WS_W2 + (size_t)e * DM * DFF; it.N = DM; it.k0 = 64 * (q >> 5); it.n0 = 32 * (q & 31); it.mode = 0; }
    return it;
}
struct WConv { unsigned char* raw; int x0, nitems, cs, slot, sh, soff; bool m1; };
__device__ __forceinline__ bool wconv_step(WConv& c, const Params& p, int lane) {
    typedef __attribute__((address_space(3))) unsigned* lds_u32p;
    const int cs = c.cs, nst = 8 * c.nitems, fi = cs - 9;
    if (fi >= 0 && (fi & 7) == 0 && (fi >> 3) < c.nitems) {
        const int i = fi >> 3; const WcItem it = wc_decode(p, c.x0 + i); const int c8 = lane & 7, nr = lane >> 3, lv = (nr >> 2) | (c8 << 1);
        int sl = c.slot + c8; sl -= (sl >= 9) ? 9 : 0;
        const unsigned char* rb = c.raw + sl * 1024 + (nr & 3) * 4;
        float v[4][8];
#pragma unroll
        for (int j = 0; j < 4; ++j)
#pragma unroll
            for (int k = 0; k < 8; ++k) v[j][k] = *(const float*)(rb + (((k * 8 + 2 * j) ^ lv) << 4));
#pragma unroll
        for (int j = 0; j < 4; ++j) {
            u32x2 o; o.x = pk4_fp8(v[j][0] * W8_SCALE, v[j][1] * W8_SCALE, v[j][2] * W8_SCALE, v[j][3] * W8_SCALE); o.y = pk4_fp8(v[j][4] * W8_SCALE, v[j][5] * W8_SCALE, v[j][6] * W8_SCALE, v[j][7] * W8_SCALE);
            int row = it.n0 + nr + 8 * j; if (it.mode == 1) { const int f = row & 1023; row = ((f >> 7) << 8) + ((row >> 10) << 7) + (f & 127); }
            *(u32x2*)(it.WT + (size_t)row * DM + it.k0 + 8 * c8) = o; }
    }
    const bool issue = cs < nst;
    if (issue) {
        const int q = cs & 7;
        if (q == 0) { const int x = c.x0 + (cs >> 3), e = x / 1536, r = x - e * 1536;
            if (r < 1024) { c.m1 = true; c.sh = 13; c.soff = e * (DM * 2048 * 4) + (64 * (r >> 6)) * 8192 + (32 * (r & 63)) * 4; }
            else { const int q2 = r - 1024; c.m1 = false; c.sh = 12; c.soff = e * (DFF * DM * 4) + (64 * (q2 >> 5)) * 4096 + (32 * (q2 & 31)) * 4; } }
        const int sv = lane ^ (q << 1), voff = ((sv >> 3) << c.sh) + ((sv & 7) << 4), so = c.soff + ((8 * q) << c.sh);
        typedef __attribute__((address_space(3))) void* lds_vp;
        const __amdgpu_buffer_rsrc_t rs = __builtin_amdgcn_make_buffer_rsrc((void*)(c.m1 ? p.w1 : p.w2), 0, 0x7fffffff, 0x00020000);
        __builtin_amdgcn_raw_ptr_buffer_load_lds(rs, (lds_vp)(c.raw + c.slot * 1024), 16, voff, so, 0, 0);
    }
    c.cs = cs + 1; c.slot = (c.slot == 8) ? 0 : c.slot + 1;
    return issue;
}

namespace att {
constexpr int NW = 8, QBLK = 32, KVBLK = 64;
constexpr float SCALE = 0.10206207261596575f;
constexpr float QSC = SCALE * 1.4426950408889634f;
constexpr int LDQ = 128, LDK = 128;
constexpr int SHM_V = KVBLK * DV, SHM_K = KVBLK * 128, SHM_ATTN = 2 * SHM_V + 2 * SHM_K + NW * 64 * 4;
#define KSWZ(row, colB) ((row) * 256 + ((colB) ^ (((row) & 7) << 4)))
#define SBAR() __builtin_amdgcn_sched_barrier(0)
__device__ __forceinline__ int crow(int r, int hi) { return (r & 3) + 8 * (r >> 2) + 4 * hi; }
__device__ __forceinline__ float fadd_s(float a, float b) { float r; asm("v_add_f32_e32 %0, %1, %2" : "=v"(r) : "v"(a), "v"(b)); return r; }
__device__ __forceinline__ unsigned cvtpk(float lo, float hi) { unsigned r; asm volatile("v_cvt_pk_bf16_f32 %0, %1, %2" : "=v"(r) : "v"(lo), "v"(hi)); return r; }
typedef int i32x4a __attribute__((ext_vector_type(4))); typedef int i32x8a __attribute__((ext_vector_type(8)));
#define EXPH(P) do { _Pragma("unroll") for (int r = 0; r < 16; ++r) P[r] = __builtin_amdgcn_exp2f(P[r]); } while (0)
__device__ __forceinline__ unsigned pk4_bf8(float a, float b, float c, float d) { unsigned w = 0u; w = (unsigned)__builtin_amdgcn_cvt_pk_bf8_f32(a, b, (int)w, false); w = (unsigned)__builtin_amdgcn_cvt_pk_bf8_f32(c, d, (int)w, true); return w; }
__device__ __forceinline__ void finishSM(f32x16& p0, f32x16& p1, float& l_reg, i32x8a& pf) {
    EXPH(p1); SBAR();
    float ps0 = p0[0], ps1 = p1[0];
#pragma unroll
    for (int r = 1; r < 16; ++r) { ps0 = fadd_s(ps0, p0[r]); ps1 = fadd_s(ps1, p1[r]); }
    l_reg += ps0 + ps1;
#pragma unroll
    for (int q = 0; q < 4; ++q) {
        pf[q] = __builtin_amdgcn_cvt_pk_bf8_f32(p0[4 * q], p0[4 * q + 1], pf[q], false); pf[q] = __builtin_amdgcn_cvt_pk_bf8_f32(p0[4 * q + 2], p0[4 * q + 3], pf[q], true);
        pf[4 + q] = __builtin_amdgcn_cvt_pk_bf8_f32(p1[4 * q], p1[4 * q + 1], pf[4 + q], false); pf[4 + q] = __builtin_amdgcn_cvt_pk_bf8_f32(p1[4 * q + 2], p1[4 * q + 3], pf[4 + q], true); }
}
__device__ __forceinline__ void qkt(f32x16& p0, f32x16& p1, const unsigned char* Ks, const i32x8a* qf, int r32, int hi) {
    const f32x16 z = {};
#pragma unroll
    for (int kh = 0; kh < 2; ++kh) { const int row = kh * 32 + r32, sw = (row >> 1) & 7; const unsigned char* rb = Ks + row * 128; f32x16 acc = z;
#pragma unroll
        for (int s = 0; s < 2; ++s) { const int c0 = 4 * s + 2 * hi; const i32x4a lo = *reinterpret_cast<const i32x4a*>(rb + ((c0 ^ sw) << 4)), hh = *reinterpret_cast<const i32x4a*>(rb + (((c0 + 1) ^ sw) << 4));
            acc = __builtin_amdgcn_mfma_scale_f32_32x32x64_f8f6f4(__builtin_shufflevector(lo, hh, 0, 1, 2, 3, 4, 5, 6, 7), qf[s], acc, 0, 0, 0, 0, 0, 0); }
        if (kh == 0) p0 = acc; else p1 = acc; }
}
__device__ __forceinline__ i32x8a kfrag(const unsigned char* Ks, int kh, int s, int r32, int hi) {
    const int row = kh * 32 + r32, sw = (row >> 1) & 7, c0 = 4 * s + 2 * hi; const unsigned char* rb = Ks + row * 128;
    const i32x4a lo = *reinterpret_cast<const i32x4a*>(rb + ((c0 ^ sw) << 4)), hh = *reinterpret_cast<const i32x4a*>(rb + (((c0 + 1) ^ sw) << 4));
    return __builtin_shufflevector(lo, hh, 0, 1, 2, 3, 4, 5, 6, 7);
}
__device__ __forceinline__ i32x8a vfrag(const unsigned char* Vs, int d0, int r32, int hi) {
    const unsigned char* b = Vs + (((hi * 2 + d0) * 32 + r32) << 5); const int sw = (r32 >> 3) & 1;
    const i32x4a lo = *reinterpret_cast<const i32x4a*>(b + (sw << 4)), hh = *reinterpret_cast<const i32x4a*>(b + ((sw ^ 1) << 4));
    return __builtin_shufflevector(lo, hh, 0, 1, 2, 3, 4, 5, 6, 7);
}
__device__ __forceinline__ void pv8(f32x16& od, const i32x8a v, const i32x8a pfr) { asm volatile("s_nop 1\n\tv_mfma_f32_32x32x64_f8f6f4 %0, %1, %2, %0 blgp:1" : "+v"(od) : "v"(v), "v"(pfr)); }
#define EXPQ(P, B) do { _Pragma("unroll") for (int r = (B); r < (B) + 8; ++r) P[r] = __builtin_amdgcn_exp2f(P[r]); } while (0)
#define PV_STEP(Vs, PN) do { const i32x8a v0_ = vfrag((Vs), 0, r32, hi), v1_ = vfrag((Vs), 1, r32, hi); pv8(o[0], v0_, pf); EXPQ(PN, 0); pv8(o[1], v1_, pf); EXPQ(PN, 8); SBAR(); } while (0)

__device__ __forceinline__ void attn_unit(const unsigned char* __restrict__ Qb, const unsigned char* __restrict__ Kh, const unsigned char* __restrict__ Vth, bf16_t* __restrict__ Ob, int seq, unsigned char* lds, WConv& wc, const Params& prm) {
    const int tid = threadIdx.x, wid = __builtin_amdgcn_readfirstlane(tid >> 6), lane = tid & 63, r32 = lane & 31, hi = lane >> 5;
    unsigned char* V_lds = lds; unsigned char* K_lds = lds + 2 * SHM_V;
    f32x16 o[2] = {}; i32x8a qr[2];
    { const unsigned char* Qw = Qb + (size_t)(wid * QBLK + r32) * LDQ + hi * 32;
#pragma unroll
      for (int s = 0; s < 2; ++s) { const i32x4a lo = *reinterpret_cast<const i32x4a*>(Qw + 64 * s), hh = *reinterpret_cast<const i32x4a*>(Qw + 64 * s + 16); qr[s] = __builtin_shufflevector(lo, hh, 0, 1, 2, 3, 4, 5, 6, 7); } }
    const int kr0 = 8 * wid + (lane >> 3), kcp = lane & 7;
    const int kvoff = kr0 * LDK + ((kcp ^ ((kr0 >> 1) & 7)) * 16), vvoff = (wid & 3) * 1024 + lane * 16;
    const __amdgpu_buffer_rsrc_t rsK = __builtin_amdgcn_make_buffer_rsrc((void*)Kh, 0, 0x7fffffff, 0x00020000), rsV = __builtin_amdgcn_make_buffer_rsrc((void*)Vth, 0, 0x7fffffff, 0x00020000);
    typedef __attribute__((address_space(3))) void* lds_vp;
    const unsigned char* vsrc = Vth + (wid & 3) * 1024 + lane * 16;
    typedef __attribute__((address_space(3))) unsigned* lds_u32p;
#define DMA_K(t, slot) __builtin_amdgcn_raw_ptr_buffer_load_lds(rsK, (lds_vp)(K_lds + (slot) * SHM_K + wid * 1024), 16, kvoff, (t) * (KVBLK * LDK), 0, 0)
#define DMA_V(t, slot) do { if (wid < 4) __builtin_amdgcn_raw_ptr_buffer_load_lds(rsV, (lds_vp)(V_lds + (slot) * SHM_V + wid * 1024), 16, vvoff, (t) * 4096, 0, 0); } while (0)
    f32x16 pA0, pA1, pB0, pB1; i32x8a pf = {}; const int NT = seq / KVBLK;
    typedef float f32x4v __attribute__((ext_vector_type(4)));
    i32x8a ones; { const int c4 = ((lane & 1) == ((lane >> 4) & 1)) ? 0x22222222 : 0; ones = (i32x8a){c4, c4, c4, c4, 0, 0, 0, 0}; }
    f32x4v lsum = {0.f, 0.f, 0.f, 0.f};
    const f32x16 zacc = {};
#define QKM(ACC, KF, S, CIN) ACC = __builtin_amdgcn_mfma_scale_f32_32x32x64_f8f6f4(KF, qr[S], CIN, 0, 0, 0, 0, 0, 0)
#define ROWSUM() lsum = __builtin_amdgcn_mfma_scale_f32_16x16x128_f8f6f4(ones, pf, lsum, 4, 1, 0, 0, 0, 0)
#define CVT8(P, Q0) do { _Pragma("unroll") for (int q_ = 0; q_ < 4; ++q_) { pf[(Q0) + q_] = __builtin_amdgcn_cvt_pk_bf8_f32(P[4 * q_], P[4 * q_ + 1], pf[(Q0) + q_], false); pf[(Q0) + q_] = __builtin_amdgcn_cvt_pk_bf8_f32(P[4 * q_ + 2], P[4 * q_ + 3], pf[(Q0) + q_], true); } } while (0)
#define WAITW(ISS) do { if (ISS) asm volatile("s_waitcnt vmcnt(1)" ::: "memory"); else asm volatile("s_waitcnt vmcnt(0)" ::: "memory"); } while (0)
#define BARE_BAR() asm volatile("s_barrier" ::: "memory")
#define PIN(P) asm volatile("" : "+v"(P))
#define STEP(Ks, Vs, PC0, PC1, PX0, PX1) do { \
        const i32x8a k00_ = kfrag((Ks), 0, 0, r32, hi), k01_ = kfrag((Ks), 0, 1, r32, hi), k10_ = kfrag((Ks), 1, 0, r32, hi), k11_ = kfrag((Ks), 1, 1, r32, hi); SBAR(); \
        QKM(PX0, k00_, 0, zacc); PIN(PX0); EXPQ(PC1, 0); PIN(PC1); SBAR(); \
        QKM(PX0, k01_, 1, PX0); PIN(PX0); EXPQ(PC1, 8); PIN(PC1); SBAR(); \
        QKM(PX1, k10_, 0, zacc); PIN(PX1); CVT8(PC0, 0); PIN(pf); SBAR(); \
        QKM(PX1, k11_, 1, PX1); PIN(PX1); CVT8(PC1, 4); PIN(pf); const i32x8a v0_ = vfrag((Vs), 0, r32, hi), v1_ = vfrag((Vs), 1, r32, hi); SBAR(); \
        ROWSUM(); PIN(lsum); pv8(o[0], v0_, pf); EXPQ(PX0, 0); PIN(PX0); SBAR(); \
        pv8(o[1], v1_, pf); EXPQ(PX0, 8); PIN(PX0); SBAR(); } while (0)
    DMA_K(0, 0); DMA_V(0, 0); DMA_K(1, 1);
    asm volatile("s_waitcnt vmcnt(0)" ::: "memory"); __syncthreads();
    qkt(pA0, pA1, K_lds, qr, r32, hi); EXPH(pA0); SBAR();
    __syncthreads();
    for (int j = 0; j + 2 < NT; j += 2) {
        DMA_K(j + 2, 0); DMA_V(j + 1, 1); const bool wlA = wconv_step(wc, prm, lane); SBAR();
        STEP(K_lds + SHM_K, V_lds, pA0, pA1, pB0, pB1);
        WAITW(wlA); BARE_BAR();
        DMA_K(j + 3, 1); DMA_V(j + 2, 0); const bool wlB = wconv_step(wc, prm, lane); SBAR();
        STEP(K_lds, V_lds + SHM_V, pB0, pB1, pA0, pA1);
        WAITW(wlB); BARE_BAR();
    }
    DMA_V(NT - 1, 1); const bool wlT = wconv_step(wc, prm, lane); SBAR();
    STEP(K_lds + SHM_K, V_lds, pA0, pA1, pB0, pB1);
    WAITW(wlT); BARE_BAR();
    EXPH(pB1); SBAR(); CVT8(pB0, 0); CVT8(pB1, 4); SBAR();
    { const i32x8a v0_ = vfrag(V_lds + SHM_V, 0, r32, hi), v1_ = vfrag(V_lds + SHM_V, 1, r32, hi); ROWSUM(); pv8(o[0], v0_, pf); pv8(o[1], v1_, pf); }
    asm volatile("s_nop 15\n\ts_nop 7" ::: "memory"); SBAR();
    const float l_reg = (lane & 16) ? lsum[1] : lsum[0];
#undef STEP
#undef PIN
#undef WAITW
#undef BARE_BAR
#undef QKM
#undef ROWSUM
#undef CVT8
    const float rl = __builtin_amdgcn_rcpf(l_reg);
    bf16_t* Ow = Ob + (size_t)(wid * QBLK + r32) * 512 + 4 * hi;
#pragma unroll
    for (int d0 = 0; d0 < 2; ++d0)
#pragma unroll
        for (int g = 0; g < 4; ++g) { u32x2 w; w.x = pk2(o[d0][4 * g] * rl, o[d0][4 * g + 1] * rl); w.y = pk2(o[d0][4 * g + 2] * rl, o[d0][4 * g + 3] * rl); *(u32x2*)(Ow + d0 * 32 + 8 * g) = w; }
    __syncthreads();
#undef DMA_K
#undef DMA_V
}
#undef KSWZ
#undef SBAR
}

__device__ __forceinline__ void phase_attn(const Params& p, unsigned char* lds) {
    const unsigned char* Q = p.ws + WS_Q; const unsigned char* Kb = p.ws + WS_K; const unsigned char* VT = p.ws + WS_V; bf16_t* AO = (bf16_t*)(p.ws + WS_AO);
    constexpr int NQB = SEQ / 256, NU = 2 * NH * NQB;
    const int lane = threadIdx.x & 63, wave = __builtin_amdgcn_readfirstlane(threadIdx.x >> 6), gw = blockIdx.x * NWAVES + wave, NGW = gridDim.x * NWAVES;
    const int ipw = (WC_EXP_ITEMS + NGW - 1) / NGW, nun = ((int)blockIdx.x < NU) ? (NU - 1 - (int)blockIdx.x) / (int)gridDim.x + 1 : 0, steps = nun * (SEQ / att::KVBLK - 1);
    int cov = (steps - 2) / 8; cov = cov < 0 ? 0 : (cov > ipw ? ipw : cov);
    WConv wc; wc.raw = lds + att::SHM_ATTN + wave * WC_RAW_B; wc.x0 = gw * ipw; wc.cs = 0; wc.slot = 0; wc.sh = 12; wc.soff = 0; wc.m1 = true;
    { const int left = WC_EXP_ITEMS - wc.x0; wc.nitems = left < 0 ? 0 : (left < cov ? left : cov); }
    if (wave >= 4) __builtin_amdgcn_s_setprio(1);
    const bool xmap = false;
    for (int u0 = blockIdx.x, rnd = 0; u0 < NU; u0 += gridDim.x, ++rnd) {
        const int u = xmap ? (((int)blockIdx.x & 7) + 8 * rnd) * NQB + ((int)blockIdx.x >> 3) : u0;
        const int qb = u % NQB, h = (u / NQB) % NH, b = u / (NQB * NH); const size_t bh = (size_t)(b * NH + h) * SEQ;
        att::attn_unit(Q + (bh + (size_t)qb * 256) * 128, Kb + bh * 128, VT + bh * DV, AO + ((size_t)b * SEQ + (size_t)qb * 256) * 512 + h * DV, SEQ, lds, wc, p);
    }
    __builtin_amdgcn_s_setprio(0);
    while (wc.cs < 8 * wc.nitems + 2) { wconv_step(wc, p, lane); asm volatile("s_waitcnt vmcnt(0)" ::: "memory"); }
}
__device__ __forceinline__ void wconv_cleanup(const Params& p, unsigned char* lds) {
    constexpr int NQB = SEQ / 256, NU = 2 * NH * NQB;
    const int lane = threadIdx.x & 63, wave = threadIdx.x >> 6, gw = blockIdx.x * NWAVES + wave, NGW = gridDim.x * NWAVES;
    const int ipw = (WC_EXP_ITEMS + NGW - 1) / NGW, nun = ((int)blockIdx.x < NU) ? (NU - 1 - (int)blockIdx.x) / (int)gridDim.x + 1 : 0, steps = nun * (SEQ / att::KVBLK - 1);
    int cov = (steps - 2) / 8; cov = cov < 0 ? 0 : (cov > ipw ? ipw : cov);
    float* scr = (float*)(lds + wave * 16384);
    for (int i = cov; i < ipw; ++i) { const int x = gw * ipw + i; if (x >= WC_EXP_ITEMS) break; const WcItem it = wc_decode(p, x); const int r = x % 1536;
        if (it.mode == 1) transpose_item_fp8<1>(it.W, DM, 2048, it.WT, scr, r, lane); else transpose_item_fp8<0>(it.W, DFF, DM, it.WT, scr, r - 1024, lane); }
    __syncthreads();
}

__device__ __forceinline__ int crow16(int r, int hi) { return (r & 3) + 8 * (r >> 2) + 4 * hi; }
__device__ __forceinline__ void phase_router(const Params& p, unsigned char* lds) {
    const int tid = threadIdx.x, lane = tid & 63, wid = tid >> 6, tile = wid >> 2, kq = wid & 3, c = lane & 31, h = lane >> 5;
    float* red = (float*)lds;
    float* ssb = red + 2 * 4 * 16 * 64;
    int* lcnt = (int*)(ssb + 2 * 4 * 64);
    int* lbase = lcnt + 32;
    unsigned* gcnt = (unsigned*)(p.ws + WS_CTL) + CW_CNT;
    int* row_tok = (int*)(p.ws + WS_RT2); float* row_w = (float*)(p.ws + WS_RT2 + 2 * MiB); int* row_slot = (int*)(p.ws + WS_RT2 + 4 * MiB); float* row_rstd = (float*)(p.ws + WS_RT2 + 6 * MiB);
    const u32x4* GF = (const u32x4*)(p.ws + WS_GF);
    for (int tg = blockIdx.x; tg < NTOK / 64; tg += gridDim.x) {
        if (tid < 32) lcnt[tid] = 0;
        const int token = tg * 64 + tile * 32 + c;
        const bf16_t* xrow = (const bf16_t*)(p.ws + WS_X1B) + (size_t)token * DM + kq * 256 + 8 * h; const float* g2p = p.norm2_g + kq * 256 + 8 * h;
        unsigned char* hrow = p.ws + WS_H8 + (size_t)token * DM + kq * 256 + 8 * h;
        f32x16 acc = {}; float ss = 0.f;
        u32x4 xh[16];
#pragma unroll
        for (int sb = 0; sb < 16; sb += 8) { u32x4 gh[8], gl[8];
#pragma unroll
            for (int s = 0; s < 8; ++s) { xh[sb + s] = *(const u32x4*)(xrow + 16 * (sb + s)); gh[s] = GF[((kq * 16 + sb + s) * 2 + 0) * 64 + lane]; gl[s] = GF[((kq * 16 + sb + s) * 2 + 1) * 64 + lane]; }
            asm volatile("" ::: "memory");
#pragma unroll
            for (int s = 0; s < 8; ++s) {
                acc = __builtin_amdgcn_mfma_f32_32x32x16_bf16(__builtin_bit_cast(bf16x8, gh[s]), __builtin_bit_cast(bf16x8, xh[sb + s]), acc, 0, 0, 0);
                acc = __builtin_amdgcn_mfma_f32_32x32x16_bf16(__builtin_bit_cast(bf16x8, gl[s]), __builtin_bit_cast(bf16x8, xh[sb + s]), acc, 0, 0, 0); } }
#pragma unroll
        for (int s = 0; s < 16; ++s) {
            const f32x4 ga = *(const f32x4*)(g2p + 16 * s), gb = *(const f32x4*)(g2p + 16 * s + 4);
            const f32x4 a = {bf_lo(xh[s].x), bf_hi(xh[s].x), bf_lo(xh[s].y), bf_hi(xh[s].y)}, b = {bf_lo(xh[s].z), bf_hi(xh[s].z), bf_lo(xh[s].w), bf_hi(xh[s].w)};
            ss += (a[0] * a[0] + a[1] * a[1]) + (a[2] * a[2] + a[3] * a[3]) + (b[0] * b[0] + b[1] * b[1]) + (b[2] * b[2] + b[3] * b[3]);
            u32x2 h8; h8.x = pk4_fp8(a[0] * ga[0], a[1] * ga[1], a[2] * ga[2], a[3] * ga[3]); h8.y = pk4_fp8(b[0] * gb[0], b[1] * gb[1], b[2] * gb[2], b[3] * gb[3]); *(u32x2*)(hrow + 16 * s) = h8;
        }
#pragma unroll
        for (int r = 0; r < 16; ++r) red[((tile * 4 + kq) * 16 + r) * 64 + lane] = acc[r];
        ssb[(tile * 4 + kq) * 64 + lane] = ss;
        __syncthreads();
        int te[4] = {0, 0, 0, 0}, rl[4] = {0, 0, 0, 0}; float tw[4] = {0.f, 0.f, 0.f, 0.f}; float rstd = 0.f;
        if (kq == 0) {
            float v[16]; float st = 0.f;
#pragma unroll
            for (int q = 0; q < 4; ++q) st += ssb[(tile * 4 + q) * 64 + lane];
            { auto rr = __builtin_amdgcn_permlane32_swap(__float_as_uint(st), __float_as_uint(st), false, false); st = __uint_as_float(rr[0]) + __uint_as_float(rr[1]); }
            rstd = rsqrtf(st * (1.f / DM) + EPS);
#pragma unroll
            for (int r = 0; r < 16; ++r) { float sacc = 0.f;
#pragma unroll
                for (int q = 0; q < 4; ++q) sacc += red[((tile * 4 + q) * 16 + r) * 64 + lane];
                v[r] = sacc * rstd + p.router_b[crow16(r, h)]; }
            float lv[4]; int le[4];
#pragma unroll
            for (int k = 0; k < 4; ++k) { float best = v[0]; int bi = 0;
#pragma unroll
                for (int r = 1; r < 16; ++r) { const bool gt = v[r] > best; best = gt ? v[r] : best; bi = gt ? r : bi; }
                lv[k] = best; le[k] = (bi & 3) + 8 * (bi >> 2) + 4 * h;
#pragma unroll
                for (int r = 0; r < 16; ++r) v[r] = (r == bi) ? -INFINITY : v[r]; }
            float cv[8]; int ce[8];
#pragma unroll
            for (int k = 0; k < 4; ++k) { auto rv = __builtin_amdgcn_permlane32_swap(__float_as_uint(lv[k]), __float_as_uint(lv[k]), false, false); auto re = __builtin_amdgcn_permlane32_swap((unsigned)le[k], (unsigned)le[k], false, false);
                cv[k] = __uint_as_float(rv[0]); cv[4 + k] = __uint_as_float(rv[1]); ce[k] = (int)re[0]; ce[4 + k] = (int)re[1]; }
            float tv[4];
#pragma unroll
            for (int k = 0; k < 4; ++k) { float best = cv[0]; int be = ce[0]; int bi = 0;
#pragma unroll
                for (int r = 1; r < 8; ++r) { const bool gt = (cv[r] > best) || (cv[r] == best && ce[r] < be); best = gt ? cv[r] : best; be = gt ? ce[r] : be; bi = gt ? r : bi; }
                tv[k] = best; te[k] = be;
#pragma unroll
                for (int r = 0; r < 8; ++r) cv[r] = (r == bi) ? -INFINITY : cv[r]; }
            const float e1 = __expf(tv[1] - tv[0]), e2 = __expf(tv[2] - tv[0]), e3 = __expf(tv[3] - tv[0]); const float inv = 1.f / (1.f + e1 + e2 + e3);
            tw[0] = inv; tw[1] = e1 * inv; tw[2] = e2 * inv; tw[3] = e3 * inv;
            if (h == 0) {
#pragma unroll
                for (int k = 0; k < 4; ++k) rl[k] = atomicAdd(&lcnt[te[k]], 1); }
        }
        __syncthreads();
        if (tid < 32) lbase[tid] = (int)atomicAdd(&gcnt[tid], (unsigned)lcnt[tid]);
        __syncthreads();
        if (kq == 0 && h == 0) {
#pragma unroll
            for (int k = 0; k < 4; ++k) { const int idx = te[k] * CAP + lbase[te[k]] + rl[k]; row_tok[idx] = token; row_w[idx] = tw[k]; row_slot[idx] = token * 4 + k; row_rstd[idx] = rstd; } }
        __syncthreads();
    }
}

__device__ __forceinline__ void build_block_table(const Params& p, int* bs) {
    const unsigned* gcnt = (const unsigned*)(p.ws + WS_CTL) + CW_CNT;
    if (threadIdx.x == 0) { int acc = 0; for (int e = 0; e < NE; ++e) { bs[e] = acc; acc += ((int)__hip_atomic_load(gcnt + e, __ATOMIC_RELAXED, __HIP_MEMORY_SCOPE_AGENT) + 255) >> 8; } bs[NE] = acc; }
    __syncthreads();
}

__device__ __forceinline__ pg8::MoeOrder make_moe_order(const Params& p, unsigned char* lds, int N, bool gather) {
    int* bs = (int*)(lds + 131072); int* utab = (int*)(lds + 131072 + 256); int* gtab = (int*)(lds + 131072 + 512);
    build_block_table(p, bs);
    const int nmb = __builtin_amdgcn_readfirstlane(bs[NE]);
    pg8::MoeOrder S; S.so.init(nmb * 256, N, (int)gridDim.x, (int)blockIdx.x); S.utab = (const PG8_LAS int*)utab; S.gtab = (const PG8_LAS int*)gtab;
    const int* row_tok = (const int*)(p.ws + WS_RT2);
    for (int i = 0; i < pg8::MOE_MAXU; ++i) { pg8::Unit u; if (!S.so.next(i, u)) break; int e = 0; for (int k = 1; k < NE; ++k) if (bs[k] <= u.pm) e = k;
        const int rb = e * CAP + (u.pm - bs[e]) * 256;
        if (threadIdx.x == 0) utab[i] = e | (rb << 8);
        if (gather && threadIdx.x < 256) gtab[i * 256 + threadIdx.x] = row_tok[rb + threadIdx.x]; }
    __syncthreads();
    return S;
}
__device__ __forceinline__ void phase_moe1(const Params& p, unsigned char* lds) {
    const pg8::MoeOrder S = make_moe_order(p, lds, 2048, true);
    pg8::Gemm g{(const bf16_t*)(p.ws + WS_H8), (const bf16_t*)(p.ws + WS_W1), 0, 2048, DM / 2, (size_t)2048 * DM, 0, 0};
    pg8::EpiSwiglu E{p.ws + WS_ACT, p.b1, (const float*)(p.ws + WS_RT2 + 6 * MiB)};
    pg8::gemm_phase<pg8::EpiSwiglu, pg8::MoeOrder, true, true, true, true>((PG8_LAS unsigned char*)lds, g, S, E);
}
__device__ __forceinline__ void phase_moe2(const Params& p, unsigned char* lds) {
    const pg8::MoeOrder S = make_moe_order(p, lds, DM, false);
    pg8::Gemm g{(const bf16_t*)(p.ws + WS_ACT), (const bf16_t*)(p.ws + WS_W2), 0, DM, DFF / 2, (size_t)DM * DFF, 0, 0};
    pg8::EpiMoeOut E{p.ws + WS_YS, p.b2, (const float*)(p.ws + WS_RT2 + 2 * MiB), (const int*)(p.ws + WS_RT2 + 4 * MiB)};
    pg8::gemm_phase<pg8::EpiMoeOut, pg8::MoeOrder, true, true, true>((PG8_LAS unsigned char*)lds, g, S, E);
}

__device__ __forceinline__ float fp8_to_f32(unsigned w, int byte) {
    return byte == 0 ? __builtin_amdgcn_cvt_f32_fp8((int)w, 0) : byte == 1 ? __builtin_amdgcn_cvt_f32_fp8((int)w, 1) : byte == 2 ? __builtin_amdgcn_cvt_f32_fp8((int)w, 2) : __builtin_amdgcn_cvt_f32_fp8((int)w, 3); }
__device__ __forceinline__ void phase_combine(const Params& p) {
    const int tid = threadIdx.x, lane = tid & 63, wave = tid >> 6;
    const int gw = blockIdx.x * NWAVES + wave, NGW = gridDim.x * NWAVES;
    const unsigned char* YS = p.ws + WS_YS;
    for (int t = gw; t < NTOK; t += NGW) {
        f32x4* orow = (f32x4*)(p.out + (size_t)t * DM) + lane; const u32x2* xrow = (const u32x2*)((const bf16_t*)(p.ws + WS_X1B) + (size_t)t * DM) + lane;
        f32x4 v[4]; unsigned w[4][4];
#pragma unroll
        for (int j = 0; j < 4; ++j) { const u32x2 xb = xrow[64 * j]; v[j] = (f32x4){bf_lo(xb.x), bf_hi(xb.x), bf_lo(xb.y), bf_hi(xb.y)};
#pragma unroll
            for (int k = 0; k < 4; ++k) w[j][k] = *((const unsigned*)(YS + ((size_t)t * 4 + k) * DM) + lane + 64 * j); }
#pragma unroll
        for (int j = 0; j < 4; ++j) { f32x4 s = {0.f, 0.f, 0.f, 0.f};
#pragma unroll
            for (int k = 0; k < 4; ++k) { s[0] += fp8_to_f32(w[j][k], 0); s[1] += fp8_to_f32(w[j][k], 1); s[2] += fp8_to_f32(w[j][k], 2); s[3] += fp8_to_f32(w[j][k], 3); }
            orow[64 * j] = v[j] + s * YS_INV; }
    }
}

template <class Epi>
__device__ __forceinline__ void dense_gemm(unsigned char* lds, const bf16_t* A, const bf16_t* Bt, int M, int N, int K, const Epi& E, int lda = 0, int ldb = 0, int cshift = 0) {
    pg8::Gemm g{A, Bt, M, N, K, 0, lda, ldb}; pg8::StaticOrder S; S.init(M, N, (int)gridDim.x, (int)((blockIdx.x + cshift) % gridDim.x));
    pg8::gemm_phase<Epi, pg8::StaticOrder, true, true>((PG8_LAS unsigned char*)lds, g, S, E);
}

constexpr int NPHASE = 13;
__global__ void __launch_bounds__(NTHREADS, 2) mk_fwd(Params p) {
    extern __shared__ __attribute__((aligned(16))) unsigned char lds[];
    cg::grid_group grid = cg::this_grid();
    unsigned char* ws = p.ws;
    volatile LAS unsigned* MISC = (volatile LAS unsigned*)((LAS unsigned char*)lds + MISC_OFF);
    if (threadIdx.x < 32) MISC[threadIdx.x] = 0u;
    __syncthreads();
    XcdBarrier bar = xcd_barrier_post((unsigned*)(ws + WS_CTL) + CW_BAR, MISC + 8);
    const int lo = p.ph_lo, hi = p.ph_hi;
    if (lo < 0) grid.sync();
#define IN(k) (lo <= (k) && (k) < hi)
#define SEAM(k) do { if (IN(k) && IN((k) + 1)) xcd_barrier(bar); } while (0)
    if (IN(0)) phase_prologue(p, lds);
    SEAM(0);
    if (IN(1)) { pg8::EpiProj E{(bf16_t*)(ws + WS_PROJ), (float*)(ws + WS_SSQ)}; dense_gemm(lds, (const bf16_t*)(ws + WS_XN), (const bf16_t*)(ws + WS_WIN), NTOK, INCP, DM, E); }
    if (IN(1) && IN(3)) xcd_barrier(bar);
    if (IN(3)) { const float* ssq = (const float*)(ws + WS_SSQ); const float* cst = (const float*)(ws + WS_CS); float* hs = (float*)(lds + 131072);
                 pg8::EpiQ Eq{ws + WS_Q, ssq, p.q_g, cst, hs}; dense_gemm(lds, (const bf16_t*)(ws + WS_PROJ) + OFF_CQ, (const bf16_t*)(ws + WS_WUQ), NTOK, 1024, QLORA, Eq, INCP);
                 pg8::EpiK Ek{ws + WS_K, ssq, p.k_g, cst, (const bf16_t*)(ws + WS_PROJ), hs, (const float*)(ws + WS_SHIFT)}; dense_gemm(lds, (const bf16_t*)(ws + WS_PROJ) + OFF_CKV, (const bf16_t*)(ws + WS_WUKV), NTOK, 512, KVLORA, Ek, INCP);
                 pg8::EpiVT Ev{ws + WS_V, ssq}; dense_gemm(lds, (const bf16_t*)(ws + WS_WUKV) + 512 * KVLORA, (const bf16_t*)(ws + WS_PROJ) + OFF_CKV, 512, NTOK, KVLORA, Ev, 0, INCP, (int)gridDim.x / 2);
                 phase_conv(p); }
    if (IN(3) && IN(5)) xcd_barrier(bar);
    if (IN(5)) phase_attn(p, lds);
    SEAM(5);
    if (IN(6)) { pg8::EpiGateA E{(bf16_t*)(ws + WS_M1), (const bf16_t*)(ws + WS_PROJ)}; dense_gemm(lds, (const bf16_t*)(ws + WS_AO), (const bf16_t*)(ws + WS_WOMLA), NTOK, DM, 512, E); }
    if (IN(7)) { pg8::EpiGateB E{(const bf16_t*)(ws + WS_M1), (const bf16_t*)(ws + WS_PROJ), (bf16_t*)(ws + WS_MERGED)}; dense_gemm(lds, (const bf16_t*)(ws + WS_YBIN), (const bf16_t*)(ws + WS_WOCONV), NTOK, DM, 512, E); }
    SEAM(7);
    if (IN(8)) { pg8::EpiResid E{p.x, (bf16_t*)(ws + WS_X1B)}; dense_gemm(lds, (const bf16_t*)(ws + WS_MERGED), (const bf16_t*)(ws + WS_WO), NTOK, DM, DM, E); }
    SEAM(8);
    if (IN(9)) { wconv_cleanup(p, lds); phase_router(p, lds); }
    if (IN(9) && IN(11)) xcd_barrier(bar);
    if (IN(11)) phase_moe1(p, lds);
    SEAM(11);
    if (IN(12)) phase_moe2(p, lds);
    SEAM(12);
    if (IN(13)) phase_combine(p);
#undef IN
#undef SEAM
}

extern "C" void kernel_launch(void* const* d_in, const int* in_sizes, int n_in, void* d_out, int out_size,
                              void* d_ws, size_t ws_size, hipStream_t stream) {
    static int grid_blocks = 0;
    if (!grid_blocks) {
        int dev = 0, cus = 0, per_cu = 0;
        (void)hipGetDevice(&dev);
        (void)hipDeviceGetAttribute(&cus, hipDeviceAttributeMultiprocessorCount, dev);
        (void)hipFuncSetAttribute((const void*)mk_fwd, hipFuncAttributeMaxDynamicSharedMemorySize, LDS_BYTES);
        (void)hipOccupancyMaxActiveBlocksPerMultiprocessor(&per_cu, (const void*)mk_fwd, NTHREADS, LDS_BYTES);
        if (per_cu < 1) { fprintf(stderr, "kernel_launch: occupancy query says %d blocks/CU\n", per_cu); per_cu = 1; }
        grid_blocks = cus;
        if (ws_size < WS_END2 || n_in != 21) fprintf(stderr, "kernel_launch: ws %zu < %zu or n_in %d != 21\n", ws_size, (size_t)WS_END2, n_in);
    }
    (void)hipMemsetAsync((char*)d_ws + WS_CTL, 0, 1 * MiB, stream);
    Params p{};
    p.x = (const float*)d_in[0]; p.pos = (const int*)d_in[1]; p.norm1_g = (const float*)d_in[2]; p.w_in = (const float*)d_in[3]; p.q_a_g = (const float*)d_in[4];
    p.kv_a_g = (const float*)d_in[5]; p.w_uq = (const float*)d_in[6]; p.w_ukv = (const float*)d_in[7]; p.q_g = (const float*)d_in[8]; p.k_g = (const float*)d_in[9];
    p.conv_w = (const float*)d_in[10]; p.w_o_mla = (const float*)d_in[11]; p.w_o_conv = (const float*)d_in[12]; p.w_o = (const float*)d_in[13]; p.norm2_g = (const float*)d_in[14];
    p.router_w = (const float*)d_in[15]; p.router_b = (const float*)d_in[16]; p.w1 = (const float*)d_in[17]; p.b1 = (const float*)d_in[18]; p.w2 = (const float*)d_in[19]; p.b2 = (const float*)d_in[20];
    p.out = (float*)d_out; p.ws = (unsigned char*)d_ws; p.ph_lo = 0; p.ph_hi = NPHASE + 1;
    void* args[] = {&p};
    hipError_t e = hipLaunchCooperativeKernel((const void*)mk_fwd, dim3(grid_blocks), dim3(NTHREADS), args, LDS_BYTES, stream);
    if (e != hipSuccess) fprintf(stderr, "cooperative launch failed: %s (grid %d)\n", hipGetErrorString(e), grid_blocks);
}
```

```cpp
#include <hip/hip_runtime.h>
#include <hip/hip_cooperative_groups.h>
#include <cstdio>
#include <cstdint>
namespace cg = cooperative_groups;

typedef unsigned short bf16_t;
typedef short bf16x8 __attribute__((ext_vector_type(8)));
typedef short s16x4 __attribute__((ext_vector_type(4)));
typedef float f32x4 __attribute__((ext_vector_type(4)));
typedef float f32x2 __attribute__((ext_vector_type(2)));
typedef float f32x16 __attribute__((ext_vector_type(16)));
typedef unsigned u32x4 __attribute__((ext_vector_type(4)));
typedef unsigned u32x2 __attribute__((ext_vector_type(2)));
typedef __bf16 bf16x2_t __attribute__((ext_vector_type(2)));

constexpr int NTOK = 16384, DM = 1024, SEQ = 8192;
constexpr int INC = 4000, INCP = 4096;
constexpr int OFF_CQ = 0, OFF_CKV = 256, OFF_KR = 384, OFF_U = 416, OFF_C = 928, OFF_B = 1440, OFF_GA = 1952, OFF_GB = 2976;
constexpr int NH = 8, DQK = 96, DV = 64, NE = 32, TOPK = 4, DFF = 1024;
constexpr int QLORA = 256, KVLORA = 128, CONVW = 512;
constexpr int NPAIR = NTOK * TOPK;
constexpr int MAXROWS = 73728;
constexpr float EPS = 1e-6f;
constexpr float QSCALE = 0.10206207261596575f * 1.4426950408889634f;
constexpr int CAP = 16384;
constexpr int NTHREADS = 512, NWAVES = 8;
constexpr int LDS_BYTES = 147456;

constexpr size_t MiB = 1ull << 20;
constexpr size_t WS_CTL = 0;
constexpr size_t WS_WIN = 1 * MiB;
constexpr size_t WS_WUQ = 9 * MiB;
constexpr size_t WS_WUKV = WS_WUQ + 512 * 1024;
constexpr size_t WS_WOMLA = 10 * MiB;
constexpr size_t WS_WOCONV = 11 * MiB;
constexpr size_t WS_WO = 12 * MiB;
constexpr size_t WS_ROUTE = 14 * MiB;
constexpr size_t WS_W1 = 18 * MiB;
constexpr size_t WS_W2 = 146 * MiB;
constexpr size_t WS_XN = 210 * MiB;
constexpr size_t WS_PROJ = 242 * MiB;
constexpr size_t WS_CQN = 370 * MiB;
constexpr size_t WS_CKVN = 378 * MiB;
constexpr size_t WS_YBIN = 386 * MiB;
constexpr size_t WS_QPRE = 402 * MiB;
constexpr size_t WS_KVPRE = 450 * MiB;
constexpr size_t WS_Q = 514 * MiB;
constexpr size_t WS_K = 538 * MiB;
constexpr size_t WS_V = 570 * MiB;
constexpr size_t WS_AO = 586 * MiB;
constexpr size_t WS_M1 = 602 * MiB;
constexpr size_t WS_MERGED = 666 * MiB;
constexpr size_t WS_YS = 698 * MiB;
constexpr size_t WS_END = 826 * MiB;
constexpr size_t WS_ACT = WS_PROJ;
constexpr size_t WS_X1B = WS_M1;
constexpr size_t WS_H8 = WS_XN;
constexpr size_t WS_GF = 830 * MiB;
constexpr size_t WS_RT2 = 832 * MiB;
constexpr size_t WS_SSQ = 840 * MiB;
constexpr size_t WS_CS = 841 * MiB;
constexpr size_t WS_SHIFT = 843 * MiB;
constexpr size_t WS_END2 = 844 * MiB;
constexpr size_t RT_PAIR_E = 0, RT_PAIR_RANK = 262144, RT_PAIR_W = 524288, RT_ROW_TOK = 786432, RT_ROW_W = 786432 + 294912, RT_ROW_SLOT = 786432 + 2 * 294912;
constexpr int CW_CNT = 64;
constexpr int CW_BAR = 4096;
constexpr int MISC_OFF = LDS_BYTES - 256;

struct Params {
    const float* x; const int* pos; const float* norm1_g; const float* w_in; const float* q_a_g; const float* kv_a_g;
    const float* w_uq; const float* w_ukv; const float* q_g; const float* k_g; const float* conv_w; const float* w_o_mla;
    const float* w_o_conv; const float* w_o; const float* norm2_g; const float* router_w; const float* router_b;
    const float* w1; const float* b1; const float* w2; const float* b2;
    float* out; unsigned char* ws; int ph_lo, ph_hi;
};

__device__ __forceinline__ unsigned pk2(float lo, float hi) { f32x2 v = {lo, hi}; bf16x2_t b = __builtin_convertvector(v, bf16x2_t); return __builtin_bit_cast(unsigned, b); }
__device__ __forceinline__ float bf_lo(unsigned w) { return __uint_as_float(w << 16); }
__device__ __forceinline__ float bf_hi(unsigned w) { return __uint_as_float(w & 0xffff0000u); }
__device__ __forceinline__ float bf1(bf16_t h) { return __uint_as_float((unsigned)h << 16); }
__device__ __forceinline__ float wave_sum(float v) {
#pragma unroll
    for (int o = 1; o < 64; o <<= 1) v += __shfl_xor(v, o);
    return v;
}
__device__ __forceinline__ unsigned pk4_fp8(float a, float b, float c, float d) { unsigned w = 0u; w = (unsigned)__builtin_amdgcn_cvt_pk_fp8_f32(a, b, (int)w, false); w = (unsigned)__builtin_amdgcn_cvt_pk_fp8_f32(c, d, (int)w, true); return w; }
constexpr float Q8_SCALE = 4.f, K8_SCALE = 0.25f;
constexpr float W8_SCALE = 32.f, W8_INV = 1.f / 32.f, YS_SCALE = 8.f, YS_INV = 0.125f;
__device__ __forceinline__ float sigmoidf_(float v) { return __builtin_amdgcn_rcpf(1.f + __builtin_amdgcn_exp2f(v * -1.4426950408889634f)); }

namespace pg8 {
#define PG8_LAS __attribute__((address_space(3)))
constexpr int BM = 256, BK = 64, HALF = 128, HTB = HALF * BK * 2  , STAGE_BYTES = 8 * HTB, NXCD = 8, WGM = 8;

__host__ __device__ __forceinline__ int lds_byte(int r, int c) { const int st = (r >> 4) * 2 + (c >> 5), rr = r & 15, cc = c & 31, ob = rr * 64 + cc * 2; return st * 1024 + (ob ^ (((ob >> 9) & 1) << 5)); }
__host__ __device__ __forceinline__ void stage_rc(int b, int& R, int& C) { const int st = b / 1024, sb = b % 1024, swz = sb ^ (((sb >> 9) & 1) << 5); R = (st >> 1) * 16 + swz / 64; C = (st & 1) * 32 + (swz % 64) / 2; }
__host__ __device__ __forceinline__ int perm32(int rho) { const int n = rho >> 4, i = rho & 15; return 8 * (i >> 2) + 4 * n + (i & 3); }

struct Unit { int pm, pn, e, rb; };
struct Gemm { const bf16_t* A; const bf16_t* Bt; int M, N, K; size_t bstride; int lda, ldb; };

struct StaticOrder {
    int nM, nN, nwg, G, c;
    __host__ __device__ void init(int M, int N, int G_, int c_) { nM = M / BM; nN = N / BM; nwg = nM * nN; G = G_; c = c_; }
    __host__ __device__ bool next(int i, Unit& u) const {
        const long L = (long)i * G + c; if (L >= nwg) return false;
        int wgid = (int)L; { const int q = nwg / NXCD, r = nwg % NXCD, xcd = wgid % NXCD, off = wgid / NXCD; wgid = (xcd < r ? xcd * (q + 1) : r * (q + 1) + (xcd - r) * q) + off; }
        const int nig = WGM * nN, gid = wgid / nig, fm = gid * WGM, gsz = (nM - fm) < WGM ? (nM - fm) : WGM;
        u.pm = fm + ((wgid % nig) % gsz); u.pn = (wgid % nig) / gsz; u.e = 0; u.rb = 0; return true;
    }
    __device__ __forceinline__ void a_ready(const Unit&) const {}
    __device__ __forceinline__ void done(const Unit&) const {}
};


struct EpiProj {
    static constexpr bool PERM = true, AFTER_DRAIN = false;
    bf16_t* O; float* ssq;
    __device__ __forceinline__ void operator()(const f32x4 (&acc)[2][2][4][2], const Unit& u, int wr, int wc, int fr, int fq) const {
        const int row0 = u.pm * BM + wr * 64 + fr, col0 = u.pn * BM + wc * 32 + 8 * fq;
#pragma unroll
        for (int ai = 0; ai < 2; ++ai)
#pragma unroll
            for (int m = 0; m < 4; ++m) { const int row = row0 + ai * HALF + m * 16; bf16_t* rowp = O + (size_t)row * INCP + col0;
#pragma unroll
                for (int bj = 0; bj < 2; ++bj) { f32x4 v0 = acc[ai][bj][m][0], v1 = acc[ai][bj][m][1]; const int col = col0 + bj * HALF;
                    if (col >= OFF_GA && col < INC) {
#pragma unroll
                        for (int j = 0; j < 4; ++j) { v0[j] = sigmoidf_(v0[j]); v1[j] = sigmoidf_(v1[j]); } }
                    u32x4 w; w.x = pk2(v0[0], v0[1]); w.y = pk2(v0[2], v0[3]); w.z = pk2(v1[0], v1[1]); w.w = pk2(v1[2], v1[3]);
                    *(u32x4*)(rowp + bj * HALF) = w;
                    const int which = u.pn == 0 ? 0 : (u.pn == 1 ? (bj == 0 ? 1 : (wc == 0 ? 2 : -1)) : -1);
                    if (which >= 0) { float s = (v0[0] * v0[0] + v0[1] * v0[1]) + (v0[2] * v0[2] + v0[3] * v0[3]) + (v1[0] * v1[0] + v1[1] * v1[1]) + (v1[2] * v1[2] + v1[3] * v1[3]);
                        s += __shfl_xor(s, 16); s += __shfl_xor(s, 32); if (fq == 0) ssq[(size_t)row * 16 + (which == 0 ? wc * 2 + bj : (which == 1 ? 8 + wc : 12))] = s; } } }
    }
};
struct EpiBf16 {
    static constexpr bool PERM = true, AFTER_DRAIN = false;
    bf16_t* O; int ldc;
    __device__ __forceinline__ void operator()(const f32x4 (&acc)[2][2][4][2], const Unit& u, int wr, int wc, int fr, int fq) const {
        const int row0 = u.pm * BM + wr * 64 + fr, col0 = u.pn * BM + wc * 32 + 8 * fq;
#pragma unroll
        for (int ai = 0; ai < 2; ++ai)
#pragma unroll
            for (int m = 0; m < 4; ++m) { bf16_t* rowp = O + (size_t)(row0 + ai * HALF + m * 16) * ldc + col0;
#pragma unroll
                for (int bj = 0; bj < 2; ++bj) { const f32x4 v0 = acc[ai][bj][m][0], v1 = acc[ai][bj][m][1];
                    u32x4 w; w.x = pk2(v0[0], v0[1]); w.y = pk2(v0[2], v0[3]); w.z = pk2(v1[0], v1[1]); w.w = pk2(v1[2], v1[3]); *(u32x4*)(rowp + bj * HALF) = w; } }
    }
};
__device__ __forceinline__ void epi_bar() { asm volatile("s_waitcnt lgkmcnt(0)" ::: "memory"); __builtin_amdgcn_s_barrier(); asm volatile("" ::: "memory"); }
__device__ __forceinline__ u32x2 pk4bf(const f32x4 v) { u32x2 w; w.x = pk2(v[0], v[1]); w.y = pk2(v[2], v[3]); return w; }
struct EpiQ {
    static constexpr bool PERM = false, AFTER_DRAIN = false;
    unsigned char* Q; const float* ssq_cq; const float* qg; const float* cs; float* hs;
    __device__ __forceinline__ void operator()(f32x4 (&acc)[2][2][4][2], const Unit& u, int wr, int wc, int fr, int fq) const {
        int lr0 = wr * 64 + fr; asm volatile("" : "+v"(lr0), "+v"(fq));
        const int t0 = u.pm * BM + lr0;
#pragma unroll
        for (int ai = 0; ai < 2; ++ai)
#pragma unroll
            for (int m = 0; m < 4; ++m) { const f32x4 sa = *(const f32x4*)(ssq_cq + (size_t)(t0 + ai * HALF + m * 16) * 16), sb = *(const f32x4*)(ssq_cq + (size_t)(t0 + ai * HALF + m * 16) * 16 + 4);
                const float rq = rsqrtf((((sa[0] + sa[1]) + (sa[2] + sa[3])) + ((sb[0] + sb[1]) + (sb[2] + sb[3]))) * (1.f / QLORA) + EPS);
#pragma unroll
                for (int bj = 0; bj < 2; ++bj) { const f32x4 x0 = acc[ai][bj][m][0] * rq, x1 = acc[ai][bj][m][1] * rq; acc[ai][bj][m][0] = x0; acc[ai][bj][m][1] = x1;
                    float s = (x0[0] * x0[0] + x0[1] * x0[1]) + (x0[2] * x0[2] + x0[3] * x0[3]) + (x1[0] * x1[0] + x1[1] * x1[1]) + (x1[2] * x1[2] + x1[3] * x1[3]);
                    s += __shfl_xor(s, 16); s += __shfl_xor(s, 32); if (fq == 0) hs[((lr0 + ai * HALF + m * 16) * 2 + bj) * 4 + wc] = s; } }
        epi_bar();
        {
            f32x4 g0 = {0.f, 0.f, 0.f, 0.f}, g1 = g0; if (wc < 3) { g0 = *(const f32x4*)(qg + 32 * wc + 4 * fq); g1 = *(const f32x4*)(qg + 32 * wc + 16 + 4 * fq); }
#pragma unroll
            for (int ai = 0; ai < 2; ++ai)
#pragma unroll
                for (int m = 0; m < 4; ++m) { const int lr = lr0 + ai * HALF + m * 16, t = u.pm * BM + lr, b = t >> 13, s = t & (SEQ - 1);
                    f32x4 c4 = {0.f, 0.f, 0.f, 0.f}, s4 = {0.f, 0.f, 0.f, 0.f}; if (wc == 2) { c4 = *(const f32x4*)(cs + (size_t)t * 32 + 4 * fq); s4 = *(const f32x4*)(cs + (size_t)t * 32 + 16 + 4 * fq); }
#pragma unroll
                    for (int bj = 0; bj < 2; ++bj) { const f32x4 h4 = *(const f32x4*)(hs + (lr * 2 + bj) * 4); const float rstd = rsqrtf(((h4[0] + h4[1]) + h4[2]) * (1.f / DQK) + EPS) * (QSCALE * Q8_SCALE); f32x4 x0 = acc[ai][bj][m][0] * rstd * g0, x1 = acc[ai][bj][m][1] * rstd * g1;
                        if (wc == 2) { const f32x4 o0 = x0 * c4 - x1 * s4, o1 = x0 * s4 + x1 * c4; x0 = o0; x1 = o1; }
                        if (wc == 3 && fq == 0) x0[0] = Q8_SCALE;
                        unsigned char* qp = Q + ((size_t)(b * NH + 2 * u.pn + bj) * SEQ + s) * 128 + 32 * wc + 4 * fq; *(unsigned*)qp = pk4_fp8(x0[0], x0[1], x0[2], x0[3]); *(unsigned*)(qp + 16) = pk4_fp8(x1[0], x1[1], x1[2], x1[3]); }
                    asm volatile("" ::: "memory"); }
        }
    }
};
struct EpiK {
    static constexpr bool PERM = false, AFTER_DRAIN = false;
    unsigned char* K; const float* ssq; const float* kg; const float* cs; const bf16_t* proj; float* hs; const float* shiftp;
    __device__ __forceinline__ void operator()(f32x4 (&acc)[2][2][4][2], const Unit& u, int wr, int wc, int fr, int fq) const {
        int lr0 = wr * 64 + fr; asm volatile("" : "+v"(lr0), "+v"(fq));
        const int t0 = u.pm * BM + lr0, wp = wc & 1, wh = wc >> 1;
#pragma unroll
        for (int ai = 0; ai < 2; ++ai)
#pragma unroll
            for (int m = 0; m < 4; ++m) { const f32x4 sa = *(const f32x4*)(ssq + (size_t)(t0 + ai * HALF + m * 16) * 16 + 8); const float rk = rsqrtf(((sa[0] + sa[1]) + (sa[2] + sa[3])) * (1.f / KVLORA) + EPS);
#pragma unroll
                for (int bj = 0; bj < 2; ++bj) { const f32x4 x0 = acc[ai][bj][m][0] * rk, x1 = acc[ai][bj][m][1] * rk; acc[ai][bj][m][0] = x0; acc[ai][bj][m][1] = x1;
                    float s = (x0[0] * x0[0] + x0[1] * x0[1]) + (x0[2] * x0[2] + x0[3] * x0[3]) + (x1[0] * x1[0] + x1[1] * x1[1]) + (x1[2] * x1[2] + x1[3] * x1[3]);
                    s += __shfl_xor(s, 16); s += __shfl_xor(s, 32); if (fq == 0) hs[((lr0 + ai * HALF + m * 16) * 4 + 2 * bj + wh) * 2 + wp] = s; } }
        epi_bar();
        const f32x4 g0 = *(const f32x4*)(kg + 32 * wp + 4 * fq), g1 = *(const f32x4*)(kg + 32 * wp + 16 + 4 * fq);
        f32x4 gr0 = {0.f, 0.f, 0.f, 0.f}, gr1 = gr0; if (wp == 1) { gr0 = *(const f32x4*)(kg + 64 + 4 * fq); gr1 = *(const f32x4*)(kg + 80 + 4 * fq); }
        const unsigned kpad = (fq == 0) ? pk4_fp8(-shiftp[0] * K8_SCALE, 0.f, 0.f, 0.f) : 0u;
#pragma unroll
        for (int ai = 0; ai < 2; ++ai)
#pragma unroll
            for (int m = 0; m < 4; ++m) { const int lr = lr0 + ai * HALF + m * 16, t = u.pm * BM + lr, b = t >> 13, s = t & (SEQ - 1); const float skr = ssq[(size_t)t * 16 + 12];
                f32x4 c4 = {0.f, 0.f, 0.f, 0.f}, s4 = c4, r1 = c4, r2 = c4;
                if (wp == 1) { c4 = *(const f32x4*)(cs + (size_t)t * 32 + 4 * fq); s4 = *(const f32x4*)(cs + (size_t)t * 32 + 16 + 4 * fq);
                    const u32x2 a = *(const u32x2*)(proj + (size_t)t * INCP + OFF_KR + 4 * fq), bb = *(const u32x2*)(proj + (size_t)t * INCP + OFF_KR + 16 + 4 * fq);
                    r1 = (f32x4){bf_lo(a.x), bf_hi(a.x), bf_lo(a.y), bf_hi(a.y)} * gr0; r2 = (f32x4){bf_lo(bb.x), bf_hi(bb.x), bf_lo(bb.y), bf_hi(bb.y)} * gr1; }
#pragma unroll
                for (int bj = 0; bj < 2; ++bj) { const size_t rowi = (size_t)(b * NH + 4 * u.pn + 2 * bj + wh) * SEQ + s; const f32x2 h2 = *(const f32x2*)(hs + (lr * 4 + 2 * bj + wh) * 2);
                    const float rstd = rsqrtf(((h2[0] + h2[1]) + skr) * (1.f / DQK) + EPS) * K8_SCALE;
                    unsigned char* kp = K + rowi * 128; const f32x4 y0 = acc[ai][bj][m][0] * rstd * g0, y1 = acc[ai][bj][m][1] * rstd * g1;
                    *(unsigned*)(kp + 32 * wp + 4 * fq) = pk4_fp8(y0[0], y0[1], y0[2], y0[3]); *(unsigned*)(kp + 32 * wp + 16 + 4 * fq) = pk4_fp8(y1[0], y1[1], y1[2], y1[3]);
                    if (wp == 1) { const f32x4 x1 = r1 * rstd, x2 = r2 * rstd, z1 = x1 * c4 - x2 * s4, z2 = x1 * s4 + x2 * c4; *(unsigned*)(kp + 64 + 4 * fq) = pk4_fp8(z1[0], z1[1], z1[2], z1[3]); *(unsigned*)(kp + 80 + 4 * fq) = pk4_fp8(z2[0], z2[1], z2[2], z2[3]); }
                    else { *(u32x2*)(kp + 96 + 8 * fq) = (u32x2){kpad, 0u}; } }
                asm volatile("" ::: "memory"); }
    }
};
struct EpiVT {
    static constexpr bool PERM = true, AFTER_DRAIN = false;
    unsigned char* VT; const float* ssq;
    __device__ __forceinline__ void operator()(f32x4 (&acc)[2][2][4][2], const Unit& u, int wr, int wc, int fr, int fq) const {
        int tok0 = u.pn * BM + wc * 32 + 8 * fq; asm volatile("" : "+v"(tok0), "+v"(fr));
        float rs[2][8];
#pragma unroll
        for (int bj = 0; bj < 2; ++bj)
#pragma unroll
            for (int i = 0; i < 8; ++i) { const f32x4 sa = *(const f32x4*)(ssq + (size_t)(tok0 + bj * HALF + i) * 16 + 8); rs[bj][i] = rsqrtf(((sa[0] + sa[1]) + (sa[2] + sa[3])) * (1.f / KVLORA) + EPS); }
#pragma unroll
        for (int ai = 0; ai < 2; ++ai)
#pragma unroll
            for (int m = 0; m < 4; ++m) { const int row = u.pm * BM + ai * HALF + wr * 64 + m * 16 + fr, h = row >> 6, d = row & 63;
#pragma unroll
                for (int bj = 0; bj < 2; ++bj) { const int tok = tok0 + bj * HALF, b = tok >> 13, s = tok & (SEQ - 1); const f32x4 v0 = acc[ai][bj][m][0], v1 = acc[ai][bj][m][1];
                    const int k0 = s & 63, j0 = 4 * ((k0 >> 3) & 3) + 16 * (k0 >> 5), r32v = d & 31, off = (j0 & 15) + 16 * ((j0 >> 4) ^ ((r32v >> 3) & 1));
                    unsigned char* tp = VT + ((size_t)(b * NH + h) * (SEQ / 64) + (s >> 6)) * 4096 + (((d >> 5) * 32 + r32v) << 5) + off;
                    *(unsigned*)tp = pk4_fp8(v0[0] * rs[bj][0], v0[1] * rs[bj][1], v0[2] * rs[bj][2], v0[3] * rs[bj][3]);
                    *(unsigned*)(tp + 2048) = pk4_fp8(v1[0] * rs[bj][4], v1[1] * rs[bj][5], v1[2] * rs[bj][6], v1[3] * rs[bj][7]); } }
    }
};
struct EpiF32 {
    static constexpr bool PERM = false, AFTER_DRAIN = false;
    float* O; int ldc;
    __device__ __forceinline__ void operator()(const f32x4 (&acc)[2][2][4][2], const Unit& u, int wr, int wc, int fr, int fq) const {
        const int row0 = u.pm * BM + wr * 64 + fr, col0 = u.pn * BM + wc * 32 + 4 * fq;
#pragma unroll
        for (int ai = 0; ai < 2; ++ai)
#pragma unroll
            for (int m = 0; m < 4; ++m) { float* rowp = O + (size_t)(row0 + ai * HALF + m * 16) * ldc + col0;
#pragma unroll
                for (int bj = 0; bj < 2; ++bj)
#pragma unroll
                    for (int n = 0; n < 2; ++n) *(f32x4*)(rowp + bj * HALF + n * 16) = acc[ai][bj][m][n]; }
    }
};
__device__ __forceinline__ void unpack8(const u32x4 g, float (&f)[8]) { f[0] = bf_lo(g.x); f[1] = bf_hi(g.x); f[2] = bf_lo(g.y); f[3] = bf_hi(g.y); f[4] = bf_lo(g.z); f[5] = bf_hi(g.z); f[6] = bf_lo(g.w); f[7] = bf_hi(g.w); }
struct EpiGateA {
    static constexpr bool PERM = true, AFTER_DRAIN = false;
    bf16_t* M1; const bf16_t* proj;
    __device__ __forceinline__ void operator()(const f32x4 (&acc)[2][2][4][2], const Unit& u, int wr, int wc, int fr, int fq) const {
        const int row0 = u.pm * BM + wr * 64 + fr, col0 = u.pn * BM + wc * 32 + 8 * fq;
#pragma unroll
        for (int ai = 0; ai < 2; ++ai)
#pragma unroll
            for (int m = 0; m < 4; ++m) { const size_t row = (size_t)(row0 + ai * HALF + m * 16);
#pragma unroll
                for (int bj = 0; bj < 2; ++bj) { const int col = col0 + bj * HALF; float g[8]; unpack8(*(const u32x4*)(proj + row * INCP + OFF_GA + col), g);
                    const f32x4 v0 = acc[ai][bj][m][0], v1 = acc[ai][bj][m][1];
                    u32x4 w; w.x = pk2(v0[0] * g[0], v0[1] * g[1]); w.y = pk2(v0[2] * g[2], v0[3] * g[3]); w.z = pk2(v1[0] * g[4], v1[1] * g[5]); w.w = pk2(v1[2] * g[6], v1[3] * g[7]);
                    *(u32x4*)(M1 + row * DM + col) = w; } }
    }
};
struct EpiGateB {
    static constexpr bool PERM = true, AFTER_DRAIN = false;
    const bf16_t* M1; const bf16_t* proj; bf16_t* O;
    __device__ __forceinline__ void operator()(const f32x4 (&acc)[2][2][4][2], const Unit& u, int wr, int wc, int fr, int fq) const {
        const int row0 = u.pm * BM + wr * 64 + fr, col0 = u.pn * BM + wc * 32 + 8 * fq;
#pragma unroll
        for (int ai = 0; ai < 2; ++ai)
#pragma unroll
            for (int m = 0; m < 4; ++m) { const size_t row = (size_t)(row0 + ai * HALF + m * 16);
#pragma unroll
                for (int bj = 0; bj < 2; ++bj) { const int col = col0 + bj * HALF; float g[8], b[8]; unpack8(*(const u32x4*)(proj + row * INCP + OFF_GB + col), g); unpack8(*(const u32x4*)(M1 + row * DM + col), b);
                    const f32x4 v0 = acc[ai][bj][m][0], v1 = acc[ai][bj][m][1];
                    u32x4 w; w.x = pk2(b[0] + v0[0] * g[0], b[1] + v0[1] * g[1]); w.y = pk2(b[2] + v0[2] * g[2], b[3] + v0[3] * g[3]);
                    w.z = pk2(b[4] + v1[0] * g[4], b[5] + v1[1] * g[5]); w.w = pk2(b[6] + v1[2] * g[6], b[7] + v1[3] * g[7]);
                    *(u32x4*)(O + row * DM + col) = w; } }
    }
};
struct EpiResid {
    static constexpr bool PERM = false, AFTER_DRAIN = false;
    const float* X; bf16_t* O;
    __device__ __forceinline__ void operator()(const f32x4 (&acc)[2][2][4][2], const Unit& u, int wr, int wc, int fr, int fq) const {
        const int row0 = u.pm * BM + wr * 64 + fr, col0 = u.pn * BM + wc * 32 + 4 * fq;
#pragma unroll
        for (int ai = 0; ai < 2; ++ai)
#pragma unroll
            for (int m = 0; m < 4; ++m) { const size_t off = (size_t)(row0 + ai * HALF + m * 16) * DM + col0;
#pragma unroll
                for (int bj = 0; bj < 2; ++bj)
#pragma unroll
                    for (int n = 0; n < 2; ++n) { const f32x4 b = *(const f32x4*)(X + off + bj * HALF + n * 16) + acc[ai][bj][m][n]; u32x2 w; w.x = pk2(b[0], b[1]); w.y = pk2(b[2], b[3]); *(u32x2*)(O + off + bj * HALF + n * 16) = w; } }
    }
};
struct EpiSwiglu {
    static constexpr bool PERM = true, AFTER_DRAIN = false;
    unsigned char* ACT; const float* b1; const float* row_rstd;
    __device__ __forceinline__ void operator()(const f32x4 (&acc)[2][2][4][2], const Unit& u, int wr, int wc, int fr, int fq) const {
        const int row0 = u.pm * BM + wr * 64 + fr, f0 = u.pn * HALF + wc * 32 + 8 * fq; const float* be = b1 + (size_t)u.e * 2048;
        const f32x4 bg0 = *(const f32x4*)(be + f0), bg1 = *(const f32x4*)(be + f0 + 4), bu0 = *(const f32x4*)(be + DFF + f0), bu1 = *(const f32x4*)(be + DFF + f0 + 4);
        float rsv[8];
#pragma unroll
        for (int i = 0; i < 8; ++i) rsv[i] = row_rstd[u.rb + wr * 64 + fr + (i >> 2) * HALF + (i & 3) * 16] * W8_INV;
#pragma unroll
        for (int ai = 0; ai < 2; ++ai)
#pragma unroll
            for (int m = 0; m < 4; ++m) { const size_t row = (size_t)(row0 + ai * HALF + m * 16); float o[8]; const float rs = rsv[ai * 4 + m];
#pragma unroll
                for (int n = 0; n < 2; ++n) { const f32x4 g4 = acc[ai][0][m][n] * rs + (n ? bg1 : bg0), u4 = acc[ai][1][m][n] * rs + (n ? bu1 : bu0);
#pragma unroll
                    for (int j = 0; j < 4; ++j) { const float g = fminf(g4[j], 7.f), uu = fminf(fmaxf(u4[j], -7.f), 7.f); o[4 * n + j] = (uu + 1.f) * (g * sigmoidf_(1.702f * g)); } }
                u32x2 w; w.x = pk4_fp8(o[0], o[1], o[2], o[3]); w.y = pk4_fp8(o[4], o[5], o[6], o[7]); *(u32x2*)(ACT + row * DFF + f0) = w; }
    }
};
struct EpiMoeOut {
    static constexpr bool PERM = true, AFTER_DRAIN = false;
    unsigned char* YS; const float* b2; const float* row_w; const int* row_slot;
    __device__ __forceinline__ void operator()(const f32x4 (&acc)[2][2][4][2], const Unit& u, int wr, int wc, int fr, int fq) const {
        const int col0 = u.pn * BM + wc * 32 + 8 * fq; const float* be = b2 + (size_t)u.e * DM; const int rbase = u.rb + wr * 64 + fr;
        int slot[8]; float w[8];
#pragma unroll
        for (int i = 0; i < 8; ++i) { const int row = rbase + (i >> 2) * HALF + (i & 3) * 16; slot[i] = row_slot[row]; w[i] = row_w[row] * (W8_INV * YS_SCALE); }
        f32x4 bv[2][2];
#pragma unroll
        for (int bj = 0; bj < 2; ++bj)
#pragma unroll
            for (int n = 0; n < 2; ++n) bv[bj][n] = *(const f32x4*)(be + col0 + bj * HALF + 4 * n) * W8_SCALE;
#pragma unroll
        for (int ai = 0; ai < 2; ++ai)
#pragma unroll
            for (int m = 0; m < 4; ++m) { const int i = ai * 4 + m;
                if (slot[i] >= 0) { unsigned char* rowp = YS + (size_t)slot[i] * DM + col0;
#pragma unroll
                    for (int bj = 0; bj < 2; ++bj) { const f32x4 v0 = (acc[ai][bj][m][0] + bv[bj][0]) * w[i], v1 = (acc[ai][bj][m][1] + bv[bj][1]) * w[i];
                        u32x2 o; o.x = pk4_fp8(v0[0], v0[1], v0[2], v0[3]); o.y = pk4_fp8(v1[0], v1[1], v1[2], v1[3]); *(u32x2*)(rowp + bj * HALF) = o; } } }
    }
};
constexpr int MOE_MAXU = 12;
struct MoeOrder {
    StaticOrder so; const PG8_LAS int* utab; const PG8_LAS int* gtab;
    __device__ __forceinline__ bool next(int i, Unit& u) const { if (i >= MOE_MAXU || !so.next(i, u)) return false; const int v = __builtin_amdgcn_readfirstlane(utab[i]); u.e = v & 31; u.rb = (int)((unsigned)v >> 8); return true; }
    __device__ __forceinline__ void a_ready(const Unit&) const {}
    __device__ __forceinline__ void done(const Unit&) const {}
};
typedef int i32x4_t __attribute__((ext_vector_type(4))); typedef int i32x8_t __attribute__((ext_vector_type(8)));
__device__ __forceinline__ i32x8_t cat8(bf16x8 lo, bf16x8 hi) { return __builtin_shufflevector(__builtin_bit_cast(i32x4_t, lo), __builtin_bit_cast(i32x4_t, hi), 0, 1, 2, 3, 4, 5, 6, 7); }
__device__ __forceinline__ void mfma_fp8_inplace(f32x4& c, const i32x8_t a, const i32x8_t b) { asm volatile("s_nop 1\n\tv_mfma_f32_16x16x128_f8f6f4 %0, %1, %2, %0" : "+v"(c) : "v"(a), "v"(b)); }
__device__ __forceinline__ void mfma_fp8_drain() { asm volatile("s_nop 15\n\ts_nop 7" ::: "memory"); __builtin_amdgcn_sched_barrier(0); }
template <class Epi, class Sched, bool ALIGN_EPI = false, bool SP2 = false, bool FP8 = false, bool GATHER = false>
__device__ __forceinline__ void gemm_phase(PG8_LAS unsigned char* lds, const Gemm g, const Sched& S, const Epi& E) {
    int tid = threadIdx.x; asm volatile("" : "+v"(tid));
    const int wid = __builtin_amdgcn_readfirstlane(tid >> 6), lane = tid & 63, wr = wid >> 2, wc = wid & 3, fr = lane & 15, fq = lane >> 4;
    const int K = g.K, nt = K / BK;
    static_assert(!GATHER || SP2, "GATHER is implemented for the SP2 loop only");
    const unsigned rowA = (unsigned)(g.lda ? g.lda : K) * 2u, rowB = (unsigned)(g.ldb ? g.ldb : K) * 2u;
    unsigned voffA[2], voffB[2]; int gR0 = 0; unsigned gC = 0u;
#pragma unroll
    for (int i = 0; i < 2; ++i) { int R, C; stage_rc(tid * 16 + i * 8192, R, C); const int Rb = Epi::PERM ? ((R & ~31) + perm32(R & 31)) : R;
        voffA[i] = (unsigned)R * rowA + (unsigned)C * 2u; voffB[i] = (unsigned)Rb * rowB + (unsigned)C * 2u; if (i == 0) { gR0 = R; gC = (unsigned)C * 2u; } }
    unsigned gA[2][2] = {{0u, 0u}, {0u, 0u}}, ngA[2][2] = {{0u, 0u}, {0u, 0u}};
#define PG8_GLOAD(dst, ui_) do { _Pragma("unroll") for (int h_ = 0; h_ < 2; ++h_) _Pragma("unroll") for (int i_ = 0; i_ < 2; ++i_) \
        dst[h_][i_] = (unsigned)S.gtab[(ui_) * 256 + 128 * h_ + gR0 + 64 * i_] * rowA + gC; } while (0)
#define PG8_VA(h) (GATHER ? gA[h] : voffA)
    const unsigned kstep = (unsigned)(BK * 2);
    const unsigned hstep = (unsigned)HALF * rowB;
    const unsigned tstep = 2u * hstep;
    const unsigned hstepA = (unsigned)HALF * rowA, tstepA = 2u * hstepA;
    const unsigned hsA = GATHER ? 0u : hstepA;
    const unsigned ldsw = (unsigned)wid * 1024u;
    const int aoff = lds_byte(wr * 64 + fr, fq * 8), boff = lds_byte(wc * 32 + fr, fq * 8);
#define PG8_SA(b, h) (((b) * 2 + (h)) * HTB)
#define PG8_SB(b, h) ((4 + (b) * 2 + (h)) * HTB)
#define PG8_STAGE(rs, bufoff, goff, voff) do { _Pragma("unroll") for (int _i = 0; _i < 2; ++_i) \
        __builtin_amdgcn_raw_ptr_buffer_load_lds(rs, (PG8_LAS void*)(lds + (bufoff) + ldsw + _i * 8192), 16, (int)(voff)[_i], (int)(goff), 0, 0); } while (0)
#define PG8_LDA(dst, b, h) do { _Pragma("unroll") for (int m = 0; m < 4; ++m) _Pragma("unroll") for (int k = 0; k < 2; ++k) dst[m][k] = *(const PG8_LAS bf16x8*)(lds + PG8_SA(b, h) + aoff + m * 2048 + k * 1024); } while (0)
#define PG8_LDB(dst, b, h) do { _Pragma("unroll") for (int n = 0; n < 2; ++n) _Pragma("unroll") for (int k = 0; k < 2; ++k) dst[n][k] = *(const PG8_LAS bf16x8*)(lds + PG8_SB(b, h) + boff + n * 2048 + k * 1024); } while (0)
#define PG8_MMA(ai, bj, At, Bt) do { __builtin_amdgcn_s_setprio(1); _Pragma("unroll") for (int m = 0; m < 4; ++m) _Pragma("unroll") for (int n = 0; n < 2; ++n) { \
        if constexpr (FP8) { mfma_fp8_inplace(acc[ai][bj][m][n], cat8(Bt[n][0], Bt[n][1]), cat8(At[m][0], At[m][1])); } \
        else { _Pragma("unroll") for (int k = 0; k < 2; ++k) acc[ai][bj][m][n] = __builtin_amdgcn_mfma_f32_16x16x32_bf16(Bt[n][k], At[m][k], acc[ai][bj][m][n], 0, 0, 0); } } \
        __builtin_amdgcn_s_setprio(0); } while (0)
#define PG8_WAIT_V(n) asm volatile("s_waitcnt vmcnt(" #n ")" ::: "memory")
#define PG8_WAIT_L(n) asm volatile("s_waitcnt lgkmcnt(" #n ")" ::: "memory")
#define PG8_BAR __builtin_amdgcn_s_barrier()
#define PG8_SCHED __builtin_amdgcn_sched_barrier(0)
    Unit cur, nxt; int ui = 0;
    if (!S.next(0, cur)) return;
    f32x4 acc[2][2][4][2];
#pragma unroll
    for (int a = 0; a < 2; ++a)
#pragma unroll
        for (int b = 0; b < 2; ++b)
#pragma unroll
            for (int m = 0; m < 4; ++m)
#pragma unroll
                for (int n = 0; n < 2; ++n) acc[a][b][m][n] = (f32x4){0.f, 0.f, 0.f, 0.f};
    bf16x8 At[4][2], B0[2][2], B1[2][2];
    unsigned cA = GATHER ? 0u : (unsigned)cur.pm * tstepA, cB = (unsigned)cur.e * (unsigned)g.bstride + (unsigned)cur.pn * tstep;
    const __amdgpu_buffer_rsrc_t rsA = __builtin_amdgcn_make_buffer_rsrc((void*)g.A, 0, 0x7fffffff, 0x00020000), rsB = __builtin_amdgcn_make_buffer_rsrc((void*)g.Bt, 0, 0x7fffffff, 0x00020000);
    S.a_ready(cur);
    if constexpr (GATHER) PG8_GLOAD(gA, 0);
    if constexpr (SP2) {
        PG8_STAGE(rsB, PG8_SB(0, 0), cB, voffB); PG8_STAGE(rsB, PG8_SB(0, 1), cB + hstep, voffB); PG8_STAGE(rsA, PG8_SA(0, 0), cA, PG8_VA(0)); PG8_STAGE(rsA, PG8_SA(0, 1), cA + hsA, PG8_VA(1));
        if (wr == 1) PG8_BAR;
        PG8_WAIT_V(2); PG8_BAR;
        PG8_STAGE(rsB, PG8_SB(1, 0), cB + kstep, voffB); PG8_STAGE(rsA, PG8_SA(1, 0), cA + kstep, PG8_VA(0)); PG8_STAGE(rsB, PG8_SB(1, 1), cB + hstep + kstep, voffB);
        PG8_WAIT_V(6); PG8_BAR;
    } else {
        PG8_STAGE(rsB, PG8_SB(0, 0), cB, voffB); PG8_STAGE(rsA, PG8_SA(0, 0), cA, PG8_VA(0)); PG8_STAGE(rsB, PG8_SB(0, 1), cB + hstep, voffB); PG8_STAGE(rsA, PG8_SA(0, 1), cA + hsA, PG8_VA(1));
        if (wr == 1) PG8_BAR;
        PG8_WAIT_V(4); PG8_BAR;
        PG8_STAGE(rsB, PG8_SB(1, 0), cB + kstep, voffB); PG8_STAGE(rsA, PG8_SA(1, 0), cA + kstep, PG8_VA(0)); PG8_STAGE(rsB, PG8_SB(1, 1), cB + hstep + kstep, voffB);
        PG8_WAIT_V(6); PG8_BAR;
    }
    for (;;) {
        const bool has_next = S.next(ui + 1, nxt);
        if constexpr (GATHER) { if (has_next) PG8_GLOAD(ngA, ui + 1); else { ngA[0][0] = gA[0][0]; ngA[0][1] = gA[0][1]; ngA[1][0] = gA[1][0]; ngA[1][1] = gA[1][1]; } }
        const unsigned nA = (has_next && !GATHER) ? (unsigned)nxt.pm * tstepA : cA, nB = has_next ? (unsigned)nxt.e * (unsigned)g.bstride + (unsigned)nxt.pn * tstep : cB;
        asm volatile(".p2align 8");
        for (int t = 0; t < nt; t += 2) {
            const bool last = (t == nt - 2);
            const unsigned a1 = cA + (unsigned)(t + 1) * kstep;
            const unsigned a2 = last ? nA : cA + (unsigned)(t + 2) * kstep, b2 = last ? nB : cB + (unsigned)(t + 2) * kstep;
            const unsigned a3 = a2 + kstep, b3 = b2 + kstep;
            if (last && has_next) S.a_ready(nxt);
            if constexpr (SP2) {
            PG8_LDB(B0, 0, 0); PG8_LDB(B1, 0, 1); PG8_SCHED; PG8_LDA(At, 0, 0); PG8_STAGE(rsA, PG8_SA(1, 1), a1 + hsA, PG8_VA(1));
            if constexpr (GATHER) { if (last) { gA[0][0] = ngA[0][0]; gA[0][1] = ngA[0][1]; gA[1][0] = ngA[1][0]; gA[1][1] = ngA[1][1]; } }
            PG8_WAIT_V(8); PG8_WAIT_L(0); PG8_BAR; PG8_MMA(0, 0, At, B0); PG8_MMA(0, 1, At, B1); PG8_BAR; PG8_SCHED;
            PG8_LDA(At, 0, 1); PG8_STAGE(rsB, PG8_SB(0, 0), b2, voffB); PG8_STAGE(rsB, PG8_SB(0, 1), b2 + hstep, voffB); PG8_STAGE(rsA, PG8_SA(0, 0), a2, PG8_VA(0));
            PG8_WAIT_V(8); PG8_WAIT_L(0); PG8_BAR; PG8_MMA(1, 0, At, B0); PG8_MMA(1, 1, At, B1); PG8_BAR; PG8_SCHED;
            PG8_LDB(B0, 1, 0); PG8_LDB(B1, 1, 1); PG8_SCHED; PG8_LDA(At, 1, 0); PG8_STAGE(rsA, PG8_SA(0, 1), a2 + hsA, PG8_VA(1));
            PG8_WAIT_V(8); PG8_WAIT_L(0); PG8_BAR; PG8_MMA(0, 0, At, B0); PG8_MMA(0, 1, At, B1); PG8_BAR; PG8_SCHED;
            PG8_LDA(At, 1, 1); PG8_STAGE(rsB, PG8_SB(1, 0), b3, voffB); PG8_STAGE(rsB, PG8_SB(1, 1), b3 + hstep, voffB); PG8_STAGE(rsA, PG8_SA(1, 0), a3, PG8_VA(0));
            PG8_WAIT_V(8); PG8_WAIT_L(0); PG8_BAR; PG8_MMA(1, 0, At, B0); PG8_MMA(1, 1, At, B1); PG8_BAR; PG8_SCHED;
            } else {
            PG8_LDB(B0, 0, 0); PG8_SCHED; PG8_LDA(At, 0, 0); PG8_STAGE(rsA, PG8_SA(1, 1), a1 + hsA, PG8_VA(1));
            PG8_WAIT_L(8); PG8_BAR; PG8_WAIT_L(0); PG8_MMA(0, 0, At, B0); PG8_BAR; PG8_SCHED;
            PG8_LDB(B1, 0, 1); PG8_STAGE(rsB, PG8_SB(0, 0), b2, voffB);
            PG8_BAR; PG8_WAIT_L(0); PG8_MMA(0, 1, At, B1); PG8_BAR;
            PG8_LDA(At, 0, 1); PG8_STAGE(rsA, PG8_SA(0, 0), a2, PG8_VA(0));
            PG8_BAR; PG8_WAIT_L(0); PG8_MMA(1, 0, At, B0); PG8_BAR; PG8_SCHED;
            PG8_STAGE(rsB, PG8_SB(0, 1), b2 + hstep, voffB);
            PG8_WAIT_V(6); PG8_BAR; PG8_MMA(1, 1, At, B1); PG8_BAR;
            PG8_LDB(B0, 1, 0); PG8_SCHED; PG8_LDA(At, 1, 0); PG8_STAGE(rsA, PG8_SA(0, 1), a2 + hsA, PG8_VA(1));
            PG8_WAIT_L(8); PG8_BAR; PG8_WAIT_L(0); PG8_MMA(0, 0, At, B0); PG8_BAR; PG8_SCHED;
            PG8_LDB(B1, 1, 1); PG8_STAGE(rsB, PG8_SB(1, 0), b3, voffB);
            PG8_BAR; PG8_WAIT_L(0); PG8_MMA(0, 1, At, B1); PG8_BAR;
            PG8_LDA(At, 1, 1); PG8_STAGE(rsA, PG8_SA(1, 0), a3, PG8_VA(0));
            PG8_BAR; PG8_WAIT_L(0); PG8_MMA(1, 0, At, B0); PG8_BAR; PG8_SCHED;
            PG8_STAGE(rsB, PG8_SB(1, 1), b3 + hstep, voffB);
            PG8_WAIT_V(6); PG8_BAR; PG8_MMA(1, 1, At, B1); PG8_BAR;
            }
        }
        if constexpr (ALIGN_EPI) { if (wr == 0) PG8_BAR; }
        if constexpr (FP8) mfma_fp8_drain();
        if constexpr (!Epi::AFTER_DRAIN) { E(acc, cur, wr, wc, fr, fq); S.done(cur); }
        if (!has_next) break;
#pragma unroll
        for (int a = 0; a < 2; ++a)
#pragma unroll
            for (int b = 0; b < 2; ++b)
#pragma unroll
                for (int m = 0; m < 4; ++m)
#pragma unroll
                    for (int n = 0; n < 2; ++n) acc[a][b][m][n] = (f32x4){0.f, 0.f, 0.f, 0.f};
        cur = nxt; cA = nA; cB = nB; ++ui;
        if constexpr (ALIGN_EPI) { if (wr == 1) PG8_BAR; }
    }
    PG8_WAIT_V(0);
    if constexpr (!ALIGN_EPI) { if (wr == 0) PG8_BAR; }
    PG8_BAR;
    if constexpr (Epi::AFTER_DRAIN) { E.fused(acc, cur, wr, wc, fr, fq, lds, wid, lane); S.done(cur); }
#undef PG8_SA
#undef PG8_GLOAD
#undef PG8_VA
#undef PG8_SB
#undef PG8_STAGE
#undef PG8_LDA
#undef PG8_LDB
#undef PG8_MMA
#undef PG8_WAIT_V
#undef PG8_WAIT_L
#undef PG8_BAR
#undef PG8_SCHED
}
}

#define GAS __attribute__((address_space(1)))
#define LAS __attribute__((address_space(3)))
#define XB_TMO      128
#define XB_XCNT(j)  (256  + 64 * (j))
#define XB_XSUB(j)  (1280 + 64 * (j))
#define XB_XGEN(j)  (2304 + 64 * (j))
#define XB_TOP      3328
#define XB_TOPGEN   3392
#define XCD_BAR_WORDS 3456
#define XB_SPIN_CAP (1u << 18)

__device__ __forceinline__ unsigned xb_ld(unsigned* p)              { return __hip_atomic_load(p, __ATOMIC_RELAXED, __HIP_MEMORY_SCOPE_AGENT); }
__device__ __forceinline__ unsigned xb_add(unsigned* p, unsigned v) { return __hip_atomic_fetch_add(p, v, __ATOMIC_RELAXED, __HIP_MEMORY_SCOPE_AGENT); }
__device__ __forceinline__ unsigned xb_xcc_id() { return (unsigned)__builtin_amdgcn_s_getreg((3 << 11) | 20) & 0xFu; }
#define XB_SPIN(cond, bar) do { unsigned _sp = 0; while (cond) { __builtin_amdgcn_s_sleep(1); \
    if ((++_sp & 255u) == 0u) { if (xb_ld(&(bar)[XB_TMO])) break; if (_sp > XB_SPIN_CAP) { atomicAdd(&(bar)[XB_TMO], 1u); break; } } } } while (0)

struct XcdBarrier {
    unsigned* bar; unsigned x;
    volatile LAS unsigned* st;
};

__device__ __forceinline__ XcdBarrier xcd_barrier_post(unsigned* bar, volatile LAS unsigned* st) {
    XcdBarrier b; b.bar = bar; b.x = xb_xcc_id(); b.st = st;
    if (threadIdx.x == 0) (void)xb_add(&bar[XB_XCNT(b.x)], 1u);
    return b;
}
__device__ __forceinline__ void xcd_barrier_complete(unsigned* bar, unsigned x, unsigned& nloc, unsigned& nx) {
    const unsigned G = gridDim.x * gridDim.y * gridDim.z;
    unsigned sum, cnt, mine, sp = 0u;
    for (;;) {
        sum = 0u; cnt = 0u; mine = 0u;
#pragma unroll
        for (unsigned j = 0; j < 16; ++j) { const unsigned c = xb_ld(&bar[XB_XCNT(j)]); sum += c; cnt += (c > 0u) ? 1u : 0u; mine = (j == x) ? c : mine; }
        if (sum == G) break;
        __builtin_amdgcn_s_sleep(1);
        if ((++sp & 255u) == 0u) { if (xb_ld(&bar[XB_TMO])) break; if (sp > XB_SPIN_CAP) { atomicAdd(&bar[XB_TMO], 1u); break; } }
    }
    nloc = mine > 0u ? mine : 1u; nx = cnt > 0u ? cnt : 1u;
}

__device__ __forceinline__ void xcd_barrier(const XcdBarrier& b) {
    asm volatile("s_waitcnt vmcnt(0)" ::: "memory");
    __syncthreads();
    if (threadIdx.x == 0) {
        unsigned* bar = b.bar;
        __builtin_amdgcn_s_waitcnt(0);
        unsigned nloc = b.st[0], nx = b.st[1];
        if (nloc == 0u) { xcd_barrier_complete(bar, b.x, nloc, nx); b.st[0] = nloc; b.st[1] = nx; }
        const unsigned old = xb_add(&bar[XB_XSUB(b.x)], 1u);
        const unsigned gen = old / nloc;
        if (old + 1u == (gen + 1u) * nloc) {
            __builtin_amdgcn_fence(__ATOMIC_RELEASE, "agent");
            asm volatile("s_waitcnt vmcnt(0)" ::: "memory");
            const unsigned og = xb_add(&bar[XB_TOP], 1u);
            const unsigned tg = og / nx;
            if (og + 1u == (tg + 1u) * nx) xb_add(&bar[XB_TOPGEN], 1u);
            else XB_SPIN(xb_ld(&bar[XB_TOPGEN]) == tg, bar);
            __builtin_amdgcn_fence(__ATOMIC_ACQUIRE, "agent");
            xb_add(&bar[XB_XGEN(b.x)], 1u);
            asm volatile("s_waitcnt vmcnt(0)" ::: "memory");
        } else {
            XB_SPIN(xb_ld(&bar[XB_XGEN(b.x)]) == gen, bar);
            __builtin_amdgcn_fence(__ATOMIC_ACQUIRE, "agent");
            asm volatile("s_waitcnt vmcnt(0)" ::: "memory");
        }
    }
    __syncthreads();
}

template <int MODE  >
__device__ __forceinline__ void transpose_item(const float* __restrict__ W, int K, int N, bf16_t* __restrict__ WT, const float* __restrict__ gain, float* scr, int item, int lane) {
    const int nblk = N / 32, kb = item / nblk, nb = item % nblk, k0 = 64 * kb, n0 = 32 * nb;
#pragma unroll
    for (int i = 0; i < 8; ++i) { const int kk = 8 * i + (lane >> 3), n4 = (lane & 7) * 4; f32x4 v = *(const f32x4*)(W + (size_t)(k0 + kk) * N + n0 + n4);
        if (gain) { const float g = gain[k0 + kk]; v = v * g; }
        float* s = scr + kk * 33 + n4; s[0] = v[0]; s[1] = v[1]; s[2] = v[2]; s[3] = v[3]; }
    asm volatile("s_waitcnt lgkmcnt(0)" ::: "memory");
    const int c = lane & 7;
#pragma unroll
    for (int j = 0; j < 4; ++j) { const int n = (lane >> 3) + 8 * j; const float* s = scr + (8 * c) * 33 + n;
        u32x4 o; o.x = pk2(s[0 * 33], s[1 * 33]); o.y = pk2(s[2 * 33], s[3 * 33]); o.z = pk2(s[4 * 33], s[5 * 33]); o.w = pk2(s[6 * 33], s[7 * 33]);
        int row = n0 + n;
        if (MODE == 1) { const int f = row & 1023; row = ((f >> 7) << 8) + ((row >> 10) << 7) + (f & 127); }
        if (MODE == 2) { const int hh = row / DQK; row = hh * 128 + (row - hh * DQK); }
        if (MODE == 3) { const int hh = row >> 7, ii = row & 127; row = ((ii >> 6) << 9) + hh * 64 + (ii & 63); }
        *(u32x4*)(WT + (size_t)row * K + k0 + 8 * c) = o; }
    asm volatile("s_waitcnt lgkmcnt(0)" ::: "memory");
}
template <int MODE>
__device__ __forceinline__ void transpose_item_fp8(const float* __restrict__ W, int K, int N, unsigned char* __restrict__ WT, float* scr, int item, int lane) {
    const int nblk = N / 32, kb = item / nblk, nb = item % nblk, k0 = 64 * kb, n0 = 32 * nb;
#pragma unroll
    for (int i = 0; i < 8; ++i) { const int kk = 8 * i + (lane >> 3), n4 = (lane & 7) * 4; const f32x4 v = *(const f32x4*)(W + (size_t)(k0 + kk) * N + n0 + n4) * W8_SCALE;
        float* s = scr + kk * 33 + n4; s[0] = v[0]; s[1] = v[1]; s[2] = v[2]; s[3] = v[3]; }
    asm volatile("s_waitcnt lgkmcnt(0)" ::: "memory");
    const int c = lane & 7;
#pragma unroll
    for (int j = 0; j < 4; ++j) { const int n = (lane >> 3) + 8 * j; const float* s = scr + (8 * c) * 33 + n;
        u32x2 o; o.x = pk4_fp8(s[0 * 33], s[1 * 33], s[2 * 33], s[3 * 33]); o.y = pk4_fp8(s[4 * 33], s[5 * 33], s[6 * 33], s[7 * 33]);
        int row = n0 + n;
        if (MODE == 1) { const int f = row & 1023; row = ((f >> 7) << 8) + ((row >> 10) << 7) + (f & 127); }
        *(u32x2*)(WT + (size_t)row * K + k0 + 8 * c) = o; }
    asm volatile("s_waitcnt lgkmcnt(0)" ::: "memory");
}
__device__ __forceinline__ void phase_prologue(const Params& p, unsigned char* lds) {
    const int tid = threadIdx.x, lane = tid & 63, wave = tid >> 6;
    float* scr = (float*)(lds + wave * 16384);
    const int gw = blockIdx.x * NWAVES + wave, NGW = gridDim.x * NWAVES;
    unsigned char* ws = p.ws;
    constexpr int I_WIN = (DM / 64) * (INC / 32), I_UQ = (QLORA / 64) * (768 / 32), I_UKV = (KVLORA / 64) * (1024 / 32), I_OM = (512 / 64) * (DM / 32), I_OC = I_OM, I_WO = (DM / 64) * (DM / 32);
    constexpr int I_W1 = (DM / 64) * (2048 / 32), I_W2 = (DFF / 64) * (DM / 32);
    constexpr int NSMALL = I_WIN + I_UQ + I_UKV + I_OM + I_OC + I_WO;
    constexpr int NITEMS = NSMALL;
    for (int it = gw; it < NITEMS; it += NGW) {
        int r = it;
        if (r < I_WIN) { transpose_item<0>(p.w_in, DM, INC, (bf16_t*)(ws + WS_WIN), p.norm1_g, scr, r, lane); continue; } r -= I_WIN;
        if (r < I_UQ) { transpose_item<2>(p.w_uq, QLORA, 768, (bf16_t*)(ws + WS_WUQ), p.q_a_g, scr, r, lane); continue; } r -= I_UQ;
        if (r < I_UKV) { transpose_item<3>(p.w_ukv, KVLORA, 1024, (bf16_t*)(ws + WS_WUKV), p.kv_a_g, scr, r, lane); continue; } r -= I_UKV;
        if (r < I_OM) { transpose_item<0>(p.w_o_mla, 512, DM, (bf16_t*)(ws + WS_WOMLA), nullptr, scr, r, lane); continue; } r -= I_OM;
        if (r < I_OC) { transpose_item<0>(p.w_o_conv, 512, DM, (bf16_t*)(ws + WS_WOCONV), nullptr, scr, r, lane); continue; } r -= I_OC;
        transpose_item<0>(p.w_o, DM, DM, (bf16_t*)(ws + WS_WO), nullptr, scr, r, lane);
    }
    { u32x4* z = (u32x4*)((bf16_t*)(ws + WS_WIN) + (size_t)INC * DM); const int nz = (INCP - INC) * DM * 2 / 16;
      for (int i = blockIdx.x * NTHREADS + tid; i < nz; i += gridDim.x * NTHREADS) z[i] = (u32x4){0u, 0u, 0u, 0u}; }
    { u32x4* wq = (u32x4*)(ws + WS_WUQ); for (int i = blockIdx.x * NTHREADS + tid; i < NH * 32 * QLORA * 2 / 16; i += gridDim.x * NTHREADS) { const int hh = i / (32 * QLORA * 2 / 16), q = i - hh * (32 * QLORA * 2 / 16); wq[(hh * 128 + 96) * (QLORA * 2 / 16) + q] = (u32x4){0u, 0u, 0u, 0u}; } }
    { float* csd = (float*)(ws + WS_CS); for (int i = blockIdx.x * NTHREADS + tid; i < NTOK * 16; i += gridDim.x * NTHREADS) { const int t = i >> 4, j = i & 15; float sn, cn; sincosf((float)p.pos[t] * exp2f(-(float)j * (13.287712379549449f / 16.f)), &sn, &cn); csd[t * 32 + j] = cn; csd[t * 32 + 16 + j] = sn; } }
    if (blockIdx.x == 0 && tid < 64) { float gq = fabsf(p.q_g[tid]), gk = fabsf(p.k_g[tid]); if (tid < 32) { gq = fmaxf(gq, fabsf(p.q_g[64 + tid])); gk = fmaxf(gk, fabsf(p.k_g[64 + tid])); }
#pragma unroll
        for (int o = 1; o < 64; o <<= 1) { gq = fmaxf(gq, __shfl_xor(gq, o)); gk = fmaxf(gk, __shfl_xor(gk, o)); }
        if (tid == 0) *(float*)(ws + WS_SHIFT) = fmaxf(2.f, ceilf(14.135f * gq * gk + 0.5f - 15.f)); }
    { int* rt = (int*)(ws + WS_RT2); int* rs = (int*)(ws + WS_RT2 + 4 * MiB); float* rr = (float*)(ws + WS_RT2 + 6 * MiB);
      for (int i = blockIdx.x * NTHREADS + tid; i < NE * CAP; i += gridDim.x * NTHREADS) { rt[i] = 0; rs[i] = -1; rr[i] = 0.f; } }
    { u32x4* GF = (u32x4*)(ws + WS_GF);
      for (int i = blockIdx.x * NTHREADS + tid; i < 64 * 64; i += gridDim.x * NTHREADS) { const int ks = i >> 6, ln = i & 63, r = ln & 31, h = ln >> 5; float v[8], lo[8]; unsigned hi[4];
#pragma unroll
          for (int j = 0; j < 8; ++j) { const int k = 16 * ks + 8 * h + j; v[j] = p.norm2_g[k] * p.router_w[(size_t)k * NE + r]; }
#pragma unroll
          for (int j = 0; j < 4; ++j) { hi[j] = pk2(v[2 * j], v[2 * j + 1]); lo[2 * j] = v[2 * j] - bf_lo(hi[j]); lo[2 * j + 1] = v[2 * j + 1] - bf_hi(hi[j]); }
          GF[(ks * 2 + 0) * 64 + ln] = (u32x4){hi[0], hi[1], hi[2], hi[3]}; GF[(ks * 2 + 1) * 64 + ln] = (u32x4){pk2(lo[0], lo[1]), pk2(lo[2], lo[3]), pk2(lo[4], lo[5]), pk2(lo[6], lo[7])}; } }
    bf16_t* XN = (bf16_t*)(ws + WS_XN);
    for (int m = gw; m < NTOK; m += NGW) {
        const f32x4* xr = (const f32x4*)(p.x + (size_t)m * DM) + lane; f32x4 v[4]; float s = 0.f;
#pragma unroll
        for (int j = 0; j < 4; ++j) { v[j] = xr[64 * j]; s += (v[j][0] * v[j][0] + v[j][1] * v[j][1]) + (v[j][2] * v[j][2] + v[j][3] * v[j][3]); }
        const float rstd = rsqrtf(wave_sum(s) * (1.f / DM) + EPS);
        u32x2* o = (u32x2*)(XN + (size_t)m * DM) + lane;
#pragma unroll
        for (int j = 0; j < 4; ++j) { u32x2 w; w.x = pk2(v[j][0] * rstd, v[j][1] * rstd); w.y = pk2(v[j][2] * rstd, v[j][3] * rstd); o[64 * j] = w; }
    }
}

struct ConvRaw { u32x4 u[3], c[3], bg; float m0, m2; };
__device__ __forceinline__ void conv_load(ConvRaw& r, const Params& p, int t, int lane) {
    const bf16_t* pr = (const bf16_t*)(p.ws + WS_PROJ) + (size_t)t * INCP; const int s = t & (SEQ - 1);
    r.m0 = s > 0 ? 1.f : 0.f; r.m2 = s < SEQ - 1 ? 1.f : 0.f;
    const bf16_t* pm = s > 0 ? pr - INCP : pr; const bf16_t* pp = s < SEQ - 1 ? pr + INCP : pr;
    r.u[0] = *(const u32x4*)(pm + OFF_U + 8 * lane); r.c[0] = *(const u32x4*)(pm + OFF_C + 8 * lane);
    r.u[1] = *(const u32x4*)(pr + OFF_U + 8 * lane); r.c[1] = *(const u32x4*)(pr + OFF_C + 8 * lane);
    r.u[2] = *(const u32x4*)(pp + OFF_U + 8 * lane); r.c[2] = *(const u32x4*)(pp + OFF_C + 8 * lane);
    r.bg = *(const u32x4*)(pr + OFF_B + 8 * lane);
}
__device__ __forceinline__ void mulpair8(const u32x4 u, const u32x4 c, float (&o)[8]) {
    o[0] = bf_lo(u.x) * bf_lo(c.x); o[1] = bf_hi(u.x) * bf_hi(c.x); o[2] = bf_lo(u.y) * bf_lo(c.y); o[3] = bf_hi(u.y) * bf_hi(c.y);
    o[4] = bf_lo(u.z) * bf_lo(c.z); o[5] = bf_hi(u.z) * bf_hi(c.z); o[6] = bf_lo(u.w) * bf_lo(c.w); o[7] = bf_hi(u.w) * bf_hi(c.w); }
__device__ __forceinline__ void conv_store(const ConvRaw& r, const Params& p, int t, int lane, const float (&cw0)[8], const float (&cw1)[8], const float (&cw2)[8]) {
    float cu0[8], cu1[8], cu2[8], bb[8], y[8]; mulpair8(r.u[0], r.c[0], cu0); mulpair8(r.u[1], r.c[1], cu1); mulpair8(r.u[2], r.c[2], cu2);
    bb[0] = bf_lo(r.bg.x); bb[1] = bf_hi(r.bg.x); bb[2] = bf_lo(r.bg.y); bb[3] = bf_hi(r.bg.y); bb[4] = bf_lo(r.bg.z); bb[5] = bf_hi(r.bg.z); bb[6] = bf_lo(r.bg.w); bb[7] = bf_hi(r.bg.w);
#pragma unroll
    for (int j = 0; j < 8; ++j) y[j] = bb[j] * (cw0[j] * r.m0 * cu0[j] + cw1[j] * cu1[j] + cw2[j] * r.m2 * cu2[j]);
    u32x4 o; o.x = pk2(y[0], y[1]); o.y = pk2(y[2], y[3]); o.z = pk2(y[4], y[5]); o.w = pk2(y[6], y[7]); *(u32x4*)((bf16_t*)(p.ws + WS_YBIN) + (size_t)t * CONVW + 8 * lane) = o;
}
__device__ __forceinline__ void phase_conv(const Params& p) {
    int tid = threadIdx.x; asm volatile("" : "+v"(tid)); const int lane = tid & 63, wave = tid >> 6;
    const int gw = blockIdx.x * NWAVES + wave, NGW = gridDim.x * NWAVES;
    float cw0[8], cw1[8], cw2[8];
#pragma unroll
    for (int j = 0; j < 8; ++j) { cw0[j] = p.conv_w[8 * lane + j]; cw1[j] = p.conv_w[CONVW + 8 * lane + j]; cw2[j] = p.conv_w[2 * CONVW + 8 * lane + j]; }
    for (int t = gw; t < NTOK; t += 2 * NGW) {
        const int t1 = t + NGW; const bool two = t1 < NTOK;
        ConvRaw r0, r1; conv_load(r0, p, t, lane); conv_load(r1, p, two ? t1 : t, lane);
        conv_store(r0, p, t, lane, cw0, cw1, cw2);
        if (two) conv_store(r1, p, t1, lane, cw0, cw1, cw2);
    }
}

constexpr int WC_EXP_ITEMS = NE * 1536, WC_RAW_B = 9 * 1024;
struct WcItem { const float* W; unsigned char* WT; int N, k0, n0, mode; };
__device__ __forceinline__ WcItem wc_decode(const Params& p, int x) {
    WcItem it; const int e = x / 1536, r = x - e * 1536;
    if (r < 1024) { it.W = p.w1 + (size_t)e * DM * 2048; it.WT = p.ws + WS_W1 + (size_t)e * 2048 * DM; it.N = 2048; it.k0 = 64 * (r >> 6); it.n0 = 32 * (r & 63); it.mode = 1; }
    else { const int q = r - 1024; it.W = p.w2 + (size_t)e * DFF * DM; it.WT = p.ws + WS_W2 + (size_t)e * DM * DFF; it.N = DM; it.k0 = 64 * (q >> 5); it.n0 = 32 * (q & 31); it.mode = 0; }
    return it;
}
struct WConv { unsigned char* raw; int x0, nitems, cs, slot, sh, soff; bool m1; };
__device__ __forceinline__ bool wconv_step(WConv& c, const Params& p, int lane) {
    typedef __attribute__((address_space(3))) unsigned* lds_u32p;
    const int cs = c.cs, nst = 8 * c.nitems, fi = cs - 9;
    if (fi >= 0 && (fi & 7) == 0 && (fi >> 3) < c.nitems) {
        const int i = fi >> 3; const WcItem it = wc_decode(p, c.x0 + i); const int c8 = lane & 7, nr = lane >> 3, lv = (nr >> 2) | (c8 << 1);
        int sl = c.slot + c8; sl -= (sl >= 9) ? 9 : 0;
        const unsigned char* rb = c.raw + sl * 1024 + (nr & 3) * 4;
        float v[4][8];
#pragma unroll
        for (int j = 0; j < 4; ++j)
#pragma unroll
            for (int k = 0; k < 8; ++k) v[j][k] = *(const float*)(rb + (((k * 8 + 2 * j) ^ lv) << 4));
#pragma unroll
        for (int j = 0; j < 4; ++j) {
            u32x2 o; o.x = pk4_fp8(v[j][0] * W8_SCALE, v[j][1] * W8_SCALE, v[j][2] * W8_SCALE, v[j][3] * W8_SCALE); o.y = pk4_fp8(v[j][4] * W8_SCALE, v[j][5] * W8_SCALE, v[j][6] * W8_SCALE, v[j][7] * W8_SCALE);
            int row = it.n0 + nr + 8 * j; if (it.mode == 1) { const int f = row & 1023; row = ((f >> 7) << 8) + ((row >> 10) << 7) + (f & 127); }
            *(u32x2*)(it.WT + (size_t)row * DM + it.k0 + 8 * c8) = o; }
    }
    const bool issue = cs < nst;
    if (issue) {
        const int q = cs & 7;
        if (q == 0) { const int x = c.x0 + (cs >> 3), e = x / 1536, r = x - e * 1536;
            if (r < 1024) { c.m1 = true; c.sh = 13; c.soff = e * (DM * 2048 * 4) + (64 * (r >> 6)) * 8192 + (32 * (r & 63)) * 4; }
            else { const int q2 = r - 1024; c.m1 = false; c.sh = 12; c.soff = e * (DFF * DM * 4) + (64 * (q2 >> 5)) * 4096 + (32 * (q2 & 31)) * 4; } }
        const int sv = lane ^ (q << 1), voff = ((sv >> 3) << c.sh) + ((sv & 7) << 4), so = c.soff + ((8 * q) << c.sh);
        typedef __attribute__((address_space(3))) void* lds_vp;
        const __amdgpu_buffer_rsrc_t rs = __builtin_amdgcn_make_buffer_rsrc((void*)(c.m1 ? p.w1 : p.w2), 0, 0x7fffffff, 0x00020000);
        __builtin_amdgcn_raw_ptr_buffer_load_lds(rs, (lds_vp)(c.raw + c.slot * 1024), 16, voff, so, 0, 0);
    }
    c.cs = cs + 1; c.slot = (c.slot == 8) ? 0 : c.slot + 1;
    return issue;
}

namespace att {
constexpr int NW = 8, QBLK = 32, KVBLK = 64;
constexpr float SCALE = 0.10206207261596575f;
constexpr float QSC = SCALE * 1.4426950408889634f;
constexpr int LDQ = 128, LDK = 128;
constexpr int SHM_V = KVBLK * DV, SHM_K = KVBLK * 128, SHM_ATTN = 2 * SHM_V + 2 * SHM_K + NW * 64 * 4;
#define KSWZ(row, colB) ((row) * 256 + ((colB) ^ (((row) & 7) << 4)))
#define SBAR() __builtin_amdgcn_sched_barrier(0)
__device__ __forceinline__ int crow(int r, int hi) { return (r & 3) + 8 * (r >> 2) + 4 * hi; }
__device__ __forceinline__ float fadd_s(float a, float b) { float r; asm("v_add_f32_e32 %0, %1, %2" : "=v"(r) : "v"(a), "v"(b)); return r; }
__device__ __forceinline__ unsigned cvtpk(float lo, float hi) { unsigned r; asm volatile("v_cvt_pk_bf16_f32 %0, %1, %2" : "=v"(r) : "v"(lo), "v"(hi)); return r; }
typedef int i32x4a __attribute__((ext_vector_type(4))); typedef int i32x8a __attribute__((ext_vector_type(8)));
#define EXPH(P) do { _Pragma("unroll") for (int r = 0; r < 16; ++r) P[r] = __builtin_amdgcn_exp2f(P[r]); } while (0)
__device__ __forceinline__ unsigned pk4_bf8(float a, float b, float c, float d) { unsigned w = 0u; w = (unsigned)__builtin_amdgcn_cvt_pk_bf8_f32(a, b, (int)w, false); w = (unsigned)__builtin_amdgcn_cvt_pk_bf8_f32(c, d, (int)w, true); return w; }
__device__ __forceinline__ void finishSM(f32x16& p0, f32x16& p1, float& l_reg, i32x8a& pf) {
    EXPH(p1); SBAR();
    float ps0 = p0[0], ps1 = p1[0];
#pragma unroll
    for (int r = 1; r < 16; ++r) { ps0 = fadd_s(ps0, p0[r]); ps1 = fadd_s(ps1, p1[r]); }
    l_reg += ps0 + ps1;
#pragma unroll
    for (int q = 0; q < 4; ++q) {
        pf[q] = __builtin_amdgcn_cvt_pk_bf8_f32(p0[4 * q], p0[4 * q + 1], pf[q], false); pf[q] = __builtin_amdgcn_cvt_pk_bf8_f32(p0[4 * q + 2], p0[4 * q + 3], pf[q], true);
        pf[4 + q] = __builtin_amdgcn_cvt_pk_bf8_f32(p1[4 * q], p1[4 * q + 1], pf[4 + q], false); pf[4 + q] = __builtin_amdgcn_cvt_pk_bf8_f32(p1[4 * q + 2], p1[4 * q + 3], pf[4 + q], true); }
}
__device__ __forceinline__ void qkt(f32x16& p0, f32x16& p1, const unsigned char* Ks, const i32x8a* qf, int r32, int hi) {
    const f32x16 z = {};
#pragma unroll
    for (int kh = 0; kh < 2; ++kh) { const int row = kh * 32 + r32, sw = (row >> 1) & 7; const unsigned char* rb = Ks + row * 128; f32x16 acc = z;
#pragma unroll
        for (int s = 0; s < 2; ++s) { const int c0 = 4 * s + 2 * hi; const i32x4a lo = *reinterpret_cast<const i32x4a*>(rb + ((c0 ^ sw) << 4)), hh = *reinterpret_cast<const i32x4a*>(rb + (((c0 + 1) ^ sw) << 4));
            acc = __builtin_amdgcn_mfma_scale_f32_32x32x64_f8f6f4(__builtin_shufflevector(lo, hh, 0, 1, 2, 3, 4, 5, 6, 7), qf[s], acc, 0, 0, 0, 0, 0, 0); }
        if (kh == 0) p0 = acc; else p1 = acc; }
}
__device__ __forceinline__ i32x8a kfrag(const unsigned char* Ks, int kh, int s, int r32, int hi) {
    const int row = kh * 32 + r32, sw = (row >> 1) & 7, c0 = 4 * s + 2 * hi; const unsigned char* rb = Ks + row * 128;
    const i32x4a lo = *reinterpret_cast<const i32x4a*>(rb + ((c0 ^ sw) << 4)), hh = *reinterpret_cast<const i32x4a*>(rb + (((c0 + 1) ^ sw) << 4));
    return __builtin_shufflevector(lo, hh, 0, 1, 2, 3, 4, 5, 6, 7);
}
__device__ __forceinline__ i32x8a vfrag(const unsigned char* Vs, int d0, int r32, int hi) {
    const unsigned char* b = Vs + (((hi * 2 + d0) * 32 + r32) << 5); const int sw = (r32 >> 3) & 1;
    const i32x4a lo = *reinterpret_cast<const i32x4a*>(b + (sw << 4)), hh = *reinterpret_cast<const i32x4a*>(b + ((sw ^ 1) << 4));
    return __builtin_shufflevector(lo, hh, 0, 1, 2, 3, 4, 5, 6, 7);
}
__device__ __forceinline__ void pv8(f32x16& od, const i32x8a v, const i32x8a pfr) { asm volatile("s_nop 1\n\tv_mfma_f32_32x32x64_f8f6f4 %0, %1, %2, %0 blgp:1" : "+v"(od) : "v"(v), "v"(pfr)); }
#define EXPQ(P, B) do { _Pragma("unroll") for (int r = (B); r < (B) + 8; ++r) P[r] = __builtin_amdgcn_exp2f(P[r]); } while (0)
#define PV_STEP(Vs, PN) do { const i32x8a v0_ = vfrag((Vs), 0, r32, hi), v1_ = vfrag((Vs), 1, r32, hi); pv8(o[0], v0_, pf); EXPQ(PN, 0); pv8(o[1], v1_, pf); EXPQ(PN, 8); SBAR(); } while (0)

__device__ __forceinline__ void attn_unit(const unsigned char* __restrict__ Qb, const unsigned char* __restrict__ Kh, const unsigned char* __restrict__ Vth, bf16_t* __restrict__ Ob, int seq, unsigned char* lds, WConv& wc, const Params& prm) {
    const int tid = threadIdx.x, wid = __builtin_amdgcn_readfirstlane(tid >> 6), lane = tid & 63, r32 = lane & 31, hi = lane >> 5;
    unsigned char* V_lds = lds; unsigned char* K_lds = lds + 2 * SHM_V;
    f32x16 o[2] = {}; i32x8a qr[2];
    { const unsigned char* Qw = Qb + (size_t)(wid * QBLK + r32) * LDQ + hi * 32;
#pragma unroll
      for (int s = 0; s < 2; ++s) { const i32x4a lo = *reinterpret_cast<const i32x4a*>(Qw + 64 * s), hh = *reinterpret_cast<const i32x4a*>(Qw + 64 * s + 16); qr[s] = __builtin_shufflevector(lo, hh, 0, 1, 2, 3, 4, 5, 6, 7); } }
    const int kr0 = 8 * wid + (lane >> 3), kcp = lane & 7;
    const int kvoff = kr0 * LDK + ((kcp ^ ((kr0 >> 1) & 7)) * 16), vvoff = (wid & 3) * 1024 + lane * 16;
    const __amdgpu_buffer_rsrc_t rsK = __builtin_amdgcn_make_buffer_rsrc((void*)Kh, 0, 0x7fffffff, 0x00020000), rsV = __builtin_amdgcn_make_buffer_rsrc((void*)Vth, 0, 0x7fffffff, 0x00020000);
    typedef __attribute__((address_space(3))) void* lds_vp;
    const unsigned char* vsrc = Vth + (wid & 3) * 1024 + lane * 16;
    typedef __attribute__((address_space(3))) unsigned* lds_u32p;
#define DMA_K(t, slot) __builtin_amdgcn_raw_ptr_buffer_load_lds(rsK, (lds_vp)(K_lds + (slot) * SHM_K + wid * 1024), 16, kvoff, (t) * (KVBLK * LDK), 0, 0)
#define DMA_V(t, slot) do { if (wid < 4) __builtin_amdgcn_raw_ptr_buffer_load_lds(rsV, (lds_vp)(V_lds + (slot) * SHM_V + wid * 1024), 16, vvoff, (t) * 4096, 0, 0); } while (0)
    f32x16 pA0, pA1, pB0, pB1; i32x8a pf = {}; const int NT = seq / KVBLK;
    typedef float f32x4v __attribute__((ext_vector_type(4)));
    i32x8a ones; { const int c4 = ((lane & 1) == ((lane >> 4) & 1)) ? 0x22222222 : 0; ones = (i32x8a){c4, c4, c4, c4, 0, 0, 0, 0}; }
    f32x4v lsum = {0.f, 0.f, 0.f, 0.f};
    const f32x16 zacc = {};
#define QKM(ACC, KF, S, CIN) ACC = __builtin_amdgcn_mfma_scale_f32_32x32x64_f8f6f4(KF, qr[S], CIN, 0, 0, 0, 0, 0, 0)
#define ROWSUM() lsum = __builtin_amdgcn_mfma_scale_f32_16x16x128_f8f6f4(ones, pf, lsum, 4, 1, 0, 0, 0, 0)
#define CVT8(P, Q0) do { _Pragma("unroll") for (int q_ = 0; q_ < 4; ++q_) { pf[(Q0) + q_] = __builtin_amdgcn_cvt_pk_bf8_f32(P[4 * q_], P[4 * q_ + 1], pf[(Q0) + q_], false); pf[(Q0) + q_] = __builtin_amdgcn_cvt_pk_bf8_f32(P[4 * q_ + 2], P[4 * q_ + 3], pf[(Q0) + q_], true); } } while (0)
#define WAITW(ISS) do { if (ISS) asm volatile("s_waitcnt vmcnt(1)" ::: "memory"); else asm volatile("s_waitcnt vmcnt(0)" ::: "memory"); } while (0)
#define BARE_BAR() asm volatile("s_barrier" ::: "memory")
#define PIN(P) asm volatile("" : "+v"(P))
#define STEP(Ks, Vs, PC0, PC1, PX0, PX1) do { \
        const i32x8a k00_ = kfrag((Ks), 0, 0, r32, hi), k01_ = kfrag((Ks), 0, 1, r32, hi), k10_ = kfrag((Ks), 1, 0, r32, hi), k11_ = kfrag((Ks), 1, 1, r32, hi); SBAR(); \
        QKM(PX0, k00_, 0, zacc); PIN(PX0); EXPQ(PC1, 0); PIN(PC1); SBAR(); \
        QKM(PX0, k01_, 1, PX0); PIN(PX0); EXPQ(PC1, 8); PIN(PC1); SBAR(); \
        QKM(PX1, k10_, 0, zacc); PIN(PX1); CVT8(PC0, 0); PIN(pf); SBAR(); \
        QKM(PX1, k11_, 1, PX1); PIN(PX1); CVT8(PC1, 4); PIN(pf); const i32x8a v0_ = vfrag((Vs), 0, r32, hi), v1_ = vfrag((Vs), 1, r32, hi); SBAR(); \
        ROWSUM(); PIN(lsum); pv8(o[0], v0_, pf); EXPQ(PX0, 0); PIN(PX0); SBAR(); \
        pv8(o[1], v1_, pf); EXPQ(PX0, 8); PIN(PX0); SBAR(); } while (0)
    DMA_K(0, 0); DMA_V(0, 0); DMA_K(1, 1);
    asm volatile("s_waitcnt vmcnt(0)" ::: "memory"); __syncthreads();
    qkt(pA0, pA1, K_lds, qr, r32, hi); EXPH(pA0); SBAR();
    __syncthreads();
    asm volatile(".p2align 8");
    for (int j = 0; j + 2 < NT; j += 2) {
        DMA_K(j + 2, 0); DMA_V(j + 1, 1); const bool wlA = wconv_step(wc, prm, lane); SBAR();
        STEP(K_lds + SHM_K, V_lds, pA0, pA1, pB0, pB1);
        WAITW(wlA); BARE_BAR();
        DMA_K(j + 3, 1); DMA_V(j + 2, 0); const bool wlB = wconv_step(wc, prm, lane); SBAR();
        STEP(K_lds, V_lds + SHM_V, pB0, pB1, pA0, pA1);
        WAITW(wlB); BARE_BAR();
    }
    DMA_V(NT - 1, 1); const bool wlT = wconv_step(wc, prm, lane); SBAR();
    STEP(K_lds + SHM_K, V_lds, pA0, pA1, pB0, pB1);
    WAITW(wlT); BARE_BAR();
    EXPH(pB1); SBAR(); CVT8(pB0, 0); CVT8(pB1, 4); SBAR();
    { const i32x8a v0_ = vfrag(V_lds + SHM_V, 0, r32, hi), v1_ = vfrag(V_lds + SHM_V, 1, r32, hi); ROWSUM(); pv8(o[0], v0_, pf); pv8(o[1], v1_, pf); }
    asm volatile("s_nop 15\n\ts_nop 7" ::: "memory"); SBAR();
    const float l_reg = (lane & 16) ? lsum[1] : lsum[0];
#undef STEP
#undef PIN
#undef WAITW
#undef BARE_BAR
#undef QKM
#undef ROWSUM
#undef CVT8
    const float rl = __builtin_amdgcn_rcpf(l_reg);
    bf16_t* Ow = Ob + (size_t)(wid * QBLK + r32) * 512 + 4 * hi;
#pragma unroll
    for (int d0 = 0; d0 < 2; ++d0)
#pragma unroll
        for (int g = 0; g < 4; ++g) { u32x2 w; w.x = pk2(o[d0][4 * g] * rl, o[d0][4 * g + 1] * rl); w.y = pk2(o[d0][4 * g + 2] * rl, o[d0][4 * g + 3] * rl); *(u32x2*)(Ow + d0 * 32 + 8 * g) = w; }
    __syncthreads();
#undef DMA_K
#undef DMA_V
}
#undef KSWZ
#undef SBAR
}

__device__ __forceinline__ void phase_attn(const Params& p, unsigned char* lds) {
    const unsigned char* Q = p.ws + WS_Q; const unsigned char* Kb = p.ws + WS_K; const unsigned char* VT = p.ws + WS_V; bf16_t* AO = (bf16_t*)(p.ws + WS_AO);
    constexpr int NQB = SEQ / 256, NU = 2 * NH * NQB;
    const int lane = threadIdx.x & 63, wave = __builtin_amdgcn_readfirstlane(threadIdx.x >> 6), gw = blockIdx.x * NWAVES + wave, NGW = gridDim.x * NWAVES;
    const int ipw = (WC_EXP_ITEMS + NGW - 1) / NGW, nun = ((int)blockIdx.x < NU) ? (NU - 1 - (int)blockIdx.x) / (int)gridDim.x + 1 : 0, steps = nun * (SEQ / att::KVBLK - 1);
    int cov = (steps - 2) / 8; cov = cov < 0 ? 0 : (cov > ipw ? ipw : cov);
    WConv wc; wc.raw = lds + att::SHM_ATTN + wave * WC_RAW_B; wc.x0 = gw * ipw; wc.cs = 0; wc.slot = 0; wc.sh = 12; wc.soff = 0; wc.m1 = true;
    { const int left = WC_EXP_ITEMS - wc.x0; wc.nitems = left < 0 ? 0 : (left < cov ? left : cov); }
    if (wave >= 4) __builtin_amdgcn_s_setprio(1);
    const bool xmap = false;
    for (int u0 = blockIdx.x, rnd = 0; u0 < NU; u0 += gridDim.x, ++rnd) {
        const int u = xmap ? (((int)blockIdx.x & 7) + 8 * rnd) * NQB + ((int)blockIdx.x >> 3) : u0;
        const int qb = u % NQB, h = (u / NQB) % NH, b = u / (NQB * NH); const size_t bh = (size_t)(b * NH + h) * SEQ;
        att::attn_unit(Q + (bh + (size_t)qb * 256) * 128, Kb + bh * 128, VT + bh * DV, AO + ((size_t)b * SEQ + (size_t)qb * 256) * 512 + h * DV, SEQ, lds, wc, p);
    }
    __builtin_amdgcn_s_setprio(0);
    while (wc.cs < 8 * wc.nitems + 2) { wconv_step(wc, p, lane); asm volatile("s_waitcnt vmcnt(0)" ::: "memory"); }
}
__device__ __forceinline__ void wconv_cleanup(const Params& p, unsigned char* lds) {
    constexpr int NQB = SEQ / 256, NU = 2 * NH * NQB;
    const int lane = threadIdx.x & 63, wave = threadIdx.x >> 6, gw = blockIdx.x * NWAVES + wave, NGW = gridDim.x * NWAVES;
    const int ipw = (WC_EXP_ITEMS + NGW - 1) / NGW, nun = ((int)blockIdx.x < NU) ? (NU - 1 - (int)blockIdx.x) / (int)gridDim.x + 1 : 0, steps = nun * (SEQ / att::KVBLK - 1);
    int cov = (steps - 2) / 8; cov = cov < 0 ? 0 : (cov > ipw ? ipw : cov);
    float* scr = (float*)(lds + wave * 16384);
    for (int i = cov; i < ipw; ++i) { const int x = gw * ipw + i; if (x >= WC_EXP_ITEMS) break; const WcItem it = wc_decode(p, x); const int r = x % 1536;
        if (it.mode == 1) transpose_item_fp8<1>(it.W, DM, 2048, it.WT, scr, r, lane); else transpose_item_fp8<0>(it.W, DFF, DM, it.WT, scr, r - 1024, lane); }
    __syncthreads();
}

__device__ __forceinline__ int crow16(int r, int hi) { return (r & 3) + 8 * (r >> 2) + 4 * hi; }
__device__ __forceinline__ void phase_router(const Params& p, unsigned char* lds) {
    const int tid = threadIdx.x, lane = tid & 63, wid = tid >> 6, tile = wid >> 2, kq = wid & 3, c = lane & 31, h = lane >> 5;
    float* red = (float*)lds;
    float* ssb = red + 2 * 4 * 16 * 64;
    int* lcnt = (int*)(ssb + 2 * 4 * 64);
    int* lbase = lcnt + 32;
    unsigned* gcnt = (unsigned*)(p.ws + WS_CTL) + CW_CNT;
    int* row_tok = (int*)(p.ws + WS_RT2); float* row_w = (float*)(p.ws + WS_RT2 + 2 * MiB); int* row_slot = (int*)(p.ws + WS_RT2 + 4 * MiB); float* row_rstd = (float*)(p.ws + WS_RT2 + 6 * MiB);
    const u32x4* GF = (const u32x4*)(p.ws + WS_GF);
    for (int tg = blockIdx.x; tg < NTOK / 64; tg += gridDim.x) {
        if (tid < 32) lcnt[tid] = 0;
        const int token = tg * 64 + tile * 32 + c;
        const bf16_t* xrow = (const bf16_t*)(p.ws + WS_X1B) + (size_t)token * DM + kq * 256 + 8 * h; const float* g2p = p.norm2_g + kq * 256 + 8 * h;
        unsigned char* hrow = p.ws + WS_H8 + (size_t)token * DM + kq * 256 + 8 * h;
        f32x16 acc = {}; float ss = 0.f;
        u32x4 xh[16];
#pragma unroll
        for (int s = 0; s < 16; ++s) xh[s] = *(const u32x4*)(xrow + 16 * s);
#pragma unroll
        for (int sb = 0; sb < 16; sb += 8) { u32x4 gh[8], gl[8];
#pragma unroll
            for (int s = 0; s < 8; ++s) { gh[s] = GF[((kq * 16 + sb + s) * 2 + 0) * 64 + lane]; gl[s] = GF[((kq * 16 + sb + s) * 2 + 1) * 64 + lane]; }
            asm volatile("" ::: "memory");
#pragma unroll
            for (int s = 0; s < 8; ++s) {
                acc = __builtin_amdgcn_mfma_f32_32x32x16_bf16(__builtin_bit_cast(bf16x8, gh[s]), __builtin_bit_cast(bf16x8, xh[sb + s]), acc, 0, 0, 0);
                acc = __builtin_amdgcn_mfma_f32_32x32x16_bf16(__builtin_bit_cast(bf16x8, gl[s]), __builtin_bit_cast(bf16x8, xh[sb + s]), acc, 0, 0, 0); } }
#pragma unroll
        for (int s = 0; s < 16; ++s) {
            const f32x4 ga = *(const f32x4*)(g2p + 16 * s), gb = *(const f32x4*)(g2p + 16 * s + 4);
            const f32x4 a = {bf_lo(xh[s].x), bf_hi(xh[s].x), bf_lo(xh[s].y), bf_hi(xh[s].y)}, b = {bf_lo(xh[s].z), bf_hi(xh[s].z), bf_lo(xh[s].w), bf_hi(xh[s].w)};
            ss += (a[0] * a[0] + a[1] * a[1]) + (a[2] * a[2] + a[3] * a[3]) + (b[0] * b[0] + b[1] * b[1]) + (b[2] * b[2] + b[3] * b[3]);
            u32x2 h8; h8.x = pk4_fp8(a[0] * ga[0], a[1] * ga[1], a[2] * ga[2], a[3] * ga[3]); h8.y = pk4_fp8(b[0] * gb[0], b[1] * gb[1], b[2] * gb[2], b[3] * gb[3]); *(u32x2*)(hrow + 16 * s) = h8;
        }
#pragma unroll
        for (int r = 0; r < 16; ++r) red[((tile * 4 + kq) * 16 + r) * 64 + lane] = acc[r];
        ssb[(tile * 4 + kq) * 64 + lane] = ss;
        __syncthreads();
        int te[4] = {0, 0, 0, 0}, rl[4] = {0, 0, 0, 0}; float tw[4] = {0.f, 0.f, 0.f, 0.f}; float rstd = 0.f;
        if (kq == 0) {
            float v[16]; float st = 0.f;
#pragma unroll
            for (int q = 0; q < 4; ++q) st += ssb[(tile * 4 + q) * 64 + lane];
            { auto rr = __builtin_amdgcn_permlane32_swap(__float_as_uint(st), __float_as_uint(st), false, false); st = __uint_as_float(rr[0]) + __uint_as_float(rr[1]); }
            rstd = rsqrtf(st * (1.f / DM) + EPS);
#pragma unroll
            for (int r = 0; r < 16; ++r) { float sacc = 0.f;
#pragma unroll
                for (int q = 0; q < 4; ++q) sacc += red[((tile * 4 + q) * 16 + r) * 64 + lane];
                v[r] = sacc * rstd + p.router_b[crow16(r, h)]; }
            float lv[4]; int le[4];
#pragma unroll
            for (int k = 0; k < 4; ++k) { float best = v[0]; int bi = 0;
#pragma unroll
                for (int r = 1; r < 16; ++r) { const bool gt = v[r] > best; best = gt ? v[r] : best; bi = gt ? r : bi; }
                lv[k] = best; le[k] = (bi & 3) + 8 * (bi >> 2) + 4 * h;
#pragma unroll
                for (int r = 0; r < 16; ++r) v[r] = (r == bi) ? -INFINITY : v[r]; }
            float cv[8]; int ce[8];
#pragma unroll
            for (int k = 0; k < 4; ++k) { auto rv = __builtin_amdgcn_permlane32_swap(__float_as_uint(lv[k]), __float_as_uint(lv[k]), false, false); auto re = __builtin_amdgcn_permlane32_swap((unsigned)le[k], (unsigned)le[k], false, false);
                cv[k] = __uint_as_float(rv[0]); cv[4 + k] = __uint_as_float(rv[1]); ce[k] = (int)re[0]; ce[4 + k] = (int)re[1]; }
            float tv[4];
#pragma unroll
            for (int k = 0; k < 4; ++k) { float best = cv[0]; int be = ce[0]; int bi = 0;
#pragma unroll
                for (int r = 1; r < 8; ++r) { const bool gt = (cv[r] > best) || (cv[r] == best && ce[r] < be); best = gt ? cv[r] : best; be = gt ? ce[r] : be; bi = gt ? r : bi; }
                tv[k] = best; te[k] = be;
#pragma unroll
                for (int r = 0; r < 8; ++r) cv[r] = (r == bi) ? -INFINITY : cv[r]; }
            const float e1 = __expf(tv[1] - tv[0]), e2 = __expf(tv[2] - tv[0]), e3 = __expf(tv[3] - tv[0]); const float inv = 1.f / (1.f + e1 + e2 + e3);
            tw[0] = inv; tw[1] = e1 * inv; tw[2] = e2 * inv; tw[3] = e3 * inv;
            if (h == 0) {
#pragma unroll
                for (int k = 0; k < 4; ++k) rl[k] = atomicAdd(&lcnt[te[k]], 1); }
        }
        __syncthreads();
        if (tid < 32) lbase[tid] = (int)atomicAdd(&gcnt[tid], (unsigned)lcnt[tid]);
        __syncthreads();
        if (kq == 0 && h == 0) {
#pragma unroll
            for (int k = 0; k < 4; ++k) { const int idx = te[k] * CAP + lbase[te[k]] + rl[k]; row_tok[idx] = token; row_w[idx] = tw[k]; row_slot[idx] = token * 4 + k; row_rstd[idx] = rstd; } }
        __syncthreads();
    }
}

__device__ __forceinline__ void build_block_table(const Params& p, int* bs) {
    const unsigned* gcnt = (const unsigned*)(p.ws + WS_CTL) + CW_CNT;
    if (threadIdx.x == 0) { int acc = 0; for (int e = 0; e < NE; ++e) { bs[e] = acc; acc += ((int)__hip_atomic_load(gcnt + e, __ATOMIC_RELAXED, __HIP_MEMORY_SCOPE_AGENT) + 255) >> 8; } bs[NE] = acc; }
    __syncthreads();
}

__device__ __forceinline__ pg8::MoeOrder make_moe_order(const Params& p, unsigned char* lds, int N, bool gather) {
    int* bs = (int*)(lds + 131072); int* utab = (int*)(lds + 131072 + 256); int* gtab = (int*)(lds + 131072 + 512);
    build_block_table(p, bs);
    const int nmb = __builtin_amdgcn_readfirstlane(bs[NE]);
    pg8::MoeOrder S; S.so.init(nmb * 256, N, (int)gridDim.x, (int)blockIdx.x); S.utab = (const PG8_LAS int*)utab; S.gtab = (const PG8_LAS int*)gtab;
    const int* row_tok = (const int*)(p.ws + WS_RT2);
    for (int i = 0; i < pg8::MOE_MAXU; ++i) { pg8::Unit u; if (!S.so.next(i, u)) break; int e = 0; for (int k = 1; k < NE; ++k) if (bs[k] <= u.pm) e = k;
        const int rb = e * CAP + (u.pm - bs[e]) * 256;
        if (threadIdx.x == 0) utab[i] = e | (rb << 8);
        if (gather && threadIdx.x < 256) gtab[i * 256 + threadIdx.x] = row_tok[rb + threadIdx.x]; }
    __syncthreads();
    return S;
}
__device__ __forceinline__ void phase_moe1(const Params& p, unsigned char* lds) {
    const pg8::MoeOrder S = make_moe_order(p, lds, 2048, true);
    pg8::Gemm g{(const bf16_t*)(p.ws + WS_H8), (const bf16_t*)(p.ws + WS_W1), 0, 2048, DM / 2, (size_t)2048 * DM, 0, 0};
    pg8::EpiSwiglu E{p.ws + WS_ACT, p.b1, (const float*)(p.ws + WS_RT2 + 6 * MiB)};
    pg8::gemm_phase<pg8::EpiSwiglu, pg8::MoeOrder, true, true, true, true>((PG8_LAS unsigned char*)lds, g, S, E);
}
__device__ __forceinline__ void phase_moe2(const Params& p, unsigned char* lds) {
    const pg8::MoeOrder S = make_moe_order(p, lds, DM, false);
    pg8::Gemm g{(const bf16_t*)(p.ws + WS_ACT), (const bf16_t*)(p.ws + WS_W2), 0, DM, DFF / 2, (size_t)DM * DFF, 0, 0};
    pg8::EpiMoeOut E{p.ws + WS_YS, p.b2, (const float*)(p.ws + WS_RT2 + 2 * MiB), (const int*)(p.ws + WS_RT2 + 4 * MiB)};
    pg8::gemm_phase<pg8::EpiMoeOut, pg8::MoeOrder, true, true, true>((PG8_LAS unsigned char*)lds, g, S, E);
}

__device__ __forceinline__ float fp8_to_f32(unsigned w, int byte) {
    return byte == 0 ? __builtin_amdgcn_cvt_f32_fp8((int)w, 0) : byte == 1 ? __builtin_amdgcn_cvt_f32_fp8((int)w, 1) : byte == 2 ? __builtin_amdgcn_cvt_f32_fp8((int)w, 2) : __builtin_amdgcn_cvt_f32_fp8((int)w, 3); }
__device__ __forceinline__ void phase_combine(const Params& p) {
    const int tid = threadIdx.x, lane = tid & 63, wave = tid >> 6;
    const int gw = blockIdx.x * NWAVES + wave, NGW = gridDim.x * NWAVES;
    const unsigned char* YS = p.ws + WS_YS;
    for (int t = gw; t < NTOK; t += NGW) {
        f32x4* orow = (f32x4*)(p.out + (size_t)t * DM) + lane; const u32x2* xrow = (const u32x2*)((const bf16_t*)(p.ws + WS_X1B) + (size_t)t * DM) + lane;
        f32x4 v[4]; unsigned w[4][4];
#pragma unroll
        for (int j = 0; j < 4; ++j) { const u32x2 xb = xrow[64 * j]; v[j] = (f32x4){bf_lo(xb.x), bf_hi(xb.x), bf_lo(xb.y), bf_hi(xb.y)};
#pragma unroll
            for (int k = 0; k < 4; ++k) w[j][k] = *((const unsigned*)(YS + ((size_t)t * 4 + k) * DM) + lane + 64 * j); }
#pragma unroll
        for (int j = 0; j < 4; ++j) { f32x4 s = {0.f, 0.f, 0.f, 0.f};
#pragma unroll
            for (int k = 0; k < 4; ++k) { s[0] += fp8_to_f32(w[j][k], 0); s[1] += fp8_to_f32(w[j][k], 1); s[2] += fp8_to_f32(w[j][k], 2); s[3] += fp8_to_f32(w[j][k], 3); }
            orow[64 * j] = v[j] + s * YS_INV; }
    }
}

template <class Epi>
__device__ __forceinline__ void dense_gemm(unsigned char* lds, const bf16_t* A, const bf16_t* Bt, int M, int N, int K, const Epi& E, int lda = 0, int ldb = 0, int cshift = 0) {
    pg8::Gemm g{A, Bt, M, N, K, 0, lda, ldb}; pg8::StaticOrder S; S.init(M, N, (int)gridDim.x, (int)((blockIdx.x + cshift) % gridDim.x));
    pg8::gemm_phase<Epi, pg8::StaticOrder, true, true>((PG8_LAS unsigned char*)lds, g, S, E);
}

constexpr int NPHASE = 13;
__global__ void __launch_bounds__(NTHREADS, 2) mk_fwd(Params p) {
    extern __shared__ __attribute__((aligned(16))) unsigned char lds[];
    cg::grid_group grid = cg::this_grid();
    unsigned char* ws = p.ws;
    volatile LAS unsigned* MISC = (volatile LAS unsigned*)((LAS unsigned char*)lds + MISC_OFF);
    if (threadIdx.x < 32) MISC[threadIdx.x] = 0u;
    __syncthreads();
    XcdBarrier bar = xcd_barrier_post((unsigned*)(ws + WS_CTL) + CW_BAR, MISC + 8);
    const int lo = p.ph_lo, hi = p.ph_hi;
    if (lo < 0) grid.sync();
#define IN(k) (lo <= (k) && (k) < hi)
#define SEAM(k) do { if (IN(k) && IN((k) + 1)) xcd_barrier(bar); } while (0)
    if (IN(0)) phase_prologue(p, lds);
    SEAM(0);
    if (IN(1)) { pg8::EpiProj E{(bf16_t*)(ws + WS_PROJ), (float*)(ws + WS_SSQ)}; dense_gemm(lds, (const bf16_t*)(ws + WS_XN), (const bf16_t*)(ws + WS_WIN), NTOK, INCP, DM, E); }
    if (IN(1) && IN(3)) xcd_barrier(bar);
    if (IN(3)) { const float* ssq = (const float*)(ws + WS_SSQ); const float* cst = (const float*)(ws + WS_CS); float* hs = (float*)(lds + 131072);
                 pg8::EpiQ Eq{ws + WS_Q, ssq, p.q_g, cst, hs}; dense_gemm(lds, (const bf16_t*)(ws + WS_PROJ) + OFF_CQ, (const bf16_t*)(ws + WS_WUQ), NTOK, 1024, QLORA, Eq, INCP);
                 pg8::EpiK Ek{ws + WS_K, ssq, p.k_g, cst, (const bf16_t*)(ws + WS_PROJ), hs, (const float*)(ws + WS_SHIFT)}; dense_gemm(lds, (const bf16_t*)(ws + WS_PROJ) + OFF_CKV, (const bf16_t*)(ws + WS_WUKV), NTOK, 512, KVLORA, Ek, INCP);
                 pg8::EpiVT Ev{ws + WS_V, ssq}; dense_gemm(lds, (const bf16_t*)(ws + WS_WUKV) + 512 * KVLORA, (const bf16_t*)(ws + WS_PROJ) + OFF_CKV, 512, NTOK, KVLORA, Ev, 0, INCP, (int)gridDim.x / 2);
                 phase_conv(p); }
    if (IN(3) && IN(5)) xcd_barrier(bar);
    if (IN(5)) phase_attn(p, lds);
    SEAM(5);
    if (IN(6)) { pg8::EpiGateA E{(bf16_t*)(ws + WS_M1), (const bf16_t*)(ws + WS_PROJ)}; dense_gemm(lds, (const bf16_t*)(ws + WS_AO), (const bf16_t*)(ws + WS_WOMLA), NTOK, DM, 512, E); }
    if (IN(7)) { pg8::EpiGateB E{(const bf16_t*)(ws + WS_M1), (const bf16_t*)(ws + WS_PROJ), (bf16_t*)(ws + WS_MERGED)}; dense_gemm(lds, (const bf16_t*)(ws + WS_YBIN), (const bf16_t*)(ws + WS_WOCONV), NTOK, DM, 512, E); }
    SEAM(7);
    if (IN(8)) { pg8::EpiResid E{p.x, (bf16_t*)(ws + WS_X1B)}; dense_gemm(lds, (const bf16_t*)(ws + WS_MERGED), (const bf16_t*)(ws + WS_WO), NTOK, DM, DM, E); }
    SEAM(8);
    if (IN(9)) { wconv_cleanup(p, lds); phase_router(p, lds); }
    if (IN(9) && IN(11)) xcd_barrier(bar);
    if (IN(11)) phase_moe1(p, lds);
    SEAM(11);
    if (IN(12)) phase_moe2(p, lds);
    SEAM(12);
    if (IN(13)) phase_combine(p);
#undef IN
#undef SEAM
}

extern "C" void kernel_launch(void* const* d_in, const int* in_sizes, int n_in, void* d_out, int out_size,
                              void* d_ws, size_t ws_size, hipStream_t stream) {
    static int grid_blocks = 0;
    if (!grid_blocks) {
        int dev = 0, cus = 0, per_cu = 0;
        (void)hipGetDevice(&dev);
        (void)hipDeviceGetAttribute(&cus, hipDeviceAttributeMultiprocessorCount, dev);
        (void)hipFuncSetAttribute((const void*)mk_fwd, hipFuncAttributeMaxDynamicSharedMemorySize, LDS_BYTES);
        (void)hipOccupancyMaxActiveBlocksPerMultiprocessor(&per_cu, (const void*)mk_fwd, NTHREADS, LDS_BYTES);
        if (per_cu < 1) { fprintf(stderr, "kernel_launch: occupancy query says %d blocks/CU\n", per_cu); per_cu = 1; }
        grid_blocks = cus;
        if (ws_size < WS_END2 || n_in != 21) fprintf(stderr, "kernel_launch: ws %zu < %zu or n_in %d != 21\n", ws_size, (size_t)WS_END2, n_in);
    }
    (void)hipMemsetAsync((char*)d_ws + WS_CTL, 0, 1 * MiB, stream);
    Params p{};
    p.x = (const float*)d_in[0]; p.pos = (const int*)d_in[1]; p.norm1_g = (const float*)d_in[2]; p.w_in = (const float*)d_in[3]; p.q_a_g = (const float*)d_in[4];
    p.kv_a_g = (const float*)d_in[5]; p.w_uq = (const float*)d_in[6]; p.w_ukv = (const float*)d_in[7]; p.q_g = (const float*)d_in[8]; p.k_g = (const float*)d_in[9];
    p.conv_w = (const float*)d_in[10]; p.w_o_mla = (const float*)d_in[11]; p.w_o_conv = (const float*)d_in[12]; p.w_o = (const float*)d_in[13]; p.norm2_g = (const float*)d_in[14];
    p.router_w = (const float*)d_in[15]; p.router_b = (const float*)d_in[16]; p.w1 = (const float*)d_in[17]; p.b1 = (const float*)d_in[18]; p.w2 = (const float*)d_in[19]; p.b2 = (const float*)d_in[20];
    p.out = (float*)d_out; p.ws = (unsigned char*)d_ws; p.ph_lo = 0; p.ph_hi = NPHASE + 1;
    void* args[] = {&p};
    hipError_t e = hipLaunchCooperativeKernel((const void*)mk_fwd, dim3(grid_blocks), dim3(NTHREADS), args, LDS_BYTES, stream);
    if (e != hipSuccess) fprintf(stderr, "cooperative launch failed: %s (grid %d)\n", hipGetErrorString(e), grid_blocks);
}
```

```cpp
#include <hip/hip_runtime.h>
#include <hip/hip_cooperative_groups.h>
#include <cstdio>
#include <cstdint>
namespace cg = cooperative_groups;

typedef unsigned short bf16_t;
typedef short bf16x8 __attribute__((ext_vector_type(8)));
typedef short s16x4 __attribute__((ext_vector_type(4)));
typedef float f32x4 __attribute__((ext_vector_type(4)));
typedef float f32x2 __attribute__((ext_vector_type(2)));
typedef float f32x16 __attribute__((ext_vector_type(16)));
typedef unsigned u32x4 __attribute__((ext_vector_type(4)));
typedef unsigned u32x2 __attribute__((ext_vector_type(2)));
typedef __bf16 bf16x2_t __attribute__((ext_vector_type(2)));

constexpr int NTOK = 16384, DM = 1024, SEQ = 8192;
constexpr int INC = 4000, INCP = 4096;
constexpr int OFF_CQ = 0, OFF_CKV = 256, OFF_KR = 384, OFF_U = 416, OFF_C = 928, OFF_B = 1440, OFF_GA = 1952, OFF_GB = 2976;
constexpr int NH = 8, DQK = 96, DV = 64, NE = 32, TOPK = 4, DFF = 1024;
constexpr int QLORA = 256, KVLORA = 128, CONVW = 512;
constexpr int NPAIR = NTOK * TOPK;
constexpr int MAXROWS = 73728;
constexpr float EPS = 1e-6f;
constexpr float QSCALE = 0.10206207261596575f * 1.4426950408889634f;
constexpr int CAP = 16384;
constexpr int NTHREADS = 512, NWAVES = 8;
constexpr int LDS_BYTES = 147456;

constexpr size_t MiB = 1ull << 20;
constexpr size_t WS_CTL = 0;
constexpr size_t WS_WIN = 1 * MiB;
constexpr size_t WS_WUQ = 9 * MiB;
constexpr size_t WS_WUKV = WS_WUQ + 512 * 1024;
constexpr size_t WS_WOMLA = 10 * MiB;
constexpr size_t WS_WOCONV = 11 * MiB;
constexpr size_t WS_WO = 12 * MiB;
constexpr size_t WS_ROUTE = 14 * MiB;
constexpr size_t WS_W1 = 18 * MiB;
constexpr size_t WS_W2 = 146 * MiB;
constexpr size_t WS_XN = 210 * MiB;
constexpr size_t WS_PROJ = 242 * MiB;
constexpr size_t WS_CQN = 370 * MiB;
constexpr size_t WS_CKVN = 378 * MiB;
constexpr size_t WS_YBIN = 386 * MiB;
constexpr size_t WS_QPRE = 402 * MiB;
constexpr size_t WS_KVPRE = 450 * MiB;
constexpr size_t WS_Q = 514 * MiB;
constexpr size_t WS_K = 538 * MiB;
constexpr size_t WS_V = 570 * MiB;
constexpr size_t WS_AO = 586 * MiB;
constexpr size_t WS_M1 = 602 * MiB;
constexpr size_t WS_MERGED = 666 * MiB;
constexpr size_t WS_YS = 698 * MiB;
constexpr size_t WS_END = 826 * MiB;
constexpr size_t WS_ACT = WS_PROJ;
constexpr size_t WS_X1B = WS_M1;
constexpr size_t WS_H8 = WS_XN;
constexpr size_t WS_GF = 830 * MiB;
constexpr size_t WS_RT2 = 832 * MiB;
constexpr size_t WS_SSQ = 840 * MiB;
constexpr size_t WS_CS = 841 * MiB;
constexpr size_t WS_SHIFT = 843 * MiB;
constexpr size_t WS_END2 = 844 * MiB;
constexpr size_t RT_PAIR_E = 0, RT_PAIR_RANK = 262144, RT_PAIR_W = 524288, RT_ROW_TOK = 786432, RT_ROW_W = 786432 + 294912, RT_ROW_SLOT = 786432 + 2 * 294912;
constexpr int CW_CNT = 64;
constexpr int CW_BAR = 4096;
constexpr int MISC_OFF = LDS_BYTES - 256;

struct Params {
    const float* x; const int* pos; const float* norm1_g; const float* w_in; const float* q_a_g; const float* kv_a_g;
    const float* w_uq; const float* w_ukv; const float* q_g; const float* k_g; const float* conv_w; const float* w_o_mla;
    const float* w_o_conv; const float* w_o; const float* norm2_g; const float* router_w; const float* router_b;
    const float* w1; const float* b1; const float* w2; const float* b2;
    float* out; unsigned char* ws; int ph_lo, ph_hi;
};

__device__ __forceinline__ unsigned pk2(float lo, float hi) { f32x2 v = {lo, hi}; bf16x2_t b = __builtin_convertvector(v, bf16x2_t); return __builtin_bit_cast(unsigned, b); }
__device__ __forceinline__ float bf_lo(unsigned w) { return __uint_as_float(w << 16); }
__device__ __forceinline__ float bf_hi(unsigned w) { return __uint_as_float(w & 0xffff0000u); }
__device__ __forceinline__ float bf1(bf16_t h) { return __uint_as_float((unsigned)h << 16); }
__device__ __forceinline__ float wave_sum(float v) {
#pragma unroll
    for (int o = 1; o < 64; o <<= 1) v += __shfl_xor(v, o);
    return v;
}
__device__ __forceinline__ unsigned pk4_fp8(float a, float b, float c, float d) { unsigned w = 0u; w = (unsigned)__builtin_amdgcn_cvt_pk_fp8_f32(a, b, (int)w, false); w = (unsigned)__builtin_amdgcn_cvt_pk_fp8_f32(c, d, (int)w, true); return w; }
constexpr float Q8_SCALE = 4.f, K8_SCALE = 0.25f;
constexpr float W8_SCALE = 32.f, W8_INV = 1.f / 32.f, YS_SCALE = 8.f, YS_INV = 0.125f;
__device__ __forceinline__ float sigmoidf_(float v) { return __builtin_amdgcn_rcpf(1.f + __builtin_amdgcn_exp2f(v * -1.4426950408889634f)); }

namespace pg8 {
#define PG8_LAS __attribute__((address_space(3)))
constexpr int BM = 256, BK = 64, HALF = 128, HTB = HALF * BK * 2  , STAGE_BYTES = 8 * HTB, NXCD = 8, WGM = 4;

__host__ __device__ __forceinline__ int lds_byte(int r, int c) { const int st = (r >> 4) * 2 + (c >> 5), rr = r & 15, cc = c & 31, ob = rr * 64 + cc * 2; return st * 1024 + (ob ^ (((ob >> 9) & 1) << 5)); }
__host__ __device__ __forceinline__ void stage_rc(int b, int& R, int& C) { const int st = b / 1024, sb = b % 1024, swz = sb ^ (((sb >> 9) & 1) << 5); R = (st >> 1) * 16 + swz / 64; C = (st & 1) * 32 + (swz % 64) / 2; }
__host__ __device__ __forceinline__ int perm32(int rho) { const int n = rho >> 4, i = rho & 15; return 8 * (i >> 2) + 4 * n + (i & 3); }

struct Unit { int pm, pn, e, rb, li; };
struct Gemm { const bf16_t* A; const bf16_t* Bt; int M, N, K; size_t bstride; int lda, ldb; };

struct StaticOrder {
    int nM, nN, nwg, G, c;
    __host__ __device__ void init(int M, int N, int G_, int c_) { nM = M / BM; nN = N / BM; nwg = nM * nN; G = G_; c = c_; }
    __host__ __device__ bool next(int i, Unit& u) const {
        const long L = (long)i * G + c; if (L >= nwg) return false;
        int wgid = (int)L; { const int q = nwg / NXCD, r = nwg % NXCD, xcd = wgid % NXCD, off = wgid / NXCD; wgid = (xcd < r ? xcd * (q + 1) : r * (q + 1) + (xcd - r) * q) + off; }
        const int nig = WGM * nN, gid = wgid / nig, fm = gid * WGM, gsz = (nM - fm) < WGM ? (nM - fm) : WGM;
        u.pm = fm + ((wgid % nig) % gsz); u.pn = (wgid % nig) / gsz; u.e = 0; u.rb = 0; u.li = i; return true;
    }
    __device__ __forceinline__ void a_ready(const Unit&) const {}
    __device__ __forceinline__ void done(const Unit&) const {}
};


struct EpiProj {
    static constexpr bool PERM = true, AFTER_DRAIN = false;
    bf16_t* O; float* ssq;
    __device__ __forceinline__ void operator()(const f32x4 (&acc)[2][2][4][2], const Unit& u, int wr, int wc, int fr, int fq) const {
        const int row0 = u.pm * BM + wr * 64 + fr, col0 = u.pn * BM + wc * 32 + 8 * fq;
#pragma unroll
        for (int ai = 0; ai < 2; ++ai)
#pragma unroll
            for (int m = 0; m < 4; ++m) { const int row = row0 + ai * HALF + m * 16; bf16_t* rowp = O + (size_t)row * INCP + col0;
#pragma unroll
                for (int bj = 0; bj < 2; ++bj) { f32x4 v0 = acc[ai][bj][m][0], v1 = acc[ai][bj][m][1]; const int col = col0 + bj * HALF;
                    if (col >= OFF_GA && col < INC) {
#pragma unroll
                        for (int j = 0; j < 4; ++j) { v0[j] = sigmoidf_(v0[j]); v1[j] = sigmoidf_(v1[j]); } }
                    u32x4 w; w.x = pk2(v0[0], v0[1]); w.y = pk2(v0[2], v0[3]); w.z = pk2(v1[0], v1[1]); w.w = pk2(v1[2], v1[3]);
                    *(u32x4*)(rowp + bj * HALF) = w;
                    const int which = u.pn == 0 ? 0 : (u.pn == 1 ? (bj == 0 ? 1 : (wc == 0 ? 2 : -1)) : -1);
                    if (which >= 0) { float s = (v0[0] * v0[0] + v0[1] * v0[1]) + (v0[2] * v0[2] + v0[3] * v0[3]) + (v1[0] * v1[0] + v1[1] * v1[1]) + (v1[2] * v1[2] + v1[3] * v1[3]);
                        s += __shfl_xor(s, 16); s += __shfl_xor(s, 32); if (fq == 0) ssq[(size_t)row * 16 + (which == 0 ? wc * 2 + bj : (which == 1 ? 8 + wc : 12))] = s; } } }
    }
};
struct EpiBf16 {
    static constexpr bool PERM = true, AFTER_DRAIN = false;
    bf16_t* O; int ldc;
    __device__ __forceinline__ void operator()(const f32x4 (&acc)[2][2][4][2], const Unit& u, int wr, int wc, int fr, int fq) const {
        const int row0 = u.pm * BM + wr * 64 + fr, col0 = u.pn * BM + wc * 32 + 8 * fq;
#pragma unroll
        for (int ai = 0; ai < 2; ++ai)
#pragma unroll
            for (int m = 0; m < 4; ++m) { bf16_t* rowp = O + (size_t)(row0 + ai * HALF + m * 16) * ldc + col0;
#pragma unroll
                for (int bj = 0; bj < 2; ++bj) { const f32x4 v0 = acc[ai][bj][m][0], v1 = acc[ai][bj][m][1];
                    u32x4 w; w.x = pk2(v0[0], v0[1]); w.y = pk2(v0[2], v0[3]); w.z = pk2(v1[0], v1[1]); w.w = pk2(v1[2], v1[3]); *(u32x4*)(rowp + bj * HALF) = w; } }
    }
};
__device__ __forceinline__ void epi_bar() { asm volatile("s_waitcnt lgkmcnt(0)" ::: "memory"); __builtin_amdgcn_s_barrier(); asm volatile("" ::: "memory"); }
__device__ __forceinline__ u32x2 pk4bf(const f32x4 v) { u32x2 w; w.x = pk2(v[0], v[1]); w.y = pk2(v[2], v[3]); return w; }
struct EpiQ {
    static constexpr bool PERM = false, AFTER_DRAIN = true;
    unsigned char* Q; const float* ssq_cq; const float* qg; const float* cs; float* hs;
    __device__ __forceinline__ void operator()(f32x4 (&)[2][2][4][2], const Unit&, int, int, int, int) const {}
    __device__ __forceinline__ void fused(f32x4 (&acc)[2][2][4][2], const Unit& u, int wr, int wc, int fr, int fq, PG8_LAS unsigned char* lds, int wid, int lane) const {
        typedef __attribute__((address_space(3))) unsigned* lds_u32p;
        const int tb = u.pm * BM;
#pragma unroll
        for (int q = 0; q < 4; ++q) { const int pc = wid + 8 * q;
            __builtin_amdgcn_global_load_lds((const unsigned*)(cs + (size_t)(tb + 8 * pc + (lane >> 3)) * 32 + (lane & 7) * 4), (lds_u32p)(lds + pc * 1024 + lane * 16), 16, 0, 0); }
        PG8_LAS float* rqT = (PG8_LAS float*)(lds + 32768);
        { const int tid = wid * 64 + lane; if (tid < 256) { const f32x4 sa = *(const f32x4*)(ssq_cq + (size_t)(tb + tid) * 16), sb = *(const f32x4*)(ssq_cq + (size_t)(tb + tid) * 16 + 4);
            rqT[tid] = rsqrtf((((sa[0] + sa[1]) + (sa[2] + sa[3])) + ((sb[0] + sb[1]) + (sb[2] + sb[3]))) * (1.f / QLORA) + EPS); } }
        asm volatile("s_waitcnt vmcnt(0) lgkmcnt(0)" ::: "memory"); __builtin_amdgcn_s_barrier(); asm volatile("" ::: "memory");
        const PG8_LAS float* csT = (const PG8_LAS float*)lds;
        int lr0 = wr * 64 + fr; asm volatile("" : "+v"(lr0), "+v"(fq));
#pragma unroll
        for (int ai = 0; ai < 2; ++ai)
#pragma unroll
            for (int m = 0; m < 4; ++m) { const float rq = rqT[lr0 + ai * HALF + m * 16];
#pragma unroll
                for (int bj = 0; bj < 2; ++bj) { const f32x4 x0 = acc[ai][bj][m][0] * rq, x1 = acc[ai][bj][m][1] * rq; acc[ai][bj][m][0] = x0; acc[ai][bj][m][1] = x1;
                    float s = (x0[0] * x0[0] + x0[1] * x0[1]) + (x0[2] * x0[2] + x0[3] * x0[3]) + (x1[0] * x1[0] + x1[1] * x1[1]) + (x1[2] * x1[2] + x1[3] * x1[3]);
                    s += __shfl_xor(s, 16); s += __shfl_xor(s, 32); if (fq == 0) hs[((lr0 + ai * HALF + m * 16) * 2 + bj) * 4 + wc] = s; } }
        epi_bar();
        {
            f32x4 g0 = {0.f, 0.f, 0.f, 0.f}, g1 = g0; if (wc < 3) { g0 = *(const f32x4*)(qg + 32 * wc + 4 * fq); g1 = *(const f32x4*)(qg + 32 * wc + 16 + 4 * fq); }
#pragma unroll
            for (int ai = 0; ai < 2; ++ai)
#pragma unroll
                for (int m = 0; m < 4; ++m) { const int lr = lr0 + ai * HALF + m * 16, t = u.pm * BM + lr, b = t >> 13, s = t & (SEQ - 1);
                    f32x4 c4 = {0.f, 0.f, 0.f, 0.f}, s4 = {0.f, 0.f, 0.f, 0.f}; if (wc == 2) { c4 = *(const PG8_LAS f32x4*)(csT + lr * 32 + 4 * fq); s4 = *(const PG8_LAS f32x4*)(csT + lr * 32 + 16 + 4 * fq); }
#pragma unroll
                    for (int bj = 0; bj < 2; ++bj) { const f32x4 h4 = *(const f32x4*)(hs + (lr * 2 + bj) * 4); const float rstd = rsqrtf(((h4[0] + h4[1]) + h4[2]) * (1.f / DQK) + EPS) * (QSCALE * Q8_SCALE); f32x4 x0 = acc[ai][bj][m][0] * rstd * g0, x1 = acc[ai][bj][m][1] * rstd * g1;
                        if (wc == 2) { const f32x4 o0 = x0 * c4 - x1 * s4, o1 = x0 * s4 + x1 * c4; x0 = o0; x1 = o1; }
                        if (wc == 3 && fq == 0) x0[0] = Q8_SCALE;
                        unsigned char* qp = Q + ((size_t)(b * NH + 2 * u.pn + bj) * SEQ + s) * 128 + 32 * wc + 4 * fq; *(unsigned*)qp = pk4_fp8(x0[0], x0[1], x0[2], x0[3]); *(unsigned*)(qp + 16) = pk4_fp8(x1[0], x1[1], x1[2], x1[3]); }
                    asm volatile("" ::: "memory"); }
        }
        epi_bar();
    }
};
struct EpiK {
    static constexpr bool PERM = false, AFTER_DRAIN = true;
    unsigned char* K; const float* ssq; const float* kg; const float* cs; const bf16_t* proj; float* hs; const float* shiftp;
    __device__ __forceinline__ void operator()(f32x4 (&)[2][2][4][2], const Unit&, int, int, int, int) const {}
    __device__ __forceinline__ void fused(f32x4 (&acc)[2][2][4][2], const Unit& u, int wr, int wc, int fr, int fq, PG8_LAS unsigned char* lds, int wid, int lane) const {
        typedef __attribute__((address_space(3))) unsigned* lds_u32p;
        const int tb = u.pm * BM;
#pragma unroll
        for (int q = 0; q < 4; ++q) { const int pc = wid + 8 * q;
            __builtin_amdgcn_global_load_lds((const unsigned*)(cs + (size_t)(tb + 8 * pc + (lane >> 3)) * 32 + (lane & 7) * 4), (lds_u32p)(lds + pc * 1024 + lane * 16), 16, 0, 0); }
#pragma unroll
        for (int q = 0; q < 2; ++q) { const int pc = wid + 8 * q;
            __builtin_amdgcn_global_load_lds((const unsigned*)(proj + (size_t)(tb + 16 * pc + (lane >> 2)) * INCP + OFF_KR + (lane & 3) * 8), (lds_u32p)(lds + 32768 + pc * 1024 + lane * 16), 16, 0, 0); }
        PG8_LAS float* rkT = (PG8_LAS float*)(lds + 49152); PG8_LAS float* skrT = (PG8_LAS float*)(lds + 50176);
        { const int tid = wid * 64 + lane; if (tid < 256) { const f32x4 sa = *(const f32x4*)(ssq + (size_t)(tb + tid) * 16 + 8); const float s12 = ssq[(size_t)(tb + tid) * 16 + 12];
            rkT[tid] = rsqrtf(((sa[0] + sa[1]) + (sa[2] + sa[3])) * (1.f / KVLORA) + EPS); skrT[tid] = s12; } }
        asm volatile("s_waitcnt vmcnt(0) lgkmcnt(0)" ::: "memory"); __builtin_amdgcn_s_barrier(); asm volatile("" ::: "memory");
        const PG8_LAS float* csT = (const PG8_LAS float*)lds; const PG8_LAS bf16_t* krT = (const PG8_LAS bf16_t*)(lds + 32768);
        int lr0 = wr * 64 + fr; asm volatile("" : "+v"(lr0), "+v"(fq));
        const int wp = wc & 1, wh = wc >> 1;
#pragma unroll
        for (int ai = 0; ai < 2; ++ai)
#pragma unroll
            for (int m = 0; m < 4; ++m) { const float rk = rkT[lr0 + ai * HALF + m * 16];
#pragma unroll
                for (int bj = 0; bj < 2; ++bj) { const f32x4 x0 = acc[ai][bj][m][0] * rk, x1 = acc[ai][bj][m][1] * rk; acc[ai][bj][m][0] = x0; acc[ai][bj][m][1] = x1;
                    float s = (x0[0] * x0[0] + x0[1] * x0[1]) + (x0[2] * x0[2] + x0[3] * x0[3]) + (x1[0] * x1[0] + x1[1] * x1[1]) + (x1[2] * x1[2] + x1[3] * x1[3]);
                    s += __shfl_xor(s, 16); s += __shfl_xor(s, 32); if (fq == 0) hs[((lr0 + ai * HALF + m * 16) * 4 + 2 * bj + wh) * 2 + wp] = s; } }
        epi_bar();
        const f32x4 g0 = *(const f32x4*)(kg + 32 * wp + 4 * fq), g1 = *(const f32x4*)(kg + 32 * wp + 16 + 4 * fq);
        f32x4 gr0 = {0.f, 0.f, 0.f, 0.f}, gr1 = gr0; if (wp == 1) { gr0 = *(const f32x4*)(kg + 64 + 4 * fq); gr1 = *(const f32x4*)(kg + 80 + 4 * fq); }
        const unsigned kpad = (fq == 0) ? pk4_fp8(-shiftp[0] * K8_SCALE, 0.f, 0.f, 0.f) : 0u;
#pragma unroll
        for (int ai = 0; ai < 2; ++ai)
#pragma unroll
            for (int m = 0; m < 4; ++m) { const int lr = lr0 + ai * HALF + m * 16, t = u.pm * BM + lr, b = t >> 13, s = t & (SEQ - 1); const float skr = skrT[lr];
                f32x4 c4 = {0.f, 0.f, 0.f, 0.f}, s4 = c4, r1 = c4, r2 = c4;
                if (wp == 1) { c4 = *(const PG8_LAS f32x4*)(csT + lr * 32 + 4 * fq); s4 = *(const PG8_LAS f32x4*)(csT + lr * 32 + 16 + 4 * fq);
                    const u32x2 a = *(const PG8_LAS u32x2*)(krT + lr * 32 + 4 * fq), bb = *(const PG8_LAS u32x2*)(krT + lr * 32 + 16 + 4 * fq);
                    r1 = (f32x4){bf_lo(a.x), bf_hi(a.x), bf_lo(a.y), bf_hi(a.y)} * gr0; r2 = (f32x4){bf_lo(bb.x), bf_hi(bb.x), bf_lo(bb.y), bf_hi(bb.y)} * gr1; }
#pragma unroll
                for (int bj = 0; bj < 2; ++bj) { const size_t rowi = (size_t)(b * NH + 4 * u.pn + 2 * bj + wh) * SEQ + s; const f32x2 h2 = *(const f32x2*)(hs + (lr * 4 + 2 * bj + wh) * 2);
                    const float rstd = rsqrtf(((h2[0] + h2[1]) + skr) * (1.f / DQK) + EPS) * K8_SCALE;
                    unsigned char* kp = K + rowi * 128; const f32x4 y0 = acc[ai][bj][m][0] * rstd * g0, y1 = acc[ai][bj][m][1] * rstd * g1;
                    *(unsigned*)(kp + 32 * wp + 4 * fq) = pk4_fp8(y0[0], y0[1], y0[2], y0[3]); *(unsigned*)(kp + 32 * wp + 16 + 4 * fq) = pk4_fp8(y1[0], y1[1], y1[2], y1[3]);
                    if (wp == 1) { const f32x4 x1 = r1 * rstd, x2 = r2 * rstd, z1 = x1 * c4 - x2 * s4, z2 = x1 * s4 + x2 * c4; *(unsigned*)(kp + 64 + 4 * fq) = pk4_fp8(z1[0], z1[1], z1[2], z1[3]); *(unsigned*)(kp + 80 + 4 * fq) = pk4_fp8(z2[0], z2[1], z2[2], z2[3]); }
                    else { *(u32x2*)(kp + 96 + 8 * fq) = (u32x2){kpad, 0u}; } }
                asm volatile("" ::: "memory"); }
        epi_bar();
    }
};
struct EpiVT {
    static constexpr bool PERM = true, AFTER_DRAIN = false;
    unsigned char* VT; const float* ssq;
    __device__ __forceinline__ void operator()(f32x4 (&acc)[2][2][4][2], const Unit& u, int wr, int wc, int fr, int fq) const {
        int tok0 = u.pn * BM + wc * 32 + 8 * fq; asm volatile("" : "+v"(tok0), "+v"(fr));
        float rs[2][8];
#pragma unroll
        for (int bj = 0; bj < 2; ++bj)
#pragma unroll
            for (int i = 0; i < 8; ++i) { const f32x4 sa = *(const f32x4*)(ssq + (size_t)(tok0 + bj * HALF + i) * 16 + 8); rs[bj][i] = rsqrtf(((sa[0] + sa[1]) + (sa[2] + sa[3])) * (1.f / KVLORA) + EPS); }
#pragma unroll
        for (int ai = 0; ai < 2; ++ai)
#pragma unroll
            for (int m = 0; m < 4; ++m) { const int row = u.pm * BM + ai * HALF + wr * 64 + m * 16 + fr, h = row >> 6, d = row & 63;
#pragma unroll
                for (int bj = 0; bj < 2; ++bj) { const int tok = tok0 + bj * HALF, b = tok >> 13, s = tok & (SEQ - 1); const f32x4 v0 = acc[ai][bj][m][0], v1 = acc[ai][bj][m][1];
                    const int k0 = s & 63, j0 = 4 * ((k0 >> 3) & 3) + 16 * (k0 >> 5), r32v = d & 31, off = (j0 & 15) + 16 * ((j0 >> 4) ^ ((r32v >> 3) & 1));
                    unsigned char* tp = VT + ((size_t)(b * NH + h) * (SEQ / 64) + (s >> 6)) * 4096 + (((d >> 5) * 32 + r32v) << 5) + off;
                    *(unsigned*)tp = pk4_fp8(v0[0] * rs[bj][0], v0[1] * rs[bj][1], v0[2] * rs[bj][2], v0[3] * rs[bj][3]);
                    *(unsigned*)(tp + 2048) = pk4_fp8(v1[0] * rs[bj][4], v1[1] * rs[bj][5], v1[2] * rs[bj][6], v1[3] * rs[bj][7]); } }
    }
};
struct EpiF32 {
    static constexpr bool PERM = false, AFTER_DRAIN = false;
    float* O; int ldc;
    __device__ __forceinline__ void operator()(const f32x4 (&acc)[2][2][4][2], const Unit& u, int wr, int wc, int fr, int fq) const {
        const int row0 = u.pm * BM + wr * 64 + fr, col0 = u.pn * BM + wc * 32 + 4 * fq;
#pragma unroll
        for (int ai = 0; ai < 2; ++ai)
#pragma unroll
            for (int m = 0; m < 4; ++m) { float* rowp = O + (size_t)(row0 + ai * HALF + m * 16) * ldc + col0;
#pragma unroll
                for (int bj = 0; bj < 2; ++bj)
#pragma unroll
                    for (int n = 0; n < 2; ++n) *(f32x4*)(rowp + bj * HALF + n * 16) = acc[ai][bj][m][n]; }
    }
};
__device__ __forceinline__ void unpack8(const u32x4 g, float (&f)[8]) { f[0] = bf_lo(g.x); f[1] = bf_hi(g.x); f[2] = bf_lo(g.y); f[3] = bf_hi(g.y); f[4] = bf_lo(g.z); f[5] = bf_hi(g.z); f[6] = bf_lo(g.w); f[7] = bf_hi(g.w); }
struct EpiGateA {
    static constexpr bool PERM = true, AFTER_DRAIN = false;
    bf16_t* M1; const bf16_t* proj;
    __device__ __forceinline__ void operator()(const f32x4 (&acc)[2][2][4][2], const Unit& u, int wr, int wc, int fr, int fq) const {
        const int row0 = u.pm * BM + wr * 64 + fr, col0 = u.pn * BM + wc * 32 + 8 * fq;
#pragma unroll
        for (int ai = 0; ai < 2; ++ai)
#pragma unroll
            for (int m = 0; m < 4; ++m) { const size_t row = (size_t)(row0 + ai * HALF + m * 16);
#pragma unroll
                for (int bj = 0; bj < 2; ++bj) { const int col = col0 + bj * HALF; float g[8]; unpack8(*(const u32x4*)(proj + row * INCP + OFF_GA + col), g);
                    const f32x4 v0 = acc[ai][bj][m][0], v1 = acc[ai][bj][m][1];
                    u32x4 w; w.x = pk2(v0[0] * g[0], v0[1] * g[1]); w.y = pk2(v0[2] * g[2], v0[3] * g[3]); w.z = pk2(v1[0] * g[4], v1[1] * g[5]); w.w = pk2(v1[2] * g[6], v1[3] * g[7]);
                    *(u32x4*)(M1 + row * DM + col) = w; } }
    }
};
struct EpiGateB {
    static constexpr bool PERM = true, AFTER_DRAIN = false;
    const bf16_t* M1; const bf16_t* proj; bf16_t* O;
    __device__ __forceinline__ void operator()(const f32x4 (&acc)[2][2][4][2], const Unit& u, int wr, int wc, int fr, int fq) const {
        const int row0 = u.pm * BM + wr * 64 + fr, col0 = u.pn * BM + wc * 32 + 8 * fq;
#pragma unroll
        for (int ai = 0; ai < 2; ++ai)
#pragma unroll
            for (int m = 0; m < 4; ++m) { const size_t row = (size_t)(row0 + ai * HALF + m * 16);
#pragma unroll
                for (int bj = 0; bj < 2; ++bj) { const int col = col0 + bj * HALF; float g[8], b[8]; unpack8(*(const u32x4*)(proj + row * INCP + OFF_GB + col), g); unpack8(*(const u32x4*)(M1 + row * DM + col), b);
                    const f32x4 v0 = acc[ai][bj][m][0], v1 = acc[ai][bj][m][1];
                    u32x4 w; w.x = pk2(b[0] + v0[0] * g[0], b[1] + v0[1] * g[1]); w.y = pk2(b[2] + v0[2] * g[2], b[3] + v0[3] * g[3]);
                    w.z = pk2(b[4] + v1[0] * g[4], b[5] + v1[1] * g[5]); w.w = pk2(b[6] + v1[2] * g[6], b[7] + v1[3] * g[7]);
                    *(u32x4*)(O + row * DM + col) = w; } }
    }
};
struct EpiResid {
    static constexpr bool PERM = false, AFTER_DRAIN = false;
    const float* X; bf16_t* O;
    __device__ __forceinline__ void operator()(const f32x4 (&acc)[2][2][4][2], const Unit& u, int wr, int wc, int fr, int fq) const {
        const int row0 = u.pm * BM + wr * 64 + fr, col0 = u.pn * BM + wc * 32 + 4 * fq;
#pragma unroll
        for (int ai = 0; ai < 2; ++ai)
#pragma unroll
            for (int m = 0; m < 4; ++m) { const size_t off = (size_t)(row0 + ai * HALF + m * 16) * DM + col0;
#pragma unroll
                for (int bj = 0; bj < 2; ++bj)
#pragma unroll
                    for (int n = 0; n < 2; ++n) { const f32x4 b = *(const f32x4*)(X + off + bj * HALF + n * 16) + acc[ai][bj][m][n]; u32x2 w; w.x = pk2(b[0], b[1]); w.y = pk2(b[2], b[3]); *(u32x2*)(O + off + bj * HALF + n * 16) = w; } }
    }
};
struct EpiSwiglu {
    static constexpr bool PERM = true, AFTER_DRAIN = false;
    unsigned char* ACT; const PG8_LAS unsigned short* btab; const PG8_LAS int* gtab;
    __device__ __forceinline__ void operator()(const f32x4 (&acc)[2][2][4][2], const Unit& u, int wr, int wc, int fr, int fq) const {
        const int row0 = u.pm * BM + wr * 64 + fr, f0 = u.pn * HALF + wc * 32 + 8 * fq;
        const u32x4 bgp = *(const PG8_LAS u32x4*)(btab + u.li * 256 + wc * 32 + 8 * fq), bup = *(const PG8_LAS u32x4*)(btab + u.li * 256 + HALF + wc * 32 + 8 * fq);
        const f32x4 bg0 = {bf_lo(bgp.x), bf_hi(bgp.x), bf_lo(bgp.y), bf_hi(bgp.y)}, bg1 = {bf_lo(bgp.z), bf_hi(bgp.z), bf_lo(bgp.w), bf_hi(bgp.w)}, bu0 = {bf_lo(bup.x), bf_hi(bup.x), bf_lo(bup.y), bf_hi(bup.y)}, bu1 = {bf_lo(bup.z), bf_hi(bup.z), bf_lo(bup.w), bf_hi(bup.w)};
        float rsv[8];
#pragma unroll
        for (int i = 0; i < 8; ++i) rsv[i] = __uint_as_float((unsigned)gtab[u.li * 256 + wr * 64 + fr + (i >> 2) * HALF + (i & 3) * 16] & 0xFFFF0000u) * W8_INV;
#pragma unroll
        for (int ai = 0; ai < 2; ++ai)
#pragma unroll
            for (int m = 0; m < 4; ++m) { const size_t row = (size_t)(row0 + ai * HALF + m * 16); float o[8]; const float rs = rsv[ai * 4 + m];
#pragma unroll
                for (int n = 0; n < 2; ++n) { const f32x4 g4 = acc[ai][0][m][n] * rs + (n ? bg1 : bg0), u4 = acc[ai][1][m][n] * rs + (n ? bu1 : bu0);
#pragma unroll
                    for (int j = 0; j < 4; ++j) { const float g = fminf(g4[j], 7.f), uu = fminf(fmaxf(u4[j], -7.f), 7.f); o[4 * n + j] = (uu + 1.f) * (g * sigmoidf_(1.702f * g)); } }
                u32x2 w; w.x = pk4_fp8(o[0], o[1], o[2], o[3]); w.y = pk4_fp8(o[4], o[5], o[6], o[7]); *(u32x2*)(ACT + row * DFF + f0) = w; }
    }
};
struct EpiMoeOut {
    static constexpr bool PERM = true, AFTER_DRAIN = false;
    unsigned char* YS; const PG8_LAS unsigned short* btab; const PG8_LAS int* mtab;
    __device__ __forceinline__ void operator()(const f32x4 (&acc)[2][2][4][2], const Unit& u, int wr, int wc, int fr, int fq) const {
        const int col0 = u.pn * BM + wc * 32 + 8 * fq;
        int slot[8]; float w[8];
#pragma unroll
        for (int i = 0; i < 8; ++i) { const int v = mtab[u.li * 256 + wr * 64 + fr + (i >> 2) * HALF + (i & 3) * 16]; slot[i] = (v & 0x1FFFF) - 1; w[i] = (float)((unsigned)v >> 17) * ((1.f / 32767.f) * W8_INV * YS_SCALE); }
        f32x4 bv[2][2];
#pragma unroll
        for (int bj = 0; bj < 2; ++bj)
#pragma unroll
            for (int n = 0; n < 2; ++n) { const u32x2 bp = *(const PG8_LAS u32x2*)(btab + u.li * 256 + wc * 32 + 8 * fq + bj * HALF + 4 * n); bv[bj][n] = (f32x4){bf_lo(bp.x), bf_hi(bp.x), bf_lo(bp.y), bf_hi(bp.y)} * W8_SCALE; }
#pragma unroll
        for (int ai = 0; ai < 2; ++ai)
#pragma unroll
            for (int m = 0; m < 4; ++m) { const int i = ai * 4 + m;
                if (slot[i] >= 0) { unsigned char* rowp = YS + (size_t)slot[i] * DM + col0;
#pragma unroll
                    for (int bj = 0; bj < 2; ++bj) { const f32x4 v0 = (acc[ai][bj][m][0] + bv[bj][0]) * w[i], v1 = (acc[ai][bj][m][1] + bv[bj][1]) * w[i];
                        u32x2 o; o.x = pk4_fp8(v0[0], v0[1], v0[2], v0[3]); o.y = pk4_fp8(v1[0], v1[1], v1[2], v1[3]); *(u32x2*)(rowp + bj * HALF) = o; } } }
    }
};
constexpr int MOE_MAXU = 10;
struct MoeOrder {
    StaticOrder so; const PG8_LAS int* utab; const PG8_LAS int* gtab; const PG8_LAS unsigned short* btab;
    __device__ __forceinline__ bool next(int i, Unit& u) const { if (i >= MOE_MAXU || !so.next(i, u)) return false; const int v = __builtin_amdgcn_readfirstlane(utab[i]); u.e = v & 31; u.rb = (int)((unsigned)v >> 8); return true; }
    __device__ __forceinline__ void a_ready(const Unit&) const {}
    __device__ __forceinline__ void done(const Unit&) const {}
};
typedef int i32x4_t __attribute__((ext_vector_type(4))); typedef int i32x8_t __attribute__((ext_vector_type(8)));
__device__ __forceinline__ i32x8_t cat8(bf16x8 lo, bf16x8 hi) { return __builtin_shufflevector(__builtin_bit_cast(i32x4_t, lo), __builtin_bit_cast(i32x4_t, hi), 0, 1, 2, 3, 4, 5, 6, 7); }
__device__ __forceinline__ void mfma_fp8_inplace(f32x4& c, const i32x8_t a, const i32x8_t b) { asm volatile("s_nop 1\n\tv_mfma_f32_16x16x128_f8f6f4 %0, %1, %2, %0" : "+v"(c) : "v"(a), "v"(b)); }
__device__ __forceinline__ void mfma_fp8_drain() { asm volatile("s_nop 15\n\ts_nop 7" ::: "memory"); __builtin_amdgcn_sched_barrier(0); }
template <class Epi, class Sched, bool ALIGN_EPI = false, bool SP2 = false, bool FP8 = false, bool GATHER = false>
__device__ __forceinline__ void gemm_phase(PG8_LAS unsigned char* lds, const Gemm g, const Sched& S, const Epi& E) {
    int tid = threadIdx.x; asm volatile("" : "+v"(tid));
    const int wid = __builtin_amdgcn_readfirstlane(tid >> 6), lane = tid & 63, wr = wid >> 2, wc = wid & 3, fr = lane & 15, fq = lane >> 4;
    const int K = g.K, nt = K / BK;
    static_assert(!GATHER || SP2, "GATHER is implemented for the SP2 loop only");
    const unsigned rowA = (unsigned)(g.lda ? g.lda : K) * 2u, rowB = (unsigned)(g.ldb ? g.ldb : K) * 2u;
    unsigned voffA[2], voffB[2]; int gR0 = 0; unsigned gC = 0u;
#pragma unroll
    for (int i = 0; i < 2; ++i) { int R, C; stage_rc(tid * 16 + i * 8192, R, C); const int Rb = Epi::PERM ? ((R & ~31) + perm32(R & 31)) : R;
        voffA[i] = (unsigned)R * rowA + (unsigned)C * 2u; voffB[i] = (unsigned)Rb * rowB + (unsigned)C * 2u; if (i == 0) { gR0 = R; gC = (unsigned)C * 2u; } }
    unsigned gA[2][2] = {{0u, 0u}, {0u, 0u}}, ngA[2][2] = {{0u, 0u}, {0u, 0u}};
#define PG8_GLOAD(dst, ui_) do { _Pragma("unroll") for (int h_ = 0; h_ < 2; ++h_) _Pragma("unroll") for (int i_ = 0; i_ < 2; ++i_) \
        dst[h_][i_] = ((unsigned)S.gtab[(ui_) * 256 + 128 * h_ + gR0 + 64 * i_] & 0xFFFFu) * rowA + gC; } while (0)
#define PG8_VA(h) (GATHER ? gA[h] : voffA)
    const unsigned kstep = (unsigned)(BK * 2);
    const unsigned hstep = (unsigned)HALF * rowB;
    const unsigned tstep = 2u * hstep;
    const unsigned hstepA = (unsigned)HALF * rowA, tstepA = 2u * hstepA;
    const unsigned hsA = GATHER ? 0u : hstepA;
    const unsigned ldsw = (unsigned)wid * 1024u;
    const int aoff = lds_byte(wr * 64 + fr, fq * 8), boff = lds_byte(wc * 32 + fr, fq * 8);
#define PG8_SA(b, h) (((b) * 2 + (h)) * HTB)
#define PG8_SB(b, h) ((4 + (b) * 2 + (h)) * HTB)
#define PG8_STAGE(rs, bufoff, goff, voff) do { _Pragma("unroll") for (int _i = 0; _i < 2; ++_i) \
        __builtin_amdgcn_raw_ptr_buffer_load_lds(rs, (PG8_LAS void*)(lds + (bufoff) + ldsw + _i * 8192), 16, (int)(voff)[_i], (int)(goff), 0, 0); } while (0)
#define PG8_LDA(dst, b, h) do { _Pragma("unroll") for (int m = 0; m < 4; ++m) _Pragma("unroll") for (int k = 0; k < 2; ++k) dst[m][k] = *(const PG8_LAS bf16x8*)(lds + PG8_SA(b, h) + aoff + m * 2048 + k * 1024); } while (0)
#define PG8_LDB(dst, b, h) do { _Pragma("unroll") for (int n = 0; n < 2; ++n) _Pragma("unroll") for (int k = 0; k < 2; ++k) dst[n][k] = *(const PG8_LAS bf16x8*)(lds + PG8_SB(b, h) + boff + n * 2048 + k * 1024); } while (0)
#define PG8_MMA(ai, bj, At, Bt) do { __builtin_amdgcn_s_setprio(1); _Pragma("unroll") for (int m = 0; m < 4; ++m) _Pragma("unroll") for (int n = 0; n < 2; ++n) { \
        if constexpr (FP8) { mfma_fp8_inplace(acc[ai][bj][m][n], cat8(Bt[n][0], Bt[n][1]), cat8(At[m][0], At[m][1])); } \
        else { _Pragma("unroll") for (int k = 0; k < 2; ++k) acc[ai][bj][m][n] = __builtin_amdgcn_mfma_f32_16x16x32_bf16(Bt[n][k], At[m][k], acc[ai][bj][m][n], 0, 0, 0); } } \
        __builtin_amdgcn_s_setprio(0); } while (0)
#define PG8_WAIT_V(n) asm volatile("s_waitcnt vmcnt(" #n ")" ::: "memory")
#define PG8_WAIT_L(n) asm volatile("s_waitcnt lgkmcnt(" #n ")" ::: "memory")
#define PG8_BAR __builtin_amdgcn_s_barrier()
#define PG8_SCHED __builtin_amdgcn_sched_barrier(0)
    Unit cur, nxt; int ui = 0;
    if (!S.next(0, cur)) return;
    f32x4 acc[2][2][4][2];
#pragma unroll
    for (int a = 0; a < 2; ++a)
#pragma unroll
        for (int b = 0; b < 2; ++b)
#pragma unroll
            for (int m = 0; m < 4; ++m)
#pragma unroll
                for (int n = 0; n < 2; ++n) acc[a][b][m][n] = (f32x4){0.f, 0.f, 0.f, 0.f};
    bf16x8 At[4][2], B0[2][2], B1[2][2];
    unsigned cA = GATHER ? 0u : (unsigned)cur.pm * tstepA, cB = (unsigned)cur.e * (unsigned)g.bstride + (unsigned)cur.pn * tstep;
    const __amdgpu_buffer_rsrc_t rsA = __builtin_amdgcn_make_buffer_rsrc((void*)g.A, 0, 0x7fffffff, 0x00020000), rsB = __builtin_amdgcn_make_buffer_rsrc((void*)g.Bt, 0, 0x7fffffff, 0x00020000);
    S.a_ready(cur);
    if constexpr (GATHER) PG8_GLOAD(gA, 0);
    if constexpr (SP2) {
        PG8_STAGE(rsB, PG8_SB(0, 0), cB, voffB); PG8_STAGE(rsB, PG8_SB(0, 1), cB + hstep, voffB); PG8_STAGE(rsA, PG8_SA(0, 0), cA, PG8_VA(0)); PG8_STAGE(rsA, PG8_SA(0, 1), cA + hsA, PG8_VA(1));
        if (wr == 1) PG8_BAR;
        PG8_WAIT_V(2); PG8_BAR;
        PG8_STAGE(rsB, PG8_SB(1, 0), cB + kstep, voffB); PG8_STAGE(rsA, PG8_SA(1, 0), cA + kstep, PG8_VA(0)); PG8_STAGE(rsB, PG8_SB(1, 1), cB + hstep + kstep, voffB);
        PG8_WAIT_V(6); PG8_BAR;
    } else {
        PG8_STAGE(rsB, PG8_SB(0, 0), cB, voffB); PG8_STAGE(rsA, PG8_SA(0, 0), cA, PG8_VA(0)); PG8_STAGE(rsB, PG8_SB(0, 1), cB + hstep, voffB); PG8_STAGE(rsA, PG8_SA(0, 1), cA + hsA, PG8_VA(1));
        if (wr == 1) PG8_BAR;
        PG8_WAIT_V(4); PG8_BAR;
        PG8_STAGE(rsB, PG8_SB(1, 0), cB + kstep, voffB); PG8_STAGE(rsA, PG8_SA(1, 0), cA + kstep, PG8_VA(0)); PG8_STAGE(rsB, PG8_SB(1, 1), cB + hstep + kstep, voffB);
        PG8_WAIT_V(6); PG8_BAR;
    }
    for (;;) {
        const bool has_next = S.next(ui + 1, nxt);
        if constexpr (GATHER) { if (has_next) PG8_GLOAD(ngA, ui + 1); else { ngA[0][0] = gA[0][0]; ngA[0][1] = gA[0][1]; ngA[1][0] = gA[1][0]; ngA[1][1] = gA[1][1]; } }
        const unsigned nA = (has_next && !GATHER) ? (unsigned)nxt.pm * tstepA : cA, nB = has_next ? (unsigned)nxt.e * (unsigned)g.bstride + (unsigned)nxt.pn * tstep : cB;
        for (int t = 0; t < nt; t += 2) {
            const bool last = (t == nt - 2);
            const unsigned a1 = cA + (unsigned)(t + 1) * kstep;
            const unsigned a2 = last ? nA : cA + (unsigned)(t + 2) * kstep, b2 = last ? nB : cB + (unsigned)(t + 2) * kstep;
            const unsigned a3 = a2 + kstep, b3 = b2 + kstep;
            if (last && has_next) S.a_ready(nxt);
            if constexpr (SP2) {
            PG8_LDB(B0, 0, 0); PG8_LDB(B1, 0, 1); PG8_SCHED; PG8_LDA(At, 0, 0); PG8_STAGE(rsA, PG8_SA(1, 1), a1 + hsA, PG8_VA(1));
            if constexpr (GATHER) { if (last) { gA[0][0] = ngA[0][0]; gA[0][1] = ngA[0][1]; gA[1][0] = ngA[1][0]; gA[1][1] = ngA[1][1]; } }
            PG8_WAIT_V(8); PG8_WAIT_L(0); PG8_BAR; PG8_MMA(0, 0, At, B0); PG8_MMA(0, 1, At, B1); PG8_BAR; PG8_SCHED;
            PG8_LDA(At, 0, 1); PG8_STAGE(rsB, PG8_SB(0, 0), b2, voffB); PG8_STAGE(rsB, PG8_SB(0, 1), b2 + hstep, voffB); PG8_STAGE(rsA, PG8_SA(0, 0), a2, PG8_VA(0));
            PG8_WAIT_V(8); PG8_WAIT_L(0); PG8_BAR; PG8_MMA(1, 0, At, B0); PG8_MMA(1, 1, At, B1); PG8_BAR; PG8_SCHED;
            PG8_LDB(B0, 1, 0); PG8_LDB(B1, 1, 1); PG8_SCHED; PG8_LDA(At, 1, 0); PG8_STAGE(rsA, PG8_SA(0, 1), a2 + hsA, PG8_VA(1));
            PG8_WAIT_V(8); PG8_WAIT_L(0); PG8_BAR; PG8_MMA(0, 0, At, B0); PG8_MMA(0, 1, At, B1); PG8_BAR; PG8_SCHED;
            PG8_LDA(At, 1, 1); PG8_STAGE(rsB, PG8_SB(1, 0), b3, voffB); PG8_STAGE(rsB, PG8_SB(1, 1), b3 + hstep, voffB); PG8_STAGE(rsA, PG8_SA(1, 0), a3, PG8_VA(0));
            PG8_WAIT_V(8); PG8_WAIT_L(0); PG8_BAR; PG8_MMA(1, 0, At, B0); PG8_MMA(1, 1, At, B1); PG8_BAR; PG8_SCHED;
            } else {
            PG8_LDB(B0, 0, 0); PG8_SCHED; PG8_LDA(At, 0, 0); PG8_STAGE(rsA, PG8_SA(1, 1), a1 + hsA, PG8_VA(1));
            PG8_WAIT_L(8); PG8_BAR; PG8_WAIT_L(0); PG8_MMA(0, 0, At, B0); PG8_BAR; PG8_SCHED;
            PG8_LDB(B1, 0, 1); PG8_STAGE(rsB, PG8_SB(0, 0), b2, voffB);
            PG8_BAR; PG8_WAIT_L(0); PG8_MMA(0, 1, At, B1); PG8_BAR;
            PG8_LDA(At, 0, 1); PG8_STAGE(rsA, PG8_SA(0, 0), a2, PG8_VA(0));
            PG8_BAR; PG8_WAIT_L(0); PG8_MMA(1, 0, At, B0); PG8_BAR; PG8_SCHED;
            PG8_STAGE(rsB, PG8_SB(0, 1), b2 + hstep, voffB);
            PG8_WAIT_V(6); PG8_BAR; PG8_MMA(1, 1, At, B1); PG8_BAR;
            PG8_LDB(B0, 1, 0); PG8_SCHED; PG8_LDA(At, 1, 0); PG8_STAGE(rsA, PG8_SA(0, 1), a2 + hsA, PG8_VA(1));
            PG8_WAIT_L(8); PG8_BAR; PG8_WAIT_L(0); PG8_MMA(0, 0, At, B0); PG8_BAR; PG8_SCHED;
            PG8_LDB(B1, 1, 1); PG8_STAGE(rsB, PG8_SB(1, 0), b3, voffB);
            PG8_BAR; PG8_WAIT_L(0); PG8_MMA(0, 1, At, B1); PG8_BAR;
            PG8_LDA(At, 1, 1); PG8_STAGE(rsA, PG8_SA(1, 0), a3, PG8_VA(0));
            PG8_BAR; PG8_WAIT_L(0); PG8_MMA(1, 0, At, B0); PG8_BAR; PG8_SCHED;
            PG8_STAGE(rsB, PG8_SB(1, 1), b3 + hstep, voffB);
            PG8_WAIT_V(6); PG8_BAR; PG8_MMA(1, 1, At, B1); PG8_BAR;
            }
        }
        if constexpr (ALIGN_EPI) { if (wr == 0) PG8_BAR; }
        if constexpr (FP8) mfma_fp8_drain();
        if constexpr (!Epi::AFTER_DRAIN) { E(acc, cur, wr, wc, fr, fq); S.done(cur); }
        if (!has_next) break;
#pragma unroll
        for (int a = 0; a < 2; ++a)
#pragma unroll
            for (int b = 0; b < 2; ++b)
#pragma unroll
                for (int m = 0; m < 4; ++m)
#pragma unroll
                    for (int n = 0; n < 2; ++n) acc[a][b][m][n] = (f32x4){0.f, 0.f, 0.f, 0.f};
        cur = nxt; cA = nA; cB = nB; ++ui;
        if constexpr (ALIGN_EPI) { if (wr == 1) PG8_BAR; }
    }
    PG8_WAIT_V(0);
    if constexpr (!ALIGN_EPI) { if (wr == 0) PG8_BAR; }
    PG8_BAR;
    if constexpr (Epi::AFTER_DRAIN) { E.fused(acc, cur, wr, wc, fr, fq, lds, wid, lane); S.done(cur); }
#undef PG8_SA
#undef PG8_GLOAD
#undef PG8_VA
#undef PG8_SB
#undef PG8_STAGE
#undef PG8_LDA
#undef PG8_LDB
#undef PG8_MMA
#undef PG8_WAIT_V
#undef PG8_WAIT_L
#undef PG8_BAR
#undef PG8_SCHED
}
}

#define GAS __attribute__((address_space(1)))
#define LAS __attribute__((address_space(3)))
#define XB_TMO      128
#define XB_XCNT(j)  (256  + 64 * (j))
#define XB_XSUB(j)  (1280 + 64 * (j))
#define XB_XGEN(j)  (2304 + 64 * (j))
#define XB_TOP      3328
#define XB_TOPGEN   3392
#define XCD_BAR_WORDS 3456
#define XB_SPIN_CAP (1u << 18)

__device__ __forceinline__ unsigned xb_ld(unsigned* p)              { return __hip_atomic_load(p, __ATOMIC_RELAXED, __HIP_MEMORY_SCOPE_AGENT); }
__device__ __forceinline__ unsigned xb_add(unsigned* p, unsigned v) { return __hip_atomic_fetch_add(p, v, __ATOMIC_RELAXED, __HIP_MEMORY_SCOPE_AGENT); }
__device__ __forceinline__ unsigned xb_xcc_id() { return (unsigned)__builtin_amdgcn_s_getreg((3 << 11) | 20) & 0xFu; }
#define XB_SPIN(cond, bar) do { unsigned _sp = 0; while (cond) { __builtin_amdgcn_s_sleep(1); \
    if ((++_sp & 255u) == 0u) { if (xb_ld(&(bar)[XB_TMO])) break; if (_sp > XB_SPIN_CAP) { atomicAdd(&(bar)[XB_TMO], 1u); break; } } } } while (0)

struct XcdBarrier {
    unsigned* bar; unsigned x;
    volatile LAS unsigned* st;
};

__device__ __forceinline__ XcdBarrier xcd_barrier_post(unsigned* bar, volatile LAS unsigned* st) {
    XcdBarrier b; b.bar = bar; b.x = xb_xcc_id(); b.st = st;
    if (threadIdx.x == 0) (void)xb_add(&bar[XB_XCNT(b.x)], 1u);
    return b;
}
__device__ __forceinline__ void xcd_barrier_complete(unsigned* bar, unsigned x, unsigned& nloc, unsigned& nx) {
    const unsigned G = gridDim.x * gridDim.y * gridDim.z;
    unsigned sum, cnt, mine, sp = 0u;
    for (;;) {
        sum = 0u; cnt = 0u; mine = 0u;
#pragma unroll
        for (unsigned j = 0; j < 16; ++j) { const unsigned c = xb_ld(&bar[XB_XCNT(j)]); sum += c; cnt += (c > 0u) ? 1u : 0u; mine = (j == x) ? c : mine; }
        if (sum == G) break;
        __builtin_amdgcn_s_sleep(1);
        if ((++sp & 255u) == 0u) { if (xb_ld(&bar[XB_TMO])) break; if (sp > XB_SPIN_CAP) { atomicAdd(&bar[XB_TMO], 1u); break; } }
    }
    nloc = mine > 0u ? mine : 1u; nx = cnt > 0u ? cnt : 1u;
}

__device__ __forceinline__ void xcd_barrier(const XcdBarrier& b) {
    asm volatile("s_waitcnt vmcnt(0)" ::: "memory");
    __syncthreads();
    if (threadIdx.x == 0) {
        unsigned* bar = b.bar;
        __builtin_amdgcn_s_waitcnt(0);
        unsigned nloc = b.st[0], nx = b.st[1];
        if (nloc == 0u) { xcd_barrier_complete(bar, b.x, nloc, nx); b.st[0] = nloc; b.st[1] = nx; }
        const unsigned old = xb_add(&bar[XB_XSUB(b.x)], 1u);
        const unsigned gen = old / nloc;
        if (old + 1u == (gen + 1u) * nloc) {
            __builtin_amdgcn_fence(__ATOMIC_RELEASE, "agent");
            asm volatile("s_waitcnt vmcnt(0)" ::: "memory");
            const unsigned og = xb_add(&bar[XB_TOP], 1u);
            const unsigned tg = og / nx;
            if (og + 1u == (tg + 1u) * nx) xb_add(&bar[XB_TOPGEN], 1u);
            else XB_SPIN(xb_ld(&bar[XB_TOPGEN]) == tg, bar);
            __builtin_amdgcn_fence(__ATOMIC_ACQUIRE, "agent");
            xb_add(&bar[XB_XGEN(b.x)], 1u);
            asm volatile("s_waitcnt vmcnt(0)" ::: "memory");
        } else {
            XB_SPIN(xb_ld(&bar[XB_XGEN(b.x)]) == gen, bar);
            __builtin_amdgcn_fence(__ATOMIC_ACQUIRE, "agent");
            asm volatile("s_waitcnt vmcnt(0)" ::: "memory");
        }
    }
    __syncthreads();
}

template <int MODE  >
__device__ __forceinline__ void transpose_item(const float* __restrict__ W, int K, int N, bf16_t* __restrict__ WT, const float* __restrict__ gain, float* scr, int item, int lane) {
    const int nblk = N / 32, kb = item / nblk, nb = item % nblk, k0 = 64 * kb, n0 = 32 * nb;
#pragma unroll
    for (int i = 0; i < 8; ++i) { const int kk = 8 * i + (lane >> 3), n4 = (lane & 7) * 4; f32x4 v = *(const f32x4*)(W + (size_t)(k0 + kk) * N + n0 + n4);
        if (gain) { const float g = gain[k0 + kk]; v = v * g; }
        float* s = scr + kk * 33 + n4; s[0] = v[0]; s[1] = v[1]; s[2] = v[2]; s[3] = v[3]; }
    asm volatile("s_waitcnt lgkmcnt(0)" ::: "memory");
    const int c = lane & 7;
#pragma unroll
    for (int j = 0; j < 4; ++j) { const int n = (lane >> 3) + 8 * j; const float* s = scr + (8 * c) * 33 + n;
        u32x4 o; o.x = pk2(s[0 * 33], s[1 * 33]); o.y = pk2(s[2 * 33], s[3 * 33]); o.z = pk2(s[4 * 33], s[5 * 33]); o.w = pk2(s[6 * 33], s[7 * 33]);
        int row = n0 + n;
        if (MODE == 1) { const int f = row & 1023; row = ((f >> 7) << 8) + ((row >> 10) << 7) + (f & 127); }
        if (MODE == 2) { const int hh = row / DQK; row = hh * 128 + (row - hh * DQK); }
        if (MODE == 3) { const int hh = row >> 7, ii = row & 127; row = ((ii >> 6) << 9) + hh * 64 + (ii & 63); }
        *(u32x4*)(WT + (size_t)row * K + k0 + 8 * c) = o; }
    asm volatile("s_waitcnt lgkmcnt(0)" ::: "memory");
}
template <int MODE>
__device__ __forceinline__ void transpose_item_fp8(const float* __restrict__ W, int K, int N, unsigned char* __restrict__ WT, float* scr, int item, int lane) {
    const int nblk = N / 32, kb = item / nblk, nb = item % nblk, k0 = 64 * kb, n0 = 32 * nb;
#pragma unroll
    for (int i = 0; i < 8; ++i) { const int kk = 8 * i + (lane >> 3), n4 = (lane & 7) * 4; const f32x4 v = *(const f32x4*)(W + (size_t)(k0 + kk) * N + n0 + n4) * W8_SCALE;
        float* s = scr + kk * 33 + n4; s[0] = v[0]; s[1] = v[1]; s[2] = v[2]; s[3] = v[3]; }
    asm volatile("s_waitcnt lgkmcnt(0)" ::: "memory");
    const int c = lane & 7;
#pragma unroll
    for (int j = 0; j < 4; ++j) { const int n = (lane >> 3) + 8 * j; const float* s = scr + (8 * c) * 33 + n;
        u32x2 o; o.x = pk4_fp8(s[0 * 33], s[1 * 33], s[2 * 33], s[3 * 33]); o.y = pk4_fp8(s[4 * 33], s[5 * 33], s[6 * 33], s[7 * 33]);
        int row = n0 + n;
        if (MODE == 1) { const int f = row & 1023; row = ((f >> 7) << 8) + ((row >> 10) << 7) + (f & 127); }
        *(u32x2*)(WT + (size_t)row * K + k0 + 8 * c) = o; }
    asm volatile("s_waitcnt lgkmcnt(0)" ::: "memory");
}
__device__ __forceinline__ void phase_prologue(const Params& p, unsigned char* lds) {
    const int tid = threadIdx.x, lane = tid & 63, wave = tid >> 6;
    float* scr = (float*)(lds + wave * 16384);
    const int gw = blockIdx.x * NWAVES + wave, NGW = gridDim.x * NWAVES;
    unsigned char* ws = p.ws;
    constexpr int I_WIN = (DM / 64) * (INC / 32), I_UQ = (QLORA / 64) * (768 / 32), I_UKV = (KVLORA / 64) * (1024 / 32), I_OM = (512 / 64) * (DM / 32), I_OC = I_OM, I_WO = (DM / 64) * (DM / 32);
    constexpr int I_W1 = (DM / 64) * (2048 / 32), I_W2 = (DFF / 64) * (DM / 32);
    constexpr int NSMALL = I_WIN + I_UQ + I_UKV + I_OM + I_OC + I_WO;
    constexpr int NITEMS = NSMALL;
    for (int it = gw; it < NITEMS; it += NGW) {
        int r = it;
        if (r < I_WIN) { transpose_item<0>(p.w_in, DM, INC, (bf16_t*)(ws + WS_WIN), p.norm1_g, scr, r, lane); continue; } r -= I_WIN;
        if (r < I_UQ) { transpose_item<2>(p.w_uq, QLORA, 768, (bf16_t*)(ws + WS_WUQ), p.q_a_g, scr, r, lane); continue; } r -= I_UQ;
        if (r < I_UKV) { transpose_item<3>(p.w_ukv, KVLORA, 1024, (bf16_t*)(ws + WS_WUKV), p.kv_a_g, scr, r, lane); continue; } r -= I_UKV;
        if (r < I_OM) { transpose_item<0>(p.w_o_mla, 512, DM, (bf16_t*)(ws + WS_WOMLA), nullptr, scr, r, lane); continue; } r -= I_OM;
        if (r < I_OC) { transpose_item<0>(p.w_o_conv, 512, DM, (bf16_t*)(ws + WS_WOCONV), nullptr, scr, r, lane); continue; } r -= I_OC;
        transpose_item<0>(p.w_o, DM, DM, (bf16_t*)(ws + WS_WO), nullptr, scr, r, lane);
    }
    { u32x4* z = (u32x4*)((bf16_t*)(ws + WS_WIN) + (size_t)INC * DM); const int nz = (INCP - INC) * DM * 2 / 16;
      for (int i = blockIdx.x * NTHREADS + tid; i < nz; i += gridDim.x * NTHREADS) z[i] = (u32x4){0u, 0u, 0u, 0u}; }
    { u32x4* wq = (u32x4*)(ws + WS_WUQ); for (int i = blockIdx.x * NTHREADS + tid; i < NH * 32 * QLORA * 2 / 16; i += gridDim.x * NTHREADS) { const int hh = i / (32 * QLORA * 2 / 16), q = i - hh * (32 * QLORA * 2 / 16); wq[(hh * 128 + 96) * (QLORA * 2 / 16) + q] = (u32x4){0u, 0u, 0u, 0u}; } }
    { float* csd = (float*)(ws + WS_CS); for (int i = blockIdx.x * NTHREADS + tid; i < NTOK * 16; i += gridDim.x * NTHREADS) { const int t = i >> 4, j = i & 15; float sn, cn; sincosf((float)p.pos[t] * exp2f(-(float)j * (13.287712379549449f / 16.f)), &sn, &cn); csd[t * 32 + j] = cn; csd[t * 32 + 16 + j] = sn; } }
    if (blockIdx.x == 0 && tid < 64) { float gq = fabsf(p.q_g[tid]), gk = fabsf(p.k_g[tid]); if (tid < 32) { gq = fmaxf(gq, fabsf(p.q_g[64 + tid])); gk = fmaxf(gk, fabsf(p.k_g[64 + tid])); }
#pragma unroll
        for (int o = 1; o < 64; o <<= 1) { gq = fmaxf(gq, __shfl_xor(gq, o)); gk = fmaxf(gk, __shfl_xor(gk, o)); }
        if (tid == 0) *(float*)(ws + WS_SHIFT) = fmaxf(2.f, ceilf(14.135f * gq * gk + 0.5f - 15.f)); }
    { int* rt = (int*)(ws + WS_RT2); int* rs = (int*)(ws + WS_RT2 + 4 * MiB); float* rr = (float*)(ws + WS_RT2 + 6 * MiB);
      for (int i = blockIdx.x * NTHREADS + tid; i < NE * CAP; i += gridDim.x * NTHREADS) { rt[i] = 0; rs[i] = -1; rr[i] = 0.f; } }
    { u32x4* GF = (u32x4*)(ws + WS_GF);
      for (int i = blockIdx.x * NTHREADS + tid; i < 64 * 64; i += gridDim.x * NTHREADS) { const int ks = i >> 6, ln = i & 63, r = ln & 31, h = ln >> 5; float v[8], lo[8]; unsigned hi[4];
#pragma unroll
          for (int j = 0; j < 8; ++j) { const int k = 16 * ks + 8 * h + j; v[j] = p.norm2_g[k] * p.router_w[(size_t)k * NE + r]; }
#pragma unroll
          for (int j = 0; j < 4; ++j) { hi[j] = pk2(v[2 * j], v[2 * j + 1]); lo[2 * j] = v[2 * j] - bf_lo(hi[j]); lo[2 * j + 1] = v[2 * j + 1] - bf_hi(hi[j]); }
          GF[(ks * 2 + 0) * 64 + ln] = (u32x4){hi[0], hi[1], hi[2], hi[3]}; GF[(ks * 2 + 1) * 64 + ln] = (u32x4){pk2(lo[0], lo[1]), pk2(lo[2], lo[3]), pk2(lo[4], lo[5]), pk2(lo[6], lo[7])}; } }
    bf16_t* XN = (bf16_t*)(ws + WS_XN);
    for (int m = gw; m < NTOK; m += NGW) {
        const f32x4* xr = (const f32x4*)(p.x + (size_t)m * DM) + lane; f32x4 v[4]; float s = 0.f;
#pragma unroll
        for (int j = 0; j < 4; ++j) { v[j] = xr[64 * j]; s += (v[j][0] * v[j][0] + v[j][1] * v[j][1]) + (v[j][2] * v[j][2] + v[j][3] * v[j][3]); }
        const float rstd = rsqrtf(wave_sum(s) * (1.f / DM) + EPS);
        u32x2* o = (u32x2*)(XN + (size_t)m * DM) + lane;
#pragma unroll
        for (int j = 0; j < 4; ++j) { u32x2 w; w.x = pk2(v[j][0] * rstd, v[j][1] * rstd); w.y = pk2(v[j][2] * rstd, v[j][3] * rstd); o[64 * j] = w; }
    }
}

struct ConvRaw { u32x4 u[3], c[3], bg; float m0, m2; };
__device__ __forceinline__ void conv_load(ConvRaw& r, const Params& p, int t, int lane) {
    const bf16_t* pr = (const bf16_t*)(p.ws + WS_PROJ) + (size_t)t * INCP; const int s = t & (SEQ - 1);
    r.m0 = s > 0 ? 1.f : 0.f; r.m2 = s < SEQ - 1 ? 1.f : 0.f;
    const bf16_t* pm = s > 0 ? pr - INCP : pr; const bf16_t* pp = s < SEQ - 1 ? pr + INCP : pr;
    r.u[0] = *(const u32x4*)(pm + OFF_U + 8 * lane); r.c[0] = *(const u32x4*)(pm + OFF_C + 8 * lane);
    r.u[1] = *(const u32x4*)(pr + OFF_U + 8 * lane); r.c[1] = *(const u32x4*)(pr + OFF_C + 8 * lane);
    r.u[2] = *(const u32x4*)(pp + OFF_U + 8 * lane); r.c[2] = *(const u32x4*)(pp + OFF_C + 8 * lane);
    r.bg = *(const u32x4*)(pr + OFF_B + 8 * lane);
}
__device__ __forceinline__ void mulpair8(const u32x4 u, const u32x4 c, float (&o)[8]) {
    o[0] = bf_lo(u.x) * bf_lo(c.x); o[1] = bf_hi(u.x) * bf_hi(c.x); o[2] = bf_lo(u.y) * bf_lo(c.y); o[3] = bf_hi(u.y) * bf_hi(c.y);
    o[4] = bf_lo(u.z) * bf_lo(c.z); o[5] = bf_hi(u.z) * bf_hi(c.z); o[6] = bf_lo(u.w) * bf_lo(c.w); o[7] = bf_hi(u.w) * bf_hi(c.w); }
__device__ __forceinline__ void conv_store(const ConvRaw& r, const Params& p, int t, int lane, const float (&cw0)[8], const float (&cw1)[8], const float (&cw2)[8]) {
    float cu0[8], cu1[8], cu2[8], bb[8], y[8]; mulpair8(r.u[0], r.c[0], cu0); mulpair8(r.u[1], r.c[1], cu1); mulpair8(r.u[2], r.c[2], cu2);
    bb[0] = bf_lo(r.bg.x); bb[1] = bf_hi(r.bg.x); bb[2] = bf_lo(r.bg.y); bb[3] = bf_hi(r.bg.y); bb[4] = bf_lo(r.bg.z); bb[5] = bf_hi(r.bg.z); bb[6] = bf_lo(r.bg.w); bb[7] = bf_hi(r.bg.w);
#pragma unroll
    for (int j = 0; j < 8; ++j) y[j] = bb[j] * (cw0[j] * r.m0 * cu0[j] + cw1[j] * cu1[j] + cw2[j] * r.m2 * cu2[j]);
    u32x4 o; o.x = pk2(y[0], y[1]); o.y = pk2(y[2], y[3]); o.z = pk2(y[4], y[5]); o.w = pk2(y[6], y[7]); *(u32x4*)((bf16_t*)(p.ws + WS_YBIN) + (size_t)t * CONVW + 8 * lane) = o;
}
__device__ __forceinline__ void phase_conv(const Params& p) {
    int tid = threadIdx.x; asm volatile("" : "+v"(tid)); const int lane = tid & 63, wave = tid >> 6;
    const int half = (int)gridDim.x / 2; if ((int)blockIdx.x < half) return;
    const int gw = ((int)blockIdx.x - half) * NWAVES + wave, NGW = ((int)gridDim.x - half) * NWAVES;
    float cw0[8], cw1[8], cw2[8];
#pragma unroll
    for (int j = 0; j < 8; ++j) { cw0[j] = p.conv_w[8 * lane + j]; cw1[j] = p.conv_w[CONVW + 8 * lane + j]; cw2[j] = p.conv_w[2 * CONVW + 8 * lane + j]; }
    const bf16_t* proj = (const bf16_t*)(p.ws + WS_PROJ);
    for (int t0 = 8 * gw; t0 < NTOK; t0 += 8 * NGW) {
        const int s0 = t0 & (SEQ - 1);
        u32x4 U[10], C[10], B[8];
#pragma unroll
        for (int r = 0; r < 10; ++r) { int tt = t0 - 1 + r; if (r == 0 && s0 == 0) tt = t0; if (r == 9 && s0 + 8 == SEQ) tt = t0 + 7;
            const bf16_t* pr = proj + (size_t)tt * INCP; U[r] = *(const u32x4*)(pr + OFF_U + 8 * lane); C[r] = *(const u32x4*)(pr + OFF_C + 8 * lane); }
#pragma unroll
        for (int k = 0; k < 8; ++k) B[k] = *(const u32x4*)(proj + (size_t)(t0 + k) * INCP + OFF_B + 8 * lane);
        float cuP[8], cuC[8], cuN[8]; mulpair8(U[0], C[0], cuP); mulpair8(U[1], C[1], cuC);
#pragma unroll
        for (int k = 0; k < 8; ++k) { mulpair8(U[k + 2], C[k + 2], cuN); const int s = s0 + k; const float m0 = s > 0 ? 1.f : 0.f, m2 = s < SEQ - 1 ? 1.f : 0.f;
            float bb[8], y[8]; bb[0] = bf_lo(B[k].x); bb[1] = bf_hi(B[k].x); bb[2] = bf_lo(B[k].y); bb[3] = bf_hi(B[k].y); bb[4] = bf_lo(B[k].z); bb[5] = bf_hi(B[k].z); bb[6] = bf_lo(B[k].w); bb[7] = bf_hi(B[k].w);
#pragma unroll
            for (int j = 0; j < 8; ++j) { y[j] = bb[j] * (cw0[j] * m0 * cuP[j] + cw1[j] * cuC[j] + cw2[j] * m2 * cuN[j]); cuP[j] = cuC[j]; cuC[j] = cuN[j]; }
            u32x4 o; o.x = pk2(y[0], y[1]); o.y = pk2(y[2], y[3]); o.z = pk2(y[4], y[5]); o.w = pk2(y[6], y[7]); *(u32x4*)((bf16_t*)(p.ws + WS_YBIN) + (size_t)(t0 + k) * CONVW + 8 * lane) = o; }
    }
}

constexpr int WC_EXP_ITEMS = NE * 1536, WC_RAW_B = 9 * 1024;
struct WcItem { const float* W; unsigned char* WT; int N, k0, n0, mode; };
__device__ __forceinline__ WcItem wc_decode(const Params& p, int x) {
    WcItem it; const int e = x / 1536, r = x - e * 1536;
    if (r < 1024) { it.W = p.w1 + (size_t)e * DM * 2048; it.WT = p.ws + WS_W1 + (size_t)e * 2048 * DM; it.N = 2048; it.k0 = 64 * (r >> 6); it.n0 = 32 * (r & 63); it.mode = 1; }
    else { const int q = r - 1024; it.W = p.w2 + (size_t)e * DFF * DM; it.WT = p.ws + WS_W2 + (size_t)e * DM * DFF; it.N = DM; it.k0 = 64 * (q >> 5); it.n0 = 32 * (q & 31); it.mode = 0; }
    return it;
}
__device__ __forceinline__ int wc_item(int g, int G, int t) {
    const int P = g + G * (t >> 1), half = t & 1, e = (int)(((unsigned)(P >> 8) * 171u) >> 9)  , rp = P - e * 768;
    const int r = rp < 512 ? ((2 * (rp >> 6) + half) << 6) + (rp & 63) : 1024 + ((2 * ((rp - 512) >> 5) + half) << 5) + ((rp - 512) & 31);
    return e * 1536 + r;
}
struct WConv { unsigned char* raw; const int* itab; int nitems, cs, slot, sh, soff; bool m1; };
__device__ __forceinline__ bool wconv_step(WConv& c, const Params& p, int lane) {
    typedef __attribute__((address_space(3))) unsigned* lds_u32p;
    const int cs = c.cs, nst = 8 * c.nitems, fi = cs - 9;
    if (fi >= 0 && (fi & 7) == 0 && (fi >> 3) < c.nitems) {
        const int i = fi >> 3; const WcItem it = wc_decode(p, __builtin_amdgcn_readfirstlane(c.itab[i])); const int c8 = lane & 7, nr = lane >> 3, lv = (nr >> 2) | (c8 << 1);
        int sl = c.slot + c8; sl -= (sl >= 9) ? 9 : 0;
        const unsigned char* rb = c.raw + sl * 1024 + (nr & 3) * 4;
        float v[4][8];
#pragma unroll
        for (int j = 0; j < 4; ++j)
#pragma unroll
            for (int k = 0; k < 8; ++k) v[j][k] = *(const float*)(rb + (((k * 8 + 2 * j) ^ lv) << 4));
#pragma unroll
        for (int j = 0; j < 4; ++j) {
            u32x2 o; o.x = pk4_fp8(v[j][0] * W8_SCALE, v[j][1] * W8_SCALE, v[j][2] * W8_SCALE, v[j][3] * W8_SCALE); o.y = pk4_fp8(v[j][4] * W8_SCALE, v[j][5] * W8_SCALE, v[j][6] * W8_SCALE, v[j][7] * W8_SCALE);
            int row = it.n0 + nr + 8 * j; if (it.mode == 1) { const int f = row & 1023; row = ((f >> 7) << 8) + ((row >> 10) << 7) + (f & 127); }
            *(u32x2*)(it.WT + (size_t)row * DM + it.k0 + 8 * c8) = o; }
    }
    const bool issue = cs < nst;
    if (issue) {
        const int q = cs & 7;
        if (q == 0) { const int x = __builtin_amdgcn_readfirstlane(c.itab[cs >> 3]), e = x / 1536, r = x - e * 1536;
            if (r < 1024) { c.m1 = true; c.sh = 13; c.soff = e * (DM * 2048 * 4) + (64 * (r >> 6)) * 8192 + (32 * (r & 63)) * 4; }
            else { const int q2 = r - 1024; c.m1 = false; c.sh = 12; c.soff = e * (DFF * DM * 4) + (64 * (q2 >> 5)) * 4096 + (32 * (q2 & 31)) * 4; } }
        const int sv = lane ^ (q << 1), voff = ((sv >> 3) << c.sh) + ((sv & 7) << 4), so = c.soff + ((8 * q) << c.sh);
        typedef __attribute__((address_space(3))) void* lds_vp;
        const __amdgpu_buffer_rsrc_t rs = __builtin_amdgcn_make_buffer_rsrc((void*)(c.m1 ? p.w1 : p.w2), 0, 0x7fffffff, 0x00020000);
        __builtin_amdgcn_raw_ptr_buffer_load_lds(rs, (lds_vp)(c.raw + c.slot * 1024), 16, voff, so, 0, 0);
    }
    c.cs = cs + 1; c.slot = (c.slot == 8) ? 0 : c.slot + 1;
    return issue;
}

namespace att {
constexpr int NW = 8, QBLK = 32, KVBLK = 64;
constexpr float SCALE = 0.10206207261596575f;
constexpr float QSC = SCALE * 1.4426950408889634f;
constexpr int LDQ = 128, LDK = 128;
constexpr int SHM_V = KVBLK * DV, SHM_K = KVBLK * 128, SHM_ATTN = 2 * SHM_V + 2 * SHM_K + NW * 64 * 4;
#define KSWZ(row, colB) ((row) * 256 + ((colB) ^ (((row) & 7) << 4)))
#define SBAR() __builtin_amdgcn_sched_barrier(0)
__device__ __forceinline__ int crow(int r, int hi) { return (r & 3) + 8 * (r >> 2) + 4 * hi; }
__device__ __forceinline__ float fadd_s(float a, float b) { float r; asm("v_add_f32_e32 %0, %1, %2" : "=v"(r) : "v"(a), "v"(b)); return r; }
__device__ __forceinline__ unsigned cvtpk(float lo, float hi) { unsigned r; asm volatile("v_cvt_pk_bf16_f32 %0, %1, %2" : "=v"(r) : "v"(lo), "v"(hi)); return r; }
typedef int i32x4a __attribute__((ext_vector_type(4))); typedef int i32x8a __attribute__((ext_vector_type(8)));
#define EXPH(P) do { _Pragma("unroll") for (int r = 0; r < 16; ++r) P[r] = __builtin_amdgcn_exp2f(P[r]); } while (0)
__device__ __forceinline__ unsigned pk4_bf8(float a, float b, float c, float d) { unsigned w = 0u; w = (unsigned)__builtin_amdgcn_cvt_pk_bf8_f32(a, b, (int)w, false); w = (unsigned)__builtin_amdgcn_cvt_pk_bf8_f32(c, d, (int)w, true); return w; }
__device__ __forceinline__ void finishSM(f32x16& p0, f32x16& p1, float& l_reg, i32x8a& pf) {
    EXPH(p1); SBAR();
    float ps0 = p0[0], ps1 = p1[0];
#pragma unroll
    for (int r = 1; r < 16; ++r) { ps0 = fadd_s(ps0, p0[r]); ps1 = fadd_s(ps1, p1[r]); }
    l_reg += ps0 + ps1;
#pragma unroll
    for (int q = 0; q < 4; ++q) {
        pf[q] = __builtin_amdgcn_cvt_pk_bf8_f32(p0[4 * q], p0[4 * q + 1], pf[q], false); pf[q] = __builtin_amdgcn_cvt_pk_bf8_f32(p0[4 * q + 2], p0[4 * q + 3], pf[q], true);
        pf[4 + q] = __builtin_amdgcn_cvt_pk_bf8_f32(p1[4 * q], p1[4 * q + 1], pf[4 + q], false); pf[4 + q] = __builtin_amdgcn_cvt_pk_bf8_f32(p1[4 * q + 2], p1[4 * q + 3], pf[4 + q], true); }
}
__device__ __forceinline__ void qkt(f32x16& p0, f32x16& p1, const unsigned char* Ks, const i32x8a* qf, int r32, int hi) {
    const f32x16 z = {};
#pragma unroll
    for (int kh = 0; kh < 2; ++kh) { const int row = kh * 32 + r32, sw = (row >> 1) & 7; const unsigned char* rb = Ks + row * 128; f32x16 acc = z;
#pragma unroll
        for (int s = 0; s < 2; ++s) { const int c0 = 4 * s + 2 * hi; const i32x4a lo = *reinterpret_cast<const i32x4a*>(rb + ((c0 ^ sw) << 4)), hh = *reinterpret_cast<const i32x4a*>(rb + (((c0 + 1) ^ sw) << 4));
            acc = __builtin_amdgcn_mfma_scale_f32_32x32x64_f8f6f4(__builtin_shufflevector(lo, hh, 0, 1, 2, 3, 4, 5, 6, 7), qf[s], acc, 0, 0, 0, 0, 0, 0); }
        if (kh == 0) p0 = acc; else p1 = acc; }
}
__device__ __forceinline__ i32x8a kfrag(const unsigned char* Ks, int kh, int s, int r32, int hi) {
    const int row = kh * 32 + r32, sw = (row >> 1) & 7, c0 = 4 * s + 2 * hi; const unsigned char* rb = Ks + row * 128;
    const i32x4a lo = *reinterpret_cast<const i32x4a*>(rb + ((c0 ^ sw) << 4)), hh = *reinterpret_cast<const i32x4a*>(rb + (((c0 + 1) ^ sw) << 4));
    return __builtin_shufflevector(lo, hh, 0, 1, 2, 3, 4, 5, 6, 7);
}
__device__ __forceinline__ i32x8a vfrag(const unsigned char* Vs, int d0, int r32, int hi) {
    const unsigned char* b = Vs + (((hi * 2 + d0) * 32 + r32) << 5); const int sw = (r32 >> 3) & 1;
    const i32x4a lo = *reinterpret_cast<const i32x4a*>(b + (sw << 4)), hh = *reinterpret_cast<const i32x4a*>(b + ((sw ^ 1) << 4));
    return __builtin_shufflevector(lo, hh, 0, 1, 2, 3, 4, 5, 6, 7);
}
__device__ __forceinline__ void pv8(f32x16& od, const i32x8a v, const i32x8a pfr) { asm volatile("s_nop 1\n\tv_mfma_f32_32x32x64_f8f6f4 %0, %1, %2, %0 blgp:1" : "+v"(od) : "v"(v), "v"(pfr)); }
#define EXPQ(P, B) do { _Pragma("unroll") for (int r = (B); r < (B) + 8; ++r) P[r] = __builtin_amdgcn_exp2f(P[r]); } while (0)
#define PV_STEP(Vs, PN) do { const i32x8a v0_ = vfrag((Vs), 0, r32, hi), v1_ = vfrag((Vs), 1, r32, hi); pv8(o[0], v0_, pf); EXPQ(PN, 0); pv8(o[1], v1_, pf); EXPQ(PN, 8); SBAR(); } while (0)

__device__ __forceinline__ void attn_unit(const unsigned char* __restrict__ Qb, const unsigned char* __restrict__ Kh, const unsigned char* __restrict__ Vth, bf16_t* __restrict__ Ob, int seq, unsigned char* lds, WConv& wc, const Params& prm) {
    const int tid = threadIdx.x, wid = __builtin_amdgcn_readfirstlane(tid >> 6), lane = tid & 63, r32 = lane & 31, hi = lane >> 5;
    unsigned char* V_lds = lds; unsigned char* K_lds = lds + 2 * SHM_V;
    f32x16 o[2] = {}; i32x8a qr[2];
    { const unsigned char* Qw = Qb + (size_t)(wid * QBLK + r32) * LDQ + hi * 32;
#pragma unroll
      for (int s = 0; s < 2; ++s) { const i32x4a lo = *reinterpret_cast<const i32x4a*>(Qw + 64 * s), hh = *reinterpret_cast<const i32x4a*>(Qw + 64 * s + 16); qr[s] = __builtin_shufflevector(lo, hh, 0, 1, 2, 3, 4, 5, 6, 7); } }
    const int kr0 = 8 * wid + (lane >> 3), kcp = lane & 7;
    const int kvoff = kr0 * LDK + ((kcp ^ ((kr0 >> 1) & 7)) * 16), vvoff = (wid & 3) * 1024 + lane * 16;
    const __amdgpu_buffer_rsrc_t rsK = __builtin_amdgcn_make_buffer_rsrc((void*)Kh, 0, 0x7fffffff, 0x00020000), rsV = __builtin_amdgcn_make_buffer_rsrc((void*)Vth, 0, 0x7fffffff, 0x00020000);
    typedef __attribute__((address_space(3))) void* lds_vp;
    const unsigned char* vsrc = Vth + (wid & 3) * 1024 + lane * 16;
    typedef __attribute__((address_space(3))) unsigned* lds_u32p;
#define DMA_K(t, slot) __builtin_amdgcn_raw_ptr_buffer_load_lds(rsK, (lds_vp)(K_lds + (slot) * SHM_K + wid * 1024), 16, kvoff, (t) * (KVBLK * LDK), 0, 0)
#define DMA_V(t, slot) do { if (wid < 4) __builtin_amdgcn_raw_ptr_buffer_load_lds(rsV, (lds_vp)(V_lds + (slot) * SHM_V + wid * 1024), 16, vvoff, (t) * 4096, 0, 0); } while (0)
    f32x16 pA0, pA1, pB0, pB1; i32x8a pf = {}; const int NT = seq / KVBLK;
    typedef float f32x4v __attribute__((ext_vector_type(4)));
    i32x8a ones; { const int c4 = ((lane & 1) == ((lane >> 4) & 1)) ? 0x22222222 : 0; ones = (i32x8a){c4, c4, c4, c4, 0, 0, 0, 0}; }
    f32x4v lsum = {0.f, 0.f, 0.f, 0.f};
    const f32x16 zacc = {};
#define QKM(ACC, KF, S, CIN) ACC = __builtin_amdgcn_mfma_scale_f32_32x32x64_f8f6f4(KF, qr[S], CIN, 0, 0, 0, 0, 0, 0)
#define ROWSUM() lsum = __builtin_amdgcn_mfma_scale_f32_16x16x128_f8f6f4(ones, pf, lsum, 4, 1, 0, 0, 0, 0)
#define CVT8(P, Q0) do { _Pragma("unroll") for (int q_ = 0; q_ < 4; ++q_) { pf[(Q0) + q_] = __builtin_amdgcn_cvt_pk_bf8_f32(P[4 * q_], P[4 * q_ + 1], pf[(Q0) + q_], false); pf[(Q0) + q_] = __builtin_amdgcn_cvt_pk_bf8_f32(P[4 * q_ + 2], P[4 * q_ + 3], pf[(Q0) + q_], true); } } while (0)
#define WAITW(ISS) do { if (ISS) asm volatile("s_waitcnt vmcnt(1)" ::: "memory"); else asm volatile("s_waitcnt vmcnt(0)" ::: "memory"); } while (0)
#define BARE_BAR() asm volatile("s_barrier" ::: "memory")
#define PIN(P) asm volatile("" : "+v"(P))
#define STEP(Ks, Vs, PC0, PC1, PX0, PX1) do { \
        const i32x8a k00_ = kfrag((Ks), 0, 0, r32, hi), k01_ = kfrag((Ks), 0, 1, r32, hi), k10_ = kfrag((Ks), 1, 0, r32, hi), k11_ = kfrag((Ks), 1, 1, r32, hi); SBAR(); \
        QKM(PX0, k00_, 0, zacc); PIN(PX0); EXPQ(PC1, 0); PIN(PC1); SBAR(); \
        QKM(PX0, k01_, 1, PX0); PIN(PX0); EXPQ(PC1, 8); PIN(PC1); SBAR(); \
        QKM(PX1, k10_, 0, zacc); PIN(PX1); CVT8(PC0, 0); PIN(pf); SBAR(); \
        QKM(PX1, k11_, 1, PX1); PIN(PX1); CVT8(PC1, 4); PIN(pf); const i32x8a v0_ = vfrag((Vs), 0, r32, hi), v1_ = vfrag((Vs), 1, r32, hi); SBAR(); \
        ROWSUM(); PIN(lsum); pv8(o[0], v0_, pf); EXPQ(PX0, 0); PIN(PX0); SBAR(); \
        pv8(o[1], v1_, pf); EXPQ(PX0, 8); PIN(PX0); SBAR(); } while (0)
    DMA_K(0, 0); DMA_V(0, 0); DMA_K(1, 1);
    asm volatile("s_waitcnt vmcnt(0)" ::: "memory"); __syncthreads();
    qkt(pA0, pA1, K_lds, qr, r32, hi); EXPH(pA0); SBAR();
    __syncthreads();
    for (int j = 0; j + 2 < NT; j += 2) {
        DMA_K(j + 2, 0); DMA_V(j + 1, 1); const bool wlA = wconv_step(wc, prm, lane); SBAR();
        STEP(K_lds + SHM_K, V_lds, pA0, pA1, pB0, pB1);
        WAITW(wlA); BARE_BAR();
        DMA_K(j + 3, 1); DMA_V(j + 2, 0); const bool wlB = wconv_step(wc, prm, lane); SBAR();
        STEP(K_lds, V_lds + SHM_V, pB0, pB1, pA0, pA1);
        WAITW(wlB); BARE_BAR();
    }
    DMA_V(NT - 1, 1); const bool wlT = wconv_step(wc, prm, lane); SBAR();
    STEP(K_lds + SHM_K, V_lds, pA0, pA1, pB0, pB1);
    WAITW(wlT); BARE_BAR();
    EXPH(pB1); SBAR(); CVT8(pB0, 0); CVT8(pB1, 4); SBAR();
    { const i32x8a v0_ = vfrag(V_lds + SHM_V, 0, r32, hi), v1_ = vfrag(V_lds + SHM_V, 1, r32, hi); ROWSUM(); pv8(o[0], v0_, pf); pv8(o[1], v1_, pf); }
    asm volatile("s_nop 15\n\ts_nop 7" ::: "memory"); SBAR();
    const float l_reg = (lane & 16) ? lsum[1] : lsum[0];
#undef STEP
#undef PIN
#undef WAITW
#undef BARE_BAR
#undef QKM
#undef ROWSUM
#undef CVT8
    const float rl = __builtin_amdgcn_rcpf(l_reg);
    bf16_t* Ow = Ob + (size_t)(wid * QBLK + r32) * 512 + 4 * hi;
#pragma unroll
    for (int d0 = 0; d0 < 2; ++d0)
#pragma unroll
        for (int g = 0; g < 4; ++g) { u32x2 w; w.x = pk2(o[d0][4 * g] * rl, o[d0][4 * g + 1] * rl); w.y = pk2(o[d0][4 * g + 2] * rl, o[d0][4 * g + 3] * rl); *(u32x2*)(Ow + d0 * 32 + 8 * g) = w; }
    __syncthreads();
#undef DMA_K
#undef DMA_V
}
#undef KSWZ
#undef SBAR
}

__device__ __forceinline__ void phase_attn(const Params& p, unsigned char* lds) {
    const unsigned char* Q = p.ws + WS_Q; const unsigned char* Kb = p.ws + WS_K; const unsigned char* VT = p.ws + WS_V; bf16_t* AO = (bf16_t*)(p.ws + WS_AO);
    constexpr int NQB = SEQ / 256, NU = 2 * NH * NQB;
    const int lane = threadIdx.x & 63, wave = __builtin_amdgcn_readfirstlane(threadIdx.x >> 6), gw = blockIdx.x * NWAVES + wave, NGW = gridDim.x * NWAVES;
    const int ipw = (WC_EXP_ITEMS + NGW - 1) / NGW, nun = ((int)blockIdx.x < NU) ? (NU - 1 - (int)blockIdx.x) / (int)gridDim.x + 1 : 0, steps = nun * (SEQ / att::KVBLK - 1);
    int cov = (steps - 2) / 8; cov = cov < 0 ? 0 : (cov > ipw ? ipw : cov);
    WConv wc; wc.raw = lds + att::SHM_ATTN + wave * WC_RAW_B; { int* tb = (int*)(lds + att::SHM_ATTN + NWAVES * WC_RAW_B) + wave * 32; if (lane < 32) tb[lane] = wc_item(gw, NGW, lane < ipw ? lane : 0); asm volatile("s_waitcnt lgkmcnt(0)" ::: "memory"); wc.itab = tb; } wc.cs = 0; wc.slot = 0; wc.sh = 12; wc.soff = 0; wc.m1 = true;
    { const int npair = gw < WC_EXP_ITEMS / 2 ? (WC_EXP_ITEMS / 2 - 1 - gw) / NGW + 1 : 0, mine = 2 * npair; wc.nitems = mine < cov ? mine : cov; }
    if (wave >= 4) __builtin_amdgcn_s_setprio(1);
    const bool xmap = false;
    for (int u0 = blockIdx.x, rnd = 0; u0 < NU; u0 += gridDim.x, ++rnd) {
        const int u = xmap ? (((int)blockIdx.x & 7) + 8 * rnd) * NQB + ((int)blockIdx.x >> 3) : u0;
        const int qb = u % NQB, h = (u / NQB) % NH, b = u / (NQB * NH); const size_t bh = (size_t)(b * NH + h) * SEQ;
        att::attn_unit(Q + (bh + (size_t)qb * 256) * 128, Kb + bh * 128, VT + bh * DV, AO + ((size_t)b * SEQ + (size_t)qb * 256) * 512 + h * DV, SEQ, lds, wc, p);
    }
    __builtin_amdgcn_s_setprio(0);
    while (wc.cs < 8 * wc.nitems + 2) { wconv_step(wc, p, lane); asm volatile("s_waitcnt vmcnt(0)" ::: "memory"); }
}
__device__ __forceinline__ void wconv_cleanup(const Params& p, unsigned char* lds) {
    constexpr int NQB = SEQ / 256, NU = 2 * NH * NQB;
    const int lane = threadIdx.x & 63, wave = threadIdx.x >> 6, gw = blockIdx.x * NWAVES + wave, NGW = gridDim.x * NWAVES;
    const int ipw = (WC_EXP_ITEMS + NGW - 1) / NGW, nun = ((int)blockIdx.x < NU) ? (NU - 1 - (int)blockIdx.x) / (int)gridDim.x + 1 : 0, steps = nun * (SEQ / att::KVBLK - 1);
    int cov = (steps - 2) / 8; cov = cov < 0 ? 0 : (cov > ipw ? ipw : cov);
    float* scr = (float*)(lds + wave * 16384);
    for (int i = cov; i < ipw; ++i) { if (gw + NGW * (i >> 1) >= WC_EXP_ITEMS / 2) break; const int x = wc_item(gw, NGW, i); const WcItem it = wc_decode(p, x); const int r = x % 1536;
        if (it.mode == 1) transpose_item_fp8<1>(it.W, DM, 2048, it.WT, scr, r, lane); else transpose_item_fp8<0>(it.W, DFF, DM, it.WT, scr, r - 1024, lane); }
    __syncthreads();
}

__device__ __forceinline__ int crow16(int r, int hi) { return (r & 3) + 8 * (r >> 2) + 4 * hi; }
__device__ __forceinline__ void phase_router(const Params& p, unsigned char* lds) {
    const int tid = threadIdx.x, lane = tid & 63, wid = tid >> 6, tile = wid >> 2, kq = wid & 3, c = lane & 31, h = lane >> 5;
    float* red = (float*)lds;
    float* ssb = red + 2 * 4 * 16 * 64;
    int* lcnt = (int*)(ssb + 2 * 4 * 64);
    int* lbase = lcnt + 32;
    unsigned* gcnt = (unsigned*)(p.ws + WS_CTL) + CW_CNT;
    int* row_tok = (int*)(p.ws + WS_RT2); float* row_w = (float*)(p.ws + WS_RT2 + 2 * MiB); int* row_slot = (int*)(p.ws + WS_RT2 + 4 * MiB); float* row_rstd = (float*)(p.ws + WS_RT2 + 6 * MiB);
    const u32x4* GF = (const u32x4*)(p.ws + WS_GF);
    for (int tg = blockIdx.x; tg < NTOK / 64; tg += gridDim.x) {
        if (tid < 32) lcnt[tid] = 0;
        const int token = tg * 64 + tile * 32 + c;
        const bf16_t* xrow = (const bf16_t*)(p.ws + WS_X1B) + (size_t)token * DM + kq * 256 + 8 * h; const float* g2p = p.norm2_g + kq * 256 + 8 * h;
        unsigned char* hrow = p.ws + WS_H8 + (size_t)token * DM + kq * 256 + 8 * h;
        f32x16 acc = {}; float ss = 0.f;
        u32x4 xh[16];
#pragma unroll
        for (int s = 0; s < 16; ++s) xh[s] = *(const u32x4*)(xrow + 16 * s);
#pragma unroll
        for (int sb = 0; sb < 16; sb += 8) { u32x4 gh[8], gl[8];
#pragma unroll
            for (int s = 0; s < 8; ++s) { gh[s] = GF[((kq * 16 + sb + s) * 2 + 0) * 64 + lane]; gl[s] = GF[((kq * 16 + sb + s) * 2 + 1) * 64 + lane]; }
            asm volatile("" ::: "memory");
#pragma unroll
            for (int s = 0; s < 8; ++s) {
                acc = __builtin_amdgcn_mfma_f32_32x32x16_bf16(__builtin_bit_cast(bf16x8, gh[s]), __builtin_bit_cast(bf16x8, xh[sb + s]), acc, 0, 0, 0);
                acc = __builtin_amdgcn_mfma_f32_32x32x16_bf16(__builtin_bit_cast(bf16x8, gl[s]), __builtin_bit_cast(bf16x8, xh[sb + s]), acc, 0, 0, 0); } }
#pragma unroll
        for (int s = 0; s < 16; ++s) {
            const f32x4 ga = *(const f32x4*)(g2p + 16 * s), gb = *(const f32x4*)(g2p + 16 * s + 4);
            const f32x4 a = {bf_lo(xh[s].x), bf_hi(xh[s].x), bf_lo(xh[s].y), bf_hi(xh[s].y)}, b = {bf_lo(xh[s].z), bf_hi(xh[s].z), bf_lo(xh[s].w), bf_hi(xh[s].w)};
            ss += (a[0] * a[0] + a[1] * a[1]) + (a[2] * a[2] + a[3] * a[3]) + (b[0] * b[0] + b[1] * b[1]) + (b[2] * b[2] + b[3] * b[3]);
            u32x2 h8; h8.x = pk4_fp8(a[0] * ga[0], a[1] * ga[1], a[2] * ga[2], a[3] * ga[3]); h8.y = pk4_fp8(b[0] * gb[0], b[1] * gb[1], b[2] * gb[2], b[3] * gb[3]); *(u32x2*)(hrow + 16 * s) = h8;
        }
#pragma unroll
        for (int r = 0; r < 16; ++r) red[((tile * 4 + kq) * 16 + r) * 64 + lane] = acc[r];
        ssb[(tile * 4 + kq) * 64 + lane] = ss;
        __syncthreads();
        int te[4] = {0, 0, 0, 0}, rl[4] = {0, 0, 0, 0}; float tw[4] = {0.f, 0.f, 0.f, 0.f}; float rstd = 0.f;
        if (kq == 0) {
            float v[16]; float st = 0.f;
#pragma unroll
            for (int q = 0; q < 4; ++q) st += ssb[(tile * 4 + q) * 64 + lane];
            { auto rr = __builtin_amdgcn_permlane32_swap(__float_as_uint(st), __float_as_uint(st), false, false); st = __uint_as_float(rr[0]) + __uint_as_float(rr[1]); }
            rstd = rsqrtf(st * (1.f / DM) + EPS);
#pragma unroll
            for (int r = 0; r < 16; ++r) { float sacc = 0.f;
#pragma unroll
                for (int q = 0; q < 4; ++q) sacc += red[((tile * 4 + q) * 16 + r) * 64 + lane];
                v[r] = sacc * rstd + p.router_b[crow16(r, h)]; }
            float lv[4]; int le[4];
#pragma unroll
            for (int k = 0; k < 4; ++k) { float best = v[0]; int bi = 0;
#pragma unroll
                for (int r = 1; r < 16; ++r) { const bool gt = v[r] > best; best = gt ? v[r] : best; bi = gt ? r : bi; }
                lv[k] = best; le[k] = (bi & 3) + 8 * (bi >> 2) + 4 * h;
#pragma unroll
                for (int r = 0; r < 16; ++r) v[r] = (r == bi) ? -INFINITY : v[r]; }
            float cv[8]; int ce[8];
#pragma unroll
            for (int k = 0; k < 4; ++k) { auto rv = __builtin_amdgcn_permlane32_swap(__float_as_uint(lv[k]), __float_as_uint(lv[k]), false, false); auto re = __builtin_amdgcn_permlane32_swap((unsigned)le[k], (unsigned)le[k], false, false);
                cv[k] = __uint_as_float(rv[0]); cv[4 + k] = __uint_as_float(rv[1]); ce[k] = (int)re[0]; ce[4 + k] = (int)re[1]; }
            float tv[4];
#pragma unroll
            for (int k = 0; k < 4; ++k) { float best = cv[0]; int be = ce[0]; int bi = 0;
#pragma unroll
                for (int r = 1; r < 8; ++r) { const bool gt = (cv[r] > best) || (cv[r] == best && ce[r] < be); best = gt ? cv[r] : best; be = gt ? ce[r] : be; bi = gt ? r : bi; }
                tv[k] = best; te[k] = be;
#pragma unroll
                for (int r = 0; r < 8; ++r) cv[r] = (r == bi) ? -INFINITY : cv[r]; }
            const float e1 = __expf(tv[1] - tv[0]), e2 = __expf(tv[2] - tv[0]), e3 = __expf(tv[3] - tv[0]); const float inv = 1.f / (1.f + e1 + e2 + e3);
            tw[0] = inv; tw[1] = e1 * inv; tw[2] = e2 * inv; tw[3] = e3 * inv;
            if (h == 0) {
#pragma unroll
                for (int k = 0; k < 4; ++k) rl[k] = atomicAdd(&lcnt[te[k]], 1); }
        }
        __syncthreads();
        if (tid < 32) lbase[tid] = (int)atomicAdd(&gcnt[tid], (unsigned)lcnt[tid]);
        __syncthreads();
        if (kq == 0 && h == 0) {
#pragma unroll
            for (int k = 0; k < 4; ++k) { const int idx = te[k] * CAP + lbase[te[k]] + rl[k]; row_tok[idx] = token; row_w[idx] = tw[k]; row_slot[idx] = token * 4 + k; row_rstd[idx] = rstd; } }
        __syncthreads();
    }
}

__device__ __forceinline__ void build_block_table(const Params& p, int* bs) {
    const unsigned* gcnt = (const unsigned*)(p.ws + WS_CTL) + CW_CNT;
    if (threadIdx.x == 0) { int acc = 0; for (int e = 0; e < NE; ++e) { bs[e] = acc; acc += ((int)__hip_atomic_load(gcnt + e, __ATOMIC_RELAXED, __HIP_MEMORY_SCOPE_AGENT) + 255) >> 8; } bs[NE] = acc; }
    __syncthreads();
}

__device__ __forceinline__ pg8::MoeOrder make_moe_order(const Params& p, unsigned char* lds, int N, bool gather) {
    int* bs = (int*)(lds + 131072); int* utab = (int*)(lds + 131072 + 256); int* gtab = (int*)(lds + 131072 + 512); unsigned short* btab = (unsigned short*)(lds + 131072 + 512 + pg8::MOE_MAXU * 1024);
    build_block_table(p, bs);
    const int nmb = __builtin_amdgcn_readfirstlane(bs[NE]);
    pg8::MoeOrder S; S.so.init(nmb * 256, N, (int)gridDim.x, (int)blockIdx.x); S.utab = (const PG8_LAS int*)utab; S.gtab = (const PG8_LAS int*)gtab; S.btab = (const PG8_LAS unsigned short*)btab;
    const int* row_tok = (const int*)(p.ws + WS_RT2); const float* row_w = (const float*)(p.ws + WS_RT2 + 2 * MiB); const int* row_slot = (const int*)(p.ws + WS_RT2 + 4 * MiB); const float* row_rstd = (const float*)(p.ws + WS_RT2 + 6 * MiB);
    for (int i = 0; i < pg8::MOE_MAXU; ++i) { pg8::Unit u; if (!S.so.next(i, u)) break; int e = 0; for (int k = 1; k < NE; ++k) if (bs[k] <= u.pm) e = k;
        const int rb = e * CAP + (u.pm - bs[e]) * 256;
        if (threadIdx.x == 0) utab[i] = e | (rb << 8);
        if (threadIdx.x < 256) {
            { const int c = (int)threadIdx.x;
              const float bvv = gather ? p.b1[(size_t)e * 2048 + (c < 128 ? u.pn * 128 + c : DFF + u.pn * 128 + c - 128)] : p.b2[(size_t)e * DM + u.pn * 256 + c];
              btab[i * 256 + c] = (unsigned short)((__float_as_uint(bvv) + 0x7FFFu + ((__float_as_uint(bvv) >> 16) & 1u)) >> 16); }
            if (gather) { const float rs = row_rstd[rb + threadIdx.x]; const unsigned rb16 = (__float_as_uint(rs) + 0x8000u) & 0xFFFF0000u;
                          gtab[i * 256 + threadIdx.x] = (int)((unsigned)row_tok[rb + threadIdx.x] | rb16); }
            else { const int sl = row_slot[rb + threadIdx.x]; const float w = row_w[rb + threadIdx.x];
                   gtab[i * 256 + threadIdx.x] = sl < 0 ? 0 : ((sl + 1) | ((int)(fminf(fmaxf(w, 0.f), 1.f) * 32767.f + 0.5f) << 17)); } } }
    __syncthreads();
    return S;
}
__device__ __forceinline__ void phase_moe1(const Params& p, unsigned char* lds) {
    const pg8::MoeOrder S = make_moe_order(p, lds, 2048, true);
    pg8::Gemm g{(const bf16_t*)(p.ws + WS_H8), (const bf16_t*)(p.ws + WS_W1), 0, 2048, DM / 2, (size_t)2048 * DM, 0, 0};
    pg8::EpiSwiglu E{p.ws + WS_ACT, S.btab, S.gtab};
    pg8::gemm_phase<pg8::EpiSwiglu, pg8::MoeOrder, true, true, true, true>((PG8_LAS unsigned char*)lds, g, S, E);
}
__device__ __forceinline__ void phase_moe2(const Params& p, unsigned char* lds) {
    const pg8::MoeOrder S = make_moe_order(p, lds, DM, false);
    pg8::Gemm g{(const bf16_t*)(p.ws + WS_ACT), (const bf16_t*)(p.ws + WS_W2), 0, DM, DFF / 2, (size_t)DM * DFF, 0, 0};
    pg8::EpiMoeOut E{p.ws + WS_YS, S.btab, S.gtab};
    pg8::gemm_phase<pg8::EpiMoeOut, pg8::MoeOrder, true, true, true>((PG8_LAS unsigned char*)lds, g, S, E);
}

__device__ __forceinline__ float fp8_to_f32(unsigned w, int byte) {
    return byte == 0 ? __builtin_amdgcn_cvt_f32_fp8((int)w, 0) : byte == 1 ? __builtin_amdgcn_cvt_f32_fp8((int)w, 1) : byte == 2 ? __builtin_amdgcn_cvt_f32_fp8((int)w, 2) : __builtin_amdgcn_cvt_f32_fp8((int)w, 3); }
__device__ __forceinline__ void phase_combine(const Params& p) {
    const int tid = threadIdx.x, lane = tid & 63, wave = tid >> 6;
    const int gw = blockIdx.x * NWAVES + wave, NGW = gridDim.x * NWAVES;
    const unsigned char* YS = p.ws + WS_YS;
    for (int t = gw; t < NTOK; t += NGW) {
        f32x4* orow = (f32x4*)(p.out + (size_t)t * DM) + lane; const u32x2* xrow = (const u32x2*)((const bf16_t*)(p.ws + WS_X1B) + (size_t)t * DM) + lane;
        f32x4 v[4]; unsigned w[4][4];
#pragma unroll
        for (int j = 0; j < 4; ++j) { const u32x2 xb = xrow[64 * j]; v[j] = (f32x4){bf_lo(xb.x), bf_hi(xb.x), bf_lo(xb.y), bf_hi(xb.y)};
#pragma unroll
            for (int k = 0; k < 4; ++k) w[j][k] = *((const unsigned*)(YS + ((size_t)t * 4 + k) * DM) + lane + 64 * j); }
#pragma unroll
        for (int j = 0; j < 4; ++j) { f32x4 s = {0.f, 0.f, 0.f, 0.f};
#pragma unroll
            for (int k = 0; k < 4; ++k) { s[0] += fp8_to_f32(w[j][k], 0); s[1] += fp8_to_f32(w[j][k], 1); s[2] += fp8_to_f32(w[j][k], 2); s[3] += fp8_to_f32(w[j][k], 3); }
            orow[64 * j] = v[j] + s * YS_INV; }
    }
}

template <class Epi>
__device__ __forceinline__ void dense_gemm(unsigned char* lds, const bf16_t* A, const bf16_t* Bt, int M, int N, int K, const Epi& E, int lda = 0, int ldb = 0, int cshift = 0) {
    pg8::Gemm g{A, Bt, M, N, K, 0, lda, ldb}; pg8::StaticOrder S; S.init(M, N, (int)gridDim.x, (int)((blockIdx.x + cshift) % gridDim.x));
    pg8::gemm_phase<Epi, pg8::StaticOrder, true, true>((PG8_LAS unsigned char*)lds, g, S, E);
}

constexpr int NPHASE = 13;
__global__ void __launch_bounds__(NTHREADS, 2) mk_fwd(Params p) {
    extern __shared__ __attribute__((aligned(16))) unsigned char lds[];
    cg::grid_group grid = cg::this_grid();
    unsigned char* ws = p.ws;
    volatile LAS unsigned* MISC = (volatile LAS unsigned*)((LAS unsigned char*)lds + MISC_OFF);
    if (threadIdx.x < 32) MISC[threadIdx.x] = 0u;
    __syncthreads();
    XcdBarrier bar = xcd_barrier_post((unsigned*)(ws + WS_CTL) + CW_BAR, MISC + 8);
    const int lo = p.ph_lo, hi = p.ph_hi;
    if (lo < 0) grid.sync();
#define IN(k) (lo <= (k) && (k) < hi)
#define SEAM(k) do { if (IN(k) && IN((k) + 1)) xcd_barrier(bar); } while (0)
    if (IN(0)) phase_prologue(p, lds);
    SEAM(0);
    if (IN(1)) { pg8::EpiProj E{(bf16_t*)(ws + WS_PROJ), (float*)(ws + WS_SSQ)}; dense_gemm(lds, (const bf16_t*)(ws + WS_XN), (const bf16_t*)(ws + WS_WIN), NTOK, INCP, DM, E); }
    if (IN(1) && IN(3)) xcd_barrier(bar);
    if (IN(3)) { const float* ssq = (const float*)(ws + WS_SSQ); const float* cst = (const float*)(ws + WS_CS); float* hs = (float*)(lds + 131072);
                 pg8::EpiQ Eq{ws + WS_Q, ssq, p.q_g, cst, hs}; dense_gemm(lds, (const bf16_t*)(ws + WS_PROJ) + OFF_CQ, (const bf16_t*)(ws + WS_WUQ), NTOK, 1024, QLORA, Eq, INCP);
                 pg8::EpiK Ek{ws + WS_K, ssq, p.k_g, cst, (const bf16_t*)(ws + WS_PROJ), hs, (const float*)(ws + WS_SHIFT)}; dense_gemm(lds, (const bf16_t*)(ws + WS_PROJ) + OFF_CKV, (const bf16_t*)(ws + WS_WUKV), NTOK, 512, KVLORA, Ek, INCP);
                 pg8::EpiVT Ev{ws + WS_V, ssq}; dense_gemm(lds, (const bf16_t*)(ws + WS_WUKV) + 512 * KVLORA, (const bf16_t*)(ws + WS_PROJ) + OFF_CKV, 512, NTOK, KVLORA, Ev, 0, INCP, (int)gridDim.x / 2);
                 phase_conv(p); }
    if (IN(3) && IN(5)) xcd_barrier(bar);
    if (IN(5)) phase_attn(p, lds);
    SEAM(5);
    if (IN(6)) { pg8::EpiGateA E{(bf16_t*)(ws + WS_M1), (const bf16_t*)(ws + WS_PROJ)}; dense_gemm(lds, (const bf16_t*)(ws + WS_AO), (const bf16_t*)(ws + WS_WOMLA), NTOK, DM, 512, E); }
    if (IN(7)) { pg8::EpiGateB E{(const bf16_t*)(ws + WS_M1), (const bf16_t*)(ws + WS_PROJ), (bf16_t*)(ws + WS_MERGED)}; dense_gemm(lds, (const bf16_t*)(ws + WS_YBIN), (const bf16_t*)(ws + WS_WOCONV), NTOK, DM, 512, E); }
    SEAM(7);
    if (IN(8)) { pg8::EpiResid E{p.x, (bf16_t*)(ws + WS_X1B)}; dense_gemm(lds, (const bf16_t*)(ws + WS_MERGED), (const bf16_t*)(ws + WS_WO), NTOK, DM, DM, E); }
    SEAM(8);
    if (IN(9)) { wconv_cleanup(p, lds); phase_router(p, lds); }
    if (IN(9) && IN(11)) xcd_barrier(bar);
    if (IN(11)) phase_moe1(p, lds);
    SEAM(11);
    if (IN(12)) phase_moe2(p, lds);
    SEAM(12);
    if (IN(13)) phase_combine(p);
#undef IN
#undef SEAM
}

extern "C" void kernel_launch(void* const* d_in, const int* in_sizes, int n_in, void* d_out, int out_size,
                              void* d_ws, size_t ws_size, hipStream_t stream) {
    static int grid_blocks = 0;
    if (!grid_blocks) {
        int dev = 0, cus = 0, per_cu = 0;
        (void)hipGetDevice(&dev);
        (void)hipDeviceGetAttribute(&cus, hipDeviceAttributeMultiprocessorCount, dev);
        (void)hipFuncSetAttribute((const void*)mk_fwd, hipFuncAttributeMaxDynamicSharedMemorySize, LDS_BYTES);
        (void)hipOccupancyMaxActiveBlocksPerMultiprocessor(&per_cu, (const void*)mk_fwd, NTHREADS, LDS_BYTES);
        if (per_cu < 1) { fprintf(stderr, "kernel_launch: occupancy query says %d blocks/CU\n", per_cu); per_cu = 1; }
        grid_blocks = cus;
        if (ws_size < WS_END2 || n_in != 21) fprintf(stderr, "kernel_launch: ws %zu < %zu or n_in %d != 21\n", ws_size, (size_t)WS_END2, n_in);
    }
    (void)hipMemsetAsync((char*)d_ws + WS_CTL, 0, 32 * 1024, stream);
    Params p{};
    p.x = (const float*)d_in[0]; p.pos = (const int*)d_in[1]; p.norm1_g = (const float*)d_in[2]; p.w_in = (const float*)d_in[3]; p.q_a_g = (const float*)d_in[4];
    p.kv_a_g = (const float*)d_in[5]; p.w_uq = (const float*)d_in[6]; p.w_ukv = (const float*)d_in[7]; p.q_g = (const float*)d_in[8]; p.k_g = (const float*)d_in[9];
    p.conv_w = (const float*)d_in[10]; p.w_o_mla = (const float*)d_in[11]; p.w_o_conv = (const float*)d_in[12]; p.w_o = (const float*)d_in[13]; p.norm2_g = (const float*)d_in[14];
    p.router_w = (const float*)d_in[15]; p.router_b = (const float*)d_in[16]; p.w1 = (const float*)d_in[17]; p.b1 = (const float*)d_in[18]; p.w2 = (const float*)d_in[19]; p.b2 = (const float*)d_in[20];
    p.out = (float*)d_out; p.ws = (unsigned char*)d_ws; p.ph_lo = 0; p.ph_hi = NPHASE + 1;
    void* args[] = {&p};
    hipError_t e = hipLaunchCooperativeKernel((const void*)mk_fwd, dim3(grid_blocks), dim3(NTHREADS), args, LDS_BYTES, stream);
    if (e != hipSuccess) fprintf(stderr, "cooperative launch failed: %s (grid %d)\n", hipGetErrorString(e), grid_blocks);
}
```
